# Optimizing an MI355X kernel written in HIP

```python
import math
import jax, jax.numpy as jnp
from jax import lax
import numpy as np

D_MODEL = 1024
BATCH = 2
SEQ = 16384
DEPTH = 4

GRID_W = 64
CTX_LEN = 256
N_MIXERS = 2
EPS = 1e-6
N_MOD = 6

POOL_WINDOWS = (2, 4, 8, 16)
N_POOL_GROUPS = len(POOL_WINDOWS)
POOL_GROUP = D_MODEL // N_POOL_GROUPS

SSD_EXPAND = 2
D_INNER = SSD_EXPAND * D_MODEL
HEAD_DIM = 64
N_SSD_HEADS = D_INNER // HEAD_DIM
N_SSD_GROUPS = 4
HEADS_PER_GROUP = N_SSD_HEADS // N_SSD_GROUPS
D_STATE = 128
D_CONV = 4
CONV_PAD_LEFT = 2
CONV_PAD_RIGHT = D_CONV - 1 - CONV_PAD_LEFT
CHUNK = 128
BC_DIM = N_SSD_GROUPS * D_STATE
CONV_DIM = D_INNER + 2 * BC_DIM
IN_PROJ_DIM = D_INNER + CONV_DIM + 2 * N_SSD_HEADS

D_FF = 2816
N_EXPERTS = 8
TOP_K = 2
D_FF_EXPERT = 3584

N_EVEN_LAYERS = (DEPTH + 1) // 2
N_ODD_LAYERS = DEPTH // 2

kernel_name = "hybrid_pool_ssd_moe_dit_prefix"


def rmsnorm(x, w):
    xf = x.astype(jnp.float32)
    y = xf * lax.rsqrt(jnp.mean(xf * xf, axis=-1, keepdims=True) + EPS)
    return (y * w.astype(jnp.float32)).astype(x.dtype)


def modulate(h, shift, scale):
    return h * (1 + scale) + shift


def window_mean_minus_self(x, w):
    L = x.shape[1]
    lo = w // 2
    hi = w - 1 - lo
    cs = jnp.pad(jnp.cumsum(x.astype(jnp.float32), axis=1), ((0, 0), (1, 0), (0, 0)))
    t = jnp.arange(L)
    end = jnp.minimum(t + hi + 1, L)
    start = jnp.maximum(t - lo, 0)
    s = jnp.take(cs, end, axis=1) - jnp.take(cs, start, axis=1)
    cnt = (end - start).astype(jnp.float32)
    return (s / cnt[None, :, None]).astype(x.dtype) - x


def pool_mix(h, w_groups, scale):
    parts = [window_mean_minus_self(h[..., g * POOL_GROUP:(g + 1) * POOL_GROUP], w)
             for g, w in enumerate(POOL_WINDOWS)]
    p = jnp.stack(parts, axis=-2)
    y = jnp.einsum('nlgi,gio->nlgo', p, w_groups).reshape(h.shape)
    return y * scale


def dwconv_centred(x, w, b):
    L = x.shape[1]
    xp = jnp.pad(x, ((0, 0), (CONV_PAD_LEFT, CONV_PAD_RIGHT), (0, 0)))
    y = b
    for k in range(D_CONV):
        y = y + xp[:, k:k + L] * w[k]
    return y


def ssd_chunked(x, dt, A, B, C, h0, need_y):
    b, L = x.shape[:2]
    nc = L // CHUNK
    xd = (x * dt[..., None]).reshape(b, nc, CHUNK, N_SSD_GROUPS, HEADS_PER_GROUP, HEAD_DIM)
    a = (dt * A).astype(jnp.float32).reshape(b, nc, CHUNK, N_SSD_GROUPS, HEADS_PER_GROUP)
    a_cum = jnp.cumsum(jnp.transpose(a, (0, 3, 4, 1, 2)), axis=-1)
    Bc = B.reshape(b, nc, CHUNK, N_SSD_GROUPS, D_STATE)
    Cc = C.reshape(b, nc, CHUNK, N_SSD_GROUPS, D_STATE)
    decay_to_end = jnp.exp(a_cum[..., -1:] - a_cum)
    states = jnp.einsum('bcsgn,bgecs,bcsgep->cbgepn', Bc, decay_to_end, xd).astype(jnp.float32)
    chunk_decay = jnp.moveaxis(jnp.exp(a_cum[..., -1]), -1, 0)

    def step(h, inp):
        s, d = inp
        return h * d[..., None, None] + s, h

    h_final, h_init = lax.scan(step, h0, (states, chunk_decay))
    if not need_y:
        return None, h_final
    seg = a_cum[..., :, None] - a_cum[..., None, :]
    lower = jnp.tril(jnp.ones((CHUNK, CHUNK), dtype=bool))
    Lmat = jnp.exp(jnp.where(lower, seg, -jnp.inf))
    CB = jnp.einsum('bclgn,bcsgn->bgcls', Cc, Bc)
    y_diag = jnp.einsum('bgcls,bgecls,bcsgep->bclgep', CB, Lmat, xd)
    y_off = jnp.einsum('bclgn,cbgepn,bgecl->bclgep', Cc, h_init, jnp.exp(a_cum))
    y = (y_diag + y_off).reshape(b, L, N_SSD_HEADS, HEAD_DIM)
    return y, h_final


def ssd_mixer(u_ctx, u_lat, in_w, conv_w, conv_b, A_log, dt_bias, D_skip, norm_w, out_w, ctx_out):
    A = -jnp.exp(A_log.astype(jnp.float32))

    def flip(t):
        return jnp.flip(t, axis=1)

    def bidir(u, h0_f, h0_b, need_y):
        bsz, L = u.shape[:2]
        proj = u @ in_w
        z = proj[..., :D_INNER]
        xbc = jax.nn.silu(dwconv_centred(proj[..., D_INNER:D_INNER + CONV_DIM], conv_w, conv_b))
        dt = jax.nn.softplus(
            proj[..., D_INNER + CONV_DIM:].astype(jnp.float32).reshape(bsz, L, 2, N_SSD_HEADS) + dt_bias)
        xs = xbc[..., :D_INNER].reshape(bsz, L, N_SSD_HEADS, HEAD_DIM)
        Bm = xbc[..., D_INNER:D_INNER + BC_DIM].reshape(bsz, L, N_SSD_GROUPS, D_STATE)
        Cm = xbc[..., D_INNER + BC_DIM:].reshape(bsz, L, N_SSD_GROUPS, D_STATE)
        y_f, hf = ssd_chunked(xs, dt[:, :, 0], A[0], Bm, Cm, h0_f, need_y)
        y_b, hb = ssd_chunked(flip(xs), flip(dt[:, :, 1]), A[1], flip(Bm), flip(Cm), h0_b, need_y)
        if not need_y:
            return None, hf, hb
        y = y_f + flip(y_b) + xs * D_skip[:, None]
        y = y.reshape(bsz, L, D_INNER).astype(u.dtype)
        y = rmsnorm(y * jax.nn.silu(z), norm_w) @ out_w
        return y, hf, hb

    zero = jnp.zeros((u_ctx.shape[0], N_SSD_GROUPS, HEADS_PER_GROUP, HEAD_DIM, D_STATE), jnp.float32)
    y_ctx, hf, hb = bidir(u_ctx, zero, zero, ctx_out)
    y_lat, _, _ = bidir(u_lat, hf, hb, True)
    return y_ctx, y_lat


def swiglu(h, w1, w3, w2):
    return (jax.nn.silu(h @ w1) * (h @ w3)) @ w2


def moe_swiglu(h, router_w, w1, w3, w2):
    logits = (h @ router_w).astype(jnp.float32)
    top_v, top_i = lax.top_k(logits, TOP_K)
    gates = jax.nn.softmax(top_v, axis=-1)
    combine = jnp.sum(jax.nn.one_hot(top_i, N_EXPERTS, dtype=jnp.float32) * gates[..., None], axis=-2)
    combine = combine.astype(h.dtype)
    out = jnp.zeros_like(h)
    for e in range(N_EXPERTS):
        out = out + combine[..., e:e + 1] * swiglu(h, w1[e], w3[e], w2[e])
    return out


def setup_inputs(seed: int = 0) -> dict:
    key = jax.random.key(seed)
    ks = jax.random.split(key, 28)
    f32 = jnp.float32

    def nrm(k, shape, s):
        return jax.random.normal(k, shape, f32) * s

    dt0 = jnp.exp(jax.random.uniform(ks[14], (N_ODD_LAYERS, 2, N_SSD_HEADS), f32,
                                     math.log(1e-3), math.log(1e-1)))
    return {
        "x": nrm(ks[0], (BATCH, SEQ, D_MODEL), 1.0),
        "c": nrm(ks[1], (BATCH, D_MODEL), 1.0),
        "ctx": nrm(ks[2], (BATCH, CTX_LEN, D_MODEL), 1.0),
        "c_ctx": nrm(ks[3], (D_MODEL,), 1.0),
        "ada_w": nrm(ks[4], (DEPTH, D_MODEL, N_MOD * D_MODEL), 0.5 * D_MODEL ** -0.5),
        "ada_b": nrm(ks[5], (DEPTH, N_MOD * D_MODEL), 0.02),
        "norm_mix_w": 1.0 + nrm(ks[6], (DEPTH, D_MODEL), 0.01),
        "norm_ffn_w": 1.0 + nrm(ks[7], (DEPTH, D_MODEL), 0.01),
        "pool_w": nrm(ks[8], (N_EVEN_LAYERS, N_POOL_GROUPS, POOL_GROUP, POOL_GROUP), POOL_GROUP ** -0.5),
        "pool_scale": 1.0 + nrm(ks[9], (N_EVEN_LAYERS, D_MODEL), 0.1),
        "ssd_in_w": nrm(ks[10], (N_ODD_LAYERS, D_MODEL, IN_PROJ_DIM), D_MODEL ** -0.5),
        "ssd_conv_w": nrm(ks[11], (N_ODD_LAYERS, D_CONV, CONV_DIM), D_CONV ** -0.5),
        "ssd_conv_b": nrm(ks[12], (N_ODD_LAYERS, CONV_DIM), 0.02),
        "ssd_A_log": jnp.log(jax.random.uniform(ks[13], (N_ODD_LAYERS, 2, N_SSD_HEADS), f32, 1.0, 16.0)),
        "ssd_dt_bias": dt0 + jnp.log(-jnp.expm1(-dt0)),
        "ssd_D": 1.0 + nrm(ks[15], (N_ODD_LAYERS, N_SSD_HEADS), 0.1),
        "ssd_norm_w": 1.0 + nrm(ks[16], (N_ODD_LAYERS, D_INNER), 0.01),
        "ssd_out_w": nrm(ks[17], (N_ODD_LAYERS, D_INNER, D_MODEL), D_INNER ** -0.5),
        "ffn_w1": nrm(ks[18], (N_EVEN_LAYERS, D_MODEL, D_FF), D_MODEL ** -0.5),
        "ffn_w3": nrm(ks[19], (N_EVEN_LAYERS, D_MODEL, D_FF), D_MODEL ** -0.5),
        "ffn_w2": nrm(ks[20], (N_EVEN_LAYERS, D_FF, D_MODEL), D_FF ** -0.5),
        "moe_router_w": nrm(ks[21], (N_ODD_LAYERS, D_MODEL, N_EXPERTS), D_MODEL ** -0.5),
        "moe_w1": nrm(ks[22], (N_ODD_LAYERS, N_EXPERTS, D_MODEL, D_FF_EXPERT), D_MODEL ** -0.5),
        "moe_w3": nrm(ks[23], (N_ODD_LAYERS, N_EXPERTS, D_MODEL, D_FF_EXPERT), D_MODEL ** -0.5),
        "moe_w2": nrm(ks[24], (N_ODD_LAYERS, N_EXPERTS, D_FF_EXPERT, D_MODEL), D_FF_EXPERT ** -0.5),
        "final_norm_w": 1.0 + nrm(ks[25], (D_MODEL,), 0.01),
    }


def reference(x, c, ctx, c_ctx, ada_w, ada_b, norm_mix_w, norm_ffn_w, pool_w, pool_scale,
              ssd_in_w, ssd_conv_w, ssd_conv_b, ssd_A_log, ssd_dt_bias, ssd_D, ssd_norm_w, ssd_out_w,
              ffn_w1, ffn_w3, ffn_w2, moe_router_w, moe_w1, moe_w3, moe_w2, final_norm_w):
    bsz, n_lat, d = x.shape
    rows = n_lat // GRID_W
    c_act = jax.nn.silu(c)
    cc_act = jax.nn.silu(c_ctx)[None]
    h_lat, h_ctx = x, ctx
    for i in range(DEPTH):
        last = i == DEPTH - 1
        j = i // 2
        mod_lat = jnp.split((c_act @ ada_w[i] + ada_b[i])[:, None, :], N_MOD, axis=-1)
        mod_ctx = jnp.split((cc_act @ ada_w[i] + ada_b[i])[:, None, :], N_MOD, axis=-1)
        sh1, sc1, g1, sh2, sc2, g2 = mod_lat
        sh1c, sc1c, g1c, sh2c, sc2c, g2c = mod_ctx

        u_lat = modulate(rmsnorm(h_lat, norm_mix_w[i]), sh1, sc1)
        if i % N_MIXERS == 0:
            y_lat = pool_mix(u_lat.reshape(bsz * rows, GRID_W, d), pool_w[j], pool_scale[j]).reshape(bsz, n_lat, d)
            if not last:
                u_ctx = modulate(rmsnorm(h_ctx, norm_mix_w[i]), sh1c, sc1c)
                y_ctx = pool_mix(u_ctx, pool_w[j], pool_scale[j])
        else:
            u_ctx = modulate(rmsnorm(h_ctx, norm_mix_w[i]), sh1c, sc1c)
            y_ctx, y_lat = ssd_mixer(u_ctx, u_lat, ssd_in_w[j], ssd_conv_w[j], ssd_conv_b[j], ssd_A_log[j],
                                     ssd_dt_bias[j], ssd_D[j], ssd_norm_w[j], ssd_out_w[j], not last)
        h_lat = h_lat + g1 * y_lat
        if not last:
            h_ctx = h_ctx + g1c * y_ctx

        v_lat = modulate(rmsnorm(h_lat, norm_ffn_w[i]), sh2, sc2)
        if i % 2 == 0:
            h_lat = h_lat + g2 * swiglu(v_lat, ffn_w1[j], ffn_w3[j], ffn_w2[j])
        else:
            h_lat = h_lat + g2 * moe_swiglu(v_lat, moe_router_w[j], moe_w1[j], moe_w3[j], moe_w2[j])
        if not last:
            v_ctx = modulate(rmsnorm(h_ctx, norm_ffn_w[i]), sh2c, sc2c)
            if i % 2 == 0:
                h_ctx = h_ctx + g2c * swiglu(v_ctx, ffn_w1[j], ffn_w3[j], ffn_w2[j])
            else:
                h_ctx = h_ctx + g2c * moe_swiglu(v_ctx, moe_router_w[j], moe_w1[j], moe_w3[j], moe_w2[j])
    return rmsnorm(h_lat, final_norm_w)
```

```cpp
#ifndef EMU
#include <hip/hip_runtime.h>
#endif
#include <cstdio>
#include <cstdint>

#ifndef CFG_SEQ
#define CFG_SEQ 16384
#endif
#ifndef CFG_DFF
#define CFG_DFF 2816
#endif
#ifndef CFG_DFFE
#define CFG_DFFE 3584
#endif
#ifndef N_LAUNCH_MODE
#define N_LAUNCH_MODE 1
#endif

#ifdef EMU
#define LAS
#define DEV inline
#define WAITV(n) ((void)0)
#define WAITL(n) ((void)0)
#define SBAR() emu_wg_sync()
#define SCHED() ((void)0)
#define SETPRIO(x) ((void)0)
#define MFMA16(a, b, c) emu_mfma16(a, b, c)
#define GLDS16(g, l) emu_glds16((const void*)(g), (void*)(l))
#define RFL(x) emu_rfl(x)
#define MEMFENCE() ((void)0)
#define WSYNC() emu_wave_sync()
#define LAUNDER_V(x) ((void)0)
#define SLEEP1() emu_yield()
#define MY_XCC_ID() ((unsigned)(blockIdx.x & 7u))
#define FENCE_REL() __atomic_thread_fence(__ATOMIC_SEQ_CST)
#define FENCE_ACQ() __atomic_thread_fence(__ATOMIC_SEQ_CST)
#define FEXP(x) expf(x)
#define RLX_AGENT __ATOMIC_RELAXED, 4
#else
#define LAS __attribute__((address_space(3)))
#define DEV __device__ __forceinline__
#define WAITV(n) asm volatile("s_waitcnt vmcnt(" #n ")" ::: "memory")
#define WAITL(n) asm volatile("s_waitcnt lgkmcnt(" #n ")" ::: "memory")
#define SBAR() __builtin_amdgcn_s_barrier()
#define SCHED() __builtin_amdgcn_sched_barrier(0)
#define SETPRIO(x) __builtin_amdgcn_s_setprio(x)
#define MFMA16(a, b, c) __builtin_amdgcn_mfma_f32_16x16x32_bf16(a, b, c, 0, 0, 0)
#define GLDS16(g, l) __builtin_amdgcn_global_load_lds((const unsigned*)(g), (LAS unsigned*)(l), 16, 0, 0)
#define RFL(x) __builtin_amdgcn_readfirstlane(x)
#define MEMFENCE() asm volatile("" ::: "memory")
#define WSYNC() asm volatile("s_waitcnt lgkmcnt(0)" ::: "memory")
#define SLEEP1() __builtin_amdgcn_s_sleep(1)
#define MY_XCC_ID() ((unsigned)__builtin_amdgcn_s_getreg((3 << 11) | 20) & 0xFu)
#define FENCE_REL() __builtin_amdgcn_fence(__ATOMIC_RELEASE, "agent")
#define FENCE_ACQ() __builtin_amdgcn_fence(__ATOMIC_ACQUIRE, "agent")
#define FEXP(x) __expf(x)
#define RLX_AGENT __ATOMIC_RELAXED, __HIP_MEMORY_SCOPE_AGENT
#define LAUNDER_V(x) asm volatile("" : "+v"(x))
#endif

typedef unsigned short bf16_t;
typedef short bf16x8 __attribute__((ext_vector_type(8)));
typedef float f32x4 __attribute__((ext_vector_type(4)));
typedef float f32x2 __attribute__((ext_vector_type(2)));
typedef unsigned u32x4 __attribute__((ext_vector_type(4)));
typedef unsigned u32x2 __attribute__((ext_vector_type(2)));

constexpr int D = 1024, NB = 2, SEQ = CFG_SEQ, CTXL = 256, DEPTH = 4;
constexpr int ML = NB * SEQ, MC = NB * CTXL, MT = ML + MC, NPAN = MT / 256;
constexpr int DFF = CFG_DFF, DFFE = CFG_DFFE, NEXP = 8;
constexpr int DIN = 2048, NH = 32, HD = 64, NG = 4, DS = 128, CONVD = 3072, NPROJ = 5184, NPROJP = 5376, BCD = 512;
constexpr int TV = CTXL + SEQ, NCH = TV / 128;
constexpr int GRIDW = 64;
constexpr float EPS = 1e-6f;
constexpr int NSLOT_TILES = (2 * MT) / 256 + NEXP, NSLOT = NSLOT_TILES * 256;
static_assert(SEQ % 128 == 0 && ML % 256 == 0 && DFF % 128 == 0 && DFFE % 128 == 0 && DFF >= 256 && DFFE >= 256, "shape constraints");

constexpr size_t MiB = 1u << 20;
constexpr size_t al(size_t x) { return (x + 4095) & ~(size_t)4095; }
constexpr size_t OFF_CTL = 0, CTL_BYTES = 1 * MiB;
constexpr size_t OFF_MOD = 1 * MiB;
constexpr size_t OFF_TOK = 2 * MiB;
constexpr size_t OFF_S2T = 3 * MiB;
constexpr size_t OFF_H = 4 * MiB, SZ_H = (size_t)MT * D * 4;
constexpr size_t OFF_W = OFF_H + al(SZ_H);
constexpr size_t W_POOL = 0, SZ_WPOOL = (size_t)4 * 256 * 256 * 2;
constexpr size_t W_UP = al(SZ_WPOOL), SZ_WUP = (size_t)2 * DFF * D * 2;
constexpr size_t W_DN = W_UP + al(SZ_WUP), SZ_WDN = (size_t)D * DFF * 2;
constexpr size_t SZ_WEVEN = W_DN + al(SZ_WDN);
constexpr size_t W_IN = 0, SZ_WIN = (size_t)NPROJP * D * 2;
constexpr size_t W_OUT = al(SZ_WIN), SZ_WOUT = (size_t)D * DIN * 2;
constexpr size_t W_DT = W_OUT + al(SZ_WOUT), SZ_DT = (size_t)NB * 2 * NH * TV * 4;
constexpr size_t W_MUP = W_DT + al(SZ_DT), SZ_WMUP = (size_t)NEXP * 2 * DFFE * D * 2;
constexpr size_t W_MDN = W_MUP + al(SZ_WMUP), SZ_WMDN = (size_t)NEXP * D * DFFE * 2;
constexpr size_t W_YB = W_MUP, SZ_Y = (size_t)MT * DIN * 2;
constexpr size_t SZ_WODD_A = W_MDN + al(SZ_WMDN), SZ_WODD_B = W_YB + al(SZ_Y);
constexpr size_t mx(size_t a, size_t b) { return a > b ? a : b; }
constexpr size_t SZ_W = mx(SZ_WEVEN, mx(SZ_WODD_A, SZ_WODD_B));
constexpr size_t OFF_ACT = OFF_W + SZ_W;
constexpr size_t A_P = 0, SZ_ACT1 = (size_t)MT * D * 2;
constexpr size_t A_HID = al(SZ_ACT1), SZ_HID = (size_t)MT * DFF * 2;
constexpr size_t SZ_AEVEN = A_HID + al(SZ_HID);
constexpr size_t A_Z = 0;
constexpr size_t A_XBC = al(SZ_Y), SZ_XBC = (size_t)MT * CONVD * 2;
constexpr size_t A_YF = A_XBC;
constexpr size_t A_CB = A_XBC + al(SZ_Y), SZ_CB = (size_t)NB * NG * NCH * 128 * 128 * 2;
static_assert(al(SZ_Y) + SZ_CB <= SZ_XBC, "CB fits behind Yf inside the XBC region");
constexpr size_t A_XT = A_XBC + al(SZ_XBC), SZ_XT = (size_t)NB * DIN * TV * 2;
constexpr size_t A_U = A_XT, A_YN = A_XT;
constexpr size_t A_BROW = A_XT + al(SZ_XT), SZ_BC = (size_t)MT * BCD * 2;
constexpr size_t A_BT = A_BROW + al(SZ_BC);
constexpr size_t A_CROW = A_BT + al(SZ_BC);
constexpr size_t SZ_ASSD = A_CROW + al(SZ_BC);
constexpr size_t A_V = 0;
constexpr size_t A_HIDM = al(SZ_ACT1), SZ_HIDM = (size_t)NSLOT * DFFE * 2;
constexpr size_t A_YS = A_HIDM + al(SZ_HIDM), SZ_YS = (size_t)NSLOT * D * 2;
constexpr size_t SZ_AMOE = A_YS + al(SZ_YS);
constexpr size_t SZ_ACT = mx(SZ_AEVEN, mx(SZ_ASSD, SZ_AMOE));
constexpr size_t WS_NEED = OFF_ACT + SZ_ACT;

constexpr int CW_BAR = 4096;
constexpr int CW_CNT = 16384;
constexpr int CW_CUR = 16384 + 2 * 8 * 64;

DEV unsigned f2bf(float f) { unsigned u = __builtin_bit_cast(unsigned, f); return (u + 0x7fffu + ((u >> 16) & 1u)) >> 16; }
#ifndef EMU
typedef __bf16 bf16x2n __attribute__((ext_vector_type(2)));
#endif
DEV unsigned pk2(float lo, float hi) {
#ifdef EMU
    return f2bf(lo) | (f2bf(hi) << 16);
#else
    f32x2 v = {lo, hi}; bf16x2n b = __builtin_convertvector(v, bf16x2n); return __builtin_bit_cast(unsigned, b);
#endif
}
DEV float bf2f(unsigned b) { return __builtin_bit_cast(float, b << 16); }
DEV float bflo(unsigned w) { return __builtin_bit_cast(float, w << 16); }
DEV float bfhi(unsigned w) { return __builtin_bit_cast(float, w & 0xffff0000u); }
#ifdef EMU
DEV float frcp(float x) { return 1.0f / x; }
#else
DEV float frcp(float x) { return __builtin_amdgcn_rcpf(x); }
#endif
DEV float siluf(float x) { return x * frcp(1.0f + FEXP(-x)); }
DEV float softplusf(float x) { return x > 20.f ? x : log1pf(expf(x)); }
DEV float wave_sum(float v) {
#pragma unroll
    for (int o = 1; o < 64; o <<= 1) v += __shfl_xor(v, o);
    return v;
}
DEV int vec_of(int r) { return r < ML ? (r / SEQ) : 2; }
DEV int row_of(int b, int tv) { return tv < CTXL ? ML + b * CTXL + tv : b * SEQ + (tv - CTXL); }

#define XB_TMO      128
#define XB_XCNT(j)  (256  + 64 * (j))
#define XB_XSUB(j)  (1280 + 64 * (j))
#define XB_XGEN(j)  (2304 + 64 * (j))
#define XB_TOP      3328
#define XB_TOPGEN   3392
#define XCD_BAR_WORDS 3456
#define XB_SPIN_CAP (1u << 22)
DEV unsigned xb_ld(unsigned* p)              { return __hip_atomic_load(p, RLX_AGENT); }
DEV unsigned xb_add(unsigned* p, unsigned v) { return __hip_atomic_fetch_add(p, v, RLX_AGENT); }
#define XB_SPIN(cond, bar) do { unsigned _sp = 0; while (cond) { SLEEP1(); \
    if ((++_sp & 255u) == 0u) { if (xb_ld(&(bar)[XB_TMO])) break; if (_sp > XB_SPIN_CAP) { atomicAdd(&(bar)[XB_TMO], 1u); break; } } } } while (0)
struct XcdBarrier { unsigned* bar; unsigned x; volatile LAS unsigned* st; };
DEV XcdBarrier xcd_barrier_post(unsigned* bar, volatile LAS unsigned* st) {
    XcdBarrier b; b.bar = bar; b.x = MY_XCC_ID(); b.st = st;
    if (threadIdx.x == 0) (void)xb_add(&bar[XB_XCNT(b.x)], 1u);
    return b;
}
DEV void xcd_barrier_complete(unsigned* bar, unsigned x, unsigned& nloc, unsigned& nx) {
    const unsigned G = gridDim.x;
    unsigned sum, cnt, mine, sp = 0u;
    for (;;) {
        sum = 0u; cnt = 0u; mine = 0u;
#pragma unroll
        for (unsigned j = 0; j < 16; ++j) { const unsigned c = xb_ld(&bar[XB_XCNT(j)]); sum += c; cnt += (c > 0u) ? 1u : 0u; mine = (j == x) ? c : mine; }
        if (sum == G) break;
        SLEEP1();
        if ((++sp & 255u) == 0u) { if (xb_ld(&bar[XB_TMO])) break; if (sp > XB_SPIN_CAP) { atomicAdd(&bar[XB_TMO], 1u); break; } }
    }
    nloc = mine > 0u ? mine : 1u; nx = cnt > 0u ? cnt : 1u;
}
DEV void xcd_barrier(const XcdBarrier& b) {
    WAITV(0);
    __syncthreads();
    if (threadIdx.x == 0) {
        unsigned* bar = b.bar;
#ifndef EMU
        __builtin_amdgcn_s_waitcnt(0);
#endif
        unsigned nloc = b.st[0], nx = b.st[1];
        if (nloc == 0u) { xcd_barrier_complete(bar, b.x, nloc, nx); b.st[0] = nloc; b.st[1] = nx; }
        const unsigned old = xb_add(&bar[XB_XSUB(b.x)], 1u);
        const unsigned gen = old / nloc;
        if (old + 1u == (gen + 1u) * nloc) {
            FENCE_REL();
            WAITV(0);
            const unsigned og = xb_add(&bar[XB_TOP], 1u);
            const unsigned tg = og / nx;
            if (og + 1u == (tg + 1u) * nx) xb_add(&bar[XB_TOPGEN], 1u);
            else XB_SPIN(xb_ld(&bar[XB_TOPGEN]) == tg, bar);
            FENCE_ACQ();
            xb_add(&bar[XB_XGEN(b.x)], 1u);
            WAITV(0);
        } else {
            XB_SPIN(xb_ld(&bar[XB_XGEN(b.x)]) == gen, bar);
            FENCE_ACQ();
            WAITV(0);
        }
    }
    __syncthreads();
}

namespace ge {
constexpr int BM = 256, BK = 64, HALF = 128, HTB = HALF * BK * 2, STAGE_BYTES = 8 * HTB, NXCD = 8, WGM = 8;
DEV int lds_byte(int r, int c) { const int st = (r >> 4) * 2 + (c >> 5), rr = r & 15, cc = c & 31, ob = rr * 64 + cc * 2; return st * 1024 + (ob ^ (((ob >> 9) & 1) << 5)); }
DEV void stage_rc(int b, int& R, int& C) { const int st = b / 1024, sb = b % 1024, swz = sb ^ (((sb >> 9) & 1) << 5); R = (st >> 1) * 16 + swz / 64; C = (st & 1) * 32 + (swz % 64) / 2; }
DEV int perm32(int rho) { const int n = rho >> 4, i = rho & 15; return 8 * (i >> 2) + 4 * n + (i & 3); }
struct Unit { int pm, pn; };
DEV bool static_next(int nM, int nN, int G, int c, int i, Unit& u) {
    const int nwg = nM * nN; const long L = (long)i * G + c; if (L >= nwg) return false;
    int wgid = (int)L; { const int q = nwg / NXCD, r = nwg % NXCD, xcd = wgid % NXCD, off = wgid / NXCD; wgid = (xcd < r ? xcd * (q + 1) : r * (q + 1) + (xcd - r) * q) + off; }
    const int nig = WGM * nN, gid = wgid / nig, fm = gid * WGM, gsz = (nM - fm) < WGM ? (nM - fm) : WGM;
    u.pm = fm + ((wgid % nig) % gsz); u.pn = (wgid % nig) / gsz; return true;
}
template <class P>
DEV void gemm_phase(LAS unsigned char* lds, const P& S, const int tid) {
    const int wid = RFL(tid >> 6), lane = tid & 63, wr = wid >> 2, wc = wid & 3, fr = lane & 15, fq = lane >> 4;
    const int K = S.K, nt = K / BK;
    unsigned voffB[2]; int RA[2], CA2[2];
#pragma unroll
    for (int i = 0; i < 2; ++i) { int R, C; stage_rc(tid * 16 + i * 8192, R, C); const int Rb = P::PERM ? ((R & ~31) + perm32(R & 31)) : R;
        RA[i] = R; CA2[i] = C * 2; voffB[i] = (unsigned)(Rb * S.ldb + C) * 2u; }
    const size_t kstep = (size_t)(BK * 2);
    const size_t hstepB = (size_t)HALF * S.ldb * 2;
    const unsigned ldsw = (unsigned)wid * 1024u;
    const int aoff = lds_byte(wr * 64 + fr, fq * 8), boff = lds_byte(wc * 32 + fr, fq * 8);
#define GE_SA(b, h) (((b) * 2 + (h)) * HTB)
#define GE_SB(b, h) ((4 + (b) * 2 + (h)) * HTB)
#define GE_STAGEB(bufoff, gbase) do { _Pragma("unroll") for (int _i = 0; _i < 2; ++_i) \
        GLDS16((const char*)(gbase) + voffB[_i], lds + (bufoff) + ldsw + _i * 8192); } while (0)
#define GE_STAGEA(bufoff, gbase, h) do { _Pragma("unroll") for (int _i = 0; _i < 2; ++_i) \
        GLDS16((const char*)(gbase) + oA[h][_i], lds + (bufoff) + ldsw + _i * 8192); } while (0)
#define GE_LDA(dst, b, h) do { _Pragma("unroll") for (int m = 0; m < 4; ++m) _Pragma("unroll") for (int k = 0; k < 2; ++k) dst[m][k] = *(const LAS bf16x8*)(lds + GE_SA(b, h) + aoff + m * 2048 + k * 1024); } while (0)
#define GE_LDB(dst, b, h) do { _Pragma("unroll") for (int n = 0; n < 2; ++n) _Pragma("unroll") for (int k = 0; k < 2; ++k) dst[n][k] = *(const LAS bf16x8*)(lds + GE_SB(b, h) + boff + n * 2048 + k * 1024); } while (0)
#define GE_MMA(ai, bj, At, Bt) do { SETPRIO(1); _Pragma("unroll") for (int m = 0; m < 4; ++m) _Pragma("unroll") for (int n = 0; n < 2; ++n) _Pragma("unroll") for (int k = 0; k < 2; ++k) \
        acc[ai][bj][m][n] = MFMA16(Bt[n][k], At[m][k], acc[ai][bj][m][n]); SETPRIO(0); } while (0)
    Unit cur, nxt; int ui = 0;
    if (!S.next(0, cur)) return;
    f32x4 acc[2][2][4][2];
#pragma unroll
    for (int a = 0; a < 2; ++a)
#pragma unroll
        for (int b = 0; b < 2; ++b)
#pragma unroll
            for (int m = 0; m < 4; ++m)
#pragma unroll
                for (int n = 0; n < 2; ++n) acc[a][b][m][n] = (f32x4){0.f, 0.f, 0.f, 0.f};
    bf16x8 At[4][2], B0[2][2], B1[2][2];
    unsigned oA[2][2], oN[2][2];
#pragma unroll
    for (int h = 0; h < 2; ++h)
#pragma unroll
        for (int i = 0; i < 2; ++i) {
            if constexpr (P::GATHER) oA[h][i] = (unsigned)S.gather_row(cur, h * HALF + RA[i]) * (unsigned)(S.lda * 2) + (unsigned)CA2[i];
            else oA[h][i] = (unsigned)((h * HALF + RA[i]) * S.lda) * 2u + (unsigned)CA2[i];
            oN[h][i] = oA[h][i]; }
    const char* cA = S.a_base(cur); const char* cB = S.b_base(cur);
    GE_STAGEB(GE_SB(0, 0), cB); GE_STAGEA(GE_SA(0, 0), cA, 0); GE_STAGEB(GE_SB(0, 1), cB + hstepB); GE_STAGEA(GE_SA(0, 1), cA, 1);
    if (wr == 1) SBAR();
    WAITV(4); SBAR();
    GE_STAGEB(GE_SB(1, 0), cB + kstep); GE_STAGEA(GE_SA(1, 0), cA + kstep, 0); GE_STAGEB(GE_SB(1, 1), cB + hstepB + kstep);
    WAITV(6); SBAR();
    for (;;) {
        const bool has_next = S.next(ui + 1, nxt);
        const char* nA = has_next ? S.a_base(nxt) : cA; const char* nB = has_next ? S.b_base(nxt) : cB;
        for (int t = 0; t < nt; t += 2) {
            const bool last = (t == nt - 2);
            const char* a1 = cA + (size_t)(t + 1) * kstep;
            const char* a2 = last ? nA : cA + (size_t)(t + 2) * kstep; const char* b2 = last ? nB : cB + (size_t)(t + 2) * kstep;
            const char* a3 = a2 + kstep; const char* b3 = b2 + kstep;
            if constexpr (P::GATHER) { if (last && has_next) {
#pragma unroll
                for (int h = 0; h < 2; ++h)
#pragma unroll
                    for (int i = 0; i < 2; ++i) oN[h][i] = (unsigned)S.gather_row(nxt, h * HALF + RA[i]) * (unsigned)(S.lda * 2) + (unsigned)CA2[i]; } }
            GE_LDB(B0, 0, 0); SCHED(); GE_LDA(At, 0, 0); GE_STAGEA(GE_SA(1, 1), a1, 1);
            WAITL(8); SBAR(); WAITL(0); GE_MMA(0, 0, At, B0); SBAR(); SCHED();
            if constexpr (P::GATHER) { if (last) {
#pragma unroll
                for (int h = 0; h < 2; ++h)
#pragma unroll
                    for (int i = 0; i < 2; ++i) oA[h][i] = oN[h][i]; } }
            GE_LDB(B1, 0, 1); GE_STAGEB(GE_SB(0, 0), b2);
            SBAR(); WAITL(0); GE_MMA(0, 1, At, B1); SBAR();
            GE_LDA(At, 0, 1); GE_STAGEA(GE_SA(0, 0), a2, 0);
            SBAR(); WAITL(0); GE_MMA(1, 0, At, B0); SBAR(); SCHED();
            GE_STAGEB(GE_SB(0, 1), b2 + hstepB);
            WAITV(6); SBAR(); GE_MMA(1, 1, At, B1); SBAR();
            GE_LDB(B0, 1, 0); SCHED(); GE_LDA(At, 1, 0); GE_STAGEA(GE_SA(0, 1), a2, 1);
            WAITL(8); SBAR(); WAITL(0); GE_MMA(0, 0, At, B0); SBAR(); SCHED();
            GE_LDB(B1, 1, 1); GE_STAGEB(GE_SB(1, 0), b3);
            SBAR(); WAITL(0); GE_MMA(0, 1, At, B1); SBAR();
            GE_LDA(At, 1, 1); GE_STAGEA(GE_SA(1, 0), a3, 0);
            SBAR(); WAITL(0); GE_MMA(1, 0, At, B0); SBAR(); SCHED();
            GE_STAGEB(GE_SB(1, 1), b3 + hstepB);
            WAITV(6); SBAR(); GE_MMA(1, 1, At, B1); SBAR();
        }
        if (wr == 0) SBAR();
        S.epi(acc, cur, wr, wc, fr, fq);
        if (!has_next) break;
#pragma unroll
        for (int a = 0; a < 2; ++a)
#pragma unroll
            for (int b = 0; b < 2; ++b)
#pragma unroll
                for (int m = 0; m < 4; ++m)
#pragma unroll
                    for (int n = 0; n < 2; ++n) acc[a][b][m][n] = (f32x4){0.f, 0.f, 0.f, 0.f};
        cur = nxt; cA = nA; cB = nB; ++ui;
        if (wr == 1) SBAR();
    }
    WAITV(0);
    SBAR();
#undef GE_SA
#undef GE_SB
#undef GE_STAGEA
#undef GE_STAGEB
#undef GE_LDA
#undef GE_LDB
#undef GE_MMA
}
}
using ge::Unit;

struct Params {
    const float* in[26];
    float* out; unsigned char* ws;
    int ph_lo, ph_hi;
};
enum { I_X = 0, I_C, I_CTX, I_CCTX, I_ADAW, I_ADAB, I_NMIX, I_NFFN, I_POOLW, I_POOLS, I_INW, I_CONVW, I_CONVB, I_ALOG, I_DTB, I_DSKIP, I_SNORM, I_OUTW,
       I_W1, I_W3, I_W2, I_RW, I_MW1, I_MW3, I_MW2, I_FNORM };

struct Frame {
    LAS unsigned char* lds;
    int tid, lane, wave, G, bx;
    const Params* p;
    unsigned char* ws;
    unsigned* ctl;
    float* H; float* mod;
};
#ifdef EMU
DEV const float* INP(const Frame& F, int i) { return F.p->in[i]; }
DEV float* OUTP(const Frame& F) { return F.p->out; }
DEV unsigned char* WSP(const Frame& F) { return F.p->ws; }
#define LAUNDER_S(x) ((void)0)
#else
typedef const float* cfptr_t;
DEV const float* INP(const Frame&, int i) { int k = i; asm volatile("" : "+s"(k)); return ((const __attribute__((address_space(4))) cfptr_t*)__builtin_amdgcn_kernarg_segment_ptr())[k]; }
DEV float* OUTP(const Frame& F) { return (float*)INP(F, 26); }
DEV unsigned char* WSP(const Frame& F) { return (unsigned char*)INP(F, 27); }
#define LAUNDER_S(x) asm volatile("" : "+s"(x))
#endif
constexpr int LDS_MISC = ge::STAGE_BYTES;
constexpr int LDS_BYTES = ge::STAGE_BYTES + 16384;

struct Src { const float* x; const float* ctx; float* H; const float* mod; };
DEV const float* modq(const float* mod, int layer, int vec, int which) { return mod + ((size_t)(layer * 3 + vec) * 6 + which) * D; }
DEV const float* modp(const Frame& F, int layer, int vec, int which) { return modq(F.mod, layer, vec, which); }
DEV const float* hsrc_row(const Src& s, bool from_input, int r) {
    if (from_input) return r < ML ? s.x + (size_t)r * D : s.ctx + (size_t)(r - ML) * D;
    return s.H + (size_t)r * D;
}
DEV Src mksrc(const Frame& F) { Src s; s.x = INP(F, I_X); s.ctx = INP(F, I_CTX); s.H = F.H; s.mod = F.mod; return s; }
DEV const float* hin_row(const Frame& F, int layer, int r) { return hsrc_row(mksrc(F), layer == 0, r); }

template <int K, int N, class RM>
DEV void transpose_item(const float* Wsrc, bf16_t* WT, int ldt, RM rowmap, LAS float* scr, int item, int lane) {
    constexpr int nblk = N / 32; const int kb = item / nblk, nb = item % nblk, k0 = 64 * kb, n0 = 32 * nb;
#pragma unroll 8
    for (int i = 0; i < 32; ++i) { const int kk = 2 * i + (lane >> 5); scr[kk * 33 + (lane & 31)] = Wsrc[(size_t)(k0 + kk) * N + n0 + (lane & 31)]; }
    WSYNC();
    const int c = lane & 7; const int row0 = rowmap(n0);
#pragma unroll
    for (int j = 0; j < 4; ++j) { const int n = (lane >> 3) + 8 * j; const LAS float* s = scr + (8 * c) * 33 + n;
        u32x4 o; o.x = pk2(s[0 * 33], s[1 * 33]); o.y = pk2(s[2 * 33], s[3 * 33]); o.z = pk2(s[4 * 33], s[5 * 33]); o.w = pk2(s[6 * 33], s[7 * 33]);
        *(u32x4*)(WT + (size_t)(row0 + n) * ldt + k0 + 8 * c) = o; }
    WSYNC();
}
struct RmId { DEV int operator()(int n0) const { return n0; } };
struct RmIlv { int s; DEV int operator()(int n0) const { return (n0 >> 7) * 256 + s * 128 + (n0 & 127); } };
template <int K, int N, class RM>
DEV void convert_job(const Frame& F, const float* Wsrc, bf16_t* WT, int ldt, RM rm) {
    LAS float* scr = (LAS float*)(F.lds + F.wave * 16384);
    constexpr int items = (K / 64) * (N / 32); const int gw = F.bx * 8 + F.wave, NGW = F.G * 8;
    for (int it = gw; it < items; it += NGW) transpose_item<K, N>(Wsrc, WT, ldt, rm, scr, it, F.lane);
}
DEV void convert_even(const Frame& F, int j) {
    bf16_t* Wb = (bf16_t*)(F.ws + OFF_W);
    for (int g = 0; g < 4; ++g) convert_job<256, 256>(F, INP(F, I_POOLW) + ((size_t)j * 4 + g) * 65536, Wb + W_POOL / 2 + (size_t)g * 65536, 256, RmId{});
    convert_job<D, DFF>(F, INP(F, I_W1) + (size_t)j * D * DFF, Wb + W_UP / 2, D, RmIlv{0});
    convert_job<D, DFF>(F, INP(F, I_W3) + (size_t)j * D * DFF, Wb + W_UP / 2, D, RmIlv{1});
    convert_job<DFF, D>(F, INP(F, I_W2) + (size_t)j * DFF * D, Wb + W_DN / 2, DFF, RmId{});
}
DEV void convert_ssd(const Frame& F, int j) {
    bf16_t* Wb = (bf16_t*)(F.ws + OFF_W);
    convert_job<D, NPROJ>(F, INP(F, I_INW) + (size_t)j * D * NPROJ, Wb + W_IN / 2, D, RmId{});
    convert_job<DIN, D>(F, INP(F, I_OUTW) + (size_t)j * DIN * D, Wb + W_OUT / 2, DIN, RmId{});
    { u32x4* z = (u32x4*)(Wb + W_IN / 2 + (size_t)NPROJ * D); const int n16 = (NPROJP - NPROJ) * D * 2 / 16;
      unsigned zz = 0u; LAUNDER_V(zz);
      for (int i = F.bx * 512 + F.tid; i < n16; i += F.G * 512) z[i] = (u32x4){zz, zz, zz, zz}; }
}
DEV void convert_moe(const Frame& F, int j) {
    bf16_t* Wb = (bf16_t*)(F.ws + OFF_W);
    for (int e = 0; e < NEXP; ++e) {
        convert_job<D, DFFE>(F, INP(F, I_MW1) + ((size_t)j * NEXP + e) * D * DFFE, Wb + W_MUP / 2 + (size_t)e * 2 * DFFE * D, D, RmIlv{0});
        convert_job<D, DFFE>(F, INP(F, I_MW3) + ((size_t)j * NEXP + e) * D * DFFE, Wb + W_MUP / 2 + (size_t)e * 2 * DFFE * D, D, RmIlv{1});
        convert_job<DFFE, D>(F, INP(F, I_MW2) + ((size_t)j * NEXP + e) * DFFE * D, Wb + W_MDN / 2 + (size_t)e * D * DFFE, DFFE, RmId{});
    }
}

DEV void phase_mod(const Frame& F) {
    LAS float* red = (LAS float*)F.lds;
    const int nblk = DEPTH * 6144 / 64;
    const int col = F.tid & 63, ks = F.tid >> 6;
    for (int blk = F.bx; blk < nblk; blk += F.G) {
        const int layer = (blk * 64) / 6144, n = (blk * 64) % 6144 + col;
        const float* W = INP(F, I_ADAW) + (size_t)layer * D * 6144 + n;
        float a0 = 0.f, a1 = 0.f, a2 = 0.f;
#pragma unroll 8
        for (int k = ks * 128; k < ks * 128 + 128; ++k) { const float w = W[(size_t)k * 6144];
            a0 += siluf(INP(F, I_C)[k]) * w; a1 += siluf(INP(F, I_C)[D + k]) * w; a2 += siluf(INP(F, I_CCTX)[k]) * w; }
        red[(ks * 64 + col) * 3 + 0] = a0; red[(ks * 64 + col) * 3 + 1] = a1; red[(ks * 64 + col) * 3 + 2] = a2;
        __syncthreads();
        if (F.tid < 192) { const int c2 = F.tid % 64, v = F.tid / 64; float s = 0.f;
            for (int q = 0; q < 8; ++q) s += red[(q * 64 + c2) * 3 + v];
            const int n2 = (blk * 64) % 6144 + c2;
            F.mod[(size_t)(layer * 3 + v) * 6144 + n2] = s + INP(F, I_ADAB)[(size_t)layer * 6144 + n2]; }
        __syncthreads();
    }
}

DEV void load_row(const float* p, int lane, f32x4 (&v)[4]) {
#pragma unroll
    for (int j = 0; j < 4; ++j) v[j] = *(const f32x4*)(p + 4 * lane + 256 * j);
}
DEV float sumsq_row(const f32x4 (&v)[4]) { float s = 0.f;
#pragma unroll
    for (int j = 0; j < 4; ++j) s += (v[j][0] * v[j][0] + v[j][1] * v[j][1]) + (v[j][2] * v[j][2] + v[j][3] * v[j][3]);
    return wave_sum(s); }
DEV void normmod_row(f32x4 (&v)[4], float rstd, const float* w, const float* sh, const float* sc, int lane) {
#pragma unroll
    for (int j = 0; j < 4; ++j) { const int c = 4 * lane + 256 * j; const f32x4 wv = *(const f32x4*)(w + c), sv = *(const f32x4*)(sh + c), cv = *(const f32x4*)(sc + c);
        v[j] = v[j] * rstd * wv * (cv + 1.0f) + sv; }
}
DEV void store_row_bf16(bf16_t* o, int lane, const f32x4 (&v)[4]) {
#pragma unroll
    for (int j = 0; j < 4; ++j) { u32x2 w; w.x = pk2(v[j][0], v[j][1]); w.y = pk2(v[j][2], v[j][3]); *(u32x2*)(o + 4 * lane + 256 * j) = w; }
}

DEV void phase_norm(const Frame& F, int layer, int which, bf16_t* out, bool from_input) {
    const int gw = F.bx * 8 + F.wave, NGW = F.G * 8;
    const float* w = INP(F, which == 0 ? I_NMIX : I_NFFN) + (size_t)layer * D;
    for (int r = gw; r < MT; r += NGW) {
        f32x4 v[4]; load_row(hsrc_row(mksrc(F), from_input, r), F.lane, v);
        const float rstd = rsqrtf(sumsq_row(v) * (1.0f / D) + EPS);
        const int vec = vec_of(r);
        normmod_row(v, rstd, w, modp(F, layer, vec, which), modp(F, layer, vec, which + 1), F.lane);
        store_row_bf16(out + (size_t)r * D, F.lane, v);
    }
}

DEV void phase_poolprep(const Frame& F, int layer, bf16_t* P) {
    LAS float* rs = (LAS float*)(F.lds);
    const float* w = INP(F, I_NMIX) + (size_t)layer * D;
    const int ntile = MT / 64;
    for (int tile = F.bx; tile < ntile; tile += F.G) {
        const int r0 = tile * 64;
        int seq0, seq1;
        if (r0 < ML) { seq0 = r0; seq1 = r0 + 64; } else { seq0 = ML + ((r0 - ML) / CTXL) * CTXL; seq1 = seq0 + CTXL; }
        const int lo_r = (r0 - 8 > seq0) ? r0 - 8 : seq0, hi_r = (r0 + 64 + 7 < seq1) ? r0 + 64 + 7 : seq1;
        for (int r = lo_r + F.wave; r < hi_r; r += 8) { f32x4 v[4]; load_row(hin_row(F, layer, r), F.lane, v); const float ss = sumsq_row(v); if (F.lane == 0) rs[r - lo_r] = rsqrtf(ss * (1.0f / D) + EPS); }
        __syncthreads();
        const int vec = vec_of(r0);
        const int cq = F.tid & 255, half = F.tid >> 8, c = cq * 4, g = c >> 8, win = 2 << g, lo = win >> 1, hi = win - 1 - lo;
        const f32x4 wv = *(const f32x4*)(w + c), sv = *(const f32x4*)(modp(F, layer, vec, 0) + c), cv = *(const f32x4*)(modp(F, layer, vec, 1) + c) + 1.0f;
        const f32x4 wc = wv * cv;
        const int ta = r0 + 32 * half;
        auto uval = [&](int r) -> f32x4 { const f32x4 h = *(const f32x4*)(hin_row(F, layer, r) + c); return h * rs[r - lo_r] * wc + sv; };
        f32x4 s = (f32x4){0.f, 0.f, 0.f, 0.f};
        { const int a = (ta - lo > seq0) ? ta - lo : seq0, b = (ta + hi + 1 < seq1) ? ta + hi + 1 : seq1; for (int r = a; r < b; ++r) s += uval(r); }
        for (int t = ta; t < ta + 32; ++t) {
            const int a = (t - lo > seq0) ? t - lo : seq0, b = (t + hi + 1 < seq1) ? t + hi + 1 : seq1;
            const float inv = 1.0f / (float)(b - a);
            const f32x4 o = s * inv - uval(t);
            u32x2 pw; pw.x = pk2(o[0], o[1]); pw.y = pk2(o[2], o[3]); *(u32x2*)(P + (size_t)t * D + c) = pw;
            if (t + 1 < ta + 32) {
                if (t + 1 + hi < seq1) s += uval(t + 1 + hi);
                if (t - lo >= seq0) s -= uval(t - lo); }
        }
        __syncthreads();
    }
}

struct PolBase { int G, c; };
struct PolPool : PolBase {
    static constexpr bool PERM = false, GATHER = false; int K, lda, ldb;
    const bf16_t* P; const bf16_t* W; Src src; int layer; const float* scale;
    DEV bool next(int i, Unit& u) const { return ge::static_next(NPAN, 4, G, c, i, u); }
    DEV const char* a_base(const Unit& u) const { return (const char*)(P + (size_t)u.pm * 256 * D + u.pn * 256); }
    DEV const char* b_base(const Unit& u) const { return (const char*)(W + (size_t)u.pn * 65536); }
    DEV void epi(const f32x4 (&acc)[2][2][4][2], const Unit& u, int wr, int wc, int fr, int fq) const {
        const int row0 = u.pm * 256 + wr * 64 + fr, col0 = u.pn * 256 + wc * 32 + 4 * fq; const int vec = vec_of(u.pm * 256);
        const float* g1 = modq(src.mod, layer, vec, 2);
        f32x4 gv[2][2];
#pragma unroll
        for (int bj = 0; bj < 2; ++bj)
#pragma unroll
            for (int n = 0; n < 2; ++n) { const int cc = col0 + bj * 128 + n * 16; gv[bj][n] = *(const f32x4*)(g1 + cc) * *(const f32x4*)(scale + cc); }
#pragma unroll
        for (int ai = 0; ai < 2; ++ai)
#pragma unroll
            for (int m = 0; m < 4; ++m) { const int r = row0 + ai * 128 + m * 16; const float* hi = hsrc_row(src, layer == 0, r) + col0; float* ho = src.H + (size_t)r * D + col0;
#pragma unroll
                for (int bj = 0; bj < 2; ++bj)
#pragma unroll
                    for (int n = 0; n < 2; ++n) *(f32x4*)(ho + bj * 128 + n * 16) = *(const f32x4*)(hi + bj * 128 + n * 16) + gv[bj][n] * acc[ai][bj][m][n]; }
    }
};
struct PolResid : PolBase {
    static constexpr bool PERM = false, GATHER = false; int K, lda, ldb;
    const bf16_t* A; const bf16_t* W; Src src; int layer, which;
    DEV bool next(int i, Unit& u) const { return ge::static_next(NPAN, 4, G, c, i, u); }
    DEV const char* a_base(const Unit& u) const { return (const char*)(A + (size_t)u.pm * 256 * lda); }
    DEV const char* b_base(const Unit& u) const { return (const char*)(W + (size_t)u.pn * 256 * ldb); }
    DEV void epi(const f32x4 (&acc)[2][2][4][2], const Unit& u, int wr, int wc, int fr, int fq) const {
        const int row0 = u.pm * 256 + wr * 64 + fr, col0 = u.pn * 256 + wc * 32 + 4 * fq; const int vec = vec_of(u.pm * 256);
        const float* gp = modq(src.mod, layer, vec, which);
        f32x4 gv[2][2];
#pragma unroll
        for (int bj = 0; bj < 2; ++bj)
#pragma unroll
            for (int n = 0; n < 2; ++n) gv[bj][n] = *(const f32x4*)(gp + col0 + bj * 128 + n * 16);
#pragma unroll
        for (int ai = 0; ai < 2; ++ai)
#pragma unroll
            for (int m = 0; m < 4; ++m) { float* ho = src.H + (size_t)(row0 + ai * 128 + m * 16) * D + col0;
#pragma unroll
                for (int bj = 0; bj < 2; ++bj)
#pragma unroll
                    for (int n = 0; n < 2; ++n) { f32x4* q = (f32x4*)(ho + bj * 128 + n * 16); *q = *q + gv[bj][n] * acc[ai][bj][m][n]; } }
    }
};
template <bool MOE>
struct PolUp : PolBase {
    static constexpr bool PERM = true, GATHER = MOE; int K, lda, ldb;
    const bf16_t* A; const bf16_t* W; bf16_t* HID; int ldh, nq;
    int nM; const int* s2t; int tstart[NEXP + 1];
    DEV bool next(int i, Unit& u) const { return ge::static_next(MOE ? nM : NPAN, nq, G, c, i, u); }
    DEV int expert_of(int pm) const { int e = 0;
#pragma unroll
        for (int k = 1; k < NEXP; ++k) e += (pm >= tstart[k]) ? 1 : 0;
        return e; }
    DEV const char* a_base(const Unit& u) const { return MOE ? (const char*)A : (const char*)(A + (size_t)u.pm * 256 * lda); }
    DEV const char* b_base(const Unit& u) const { size_t off = (size_t)u.pn * 256 * ldb; if (MOE) off += (size_t)expert_of(u.pm) * 2 * DFFE * ldb; return (const char*)(W + off); }
    DEV int gather_row(const Unit& u, int R) const { return s2t[u.pm * 256 + R]; }
    DEV void epi(const f32x4 (&acc)[2][2][4][2], const Unit& u, int wr, int wc, int fr, int fq) const {
        const int row0 = u.pm * 256 + wr * 64 + fr, col0 = u.pn * 128 + wc * 32 + 8 * fq;
#pragma unroll
        for (int ai = 0; ai < 2; ++ai)
#pragma unroll
            for (int m = 0; m < 4; ++m) { bf16_t* o = HID + (size_t)(row0 + ai * 128 + m * 16) * ldh + col0;
                float h[8];
#pragma unroll
                for (int n = 0; n < 2; ++n)
#pragma unroll
                    for (int i = 0; i < 4; ++i) h[4 * n + i] = siluf(acc[ai][0][m][n][i]) * acc[ai][1][m][n][i];
                u32x4 w; w.x = pk2(h[0], h[1]); w.y = pk2(h[2], h[3]); w.z = pk2(h[4], h[5]); w.w = pk2(h[6], h[7]);
                *(u32x4*)o = w; }
    }
};
struct PolMoeDown : PolBase {
    static constexpr bool PERM = true, GATHER = false; int K, lda, ldb;
    const bf16_t* A; const bf16_t* W; bf16_t* YS; int nM; int tstart[NEXP + 1];
    DEV bool next(int i, Unit& u) const { return ge::static_next(nM, 4, G, c, i, u); }
    DEV int expert_of(int pm) const { int e = 0;
#pragma unroll
        for (int k = 1; k < NEXP; ++k) e += (pm >= tstart[k]) ? 1 : 0;
        return e; }
    DEV const char* a_base(const Unit& u) const { return (const char*)(A + (size_t)u.pm * 256 * lda); }
    DEV const char* b_base(const Unit& u) const { return (const char*)(W + ((size_t)expert_of(u.pm) * D + (size_t)u.pn * 256) * ldb); }
    DEV void epi(const f32x4 (&acc)[2][2][4][2], const Unit& u, int wr, int wc, int fr, int fq) const {
        const int row0 = u.pm * 256 + wr * 64 + fr, col0 = u.pn * 256 + wc * 32 + 8 * fq;
#pragma unroll
        for (int ai = 0; ai < 2; ++ai)
#pragma unroll
            for (int m = 0; m < 4; ++m) { bf16_t* o = YS + (size_t)(row0 + ai * 128 + m * 16) * D + col0;
#pragma unroll
                for (int bj = 0; bj < 2; ++bj) { u32x4 w; w.x = pk2(acc[ai][bj][m][0][0], acc[ai][bj][m][0][1]); w.y = pk2(acc[ai][bj][m][0][2], acc[ai][bj][m][0][3]);
                    w.z = pk2(acc[ai][bj][m][1][0], acc[ai][bj][m][1][1]); w.w = pk2(acc[ai][bj][m][1][2], acc[ai][bj][m][1][3]); *(u32x4*)(o + bj * 128) = w; } }
    }
};
struct PolInProj : PolBase {
    static constexpr bool PERM = true, GATHER = false; int K, lda, ldb;
    const bf16_t* A; const bf16_t* W; bf16_t* Z; bf16_t* XBC; float* DT; const float* dtb;
    DEV bool next(int i, Unit& u) const { return ge::static_next(NPAN, NPROJP / 256, G, c, i, u); }
    DEV const char* a_base(const Unit& u) const { return (const char*)(A + (size_t)u.pm * 256 * lda); }
    DEV const char* b_base(const Unit& u) const { return (const char*)(W + (size_t)u.pn * 256 * ldb); }
    DEV void epi(const f32x4 (&acc)[2][2][4][2], const Unit& u, int wr, int wc, int fr, int fq) const {
        const int row0 = u.pm * 256 + wr * 64 + fr, cw = wc * 32 + 8 * fq;
        if (u.pn < 20) {
            bf16_t* base; int ld, col0;
            if (u.pn < 8) { base = Z; ld = DIN; col0 = u.pn * 256 + cw; } else { base = XBC; ld = CONVD; col0 = (u.pn - 8) * 256 + cw; }
#pragma unroll
            for (int ai = 0; ai < 2; ++ai)
#pragma unroll
                for (int m = 0; m < 4; ++m) { bf16_t* o = base + (size_t)(row0 + ai * 128 + m * 16) * ld + col0;
#pragma unroll
                    for (int bj = 0; bj < 2; ++bj) { u32x4 w; w.x = pk2(acc[ai][bj][m][0][0], acc[ai][bj][m][0][1]); w.y = pk2(acc[ai][bj][m][0][2], acc[ai][bj][m][0][3]);
                        w.z = pk2(acc[ai][bj][m][1][0], acc[ai][bj][m][1][1]); w.w = pk2(acc[ai][bj][m][1][2], acc[ai][bj][m][1][3]); *(u32x4*)(o + bj * 128) = w; } }
        } else if (cw < 64) {
#pragma unroll
            for (int ai = 0; ai < 2; ++ai)
#pragma unroll
                for (int m = 0; m < 4; ++m) { const int r = row0 + ai * 128 + m * 16; int b, tv;
                    if (r < ML) { b = r / SEQ; tv = CTXL + r % SEQ; } else { b = (r - ML) / CTXL; tv = (r - ML) % CTXL; }
#pragma unroll
                    for (int n = 0; n < 2; ++n)
#pragma unroll
                        for (int i = 0; i < 4; ++i) { const int j = cw + 4 * n + i, dir = j >> 5, h = j & 31;
                            DT[((size_t)(b * 2 + dir) * NH + h) * TV + tv] = softplusf(acc[ai][0][m][n][i] + dtb[dir * NH + h]); } }
        }
    }
};

DEV void phase_conv(const Frame& F, int j, const bf16_t* XBC, bf16_t* XT, bf16_t* Brow, bf16_t* BT, bf16_t* Crow) {
    LAS bf16_t* tl = (LAS bf16_t*)F.lds;
    const float* cw = INP(F, I_CONVW) + (size_t)j * 4 * CONVD; const float* cb = INP(F, I_CONVB) + (size_t)j * CONVD;
    const int nitem = NB * NCH * (CONVD / 64);
    const int t = F.tid & 127, cg = F.tid >> 7;
    for (int it = F.bx; it < nitem; it += F.G) {
        const int cblk = it % (CONVD / 64), cv = (it / (CONVD / 64)) % NCH, b = it / ((CONVD / 64) * NCH);
        const int ch0 = cblk * 64 + cg * 16, tv = cv * 128 + t;
        const int seg0 = tv < CTXL ? 0 : CTXL, seg1 = tv < CTXL ? CTXL : TV;
        float a[16];
#pragma unroll
        for (int i = 0; i < 16; ++i) a[i] = cb[ch0 + i];
#pragma unroll
        for (int k = 0; k < 4; ++k) { const int tk = tv - 2 + k;
            if (tk >= seg0 && tk < seg1) { const bf16_t* src = XBC + (size_t)row_of(b, tk) * CONVD + ch0; const u32x4 q0 = *(const u32x4*)src, q1 = *(const u32x4*)(src + 8);
                const unsigned qq[8] = {q0.x, q0.y, q0.z, q0.w, q1.x, q1.y, q1.z, q1.w};
#pragma unroll
                for (int i = 0; i < 8; ++i) { a[2 * i] += cw[k * CONVD + ch0 + 2 * i] * bflo(qq[i]); a[2 * i + 1] += cw[k * CONVD + ch0 + 2 * i + 1] * bfhi(qq[i]); } } }
        unsigned pk[8];
#pragma unroll
        for (int i = 0; i < 8; ++i) pk[i] = pk2(siluf(a[2 * i]), siluf(a[2 * i + 1]));
        const int r = row_of(b, tv);
        const bool isx = cblk < DIN / 64, isb = !isx && cblk < (DIN + BCD) / 64;
        if (isb) { bf16_t* o = Brow + (size_t)r * BCD + (ch0 - DIN); *(u32x4*)o = (u32x4){pk[0], pk[1], pk[2], pk[3]}; *(u32x4*)(o + 8) = (u32x4){pk[4], pk[5], pk[6], pk[7]}; }
        if (!isx && !isb) { bf16_t* o = Crow + (size_t)r * BCD + (ch0 - DIN - BCD); *(u32x4*)o = (u32x4){pk[0], pk[1], pk[2], pk[3]}; *(u32x4*)(o + 8) = (u32x4){pk[4], pk[5], pk[6], pk[7]}; }
        if (isx || isb) {
#pragma unroll
            for (int i = 0; i < 8; ++i) { tl[(cg * 16 + 2 * i) * 136 + t] = (bf16_t)(pk[i] & 0xffffu); tl[(cg * 16 + 2 * i + 1) * 136 + t] = (bf16_t)(pk[i] >> 16); }
            __syncthreads();
            bf16_t* dst = isx ? XT + ((size_t)b * DIN + cblk * 64) * TV : BT + ((size_t)b * BCD + (cblk * 64 - DIN)) * TV;
#pragma unroll
            for (int q = 0; q < 2; ++q) { const int idx = F.tid + q * 512, ch = idx >> 4, t8 = (idx & 15) * 8;
                const LAS bf16_t* s = tl + ch * 136 + t8; u32x4 w; w.x = s[0] | ((unsigned)s[1] << 16); w.y = s[2] | ((unsigned)s[3] << 16); w.z = s[4] | ((unsigned)s[5] << 16); w.w = s[6] | ((unsigned)s[7] << 16);
                *(u32x4*)(dst + (size_t)ch * TV + cv * 128 + t8) = w; }
            __syncthreads();
        }
    }
}

DEV void phase_cb(const Frame& F, const bf16_t* Brow, const bf16_t* Crow, bf16_t* CB) {
    const int nitem = NB * NG * NCH; const int fr = F.lane & 15, fq = F.lane >> 4;
    for (int it = F.bx; it < nitem; it += F.G) {
        const int cv = it % NCH, g = (it / NCH) % NG, b = it / (NCH * NG);
        const int rbase = row_of(b, cv * 128);
        bf16x8 cf[4];
#pragma unroll
        for (int ks = 0; ks < 4; ++ks) cf[ks] = *(const bf16x8*)(Crow + (size_t)(rbase + 16 * F.wave + fr) * BCD + g * 128 + 32 * ks + 8 * fq);
        bf16_t* out = CB + ((size_t)((b * NG + g) * NCH + cv)) * 16384;
#pragma unroll
        for (int nt = 0; nt < 8; ++nt) {
            f32x4 acc = (f32x4){0.f, 0.f, 0.f, 0.f};
#pragma unroll
            for (int ks = 0; ks < 4; ++ks) { const bf16x8 bfr = *(const bf16x8*)(Brow + (size_t)(rbase + 16 * nt + fr) * BCD + g * 128 + 32 * ks + 8 * fq); acc = MFMA16(bfr, cf[ks], acc); }
            u32x2 w; w.x = pk2(acc[0], acc[1]); w.y = pk2(acc[2], acc[3]);
            *(u32x2*)(out + (size_t)(16 * F.wave + fr) * 128 + 16 * nt + 4 * fq) = w;
        }
    }
}

DEV void phase_scan(const Frame& F, int j, const bf16_t* XT, const bf16_t* BT, const bf16_t* Crow, const bf16_t* CB, const float* DT, bf16_t* Yf, bf16_t* Yb) {
    LAS unsigned char* L = F.lds;
    LAS bf16_t* Hl = (LAS bf16_t*)L;
    LAS float* wl = (LAS float*)(L + 32768 + F.wave * 2048);
    const int fr = F.lane & 15, fq = F.lane >> 4, w = F.wave;
    const int nitem = NB * NH * 2 * 2;
    for (int it = F.bx; it < nitem; it += F.G) {
        const int ph = it & 1, dir = (it >> 1) & 1, h = (it >> 2) % NH, b = it / (4 * NH), g = h / 8;
        const float A = -expf(INP(F, I_ALOG)[(size_t)(j * 2 + dir) * NH + h]);
        const float Dsk = INP(F, I_DSKIP)[(size_t)j * NH + h];
        const float* dtp = DT + ((size_t)(b * 2 + dir) * NH + h) * TV;
        const bf16_t* xt = XT + ((size_t)b * DIN + h * HD + ph * 32) * TV;
        const bf16_t* bt = BT + ((size_t)b * BCD + g * 128) * TV;
        bf16_t* Y = dir ? Yb : Yf;
        f32x4 accH[2]; accH[0] = (f32x4){0.f, 0.f, 0.f, 0.f}; accH[1] = accH[0];
        for (int i = F.tid; i < 32 * 136 / 2; i += 512) ((LAS unsigned*)Hl)[i] = 0u;
        __syncthreads();
        for (int step = 0; step < NCH; ++step) {
            int cv;
            if (dir == 0) cv = step; else cv = step < 2 ? 1 - step : (NCH - 1) - (step - 2);
            const int buf = step & 1;
            const int tv0 = cv * 128, rbase = row_of(b, tv0);
            { const f32x2 d2 = *(const f32x2*)(dtp + tv0 + 2 * F.lane); const float a0 = d2.x * A, a1 = d2.y * A;
              float c0, c1, tot;
              if (dir == 0) { float s = a0 + a1;
#pragma unroll
                  for (int o = 1; o < 64; o <<= 1) { const float t2 = __shfl_up(s, o); if (F.lane >= o) s += t2; }
                  c1 = s; c0 = s - a1; tot = __shfl(s, 63); }
              else { float s = a0 + a1;
#pragma unroll
                  for (int o = 1; o < 64; o <<= 1) { const float t2 = __shfl_down(s, o); if (F.lane + o < 64) s += t2; }
                  c0 = s; c1 = s - a0; tot = __shfl(s, 0); }
              wl[2 * F.lane] = c0; wl[2 * F.lane + 1] = c1;
              wl[128 + 2 * F.lane] = d2.x; wl[128 + 2 * F.lane + 1] = d2.y;
              wl[256 + 2 * F.lane] = d2.x * FEXP(tot - c0); wl[256 + 2 * F.lane + 1] = d2.y * FEXP(tot - c1);
              wl[384] = FEXP(tot); }
            WSYNC();
            const float chunk_decay = wl[384];
            const int lrow = 16 * w + fr;
            const float cum_l = wl[lrow];
            bf16x8 mf[4];
            { const bf16_t* cbp = CB + ((size_t)((b * NG + g) * NCH + cv)) * 16384 + (size_t)lrow * 128;
#pragma unroll
              for (int ks = 0; ks < 4; ++ks) { const u32x4 q = *(const u32x4*)(cbp + 32 * ks + 8 * fq); const unsigned qq[4] = {q.x, q.y, q.z, q.w}; unsigned o[4];
#pragma unroll
                  for (int i = 0; i < 4; ++i) { const int s0 = 32 * ks + 8 * fq + 2 * i; float v0 = bflo(qq[i]), v1 = bfhi(qq[i]);
                      const bool k0 = dir == 0 ? (s0 <= lrow) : (s0 >= lrow), k1 = dir == 0 ? (s0 + 1 <= lrow) : (s0 + 1 >= lrow);
                      const float e0 = cum_l - wl[s0], e1 = cum_l - wl[s0 + 1];
                      v0 = k0 ? v0 * FEXP(e0 < 0.f ? e0 : 0.f) : 0.f; v1 = k1 ? v1 * FEXP(e1 < 0.f ? e1 : 0.f) : 0.f; o[i] = pk2(v0, v1); }
                  mf[ks] = __builtin_bit_cast(bf16x8, (u32x4){o[0], o[1], o[2], o[3]}); } }
            bf16x8 xd[2][4], xw[2][4];
#pragma unroll
            for (int nt = 0; nt < 2; ++nt)
#pragma unroll
                for (int ks = 0; ks < 4; ++ks) { const u32x4 q = *(const u32x4*)(xt + (size_t)(16 * nt + fr) * TV + tv0 + 32 * ks + 8 * fq); const unsigned qq[4] = {q.x, q.y, q.z, q.w}; unsigned o1[4], o2[4];
#pragma unroll
                    for (int i = 0; i < 4; ++i) { const int s0 = 32 * ks + 8 * fq + 2 * i; const float x0 = bflo(qq[i]), x1 = bfhi(qq[i]);
                        o1[i] = pk2(x0 * wl[128 + s0], x1 * wl[128 + s0 + 1]); o2[i] = pk2(x0 * wl[256 + s0], x1 * wl[256 + s0 + 1]); }
                    xd[nt][ks] = __builtin_bit_cast(bf16x8, (u32x4){o1[0], o1[1], o1[2], o1[3]}); xw[nt][ks] = __builtin_bit_cast(bf16x8, (u32x4){o2[0], o2[1], o2[2], o2[3]}); }
            f32x4 yd[2], yo[2];
#pragma unroll
            for (int nt = 0; nt < 2; ++nt) { yd[nt] = (f32x4){0.f, 0.f, 0.f, 0.f}; yo[nt] = yd[nt]; }
            bf16x8 cf[4];
#pragma unroll
            for (int ks = 0; ks < 4; ++ks) cf[ks] = *(const bf16x8*)(Crow + (size_t)(rbase + lrow) * BCD + g * 128 + 32 * ks + 8 * fq);
#pragma unroll
            for (int nt = 0; nt < 2; ++nt)
#pragma unroll
                for (int ks = 0; ks < 4; ++ks) {
                    yd[nt] = MFMA16(mf[ks], xd[nt][ks], yd[nt]);
                    const bf16x8 hf = *(const LAS bf16x8*)(Hl + buf * (32 * 136) + (16 * nt + fr) * 136 + 32 * ks + 8 * fq);
                    yo[nt] = MFMA16(cf[ks], hf, yo[nt]); }
#pragma unroll
            for (int nt = 0; nt < 2; ++nt) accH[nt] = accH[nt] * chunk_decay;
#pragma unroll
            for (int ks = 0; ks < 4; ++ks) { const bf16x8 bfr = *(const bf16x8*)(bt + (size_t)lrow * TV + tv0 + 32 * ks + 8 * fq);
#pragma unroll
                for (int nt = 0; nt < 2; ++nt) accH[nt] = MFMA16(bfr, xw[nt][ks], accH[nt]); }
#pragma unroll
            for (int nt = 0; nt < 2; ++nt) { u32x2 hw; hw.x = pk2(accH[nt][0], accH[nt][1]); hw.y = pk2(accH[nt][2], accH[nt][3]);
                *(LAS u32x2*)(Hl + (buf ^ 1) * (32 * 136) + (16 * nt + fr) * 136 + 16 * w + 4 * fq) = hw; }
#pragma unroll
            for (int nt = 0; nt < 2; ++nt) {
                const int p = 16 * nt + fr; const u32x2 xq = *(const u32x2*)(xt + (size_t)p * TV + tv0 + 16 * w + 4 * fq);
                const float xv[4] = {bflo(xq.x), bfhi(xq.x), bflo(xq.y), bfhi(xq.y)};
#pragma unroll
                for (int r = 0; r < 4; ++r) { const int l = 16 * w + 4 * fq + r; float y = yd[nt][r] + FEXP(wl[l]) * yo[nt][r]; if (dir == 0) y += Dsk * xv[r];
                    Y[(size_t)(rbase + l) * DIN + h * HD + ph * 32 + p] = (bf16_t)f2bf(y); }
            }
            __syncthreads();
        }
    }
}

DEV void phase_gate(const Frame& F, int j, const bf16_t* Yf, const bf16_t* Yb, const bf16_t* Z, bf16_t* YN) {
    const int gw = F.bx * 8 + F.wave, NGW = F.G * 8; const float* nw = INP(F, I_SNORM) + (size_t)j * DIN;
    for (int r = gw; r < MT; r += NGW) {
        float t[32]; float ss = 0.f;
#pragma unroll
        for (int q = 0; q < 4; ++q) { const size_t o = (size_t)r * DIN + 8 * F.lane + 512 * q; const u32x4 a = *(const u32x4*)(Yf + o), bq = *(const u32x4*)(Yb + o), z = *(const u32x4*)(Z + o);
            const unsigned aa[4] = {a.x, a.y, a.z, a.w}, bb[4] = {bq.x, bq.y, bq.z, bq.w}, zz[4] = {z.x, z.y, z.z, z.w};
#pragma unroll
            for (int i = 0; i < 4; ++i) { const float v0 = (bflo(aa[i]) + bflo(bb[i])) * siluf(bflo(zz[i])), v1 = (bfhi(aa[i]) + bfhi(bb[i])) * siluf(bfhi(zz[i])); t[8 * q + 2 * i] = v0; t[8 * q + 2 * i + 1] = v1; ss += v0 * v0 + v1 * v1; } }
        const float rstd = rsqrtf(wave_sum(ss) * (1.0f / DIN) + EPS);
#pragma unroll
        for (int q = 0; q < 4; ++q) { const int c = 8 * F.lane + 512 * q; const f32x4 w0 = *(const f32x4*)(nw + c), w1 = *(const f32x4*)(nw + c + 4);
            u32x4 o; o.x = pk2(t[8 * q] * rstd * w0[0], t[8 * q + 1] * rstd * w0[1]); o.y = pk2(t[8 * q + 2] * rstd * w0[2], t[8 * q + 3] * rstd * w0[3]);
            o.z = pk2(t[8 * q + 4] * rstd * w1[0], t[8 * q + 5] * rstd * w1[1]); o.w = pk2(t[8 * q + 6] * rstd * w1[2], t[8 * q + 7] * rstd * w1[3]);
            *(u32x4*)(YN + (size_t)r * DIN + c) = o; }
    }
}

struct TokInfo { int s0, s1; float g0, g1; };
DEV void phase_route(const Frame& F, int layer, int ml, bf16_t* V) {
    LAS unsigned* lc = (LAS unsigned*)(F.lds + LDS_MISC + 256);
    if (F.tid < 8) lc[F.tid] = 0u;
    __syncthreads();
    const int gw = F.bx * 8 + F.wave, NGW = F.G * 8; const int j = layer / 2;
    const float* w = INP(F, I_NFFN) + (size_t)layer * D; const float* rw = INP(F, I_RW) + (size_t)j * D * NEXP;
    TokInfo* tok = (TokInfo*)(F.ws + OFF_TOK);
    for (int r = gw; r < MT; r += NGW) {
        f32x4 v[4]; load_row(F.H + (size_t)r * D, F.lane, v);
        const float rstd = rsqrtf(sumsq_row(v) * (1.0f / D) + EPS);
        const int vec = vec_of(r);
        normmod_row(v, rstd, w, modp(F, layer, vec, 3), modp(F, layer, vec, 4), F.lane);
        store_row_bf16(V + (size_t)r * D, F.lane, v);
        float lg[NEXP];
#pragma unroll
        for (int e = 0; e < NEXP; ++e) lg[e] = 0.f;
#pragma unroll
        for (int jj = 0; jj < 4; ++jj)
#pragma unroll
            for (int i = 0; i < 4; ++i) { const int c = 4 * F.lane + 256 * jj + i; const f32x4 r0 = *(const f32x4*)(rw + (size_t)c * NEXP), r1 = *(const f32x4*)(rw + (size_t)c * NEXP + 4);
#pragma unroll
                for (int e = 0; e < 4; ++e) { lg[e] += v[jj][i] * r0[e]; lg[4 + e] += v[jj][i] * r1[e]; } }
#pragma unroll
        for (int e = 0; e < NEXP; ++e) lg[e] = wave_sum(lg[e]);
        int e0 = 0; float v0 = lg[0];
#pragma unroll
        for (int e = 1; e < NEXP; ++e) if (lg[e] > v0) { v0 = lg[e]; e0 = e; }
        int e1 = -1; float v1 = -3.0e38f;
#pragma unroll
        for (int e = 0; e < NEXP; ++e) if (e != e0 && lg[e] > v1) { v1 = lg[e]; e1 = e; }
        const float g1 = 1.0f / (1.0f + expf(v0 - v1)), g0 = 1.0f - g1;
        if (F.lane == 0) { TokInfo ti; ti.s0 = e0; ti.s1 = e1; ti.g0 = g0; ti.g1 = g1; tok[r] = ti; atomicAdd((unsigned*)&lc[e0], 1u); atomicAdd((unsigned*)&lc[e1], 1u); }
    }
    __syncthreads();
    if (F.tid < 8) __hip_atomic_fetch_add(F.ctl + CW_CNT + (ml * 8 + F.tid) * 64, lc[F.tid], RLX_AGENT);
}
DEV void tile_starts(const Frame& F, int ml, int (&ts)[NEXP + 1], unsigned (&cnt)[NEXP]) {
    ts[0] = 0;
#pragma unroll
    for (int e = 0; e < NEXP; ++e) { cnt[e] = __hip_atomic_load(F.ctl + CW_CNT + (ml * 8 + e) * 64, RLX_AGENT); ts[e + 1] = ts[e] + (int)((cnt[e] + 255u) / 256u); }
}
DEV void phase_slots(const Frame& F, int ml) {
    int ts[NEXP + 1]; unsigned cnt[NEXP]; tile_starts(F, ml, ts, cnt);
    TokInfo* tok = (TokInfo*)(F.ws + OFF_TOK); int* s2t = (int*)(F.ws + OFF_S2T);
    const int gw = F.bx * 8 + F.wave, NGW = F.G * 8;
    for (int base = gw * 64; base < MT; base += NGW * 64) {
        const int r = base + F.lane; TokInfo ti = tok[r];
        const int ek[2] = {ti.s0, ti.s1}; int sl[2];
#pragma unroll
        for (int k = 0; k < 2; ++k) { sl[k] = 0;
            for (int e = 0; e < NEXP; ++e) { const unsigned long long m = __ballot(ek[k] == e);
                if (m) { const int leader = __builtin_ctzll(m); unsigned b0 = 0;
                    if (F.lane == leader) b0 = __hip_atomic_fetch_add(F.ctl + CW_CUR + (ml * 8 + e) * 64, (unsigned)__builtin_popcountll(m), RLX_AGENT);
                    b0 = __shfl(b0, leader);
                    if (ek[k] == e) sl[k] = ts[e] * 256 + (int)b0 + __builtin_popcountll(m & ((1ull << F.lane) - 1ull)); } } }
        ti.s0 = sl[0]; ti.s1 = sl[1]; tok[r] = ti; s2t[sl[0]] = r; s2t[sl[1]] = r;
    }
    if (F.bx == 0) { for (int e = 0; e < NEXP; ++e) { const int a = ts[e] * 256 + (int)cnt[e], b2 = ts[e + 1] * 256; for (int s = a + F.tid; s < b2; s += 512) s2t[s] = 0; } }
}
DEV void phase_combine(const Frame& F, int layer, const bf16_t* YS, bool final_) {
    const int gw = F.bx * 8 + F.wave, NGW = F.G * 8; const TokInfo* tok = (const TokInfo*)(F.ws + OFF_TOK);
    const int nrows = final_ ? ML : MT;
    for (int r = gw; r < nrows; r += NGW) {
        f32x4 v[4]; load_row(F.H + (size_t)r * D, F.lane, v);
        const TokInfo ti = tok[r]; const float* g2 = modp(F, layer, vec_of(r), 5);
#pragma unroll
        for (int jj = 0; jj < 4; ++jj) { const int c = 4 * F.lane + 256 * jj; const u32x2 a = *(const u32x2*)(YS + (size_t)ti.s0 * D + c), b = *(const u32x2*)(YS + (size_t)ti.s1 * D + c); const f32x4 gv = *(const f32x4*)(g2 + c);
            v[jj][0] += gv[0] * (ti.g0 * bflo(a.x) + ti.g1 * bflo(b.x)); v[jj][1] += gv[1] * (ti.g0 * bfhi(a.x) + ti.g1 * bfhi(b.x));
            v[jj][2] += gv[2] * (ti.g0 * bflo(a.y) + ti.g1 * bflo(b.y)); v[jj][3] += gv[3] * (ti.g0 * bfhi(a.y) + ti.g1 * bfhi(b.y)); }
        if (!final_) {
#pragma unroll
            for (int jj = 0; jj < 4; ++jj) *(f32x4*)(F.H + (size_t)r * D + 4 * F.lane + 256 * jj) = v[jj];
        } else {
            const float rstd = rsqrtf(sumsq_row(v) * (1.0f / D) + EPS); const float* fw = INP(F, I_FNORM);
#pragma unroll
            for (int jj = 0; jj < 4; ++jj) { const int c = 4 * F.lane + 256 * jj; *(f32x4*)(OUTP(F) + (size_t)r * D + c) = v[jj] * rstd * *(const f32x4*)(fw + c); }
        }
    }
}

constexpr int PH_PER_PAIR = 17, N_PHASES = 1 + 2 * PH_PER_PAIR;
__global__ void __launch_bounds__(512, 2) fwd_kernel(Params prm) {
#ifdef EMU
    unsigned char* lds_raw = emu_lds();
#else
    extern __shared__ __attribute__((aligned(16))) unsigned char lds_raw[];
#endif
    Frame F;
    F.lds = (LAS unsigned char*)lds_raw;
    F.tid = threadIdx.x; F.lane = F.tid & 63; F.wave = RFL(F.tid >> 6); F.G = gridDim.x; F.bx = blockIdx.x;
    F.p = &prm; F.ws = prm.ws; F.ctl = (unsigned*)(prm.ws + OFF_CTL); F.H = (float*)(prm.ws + OFF_H); F.mod = (float*)(prm.ws + OFF_MOD);
    volatile LAS unsigned* misc = (volatile LAS unsigned*)(F.lds + LDS_MISC);
    if (F.tid < 64) misc[F.tid] = 0u;
    __syncthreads();
    XcdBarrier bar; bar.bar = F.ctl + CW_BAR; bar.x = 0; bar.st = misc;
    const int lo = prm.ph_lo, hi = prm.ph_hi;
    if (hi - lo > 1) bar = xcd_barrier_post(F.ctl + CW_BAR, misc);
    int ph = 0;
#ifndef SITE_MASK
#define SITE_MASK 0xFFFFFFFFu
#endif
#define PHASE_BEGIN(site) if (((SITE_MASK >> (site)) & 1u) && lo <= ph && ph < hi) { { int _t = threadIdx.x; LAUNDER_V(_t); F.tid = _t; F.lane = _t & 63; int _b = blockIdx.x; LAUNDER_S(_b); F.bx = _b; int _g = gridDim.x; LAUNDER_S(_g); F.G = _g; \
      F.ws = WSP(F); F.ctl = (unsigned*)(F.ws + OFF_CTL); F.H = (float*)(F.ws + OFF_H); F.mod = (float*)(F.ws + OFF_MOD); }
#define PHASE_END   if (ph + 1 < hi) xcd_barrier(bar); } ++ph;
#define B_W (F.ws + OFF_W)
#define B_ACT (F.ws + OFF_ACT)
#define B_P ((bf16_t*)(B_ACT + A_P))
#define B_HID ((bf16_t*)(B_ACT + A_HID))
#define B_U ((bf16_t*)(B_ACT + A_U))
#define B_Z ((bf16_t*)(B_ACT + A_Z))
#define B_XBC ((bf16_t*)(B_ACT + A_XBC))
#define B_DT ((float*)(B_W + W_DT))
#define B_XT ((bf16_t*)(B_ACT + A_XT))
#define B_BROW ((bf16_t*)(B_ACT + A_BROW))
#define B_BT ((bf16_t*)(B_ACT + A_BT))
#define B_CROW ((bf16_t*)(B_ACT + A_CROW))
#define B_CB ((bf16_t*)(B_ACT + A_CB))
#define B_YF ((bf16_t*)(B_ACT + A_YF))
#define B_YB ((bf16_t*)(B_W + W_YB))
#define B_YN ((bf16_t*)(B_ACT + A_YN))
#define B_V ((bf16_t*)(B_ACT + A_V))
#define B_HIDM ((bf16_t*)(B_ACT + A_HIDM))
#define B_YS ((bf16_t*)(B_ACT + A_YS))

    PHASE_BEGIN(0) phase_mod(F); convert_even(F, 0); PHASE_END

    for (int lp = 0; lp < 2; ++lp) {
        const int le = 2 * lp, lod = 2 * lp + 1;
        PHASE_BEGIN(1) phase_poolprep(F, le, B_P); PHASE_END
        PHASE_BEGIN(2) { PolPool S; S.G = F.G; S.c = F.bx; S.K = 256; S.lda = D; S.ldb = 256; S.P = B_P; S.W = (const bf16_t*)(B_W + W_POOL); S.src = mksrc(F); S.layer = le; S.scale = INP(F, I_POOLS) + (size_t)lp * D;
                      ge::gemm_phase(F.lds, S, F.tid); } PHASE_END
        PHASE_BEGIN(3) phase_norm(F, le, 3, B_P, false); PHASE_END
        PHASE_BEGIN(4) { PolUp<false> S; S.G = F.G; S.c = F.bx; S.K = D; S.lda = D; S.ldb = D; S.A = B_P; S.W = (const bf16_t*)(B_W + W_UP); S.HID = B_HID; S.ldh = DFF; S.nq = DFF / 128; S.nM = NPAN; S.s2t = nullptr;
                      ge::gemm_phase(F.lds, S, F.tid); } PHASE_END
        PHASE_BEGIN(5) { PolResid S; S.G = F.G; S.c = F.bx; S.K = DFF; S.lda = DFF; S.ldb = DFF; S.A = B_HID; S.W = (const bf16_t*)(B_W + W_DN); S.src = mksrc(F); S.layer = le; S.which = 5;
                      ge::gemm_phase(F.lds, S, F.tid); } PHASE_END
        PHASE_BEGIN(6) phase_norm(F, lod, 0, B_U, false); convert_ssd(F, lp); PHASE_END
        PHASE_BEGIN(7) { PolInProj S; S.G = F.G; S.c = F.bx; S.K = D; S.lda = D; S.ldb = D; S.A = B_U; S.W = (const bf16_t*)(B_W + W_IN); S.Z = B_Z; S.XBC = B_XBC; S.DT = B_DT; S.dtb = INP(F, I_DTB) + (size_t)lp * 2 * NH;
                      ge::gemm_phase(F.lds, S, F.tid); } PHASE_END
        PHASE_BEGIN(8) phase_conv(F, lp, B_XBC, B_XT, B_BROW, B_BT, B_CROW); PHASE_END
        PHASE_BEGIN(9) phase_cb(F, B_BROW, B_CROW, B_CB); PHASE_END
        PHASE_BEGIN(10) phase_scan(F, lp, B_XT, B_BT, B_CROW, B_CB, B_DT, B_YF, B_YB); PHASE_END
        PHASE_BEGIN(11) phase_gate(F, lp, B_YF, B_YB, B_Z, B_YN); PHASE_END
        PHASE_BEGIN(12) { PolResid S; S.G = F.G; S.c = F.bx; S.K = DIN; S.lda = DIN; S.ldb = DIN; S.A = B_YN; S.W = (const bf16_t*)(B_W + W_OUT); S.src = mksrc(F); S.layer = lod; S.which = 2;
                      ge::gemm_phase(F.lds, S, F.tid); } PHASE_END
        PHASE_BEGIN(13) phase_route(F, lod, lp, B_V); convert_moe(F, lp); PHASE_END
        PHASE_BEGIN(14) phase_slots(F, lp); PHASE_END
        PHASE_BEGIN(15) { int ts[NEXP + 1]; unsigned cnt[NEXP]; tile_starts(F, lp, ts, cnt);
                      PolUp<true> S; S.G = F.G; S.c = F.bx; S.K = D; S.lda = D; S.ldb = D; S.A = B_V; S.W = (const bf16_t*)(B_W + W_MUP); S.HID = B_HIDM; S.ldh = DFFE; S.nq = DFFE / 128; S.nM = ts[NEXP];
                      S.s2t = (const int*)(F.ws + OFF_S2T);
#pragma unroll
                      for (int e = 0; e <= NEXP; ++e) S.tstart[e] = ts[e];
                      ge::gemm_phase(F.lds, S, F.tid); } PHASE_END
        PHASE_BEGIN(16) { int ts[NEXP + 1]; unsigned cnt[NEXP]; tile_starts(F, lp, ts, cnt);
                      PolMoeDown S; S.G = F.G; S.c = F.bx; S.K = DFFE; S.lda = DFFE; S.ldb = DFFE; S.A = B_HIDM; S.W = (const bf16_t*)(B_W + W_MDN); S.YS = B_YS; S.nM = ts[NEXP];
#pragma unroll
                      for (int e = 0; e <= NEXP; ++e) S.tstart[e] = ts[e];
                      ge::gemm_phase(F.lds, S, F.tid); } PHASE_END
        PHASE_BEGIN(17) phase_combine(F, lod, B_YS, lp == 1); if (lp == 0) convert_even(F, 1); PHASE_END
    }
#undef PHASE_BEGIN
#undef PHASE_END
}

extern "C" void kernel_launch(void* const* d_in, const int* in_sizes, int n_in, void* d_out, int out_size, void* d_ws, size_t ws_size, hipStream_t stream) {
    static int grid = 0;
    if (grid == 0) {
        if (n_in != 26 || ws_size < WS_NEED) { fprintf(stderr, "kernel_launch: need 26 inputs and %zu bytes of workspace (got %d, %zu)\n", (size_t)WS_NEED, n_in, ws_size); grid = -1; return; }
        int dev = 0, cus = 0, per_cu = 0;
        if (hipGetDevice(&dev) != hipSuccess || hipDeviceGetAttribute(&cus, hipDeviceAttributeMultiprocessorCount, dev) != hipSuccess) { grid = -1; return; }
        if (hipFuncSetAttribute((const void*)fwd_kernel, hipFuncAttributeMaxDynamicSharedMemorySize, LDS_BYTES) != hipSuccess) { grid = -1; return; }
        if (hipOccupancyMaxActiveBlocksPerMultiprocessor(&per_cu, (const void*)fwd_kernel, 512, LDS_BYTES) != hipSuccess || per_cu < 1) { fprintf(stderr, "kernel_launch: occupancy query says %d\n", per_cu); }
        (void)hipGetLastError();
        grid = cus;
    }
    if (grid < 0) return;
    (void)in_sizes; (void)out_size;
    if (hipMemsetAsync((char*)d_ws + OFF_CTL, 0, CTL_BYTES, stream) != hipSuccess) return;
    Params p{};
    for (int i = 0; i < 26; ++i) p.in[i] = (const float*)d_in[i];
    p.out = (float*)d_out; p.ws = (unsigned char*)d_ws;
    if (N_LAUNCH_MODE == 1) { p.ph_lo = 0; p.ph_hi = N_PHASES; hipLaunchKernelGGL(fwd_kernel, dim3(grid), dim3(512), LDS_BYTES, stream, p); }
    else for (int ph = 0; ph < N_PHASES; ++ph) { p.ph_lo = ph; p.ph_hi = ph + 1; hipLaunchKernelGGL(fwd_kernel, dim3(grid), dim3(512), LDS_BYTES, stream, p); }
}
```

```cpp
#ifndef EMU
#include <hip/hip_runtime.h>
#endif
#include <cstdio>
#include <cstdint>

#ifndef CFG_SEQ
#define CFG_SEQ 16384
#endif
#ifndef CFG_DFF
#define CFG_DFF 2816
#endif
#ifndef CFG_DFFE
#define CFG_DFFE 3584
#endif
#ifndef N_LAUNCH_MODE
#define N_LAUNCH_MODE 1
#endif

#ifdef EMU
#define LAS
#define DEV inline
#define WAITV(n) ((void)0)
#define WAITL(n) ((void)0)
#define SBAR() emu_wg_sync()
#define SCHED() ((void)0)
#define SETPRIO(x) ((void)0)
#define MFMA16(a, b, c) emu_mfma16(a, b, c)
#define GLDS16(g, l) emu_glds16((const void*)(g), (void*)(l))
#define GLDS4(g, l) emu_glds4((const void*)(g), (void*)(l))
#define RFL(x) emu_rfl(x)
#define MEMFENCE() ((void)0)
#define WSYNC() emu_wave_sync()
#define LDSBAR() emu_wg_sync()
#define LAUNDER_V(x) ((void)0)
#define SLEEP1() emu_yield()
#define MY_XCC_ID() ((unsigned)(blockIdx.x & 7u))
#define FENCE_REL() __atomic_thread_fence(__ATOMIC_SEQ_CST)
#define FENCE_ACQ() __atomic_thread_fence(__ATOMIC_SEQ_CST)
#define FEXP(x) expf(x)
#define RLX_AGENT __ATOMIC_RELAXED, 4
#else
#define LAS __attribute__((address_space(3)))
#define DEV __device__ __forceinline__
#define WAITV(n) asm volatile("s_waitcnt vmcnt(" #n ")" ::: "memory")
#define WAITL(n) asm volatile("s_waitcnt lgkmcnt(" #n ")" ::: "memory")
#define SBAR() __builtin_amdgcn_s_barrier()
#define SCHED() __builtin_amdgcn_sched_barrier(0)
#define SETPRIO(x) __builtin_amdgcn_s_setprio(x)
#define MFMA16(a, b, c) __builtin_amdgcn_mfma_f32_16x16x32_bf16(a, b, c, 0, 0, 0)
#define GLDS16(g, l) __builtin_amdgcn_global_load_lds((const unsigned*)(g), (LAS unsigned*)(l), 16, 0, 0)
#define GLDS4(g, l) __builtin_amdgcn_global_load_lds((const unsigned*)(g), (LAS unsigned*)(l), 4, 0, 0)
#define RFL(x) __builtin_amdgcn_readfirstlane(x)
#define MEMFENCE() asm volatile("" ::: "memory")
#define LDSBAR() do { asm volatile("s_waitcnt lgkmcnt(0)" ::: "memory"); __builtin_amdgcn_s_barrier(); asm volatile("" ::: "memory"); } while (0)
#define WSYNC() asm volatile("s_waitcnt lgkmcnt(0)" ::: "memory")
#define SLEEP1() __builtin_amdgcn_s_sleep(1)
#define MY_XCC_ID() ((unsigned)__builtin_amdgcn_s_getreg((3 << 11) | 20) & 0xFu)
#define FENCE_REL() __builtin_amdgcn_fence(__ATOMIC_RELEASE, "agent")
#define FENCE_ACQ() __builtin_amdgcn_fence(__ATOMIC_ACQUIRE, "agent")
#define FEXP(x) __expf(x)
#define RLX_AGENT __ATOMIC_RELAXED, __HIP_MEMORY_SCOPE_AGENT
#define LAUNDER_V(x) asm volatile("" : "+v"(x))
#endif

typedef unsigned short bf16_t;
typedef short bf16x8 __attribute__((ext_vector_type(8)));
typedef float f32x4 __attribute__((ext_vector_type(4)));
typedef float f32x2 __attribute__((ext_vector_type(2)));
typedef unsigned u32x4 __attribute__((ext_vector_type(4)));
typedef unsigned u32x2 __attribute__((ext_vector_type(2)));

constexpr int D = 1024, NB = 2, SEQ = CFG_SEQ, CTXL = 256, DEPTH = 4;
constexpr int ML = NB * SEQ, MC = NB * CTXL, MT = ML + MC, NPAN = MT / 256;
constexpr int DFF = CFG_DFF, DFFE = CFG_DFFE, NEXP = 8;
constexpr int DIN = 2048, NH = 32, HD = 64, NG = 4, DS = 128, CONVD = 3072, NPROJ = 5184, NPROJP = 5376, BCD = 512;
constexpr int TV = CTXL + SEQ, NCH = TV / 128;
constexpr int GRIDW = 64;
constexpr float EPS = 1e-6f;
constexpr int NSLOT_TILES = (2 * MT) / 256 + NEXP, NSLOT = NSLOT_TILES * 256;
static_assert(SEQ % 128 == 0 && ML % 256 == 0 && DFF % 128 == 0 && DFFE % 128 == 0 && DFF >= 256 && DFFE >= 256, "shape constraints");

constexpr size_t MiB = 1u << 20;
constexpr size_t al(size_t x) { return (x + 4095) & ~(size_t)4095; }
constexpr size_t OFF_CTL = 0, CTL_BYTES = 1 * MiB;
constexpr size_t OFF_MOD = 1 * MiB;
constexpr size_t OFF_TOK = 2 * MiB;
constexpr size_t OFF_S2T = 3 * MiB;
constexpr size_t OFF_H = 4 * MiB, SZ_H = (size_t)MT * D * 4;
constexpr size_t OFF_W = OFF_H + al(SZ_H);
constexpr size_t W_POOL = 0, SZ_WPOOL = (size_t)4 * 256 * 256 * 2;
constexpr size_t W_UP = al(SZ_WPOOL), SZ_WUP = (size_t)2 * DFF * D * 2;
constexpr size_t W_DN = W_UP + al(SZ_WUP), SZ_WDN = (size_t)D * DFF * 2;
constexpr size_t SZ_WEVEN = W_DN + al(SZ_WDN);
constexpr size_t W_IN = 0, SZ_WIN = (size_t)NPROJP * D * 2;
constexpr size_t W_OUT = al(SZ_WIN), SZ_WOUT = (size_t)D * DIN * 2;
constexpr size_t W_DT = W_OUT + al(SZ_WOUT), SZ_DT = (size_t)NB * 2 * NH * TV * 4;
constexpr size_t W_MUP = W_DT + al(SZ_DT), SZ_WMUP = (size_t)NEXP * 2 * DFFE * D * 2;
constexpr size_t W_MDN = W_MUP + al(SZ_WMUP), SZ_WMDN = (size_t)NEXP * D * DFFE * 2;
constexpr size_t W_YB = W_MUP, SZ_Y = (size_t)MT * DIN * 2;
constexpr size_t SZ_WODD_A = W_MDN + al(SZ_WMDN), SZ_WODD_B = W_YB + al(SZ_Y);
constexpr size_t mx(size_t a, size_t b) { return a > b ? a : b; }
constexpr size_t SZ_W = mx(SZ_WEVEN, mx(SZ_WODD_A, SZ_WODD_B));
constexpr size_t OFF_ACT = OFF_W + SZ_W;
constexpr size_t A_P = 0, SZ_ACT1 = (size_t)MT * D * 2;
constexpr size_t A_HID = al(SZ_ACT1), SZ_HID = (size_t)MT * DFF * 2;
constexpr size_t SZ_AEVEN = A_HID + al(SZ_HID);
constexpr size_t A_Z = 0;
constexpr size_t A_XBC = al(SZ_Y), SZ_XBC = (size_t)MT * CONVD * 2;
constexpr size_t A_YF = A_XBC;
constexpr size_t A_CB = A_XBC + al(SZ_Y), SZ_CB = (size_t)NB * NG * NCH * 128 * 128 * 2;
static_assert(al(SZ_Y) + SZ_CB <= SZ_XBC, "CB fits behind Yf inside the XBC region");
constexpr size_t A_XT = A_XBC + al(SZ_XBC), SZ_XT = (size_t)NB * DIN * TV * 2;
constexpr size_t A_U = A_XT, A_YN = A_XT;
constexpr size_t A_BROW = A_XT + al(SZ_XT), SZ_BC = (size_t)MT * BCD * 2;
constexpr size_t A_BT = A_BROW + al(SZ_BC);
constexpr size_t A_CROW = A_BT + al(SZ_BC);
constexpr size_t A_CUM = A_CROW + al(SZ_BC);
constexpr size_t A_WJ = A_CUM + al(SZ_DT);
constexpr size_t SZ_ASSD = A_WJ + al(SZ_DT);
constexpr size_t A_V = 0;
constexpr size_t A_HIDM = al(SZ_ACT1), SZ_HIDM = (size_t)NSLOT * DFFE * 2;
constexpr size_t A_YS = A_HIDM + al(SZ_HIDM), SZ_YS = (size_t)NSLOT * D * 2;
constexpr size_t SZ_AMOE = A_YS + al(SZ_YS);
constexpr size_t SZ_ACT = mx(SZ_AEVEN, mx(SZ_ASSD, SZ_AMOE));
constexpr size_t WS_NEED = OFF_ACT + SZ_ACT;

constexpr int CW_BAR = 4096;
constexpr int CW_CNT = 16384;
constexpr int CW_CUR = 16384 + 2 * 8 * 64;

DEV unsigned f2bf(float f) { unsigned u = __builtin_bit_cast(unsigned, f); return (u + 0x7fffu + ((u >> 16) & 1u)) >> 16; }
#ifndef EMU
typedef __bf16 bf16x2n __attribute__((ext_vector_type(2)));
#endif
DEV unsigned pk2(float lo, float hi) {
#ifdef EMU
    return f2bf(lo) | (f2bf(hi) << 16);
#else
    f32x2 v = {lo, hi}; bf16x2n b = __builtin_convertvector(v, bf16x2n); return __builtin_bit_cast(unsigned, b);
#endif
}
DEV float bf2f(unsigned b) { return __builtin_bit_cast(float, b << 16); }
DEV float bflo(unsigned w) { return __builtin_bit_cast(float, w << 16); }
DEV float bfhi(unsigned w) { return __builtin_bit_cast(float, w & 0xffff0000u); }
#ifdef EMU
DEV float frcp(float x) { return 1.0f / x; }
#else
DEV float frcp(float x) { return __builtin_amdgcn_rcpf(x); }
#endif
#ifdef EMU
DEV float fexp2(float x) { return exp2f(x); }
#else
DEV float fexp2(float x) { return __builtin_amdgcn_exp2f(x); }
#endif
DEV float siluf(float x) { return x * frcp(1.0f + FEXP(-x)); }
DEV float softplusf(float x) { return x > 20.f ? x : log1pf(expf(x)); }
DEV float wave_sum(float v) {
#pragma unroll
    for (int o = 1; o < 64; o <<= 1) v += __shfl_xor(v, o);
    return v;
}
DEV int vec_of(int r) { return r < ML ? (r / SEQ) : 2; }
DEV int row_of(int b, int tv) { return tv < CTXL ? ML + b * CTXL + tv : b * SEQ + (tv - CTXL); }

#define XB_TMO      128
#define XB_XCNT(j)  (256  + 64 * (j))
#define XB_XSUB(j)  (1280 + 64 * (j))
#define XB_XGEN(j)  (2304 + 64 * (j))
#define XB_TOP      3328
#define XB_TOPGEN   3392
#define XCD_BAR_WORDS 3456
#define XB_SPIN_CAP (1u << 22)
DEV unsigned xb_ld(unsigned* p)              { return __hip_atomic_load(p, RLX_AGENT); }
DEV unsigned xb_add(unsigned* p, unsigned v) { return __hip_atomic_fetch_add(p, v, RLX_AGENT); }
#define XB_SPIN(cond, bar) do { unsigned _sp = 0; while (cond) { SLEEP1(); \
    if ((++_sp & 255u) == 0u) { if (xb_ld(&(bar)[XB_TMO])) break; if (_sp > XB_SPIN_CAP) { atomicAdd(&(bar)[XB_TMO], 1u); break; } } } } while (0)
struct XcdBarrier { unsigned* bar; unsigned x; volatile LAS unsigned* st; };
DEV XcdBarrier xcd_barrier_post(unsigned* bar, volatile LAS unsigned* st) {
    XcdBarrier b; b.bar = bar; b.x = MY_XCC_ID(); b.st = st;
    if (threadIdx.x == 0) (void)xb_add(&bar[XB_XCNT(b.x)], 1u);
    return b;
}
DEV void xcd_barrier_complete(unsigned* bar, unsigned x, unsigned& nloc, unsigned& nx) {
    const unsigned G = gridDim.x;
    unsigned sum, cnt, mine, sp = 0u;
    for (;;) {
        sum = 0u; cnt = 0u; mine = 0u;
#pragma unroll
        for (unsigned j = 0; j < 16; ++j) { const unsigned c = xb_ld(&bar[XB_XCNT(j)]); sum += c; cnt += (c > 0u) ? 1u : 0u; mine = (j == x) ? c : mine; }
        if (sum == G) break;
        SLEEP1();
        if ((++sp & 255u) == 0u) { if (xb_ld(&bar[XB_TMO])) break; if (sp > XB_SPIN_CAP) { atomicAdd(&bar[XB_TMO], 1u); break; } }
    }
    nloc = mine > 0u ? mine : 1u; nx = cnt > 0u ? cnt : 1u;
}
DEV void xcd_barrier(const XcdBarrier& b) {
    WAITV(0);
    __syncthreads();
    if (threadIdx.x == 0) {
        unsigned* bar = b.bar;
#ifndef EMU
        __builtin_amdgcn_s_waitcnt(0);
#endif
        unsigned nloc = b.st[0], nx = b.st[1];
        if (nloc == 0u) { xcd_barrier_complete(bar, b.x, nloc, nx); b.st[0] = nloc; b.st[1] = nx; }
        const unsigned old = xb_add(&bar[XB_XSUB(b.x)], 1u);
        const unsigned gen = old / nloc;
        if (old + 1u == (gen + 1u) * nloc) {
            FENCE_REL();
            WAITV(0);
            const unsigned og = xb_add(&bar[XB_TOP], 1u);
            const unsigned tg = og / nx;
            if (og + 1u == (tg + 1u) * nx) xb_add(&bar[XB_TOPGEN], 1u);
            else XB_SPIN(xb_ld(&bar[XB_TOPGEN]) == tg, bar);
            FENCE_ACQ();
            xb_add(&bar[XB_XGEN(b.x)], 1u);
            WAITV(0);
        } else {
            XB_SPIN(xb_ld(&bar[XB_XGEN(b.x)]) == gen, bar);
            FENCE_ACQ();
            WAITV(0);
        }
    }
    __syncthreads();
}

namespace ge {
constexpr int BM = 256, BK = 64, HALF = 128, HTB = HALF * BK * 2, STAGE_BYTES = 8 * HTB, NXCD = 8, WGM = 8;
DEV int lds_byte(int r, int c) { const int st = (r >> 4) * 2 + (c >> 5), rr = r & 15, cc = c & 31, ob = rr * 64 + cc * 2; return st * 1024 + (ob ^ (((ob >> 9) & 1) << 5)); }
DEV void stage_rc(int b, int& R, int& C) { const int st = b / 1024, sb = b % 1024, swz = sb ^ (((sb >> 9) & 1) << 5); R = (st >> 1) * 16 + swz / 64; C = (st & 1) * 32 + (swz % 64) / 2; }
DEV int perm32(int rho) { const int n = rho >> 4, i = rho & 15; return 8 * (i >> 2) + 4 * n + (i & 3); }
struct Unit { int pm, pn; };
DEV bool static_next(int nM, int nN, int G, int c, int i, Unit& u) {
    const int nwg = nM * nN; const long L = (long)i * G + c; if (L >= nwg) return false;
    int wgid = (int)L; { const int q = nwg / NXCD, r = nwg % NXCD, xcd = wgid % NXCD, off = wgid / NXCD; wgid = (xcd < r ? xcd * (q + 1) : r * (q + 1) + (xcd - r) * q) + off; }
    const int nig = WGM * nN, gid = wgid / nig, fm = gid * WGM, gsz = (nM - fm) < WGM ? (nM - fm) : WGM;
    u.pm = fm + ((wgid % nig) % gsz); u.pn = (wgid % nig) / gsz; return true;
}
template <class P>
DEV void gemm_phase(LAS unsigned char* lds, const P& S, const int tid) {
    const int wid = RFL(tid >> 6), lane = tid & 63, wr = wid >> 2, wc = wid & 3, fr = lane & 15, fq = lane >> 4;
    const int K = S.K, nt = K / BK;
    unsigned voffB[2]; int RA[2], CA2[2];
#pragma unroll
    for (int i = 0; i < 2; ++i) { int R, C; stage_rc(tid * 16 + i * 8192, R, C); const int Rb = P::PERM ? ((R & ~31) + perm32(R & 31)) : R;
        RA[i] = R; CA2[i] = C * 2; voffB[i] = (unsigned)(Rb * S.ldb + C) * 2u; }
    const size_t kstep = (size_t)(BK * 2);
    const size_t hstepB = (size_t)HALF * S.ldb * 2;
    const unsigned ldsw = (unsigned)wid * 1024u;
    const int aoff = lds_byte(wr * 64 + fr, fq * 8), boff = lds_byte(wc * 32 + fr, fq * 8);
#define GE_SA(b, h) (((b) * 2 + (h)) * HTB)
#define GE_SB(b, h) ((4 + (b) * 2 + (h)) * HTB)
#define GE_STAGEB(bufoff, gbase) do { _Pragma("unroll") for (int _i = 0; _i < 2; ++_i) \
        GLDS16((const char*)(gbase) + voffB[_i], lds + (bufoff) + ldsw + _i * 8192); } while (0)
#define GE_STAGEA(bufoff, gbase, h) do { _Pragma("unroll") for (int _i = 0; _i < 2; ++_i) \
        GLDS16((const char*)(gbase) + oA[h][_i], lds + (bufoff) + ldsw + _i * 8192); } while (0)
#define GE_LDA(dst, b, h) do { _Pragma("unroll") for (int m = 0; m < 4; ++m) _Pragma("unroll") for (int k = 0; k < 2; ++k) dst[m][k] = *(const LAS bf16x8*)(lds + GE_SA(b, h) + aoff + m * 2048 + k * 1024); } while (0)
#define GE_LDB(dst, b, h) do { _Pragma("unroll") for (int n = 0; n < 2; ++n) _Pragma("unroll") for (int k = 0; k < 2; ++k) dst[n][k] = *(const LAS bf16x8*)(lds + GE_SB(b, h) + boff + n * 2048 + k * 1024); } while (0)
#define GE_MMA(ai, bj, At, Bt) do { SETPRIO(1); _Pragma("unroll") for (int m = 0; m < 4; ++m) _Pragma("unroll") for (int n = 0; n < 2; ++n) _Pragma("unroll") for (int k = 0; k < 2; ++k) \
        acc[ai][bj][m][n] = MFMA16(Bt[n][k], At[m][k], acc[ai][bj][m][n]); SETPRIO(0); } while (0)
    Unit cur, nxt; int ui = 0;
    if (!S.next(0, cur)) return;
    f32x4 acc[2][2][4][2];
#pragma unroll
    for (int a = 0; a < 2; ++a)
#pragma unroll
        for (int b = 0; b < 2; ++b)
#pragma unroll
            for (int m = 0; m < 4; ++m)
#pragma unroll
                for (int n = 0; n < 2; ++n) acc[a][b][m][n] = (f32x4){0.f, 0.f, 0.f, 0.f};
    bf16x8 At[4][2], B0[2][2], B1[2][2];
    unsigned oA[2][2];
#pragma unroll
    for (int h = 0; h < 2; ++h)
#pragma unroll
        for (int i = 0; i < 2; ++i) {
            if constexpr (P::GATHER) oA[h][i] = (unsigned)S.gather_row(cur, h * HALF + RA[i]) * (unsigned)(S.lda * 2) + (unsigned)CA2[i];
            else oA[h][i] = (unsigned)((h * HALF + RA[i]) * S.lda) * 2u + (unsigned)CA2[i];
            }
    const char* cA = S.a_base(cur); const char* cB = S.b_base(cur);
    GE_STAGEB(GE_SB(0, 0), cB); GE_STAGEA(GE_SA(0, 0), cA, 0); GE_STAGEB(GE_SB(0, 1), cB + hstepB); GE_STAGEA(GE_SA(0, 1), cA, 1);
    if (wr == 1) SBAR();
    WAITV(4); SBAR();
    GE_STAGEB(GE_SB(1, 0), cB + kstep); GE_STAGEA(GE_SA(1, 0), cA + kstep, 0); GE_STAGEB(GE_SB(1, 1), cB + hstepB + kstep);
    WAITV(6); SBAR();
    for (;;) {
        const bool has_next = S.next(ui + 1, nxt);
        const char* nA = has_next ? S.a_base(nxt) : cA; const char* nB = has_next ? S.b_base(nxt) : cB;
        for (int t = 0; t < nt; t += 2) {
            const bool last = (t == nt - 2);
            const char* a1 = cA + (size_t)(t + 1) * kstep;
            const char* a2 = last ? nA : cA + (size_t)(t + 2) * kstep; const char* b2 = last ? nB : cB + (size_t)(t + 2) * kstep;
            const char* a3 = a2 + kstep; const char* b3 = b2 + kstep;
            GE_LDB(B0, 0, 0); SCHED(); GE_LDA(At, 0, 0); GE_STAGEA(GE_SA(1, 1), a1, 1);
            WAITL(8); SBAR(); WAITL(0); GE_MMA(0, 0, At, B0); SBAR(); SCHED();
            if constexpr (P::GATHER) { if (last && has_next) {
#pragma unroll
                for (int i = 0; i < 2; ++i) { int R2, C2; stage_rc(tid * 16 + i * 8192, R2, C2);
#pragma unroll
                    for (int h = 0; h < 2; ++h) oA[h][i] = (unsigned)S.gather_row(nxt, h * HALF + R2) * (unsigned)(S.lda * 2) + (unsigned)(C2 * 2); } } }
            GE_LDB(B1, 0, 1); GE_STAGEB(GE_SB(0, 0), b2);
            SBAR(); WAITL(0); GE_MMA(0, 1, At, B1); SBAR();
            GE_LDA(At, 0, 1); GE_STAGEA(GE_SA(0, 0), a2, 0);
            SBAR(); WAITL(0); GE_MMA(1, 0, At, B0); SBAR(); SCHED();
            GE_STAGEB(GE_SB(0, 1), b2 + hstepB);
            WAITV(6); SBAR(); GE_MMA(1, 1, At, B1); SBAR();
            GE_LDB(B0, 1, 0); SCHED(); GE_LDA(At, 1, 0); GE_STAGEA(GE_SA(0, 1), a2, 1);
            WAITL(8); SBAR(); WAITL(0); GE_MMA(0, 0, At, B0); SBAR(); SCHED();
            GE_LDB(B1, 1, 1); GE_STAGEB(GE_SB(1, 0), b3);
            SBAR(); WAITL(0); GE_MMA(0, 1, At, B1); SBAR();
            GE_LDA(At, 1, 1); GE_STAGEA(GE_SA(1, 0), a3, 0);
            SBAR(); WAITL(0); GE_MMA(1, 0, At, B0); SBAR(); SCHED();
            GE_STAGEB(GE_SB(1, 1), b3 + hstepB);
            WAITV(6); SBAR(); GE_MMA(1, 1, At, B1); SBAR();
        }
        if (wr == 0) SBAR();
        S.epi(acc, cur, wr, wc, fr, fq);
        if (!has_next) break;
#pragma unroll
        for (int a = 0; a < 2; ++a)
#pragma unroll
            for (int b = 0; b < 2; ++b)
#pragma unroll
                for (int m = 0; m < 4; ++m)
#pragma unroll
                    for (int n = 0; n < 2; ++n) acc[a][b][m][n] = (f32x4){0.f, 0.f, 0.f, 0.f};
        cur = nxt; cA = nA; cB = nB; ++ui;
        if (wr == 1) SBAR();
    }
    WAITV(0);
    SBAR();
#undef GE_SA
#undef GE_SB
#undef GE_STAGEA
#undef GE_STAGEB
#undef GE_LDA
#undef GE_LDB
#undef GE_MMA
}
}
using ge::Unit;

struct Params {
    const float* in[26];
    float* out; unsigned char* ws;
    int ph_lo, ph_hi;
};
enum { I_X = 0, I_C, I_CTX, I_CCTX, I_ADAW, I_ADAB, I_NMIX, I_NFFN, I_POOLW, I_POOLS, I_INW, I_CONVW, I_CONVB, I_ALOG, I_DTB, I_DSKIP, I_SNORM, I_OUTW,
       I_W1, I_W3, I_W2, I_RW, I_MW1, I_MW3, I_MW2, I_FNORM };

struct Frame {
    LAS unsigned char* lds;
    int tid, lane, wave, G, bx;
    const Params* p;
    unsigned char* ws;
    unsigned* ctl;
    float* H; float* mod;
};
#ifdef EMU
DEV const float* INP(const Frame& F, int i) { return F.p->in[i]; }
DEV float* OUTP(const Frame& F) { return F.p->out; }
DEV unsigned char* WSP(const Frame& F) { return F.p->ws; }
#define LAUNDER_S(x) ((void)0)
#else
typedef const float* cfptr_t;
DEV const float* INP(const Frame&, int i) { int k = i; asm volatile("" : "+s"(k)); return ((const __attribute__((address_space(4))) cfptr_t*)__builtin_amdgcn_kernarg_segment_ptr())[k]; }
DEV float* OUTP(const Frame& F) { return (float*)INP(F, 26); }
DEV unsigned char* WSP(const Frame& F) { return (unsigned char*)INP(F, 27); }
#define LAUNDER_S(x) asm volatile("" : "+s"(x))
#endif
constexpr int LDS_MISC = ge::STAGE_BYTES;
constexpr int LDS_BYTES = ge::STAGE_BYTES + 16384;

struct Src { const float* x; const float* ctx; float* H; const float* mod; };
DEV const float* modq(const float* mod, int layer, int vec, int which) { return mod + ((size_t)(layer * 3 + vec) * 6 + which) * D; }
DEV const float* modp(const Frame& F, int layer, int vec, int which) { return modq(F.mod, layer, vec, which); }
DEV const float* hsrc_row(const Src& s, bool from_input, int r) {
    if (from_input) return r < ML ? s.x + (size_t)r * D : s.ctx + (size_t)(r - ML) * D;
    return s.H + (size_t)r * D;
}
DEV Src mksrc(const Frame& F) { Src s; s.x = INP(F, I_X); s.ctx = INP(F, I_CTX); s.H = F.H; s.mod = F.mod; return s; }
DEV const float* hin_row(const Frame& F, int layer, int r) { return hsrc_row(mksrc(F), layer == 0, r); }

template <int K, int N, class RM>
DEV void transpose_item(const float* Wsrc, bf16_t* WT, int ldt, RM rowmap, LAS float* scr, int item, int lane) {
    constexpr int nblk = N / 32; const int kb = item / nblk, nb = item % nblk, k0 = 64 * kb, n0 = 32 * nb;
    float tmp[32];
#pragma unroll
    for (int i = 0; i < 32; ++i) { const int kk = 2 * i + (lane >> 5); tmp[i] = Wsrc[(size_t)(k0 + kk) * N + n0 + (lane & 31)]; }
#pragma unroll
    for (int i = 0; i < 32; ++i) { const int kk = 2 * i + (lane >> 5); scr[kk * 33 + (lane & 31)] = tmp[i]; }
    WSYNC();
    const int c = lane & 7; const int row0 = rowmap(n0);
#pragma unroll
    for (int j = 0; j < 4; ++j) { const int n = (lane >> 3) + 8 * j; const LAS float* s = scr + (8 * c) * 33 + n;
        u32x4 o; o.x = pk2(s[0 * 33], s[1 * 33]); o.y = pk2(s[2 * 33], s[3 * 33]); o.z = pk2(s[4 * 33], s[5 * 33]); o.w = pk2(s[6 * 33], s[7 * 33]);
        *(u32x4*)(WT + (size_t)(row0 + n) * ldt + k0 + 8 * c) = o; }
    WSYNC();
}
struct RmId { DEV int operator()(int n0) const { return n0; } };
struct RmIlv { int s; DEV int operator()(int n0) const { return (n0 >> 7) * 256 + s * 128 + (n0 & 127); } };
template <int K, int N, class RM>
DEV void convert_job(const Frame& F, const float* Wsrc, bf16_t* WT, int ldt, RM rm) {
    LAS float* scr = (LAS float*)(F.lds + F.wave * 16384);
    constexpr int items = (K / 64) * (N / 32); const int gw = F.bx * 8 + F.wave, NGW = F.G * 8;
    for (int it = gw; it < items; it += NGW) transpose_item<K, N>(Wsrc, WT, ldt, rm, scr, it, F.lane);
}
DEV void convert_even(const Frame& F, int j) {
    bf16_t* Wb = (bf16_t*)(F.ws + OFF_W);
    for (int g = 0; g < 4; ++g) convert_job<256, 256>(F, INP(F, I_POOLW) + ((size_t)j * 4 + g) * 65536, Wb + W_POOL / 2 + (size_t)g * 65536, 256, RmId{});
    convert_job<D, DFF>(F, INP(F, I_W1) + (size_t)j * D * DFF, Wb + W_UP / 2, D, RmIlv{0});
    convert_job<D, DFF>(F, INP(F, I_W3) + (size_t)j * D * DFF, Wb + W_UP / 2, D, RmIlv{1});
    convert_job<DFF, D>(F, INP(F, I_W2) + (size_t)j * DFF * D, Wb + W_DN / 2, DFF, RmId{});
}
DEV void convert_ssd(const Frame& F, int j) {
    bf16_t* Wb = (bf16_t*)(F.ws + OFF_W);
    convert_job<D, NPROJ>(F, INP(F, I_INW) + (size_t)j * D * NPROJ, Wb + W_IN / 2, D, RmId{});
    convert_job<DIN, D>(F, INP(F, I_OUTW) + (size_t)j * DIN * D, Wb + W_OUT / 2, DIN, RmId{});
    { u32x4* z = (u32x4*)(Wb + W_IN / 2 + (size_t)NPROJ * D); const int n16 = (NPROJP - NPROJ) * D * 2 / 16;
      unsigned zz = 0u; LAUNDER_V(zz);
      for (int i = F.bx * 512 + F.tid; i < n16; i += F.G * 512) z[i] = (u32x4){zz, zz, zz, zz}; }
}
DEV void convert_moe(const Frame& F, int j) {
    bf16_t* Wb = (bf16_t*)(F.ws + OFF_W);
    for (int e = 0; e < NEXP; ++e) {
        convert_job<D, DFFE>(F, INP(F, I_MW1) + ((size_t)j * NEXP + e) * D * DFFE, Wb + W_MUP / 2 + (size_t)e * 2 * DFFE * D, D, RmIlv{0});
        convert_job<D, DFFE>(F, INP(F, I_MW3) + ((size_t)j * NEXP + e) * D * DFFE, Wb + W_MUP / 2 + (size_t)e * 2 * DFFE * D, D, RmIlv{1});
        convert_job<DFFE, D>(F, INP(F, I_MW2) + ((size_t)j * NEXP + e) * DFFE * D, Wb + W_MDN / 2 + (size_t)e * D * DFFE, DFFE, RmId{});
    }
}

DEV void phase_mod(const Frame& F) {
    LAS float* red = (LAS float*)F.lds;
    const int nblk = DEPTH * 6144 / 64;
    const int col = F.tid & 63, ks = F.tid >> 6;
    for (int blk = F.bx; blk < nblk; blk += F.G) {
        const int layer = (blk * 64) / 6144, n = (blk * 64) % 6144 + col;
        const float* W = INP(F, I_ADAW) + (size_t)layer * D * 6144 + n;
        float a0 = 0.f, a1 = 0.f, a2 = 0.f;
#pragma unroll 8
        for (int k = ks * 128; k < ks * 128 + 128; ++k) { const float w = W[(size_t)k * 6144];
            a0 += siluf(INP(F, I_C)[k]) * w; a1 += siluf(INP(F, I_C)[D + k]) * w; a2 += siluf(INP(F, I_CCTX)[k]) * w; }
        red[(ks * 64 + col) * 3 + 0] = a0; red[(ks * 64 + col) * 3 + 1] = a1; red[(ks * 64 + col) * 3 + 2] = a2;
        __syncthreads();
        if (F.tid < 192) { const int c2 = F.tid % 64, v = F.tid / 64; float s = 0.f;
            for (int q = 0; q < 8; ++q) s += red[(q * 64 + c2) * 3 + v];
            const int n2 = (blk * 64) % 6144 + c2;
            F.mod[(size_t)(layer * 3 + v) * 6144 + n2] = s + INP(F, I_ADAB)[(size_t)layer * 6144 + n2]; }
        __syncthreads();
    }
}

DEV void load_row(const float* p, int lane, f32x4 (&v)[4]) {
#pragma unroll
    for (int j = 0; j < 4; ++j) v[j] = *(const f32x4*)(p + 4 * lane + 256 * j);
}
DEV float sumsq_row(const f32x4 (&v)[4]) { float s = 0.f;
#pragma unroll
    for (int j = 0; j < 4; ++j) s += (v[j][0] * v[j][0] + v[j][1] * v[j][1]) + (v[j][2] * v[j][2] + v[j][3] * v[j][3]);
    return wave_sum(s); }
DEV void normmod_row(f32x4 (&v)[4], float rstd, const float* w, const float* sh, const float* sc, int lane) {
#pragma unroll
    for (int j = 0; j < 4; ++j) { const int c = 4 * lane + 256 * j; const f32x4 wv = *(const f32x4*)(w + c), sv = *(const f32x4*)(sh + c), cv = *(const f32x4*)(sc + c);
        v[j] = v[j] * rstd * wv * (cv + 1.0f) + sv; }
}
DEV void store_row_bf16(bf16_t* o, int lane, const f32x4 (&v)[4]) {
#pragma unroll
    for (int j = 0; j < 4; ++j) { u32x2 w; w.x = pk2(v[j][0], v[j][1]); w.y = pk2(v[j][2], v[j][3]); *(u32x2*)(o + 4 * lane + 256 * j) = w; }
}

DEV void phase_norm(const Frame& F, int layer, int which, bf16_t* out, bool from_input) {
    const int gw = F.bx * 8 + F.wave, NGW = F.G * 8;
    const float* w = INP(F, which == 0 ? I_NMIX : I_NFFN) + (size_t)layer * D;
    for (int r = gw; r < MT; r += NGW) {
        f32x4 v[4]; load_row(hsrc_row(mksrc(F), from_input, r), F.lane, v);
        const float rstd = rsqrtf(sumsq_row(v) * (1.0f / D) + EPS);
        const int vec = vec_of(r);
        normmod_row(v, rstd, w, modp(F, layer, vec, which), modp(F, layer, vec, which + 1), F.lane);
        store_row_bf16(out + (size_t)r * D, F.lane, v);
    }
}

DEV void phase_poolprep(const Frame& F, int layer, bf16_t* P) {
    LAS float* rs = (LAS float*)(F.lds);
    const float* w = INP(F, I_NMIX) + (size_t)layer * D;
    const int ntile = MT / 64;
    for (int tile = F.bx; tile < ntile; tile += F.G) {
        const int r0 = tile * 64;
        int seq0, seq1;
        if (r0 < ML) { seq0 = r0; seq1 = r0 + 64; } else { seq0 = ML + ((r0 - ML) / CTXL) * CTXL; seq1 = seq0 + CTXL; }
        const int lo_r = (r0 - 8 > seq0) ? r0 - 8 : seq0, hi_r = (r0 + 64 + 7 < seq1) ? r0 + 64 + 7 : seq1;
        for (int r = lo_r + F.wave; r < hi_r; r += 8) { f32x4 v[4]; load_row(hin_row(F, layer, r), F.lane, v); const float ss = sumsq_row(v); if (F.lane == 0) rs[r - lo_r] = rsqrtf(ss * (1.0f / D) + EPS); }
        __syncthreads();
        const int vec = vec_of(r0);
        const int cq = F.tid & 255, half = F.tid >> 8, c = cq * 4, g = c >> 8, win = 2 << g, lo = win >> 1, hi = win - 1 - lo;
        const f32x4 wv = *(const f32x4*)(w + c), sv = *(const f32x4*)(modp(F, layer, vec, 0) + c), cv = *(const f32x4*)(modp(F, layer, vec, 1) + c) + 1.0f;
        const f32x4 wc = wv * cv;
        const int ta = r0 + 32 * half;
        auto uval = [&](int r) -> f32x4 { const f32x4 h = *(const f32x4*)(hin_row(F, layer, r) + c); return h * rs[r - lo_r] * wc + sv; };
        f32x4 s = (f32x4){0.f, 0.f, 0.f, 0.f};
        { const int a = (ta - lo > seq0) ? ta - lo : seq0, b = (ta + hi + 1 < seq1) ? ta + hi + 1 : seq1; for (int r = a; r < b; ++r) s += uval(r); }
        for (int t = ta; t < ta + 32; ++t) {
            const int a = (t - lo > seq0) ? t - lo : seq0, b = (t + hi + 1 < seq1) ? t + hi + 1 : seq1;
            const float inv = 1.0f / (float)(b - a);
            const f32x4 o = s * inv - uval(t);
            u32x2 pw; pw.x = pk2(o[0], o[1]); pw.y = pk2(o[2], o[3]); *(u32x2*)(P + (size_t)t * D + c) = pw;
            if (t + 1 < ta + 32) {
                if (t + 1 + hi < seq1) s += uval(t + 1 + hi);
                if (t - lo >= seq0) s -= uval(t - lo); }
        }
        __syncthreads();
    }
}

struct PolBase { int G, c; };
struct PolPool : PolBase {
    static constexpr bool PERM = false, GATHER = false; int K, lda, ldb;
    const bf16_t* P; const bf16_t* W; Src src; int layer; const float* scale;
    DEV bool next(int i, Unit& u) const { return ge::static_next(NPAN, 4, G, c, i, u); }
    DEV const char* a_base(const Unit& u) const { return (const char*)(P + (size_t)u.pm * 256 * D + u.pn * 256); }
    DEV const char* b_base(const Unit& u) const { return (const char*)(W + (size_t)u.pn * 65536); }
    DEV void epi(const f32x4 (&acc)[2][2][4][2], const Unit& u, int wr, int wc, int fr, int fq) const {
        const int row0 = u.pm * 256 + wr * 64 + fr, col0 = u.pn * 256 + wc * 32 + 4 * fq; const int vec = vec_of(u.pm * 256);
        const float* g1 = modq(src.mod, layer, vec, 2);
        f32x4 gv[2][2];
#pragma unroll
        for (int bj = 0; bj < 2; ++bj)
#pragma unroll
            for (int n = 0; n < 2; ++n) { const int cc = col0 + bj * 128 + n * 16; gv[bj][n] = *(const f32x4*)(g1 + cc) * *(const f32x4*)(scale + cc); }
#pragma unroll
        for (int ai = 0; ai < 2; ++ai)
#pragma unroll
            for (int m = 0; m < 4; ++m) { const int r = row0 + ai * 128 + m * 16; const float* hi = hsrc_row(src, layer == 0, r) + col0; float* ho = src.H + (size_t)r * D + col0;
#pragma unroll
                for (int bj = 0; bj < 2; ++bj)
#pragma unroll
                    for (int n = 0; n < 2; ++n) *(f32x4*)(ho + bj * 128 + n * 16) = *(const f32x4*)(hi + bj * 128 + n * 16) + gv[bj][n] * acc[ai][bj][m][n]; }
    }
};
struct PolResid : PolBase {
    static constexpr bool PERM = false, GATHER = false; int K, lda, ldb;
    const bf16_t* A; const bf16_t* W; Src src; int layer, which;
    DEV bool next(int i, Unit& u) const { return ge::static_next(NPAN, 4, G, c, i, u); }
    DEV const char* a_base(const Unit& u) const { return (const char*)(A + (size_t)u.pm * 256 * lda); }
    DEV const char* b_base(const Unit& u) const { return (const char*)(W + (size_t)u.pn * 256 * ldb); }
    DEV void epi(const f32x4 (&acc)[2][2][4][2], const Unit& u, int wr, int wc, int fr, int fq) const {
        const int row0 = u.pm * 256 + wr * 64 + fr, col0 = u.pn * 256 + wc * 32 + 4 * fq; const int vec = vec_of(u.pm * 256);
        const float* gp = modq(src.mod, layer, vec, which);
        f32x4 gv[2][2];
#pragma unroll
        for (int bj = 0; bj < 2; ++bj)
#pragma unroll
            for (int n = 0; n < 2; ++n) gv[bj][n] = *(const f32x4*)(gp + col0 + bj * 128 + n * 16);
#pragma unroll
        for (int ai = 0; ai < 2; ++ai)
#pragma unroll
            for (int m = 0; m < 4; ++m) { float* ho = src.H + (size_t)(row0 + ai * 128 + m * 16) * D + col0;
#pragma unroll
                for (int bj = 0; bj < 2; ++bj)
#pragma unroll
                    for (int n = 0; n < 2; ++n) { f32x4* q = (f32x4*)(ho + bj * 128 + n * 16); *q = *q + gv[bj][n] * acc[ai][bj][m][n]; } }
    }
};
template <bool MOE>
struct PolUp : PolBase {
    static constexpr bool PERM = true, GATHER = MOE; int K, lda, ldb;
    const bf16_t* A; const bf16_t* W; bf16_t* HID; int ldh, nq;
    int nM; const int* s2t; int tstart[NEXP + 1];
    DEV bool next(int i, Unit& u) const { return ge::static_next(MOE ? nM : NPAN, nq, G, c, i, u); }
    DEV int expert_of(int pm) const { int e = 0;
#pragma unroll
        for (int k = 1; k < NEXP; ++k) e += (pm >= tstart[k]) ? 1 : 0;
        return e; }
    DEV const char* a_base(const Unit& u) const { return MOE ? (const char*)A : (const char*)(A + (size_t)u.pm * 256 * lda); }
    DEV const char* b_base(const Unit& u) const { size_t off = (size_t)u.pn * 256 * ldb; if (MOE) off += (size_t)expert_of(u.pm) * 2 * DFFE * ldb; return (const char*)(W + off); }
    DEV int gather_row(const Unit& u, int R) const { return s2t[u.pm * 256 + R]; }
    DEV void epi(const f32x4 (&acc)[2][2][4][2], const Unit& u, int wr, int wc, int fr, int fq) const {
        const int row0 = u.pm * 256 + wr * 64 + fr, col0 = u.pn * 128 + wc * 32 + 8 * fq;
#pragma unroll
        for (int ai = 0; ai < 2; ++ai)
#pragma unroll
            for (int m = 0; m < 4; ++m) { bf16_t* o = HID + (size_t)(row0 + ai * 128 + m * 16) * ldh + col0;
                float h[8];
#pragma unroll
                for (int n = 0; n < 2; ++n)
#pragma unroll
                    for (int i = 0; i < 4; ++i) h[4 * n + i] = siluf(acc[ai][0][m][n][i]) * acc[ai][1][m][n][i];
                u32x4 w; w.x = pk2(h[0], h[1]); w.y = pk2(h[2], h[3]); w.z = pk2(h[4], h[5]); w.w = pk2(h[6], h[7]);
                *(u32x4*)o = w; }
    }
};
struct PolMoeDown : PolBase {
    static constexpr bool PERM = true, GATHER = false; int K, lda, ldb;
    const bf16_t* A; const bf16_t* W; bf16_t* YS; int nM; int tstart[NEXP + 1];
    DEV bool next(int i, Unit& u) const { return ge::static_next(nM, 4, G, c, i, u); }
    DEV int expert_of(int pm) const { int e = 0;
#pragma unroll
        for (int k = 1; k < NEXP; ++k) e += (pm >= tstart[k]) ? 1 : 0;
        return e; }
    DEV const char* a_base(const Unit& u) const { return (const char*)(A + (size_t)u.pm * 256 * lda); }
    DEV const char* b_base(const Unit& u) const { return (const char*)(W + ((size_t)expert_of(u.pm) * D + (size_t)u.pn * 256) * ldb); }
    DEV void epi(const f32x4 (&acc)[2][2][4][2], const Unit& u, int wr, int wc, int fr, int fq) const {
        const int row0 = u.pm * 256 + wr * 64 + fr, col0 = u.pn * 256 + wc * 32 + 8 * fq;
#pragma unroll
        for (int ai = 0; ai < 2; ++ai)
#pragma unroll
            for (int m = 0; m < 4; ++m) { bf16_t* o = YS + (size_t)(row0 + ai * 128 + m * 16) * D + col0;
#pragma unroll
                for (int bj = 0; bj < 2; ++bj) { u32x4 w; w.x = pk2(acc[ai][bj][m][0][0], acc[ai][bj][m][0][1]); w.y = pk2(acc[ai][bj][m][0][2], acc[ai][bj][m][0][3]);
                    w.z = pk2(acc[ai][bj][m][1][0], acc[ai][bj][m][1][1]); w.w = pk2(acc[ai][bj][m][1][2], acc[ai][bj][m][1][3]); *(u32x4*)(o + bj * 128) = w; } }
    }
};
struct PolInProj : PolBase {
    static constexpr bool PERM = true, GATHER = false; int K, lda, ldb;
    const bf16_t* A; const bf16_t* W; bf16_t* Z; bf16_t* XBC; float* DT;
    DEV bool next(int i, Unit& u) const { return ge::static_next(NPAN, NPROJP / 256, G, c, i, u); }
    DEV const char* a_base(const Unit& u) const { return (const char*)(A + (size_t)u.pm * 256 * lda); }
    DEV const char* b_base(const Unit& u) const { return (const char*)(W + (size_t)u.pn * 256 * ldb); }
    DEV void epi(const f32x4 (&acc)[2][2][4][2], const Unit& u, int wr, int wc, int fr, int fq) const {
        const int row0 = u.pm * 256 + wr * 64 + fr, cw = wc * 32 + 8 * fq;
        if (u.pn < 20) {
            bf16_t* base; int ld, col0;
            if (u.pn < 8) { base = Z; ld = DIN; col0 = u.pn * 256 + cw; } else { base = XBC; ld = CONVD; col0 = (u.pn - 8) * 256 + cw; }
#pragma unroll
            for (int ai = 0; ai < 2; ++ai)
#pragma unroll
                for (int m = 0; m < 4; ++m) { bf16_t* o = base + (size_t)(row0 + ai * 128 + m * 16) * ld + col0;
#pragma unroll
                    for (int bj = 0; bj < 2; ++bj) { u32x4 w; w.x = pk2(acc[ai][bj][m][0][0], acc[ai][bj][m][0][1]); w.y = pk2(acc[ai][bj][m][0][2], acc[ai][bj][m][0][3]);
                        w.z = pk2(acc[ai][bj][m][1][0], acc[ai][bj][m][1][1]); w.w = pk2(acc[ai][bj][m][1][2], acc[ai][bj][m][1][3]); *(u32x4*)(o + bj * 128) = w; } }
        } else if (cw < 64) {
#pragma unroll
            for (int ai = 0; ai < 2; ++ai)
#pragma unroll
                for (int m = 0; m < 4; ++m) { const int r = row0 + ai * 128 + m * 16; int b, tv;
                    if (r < ML) { b = r / SEQ; tv = CTXL + r % SEQ; } else { b = (r - ML) / CTXL; tv = (r - ML) % CTXL; }
#pragma unroll
                    for (int n = 0; n < 2; ++n)
#pragma unroll
                        for (int i = 0; i < 4; ++i) { const int j = cw + 4 * n + i, dir = j >> 5, h = j & 31;
                            DT[((size_t)(b * 2 + dir) * NH + h) * TV + tv] = acc[ai][0][m][n][i]; } }
        }
    }
};

DEV void phase_conv(const Frame& F, int j, const bf16_t* XBC, bf16_t* XT, bf16_t* Brow, bf16_t* BT, bf16_t* Crow) {
    LAS bf16_t* tl = (LAS bf16_t*)F.lds;
    const float* cw = INP(F, I_CONVW) + (size_t)j * 4 * CONVD; const float* cb = INP(F, I_CONVB) + (size_t)j * CONVD;
    const int nitem = NB * NCH * (CONVD / 64);
    const int t = F.tid & 127, cg = F.tid >> 7;
    for (int it = F.bx; it < nitem; it += F.G) {
        const int cblk = it % (CONVD / 64), cv = (it / (CONVD / 64)) % NCH, b = it / ((CONVD / 64) * NCH);
        const int ch0 = cblk * 64 + cg * 16, tv = cv * 128 + t;
        const int seg0 = tv < CTXL ? 0 : CTXL, seg1 = tv < CTXL ? CTXL : TV;
        float a[16];
#pragma unroll
        for (int i = 0; i < 16; ++i) a[i] = cb[ch0 + i];
#pragma unroll
        for (int k = 0; k < 4; ++k) { const int tk = tv - 2 + k;
            if (tk >= seg0 && tk < seg1) { const bf16_t* src = XBC + (size_t)row_of(b, tk) * CONVD + ch0; const u32x4 q0 = *(const u32x4*)src, q1 = *(const u32x4*)(src + 8);
                const unsigned qq[8] = {q0.x, q0.y, q0.z, q0.w, q1.x, q1.y, q1.z, q1.w};
#pragma unroll
                for (int i = 0; i < 8; ++i) { a[2 * i] += cw[k * CONVD + ch0 + 2 * i] * bflo(qq[i]); a[2 * i + 1] += cw[k * CONVD + ch0 + 2 * i + 1] * bfhi(qq[i]); } } }
        unsigned pk[8];
#pragma unroll
        for (int i = 0; i < 8; ++i) pk[i] = pk2(siluf(a[2 * i]), siluf(a[2 * i + 1]));
        const int r = row_of(b, tv);
        const bool isx = cblk < DIN / 64, isb = !isx && cblk < (DIN + BCD) / 64;
        if (isb) { bf16_t* o = Brow + (size_t)r * BCD + (ch0 - DIN); *(u32x4*)o = (u32x4){pk[0], pk[1], pk[2], pk[3]}; *(u32x4*)(o + 8) = (u32x4){pk[4], pk[5], pk[6], pk[7]}; }
        if (!isx && !isb) { bf16_t* o = Crow + (size_t)r * BCD + (ch0 - DIN - BCD); *(u32x4*)o = (u32x4){pk[0], pk[1], pk[2], pk[3]}; *(u32x4*)(o + 8) = (u32x4){pk[4], pk[5], pk[6], pk[7]}; }
        if (isx || isb) {
#pragma unroll
            for (int i = 0; i < 8; ++i) { tl[(cg * 16 + 2 * i) * 136 + t] = (bf16_t)(pk[i] & 0xffffu); tl[(cg * 16 + 2 * i + 1) * 136 + t] = (bf16_t)(pk[i] >> 16); }
            __syncthreads();
            bf16_t* dst = isx ? XT + ((size_t)b * DIN + cblk * 64) * TV : BT + ((size_t)b * BCD + (cblk * 64 - DIN)) * TV;
#pragma unroll
            for (int q = 0; q < 2; ++q) { const int idx = F.tid + q * 512, ch = idx >> 4, t8 = (idx & 15) * 8;
                const LAS bf16_t* s = tl + ch * 136 + t8; u32x4 w; w.x = s[0] | ((unsigned)s[1] << 16); w.y = s[2] | ((unsigned)s[3] << 16); w.z = s[4] | ((unsigned)s[5] << 16); w.w = s[6] | ((unsigned)s[7] << 16);
                *(u32x4*)(dst + (size_t)ch * TV + cv * 128 + t8) = w; }
            __syncthreads();
        }
    }
}

DEV void phase_cb(const Frame& F, const bf16_t* Brow, const bf16_t* Crow, bf16_t* CB) {
    const int nitem = NB * NG * NCH; const int fr = F.lane & 15, fq = F.lane >> 4;
    for (int it = F.bx; it < nitem; it += F.G) {
        const int cv = it % NCH, g = (it / NCH) % NG, b = it / (NCH * NG);
        const int rbase = row_of(b, cv * 128);
        bf16x8 cf[4];
#pragma unroll
        for (int ks = 0; ks < 4; ++ks) cf[ks] = *(const bf16x8*)(Crow + (size_t)(rbase + 16 * F.wave + fr) * BCD + g * 128 + 32 * ks + 8 * fq);
        bf16_t* out = CB + ((size_t)((b * NG + g) * NCH + cv)) * 16384;
#pragma unroll
        for (int nt = 0; nt < 8; ++nt) {
            f32x4 acc = (f32x4){0.f, 0.f, 0.f, 0.f};
#pragma unroll
            for (int ks = 0; ks < 4; ++ks) { const bf16x8 bfr = *(const bf16x8*)(Brow + (size_t)(rbase + 16 * nt + fr) * BCD + g * 128 + 32 * ks + 8 * fq); acc = MFMA16(bfr, cf[ks], acc); }
            u32x2 w; w.x = pk2(acc[0], acc[1]); w.y = pk2(acc[2], acc[3]);
            *(u32x2*)(out + (size_t)(16 * F.wave + fr) * 128 + 16 * nt + 4 * fq) = w;
        }
    }
}

DEV void phase_tables(const Frame& F, int j, float* DT, float* CUM, float* WJ) {
    const int nitem = NB * 2 * NH * NCH; const int gw = F.bx * 8 + F.wave, NGW = F.G * 8;
    for (int it = gw; it < nitem; it += NGW) {
        const int cv = it % NCH, h = (it / NCH) % NH, dir = (it / (NCH * NH)) & 1, b = it / (NCH * NH * 2);
        const float A = -expf(INP(F, I_ALOG)[(size_t)(j * 2 + dir) * NH + h]); const float bias = INP(F, I_DTB)[(size_t)(j * 2 + dir) * NH + h];
        const size_t o = ((size_t)(b * 2 + dir) * NH + h) * TV + cv * 128 + 2 * F.lane;
        const f32x2 raw = *(const f32x2*)(DT + o); const float d0 = softplusf(raw.x + bias), d1 = softplusf(raw.y + bias); const float a0 = d0 * A, a1 = d1 * A;
        float c0, c1, tot, sum = a0 + a1;
        if (dir == 0) {
#pragma unroll
            for (int q = 1; q < 64; q <<= 1) { const float t2 = __shfl_up(sum, q); if (F.lane >= q) sum += t2; }
            c1 = sum; c0 = sum - a1; tot = __shfl(sum, 63);
        } else {
#pragma unroll
            for (int q = 1; q < 64; q <<= 1) { const float t2 = __shfl_down(sum, q); if (F.lane + q < 64) sum += t2; }
            c0 = sum; c1 = sum - a0; tot = __shfl(sum, 0);
        }
        constexpr float L2E = 1.4426950408889634f;
        *(f32x2*)(DT + o) = (f32x2){c0 * L2E - log2f(d0), c1 * L2E - log2f(d1)};
        *(f32x2*)(CUM + o) = (f32x2){c0 * L2E, c1 * L2E};
        *(f32x2*)(WJ + o) = (f32x2){d0 * FEXP(tot - c0), d1 * FEXP(tot - c1)};
    }
}

constexpr int SC_HL = 0, SC_TAB = 17408, SC_CB = 20480, SC_BT = SC_CB + 32768, SC_C = SC_BT + 32768, SC_X = SC_C + 32768, SC_END = SC_X + 8192;
static_assert(SC_END <= ge::STAGE_BYTES, "scan LDS map");
DEV void phase_scan(const Frame& F, int j, const bf16_t* XT, const bf16_t* BT, const bf16_t* Crow, const bf16_t* CB, const float* DT, const float* CUM, const float* WJ, bf16_t* Yf, bf16_t* Yb) {
    LAS unsigned char* L = F.lds;
    LAS bf16_t* Hl = (LAS bf16_t*)(L + SC_HL);
    LAS float* tab = (LAS float*)(L + SC_TAB);
    const int fr = F.lane & 15, fq = F.lane >> 4, w = F.wave;
    const int nitem = NB * NH * 2 * 2;
    for (int it = F.bx; it < nitem; it += F.G) {
        const int xq = it & 7, kq = it >> 3; const int b = xq >> 2, g = xq & 3, h = 8 * g + (kq >> 2), dir = (kq >> 1) & 1, ph = kq & 1;
        const float Dsk = dir == 0 ? INP(F, I_DSKIP)[(size_t)j * NH + h] : 0.f;
        const size_t tbase = ((size_t)(b * 2 + dir) * NH + h) * TV;
        const bf16_t* xt = XT + ((size_t)b * DIN + h * HD + ph * 32) * TV;
        const bf16_t* bt = BT + ((size_t)b * BCD + g * 128) * TV;
        const bf16_t* CBh = CB + (size_t)((b * NG + g) * NCH) * 16384;
        const bf16_t* Cg = Crow + g * 128;
        bf16_t* Y = (dir ? Yb : Yf) + h * HD + ph * 32;
        const int lrow = 16 * w + fr;
        const int dr = F.lane >> 4, dc = F.lane & 15;
        f32x4 accH[2]; accH[0] = (f32x4){0.f, 0.f, 0.f, 0.f}; accH[1] = accH[0];
        for (int i = F.tid; i < 32 * 136 / 2; i += 512) ((LAS unsigned*)Hl)[i] = 0u;
#define SC_CHUNK_OF(step) (dir == 0 ? (step) : ((step) < 2 ? 1 - (step) : (NCH - 1) - ((step) - 2)))
        const int rsw = (4 * (w & 3) + dr) & 15, gc = dc ^ rsw;
        const unsigned loCB = (unsigned)(dr * 128 + 8 * gc) * 2u, loT = (unsigned)(dr * TV + 8 * gc) * 2u, loC = (unsigned)(dr * BCD + 8 * gc) * 2u;
#define SC_ISSUE_TILES(cvx_) do { const int cvx = (cvx_); const unsigned tvx = cvx * 128u; const unsigned rbx = (unsigned)row_of(b, cvx * 128); \
            _Pragma("unroll") for (int jj = 0; jj < 13; ++jj) { const int q = 8 * jj + w, r0 = 4 * (q & 31);   \
                const char* src; int toff; \
                if (jj < 4) { src = (const char*)(CBh + ((size_t)cvx * 16384u + (unsigned)r0 * 128u)) + loCB; toff = SC_CB; } \
                else if (jj < 8) { src = (const char*)(bt + ((size_t)r0 * TV + tvx)) + loT; toff = SC_BT; } \
                else if (jj < 12) { src = (const char*)(Cg + (size_t)(rbx + r0) * BCD) + loC; toff = SC_C; } \
                else { src = (const char*)(xt + ((size_t)r0 * TV + tvx)) + loT; toff = SC_X; } \
                GLDS16(src, L + toff + (q & 31) * 1024); } } while (0)
        const int kd = w >> 1; float km[8], dk[8];
#pragma unroll
        for (int i = 0; i < 8; ++i) { const int sidx = 32 * kd + 8 * fq + i; km[i] = (dir == 0 ? (sidx <= lrow) : (sidx >= lrow)) ? 1.f : 0.f; dk[i] = (sidx == lrow) ? Dsk : 0.f; }
#define SC_ISSUE_TAB(cvx_, tbuf_) do { if (w < 6) { const int tsel = w >> 1, half = w & 1; const float* tsrc = tsel == 0 ? CUM : (tsel == 1 ? DT : WJ); \
            GLDS4(tsrc + tbase + (cvx_) * 128 + half * 64 + F.lane, (LAS unsigned char*)(tab + (tbuf_) * 384 + tsel * 128 + half * 64)); } } while (0)
        { const int cv0 = SC_CHUNK_OF(0); SC_ISSUE_TILES(cv0); SC_ISSUE_TAB(cv0, 0); }
        for (int step = 0; step < NCH; ++step) {
            const int cv = SC_CHUNK_OF(step), buf = step & 1; const bool more = step + 1 < NCH;
            const int cvn = more ? SC_CHUNK_OF(step + 1) : cv;
            const unsigned rbase = (unsigned)row_of(b, cv * 128);
            if (step == 0) WAITV(0); else WAITV(2);
            LDSBAR();
            u32x4 rcb[4], rbt[4]; bf16x8 xf[2][4], cf[4];
#pragma unroll
            for (int ks = 0; ks < 4; ++ks) { const int fo = lrow * 256 + (((4 * ks + fq) ^ fr) << 4);
                rcb[ks] = *(const LAS u32x4*)(L + SC_CB + fo); rbt[ks] = *(const LAS u32x4*)(L + SC_BT + fo); cf[ks] = *(const LAS bf16x8*)(L + SC_C + fo);
#pragma unroll
                for (int nt = 0; nt < 2; ++nt) xf[nt][ks] = *(const LAS bf16x8*)(L + SC_X + (16 * nt + fr) * 256 + (((4 * ks + fq) ^ fr) << 4)); }
            LDSBAR();
            if (more) { SC_ISSUE_TILES(cvn); SC_ISSUE_TAB(cvn, buf ^ 1); }
            const LAS float* tb = tab + buf * 384;
            const float cl2 = tb[lrow]; const float ecum_l = fexp2(cl2);
            const float chunk_decay = fexp2(dir == 0 ? tb[127] : tb[0]);
            bf16x8 mf[4], bw[4];
#pragma unroll
            for (int ks = 0; ks < 4; ++ks) { const int s0 = 32 * ks + 8 * fq;
                const bool none = dir == 0 ? (ks > kd) : (ks < kd), diag = (ks == kd);
                unsigned om[4] = {0u, 0u, 0u, 0u};
                if (!none) {
                    const f32x4 cs0 = *(const LAS f32x4*)(tb + 128 + s0), cs1 = *(const LAS f32x4*)(tb + 128 + s0 + 4);
                    const float cs[8] = {cs0[0], cs0[1], cs0[2], cs0[3], cs1[0], cs1[1], cs1[2], cs1[3]};
                    const unsigned qc[4] = {rcb[ks].x, rcb[ks].y, rcb[ks].z, rcb[ks].w};
                    float v[8];
                    if (!diag) {
#pragma unroll
                        for (int i = 0; i < 8; ++i) { const float cbv = (i & 1) ? bfhi(qc[i >> 1]) : bflo(qc[i >> 1]); v[i] = cbv * fexp2(cl2 - cs[i]); }
                    } else {
#pragma unroll
                        for (int i = 0; i < 8; ++i) { const float cbv = (i & 1) ? bfhi(qc[i >> 1]) : bflo(qc[i >> 1]); const float x = cl2 - cs[i]; v[i] = (cbv * fexp2(x < 60.f ? x : 60.f)) * km[i] + dk[i]; }
                    }
#pragma unroll
                    for (int i = 0; i < 4; ++i) om[i] = pk2(v[2 * i], v[2 * i + 1]);
                }
                mf[ks] = __builtin_bit_cast(bf16x8, (u32x4){om[0], om[1], om[2], om[3]});
                { const f32x4 ws0 = *(const LAS f32x4*)(tb + 256 + s0), ws1 = *(const LAS f32x4*)(tb + 256 + s0 + 4); const float wsv[8] = {ws0[0], ws0[1], ws0[2], ws0[3], ws1[0], ws1[1], ws1[2], ws1[3]};
                  const unsigned qb[4] = {rbt[ks].x, rbt[ks].y, rbt[ks].z, rbt[ks].w}; unsigned ob[4];
#pragma unroll
                  for (int i = 0; i < 4; ++i) ob[i] = pk2(bflo(qb[i]) * wsv[2 * i], bfhi(qb[i]) * wsv[2 * i + 1]);
                  bw[ks] = __builtin_bit_cast(bf16x8, (u32x4){ob[0], ob[1], ob[2], ob[3]}); } }
            f32x4 yd[2], yo[2];
#pragma unroll
            for (int nt = 0; nt < 2; ++nt) { yd[nt] = (f32x4){0.f, 0.f, 0.f, 0.f}; yo[nt] = yd[nt]; accH[nt] = accH[nt] * chunk_decay; }
#pragma unroll
            for (int nt = 0; nt < 2; ++nt)
#pragma unroll
                for (int ks = 0; ks < 4; ++ks) {
                    yd[nt] = MFMA16(xf[nt][ks], mf[ks], yd[nt]);
                    const bf16x8 hf = *(const LAS bf16x8*)(Hl + buf * (32 * 136) + (16 * nt + fr) * 136 + 32 * ks + 8 * fq);
                    yo[nt] = MFMA16(hf, cf[ks], yo[nt]);
                    accH[nt] = MFMA16(bw[ks], xf[nt][ks], accH[nt]); }
#pragma unroll
            for (int nt = 0; nt < 2; ++nt) { u32x2 hw; hw.x = pk2(accH[nt][0], accH[nt][1]); hw.y = pk2(accH[nt][2], accH[nt][3]);
                *(LAS u32x2*)(Hl + (buf ^ 1) * (32 * 136) + (16 * nt + fr) * 136 + 16 * w + 4 * fq) = hw; }
#pragma unroll
            for (int nt = 0; nt < 2; ++nt) { u32x2 yw; yw.x = pk2(yd[nt][0] + ecum_l * yo[nt][0], yd[nt][1] + ecum_l * yo[nt][1]); yw.y = pk2(yd[nt][2] + ecum_l * yo[nt][2], yd[nt][3] + ecum_l * yo[nt][3]);
                *(u32x2*)(Y + ((size_t)(rbase + lrow) * DIN + 16 * nt + 4 * fq)) = yw; }
        }
        WAITV(0); LDSBAR();
    }
}

DEV void phase_gate(const Frame& F, int j, const bf16_t* Yf, const bf16_t* Yb, const bf16_t* Z, bf16_t* YN) {
    const int gw = F.bx * 8 + F.wave, NGW = F.G * 8; const float* nw = INP(F, I_SNORM) + (size_t)j * DIN;
    for (int r = gw; r < MT; r += NGW) {
        float t[32]; float ss = 0.f;
#pragma unroll
        for (int q = 0; q < 4; ++q) { const size_t o = (size_t)r * DIN + 8 * F.lane + 512 * q; const u32x4 a = *(const u32x4*)(Yf + o), bq = *(const u32x4*)(Yb + o), z = *(const u32x4*)(Z + o);
            const unsigned aa[4] = {a.x, a.y, a.z, a.w}, bb[4] = {bq.x, bq.y, bq.z, bq.w}, zz[4] = {z.x, z.y, z.z, z.w};
#pragma unroll
            for (int i = 0; i < 4; ++i) { const float v0 = (bflo(aa[i]) + bflo(bb[i])) * siluf(bflo(zz[i])), v1 = (bfhi(aa[i]) + bfhi(bb[i])) * siluf(bfhi(zz[i])); t[8 * q + 2 * i] = v0; t[8 * q + 2 * i + 1] = v1; ss += v0 * v0 + v1 * v1; } }
        const float rstd = rsqrtf(wave_sum(ss) * (1.0f / DIN) + EPS);
#pragma unroll
        for (int q = 0; q < 4; ++q) { const int c = 8 * F.lane + 512 * q; const f32x4 w0 = *(const f32x4*)(nw + c), w1 = *(const f32x4*)(nw + c + 4);
            u32x4 o; o.x = pk2(t[8 * q] * rstd * w0[0], t[8 * q + 1] * rstd * w0[1]); o.y = pk2(t[8 * q + 2] * rstd * w0[2], t[8 * q + 3] * rstd * w0[3]);
            o.z = pk2(t[8 * q + 4] * rstd * w1[0], t[8 * q + 5] * rstd * w1[1]); o.w = pk2(t[8 * q + 6] * rstd * w1[2], t[8 * q + 7] * rstd * w1[3]);
            *(u32x4*)(YN + (size_t)r * DIN + c) = o; }
    }
}

struct TokInfo { int s0, s1; float g0, g1; };
DEV void phase_route(const Frame& F, int layer, int ml, bf16_t* V) {
    LAS unsigned* lc = (LAS unsigned*)(F.lds + LDS_MISC + 256);
    if (F.tid < 8) lc[F.tid] = 0u;
    __syncthreads();
    const int gw = F.bx * 8 + F.wave, NGW = F.G * 8; const int j = layer / 2;
    const float* w = INP(F, I_NFFN) + (size_t)layer * D; const float* rw = INP(F, I_RW) + (size_t)j * D * NEXP;
    TokInfo* tok = (TokInfo*)(F.ws + OFF_TOK);
    for (int r = gw; r < MT; r += NGW) {
        f32x4 v[4]; load_row(F.H + (size_t)r * D, F.lane, v);
        const float rstd = rsqrtf(sumsq_row(v) * (1.0f / D) + EPS);
        const int vec = vec_of(r);
        normmod_row(v, rstd, w, modp(F, layer, vec, 3), modp(F, layer, vec, 4), F.lane);
        store_row_bf16(V + (size_t)r * D, F.lane, v);
        float lg[NEXP];
#pragma unroll
        for (int e = 0; e < NEXP; ++e) lg[e] = 0.f;
#pragma unroll
        for (int jj = 0; jj < 4; ++jj)
#pragma unroll
            for (int i = 0; i < 4; ++i) { const int c = 4 * F.lane + 256 * jj + i; const f32x4 r0 = *(const f32x4*)(rw + (size_t)c * NEXP), r1 = *(const f32x4*)(rw + (size_t)c * NEXP + 4);
#pragma unroll
                for (int e = 0; e < 4; ++e) { lg[e] += v[jj][i] * r0[e]; lg[4 + e] += v[jj][i] * r1[e]; } }
#pragma unroll
        for (int e = 0; e < NEXP; ++e) lg[e] = wave_sum(lg[e]);
        int e0 = 0; float v0 = lg[0];
#pragma unroll
        for (int e = 1; e < NEXP; ++e) if (lg[e] > v0) { v0 = lg[e]; e0 = e; }
        int e1 = -1; float v1 = -3.0e38f;
#pragma unroll
        for (int e = 0; e < NEXP; ++e) if (e != e0 && lg[e] > v1) { v1 = lg[e]; e1 = e; }
        const float g1 = 1.0f / (1.0f + expf(v0 - v1)), g0 = 1.0f - g1;
        if (F.lane == 0) { TokInfo ti; ti.s0 = e0; ti.s1 = e1; ti.g0 = g0; ti.g1 = g1; tok[r] = ti; atomicAdd((unsigned*)&lc[e0], 1u); atomicAdd((unsigned*)&lc[e1], 1u); }
    }
    __syncthreads();
    if (F.tid < 8) __hip_atomic_fetch_add(F.ctl + CW_CNT + (ml * 8 + F.tid) * 64, lc[F.tid], RLX_AGENT);
}
DEV void tile_starts(const Frame& F, int ml, int (&ts)[NEXP + 1], unsigned (&cnt)[NEXP]) {
    ts[0] = 0;
#pragma unroll
    for (int e = 0; e < NEXP; ++e) { cnt[e] = __hip_atomic_load(F.ctl + CW_CNT + (ml * 8 + e) * 64, RLX_AGENT); ts[e + 1] = ts[e] + (int)((cnt[e] + 255u) / 256u); }
}
DEV void phase_slots(const Frame& F, int ml) {
    int ts[NEXP + 1]; unsigned cnt[NEXP]; tile_starts(F, ml, ts, cnt);
    TokInfo* tok = (TokInfo*)(F.ws + OFF_TOK); int* s2t = (int*)(F.ws + OFF_S2T);
    const int gw = F.bx * 8 + F.wave, NGW = F.G * 8;
    for (int base = gw * 64; base < MT; base += NGW * 64) {
        const int r = base + F.lane; TokInfo ti = tok[r];
        const int ek[2] = {ti.s0, ti.s1}; int sl[2];
#pragma unroll
        for (int k = 0; k < 2; ++k) { sl[k] = 0;
            for (int e = 0; e < NEXP; ++e) { const unsigned long long m = __ballot(ek[k] == e);
                if (m) { const int leader = __builtin_ctzll(m); unsigned b0 = 0;
                    if (F.lane == leader) b0 = __hip_atomic_fetch_add(F.ctl + CW_CUR + (ml * 8 + e) * 64, (unsigned)__builtin_popcountll(m), RLX_AGENT);
                    b0 = __shfl(b0, leader);
                    if (ek[k] == e) sl[k] = ts[e] * 256 + (int)b0 + __builtin_popcountll(m & ((1ull << F.lane) - 1ull)); } } }
        ti.s0 = sl[0]; ti.s1 = sl[1]; tok[r] = ti; s2t[sl[0]] = r; s2t[sl[1]] = r;
    }
    if (F.bx == 0) { for (int e = 0; e < NEXP; ++e) { const int a = ts[e] * 256 + (int)cnt[e], b2 = ts[e + 1] * 256; for (int s = a + F.tid; s < b2; s += 512) s2t[s] = 0; } }
}
DEV void phase_combine(const Frame& F, int layer, const bf16_t* YS, bool final_) {
    const int gw = F.bx * 8 + F.wave, NGW = F.G * 8; const TokInfo* tok = (const TokInfo*)(F.ws + OFF_TOK);
    const int nrows = final_ ? ML : MT;
    for (int r = gw; r < nrows; r += NGW) {
        f32x4 v[4]; load_row(F.H + (size_t)r * D, F.lane, v);
        const TokInfo ti = tok[r]; const float* g2 = modp(F, layer, vec_of(r), 5);
#pragma unroll
        for (int jj = 0; jj < 4; ++jj) { const int c = 4 * F.lane + 256 * jj; const u32x2 a = *(const u32x2*)(YS + (size_t)ti.s0 * D + c), b = *(const u32x2*)(YS + (size_t)ti.s1 * D + c); const f32x4 gv = *(const f32x4*)(g2 + c);
            v[jj][0] += gv[0] * (ti.g0 * bflo(a.x) + ti.g1 * bflo(b.x)); v[jj][1] += gv[1] * (ti.g0 * bfhi(a.x) + ti.g1 * bfhi(b.x));
            v[jj][2] += gv[2] * (ti.g0 * bflo(a.y) + ti.g1 * bflo(b.y)); v[jj][3] += gv[3] * (ti.g0 * bfhi(a.y) + ti.g1 * bfhi(b.y)); }
        if (!final_) {
#pragma unroll
            for (int jj = 0; jj < 4; ++jj) *(f32x4*)(F.H + (size_t)r * D + 4 * F.lane + 256 * jj) = v[jj];
        } else {
            const float rstd = rsqrtf(sumsq_row(v) * (1.0f / D) + EPS); const float* fw = INP(F, I_FNORM);
#pragma unroll
            for (int jj = 0; jj < 4; ++jj) { const int c = 4 * F.lane + 256 * jj; *(f32x4*)(OUTP(F) + (size_t)r * D + c) = v[jj] * rstd * *(const f32x4*)(fw + c); }
        }
    }
}

constexpr int PH_PER_PAIR = 17, N_PHASES = 1 + 2 * PH_PER_PAIR;
__global__ void __launch_bounds__(512, 2) fwd_kernel(Params prm) {
#ifdef EMU
    unsigned char* lds_raw = emu_lds();
#else
    extern __shared__ __attribute__((aligned(16))) unsigned char lds_raw[];
#endif
    Frame F;
    F.lds = (LAS unsigned char*)lds_raw;
    F.tid = threadIdx.x; F.lane = F.tid & 63; F.wave = RFL(F.tid >> 6); F.G = gridDim.x; F.bx = blockIdx.x;
    F.p = &prm; F.ws = prm.ws; F.ctl = (unsigned*)(prm.ws + OFF_CTL); F.H = (float*)(prm.ws + OFF_H); F.mod = (float*)(prm.ws + OFF_MOD);
    volatile LAS unsigned* misc = (volatile LAS unsigned*)(F.lds + LDS_MISC);
    if (F.tid < 64) misc[F.tid] = 0u;
    __syncthreads();
    XcdBarrier bar; bar.bar = F.ctl + CW_BAR; bar.x = 0; bar.st = misc;
    const int lo = prm.ph_lo, hi = prm.ph_hi;
    if (hi - lo > 1) bar = xcd_barrier_post(F.ctl + CW_BAR, misc);
    int ph = 0;
#ifndef SITE_MASK
#define SITE_MASK 0xFFFFFFFFu
#endif
#ifndef PROBE_REPEAT_SITE
#define PROBE_REPEAT_SITE (-1)
#endif
#define PH_REPS(site) ((PROBE_REPEAT_SITE == (site)) ? 2 : 1)
#define PHASE_BEGIN(site) if (((SITE_MASK >> (site)) & 1u) && lo <= ph && ph < hi) { { int _t = threadIdx.x; LAUNDER_V(_t); F.tid = _t; F.lane = _t & 63; int _b = blockIdx.x; LAUNDER_S(_b); F.bx = _b; int _g = gridDim.x; LAUNDER_S(_g); F.G = _g; \
      F.ws = WSP(F); F.ctl = (unsigned*)(F.ws + OFF_CTL); F.H = (float*)(F.ws + OFF_H); F.mod = (float*)(F.ws + OFF_MOD); } \
      for (int _rep = 0; _rep < PH_REPS(site); ++_rep) { if (_rep) __syncthreads();
#define PHASE_END   } if (ph + 1 < hi) xcd_barrier(bar); } ++ph;
#define B_W (F.ws + OFF_W)
#define B_ACT (F.ws + OFF_ACT)
#define B_P ((bf16_t*)(B_ACT + A_P))
#define B_HID ((bf16_t*)(B_ACT + A_HID))
#define B_U ((bf16_t*)(B_ACT + A_U))
#define B_Z ((bf16_t*)(B_ACT + A_Z))
#define B_XBC ((bf16_t*)(B_ACT + A_XBC))
#define B_DT ((float*)(B_W + W_DT))
#define B_XT ((bf16_t*)(B_ACT + A_XT))
#define B_BROW ((bf16_t*)(B_ACT + A_BROW))
#define B_BT ((bf16_t*)(B_ACT + A_BT))
#define B_CROW ((bf16_t*)(B_ACT + A_CROW))
#define B_CB ((bf16_t*)(B_ACT + A_CB))
#define B_CUM ((float*)(B_ACT + A_CUM))
#define B_WJ ((float*)(B_ACT + A_WJ))
#define B_YF ((bf16_t*)(B_ACT + A_YF))
#define B_YB ((bf16_t*)(B_W + W_YB))
#define B_YN ((bf16_t*)(B_ACT + A_YN))
#define B_V ((bf16_t*)(B_ACT + A_V))
#define B_HIDM ((bf16_t*)(B_ACT + A_HIDM))
#define B_YS ((bf16_t*)(B_ACT + A_YS))

    PHASE_BEGIN(0) phase_mod(F); convert_even(F, 0); PHASE_END

    for (int lp = 0; lp < 2; ++lp) {
        const int le = 2 * lp, lod = 2 * lp + 1;
        PHASE_BEGIN(1) phase_poolprep(F, le, B_P); PHASE_END
        PHASE_BEGIN(2) { PolPool S; S.G = F.G; S.c = F.bx; S.K = 256; S.lda = D; S.ldb = 256; S.P = B_P; S.W = (const bf16_t*)(B_W + W_POOL); S.src = mksrc(F); S.layer = le; S.scale = INP(F, I_POOLS) + (size_t)lp * D;
                      ge::gemm_phase(F.lds, S, F.tid); } PHASE_END
        PHASE_BEGIN(3) phase_norm(F, le, 3, B_P, false); PHASE_END
        PHASE_BEGIN(4) { PolUp<false> S; S.G = F.G; S.c = F.bx; S.K = D; S.lda = D; S.ldb = D; S.A = B_P; S.W = (const bf16_t*)(B_W + W_UP); S.HID = B_HID; S.ldh = DFF; S.nq = DFF / 128; S.nM = NPAN; S.s2t = nullptr;
                      ge::gemm_phase(F.lds, S, F.tid); } PHASE_END
        PHASE_BEGIN(5) { PolResid S; S.G = F.G; S.c = F.bx; S.K = DFF; S.lda = DFF; S.ldb = DFF; S.A = B_HID; S.W = (const bf16_t*)(B_W + W_DN); S.src = mksrc(F); S.layer = le; S.which = 5;
                      ge::gemm_phase(F.lds, S, F.tid); } PHASE_END
        PHASE_BEGIN(6) phase_norm(F, lod, 0, B_U, false); convert_ssd(F, lp); PHASE_END
        PHASE_BEGIN(7) { PolInProj S; S.G = F.G; S.c = F.bx; S.K = D; S.lda = D; S.ldb = D; S.A = B_U; S.W = (const bf16_t*)(B_W + W_IN); S.Z = B_Z; S.XBC = B_XBC; S.DT = B_DT;
                      ge::gemm_phase(F.lds, S, F.tid); } PHASE_END
        PHASE_BEGIN(8) phase_conv(F, lp, B_XBC, B_XT, B_BROW, B_BT, B_CROW); PHASE_END
        PHASE_BEGIN(9) phase_cb(F, B_BROW, B_CROW, B_CB); phase_tables(F, lp, B_DT, B_CUM, B_WJ); PHASE_END
        PHASE_BEGIN(10) phase_scan(F, lp, B_XT, B_BT, B_CROW, B_CB, B_DT, B_CUM, B_WJ, B_YF, B_YB); PHASE_END
        PHASE_BEGIN(11) phase_gate(F, lp, B_YF, B_YB, B_Z, B_YN); PHASE_END
        PHASE_BEGIN(12) { PolResid S; S.G = F.G; S.c = F.bx; S.K = DIN; S.lda = DIN; S.ldb = DIN; S.A = B_YN; S.W = (const bf16_t*)(B_W + W_OUT); S.src = mksrc(F); S.layer = lod; S.which = 2;
                      ge::gemm_phase(F.lds, S, F.tid); } PHASE_END
        PHASE_BEGIN(13) phase_route(F, lod, lp, B_V); convert_moe(F, lp); PHASE_END
        PHASE_BEGIN(14) phase_slots(F, lp); PHASE_END
        PHASE_BEGIN(15) { int ts[NEXP + 1]; unsigned cnt[NEXP]; tile_starts(F, lp, ts, cnt);
                      PolUp<true> S; S.G = F.G; S.c = F.bx; S.K = D; S.lda = D; S.ldb = D; S.A = B_V; S.W = (const bf16_t*)(B_W + W_MUP); S.HID = B_HIDM; S.ldh = DFFE; S.nq = DFFE / 128; S.nM = ts[NEXP];
                      S.s2t = (const int*)(F.ws + OFF_S2T);
#pragma unroll
                      for (int e = 0; e <= NEXP; ++e) S.tstart[e] = ts[e];
                      ge::gemm_phase(F.lds, S, F.tid); } PHASE_END
        PHASE_BEGIN(16) { int ts[NEXP + 1]; unsigned cnt[NEXP]; tile_starts(F, lp, ts, cnt);
                      PolMoeDown S; S.G = F.G; S.c = F.bx; S.K = DFFE; S.lda = DFFE; S.ldb = DFFE; S.A = B_HIDM; S.W = (const bf16_t*)(B_W + W_MDN); S.YS = B_YS; S.nM = ts[NEXP];
#pragma unroll
                      for (int e = 0; e <= NEXP; ++e) S.tstart[e] = ts[e];
                      ge::gemm_phase(F.lds, S, F.tid); } PHASE_END
        PHASE_BEGIN(17) phase_combine(F, lod, B_YS, lp == 1); if (lp == 0) convert_even(F, 1); PHASE_END
    }
#undef PHASE_BEGIN
#undef PHASE_END
}

extern "C" void kernel_launch(void* const* d_in, const int* in_sizes, int n_in, void* d_out, int out_size, void* d_ws, size_t ws_size, hipStream_t stream) {
    static int grid = 0;
    if (grid == 0) {
        if (n_in != 26 || ws_size < WS_NEED) { fprintf(stderr, "kernel_launch: need 26 inputs and %zu bytes of workspace (got %d, %zu)\n", (size_t)WS_NEED, n_in, ws_size); grid = -1; return; }
        int dev = 0, cus = 0, per_cu = 0;
        if (hipGetDevice(&dev) != hipSuccess || hipDeviceGetAttribute(&cus, hipDeviceAttributeMultiprocessorCount, dev) != hipSuccess) { grid = -1; return; }
        if (hipFuncSetAttribute((const void*)fwd_kernel, hipFuncAttributeMaxDynamicSharedMemorySize, LDS_BYTES) != hipSuccess) { grid = -1; return; }
        if (hipOccupancyMaxActiveBlocksPerMultiprocessor(&per_cu, (const void*)fwd_kernel, 512, LDS_BYTES) != hipSuccess || per_cu < 1) { fprintf(stderr, "kernel_launch: occupancy query says %d\n", per_cu); }
        (void)hipGetLastError();
        grid = cus;
    }
    if (grid < 0) return;
    (void)in_sizes; (void)out_size;
    if (hipMemsetAsync((char*)d_ws + OFF_CTL, 0, CTL_BYTES, stream) != hipSuccess) return;
    Params p{};
    for (int i = 0; i < 26; ++i) p.in[i] = (const float*)d_in[i];
    p.out = (float*)d_out; p.ws = (unsigned char*)d_ws;
    if (N_LAUNCH_MODE == 1) { p.ph_lo = 0; p.ph_hi = N_PHASES; hipLaunchKernelGGL(fwd_kernel, dim3(grid), dim3(512), LDS_BYTES, stream, p); }
    else for (int ph = 0; ph < N_PHASES; ++ph) { p.ph_lo = ph; p.ph_hi = ph + 1; hipLaunchKernelGGL(fwd_kernel, dim3(grid), dim3(512), LDS_BYTES, stream, p); }
}
```

```cpp
#ifndef EMU
#include <hip/hip_runtime.h>
#endif
#include <cstdio>
#include <cstdint>

#ifndef CFG_SEQ
#define CFG_SEQ 16384
#endif
#ifndef CFG_DFF
#define CFG_DFF 2816
#endif
#ifndef CFG_DFFE
#define CFG_DFFE 3584
#endif
#ifndef N_LAUNCH_MODE
#define N_LAUNCH_MODE 1
#endif

#ifdef EMU
#define LAS
#define DEV inline
#define WAITV(n) ((void)0)
#define WAITL(n) ((void)0)
#define SBAR() emu_wg_sync()
#define SCHED() ((void)0)
#define SETPRIO(x) ((void)0)
#define MFMA16(a, b, c) emu_mfma16(a, b, c)
#define GLDS16(g, l) emu_glds16((const void*)(g), (void*)(l))
#define GLDS4(g, l) emu_glds4((const void*)(g), (void*)(l))
#define RFL(x) emu_rfl(x)
#define MEMFENCE() ((void)0)
#define WSYNC() emu_wave_sync()
#define LDSBAR() emu_wg_sync()
#define LAUNDER_V(x) ((void)0)
#define SLEEP1() emu_yield()
#define MY_XCC_ID() ((unsigned)(blockIdx.x & 7u))
#define FENCE_REL() __atomic_thread_fence(__ATOMIC_SEQ_CST)
#define FENCE_ACQ() __atomic_thread_fence(__ATOMIC_SEQ_CST)
#define FEXP(x) expf(x)
#define RLX_AGENT __ATOMIC_RELAXED, 4
#else
#define LAS __attribute__((address_space(3)))
#define DEV __device__ __forceinline__
#define WAITV(n) asm volatile("s_waitcnt vmcnt(" #n ")" ::: "memory")
#define WAITL(n) asm volatile("s_waitcnt lgkmcnt(" #n ")" ::: "memory")
#define SBAR() __builtin_amdgcn_s_barrier()
#define SCHED() __builtin_amdgcn_sched_barrier(0)
#define SETPRIO(x) __builtin_amdgcn_s_setprio(x)
#define MFMA16(a, b, c) __builtin_amdgcn_mfma_f32_16x16x32_bf16(a, b, c, 0, 0, 0)
#define GLDS16(g, l) __builtin_amdgcn_global_load_lds((const unsigned*)(g), (LAS unsigned*)(l), 16, 0, 0)
#define GLDS4(g, l) __builtin_amdgcn_global_load_lds((const unsigned*)(g), (LAS unsigned*)(l), 4, 0, 0)
#define RFL(x) __builtin_amdgcn_readfirstlane(x)
#define MEMFENCE() asm volatile("" ::: "memory")
#define LDSBAR() do { asm volatile("s_waitcnt lgkmcnt(0)" ::: "memory"); __builtin_amdgcn_s_barrier(); asm volatile("" ::: "memory"); } while (0)
#define WSYNC() asm volatile("s_waitcnt lgkmcnt(0)" ::: "memory")
#define SLEEP1() __builtin_amdgcn_s_sleep(1)
#define MY_XCC_ID() ((unsigned)__builtin_amdgcn_s_getreg((3 << 11) | 20) & 0xFu)
#define FENCE_REL() __builtin_amdgcn_fence(__ATOMIC_RELEASE, "agent")
#define FENCE_ACQ() __builtin_amdgcn_fence(__ATOMIC_ACQUIRE, "agent")
#define FEXP(x) __expf(x)
#define RLX_AGENT __ATOMIC_RELAXED, __HIP_MEMORY_SCOPE_AGENT
#define LAUNDER_V(x) asm volatile("" : "+v"(x))
#endif

typedef unsigned short bf16_t;
typedef short bf16x8 __attribute__((ext_vector_type(8)));
typedef float f32x4 __attribute__((ext_vector_type(4)));
typedef float f32x2 __attribute__((ext_vector_type(2)));
typedef unsigned u32x4 __attribute__((ext_vector_type(4)));
typedef unsigned u32x2 __attribute__((ext_vector_type(2)));

constexpr int D = 1024, NB = 2, SEQ = CFG_SEQ, CTXL = 256, DEPTH = 4;
constexpr int ML = NB * SEQ, MC = NB * CTXL, MT = ML + MC, NPAN = MT / 256;
constexpr int DFF = CFG_DFF, DFFE = CFG_DFFE, NEXP = 8;
constexpr int DIN = 2048, NH = 32, HD = 64, NG = 4, DS = 128, CONVD = 3072, NPROJ = 5184, NPROJP = 5376, BCD = 512;
constexpr int TV = CTXL + SEQ, NCH = TV / 128;
constexpr int GRIDW = 64;
constexpr float EPS = 1e-6f;
constexpr int NSLOT_TILES = (2 * MT) / 256 + NEXP, NSLOT = NSLOT_TILES * 256;
static_assert(SEQ % 128 == 0 && ML % 256 == 0 && DFF % 128 == 0 && DFFE % 128 == 0 && DFF >= 256 && DFFE >= 256, "shape constraints");

constexpr size_t MiB = 1u << 20;
constexpr size_t al(size_t x) { return (x + 4095) & ~(size_t)4095; }
constexpr size_t OFF_CTL = 0, CTL_BYTES = 1 * MiB;
constexpr size_t OFF_MOD = 1 * MiB;
constexpr size_t OFF_TOK = 2 * MiB;
constexpr size_t OFF_S2T = 3 * MiB;
constexpr size_t OFF_H = 4 * MiB, SZ_H = (size_t)MT * D * 4;
constexpr size_t OFF_W = OFF_H + al(SZ_H);
constexpr size_t W_POOL = 0, SZ_WPOOL = (size_t)4 * 256 * 256 * 2;
constexpr size_t W_UP = al(SZ_WPOOL), SZ_WUP = (size_t)2 * DFF * D * 2;
constexpr size_t W_DN = W_UP + al(SZ_WUP), SZ_WDN = (size_t)D * DFF * 2;
constexpr size_t SZ_WEVEN = W_DN + al(SZ_WDN);
constexpr size_t W_IN = 0, SZ_WIN = (size_t)NPROJP * D * 2;
constexpr size_t W_OUT = al(SZ_WIN), SZ_WOUT = (size_t)D * DIN * 2;
constexpr size_t W_DT = W_OUT + al(SZ_WOUT), SZ_DT = (size_t)NB * 2 * NH * TV * 4;
constexpr size_t W_MUP = W_DT + al(SZ_DT), SZ_WMUP = (size_t)NEXP * 2 * DFFE * D * 2;
constexpr size_t W_MDN = W_MUP + al(SZ_WMUP), SZ_WMDN = (size_t)NEXP * D * DFFE * 2;
constexpr size_t W_YB = W_MUP, SZ_Y = (size_t)MT * DIN * 2;
constexpr size_t SZ_WODD_A = W_MDN + al(SZ_WMDN), SZ_WODD_B = W_YB + al(SZ_Y);
constexpr size_t mx(size_t a, size_t b) { return a > b ? a : b; }
constexpr size_t SZ_W = mx(SZ_WEVEN, mx(SZ_WODD_A, SZ_WODD_B));
constexpr size_t OFF_ACT = OFF_W + SZ_W;
constexpr size_t A_P = 0, SZ_ACT1 = (size_t)MT * D * 2;
constexpr size_t A_HID = al(SZ_ACT1), SZ_HID = (size_t)MT * DFF * 2;
constexpr size_t SZ_AEVEN = A_HID + al(SZ_HID);
constexpr size_t A_Z = 0;
constexpr size_t A_XBC = al(SZ_Y), SZ_XBC = (size_t)MT * CONVD * 2;
constexpr size_t A_YF = A_XBC;
constexpr size_t A_CB = A_XBC + al(SZ_Y), SZ_CB = (size_t)NB * NG * NCH * 128 * 128 * 2;
static_assert(al(SZ_Y) + SZ_CB <= SZ_XBC, "CB fits behind Yf inside the XBC region");
constexpr size_t A_XT = A_XBC + al(SZ_XBC), SZ_XT = (size_t)NB * DIN * TV * 2;
constexpr size_t A_U = A_XT, A_YN = A_XT;
constexpr size_t A_BROW = A_XT + al(SZ_XT), SZ_BC = (size_t)MT * BCD * 2;
constexpr size_t A_BT = A_BROW + al(SZ_BC);
constexpr size_t A_CROW = A_BT + al(SZ_BC);
constexpr size_t A_CUM = A_CROW + al(SZ_BC);
constexpr size_t A_WJ = A_CUM + al(SZ_DT);
constexpr size_t SZ_ASSD = A_WJ + al(SZ_DT);
constexpr size_t A_V = 0;
constexpr size_t A_HIDM = al(SZ_ACT1), SZ_HIDM = (size_t)NSLOT * DFFE * 2;
constexpr size_t A_YS = A_HIDM + al(SZ_HIDM), SZ_YS = (size_t)NSLOT * D * 2;
constexpr size_t SZ_AMOE = A_YS + al(SZ_YS);
constexpr size_t SZ_ACT = mx(SZ_AEVEN, mx(SZ_ASSD, SZ_AMOE));
constexpr size_t WS_NEED = OFF_ACT + SZ_ACT;

constexpr int CW_BAR = 4096;
constexpr int CW_CNT = 16384;
constexpr int CW_CUR = 16384 + 2 * 8 * 64;

DEV unsigned f2bf(float f) { unsigned u = __builtin_bit_cast(unsigned, f); return (u + 0x7fffu + ((u >> 16) & 1u)) >> 16; }
#ifndef EMU
typedef __bf16 bf16x2n __attribute__((ext_vector_type(2)));
#endif
DEV unsigned pk2(float lo, float hi) {
#ifdef EMU
    return f2bf(lo) | (f2bf(hi) << 16);
#else
    f32x2 v = {lo, hi}; bf16x2n b = __builtin_convertvector(v, bf16x2n); return __builtin_bit_cast(unsigned, b);
#endif
}
DEV float bf2f(unsigned b) { return __builtin_bit_cast(float, b << 16); }
DEV float bflo(unsigned w) { return __builtin_bit_cast(float, w << 16); }
DEV float bfhi(unsigned w) { return __builtin_bit_cast(float, w & 0xffff0000u); }
#ifdef EMU
DEV float frcp(float x) { return 1.0f / x; }
#else
DEV float frcp(float x) { return __builtin_amdgcn_rcpf(x); }
#endif
#ifdef EMU
DEV float fexp2(float x) { return exp2f(x); }
#else
DEV float fexp2(float x) { return __builtin_amdgcn_exp2f(x); }
#endif
DEV float siluf(float x) { return x * frcp(1.0f + FEXP(-x)); }
DEV float softplusf(float x) { return x > 20.f ? x : log1pf(expf(x)); }
DEV float wave_sum(float v) {
#pragma unroll
    for (int o = 1; o < 64; o <<= 1) v += __shfl_xor(v, o);
    return v;
}
DEV int vec_of(int r) { return r < ML ? (r / SEQ) : 2; }
DEV int row_of(int b, int tv) { return tv < CTXL ? ML + b * CTXL + tv : b * SEQ + (tv - CTXL); }

#define XB_TMO      128
#define XB_XCNT(j)  (256  + 64 * (j))
#define XB_XSUB(j)  (1280 + 64 * (j))
#define XB_XGEN(j)  (2304 + 64 * (j))
#define XB_TOP      3328
#define XB_TOPGEN   3392
#define XCD_BAR_WORDS 3456
#define XB_SPIN_CAP (1u << 22)
DEV unsigned xb_ld(unsigned* p)              { return __hip_atomic_load(p, RLX_AGENT); }
DEV unsigned xb_add(unsigned* p, unsigned v) { return __hip_atomic_fetch_add(p, v, RLX_AGENT); }
#define XB_SPIN(cond, bar) do { unsigned _sp = 0; while (cond) { SLEEP1(); \
    if ((++_sp & 255u) == 0u) { if (xb_ld(&(bar)[XB_TMO])) break; if (_sp > XB_SPIN_CAP) { atomicAdd(&(bar)[XB_TMO], 1u); break; } } } } while (0)
struct XcdBarrier { unsigned* bar; unsigned x; volatile LAS unsigned* st; };
DEV XcdBarrier xcd_barrier_post(unsigned* bar, volatile LAS unsigned* st) {
    XcdBarrier b; b.bar = bar; b.x = MY_XCC_ID(); b.st = st;
    if (threadIdx.x == 0) (void)xb_add(&bar[XB_XCNT(b.x)], 1u);
    return b;
}
DEV void xcd_barrier_complete(unsigned* bar, unsigned x, unsigned& nloc, unsigned& nx) {
    const unsigned G = gridDim.x;
    unsigned sum, cnt, mine, sp = 0u;
    for (;;) {
        sum = 0u; cnt = 0u; mine = 0u;
#pragma unroll
        for (unsigned j = 0; j < 16; ++j) { const unsigned c = xb_ld(&bar[XB_XCNT(j)]); sum += c; cnt += (c > 0u) ? 1u : 0u; mine = (j == x) ? c : mine; }
        if (sum == G) break;
        SLEEP1();
        if ((++sp & 255u) == 0u) { if (xb_ld(&bar[XB_TMO])) break; if (sp > XB_SPIN_CAP) { atomicAdd(&bar[XB_TMO], 1u); break; } }
    }
    nloc = mine > 0u ? mine : 1u; nx = cnt > 0u ? cnt : 1u;
}
DEV void xcd_barrier(const XcdBarrier& b) {
    WAITV(0);
    __syncthreads();
    if (threadIdx.x == 0) {
        unsigned* bar = b.bar;
#ifndef EMU
        __builtin_amdgcn_s_waitcnt(0);
#endif
        unsigned nloc = b.st[0], nx = b.st[1];
        if (nloc == 0u) { xcd_barrier_complete(bar, b.x, nloc, nx); b.st[0] = nloc; b.st[1] = nx; }
        const unsigned old = xb_add(&bar[XB_XSUB(b.x)], 1u);
        const unsigned gen = old / nloc;
        if (old + 1u == (gen + 1u) * nloc) {
            FENCE_REL();
            WAITV(0);
            const unsigned og = xb_add(&bar[XB_TOP], 1u);
            const unsigned tg = og / nx;
            if (og + 1u == (tg + 1u) * nx) xb_add(&bar[XB_TOPGEN], 1u);
            else XB_SPIN(xb_ld(&bar[XB_TOPGEN]) == tg, bar);
            FENCE_ACQ();
            xb_add(&bar[XB_XGEN(b.x)], 1u);
            WAITV(0);
        } else {
            XB_SPIN(xb_ld(&bar[XB_XGEN(b.x)]) == gen, bar);
            FENCE_ACQ();
            WAITV(0);
        }
    }
    __syncthreads();
}

namespace ge {
constexpr int BM = 256, BK = 64, HALF = 128, HTB = HALF * BK * 2, STAGE_BYTES = 8 * HTB, NXCD = 8, WGM = 8;
DEV int lds_byte(int r, int c) { const int st = (r >> 4) * 2 + (c >> 5), rr = r & 15, cc = c & 31, ob = rr * 64 + cc * 2; return st * 1024 + (ob ^ (((ob >> 9) & 1) << 5)); }
DEV void stage_rc(int b, int& R, int& C) { const int st = b / 1024, sb = b % 1024, swz = sb ^ (((sb >> 9) & 1) << 5); R = (st >> 1) * 16 + swz / 64; C = (st & 1) * 32 + (swz % 64) / 2; }
DEV int perm32(int rho) { const int n = rho >> 4, i = rho & 15; return 8 * (i >> 2) + 4 * n + (i & 3); }
struct Unit { int pm, pn; };
DEV bool static_next(int nM, int nN, int G, int c, int i, Unit& u) {
    const int nwg = nM * nN; const long L = (long)i * G + c; if (L >= nwg) return false;
    int wgid = (int)L; { const int q = nwg / NXCD, r = nwg % NXCD, xcd = wgid % NXCD, off = wgid / NXCD; wgid = (xcd < r ? xcd * (q + 1) : r * (q + 1) + (xcd - r) * q) + off; }
    const int nig = WGM * nN, gid = wgid / nig, fm = gid * WGM, gsz = (nM - fm) < WGM ? (nM - fm) : WGM;
    u.pm = fm + ((wgid % nig) % gsz); u.pn = (wgid % nig) / gsz; return true;
}
template <class P, bool SP2 = true>
DEV void gemm_phase(LAS unsigned char* lds, const P& S, const int tid) {
    const int wid = RFL(tid >> 6), lane = tid & 63, wr = wid >> 2, wc = wid & 3, fr = lane & 15, fq = lane >> 4;
    const int K = S.K, nt = K / BK;
    unsigned voffB[2]; int RA[2], CA2[2];
#pragma unroll
    for (int i = 0; i < 2; ++i) { int R, C; stage_rc(tid * 16 + i * 8192, R, C); const int Rb = P::PERM ? ((R & ~31) + perm32(R & 31)) : R;
        RA[i] = R; CA2[i] = C * 2; voffB[i] = (unsigned)(Rb * S.ldb + C) * 2u; }
    const size_t kstep = (size_t)(BK * 2);
    const size_t hstepB = (size_t)HALF * S.ldb * 2;
    const unsigned ldsw = (unsigned)wid * 1024u;
    const int aoff = lds_byte(wr * 64 + fr, fq * 8), boff = lds_byte(wc * 32 + fr, fq * 8);
#define GE_SA(b, h) (((b) * 2 + (h)) * HTB)
#define GE_SB(b, h) ((4 + (b) * 2 + (h)) * HTB)
#define GE_STAGEB(bufoff, gbase) do { _Pragma("unroll") for (int _i = 0; _i < 2; ++_i) \
        GLDS16((const char*)(gbase) + voffB[_i], lds + (bufoff) + ldsw + _i * 8192); } while (0)
#define GE_STAGEA(bufoff, gbase, h) do { _Pragma("unroll") for (int _i = 0; _i < 2; ++_i) \
        GLDS16((const char*)(gbase) + oA[h][_i], lds + (bufoff) + ldsw + _i * 8192); } while (0)
#define GE_LDA(dst, b, h) do { _Pragma("unroll") for (int m = 0; m < 4; ++m) _Pragma("unroll") for (int k = 0; k < 2; ++k) dst[m][k] = *(const LAS bf16x8*)(lds + GE_SA(b, h) + aoff + m * 2048 + k * 1024); } while (0)
#define GE_LDB(dst, b, h) do { _Pragma("unroll") for (int n = 0; n < 2; ++n) _Pragma("unroll") for (int k = 0; k < 2; ++k) dst[n][k] = *(const LAS bf16x8*)(lds + GE_SB(b, h) + boff + n * 2048 + k * 1024); } while (0)
#define GE_MMA(ai, bj, At, Bt) do { SETPRIO(1); _Pragma("unroll") for (int m = 0; m < 4; ++m) _Pragma("unroll") for (int n = 0; n < 2; ++n) _Pragma("unroll") for (int k = 0; k < 2; ++k) \
        acc[ai][bj][m][n] = MFMA16(Bt[n][k], At[m][k], acc[ai][bj][m][n]); SETPRIO(0); } while (0)
    Unit cur, nxt; int ui = 0;
    if (!S.next(0, cur)) return;
    f32x4 acc[2][2][4][2];
#pragma unroll
    for (int a = 0; a < 2; ++a)
#pragma unroll
        for (int b = 0; b < 2; ++b)
#pragma unroll
            for (int m = 0; m < 4; ++m)
#pragma unroll
                for (int n = 0; n < 2; ++n) acc[a][b][m][n] = (f32x4){0.f, 0.f, 0.f, 0.f};
    bf16x8 At[4][2], B0[2][2], B1[2][2];
    unsigned oA[2][2];
#pragma unroll
    for (int h = 0; h < 2; ++h)
#pragma unroll
        for (int i = 0; i < 2; ++i) {
            if constexpr (P::GATHER) oA[h][i] = (unsigned)S.gather_row(cur, h * HALF + RA[i]) * (unsigned)(S.lda * 2) + (unsigned)CA2[i];
            else oA[h][i] = (unsigned)((h * HALF + RA[i]) * S.lda) * 2u + (unsigned)CA2[i];
            }
    const char* cA = S.a_base(cur); const char* cB = S.b_base(cur);
    if constexpr (SP2) {
        GE_STAGEB(GE_SB(0, 0), cB); GE_STAGEB(GE_SB(0, 1), cB + hstepB); GE_STAGEA(GE_SA(0, 0), cA, 0); GE_STAGEA(GE_SA(0, 1), cA, 1);
        if (wr == 1) SBAR();
        WAITV(2); SBAR();
        GE_STAGEB(GE_SB(1, 0), cB + kstep); GE_STAGEA(GE_SA(1, 0), cA + kstep, 0); GE_STAGEB(GE_SB(1, 1), cB + hstepB + kstep);
        WAITV(6); SBAR();
    } else {
    GE_STAGEB(GE_SB(0, 0), cB); GE_STAGEA(GE_SA(0, 0), cA, 0); GE_STAGEB(GE_SB(0, 1), cB + hstepB); GE_STAGEA(GE_SA(0, 1), cA, 1);
    if (wr == 1) SBAR();
    WAITV(4); SBAR();
    GE_STAGEB(GE_SB(1, 0), cB + kstep); GE_STAGEA(GE_SA(1, 0), cA + kstep, 0); GE_STAGEB(GE_SB(1, 1), cB + hstepB + kstep);
    WAITV(6); SBAR();
    }
    for (;;) {
        const bool has_next = S.next(ui + 1, nxt);
        const char* nA = has_next ? S.a_base(nxt) : cA; const char* nB = has_next ? S.b_base(nxt) : cB;
        for (int t = 0; t < nt; t += 2) {
            const bool last = (t == nt - 2);
            const char* a1 = cA + (size_t)(t + 1) * kstep;
            const char* a2 = last ? nA : cA + (size_t)(t + 2) * kstep; const char* b2 = last ? nB : cB + (size_t)(t + 2) * kstep;
            const char* a3 = a2 + kstep; const char* b3 = b2 + kstep;
            if constexpr (SP2) {
            GE_LDB(B0, 0, 0); GE_LDB(B1, 0, 1); SCHED(); GE_LDA(At, 0, 0); GE_STAGEA(GE_SA(1, 1), a1, 1);
            WAITV(8); WAITL(0); SBAR(); GE_MMA(0, 0, At, B0); GE_MMA(0, 1, At, B1); SBAR(); SCHED();
            if constexpr (P::GATHER) { if (last && has_next) {
#pragma unroll
                for (int i = 0; i < 2; ++i) { int R2, C2; stage_rc(tid * 16 + i * 8192, R2, C2);
#pragma unroll
                    for (int h = 0; h < 2; ++h) oA[h][i] = (unsigned)S.gather_row(nxt, h * HALF + R2) * (unsigned)(S.lda * 2) + (unsigned)(C2 * 2); } } }
            GE_LDA(At, 0, 1); GE_STAGEB(GE_SB(0, 0), b2); GE_STAGEB(GE_SB(0, 1), b2 + hstepB); GE_STAGEA(GE_SA(0, 0), a2, 0);
            WAITV(8); WAITL(0); SBAR(); GE_MMA(1, 0, At, B0); GE_MMA(1, 1, At, B1); SBAR(); SCHED();
            GE_LDB(B0, 1, 0); GE_LDB(B1, 1, 1); SCHED(); GE_LDA(At, 1, 0); GE_STAGEA(GE_SA(0, 1), a2, 1);
            WAITV(8); WAITL(0); SBAR(); GE_MMA(0, 0, At, B0); GE_MMA(0, 1, At, B1); SBAR(); SCHED();
            GE_LDA(At, 1, 1); GE_STAGEB(GE_SB(1, 0), b3); GE_STAGEB(GE_SB(1, 1), b3 + hstepB); GE_STAGEA(GE_SA(1, 0), a3, 0);
            WAITV(8); WAITL(0); SBAR(); GE_MMA(1, 0, At, B0); GE_MMA(1, 1, At, B1); SBAR(); SCHED();
            } else {
            GE_LDB(B0, 0, 0); SCHED(); GE_LDA(At, 0, 0); GE_STAGEA(GE_SA(1, 1), a1, 1);
            WAITL(8); SBAR(); WAITL(0); GE_MMA(0, 0, At, B0); SBAR(); SCHED();
            if constexpr (P::GATHER) { if (last && has_next) {
#pragma unroll
                for (int i = 0; i < 2; ++i) { int R2, C2; stage_rc(tid * 16 + i * 8192, R2, C2);
#pragma unroll
                    for (int h = 0; h < 2; ++h) oA[h][i] = (unsigned)S.gather_row(nxt, h * HALF + R2) * (unsigned)(S.lda * 2) + (unsigned)(C2 * 2); } } }
            GE_LDB(B1, 0, 1); GE_STAGEB(GE_SB(0, 0), b2);
            SBAR(); WAITL(0); GE_MMA(0, 1, At, B1); SBAR();
            GE_LDA(At, 0, 1); GE_STAGEA(GE_SA(0, 0), a2, 0);
            SBAR(); WAITL(0); GE_MMA(1, 0, At, B0); SBAR(); SCHED();
            GE_STAGEB(GE_SB(0, 1), b2 + hstepB);
            WAITV(6); SBAR(); GE_MMA(1, 1, At, B1); SBAR();
            GE_LDB(B0, 1, 0); SCHED(); GE_LDA(At, 1, 0); GE_STAGEA(GE_SA(0, 1), a2, 1);
            WAITL(8); SBAR(); WAITL(0); GE_MMA(0, 0, At, B0); SBAR(); SCHED();
            GE_LDB(B1, 1, 1); GE_STAGEB(GE_SB(1, 0), b3);
            SBAR(); WAITL(0); GE_MMA(0, 1, At, B1); SBAR();
            GE_LDA(At, 1, 1); GE_STAGEA(GE_SA(1, 0), a3, 0);
            SBAR(); WAITL(0); GE_MMA(1, 0, At, B0); SBAR(); SCHED();
            GE_STAGEB(GE_SB(1, 1), b3 + hstepB);
            WAITV(6); SBAR(); GE_MMA(1, 1, At, B1); SBAR();
            }
        }
        if (wr == 0) SBAR();
        S.epi(acc, cur, wr, wc, fr, fq);
        if (!has_next) break;
#pragma unroll
        for (int a = 0; a < 2; ++a)
#pragma unroll
            for (int b = 0; b < 2; ++b)
#pragma unroll
                for (int m = 0; m < 4; ++m)
#pragma unroll
                    for (int n = 0; n < 2; ++n) acc[a][b][m][n] = (f32x4){0.f, 0.f, 0.f, 0.f};
        cur = nxt; cA = nA; cB = nB; ++ui;
        if (wr == 1) SBAR();
    }
    WAITV(0);
    SBAR();
#undef GE_SA
#undef GE_SB
#undef GE_STAGEA
#undef GE_STAGEB
#undef GE_LDA
#undef GE_LDB
#undef GE_MMA
}
}
using ge::Unit;

struct Params {
    const float* in[26];
    float* out; unsigned char* ws;
    int ph_lo, ph_hi;
};
enum { I_X = 0, I_C, I_CTX, I_CCTX, I_ADAW, I_ADAB, I_NMIX, I_NFFN, I_POOLW, I_POOLS, I_INW, I_CONVW, I_CONVB, I_ALOG, I_DTB, I_DSKIP, I_SNORM, I_OUTW,
       I_W1, I_W3, I_W2, I_RW, I_MW1, I_MW3, I_MW2, I_FNORM };

struct Frame {
    LAS unsigned char* lds;
    int tid, lane, wave, G, bx;
    const Params* p;
    unsigned char* ws;
    unsigned* ctl;
    float* H; float* mod;
};
#ifdef EMU
DEV const float* INP(const Frame& F, int i) { return F.p->in[i]; }
DEV float* OUTP(const Frame& F) { return F.p->out; }
DEV unsigned char* WSP(const Frame& F) { return F.p->ws; }
#define LAUNDER_S(x) ((void)0)
#else
typedef const float* cfptr_t;
DEV const float* INP(const Frame&, int i) { int k = i; asm volatile("" : "+s"(k)); return ((const __attribute__((address_space(4))) cfptr_t*)__builtin_amdgcn_kernarg_segment_ptr())[k]; }
DEV float* OUTP(const Frame& F) { return (float*)INP(F, 26); }
DEV unsigned char* WSP(const Frame& F) { return (unsigned char*)INP(F, 27); }
#define LAUNDER_S(x) asm volatile("" : "+s"(x))
#endif
constexpr int LDS_MISC = ge::STAGE_BYTES;
constexpr int LDS_BYTES = ge::STAGE_BYTES + 16384;

struct Src { const float* x; const float* ctx; float* H; const float* mod; };
DEV const float* modq(const float* mod, int layer, int vec, int which) { return mod + ((size_t)(layer * 3 + vec) * 6 + which) * D; }
DEV const float* modp(const Frame& F, int layer, int vec, int which) { return modq(F.mod, layer, vec, which); }
DEV const float* hsrc_row(const Src& s, bool from_input, int r) {
    if (from_input) return r < ML ? s.x + (size_t)r * D : s.ctx + (size_t)(r - ML) * D;
    return s.H + (size_t)r * D;
}
DEV Src mksrc(const Frame& F) { Src s; s.x = INP(F, I_X); s.ctx = INP(F, I_CTX); s.H = F.H; s.mod = F.mod; return s; }
DEV const float* hin_row(const Frame& F, int layer, int r) { return hsrc_row(mksrc(F), layer == 0, r); }

template <int K, int N, class RM>
DEV void transpose_item(const float* Wsrc, bf16_t* WT, int ldt, RM rowmap, LAS float* scr, int item, int lane) {
    constexpr int nblk = N / 32; const int kb = item / nblk, nb = item % nblk, k0 = 64 * kb, n0 = 32 * nb;
    float tmp[32];
#pragma unroll
    for (int i = 0; i < 32; ++i) { const int kk = 2 * i + (lane >> 5); tmp[i] = Wsrc[(size_t)(k0 + kk) * N + n0 + (lane & 31)]; }
#pragma unroll
    for (int i = 0; i < 32; ++i) { const int kk = 2 * i + (lane >> 5); scr[kk * 33 + (lane & 31)] = tmp[i]; }
    WSYNC();
    const int c = lane & 7; const int row0 = rowmap(n0);
#pragma unroll
    for (int j = 0; j < 4; ++j) { const int n = (lane >> 3) + 8 * j; const LAS float* s = scr + (8 * c) * 33 + n;
        u32x4 o; o.x = pk2(s[0 * 33], s[1 * 33]); o.y = pk2(s[2 * 33], s[3 * 33]); o.z = pk2(s[4 * 33], s[5 * 33]); o.w = pk2(s[6 * 33], s[7 * 33]);
        *(u32x4*)(WT + (size_t)(row0 + n) * ldt + k0 + 8 * c) = o; }
    WSYNC();
}
struct RmId { DEV int operator()(int n0) const { return n0; } };
struct RmIlv { int s; DEV int operator()(int n0) const { return (n0 >> 7) * 256 + s * 128 + (n0 & 127); } };
template <int K, int N, class RM>
DEV void convert_job(const Frame& F, const float* Wsrc, bf16_t* WT, int ldt, RM rm) {
    LAS float* scr = (LAS float*)(F.lds + F.wave * 16384);
    constexpr int items = (K / 64) * (N / 32); const int gw = F.bx * 8 + F.wave, NGW = F.G * 8;
    for (int it = gw; it < items; it += NGW) transpose_item<K, N>(Wsrc, WT, ldt, rm, scr, it, F.lane);
}
DEV void convert_even(const Frame& F, int j) {
    bf16_t* Wb = (bf16_t*)(F.ws + OFF_W);
    for (int g = 0; g < 4; ++g) convert_job<256, 256>(F, INP(F, I_POOLW) + ((size_t)j * 4 + g) * 65536, Wb + W_POOL / 2 + (size_t)g * 65536, 256, RmId{});
    convert_job<D, DFF>(F, INP(F, I_W1) + (size_t)j * D * DFF, Wb + W_UP / 2, D, RmIlv{0});
    convert_job<D, DFF>(F, INP(F, I_W3) + (size_t)j * D * DFF, Wb + W_UP / 2, D, RmIlv{1});
    convert_job<DFF, D>(F, INP(F, I_W2) + (size_t)j * DFF * D, Wb + W_DN / 2, DFF, RmId{});
}
DEV void convert_ssd(const Frame& F, int j) {
    bf16_t* Wb = (bf16_t*)(F.ws + OFF_W);
    convert_job<D, NPROJ>(F, INP(F, I_INW) + (size_t)j * D * NPROJ, Wb + W_IN / 2, D, RmId{});
    convert_job<DIN, D>(F, INP(F, I_OUTW) + (size_t)j * DIN * D, Wb + W_OUT / 2, DIN, RmId{});
    { u32x4* z = (u32x4*)(Wb + W_IN / 2 + (size_t)NPROJ * D); const int n16 = (NPROJP - NPROJ) * D * 2 / 16;
      unsigned zz = 0u; LAUNDER_V(zz);
      for (int i = F.bx * 512 + F.tid; i < n16; i += F.G * 512) z[i] = (u32x4){zz, zz, zz, zz}; }
}
DEV void convert_moe(const Frame& F, int j) {
    bf16_t* Wb = (bf16_t*)(F.ws + OFF_W);
    for (int e = 0; e < NEXP; ++e) {
        convert_job<D, DFFE>(F, INP(F, I_MW1) + ((size_t)j * NEXP + e) * D * DFFE, Wb + W_MUP / 2 + (size_t)e * 2 * DFFE * D, D, RmIlv{0});
        convert_job<D, DFFE>(F, INP(F, I_MW3) + ((size_t)j * NEXP + e) * D * DFFE, Wb + W_MUP / 2 + (size_t)e * 2 * DFFE * D, D, RmIlv{1});
        convert_job<DFFE, D>(F, INP(F, I_MW2) + ((size_t)j * NEXP + e) * DFFE * D, Wb + W_MDN / 2 + (size_t)e * D * DFFE, DFFE, RmId{});
    }
}

DEV void phase_mod(const Frame& F) {
    LAS float* red = (LAS float*)F.lds;
    const int nblk = DEPTH * 6144 / 64;
    const int col = F.tid & 63, ks = F.tid >> 6;
    for (int blk = F.bx; blk < nblk; blk += F.G) {
        const int layer = (blk * 64) / 6144, n = (blk * 64) % 6144 + col;
        const float* W = INP(F, I_ADAW) + (size_t)layer * D * 6144 + n;
        float a0 = 0.f, a1 = 0.f, a2 = 0.f;
#pragma unroll 8
        for (int k = ks * 128; k < ks * 128 + 128; ++k) { const float w = W[(size_t)k * 6144];
            a0 += siluf(INP(F, I_C)[k]) * w; a1 += siluf(INP(F, I_C)[D + k]) * w; a2 += siluf(INP(F, I_CCTX)[k]) * w; }
        red[(ks * 64 + col) * 3 + 0] = a0; red[(ks * 64 + col) * 3 + 1] = a1; red[(ks * 64 + col) * 3 + 2] = a2;
        __syncthreads();
        if (F.tid < 192) { const int c2 = F.tid % 64, v = F.tid / 64; float s = 0.f;
            for (int q = 0; q < 8; ++q) s += red[(q * 64 + c2) * 3 + v];
            const int n2 = (blk * 64) % 6144 + c2;
            F.mod[(size_t)(layer * 3 + v) * 6144 + n2] = s + INP(F, I_ADAB)[(size_t)layer * 6144 + n2]; }
        __syncthreads();
    }
}

DEV void load_row(const float* p, int lane, f32x4 (&v)[4]) {
#pragma unroll
    for (int j = 0; j < 4; ++j) v[j] = *(const f32x4*)(p + 4 * lane + 256 * j);
}
DEV float sumsq_row(const f32x4 (&v)[4]) { float s = 0.f;
#pragma unroll
    for (int j = 0; j < 4; ++j) s += (v[j][0] * v[j][0] + v[j][1] * v[j][1]) + (v[j][2] * v[j][2] + v[j][3] * v[j][3]);
    return wave_sum(s); }
DEV void normmod_row(f32x4 (&v)[4], float rstd, const float* w, const float* sh, const float* sc, int lane) {
#pragma unroll
    for (int j = 0; j < 4; ++j) { const int c = 4 * lane + 256 * j; const f32x4 wv = *(const f32x4*)(w + c), sv = *(const f32x4*)(sh + c), cv = *(const f32x4*)(sc + c);
        v[j] = v[j] * rstd * wv * (cv + 1.0f) + sv; }
}
DEV void store_row_bf16(bf16_t* o, int lane, const f32x4 (&v)[4]) {
#pragma unroll
    for (int j = 0; j < 4; ++j) { u32x2 w; w.x = pk2(v[j][0], v[j][1]); w.y = pk2(v[j][2], v[j][3]); *(u32x2*)(o + 4 * lane + 256 * j) = w; }
}

DEV void phase_norm(const Frame& F, int layer, int which, bf16_t* out, bool from_input) {
    const int gw = F.bx * 8 + F.wave, NGW = F.G * 8;
    const float* w = INP(F, which == 0 ? I_NMIX : I_NFFN) + (size_t)layer * D;
    for (int r = gw; r < MT; r += NGW) {
        f32x4 v[4]; load_row(hsrc_row(mksrc(F), from_input, r), F.lane, v);
        const float rstd = rsqrtf(sumsq_row(v) * (1.0f / D) + EPS);
        const int vec = vec_of(r);
        normmod_row(v, rstd, w, modp(F, layer, vec, which), modp(F, layer, vec, which + 1), F.lane);
        store_row_bf16(out + (size_t)r * D, F.lane, v);
    }
}

DEV void phase_poolprep(const Frame& F, int layer, bf16_t* P) {
    LAS float* rs = (LAS float*)(F.lds);
    const float* w = INP(F, I_NMIX) + (size_t)layer * D;
    const int ntile = MT / 64;
    for (int tile = F.bx; tile < ntile; tile += F.G) {
        const int r0 = tile * 64;
        int seq0, seq1;
        if (r0 < ML) { seq0 = r0; seq1 = r0 + 64; } else { seq0 = ML + ((r0 - ML) / CTXL) * CTXL; seq1 = seq0 + CTXL; }
        const int lo_r = (r0 - 8 > seq0) ? r0 - 8 : seq0, hi_r = (r0 + 64 + 7 < seq1) ? r0 + 64 + 7 : seq1;
        for (int r = lo_r + F.wave; r < hi_r; r += 8) { f32x4 v[4]; load_row(hin_row(F, layer, r), F.lane, v); const float ss = sumsq_row(v); if (F.lane == 0) rs[r - lo_r] = rsqrtf(ss * (1.0f / D) + EPS); }
        __syncthreads();
        const int vec = vec_of(r0);
        const int cq = F.tid & 255, half = F.tid >> 8, c = cq * 4, g = c >> 8, win = 2 << g, lo = win >> 1, hi = win - 1 - lo;
        const f32x4 wv = *(const f32x4*)(w + c), sv = *(const f32x4*)(modp(F, layer, vec, 0) + c), cv = *(const f32x4*)(modp(F, layer, vec, 1) + c) + 1.0f;
        const f32x4 wc = wv * cv;
        const int ta = r0 + 32 * half;
        auto uval = [&](int r) -> f32x4 { const f32x4 h = *(const f32x4*)(hin_row(F, layer, r) + c); return h * rs[r - lo_r] * wc + sv; };
        f32x4 s = (f32x4){0.f, 0.f, 0.f, 0.f};
        { const int a = (ta - lo > seq0) ? ta - lo : seq0, b = (ta + hi + 1 < seq1) ? ta + hi + 1 : seq1; for (int r = a; r < b; ++r) s += uval(r); }
        for (int t = ta; t < ta + 32; ++t) {
            const int a = (t - lo > seq0) ? t - lo : seq0, b = (t + hi + 1 < seq1) ? t + hi + 1 : seq1;
            const float inv = 1.0f / (float)(b - a);
            const f32x4 o = s * inv - uval(t);
            u32x2 pw; pw.x = pk2(o[0], o[1]); pw.y = pk2(o[2], o[3]); *(u32x2*)(P + (size_t)t * D + c) = pw;
            if (t + 1 < ta + 32) {
                if (t + 1 + hi < seq1) s += uval(t + 1 + hi);
                if (t - lo >= seq0) s -= uval(t - lo); }
        }
        __syncthreads();
    }
}

struct PolBase { int G, c; };
struct PolPool : PolBase {
    static constexpr bool PERM = false, GATHER = false; int K, lda, ldb;
    const bf16_t* P; const bf16_t* W; Src src; int layer; const float* scale;
    DEV bool next(int i, Unit& u) const { return ge::static_next(NPAN, 4, G, c, i, u); }
    DEV const char* a_base(const Unit& u) const { return (const char*)(P + (size_t)u.pm * 256 * D + u.pn * 256); }
    DEV const char* b_base(const Unit& u) const { return (const char*)(W + (size_t)u.pn * 65536); }
    DEV void epi(const f32x4 (&acc)[2][2][4][2], const Unit& u, int wr, int wc, int fr, int fq) const {
        const int row0 = u.pm * 256 + wr * 64 + fr, col0 = u.pn * 256 + wc * 32 + 4 * fq; const int vec = vec_of(u.pm * 256);
        const float* g1 = modq(src.mod, layer, vec, 2);
        f32x4 gv[2][2];
#pragma unroll
        for (int bj = 0; bj < 2; ++bj)
#pragma unroll
            for (int n = 0; n < 2; ++n) { const int cc = col0 + bj * 128 + n * 16; gv[bj][n] = *(const f32x4*)(g1 + cc) * *(const f32x4*)(scale + cc); }
#pragma unroll
        for (int ai = 0; ai < 2; ++ai)
#pragma unroll
            for (int m = 0; m < 4; ++m) { const int r = row0 + ai * 128 + m * 16; const float* hi = hsrc_row(src, layer == 0, r) + col0; float* ho = src.H + (size_t)r * D + col0;
#pragma unroll
                for (int bj = 0; bj < 2; ++bj)
#pragma unroll
                    for (int n = 0; n < 2; ++n) *(f32x4*)(ho + bj * 128 + n * 16) = *(const f32x4*)(hi + bj * 128 + n * 16) + gv[bj][n] * acc[ai][bj][m][n]; }
    }
};
struct PolResid : PolBase {
    static constexpr bool PERM = false, GATHER = false; int K, lda, ldb;
    const bf16_t* A; const bf16_t* W; Src src; int layer, which;
    DEV bool next(int i, Unit& u) const { return ge::static_next(NPAN, 4, G, c, i, u); }
    DEV const char* a_base(const Unit& u) const { return (const char*)(A + (size_t)u.pm * 256 * lda); }
    DEV const char* b_base(const Unit& u) const { return (const char*)(W + (size_t)u.pn * 256 * ldb); }
    DEV void epi(const f32x4 (&acc)[2][2][4][2], const Unit& u, int wr, int wc, int fr, int fq) const {
        const int row0 = u.pm * 256 + wr * 64 + fr, col0 = u.pn * 256 + wc * 32 + 4 * fq; const int vec = vec_of(u.pm * 256);
        const float* gp = modq(src.mod, layer, vec, which);
        f32x4 gv[2][2];
#pragma unroll
        for (int bj = 0; bj < 2; ++bj)
#pragma unroll
            for (int n = 0; n < 2; ++n) gv[bj][n] = *(const f32x4*)(gp + col0 + bj * 128 + n * 16);
#pragma unroll
        for (int ai = 0; ai < 2; ++ai)
#pragma unroll
            for (int m = 0; m < 4; ++m) { float* ho = src.H + (size_t)(row0 + ai * 128 + m * 16) * D + col0;
#pragma unroll
                for (int bj = 0; bj < 2; ++bj)
#pragma unroll
                    for (int n = 0; n < 2; ++n) { f32x4* q = (f32x4*)(ho + bj * 128 + n * 16); *q = *q + gv[bj][n] * acc[ai][bj][m][n]; } }
    }
};
template <bool MOE>
struct PolUp : PolBase {
    static constexpr bool PERM = true, GATHER = MOE; int K, lda, ldb;
    const bf16_t* A; const bf16_t* W; bf16_t* HID; int ldh, nq;
    int nM; const int* s2t; int tstart[NEXP + 1];
    DEV bool next(int i, Unit& u) const { return ge::static_next(MOE ? nM : NPAN, nq, G, c, i, u); }
    DEV int expert_of(int pm) const { int e = 0;
#pragma unroll
        for (int k = 1; k < NEXP; ++k) e += (pm >= tstart[k]) ? 1 : 0;
        return e; }
    DEV const char* a_base(const Unit& u) const { return MOE ? (const char*)A : (const char*)(A + (size_t)u.pm * 256 * lda); }
    DEV const char* b_base(const Unit& u) const { size_t off = (size_t)u.pn * 256 * ldb; if (MOE) off += (size_t)expert_of(u.pm) * 2 * DFFE * ldb; return (const char*)(W + off); }
    DEV int gather_row(const Unit& u, int R) const { return s2t[u.pm * 256 + R]; }
    DEV void epi(const f32x4 (&acc)[2][2][4][2], const Unit& u, int wr, int wc, int fr, int fq) const {
        const int row0 = u.pm * 256 + wr * 64 + fr, col0 = u.pn * 128 + wc * 32 + 8 * fq;
#pragma unroll
        for (int ai = 0; ai < 2; ++ai)
#pragma unroll
            for (int m = 0; m < 4; ++m) { bf16_t* o = HID + (size_t)(row0 + ai * 128 + m * 16) * ldh + col0;
                float h[8];
#pragma unroll
                for (int n = 0; n < 2; ++n)
#pragma unroll
                    for (int i = 0; i < 4; ++i) h[4 * n + i] = siluf(acc[ai][0][m][n][i]) * acc[ai][1][m][n][i];
                u32x4 w; w.x = pk2(h[0], h[1]); w.y = pk2(h[2], h[3]); w.z = pk2(h[4], h[5]); w.w = pk2(h[6], h[7]);
                *(u32x4*)o = w; }
    }
};
struct PolMoeDown : PolBase {
    static constexpr bool PERM = true, GATHER = false; int K, lda, ldb;
    const bf16_t* A; const bf16_t* W; bf16_t* YS; int nM; int tstart[NEXP + 1];
    DEV bool next(int i, Unit& u) const { return ge::static_next(nM, 4, G, c, i, u); }
    DEV int expert_of(int pm) const { int e = 0;
#pragma unroll
        for (int k = 1; k < NEXP; ++k) e += (pm >= tstart[k]) ? 1 : 0;
        return e; }
    DEV const char* a_base(const Unit& u) const { return (const char*)(A + (size_t)u.pm * 256 * lda); }
    DEV const char* b_base(const Unit& u) const { return (const char*)(W + ((size_t)expert_of(u.pm) * D + (size_t)u.pn * 256) * ldb); }
    DEV void epi(const f32x4 (&acc)[2][2][4][2], const Unit& u, int wr, int wc, int fr, int fq) const {
        const int row0 = u.pm * 256 + wr * 64 + fr, col0 = u.pn * 256 + wc * 32 + 8 * fq;
#pragma unroll
        for (int ai = 0; ai < 2; ++ai)
#pragma unroll
            for (int m = 0; m < 4; ++m) { bf16_t* o = YS + (size_t)(row0 + ai * 128 + m * 16) * D + col0;
#pragma unroll
                for (int bj = 0; bj < 2; ++bj) { u32x4 w; w.x = pk2(acc[ai][bj][m][0][0], acc[ai][bj][m][0][1]); w.y = pk2(acc[ai][bj][m][0][2], acc[ai][bj][m][0][3]);
                    w.z = pk2(acc[ai][bj][m][1][0], acc[ai][bj][m][1][1]); w.w = pk2(acc[ai][bj][m][1][2], acc[ai][bj][m][1][3]); *(u32x4*)(o + bj * 128) = w; } }
    }
};
struct PolInProj : PolBase {
    static constexpr bool PERM = true, GATHER = false; int K, lda, ldb;
    const bf16_t* A; const bf16_t* W; bf16_t* Z; bf16_t* XBC; float* DT;
    DEV bool next(int i, Unit& u) const { return ge::static_next(NPAN, NPROJP / 256, G, c, i, u); }
    DEV const char* a_base(const Unit& u) const { return (const char*)(A + (size_t)u.pm * 256 * lda); }
    DEV const char* b_base(const Unit& u) const { return (const char*)(W + (size_t)u.pn * 256 * ldb); }
    DEV void epi(const f32x4 (&acc)[2][2][4][2], const Unit& u, int wr, int wc, int fr, int fq) const {
        const int row0 = u.pm * 256 + wr * 64 + fr, cw = wc * 32 + 8 * fq;
        if (u.pn < 20) {
            bf16_t* base; int ld, col0;
            if (u.pn < 8) { base = Z; ld = DIN; col0 = u.pn * 256 + cw; } else { base = XBC; ld = CONVD; col0 = (u.pn - 8) * 256 + cw; }
#pragma unroll
            for (int ai = 0; ai < 2; ++ai)
#pragma unroll
                for (int m = 0; m < 4; ++m) { bf16_t* o = base + (size_t)(row0 + ai * 128 + m * 16) * ld + col0;
#pragma unroll
                    for (int bj = 0; bj < 2; ++bj) { u32x4 w; w.x = pk2(acc[ai][bj][m][0][0], acc[ai][bj][m][0][1]); w.y = pk2(acc[ai][bj][m][0][2], acc[ai][bj][m][0][3]);
                        w.z = pk2(acc[ai][bj][m][1][0], acc[ai][bj][m][1][1]); w.w = pk2(acc[ai][bj][m][1][2], acc[ai][bj][m][1][3]); *(u32x4*)(o + bj * 128) = w; } }
        } else if (cw < 64) {
#pragma unroll
            for (int ai = 0; ai < 2; ++ai)
#pragma unroll
                for (int m = 0; m < 4; ++m) { const int r = row0 + ai * 128 + m * 16; int b, tv;
                    if (r < ML) { b = r / SEQ; tv = CTXL + r % SEQ; } else { b = (r - ML) / CTXL; tv = (r - ML) % CTXL; }
#pragma unroll
                    for (int n = 0; n < 2; ++n)
#pragma unroll
                        for (int i = 0; i < 4; ++i) { const int j = cw + 4 * n + i, dir = j >> 5, h = j & 31;
                            DT[((size_t)(b * 2 + dir) * NH + h) * TV + tv] = acc[ai][0][m][n][i]; } }
        }
    }
};

DEV void phase_conv(const Frame& F, int j, const bf16_t* XBC, bf16_t* XT, bf16_t* Brow, bf16_t* BT, bf16_t* Crow) {
    LAS bf16_t* tl0 = (LAS bf16_t*)F.lds;
    const float* cw = INP(F, I_CONVW) + (size_t)j * 4 * CONVD; const float* cb = INP(F, I_CONVB) + (size_t)j * CONVD;
    constexpr int NPER = NB * NCH, nitem = NPER * (CONVD / 64);
    const int t2 = 2 * (F.tid >> 3), cg = F.tid & 7;
    const int i0 = (int)(((long)F.bx * nitem) / F.G), i1 = (int)(((long)(F.bx + 1) * nitem) / F.G);
    int cblk_cur = -1; f32x4 wv[4][2], bv[2]; int par = 0;
    for (int it = i0; it < i1; ++it) {
        const int cblk = it / NPER, rest = it % NPER, b = rest / NCH, cv = rest % NCH;
        const int ch0 = cblk * 64 + cg * 8;
        if (cblk != cblk_cur) { cblk_cur = cblk;
#pragma unroll
            for (int k = 0; k < 4; ++k) { wv[k][0] = *(const f32x4*)(cw + k * CONVD + ch0); wv[k][1] = *(const f32x4*)(cw + k * CONVD + ch0 + 4); }
            bv[0] = *(const f32x4*)(cb + ch0); bv[1] = *(const f32x4*)(cb + ch0 + 4); }
        const int tv = cv * 128 + t2;
        const int seg0 = tv < CTXL ? 0 : CTXL, seg1 = tv < CTXL ? CTXL : TV;
        float xin[5][8];
#pragma unroll
        for (int k = 0; k < 5; ++k) { const int tk = tv - 2 + k; u32x4 q = (u32x4){0u, 0u, 0u, 0u};
            if (tk >= seg0 && tk < seg1) q = *(const u32x4*)(XBC + (size_t)row_of(b, tk) * CONVD + ch0);
            xin[k][0] = bflo(q.x); xin[k][1] = bfhi(q.x); xin[k][2] = bflo(q.y); xin[k][3] = bfhi(q.y); xin[k][4] = bflo(q.z); xin[k][5] = bfhi(q.z); xin[k][6] = bflo(q.w); xin[k][7] = bfhi(q.w); }
        unsigned pk[2][4];
#pragma unroll
        for (int o = 0; o < 2; ++o) { float a[8];
#pragma unroll
            for (int i = 0; i < 8; ++i) { float acc = bv[i >> 2][i & 3];
#pragma unroll
                for (int k = 0; k < 4; ++k) acc += wv[k][i >> 2][i & 3] * xin[o + k][i];
                a[i] = siluf(acc); }
#pragma unroll
            for (int i = 0; i < 4; ++i) pk[o][i] = pk2(a[2 * i], a[2 * i + 1]); }
        const int r = row_of(b, tv);
        const bool isx = cblk < DIN / 64, isb = !isx && cblk < (DIN + BCD) / 64;
        if (!isx) { bf16_t* o = (isb ? Brow + (ch0 - DIN) : Crow + (ch0 - DIN - BCD)) + (size_t)r * BCD;
            *(u32x4*)o = (u32x4){pk[0][0], pk[0][1], pk[0][2], pk[0][3]}; *(u32x4*)(o + BCD) = (u32x4){pk[1][0], pk[1][1], pk[1][2], pk[1][3]}; }
        if (isx || isb) {
            LAS bf16_t* tl = tl0 + par * (64 * 136); par ^= 1;
#pragma unroll
            for (int i = 0; i < 4; ++i) { const unsigned lo = (pk[0][i] & 0xffffu) | (pk[1][i] << 16), hi = (pk[0][i] >> 16) | (pk[1][i] & 0xffff0000u);
                *(LAS unsigned*)(tl + (cg * 8 + 2 * i) * 136 + t2) = lo; *(LAS unsigned*)(tl + (cg * 8 + 2 * i + 1) * 136 + t2) = hi; }
            __syncthreads();
            bf16_t* dst = isx ? XT + ((size_t)b * DIN + cblk * 64) * TV : BT + ((size_t)b * BCD + (cblk * 64 - DIN)) * TV;
#pragma unroll
            for (int q = 0; q < 2; ++q) { const int idx = F.tid + q * 512, ch = idx >> 4, t8 = (idx & 15) * 8;
                *(u32x4*)(dst + (size_t)ch * TV + cv * 128 + t8) = *(const LAS u32x4*)(tl + ch * 136 + t8); }
        }
    }
}

DEV void phase_cb(const Frame& F, const bf16_t* Brow, const bf16_t* Crow, bf16_t* CB) {
    const int nitem = NB * NG * NCH; const int fr = F.lane & 15, fq = F.lane >> 4;
    for (int it = F.bx; it < nitem; it += F.G) {
        const int cv = it % NCH, g = (it / NCH) % NG, b = it / (NCH * NG);
        const int rbase = row_of(b, cv * 128);
        bf16x8 cf[4];
#pragma unroll
        for (int ks = 0; ks < 4; ++ks) cf[ks] = *(const bf16x8*)(Crow + (size_t)(rbase + 16 * F.wave + fr) * BCD + g * 128 + 32 * ks + 8 * fq);
        bf16_t* out = CB + ((size_t)((b * NG + g) * NCH + cv)) * 16384;
#pragma unroll
        for (int nt = 0; nt < 8; ++nt) {
            f32x4 acc = (f32x4){0.f, 0.f, 0.f, 0.f};
#pragma unroll
            for (int ks = 0; ks < 4; ++ks) { const bf16x8 bfr = *(const bf16x8*)(Brow + (size_t)(rbase + 16 * nt + fr) * BCD + g * 128 + 32 * ks + 8 * fq); acc = MFMA16(bfr, cf[ks], acc); }
            u32x2 w; w.x = pk2(acc[0], acc[1]); w.y = pk2(acc[2], acc[3]);
            *(u32x2*)(out + (size_t)(16 * F.wave + fr) * 128 + 16 * nt + 4 * fq) = w;
        }
    }
}

DEV void phase_tables(const Frame& F, int j, float* DT, float* CUM, float* WJ) {
    const int nitem = NB * 2 * NH * NCH; const int gw = F.bx * 8 + F.wave, NGW = F.G * 8;
    for (int it = gw; it < nitem; it += NGW) {
        const int cv = it % NCH, h = (it / NCH) % NH, dir = (it / (NCH * NH)) & 1, b = it / (NCH * NH * 2);
        const float A = -expf(INP(F, I_ALOG)[(size_t)(j * 2 + dir) * NH + h]); const float bias = INP(F, I_DTB)[(size_t)(j * 2 + dir) * NH + h];
        const size_t o = ((size_t)(b * 2 + dir) * NH + h) * TV + cv * 128 + 2 * F.lane;
        const f32x2 raw = *(const f32x2*)(DT + o); const float d0 = softplusf(raw.x + bias), d1 = softplusf(raw.y + bias); const float a0 = d0 * A, a1 = d1 * A;
        float c0, c1, tot, sum = a0 + a1;
        if (dir == 0) {
#pragma unroll
            for (int q = 1; q < 64; q <<= 1) { const float t2 = __shfl_up(sum, q); if (F.lane >= q) sum += t2; }
            c1 = sum; c0 = sum - a1; tot = __shfl(sum, 63);
        } else {
#pragma unroll
            for (int q = 1; q < 64; q <<= 1) { const float t2 = __shfl_down(sum, q); if (F.lane + q < 64) sum += t2; }
            c0 = sum; c1 = sum - a0; tot = __shfl(sum, 0);
        }
        constexpr float L2E = 1.4426950408889634f;
        *(f32x2*)(DT + o) = (f32x2){c0 * L2E - log2f(d0), c1 * L2E - log2f(d1)};
        *(f32x2*)(CUM + o) = (f32x2){c0 * L2E, c1 * L2E};
        *(f32x2*)(WJ + o) = (f32x2){d0 * FEXP(tot - c0), d1 * FEXP(tot - c1)};
    }
}

constexpr int SC_HL = 0, SC_TAB = 17408, SC_CB = 20480, SC_BT = SC_CB + 32768, SC_C = SC_BT + 32768, SC_X = SC_C + 32768, SC_END = SC_X + 8192;
static_assert(SC_END <= ge::STAGE_BYTES, "scan LDS map");
DEV void phase_scan(const Frame& F, int j, const bf16_t* XT, const bf16_t* BT, const bf16_t* Crow, const bf16_t* CB, const float* DT, const float* CUM, const float* WJ, bf16_t* Yf, bf16_t* Yb) {
    LAS unsigned char* L = F.lds;
    LAS bf16_t* Hl = (LAS bf16_t*)(L + SC_HL);
    LAS float* tab = (LAS float*)(L + SC_TAB);
    const int fr = F.lane & 15, fq = F.lane >> 4, w = F.wave;
    const int nitem = NB * NH * 2 * 2;
    for (int it = F.bx; it < nitem; it += F.G) {
        const int xq = it & 7, kq = it >> 3; const int b = xq >> 2, g = xq & 3, h = 8 * g + (kq >> 2), dir = (kq >> 1) & 1, ph = kq & 1;
        const float Dsk = dir == 0 ? INP(F, I_DSKIP)[(size_t)j * NH + h] : 0.f;
        const size_t tbase = ((size_t)(b * 2 + dir) * NH + h) * TV;
        const bf16_t* xt = XT + ((size_t)b * DIN + h * HD + ph * 32) * TV;
        const bf16_t* bt = BT + ((size_t)b * BCD + g * 128) * TV;
        const bf16_t* CBh = CB + (size_t)((b * NG + g) * NCH) * 16384;
        const bf16_t* Cg = Crow + g * 128;
        bf16_t* Y = (dir ? Yb : Yf) + h * HD + ph * 32;
        const int lrow = 16 * w + fr;
        const int dr = F.lane >> 4, dc = F.lane & 15;
        f32x4 accH[2]; accH[0] = (f32x4){0.f, 0.f, 0.f, 0.f}; accH[1] = accH[0];
        for (int i = F.tid; i < 32 * 136 / 2; i += 512) ((LAS unsigned*)Hl)[i] = 0u;
#define SC_CHUNK_OF(step) (dir == 0 ? (step) : ((step) < 2 ? 1 - (step) : (NCH - 1) - ((step) - 2)))
        const int rsw = (4 * (w & 3) + dr) & 15, gc = dc ^ rsw;
        const unsigned loCB = (unsigned)(dr * 128 + 8 * gc) * 2u, loT = (unsigned)(dr * TV + 8 * gc) * 2u, loC = (unsigned)(dr * BCD + 8 * gc) * 2u;
#define SC_ISSUE_TILES(cvx_) do { const int cvx = (cvx_); const unsigned tvx = cvx * 128u; const unsigned rbx = (unsigned)row_of(b, cvx * 128); \
            _Pragma("unroll") for (int jj = 0; jj < 13; ++jj) { const int q = 8 * jj + w, r0 = 4 * (q & 31);   \
                const char* src; int toff; \
                if (jj < 4) { src = (const char*)(CBh + ((size_t)cvx * 16384u + (unsigned)r0 * 128u)) + loCB; toff = SC_CB; } \
                else if (jj < 8) { src = (const char*)(bt + ((size_t)r0 * TV + tvx)) + loT; toff = SC_BT; } \
                else if (jj < 12) { src = (const char*)(Cg + (size_t)(rbx + r0) * BCD) + loC; toff = SC_C; } \
                else { src = (const char*)(xt + ((size_t)r0 * TV + tvx)) + loT; toff = SC_X; } \
                GLDS16(src, L + toff + (q & 31) * 1024); } } while (0)
        const int kd = w >> 1; float km[8], dk[8];
#pragma unroll
        for (int i = 0; i < 8; ++i) { const int sidx = 32 * kd + 8 * fq + i; km[i] = (dir == 0 ? (sidx <= lrow) : (sidx >= lrow)) ? 1.f : 0.f; dk[i] = (sidx == lrow) ? Dsk : 0.f; }
#define SC_ISSUE_TAB(cvx_, tbuf_) do { if (w < 6) { const int tsel = w >> 1, half = w & 1; const float* tsrc = tsel == 0 ? CUM : (tsel == 1 ? DT : WJ); \
            GLDS4(tsrc + tbase + (cvx_) * 128 + half * 64 + F.lane, (LAS unsigned char*)(tab + (tbuf_) * 384 + tsel * 128 + half * 64)); } } while (0)
        { const int cv0 = SC_CHUNK_OF(0); SC_ISSUE_TILES(cv0); SC_ISSUE_TAB(cv0, 0); }
        for (int step = 0; step < NCH; ++step) {
            const int cv = SC_CHUNK_OF(step), buf = step & 1; const bool more = step + 1 < NCH;
            const int cvn = more ? SC_CHUNK_OF(step + 1) : cv;
            const unsigned rbase = (unsigned)row_of(b, cv * 128);
            if (step == 0) WAITV(0); else WAITV(2);
            LDSBAR();
            u32x4 rcb[4], rbt[4]; bf16x8 xf[2][4], cf[4];
#pragma unroll
            for (int ks = 0; ks < 4; ++ks) { const int fo = lrow * 256 + (((4 * ks + fq) ^ fr) << 4);
                rcb[ks] = *(const LAS u32x4*)(L + SC_CB + fo); rbt[ks] = *(const LAS u32x4*)(L + SC_BT + fo); cf[ks] = *(const LAS bf16x8*)(L + SC_C + fo);
#pragma unroll
                for (int nt = 0; nt < 2; ++nt) xf[nt][ks] = *(const LAS bf16x8*)(L + SC_X + (16 * nt + fr) * 256 + (((4 * ks + fq) ^ fr) << 4)); }
            LDSBAR();
            if (more) { SC_ISSUE_TILES(cvn); SC_ISSUE_TAB(cvn, buf ^ 1); }
            const LAS float* tb = tab + buf * 384;
            const float cl2 = tb[lrow]; const float ecum_l = fexp2(cl2);
            const float chunk_decay = fexp2(dir == 0 ? tb[127] : tb[0]);
            bf16x8 mf[4], bw[4];
#pragma unroll
            for (int ks = 0; ks < 4; ++ks) { const int s0 = 32 * ks + 8 * fq;
                const bool none = dir == 0 ? (ks > kd) : (ks < kd), diag = (ks == kd);
                unsigned om[4] = {0u, 0u, 0u, 0u};
                if (!none) {
                    const f32x4 cs0 = *(const LAS f32x4*)(tb + 128 + s0), cs1 = *(const LAS f32x4*)(tb + 128 + s0 + 4);
                    const float cs[8] = {cs0[0], cs0[1], cs0[2], cs0[3], cs1[0], cs1[1], cs1[2], cs1[3]};
                    const unsigned qc[4] = {rcb[ks].x, rcb[ks].y, rcb[ks].z, rcb[ks].w};
                    float v[8];
                    if (!diag) {
#pragma unroll
                        for (int i = 0; i < 8; ++i) { const float cbv = (i & 1) ? bfhi(qc[i >> 1]) : bflo(qc[i >> 1]); v[i] = cbv * fexp2(cl2 - cs[i]); }
                    } else {
#pragma unroll
                        for (int i = 0; i < 8; ++i) { const float cbv = (i & 1) ? bfhi(qc[i >> 1]) : bflo(qc[i >> 1]); const float x = cl2 - cs[i]; v[i] = (cbv * fexp2(x < 60.f ? x : 60.f)) * km[i] + dk[i]; }
                    }
#pragma unroll
                    for (int i = 0; i < 4; ++i) om[i] = pk2(v[2 * i], v[2 * i + 1]);
                }
                mf[ks] = __builtin_bit_cast(bf16x8, (u32x4){om[0], om[1], om[2], om[3]});
                { const f32x4 ws0 = *(const LAS f32x4*)(tb + 256 + s0), ws1 = *(const LAS f32x4*)(tb + 256 + s0 + 4); const float wsv[8] = {ws0[0], ws0[1], ws0[2], ws0[3], ws1[0], ws1[1], ws1[2], ws1[3]};
                  const unsigned qb[4] = {rbt[ks].x, rbt[ks].y, rbt[ks].z, rbt[ks].w}; unsigned ob[4];
#pragma unroll
                  for (int i = 0; i < 4; ++i) ob[i] = pk2(bflo(qb[i]) * wsv[2 * i], bfhi(qb[i]) * wsv[2 * i + 1]);
                  bw[ks] = __builtin_bit_cast(bf16x8, (u32x4){ob[0], ob[1], ob[2], ob[3]}); } }
            f32x4 yd[2], yo[2];
#pragma unroll
            for (int nt = 0; nt < 2; ++nt) { yd[nt] = (f32x4){0.f, 0.f, 0.f, 0.f}; yo[nt] = yd[nt]; accH[nt] = accH[nt] * chunk_decay; }
#pragma unroll
            for (int nt = 0; nt < 2; ++nt)
#pragma unroll
                for (int ks = 0; ks < 4; ++ks) {
                    yd[nt] = MFMA16(xf[nt][ks], mf[ks], yd[nt]);
                    const bf16x8 hf = *(const LAS bf16x8*)(Hl + buf * (32 * 136) + (16 * nt + fr) * 136 + 32 * ks + 8 * fq);
                    yo[nt] = MFMA16(hf, cf[ks], yo[nt]);
                    accH[nt] = MFMA16(bw[ks], xf[nt][ks], accH[nt]); }
#pragma unroll
            for (int nt = 0; nt < 2; ++nt) { u32x2 hw; hw.x = pk2(accH[nt][0], accH[nt][1]); hw.y = pk2(accH[nt][2], accH[nt][3]);
                *(LAS u32x2*)(Hl + (buf ^ 1) * (32 * 136) + (16 * nt + fr) * 136 + 16 * w + 4 * fq) = hw; }
#pragma unroll
            for (int nt = 0; nt < 2; ++nt) { u32x2 yw; yw.x = pk2(yd[nt][0] + ecum_l * yo[nt][0], yd[nt][1] + ecum_l * yo[nt][1]); yw.y = pk2(yd[nt][2] + ecum_l * yo[nt][2], yd[nt][3] + ecum_l * yo[nt][3]);
                *(u32x2*)(Y + ((size_t)(rbase + lrow) * DIN + 16 * nt + 4 * fq)) = yw; }
        }
        WAITV(0); LDSBAR();
    }
}

DEV void phase_gate(const Frame& F, int j, const bf16_t* Yf, const bf16_t* Yb, const bf16_t* Z, bf16_t* YN) {
    const int gw = F.bx * 8 + F.wave, NGW = F.G * 8; const float* nw = INP(F, I_SNORM) + (size_t)j * DIN;
    for (int r = gw; r < MT; r += NGW) {
        float t[32]; float ss = 0.f;
#pragma unroll
        for (int q = 0; q < 4; ++q) { const size_t o = (size_t)r * DIN + 8 * F.lane + 512 * q; const u32x4 a = *(const u32x4*)(Yf + o), bq = *(const u32x4*)(Yb + o), z = *(const u32x4*)(Z + o);
            const unsigned aa[4] = {a.x, a.y, a.z, a.w}, bb[4] = {bq.x, bq.y, bq.z, bq.w}, zz[4] = {z.x, z.y, z.z, z.w};
#pragma unroll
            for (int i = 0; i < 4; ++i) { const float v0 = (bflo(aa[i]) + bflo(bb[i])) * siluf(bflo(zz[i])), v1 = (bfhi(aa[i]) + bfhi(bb[i])) * siluf(bfhi(zz[i])); t[8 * q + 2 * i] = v0; t[8 * q + 2 * i + 1] = v1; ss += v0 * v0 + v1 * v1; } }
        const float rstd = rsqrtf(wave_sum(ss) * (1.0f / DIN) + EPS);
#pragma unroll
        for (int q = 0; q < 4; ++q) { const int c = 8 * F.lane + 512 * q; const f32x4 w0 = *(const f32x4*)(nw + c), w1 = *(const f32x4*)(nw + c + 4);
            u32x4 o; o.x = pk2(t[8 * q] * rstd * w0[0], t[8 * q + 1] * rstd * w0[1]); o.y = pk2(t[8 * q + 2] * rstd * w0[2], t[8 * q + 3] * rstd * w0[3]);
            o.z = pk2(t[8 * q + 4] * rstd * w1[0], t[8 * q + 5] * rstd * w1[1]); o.w = pk2(t[8 * q + 6] * rstd * w1[2], t[8 * q + 7] * rstd * w1[3]);
            *(u32x4*)(YN + (size_t)r * DIN + c) = o; }
    }
}

struct TokInfo { int s0, s1; float g0, g1; };
DEV void phase_route(const Frame& F, int layer, int ml, bf16_t* V) {
    LAS unsigned* lc = (LAS unsigned*)(F.lds + LDS_MISC + 256);
    if (F.tid < 8) lc[F.tid] = 0u;
    __syncthreads();
    const int gw = F.bx * 8 + F.wave, NGW = F.G * 8; const int j = layer / 2;
    const float* w = INP(F, I_NFFN) + (size_t)layer * D; const float* rw = INP(F, I_RW) + (size_t)j * D * NEXP;
    LAS float* rwl = (LAS float*)F.lds;
    for (int q = F.tid; q < D * 2; q += 512) { const int c = q >> 1, hf = q & 1; const int ln = (c & 255) >> 2, ii = c & 3, jq = c >> 8;
        *(LAS f32x4*)(rwl + ((jq * 4 + ii) * 64 + ln) * 8 + hf * 4) = *(const f32x4*)(rw + (size_t)q * 4); }
    __syncthreads();
    TokInfo* tok = (TokInfo*)(F.ws + OFF_TOK);
    for (int r = gw; r < MT; r += NGW) {
        f32x4 v[4]; load_row(F.H + (size_t)r * D, F.lane, v);
        const float rstd = rsqrtf(sumsq_row(v) * (1.0f / D) + EPS);
        const int vec = vec_of(r);
        normmod_row(v, rstd, w, modp(F, layer, vec, 3), modp(F, layer, vec, 4), F.lane);
        store_row_bf16(V + (size_t)r * D, F.lane, v);
        float lg[NEXP];
#pragma unroll
        for (int e = 0; e < NEXP; ++e) lg[e] = 0.f;
#pragma unroll
        for (int jj = 0; jj < 4; ++jj)
#pragma unroll
            for (int i = 0; i < 4; ++i) { const LAS float* rp = rwl + ((jj * 4 + i) * 64 + F.lane) * 8; const f32x4 r0 = *(const LAS f32x4*)rp, r1 = *(const LAS f32x4*)(rp + 4);
#pragma unroll
                for (int e = 0; e < 4; ++e) { lg[e] += v[jj][i] * r0[e]; lg[4 + e] += v[jj][i] * r1[e]; } }
#pragma unroll
        for (int e = 0; e < NEXP; ++e) lg[e] = wave_sum(lg[e]);
        int e0 = 0; float v0 = lg[0];
#pragma unroll
        for (int e = 1; e < NEXP; ++e) if (lg[e] > v0) { v0 = lg[e]; e0 = e; }
        int e1 = -1; float v1 = -3.0e38f;
#pragma unroll
        for (int e = 0; e < NEXP; ++e) if (e != e0 && lg[e] > v1) { v1 = lg[e]; e1 = e; }
        const float g1 = 1.0f / (1.0f + expf(v0 - v1)), g0 = 1.0f - g1;
        if (F.lane == 0) { TokInfo ti; ti.s0 = e0; ti.s1 = e1; ti.g0 = g0; ti.g1 = g1; tok[r] = ti; atomicAdd((unsigned*)&lc[e0], 1u); atomicAdd((unsigned*)&lc[e1], 1u); }
    }
    __syncthreads();
    if (F.tid < 8) __hip_atomic_fetch_add(F.ctl + CW_CNT + (ml * 8 + F.tid) * 64, lc[F.tid], RLX_AGENT);
}
DEV void tile_starts(const Frame& F, int ml, int (&ts)[NEXP + 1], unsigned (&cnt)[NEXP]) {
    ts[0] = 0;
#pragma unroll
    for (int e = 0; e < NEXP; ++e) { cnt[e] = __hip_atomic_load(F.ctl + CW_CNT + (ml * 8 + e) * 64, RLX_AGENT); ts[e + 1] = ts[e] + (int)((cnt[e] + 255u) / 256u); }
}
DEV void phase_slots(const Frame& F, int ml) {
    int ts[NEXP + 1]; unsigned cnt[NEXP]; tile_starts(F, ml, ts, cnt);
    TokInfo* tok = (TokInfo*)(F.ws + OFF_TOK); int* s2t = (int*)(F.ws + OFF_S2T);
    const int gw = F.bx * 8 + F.wave, NGW = F.G * 8;
    for (int base = gw * 64; base < MT; base += NGW * 64) {
        const int r = base + F.lane; TokInfo ti = tok[r];
        const int ek[2] = {ti.s0, ti.s1}; int sl[2];
#pragma unroll
        for (int k = 0; k < 2; ++k) { sl[k] = 0;
            for (int e = 0; e < NEXP; ++e) { const unsigned long long m = __ballot(ek[k] == e);
                if (m) { const int leader = __builtin_ctzll(m); unsigned b0 = 0;
                    if (F.lane == leader) b0 = __hip_atomic_fetch_add(F.ctl + CW_CUR + (ml * 8 + e) * 64, (unsigned)__builtin_popcountll(m), RLX_AGENT);
                    b0 = __shfl(b0, leader);
                    if (ek[k] == e) sl[k] = ts[e] * 256 + (int)b0 + __builtin_popcountll(m & ((1ull << F.lane) - 1ull)); } } }
        ti.s0 = sl[0]; ti.s1 = sl[1]; tok[r] = ti; s2t[sl[0]] = r; s2t[sl[1]] = r;
    }
    if (F.bx == 0) { for (int e = 0; e < NEXP; ++e) { const int a = ts[e] * 256 + (int)cnt[e], b2 = ts[e + 1] * 256; for (int s = a + F.tid; s < b2; s += 512) s2t[s] = 0; } }
}
DEV void phase_combine(const Frame& F, int layer, const bf16_t* YS, bool final_) {
    const int gw = F.bx * 8 + F.wave, NGW = F.G * 8; const TokInfo* tok = (const TokInfo*)(F.ws + OFF_TOK);
    const int nrows = final_ ? ML : MT;
    for (int r = gw; r < nrows; r += NGW) {
        f32x4 v[4]; load_row(F.H + (size_t)r * D, F.lane, v);
        const TokInfo ti = tok[r]; const float* g2 = modp(F, layer, vec_of(r), 5);
#pragma unroll
        for (int jj = 0; jj < 4; ++jj) { const int c = 4 * F.lane + 256 * jj; const u32x2 a = *(const u32x2*)(YS + (size_t)ti.s0 * D + c), b = *(const u32x2*)(YS + (size_t)ti.s1 * D + c); const f32x4 gv = *(const f32x4*)(g2 + c);
            v[jj][0] += gv[0] * (ti.g0 * bflo(a.x) + ti.g1 * bflo(b.x)); v[jj][1] += gv[1] * (ti.g0 * bfhi(a.x) + ti.g1 * bfhi(b.x));
            v[jj][2] += gv[2] * (ti.g0 * bflo(a.y) + ti.g1 * bflo(b.y)); v[jj][3] += gv[3] * (ti.g0 * bfhi(a.y) + ti.g1 * bfhi(b.y)); }
        if (!final_) {
#pragma unroll
            for (int jj = 0; jj < 4; ++jj) *(f32x4*)(F.H + (size_t)r * D + 4 * F.lane + 256 * jj) = v[jj];
        } else {
            const float rstd = rsqrtf(sumsq_row(v) * (1.0f / D) + EPS); const float* fw = INP(F, I_FNORM);
#pragma unroll
            for (int jj = 0; jj < 4; ++jj) { const int c = 4 * F.lane + 256 * jj; *(f32x4*)(OUTP(F) + (size_t)r * D + c) = v[jj] * rstd * *(const f32x4*)(fw + c); }
        }
    }
}

constexpr int PH_PER_PAIR = 17, N_PHASES = 1 + 2 * PH_PER_PAIR;
__global__ void __launch_bounds__(512, 2) fwd_kernel(Params prm) {
#ifdef EMU
    unsigned char* lds_raw = emu_lds();
#else
    extern __shared__ __attribute__((aligned(16))) unsigned char lds_raw[];
#endif
    Frame F;
    F.lds = (LAS unsigned char*)lds_raw;
    F.tid = threadIdx.x; F.lane = F.tid & 63; F.wave = RFL(F.tid >> 6); F.G = gridDim.x; F.bx = blockIdx.x;
    F.p = &prm; F.ws = prm.ws; F.ctl = (unsigned*)(prm.ws + OFF_CTL); F.H = (float*)(prm.ws + OFF_H); F.mod = (float*)(prm.ws + OFF_MOD);
    volatile LAS unsigned* misc = (volatile LAS unsigned*)(F.lds + LDS_MISC);
    if (F.tid < 64) misc[F.tid] = 0u;
    __syncthreads();
    XcdBarrier bar; bar.bar = F.ctl + CW_BAR; bar.x = 0; bar.st = misc;
    const int lo = prm.ph_lo, hi = prm.ph_hi;
    if (hi - lo > 1) bar = xcd_barrier_post(F.ctl + CW_BAR, misc);
    int ph = 0;
#ifndef SITE_MASK
#define SITE_MASK 0xFFFFFFFFu
#endif
#ifndef PROBE_REPEAT_SITE
#define PROBE_REPEAT_SITE (-1)
#endif
#define PH_REPS(site) ((PROBE_REPEAT_SITE == (site)) ? 2 : 1)
#define PHASE_BEGIN(site) if (((SITE_MASK >> (site)) & 1u) && lo <= ph && ph < hi) { { int _t = threadIdx.x; LAUNDER_V(_t); F.tid = _t; F.lane = _t & 63; int _b = blockIdx.x; LAUNDER_S(_b); F.bx = _b; int _g = gridDim.x; LAUNDER_S(_g); F.G = _g; \
      F.ws = WSP(F); F.ctl = (unsigned*)(F.ws + OFF_CTL); F.H = (float*)(F.ws + OFF_H); F.mod = (float*)(F.ws + OFF_MOD); } \
      for (int _rep = 0; _rep < PH_REPS(site); ++_rep) { if (_rep) __syncthreads();
#define PHASE_END   } if (ph + 1 < hi) xcd_barrier(bar); } ++ph;
#define B_W (F.ws + OFF_W)
#define B_ACT (F.ws + OFF_ACT)
#define B_P ((bf16_t*)(B_ACT + A_P))
#define B_HID ((bf16_t*)(B_ACT + A_HID))
#define B_U ((bf16_t*)(B_ACT + A_U))
#define B_Z ((bf16_t*)(B_ACT + A_Z))
#define B_XBC ((bf16_t*)(B_ACT + A_XBC))
#define B_DT ((float*)(B_W + W_DT))
#define B_XT ((bf16_t*)(B_ACT + A_XT))
#define B_BROW ((bf16_t*)(B_ACT + A_BROW))
#define B_BT ((bf16_t*)(B_ACT + A_BT))
#define B_CROW ((bf16_t*)(B_ACT + A_CROW))
#define B_CB ((bf16_t*)(B_ACT + A_CB))
#define B_CUM ((float*)(B_ACT + A_CUM))
#define B_WJ ((float*)(B_ACT + A_WJ))
#define B_YF ((bf16_t*)(B_ACT + A_YF))
#define B_YB ((bf16_t*)(B_W + W_YB))
#define B_YN ((bf16_t*)(B_ACT + A_YN))
#define B_V ((bf16_t*)(B_ACT + A_V))
#define B_HIDM ((bf16_t*)(B_ACT + A_HIDM))
#define B_YS ((bf16_t*)(B_ACT + A_YS))

    PHASE_BEGIN(0) phase_mod(F); convert_even(F, 0); PHASE_END

    for (int lp = 0; lp < 2; ++lp) {
        const int le = 2 * lp, lod = 2 * lp + 1;
        PHASE_BEGIN(1) phase_poolprep(F, le, B_P); PHASE_END
        PHASE_BEGIN(2) { PolPool S; S.G = F.G; S.c = F.bx; S.K = 256; S.lda = D; S.ldb = 256; S.P = B_P; S.W = (const bf16_t*)(B_W + W_POOL); S.src = mksrc(F); S.layer = le; S.scale = INP(F, I_POOLS) + (size_t)lp * D;
                      ge::gemm_phase(F.lds, S, F.tid); } PHASE_END
        PHASE_BEGIN(3) phase_norm(F, le, 3, B_P, false); PHASE_END
        PHASE_BEGIN(4) { PolUp<false> S; S.G = F.G; S.c = F.bx; S.K = D; S.lda = D; S.ldb = D; S.A = B_P; S.W = (const bf16_t*)(B_W + W_UP); S.HID = B_HID; S.ldh = DFF; S.nq = DFF / 128; S.nM = NPAN; S.s2t = nullptr;
                      ge::gemm_phase(F.lds, S, F.tid); } PHASE_END
        PHASE_BEGIN(5) { PolResid S; S.G = F.G; S.c = F.bx; S.K = DFF; S.lda = DFF; S.ldb = DFF; S.A = B_HID; S.W = (const bf16_t*)(B_W + W_DN); S.src = mksrc(F); S.layer = le; S.which = 5;
                      ge::gemm_phase(F.lds, S, F.tid); } PHASE_END
        PHASE_BEGIN(6) phase_norm(F, lod, 0, B_U, false); convert_ssd(F, lp); PHASE_END
        PHASE_BEGIN(7) { PolInProj S; S.G = F.G; S.c = F.bx; S.K = D; S.lda = D; S.ldb = D; S.A = B_U; S.W = (const bf16_t*)(B_W + W_IN); S.Z = B_Z; S.XBC = B_XBC; S.DT = B_DT;
                      ge::gemm_phase(F.lds, S, F.tid); } PHASE_END
        PHASE_BEGIN(8) phase_conv(F, lp, B_XBC, B_XT, B_BROW, B_BT, B_CROW); PHASE_END
        PHASE_BEGIN(9) phase_cb(F, B_BROW, B_CROW, B_CB); phase_tables(F, lp, B_DT, B_CUM, B_WJ); PHASE_END
        PHASE_BEGIN(10) phase_scan(F, lp, B_XT, B_BT, B_CROW, B_CB, B_DT, B_CUM, B_WJ, B_YF, B_YB); PHASE_END
        PHASE_BEGIN(11) phase_gate(F, lp, B_YF, B_YB, B_Z, B_YN); PHASE_END
        PHASE_BEGIN(12) { PolResid S; S.G = F.G; S.c = F.bx; S.K = DIN; S.lda = DIN; S.ldb = DIN; S.A = B_YN; S.W = (const bf16_t*)(B_W + W_OUT); S.src = mksrc(F); S.layer = lod; S.which = 2;
                      ge::gemm_phase(F.lds, S, F.tid); } PHASE_END
        PHASE_BEGIN(13) phase_route(F, lod, lp, B_V); convert_moe(F, lp); PHASE_END
        PHASE_BEGIN(14) phase_slots(F, lp); PHASE_END
        PHASE_BEGIN(15) { int ts[NEXP + 1]; unsigned cnt[NEXP]; tile_starts(F, lp, ts, cnt);
                      PolUp<true> S; S.G = F.G; S.c = F.bx; S.K = D; S.lda = D; S.ldb = D; S.A = B_V; S.W = (const bf16_t*)(B_W + W_MUP); S.HID = B_HIDM; S.ldh = DFFE; S.nq = DFFE / 128; S.nM = ts[NEXP];
                      S.s2t = (const int*)(F.ws + OFF_S2T);
#pragma unroll
                      for (int e = 0; e <= NEXP; ++e) S.tstart[e] = ts[e];
                      ge::gemm_phase(F.lds, S, F.tid); } PHASE_END
        PHASE_BEGIN(16) { int ts[NEXP + 1]; unsigned cnt[NEXP]; tile_starts(F, lp, ts, cnt);
                      PolMoeDown S; S.G = F.G; S.c = F.bx; S.K = DFFE; S.lda = DFFE; S.ldb = DFFE; S.A = B_HIDM; S.W = (const bf16_t*)(B_W + W_MDN); S.YS = B_YS; S.nM = ts[NEXP];
#pragma unroll
                      for (int e = 0; e <= NEXP; ++e) S.tstart[e] = ts[e];
                      ge::gemm_phase(F.lds, S, F.tid); } PHASE_END
        PHASE_BEGIN(17) phase_combine(F, lod, B_YS, lp == 1); if (lp == 0) convert_even(F, 1); PHASE_END
    }
#undef PHASE_BEGIN
#undef PHASE_END
}

extern "C" void kernel_launch(void* const* d_in, const int* in_sizes, int n_in, void* d_out, int out_size, void* d_ws, size_t ws_size, hipStream_t stream) {
    static int grid = 0;
    if (grid == 0) {
        if (n_in != 26 || ws_size < WS_NEED) { fprintf(stderr, "kernel_launch: need 26 inputs and %zu bytes of workspace (got %d, %zu)\n", (size_t)WS_NEED, n_in, ws_size); grid = -1; return; }
        int dev = 0, cus = 0, per_cu = 0;
        if (hipGetDevice(&dev) != hipSuccess || hipDeviceGetAttribute(&cus, hipDeviceAttributeMultiprocessorCount, dev) != hipSuccess) { grid = -1; return; }
        if (hipFuncSetAttribute((const void*)fwd_kernel, hipFuncAttributeMaxDynamicSharedMemorySize, LDS_BYTES) != hipSuccess) { grid = -1; return; }
        if (hipOccupancyMaxActiveBlocksPerMultiprocessor(&per_cu, (const void*)fwd_kernel, 512, LDS_BYTES) != hipSuccess || per_cu < 1) { fprintf(stderr, "kernel_launch: occupancy query says %d\n", per_cu); }
        (void)hipGetLastError();
        grid = cus;
    }
    if (grid < 0) return;
    (void)in_sizes; (void)out_size;
    if (hipMemsetAsync((char*)d_ws + OFF_CTL, 0, CTL_BYTES, stream) != hipSuccess) return;
    Params p{};
    for (int i = 0; i < 26; ++i) p.in[i] = (const float*)d_in[i];
    p.out = (float*)d_out; p.ws = (unsigned char*)d_ws;
    if (N_LAUNCH_MODE == 1) { p.ph_lo = 0; p.ph_hi = N_PHASES; hipLaunchKernelGGL(fwd_kernel, dim3(grid), dim3(512), LDS_BYTES, stream, p); }
    else for (int ph = 0; ph < N_PHASES; ++ph) { p.ph_lo = ph; p.ph_hi = ph + 1; hipLaunchKernelGGL(fwd_kernel, dim3(grid), dim3(512), LDS_BYTES, stream, p); }
}
```

```cpp
#ifndef EMU
#include <hip/hip_runtime.h>
#endif
#include <cstdio>
#include <cstdint>

#ifndef CFG_SEQ
#define CFG_SEQ 16384
#endif
#ifndef CFG_DFF
#define CFG_DFF 2816
#endif
#ifndef CFG_DFFE
#define CFG_DFFE 3584
#endif
#ifndef MOE_DOWN_FP8
#define MOE_DOWN_FP8 0
#endif
#ifndef N_LAUNCH_MODE
#define N_LAUNCH_MODE 1
#endif

#ifdef EMU
#define LAS
#define DEV inline
#define WAITV(n) ((void)0)
#define WAITL(n) ((void)0)
#define SBAR() emu_wg_sync()
#define SCHED() ((void)0)
#define SETPRIO(x) ((void)0)
#define MFMA16(a, b, c) emu_mfma16(a, b, c)
#define GLDS16(g, l) emu_glds16((const void*)(g), (void*)(l))
#define GLDS4(g, l) emu_glds4((const void*)(g), (void*)(l))
#define MFMA8(a, b, c) emu_mfma8(a, b, c)
#define RFL(x) emu_rfl(x)
#define MEMFENCE() ((void)0)
#define WSYNC() emu_wave_sync()
#define LDSBAR() emu_wg_sync()
#define LAUNDER_V(x) ((void)0)
#define SLEEP1() emu_yield()
#define MY_XCC_ID() ((unsigned)(blockIdx.x & 7u))
#define FENCE_REL() __atomic_thread_fence(__ATOMIC_SEQ_CST)
#define FENCE_ACQ() __atomic_thread_fence(__ATOMIC_SEQ_CST)
#define FEXP(x) expf(x)
#define RLX_AGENT __ATOMIC_RELAXED, 4
#else
#define LAS __attribute__((address_space(3)))
#define DEV __device__ __forceinline__
#define WAITV(n) asm volatile("s_waitcnt vmcnt(" #n ")" ::: "memory")
#define WAITL(n) asm volatile("s_waitcnt lgkmcnt(" #n ")" ::: "memory")
#define SBAR() __builtin_amdgcn_s_barrier()
#define SCHED() __builtin_amdgcn_sched_barrier(0)
#define SETPRIO(x) __builtin_amdgcn_s_setprio(x)
#define MFMA16(a, b, c) __builtin_amdgcn_mfma_f32_16x16x32_bf16(a, b, c, 0, 0, 0)
#define GLDS16(g, l) __builtin_amdgcn_global_load_lds((const unsigned*)(g), (LAS unsigned*)(l), 16, 0, 0)
#define GLDS4(g, l) __builtin_amdgcn_global_load_lds((const unsigned*)(g), (LAS unsigned*)(l), 4, 0, 0)
#define MFMA8(a, b, c) __builtin_amdgcn_mfma_scale_f32_16x16x128_f8f6f4(a, b, c, 0, 0, 0, 0x7f7f7f7f, 0, 0x7f7f7f7f)
#define RFL(x) __builtin_amdgcn_readfirstlane(x)
#define MEMFENCE() asm volatile("" ::: "memory")
#define LDSBAR() do { asm volatile("s_waitcnt lgkmcnt(0)" ::: "memory"); __builtin_amdgcn_s_barrier(); asm volatile("" ::: "memory"); } while (0)
#define WSYNC() asm volatile("s_waitcnt lgkmcnt(0)" ::: "memory")
#define SLEEP1() __builtin_amdgcn_s_sleep(1)
#define MY_XCC_ID() ((unsigned)__builtin_amdgcn_s_getreg((3 << 11) | 20) & 0xFu)
#define FENCE_REL() __builtin_amdgcn_fence(__ATOMIC_RELEASE, "agent")
#define FENCE_ACQ() __builtin_amdgcn_fence(__ATOMIC_ACQUIRE, "agent")
#define FEXP(x) __expf(x)
#define RLX_AGENT __ATOMIC_RELAXED, __HIP_MEMORY_SCOPE_AGENT
#define LAUNDER_V(x) asm volatile("" : "+v"(x))
#endif

typedef unsigned short bf16_t;
typedef short bf16x8 __attribute__((ext_vector_type(8)));
typedef float f32x4 __attribute__((ext_vector_type(4)));
typedef float f32x2 __attribute__((ext_vector_type(2)));
typedef unsigned u32x4 __attribute__((ext_vector_type(4)));
typedef unsigned u32x2 __attribute__((ext_vector_type(2)));
typedef int i32x8 __attribute__((ext_vector_type(8)));
typedef int i32x4 __attribute__((ext_vector_type(4)));
typedef unsigned char fp8_t;

constexpr int D = 1024, NB = 2, SEQ = CFG_SEQ, CTXL = 256, DEPTH = 4;
constexpr int ML = NB * SEQ, MC = NB * CTXL, MT = ML + MC, NPAN = MT / 256;
constexpr int DFF = CFG_DFF, DFFE = CFG_DFFE, NEXP = 8;
constexpr int DIN = 2048, NH = 32, HD = 64, NG = 4, DS = 128, CONVD = 3072, NPROJ = 5184, NPROJP = 5376, BCD = 512;
constexpr int TV = CTXL + SEQ, NCH = TV / 128;
constexpr int GRIDW = 64;
constexpr float EPS = 1e-6f;
constexpr int NSLOT_TILES = (2 * MT) / 256 + NEXP, NSLOT = NSLOT_TILES * 256;
static_assert(SEQ % 128 == 0 && ML % 256 == 0 && DFF % 128 == 0 && DFFE % 128 == 0 && DFF >= 256 && DFFE >= 256, "shape constraints");

constexpr size_t MiB = 1u << 20;
constexpr size_t al(size_t x) { return (x + 4095) & ~(size_t)4095; }
constexpr size_t OFF_CTL = 0, CTL_BYTES = 1 * MiB;
constexpr size_t OFF_MOD = 1 * MiB;
constexpr size_t OFF_TOK = 2 * MiB;
constexpr size_t OFF_S2T = 3 * MiB;
constexpr size_t OFF_H = 4 * MiB, SZ_H = (size_t)MT * D * 4;
constexpr size_t OFF_W = OFF_H + al(SZ_H);
constexpr size_t W_POOL = 0, SZ_WPOOL = (size_t)4 * 256 * 256 * 2;
constexpr size_t W_UP = al(SZ_WPOOL), SZ_WUP = (size_t)2 * DFF * D * 2;
constexpr size_t W_DN = W_UP + al(SZ_WUP), SZ_WDN = (size_t)D * DFF * 2;
constexpr size_t SZ_WEVEN = W_DN + al(SZ_WDN);
constexpr size_t W_IN = 0, SZ_WIN = (size_t)NPROJP * D * 2;
constexpr size_t W_OUT = al(SZ_WIN), SZ_WOUT = (size_t)D * DIN * 2;
constexpr size_t W_DT = W_OUT + al(SZ_WOUT), SZ_DT = (size_t)NB * 2 * NH * TV * 4;
constexpr size_t W_MUP = W_DT + al(SZ_DT), SZ_WMUP = (size_t)NEXP * 2 * DFFE * D * 2;
constexpr size_t W_MDN = W_MUP + al(SZ_WMUP), SZ_WMDN = (size_t)NEXP * D * DFFE * 2;
constexpr size_t W_YB = W_MUP, SZ_Y = (size_t)MT * DIN * 2;
constexpr size_t SZ_WODD_A = W_MDN + al(SZ_WMDN), SZ_WODD_B = W_YB + al(SZ_Y);
constexpr size_t mx(size_t a, size_t b) { return a > b ? a : b; }
constexpr size_t SZ_W = mx(SZ_WEVEN, mx(SZ_WODD_A, SZ_WODD_B));
constexpr size_t OFF_ACT = OFF_W + SZ_W;
constexpr size_t A_P = 0, SZ_ACT1 = (size_t)MT * D * 2;
constexpr size_t A_HID = al(SZ_ACT1), SZ_HID = (size_t)MT * DFF * 2;
constexpr size_t SZ_AEVEN = A_HID + al(SZ_HID);
constexpr size_t A_Z = 0;
constexpr size_t A_XBC = al(SZ_Y), SZ_XBC = (size_t)MT * CONVD * 2;
constexpr size_t A_YF = A_XBC;
constexpr size_t A_CB = A_XBC + al(SZ_Y), SZ_CB = (size_t)NB * NG * NCH * 128 * 128 * 2;
static_assert(al(SZ_Y) + SZ_CB <= SZ_XBC, "CB fits behind Yf inside the XBC region");
constexpr size_t A_XT = A_XBC + al(SZ_XBC), SZ_XT = (size_t)NB * DIN * TV * 2;
constexpr size_t A_U = A_XT, A_YN = A_XT;
constexpr size_t A_BROW = A_XT + al(SZ_XT), SZ_BC = (size_t)MT * BCD * 2;
constexpr size_t A_BT = A_BROW + al(SZ_BC);
constexpr size_t A_CROW = A_BT + al(SZ_BC);
constexpr size_t A_CUM = A_CROW + al(SZ_BC);
constexpr size_t A_WJ = A_CUM + al(SZ_DT);
constexpr size_t SZ_ASSD = A_WJ + al(SZ_DT);
constexpr size_t A_V = 0;
constexpr size_t A_HIDM = al(SZ_ACT1), SZ_HIDM = (size_t)NSLOT * DFFE * 2;
constexpr size_t A_YS = A_HIDM + al(SZ_HIDM), SZ_YS = (size_t)NSLOT * D * 2;
constexpr size_t SZ_AMOE = A_YS + al(SZ_YS);
constexpr size_t SZ_ACT = mx(SZ_AEVEN, mx(SZ_ASSD, SZ_AMOE));
constexpr size_t WS_NEED = OFF_ACT + SZ_ACT;

constexpr int CW_BAR = 4096;
constexpr int CW_CNT = 16384;
constexpr int CW_CUR = 16384 + 2 * 8 * 64;

DEV unsigned f2bf(float f) { unsigned u = __builtin_bit_cast(unsigned, f); return (u + 0x7fffu + ((u >> 16) & 1u)) >> 16; }
#ifndef EMU
typedef __bf16 bf16x2n __attribute__((ext_vector_type(2)));
#endif
DEV unsigned pk2(float lo, float hi) {
#ifdef EMU
    return f2bf(lo) | (f2bf(hi) << 16);
#else
    f32x2 v = {lo, hi}; bf16x2n b = __builtin_convertvector(v, bf16x2n); return __builtin_bit_cast(unsigned, b);
#endif
}
DEV unsigned pk4_fp8(float a, float b, float c, float d) {
#ifdef EMU
    return emu_f2fp8(a) | (emu_f2fp8(b) << 8) | (emu_f2fp8(c) << 16) | (emu_f2fp8(d) << 24);
#else
    unsigned w = 0; w = __builtin_amdgcn_cvt_pk_fp8_f32(a, b, w, false); w = __builtin_amdgcn_cvt_pk_fp8_f32(c, d, w, true); return w;
#endif
}
DEV float bf2f(unsigned b) { return __builtin_bit_cast(float, b << 16); }
DEV float bflo(unsigned w) { return __builtin_bit_cast(float, w << 16); }
DEV float bfhi(unsigned w) { return __builtin_bit_cast(float, w & 0xffff0000u); }
#ifdef EMU
DEV float frcp(float x) { return 1.0f / x; }
#else
DEV float frcp(float x) { return __builtin_amdgcn_rcpf(x); }
#endif
#ifdef EMU
DEV float fexp2(float x) { return exp2f(x); }
#else
DEV float fexp2(float x) { return __builtin_amdgcn_exp2f(x); }
#endif
DEV float siluf(float x) { return x * frcp(1.0f + FEXP(-x)); }
#ifdef EMU
DEV float flog2(float x) { return log2f(x); }
#else
DEV float flog2(float x) { return __builtin_amdgcn_logf(x); }
#endif
DEV float softplusf(float x) { if (x > 20.f) return x; const float e = FEXP(x); return e < 0.0625f ? e * (1.0f - e * (0.5f - e * (0.33333334f - e * (0.25f - e * 0.2f)))) : flog2(1.0f + e) * 0.6931471806f; }
DEV float wave_sum(float v) {
#pragma unroll
    for (int o = 1; o < 64; o <<= 1) v += __shfl_xor(v, o);
    return v;
}
DEV int vec_of(int r) { return r < ML ? (r / SEQ) : 2; }
DEV int row_of(int b, int tv) { return tv < CTXL ? ML + b * CTXL + tv : b * SEQ + (tv - CTXL); }

#define XB_TMO      128
#define XB_XCNT(j)  (256  + 64 * (j))
#define XB_XSUB(j)  (1280 + 64 * (j))
#define XB_XGEN(j)  (2304 + 64 * (j))
#define XB_TOP      3328
#define XB_TOPGEN   3392
#define XCD_BAR_WORDS 3456
#define XB_SPIN_CAP (1u << 22)
DEV unsigned xb_ld(unsigned* p)              { return __hip_atomic_load(p, RLX_AGENT); }
DEV unsigned xb_add(unsigned* p, unsigned v) { return __hip_atomic_fetch_add(p, v, RLX_AGENT); }
#define XB_SPIN(cond, bar) do { unsigned _sp = 0; while (cond) { SLEEP1(); \
    if ((++_sp & 255u) == 0u) { if (xb_ld(&(bar)[XB_TMO])) break; if (_sp > XB_SPIN_CAP) { atomicAdd(&(bar)[XB_TMO], 1u); break; } } } } while (0)
struct XcdBarrier { unsigned* bar; unsigned x; volatile LAS unsigned* st; };
DEV XcdBarrier xcd_barrier_post(unsigned* bar, volatile LAS unsigned* st) {
    XcdBarrier b; b.bar = bar; b.x = MY_XCC_ID(); b.st = st;
    if (threadIdx.x == 0) (void)xb_add(&bar[XB_XCNT(b.x)], 1u);
    return b;
}
DEV void xcd_barrier_complete(unsigned* bar, unsigned x, unsigned& nloc, unsigned& nx) {
    const unsigned G = gridDim.x;
    unsigned sum, cnt, mine, sp = 0u;
    for (;;) {
        sum = 0u; cnt = 0u; mine = 0u;
#pragma unroll
        for (unsigned j = 0; j < 16; ++j) { const unsigned c = xb_ld(&bar[XB_XCNT(j)]); sum += c; cnt += (c > 0u) ? 1u : 0u; mine = (j == x) ? c : mine; }
        if (sum == G) break;
        SLEEP1();
        if ((++sp & 255u) == 0u) { if (xb_ld(&bar[XB_TMO])) break; if (sp > XB_SPIN_CAP) { atomicAdd(&bar[XB_TMO], 1u); break; } }
    }
    nloc = mine > 0u ? mine : 1u; nx = cnt > 0u ? cnt : 1u;
}
DEV void xcd_barrier(const XcdBarrier& b) {
    WAITV(0);
    __syncthreads();
    if (threadIdx.x == 0) {
        unsigned* bar = b.bar;
#ifndef EMU
        __builtin_amdgcn_s_waitcnt(0);
#endif
        unsigned nloc = b.st[0], nx = b.st[1];
        if (nloc == 0u) { xcd_barrier_complete(bar, b.x, nloc, nx); b.st[0] = nloc; b.st[1] = nx; }
        const unsigned old = xb_add(&bar[XB_XSUB(b.x)], 1u);
        const unsigned gen = old / nloc;
        if (old + 1u == (gen + 1u) * nloc) {
            FENCE_REL();
            WAITV(0);
            const unsigned og = xb_add(&bar[XB_TOP], 1u);
            const unsigned tg = og / nx;
            if (og + 1u == (tg + 1u) * nx) xb_add(&bar[XB_TOPGEN], 1u);
            else XB_SPIN(xb_ld(&bar[XB_TOPGEN]) == tg, bar);
            FENCE_ACQ();
            xb_add(&bar[XB_XGEN(b.x)], 1u);
            WAITV(0);
        } else {
            XB_SPIN(xb_ld(&bar[XB_XGEN(b.x)]) == gen, bar);
            FENCE_ACQ();
            WAITV(0);
        }
    }
    __syncthreads();
}

namespace ge {
constexpr int BM = 256, BK = 64, HALF = 128, HTB = HALF * BK * 2, STAGE_BYTES = 8 * HTB, NXCD = 8, WGM = 8;
DEV int lds_byte(int r, int c) { const int st = (r >> 4) * 2 + (c >> 5), rr = r & 15, cc = c & 31, ob = rr * 64 + cc * 2; return st * 1024 + (ob ^ (((ob >> 9) & 1) << 5)); }
DEV void stage_rc(int b, int& R, int& C) { const int st = b / 1024, sb = b % 1024, swz = sb ^ (((sb >> 9) & 1) << 5); R = (st >> 1) * 16 + swz / 64; C = (st & 1) * 32 + (swz % 64) / 2; }
DEV int perm32(int rho) { const int n = rho >> 4, i = rho & 15; return 8 * (i >> 2) + 4 * n + (i & 3); }
struct Unit { int pm, pn; };
DEV bool static_next(int nM, int nN, int G, int c, int i, Unit& u) {
    const int nwg = nM * nN; const long L = (long)i * G + c; if (L >= nwg) return false;
    int wgid = (int)L; { const int q = nwg / NXCD, r = nwg % NXCD, xcd = wgid % NXCD, off = wgid / NXCD; wgid = (xcd < r ? xcd * (q + 1) : r * (q + 1) + (xcd - r) * q) + off; }
    const int nig = WGM * nN, gid = wgid / nig, fm = gid * WGM, gsz = (nM - fm) < WGM ? (nM - fm) : WGM;
    u.pm = fm + ((wgid % nig) % gsz); u.pn = (wgid % nig) / gsz; return true;
}
template <class P, bool SP2 = true>
DEV void gemm_phase(LAS unsigned char* lds, const P& S, const int tid) {
    const int wid = RFL(tid >> 6), lane = tid & 63, wr = wid >> 2, wc = wid & 3, fr = lane & 15, fq = lane >> 4;
    const int K = S.K, nt = K * P::ES / (BK * 2);
    unsigned voffB[2]; int RA[2], CA2[2];
#pragma unroll
    for (int i = 0; i < 2; ++i) { int R, C; stage_rc(tid * 16 + i * 8192, R, C); const int Rb = P::PERM ? ((R & ~31) + perm32(R & 31)) : R;
        RA[i] = R; CA2[i] = C * 2; voffB[i] = (unsigned)(Rb * S.ldb) * (unsigned)P::ES + (unsigned)(C * 2); }
    const size_t kstep = (size_t)(BK * 2);
    const size_t hstepB = (size_t)HALF * S.ldb * P::ES;
    const unsigned ldsw = (unsigned)wid * 1024u;
    const int aoff = lds_byte(wr * 64 + fr, fq * 8), boff = lds_byte(wc * 32 + fr, fq * 8);
#define GE_SA(b, h) (((b) * 2 + (h)) * HTB)
#define GE_SB(b, h) ((4 + (b) * 2 + (h)) * HTB)
#define GE_STAGEB(bufoff, gbase) do { _Pragma("unroll") for (int _i = 0; _i < 2; ++_i) \
        GLDS16((const char*)(gbase) + voffB[_i], lds + (bufoff) + ldsw + _i * 8192); } while (0)
#define GE_STAGEA(bufoff, gbase, h) do { _Pragma("unroll") for (int _i = 0; _i < 2; ++_i) \
        GLDS16((const char*)(gbase) + oA[h][_i], lds + (bufoff) + ldsw + _i * 8192); } while (0)
#define GE_LD1(p_) __builtin_shufflevector(*(const LAS i32x4*)(p_), *(const LAS i32x4*)((p_) + 1024), 0, 1, 2, 3, 4, 5, 6, 7)
#define GE_LDA(dst, b, h) do { _Pragma("unroll") for (int m = 0; m < 4; ++m) dst[m] = GE_LD1(lds + GE_SA(b, h) + aoff + m * 2048); } while (0)
#define GE_LDB(dst, b, h) do { _Pragma("unroll") for (int n = 0; n < 2; ++n) dst[n] = GE_LD1(lds + GE_SB(b, h) + boff + n * 2048); } while (0)
#define GE_LO(x) __builtin_bit_cast(bf16x8, __builtin_shufflevector(x, x, 0, 1, 2, 3))
#define GE_HI(x) __builtin_bit_cast(bf16x8, __builtin_shufflevector(x, x, 4, 5, 6, 7))
#define GE_MMA(ai, bj, At, Bt) do { SETPRIO(1); _Pragma("unroll") for (int m = 0; m < 4; ++m) _Pragma("unroll") for (int n = 0; n < 2; ++n) { \
        if constexpr (P::FP8) acc[ai][bj][m][n] = MFMA8(Bt[n], At[m], acc[ai][bj][m][n]);     \
        else { acc[ai][bj][m][n] = MFMA16(GE_LO(Bt[n]), GE_LO(At[m]), acc[ai][bj][m][n]); acc[ai][bj][m][n] = MFMA16(GE_HI(Bt[n]), GE_HI(At[m]), acc[ai][bj][m][n]); } } SETPRIO(0); } while (0)
    Unit cur, nxt; int ui = 0;
    if (!S.next(0, cur)) return;
    f32x4 acc[2][2][4][2];
#pragma unroll
    for (int a = 0; a < 2; ++a)
#pragma unroll
        for (int b = 0; b < 2; ++b)
#pragma unroll
            for (int m = 0; m < 4; ++m)
#pragma unroll
                for (int n = 0; n < 2; ++n) acc[a][b][m][n] = (f32x4){0.f, 0.f, 0.f, 0.f};
    unsigned oA[2][2];
#pragma unroll
    for (int h = 0; h < 2; ++h)
#pragma unroll
        for (int i = 0; i < 2; ++i) {
            if constexpr (P::GATHER) oA[h][i] = (unsigned)S.gather_row(cur, h * HALF + RA[i]) * (unsigned)(S.lda * P::ES) + (unsigned)CA2[i];
            else oA[h][i] = (unsigned)((h * HALF + RA[i]) * S.lda) * (unsigned)P::ES + (unsigned)CA2[i];
            }
    const char* cA = S.a_base(cur); const char* cB = S.b_base(cur);
    if constexpr (SP2) {
        GE_STAGEB(GE_SB(0, 0), cB); GE_STAGEB(GE_SB(0, 1), cB + hstepB); GE_STAGEA(GE_SA(0, 0), cA, 0); GE_STAGEA(GE_SA(0, 1), cA, 1);
        if (wr == 1) SBAR();
        WAITV(2); SBAR();
        GE_STAGEB(GE_SB(1, 0), cB + kstep); GE_STAGEA(GE_SA(1, 0), cA + kstep, 0); GE_STAGEB(GE_SB(1, 1), cB + hstepB + kstep);
        WAITV(6); SBAR();
    } else {
    GE_STAGEB(GE_SB(0, 0), cB); GE_STAGEA(GE_SA(0, 0), cA, 0); GE_STAGEB(GE_SB(0, 1), cB + hstepB); GE_STAGEA(GE_SA(0, 1), cA, 1);
    if (wr == 1) SBAR();
    WAITV(4); SBAR();
    GE_STAGEB(GE_SB(1, 0), cB + kstep); GE_STAGEA(GE_SA(1, 0), cA + kstep, 0); GE_STAGEB(GE_SB(1, 1), cB + hstepB + kstep);
    WAITV(6); SBAR();
    }
    for (;;) {
        const bool has_next = S.next(ui + 1, nxt);
        const char* nA = has_next ? S.a_base(nxt) : cA; const char* nB = has_next ? S.b_base(nxt) : cB;
        for (int t = 0; t < nt; t += 2) {
            const bool last = (t == nt - 2);
            const char* a1 = cA + (size_t)(t + 1) * kstep;
            const char* a2 = last ? nA : cA + (size_t)(t + 2) * kstep; const char* b2 = last ? nB : cB + (size_t)(t + 2) * kstep;
            const char* a3 = a2 + kstep; const char* b3 = b2 + kstep;
            i32x8 At[4], B0[2], B1[2];
            if constexpr (SP2) {
            GE_LDB(B0, 0, 0); GE_LDB(B1, 0, 1); SCHED(); GE_LDA(At, 0, 0); GE_STAGEA(GE_SA(1, 1), a1, 1);
            WAITV(8); WAITL(0); SBAR(); GE_MMA(0, 0, At, B0); GE_MMA(0, 1, At, B1); SBAR(); SCHED();
            if constexpr (P::GATHER) { if (last && has_next) {
#pragma unroll
                for (int i = 0; i < 2; ++i) { int R2, C2; stage_rc(tid * 16 + i * 8192, R2, C2);
#pragma unroll
                    for (int h = 0; h < 2; ++h) oA[h][i] = (unsigned)S.gather_row(nxt, h * HALF + R2) * (unsigned)(S.lda * P::ES) + (unsigned)(C2 * 2); } } }
            GE_LDA(At, 0, 1); GE_STAGEB(GE_SB(0, 0), b2); GE_STAGEB(GE_SB(0, 1), b2 + hstepB); GE_STAGEA(GE_SA(0, 0), a2, 0);
            WAITV(8); WAITL(0); SBAR(); GE_MMA(1, 0, At, B0); GE_MMA(1, 1, At, B1); SBAR(); SCHED();
            GE_LDB(B0, 1, 0); GE_LDB(B1, 1, 1); SCHED(); GE_LDA(At, 1, 0); GE_STAGEA(GE_SA(0, 1), a2, 1);
            WAITV(8); WAITL(0); SBAR(); GE_MMA(0, 0, At, B0); GE_MMA(0, 1, At, B1); SBAR(); SCHED();
            GE_LDA(At, 1, 1); GE_STAGEB(GE_SB(1, 0), b3); GE_STAGEB(GE_SB(1, 1), b3 + hstepB); GE_STAGEA(GE_SA(1, 0), a3, 0);
            WAITV(8); WAITL(0); SBAR(); GE_MMA(1, 0, At, B0); GE_MMA(1, 1, At, B1); SBAR(); SCHED();
            } else {
            GE_LDB(B0, 0, 0); SCHED(); GE_LDA(At, 0, 0); GE_STAGEA(GE_SA(1, 1), a1, 1);
            WAITL(8); SBAR(); WAITL(0); GE_MMA(0, 0, At, B0); SBAR(); SCHED();
            if constexpr (P::GATHER) { if (last && has_next) {
#pragma unroll
                for (int i = 0; i < 2; ++i) { int R2, C2; stage_rc(tid * 16 + i * 8192, R2, C2);
#pragma unroll
                    for (int h = 0; h < 2; ++h) oA[h][i] = (unsigned)S.gather_row(nxt, h * HALF + R2) * (unsigned)(S.lda * P::ES) + (unsigned)(C2 * 2); } } }
            GE_LDB(B1, 0, 1); GE_STAGEB(GE_SB(0, 0), b2);
            SBAR(); WAITL(0); GE_MMA(0, 1, At, B1); SBAR();
            GE_LDA(At, 0, 1); GE_STAGEA(GE_SA(0, 0), a2, 0);
            SBAR(); WAITL(0); GE_MMA(1, 0, At, B0); SBAR(); SCHED();
            GE_STAGEB(GE_SB(0, 1), b2 + hstepB);
            WAITV(6); SBAR(); GE_MMA(1, 1, At, B1); SBAR();
            GE_LDB(B0, 1, 0); SCHED(); GE_LDA(At, 1, 0); GE_STAGEA(GE_SA(0, 1), a2, 1);
            WAITL(8); SBAR(); WAITL(0); GE_MMA(0, 0, At, B0); SBAR(); SCHED();
            GE_LDB(B1, 1, 1); GE_STAGEB(GE_SB(1, 0), b3);
            SBAR(); WAITL(0); GE_MMA(0, 1, At, B1); SBAR();
            GE_LDA(At, 1, 1); GE_STAGEA(GE_SA(1, 0), a3, 0);
            SBAR(); WAITL(0); GE_MMA(1, 0, At, B0); SBAR(); SCHED();
            GE_STAGEB(GE_SB(1, 1), b3 + hstepB);
            WAITV(6); SBAR(); GE_MMA(1, 1, At, B1); SBAR();
            }
        }
        if (wr == 0) SBAR();
        S.epi(acc, cur, wr, wc, fr, fq);
        if (!has_next) break;
#pragma unroll
        for (int a = 0; a < 2; ++a)
#pragma unroll
            for (int b = 0; b < 2; ++b)
#pragma unroll
                for (int m = 0; m < 4; ++m)
#pragma unroll
                    for (int n = 0; n < 2; ++n) acc[a][b][m][n] = (f32x4){0.f, 0.f, 0.f, 0.f};
        cur = nxt; cA = nA; cB = nB; ++ui;
        if (wr == 1) SBAR();
    }
    WAITV(0);
    SBAR();
#undef GE_SA
#undef GE_SB
#undef GE_STAGEA
#undef GE_STAGEB
#undef GE_LDA
#undef GE_LDB
#undef GE_MMA
#undef GE_LO
#undef GE_HI
#undef GE_LD1
}
}
using ge::Unit;

struct Params {
    const float* in[26];
    float* out; unsigned char* ws;
    int ph_lo, ph_hi;
};
enum { I_X = 0, I_C, I_CTX, I_CCTX, I_ADAW, I_ADAB, I_NMIX, I_NFFN, I_POOLW, I_POOLS, I_INW, I_CONVW, I_CONVB, I_ALOG, I_DTB, I_DSKIP, I_SNORM, I_OUTW,
       I_W1, I_W3, I_W2, I_RW, I_MW1, I_MW3, I_MW2, I_FNORM };

struct Frame {
    LAS unsigned char* lds;
    int tid, lane, wave, G, bx;
    const Params* p;
    unsigned char* ws;
    unsigned* ctl;
    float* H; float* mod;
};
#ifdef EMU
DEV const float* INP(const Frame& F, int i) { return F.p->in[i]; }
DEV float* OUTP(const Frame& F) { return F.p->out; }
DEV unsigned char* WSP(const Frame& F) { return F.p->ws; }
#define LAUNDER_S(x) ((void)0)
#else
typedef const float* cfptr_t;
DEV const float* INP(const Frame&, int i) { int k = i; asm volatile("" : "+s"(k)); return ((const __attribute__((address_space(4))) cfptr_t*)__builtin_amdgcn_kernarg_segment_ptr())[k]; }
DEV float* OUTP(const Frame& F) { return (float*)INP(F, 26); }
DEV unsigned char* WSP(const Frame& F) { return (unsigned char*)INP(F, 27); }
#define LAUNDER_S(x) asm volatile("" : "+s"(x))
#endif
constexpr int LDS_MISC = ge::STAGE_BYTES;
constexpr int LDS_BYTES = ge::STAGE_BYTES + 16384;

struct Src { const float* x; const float* ctx; float* H; const float* mod; };
DEV const float* modq(const float* mod, int layer, int vec, int which) { return mod + ((size_t)(layer * 3 + vec) * 6 + which) * D; }
DEV const float* modp(const Frame& F, int layer, int vec, int which) { return modq(F.mod, layer, vec, which); }
DEV const float* hsrc_row(const Src& s, bool from_input, int r) {
    if (from_input) return r < ML ? s.x + (size_t)r * D : s.ctx + (size_t)(r - ML) * D;
    return s.H + (size_t)r * D;
}
DEV Src mksrc(const Frame& F) { Src s; s.x = INP(F, I_X); s.ctx = INP(F, I_CTX); s.H = F.H; s.mod = F.mod; return s; }
DEV const float* hin_row(const Frame& F, int layer, int r) { return hsrc_row(mksrc(F), layer == 0, r); }

template <int K, int N, class RM>
DEV void transpose_item(const float* Wsrc, bf16_t* WT, int ldt, RM rowmap, LAS float* scr, int item, int lane) {
    constexpr int nblk = N / 32; const int kb = item / nblk, nb = item % nblk, k0 = 64 * kb, n0 = 32 * nb;
    float tmp[32];
#pragma unroll
    for (int i = 0; i < 32; ++i) { const int kk = 2 * i + (lane >> 5); tmp[i] = Wsrc[(size_t)(k0 + kk) * N + n0 + (lane & 31)]; }
#pragma unroll
    for (int i = 0; i < 32; ++i) { const int kk = 2 * i + (lane >> 5); scr[kk * 33 + (lane & 31)] = tmp[i]; }
    WSYNC();
    const int c = lane & 7; const int row0 = rowmap(n0);
#pragma unroll
    for (int j = 0; j < 4; ++j) { const int n = (lane >> 3) + 8 * j; const LAS float* s = scr + (8 * c) * 33 + n;
        u32x4 o; o.x = pk2(s[0 * 33], s[1 * 33]); o.y = pk2(s[2 * 33], s[3 * 33]); o.z = pk2(s[4 * 33], s[5 * 33]); o.w = pk2(s[6 * 33], s[7 * 33]);
        *(u32x4*)(WT + (size_t)(row0 + n) * ldt + k0 + 8 * c) = o; }
    WSYNC();
}
template <int K, int N, class RM>
DEV void transpose_item_fp8(const float* Wsrc, fp8_t* WT, int ldt, RM rowmap, float scale, LAS float* scr, int item, int lane) {
    constexpr int nblk = N / 32; const int kb = item / nblk, nb = item % nblk, k0 = 64 * kb, n0 = 32 * nb;
    float tmp[32];
#pragma unroll
    for (int i = 0; i < 32; ++i) { const int kk = 2 * i + (lane >> 5); tmp[i] = Wsrc[(size_t)(k0 + kk) * N + n0 + (lane & 31)]; }
#pragma unroll
    for (int i = 0; i < 32; ++i) { const int kk = 2 * i + (lane >> 5); scr[kk * 33 + (lane & 31)] = tmp[i] * scale; }
    WSYNC();
    const int c = lane & 7; const int row0 = rowmap(n0);
#pragma unroll
    for (int j = 0; j < 4; ++j) { const int n = (lane >> 3) + 8 * j; const LAS float* s = scr + (8 * c) * 33 + n;
        u32x2 o; o.x = pk4_fp8(s[0 * 33], s[1 * 33], s[2 * 33], s[3 * 33]); o.y = pk4_fp8(s[4 * 33], s[5 * 33], s[6 * 33], s[7 * 33]);
        *(u32x2*)(WT + (size_t)(row0 + n) * ldt + k0 + 8 * c) = o; }
    WSYNC();
}
template <int K, int N, class RM>
DEV void convert_job_fp8(const Frame& F, const float* Wsrc, fp8_t* WT, int ldt, RM rm, float scale) {
    LAS float* scr = (LAS float*)(F.lds + F.wave * 16384);
    constexpr int items = (K / 64) * (N / 32); const int gw = F.bx * 8 + F.wave, NGW = F.G * 8;
    for (int it = gw; it < items; it += NGW) transpose_item_fp8<K, N>(Wsrc, WT, ldt, rm, scale, scr, it, F.lane);
}
struct RmId { DEV int operator()(int n0) const { return n0; } };
struct RmIlv { int s; DEV int operator()(int n0) const { return (n0 >> 7) * 256 + s * 128 + (n0 & 127); } };
template <int K, int N, class RM>
DEV void convert_job(const Frame& F, const float* Wsrc, bf16_t* WT, int ldt, RM rm) {
    LAS float* scr = (LAS float*)(F.lds + F.wave * 16384);
    constexpr int items = (K / 64) * (N / 32); const int gw = F.bx * 8 + F.wave, NGW = F.G * 8;
    for (int it = gw; it < items; it += NGW) transpose_item<K, N>(Wsrc, WT, ldt, rm, scr, it, F.lane);
}
DEV void convert_even(const Frame& F, int j) {
    bf16_t* Wb = (bf16_t*)(F.ws + OFF_W);
    for (int g = 0; g < 4; ++g) convert_job<256, 256>(F, INP(F, I_POOLW) + ((size_t)j * 4 + g) * 65536, Wb + W_POOL / 2 + (size_t)g * 65536, 256, RmId{});
    convert_job<D, DFF>(F, INP(F, I_W1) + (size_t)j * D * DFF, Wb + W_UP / 2, D, RmIlv{0});
    convert_job<D, DFF>(F, INP(F, I_W3) + (size_t)j * D * DFF, Wb + W_UP / 2, D, RmIlv{1});
    convert_job<DFF, D>(F, INP(F, I_W2) + (size_t)j * DFF * D, Wb + W_DN / 2, DFF, RmId{});
}
DEV void convert_ssd(const Frame& F, int j) {
    bf16_t* Wb = (bf16_t*)(F.ws + OFF_W);
    convert_job<D, NPROJ>(F, INP(F, I_INW) + (size_t)j * D * NPROJ, Wb + W_IN / 2, D, RmId{});
    convert_job<DIN, D>(F, INP(F, I_OUTW) + (size_t)j * DIN * D, Wb + W_OUT / 2, DIN, RmId{});
    { u32x4* z = (u32x4*)(Wb + W_IN / 2 + (size_t)NPROJ * D); const int n16 = (NPROJP - NPROJ) * D * 2 / 16;
      unsigned zz = 0u; LAUNDER_V(zz);
      for (int i = F.bx * 512 + F.tid; i < n16; i += F.G * 512) z[i] = (u32x4){zz, zz, zz, zz}; }
}
DEV void convert_moe(const Frame& F, int j) {
    fp8_t* Wb = (fp8_t*)(F.ws + OFF_W);
    for (int e = 0; e < NEXP; ++e) {
        convert_job_fp8<D, DFFE>(F, INP(F, I_MW1) + ((size_t)j * NEXP + e) * D * DFFE, Wb + W_MUP + (size_t)e * 2 * DFFE * D, D, RmIlv{0}, 32.0f);
        convert_job_fp8<D, DFFE>(F, INP(F, I_MW3) + ((size_t)j * NEXP + e) * D * DFFE, Wb + W_MUP + (size_t)e * 2 * DFFE * D, D, RmIlv{1}, 32.0f);
        if (MOE_DOWN_FP8) convert_job_fp8<DFFE, D>(F, INP(F, I_MW2) + ((size_t)j * NEXP + e) * DFFE * D, Wb + W_MDN + (size_t)e * D * DFFE, DFFE, RmId{}, 64.0f);
        else convert_job<DFFE, D>(F, INP(F, I_MW2) + ((size_t)j * NEXP + e) * DFFE * D, (bf16_t*)(Wb + W_MDN) + (size_t)e * D * DFFE, DFFE, RmId{});
    }
}

DEV void phase_mod(const Frame& F) {
    LAS float* red = (LAS float*)F.lds;
    const int nblk = DEPTH * 6144 / 64;
    const int col = F.tid & 63, ks = F.tid >> 6;
    for (int blk = F.bx; blk < nblk; blk += F.G) {
        const int layer = (blk * 64) / 6144, n = (blk * 64) % 6144 + col;
        const float* W = INP(F, I_ADAW) + (size_t)layer * D * 6144 + n;
        float a0 = 0.f, a1 = 0.f, a2 = 0.f;
#pragma unroll 8
        for (int k = ks * 128; k < ks * 128 + 128; ++k) { const float w = W[(size_t)k * 6144];
            a0 += siluf(INP(F, I_C)[k]) * w; a1 += siluf(INP(F, I_C)[D + k]) * w; a2 += siluf(INP(F, I_CCTX)[k]) * w; }
        red[(ks * 64 + col) * 3 + 0] = a0; red[(ks * 64 + col) * 3 + 1] = a1; red[(ks * 64 + col) * 3 + 2] = a2;
        __syncthreads();
        if (F.tid < 192) { const int c2 = F.tid % 64, v = F.tid / 64; float s = 0.f;
            for (int q = 0; q < 8; ++q) s += red[(q * 64 + c2) * 3 + v];
            const int n2 = (blk * 64) % 6144 + c2;
            F.mod[(size_t)(layer * 3 + v) * 6144 + n2] = s + INP(F, I_ADAB)[(size_t)layer * 6144 + n2]; }
        __syncthreads();
    }
}

DEV void load_row(const float* p, int lane, f32x4 (&v)[4]) {
#pragma unroll
    for (int j = 0; j < 4; ++j) v[j] = *(const f32x4*)(p + 4 * lane + 256 * j);
}
DEV float sumsq_row(const f32x4 (&v)[4]) { float s = 0.f;
#pragma unroll
    for (int j = 0; j < 4; ++j) s += (v[j][0] * v[j][0] + v[j][1] * v[j][1]) + (v[j][2] * v[j][2] + v[j][3] * v[j][3]);
    return wave_sum(s); }
DEV void normmod_row(f32x4 (&v)[4], float rstd, const float* w, const float* sh, const float* sc, int lane) {
#pragma unroll
    for (int j = 0; j < 4; ++j) { const int c = 4 * lane + 256 * j; const f32x4 wv = *(const f32x4*)(w + c), sv = *(const f32x4*)(sh + c), cv = *(const f32x4*)(sc + c);
        v[j] = v[j] * rstd * wv * (cv + 1.0f) + sv; }
}
DEV void store_row_bf16(bf16_t* o, int lane, const f32x4 (&v)[4]) {
#pragma unroll
    for (int j = 0; j < 4; ++j) { u32x2 w; w.x = pk2(v[j][0], v[j][1]); w.y = pk2(v[j][2], v[j][3]); *(u32x2*)(o + 4 * lane + 256 * j) = w; }
}

DEV void phase_norm(const Frame& F, int layer, int which, bf16_t* out, bool from_input) {
    const int gw = F.bx * 8 + F.wave, NGW = F.G * 8;
    const float* w = INP(F, which == 0 ? I_NMIX : I_NFFN) + (size_t)layer * D;
    for (int r = gw; r < MT; r += NGW) {
        f32x4 v[4]; load_row(hsrc_row(mksrc(F), from_input, r), F.lane, v);
        const float rstd = rsqrtf(sumsq_row(v) * (1.0f / D) + EPS);
        const int vec = vec_of(r);
        normmod_row(v, rstd, w, modp(F, layer, vec, which), modp(F, layer, vec, which + 1), F.lane);
        store_row_bf16(out + (size_t)r * D, F.lane, v);
    }
}

DEV void phase_poolprep(const Frame& F, int layer, bf16_t* P) {
    LAS float* rs = (LAS float*)(F.lds);
    const float* w = INP(F, I_NMIX) + (size_t)layer * D;
    const int ntile = MT / 64;
    for (int tile = F.bx; tile < ntile; tile += F.G) {
        const int r0 = tile * 64;
        int seq0, seq1;
        if (r0 < ML) { seq0 = r0; seq1 = r0 + 64; } else { seq0 = ML + ((r0 - ML) / CTXL) * CTXL; seq1 = seq0 + CTXL; }
        const int lo_r = (r0 - 8 > seq0) ? r0 - 8 : seq0, hi_r = (r0 + 64 + 7 < seq1) ? r0 + 64 + 7 : seq1;
        for (int r = lo_r + F.wave; r < hi_r; r += 8) { f32x4 v[4]; load_row(hin_row(F, layer, r), F.lane, v); const float ss = sumsq_row(v); if (F.lane == 0) rs[r - lo_r] = rsqrtf(ss * (1.0f / D) + EPS); }
        __syncthreads();
        const int vec = vec_of(r0);
        const int cq = F.tid & 255, half = F.tid >> 8, c = cq * 4, g = c >> 8, win = 2 << g, lo = win >> 1, hi = win - 1 - lo;
        const f32x4 wv = *(const f32x4*)(w + c), sv = *(const f32x4*)(modp(F, layer, vec, 0) + c), cv = *(const f32x4*)(modp(F, layer, vec, 1) + c) + 1.0f;
        const f32x4 wc = wv * cv;
        const int ta = r0 + 32 * half;
        auto uval = [&](int r) -> f32x4 { const f32x4 h = *(const f32x4*)(hin_row(F, layer, r) + c); return h * rs[r - lo_r] * wc + sv; };
        f32x4 s = (f32x4){0.f, 0.f, 0.f, 0.f};
        { const int a = (ta - lo > seq0) ? ta - lo : seq0, b = (ta + hi + 1 < seq1) ? ta + hi + 1 : seq1; for (int r = a; r < b; ++r) s += uval(r); }
        for (int t = ta; t < ta + 32; ++t) {
            const int a = (t - lo > seq0) ? t - lo : seq0, b = (t + hi + 1 < seq1) ? t + hi + 1 : seq1;
            const float inv = 1.0f / (float)(b - a);
            const f32x4 o = s * inv - uval(t);
            u32x2 pw; pw.x = pk2(o[0], o[1]); pw.y = pk2(o[2], o[3]); *(u32x2*)(P + (size_t)t * D + c) = pw;
            if (t + 1 < ta + 32) {
                if (t + 1 + hi < seq1) s += uval(t + 1 + hi);
                if (t - lo >= seq0) s -= uval(t - lo); }
        }
        __syncthreads();
    }
}

struct PolBase { int G, c; };
struct PolPool : PolBase {
    static constexpr bool PERM = false, GATHER = false; static constexpr bool FP8 = false; static constexpr int ES = 2; int K, lda, ldb;
    const bf16_t* P; const bf16_t* W; Src src; int layer; const float* scale;
    DEV bool next(int i, Unit& u) const { return ge::static_next(NPAN, 4, G, c, i, u); }
    DEV const char* a_base(const Unit& u) const { return (const char*)(P + (size_t)u.pm * 256 * D + u.pn * 256); }
    DEV const char* b_base(const Unit& u) const { return (const char*)(W + (size_t)u.pn * 65536); }
    DEV void epi(const f32x4 (&acc)[2][2][4][2], const Unit& u, int wr, int wc, int fr, int fq) const {
        const int row0 = u.pm * 256 + wr * 64 + fr, col0 = u.pn * 256 + wc * 32 + 4 * fq; const int vec = vec_of(u.pm * 256);
        const float* g1 = modq(src.mod, layer, vec, 2);
        f32x4 gv[2][2];
#pragma unroll
        for (int bj = 0; bj < 2; ++bj)
#pragma unroll
            for (int n = 0; n < 2; ++n) { const int cc = col0 + bj * 128 + n * 16; gv[bj][n] = *(const f32x4*)(g1 + cc) * *(const f32x4*)(scale + cc); }
#pragma unroll
        for (int ai = 0; ai < 2; ++ai)
#pragma unroll
            for (int m = 0; m < 4; ++m) { const int r = row0 + ai * 128 + m * 16; const float* hi = hsrc_row(src, layer == 0, r) + col0; float* ho = src.H + (size_t)r * D + col0;
#pragma unroll
                for (int bj = 0; bj < 2; ++bj)
#pragma unroll
                    for (int n = 0; n < 2; ++n) *(f32x4*)(ho + bj * 128 + n * 16) = *(const f32x4*)(hi + bj * 128 + n * 16) + gv[bj][n] * acc[ai][bj][m][n]; }
    }
};
struct PolResid : PolBase {
    static constexpr bool PERM = false, GATHER = false; static constexpr bool FP8 = false; static constexpr int ES = 2; int K, lda, ldb;
    const bf16_t* A; const bf16_t* W; Src src; int layer, which;
    DEV bool next(int i, Unit& u) const { return ge::static_next(NPAN, 4, G, c, i, u); }
    DEV const char* a_base(const Unit& u) const { return (const char*)(A + (size_t)u.pm * 256 * lda); }
    DEV const char* b_base(const Unit& u) const { return (const char*)(W + (size_t)u.pn * 256 * ldb); }
    DEV void epi(const f32x4 (&acc)[2][2][4][2], const Unit& u, int wr, int wc, int fr, int fq) const {
        const int row0 = u.pm * 256 + wr * 64 + fr, col0 = u.pn * 256 + wc * 32 + 4 * fq; const int vec = vec_of(u.pm * 256);
        const float* gp = modq(src.mod, layer, vec, which);
        f32x4 gv[2][2];
#pragma unroll
        for (int bj = 0; bj < 2; ++bj)
#pragma unroll
            for (int n = 0; n < 2; ++n) gv[bj][n] = *(const f32x4*)(gp + col0 + bj * 128 + n * 16);
#pragma unroll
        for (int ai = 0; ai < 2; ++ai)
#pragma unroll
            for (int m = 0; m < 4; ++m) { float* ho = src.H + (size_t)(row0 + ai * 128 + m * 16) * D + col0;
#pragma unroll
                for (int bj = 0; bj < 2; ++bj)
#pragma unroll
                    for (int n = 0; n < 2; ++n) { f32x4* q = (f32x4*)(ho + bj * 128 + n * 16); *q = *q + gv[bj][n] * acc[ai][bj][m][n]; } }
    }
};
template <bool MOE>
struct PolUp : PolBase {
    static constexpr bool PERM = true, GATHER = MOE, FP8 = MOE; static constexpr int ES = MOE ? 1 : 2; int K, lda, ldb;
    const bf16_t* A; const bf16_t* W; bf16_t* HID; int ldh, nq;
    int nM; const int* s2t; int tstart[NEXP + 1];
    DEV bool next(int i, Unit& u) const { return ge::static_next(MOE ? nM : NPAN, nq, G, c, i, u); }
    DEV int expert_of(int pm) const { int e = 0;
#pragma unroll
        for (int k = 1; k < NEXP; ++k) e += (pm >= tstart[k]) ? 1 : 0;
        return e; }
    DEV const char* a_base(const Unit& u) const { return MOE ? (const char*)A : (const char*)(A + (size_t)u.pm * 256 * lda); }
    DEV const char* b_base(const Unit& u) const { size_t off = (size_t)u.pn * 256 * ldb; if (MOE) off += (size_t)expert_of(u.pm) * 2 * DFFE * ldb; return (const char*)W + off * ES; }
    DEV int gather_row(const Unit& u, int R) const { return s2t[u.pm * 256 + R]; }
    DEV void epi(const f32x4 (&acc)[2][2][4][2], const Unit& u, int wr, int wc, int fr, int fq) const {
        const int row0 = u.pm * 256 + wr * 64 + fr, col0 = u.pn * 128 + wc * 32 + 8 * fq;
#pragma unroll
        for (int ai = 0; ai < 2; ++ai)
#pragma unroll
            for (int m = 0; m < 4; ++m) { bf16_t* o = HID + (size_t)(row0 + ai * 128 + m * 16) * ldh + col0;
                float h[8];
#pragma unroll
                for (int n = 0; n < 2; ++n)
#pragma unroll
                    for (int i = 0; i < 4; ++i) { if (MOE) h[4 * n + i] = siluf(acc[ai][0][m][n][i] * 0.00390625f) * (acc[ai][1][m][n][i] * (MOE_DOWN_FP8 ? 0.015625f : 0.00390625f));
                                                  else h[4 * n + i] = siluf(acc[ai][0][m][n][i]) * acc[ai][1][m][n][i]; }
                if (MOE && MOE_DOWN_FP8) { u32x2 w8; w8.x = pk4_fp8(h[0], h[1], h[2], h[3]); w8.y = pk4_fp8(h[4], h[5], h[6], h[7]);
                    *(u32x2*)((fp8_t*)HID + (size_t)(row0 + ai * 128 + m * 16) * ldh + col0) = w8; }
                else { u32x4 w; w.x = pk2(h[0], h[1]); w.y = pk2(h[2], h[3]); w.z = pk2(h[4], h[5]); w.w = pk2(h[6], h[7]); *(u32x4*)o = w; } }
    }
};
struct PolMoeDown : PolBase {
    static constexpr bool PERM = true, GATHER = false, FP8 = (MOE_DOWN_FP8 != 0); static constexpr int ES = MOE_DOWN_FP8 ? 1 : 2; int K, lda, ldb;
    const bf16_t* A; const bf16_t* W; bf16_t* YS; int nM; int tstart[NEXP + 1];
    DEV bool next(int i, Unit& u) const { return ge::static_next(nM, 4, G, c, i, u); }
    DEV int expert_of(int pm) const { int e = 0;
#pragma unroll
        for (int k = 1; k < NEXP; ++k) e += (pm >= tstart[k]) ? 1 : 0;
        return e; }
    DEV const char* a_base(const Unit& u) const { return (const char*)A + (size_t)u.pm * 256 * lda * ES; }
    DEV const char* b_base(const Unit& u) const { return (const char*)W + ((size_t)expert_of(u.pm) * D + (size_t)u.pn * 256) * ldb * ES; }
    DEV void epi(const f32x4 (&acc)[2][2][4][2], const Unit& u, int wr, int wc, int fr, int fq) const {
        const int row0 = u.pm * 256 + wr * 64 + fr, col0 = u.pn * 256 + wc * 32 + 8 * fq;
#pragma unroll
        for (int ai = 0; ai < 2; ++ai)
#pragma unroll
            for (int m = 0; m < 4; ++m) { bf16_t* o = YS + (size_t)(row0 + ai * 128 + m * 16) * D + col0;
#pragma unroll
                for (int bj = 0; bj < 2; ++bj) { u32x4 w; w.x = pk2(acc[ai][bj][m][0][0], acc[ai][bj][m][0][1]); w.y = pk2(acc[ai][bj][m][0][2], acc[ai][bj][m][0][3]);
                    w.z = pk2(acc[ai][bj][m][1][0], acc[ai][bj][m][1][1]); w.w = pk2(acc[ai][bj][m][1][2], acc[ai][bj][m][1][3]); *(u32x4*)(o + bj * 128) = w; } }
    }
};
struct PolInProj : PolBase {
    static constexpr bool PERM = true, GATHER = false; static constexpr bool FP8 = false; static constexpr int ES = 2; int K, lda, ldb;
    const bf16_t* A; const bf16_t* W; bf16_t* Z; bf16_t* XBC; float* DT;
    DEV bool next(int i, Unit& u) const { return ge::static_next(NPAN, NPROJP / 256, G, c, i, u); }
    DEV const char* a_base(const Unit& u) const { return (const char*)(A + (size_t)u.pm * 256 * lda); }
    DEV const char* b_base(const Unit& u) const { return (const char*)(W + (size_t)u.pn * 256 * ldb); }
    DEV void epi(const f32x4 (&acc)[2][2][4][2], const Unit& u, int wr, int wc, int fr, int fq) const {
        const int row0 = u.pm * 256 + wr * 64 + fr, cw = wc * 32 + 8 * fq;
        if (u.pn < 20) {
            bf16_t* base; int ld, col0;
            if (u.pn < 8) { base = Z; ld = DIN; col0 = u.pn * 256 + cw; } else { base = XBC; ld = CONVD; col0 = (u.pn - 8) * 256 + cw; }
#pragma unroll
            for (int ai = 0; ai < 2; ++ai)
#pragma unroll
                for (int m = 0; m < 4; ++m) { bf16_t* o = base + (size_t)(row0 + ai * 128 + m * 16) * ld + col0;
#pragma unroll
                    for (int bj = 0; bj < 2; ++bj) { u32x4 w; w.x = pk2(acc[ai][bj][m][0][0], acc[ai][bj][m][0][1]); w.y = pk2(acc[ai][bj][m][0][2], acc[ai][bj][m][0][3]);
                        w.z = pk2(acc[ai][bj][m][1][0], acc[ai][bj][m][1][1]); w.w = pk2(acc[ai][bj][m][1][2], acc[ai][bj][m][1][3]); *(u32x4*)(o + bj * 128) = w; } }
        } else if (cw < 64) {
#pragma unroll
            for (int ai = 0; ai < 2; ++ai)
#pragma unroll
                for (int m = 0; m < 4; ++m) { const int r = row0 + ai * 128 + m * 16; int b, tv;
                    if (r < ML) { b = r / SEQ; tv = CTXL + r % SEQ; } else { b = (r - ML) / CTXL; tv = (r - ML) % CTXL; }
#pragma unroll
                    for (int n = 0; n < 2; ++n)
#pragma unroll
                        for (int i = 0; i < 4; ++i) { const int j = cw + 4 * n + i, dir = j >> 5, h = j & 31;
                            DT[((size_t)(b * 2 + dir) * NH + h) * TV + tv] = acc[ai][0][m][n][i]; } }
        }
    }
};

DEV void phase_conv(const Frame& F, int j, const bf16_t* XBC, bf16_t* XT, bf16_t* Brow, bf16_t* BT, bf16_t* Crow) {
    LAS bf16_t* tl0 = (LAS bf16_t*)F.lds;
    const float* cw = INP(F, I_CONVW) + (size_t)j * 4 * CONVD; const float* cb = INP(F, I_CONVB) + (size_t)j * CONVD;
    constexpr int NPER = NB * NCH, nitem = NPER * (CONVD / 64);
    const int t2 = 2 * (F.tid >> 3), cg = F.tid & 7;
    const int i0 = (int)(((long)F.bx * nitem) / F.G), i1 = (int)(((long)(F.bx + 1) * nitem) / F.G);
    int cblk_cur = -1; f32x4 wv[4][2], bv[2]; int par = 0;
    for (int it = i0; it < i1; ++it) {
        const int cblk = it / NPER, rest = it % NPER, b = rest / NCH, cv = rest % NCH;
        const int ch0 = cblk * 64 + cg * 8;
        if (cblk != cblk_cur) { cblk_cur = cblk;
#pragma unroll
            for (int k = 0; k < 4; ++k) { wv[k][0] = *(const f32x4*)(cw + k * CONVD + ch0); wv[k][1] = *(const f32x4*)(cw + k * CONVD + ch0 + 4); }
            bv[0] = *(const f32x4*)(cb + ch0); bv[1] = *(const f32x4*)(cb + ch0 + 4); }
        const int tv = cv * 128 + t2;
        const int seg0 = tv < CTXL ? 0 : CTXL, seg1 = tv < CTXL ? CTXL : TV;
        float xin[5][8];
#pragma unroll
        for (int k = 0; k < 5; ++k) { const int tk = tv - 2 + k; u32x4 q = (u32x4){0u, 0u, 0u, 0u};
            if (tk >= seg0 && tk < seg1) q = *(const u32x4*)(XBC + (size_t)row_of(b, tk) * CONVD + ch0);
            xin[k][0] = bflo(q.x); xin[k][1] = bfhi(q.x); xin[k][2] = bflo(q.y); xin[k][3] = bfhi(q.y); xin[k][4] = bflo(q.z); xin[k][5] = bfhi(q.z); xin[k][6] = bflo(q.w); xin[k][7] = bfhi(q.w); }
        unsigned pk[2][4];
#pragma unroll
        for (int o = 0; o < 2; ++o) { float a[8];
#pragma unroll
            for (int i = 0; i < 8; ++i) { float acc = bv[i >> 2][i & 3];
#pragma unroll
                for (int k = 0; k < 4; ++k) acc += wv[k][i >> 2][i & 3] * xin[o + k][i];
                a[i] = siluf(acc); }
#pragma unroll
            for (int i = 0; i < 4; ++i) pk[o][i] = pk2(a[2 * i], a[2 * i + 1]); }
        const int r = row_of(b, tv);
        const bool isx = cblk < DIN / 64, isb = !isx && cblk < (DIN + BCD) / 64;
        if (!isx) { bf16_t* o = (isb ? Brow + (ch0 - DIN) : Crow + (ch0 - DIN - BCD)) + (size_t)r * BCD;
            *(u32x4*)o = (u32x4){pk[0][0], pk[0][1], pk[0][2], pk[0][3]}; *(u32x4*)(o + BCD) = (u32x4){pk[1][0], pk[1][1], pk[1][2], pk[1][3]}; }
        if (isx || isb) {
            LAS bf16_t* tl = tl0 + par * (64 * 136); par ^= 1;
#pragma unroll
            for (int i = 0; i < 4; ++i) { const unsigned lo = (pk[0][i] & 0xffffu) | (pk[1][i] << 16), hi = (pk[0][i] >> 16) | (pk[1][i] & 0xffff0000u);
                *(LAS unsigned*)(tl + (cg * 8 + 2 * i) * 136 + t2) = lo; *(LAS unsigned*)(tl + (cg * 8 + 2 * i + 1) * 136 + t2) = hi; }
            __syncthreads();
            bf16_t* dst = isx ? XT + ((size_t)b * DIN + cblk * 64) * TV : BT + ((size_t)b * BCD + (cblk * 64 - DIN)) * TV;
#pragma unroll
            for (int q = 0; q < 2; ++q) { const int idx = F.tid + q * 512, ch = idx >> 4, t8 = (idx & 15) * 8;
                *(u32x4*)(dst + (size_t)ch * TV + cv * 128 + t8) = *(const LAS u32x4*)(tl + ch * 136 + t8); }
        }
    }
}

DEV void phase_cb(const Frame& F, const bf16_t* Brow, const bf16_t* Crow, bf16_t* CB) {
    const int nitem = NB * NG * NCH; const int fr = F.lane & 15, fq = F.lane >> 4;
    for (int it = F.bx; it < nitem; it += F.G) {
        const int cv = it % NCH, g = (it / NCH) % NG, b = it / (NCH * NG);
        const int rbase = row_of(b, cv * 128);
        bf16x8 cf[4];
#pragma unroll
        for (int ks = 0; ks < 4; ++ks) cf[ks] = *(const bf16x8*)(Crow + (size_t)(rbase + 16 * F.wave + fr) * BCD + g * 128 + 32 * ks + 8 * fq);
        bf16_t* out = CB + ((size_t)((b * NG + g) * NCH + cv)) * 16384;
#pragma unroll
        for (int nt = 0; nt < 8; ++nt) {
            f32x4 acc = (f32x4){0.f, 0.f, 0.f, 0.f};
#pragma unroll
            for (int ks = 0; ks < 4; ++ks) { const bf16x8 bfr = *(const bf16x8*)(Brow + (size_t)(rbase + 16 * nt + fr) * BCD + g * 128 + 32 * ks + 8 * fq); acc = MFMA16(bfr, cf[ks], acc); }
            u32x2 w; w.x = pk2(acc[0], acc[1]); w.y = pk2(acc[2], acc[3]);
            *(u32x2*)(out + (size_t)(16 * F.wave + fr) * 128 + 16 * nt + 4 * fq) = w;
        }
    }
}

DEV void phase_tables(const Frame& F, int j, float* DT, float* CUM, float* WJ) {
    const int nitem = NB * 2 * NH * NCH; const int gw = F.bx * 8 + F.wave, NGW = F.G * 8;
    for (int it = gw; it < nitem; it += NGW) {
        const int cv = it % NCH, h = (it / NCH) % NH, dir = (it / (NCH * NH)) & 1, b = it / (NCH * NH * 2);
        const float A = -expf(INP(F, I_ALOG)[(size_t)(j * 2 + dir) * NH + h]); const float bias = INP(F, I_DTB)[(size_t)(j * 2 + dir) * NH + h];
        const size_t o = ((size_t)(b * 2 + dir) * NH + h) * TV + cv * 128 + 2 * F.lane;
        const f32x2 raw = *(const f32x2*)(DT + o); const float d0 = softplusf(raw.x + bias), d1 = softplusf(raw.y + bias); const float a0 = d0 * A, a1 = d1 * A;
        float c0, c1, tot, sum = a0 + a1;
        if (dir == 0) {
#pragma unroll
            for (int q = 1; q < 64; q <<= 1) { const float t2 = __shfl_up(sum, q); if (F.lane >= q) sum += t2; }
            c1 = sum; c0 = sum - a1; tot = __shfl(sum, 63);
        } else {
#pragma unroll
            for (int q = 1; q < 64; q <<= 1) { const float t2 = __shfl_down(sum, q); if (F.lane + q < 64) sum += t2; }
            c0 = sum; c1 = sum - a0; tot = __shfl(sum, 0);
        }
        constexpr float L2E = 1.4426950408889634f;
        *(f32x2*)(DT + o) = (f32x2){c0 * L2E - flog2(d0), c1 * L2E - flog2(d1)};
        *(f32x2*)(CUM + o) = (f32x2){c0 * L2E, c1 * L2E};
        *(f32x2*)(WJ + o) = (f32x2){d0 * FEXP(tot - c0), d1 * FEXP(tot - c1)};
    }
}

constexpr int SC_HL = 0, SC_TAB = 17408, SC_CB = 20480, SC_BT = SC_CB + 32768, SC_C = SC_BT + 32768, SC_X = SC_C + 32768, SC_END = SC_X + 8192;
static_assert(SC_END <= ge::STAGE_BYTES, "scan LDS map");
DEV void phase_scan(const Frame& F, int j, const bf16_t* XT, const bf16_t* BT, const bf16_t* Crow, const bf16_t* CB, const float* DT, const float* CUM, const float* WJ, bf16_t* Yf, bf16_t* Yb) {
    LAS unsigned char* L = F.lds;
    LAS bf16_t* Hl = (LAS bf16_t*)(L + SC_HL);
    LAS float* tab = (LAS float*)(L + SC_TAB);
    const int fr = F.lane & 15, fq = F.lane >> 4, w = F.wave;
    const int nitem = NB * NH * 2 * 2;
    for (int it = F.bx; it < nitem; it += F.G) {
        const int xq = it & 7, kq = it >> 3; const int b = xq >> 2, g = xq & 3, h = 8 * g + (kq >> 2), dir = (kq >> 1) & 1, ph = kq & 1;
        const float Dsk = dir == 0 ? INP(F, I_DSKIP)[(size_t)j * NH + h] : 0.f;
        const size_t tbase = ((size_t)(b * 2 + dir) * NH + h) * TV;
        const bf16_t* xt = XT + ((size_t)b * DIN + h * HD + ph * 32) * TV;
        const bf16_t* bt = BT + ((size_t)b * BCD + g * 128) * TV;
        const bf16_t* CBh = CB + (size_t)((b * NG + g) * NCH) * 16384;
        const bf16_t* Cg = Crow + g * 128;
        bf16_t* Y = (dir ? Yb : Yf) + h * HD + ph * 32;
        const int lrow = 16 * w + fr;
        const int dr = F.lane >> 4, dc = F.lane & 15;
        f32x4 accH[2]; accH[0] = (f32x4){0.f, 0.f, 0.f, 0.f}; accH[1] = accH[0];
        for (int i = F.tid; i < 32 * 136 / 2; i += 512) ((LAS unsigned*)Hl)[i] = 0u;
#define SC_CHUNK_OF(step) (dir == 0 ? (step) : ((step) < 2 ? 1 - (step) : (NCH - 1) - ((step) - 2)))
        const int rsw = (4 * (w & 3) + dr) & 15, gc = dc ^ rsw;
        const unsigned loCB = (unsigned)(dr * 128 + 8 * gc) * 2u, loT = (unsigned)(dr * TV + 8 * gc) * 2u, loC = (unsigned)(dr * BCD + 8 * gc) * 2u;
#define SC_ISSUE_TILES(cvx_) do { const int cvx = (cvx_); const unsigned tvx = cvx * 128u; const unsigned rbx = (unsigned)row_of(b, cvx * 128); \
            _Pragma("unroll") for (int jj = 0; jj < 13; ++jj) { const int q = 8 * jj + w, r0 = 4 * (q & 31);   \
                const char* src; int toff; \
                if (jj < 4) { src = (const char*)(CBh + ((size_t)cvx * 16384u + (unsigned)r0 * 128u)) + loCB; toff = SC_CB; } \
                else if (jj < 8) { src = (const char*)(bt + ((size_t)r0 * TV + tvx)) + loT; toff = SC_BT; } \
                else if (jj < 12) { src = (const char*)(Cg + (size_t)(rbx + r0) * BCD) + loC; toff = SC_C; } \
                else { src = (const char*)(xt + ((size_t)r0 * TV + tvx)) + loT; toff = SC_X; } \
                GLDS16(src, L + toff + (q & 31) * 1024); } } while (0)
        const int kd = w >> 1; float km[8], dk[8];
#pragma unroll
        for (int i = 0; i < 8; ++i) { const int sidx = 32 * kd + 8 * fq + i; km[i] = (dir == 0 ? (sidx <= lrow) : (sidx >= lrow)) ? 1.f : 0.f; dk[i] = (sidx == lrow) ? Dsk : 0.f; }
#define SC_ISSUE_TAB(cvx_, tbuf_) do { if (w < 6) { const int tsel = w >> 1, half = w & 1; const float* tsrc = tsel == 0 ? CUM : (tsel == 1 ? DT : WJ); \
            GLDS4(tsrc + tbase + (cvx_) * 128 + half * 64 + F.lane, (LAS unsigned char*)(tab + (tbuf_) * 384 + tsel * 128 + half * 64)); } } while (0)
        { const int cv0 = SC_CHUNK_OF(0); SC_ISSUE_TILES(cv0); SC_ISSUE_TAB(cv0, 0); }
        for (int step = 0; step < NCH; ++step) {
            const int cv = SC_CHUNK_OF(step), buf = step & 1; const bool more = step + 1 < NCH;
            const int cvn = more ? SC_CHUNK_OF(step + 1) : cv;
            const unsigned rbase = (unsigned)row_of(b, cv * 128);
            if (step == 0) WAITV(0); else WAITV(2);
            LDSBAR();
            u32x4 rcb[4], rbt[4]; bf16x8 xf[2][4], cf[4];
#pragma unroll
            for (int ks = 0; ks < 4; ++ks) { const int fo = lrow * 256 + (((4 * ks + fq) ^ fr) << 4);
                rcb[ks] = *(const LAS u32x4*)(L + SC_CB + fo); rbt[ks] = *(const LAS u32x4*)(L + SC_BT + fo); cf[ks] = *(const LAS bf16x8*)(L + SC_C + fo);
#pragma unroll
                for (int nt = 0; nt < 2; ++nt) xf[nt][ks] = *(const LAS bf16x8*)(L + SC_X + (16 * nt + fr) * 256 + (((4 * ks + fq) ^ fr) << 4)); }
            LDSBAR();
            if (more) { SC_ISSUE_TILES(cvn); SC_ISSUE_TAB(cvn, buf ^ 1); }
            const LAS float* tb = tab + buf * 384;
            const float cl2 = tb[lrow]; const float ecum_l = fexp2(cl2);
            const float chunk_decay = fexp2(dir == 0 ? tb[127] : tb[0]);
            bf16x8 mf[4], bw[4];
#pragma unroll
            for (int ks = 0; ks < 4; ++ks) { const int s0 = 32 * ks + 8 * fq;
                const bool none = dir == 0 ? (ks > kd) : (ks < kd), diag = (ks == kd);
                unsigned om[4] = {0u, 0u, 0u, 0u};
                if (!none) {
                    const f32x4 cs0 = *(const LAS f32x4*)(tb + 128 + s0), cs1 = *(const LAS f32x4*)(tb + 128 + s0 + 4);
                    const float cs[8] = {cs0[0], cs0[1], cs0[2], cs0[3], cs1[0], cs1[1], cs1[2], cs1[3]};
                    const unsigned qc[4] = {rcb[ks].x, rcb[ks].y, rcb[ks].z, rcb[ks].w};
                    float v[8];
                    if (!diag) {
#pragma unroll
                        for (int i = 0; i < 8; ++i) { const float cbv = (i & 1) ? bfhi(qc[i >> 1]) : bflo(qc[i >> 1]); v[i] = cbv * fexp2(cl2 - cs[i]); }
                    } else {
#pragma unroll
                        for (int i = 0; i < 8; ++i) { const float cbv = (i & 1) ? bfhi(qc[i >> 1]) : bflo(qc[i >> 1]); const float x = cl2 - cs[i]; v[i] = (cbv * fexp2(x < 60.f ? x : 60.f)) * km[i] + dk[i]; }
                    }
#pragma unroll
                    for (int i = 0; i < 4; ++i) om[i] = pk2(v[2 * i], v[2 * i + 1]);
                }
                mf[ks] = __builtin_bit_cast(bf16x8, (u32x4){om[0], om[1], om[2], om[3]});
                { const f32x4 ws0 = *(const LAS f32x4*)(tb + 256 + s0), ws1 = *(const LAS f32x4*)(tb + 256 + s0 + 4); const float wsv[8] = {ws0[0], ws0[1], ws0[2], ws0[3], ws1[0], ws1[1], ws1[2], ws1[3]};
                  const unsigned qb[4] = {rbt[ks].x, rbt[ks].y, rbt[ks].z, rbt[ks].w}; unsigned ob[4];
#pragma unroll
                  for (int i = 0; i < 4; ++i) ob[i] = pk2(bflo(qb[i]) * wsv[2 * i], bfhi(qb[i]) * wsv[2 * i + 1]);
                  bw[ks] = __builtin_bit_cast(bf16x8, (u32x4){ob[0], ob[1], ob[2], ob[3]}); } }
            f32x4 yd[2], yo[2];
#pragma unroll
            for (int nt = 0; nt < 2; ++nt) { yd[nt] = (f32x4){0.f, 0.f, 0.f, 0.f}; yo[nt] = yd[nt]; accH[nt] = accH[nt] * chunk_decay; }
#pragma unroll
            for (int nt = 0; nt < 2; ++nt)
#pragma unroll
                for (int ks = 0; ks < 4; ++ks) {
                    yd[nt] = MFMA16(xf[nt][ks], mf[ks], yd[nt]);
                    const bf16x8 hf = *(const LAS bf16x8*)(Hl + buf * (32 * 136) + (16 * nt + fr) * 136 + 32 * ks + 8 * fq);
                    yo[nt] = MFMA16(hf, cf[ks], yo[nt]);
                    accH[nt] = MFMA16(bw[ks], xf[nt][ks], accH[nt]); }
#pragma unroll
            for (int nt = 0; nt < 2; ++nt) { u32x2 hw; hw.x = pk2(accH[nt][0], accH[nt][1]); hw.y = pk2(accH[nt][2], accH[nt][3]);
                *(LAS u32x2*)(Hl + (buf ^ 1) * (32 * 136) + (16 * nt + fr) * 136 + 16 * w + 4 * fq) = hw; }
#pragma unroll
            for (int nt = 0; nt < 2; ++nt) { u32x2 yw; yw.x = pk2(yd[nt][0] + ecum_l * yo[nt][0], yd[nt][1] + ecum_l * yo[nt][1]); yw.y = pk2(yd[nt][2] + ecum_l * yo[nt][2], yd[nt][3] + ecum_l * yo[nt][3]);
                *(u32x2*)(Y + ((size_t)(rbase + lrow) * DIN + 16 * nt + 4 * fq)) = yw; }
        }
        WAITV(0); LDSBAR();
    }
}

DEV void phase_gate(const Frame& F, int j, const bf16_t* Yf, const bf16_t* Yb, const bf16_t* Z, bf16_t* YN) {
    const int gw = F.bx * 8 + F.wave, NGW = F.G * 8; const float* nw = INP(F, I_SNORM) + (size_t)j * DIN;
    for (int r = gw; r < MT; r += NGW) {
        float t[32]; float ss = 0.f;
#pragma unroll
        for (int q = 0; q < 4; ++q) { const size_t o = (size_t)r * DIN + 8 * F.lane + 512 * q; const u32x4 a = *(const u32x4*)(Yf + o), bq = *(const u32x4*)(Yb + o), z = *(const u32x4*)(Z + o);
            const unsigned aa[4] = {a.x, a.y, a.z, a.w}, bb[4] = {bq.x, bq.y, bq.z, bq.w}, zz[4] = {z.x, z.y, z.z, z.w};
#pragma unroll
            for (int i = 0; i < 4; ++i) { const float v0 = (bflo(aa[i]) + bflo(bb[i])) * siluf(bflo(zz[i])), v1 = (bfhi(aa[i]) + bfhi(bb[i])) * siluf(bfhi(zz[i])); t[8 * q + 2 * i] = v0; t[8 * q + 2 * i + 1] = v1; ss += v0 * v0 + v1 * v1; } }
        const float rstd = rsqrtf(wave_sum(ss) * (1.0f / DIN) + EPS);
#pragma unroll
        for (int q = 0; q < 4; ++q) { const int c = 8 * F.lane + 512 * q; const f32x4 w0 = *(const f32x4*)(nw + c), w1 = *(const f32x4*)(nw + c + 4);
            u32x4 o; o.x = pk2(t[8 * q] * rstd * w0[0], t[8 * q + 1] * rstd * w0[1]); o.y = pk2(t[8 * q + 2] * rstd * w0[2], t[8 * q + 3] * rstd * w0[3]);
            o.z = pk2(t[8 * q + 4] * rstd * w1[0], t[8 * q + 5] * rstd * w1[1]); o.w = pk2(t[8 * q + 6] * rstd * w1[2], t[8 * q + 7] * rstd * w1[3]);
            *(u32x4*)(YN + (size_t)r * DIN + c) = o; }
    }
}

struct TokInfo { int s0, s1; float g0, g1; };
DEV void phase_route(const Frame& F, int layer, int ml, bf16_t* V) {
    LAS unsigned* lc = (LAS unsigned*)(F.lds + LDS_MISC + 256);
    if (F.tid < 8) lc[F.tid] = 0u;
    __syncthreads();
    const int gw = F.bx * 8 + F.wave, NGW = F.G * 8; const int j = layer / 2;
    const float* w = INP(F, I_NFFN) + (size_t)layer * D; const float* rw = INP(F, I_RW) + (size_t)j * D * NEXP;
    LAS float* rwl = (LAS float*)F.lds;
    for (int q = F.tid; q < D * 2; q += 512) { const int c = q >> 1, hf = q & 1; const int ln = (c & 255) >> 2, ii = c & 3, jq = c >> 8;
        *(LAS f32x4*)(rwl + ((jq * 4 + ii) * 64 + ln) * 8 + hf * 4) = *(const f32x4*)(rw + (size_t)q * 4); }
    __syncthreads();
    TokInfo* tok = (TokInfo*)(F.ws + OFF_TOK);
    for (int r = gw; r < MT; r += NGW) {
        f32x4 v[4]; load_row(F.H + (size_t)r * D, F.lane, v);
        const float rstd = rsqrtf(sumsq_row(v) * (1.0f / D) + EPS);
        const int vec = vec_of(r);
        normmod_row(v, rstd, w, modp(F, layer, vec, 3), modp(F, layer, vec, 4), F.lane);
#pragma unroll
        for (int jq = 0; jq < 4; ++jq) *(unsigned*)((fp8_t*)V + (size_t)r * D + 4 * F.lane + 256 * jq) = pk4_fp8(v[jq][0] * 8.0f, v[jq][1] * 8.0f, v[jq][2] * 8.0f, v[jq][3] * 8.0f);
        float lg[NEXP];
#pragma unroll
        for (int e = 0; e < NEXP; ++e) lg[e] = 0.f;
#pragma unroll
        for (int jj = 0; jj < 4; ++jj)
#pragma unroll
            for (int i = 0; i < 4; ++i) { const LAS float* rp = rwl + ((jj * 4 + i) * 64 + F.lane) * 8; const f32x4 r0 = *(const LAS f32x4*)rp, r1 = *(const LAS f32x4*)(rp + 4);
#pragma unroll
                for (int e = 0; e < 4; ++e) { lg[e] += v[jj][i] * r0[e]; lg[4 + e] += v[jj][i] * r1[e]; } }
#pragma unroll
        for (int e = 0; e < NEXP; ++e) lg[e] = wave_sum(lg[e]);
        int e0 = 0; float v0 = lg[0];
#pragma unroll
        for (int e = 1; e < NEXP; ++e) if (lg[e] > v0) { v0 = lg[e]; e0 = e; }
        int e1 = -1; float v1 = -3.0e38f;
#pragma unroll
        for (int e = 0; e < NEXP; ++e) if (e != e0 && lg[e] > v1) { v1 = lg[e]; e1 = e; }
        const float g1 = frcp(1.0f + FEXP(v0 - v1)), g0 = 1.0f - g1;
        if (F.lane == 0) { TokInfo ti; ti.s0 = e0; ti.s1 = e1; ti.g0 = g0; ti.g1 = g1; tok[r] = ti; atomicAdd((unsigned*)&lc[e0], 1u); atomicAdd((unsigned*)&lc[e1], 1u); }
    }
    __syncthreads();
    if (F.tid < 8) __hip_atomic_fetch_add(F.ctl + CW_CNT + (ml * 8 + F.tid) * 64, lc[F.tid], RLX_AGENT);
}
DEV void tile_starts(const Frame& F, int ml, int (&ts)[NEXP + 1], unsigned (&cnt)[NEXP]) {
    ts[0] = 0;
#pragma unroll
    for (int e = 0; e < NEXP; ++e) { cnt[e] = __hip_atomic_load(F.ctl + CW_CNT + (ml * 8 + e) * 64, RLX_AGENT); ts[e + 1] = ts[e] + (int)((cnt[e] + 255u) / 256u); }
}
DEV void phase_slots(const Frame& F, int ml) {
    int ts[NEXP + 1]; unsigned cnt[NEXP]; tile_starts(F, ml, ts, cnt);
    TokInfo* tok = (TokInfo*)(F.ws + OFF_TOK); int* s2t = (int*)(F.ws + OFF_S2T);
    const int gw = F.bx * 8 + F.wave, NGW = F.G * 8;
    for (int base = gw * 64; base < MT; base += NGW * 64) {
        const int r = base + F.lane; TokInfo ti = tok[r];
        const int ek[2] = {ti.s0, ti.s1}; int sl[2];
#pragma unroll
        for (int k = 0; k < 2; ++k) { sl[k] = 0;
            for (int e = 0; e < NEXP; ++e) { const unsigned long long m = __ballot(ek[k] == e);
                if (m) { const int leader = __builtin_ctzll(m); unsigned b0 = 0;
                    if (F.lane == leader) b0 = __hip_atomic_fetch_add(F.ctl + CW_CUR + (ml * 8 + e) * 64, (unsigned)__builtin_popcountll(m), RLX_AGENT);
                    b0 = __shfl(b0, leader);
                    if (ek[k] == e) sl[k] = ts[e] * 256 + (int)b0 + __builtin_popcountll(m & ((1ull << F.lane) - 1ull)); } } }
        ti.s0 = sl[0]; ti.s1 = sl[1]; tok[r] = ti; s2t[sl[0]] = r; s2t[sl[1]] = r;
    }
    if (F.bx == 0) { for (int e = 0; e < NEXP; ++e) { const int a = ts[e] * 256 + (int)cnt[e], b2 = ts[e + 1] * 256; for (int s = a + F.tid; s < b2; s += 512) s2t[s] = 0; } }
}
DEV void phase_combine(const Frame& F, int layer, const bf16_t* YS, bool final_) {
    const int gw = F.bx * 8 + F.wave, NGW = F.G * 8; const TokInfo* tok = (const TokInfo*)(F.ws + OFF_TOK);
    const int nrows = final_ ? ML : MT;
    for (int r = gw; r < nrows; r += NGW) {
        f32x4 v[4]; load_row(F.H + (size_t)r * D, F.lane, v);
        TokInfo ti = tok[r]; if (MOE_DOWN_FP8) { ti.g0 *= 0.00390625f; ti.g1 *= 0.00390625f; }
        const float* g2 = modp(F, layer, vec_of(r), 5);
#pragma unroll
        for (int jj = 0; jj < 4; ++jj) { const int c = 4 * F.lane + 256 * jj; const u32x2 a = *(const u32x2*)(YS + (size_t)ti.s0 * D + c), b = *(const u32x2*)(YS + (size_t)ti.s1 * D + c); const f32x4 gv = *(const f32x4*)(g2 + c);
            v[jj][0] += gv[0] * (ti.g0 * bflo(a.x) + ti.g1 * bflo(b.x)); v[jj][1] += gv[1] * (ti.g0 * bfhi(a.x) + ti.g1 * bfhi(b.x));
            v[jj][2] += gv[2] * (ti.g0 * bflo(a.y) + ti.g1 * bflo(b.y)); v[jj][3] += gv[3] * (ti.g0 * bfhi(a.y) + ti.g1 * bfhi(b.y)); }
        if (!final_) {
#pragma unroll
            for (int jj = 0; jj < 4; ++jj) *(f32x4*)(F.H + (size_t)r * D + 4 * F.lane + 256 * jj) = v[jj];
        } else {
            const float rstd = rsqrtf(sumsq_row(v) * (1.0f / D) + EPS); const float* fw = INP(F, I_FNORM);
#pragma unroll
            for (int jj = 0; jj < 4; ++jj) { const int c = 4 * F.lane + 256 * jj; *(f32x4*)(OUTP(F) + (size_t)r * D + c) = v[jj] * rstd * *(const f32x4*)(fw + c); }
        }
    }
}

constexpr int PH_PER_PAIR = 17, N_PHASES = 1 + 2 * PH_PER_PAIR;
__global__ void __launch_bounds__(512, 2) fwd_kernel(Params prm) {
#ifdef EMU
    unsigned char* lds_raw = emu_lds();
#else
    extern __shared__ __attribute__((aligned(16))) unsigned char lds_raw[];
#endif
    Frame F;
    F.lds = (LAS unsigned char*)lds_raw;
    F.tid = threadIdx.x; F.lane = F.tid & 63; F.wave = RFL(F.tid >> 6); F.G = gridDim.x; F.bx = blockIdx.x;
    F.p = &prm; F.ws = prm.ws; F.ctl = (unsigned*)(prm.ws + OFF_CTL); F.H = (float*)(prm.ws + OFF_H); F.mod = (float*)(prm.ws + OFF_MOD);
    volatile LAS unsigned* misc = (volatile LAS unsigned*)(F.lds + LDS_MISC);
    if (F.tid < 64) misc[F.tid] = 0u;
    __syncthreads();
    XcdBarrier bar; bar.bar = F.ctl + CW_BAR; bar.x = 0; bar.st = misc;
    const int lo = prm.ph_lo, hi = prm.ph_hi;
    if (hi - lo > 1) bar = xcd_barrier_post(F.ctl + CW_BAR, misc);
    int ph = 0;
#ifndef SITE_MASK
#define SITE_MASK 0xFFFFFFFFu
#endif
#ifndef PROBE_REPEAT_SITE
#define PROBE_REPEAT_SITE (-1)
#endif
#define PH_REPS(site) ((PROBE_REPEAT_SITE == (site)) ? 2 : 1)
#define PHASE_BEGIN(site) if (((SITE_MASK >> (site)) & 1u) && lo <= ph && ph < hi) { { int _t = threadIdx.x; LAUNDER_V(_t); F.tid = _t; F.lane = _t & 63; int _b = blockIdx.x; LAUNDER_S(_b); F.bx = _b; int _g = gridDim.x; LAUNDER_S(_g); F.G = _g; \
      F.ws = WSP(F); F.ctl = (unsigned*)(F.ws + OFF_CTL); F.H = (float*)(F.ws + OFF_H); F.mod = (float*)(F.ws + OFF_MOD); } \
      for (int _rep = 0; _rep < PH_REPS(site); ++_rep) { if (_rep) __syncthreads();
#define PHASE_END   } if (ph + 1 < hi) xcd_barrier(bar); } ++ph;
#define B_W (F.ws + OFF_W)
#define B_ACT (F.ws + OFF_ACT)
#define B_P ((bf16_t*)(B_ACT + A_P))
#define B_HID ((bf16_t*)(B_ACT + A_HID))
#define B_U ((bf16_t*)(B_ACT + A_U))
#define B_Z ((bf16_t*)(B_ACT + A_Z))
#define B_XBC ((bf16_t*)(B_ACT + A_XBC))
#define B_DT ((float*)(B_W + W_DT))
#define B_XT ((bf16_t*)(B_ACT + A_XT))
#define B_BROW ((bf16_t*)(B_ACT + A_BROW))
#define B_BT ((bf16_t*)(B_ACT + A_BT))
#define B_CROW ((bf16_t*)(B_ACT + A_CROW))
#define B_CB ((bf16_t*)(B_ACT + A_CB))
#define B_CUM ((float*)(B_ACT + A_CUM))
#define B_WJ ((float*)(B_ACT + A_WJ))
#define B_YF ((bf16_t*)(B_ACT + A_YF))
#define B_YB ((bf16_t*)(B_W + W_YB))
#define B_YN ((bf16_t*)(B_ACT + A_YN))
#define B_V ((bf16_t*)(B_ACT + A_V))
#define B_HIDM ((bf16_t*)(B_ACT + A_HIDM))
#define B_YS ((bf16_t*)(B_ACT + A_YS))

    PHASE_BEGIN(0) phase_mod(F); convert_even(F, 0); PHASE_END

    for (int lp = 0; lp < 2; ++lp) {
        const int le = 2 * lp, lod = 2 * lp + 1;
        PHASE_BEGIN(1) phase_poolprep(F, le, B_P); PHASE_END
        PHASE_BEGIN(2) { PolPool S; S.G = F.G; S.c = F.bx; S.K = 256; S.lda = D; S.ldb = 256; S.P = B_P; S.W = (const bf16_t*)(B_W + W_POOL); S.src = mksrc(F); S.layer = le; S.scale = INP(F, I_POOLS) + (size_t)lp * D;
                      ge::gemm_phase(F.lds, S, F.tid); } PHASE_END
        PHASE_BEGIN(3) phase_norm(F, le, 3, B_P, false); PHASE_END
        PHASE_BEGIN(4) { PolUp<false> S; S.G = F.G; S.c = F.bx; S.K = D; S.lda = D; S.ldb = D; S.A = B_P; S.W = (const bf16_t*)(B_W + W_UP); S.HID = B_HID; S.ldh = DFF; S.nq = DFF / 128; S.nM = NPAN; S.s2t = nullptr;
                      ge::gemm_phase(F.lds, S, F.tid); } PHASE_END
        PHASE_BEGIN(5) { PolResid S; S.G = F.G; S.c = F.bx; S.K = DFF; S.lda = DFF; S.ldb = DFF; S.A = B_HID; S.W = (const bf16_t*)(B_W + W_DN); S.src = mksrc(F); S.layer = le; S.which = 5;
                      ge::gemm_phase(F.lds, S, F.tid); } PHASE_END
        PHASE_BEGIN(6) phase_norm(F, lod, 0, B_U, false); convert_ssd(F, lp); PHASE_END
        PHASE_BEGIN(7) { PolInProj S; S.G = F.G; S.c = F.bx; S.K = D; S.lda = D; S.ldb = D; S.A = B_U; S.W = (const bf16_t*)(B_W + W_IN); S.Z = B_Z; S.XBC = B_XBC; S.DT = B_DT;
                      ge::gemm_phase(F.lds, S, F.tid); } PHASE_END
        PHASE_BEGIN(8) phase_conv(F, lp, B_XBC, B_XT, B_BROW, B_BT, B_CROW); PHASE_END
        PHASE_BEGIN(9) phase_cb(F, B_BROW, B_CROW, B_CB); phase_tables(F, lp, B_DT, B_CUM, B_WJ); PHASE_END
        PHASE_BEGIN(10) phase_scan(F, lp, B_XT, B_BT, B_CROW, B_CB, B_DT, B_CUM, B_WJ, B_YF, B_YB); PHASE_END
        PHASE_BEGIN(11) phase_gate(F, lp, B_YF, B_YB, B_Z, B_YN); PHASE_END
        PHASE_BEGIN(12) { PolResid S; S.G = F.G; S.c = F.bx; S.K = DIN; S.lda = DIN; S.ldb = DIN; S.A = B_YN; S.W = (const bf16_t*)(B_W + W_OUT); S.src = mksrc(F); S.layer = lod; S.which = 2;
                      ge::gemm_phase(F.lds, S, F.tid); } PHASE_END
        PHASE_BEGIN(13) phase_route(F, lod, lp, B_V); convert_moe(F, lp); PHASE_END
        PHASE_BEGIN(14) phase_slots(F, lp); PHASE_END
        PHASE_BEGIN(15) { int ts[NEXP + 1]; unsigned cnt[NEXP]; tile_starts(F, lp, ts, cnt);
                      PolUp<true> S; S.G = F.G; S.c = F.bx; S.K = D; S.lda = D; S.ldb = D; S.A = B_V; S.W = (const bf16_t*)(B_W + W_MUP); S.HID = B_HIDM; S.ldh = DFFE; S.nq = DFFE / 128; S.nM = ts[NEXP];
                      S.s2t = (const int*)(F.ws + OFF_S2T);
#pragma unroll
                      for (int e = 0; e <= NEXP; ++e) S.tstart[e] = ts[e];
                      ge::gemm_phase(F.lds, S, F.tid); } PHASE_END
        PHASE_BEGIN(16) { int ts[NEXP + 1]; unsigned cnt[NEXP]; tile_starts(F, lp, ts, cnt);
                      PolMoeDown S; S.G = F.G; S.c = F.bx; S.K = DFFE; S.lda = DFFE; S.ldb = DFFE; S.A = B_HIDM; S.W = (const bf16_t*)(B_W + W_MDN); S.YS = B_YS; S.nM = ts[NEXP];
#pragma unroll
                      for (int e = 0; e <= NEXP; ++e) S.tstart[e] = ts[e];
                      ge::gemm_phase(F.lds, S, F.tid); } PHASE_END
        PHASE_BEGIN(17) phase_combine(F, lod, B_YS, lp == 1); if (lp == 0) convert_even(F, 1); PHASE_END
    }
#undef PHASE_BEGIN
#undef PHASE_END
}

extern "C" void kernel_launch(void* const* d_in, const int* in_sizes, int n_in, void* d_out, int out_size, void* d_ws, size_t ws_size, hipStream_t stream) {
    static int grid = 0;
    if (grid == 0) {
        if (n_in != 26 || ws_size < WS_NEED) { fprintf(stderr, "kernel_launch: need 26 inputs and %zu bytes of workspace (got %d, %zu)\n", (size_t)WS_NEED, n_in, ws_size); grid = -1; return; }
        int dev = 0, cus = 0, per_cu = 0;
        if (hipGetDevice(&dev) != hipSuccess || hipDeviceGetAttribute(&cus, hipDeviceAttributeMultiprocessorCount, dev) != hipSuccess) { grid = -1; return; }
        if (hipFuncSetAttribute((const void*)fwd_kernel, hipFuncAttributeMaxDynamicSharedMemorySize, LDS_BYTES) != hipSuccess) { grid = -1; return; }
        if (hipOccupancyMaxActiveBlocksPerMultiprocessor(&per_cu, (const void*)fwd_kernel, 512, LDS_BYTES) != hipSuccess || per_cu < 1) { fprintf(stderr, "kernel_launch: occupancy query says %d\n", per_cu); }
        (void)hipGetLastError();
        grid = cus;
    }
    if (grid < 0) return;
    (void)in_sizes; (void)out_size;
    if (hipMemsetAsync((char*)d_ws + OFF_CTL, 0, CTL_BYTES, stream) != hipSuccess) return;
    Params p{};
    for (int i = 0; i < 26; ++i) p.in[i] = (const float*)d_in[i];
    p.out = (float*)d_out; p.ws = (unsigned char*)d_ws;
    if (N_LAUNCH_MODE == 1) { p.ph_lo = 0; p.ph_hi = N_PHASES; hipLaunchKernelGGL(fwd_kernel, dim3(grid), dim3(512), LDS_BYTES, stream, p); }
    else for (int ph = 0; ph < N_PHASES; ++ph) { p.ph_lo = ph; p.ph_hi = ph + 1; hipLaunchKernelGGL(fwd_kernel, dim3(grid), dim3(512), LDS_BYTES, stream, p); }
}
```

```cpp
#ifndef EMU
#include <hip/hip_runtime.h>
#endif
#include <cstdio>
#include <cstdint>

#ifndef CFG_SEQ
#define CFG_SEQ 16384
#endif
#ifndef CFG_DFF
#define CFG_DFF 2816
#endif
#ifndef CFG_DFFE
#define CFG_DFFE 3584
#endif
#ifndef MOE_DOWN_FP8
#define MOE_DOWN_FP8 1
#endif
#ifndef N_LAUNCH_MODE
#define N_LAUNCH_MODE 1
#endif

#ifdef EMU
#define LAS
#define DEV inline
#define WAITV(n) ((void)0)
#define WAITL(n) ((void)0)
#define SBAR() emu_wg_sync()
#define SCHED() ((void)0)
#define SETPRIO(x) ((void)0)
#define MFMA16(a, b, c) emu_mfma16(a, b, c)
#define GLDS16(g, l) emu_glds16((const void*)(g), (void*)(l))
#define GLDS4(g, l) emu_glds4((const void*)(g), (void*)(l))
#define MFMA8(a, b, c) emu_mfma8(a, b, c)
#define RFL(x) emu_rfl(x)
#define MEMFENCE() ((void)0)
#define WSYNC() emu_wave_sync()
#define LDSBAR() emu_wg_sync()
#define LAUNDER_V(x) ((void)0)
#define SLEEP1() emu_yield()
#define MY_XCC_ID() ((unsigned)(blockIdx.x & 7u))
#define FENCE_REL() __atomic_thread_fence(__ATOMIC_SEQ_CST)
#define FENCE_ACQ() __atomic_thread_fence(__ATOMIC_SEQ_CST)
#define FEXP(x) expf(x)
#define RLX_AGENT __ATOMIC_RELAXED, 4
#else
#define LAS __attribute__((address_space(3)))
#define DEV __device__ __forceinline__
#define WAITV(n) asm volatile("s_waitcnt vmcnt(" #n ")" ::: "memory")
#define WAITL(n) asm volatile("s_waitcnt lgkmcnt(" #n ")" ::: "memory")
#define SBAR() __builtin_amdgcn_s_barrier()
#define SCHED() __builtin_amdgcn_sched_barrier(0)
#define SETPRIO(x) __builtin_amdgcn_s_setprio(x)
#define MFMA16(a, b, c) __builtin_amdgcn_mfma_f32_16x16x32_bf16(a, b, c, 0, 0, 0)
#define GLDS16(g, l) __builtin_amdgcn_global_load_lds((const unsigned*)(g), (LAS unsigned*)(l), 16, 0, 0)
#define GLDS4(g, l) __builtin_amdgcn_global_load_lds((const unsigned*)(g), (LAS unsigned*)(l), 4, 0, 0)
#define MFMA8(a, b, c) __builtin_amdgcn_mfma_scale_f32_16x16x128_f8f6f4(a, b, c, 0, 0, 0, 0x7f7f7f7f, 0, 0x7f7f7f7f)
#define RFL(x) __builtin_amdgcn_readfirstlane(x)
#define MEMFENCE() asm volatile("" ::: "memory")
#define LDSBAR() do { asm volatile("s_waitcnt lgkmcnt(0)" ::: "memory"); __builtin_amdgcn_s_barrier(); asm volatile("" ::: "memory"); } while (0)
#define WSYNC() asm volatile("s_waitcnt lgkmcnt(0)" ::: "memory")
#define SLEEP1() __builtin_amdgcn_s_sleep(1)
#define MY_XCC_ID() ((unsigned)__builtin_amdgcn_s_getreg((3 << 11) | 20) & 0xFu)
#define FENCE_REL() __builtin_amdgcn_fence(__ATOMIC_RELEASE, "agent")
#define FENCE_ACQ() __builtin_amdgcn_fence(__ATOMIC_ACQUIRE, "agent")
#define FEXP(x) __expf(x)
#define RLX_AGENT __ATOMIC_RELAXED, __HIP_MEMORY_SCOPE_AGENT
#define LAUNDER_V(x) asm volatile("" : "+v"(x))
#endif

typedef unsigned short bf16_t;
typedef short bf16x8 __attribute__((ext_vector_type(8)));
typedef float f32x4 __attribute__((ext_vector_type(4)));
typedef float f32x2 __attribute__((ext_vector_type(2)));
typedef unsigned u32x4 __attribute__((ext_vector_type(4)));
typedef unsigned u32x2 __attribute__((ext_vector_type(2)));
typedef int i32x8 __attribute__((ext_vector_type(8)));
typedef int i32x4 __attribute__((ext_vector_type(4)));
typedef unsigned char fp8_t;

constexpr int D = 1024, NB = 2, SEQ = CFG_SEQ, CTXL = 256, DEPTH = 4;
constexpr int ML = NB * SEQ, MC = NB * CTXL, MT = ML + MC, NPAN = MT / 256;
constexpr int DFF = CFG_DFF, DFFE = CFG_DFFE, NEXP = 8;
constexpr int DIN = 2048, NH = 32, HD = 64, NG = 4, DS = 128, CONVD = 3072, NPROJ = 5184, NPROJP = 5376, BCD = 512;
constexpr int TV = CTXL + SEQ, NCH = TV / 128;
constexpr int GRIDW = 64;
constexpr float EPS = 1e-6f;
constexpr int NSLOT_TILES = (2 * MT) / 256 + NEXP, NSLOT = NSLOT_TILES * 256;
static_assert(SEQ % 128 == 0 && ML % 256 == 0 && DFF % 128 == 0 && DFFE % 128 == 0 && DFF >= 256 && DFFE >= 256, "shape constraints");

constexpr size_t MiB = 1u << 20;
constexpr size_t al(size_t x) { return (x + 4095) & ~(size_t)4095; }
constexpr size_t OFF_CTL = 0, CTL_BYTES = 1 * MiB;
constexpr size_t OFF_MOD = 1 * MiB;
constexpr size_t OFF_TOK = 2 * MiB;
constexpr size_t OFF_S2T = 3 * MiB;
constexpr size_t OFF_H = 4 * MiB, SZ_H = (size_t)MT * D * 4;
constexpr size_t OFF_W = OFF_H + al(SZ_H);
constexpr size_t W_POOL = 0, SZ_WPOOL = (size_t)4 * 256 * 256 * 2;
constexpr size_t W_UP = al(SZ_WPOOL), SZ_WUP = (size_t)2 * DFF * D * 2;
constexpr size_t W_DN = W_UP + al(SZ_WUP), SZ_WDN = (size_t)D * DFF * 2;
constexpr size_t SZ_WEVEN = W_DN + al(SZ_WDN);
constexpr size_t W_IN = 0, SZ_WIN = (size_t)NPROJP * D * 2;
constexpr size_t W_OUT = al(SZ_WIN), SZ_WOUT = (size_t)D * DIN * 2;
constexpr size_t W_DT = W_OUT + al(SZ_WOUT), SZ_DT = (size_t)NB * 2 * NH * TV * 4;
constexpr size_t W_MUP = W_DT + al(SZ_DT), SZ_WMUP = (size_t)NEXP * 2 * DFFE * D * 2;
constexpr size_t W_MDN = W_MUP + al(SZ_WMUP), SZ_WMDN = (size_t)NEXP * D * DFFE * 2;
constexpr size_t W_YB = W_MUP, SZ_Y = (size_t)MT * DIN * 2;
constexpr size_t SZ_WODD_A = W_MDN + al(SZ_WMDN), SZ_WODD_B = W_YB + al(SZ_Y);
constexpr size_t mx(size_t a, size_t b) { return a > b ? a : b; }
constexpr size_t SZ_W = mx(SZ_WEVEN, mx(SZ_WODD_A, SZ_WODD_B));
constexpr size_t OFF_ACT = OFF_W + SZ_W;
constexpr size_t A_P = 0, SZ_ACT1 = (size_t)MT * D * 2;
constexpr size_t A_HID = al(SZ_ACT1), SZ_HID = (size_t)MT * DFF * 2;
constexpr size_t SZ_AEVEN = A_HID + al(SZ_HID);
constexpr size_t A_Z = 0;
constexpr size_t A_XBC = al(SZ_Y), SZ_XBC = (size_t)MT * CONVD * 2;
constexpr size_t A_YF = A_XBC;
constexpr size_t A_CB = A_XBC + al(SZ_Y), SZ_CB = (size_t)NB * NG * NCH * 128 * 128 * 2;
static_assert(al(SZ_Y) + SZ_CB <= SZ_XBC, "CB fits behind Yf inside the XBC region");
constexpr size_t A_XT = A_XBC + al(SZ_XBC), SZ_XT = (size_t)NB * DIN * TV * 2;
constexpr size_t A_U = A_XT, A_YN = A_XT;
constexpr size_t A_BROW = A_XT + al(SZ_XT), SZ_BC = (size_t)MT * BCD * 2;
constexpr size_t A_BT = A_BROW + al(SZ_BC);
constexpr size_t A_CROW = A_BT + al(SZ_BC);
constexpr size_t A_CUM = A_CROW + al(SZ_BC);
constexpr size_t A_WJ = A_CUM + al(SZ_DT);
constexpr size_t SZ_ASSD = A_WJ + al(SZ_DT);
constexpr size_t A_V = 0;
constexpr size_t A_HIDM = al(SZ_ACT1), SZ_HIDM = (size_t)NSLOT * DFFE * 2;
constexpr size_t A_YS = A_HIDM + al(SZ_HIDM), SZ_YS = (size_t)NSLOT * D * 2;
constexpr size_t SZ_AMOE = A_YS + al(SZ_YS);
constexpr size_t SZ_ACT = mx(SZ_AEVEN, mx(SZ_ASSD, SZ_AMOE));
constexpr size_t WS_NEED = OFF_ACT + SZ_ACT;

constexpr int CW_BAR = 4096;
constexpr int CW_CNT = 16384;
constexpr int CW_CUR = 16384 + 2 * 8 * 64;

DEV unsigned f2bf(float f) { unsigned u = __builtin_bit_cast(unsigned, f); return (u + 0x7fffu + ((u >> 16) & 1u)) >> 16; }
#ifndef EMU
typedef __bf16 bf16x2n __attribute__((ext_vector_type(2)));
#endif
DEV unsigned pk2(float lo, float hi) {
#ifdef EMU
    return f2bf(lo) | (f2bf(hi) << 16);
#else
    f32x2 v = {lo, hi}; bf16x2n b = __builtin_convertvector(v, bf16x2n); return __builtin_bit_cast(unsigned, b);
#endif
}
DEV unsigned pk4_fp8(float a, float b, float c, float d) {
#ifdef EMU
    return emu_f2fp8(a) | (emu_f2fp8(b) << 8) | (emu_f2fp8(c) << 16) | (emu_f2fp8(d) << 24);
#else
    unsigned w = 0; w = __builtin_amdgcn_cvt_pk_fp8_f32(a, b, w, false); w = __builtin_amdgcn_cvt_pk_fp8_f32(c, d, w, true); return w;
#endif
}
DEV float bf2f(unsigned b) { return __builtin_bit_cast(float, b << 16); }
DEV float bflo(unsigned w) { return __builtin_bit_cast(float, w << 16); }
DEV float bfhi(unsigned w) { return __builtin_bit_cast(float, w & 0xffff0000u); }
#ifdef EMU
DEV float frcp(float x) { return 1.0f / x; }
#else
DEV float frcp(float x) { return __builtin_amdgcn_rcpf(x); }
#endif
#ifdef EMU
DEV float fexp2(float x) { return exp2f(x); }
#else
DEV float fexp2(float x) { return __builtin_amdgcn_exp2f(x); }
#endif
DEV float siluf(float x) { return x * frcp(1.0f + FEXP(-x)); }
#ifdef EMU
DEV float flog2(float x) { return log2f(x); }
#else
DEV float flog2(float x) { return __builtin_amdgcn_logf(x); }
#endif
DEV float softplusf(float x) { if (x > 20.f) return x; const float e = FEXP(x); return e < 0.0625f ? e * (1.0f - e * (0.5f - e * (0.33333334f - e * (0.25f - e * 0.2f)))) : flog2(1.0f + e) * 0.6931471806f; }
DEV float wave_sum(float v) {
#pragma unroll
    for (int o = 1; o < 64; o <<= 1) v += __shfl_xor(v, o);
    return v;
}
DEV int vec_of(int r) { return r < ML ? (r / SEQ) : 2; }
DEV int row_of(int b, int tv) { return tv < CTXL ? ML + b * CTXL + tv : b * SEQ + (tv - CTXL); }

#define XB_TMO      128
#define XB_XCNT(j)  (256  + 64 * (j))
#define XB_XSUB(j)  (1280 + 64 * (j))
#define XB_XGEN(j)  (2304 + 64 * (j))
#define XB_TOP      3328
#define XB_TOPGEN   3392
#define XCD_BAR_WORDS 3456
#define XB_SPIN_CAP (1u << 22)
DEV unsigned xb_ld(unsigned* p)              { return __hip_atomic_load(p, RLX_AGENT); }
DEV unsigned xb_add(unsigned* p, unsigned v) { return __hip_atomic_fetch_add(p, v, RLX_AGENT); }
#define XB_SPIN(cond, bar) do { unsigned _sp = 0; while (cond) { SLEEP1(); \
    if ((++_sp & 255u) == 0u) { if (xb_ld(&(bar)[XB_TMO])) break; if (_sp > XB_SPIN_CAP) { atomicAdd(&(bar)[XB_TMO], 1u); break; } } } } while (0)
struct XcdBarrier { unsigned* bar; unsigned x; volatile LAS unsigned* st; };
DEV XcdBarrier xcd_barrier_post(unsigned* bar, volatile LAS unsigned* st) {
    XcdBarrier b; b.bar = bar; b.x = MY_XCC_ID(); b.st = st;
    if (threadIdx.x == 0) (void)xb_add(&bar[XB_XCNT(b.x)], 1u);
    return b;
}
DEV void xcd_barrier_complete(unsigned* bar, unsigned x, unsigned& nloc, unsigned& nx) {
    const unsigned G = gridDim.x;
    unsigned sum, cnt, mine, sp = 0u;
    for (;;) {
        sum = 0u; cnt = 0u; mine = 0u;
#pragma unroll
        for (unsigned j = 0; j < 16; ++j) { const unsigned c = xb_ld(&bar[XB_XCNT(j)]); sum += c; cnt += (c > 0u) ? 1u : 0u; mine = (j == x) ? c : mine; }
        if (sum == G) break;
        SLEEP1();
        if ((++sp & 255u) == 0u) { if (xb_ld(&bar[XB_TMO])) break; if (sp > XB_SPIN_CAP) { atomicAdd(&bar[XB_TMO], 1u); break; } }
    }
    nloc = mine > 0u ? mine : 1u; nx = cnt > 0u ? cnt : 1u;
}
DEV void xcd_barrier(const XcdBarrier& b) {
    WAITV(0);
    __syncthreads();
    if (threadIdx.x == 0) {
        unsigned* bar = b.bar;
#ifndef EMU
        __builtin_amdgcn_s_waitcnt(0);
#endif
        unsigned nloc = b.st[0], nx = b.st[1];
        if (nloc == 0u) { xcd_barrier_complete(bar, b.x, nloc, nx); b.st[0] = nloc; b.st[1] = nx; }
        const unsigned old = xb_add(&bar[XB_XSUB(b.x)], 1u);
        const unsigned gen = old / nloc;
        if (old + 1u == (gen + 1u) * nloc) {
            FENCE_REL();
            WAITV(0);
            const unsigned og = xb_add(&bar[XB_TOP], 1u);
            const unsigned tg = og / nx;
            if (og + 1u == (tg + 1u) * nx) xb_add(&bar[XB_TOPGEN], 1u);
            else XB_SPIN(xb_ld(&bar[XB_TOPGEN]) == tg, bar);
            FENCE_ACQ();
            xb_add(&bar[XB_XGEN(b.x)], 1u);
            WAITV(0);
        } else {
            XB_SPIN(xb_ld(&bar[XB_XGEN(b.x)]) == gen, bar);
            FENCE_ACQ();
            WAITV(0);
        }
    }
    __syncthreads();
}

namespace ge {
constexpr int BM = 256, BK = 64, HALF = 128, HTB = HALF * BK * 2, STAGE_BYTES = 8 * HTB, NXCD = 8, WGM = 8;
DEV int lds_byte(int r, int c) { const int st = (r >> 4) * 2 + (c >> 5), rr = r & 15, cc = c & 31, ob = rr * 64 + cc * 2; return st * 1024 + (ob ^ (((ob >> 9) & 1) << 5)); }
DEV void stage_rc(int b, int& R, int& C) { const int st = b / 1024, sb = b % 1024, swz = sb ^ (((sb >> 9) & 1) << 5); R = (st >> 1) * 16 + swz / 64; C = (st & 1) * 32 + (swz % 64) / 2; }
DEV int perm32(int rho) { const int n = rho >> 4, i = rho & 15; return 8 * (i >> 2) + 4 * n + (i & 3); }
struct Unit { int pm, pn; };
DEV bool static_next(int nM, int nN, int G, int c, int i, Unit& u) {
    const int nwg = nM * nN; const long L = (long)i * G + c; if (L >= nwg) return false;
    int wgid = (int)L; { const int q = nwg / NXCD, r = nwg % NXCD, xcd = wgid % NXCD, off = wgid / NXCD; wgid = (xcd < r ? xcd * (q + 1) : r * (q + 1) + (xcd - r) * q) + off; }
    const int nig = WGM * nN, gid = wgid / nig, fm = gid * WGM, gsz = (nM - fm) < WGM ? (nM - fm) : WGM;
    u.pm = fm + ((wgid % nig) % gsz); u.pn = (wgid % nig) / gsz; return true;
}
template <class P, bool SP2 = true>
DEV void gemm_phase(LAS unsigned char* lds, const P& S, const int tid) {
    const int wid = RFL(tid >> 6), lane = tid & 63, wr = wid >> 2, wc = wid & 3, fr = lane & 15, fq = lane >> 4;
    const int K = S.K, nt = K * P::ES / (BK * 2);
    unsigned voffB[2]; int RA[2], CA2[2];
#pragma unroll
    for (int i = 0; i < 2; ++i) { int R, C; stage_rc(tid * 16 + i * 8192, R, C); const int Rb = P::PERM ? ((R & ~31) + perm32(R & 31)) : R;
        RA[i] = R; CA2[i] = C * 2; voffB[i] = (unsigned)(Rb * S.ldb) * (unsigned)P::ES + (unsigned)(C * 2); }
    const size_t kstep = (size_t)(BK * 2);
    const size_t hstepB = (size_t)HALF * S.ldb * P::ES;
    const unsigned ldsw = (unsigned)wid * 1024u;
    const int aoff = lds_byte(wr * 64 + fr, fq * 8), boff = lds_byte(wc * 32 + fr, fq * 8);
#define GE_SA(b, h) (((b) * 2 + (h)) * HTB)
#define GE_SB(b, h) ((4 + (b) * 2 + (h)) * HTB)
#define GE_STAGEB(bufoff, gbase) do { _Pragma("unroll") for (int _i = 0; _i < 2; ++_i) { unsigned _o = voffB[_i]; LAUNDER_V(_o); \
        GLDS16((const char*)(gbase) + _o, lds + (bufoff) + ldsw + _i * 8192); } } while (0)
#define GE_STAGEA(bufoff, gbase, h) do { _Pragma("unroll") for (int _i = 0; _i < 2; ++_i) { unsigned _o = oA[h][_i]; LAUNDER_V(_o); \
        GLDS16((const char*)(gbase) + _o, lds + (bufoff) + ldsw + _i * 8192); } } while (0)
#define GE_LD1(p_) __builtin_shufflevector(*(const LAS i32x4*)(p_), *(const LAS i32x4*)((p_) + 1024), 0, 1, 2, 3, 4, 5, 6, 7)
#define GE_LDA(dst, b, h) do { _Pragma("unroll") for (int m = 0; m < 4; ++m) dst[m] = GE_LD1(lds + GE_SA(b, h) + aoff + m * 2048); } while (0)
#define GE_LDB(dst, b, h) do { _Pragma("unroll") for (int n = 0; n < 2; ++n) dst[n] = GE_LD1(lds + GE_SB(b, h) + boff + n * 2048); } while (0)
#define GE_LO(x) __builtin_bit_cast(bf16x8, __builtin_shufflevector(x, x, 0, 1, 2, 3))
#define GE_HI(x) __builtin_bit_cast(bf16x8, __builtin_shufflevector(x, x, 4, 5, 6, 7))
#define GE_MMA(ai, bj, At, Bt) do { SETPRIO(1); _Pragma("unroll") for (int m = 0; m < 4; ++m) _Pragma("unroll") for (int n = 0; n < 2; ++n) { \
        if constexpr (P::FP8) acc[ai][bj][m][n] = MFMA8(Bt[n], At[m], acc[ai][bj][m][n]);     \
        else { acc[ai][bj][m][n] = MFMA16(GE_LO(Bt[n]), GE_LO(At[m]), acc[ai][bj][m][n]); acc[ai][bj][m][n] = MFMA16(GE_HI(Bt[n]), GE_HI(At[m]), acc[ai][bj][m][n]); } } SETPRIO(0); } while (0)
    Unit cur, nxt; int ui = 0;
    if (!S.next(0, cur)) return;
    f32x4 acc[2][2][4][2];
#pragma unroll
    for (int a = 0; a < 2; ++a)
#pragma unroll
        for (int b = 0; b < 2; ++b)
#pragma unroll
            for (int m = 0; m < 4; ++m)
#pragma unroll
                for (int n = 0; n < 2; ++n) acc[a][b][m][n] = (f32x4){0.f, 0.f, 0.f, 0.f};
    unsigned oA[2][2];
#pragma unroll
    for (int h = 0; h < 2; ++h)
#pragma unroll
        for (int i = 0; i < 2; ++i) {
            if constexpr (P::GATHER) oA[h][i] = (unsigned)S.gather_row(cur, h * HALF + RA[i]) * (unsigned)(S.lda * P::ES) + (unsigned)CA2[i];
            else oA[h][i] = (unsigned)((h * HALF + RA[i]) * S.lda) * (unsigned)P::ES + (unsigned)CA2[i];
            }
    const char* cA = S.a_base(cur); const char* cB = S.b_base(cur);
    if constexpr (SP2) {
        GE_STAGEB(GE_SB(0, 0), cB); GE_STAGEB(GE_SB(0, 1), cB + hstepB); GE_STAGEA(GE_SA(0, 0), cA, 0); GE_STAGEA(GE_SA(0, 1), cA, 1);
        if (wr == 1) SBAR();
        WAITV(2); SBAR();
        GE_STAGEB(GE_SB(1, 0), cB + kstep); GE_STAGEA(GE_SA(1, 0), cA + kstep, 0); GE_STAGEB(GE_SB(1, 1), cB + hstepB + kstep);
        WAITV(6); SBAR();
    } else {
    GE_STAGEB(GE_SB(0, 0), cB); GE_STAGEA(GE_SA(0, 0), cA, 0); GE_STAGEB(GE_SB(0, 1), cB + hstepB); GE_STAGEA(GE_SA(0, 1), cA, 1);
    if (wr == 1) SBAR();
    WAITV(4); SBAR();
    GE_STAGEB(GE_SB(1, 0), cB + kstep); GE_STAGEA(GE_SA(1, 0), cA + kstep, 0); GE_STAGEB(GE_SB(1, 1), cB + hstepB + kstep);
    WAITV(6); SBAR();
    }
    for (;;) {
        const bool has_next = S.next(ui + 1, nxt);
        const char* nA = has_next ? S.a_base(nxt) : cA; const char* nB = has_next ? S.b_base(nxt) : cB;
        for (int t = 0; t < nt; t += 2) {
            const bool last = (t == nt - 2);
            const char* a1 = cA + (size_t)(t + 1) * kstep;
            const char* a2 = last ? nA : cA + (size_t)(t + 2) * kstep; const char* b2 = last ? nB : cB + (size_t)(t + 2) * kstep;
            const char* a3 = a2 + kstep; const char* b3 = b2 + kstep;
            i32x8 At[4], B0[2], B1[2];
            if constexpr (SP2) {
            GE_LDB(B0, 0, 0); GE_LDB(B1, 0, 1); SCHED(); GE_LDA(At, 0, 0); GE_STAGEA(GE_SA(1, 1), a1, 1);
            WAITV(8); WAITL(0); SBAR(); GE_MMA(0, 0, At, B0); GE_MMA(0, 1, At, B1); SBAR(); SCHED();
            if constexpr (P::GATHER) { if (last && has_next) {
#pragma unroll
                for (int i = 0; i < 2; ++i) { int R2, C2; stage_rc(tid * 16 + i * 8192, R2, C2);
#pragma unroll
                    for (int h = 0; h < 2; ++h) oA[h][i] = (unsigned)S.gather_row(nxt, h * HALF + R2) * (unsigned)(S.lda * P::ES) + (unsigned)(C2 * 2); } } }
            GE_LDA(At, 0, 1); GE_STAGEB(GE_SB(0, 0), b2); GE_STAGEB(GE_SB(0, 1), b2 + hstepB); GE_STAGEA(GE_SA(0, 0), a2, 0);
            WAITV(8); WAITL(0); SBAR(); GE_MMA(1, 0, At, B0); GE_MMA(1, 1, At, B1); SBAR(); SCHED();
            GE_LDB(B0, 1, 0); GE_LDB(B1, 1, 1); SCHED(); GE_LDA(At, 1, 0); GE_STAGEA(GE_SA(0, 1), a2, 1);
            WAITV(8); WAITL(0); SBAR(); GE_MMA(0, 0, At, B0); GE_MMA(0, 1, At, B1); SBAR(); SCHED();
            GE_LDA(At, 1, 1); GE_STAGEB(GE_SB(1, 0), b3); GE_STAGEB(GE_SB(1, 1), b3 + hstepB); GE_STAGEA(GE_SA(1, 0), a3, 0);
            WAITV(8); WAITL(0); SBAR(); GE_MMA(1, 0, At, B0); GE_MMA(1, 1, At, B1); SBAR(); SCHED();
            } else {
            GE_LDB(B0, 0, 0); SCHED(); GE_LDA(At, 0, 0); GE_STAGEA(GE_SA(1, 1), a1, 1);
            WAITL(8); SBAR(); WAITL(0); GE_MMA(0, 0, At, B0); SBAR(); SCHED();
            if constexpr (P::GATHER) { if (last && has_next) {
#pragma unroll
                for (int i = 0; i < 2; ++i) { int R2, C2; stage_rc(tid * 16 + i * 8192, R2, C2);
#pragma unroll
                    for (int h = 0; h < 2; ++h) oA[h][i] = (unsigned)S.gather_row(nxt, h * HALF + R2) * (unsigned)(S.lda * P::ES) + (unsigned)(C2 * 2); } } }
            GE_LDB(B1, 0, 1); GE_STAGEB(GE_SB(0, 0), b2);
            SBAR(); WAITL(0); GE_MMA(0, 1, At, B1); SBAR();
            GE_LDA(At, 0, 1); GE_STAGEA(GE_SA(0, 0), a2, 0);
            SBAR(); WAITL(0); GE_MMA(1, 0, At, B0); SBAR(); SCHED();
            GE_STAGEB(GE_SB(0, 1), b2 + hstepB);
            WAITV(6); SBAR(); GE_MMA(1, 1, At, B1); SBAR();
            GE_LDB(B0, 1, 0); SCHED(); GE_LDA(At, 1, 0); GE_STAGEA(GE_SA(0, 1), a2, 1);
            WAITL(8); SBAR(); WAITL(0); GE_MMA(0, 0, At, B0); SBAR(); SCHED();
            GE_LDB(B1, 1, 1); GE_STAGEB(GE_SB(1, 0), b3);
            SBAR(); WAITL(0); GE_MMA(0, 1, At, B1); SBAR();
            GE_LDA(At, 1, 1); GE_STAGEA(GE_SA(1, 0), a3, 0);
            SBAR(); WAITL(0); GE_MMA(1, 0, At, B0); SBAR(); SCHED();
            GE_STAGEB(GE_SB(1, 1), b3 + hstepB);
            WAITV(6); SBAR(); GE_MMA(1, 1, At, B1); SBAR();
            }
        }
        if (wr == 0) SBAR();
        S.epi(acc, cur, wr, wc, fr, fq);
        if (!has_next) break;
#pragma unroll
        for (int a = 0; a < 2; ++a)
#pragma unroll
            for (int b = 0; b < 2; ++b)
#pragma unroll
                for (int m = 0; m < 4; ++m)
#pragma unroll
                    for (int n = 0; n < 2; ++n) acc[a][b][m][n] = (f32x4){0.f, 0.f, 0.f, 0.f};
        cur = nxt; cA = nA; cB = nB; ++ui;
        if (wr == 1) SBAR();
    }
    WAITV(0);
    SBAR();
#undef GE_SA
#undef GE_SB
#undef GE_STAGEA
#undef GE_STAGEB
#undef GE_LDA
#undef GE_LDB
#undef GE_MMA
#undef GE_LO
#undef GE_HI
#undef GE_LD1
}
}
using ge::Unit;

struct Params {
    const float* in[26];
    float* out; unsigned char* ws;
    int ph_lo, ph_hi;
};
enum { I_X = 0, I_C, I_CTX, I_CCTX, I_ADAW, I_ADAB, I_NMIX, I_NFFN, I_POOLW, I_POOLS, I_INW, I_CONVW, I_CONVB, I_ALOG, I_DTB, I_DSKIP, I_SNORM, I_OUTW,
       I_W1, I_W3, I_W2, I_RW, I_MW1, I_MW3, I_MW2, I_FNORM };

struct Frame {
    LAS unsigned char* lds;
    int tid, lane, wave, G, bx;
    const Params* p;
    unsigned char* ws;
    unsigned* ctl;
    float* H; float* mod;
};
#ifdef EMU
DEV const float* INP(const Frame& F, int i) { return F.p->in[i]; }
DEV float* OUTP(const Frame& F) { return F.p->out; }
DEV unsigned char* WSP(const Frame& F) { return F.p->ws; }
#define LAUNDER_S(x) ((void)0)
#else
typedef const float* cfptr_t;
DEV const float* INP(const Frame&, int i) { int k = i; asm volatile("" : "+s"(k)); return ((const __attribute__((address_space(4))) cfptr_t*)__builtin_amdgcn_kernarg_segment_ptr())[k]; }
DEV float* OUTP(const Frame& F) { return (float*)INP(F, 26); }
DEV unsigned char* WSP(const Frame& F) { return (unsigned char*)INP(F, 27); }
#define LAUNDER_S(x) asm volatile("" : "+s"(x))
#endif
constexpr int LDS_MISC = ge::STAGE_BYTES;
constexpr int LDS_BYTES = ge::STAGE_BYTES + 16384;

struct Src { const float* x; const float* ctx; float* H; const float* mod; };
DEV const float* modq(const float* mod, int layer, int vec, int which) { return mod + ((size_t)(layer * 3 + vec) * 6 + which) * D; }
DEV const float* modp(const Frame& F, int layer, int vec, int which) { return modq(F.mod, layer, vec, which); }
DEV const float* hsrc_row(const Src& s, bool from_input, int r) {
    if (from_input) return r < ML ? s.x + (size_t)r * D : s.ctx + (size_t)(r - ML) * D;
    return s.H + (size_t)r * D;
}
DEV Src mksrc(const Frame& F) { Src s; s.x = INP(F, I_X); s.ctx = INP(F, I_CTX); s.H = F.H; s.mod = F.mod; return s; }
DEV const float* hin_row(const Frame& F, int layer, int r) { return hsrc_row(mksrc(F), layer == 0, r); }

template <int K, int N, class RM>
DEV void transpose_item(const float* Wsrc, bf16_t* WT, int ldt, RM rowmap, LAS float* scr, int item, int lane) {
    constexpr int nblk = N / 32; const int kb = item / nblk, nb = item % nblk, k0 = 64 * kb, n0 = 32 * nb;
    float tmp[32];
#pragma unroll
    for (int i = 0; i < 32; ++i) { const int kk = 2 * i + (lane >> 5); tmp[i] = Wsrc[(size_t)(k0 + kk) * N + n0 + (lane & 31)]; }
#pragma unroll
    for (int i = 0; i < 32; ++i) { const int kk = 2 * i + (lane >> 5); scr[kk * 33 + (lane & 31)] = tmp[i]; }
    WSYNC();
    const int c = lane & 7; const int row0 = rowmap(n0);
#pragma unroll
    for (int j = 0; j < 4; ++j) { const int n = (lane >> 3) + 8 * j; const LAS float* s = scr + (8 * c) * 33 + n;
        u32x4 o; o.x = pk2(s[0 * 33], s[1 * 33]); o.y = pk2(s[2 * 33], s[3 * 33]); o.z = pk2(s[4 * 33], s[5 * 33]); o.w = pk2(s[6 * 33], s[7 * 33]);
        *(u32x4*)(WT + (size_t)(row0 + n) * ldt + k0 + 8 * c) = o; }
    WSYNC();
}
template <int K, int N, class RM>
DEV void transpose_item_fp8(const float* Wsrc, fp8_t* WT, int ldt, RM rowmap, float scale, LAS float* scr, int item, int lane) {
    constexpr int nblk = N / 32; const int kb = item / nblk, nb = item % nblk, k0 = 64 * kb, n0 = 32 * nb;
    float tmp[32];
#pragma unroll
    for (int i = 0; i < 32; ++i) { const int kk = 2 * i + (lane >> 5); tmp[i] = Wsrc[(size_t)(k0 + kk) * N + n0 + (lane & 31)]; }
#pragma unroll
    for (int i = 0; i < 32; ++i) { const int kk = 2 * i + (lane >> 5); scr[kk * 33 + (lane & 31)] = tmp[i] * scale; }
    WSYNC();
    const int c = lane & 7; const int row0 = rowmap(n0);
#pragma unroll
    for (int j = 0; j < 4; ++j) { const int n = (lane >> 3) + 8 * j; const LAS float* s = scr + (8 * c) * 33 + n;
        u32x2 o; o.x = pk4_fp8(s[0 * 33], s[1 * 33], s[2 * 33], s[3 * 33]); o.y = pk4_fp8(s[4 * 33], s[5 * 33], s[6 * 33], s[7 * 33]);
        *(u32x2*)(WT + (size_t)(row0 + n) * ldt + k0 + 8 * c) = o; }
    WSYNC();
}
template <int K, int N, class RM>
DEV void convert_job_fp8(const Frame& F, const float* Wsrc, fp8_t* WT, int ldt, RM rm, float scale) {
    LAS float* scr = (LAS float*)(F.lds + F.wave * 16384);
    constexpr int items = (K / 64) * (N / 32); const int gw = F.bx * 8 + F.wave, NGW = F.G * 8;
    for (int it = gw; it < items; it += NGW) transpose_item_fp8<K, N>(Wsrc, WT, ldt, rm, scale, scr, it, F.lane);
}
struct RmId { DEV int operator()(int n0) const { return n0; } };
struct RmIlv { int s; DEV int operator()(int n0) const { return (n0 >> 7) * 256 + s * 128 + (n0 & 127); } };
template <int K, int N, class RM>
DEV void convert_job(const Frame& F, const float* Wsrc, bf16_t* WT, int ldt, RM rm) {
    LAS float* scr = (LAS float*)(F.lds + F.wave * 16384);
    constexpr int items = (K / 64) * (N / 32); const int gw = F.bx * 8 + F.wave, NGW = F.G * 8;
    for (int it = gw; it < items; it += NGW) transpose_item<K, N>(Wsrc, WT, ldt, rm, scr, it, F.lane);
}
DEV void convert_even(const Frame& F, int j) {
    bf16_t* Wb = (bf16_t*)(F.ws + OFF_W);
    for (int g = 0; g < 4; ++g) convert_job<256, 256>(F, INP(F, I_POOLW) + ((size_t)j * 4 + g) * 65536, Wb + W_POOL / 2 + (size_t)g * 65536, 256, RmId{});
    convert_job<D, DFF>(F, INP(F, I_W1) + (size_t)j * D * DFF, Wb + W_UP / 2, D, RmIlv{0});
    convert_job<D, DFF>(F, INP(F, I_W3) + (size_t)j * D * DFF, Wb + W_UP / 2, D, RmIlv{1});
    convert_job<DFF, D>(F, INP(F, I_W2) + (size_t)j * DFF * D, Wb + W_DN / 2, DFF, RmId{});
}
DEV void convert_ssd(const Frame& F, int j) {
    bf16_t* Wb = (bf16_t*)(F.ws + OFF_W);
    convert_job<D, NPROJ>(F, INP(F, I_INW) + (size_t)j * D * NPROJ, Wb + W_IN / 2, D, RmId{});
    convert_job<DIN, D>(F, INP(F, I_OUTW) + (size_t)j * DIN * D, Wb + W_OUT / 2, DIN, RmId{});
    { u32x4* z = (u32x4*)(Wb + W_IN / 2 + (size_t)NPROJ * D); const int n16 = (NPROJP - NPROJ) * D * 2 / 16;
      unsigned zz = 0u; LAUNDER_V(zz);
      for (int i = F.bx * 512 + F.tid; i < n16; i += F.G * 512) z[i] = (u32x4){zz, zz, zz, zz}; }
}
DEV void convert_moe(const Frame& F, int j) {
    fp8_t* Wb = (fp8_t*)(F.ws + OFF_W);
    for (int e = 0; e < NEXP; ++e) {
        convert_job_fp8<D, DFFE>(F, INP(F, I_MW1) + ((size_t)j * NEXP + e) * D * DFFE, Wb + W_MUP + (size_t)e * 2 * DFFE * D, D, RmIlv{0}, 32.0f);
        convert_job_fp8<D, DFFE>(F, INP(F, I_MW3) + ((size_t)j * NEXP + e) * D * DFFE, Wb + W_MUP + (size_t)e * 2 * DFFE * D, D, RmIlv{1}, 32.0f);
        if (MOE_DOWN_FP8) convert_job_fp8<DFFE, D>(F, INP(F, I_MW2) + ((size_t)j * NEXP + e) * DFFE * D, Wb + W_MDN + (size_t)e * D * DFFE, DFFE, RmId{}, 64.0f);
        else convert_job<DFFE, D>(F, INP(F, I_MW2) + ((size_t)j * NEXP + e) * DFFE * D, (bf16_t*)(Wb + W_MDN) + (size_t)e * D * DFFE, DFFE, RmId{});
    }
}

DEV void phase_mod(const Frame& F) {
    LAS float* red = (LAS float*)F.lds;
    const int nblk = DEPTH * 6144 / 64;
    const int col = F.tid & 63, ks = F.tid >> 6;
    for (int blk = F.bx; blk < nblk; blk += F.G) {
        const int layer = (blk * 64) / 6144, n = (blk * 64) % 6144 + col;
        const float* W = INP(F, I_ADAW) + (size_t)layer * D * 6144 + n;
        float a0 = 0.f, a1 = 0.f, a2 = 0.f;
#pragma unroll 8
        for (int k = ks * 128; k < ks * 128 + 128; ++k) { const float w = W[(size_t)k * 6144];
            a0 += siluf(INP(F, I_C)[k]) * w; a1 += siluf(INP(F, I_C)[D + k]) * w; a2 += siluf(INP(F, I_CCTX)[k]) * w; }
        red[(ks * 64 + col) * 3 + 0] = a0; red[(ks * 64 + col) * 3 + 1] = a1; red[(ks * 64 + col) * 3 + 2] = a2;
        __syncthreads();
        if (F.tid < 192) { const int c2 = F.tid % 64, v = F.tid / 64; float s = 0.f;
            for (int q = 0; q < 8; ++q) s += red[(q * 64 + c2) * 3 + v];
            const int n2 = (blk * 64) % 6144 + c2;
            F.mod[(size_t)(layer * 3 + v) * 6144 + n2] = s + INP(F, I_ADAB)[(size_t)layer * 6144 + n2]; }
        __syncthreads();
    }
}

DEV void load_row(const float* p, int lane, f32x4 (&v)[4]) {
#pragma unroll
    for (int j = 0; j < 4; ++j) v[j] = *(const f32x4*)(p + 4 * lane + 256 * j);
}
DEV float sumsq_row(const f32x4 (&v)[4]) { float s = 0.f;
#pragma unroll
    for (int j = 0; j < 4; ++j) s += (v[j][0] * v[j][0] + v[j][1] * v[j][1]) + (v[j][2] * v[j][2] + v[j][3] * v[j][3]);
    return wave_sum(s); }
DEV void normmod_row(f32x4 (&v)[4], float rstd, const float* w, const float* sh, const float* sc, int lane) {
#pragma unroll
    for (int j = 0; j < 4; ++j) { const int c = 4 * lane + 256 * j; const f32x4 wv = *(const f32x4*)(w + c), sv = *(const f32x4*)(sh + c), cv = *(const f32x4*)(sc + c);
        v[j] = v[j] * rstd * wv * (cv + 1.0f) + sv; }
}
DEV void store_row_bf16(bf16_t* o, int lane, const f32x4 (&v)[4]) {
#pragma unroll
    for (int j = 0; j < 4; ++j) { u32x2 w; w.x = pk2(v[j][0], v[j][1]); w.y = pk2(v[j][2], v[j][3]); *(u32x2*)(o + 4 * lane + 256 * j) = w; }
}

DEV void phase_norm(const Frame& F, int layer, int which, bf16_t* out, bool from_input) {
    const int gw = F.bx * 8 + F.wave, NGW = F.G * 8;
    const float* w = INP(F, which == 0 ? I_NMIX : I_NFFN) + (size_t)layer * D;
    for (int r = gw; r < MT; r += NGW) {
        f32x4 v[4]; load_row(hsrc_row(mksrc(F), from_input, r), F.lane, v);
        const float rstd = rsqrtf(sumsq_row(v) * (1.0f / D) + EPS);
        const int vec = vec_of(r);
        normmod_row(v, rstd, w, modp(F, layer, vec, which), modp(F, layer, vec, which + 1), F.lane);
        store_row_bf16(out + (size_t)r * D, F.lane, v);
    }
}

DEV void phase_poolprep(const Frame& F, int layer, bf16_t* P) {
    LAS float* rs = (LAS float*)(F.lds);
    const float* w = INP(F, I_NMIX) + (size_t)layer * D;
    const int ntile = MT / 64;
    for (int tile = F.bx; tile < ntile; tile += F.G) {
        const int r0 = tile * 64;
        int seq0, seq1;
        if (r0 < ML) { seq0 = r0; seq1 = r0 + 64; } else { seq0 = ML + ((r0 - ML) / CTXL) * CTXL; seq1 = seq0 + CTXL; }
        const int lo_r = (r0 - 8 > seq0) ? r0 - 8 : seq0, hi_r = (r0 + 64 + 7 < seq1) ? r0 + 64 + 7 : seq1;
        for (int r = lo_r + F.wave; r < hi_r; r += 8) { f32x4 v[4]; load_row(hin_row(F, layer, r), F.lane, v); const float ss = sumsq_row(v); if (F.lane == 0) rs[r - lo_r] = rsqrtf(ss * (1.0f / D) + EPS); }
        __syncthreads();
        const int vec = vec_of(r0);
        const int cq = F.tid & 255, half = F.tid >> 8, c = cq * 4, g = c >> 8, win = 2 << g, lo = win >> 1, hi = win - 1 - lo;
        const f32x4 wv = *(const f32x4*)(w + c), sv = *(const f32x4*)(modp(F, layer, vec, 0) + c), cv = *(const f32x4*)(modp(F, layer, vec, 1) + c) + 1.0f;
        const f32x4 wc = wv * cv;
        const int ta = r0 + 32 * half;
        auto uval = [&](int r) -> f32x4 { const f32x4 h = *(const f32x4*)(hin_row(F, layer, r) + c); return h * rs[r - lo_r] * wc + sv; };
        f32x4 s = (f32x4){0.f, 0.f, 0.f, 0.f};
        { const int a = (ta - lo > seq0) ? ta - lo : seq0, b = (ta + hi + 1 < seq1) ? ta + hi + 1 : seq1; for (int r = a; r < b; ++r) s += uval(r); }
        for (int t = ta; t < ta + 32; ++t) {
            const int a = (t - lo > seq0) ? t - lo : seq0, b = (t + hi + 1 < seq1) ? t + hi + 1 : seq1;
            const float inv = 1.0f / (float)(b - a);
            const f32x4 o = s * inv - uval(t);
            u32x2 pw; pw.x = pk2(o[0], o[1]); pw.y = pk2(o[2], o[3]); *(u32x2*)(P + (size_t)t * D + c) = pw;
            if (t + 1 < ta + 32) {
                if (t + 1 + hi < seq1) s += uval(t + 1 + hi);
                if (t - lo >= seq0) s -= uval(t - lo); }
        }
        __syncthreads();
    }
}

struct PolBase { int G, c; };
struct PolPool : PolBase {
    static constexpr bool PERM = false, GATHER = false; static constexpr bool FP8 = false; static constexpr int ES = 2; int K, lda, ldb;
    const bf16_t* P; const bf16_t* W; Src src; int layer; const float* scale;
    DEV bool next(int i, Unit& u) const { return ge::static_next(NPAN, 4, G, c, i, u); }
    DEV const char* a_base(const Unit& u) const { return (const char*)(P + (size_t)u.pm * 256 * D + u.pn * 256); }
    DEV const char* b_base(const Unit& u) const { return (const char*)(W + (size_t)u.pn * 65536); }
    DEV void epi(const f32x4 (&acc)[2][2][4][2], const Unit& u, int wr, int wc, int fr, int fq) const {
        const int row0 = u.pm * 256 + wr * 64 + fr, col0 = u.pn * 256 + wc * 32 + 4 * fq; const int vec = vec_of(u.pm * 256);
        const float* g1 = modq(src.mod, layer, vec, 2);
        f32x4 gv[2][2];
#pragma unroll
        for (int bj = 0; bj < 2; ++bj)
#pragma unroll
            for (int n = 0; n < 2; ++n) { const int cc = col0 + bj * 128 + n * 16; gv[bj][n] = *(const f32x4*)(g1 + cc) * *(const f32x4*)(scale + cc); }
#pragma unroll
        for (int ai = 0; ai < 2; ++ai)
#pragma unroll
            for (int m = 0; m < 4; ++m) { const int r = row0 + ai * 128 + m * 16; const float* hi = hsrc_row(src, layer == 0, r) + col0; float* ho = src.H + (size_t)r * D + col0;
#pragma unroll
                for (int bj = 0; bj < 2; ++bj)
#pragma unroll
                    for (int n = 0; n < 2; ++n) *(f32x4*)(ho + bj * 128 + n * 16) = *(const f32x4*)(hi + bj * 128 + n * 16) + gv[bj][n] * acc[ai][bj][m][n]; }
    }
};
struct PolResid : PolBase {
    static constexpr bool PERM = false, GATHER = false; static constexpr bool FP8 = false; static constexpr int ES = 2; int K, lda, ldb;
    const bf16_t* A; const bf16_t* W; Src src; int layer, which;
    DEV bool next(int i, Unit& u) const { return ge::static_next(NPAN, 4, G, c, i, u); }
    DEV const char* a_base(const Unit& u) const { return (const char*)(A + (size_t)u.pm * 256 * lda); }
    DEV const char* b_base(const Unit& u) const { return (const char*)(W + (size_t)u.pn * 256 * ldb); }
    DEV void epi(const f32x4 (&acc)[2][2][4][2], const Unit& u, int wr, int wc, int fr, int fq) const {
        const int row0 = u.pm * 256 + wr * 64 + fr, col0 = u.pn * 256 + wc * 32 + 4 * fq; const int vec = vec_of(u.pm * 256);
        const float* gp = modq(src.mod, layer, vec, which);
        f32x4 gv[2][2];
#pragma unroll
        for (int bj = 0; bj < 2; ++bj)
#pragma unroll
            for (int n = 0; n < 2; ++n) gv[bj][n] = *(const f32x4*)(gp + col0 + bj * 128 + n * 16);
#pragma unroll
        for (int ai = 0; ai < 2; ++ai)
#pragma unroll
            for (int m = 0; m < 4; ++m) { float* ho = src.H + (size_t)(row0 + ai * 128 + m * 16) * D + col0;
#pragma unroll
                for (int bj = 0; bj < 2; ++bj)
#pragma unroll
                    for (int n = 0; n < 2; ++n) { f32x4* q = (f32x4*)(ho + bj * 128 + n * 16); *q = *q + gv[bj][n] * acc[ai][bj][m][n]; } }
    }
};
template <bool MOE>
struct PolUp : PolBase {
    static constexpr bool PERM = true, GATHER = MOE, FP8 = MOE; static constexpr int ES = MOE ? 1 : 2; int K, lda, ldb;
    const bf16_t* A; const bf16_t* W; bf16_t* HID; int ldh, nq;
    int nM; const int* s2t; int tstart[NEXP + 1];
    DEV bool next(int i, Unit& u) const { return ge::static_next(MOE ? nM : NPAN, nq, G, c, i, u); }
    DEV int expert_of(int pm) const { int e = 0;
#pragma unroll
        for (int k = 1; k < NEXP; ++k) e += (pm >= tstart[k]) ? 1 : 0;
        return e; }
    DEV const char* a_base(const Unit& u) const { return MOE ? (const char*)A : (const char*)(A + (size_t)u.pm * 256 * lda); }
    DEV const char* b_base(const Unit& u) const { size_t off = (size_t)u.pn * 256 * ldb; if (MOE) off += (size_t)expert_of(u.pm) * 2 * DFFE * ldb; return (const char*)W + off * ES; }
    DEV int gather_row(const Unit& u, int R) const { return s2t[u.pm * 256 + R]; }
    DEV void epi(const f32x4 (&acc)[2][2][4][2], const Unit& u, int wr, int wc, int fr, int fq) const {
        const int row0 = u.pm * 256 + wr * 64 + fr, col0 = u.pn * 128 + wc * 32 + 8 * fq;
#pragma unroll
        for (int ai = 0; ai < 2; ++ai)
#pragma unroll
            for (int m = 0; m < 4; ++m) { bf16_t* o = HID + (size_t)(row0 + ai * 128 + m * 16) * ldh + col0;
                float h[8];
#pragma unroll
                for (int n = 0; n < 2; ++n)
#pragma unroll
                    for (int i = 0; i < 4; ++i) { if (MOE) h[4 * n + i] = siluf(acc[ai][0][m][n][i] * 0.00390625f) * (acc[ai][1][m][n][i] * (MOE_DOWN_FP8 ? 0.015625f : 0.00390625f));
                                                  else h[4 * n + i] = siluf(acc[ai][0][m][n][i]) * acc[ai][1][m][n][i]; }
                if (MOE && MOE_DOWN_FP8) { u32x2 w8; w8.x = pk4_fp8(h[0], h[1], h[2], h[3]); w8.y = pk4_fp8(h[4], h[5], h[6], h[7]);
                    *(u32x2*)((fp8_t*)HID + (size_t)(row0 + ai * 128 + m * 16) * ldh + col0) = w8; }
                else { u32x4 w; w.x = pk2(h[0], h[1]); w.y = pk2(h[2], h[3]); w.z = pk2(h[4], h[5]); w.w = pk2(h[6], h[7]); *(u32x4*)o = w; } }
    }
};
struct PolMoeDown : PolBase {
    static constexpr bool PERM = true, GATHER = (MOE_DOWN_FP8 != 0), FP8 = (MOE_DOWN_FP8 != 0); static constexpr int ES = MOE_DOWN_FP8 ? 1 : 2; int K, lda, ldb;
    const bf16_t* A; const bf16_t* W; bf16_t* YS; int nM; int tstart[NEXP + 1];
    DEV bool next(int i, Unit& u) const { return ge::static_next(nM, 4, G, c, i, u); }
    DEV int expert_of(int pm) const { int e = 0;
#pragma unroll
        for (int k = 1; k < NEXP; ++k) e += (pm >= tstart[k]) ? 1 : 0;
        return e; }
    DEV const char* a_base(const Unit& u) const { return GATHER ? (const char*)A : (const char*)A + (size_t)u.pm * 256 * lda * ES; }
    DEV int gather_row(const Unit& u, int R) const { return u.pm * 256 + R; }
    DEV const char* b_base(const Unit& u) const { return (const char*)W + ((size_t)expert_of(u.pm) * D + (size_t)u.pn * 256) * ldb * ES; }
    DEV void epi(const f32x4 (&acc)[2][2][4][2], const Unit& u, int wr, int wc, int fr, int fq) const {
        const int row0 = u.pm * 256 + wr * 64 + fr, col0 = u.pn * 256 + wc * 32 + 8 * fq;
#pragma unroll
        for (int ai = 0; ai < 2; ++ai)
#pragma unroll
            for (int m = 0; m < 4; ++m) { bf16_t* o = YS + (size_t)(row0 + ai * 128 + m * 16) * D + col0;
#pragma unroll
                for (int bj = 0; bj < 2; ++bj) { u32x4 w; w.x = pk2(acc[ai][bj][m][0][0], acc[ai][bj][m][0][1]); w.y = pk2(acc[ai][bj][m][0][2], acc[ai][bj][m][0][3]);
                    w.z = pk2(acc[ai][bj][m][1][0], acc[ai][bj][m][1][1]); w.w = pk2(acc[ai][bj][m][1][2], acc[ai][bj][m][1][3]); *(u32x4*)(o + bj * 128) = w; } }
    }
};
struct PolInProj : PolBase {
    static constexpr bool PERM = true, GATHER = false; static constexpr bool FP8 = false; static constexpr int ES = 2; int K, lda, ldb;
    const bf16_t* A; const bf16_t* W; bf16_t* Z; bf16_t* XBC; float* DT;
    DEV bool next(int i, Unit& u) const { return ge::static_next(NPAN, NPROJP / 256, G, c, i, u); }
    DEV const char* a_base(const Unit& u) const { return (const char*)(A + (size_t)u.pm * 256 * lda); }
    DEV const char* b_base(const Unit& u) const { return (const char*)(W + (size_t)u.pn * 256 * ldb); }
    DEV void epi(const f32x4 (&acc)[2][2][4][2], const Unit& u, int wr, int wc, int fr, int fq) const {
        const int row0 = u.pm * 256 + wr * 64 + fr, cw = wc * 32 + 8 * fq;
        if (u.pn < 20) {
            bf16_t* base; int ld, col0;
            if (u.pn < 8) { base = Z; ld = DIN; col0 = u.pn * 256 + cw; } else { base = XBC; ld = CONVD; col0 = (u.pn - 8) * 256 + cw; }
#pragma unroll
            for (int ai = 0; ai < 2; ++ai)
#pragma unroll
                for (int m = 0; m < 4; ++m) { bf16_t* o = base + (size_t)(row0 + ai * 128 + m * 16) * ld + col0;
#pragma unroll
                    for (int bj = 0; bj < 2; ++bj) { u32x4 w; w.x = pk2(acc[ai][bj][m][0][0], acc[ai][bj][m][0][1]); w.y = pk2(acc[ai][bj][m][0][2], acc[ai][bj][m][0][3]);
                        w.z = pk2(acc[ai][bj][m][1][0], acc[ai][bj][m][1][1]); w.w = pk2(acc[ai][bj][m][1][2], acc[ai][bj][m][1][3]); *(u32x4*)(o + bj * 128) = w; } }
        } else if (cw < 64) {
#pragma unroll
            for (int ai = 0; ai < 2; ++ai)
#pragma unroll
                for (int m = 0; m < 4; ++m) { const int r = row0 + ai * 128 + m * 16; int b, tv;
                    if (r < ML) { b = r / SEQ; tv = CTXL + r % SEQ; } else { b = (r - ML) / CTXL; tv = (r - ML) % CTXL; }
#pragma unroll
                    for (int n = 0; n < 2; ++n)
#pragma unroll
                        for (int i = 0; i < 4; ++i) { const int j = cw + 4 * n + i, dir = j >> 5, h = j & 31;
                            DT[((size_t)(b * 2 + dir) * NH + h) * TV + tv] = acc[ai][0][m][n][i]; } }
        }
    }
};

DEV void phase_conv(const Frame& F, int j, const bf16_t* XBC, bf16_t* XT, bf16_t* Brow, bf16_t* BT, bf16_t* Crow) {
    LAS bf16_t* tl0 = (LAS bf16_t*)F.lds;
    const float* cw = INP(F, I_CONVW) + (size_t)j * 4 * CONVD; const float* cb = INP(F, I_CONVB) + (size_t)j * CONVD;
    constexpr int NPER = NB * NCH, nitem = NPER * (CONVD / 64);
    const int t2 = 2 * (F.tid >> 3), cg = F.tid & 7;
    const int i0 = (int)(((long)F.bx * nitem) / F.G), i1 = (int)(((long)(F.bx + 1) * nitem) / F.G);
    int cblk_cur = -1; f32x4 wv[4][2], bv[2]; int par = 0;
    for (int it = i0; it < i1; ++it) {
        const int cblk = it / NPER, rest = it % NPER, b = rest / NCH, cv = rest % NCH;
        const int ch0 = cblk * 64 + cg * 8;
        if (cblk != cblk_cur) { cblk_cur = cblk;
#pragma unroll
            for (int k = 0; k < 4; ++k) { wv[k][0] = *(const f32x4*)(cw + k * CONVD + ch0); wv[k][1] = *(const f32x4*)(cw + k * CONVD + ch0 + 4); }
            bv[0] = *(const f32x4*)(cb + ch0); bv[1] = *(const f32x4*)(cb + ch0 + 4); }
        const int tv = cv * 128 + t2;
        const int seg0 = tv < CTXL ? 0 : CTXL, seg1 = tv < CTXL ? CTXL : TV;
        float xin[5][8];
#pragma unroll
        for (int k = 0; k < 5; ++k) { const int tk = tv - 2 + k; u32x4 q = (u32x4){0u, 0u, 0u, 0u};
            if (tk >= seg0 && tk < seg1) q = *(const u32x4*)(XBC + (size_t)row_of(b, tk) * CONVD + ch0);
            xin[k][0] = bflo(q.x); xin[k][1] = bfhi(q.x); xin[k][2] = bflo(q.y); xin[k][3] = bfhi(q.y); xin[k][4] = bflo(q.z); xin[k][5] = bfhi(q.z); xin[k][6] = bflo(q.w); xin[k][7] = bfhi(q.w); }
        unsigned pk[2][4];
#pragma unroll
        for (int o = 0; o < 2; ++o) { float a[8];
#pragma unroll
            for (int i = 0; i < 8; ++i) { float acc = bv[i >> 2][i & 3];
#pragma unroll
                for (int k = 0; k < 4; ++k) acc += wv[k][i >> 2][i & 3] * xin[o + k][i];
                a[i] = siluf(acc); }
#pragma unroll
            for (int i = 0; i < 4; ++i) pk[o][i] = pk2(a[2 * i], a[2 * i + 1]); }
        const int r = row_of(b, tv);
        const bool isx = cblk < DIN / 64, isb = !isx && cblk < (DIN + BCD) / 64;
        if (!isx) { bf16_t* o = (isb ? Brow + (ch0 - DIN) : Crow + (ch0 - DIN - BCD)) + (size_t)r * BCD;
            *(u32x4*)o = (u32x4){pk[0][0], pk[0][1], pk[0][2], pk[0][3]}; *(u32x4*)(o + BCD) = (u32x4){pk[1][0], pk[1][1], pk[1][2], pk[1][3]}; }
        if (isx || isb) {
            LAS bf16_t* tl = tl0 + par * (64 * 136); par ^= 1;
#pragma unroll
            for (int i = 0; i < 4; ++i) { const unsigned lo = (pk[0][i] & 0xffffu) | (pk[1][i] << 16), hi = (pk[0][i] >> 16) | (pk[1][i] & 0xffff0000u);
                *(LAS unsigned*)(tl + (cg * 8 + 2 * i) * 136 + t2) = lo; *(LAS unsigned*)(tl + (cg * 8 + 2 * i + 1) * 136 + t2) = hi; }
            __syncthreads();
            bf16_t* dst = isx ? XT + ((size_t)b * DIN + cblk * 64) * TV : BT + ((size_t)b * BCD + (cblk * 64 - DIN)) * TV;
#pragma unroll
            for (int q = 0; q < 2; ++q) { const int idx = F.tid + q * 512, ch = idx >> 4, t8 = (idx & 15) * 8;
                *(u32x4*)(dst + (size_t)ch * TV + cv * 128 + t8) = *(const LAS u32x4*)(tl + ch * 136 + t8); }
        }
    }
}

DEV void phase_cb(const Frame& F, const bf16_t* Brow, const bf16_t* Crow, bf16_t* CB) {
    const int nitem = NB * NG * NCH; const int fr = F.lane & 15, fq = F.lane >> 4;
    for (int it = F.bx; it < nitem; it += F.G) {
        const int cv = it % NCH, g = (it / NCH) % NG, b = it / (NCH * NG);
        const int rbase = row_of(b, cv * 128);
        bf16x8 cf[4];
#pragma unroll
        for (int ks = 0; ks < 4; ++ks) cf[ks] = *(const bf16x8*)(Crow + (size_t)(rbase + 16 * F.wave + fr) * BCD + g * 128 + 32 * ks + 8 * fq);
        bf16_t* out = CB + ((size_t)((b * NG + g) * NCH + cv)) * 16384;
#pragma unroll
        for (int nt = 0; nt < 8; ++nt) {
            f32x4 acc = (f32x4){0.f, 0.f, 0.f, 0.f};
#pragma unroll
            for (int ks = 0; ks < 4; ++ks) { const bf16x8 bfr = *(const bf16x8*)(Brow + (size_t)(rbase + 16 * nt + fr) * BCD + g * 128 + 32 * ks + 8 * fq); acc = MFMA16(bfr, cf[ks], acc); }
            u32x2 w; w.x = pk2(acc[0], acc[1]); w.y = pk2(acc[2], acc[3]);
            *(u32x2*)(out + (size_t)(16 * F.wave + fr) * 128 + 16 * nt + 4 * fq) = w;
        }
    }
}

DEV void phase_tables(const Frame& F, int j, float* DT, float* CUM, float* WJ) {
    const int nitem = NB * 2 * NH * NCH; const int gw = F.bx * 8 + F.wave, NGW = F.G * 8;
    for (int it = gw; it < nitem; it += NGW) {
        const int cv = it % NCH, h = (it / NCH) % NH, dir = (it / (NCH * NH)) & 1, b = it / (NCH * NH * 2);
        const float A = -expf(INP(F, I_ALOG)[(size_t)(j * 2 + dir) * NH + h]); const float bias = INP(F, I_DTB)[(size_t)(j * 2 + dir) * NH + h];
        const size_t o = ((size_t)(b * 2 + dir) * NH + h) * TV + cv * 128 + 2 * F.lane;
        const f32x2 raw = *(const f32x2*)(DT + o); const float d0 = softplusf(raw.x + bias), d1 = softplusf(raw.y + bias); const float a0 = d0 * A, a1 = d1 * A;
        float c0, c1, tot, sum = a0 + a1;
        if (dir == 0) {
#pragma unroll
            for (int q = 1; q < 64; q <<= 1) { const float t2 = __shfl_up(sum, q); if (F.lane >= q) sum += t2; }
            c1 = sum; c0 = sum - a1; tot = __shfl(sum, 63);
        } else {
#pragma unroll
            for (int q = 1; q < 64; q <<= 1) { const float t2 = __shfl_down(sum, q); if (F.lane + q < 64) sum += t2; }
            c0 = sum; c1 = sum - a0; tot = __shfl(sum, 0);
        }
        constexpr float L2E = 1.4426950408889634f;
        *(f32x2*)(DT + o) = (f32x2){c0 * L2E - flog2(d0), c1 * L2E - flog2(d1)};
        *(f32x2*)(CUM + o) = (f32x2){c0 * L2E, c1 * L2E};
        *(f32x2*)(WJ + o) = (f32x2){d0 * FEXP(tot - c0), d1 * FEXP(tot - c1)};
    }
}

constexpr int SC_HL = 0, SC_TAB = 17408, SC_CB = 20480, SC_BT = SC_CB + 32768, SC_C = SC_BT + 32768, SC_X = SC_C + 32768, SC_END = SC_X + 8192;
static_assert(SC_END <= ge::STAGE_BYTES, "scan LDS map");
DEV void phase_scan(const Frame& F, int j, const bf16_t* XT, const bf16_t* BT, const bf16_t* Crow, const bf16_t* CB, const float* DT, const float* CUM, const float* WJ, bf16_t* Yf, bf16_t* Yb) {
    LAS unsigned char* L = F.lds;
    LAS bf16_t* Hl = (LAS bf16_t*)(L + SC_HL);
    LAS float* tab = (LAS float*)(L + SC_TAB);
    const int fr = F.lane & 15, fq = F.lane >> 4, w = F.wave;
    const int nitem = NB * NH * 2 * 2;
    for (int it = F.bx; it < nitem; it += F.G) {
        const int xq = it & 7, kq = it >> 3; const int b = xq >> 2, g = xq & 3, h = 8 * g + (kq >> 2), dir = (kq >> 1) & 1, ph = kq & 1;
        const float Dsk = dir == 0 ? INP(F, I_DSKIP)[(size_t)j * NH + h] : 0.f;
        const size_t tbase = ((size_t)(b * 2 + dir) * NH + h) * TV;
        const bf16_t* xt = XT + ((size_t)b * DIN + h * HD + ph * 32) * TV;
        const bf16_t* bt = BT + ((size_t)b * BCD + g * 128) * TV;
        const bf16_t* CBh = CB + (size_t)((b * NG + g) * NCH) * 16384;
        const bf16_t* Cg = Crow + g * 128;
        bf16_t* Y = (dir ? Yb : Yf) + h * HD + ph * 32;
        const int lrow = 16 * w + fr;
        const int dr = F.lane >> 4, dc = F.lane & 15;
        f32x4 accH[2]; accH[0] = (f32x4){0.f, 0.f, 0.f, 0.f}; accH[1] = accH[0];
        for (int i = F.tid; i < 32 * 136 / 2; i += 512) ((LAS unsigned*)Hl)[i] = 0u;
#define SC_CHUNK_OF(step) (dir == 0 ? (step) : ((step) < 2 ? 1 - (step) : (NCH - 1) - ((step) - 2)))
        const int rsw = (4 * (w & 3) + dr) & 15, gc = dc ^ rsw;
        const unsigned loCB = (unsigned)(dr * 128 + 8 * gc) * 2u, loT = (unsigned)(dr * TV + 8 * gc) * 2u, loC = (unsigned)(dr * BCD + 8 * gc) * 2u;
#define SC_ISSUE_TILES(cvx_) do { const int cvx = (cvx_); const unsigned tvx = cvx * 128u; const unsigned rbx = (unsigned)row_of(b, cvx * 128); \
            _Pragma("unroll") for (int jj = 0; jj < 13; ++jj) { const int q = 8 * jj + w, r0 = 4 * (q & 31);   \
                const char* src; int toff; \
                if (jj < 4) { src = (const char*)(CBh + ((size_t)cvx * 16384u + (unsigned)r0 * 128u)) + loCB; toff = SC_CB; } \
                else if (jj < 8) { src = (const char*)(bt + ((size_t)r0 * TV + tvx)) + loT; toff = SC_BT; } \
                else if (jj < 12) { src = (const char*)(Cg + (size_t)(rbx + r0) * BCD) + loC; toff = SC_C; } \
                else { src = (const char*)(xt + ((size_t)r0 * TV + tvx)) + loT; toff = SC_X; } \
                GLDS16(src, L + toff + (q & 31) * 1024); } } while (0)
        const int kd = w >> 1; float km[8], dk[8];
#pragma unroll
        for (int i = 0; i < 8; ++i) { const int sidx = 32 * kd + 8 * fq + i; km[i] = (dir == 0 ? (sidx <= lrow) : (sidx >= lrow)) ? 1.f : 0.f; dk[i] = (sidx == lrow) ? Dsk : 0.f; }
#define SC_ISSUE_TAB(cvx_, tbuf_) do { if (w < 6) { const int tsel = w >> 1, half = w & 1; const float* tsrc = tsel == 0 ? CUM : (tsel == 1 ? DT : WJ); \
            GLDS4(tsrc + tbase + (cvx_) * 128 + half * 64 + F.lane, (LAS unsigned char*)(tab + (tbuf_) * 384 + tsel * 128 + half * 64)); } } while (0)
        { const int cv0 = SC_CHUNK_OF(0); SC_ISSUE_TILES(cv0); SC_ISSUE_TAB(cv0, 0); }
        for (int step = 0; step < NCH; ++step) {
            const int cv = SC_CHUNK_OF(step), buf = step & 1; const bool more = step + 1 < NCH;
            const int cvn = more ? SC_CHUNK_OF(step + 1) : cv;
            const unsigned rbase = (unsigned)row_of(b, cv * 128);
            if (step == 0) WAITV(0); else WAITV(2);
            LDSBAR();
            u32x4 rcb[4], rbt[4]; bf16x8 xf[2][4], cf[4];
#pragma unroll
            for (int ks = 0; ks < 4; ++ks) { const int fo = lrow * 256 + (((4 * ks + fq) ^ fr) << 4);
                rcb[ks] = *(const LAS u32x4*)(L + SC_CB + fo); rbt[ks] = *(const LAS u32x4*)(L + SC_BT + fo); cf[ks] = *(const LAS bf16x8*)(L + SC_C + fo);
#pragma unroll
                for (int nt = 0; nt < 2; ++nt) xf[nt][ks] = *(const LAS bf16x8*)(L + SC_X + (16 * nt + fr) * 256 + (((4 * ks + fq) ^ fr) << 4)); }
            LDSBAR();
            if (more) { SC_ISSUE_TILES(cvn); SC_ISSUE_TAB(cvn, buf ^ 1); }
            const LAS float* tb = tab + buf * 384;
            const float cl2 = tb[lrow]; const float ecum_l = fexp2(cl2);
            const float chunk_decay = fexp2(dir == 0 ? tb[127] : tb[0]);
            bf16x8 mf[4], bw[4];
#pragma unroll
            for (int ks = 0; ks < 4; ++ks) { const int s0 = 32 * ks + 8 * fq;
                const bool none = dir == 0 ? (ks > kd) : (ks < kd), diag = (ks == kd);
                unsigned om[4] = {0u, 0u, 0u, 0u};
                if (!none) {
                    const f32x4 cs0 = *(const LAS f32x4*)(tb + 128 + s0), cs1 = *(const LAS f32x4*)(tb + 128 + s0 + 4);
                    const float cs[8] = {cs0[0], cs0[1], cs0[2], cs0[3], cs1[0], cs1[1], cs1[2], cs1[3]};
                    const unsigned qc[4] = {rcb[ks].x, rcb[ks].y, rcb[ks].z, rcb[ks].w};
                    float v[8];
                    if (!diag) {
#pragma unroll
                        for (int i = 0; i < 8; ++i) { const float cbv = (i & 1) ? bfhi(qc[i >> 1]) : bflo(qc[i >> 1]); v[i] = cbv * fexp2(cl2 - cs[i]); }
                    } else {
#pragma unroll
                        for (int i = 0; i < 8; ++i) { const float cbv = (i & 1) ? bfhi(qc[i >> 1]) : bflo(qc[i >> 1]); const float x = cl2 - cs[i]; v[i] = (cbv * fexp2(x < 60.f ? x : 60.f)) * km[i] + dk[i]; }
                    }
#pragma unroll
                    for (int i = 0; i < 4; ++i) om[i] = pk2(v[2 * i], v[2 * i + 1]);
                }
                mf[ks] = __builtin_bit_cast(bf16x8, (u32x4){om[0], om[1], om[2], om[3]});
                { const f32x4 ws0 = *(const LAS f32x4*)(tb + 256 + s0), ws1 = *(const LAS f32x4*)(tb + 256 + s0 + 4); const float wsv[8] = {ws0[0], ws0[1], ws0[2], ws0[3], ws1[0], ws1[1], ws1[2], ws1[3]};
                  const unsigned qb[4] = {rbt[ks].x, rbt[ks].y, rbt[ks].z, rbt[ks].w}; unsigned ob[4];
#pragma unroll
                  for (int i = 0; i < 4; ++i) ob[i] = pk2(bflo(qb[i]) * wsv[2 * i], bfhi(qb[i]) * wsv[2 * i + 1]);
                  bw[ks] = __builtin_bit_cast(bf16x8, (u32x4){ob[0], ob[1], ob[2], ob[3]}); } }
            f32x4 yd[2], yo[2];
#pragma unroll
            for (int nt = 0; nt < 2; ++nt) { yd[nt] = (f32x4){0.f, 0.f, 0.f, 0.f}; yo[nt] = yd[nt]; accH[nt] = accH[nt] * chunk_decay; }
#pragma unroll
            for (int nt = 0; nt < 2; ++nt)
#pragma unroll
                for (int ks = 0; ks < 4; ++ks) {
                    yd[nt] = MFMA16(xf[nt][ks], mf[ks], yd[nt]);
                    const bf16x8 hf = *(const LAS bf16x8*)(Hl + buf * (32 * 136) + (16 * nt + fr) * 136 + 32 * ks + 8 * fq);
                    yo[nt] = MFMA16(hf, cf[ks], yo[nt]);
                    accH[nt] = MFMA16(bw[ks], xf[nt][ks], accH[nt]); }
#pragma unroll
            for (int nt = 0; nt < 2; ++nt) { u32x2 hw; hw.x = pk2(accH[nt][0], accH[nt][1]); hw.y = pk2(accH[nt][2], accH[nt][3]);
                *(LAS u32x2*)(Hl + (buf ^ 1) * (32 * 136) + (16 * nt + fr) * 136 + 16 * w + 4 * fq) = hw; }
#pragma unroll
            for (int nt = 0; nt < 2; ++nt) { u32x2 yw; yw.x = pk2(yd[nt][0] + ecum_l * yo[nt][0], yd[nt][1] + ecum_l * yo[nt][1]); yw.y = pk2(yd[nt][2] + ecum_l * yo[nt][2], yd[nt][3] + ecum_l * yo[nt][3]);
                *(u32x2*)(Y + ((size_t)(rbase + lrow) * DIN + 16 * nt + 4 * fq)) = yw; }
        }
        WAITV(0); LDSBAR();
    }
}

DEV void phase_gate(const Frame& F, int j, const bf16_t* Yf, const bf16_t* Yb, const bf16_t* Z, bf16_t* YN) {
    const int gw = F.bx * 8 + F.wave, NGW = F.G * 8; const float* nw = INP(F, I_SNORM) + (size_t)j * DIN;
    for (int r = gw; r < MT; r += NGW) {
        float t[32]; float ss = 0.f;
#pragma unroll
        for (int q = 0; q < 4; ++q) { const size_t o = (size_t)r * DIN + 8 * F.lane + 512 * q; const u32x4 a = *(const u32x4*)(Yf + o), bq = *(const u32x4*)(Yb + o), z = *(const u32x4*)(Z + o);
            const unsigned aa[4] = {a.x, a.y, a.z, a.w}, bb[4] = {bq.x, bq.y, bq.z, bq.w}, zz[4] = {z.x, z.y, z.z, z.w};
#pragma unroll
            for (int i = 0; i < 4; ++i) { const float v0 = (bflo(aa[i]) + bflo(bb[i])) * siluf(bflo(zz[i])), v1 = (bfhi(aa[i]) + bfhi(bb[i])) * siluf(bfhi(zz[i])); t[8 * q + 2 * i] = v0; t[8 * q + 2 * i + 1] = v1; ss += v0 * v0 + v1 * v1; } }
        const float rstd = rsqrtf(wave_sum(ss) * (1.0f / DIN) + EPS);
#pragma unroll
        for (int q = 0; q < 4; ++q) { const int c = 8 * F.lane + 512 * q; const f32x4 w0 = *(const f32x4*)(nw + c), w1 = *(const f32x4*)(nw + c + 4);
            u32x4 o; o.x = pk2(t[8 * q] * rstd * w0[0], t[8 * q + 1] * rstd * w0[1]); o.y = pk2(t[8 * q + 2] * rstd * w0[2], t[8 * q + 3] * rstd * w0[3]);
            o.z = pk2(t[8 * q + 4] * rstd * w1[0], t[8 * q + 5] * rstd * w1[1]); o.w = pk2(t[8 * q + 6] * rstd * w1[2], t[8 * q + 7] * rstd * w1[3]);
            *(u32x4*)(YN + (size_t)r * DIN + c) = o; }
    }
}

struct TokInfo { int s0, s1; float g0, g1; };
DEV void phase_route(const Frame& F, int layer, int ml, bf16_t* V) {
    LAS unsigned* lc = (LAS unsigned*)(F.lds + LDS_MISC + 256);
    if (F.tid < 8) lc[F.tid] = 0u;
    __syncthreads();
    const int gw = F.bx * 8 + F.wave, NGW = F.G * 8; const int j = layer / 2;
    const float* w = INP(F, I_NFFN) + (size_t)layer * D; const float* rw = INP(F, I_RW) + (size_t)j * D * NEXP;
    LAS float* rwl = (LAS float*)F.lds;
    for (int q = F.tid; q < D * 2; q += 512) { const int c = q >> 1, hf = q & 1; const int ln = (c & 255) >> 2, ii = c & 3, jq = c >> 8;
        *(LAS f32x4*)(rwl + ((jq * 4 + ii) * 64 + ln) * 8 + hf * 4) = *(const f32x4*)(rw + (size_t)q * 4); }
    __syncthreads();
    TokInfo* tok = (TokInfo*)(F.ws + OFF_TOK);
    for (int r = gw; r < MT; r += NGW) {
        f32x4 v[4]; load_row(F.H + (size_t)r * D, F.lane, v);
        const float rstd = rsqrtf(sumsq_row(v) * (1.0f / D) + EPS);
        const int vec = vec_of(r);
        normmod_row(v, rstd, w, modp(F, layer, vec, 3), modp(F, layer, vec, 4), F.lane);
#pragma unroll
        for (int jq = 0; jq < 4; ++jq) *(unsigned*)((fp8_t*)V + (size_t)r * D + 4 * F.lane + 256 * jq) = pk4_fp8(v[jq][0] * 8.0f, v[jq][1] * 8.0f, v[jq][2] * 8.0f, v[jq][3] * 8.0f);
        float lg[NEXP];
#pragma unroll
        for (int e = 0; e < NEXP; ++e) lg[e] = 0.f;
#pragma unroll
        for (int jj = 0; jj < 4; ++jj)
#pragma unroll
            for (int i = 0; i < 4; ++i) { const LAS float* rp = rwl + ((jj * 4 + i) * 64 + F.lane) * 8; const f32x4 r0 = *(const LAS f32x4*)rp, r1 = *(const LAS f32x4*)(rp + 4);
#pragma unroll
                for (int e = 0; e < 4; ++e) { lg[e] += v[jj][i] * r0[e]; lg[4 + e] += v[jj][i] * r1[e]; } }
#pragma unroll
        for (int e = 0; e < NEXP; ++e) lg[e] = wave_sum(lg[e]);
        int e0 = 0; float v0 = lg[0];
#pragma unroll
        for (int e = 1; e < NEXP; ++e) if (lg[e] > v0) { v0 = lg[e]; e0 = e; }
        int e1 = -1; float v1 = -3.0e38f;
#pragma unroll
        for (int e = 0; e < NEXP; ++e) if (e != e0 && lg[e] > v1) { v1 = lg[e]; e1 = e; }
        const float g1 = frcp(1.0f + FEXP(v0 - v1)), g0 = 1.0f - g1;
        if (F.lane == 0) { TokInfo ti; ti.s0 = e0; ti.s1 = e1; ti.g0 = g0; ti.g1 = g1; tok[r] = ti; atomicAdd((unsigned*)&lc[e0], 1u); atomicAdd((unsigned*)&lc[e1], 1u); }
    }
    __syncthreads();
    if (F.tid < 8) __hip_atomic_fetch_add(F.ctl + CW_CNT + (ml * 8 + F.tid) * 64, lc[F.tid], RLX_AGENT);
}
DEV void tile_starts(const Frame& F, int ml, int (&ts)[NEXP + 1], unsigned (&cnt)[NEXP]) {
    ts[0] = 0;
#pragma unroll
    for (int e = 0; e < NEXP; ++e) { cnt[e] = __hip_atomic_load(F.ctl + CW_CNT + (ml * 8 + e) * 64, RLX_AGENT); ts[e + 1] = ts[e] + (int)((cnt[e] + 255u) / 256u); }
}
DEV void phase_slots(const Frame& F, int ml) {
    int ts[NEXP + 1]; unsigned cnt[NEXP]; tile_starts(F, ml, ts, cnt);
    TokInfo* tok = (TokInfo*)(F.ws + OFF_TOK); int* s2t = (int*)(F.ws + OFF_S2T);
    const int gw = F.bx * 8 + F.wave, NGW = F.G * 8;
    for (int base = gw * 64; base < MT; base += NGW * 64) {
        const int r = base + F.lane; TokInfo ti = tok[r];
        const int ek[2] = {ti.s0, ti.s1}; int sl[2];
#pragma unroll
        for (int k = 0; k < 2; ++k) { sl[k] = 0;
            for (int e = 0; e < NEXP; ++e) { const unsigned long long m = __ballot(ek[k] == e);
                if (m) { const int leader = __builtin_ctzll(m); unsigned b0 = 0;
                    if (F.lane == leader) b0 = __hip_atomic_fetch_add(F.ctl + CW_CUR + (ml * 8 + e) * 64, (unsigned)__builtin_popcountll(m), RLX_AGENT);
                    b0 = __shfl(b0, leader);
                    if (ek[k] == e) sl[k] = ts[e] * 256 + (int)b0 + __builtin_popcountll(m & ((1ull << F.lane) - 1ull)); } } }
        ti.s0 = sl[0]; ti.s1 = sl[1]; tok[r] = ti; s2t[sl[0]] = r; s2t[sl[1]] = r;
    }
    if (F.bx == 0) { for (int e = 0; e < NEXP; ++e) { const int a = ts[e] * 256 + (int)cnt[e], b2 = ts[e + 1] * 256; for (int s = a + F.tid; s < b2; s += 512) s2t[s] = 0; } }
}
DEV void phase_combine(const Frame& F, int layer, const bf16_t* YS, bool final_) {
    const int gw = F.bx * 8 + F.wave, NGW = F.G * 8; const TokInfo* tok = (const TokInfo*)(F.ws + OFF_TOK);
    const int nrows = final_ ? ML : MT;
    for (int r = gw; r < nrows; r += NGW) {
        f32x4 v[4]; load_row(F.H + (size_t)r * D, F.lane, v);
        TokInfo ti = tok[r]; if (MOE_DOWN_FP8) { ti.g0 *= 0.00390625f; ti.g1 *= 0.00390625f; }
        const float* g2 = modp(F, layer, vec_of(r), 5);
#pragma unroll
        for (int jj = 0; jj < 4; ++jj) { const int c = 4 * F.lane + 256 * jj; const u32x2 a = *(const u32x2*)(YS + (size_t)ti.s0 * D + c), b = *(const u32x2*)(YS + (size_t)ti.s1 * D + c); const f32x4 gv = *(const f32x4*)(g2 + c);
            v[jj][0] += gv[0] * (ti.g0 * bflo(a.x) + ti.g1 * bflo(b.x)); v[jj][1] += gv[1] * (ti.g0 * bfhi(a.x) + ti.g1 * bfhi(b.x));
            v[jj][2] += gv[2] * (ti.g0 * bflo(a.y) + ti.g1 * bflo(b.y)); v[jj][3] += gv[3] * (ti.g0 * bfhi(a.y) + ti.g1 * bfhi(b.y)); }
        if (!final_) {
#pragma unroll
            for (int jj = 0; jj < 4; ++jj) *(f32x4*)(F.H + (size_t)r * D + 4 * F.lane + 256 * jj) = v[jj];
        } else {
            const float rstd = rsqrtf(sumsq_row(v) * (1.0f / D) + EPS); const float* fw = INP(F, I_FNORM);
#pragma unroll
            for (int jj = 0; jj < 4; ++jj) { const int c = 4 * F.lane + 256 * jj; *(f32x4*)(OUTP(F) + (size_t)r * D + c) = v[jj] * rstd * *(const f32x4*)(fw + c); }
        }
    }
}

constexpr int PH_PER_PAIR = 17, N_PHASES = 1 + 2 * PH_PER_PAIR;
__global__ void __launch_bounds__(512, 2) fwd_kernel(Params prm) {
#ifdef EMU
    unsigned char* lds_raw = emu_lds();
#else
    extern __shared__ __attribute__((aligned(16))) unsigned char lds_raw[];
#endif
    Frame F;
    F.lds = (LAS unsigned char*)lds_raw;
    F.tid = threadIdx.x; F.lane = F.tid & 63; F.wave = RFL(F.tid >> 6); F.G = gridDim.x; F.bx = blockIdx.x;
    F.p = &prm; F.ws = prm.ws; F.ctl = (unsigned*)(prm.ws + OFF_CTL); F.H = (float*)(prm.ws + OFF_H); F.mod = (float*)(prm.ws + OFF_MOD);
    volatile LAS unsigned* misc = (volatile LAS unsigned*)(F.lds + LDS_MISC);
    if (F.tid < 64) misc[F.tid] = 0u;
    __syncthreads();
    XcdBarrier bar; bar.bar = F.ctl + CW_BAR; bar.x = 0; bar.st = misc;
    const int lo = prm.ph_lo, hi = prm.ph_hi;
    if (hi - lo > 1) bar = xcd_barrier_post(F.ctl + CW_BAR, misc);
    int ph = 0;
#ifndef SITE_MASK
#define SITE_MASK 0xFFFFFFFFu
#endif
#ifndef PROBE_REPEAT_SITE
#define PROBE_REPEAT_SITE (-1)
#endif
#define PH_REPS(site) ((PROBE_REPEAT_SITE == (site)) ? 2 : 1)
#define PHASE_BEGIN(site) if (((SITE_MASK >> (site)) & 1u) && lo <= ph && ph < hi) { { int _t = threadIdx.x; LAUNDER_V(_t); F.tid = _t; F.lane = _t & 63; int _b = blockIdx.x; LAUNDER_S(_b); F.bx = _b; int _g = gridDim.x; LAUNDER_S(_g); F.G = _g; \
      F.ws = WSP(F); F.ctl = (unsigned*)(F.ws + OFF_CTL); F.H = (float*)(F.ws + OFF_H); F.mod = (float*)(F.ws + OFF_MOD); } \
      for (int _rep = 0; _rep < PH_REPS(site); ++_rep) { if (_rep) __syncthreads();
#define PHASE_END   } if (ph + 1 < hi) xcd_barrier(bar); } ++ph;
#define B_W (F.ws + OFF_W)
#define B_ACT (F.ws + OFF_ACT)
#define B_P ((bf16_t*)(B_ACT + A_P))
#define B_HID ((bf16_t*)(B_ACT + A_HID))
#define B_U ((bf16_t*)(B_ACT + A_U))
#define B_Z ((bf16_t*)(B_ACT + A_Z))
#define B_XBC ((bf16_t*)(B_ACT + A_XBC))
#define B_DT ((float*)(B_W + W_DT))
#define B_XT ((bf16_t*)(B_ACT + A_XT))
#define B_BROW ((bf16_t*)(B_ACT + A_BROW))
#define B_BT ((bf16_t*)(B_ACT + A_BT))
#define B_CROW ((bf16_t*)(B_ACT + A_CROW))
#define B_CB ((bf16_t*)(B_ACT + A_CB))
#define B_CUM ((float*)(B_ACT + A_CUM))
#define B_WJ ((float*)(B_ACT + A_WJ))
#define B_YF ((bf16_t*)(B_ACT + A_YF))
#define B_YB ((bf16_t*)(B_W + W_YB))
#define B_YN ((bf16_t*)(B_ACT + A_YN))
#define B_V ((bf16_t*)(B_ACT + A_V))
#define B_HIDM ((bf16_t*)(B_ACT + A_HIDM))
#define B_YS ((bf16_t*)(B_ACT + A_YS))

    PHASE_BEGIN(0) phase_mod(F); convert_even(F, 0); PHASE_END

    for (int lp = 0; lp < 2; ++lp) {
        const int le = 2 * lp, lod = 2 * lp + 1;
        PHASE_BEGIN(1) phase_poolprep(F, le, B_P); PHASE_END
        PHASE_BEGIN(2) { PolPool S; S.G = F.G; S.c = F.bx; S.K = 256; S.lda = D; S.ldb = 256; S.P = B_P; S.W = (const bf16_t*)(B_W + W_POOL); S.src = mksrc(F); S.layer = le; S.scale = INP(F, I_POOLS) + (size_t)lp * D;
                      ge::gemm_phase(F.lds, S, F.tid); } PHASE_END
        PHASE_BEGIN(3) phase_norm(F, le, 3, B_P, false); PHASE_END
        PHASE_BEGIN(4) { PolUp<false> S; S.G = F.G; S.c = F.bx; S.K = D; S.lda = D; S.ldb = D; S.A = B_P; S.W = (const bf16_t*)(B_W + W_UP); S.HID = B_HID; S.ldh = DFF; S.nq = DFF / 128; S.nM = NPAN; S.s2t = nullptr;
                      ge::gemm_phase(F.lds, S, F.tid); } PHASE_END
        PHASE_BEGIN(5) { PolResid S; S.G = F.G; S.c = F.bx; S.K = DFF; S.lda = DFF; S.ldb = DFF; S.A = B_HID; S.W = (const bf16_t*)(B_W + W_DN); S.src = mksrc(F); S.layer = le; S.which = 5;
                      ge::gemm_phase(F.lds, S, F.tid); } PHASE_END
        PHASE_BEGIN(6) phase_norm(F, lod, 0, B_U, false); convert_ssd(F, lp); PHASE_END
        PHASE_BEGIN(7) { PolInProj S; S.G = F.G; S.c = F.bx; S.K = D; S.lda = D; S.ldb = D; S.A = B_U; S.W = (const bf16_t*)(B_W + W_IN); S.Z = B_Z; S.XBC = B_XBC; S.DT = B_DT;
                      ge::gemm_phase(F.lds, S, F.tid); } PHASE_END
        PHASE_BEGIN(8) phase_conv(F, lp, B_XBC, B_XT, B_BROW, B_BT, B_CROW); PHASE_END
        PHASE_BEGIN(9) phase_cb(F, B_BROW, B_CROW, B_CB); phase_tables(F, lp, B_DT, B_CUM, B_WJ); PHASE_END
        PHASE_BEGIN(10) phase_scan(F, lp, B_XT, B_BT, B_CROW, B_CB, B_DT, B_CUM, B_WJ, B_YF, B_YB); PHASE_END
        PHASE_BEGIN(11) phase_gate(F, lp, B_YF, B_YB, B_Z, B_YN); PHASE_END
        PHASE_BEGIN(12) { PolResid S; S.G = F.G; S.c = F.bx; S.K = DIN; S.lda = DIN; S.ldb = DIN; S.A = B_YN; S.W = (const bf16_t*)(B_W + W_OUT); S.src = mksrc(F); S.layer = lod; S.which = 2;
                      ge::gemm_phase(F.lds, S, F.tid); } PHASE_END
        PHASE_BEGIN(13) phase_route(F, lod, lp, B_V); convert_moe(F, lp); PHASE_END
        PHASE_BEGIN(14) phase_slots(F, lp); PHASE_END
        PHASE_BEGIN(15) { int ts[NEXP + 1]; unsigned cnt[NEXP]; tile_starts(F, lp, ts, cnt);
                      PolUp<true> S; S.G = F.G; S.c = F.bx; S.K = D; S.lda = D; S.ldb = D; S.A = B_V; S.W = (const bf16_t*)(B_W + W_MUP); S.HID = B_HIDM; S.ldh = DFFE; S.nq = DFFE / 128; S.nM = ts[NEXP];
                      S.s2t = (const int*)(F.ws + OFF_S2T);
#pragma unroll
                      for (int e = 0; e <= NEXP; ++e) S.tstart[e] = ts[e];
                      ge::gemm_phase(F.lds, S, F.tid); } PHASE_END
        PHASE_BEGIN(16) { int ts[NEXP + 1]; unsigned cnt[NEXP]; tile_starts(F, lp, ts, cnt);
                      PolMoeDown S; S.G = F.G; S.c = F.bx; S.K = DFFE; S.lda = DFFE; S.ldb = DFFE; S.A = B_HIDM; S.W = (const bf16_t*)(B_W + W_MDN); S.YS = B_YS; S.nM = ts[NEXP];
#pragma unroll
                      for (int e = 0; e <= NEXP; ++e) S.tstart[e] = ts[e];
                      ge::gemm_phase(F.lds, S, F.tid); } PHASE_END
        PHASE_BEGIN(17) phase_combine(F, lod, B_YS, lp == 1); if (lp == 0) convert_even(F, 1); PHASE_END
    }
#undef PHASE_BEGIN
#undef PHASE_END
}

extern "C" void kernel_launch(void* const* d_in, const int* in_sizes, int n_in, void* d_out, int out_size, void* d_ws, size_t ws_size, hipStream_t stream) {
    static int grid = 0;
    if (grid == 0) {
        if (n_in != 26 || ws_size < WS_NEED) { fprintf(stderr, "kernel_launch: need 26 inputs and %zu bytes of workspace (got %d, %zu)\n", (size_t)WS_NEED, n_in, ws_size); grid = -1; return; }
        int dev = 0, cus = 0, per_cu = 0;
        if (hipGetDevice(&dev) != hipSuccess || hipDeviceGetAttribute(&cus, hipDeviceAttributeMultiprocessorCount, dev) != hipSuccess) { grid = -1; return; }
        if (hipFuncSetAttribute((const void*)fwd_kernel, hipFuncAttributeMaxDynamicSharedMemorySize, LDS_BYTES) != hipSuccess) { grid = -1; return; }
        if (hipOccupancyMaxActiveBlocksPerMultiprocessor(&per_cu, (const void*)fwd_kernel, 512, LDS_BYTES) != hipSuccess || per_cu < 1) { fprintf(stderr, "kernel_launch: occupancy query says %d\n", per_cu); }
        (void)hipGetLastError();
        grid = cus;
    }
    if (grid < 0) return;
    (void)in_sizes; (void)out_size;
    if (hipMemsetAsync((char*)d_ws + OFF_CTL, 0, CTL_BYTES, stream) != hipSuccess) return;
    Params p{};
    for (int i = 0; i < 26; ++i) p.in[i] = (const float*)d_in[i];
    p.out = (float*)d_out; p.ws = (unsigned char*)d_ws;
    if (N_LAUNCH_MODE == 1) { p.ph_lo = 0; p.ph_hi = N_PHASES; hipLaunchKernelGGL(fwd_kernel, dim3(grid), dim3(512), LDS_BYTES, stream, p); }
    else for (int ph = 0; ph < N_PHASES; ++ph) { p.ph_lo = ph; p.ph_hi = ph + 1; hipLaunchKernelGGL(fwd_kernel, dim3(grid), dim3(512), LDS_BYTES, stream, p); }
}
```

```cpp
#ifndef EMU
#include <hip/hip_runtime.h>
#endif
#include <cstdio>
#include <cstdint>

#ifndef CFG_SEQ
#define CFG_SEQ 16384
#endif
#ifndef CFG_DFF
#define CFG_DFF 2816
#endif
#ifndef CFG_DFFE
#define CFG_DFFE 3584
#endif
#ifndef MOE_DOWN_FP8
#define MOE_DOWN_FP8 1
#endif
#ifndef N_LAUNCH_MODE
#define N_LAUNCH_MODE 1
#endif

#ifdef EMU
#define LAS
#define DEV inline
#define WAITV(n) ((void)0)
#define WAITL(n) ((void)0)
#define SBAR() emu_wg_sync()
#define SCHED() ((void)0)
#define SETPRIO(x) ((void)0)
#define MFMA16(a, b, c) emu_mfma16(a, b, c)
#define GLDS16(g, l) emu_glds16((const void*)(g), (void*)(l))
#define GLDS4(g, l) emu_glds4((const void*)(g), (void*)(l))
#define MFMA8(a, b, c) emu_mfma8(a, b, c)
#define RFL(x) emu_rfl(x)
#define MEMFENCE() ((void)0)
#define WSYNC() emu_wave_sync()
#define LDSBAR() emu_wg_sync()
#define LAUNDER_V(x) ((void)0)
#define SLEEP1() emu_yield()
#define MY_XCC_ID() ((unsigned)(blockIdx.x & 7u))
#define FENCE_REL() __atomic_thread_fence(__ATOMIC_SEQ_CST)
#define FENCE_ACQ() __atomic_thread_fence(__ATOMIC_SEQ_CST)
#define FEXP(x) expf(x)
#define RLX_AGENT __ATOMIC_RELAXED, 4
#else
#define LAS __attribute__((address_space(3)))
#define DEV __device__ __forceinline__
#define WAITV(n) asm volatile("s_waitcnt vmcnt(" #n ")" ::: "memory")
#define WAITL(n) asm volatile("s_waitcnt lgkmcnt(" #n ")" ::: "memory")
#define SBAR() __builtin_amdgcn_s_barrier()
#define SCHED() __builtin_amdgcn_sched_barrier(0)
#define SETPRIO(x) __builtin_amdgcn_s_setprio(x)
#define MFMA16(a, b, c) __builtin_amdgcn_mfma_f32_16x16x32_bf16(a, b, c, 0, 0, 0)
#define GLDS16(g, l) __builtin_amdgcn_global_load_lds((const unsigned*)(g), (LAS unsigned*)(l), 16, 0, 0)
#define GLDS4(g, l) __builtin_amdgcn_global_load_lds((const unsigned*)(g), (LAS unsigned*)(l), 4, 0, 0)
#define MFMA8(a, b, c) __builtin_amdgcn_mfma_scale_f32_16x16x128_f8f6f4(a, b, c, 0, 0, 0, 0x7f7f7f7f, 0, 0x7f7f7f7f)
#define RFL(x) __builtin_amdgcn_readfirstlane(x)
#define MEMFENCE() asm volatile("" ::: "memory")
#define LDSBAR() do { asm volatile("s_waitcnt lgkmcnt(0)" ::: "memory"); __builtin_amdgcn_s_barrier(); asm volatile("" ::: "memory"); } while (0)
#define WSYNC() asm volatile("s_waitcnt lgkmcnt(0)" ::: "memory")
#define SLEEP1() __builtin_amdgcn_s_sleep(1)
#define MY_XCC_ID() ((unsigned)__builtin_amdgcn_s_getreg((3 << 11) | 20) & 0xFu)
#define FENCE_REL() __builtin_amdgcn_fence(__ATOMIC_RELEASE, "agent")
#define FENCE_ACQ() __builtin_amdgcn_fence(__ATOMIC_ACQUIRE, "agent")
#define FEXP(x) __expf(x)
#define RLX_AGENT __ATOMIC_RELAXED, __HIP_MEMORY_SCOPE_AGENT
#define LAUNDER_V(x) asm volatile("" : "+v"(x))
#endif

typedef unsigned short bf16_t;
typedef short bf16x8 __attribute__((ext_vector_type(8)));
typedef float f32x4 __attribute__((ext_vector_type(4)));
typedef float f32x2 __attribute__((ext_vector_type(2)));
typedef unsigned u32x4 __attribute__((ext_vector_type(4)));
typedef unsigned u32x2 __attribute__((ext_vector_type(2)));
typedef int i32x8 __attribute__((ext_vector_type(8)));
typedef int i32x4 __attribute__((ext_vector_type(4)));
typedef unsigned char fp8_t;

constexpr int D = 1024, NB = 2, SEQ = CFG_SEQ, CTXL = 256, DEPTH = 4;
constexpr int ML = NB * SEQ, MC = NB * CTXL, MT = ML + MC, NPAN = MT / 256;
constexpr int DFF = CFG_DFF, DFFE = CFG_DFFE, NEXP = 8;
constexpr int DIN = 2048, NH = 32, HD = 64, NG = 4, DS = 128, CONVD = 3072, NPROJ = 5184, NPROJP = 5376, BCD = 512;
constexpr int TV = CTXL + SEQ, NCH = TV / 128;
constexpr int GRIDW = 64;
constexpr float EPS = 1e-6f;
constexpr int NSLOT_TILES = (2 * MT) / 256 + NEXP, NSLOT = NSLOT_TILES * 256;
static_assert(SEQ % 128 == 0 && ML % 256 == 0 && DFF % 128 == 0 && DFFE % 128 == 0 && DFF >= 256 && DFFE >= 256, "shape constraints");

constexpr size_t MiB = 1u << 20;
constexpr size_t al(size_t x) { return (x + 4095) & ~(size_t)4095; }
constexpr size_t OFF_CTL = 0, CTL_BYTES = 1 * MiB;
constexpr size_t OFF_MOD = 1 * MiB;
constexpr size_t OFF_TOK = 2 * MiB;
constexpr size_t OFF_S2T = 3 * MiB;
constexpr size_t OFF_H = 4 * MiB, SZ_H = (size_t)MT * D * 4;
constexpr size_t OFF_W = OFF_H + al(SZ_H);
constexpr size_t W_POOL = 0, SZ_WPOOL = (size_t)4 * 256 * 256 * 2;
constexpr size_t W_UP = al(SZ_WPOOL), SZ_WUP = (size_t)2 * DFF * D * 2;
constexpr size_t W_DN = W_UP + al(SZ_WUP), SZ_WDN = (size_t)D * DFF * 2;
constexpr size_t SZ_WEVEN = W_DN + al(SZ_WDN);
constexpr size_t W_IN = 0, SZ_WIN = (size_t)NPROJP * D * 2;
constexpr size_t W_OUT = al(SZ_WIN), SZ_WOUT = (size_t)D * DIN * 2;
constexpr size_t W_DT = W_OUT + al(SZ_WOUT), SZ_DT = (size_t)NB * 2 * NH * TV * 4;
constexpr size_t W_MUP = W_DT + al(SZ_DT), SZ_WMUP = (size_t)NEXP * 2 * DFFE * D * 2;
constexpr size_t W_MDN = W_MUP + al(SZ_WMUP), SZ_WMDN = (size_t)NEXP * D * DFFE * 2;
constexpr size_t W_YB = W_MUP, SZ_Y = (size_t)MT * DIN * 2;
constexpr size_t SZ_WODD_A = W_MDN + al(SZ_WMDN), SZ_WODD_B = W_YB + al(SZ_Y);
constexpr size_t mx(size_t a, size_t b) { return a > b ? a : b; }
constexpr size_t SZ_W = mx(SZ_WEVEN, mx(SZ_WODD_A, SZ_WODD_B));
constexpr size_t OFF_ACT = OFF_W + SZ_W;
constexpr size_t A_P = 0, SZ_ACT1 = (size_t)MT * D * 2;
constexpr size_t A_HID = al(SZ_ACT1), SZ_HID = (size_t)MT * DFF * 2;
constexpr size_t SZ_AEVEN = A_HID + al(SZ_HID);
constexpr size_t A_Z = 0;
constexpr size_t A_XBC = al(SZ_Y), SZ_XBC = (size_t)MT * CONVD * 2;
constexpr size_t A_YF = A_XBC;
constexpr size_t A_CB = A_XBC + al(SZ_Y), SZ_CB = (size_t)NB * NG * NCH * 128 * 128 * 2;
static_assert(al(SZ_Y) + SZ_CB <= SZ_XBC, "CB fits behind Yf inside the XBC region");
constexpr size_t A_XT = A_XBC + al(SZ_XBC), SZ_XT = (size_t)NB * DIN * TV * 2;
constexpr size_t A_U = A_XT, A_YN = A_XT;
constexpr size_t A_BROW = A_XT + al(SZ_XT), SZ_BC = (size_t)MT * BCD * 2;
constexpr size_t A_BT = A_BROW + al(SZ_BC);
constexpr size_t A_CROW = A_BT + al(SZ_BC);
constexpr size_t A_CUM = A_CROW + al(SZ_BC);
constexpr size_t A_WJ = A_CUM + al(SZ_DT);
constexpr size_t SZ_ASSD = A_WJ + al(SZ_DT);
constexpr size_t A_V = 0;
constexpr size_t A_HIDM = al(SZ_ACT1), SZ_HIDM = (size_t)NSLOT * DFFE * 2;
constexpr size_t A_YS = A_HIDM + al(SZ_HIDM), SZ_YS = (size_t)NSLOT * D * 2;
constexpr size_t SZ_AMOE = A_YS + al(SZ_YS);
constexpr size_t SZ_ACT = mx(SZ_AEVEN, mx(SZ_ASSD, SZ_AMOE));
constexpr size_t WS_NEED = OFF_ACT + SZ_ACT;

constexpr int CW_BAR = 4096;
constexpr int CW_CNT = 16384;
constexpr int CW_CUR = 16384 + 2 * 8 * 64;

DEV unsigned f2bf(float f) { unsigned u = __builtin_bit_cast(unsigned, f); return (u + 0x7fffu + ((u >> 16) & 1u)) >> 16; }
#ifndef EMU
typedef __bf16 bf16x2n __attribute__((ext_vector_type(2)));
#endif
DEV unsigned pk2(float lo, float hi) {
#ifdef EMU
    return f2bf(lo) | (f2bf(hi) << 16);
#else
    f32x2 v = {lo, hi}; bf16x2n b = __builtin_convertvector(v, bf16x2n); return __builtin_bit_cast(unsigned, b);
#endif
}
DEV unsigned pk4_fp8(float a, float b, float c, float d) {
#ifdef EMU
    return emu_f2fp8(a) | (emu_f2fp8(b) << 8) | (emu_f2fp8(c) << 16) | (emu_f2fp8(d) << 24);
#else
    unsigned w = 0; w = __builtin_amdgcn_cvt_pk_fp8_f32(a, b, w, false); w = __builtin_amdgcn_cvt_pk_fp8_f32(c, d, w, true); return w;
#endif
}
DEV float bf2f(unsigned b) { return __builtin_bit_cast(float, b << 16); }
DEV float bflo(unsigned w) { return __builtin_bit_cast(float, w << 16); }
DEV float bfhi(unsigned w) { return __builtin_bit_cast(float, w & 0xffff0000u); }
#ifdef EMU
DEV float frcp(float x) { return 1.0f / x; }
#else
DEV float frcp(float x) { return __builtin_amdgcn_rcpf(x); }
#endif
#ifdef EMU
DEV float fexp2(float x) { return exp2f(x); }
#else
DEV float fexp2(float x) { return __builtin_amdgcn_exp2f(x); }
#endif
DEV float siluf(float x) { return x * frcp(1.0f + FEXP(-x)); }
#ifdef EMU
DEV float flog2(float x) { return log2f(x); }
#else
DEV float flog2(float x) { return __builtin_amdgcn_logf(x); }
#endif
DEV float softplusf(float x) { if (x > 20.f) return x; const float e = FEXP(x); return e < 0.0625f ? e * (1.0f - e * (0.5f - e * (0.33333334f - e * (0.25f - e * 0.2f)))) : flog2(1.0f + e) * 0.6931471806f; }
DEV float wave_sum(float v) {
#pragma unroll
    for (int o = 1; o < 64; o <<= 1) v += __shfl_xor(v, o);
    return v;
}
DEV int vec_of(int r) { return r < ML ? (r / SEQ) : 2; }
DEV int row_of(int b, int tv) { return tv < CTXL ? ML + b * CTXL + tv : b * SEQ + (tv - CTXL); }

#define XB_TMO      128
#define XB_XCNT(j)  (256  + 64 * (j))
#define XB_XSUB(j)  (1280 + 64 * (j))
#define XB_XGEN(j)  (2304 + 64 * (j))
#define XB_TOP      3328
#define XB_TOPGEN   3392
#define XCD_BAR_WORDS 3456
#define XB_SPIN_CAP (1u << 22)
DEV unsigned xb_ld(unsigned* p)              { return __hip_atomic_load(p, RLX_AGENT); }
DEV unsigned xb_add(unsigned* p, unsigned v) { return __hip_atomic_fetch_add(p, v, RLX_AGENT); }
#define XB_SPIN(cond, bar) do { unsigned _sp = 0; while (cond) { SLEEP1(); \
    if ((++_sp & 255u) == 0u) { if (xb_ld(&(bar)[XB_TMO])) break; if (_sp > XB_SPIN_CAP) { atomicAdd(&(bar)[XB_TMO], 1u); break; } } } } while (0)
struct XcdBarrier { unsigned* bar; unsigned x; volatile LAS unsigned* st; };
DEV XcdBarrier xcd_barrier_post(unsigned* bar, volatile LAS unsigned* st) {
    XcdBarrier b; b.bar = bar; b.x = MY_XCC_ID(); b.st = st;
    if (threadIdx.x == 0) (void)xb_add(&bar[XB_XCNT(b.x)], 1u);
    return b;
}
DEV void xcd_barrier_complete(unsigned* bar, unsigned x, unsigned& nloc, unsigned& nx) {
    const unsigned G = gridDim.x;
    unsigned sum, cnt, mine, sp = 0u;
    for (;;) {
        sum = 0u; cnt = 0u; mine = 0u;
#pragma unroll
        for (unsigned j = 0; j < 16; ++j) { const unsigned c = xb_ld(&bar[XB_XCNT(j)]); sum += c; cnt += (c > 0u) ? 1u : 0u; mine = (j == x) ? c : mine; }
        if (sum == G) break;
        SLEEP1();
        if ((++sp & 255u) == 0u) { if (xb_ld(&bar[XB_TMO])) break; if (sp > XB_SPIN_CAP) { atomicAdd(&bar[XB_TMO], 1u); break; } }
    }
    nloc = mine > 0u ? mine : 1u; nx = cnt > 0u ? cnt : 1u;
}
DEV void xcd_barrier(const XcdBarrier& b) {
    WAITV(0);
    __syncthreads();
    if (threadIdx.x == 0) {
        unsigned* bar = b.bar;
#ifndef EMU
        __builtin_amdgcn_s_waitcnt(0);
#endif
        unsigned nloc = b.st[0], nx = b.st[1];
        if (nloc == 0u) { xcd_barrier_complete(bar, b.x, nloc, nx); b.st[0] = nloc; b.st[1] = nx; }
        const unsigned old = xb_add(&bar[XB_XSUB(b.x)], 1u);
        const unsigned gen = old / nloc;
        if (old + 1u == (gen + 1u) * nloc) {
            FENCE_REL();
            WAITV(0);
            const unsigned og = xb_add(&bar[XB_TOP], 1u);
            const unsigned tg = og / nx;
            if (og + 1u == (tg + 1u) * nx) xb_add(&bar[XB_TOPGEN], 1u);
            else XB_SPIN(xb_ld(&bar[XB_TOPGEN]) == tg, bar);
            FENCE_ACQ();
            xb_add(&bar[XB_XGEN(b.x)], 1u);
            WAITV(0);
        } else {
            XB_SPIN(xb_ld(&bar[XB_XGEN(b.x)]) == gen, bar);
            FENCE_ACQ();
            WAITV(0);
        }
    }
    __syncthreads();
}

namespace ge {
constexpr int BM = 256, BK = 64, HALF = 128, HTB = HALF * BK * 2, STAGE_BYTES = 8 * HTB, NXCD = 8, WGM = 8;
DEV int lds_byte(int r, int c) { const int st = (r >> 4) * 2 + (c >> 5), rr = r & 15, cc = c & 31, ob = rr * 64 + cc * 2; return st * 1024 + (ob ^ (((ob >> 9) & 1) << 5)); }
DEV void stage_rc(int b, int& R, int& C) { const int st = b / 1024, sb = b % 1024, swz = sb ^ (((sb >> 9) & 1) << 5); R = (st >> 1) * 16 + swz / 64; C = (st & 1) * 32 + (swz % 64) / 2; }
DEV int perm32(int rho) { const int n = rho >> 4, i = rho & 15; return 8 * (i >> 2) + 4 * n + (i & 3); }
struct Unit { int pm, pn; };
DEV bool static_next(int nM, int nN, int G, int c, int i, Unit& u) {
    const int nwg = nM * nN; const long L = (long)i * G + c; if (L >= nwg) return false;
    int wgid = (int)L; { const int q = nwg / NXCD, r = nwg % NXCD, xcd = wgid % NXCD, off = wgid / NXCD; wgid = (xcd < r ? xcd * (q + 1) : r * (q + 1) + (xcd - r) * q) + off; }
    const int nig = WGM * nN, gid = wgid / nig, fm = gid * WGM, gsz = (nM - fm) < WGM ? (nM - fm) : WGM;
    u.pm = fm + ((wgid % nig) % gsz); u.pn = (wgid % nig) / gsz; return true;
}
template <class P, bool SP2 = true>
DEV void gemm_phase(LAS unsigned char* lds, const P& S, const int tid) {
    const int wid = RFL(tid >> 6), lane = tid & 63, wr = wid >> 2, wc = wid & 3, fr = lane & 15, fq = lane >> 4;
    const int K = S.K, nt = K * P::ES / (BK * 2);
    unsigned voffB[2]; int RA[2], CA2[2];
#pragma unroll
    for (int i = 0; i < 2; ++i) { int R, C; stage_rc(tid * 16 + i * 8192, R, C); const int Rb = P::PERM ? ((R & ~31) + perm32(R & 31)) : R;
        RA[i] = R; CA2[i] = C * 2; voffB[i] = (unsigned)(Rb * S.ldb) * (unsigned)P::ES + (unsigned)(C * 2); }
    const size_t kstep = (size_t)(BK * 2);
    const size_t hstepB = (size_t)HALF * S.ldb * P::ES;
    const unsigned ldsw = (unsigned)wid * 1024u;
    const int aoff = lds_byte(wr * 64 + fr, fq * 8), boff = lds_byte(wc * 32 + fr, fq * 8);
#define GE_SA(b, h) (((b) * 2 + (h)) * HTB)
#define GE_SB(b, h) ((4 + (b) * 2 + (h)) * HTB)
#define GE_STAGEB(bufoff, gbase) do { _Pragma("unroll") for (int _i = 0; _i < 2; ++_i) { unsigned _o = voffB[_i]; LAUNDER_V(_o); \
        GLDS16((const char*)(gbase) + _o, lds + (bufoff) + ldsw + _i * 8192); } } while (0)
#define GE_STAGEA(bufoff, gbase, h) do { _Pragma("unroll") for (int _i = 0; _i < 2; ++_i) { unsigned _o = oA[h][_i]; LAUNDER_V(_o); \
        GLDS16((const char*)(gbase) + _o, lds + (bufoff) + ldsw + _i * 8192); } } while (0)
#define GE_LD1(p_) __builtin_shufflevector(*(const LAS i32x4*)(p_), *(const LAS i32x4*)((p_) + 1024), 0, 1, 2, 3, 4, 5, 6, 7)
#define GE_LDA(dst, b, h) do { _Pragma("unroll") for (int m = 0; m < 4; ++m) dst[m] = GE_LD1(lds + GE_SA(b, h) + aoff + m * 2048); } while (0)
#define GE_LDB(dst, b, h) do { _Pragma("unroll") for (int n = 0; n < 2; ++n) dst[n] = GE_LD1(lds + GE_SB(b, h) + boff + n * 2048); } while (0)
#define GE_LO(x) __builtin_bit_cast(bf16x8, __builtin_shufflevector(x, x, 0, 1, 2, 3))
#define GE_HI(x) __builtin_bit_cast(bf16x8, __builtin_shufflevector(x, x, 4, 5, 6, 7))
#define GE_MMA(ai, bj, At, Bt) do { SETPRIO(1); _Pragma("unroll") for (int m = 0; m < 4; ++m) _Pragma("unroll") for (int n = 0; n < 2; ++n) { \
        if constexpr (P::FP8) acc[ai][bj][m][n] = MFMA8(Bt[n], At[m], acc[ai][bj][m][n]);     \
        else { acc[ai][bj][m][n] = MFMA16(GE_LO(Bt[n]), GE_LO(At[m]), acc[ai][bj][m][n]); acc[ai][bj][m][n] = MFMA16(GE_HI(Bt[n]), GE_HI(At[m]), acc[ai][bj][m][n]); } } SETPRIO(0); } while (0)
    Unit cur, nxt; int ui = 0;
    if (!S.next(0, cur)) return;
    f32x4 acc[2][2][4][2];
#pragma unroll
    for (int a = 0; a < 2; ++a)
#pragma unroll
        for (int b = 0; b < 2; ++b)
#pragma unroll
            for (int m = 0; m < 4; ++m)
#pragma unroll
                for (int n = 0; n < 2; ++n) acc[a][b][m][n] = (f32x4){0.f, 0.f, 0.f, 0.f};
    unsigned oA[2][2];
#pragma unroll
    for (int h = 0; h < 2; ++h)
#pragma unroll
        for (int i = 0; i < 2; ++i) {
            if constexpr (P::GATHER) oA[h][i] = (unsigned)S.gather_row(cur, h * HALF + RA[i]) * (unsigned)(S.lda * P::ES) + (unsigned)CA2[i];
            else oA[h][i] = (unsigned)((h * HALF + RA[i]) * S.lda) * (unsigned)P::ES + (unsigned)CA2[i];
            }
    const char* cA = S.a_base(cur); const char* cB = S.b_base(cur);
    if constexpr (SP2) {
        GE_STAGEB(GE_SB(0, 0), cB); GE_STAGEB(GE_SB(0, 1), cB + hstepB); GE_STAGEA(GE_SA(0, 0), cA, 0); GE_STAGEA(GE_SA(0, 1), cA, 1);
        if (wr == 1) SBAR();
        WAITV(2); SBAR();
        GE_STAGEB(GE_SB(1, 0), cB + kstep); GE_STAGEA(GE_SA(1, 0), cA + kstep, 0); GE_STAGEB(GE_SB(1, 1), cB + hstepB + kstep);
        WAITV(6); SBAR();
    } else {
    GE_STAGEB(GE_SB(0, 0), cB); GE_STAGEA(GE_SA(0, 0), cA, 0); GE_STAGEB(GE_SB(0, 1), cB + hstepB); GE_STAGEA(GE_SA(0, 1), cA, 1);
    if (wr == 1) SBAR();
    WAITV(4); SBAR();
    GE_STAGEB(GE_SB(1, 0), cB + kstep); GE_STAGEA(GE_SA(1, 0), cA + kstep, 0); GE_STAGEB(GE_SB(1, 1), cB + hstepB + kstep);
    WAITV(6); SBAR();
    }
    for (;;) {
        const bool has_next = S.next(ui + 1, nxt);
        const char* nA = has_next ? S.a_base(nxt) : cA; const char* nB = has_next ? S.b_base(nxt) : cB;
        for (int t = 0; t < nt; t += 2) {
            const bool last = (t == nt - 2);
            const char* a1 = cA + (size_t)(t + 1) * kstep;
            const char* a2 = last ? nA : cA + (size_t)(t + 2) * kstep; const char* b2 = last ? nB : cB + (size_t)(t + 2) * kstep;
            const char* a3 = a2 + kstep; const char* b3 = b2 + kstep;
            i32x8 At[4], B0[2], B1[2];
            if constexpr (SP2) {
            GE_LDB(B0, 0, 0); GE_LDB(B1, 0, 1); SCHED(); GE_LDA(At, 0, 0); GE_STAGEA(GE_SA(1, 1), a1, 1);
            WAITV(8); WAITL(0); SBAR(); GE_MMA(0, 0, At, B0); GE_MMA(0, 1, At, B1); SBAR(); SCHED();
            if constexpr (P::GATHER) { if (last && has_next) {
#pragma unroll
                for (int i = 0; i < 2; ++i) { int R2, C2; stage_rc(tid * 16 + i * 8192, R2, C2);
#pragma unroll
                    for (int h = 0; h < 2; ++h) oA[h][i] = (unsigned)S.gather_row(nxt, h * HALF + R2) * (unsigned)(S.lda * P::ES) + (unsigned)(C2 * 2); } } }
            GE_LDA(At, 0, 1); GE_STAGEB(GE_SB(0, 0), b2); GE_STAGEB(GE_SB(0, 1), b2 + hstepB); GE_STAGEA(GE_SA(0, 0), a2, 0);
            WAITV(8); WAITL(0); SBAR(); GE_MMA(1, 0, At, B0); GE_MMA(1, 1, At, B1); SBAR(); SCHED();
            GE_LDB(B0, 1, 0); GE_LDB(B1, 1, 1); SCHED(); GE_LDA(At, 1, 0); GE_STAGEA(GE_SA(0, 1), a2, 1);
            WAITV(8); WAITL(0); SBAR(); GE_MMA(0, 0, At, B0); GE_MMA(0, 1, At, B1); SBAR(); SCHED();
            GE_LDA(At, 1, 1); GE_STAGEB(GE_SB(1, 0), b3); GE_STAGEB(GE_SB(1, 1), b3 + hstepB); GE_STAGEA(GE_SA(1, 0), a3, 0);
            WAITV(8); WAITL(0); SBAR(); GE_MMA(1, 0, At, B0); GE_MMA(1, 1, At, B1); SBAR(); SCHED();
            } else {
            GE_LDB(B0, 0, 0); SCHED(); GE_LDA(At, 0, 0); GE_STAGEA(GE_SA(1, 1), a1, 1);
            WAITL(8); SBAR(); WAITL(0); GE_MMA(0, 0, At, B0); SBAR(); SCHED();
            if constexpr (P::GATHER) { if (last && has_next) {
#pragma unroll
                for (int i = 0; i < 2; ++i) { int R2, C2; stage_rc(tid * 16 + i * 8192, R2, C2);
#pragma unroll
                    for (int h = 0; h < 2; ++h) oA[h][i] = (unsigned)S.gather_row(nxt, h * HALF + R2) * (unsigned)(S.lda * P::ES) + (unsigned)(C2 * 2); } } }
            GE_LDB(B1, 0, 1); GE_STAGEB(GE_SB(0, 0), b2);
            SBAR(); WAITL(0); GE_MMA(0, 1, At, B1); SBAR();
            GE_LDA(At, 0, 1); GE_STAGEA(GE_SA(0, 0), a2, 0);
            SBAR(); WAITL(0); GE_MMA(1, 0, At, B0); SBAR(); SCHED();
            GE_STAGEB(GE_SB(0, 1), b2 + hstepB);
            WAITV(6); SBAR(); GE_MMA(1, 1, At, B1); SBAR();
            GE_LDB(B0, 1, 0); SCHED(); GE_LDA(At, 1, 0); GE_STAGEA(GE_SA(0, 1), a2, 1);
            WAITL(8); SBAR(); WAITL(0); GE_MMA(0, 0, At, B0); SBAR(); SCHED();
            GE_LDB(B1, 1, 1); GE_STAGEB(GE_SB(1, 0), b3);
            SBAR(); WAITL(0); GE_MMA(0, 1, At, B1); SBAR();
            GE_LDA(At, 1, 1); GE_STAGEA(GE_SA(1, 0), a3, 0);
            SBAR(); WAITL(0); GE_MMA(1, 0, At, B0); SBAR(); SCHED();
            GE_STAGEB(GE_SB(1, 1), b3 + hstepB);
            WAITV(6); SBAR(); GE_MMA(1, 1, At, B1); SBAR();
            }
        }
        if (wr == 0) SBAR();
        S.epi(acc, cur, wr, wc, fr, fq);
        if (!has_next) break;
#pragma unroll
        for (int a = 0; a < 2; ++a)
#pragma unroll
            for (int b = 0; b < 2; ++b)
#pragma unroll
                for (int m = 0; m < 4; ++m)
#pragma unroll
                    for (int n = 0; n < 2; ++n) acc[a][b][m][n] = (f32x4){0.f, 0.f, 0.f, 0.f};
        cur = nxt; cA = nA; cB = nB; ++ui;
        if (wr == 1) SBAR();
    }
    WAITV(0);
    SBAR();
#undef GE_SA
#undef GE_SB
#undef GE_STAGEA
#undef GE_STAGEB
#undef GE_LDA
#undef GE_LDB
#undef GE_MMA
#undef GE_LO
#undef GE_HI
#undef GE_LD1
}
}
using ge::Unit;

struct Params {
    const float* in[26];
    float* out; unsigned char* ws;
    int ph_lo, ph_hi;
};
enum { I_X = 0, I_C, I_CTX, I_CCTX, I_ADAW, I_ADAB, I_NMIX, I_NFFN, I_POOLW, I_POOLS, I_INW, I_CONVW, I_CONVB, I_ALOG, I_DTB, I_DSKIP, I_SNORM, I_OUTW,
       I_W1, I_W3, I_W2, I_RW, I_MW1, I_MW3, I_MW2, I_FNORM };

struct Frame {
    LAS unsigned char* lds;
    int tid, lane, wave, G, bx;
    const Params* p;
    unsigned char* ws;
    unsigned* ctl;
    float* H; float* mod;
};
#ifdef EMU
DEV const float* INP(const Frame& F, int i) { return F.p->in[i]; }
DEV float* OUTP(const Frame& F) { return F.p->out; }
DEV unsigned char* WSP(const Frame& F) { return F.p->ws; }
#define LAUNDER_S(x) ((void)0)
#else
typedef const float* cfptr_t;
DEV const float* INP(const Frame&, int i) { int k = i; asm volatile("" : "+s"(k)); return ((const __attribute__((address_space(4))) cfptr_t*)__builtin_amdgcn_kernarg_segment_ptr())[k]; }
DEV float* OUTP(const Frame& F) { return (float*)INP(F, 26); }
DEV unsigned char* WSP(const Frame& F) { return (unsigned char*)INP(F, 27); }
#define LAUNDER_S(x) asm volatile("" : "+s"(x))
#endif
constexpr int LDS_MISC = ge::STAGE_BYTES;
constexpr int LDS_BYTES = ge::STAGE_BYTES + 16384;

struct Src { const float* x; const float* ctx; float* H; const float* mod; };
DEV const float* modq(const float* mod, int layer, int vec, int which) { return mod + ((size_t)(layer * 3 + vec) * 6 + which) * D; }
DEV const float* modp(const Frame& F, int layer, int vec, int which) { return modq(F.mod, layer, vec, which); }
DEV const float* hsrc_row(const Src& s, bool from_input, int r) {
    if (from_input) return r < ML ? s.x + (size_t)r * D : s.ctx + (size_t)(r - ML) * D;
    return s.H + (size_t)r * D;
}
DEV Src mksrc(const Frame& F) { Src s; s.x = INP(F, I_X); s.ctx = INP(F, I_CTX); s.H = F.H; s.mod = F.mod; return s; }
DEV const float* hin_row(const Frame& F, int layer, int r) { return hsrc_row(mksrc(F), layer == 0, r); }

template <int K, int N, class RM>
DEV void transpose_item(const float* Wsrc, bf16_t* WT, int ldt, RM rowmap, LAS float* scr, int item, int lane) {
    constexpr int nblk = N / 32; const int kb = item / nblk, nb = item % nblk, k0 = 64 * kb, n0 = 32 * nb;
    float tmp[32];
#pragma unroll
    for (int i = 0; i < 32; ++i) { const int kk = 2 * i + (lane >> 5); tmp[i] = Wsrc[(size_t)(k0 + kk) * N + n0 + (lane & 31)]; }
#pragma unroll
    for (int i = 0; i < 32; ++i) { const int kk = 2 * i + (lane >> 5); scr[kk * 33 + (lane & 31)] = tmp[i]; }
    WSYNC();
    const int c = lane & 7; const int row0 = rowmap(n0);
#pragma unroll
    for (int j = 0; j < 4; ++j) { const int n = (lane >> 3) + 8 * j; const LAS float* s = scr + (8 * c) * 33 + n;
        u32x4 o; o.x = pk2(s[0 * 33], s[1 * 33]); o.y = pk2(s[2 * 33], s[3 * 33]); o.z = pk2(s[4 * 33], s[5 * 33]); o.w = pk2(s[6 * 33], s[7 * 33]);
        *(u32x4*)(WT + (size_t)(row0 + n) * ldt + k0 + 8 * c) = o; }
    WSYNC();
}
template <int K, int N, class RM>
DEV void transpose_item_fp8(const float* Wsrc, fp8_t* WT, int ldt, RM rowmap, float scale, LAS float* scr, int item, int lane) {
    constexpr int nblk = N / 32; const int kb = item / nblk, nb = item % nblk, k0 = 64 * kb, n0 = 32 * nb;
    float tmp[32];
#pragma unroll
    for (int i = 0; i < 32; ++i) { const int kk = 2 * i + (lane >> 5); tmp[i] = Wsrc[(size_t)(k0 + kk) * N + n0 + (lane & 31)]; }
#pragma unroll
    for (int i = 0; i < 32; ++i) { const int kk = 2 * i + (lane >> 5); scr[kk * 33 + (lane & 31)] = tmp[i] * scale; }
    WSYNC();
    const int c = lane & 7; const int row0 = rowmap(n0);
#pragma unroll
    for (int j = 0; j < 4; ++j) { const int n = (lane >> 3) + 8 * j; const LAS float* s = scr + (8 * c) * 33 + n;
        u32x2 o; o.x = pk4_fp8(s[0 * 33], s[1 * 33], s[2 * 33], s[3 * 33]); o.y = pk4_fp8(s[4 * 33], s[5 * 33], s[6 * 33], s[7 * 33]);
        *(u32x2*)(WT + (size_t)(row0 + n) * ldt + k0 + 8 * c) = o; }
    WSYNC();
}
template <int K, int N, class RM>
DEV void convert_job_fp8(const Frame& F, const float* Wsrc, fp8_t* WT, int ldt, RM rm, float scale) {
    LAS float* scr = (LAS float*)(F.lds + F.wave * 16384);
    constexpr int items = (K / 64) * (N / 32); const int gw = F.bx * 8 + F.wave, NGW = F.G * 8;
    for (int it = gw; it < items; it += NGW) transpose_item_fp8<K, N>(Wsrc, WT, ldt, rm, scale, scr, it, F.lane);
}
struct RmId { DEV int operator()(int n0) const { return n0; } };
struct RmIlv { int s; DEV int operator()(int n0) const { return (n0 >> 7) * 256 + s * 128 + (n0 & 127); } };
template <int K, int N, class RM>
DEV void convert_job(const Frame& F, const float* Wsrc, bf16_t* WT, int ldt, RM rm) {
    LAS float* scr = (LAS float*)(F.lds + F.wave * 16384);
    constexpr int items = (K / 64) * (N / 32); const int gw = F.bx * 8 + F.wave, NGW = F.G * 8;
    for (int it = gw; it < items; it += NGW) transpose_item<K, N>(Wsrc, WT, ldt, rm, scr, it, F.lane);
}
DEV void convert_even(const Frame& F, int j) {
    bf16_t* Wb = (bf16_t*)(F.ws + OFF_W);
    for (int g = 0; g < 4; ++g) convert_job<256, 256>(F, INP(F, I_POOLW) + ((size_t)j * 4 + g) * 65536, Wb + W_POOL / 2 + (size_t)g * 65536, 256, RmId{});
    convert_job<D, DFF>(F, INP(F, I_W1) + (size_t)j * D * DFF, Wb + W_UP / 2, D, RmIlv{0});
    convert_job<D, DFF>(F, INP(F, I_W3) + (size_t)j * D * DFF, Wb + W_UP / 2, D, RmIlv{1});
    convert_job<DFF, D>(F, INP(F, I_W2) + (size_t)j * DFF * D, Wb + W_DN / 2, DFF, RmId{});
}
DEV void convert_ssd(const Frame& F, int j) {
    bf16_t* Wb = (bf16_t*)(F.ws + OFF_W);
    convert_job<D, NPROJ>(F, INP(F, I_INW) + (size_t)j * D * NPROJ, Wb + W_IN / 2, D, RmId{});
    convert_job<DIN, D>(F, INP(F, I_OUTW) + (size_t)j * DIN * D, Wb + W_OUT / 2, DIN, RmId{});
    { u32x4* z = (u32x4*)(Wb + W_IN / 2 + (size_t)NPROJ * D); const int n16 = (NPROJP - NPROJ) * D * 2 / 16;
      unsigned zz = 0u; LAUNDER_V(zz);
      for (int i = F.bx * 512 + F.tid; i < n16; i += F.G * 512) z[i] = (u32x4){zz, zz, zz, zz}; }
}
DEV void convert_moe(const Frame& F, int j) {
    fp8_t* Wb = (fp8_t*)(F.ws + OFF_W);
    for (int e = 0; e < NEXP; ++e) {
        convert_job_fp8<D, DFFE>(F, INP(F, I_MW1) + ((size_t)j * NEXP + e) * D * DFFE, Wb + W_MUP + (size_t)e * 2 * DFFE * D, D, RmIlv{0}, 32.0f);
        convert_job_fp8<D, DFFE>(F, INP(F, I_MW3) + ((size_t)j * NEXP + e) * D * DFFE, Wb + W_MUP + (size_t)e * 2 * DFFE * D, D, RmIlv{1}, 32.0f);
        if (MOE_DOWN_FP8) convert_job_fp8<DFFE, D>(F, INP(F, I_MW2) + ((size_t)j * NEXP + e) * DFFE * D, Wb + W_MDN + (size_t)e * D * DFFE, DFFE, RmId{}, 64.0f);
        else convert_job<DFFE, D>(F, INP(F, I_MW2) + ((size_t)j * NEXP + e) * DFFE * D, (bf16_t*)(Wb + W_MDN) + (size_t)e * D * DFFE, DFFE, RmId{});
    }
}

DEV void phase_mod(const Frame& F) {
    LAS float* red = (LAS float*)F.lds;
    const int nblk = DEPTH * 6144 / 64;
    const int col = F.tid & 63, ks = F.tid >> 6;
    for (int blk = F.bx; blk < nblk; blk += F.G) {
        const int layer = (blk * 64) / 6144, n = (blk * 64) % 6144 + col;
        const float* W = INP(F, I_ADAW) + (size_t)layer * D * 6144 + n;
        float a0 = 0.f, a1 = 0.f, a2 = 0.f;
#pragma unroll 8
        for (int k = ks * 128; k < ks * 128 + 128; ++k) { const float w = W[(size_t)k * 6144];
            a0 += siluf(INP(F, I_C)[k]) * w; a1 += siluf(INP(F, I_C)[D + k]) * w; a2 += siluf(INP(F, I_CCTX)[k]) * w; }
        red[(ks * 64 + col) * 3 + 0] = a0; red[(ks * 64 + col) * 3 + 1] = a1; red[(ks * 64 + col) * 3 + 2] = a2;
        __syncthreads();
        if (F.tid < 192) { const int c2 = F.tid % 64, v = F.tid / 64; float s = 0.f;
            for (int q = 0; q < 8; ++q) s += red[(q * 64 + c2) * 3 + v];
            const int n2 = (blk * 64) % 6144 + c2;
            F.mod[(size_t)(layer * 3 + v) * 6144 + n2] = s + INP(F, I_ADAB)[(size_t)layer * 6144 + n2]; }
        __syncthreads();
    }
}

DEV void load_row(const float* p, int lane, f32x4 (&v)[4]) {
#pragma unroll
    for (int j = 0; j < 4; ++j) v[j] = *(const f32x4*)(p + 4 * lane + 256 * j);
}
DEV float sumsq_row(const f32x4 (&v)[4]) { float s = 0.f;
#pragma unroll
    for (int j = 0; j < 4; ++j) s += (v[j][0] * v[j][0] + v[j][1] * v[j][1]) + (v[j][2] * v[j][2] + v[j][3] * v[j][3]);
    return wave_sum(s); }
DEV void normmod_row(f32x4 (&v)[4], float rstd, const float* w, const float* sh, const float* sc, int lane) {
#pragma unroll
    for (int j = 0; j < 4; ++j) { const int c = 4 * lane + 256 * j; const f32x4 wv = *(const f32x4*)(w + c), sv = *(const f32x4*)(sh + c), cv = *(const f32x4*)(sc + c);
        v[j] = v[j] * rstd * wv * (cv + 1.0f) + sv; }
}
DEV void store_row_bf16(bf16_t* o, int lane, const f32x4 (&v)[4]) {
#pragma unroll
    for (int j = 0; j < 4; ++j) { u32x2 w; w.x = pk2(v[j][0], v[j][1]); w.y = pk2(v[j][2], v[j][3]); *(u32x2*)(o + 4 * lane + 256 * j) = w; }
}

DEV void phase_norm(const Frame& F, int layer, int which, bf16_t* out, bool from_input) {
    const int gw = F.bx * 8 + F.wave, NGW = F.G * 8;
    const float* w = INP(F, which == 0 ? I_NMIX : I_NFFN) + (size_t)layer * D;
    f32x4 nx[4];
    if (gw < MT) load_row(hsrc_row(mksrc(F), from_input, gw), F.lane, nx);
    for (int r = gw; r < MT; r += NGW) {
        f32x4 v[4];
#pragma unroll
        for (int q = 0; q < 4; ++q) v[q] = nx[q];
        if (r + NGW < MT) load_row(hsrc_row(mksrc(F), from_input, r + NGW), F.lane, nx);
        const float rstd = rsqrtf(sumsq_row(v) * (1.0f / D) + EPS);
        const int vec = vec_of(r);
        normmod_row(v, rstd, w, modp(F, layer, vec, which), modp(F, layer, vec, which + 1), F.lane);
        store_row_bf16(out + (size_t)r * D, F.lane, v);
    }
}

DEV void phase_poolprep(const Frame& F, int layer, bf16_t* P) {
    LAS bf16_t* ub = (LAS bf16_t*)(F.lds);
    LAS float* rs = (LAS float*)(F.lds + 81920);
    const float* w = INP(F, I_NMIX) + (size_t)layer * D;
    const int ntile = MT / 64;
    const int chunk = F.tid & 127, tg = F.tid >> 7;
    for (int tile = F.bx; tile < ntile; tile += F.G) {
        const int r0 = tile * 64;
        int seq0, seq1;
        if (r0 < ML) { seq0 = r0; seq1 = r0 + 64; } else { seq0 = ML + ((r0 - ML) / CTXL) * CTXL; seq1 = seq0 + CTXL; }
        const int lo_r = (r0 - 8 > seq0) ? r0 - 8 : seq0, hi_r = (r0 + 64 + 7 < seq1) ? r0 + 64 + 7 : seq1;
        const int nrow = hi_r - lo_r;
        for (int rb = lo_r + F.wave; rb < hi_r; rb += 40) {
            f32x4 v5[5][4];
#pragma unroll
            for (int k = 0; k < 5; ++k) { const int r = rb + 8 * k; if (r < hi_r) load_row(hin_row(F, layer, r), F.lane, v5[k]); }
#pragma unroll
            for (int k = 0; k < 5; ++k) { const int r = rb + 8 * k; if (r < hi_r) { const float ss = sumsq_row(v5[k]); if (F.lane == 0) rs[r - lo_r] = rsqrtf(ss * (1.0f / D) + EPS); } } }
        __syncthreads();
        const int vec = vec_of(r0);
#pragma unroll 1
        for (int half = 0; half < 2; ++half) {
            const int c = half * 512 + 4 * chunk, g = c >> 8, win = 2 << g, lo = win >> 1, hi = win - 1 - lo;
            const f32x4 wv = *(const f32x4*)(w + c), sv = *(const f32x4*)(modp(F, layer, vec, 0) + c), cv = *(const f32x4*)(modp(F, layer, vec, 1) + c) + 1.0f;
            const f32x4 wc = wv * cv;
#pragma unroll 4
            for (int rr = tg; rr < nrow; rr += 4) { const f32x4 h = *(const f32x4*)(hin_row(F, layer, lo_r + rr) + c); const f32x4 u = h * rs[rr] * wc + sv;
                u32x2 pw; pw.x = pk2(u[0], u[1]); pw.y = pk2(u[2], u[3]); *(LAS u32x2*)(ub + rr * 512 + 4 * chunk) = pw; }
            __syncthreads();
#define PP_U(r_) ({ const u32x2 _q = *(const LAS u32x2*)(ub + ((r_) - lo_r) * 512 + 4 * chunk); (f32x4){bflo(_q.x), bfhi(_q.x), bflo(_q.y), bfhi(_q.y)}; })
            const int ta = r0 + 16 * tg;
            f32x4 s = (f32x4){0.f, 0.f, 0.f, 0.f};
            { const int a = (ta - lo > seq0) ? ta - lo : seq0, b = (ta + hi + 1 < seq1) ? ta + hi + 1 : seq1; for (int r = a; r < b; ++r) s += PP_U(r); }
            for (int t = ta; t < ta + 16; ++t) {
                const int a = (t - lo > seq0) ? t - lo : seq0, b = (t + hi + 1 < seq1) ? t + hi + 1 : seq1;
                const float inv = 1.0f / (float)(b - a);
                const f32x4 o = s * inv - PP_U(t);
                u32x2 pw; pw.x = pk2(o[0], o[1]); pw.y = pk2(o[2], o[3]); *(u32x2*)(P + (size_t)t * D + c) = pw;
                if (t + 1 < ta + 16) {
                    if (t + 1 + hi < seq1) s += PP_U(t + 1 + hi);
                    if (t - lo >= seq0) s -= PP_U(t - lo); }
            }
#undef PP_U
            __syncthreads();
        }
    }
}

struct PolBase { int G, c; };
struct PolPool : PolBase {
    static constexpr bool PERM = false, GATHER = false; static constexpr bool FP8 = false; static constexpr int ES = 2; int K, lda, ldb;
    const bf16_t* P; const bf16_t* W; Src src; int layer; const float* scale;
    DEV bool next(int i, Unit& u) const { return ge::static_next(NPAN, 4, G, c, i, u); }
    DEV const char* a_base(const Unit& u) const { return (const char*)(P + (size_t)u.pm * 256 * D + u.pn * 256); }
    DEV const char* b_base(const Unit& u) const { return (const char*)(W + (size_t)u.pn * 65536); }
    DEV void epi(const f32x4 (&acc)[2][2][4][2], const Unit& u, int wr, int wc, int fr, int fq) const {
        const int row0 = u.pm * 256 + wr * 64 + fr, col0 = u.pn * 256 + wc * 32 + 4 * fq; const int vec = vec_of(u.pm * 256);
        const float* g1 = modq(src.mod, layer, vec, 2);
        f32x4 gv[2][2];
#pragma unroll
        for (int bj = 0; bj < 2; ++bj)
#pragma unroll
            for (int n = 0; n < 2; ++n) { const int cc = col0 + bj * 128 + n * 16; gv[bj][n] = *(const f32x4*)(g1 + cc) * *(const f32x4*)(scale + cc); }
#pragma unroll
        for (int ai = 0; ai < 2; ++ai)
#pragma unroll
            for (int m = 0; m < 4; ++m) { const int r = row0 + ai * 128 + m * 16; const float* hi = hsrc_row(src, layer == 0, r) + col0; float* ho = src.H + (size_t)r * D + col0;
#pragma unroll
                for (int bj = 0; bj < 2; ++bj)
#pragma unroll
                    for (int n = 0; n < 2; ++n) *(f32x4*)(ho + bj * 128 + n * 16) = *(const f32x4*)(hi + bj * 128 + n * 16) + gv[bj][n] * acc[ai][bj][m][n]; }
    }
};
struct PolResid : PolBase {
    static constexpr bool PERM = false, GATHER = false; static constexpr bool FP8 = false; static constexpr int ES = 2; int K, lda, ldb;
    const bf16_t* A; const bf16_t* W; Src src; int layer, which, npan;
    DEV bool next(int i, Unit& u) const { return ge::static_next(npan, 4, G, c, i, u); }
    DEV const char* a_base(const Unit& u) const { return (const char*)(A + (size_t)u.pm * 256 * lda); }
    DEV const char* b_base(const Unit& u) const { return (const char*)(W + (size_t)u.pn * 256 * ldb); }
    DEV void epi(const f32x4 (&acc)[2][2][4][2], const Unit& u, int wr, int wc, int fr, int fq) const {
        const int row0 = u.pm * 256 + wr * 64 + fr, col0 = u.pn * 256 + wc * 32 + 4 * fq; const int vec = vec_of(u.pm * 256);
        const float* gp = modq(src.mod, layer, vec, which);
        f32x4 gv[2][2];
#pragma unroll
        for (int bj = 0; bj < 2; ++bj)
#pragma unroll
            for (int n = 0; n < 2; ++n) gv[bj][n] = *(const f32x4*)(gp + col0 + bj * 128 + n * 16);
#pragma unroll
        for (int ai = 0; ai < 2; ++ai)
#pragma unroll
            for (int m = 0; m < 4; ++m) { float* ho = src.H + (size_t)(row0 + ai * 128 + m * 16) * D + col0;
#pragma unroll
                for (int bj = 0; bj < 2; ++bj)
#pragma unroll
                    for (int n = 0; n < 2; ++n) { f32x4* q = (f32x4*)(ho + bj * 128 + n * 16); *q = *q + gv[bj][n] * acc[ai][bj][m][n]; } }
    }
};
template <bool MOE>
struct PolUp : PolBase {
    static constexpr bool PERM = true, GATHER = MOE, FP8 = MOE; static constexpr int ES = MOE ? 1 : 2; int K, lda, ldb;
    const bf16_t* A; const bf16_t* W; bf16_t* HID; int ldh, nq;
    int nM; const int* s2t; int tstart[NEXP + 1];
    DEV bool next(int i, Unit& u) const { return ge::static_next(MOE ? nM : NPAN, nq, G, c, i, u); }
    DEV int expert_of(int pm) const { int e = 0;
#pragma unroll
        for (int k = 1; k < NEXP; ++k) e += (pm >= tstart[k]) ? 1 : 0;
        return e; }
    DEV const char* a_base(const Unit& u) const { return MOE ? (const char*)A : (const char*)(A + (size_t)u.pm * 256 * lda); }
    DEV const char* b_base(const Unit& u) const { size_t off = (size_t)u.pn * 256 * ldb; if (MOE) off += (size_t)expert_of(u.pm) * 2 * DFFE * ldb; return (const char*)W + off * ES; }
    DEV int gather_row(const Unit& u, int R) const { return s2t[u.pm * 256 + R]; }
    DEV void epi(const f32x4 (&acc)[2][2][4][2], const Unit& u, int wr, int wc, int fr, int fq) const {
        const int row0 = u.pm * 256 + wr * 64 + fr, col0 = u.pn * 128 + wc * 32 + 8 * fq;
#pragma unroll
        for (int ai = 0; ai < 2; ++ai)
#pragma unroll
            for (int m = 0; m < 4; ++m) { bf16_t* o = HID + (size_t)(row0 + ai * 128 + m * 16) * ldh + col0;
                float h[8];
#pragma unroll
                for (int n = 0; n < 2; ++n)
#pragma unroll
                    for (int i = 0; i < 4; ++i) { if (MOE) h[4 * n + i] = siluf(acc[ai][0][m][n][i] * 0.00390625f) * (acc[ai][1][m][n][i] * (MOE_DOWN_FP8 ? 0.015625f : 0.00390625f));
                                                  else h[4 * n + i] = siluf(acc[ai][0][m][n][i]) * acc[ai][1][m][n][i]; }
                if (MOE && MOE_DOWN_FP8) { u32x2 w8; w8.x = pk4_fp8(h[0], h[1], h[2], h[3]); w8.y = pk4_fp8(h[4], h[5], h[6], h[7]);
                    *(u32x2*)((fp8_t*)HID + (size_t)(row0 + ai * 128 + m * 16) * ldh + col0) = w8; }
                else { u32x4 w; w.x = pk2(h[0], h[1]); w.y = pk2(h[2], h[3]); w.z = pk2(h[4], h[5]); w.w = pk2(h[6], h[7]); *(u32x4*)o = w; } }
    }
};
struct PolMoeDown : PolBase {
    static constexpr bool PERM = true, GATHER = (MOE_DOWN_FP8 != 0), FP8 = (MOE_DOWN_FP8 != 0); static constexpr int ES = MOE_DOWN_FP8 ? 1 : 2; int K, lda, ldb;
    const bf16_t* A; const bf16_t* W; bf16_t* YS; int nM; int tstart[NEXP + 1];
    DEV bool next(int i, Unit& u) const { return ge::static_next(nM, 4, G, c, i, u); }
    DEV int expert_of(int pm) const { int e = 0;
#pragma unroll
        for (int k = 1; k < NEXP; ++k) e += (pm >= tstart[k]) ? 1 : 0;
        return e; }
    DEV const char* a_base(const Unit& u) const { return GATHER ? (const char*)A : (const char*)A + (size_t)u.pm * 256 * lda * ES; }
    DEV int gather_row(const Unit& u, int R) const { return u.pm * 256 + R; }
    DEV const char* b_base(const Unit& u) const { return (const char*)W + ((size_t)expert_of(u.pm) * D + (size_t)u.pn * 256) * ldb * ES; }
    DEV void epi(const f32x4 (&acc)[2][2][4][2], const Unit& u, int wr, int wc, int fr, int fq) const {
        const int row0 = u.pm * 256 + wr * 64 + fr, col0 = u.pn * 256 + wc * 32 + 8 * fq;
#pragma unroll
        for (int ai = 0; ai < 2; ++ai)
#pragma unroll
            for (int m = 0; m < 4; ++m) { bf16_t* o = YS + (size_t)(row0 + ai * 128 + m * 16) * D + col0;
#pragma unroll
                for (int bj = 0; bj < 2; ++bj) { u32x4 w; w.x = pk2(acc[ai][bj][m][0][0], acc[ai][bj][m][0][1]); w.y = pk2(acc[ai][bj][m][0][2], acc[ai][bj][m][0][3]);
                    w.z = pk2(acc[ai][bj][m][1][0], acc[ai][bj][m][1][1]); w.w = pk2(acc[ai][bj][m][1][2], acc[ai][bj][m][1][3]); *(u32x4*)(o + bj * 128) = w; } }
    }
};
struct PolInProj : PolBase {
    static constexpr bool PERM = true, GATHER = false; static constexpr bool FP8 = false; static constexpr int ES = 2; int K, lda, ldb;
    const bf16_t* A; const bf16_t* W; bf16_t* Z; bf16_t* XBC; float* DT;
    DEV bool next(int i, Unit& u) const { return ge::static_next(NPAN, NPROJP / 256, G, c, i, u); }
    DEV const char* a_base(const Unit& u) const { return (const char*)(A + (size_t)u.pm * 256 * lda); }
    DEV const char* b_base(const Unit& u) const { return (const char*)(W + (size_t)u.pn * 256 * ldb); }
    DEV void epi(const f32x4 (&acc)[2][2][4][2], const Unit& u, int wr, int wc, int fr, int fq) const {
        const int row0 = u.pm * 256 + wr * 64 + fr, cw = wc * 32 + 8 * fq;
        if (u.pn < 20) {
            bf16_t* base; int ld, col0;
            if (u.pn < 8) { base = Z; ld = DIN; col0 = u.pn * 256 + cw; } else { base = XBC; ld = CONVD; col0 = (u.pn - 8) * 256 + cw; }
#pragma unroll
            for (int ai = 0; ai < 2; ++ai)
#pragma unroll
                for (int m = 0; m < 4; ++m) { bf16_t* o = base + (size_t)(row0 + ai * 128 + m * 16) * ld + col0;
#pragma unroll
                    for (int bj = 0; bj < 2; ++bj) { u32x4 w; w.x = pk2(acc[ai][bj][m][0][0], acc[ai][bj][m][0][1]); w.y = pk2(acc[ai][bj][m][0][2], acc[ai][bj][m][0][3]);
                        w.z = pk2(acc[ai][bj][m][1][0], acc[ai][bj][m][1][1]); w.w = pk2(acc[ai][bj][m][1][2], acc[ai][bj][m][1][3]); *(u32x4*)(o + bj * 128) = w; } }
        } else if (cw < 64) {
#pragma unroll
            for (int ai = 0; ai < 2; ++ai)
#pragma unroll
                for (int m = 0; m < 4; ++m) { const int r = row0 + ai * 128 + m * 16; int b, tv;
                    if (r < ML) { b = r / SEQ; tv = CTXL + r % SEQ; } else { b = (r - ML) / CTXL; tv = (r - ML) % CTXL; }
#pragma unroll
                    for (int n = 0; n < 2; ++n)
#pragma unroll
                        for (int i = 0; i < 4; ++i) { const int j = cw + 4 * n + i, dir = j >> 5, h = j & 31;
                            DT[((size_t)(b * 2 + dir) * NH + h) * TV + tv] = acc[ai][0][m][n][i]; } }
        }
    }
};

DEV void phase_conv(const Frame& F, int j, const bf16_t* XBC, bf16_t* XT, bf16_t* Brow, bf16_t* BT, bf16_t* Crow) {
    LAS bf16_t* tl0 = (LAS bf16_t*)F.lds;
    const float* cw = INP(F, I_CONVW) + (size_t)j * 4 * CONVD; const float* cb = INP(F, I_CONVB) + (size_t)j * CONVD;
    constexpr int NPER = NB * NCH, nitem = NPER * (CONVD / 64);
    const int t2 = 2 * (F.tid >> 3), cg = F.tid & 7;
    const int i0 = (int)(((long)F.bx * nitem) / F.G), i1 = (int)(((long)(F.bx + 1) * nitem) / F.G);
    int cblk_cur = -1; f32x4 wv[4][2], bv[2]; int par = 0;
    for (int it = i0; it < i1; ++it) {
        const int cblk = it / NPER, rest = it % NPER, b = rest / NCH, cv = rest % NCH;
        const int ch0 = cblk * 64 + cg * 8;
        if (cblk != cblk_cur) { cblk_cur = cblk;
#pragma unroll
            for (int k = 0; k < 4; ++k) { wv[k][0] = *(const f32x4*)(cw + k * CONVD + ch0); wv[k][1] = *(const f32x4*)(cw + k * CONVD + ch0 + 4); }
            bv[0] = *(const f32x4*)(cb + ch0); bv[1] = *(const f32x4*)(cb + ch0 + 4); }
        const int tv = cv * 128 + t2;
        const int seg0 = tv < CTXL ? 0 : CTXL, seg1 = tv < CTXL ? CTXL : TV;
        float xin[5][8];
#pragma unroll
        for (int k = 0; k < 5; ++k) { const int tk = tv - 2 + k; u32x4 q = (u32x4){0u, 0u, 0u, 0u};
            if (tk >= seg0 && tk < seg1) q = *(const u32x4*)(XBC + (size_t)row_of(b, tk) * CONVD + ch0);
            xin[k][0] = bflo(q.x); xin[k][1] = bfhi(q.x); xin[k][2] = bflo(q.y); xin[k][3] = bfhi(q.y); xin[k][4] = bflo(q.z); xin[k][5] = bfhi(q.z); xin[k][6] = bflo(q.w); xin[k][7] = bfhi(q.w); }
        unsigned pk[2][4];
#pragma unroll
        for (int o = 0; o < 2; ++o) { float a[8];
#pragma unroll
            for (int i = 0; i < 8; ++i) { float acc = bv[i >> 2][i & 3];
#pragma unroll
                for (int k = 0; k < 4; ++k) acc += wv[k][i >> 2][i & 3] * xin[o + k][i];
                a[i] = siluf(acc); }
#pragma unroll
            for (int i = 0; i < 4; ++i) pk[o][i] = pk2(a[2 * i], a[2 * i + 1]); }
        const int r = row_of(b, tv);
        const bool isx = cblk < DIN / 64, isb = !isx && cblk < (DIN + BCD) / 64;
        if (!isx) { bf16_t* o = (isb ? Brow + (ch0 - DIN) : Crow + (ch0 - DIN - BCD)) + (size_t)r * BCD;
            *(u32x4*)o = (u32x4){pk[0][0], pk[0][1], pk[0][2], pk[0][3]}; *(u32x4*)(o + BCD) = (u32x4){pk[1][0], pk[1][1], pk[1][2], pk[1][3]}; }
        if (isx || isb) {
            LAS bf16_t* tl = tl0 + par * (64 * 136); par ^= 1;
#pragma unroll
            for (int i = 0; i < 4; ++i) { const unsigned lo = (pk[0][i] & 0xffffu) | (pk[1][i] << 16), hi = (pk[0][i] >> 16) | (pk[1][i] & 0xffff0000u);
                *(LAS unsigned*)(tl + (cg * 8 + 2 * i) * 136 + t2) = lo; *(LAS unsigned*)(tl + (cg * 8 + 2 * i + 1) * 136 + t2) = hi; }
            __syncthreads();
            bf16_t* dst = isx ? XT + ((size_t)b * DIN + cblk * 64) * TV : BT + ((size_t)b * BCD + (cblk * 64 - DIN)) * TV;
#pragma unroll
            for (int q = 0; q < 2; ++q) { const int idx = F.tid + q * 512, ch = idx >> 4, t8 = (idx & 15) * 8;
                *(u32x4*)(dst + (size_t)ch * TV + cv * 128 + t8) = *(const LAS u32x4*)(tl + ch * 136 + t8); }
        }
    }
}

DEV void phase_cb(const Frame& F, const bf16_t* Brow, const bf16_t* Crow, bf16_t* CB) {
    const int nitem = NB * NG * NCH; const int fr = F.lane & 15, fq = F.lane >> 4;
    for (int it = F.bx; it < nitem; it += F.G) {
        const int cv = it % NCH, g = (it / NCH) % NG, b = it / (NCH * NG);
        const int rbase = row_of(b, cv * 128);
        bf16x8 cf[4];
#pragma unroll
        for (int ks = 0; ks < 4; ++ks) cf[ks] = *(const bf16x8*)(Crow + (size_t)(rbase + 16 * F.wave + fr) * BCD + g * 128 + 32 * ks + 8 * fq);
        bf16_t* out = CB + ((size_t)((b * NG + g) * NCH + cv)) * 16384;
#pragma unroll
        for (int nt = 0; nt < 8; ++nt) {
            f32x4 acc = (f32x4){0.f, 0.f, 0.f, 0.f};
#pragma unroll
            for (int ks = 0; ks < 4; ++ks) { const bf16x8 bfr = *(const bf16x8*)(Brow + (size_t)(rbase + 16 * nt + fr) * BCD + g * 128 + 32 * ks + 8 * fq); acc = MFMA16(bfr, cf[ks], acc); }
            u32x2 w; w.x = pk2(acc[0], acc[1]); w.y = pk2(acc[2], acc[3]);
            *(u32x2*)(out + (size_t)(16 * F.wave + fr) * 128 + 16 * nt + 4 * fq) = w;
        }
    }
}

DEV void phase_tables(const Frame& F, int j, float* DT, float* CUM, float* WJ) {
    const int nitem = NB * 2 * NH * NCH; const int gw = F.bx * 8 + F.wave, NGW = F.G * 8;
    for (int it = gw; it < nitem; it += NGW) {
        const int cv = it % NCH, h = (it / NCH) % NH, dir = (it / (NCH * NH)) & 1, b = it / (NCH * NH * 2);
        const float A = -expf(INP(F, I_ALOG)[(size_t)(j * 2 + dir) * NH + h]); const float bias = INP(F, I_DTB)[(size_t)(j * 2 + dir) * NH + h];
        const size_t o = ((size_t)(b * 2 + dir) * NH + h) * TV + cv * 128 + 2 * F.lane;
        const f32x2 raw = *(const f32x2*)(DT + o); const float d0 = softplusf(raw.x + bias), d1 = softplusf(raw.y + bias); const float a0 = d0 * A, a1 = d1 * A;
        float c0, c1, tot, sum = a0 + a1;
        if (dir == 0) {
#pragma unroll
            for (int q = 1; q < 64; q <<= 1) { const float t2 = __shfl_up(sum, q); if (F.lane >= q) sum += t2; }
            c1 = sum; c0 = sum - a1; tot = __shfl(sum, 63);
        } else {
#pragma unroll
            for (int q = 1; q < 64; q <<= 1) { const float t2 = __shfl_down(sum, q); if (F.lane + q < 64) sum += t2; }
            c0 = sum; c1 = sum - a0; tot = __shfl(sum, 0);
        }
        constexpr float L2E = 1.4426950408889634f;
        *(f32x2*)(DT + o) = (f32x2){c0 * L2E - flog2(d0), c1 * L2E - flog2(d1)};
        *(f32x2*)(CUM + o) = (f32x2){c0 * L2E, c1 * L2E};
        *(f32x2*)(WJ + o) = (f32x2){d0 * FEXP(tot - c0), d1 * FEXP(tot - c1)};
    }
}

constexpr int SC_HL = 0, SC_TAB = 17408, SC_CB = 20480, SC_BT = SC_CB + 32768, SC_C = SC_BT + 32768, SC_X = SC_C + 32768, SC_END = SC_X + 8192;
static_assert(SC_END <= ge::STAGE_BYTES, "scan LDS map");
DEV void phase_scan(const Frame& F, int j, const bf16_t* XT, const bf16_t* BT, const bf16_t* Crow, const bf16_t* CB, const float* DT, const float* CUM, const float* WJ, bf16_t* Yf, bf16_t* Yb) {
    LAS unsigned char* L = F.lds;
    LAS bf16_t* Hl = (LAS bf16_t*)(L + SC_HL);
    LAS float* tab = (LAS float*)(L + SC_TAB);
    const int fr = F.lane & 15, fq = F.lane >> 4, w = F.wave;
    const int nitem = NB * NH * 2 * 2;
    for (int it = F.bx; it < nitem; it += F.G) {
        const int xq = it & 7, kq = it >> 3; const int b = xq >> 2, g = xq & 3, h = 8 * g + (kq >> 2), dir = (kq >> 1) & 1, ph = kq & 1;
        const float Dsk = dir == 0 ? INP(F, I_DSKIP)[(size_t)j * NH + h] : 0.f;
        const size_t tbase = ((size_t)(b * 2 + dir) * NH + h) * TV;
        const bf16_t* xt = XT + ((size_t)b * DIN + h * HD + ph * 32) * TV;
        const bf16_t* bt = BT + ((size_t)b * BCD + g * 128) * TV;
        const bf16_t* CBh = CB + (size_t)((b * NG + g) * NCH) * 16384;
        const bf16_t* Cg = Crow + g * 128;
        bf16_t* Y = (dir ? Yb : Yf) + h * HD + ph * 32;
        const int lrow = 16 * w + fr;
        const int dr = F.lane >> 4, dc = F.lane & 15;
        f32x4 accH[2]; accH[0] = (f32x4){0.f, 0.f, 0.f, 0.f}; accH[1] = accH[0];
        for (int i = F.tid; i < 32 * 136 / 2; i += 512) ((LAS unsigned*)Hl)[i] = 0u;
#define SC_CHUNK_OF(step) (dir == 0 ? (step) : ((step) < 2 ? 1 - (step) : (NCH - 1) - ((step) - 2)))
        const int rsw = (4 * (w & 3) + dr) & 15, gc = dc ^ rsw;
        const unsigned loCB = (unsigned)(dr * 128 + 8 * gc) * 2u, loT = (unsigned)(dr * TV + 8 * gc) * 2u, loC = (unsigned)(dr * BCD + 8 * gc) * 2u;
#define SC_ISSUE_TILES(cvx_) do { const int cvx = (cvx_); const unsigned tvx = cvx * 128u; const unsigned rbx = (unsigned)row_of(b, cvx * 128); \
            _Pragma("unroll") for (int jj = 0; jj < 13; ++jj) { const int q = 8 * jj + w, r0 = 4 * (q & 31);   \
                const char* src; int toff; \
                if (jj < 4) { src = (const char*)(CBh + ((size_t)cvx * 16384u + (unsigned)r0 * 128u)) + loCB; toff = SC_CB; } \
                else if (jj < 8) { src = (const char*)(bt + ((size_t)r0 * TV + tvx)) + loT; toff = SC_BT; } \
                else if (jj < 12) { src = (const char*)(Cg + (size_t)(rbx + r0) * BCD) + loC; toff = SC_C; } \
                else { src = (const char*)(xt + ((size_t)r0 * TV + tvx)) + loT; toff = SC_X; } \
                GLDS16(src, L + toff + (q & 31) * 1024); } } while (0)
        const int kd = w >> 1; float km[8], dk[8];
#pragma unroll
        for (int i = 0; i < 8; ++i) { const int sidx = 32 * kd + 8 * fq + i; km[i] = (dir == 0 ? (sidx <= lrow) : (sidx >= lrow)) ? 1.f : 0.f; dk[i] = (sidx == lrow) ? Dsk : 0.f; }
#define SC_ISSUE_TAB(cvx_, tbuf_) do { if (w < 6) { const int tsel = w >> 1, half = w & 1; const float* tsrc = tsel == 0 ? CUM : (tsel == 1 ? DT : WJ); \
            GLDS4(tsrc + tbase + (cvx_) * 128 + half * 64 + F.lane, (LAS unsigned char*)(tab + (tbuf_) * 384 + tsel * 128 + half * 64)); } } while (0)
        { const int cv0 = SC_CHUNK_OF(0); SC_ISSUE_TILES(cv0); SC_ISSUE_TAB(cv0, 0); }
        for (int step = 0; step < NCH; ++step) {
            const int cv = SC_CHUNK_OF(step), buf = step & 1; const bool more = step + 1 < NCH;
            const int cvn = more ? SC_CHUNK_OF(step + 1) : cv;
            const unsigned rbase = (unsigned)row_of(b, cv * 128);
            if (step == 0) WAITV(0); else WAITV(2);
            LDSBAR();
            u32x4 rcb[4], rbt[4]; bf16x8 xf[2][4], cf[4];
#pragma unroll
            for (int ks = 0; ks < 4; ++ks) { const int fo = lrow * 256 + (((4 * ks + fq) ^ fr) << 4);
                rcb[ks] = *(const LAS u32x4*)(L + SC_CB + fo); rbt[ks] = *(const LAS u32x4*)(L + SC_BT + fo); cf[ks] = *(const LAS bf16x8*)(L + SC_C + fo);
#pragma unroll
                for (int nt = 0; nt < 2; ++nt) xf[nt][ks] = *(const LAS bf16x8*)(L + SC_X + (16 * nt + fr) * 256 + (((4 * ks + fq) ^ fr) << 4)); }
            LDSBAR();
            if (more) { SC_ISSUE_TILES(cvn); SC_ISSUE_TAB(cvn, buf ^ 1); }
            const LAS float* tb = tab + buf * 384;
            const float cl2 = tb[lrow]; const float ecum_l = fexp2(cl2);
            const float chunk_decay = fexp2(dir == 0 ? tb[127] : tb[0]);
            bf16x8 mf[4], bw[4];
#pragma unroll
            for (int ks = 0; ks < 4; ++ks) { const int s0 = 32 * ks + 8 * fq;
                const bool none = dir == 0 ? (ks > kd) : (ks < kd), diag = (ks == kd);
                unsigned om[4] = {0u, 0u, 0u, 0u};
                if (!none) {
                    const f32x4 cs0 = *(const LAS f32x4*)(tb + 128 + s0), cs1 = *(const LAS f32x4*)(tb + 128 + s0 + 4);
                    const float cs[8] = {cs0[0], cs0[1], cs0[2], cs0[3], cs1[0], cs1[1], cs1[2], cs1[3]};
                    const unsigned qc[4] = {rcb[ks].x, rcb[ks].y, rcb[ks].z, rcb[ks].w};
                    float v[8];
                    if (!diag) {
#pragma unroll
                        for (int i = 0; i < 8; ++i) { const float cbv = (i & 1) ? bfhi(qc[i >> 1]) : bflo(qc[i >> 1]); v[i] = cbv * fexp2(cl2 - cs[i]); }
                    } else {
#pragma unroll
                        for (int i = 0; i < 8; ++i) { const float cbv = (i & 1) ? bfhi(qc[i >> 1]) : bflo(qc[i >> 1]); const float x = cl2 - cs[i]; v[i] = (cbv * fexp2(x < 60.f ? x : 60.f)) * km[i] + dk[i]; }
                    }
#pragma unroll
                    for (int i = 0; i < 4; ++i) om[i] = pk2(v[2 * i], v[2 * i + 1]);
                }
                mf[ks] = __builtin_bit_cast(bf16x8, (u32x4){om[0], om[1], om[2], om[3]});
                { const f32x4 ws0 = *(const LAS f32x4*)(tb + 256 + s0), ws1 = *(const LAS f32x4*)(tb + 256 + s0 + 4); const float wsv[8] = {ws0[0], ws0[1], ws0[2], ws0[3], ws1[0], ws1[1], ws1[2], ws1[3]};
                  const unsigned qb[4] = {rbt[ks].x, rbt[ks].y, rbt[ks].z, rbt[ks].w}; unsigned ob[4];
#pragma unroll
                  for (int i = 0; i < 4; ++i) ob[i] = pk2(bflo(qb[i]) * wsv[2 * i], bfhi(qb[i]) * wsv[2 * i + 1]);
                  bw[ks] = __builtin_bit_cast(bf16x8, (u32x4){ob[0], ob[1], ob[2], ob[3]}); } }
            f32x4 yd[2], yo[2];
#pragma unroll
            for (int nt = 0; nt < 2; ++nt) { yd[nt] = (f32x4){0.f, 0.f, 0.f, 0.f}; yo[nt] = yd[nt]; accH[nt] = accH[nt] * chunk_decay; }
#pragma unroll
            for (int nt = 0; nt < 2; ++nt)
#pragma unroll
                for (int ks = 0; ks < 4; ++ks) {
                    yd[nt] = MFMA16(xf[nt][ks], mf[ks], yd[nt]);
                    const bf16x8 hf = *(const LAS bf16x8*)(Hl + buf * (32 * 136) + (16 * nt + fr) * 136 + 32 * ks + 8 * fq);
                    yo[nt] = MFMA16(hf, cf[ks], yo[nt]);
                    accH[nt] = MFMA16(bw[ks], xf[nt][ks], accH[nt]); }
#pragma unroll
            for (int nt = 0; nt < 2; ++nt) { u32x2 hw; hw.x = pk2(accH[nt][0], accH[nt][1]); hw.y = pk2(accH[nt][2], accH[nt][3]);
                *(LAS u32x2*)(Hl + (buf ^ 1) * (32 * 136) + (16 * nt + fr) * 136 + 16 * w + 4 * fq) = hw; }
#pragma unroll
            for (int nt = 0; nt < 2; ++nt) { u32x2 yw; yw.x = pk2(yd[nt][0] + ecum_l * yo[nt][0], yd[nt][1] + ecum_l * yo[nt][1]); yw.y = pk2(yd[nt][2] + ecum_l * yo[nt][2], yd[nt][3] + ecum_l * yo[nt][3]);
                *(u32x2*)(Y + ((size_t)(rbase + lrow) * DIN + 16 * nt + 4 * fq)) = yw; }
        }
        WAITV(0); LDSBAR();
    }
}

DEV void phase_gate(const Frame& F, int j, const bf16_t* Yf, const bf16_t* Yb, const bf16_t* Z, bf16_t* YN, int nrows) {
    const int gw = F.bx * 8 + F.wave, NGW = F.G * 8; const float* nw = INP(F, I_SNORM) + (size_t)j * DIN;
    u32x4 na[4], nb[4], nz[4];
    if (gw < nrows) {
#pragma unroll
        for (int q = 0; q < 4; ++q) { const size_t o = (size_t)gw * DIN + 8 * F.lane + 512 * q; na[q] = *(const u32x4*)(Yf + o); nb[q] = *(const u32x4*)(Yb + o); nz[q] = *(const u32x4*)(Z + o); } }
    for (int r = gw; r < nrows; r += NGW) {
        float t[32]; float ss = 0.f;
        u32x4 ca[4], cb4[4], cz[4];
#pragma unroll
        for (int q = 0; q < 4; ++q) { ca[q] = na[q]; cb4[q] = nb[q]; cz[q] = nz[q]; }
        if (r + NGW < nrows) {
#pragma unroll
            for (int q = 0; q < 4; ++q) { const size_t o = (size_t)(r + NGW) * DIN + 8 * F.lane + 512 * q; na[q] = *(const u32x4*)(Yf + o); nb[q] = *(const u32x4*)(Yb + o); nz[q] = *(const u32x4*)(Z + o); } }
#pragma unroll
        for (int q = 0; q < 4; ++q) { const u32x4 a = ca[q], bq = cb4[q], z = cz[q];
            const unsigned aa[4] = {a.x, a.y, a.z, a.w}, bb[4] = {bq.x, bq.y, bq.z, bq.w}, zz[4] = {z.x, z.y, z.z, z.w};
#pragma unroll
            for (int i = 0; i < 4; ++i) { const float v0 = (bflo(aa[i]) + bflo(bb[i])) * siluf(bflo(zz[i])), v1 = (bfhi(aa[i]) + bfhi(bb[i])) * siluf(bfhi(zz[i])); t[8 * q + 2 * i] = v0; t[8 * q + 2 * i + 1] = v1; ss += v0 * v0 + v1 * v1; } }
        const float rstd = rsqrtf(wave_sum(ss) * (1.0f / DIN) + EPS);
#pragma unroll
        for (int q = 0; q < 4; ++q) { const int c = 8 * F.lane + 512 * q; const f32x4 w0 = *(const f32x4*)(nw + c), w1 = *(const f32x4*)(nw + c + 4);
            u32x4 o; o.x = pk2(t[8 * q] * rstd * w0[0], t[8 * q + 1] * rstd * w0[1]); o.y = pk2(t[8 * q + 2] * rstd * w0[2], t[8 * q + 3] * rstd * w0[3]);
            o.z = pk2(t[8 * q + 4] * rstd * w1[0], t[8 * q + 5] * rstd * w1[1]); o.w = pk2(t[8 * q + 6] * rstd * w1[2], t[8 * q + 7] * rstd * w1[3]);
            *(u32x4*)(YN + (size_t)r * DIN + c) = o; }
    }
}

struct TokInfo { int s0, s1; float g0, g1; };
DEV void phase_route(const Frame& F, int layer, int ml, bf16_t* V, int nrows) {
    LAS unsigned* lc = (LAS unsigned*)(F.lds + LDS_MISC + 256);
    if (F.tid < 8) lc[F.tid] = 0u;
    __syncthreads();
    const int gw = F.bx * 8 + F.wave, NGW = F.G * 8; const int j = layer / 2;
    const float* w = INP(F, I_NFFN) + (size_t)layer * D; const float* rw = INP(F, I_RW) + (size_t)j * D * NEXP;
    LAS float* rwl = (LAS float*)F.lds;
    for (int q = F.tid; q < D * 2; q += 512) { const int c = q >> 1, hf = q & 1; const int ln = (c & 255) >> 2, ii = c & 3, jq = c >> 8;
        *(LAS f32x4*)(rwl + ((jq * 4 + ii) * 64 + ln) * 8 + hf * 4) = *(const f32x4*)(rw + (size_t)q * 4); }
    __syncthreads();
    TokInfo* tok = (TokInfo*)(F.ws + OFF_TOK);
    f32x4 nx[4];
    if (gw < nrows) load_row(F.H + (size_t)gw * D, F.lane, nx);
    for (int r = gw; r < nrows; r += NGW) {
        f32x4 v[4];
#pragma unroll
        for (int q = 0; q < 4; ++q) v[q] = nx[q];
        if (r + NGW < nrows) load_row(F.H + (size_t)(r + NGW) * D, F.lane, nx);
        const float rstd = rsqrtf(sumsq_row(v) * (1.0f / D) + EPS);
        const int vec = vec_of(r);
        normmod_row(v, rstd, w, modp(F, layer, vec, 3), modp(F, layer, vec, 4), F.lane);
#pragma unroll
        for (int jq = 0; jq < 4; ++jq) *(unsigned*)((fp8_t*)V + (size_t)r * D + 4 * F.lane + 256 * jq) = pk4_fp8(v[jq][0] * 8.0f, v[jq][1] * 8.0f, v[jq][2] * 8.0f, v[jq][3] * 8.0f);
        float lg[NEXP];
#pragma unroll
        for (int e = 0; e < NEXP; ++e) lg[e] = 0.f;
#pragma unroll
        for (int jj = 0; jj < 4; ++jj)
#pragma unroll
            for (int i = 0; i < 4; ++i) { const LAS float* rp = rwl + ((jj * 4 + i) * 64 + F.lane) * 8; const f32x4 r0 = *(const LAS f32x4*)rp, r1 = *(const LAS f32x4*)(rp + 4);
#pragma unroll
                for (int e = 0; e < 4; ++e) { lg[e] += v[jj][i] * r0[e]; lg[4 + e] += v[jj][i] * r1[e]; } }
#pragma unroll
        for (int e = 0; e < NEXP; ++e) lg[e] = wave_sum(lg[e]);
        int e0 = 0; float v0 = lg[0];
#pragma unroll
        for (int e = 1; e < NEXP; ++e) if (lg[e] > v0) { v0 = lg[e]; e0 = e; }
        int e1 = -1; float v1 = -3.0e38f;
#pragma unroll
        for (int e = 0; e < NEXP; ++e) if (e != e0 && lg[e] > v1) { v1 = lg[e]; e1 = e; }
        const float g1 = frcp(1.0f + FEXP(v0 - v1)), g0 = 1.0f - g1;
        if (F.lane == 0) { TokInfo ti; ti.s0 = e0; ti.s1 = e1; ti.g0 = g0; ti.g1 = g1; tok[r] = ti; atomicAdd((unsigned*)&lc[e0], 1u); atomicAdd((unsigned*)&lc[e1], 1u); }
    }
    __syncthreads();
    if (F.tid < 8) __hip_atomic_fetch_add(F.ctl + CW_CNT + (ml * 8 + F.tid) * 64, lc[F.tid], RLX_AGENT);
}
DEV void tile_starts(const Frame& F, int ml, int (&ts)[NEXP + 1], unsigned (&cnt)[NEXP]) {
    ts[0] = 0;
#pragma unroll
    for (int e = 0; e < NEXP; ++e) { cnt[e] = __hip_atomic_load(F.ctl + CW_CNT + (ml * 8 + e) * 64, RLX_AGENT); ts[e + 1] = ts[e] + (int)((cnt[e] + 255u) / 256u); }
}
DEV void phase_slots(const Frame& F, int ml, int nrows) {
    int ts[NEXP + 1]; unsigned cnt[NEXP]; tile_starts(F, ml, ts, cnt);
    TokInfo* tok = (TokInfo*)(F.ws + OFF_TOK); int* s2t = (int*)(F.ws + OFF_S2T);
    const int gw = F.bx * 8 + F.wave, NGW = F.G * 8;
    for (int base = gw * 64; base < nrows; base += NGW * 64) {
        const int r = base + F.lane; TokInfo ti = tok[r];
        const int ek[2] = {ti.s0, ti.s1}; int sl[2];
#pragma unroll
        for (int k = 0; k < 2; ++k) { sl[k] = 0;
            for (int e = 0; e < NEXP; ++e) { const unsigned long long m = __ballot(ek[k] == e);
                if (m) { const int leader = __builtin_ctzll(m); unsigned b0 = 0;
                    if (F.lane == leader) b0 = __hip_atomic_fetch_add(F.ctl + CW_CUR + (ml * 8 + e) * 64, (unsigned)__builtin_popcountll(m), RLX_AGENT);
                    b0 = __shfl(b0, leader);
                    if (ek[k] == e) sl[k] = ts[e] * 256 + (int)b0 + __builtin_popcountll(m & ((1ull << F.lane) - 1ull)); } } }
        ti.s0 = sl[0]; ti.s1 = sl[1]; tok[r] = ti; s2t[sl[0]] = r; s2t[sl[1]] = r;
    }
    if (F.bx == 0) { for (int e = 0; e < NEXP; ++e) { const int a = ts[e] * 256 + (int)cnt[e], b2 = ts[e + 1] * 256; for (int s = a + F.tid; s < b2; s += 512) s2t[s] = 0; } }
}
DEV void phase_combine(const Frame& F, int layer, const bf16_t* YS, bool final_) {
    const int gw = F.bx * 8 + F.wave, NGW = F.G * 8; const TokInfo* tok = (const TokInfo*)(F.ws + OFF_TOK);
    const int nrows = final_ ? ML : MT;
    f32x4 nh[4]; u32x2 nya[4], nyb[4]; TokInfo tcur, tnxt;
    tcur.s0 = tcur.s1 = 0; tcur.g0 = tcur.g1 = 0.f; tnxt = tcur;
    if (gw < nrows) { tcur = tok[gw]; load_row(F.H + (size_t)gw * D, F.lane, nh);
#pragma unroll
        for (int jj = 0; jj < 4; ++jj) { const int c = 4 * F.lane + 256 * jj; nya[jj] = *(const u32x2*)(YS + (size_t)tcur.s0 * D + c); nyb[jj] = *(const u32x2*)(YS + (size_t)tcur.s1 * D + c); } }
    if (gw + NGW < nrows) tnxt = tok[gw + NGW];
    for (int r = gw; r < nrows; r += NGW) {
        f32x4 v[4]; u32x2 ya[4], yb[4]; TokInfo ti = tcur;
#pragma unroll
        for (int q = 0; q < 4; ++q) { v[q] = nh[q]; ya[q] = nya[q]; yb[q] = nyb[q]; }
        tcur = tnxt;
        if (r + NGW < nrows) { load_row(F.H + (size_t)(r + NGW) * D, F.lane, nh);
#pragma unroll
            for (int jj = 0; jj < 4; ++jj) { const int c = 4 * F.lane + 256 * jj; nya[jj] = *(const u32x2*)(YS + (size_t)tcur.s0 * D + c); nyb[jj] = *(const u32x2*)(YS + (size_t)tcur.s1 * D + c); } }
        if (r + 2 * NGW < nrows) tnxt = tok[r + 2 * NGW];
        if (MOE_DOWN_FP8) { ti.g0 *= 0.00390625f; ti.g1 *= 0.00390625f; }
        const float* g2 = modp(F, layer, vec_of(r), 5);
#pragma unroll
        for (int jj = 0; jj < 4; ++jj) { const int c = 4 * F.lane + 256 * jj; const u32x2 a = ya[jj], b = yb[jj]; const f32x4 gv = *(const f32x4*)(g2 + c);
            v[jj][0] += gv[0] * (ti.g0 * bflo(a.x) + ti.g1 * bflo(b.x)); v[jj][1] += gv[1] * (ti.g0 * bfhi(a.x) + ti.g1 * bfhi(b.x));
            v[jj][2] += gv[2] * (ti.g0 * bflo(a.y) + ti.g1 * bflo(b.y)); v[jj][3] += gv[3] * (ti.g0 * bfhi(a.y) + ti.g1 * bfhi(b.y)); }
        if (!final_) {
#pragma unroll
            for (int jj = 0; jj < 4; ++jj) *(f32x4*)(F.H + (size_t)r * D + 4 * F.lane + 256 * jj) = v[jj];
        } else {
            const float rstd = rsqrtf(sumsq_row(v) * (1.0f / D) + EPS); const float* fw = INP(F, I_FNORM);
#pragma unroll
            for (int jj = 0; jj < 4; ++jj) { const int c = 4 * F.lane + 256 * jj; *(f32x4*)(OUTP(F) + (size_t)r * D + c) = v[jj] * rstd * *(const f32x4*)(fw + c); }
        }
    }
}

constexpr int PH_PER_PAIR = 17, N_PHASES = 1 + 2 * PH_PER_PAIR;
__global__ void __launch_bounds__(512, 2) fwd_kernel(Params prm) {
#ifdef EMU
    unsigned char* lds_raw = emu_lds();
#else
    extern __shared__ __attribute__((aligned(16))) unsigned char lds_raw[];
#endif
    Frame F;
    F.lds = (LAS unsigned char*)lds_raw;
    F.tid = threadIdx.x; F.lane = F.tid & 63; F.wave = RFL(F.tid >> 6); F.G = gridDim.x; F.bx = blockIdx.x;
    F.p = &prm; F.ws = prm.ws; F.ctl = (unsigned*)(prm.ws + OFF_CTL); F.H = (float*)(prm.ws + OFF_H); F.mod = (float*)(prm.ws + OFF_MOD);
    volatile LAS unsigned* misc = (volatile LAS unsigned*)(F.lds + LDS_MISC);
    if (F.tid < 64) misc[F.tid] = 0u;
    __syncthreads();
    XcdBarrier bar; bar.bar = F.ctl + CW_BAR; bar.x = 0; bar.st = misc;
    const int lo = prm.ph_lo, hi = prm.ph_hi;
    if (hi - lo > 1) bar = xcd_barrier_post(F.ctl + CW_BAR, misc);
    int ph = 0;
#ifndef SITE_MASK
#define SITE_MASK 0xFFFFFFFFu
#endif
#ifndef PROBE_REPEAT_SITE
#define PROBE_REPEAT_SITE (-1)
#endif
#define PH_REPS(site) ((PROBE_REPEAT_SITE == (site)) ? 2 : 1)
#define PHASE_BEGIN(site) if (((SITE_MASK >> (site)) & 1u) && lo <= ph && ph < hi) { { int _t = threadIdx.x; LAUNDER_V(_t); F.tid = _t; F.lane = _t & 63; int _b = blockIdx.x; LAUNDER_S(_b); F.bx = _b; int _g = gridDim.x; LAUNDER_S(_g); F.G = _g; \
      F.ws = WSP(F); F.ctl = (unsigned*)(F.ws + OFF_CTL); F.H = (float*)(F.ws + OFF_H); F.mod = (float*)(F.ws + OFF_MOD); } \
      for (int _rep = 0; _rep < PH_REPS(site); ++_rep) { if (_rep) __syncthreads();
#define PHASE_END   } if (ph + 1 < hi) xcd_barrier(bar); } ++ph;
#define B_W (F.ws + OFF_W)
#define B_ACT (F.ws + OFF_ACT)
#define B_P ((bf16_t*)(B_ACT + A_P))
#define B_HID ((bf16_t*)(B_ACT + A_HID))
#define B_U ((bf16_t*)(B_ACT + A_U))
#define B_Z ((bf16_t*)(B_ACT + A_Z))
#define B_XBC ((bf16_t*)(B_ACT + A_XBC))
#define B_DT ((float*)(B_W + W_DT))
#define B_XT ((bf16_t*)(B_ACT + A_XT))
#define B_BROW ((bf16_t*)(B_ACT + A_BROW))
#define B_BT ((bf16_t*)(B_ACT + A_BT))
#define B_CROW ((bf16_t*)(B_ACT + A_CROW))
#define B_CB ((bf16_t*)(B_ACT + A_CB))
#define B_CUM ((float*)(B_ACT + A_CUM))
#define B_WJ ((float*)(B_ACT + A_WJ))
#define B_YF ((bf16_t*)(B_ACT + A_YF))
#define B_YB ((bf16_t*)(B_W + W_YB))
#define B_YN ((bf16_t*)(B_ACT + A_YN))
#define B_V ((bf16_t*)(B_ACT + A_V))
#define B_HIDM ((bf16_t*)(B_ACT + A_HIDM))
#define B_YS ((bf16_t*)(B_ACT + A_YS))

    PHASE_BEGIN(0) phase_mod(F); convert_even(F, 0); PHASE_END

    for (int lp = 0; lp < 2; ++lp) {
        const int le = 2 * lp, lod = 2 * lp + 1;
        PHASE_BEGIN(1) phase_poolprep(F, le, B_P); PHASE_END
        PHASE_BEGIN(2) { PolPool S; S.G = F.G; S.c = F.bx; S.K = 256; S.lda = D; S.ldb = 256; S.P = B_P; S.W = (const bf16_t*)(B_W + W_POOL); S.src = mksrc(F); S.layer = le; S.scale = INP(F, I_POOLS) + (size_t)lp * D;
                      ge::gemm_phase(F.lds, S, F.tid); } PHASE_END
        PHASE_BEGIN(3) phase_norm(F, le, 3, B_P, false); PHASE_END
        PHASE_BEGIN(4) { PolUp<false> S; S.G = F.G; S.c = F.bx; S.K = D; S.lda = D; S.ldb = D; S.A = B_P; S.W = (const bf16_t*)(B_W + W_UP); S.HID = B_HID; S.ldh = DFF; S.nq = DFF / 128; S.nM = NPAN; S.s2t = nullptr;
                      ge::gemm_phase(F.lds, S, F.tid); } PHASE_END
        PHASE_BEGIN(5) { PolResid S; S.G = F.G; S.c = F.bx; S.K = DFF; S.lda = DFF; S.ldb = DFF; S.A = B_HID; S.W = (const bf16_t*)(B_W + W_DN); S.src = mksrc(F); S.layer = le; S.which = 5; S.npan = NPAN;
                      ge::gemm_phase(F.lds, S, F.tid); } PHASE_END
        PHASE_BEGIN(6) phase_norm(F, lod, 0, B_U, false); convert_ssd(F, lp); PHASE_END
        PHASE_BEGIN(7) { PolInProj S; S.G = F.G; S.c = F.bx; S.K = D; S.lda = D; S.ldb = D; S.A = B_U; S.W = (const bf16_t*)(B_W + W_IN); S.Z = B_Z; S.XBC = B_XBC; S.DT = B_DT;
                      ge::gemm_phase(F.lds, S, F.tid); } PHASE_END
        PHASE_BEGIN(8) phase_conv(F, lp, B_XBC, B_XT, B_BROW, B_BT, B_CROW); PHASE_END
        PHASE_BEGIN(9) phase_cb(F, B_BROW, B_CROW, B_CB); phase_tables(F, lp, B_DT, B_CUM, B_WJ); PHASE_END
        PHASE_BEGIN(10) phase_scan(F, lp, B_XT, B_BT, B_CROW, B_CB, B_DT, B_CUM, B_WJ, B_YF, B_YB); PHASE_END
        PHASE_BEGIN(11) phase_gate(F, lp, B_YF, B_YB, B_Z, B_YN, lp == 1 ? ML : MT); PHASE_END
        PHASE_BEGIN(12) { PolResid S; S.G = F.G; S.c = F.bx; S.K = DIN; S.lda = DIN; S.ldb = DIN; S.A = B_YN; S.W = (const bf16_t*)(B_W + W_OUT); S.src = mksrc(F); S.layer = lod; S.which = 2; S.npan = lp == 1 ? ML / 256 : NPAN;
                      ge::gemm_phase(F.lds, S, F.tid); } PHASE_END
        PHASE_BEGIN(13) phase_route(F, lod, lp, B_V, lp == 1 ? ML : MT); convert_moe(F, lp); PHASE_END
        PHASE_BEGIN(14) phase_slots(F, lp, lp == 1 ? ML : MT); PHASE_END
        PHASE_BEGIN(15) { int ts[NEXP + 1]; unsigned cnt[NEXP]; tile_starts(F, lp, ts, cnt);
                      PolUp<true> S; S.G = F.G; S.c = F.bx; S.K = D; S.lda = D; S.ldb = D; S.A = B_V; S.W = (const bf16_t*)(B_W + W_MUP); S.HID = B_HIDM; S.ldh = DFFE; S.nq = DFFE / 128; S.nM = ts[NEXP];
                      S.s2t = (const int*)(F.ws + OFF_S2T);
#pragma unroll
                      for (int e = 0; e <= NEXP; ++e) S.tstart[e] = ts[e];
                      ge::gemm_phase(F.lds, S, F.tid); } PHASE_END
        PHASE_BEGIN(16) { int ts[NEXP + 1]; unsigned cnt[NEXP]; tile_starts(F, lp, ts, cnt);
                      PolMoeDown S; S.G = F.G; S.c = F.bx; S.K = DFFE; S.lda = DFFE; S.ldb = DFFE; S.A = B_HIDM; S.W = (const bf16_t*)(B_W + W_MDN); S.YS = B_YS; S.nM = ts[NEXP];
#pragma unroll
                      for (int e = 0; e <= NEXP; ++e) S.tstart[e] = ts[e];
                      ge::gemm_phase(F.lds, S, F.tid); } PHASE_END
        PHASE_BEGIN(17) phase_combine(F, lod, B_YS, lp == 1); if (lp == 0) convert_even(F, 1); PHASE_END
    }
#undef PHASE_BEGIN
#undef PHASE_END
}

extern "C" void kernel_launch(void* const* d_in, const int* in_sizes, int n_in, void* d_out, int out_size, void* d_ws, size_t ws_size, hipStream_t stream) {
    static int grid = 0;
    if (grid == 0) {
        if (n_in != 26 || ws_size < WS_NEED) { fprintf(stderr, "kernel_launch: need 26 inputs and %zu bytes of workspace (got %d, %zu)\n", (size_t)WS_NEED, n_in, ws_size); grid = -1; return; }
        int dev = 0, cus = 0, per_cu = 0;
        if (hipGetDevice(&dev) != hipSuccess || hipDeviceGetAttribute(&cus, hipDeviceAttributeMultiprocessorCount, dev) != hipSuccess) { grid = -1; return; }
        if (hipFuncSetAttribute((const void*)fwd_kernel, hipFuncAttributeMaxDynamicSharedMemorySize, LDS_BYTES) != hipSuccess) { grid = -1; return; }
        if (hipOccupancyMaxActiveBlocksPerMultiprocessor(&per_cu, (const void*)fwd_kernel, 512, LDS_BYTES) != hipSuccess || per_cu < 1) { fprintf(stderr, "kernel_launch: occupancy query says %d\n", per_cu); }
        (void)hipGetLastError();
        grid = cus;
    }
    if (grid < 0) return;
    (void)in_sizes; (void)out_size;
    if (hipMemsetAsync((char*)d_ws + OFF_CTL, 0, CTL_BYTES, stream) != hipSuccess) return;
    Params p{};
    for (int i = 0; i < 26; ++i) p.in[i] = (const float*)d_in[i];
    p.out = (float*)d_out; p.ws = (unsigned char*)d_ws;
    if (N_LAUNCH_MODE == 1) { p.ph_lo = 0; p.ph_hi = N_PHASES; hipLaunchKernelGGL(fwd_kernel, dim3(grid), dim3(512), LDS_BYTES, stream, p); }
    else for (int ph = 0; ph < N_PHASES; ++ph) { p.ph_lo = ph; p.ph_hi = ph + 1; hipLaunchKernelGGL(fwd_kernel, dim3(grid), dim3(512), LDS_BYTES, stream, p); }
}
```

```cpp
#ifndef EMU
#include <hip/hip_runtime.h>
#endif
#include <cstdio>
#include <cstdint>

#ifndef CFG_SEQ
#define CFG_SEQ 16384
#endif
#ifndef CFG_DFF
#define CFG_DFF 2816
#endif
#ifndef CFG_DFFE
#define CFG_DFFE 3584
#endif
#ifndef MOE_DOWN_FP8
#define MOE_DOWN_FP8 1
#endif
#ifndef N_LAUNCH_MODE
#define N_LAUNCH_MODE 1
#endif

#ifdef EMU
#define LAS
#define DEV inline
#define WAITV(n) ((void)0)
#define WAITL(n) ((void)0)
#define SBAR() emu_wg_sync()
#define SCHED() ((void)0)
#define SETPRIO(x) ((void)0)
#define MFMA16(a, b, c) emu_mfma16(a, b, c)
#define GLDS16(g, l) emu_glds16((const void*)(g), (void*)(l))
#define GLDS4(g, l) emu_glds4((const void*)(g), (void*)(l))
#define MFMA8(a, b, c) emu_mfma8(a, b, c)
#define RFL(x) emu_rfl(x)
#define MEMFENCE() ((void)0)
#define WSYNC() emu_wave_sync()
#define LDSBAR() emu_wg_sync()
#define LAUNDER_V(x) ((void)0)
#define SLEEP1() emu_yield()
#define MY_XCC_ID() ((unsigned)(blockIdx.x & 7u))
#define FENCE_REL() __atomic_thread_fence(__ATOMIC_SEQ_CST)
#define FENCE_ACQ() __atomic_thread_fence(__ATOMIC_SEQ_CST)
#define FEXP(x) expf(x)
#define RLX_AGENT __ATOMIC_RELAXED, 4
#else
#define LAS __attribute__((address_space(3)))
#define DEV __device__ __forceinline__
#define WAITV(n) asm volatile("s_waitcnt vmcnt(" #n ")" ::: "memory")
#define WAITL(n) asm volatile("s_waitcnt lgkmcnt(" #n ")" ::: "memory")
#define SBAR() __builtin_amdgcn_s_barrier()
#define SCHED() __builtin_amdgcn_sched_barrier(0)
#define SETPRIO(x) __builtin_amdgcn_s_setprio(x)
#define MFMA16(a, b, c) __builtin_amdgcn_mfma_f32_16x16x32_bf16(a, b, c, 0, 0, 0)
#define GLDS16(g, l) __builtin_amdgcn_global_load_lds((const unsigned*)(g), (LAS unsigned*)(l), 16, 0, 0)
#define GLDS4(g, l) __builtin_amdgcn_global_load_lds((const unsigned*)(g), (LAS unsigned*)(l), 4, 0, 0)
#define MFMA8(a, b, c) __builtin_amdgcn_mfma_scale_f32_16x16x128_f8f6f4(a, b, c, 0, 0, 0, 0x7f7f7f7f, 0, 0x7f7f7f7f)
#define RFL(x) __builtin_amdgcn_readfirstlane(x)
#define MEMFENCE() asm volatile("" ::: "memory")
#define LDSBAR() do { asm volatile("s_waitcnt lgkmcnt(0)" ::: "memory"); __builtin_amdgcn_s_barrier(); asm volatile("" ::: "memory"); } while (0)
#define WSYNC() asm volatile("s_waitcnt lgkmcnt(0)" ::: "memory")
#define SLEEP1() __builtin_amdgcn_s_sleep(1)
#define MY_XCC_ID() ((unsigned)__builtin_amdgcn_s_getreg((3 << 11) | 20) & 0xFu)
#define FENCE_REL() __builtin_amdgcn_fence(__ATOMIC_RELEASE, "agent")
#define FENCE_ACQ() __builtin_amdgcn_fence(__ATOMIC_ACQUIRE, "agent")
#define FEXP(x) __expf(x)
#define RLX_AGENT __ATOMIC_RELAXED, __HIP_MEMORY_SCOPE_AGENT
#define LAUNDER_V(x) asm volatile("" : "+v"(x))
#endif

typedef unsigned short bf16_t;
typedef short bf16x8 __attribute__((ext_vector_type(8)));
typedef float f32x4 __attribute__((ext_vector_type(4)));
typedef float f32x2 __attribute__((ext_vector_type(2)));
typedef unsigned u32x4 __attribute__((ext_vector_type(4)));
typedef unsigned u32x2 __attribute__((ext_vector_type(2)));
typedef int i32x8 __attribute__((ext_vector_type(8)));
typedef int i32x4 __attribute__((ext_vector_type(4)));
typedef unsigned char fp8_t;

constexpr int D = 1024, NB = 2, SEQ = CFG_SEQ, CTXL = 256, DEPTH = 4;
constexpr int ML = NB * SEQ, MC = NB * CTXL, MT = ML + MC, NPAN = MT / 256;
constexpr int DFF = CFG_DFF, DFFE = CFG_DFFE, NEXP = 8;
constexpr int DIN = 2048, NH = 32, HD = 64, NG = 4, DS = 128, CONVD = 3072, NPROJ = 5184, NPROJP = 5376, BCD = 512;
constexpr int TV = CTXL + SEQ, NCH = TV / 128;
constexpr int GRIDW = 64;
constexpr float EPS = 1e-6f;
constexpr int NSLOT_TILES = (2 * MT) / 256 + NEXP, NSLOT = NSLOT_TILES * 256;
static_assert(SEQ % 128 == 0 && ML % 256 == 0 && DFF % 128 == 0 && DFFE % 128 == 0 && DFF >= 256 && DFFE >= 256, "shape constraints");

constexpr size_t MiB = 1u << 20;
constexpr size_t al(size_t x) { return (x + 4095) & ~(size_t)4095; }
constexpr size_t OFF_CTL = 0, CTL_BYTES = 1 * MiB;
constexpr size_t OFF_MOD = 1 * MiB;
constexpr size_t OFF_TOK = 2 * MiB;
constexpr size_t OFF_S2T = 3 * MiB;
constexpr size_t OFF_H = 4 * MiB, SZ_H = (size_t)MT * D * 4;
constexpr size_t OFF_W = OFF_H + al(SZ_H);
constexpr size_t W_POOL = 0, SZ_WPOOL = (size_t)4 * 256 * 256 * 2;
constexpr size_t W_UP = al(SZ_WPOOL), SZ_WUP = (size_t)2 * DFF * D * 2;
constexpr size_t W_DN = W_UP + al(SZ_WUP), SZ_WDN = (size_t)D * DFF * 2;
constexpr size_t SZ_WEVEN = W_DN + al(SZ_WDN);
constexpr size_t W_IN = 0, SZ_WIN = (size_t)NPROJP * D * 2;
constexpr size_t W_OUT = al(SZ_WIN), SZ_WOUT = (size_t)D * DIN * 2;
constexpr size_t W_DT = W_OUT + al(SZ_WOUT), SZ_DT = (size_t)NB * 2 * NH * TV * 4;
constexpr size_t W_MUP = W_DT + al(SZ_DT), SZ_WMUP = (size_t)NEXP * 2 * DFFE * D * 2;
constexpr size_t W_MDN = W_MUP + al(SZ_WMUP), SZ_WMDN = (size_t)NEXP * D * DFFE * 2;
constexpr size_t W_YB = W_MUP, SZ_Y = (size_t)MT * DIN * 2;
constexpr size_t SZ_WODD_A = W_MDN + al(SZ_WMDN), SZ_WODD_B = W_YB + al(SZ_Y);
constexpr size_t mx(size_t a, size_t b) { return a > b ? a : b; }
constexpr size_t SZ_W = mx(SZ_WEVEN, mx(SZ_WODD_A, SZ_WODD_B));
constexpr size_t OFF_ACT = OFF_W + SZ_W;
constexpr size_t A_P = 0, SZ_ACT1 = (size_t)MT * D * 2;
constexpr size_t A_HID = al(SZ_ACT1), SZ_HID = (size_t)MT * DFF * 2;
constexpr size_t SZ_AEVEN = A_HID + al(SZ_HID);
constexpr size_t A_Z = 0;
constexpr size_t A_XBC = al(SZ_Y), SZ_XBC = (size_t)MT * CONVD * 2;
constexpr size_t A_YF = A_XBC;
constexpr size_t A_CB = A_XBC + al(SZ_Y), SZ_CB = (size_t)NB * NG * NCH * 128 * 128 * 2;
static_assert(al(SZ_Y) + SZ_CB <= SZ_XBC, "CB fits behind Yf inside the XBC region");
constexpr size_t A_XT = A_XBC + al(SZ_XBC), SZ_XT = (size_t)NB * DIN * TV * 2;
constexpr size_t A_U = A_XT, A_YN = A_XT;
constexpr size_t A_BROW = A_XT + al(SZ_XT), SZ_BC = (size_t)MT * BCD * 2;
constexpr size_t A_BT = A_BROW + al(SZ_BC);
constexpr size_t A_CROW = A_BT + al(SZ_BC);
constexpr size_t A_CUM = A_CROW + al(SZ_BC);
constexpr size_t A_WJ = A_CUM + al(SZ_DT);
constexpr size_t SZ_ASSD = A_WJ + al(SZ_DT);
constexpr size_t A_V = 0;
constexpr size_t A_HIDM = al(SZ_ACT1), SZ_HIDM = (size_t)NSLOT * DFFE * 2;
constexpr size_t A_YS = A_HIDM + al(SZ_HIDM), SZ_YS = (size_t)NSLOT * D * 2;
constexpr size_t SZ_AMOE = A_YS + al(SZ_YS);
constexpr size_t SZ_ACT = mx(SZ_AEVEN, mx(SZ_ASSD, SZ_AMOE));
constexpr size_t WS_NEED = OFF_ACT + SZ_ACT;

constexpr int CW_BAR = 4096;
constexpr int CW_CNT = 16384;
constexpr int CW_CUR = 16384 + 2 * 8 * 64;

DEV unsigned f2bf(float f) { unsigned u = __builtin_bit_cast(unsigned, f); return (u + 0x7fffu + ((u >> 16) & 1u)) >> 16; }
#ifndef EMU
typedef __bf16 bf16x2n __attribute__((ext_vector_type(2)));
#endif
DEV unsigned pk2(float lo, float hi) {
#ifdef EMU
    return f2bf(lo) | (f2bf(hi) << 16);
#else
    f32x2 v = {lo, hi}; bf16x2n b = __builtin_convertvector(v, bf16x2n); return __builtin_bit_cast(unsigned, b);
#endif
}
DEV unsigned pk4_fp8(float a, float b, float c, float d) {
#ifdef EMU
    return emu_f2fp8(a) | (emu_f2fp8(b) << 8) | (emu_f2fp8(c) << 16) | (emu_f2fp8(d) << 24);
#else
    unsigned w = 0; w = __builtin_amdgcn_cvt_pk_fp8_f32(a, b, w, false); w = __builtin_amdgcn_cvt_pk_fp8_f32(c, d, w, true); return w;
#endif
}
DEV float bf2f(unsigned b) { return __builtin_bit_cast(float, b << 16); }
DEV float bflo(unsigned w) { return __builtin_bit_cast(float, w << 16); }
DEV float bfhi(unsigned w) { return __builtin_bit_cast(float, w & 0xffff0000u); }
#ifdef EMU
DEV float frcp(float x) { return 1.0f / x; }
#else
DEV float frcp(float x) { return __builtin_amdgcn_rcpf(x); }
#endif
#ifdef EMU
DEV float fexp2(float x) { return exp2f(x); }
#else
DEV float fexp2(float x) { return __builtin_amdgcn_exp2f(x); }
#endif
DEV float siluf(float x) { return x * frcp(1.0f + FEXP(-x)); }
#ifdef EMU
DEV float flog2(float x) { return log2f(x); }
#else
DEV float flog2(float x) { return __builtin_amdgcn_logf(x); }
#endif
DEV float softplusf(float x) { if (x > 20.f) return x; const float e = FEXP(x); return e < 0.0625f ? e * (1.0f - e * (0.5f - e * (0.33333334f - e * (0.25f - e * 0.2f)))) : flog2(1.0f + e) * 0.6931471806f; }
DEV float wave_sum(float v) {
#pragma unroll
    for (int o = 1; o < 64; o <<= 1) v += __shfl_xor(v, o);
    return v;
}
DEV int vec_of(int r) { return r < ML ? (r / SEQ) : 2; }
DEV int row_of(int b, int tv) { return tv < CTXL ? ML + b * CTXL + tv : b * SEQ + (tv - CTXL); }

#define XB_TMO      128
#define XB_XCNT(j)  (256  + 64 * (j))
#define XB_XSUB(j)  (1280 + 64 * (j))
#define XB_XGEN(j)  (2304 + 64 * (j))
#define XB_TOP      3328
#define XB_TOPGEN   3392
#define XCD_BAR_WORDS 3456
#define XB_SPIN_CAP (1u << 22)
DEV unsigned xb_ld(unsigned* p)              { return __hip_atomic_load(p, RLX_AGENT); }
DEV unsigned xb_add(unsigned* p, unsigned v) { return __hip_atomic_fetch_add(p, v, RLX_AGENT); }
#define XB_SPIN(cond, bar) do { unsigned _sp = 0; while (cond) { SLEEP1(); \
    if ((++_sp & 255u) == 0u) { if (xb_ld(&(bar)[XB_TMO])) break; if (_sp > XB_SPIN_CAP) { atomicAdd(&(bar)[XB_TMO], 1u); break; } } } } while (0)
struct XcdBarrier { unsigned* bar; unsigned x; volatile LAS unsigned* st; };
DEV XcdBarrier xcd_barrier_post(unsigned* bar, volatile LAS unsigned* st) {
    XcdBarrier b; b.bar = bar; b.x = MY_XCC_ID(); b.st = st;
    if (threadIdx.x == 0) (void)xb_add(&bar[XB_XCNT(b.x)], 1u);
    return b;
}
DEV void xcd_barrier_complete(unsigned* bar, unsigned x, unsigned& nloc, unsigned& nx) {
    const unsigned G = gridDim.x;
    unsigned sum, cnt, mine, sp = 0u;
    for (;;) {
        sum = 0u; cnt = 0u; mine = 0u;
#pragma unroll
        for (unsigned j = 0; j < 16; ++j) { const unsigned c = xb_ld(&bar[XB_XCNT(j)]); sum += c; cnt += (c > 0u) ? 1u : 0u; mine = (j == x) ? c : mine; }
        if (sum == G) break;
        SLEEP1();
        if ((++sp & 255u) == 0u) { if (xb_ld(&bar[XB_TMO])) break; if (sp > XB_SPIN_CAP) { atomicAdd(&bar[XB_TMO], 1u); break; } }
    }
    nloc = mine > 0u ? mine : 1u; nx = cnt > 0u ? cnt : 1u;
}
DEV void xcd_barrier(const XcdBarrier& b) {
    WAITV(0);
    __syncthreads();
    if (threadIdx.x == 0) {
        unsigned* bar = b.bar;
#ifndef EMU
        __builtin_amdgcn_s_waitcnt(0);
#endif
        unsigned nloc = b.st[0], nx = b.st[1];
        if (nloc == 0u) { xcd_barrier_complete(bar, b.x, nloc, nx); b.st[0] = nloc; b.st[1] = nx; }
        const unsigned old = xb_add(&bar[XB_XSUB(b.x)], 1u);
        const unsigned gen = old / nloc;
        if (old + 1u == (gen + 1u) * nloc) {
            FENCE_REL();
            WAITV(0);
            const unsigned og = xb_add(&bar[XB_TOP], 1u);
            const unsigned tg = og / nx;
            if (og + 1u == (tg + 1u) * nx) xb_add(&bar[XB_TOPGEN], 1u);
            else XB_SPIN(xb_ld(&bar[XB_TOPGEN]) == tg, bar);
            FENCE_ACQ();
            xb_add(&bar[XB_XGEN(b.x)], 1u);
            WAITV(0);
        } else {
            XB_SPIN(xb_ld(&bar[XB_XGEN(b.x)]) == gen, bar);
            FENCE_ACQ();
            WAITV(0);
        }
    }
    __syncthreads();
}

namespace ge {
constexpr int BM = 256, BK = 64, HALF = 128, HTB = HALF * BK * 2, STAGE_BYTES = 8 * HTB, NXCD = 8, WGM = 8;
DEV int lds_byte(int r, int c) { const int st = (r >> 4) * 2 + (c >> 5), rr = r & 15, cc = c & 31, ob = rr * 64 + cc * 2; return st * 1024 + (ob ^ (((ob >> 9) & 1) << 5)); }
DEV void stage_rc(int b, int& R, int& C) { const int st = b / 1024, sb = b % 1024, swz = sb ^ (((sb >> 9) & 1) << 5); R = (st >> 1) * 16 + swz / 64; C = (st & 1) * 32 + (swz % 64) / 2; }
DEV int perm32(int rho) { const int n = rho >> 4, i = rho & 15; return 8 * (i >> 2) + 4 * n + (i & 3); }
struct Unit { int pm, pn; };
DEV bool static_next(int nM, int nN, int G, int c, int i, Unit& u) {
    const int nwg = nM * nN; const long L = (long)i * G + c; if (L >= nwg) return false;
    int wgid = (int)L; { const int q = nwg / NXCD, r = nwg % NXCD, xcd = wgid % NXCD, off = wgid / NXCD; wgid = (xcd < r ? xcd * (q + 1) : r * (q + 1) + (xcd - r) * q) + off; }
    const int nig = WGM * nN, gid = wgid / nig, fm = gid * WGM, gsz = (nM - fm) < WGM ? (nM - fm) : WGM;
    u.pm = fm + ((wgid % nig) % gsz); u.pn = (wgid % nig) / gsz; return true;
}
template <class P, bool SP2 = true>
DEV void gemm_phase(LAS unsigned char* lds, const P& S, const int tid) {
    const int wid = RFL(tid >> 6), lane = tid & 63, wr = wid >> 2, wc = wid & 3, fr = lane & 15, fq = lane >> 4;
    const int K = S.K, nt = K * P::ES / (BK * 2);
    unsigned voffB[2]; int RA[2], CA2[2];
#pragma unroll
    for (int i = 0; i < 2; ++i) { int R, C; stage_rc(tid * 16 + i * 8192, R, C); const int Rb = P::PERM ? ((R & ~31) + perm32(R & 31)) : R;
        RA[i] = R; CA2[i] = C * 2; voffB[i] = (unsigned)(Rb * S.ldb) * (unsigned)P::ES + (unsigned)(C * 2); }
    const size_t kstep = (size_t)(BK * 2);
    const size_t hstepB = (size_t)HALF * S.ldb * P::ES;
    const unsigned ldsw = (unsigned)wid * 1024u;
    const int aoff = lds_byte(wr * 64 + fr, fq * 8), boff = lds_byte(wc * 32 + fr, fq * 8);
#define GE_SA(b, h) (((b) * 2 + (h)) * HTB)
#define GE_SB(b, h) ((4 + (b) * 2 + (h)) * HTB)
#define GE_STAGEB(bufoff, gbase) do { _Pragma("unroll") for (int _i = 0; _i < 2; ++_i) { unsigned _o = voffB[_i]; LAUNDER_V(_o); \
        GLDS16((const char*)(gbase) + _o, lds + (bufoff) + ldsw + _i * 8192); } } while (0)
#define GE_STAGEA(bufoff, gbase, h) do { _Pragma("unroll") for (int _i = 0; _i < 2; ++_i) { unsigned _o = oA[h][_i]; LAUNDER_V(_o); \
        GLDS16((const char*)(gbase) + _o, lds + (bufoff) + ldsw + _i * 8192); } } while (0)
#define GE_LD1(p_) __builtin_shufflevector(*(const LAS i32x4*)(p_), *(const LAS i32x4*)((p_) + 1024), 0, 1, 2, 3, 4, 5, 6, 7)
#define GE_LDA(dst, b, h) do { _Pragma("unroll") for (int m = 0; m < 4; ++m) dst[m] = GE_LD1(lds + GE_SA(b, h) + aoff + m * 2048); } while (0)
#define GE_LDB(dst, b, h) do { _Pragma("unroll") for (int n = 0; n < 2; ++n) dst[n] = GE_LD1(lds + GE_SB(b, h) + boff + n * 2048); } while (0)
#define GE_LO(x) __builtin_bit_cast(bf16x8, __builtin_shufflevector(x, x, 0, 1, 2, 3))
#define GE_HI(x) __builtin_bit_cast(bf16x8, __builtin_shufflevector(x, x, 4, 5, 6, 7))
#define GE_MMA(ai, bj, At, Bt) do { SETPRIO(1); _Pragma("unroll") for (int m = 0; m < 4; ++m) _Pragma("unroll") for (int n = 0; n < 2; ++n) { \
        if constexpr (P::FP8) acc[ai][bj][m][n] = MFMA8(Bt[n], At[m], acc[ai][bj][m][n]);     \
        else { acc[ai][bj][m][n] = MFMA16(GE_LO(Bt[n]), GE_LO(At[m]), acc[ai][bj][m][n]); acc[ai][bj][m][n] = MFMA16(GE_HI(Bt[n]), GE_HI(At[m]), acc[ai][bj][m][n]); } } SETPRIO(0); } while (0)
    Unit cur, nxt; int ui = 0;
    if (!S.next(0, cur)) return;
    f32x4 acc[2][2][4][2];
#pragma unroll
    for (int a = 0; a < 2; ++a)
#pragma unroll
        for (int b = 0; b < 2; ++b)
#pragma unroll
            for (int m = 0; m < 4; ++m)
#pragma unroll
                for (int n = 0; n < 2; ++n) acc[a][b][m][n] = (f32x4){0.f, 0.f, 0.f, 0.f};
    unsigned oA[2][2];
#pragma unroll
    for (int h = 0; h < 2; ++h)
#pragma unroll
        for (int i = 0; i < 2; ++i) {
            if constexpr (P::GATHER) oA[h][i] = (unsigned)S.gather_row(cur, h * HALF + RA[i]) * (unsigned)(S.lda * P::ES) + (unsigned)CA2[i];
            else oA[h][i] = (unsigned)((h * HALF + RA[i]) * S.lda) * (unsigned)P::ES + (unsigned)CA2[i];
            }
    const char* cA = S.a_base(cur); const char* cB = S.b_base(cur);
    if constexpr (SP2) {
        GE_STAGEB(GE_SB(0, 0), cB); GE_STAGEB(GE_SB(0, 1), cB + hstepB); GE_STAGEA(GE_SA(0, 0), cA, 0); GE_STAGEA(GE_SA(0, 1), cA, 1);
        if (wr == 1) SBAR();
        WAITV(2); SBAR();
        GE_STAGEB(GE_SB(1, 0), cB + kstep); GE_STAGEA(GE_SA(1, 0), cA + kstep, 0); GE_STAGEB(GE_SB(1, 1), cB + hstepB + kstep);
        WAITV(6); SBAR();
    } else {
    GE_STAGEB(GE_SB(0, 0), cB); GE_STAGEA(GE_SA(0, 0), cA, 0); GE_STAGEB(GE_SB(0, 1), cB + hstepB); GE_STAGEA(GE_SA(0, 1), cA, 1);
    if (wr == 1) SBAR();
    WAITV(4); SBAR();
    GE_STAGEB(GE_SB(1, 0), cB + kstep); GE_STAGEA(GE_SA(1, 0), cA + kstep, 0); GE_STAGEB(GE_SB(1, 1), cB + hstepB + kstep);
    WAITV(6); SBAR();
    }
    for (;;) {
        const bool has_next = S.next(ui + 1, nxt);
        const char* nA = has_next ? S.a_base(nxt) : cA; const char* nB = has_next ? S.b_base(nxt) : cB;
        for (int t = 0; t < nt; t += 2) {
            const bool last = (t == nt - 2);
            const char* a1 = cA + (size_t)(t + 1) * kstep;
            const char* a2 = last ? nA : cA + (size_t)(t + 2) * kstep; const char* b2 = last ? nB : cB + (size_t)(t + 2) * kstep;
            const char* a3 = a2 + kstep; const char* b3 = b2 + kstep;
            i32x8 At[4], B0[2], B1[2];
            if constexpr (SP2) {
            GE_LDB(B0, 0, 0); GE_LDB(B1, 0, 1); SCHED(); GE_LDA(At, 0, 0); GE_STAGEA(GE_SA(1, 1), a1, 1);
            WAITV(8); WAITL(0); SBAR(); GE_MMA(0, 0, At, B0); GE_MMA(0, 1, At, B1); SBAR(); SCHED();
            if constexpr (P::GATHER) { if (last && has_next) {
#pragma unroll
                for (int i = 0; i < 2; ++i) { int R2, C2; stage_rc(tid * 16 + i * 8192, R2, C2);
#pragma unroll
                    for (int h = 0; h < 2; ++h) oA[h][i] = (unsigned)S.gather_row(nxt, h * HALF + R2) * (unsigned)(S.lda * P::ES) + (unsigned)(C2 * 2); } } }
            GE_LDA(At, 0, 1); GE_STAGEB(GE_SB(0, 0), b2); GE_STAGEB(GE_SB(0, 1), b2 + hstepB); GE_STAGEA(GE_SA(0, 0), a2, 0);
            WAITV(8); WAITL(0); SBAR(); GE_MMA(1, 0, At, B0); GE_MMA(1, 1, At, B1); SBAR(); SCHED();
            GE_LDB(B0, 1, 0); GE_LDB(B1, 1, 1); SCHED(); GE_LDA(At, 1, 0); GE_STAGEA(GE_SA(0, 1), a2, 1);
            WAITV(8); WAITL(0); SBAR(); GE_MMA(0, 0, At, B0); GE_MMA(0, 1, At, B1); SBAR(); SCHED();
            GE_LDA(At, 1, 1); GE_STAGEB(GE_SB(1, 0), b3); GE_STAGEB(GE_SB(1, 1), b3 + hstepB); GE_STAGEA(GE_SA(1, 0), a3, 0);
            WAITV(8); WAITL(0); SBAR(); GE_MMA(1, 0, At, B0); GE_MMA(1, 1, At, B1); SBAR(); SCHED();
            } else {
            GE_LDB(B0, 0, 0); SCHED(); GE_LDA(At, 0, 0); GE_STAGEA(GE_SA(1, 1), a1, 1);
            WAITL(8); SBAR(); WAITL(0); GE_MMA(0, 0, At, B0); SBAR(); SCHED();
            if constexpr (P::GATHER) { if (last && has_next) {
#pragma unroll
                for (int i = 0; i < 2; ++i) { int R2, C2; stage_rc(tid * 16 + i * 8192, R2, C2);
#pragma unroll
                    for (int h = 0; h < 2; ++h) oA[h][i] = (unsigned)S.gather_row(nxt, h * HALF + R2) * (unsigned)(S.lda * P::ES) + (unsigned)(C2 * 2); } } }
            GE_LDB(B1, 0, 1); GE_STAGEB(GE_SB(0, 0), b2);
            SBAR(); WAITL(0); GE_MMA(0, 1, At, B1); SBAR();
            GE_LDA(At, 0, 1); GE_STAGEA(GE_SA(0, 0), a2, 0);
            SBAR(); WAITL(0); GE_MMA(1, 0, At, B0); SBAR(); SCHED();
            GE_STAGEB(GE_SB(0, 1), b2 + hstepB);
            WAITV(6); SBAR(); GE_MMA(1, 1, At, B1); SBAR();
            GE_LDB(B0, 1, 0); SCHED(); GE_LDA(At, 1, 0); GE_STAGEA(GE_SA(0, 1), a2, 1);
            WAITL(8); SBAR(); WAITL(0); GE_MMA(0, 0, At, B0); SBAR(); SCHED();
            GE_LDB(B1, 1, 1); GE_STAGEB(GE_SB(1, 0), b3);
            SBAR(); WAITL(0); GE_MMA(0, 1, At, B1); SBAR();
            GE_LDA(At, 1, 1); GE_STAGEA(GE_SA(1, 0), a3, 0);
            SBAR(); WAITL(0); GE_MMA(1, 0, At, B0); SBAR(); SCHED();
            GE_STAGEB(GE_SB(1, 1), b3 + hstepB);
            WAITV(6); SBAR(); GE_MMA(1, 1, At, B1); SBAR();
            }
        }
        if (wr == 0) SBAR();
        S.epi(acc, cur, wr, wc, fr, fq);
        if (!has_next) break;
#pragma unroll
        for (int a = 0; a < 2; ++a)
#pragma unroll
            for (int b = 0; b < 2; ++b)
#pragma unroll
                for (int m = 0; m < 4; ++m)
#pragma unroll
                    for (int n = 0; n < 2; ++n) acc[a][b][m][n] = (f32x4){0.f, 0.f, 0.f, 0.f};
        cur = nxt; cA = nA; cB = nB; ++ui;
        if (wr == 1) SBAR();
    }
    WAITV(0);
    SBAR();
#undef GE_SA
#undef GE_SB
#undef GE_STAGEA
#undef GE_STAGEB
#undef GE_LDA
#undef GE_LDB
#undef GE_MMA
#undef GE_LO
#undef GE_HI
#undef GE_LD1
}
}
using ge::Unit;

struct Params {
    const float* in[26];
    float* out; unsigned char* ws;
    int ph_lo, ph_hi;
};
enum { I_X = 0, I_C, I_CTX, I_CCTX, I_ADAW, I_ADAB, I_NMIX, I_NFFN, I_POOLW, I_POOLS, I_INW, I_CONVW, I_CONVB, I_ALOG, I_DTB, I_DSKIP, I_SNORM, I_OUTW,
       I_W1, I_W3, I_W2, I_RW, I_MW1, I_MW3, I_MW2, I_FNORM };

struct Frame {
    LAS unsigned char* lds;
    int tid, lane, wave, G, bx;
    const Params* p;
    unsigned char* ws;
    unsigned* ctl;
    float* H; float* mod;
};
#ifdef EMU
DEV const float* INP(const Frame& F, int i) { return F.p->in[i]; }
DEV float* OUTP(const Frame& F) { return F.p->out; }
DEV unsigned char* WSP(const Frame& F) { return F.p->ws; }
#define LAUNDER_S(x) ((void)0)
#else
typedef const float* cfptr_t;
DEV const float* INP(const Frame&, int i) { int k = i; asm volatile("" : "+s"(k)); return ((const __attribute__((address_space(4))) cfptr_t*)__builtin_amdgcn_kernarg_segment_ptr())[k]; }
DEV float* OUTP(const Frame& F) { return (float*)INP(F, 26); }
DEV unsigned char* WSP(const Frame& F) { return (unsigned char*)INP(F, 27); }
#define LAUNDER_S(x) asm volatile("" : "+s"(x))
#endif
constexpr int LDS_MISC = ge::STAGE_BYTES;
constexpr int LDS_BYTES = ge::STAGE_BYTES + 16384;

struct Src { const float* x; const float* ctx; float* H; const float* mod; };
DEV const float* modq(const float* mod, int layer, int vec, int which) { return mod + ((size_t)(layer * 3 + vec) * 6 + which) * D; }
DEV const float* modp(const Frame& F, int layer, int vec, int which) { return modq(F.mod, layer, vec, which); }
DEV const float* hsrc_row(const Src& s, bool from_input, int r) {
    if (from_input) return r < ML ? s.x + (size_t)r * D : s.ctx + (size_t)(r - ML) * D;
    return s.H + (size_t)r * D;
}
DEV Src mksrc(const Frame& F) { Src s; s.x = INP(F, I_X); s.ctx = INP(F, I_CTX); s.H = F.H; s.mod = F.mod; return s; }
DEV const float* hin_row(const Frame& F, int layer, int r) { return hsrc_row(mksrc(F), layer == 0, r); }

template <int K, int N, class RM>
DEV void transpose_item(const float* Wsrc, bf16_t* WT, int ldt, RM rowmap, LAS float* scr, int item, int lane) {
    constexpr int nblk = N / 32; const int kb = item / nblk, nb = item % nblk, k0 = 64 * kb, n0 = 32 * nb;
    float tmp[32];
#pragma unroll
    for (int i = 0; i < 32; ++i) { const int kk = 2 * i + (lane >> 5); tmp[i] = Wsrc[(size_t)(k0 + kk) * N + n0 + (lane & 31)]; }
#pragma unroll
    for (int i = 0; i < 32; ++i) { const int kk = 2 * i + (lane >> 5); scr[kk * 33 + (lane & 31)] = tmp[i]; }
    WSYNC();
    const int c = lane & 7; const int row0 = rowmap(n0);
#pragma unroll
    for (int j = 0; j < 4; ++j) { const int n = (lane >> 3) + 8 * j; const LAS float* s = scr + (8 * c) * 33 + n;
        u32x4 o; o.x = pk2(s[0 * 33], s[1 * 33]); o.y = pk2(s[2 * 33], s[3 * 33]); o.z = pk2(s[4 * 33], s[5 * 33]); o.w = pk2(s[6 * 33], s[7 * 33]);
        *(u32x4*)(WT + (size_t)(row0 + n) * ldt + k0 + 8 * c) = o; }
    WSYNC();
}
template <int K, int N, class RM>
DEV void transpose_item_fp8(const float* Wsrc, fp8_t* WT, int ldt, RM rowmap, float scale, LAS float* scr, int item, int lane) {
    constexpr int nblk = N / 32; const int kb = item / nblk, nb = item % nblk, k0 = 64 * kb, n0 = 32 * nb;
    float tmp[32];
#pragma unroll
    for (int i = 0; i < 32; ++i) { const int kk = 2 * i + (lane >> 5); tmp[i] = Wsrc[(size_t)(k0 + kk) * N + n0 + (lane & 31)]; }
#pragma unroll
    for (int i = 0; i < 32; ++i) { const int kk = 2 * i + (lane >> 5); scr[kk * 33 + (lane & 31)] = tmp[i] * scale; }
    WSYNC();
    const int c = lane & 7; const int row0 = rowmap(n0);
#pragma unroll
    for (int j = 0; j < 4; ++j) { const int n = (lane >> 3) + 8 * j; const LAS float* s = scr + (8 * c) * 33 + n;
        u32x2 o; o.x = pk4_fp8(s[0 * 33], s[1 * 33], s[2 * 33], s[3 * 33]); o.y = pk4_fp8(s[4 * 33], s[5 * 33], s[6 * 33], s[7 * 33]);
        *(u32x2*)(WT + (size_t)(row0 + n) * ldt + k0 + 8 * c) = o; }
    WSYNC();
}
template <int K, int N, class RM>
DEV void convert_job_fp8(const Frame& F, const float* Wsrc, fp8_t* WT, int ldt, RM rm, float scale) {
    LAS float* scr = (LAS float*)(F.lds + F.wave * 16384);
    constexpr int items = (K / 64) * (N / 32); const int gw = F.bx * 8 + F.wave, NGW = F.G * 8;
    for (int it = gw; it < items; it += NGW) transpose_item_fp8<K, N>(Wsrc, WT, ldt, rm, scale, scr, it, F.lane);
}
struct RmId { DEV int operator()(int n0) const { return n0; } };
struct RmIlv { int s; DEV int operator()(int n0) const { return (n0 >> 7) * 256 + s * 128 + (n0 & 127); } };
template <int K, int N, class RM>
DEV void convert_job(const Frame& F, const float* Wsrc, bf16_t* WT, int ldt, RM rm) {
    LAS float* scr = (LAS float*)(F.lds + F.wave * 16384);
    constexpr int items = (K / 64) * (N / 32); const int gw = F.bx * 8 + F.wave, NGW = F.G * 8;
    for (int it = gw; it < items; it += NGW) transpose_item<K, N>(Wsrc, WT, ldt, rm, scr, it, F.lane);
}
DEV void convert_even(const Frame& F, int j) {
    bf16_t* Wb = (bf16_t*)(F.ws + OFF_W);
    for (int g = 0; g < 4; ++g) convert_job<256, 256>(F, INP(F, I_POOLW) + ((size_t)j * 4 + g) * 65536, Wb + W_POOL / 2 + (size_t)g * 65536, 256, RmId{});
    convert_job<D, DFF>(F, INP(F, I_W1) + (size_t)j * D * DFF, Wb + W_UP / 2, D, RmIlv{0});
    convert_job<D, DFF>(F, INP(F, I_W3) + (size_t)j * D * DFF, Wb + W_UP / 2, D, RmIlv{1});
    convert_job<DFF, D>(F, INP(F, I_W2) + (size_t)j * DFF * D, Wb + W_DN / 2, DFF, RmId{});
}
DEV void convert_ssd(const Frame& F, int j) {
    bf16_t* Wb = (bf16_t*)(F.ws + OFF_W);
    convert_job<D, NPROJ>(F, INP(F, I_INW) + (size_t)j * D * NPROJ, Wb + W_IN / 2, D, RmId{});
    convert_job<DIN, D>(F, INP(F, I_OUTW) + (size_t)j * DIN * D, Wb + W_OUT / 2, DIN, RmId{});
    { u32x4* z = (u32x4*)(Wb + W_IN / 2 + (size_t)NPROJ * D); const int n16 = (NPROJP - NPROJ) * D * 2 / 16;
      unsigned zz = 0u; LAUNDER_V(zz);
      for (int i = F.bx * 512 + F.tid; i < n16; i += F.G * 512) z[i] = (u32x4){zz, zz, zz, zz}; }
}
DEV void convert_moe(const Frame& F, int j) {
    fp8_t* Wb = (fp8_t*)(F.ws + OFF_W);
    for (int e = 0; e < NEXP; ++e) {
        convert_job_fp8<D, DFFE>(F, INP(F, I_MW1) + ((size_t)j * NEXP + e) * D * DFFE, Wb + W_MUP + (size_t)e * 2 * DFFE * D, D, RmIlv{0}, 32.0f);
        convert_job_fp8<D, DFFE>(F, INP(F, I_MW3) + ((size_t)j * NEXP + e) * D * DFFE, Wb + W_MUP + (size_t)e * 2 * DFFE * D, D, RmIlv{1}, 32.0f);
        if (MOE_DOWN_FP8) convert_job_fp8<DFFE, D>(F, INP(F, I_MW2) + ((size_t)j * NEXP + e) * DFFE * D, Wb + W_MDN + (size_t)e * D * DFFE, DFFE, RmId{}, 64.0f);
        else convert_job<DFFE, D>(F, INP(F, I_MW2) + ((size_t)j * NEXP + e) * DFFE * D, (bf16_t*)(Wb + W_MDN) + (size_t)e * D * DFFE, DFFE, RmId{});
    }
}

DEV void phase_mod(const Frame& F) {
    LAS float* red = (LAS float*)F.lds;
    const int nblk = DEPTH * 6144 / 64;
    const int col = F.tid & 63, ks = F.tid >> 6;
    for (int blk = F.bx; blk < nblk; blk += F.G) {
        const int layer = (blk * 64) / 6144, n = (blk * 64) % 6144 + col;
        const float* W = INP(F, I_ADAW) + (size_t)layer * D * 6144 + n;
        float a0 = 0.f, a1 = 0.f, a2 = 0.f;
#pragma unroll 8
        for (int k = ks * 128; k < ks * 128 + 128; ++k) { const float w = W[(size_t)k * 6144];
            a0 += siluf(INP(F, I_C)[k]) * w; a1 += siluf(INP(F, I_C)[D + k]) * w; a2 += siluf(INP(F, I_CCTX)[k]) * w; }
        red[(ks * 64 + col) * 3 + 0] = a0; red[(ks * 64 + col) * 3 + 1] = a1; red[(ks * 64 + col) * 3 + 2] = a2;
        __syncthreads();
        if (F.tid < 192) { const int c2 = F.tid % 64, v = F.tid / 64; float s = 0.f;
            for (int q = 0; q < 8; ++q) s += red[(q * 64 + c2) * 3 + v];
            const int n2 = (blk * 64) % 6144 + c2;
            F.mod[(size_t)(layer * 3 + v) * 6144 + n2] = s + INP(F, I_ADAB)[(size_t)layer * 6144 + n2]; }
        __syncthreads();
    }
}

DEV void load_row(const float* p, int lane, f32x4 (&v)[4]) {
#pragma unroll
    for (int j = 0; j < 4; ++j) v[j] = *(const f32x4*)(p + 4 * lane + 256 * j);
}
DEV float sumsq_row(const f32x4 (&v)[4]) { float s = 0.f;
#pragma unroll
    for (int j = 0; j < 4; ++j) s += (v[j][0] * v[j][0] + v[j][1] * v[j][1]) + (v[j][2] * v[j][2] + v[j][3] * v[j][3]);
    return wave_sum(s); }
DEV void normmod_row(f32x4 (&v)[4], float rstd, const float* w, const float* sh, const float* sc, int lane) {
#pragma unroll
    for (int j = 0; j < 4; ++j) { const int c = 4 * lane + 256 * j; const f32x4 wv = *(const f32x4*)(w + c), sv = *(const f32x4*)(sh + c), cv = *(const f32x4*)(sc + c);
        v[j] = v[j] * rstd * wv * (cv + 1.0f) + sv; }
}
DEV void store_row_bf16(bf16_t* o, int lane, const f32x4 (&v)[4]) {
#pragma unroll
    for (int j = 0; j < 4; ++j) { u32x2 w; w.x = pk2(v[j][0], v[j][1]); w.y = pk2(v[j][2], v[j][3]); *(u32x2*)(o + 4 * lane + 256 * j) = w; }
}

DEV void phase_norm(const Frame& F, int layer, int which, bf16_t* out, bool from_input) {
    const int gw = F.bx * 8 + F.wave, NGW = F.G * 8;
    const float* w = INP(F, which == 0 ? I_NMIX : I_NFFN) + (size_t)layer * D;
    f32x4 nx[4];
    if (gw < MT) load_row(hsrc_row(mksrc(F), from_input, gw), F.lane, nx);
    for (int r = gw; r < MT; r += NGW) {
        f32x4 v[4];
#pragma unroll
        for (int q = 0; q < 4; ++q) v[q] = nx[q];
        if (r + NGW < MT) load_row(hsrc_row(mksrc(F), from_input, r + NGW), F.lane, nx);
        const float rstd = rsqrtf(sumsq_row(v) * (1.0f / D) + EPS);
        const int vec = vec_of(r);
        normmod_row(v, rstd, w, modp(F, layer, vec, which), modp(F, layer, vec, which + 1), F.lane);
        store_row_bf16(out + (size_t)r * D, F.lane, v);
    }
}

DEV void phase_poolprep(const Frame& F, int layer, bf16_t* P) {
    LAS bf16_t* ub = (LAS bf16_t*)(F.lds);
    LAS float* rs = (LAS float*)(F.lds + 81920);
    const float* w = INP(F, I_NMIX) + (size_t)layer * D;
    const int ntile = MT / 64;
    const int chunk = F.tid & 127, tg = F.tid >> 7;
    for (int tile = F.bx; tile < ntile; tile += F.G) {
        const int r0 = tile * 64;
        int seq0, seq1;
        if (r0 < ML) { seq0 = r0; seq1 = r0 + 64; } else { seq0 = ML + ((r0 - ML) / CTXL) * CTXL; seq1 = seq0 + CTXL; }
        const int lo_r = (r0 - 8 > seq0) ? r0 - 8 : seq0, hi_r = (r0 + 64 + 7 < seq1) ? r0 + 64 + 7 : seq1;
        const int nrow = hi_r - lo_r;
        for (int rb = lo_r + F.wave; rb < hi_r; rb += 40) {
            f32x4 v5[5][4];
#pragma unroll
            for (int k = 0; k < 5; ++k) { const int r = rb + 8 * k; if (r < hi_r) load_row(hin_row(F, layer, r), F.lane, v5[k]); }
#pragma unroll
            for (int k = 0; k < 5; ++k) { const int r = rb + 8 * k; if (r < hi_r) { const float ss = sumsq_row(v5[k]); if (F.lane == 0) rs[r - lo_r] = rsqrtf(ss * (1.0f / D) + EPS); } } }
        __syncthreads();
        const int vec = vec_of(r0);
#pragma unroll 1
        for (int half = 0; half < 2; ++half) {
            const int c = half * 512 + 4 * chunk, g = c >> 8, win = 2 << g, lo = win >> 1, hi = win - 1 - lo;
            const f32x4 wv = *(const f32x4*)(w + c), sv = *(const f32x4*)(modp(F, layer, vec, 0) + c), cv = *(const f32x4*)(modp(F, layer, vec, 1) + c) + 1.0f;
            const f32x4 wc = wv * cv;
#pragma unroll 1
            for (int kb = 0; kb < 20; kb += 10) {
                f32x4 hv[10];
#pragma unroll
                for (int k = 0; k < 10; ++k) { const int rr = tg + 4 * (kb + k); if (rr < nrow) hv[k] = *(const f32x4*)(hin_row(F, layer, lo_r + rr) + c); }
#pragma unroll
                for (int k = 0; k < 10; ++k) { const int rr = tg + 4 * (kb + k); if (rr < nrow) { const f32x4 u = hv[k] * rs[rr] * wc + sv;
                    u32x2 pw; pw.x = pk2(u[0], u[1]); pw.y = pk2(u[2], u[3]); *(LAS u32x2*)(ub + rr * 512 + 4 * chunk) = pw; } } }
            __syncthreads();
#define PP_U(r_) ({ const u32x2 _q = *(const LAS u32x2*)(ub + ((r_) - lo_r) * 512 + 4 * chunk); (f32x4){bflo(_q.x), bfhi(_q.x), bflo(_q.y), bfhi(_q.y)}; })
            const int ta = r0 + 16 * tg;
            f32x4 s = (f32x4){0.f, 0.f, 0.f, 0.f};
            { const int a = (ta - lo > seq0) ? ta - lo : seq0, b = (ta + hi + 1 < seq1) ? ta + hi + 1 : seq1; for (int r = a; r < b; ++r) s += PP_U(r); }
            for (int t = ta; t < ta + 16; ++t) {
                const int a = (t - lo > seq0) ? t - lo : seq0, b = (t + hi + 1 < seq1) ? t + hi + 1 : seq1;
                const float inv = 1.0f / (float)(b - a);
                const f32x4 o = s * inv - PP_U(t);
                u32x2 pw; pw.x = pk2(o[0], o[1]); pw.y = pk2(o[2], o[3]); *(u32x2*)(P + (size_t)t * D + c) = pw;
                if (t + 1 < ta + 16) {
                    if (t + 1 + hi < seq1) s += PP_U(t + 1 + hi);
                    if (t - lo >= seq0) s -= PP_U(t - lo); }
            }
#undef PP_U
            __syncthreads();
        }
    }
}

struct PolBase { int G, c; };
struct PolPool : PolBase {
    static constexpr bool PERM = false, GATHER = false; static constexpr bool FP8 = false; static constexpr int ES = 2; int K, lda, ldb;
    const bf16_t* P; const bf16_t* W; Src src; int layer; const float* scale;
    DEV bool next(int i, Unit& u) const { return ge::static_next(NPAN, 4, G, c, i, u); }
    DEV const char* a_base(const Unit& u) const { return (const char*)(P + (size_t)u.pm * 256 * D + u.pn * 256); }
    DEV const char* b_base(const Unit& u) const { return (const char*)(W + (size_t)u.pn * 65536); }
    DEV void epi(const f32x4 (&acc)[2][2][4][2], const Unit& u, int wr, int wc, int fr, int fq) const {
        const int row0 = u.pm * 256 + wr * 64 + fr, col0 = u.pn * 256 + wc * 32 + 4 * fq; const int vec = vec_of(u.pm * 256);
        const float* g1 = modq(src.mod, layer, vec, 2);
        f32x4 gv[2][2];
#pragma unroll
        for (int bj = 0; bj < 2; ++bj)
#pragma unroll
            for (int n = 0; n < 2; ++n) { const int cc = col0 + bj * 128 + n * 16; gv[bj][n] = *(const f32x4*)(g1 + cc) * *(const f32x4*)(scale + cc); }
#pragma unroll
        for (int ai = 0; ai < 2; ++ai)
#pragma unroll
            for (int m = 0; m < 4; ++m) { const int r = row0 + ai * 128 + m * 16; const float* hi = hsrc_row(src, layer == 0, r) + col0; float* ho = src.H + (size_t)r * D + col0;
#pragma unroll
                for (int bj = 0; bj < 2; ++bj)
#pragma unroll
                    for (int n = 0; n < 2; ++n) *(f32x4*)(ho + bj * 128 + n * 16) = *(const f32x4*)(hi + bj * 128 + n * 16) + gv[bj][n] * acc[ai][bj][m][n]; }
    }
};
struct PolResid : PolBase {
    static constexpr bool PERM = false, GATHER = false; static constexpr bool FP8 = false; static constexpr int ES = 2; int K, lda, ldb;
    const bf16_t* A; const bf16_t* W; Src src; int layer, which, npan;
    DEV bool next(int i, Unit& u) const { return ge::static_next(npan, 4, G, c, i, u); }
    DEV const char* a_base(const Unit& u) const { return (const char*)(A + (size_t)u.pm * 256 * lda); }
    DEV const char* b_base(const Unit& u) const { return (const char*)(W + (size_t)u.pn * 256 * ldb); }
    DEV void epi(const f32x4 (&acc)[2][2][4][2], const Unit& u, int wr, int wc, int fr, int fq) const {
        const int row0 = u.pm * 256 + wr * 64 + fr, col0 = u.pn * 256 + wc * 32 + 4 * fq; const int vec = vec_of(u.pm * 256);
        const float* gp = modq(src.mod, layer, vec, which);
        f32x4 gv[2][2];
#pragma unroll
        for (int bj = 0; bj < 2; ++bj)
#pragma unroll
            for (int n = 0; n < 2; ++n) gv[bj][n] = *(const f32x4*)(gp + col0 + bj * 128 + n * 16);
#pragma unroll
        for (int ai = 0; ai < 2; ++ai)
#pragma unroll
            for (int mp = 0; mp < 4; mp += 2) { f32x4 hv[2][2][2];
#pragma unroll
                for (int m2 = 0; m2 < 2; ++m2) { const float* hi = src.H + (size_t)(row0 + ai * 128 + (mp + m2) * 16) * D + col0;
#pragma unroll
                    for (int bj = 0; bj < 2; ++bj)
#pragma unroll
                        for (int n = 0; n < 2; ++n) hv[m2][bj][n] = *(const f32x4*)(hi + bj * 128 + n * 16); }
#pragma unroll
                for (int m2 = 0; m2 < 2; ++m2) { float* ho = src.H + (size_t)(row0 + ai * 128 + (mp + m2) * 16) * D + col0;
#pragma unroll
                    for (int bj = 0; bj < 2; ++bj)
#pragma unroll
                        for (int n = 0; n < 2; ++n) *(f32x4*)(ho + bj * 128 + n * 16) = hv[m2][bj][n] + gv[bj][n] * acc[ai][bj][mp + m2][n]; } }
    }
};
template <bool MOE>
struct PolUp : PolBase {
    static constexpr bool PERM = true, GATHER = MOE, FP8 = MOE; static constexpr int ES = MOE ? 1 : 2; int K, lda, ldb;
    const bf16_t* A; const bf16_t* W; bf16_t* HID; int ldh, nq;
    int nM; const int* s2t; int tstart[NEXP + 1];
    DEV bool next(int i, Unit& u) const { return ge::static_next(MOE ? nM : NPAN, nq, G, c, i, u); }
    DEV int expert_of(int pm) const { int e = 0;
#pragma unroll
        for (int k = 1; k < NEXP; ++k) e += (pm >= tstart[k]) ? 1 : 0;
        return e; }
    DEV const char* a_base(const Unit& u) const { return MOE ? (const char*)A : (const char*)(A + (size_t)u.pm * 256 * lda); }
    DEV const char* b_base(const Unit& u) const { size_t off = (size_t)u.pn * 256 * ldb; if (MOE) off += (size_t)expert_of(u.pm) * 2 * DFFE * ldb; return (const char*)W + off * ES; }
    DEV int gather_row(const Unit& u, int R) const { return s2t[u.pm * 256 + R]; }
    DEV void epi(const f32x4 (&acc)[2][2][4][2], const Unit& u, int wr, int wc, int fr, int fq) const {
        const int row0 = u.pm * 256 + wr * 64 + fr, col0 = u.pn * 128 + wc * 32 + 8 * fq;
#pragma unroll
        for (int ai = 0; ai < 2; ++ai)
#pragma unroll
            for (int m = 0; m < 4; ++m) { bf16_t* o = HID + (size_t)(row0 + ai * 128 + m * 16) * ldh + col0;
                float h[8];
#pragma unroll
                for (int n = 0; n < 2; ++n)
#pragma unroll
                    for (int i = 0; i < 4; ++i) { if (MOE) h[4 * n + i] = siluf(acc[ai][0][m][n][i] * 0.00390625f) * (acc[ai][1][m][n][i] * (MOE_DOWN_FP8 ? 0.015625f : 0.00390625f));
                                                  else h[4 * n + i] = siluf(acc[ai][0][m][n][i]) * acc[ai][1][m][n][i]; }
                if (MOE && MOE_DOWN_FP8) { u32x2 w8; w8.x = pk4_fp8(h[0], h[1], h[2], h[3]); w8.y = pk4_fp8(h[4], h[5], h[6], h[7]);
                    *(u32x2*)((fp8_t*)HID + (size_t)(row0 + ai * 128 + m * 16) * ldh + col0) = w8; }
                else { u32x4 w; w.x = pk2(h[0], h[1]); w.y = pk2(h[2], h[3]); w.z = pk2(h[4], h[5]); w.w = pk2(h[6], h[7]); *(u32x4*)o = w; } }
    }
};
struct PolMoeDown : PolBase {
    static constexpr bool PERM = true, GATHER = (MOE_DOWN_FP8 != 0), FP8 = (MOE_DOWN_FP8 != 0); static constexpr int ES = MOE_DOWN_FP8 ? 1 : 2; int K, lda, ldb;
    const bf16_t* A; const bf16_t* W; bf16_t* YS; int nM; int tstart[NEXP + 1];
    DEV bool next(int i, Unit& u) const { return ge::static_next(nM, 4, G, c, i, u); }
    DEV int expert_of(int pm) const { int e = 0;
#pragma unroll
        for (int k = 1; k < NEXP; ++k) e += (pm >= tstart[k]) ? 1 : 0;
        return e; }
    DEV const char* a_base(const Unit& u) const { return GATHER ? (const char*)A : (const char*)A + (size_t)u.pm * 256 * lda * ES; }
    DEV int gather_row(const Unit& u, int R) const { return u.pm * 256 + R; }
    DEV const char* b_base(const Unit& u) const { return (const char*)W + ((size_t)expert_of(u.pm) * D + (size_t)u.pn * 256) * ldb * ES; }
    DEV void epi(const f32x4 (&acc)[2][2][4][2], const Unit& u, int wr, int wc, int fr, int fq) const {
        const int row0 = u.pm * 256 + wr * 64 + fr, col0 = u.pn * 256 + wc * 32 + 8 * fq;
#pragma unroll
        for (int ai = 0; ai < 2; ++ai)
#pragma unroll
            for (int m = 0; m < 4; ++m) { bf16_t* o = YS + (size_t)(row0 + ai * 128 + m * 16) * D + col0;
#pragma unroll
                for (int bj = 0; bj < 2; ++bj) { u32x4 w; w.x = pk2(acc[ai][bj][m][0][0], acc[ai][bj][m][0][1]); w.y = pk2(acc[ai][bj][m][0][2], acc[ai][bj][m][0][3]);
                    w.z = pk2(acc[ai][bj][m][1][0], acc[ai][bj][m][1][1]); w.w = pk2(acc[ai][bj][m][1][2], acc[ai][bj][m][1][3]); *(u32x4*)(o + bj * 128) = w; } }
    }
};
struct PolInProj : PolBase {
    static constexpr bool PERM = true, GATHER = false; static constexpr bool FP8 = false; static constexpr int ES = 2; int K, lda, ldb;
    const bf16_t* A; const bf16_t* W; bf16_t* Z; bf16_t* XBC; float* DT;
    DEV bool next(int i, Unit& u) const { return ge::static_next(NPAN, NPROJP / 256, G, c, i, u); }
    DEV const char* a_base(const Unit& u) const { return (const char*)(A + (size_t)u.pm * 256 * lda); }
    DEV const char* b_base(const Unit& u) const { return (const char*)(W + (size_t)u.pn * 256 * ldb); }
    DEV void epi(const f32x4 (&acc)[2][2][4][2], const Unit& u, int wr, int wc, int fr, int fq) const {
        const int row0 = u.pm * 256 + wr * 64 + fr, cw = wc * 32 + 8 * fq;
        if (u.pn < 20) {
            bf16_t* base; int ld, col0;
            if (u.pn < 8) { base = Z; ld = DIN; col0 = u.pn * 256 + cw; } else { base = XBC; ld = CONVD; col0 = (u.pn - 8) * 256 + cw; }
#pragma unroll
            for (int ai = 0; ai < 2; ++ai)
#pragma unroll
                for (int m = 0; m < 4; ++m) { bf16_t* o = base + (size_t)(row0 + ai * 128 + m * 16) * ld + col0;
#pragma unroll
                    for (int bj = 0; bj < 2; ++bj) { u32x4 w; w.x = pk2(acc[ai][bj][m][0][0], acc[ai][bj][m][0][1]); w.y = pk2(acc[ai][bj][m][0][2], acc[ai][bj][m][0][3]);
                        w.z = pk2(acc[ai][bj][m][1][0], acc[ai][bj][m][1][1]); w.w = pk2(acc[ai][bj][m][1][2], acc[ai][bj][m][1][3]); *(u32x4*)(o + bj * 128) = w; } }
        } else if (cw < 64) {
#pragma unroll
            for (int ai = 0; ai < 2; ++ai)
#pragma unroll
                for (int m = 0; m < 4; ++m) { const int r = row0 + ai * 128 + m * 16; int b, tv;
                    if (r < ML) { b = r / SEQ; tv = CTXL + r % SEQ; } else { b = (r - ML) / CTXL; tv = (r - ML) % CTXL; }
#pragma unroll
                    for (int n = 0; n < 2; ++n)
#pragma unroll
                        for (int i = 0; i < 4; ++i) { const int j = cw + 4 * n + i, dir = j >> 5, h = j & 31;
                            DT[((size_t)(b * 2 + dir) * NH + h) * TV + tv] = acc[ai][0][m][n][i]; } }
        }
    }
};

DEV void phase_conv(const Frame& F, int j, const bf16_t* XBC, bf16_t* XT, bf16_t* Brow, bf16_t* BT, bf16_t* Crow) {
    LAS bf16_t* tl0 = (LAS bf16_t*)F.lds;
    const float* cw = INP(F, I_CONVW) + (size_t)j * 4 * CONVD; const float* cb = INP(F, I_CONVB) + (size_t)j * CONVD;
    constexpr int NPER = NB * NCH, nitem = NPER * (CONVD / 64);
    const int t2 = 2 * (F.tid >> 3), cg = F.tid & 7;
    const int i0 = (int)(((long)F.bx * nitem) / F.G), i1 = (int)(((long)(F.bx + 1) * nitem) / F.G);
    int cblk_cur = -1; f32x4 wv[4][2], bv[2]; int par = 0;
#define CV_LOAD(it_, q_) do { const int _cb = (it_) / NPER, _rs = (it_) % NPER, _b = _rs / NCH, _cv = _rs % NCH; const int _ch = _cb * 64 + cg * 8, _tv = _cv * 128 + t2; \
        const int _s0 = _tv < CTXL ? 0 : CTXL, _s1 = _tv < CTXL ? CTXL : TV; \
        _Pragma("unroll") for (int k = 0; k < 5; ++k) { const int tk = _tv - 2 + k; q_[k] = (u32x4){0u, 0u, 0u, 0u}; \
            if (tk >= _s0 && tk < _s1) q_[k] = *(const u32x4*)(XBC + (size_t)row_of(_b, tk) * CONVD + _ch); } } while (0)
    u32x4 qn[5];
    if (i0 < i1) CV_LOAD(i0, qn);
    for (int it = i0; it < i1; ++it) {
        const int cblk = it / NPER, rest = it % NPER, b = rest / NCH, cv = rest % NCH;
        const int ch0 = cblk * 64 + cg * 8;
        if (cblk != cblk_cur) { cblk_cur = cblk;
#pragma unroll
            for (int k = 0; k < 4; ++k) { wv[k][0] = *(const f32x4*)(cw + k * CONVD + ch0); wv[k][1] = *(const f32x4*)(cw + k * CONVD + ch0 + 4); }
            bv[0] = *(const f32x4*)(cb + ch0); bv[1] = *(const f32x4*)(cb + ch0 + 4); }
        const int tv = cv * 128 + t2;
        float xin[5][8];
#pragma unroll
        for (int k = 0; k < 5; ++k) { const u32x4 q = qn[k];
            xin[k][0] = bflo(q.x); xin[k][1] = bfhi(q.x); xin[k][2] = bflo(q.y); xin[k][3] = bfhi(q.y); xin[k][4] = bflo(q.z); xin[k][5] = bfhi(q.z); xin[k][6] = bflo(q.w); xin[k][7] = bfhi(q.w); }
        if (it + 1 < i1) CV_LOAD(it + 1, qn);
        unsigned pk[2][4];
#pragma unroll
        for (int o = 0; o < 2; ++o) { float a[8];
#pragma unroll
            for (int i = 0; i < 8; ++i) { float acc = bv[i >> 2][i & 3];
#pragma unroll
                for (int k = 0; k < 4; ++k) acc += wv[k][i >> 2][i & 3] * xin[o + k][i];
                a[i] = siluf(acc); }
#pragma unroll
            for (int i = 0; i < 4; ++i) pk[o][i] = pk2(a[2 * i], a[2 * i + 1]); }
        const int r = row_of(b, tv);
        const bool isx = cblk < DIN / 64, isb = !isx && cblk < (DIN + BCD) / 64;
        if (!isx) { bf16_t* o = (isb ? Brow + (ch0 - DIN) : Crow + (ch0 - DIN - BCD)) + (size_t)r * BCD;
            *(u32x4*)o = (u32x4){pk[0][0], pk[0][1], pk[0][2], pk[0][3]}; *(u32x4*)(o + BCD) = (u32x4){pk[1][0], pk[1][1], pk[1][2], pk[1][3]}; }
        if (isx || isb) {
            LAS bf16_t* tl = tl0 + par * (64 * 136); par ^= 1;
#pragma unroll
            for (int i = 0; i < 4; ++i) { const unsigned lo = (pk[0][i] & 0xffffu) | (pk[1][i] << 16), hi = (pk[0][i] >> 16) | (pk[1][i] & 0xffff0000u);
                *(LAS unsigned*)(tl + (cg * 8 + 2 * i) * 136 + t2) = lo; *(LAS unsigned*)(tl + (cg * 8 + 2 * i + 1) * 136 + t2) = hi; }
            __syncthreads();
            bf16_t* dst = isx ? XT + ((size_t)b * DIN + cblk * 64) * TV : BT + ((size_t)b * BCD + (cblk * 64 - DIN)) * TV;
#pragma unroll
            for (int q = 0; q < 2; ++q) { const int idx = F.tid + q * 512, ch = idx >> 4, t8 = (idx & 15) * 8;
                *(u32x4*)(dst + (size_t)ch * TV + cv * 128 + t8) = *(const LAS u32x4*)(tl + ch * 136 + t8); }
        }
    }
}

#undef CV_LOAD
DEV void phase_cb(const Frame& F, const bf16_t* Brow, const bf16_t* Crow, bf16_t* CB) {
    const int nitem = NB * NG * NCH; const int fr = F.lane & 15, fq = F.lane >> 4;
    for (int it = F.bx; it < nitem; it += F.G) {
        const int cv = it % NCH, g = (it / NCH) % NG, b = it / (NCH * NG);
        const int rbase = row_of(b, cv * 128);
        bf16x8 cf[4];
#pragma unroll
        for (int ks = 0; ks < 4; ++ks) cf[ks] = *(const bf16x8*)(Crow + (size_t)(rbase + 16 * F.wave + fr) * BCD + g * 128 + 32 * ks + 8 * fq);
        bf16_t* out = CB + ((size_t)((b * NG + g) * NCH + cv)) * 16384;
#pragma unroll
        for (int nt = 0; nt < 8; ++nt) {
            f32x4 acc = (f32x4){0.f, 0.f, 0.f, 0.f};
#pragma unroll
            for (int ks = 0; ks < 4; ++ks) { const bf16x8 bfr = *(const bf16x8*)(Brow + (size_t)(rbase + 16 * nt + fr) * BCD + g * 128 + 32 * ks + 8 * fq); acc = MFMA16(bfr, cf[ks], acc); }
            u32x2 w; w.x = pk2(acc[0], acc[1]); w.y = pk2(acc[2], acc[3]);
            *(u32x2*)(out + (size_t)(16 * F.wave + fr) * 128 + 16 * nt + 4 * fq) = w;
        }
    }
}

DEV void phase_tables(const Frame& F, int j, float* DT, float* CUM, float* WJ) {
    const int nitem = NB * 2 * NH * NCH; const int gw = F.bx * 8 + F.wave, NGW = F.G * 8;
    for (int it = gw; it < nitem; it += NGW) {
        const int cv = it % NCH, h = (it / NCH) % NH, dir = (it / (NCH * NH)) & 1, b = it / (NCH * NH * 2);
        const float A = -expf(INP(F, I_ALOG)[(size_t)(j * 2 + dir) * NH + h]); const float bias = INP(F, I_DTB)[(size_t)(j * 2 + dir) * NH + h];
        const size_t o = ((size_t)(b * 2 + dir) * NH + h) * TV + cv * 128 + 2 * F.lane;
        const f32x2 raw = *(const f32x2*)(DT + o); const float d0 = softplusf(raw.x + bias), d1 = softplusf(raw.y + bias); const float a0 = d0 * A, a1 = d1 * A;
        float c0, c1, tot, sum = a0 + a1;
        if (dir == 0) {
#pragma unroll
            for (int q = 1; q < 64; q <<= 1) { const float t2 = __shfl_up(sum, q); if (F.lane >= q) sum += t2; }
            c1 = sum; c0 = sum - a1; tot = __shfl(sum, 63);
        } else {
#pragma unroll
            for (int q = 1; q < 64; q <<= 1) { const float t2 = __shfl_down(sum, q); if (F.lane + q < 64) sum += t2; }
            c0 = sum; c1 = sum - a0; tot = __shfl(sum, 0);
        }
        constexpr float L2E = 1.4426950408889634f;
        *(f32x2*)(DT + o) = (f32x2){c0 * L2E - flog2(d0), c1 * L2E - flog2(d1)};
        *(f32x2*)(CUM + o) = (f32x2){c0 * L2E, c1 * L2E};
        *(f32x2*)(WJ + o) = (f32x2){d0 * FEXP(tot - c0), d1 * FEXP(tot - c1)};
    }
}

constexpr int SC_HL = 0, SC_TAB = 17408, SC_CB = 20480, SC_BT = SC_CB + 32768, SC_C = SC_BT + 32768, SC_X = SC_C + 32768, SC_END = SC_X + 8192;
static_assert(SC_END <= ge::STAGE_BYTES, "scan LDS map");
DEV void phase_scan(const Frame& F, int j, const bf16_t* XT, const bf16_t* BT, const bf16_t* Crow, const bf16_t* CB, const float* DT, const float* CUM, const float* WJ, bf16_t* Yf, bf16_t* Yb) {
    LAS unsigned char* L = F.lds;
    LAS bf16_t* Hl = (LAS bf16_t*)(L + SC_HL);
    LAS float* tab = (LAS float*)(L + SC_TAB);
    const int fr = F.lane & 15, fq = F.lane >> 4, w = F.wave;
    const int nitem = NB * NH * 2 * 2;
    for (int it = F.bx; it < nitem; it += F.G) {
        const int xq = it & 7, kq = it >> 3; const int b = xq >> 2, g = xq & 3, h = 8 * g + (kq >> 2), dir = (kq >> 1) & 1, ph = kq & 1;
        const float Dsk = dir == 0 ? INP(F, I_DSKIP)[(size_t)j * NH + h] : 0.f;
        const size_t tbase = ((size_t)(b * 2 + dir) * NH + h) * TV;
        const bf16_t* xt = XT + ((size_t)b * DIN + h * HD + ph * 32) * TV;
        const bf16_t* bt = BT + ((size_t)b * BCD + g * 128) * TV;
        const bf16_t* CBh = CB + (size_t)((b * NG + g) * NCH) * 16384;
        const bf16_t* Cg = Crow + g * 128;
        bf16_t* Y = (dir ? Yb : Yf) + h * HD + ph * 32;
        const int lrow = 16 * w + fr;
        const int dr = F.lane >> 4, dc = F.lane & 15;
        f32x4 accH[2]; accH[0] = (f32x4){0.f, 0.f, 0.f, 0.f}; accH[1] = accH[0];
        for (int i = F.tid; i < 32 * 136 / 2; i += 512) ((LAS unsigned*)Hl)[i] = 0u;
#define SC_CHUNK_OF(step) (dir == 0 ? (step) : ((step) < 2 ? 1 - (step) : (NCH - 1) - ((step) - 2)))
        const int rsw = (4 * (w & 3) + dr) & 15, gc = dc ^ rsw;
        const unsigned loCB = (unsigned)(dr * 128 + 8 * gc) * 2u, loT = (unsigned)(dr * TV + 8 * gc) * 2u, loC = (unsigned)(dr * BCD + 8 * gc) * 2u;
#define SC_ISSUE_TILES(cvx_) SC_ISSUE_PIECES(cvx_, 0, 13)
#define SC_ISSUE_PIECES(cvx_, j0_, j1_) do { const int cvx = (cvx_); const unsigned tvx = cvx * 128u; const unsigned rbx = (unsigned)row_of(b, cvx * 128); \
            _Pragma("unroll") for (int jj = (j0_); jj < (j1_); ++jj) { const int q = 8 * jj + w, r0 = 4 * (q & 31);   \
                const char* src; int toff; \
                if (jj < 4) { src = (const char*)(CBh + ((size_t)cvx * 16384u + (unsigned)r0 * 128u)) + loCB; toff = SC_CB; } \
                else if (jj < 8) { src = (const char*)(bt + ((size_t)r0 * TV + tvx)) + loT; toff = SC_BT; } \
                else if (jj < 12) { src = (const char*)(Cg + (size_t)(rbx + r0) * BCD) + loC; toff = SC_C; } \
                else { src = (const char*)(xt + ((size_t)r0 * TV + tvx)) + loT; toff = SC_X; } \
                GLDS16(src, L + toff + (q & 31) * 1024); } } while (0)
        const int kd = w >> 1; float km[8], dk[8];
#pragma unroll
        for (int i = 0; i < 8; ++i) { const int sidx = 32 * kd + 8 * fq + i; km[i] = (dir == 0 ? (sidx <= lrow) : (sidx >= lrow)) ? 1.f : 0.f; dk[i] = (sidx == lrow) ? Dsk : 0.f; }
#define SC_ISSUE_TAB(cvx_, tbuf_) do { if (w < 6) { const int tsel = w >> 1, half = w & 1; const float* tsrc = tsel == 0 ? CUM : (tsel == 1 ? DT : WJ); \
            GLDS4(tsrc + tbase + (cvx_) * 128 + half * 64 + F.lane, (LAS unsigned char*)(tab + (tbuf_) * 384 + tsel * 128 + half * 64)); } } while (0)
        { const int cv0 = SC_CHUNK_OF(0); SC_ISSUE_TILES(cv0); SC_ISSUE_TAB(cv0, 0); }
        for (int step = 0; step < NCH; ++step) {
            const int cv = SC_CHUNK_OF(step), buf = step & 1; const bool more = step + 1 < NCH;
            const int cvn = more ? SC_CHUNK_OF(step + 1) : cv;
            const unsigned rbase = (unsigned)row_of(b, cv * 128);
            if (step == 0) WAITV(0); else WAITV(2);
            LDSBAR();
            u32x4 rcb[4], rbt[4]; bf16x8 xf[2][4], cf[4];
#pragma unroll
            for (int ks = 0; ks < 4; ++ks) { const int fo = lrow * 256 + (((4 * ks + fq) ^ fr) << 4);
                rcb[ks] = *(const LAS u32x4*)(L + SC_CB + fo); rbt[ks] = *(const LAS u32x4*)(L + SC_BT + fo); cf[ks] = *(const LAS bf16x8*)(L + SC_C + fo);
#pragma unroll
                for (int nt = 0; nt < 2; ++nt) xf[nt][ks] = *(const LAS bf16x8*)(L + SC_X + (16 * nt + fr) * 256 + (((4 * ks + fq) ^ fr) << 4)); }
            LDSBAR();
            const LAS float* tb = tab + buf * 384;
            const float cl2 = tb[lrow]; const float ecum_l = fexp2(cl2);
            const float chunk_decay = fexp2(dir == 0 ? tb[127] : tb[0]);
            bf16x8 mf[4], bw[4];
#pragma unroll
            for (int ks = 0; ks < 4; ++ks) { const int s0 = 32 * ks + 8 * fq;
                const bool none = dir == 0 ? (ks > kd) : (ks < kd), diag = (ks == kd);
                unsigned om[4] = {0u, 0u, 0u, 0u};
                if (!none) {
                    const f32x4 cs0 = *(const LAS f32x4*)(tb + 128 + s0), cs1 = *(const LAS f32x4*)(tb + 128 + s0 + 4);
                    const float cs[8] = {cs0[0], cs0[1], cs0[2], cs0[3], cs1[0], cs1[1], cs1[2], cs1[3]};
                    const unsigned qc[4] = {rcb[ks].x, rcb[ks].y, rcb[ks].z, rcb[ks].w};
                    float v[8];
                    if (!diag) {
#pragma unroll
                        for (int i = 0; i < 8; ++i) { const float cbv = (i & 1) ? bfhi(qc[i >> 1]) : bflo(qc[i >> 1]); v[i] = cbv * fexp2(cl2 - cs[i]); }
                    } else {
#pragma unroll
                        for (int i = 0; i < 8; ++i) { const float cbv = (i & 1) ? bfhi(qc[i >> 1]) : bflo(qc[i >> 1]); const float x = cl2 - cs[i]; v[i] = (cbv * fexp2(x < 60.f ? x : 60.f)) * km[i] + dk[i]; }
                    }
#pragma unroll
                    for (int i = 0; i < 4; ++i) om[i] = pk2(v[2 * i], v[2 * i + 1]);
                }
                mf[ks] = __builtin_bit_cast(bf16x8, (u32x4){om[0], om[1], om[2], om[3]});
                { const f32x4 ws0 = *(const LAS f32x4*)(tb + 256 + s0), ws1 = *(const LAS f32x4*)(tb + 256 + s0 + 4); const float wsv[8] = {ws0[0], ws0[1], ws0[2], ws0[3], ws1[0], ws1[1], ws1[2], ws1[3]};
                  const unsigned qb[4] = {rbt[ks].x, rbt[ks].y, rbt[ks].z, rbt[ks].w}; unsigned ob[4];
#pragma unroll
                  for (int i = 0; i < 4; ++i) ob[i] = pk2(bflo(qb[i]) * wsv[2 * i], bfhi(qb[i]) * wsv[2 * i + 1]);
                  bw[ks] = __builtin_bit_cast(bf16x8, (u32x4){ob[0], ob[1], ob[2], ob[3]}); }
                if (more) { if (ks == 0) SC_ISSUE_PIECES(cvn, 0, 4); else if (ks == 1) SC_ISSUE_PIECES(cvn, 4, 8); else if (ks == 2) SC_ISSUE_PIECES(cvn, 8, 12); else { SC_ISSUE_PIECES(cvn, 12, 13); SC_ISSUE_TAB(cvn, buf ^ 1); } } }
            f32x4 yd[2], yo[2];
#pragma unroll
            for (int nt = 0; nt < 2; ++nt) { yd[nt] = (f32x4){0.f, 0.f, 0.f, 0.f}; yo[nt] = yd[nt]; accH[nt] = accH[nt] * chunk_decay; }
#pragma unroll
            for (int nt = 0; nt < 2; ++nt)
#pragma unroll
                for (int ks = 0; ks < 4; ++ks) {
                    yd[nt] = MFMA16(xf[nt][ks], mf[ks], yd[nt]);
                    const bf16x8 hf = *(const LAS bf16x8*)(Hl + buf * (32 * 136) + (16 * nt + fr) * 136 + 32 * ks + 8 * fq);
                    yo[nt] = MFMA16(hf, cf[ks], yo[nt]);
                    accH[nt] = MFMA16(bw[ks], xf[nt][ks], accH[nt]); }
#pragma unroll
            for (int nt = 0; nt < 2; ++nt) { u32x2 hw; hw.x = pk2(accH[nt][0], accH[nt][1]); hw.y = pk2(accH[nt][2], accH[nt][3]);
                *(LAS u32x2*)(Hl + (buf ^ 1) * (32 * 136) + (16 * nt + fr) * 136 + 16 * w + 4 * fq) = hw; }
#pragma unroll
            for (int nt = 0; nt < 2; ++nt) { u32x2 yw; yw.x = pk2(yd[nt][0] + ecum_l * yo[nt][0], yd[nt][1] + ecum_l * yo[nt][1]); yw.y = pk2(yd[nt][2] + ecum_l * yo[nt][2], yd[nt][3] + ecum_l * yo[nt][3]);
                *(u32x2*)(Y + ((size_t)(rbase + lrow) * DIN + 16 * nt + 4 * fq)) = yw; }
        }
        WAITV(0); LDSBAR();
    }
}

DEV void phase_gate(const Frame& F, int j, const bf16_t* Yf, const bf16_t* Yb, const bf16_t* Z, bf16_t* YN, int nrows) {
    const int gw = F.bx * 8 + F.wave, NGW = F.G * 8; const float* nw = INP(F, I_SNORM) + (size_t)j * DIN;
    u32x4 na[4], nb[4], nz[4];
    if (gw < nrows) {
#pragma unroll
        for (int q = 0; q < 4; ++q) { const size_t o = (size_t)gw * DIN + 8 * F.lane + 512 * q; na[q] = *(const u32x4*)(Yf + o); nb[q] = *(const u32x4*)(Yb + o); nz[q] = *(const u32x4*)(Z + o); } }
    for (int r = gw; r < nrows; r += NGW) {
        float t[32]; float ss = 0.f;
        u32x4 ca[4], cb4[4], cz[4];
#pragma unroll
        for (int q = 0; q < 4; ++q) { ca[q] = na[q]; cb4[q] = nb[q]; cz[q] = nz[q]; }
        if (r + NGW < nrows) {
#pragma unroll
            for (int q = 0; q < 4; ++q) { const size_t o = (size_t)(r + NGW) * DIN + 8 * F.lane + 512 * q; na[q] = *(const u32x4*)(Yf + o); nb[q] = *(const u32x4*)(Yb + o); nz[q] = *(const u32x4*)(Z + o); } }
#pragma unroll
        for (int q = 0; q < 4; ++q) { const u32x4 a = ca[q], bq = cb4[q], z = cz[q];
            const unsigned aa[4] = {a.x, a.y, a.z, a.w}, bb[4] = {bq.x, bq.y, bq.z, bq.w}, zz[4] = {z.x, z.y, z.z, z.w};
#pragma unroll
            for (int i = 0; i < 4; ++i) { const float v0 = (bflo(aa[i]) + bflo(bb[i])) * siluf(bflo(zz[i])), v1 = (bfhi(aa[i]) + bfhi(bb[i])) * siluf(bfhi(zz[i])); t[8 * q + 2 * i] = v0; t[8 * q + 2 * i + 1] = v1; ss += v0 * v0 + v1 * v1; } }
        const float rstd = rsqrtf(wave_sum(ss) * (1.0f / DIN) + EPS);
#pragma unroll
        for (int q = 0; q < 4; ++q) { const int c = 8 * F.lane + 512 * q; const f32x4 w0 = *(const f32x4*)(nw + c), w1 = *(const f32x4*)(nw + c + 4);
            u32x4 o; o.x = pk2(t[8 * q] * rstd * w0[0], t[8 * q + 1] * rstd * w0[1]); o.y = pk2(t[8 * q + 2] * rstd * w0[2], t[8 * q + 3] * rstd * w0[3]);
            o.z = pk2(t[8 * q + 4] * rstd * w1[0], t[8 * q + 5] * rstd * w1[1]); o.w = pk2(t[8 * q + 6] * rstd * w1[2], t[8 * q + 7] * rstd * w1[3]);
            *(u32x4*)(YN + (size_t)r * DIN + c) = o; }
    }
}

struct TokInfo { int s0, s1; float g0, g1; };
DEV void phase_route(const Frame& F, int layer, int ml, bf16_t* V, int nrows) {
    LAS unsigned* lc = (LAS unsigned*)(F.lds + LDS_MISC + 256);
    if (F.tid < 8) lc[F.tid] = 0u;
    __syncthreads();
    const int gw = F.bx * 8 + F.wave, NGW = F.G * 8; const int j = layer / 2;
    const float* w = INP(F, I_NFFN) + (size_t)layer * D; const float* rw = INP(F, I_RW) + (size_t)j * D * NEXP;
    LAS float* rwl = (LAS float*)F.lds;
    for (int q = F.tid; q < D * 2; q += 512) { const int c = q >> 1, hf = q & 1; const int ln = (c & 255) >> 2, ii = c & 3, jq = c >> 8;
        *(LAS f32x4*)(rwl + ((jq * 4 + ii) * 64 + ln) * 8 + hf * 4) = *(const f32x4*)(rw + (size_t)q * 4); }
    __syncthreads();
    TokInfo* tok = (TokInfo*)(F.ws + OFF_TOK);
    f32x4 nx[4];
    if (gw < nrows) load_row(F.H + (size_t)gw * D, F.lane, nx);
    for (int r = gw; r < nrows; r += NGW) {
        f32x4 v[4];
#pragma unroll
        for (int q = 0; q < 4; ++q) v[q] = nx[q];
        if (r + NGW < nrows) load_row(F.H + (size_t)(r + NGW) * D, F.lane, nx);
        const float rstd = rsqrtf(sumsq_row(v) * (1.0f / D) + EPS);
        const int vec = vec_of(r);
        normmod_row(v, rstd, w, modp(F, layer, vec, 3), modp(F, layer, vec, 4), F.lane);
#pragma unroll
        for (int jq = 0; jq < 4; ++jq) *(unsigned*)((fp8_t*)V + (size_t)r * D + 4 * F.lane + 256 * jq) = pk4_fp8(v[jq][0] * 8.0f, v[jq][1] * 8.0f, v[jq][2] * 8.0f, v[jq][3] * 8.0f);
        float lg[NEXP];
#pragma unroll
        for (int e = 0; e < NEXP; ++e) lg[e] = 0.f;
#pragma unroll
        for (int jj = 0; jj < 4; ++jj)
#pragma unroll
            for (int i = 0; i < 4; ++i) { const LAS float* rp = rwl + ((jj * 4 + i) * 64 + F.lane) * 8; const f32x4 r0 = *(const LAS f32x4*)rp, r1 = *(const LAS f32x4*)(rp + 4);
#pragma unroll
                for (int e = 0; e < 4; ++e) { lg[e] += v[jj][i] * r0[e]; lg[4 + e] += v[jj][i] * r1[e]; } }
#pragma unroll
        for (int e = 0; e < NEXP; ++e) lg[e] = wave_sum(lg[e]);
        int e0 = 0; float v0 = lg[0];
#pragma unroll
        for (int e = 1; e < NEXP; ++e) if (lg[e] > v0) { v0 = lg[e]; e0 = e; }
        int e1 = -1; float v1 = -3.0e38f;
#pragma unroll
        for (int e = 0; e < NEXP; ++e) if (e != e0 && lg[e] > v1) { v1 = lg[e]; e1 = e; }
        const float g1 = frcp(1.0f + FEXP(v0 - v1)), g0 = 1.0f - g1;
        if (F.lane == 0) { TokInfo ti; ti.s0 = e0; ti.s1 = e1; ti.g0 = g0; ti.g1 = g1; tok[r] = ti; atomicAdd((unsigned*)&lc[e0], 1u); atomicAdd((unsigned*)&lc[e1], 1u); }
    }
    __syncthreads();
    if (F.tid < 8) __hip_atomic_fetch_add(F.ctl + CW_CNT + (ml * 8 + F.tid) * 64, lc[F.tid], RLX_AGENT);
}
DEV void tile_starts(const Frame& F, int ml, int (&ts)[NEXP + 1], unsigned (&cnt)[NEXP]) {
    ts[0] = 0;
#pragma unroll
    for (int e = 0; e < NEXP; ++e) { cnt[e] = __hip_atomic_load(F.ctl + CW_CNT + (ml * 8 + e) * 64, RLX_AGENT); ts[e + 1] = ts[e] + (int)((cnt[e] + 255u) / 256u); }
}
DEV void phase_slots(const Frame& F, int ml, int nrows) {
    int ts[NEXP + 1]; unsigned cnt[NEXP]; tile_starts(F, ml, ts, cnt);
    TokInfo* tok = (TokInfo*)(F.ws + OFF_TOK); int* s2t = (int*)(F.ws + OFF_S2T);
    const int gw = F.bx * 8 + F.wave, NGW = F.G * 8;
    for (int base = gw * 64; base < nrows; base += NGW * 64) {
        const int r = base + F.lane; TokInfo ti = tok[r];
        unsigned long long m0[NEXP], m1[NEXP]; unsigned mycnt = 0;
#pragma unroll
        for (int e = 0; e < NEXP; ++e) { m0[e] = __ballot(ti.s0 == e); m1[e] = __ballot(ti.s1 == e); if (F.lane == e) mycnt = (unsigned)(__builtin_popcountll(m0[e]) + __builtin_popcountll(m1[e])); }
        unsigned b0 = 0;
        if (F.lane < NEXP && mycnt) b0 = __hip_atomic_fetch_add(F.ctl + CW_CUR + (ml * 8 + F.lane) * 64, mycnt, RLX_AGENT);
        const unsigned long long below = (1ull << F.lane) - 1ull; int sl0 = 0, sl1 = 0;
#pragma unroll
        for (int e = 0; e < NEXP; ++e) { const unsigned be = __shfl(b0, e); const int c0 = __builtin_popcountll(m0[e]);
            if (ti.s0 == e) sl0 = ts[e] * 256 + (int)be + __builtin_popcountll(m0[e] & below);
            if (ti.s1 == e) sl1 = ts[e] * 256 + (int)be + c0 + __builtin_popcountll(m1[e] & below); }
        ti.s0 = sl0; ti.s1 = sl1; tok[r] = ti; s2t[sl0] = r; s2t[sl1] = r;
    }
    if (F.bx == 0) { for (int e = 0; e < NEXP; ++e) { const int a = ts[e] * 256 + (int)cnt[e], b2 = ts[e + 1] * 256; for (int s = a + F.tid; s < b2; s += 512) s2t[s] = 0; } }
}
DEV void phase_combine(const Frame& F, int layer, const bf16_t* YS, bool final_) {
    const int gw = F.bx * 8 + F.wave, NGW = F.G * 8; const TokInfo* tok = (const TokInfo*)(F.ws + OFF_TOK);
    const int nrows = final_ ? ML : MT;
    f32x4 nh[4]; u32x2 nya[4], nyb[4]; TokInfo tcur, tnxt;
    tcur.s0 = tcur.s1 = 0; tcur.g0 = tcur.g1 = 0.f; tnxt = tcur;
    if (gw < nrows) { tcur = tok[gw]; load_row(F.H + (size_t)gw * D, F.lane, nh);
#pragma unroll
        for (int jj = 0; jj < 4; ++jj) { const int c = 4 * F.lane + 256 * jj; nya[jj] = *(const u32x2*)(YS + (size_t)tcur.s0 * D + c); nyb[jj] = *(const u32x2*)(YS + (size_t)tcur.s1 * D + c); } }
    if (gw + NGW < nrows) tnxt = tok[gw + NGW];
    for (int r = gw; r < nrows; r += NGW) {
        f32x4 v[4]; u32x2 ya[4], yb[4]; TokInfo ti = tcur;
#pragma unroll
        for (int q = 0; q < 4; ++q) { v[q] = nh[q]; ya[q] = nya[q]; yb[q] = nyb[q]; }
        tcur = tnxt;
        if (r + NGW < nrows) { load_row(F.H + (size_t)(r + NGW) * D, F.lane, nh);
#pragma unroll
            for (int jj = 0; jj < 4; ++jj) { const int c = 4 * F.lane + 256 * jj; nya[jj] = *(const u32x2*)(YS + (size_t)tcur.s0 * D + c); nyb[jj] = *(const u32x2*)(YS + (size_t)tcur.s1 * D + c); } }
        if (r + 2 * NGW < nrows) tnxt = tok[r + 2 * NGW];
        if (MOE_DOWN_FP8) { ti.g0 *= 0.00390625f; ti.g1 *= 0.00390625f; }
        const float* g2 = modp(F, layer, vec_of(r), 5);
#pragma unroll
        for (int jj = 0; jj < 4; ++jj) { const int c = 4 * F.lane + 256 * jj; const u32x2 a = ya[jj], b = yb[jj]; const f32x4 gv = *(const f32x4*)(g2 + c);
            v[jj][0] += gv[0] * (ti.g0 * bflo(a.x) + ti.g1 * bflo(b.x)); v[jj][1] += gv[1] * (ti.g0 * bfhi(a.x) + ti.g1 * bfhi(b.x));
            v[jj][2] += gv[2] * (ti.g0 * bflo(a.y) + ti.g1 * bflo(b.y)); v[jj][3] += gv[3] * (ti.g0 * bfhi(a.y) + ti.g1 * bfhi(b.y)); }
        if (!final_) {
#pragma unroll
            for (int jj = 0; jj < 4; ++jj) *(f32x4*)(F.H + (size_t)r * D + 4 * F.lane + 256 * jj) = v[jj];
        } else {
            const float rstd = rsqrtf(sumsq_row(v) * (1.0f / D) + EPS); const float* fw = INP(F, I_FNORM);
#pragma unroll
            for (int jj = 0; jj < 4; ++jj) { const int c = 4 * F.lane + 256 * jj; *(f32x4*)(OUTP(F) + (size_t)r * D + c) = v[jj] * rstd * *(const f32x4*)(fw + c); }
        }
    }
}

constexpr int PH_PER_PAIR = 17, N_PHASES = 1 + 2 * PH_PER_PAIR;
__global__ void __launch_bounds__(512, 2) fwd_kernel(Params prm) {
#ifdef EMU
    unsigned char* lds_raw = emu_lds();
#else
    extern __shared__ __attribute__((aligned(16))) unsigned char lds_raw[];
#endif
    Frame F;
    F.lds = (LAS unsigned char*)lds_raw;
    F.tid = threadIdx.x; F.lane = F.tid & 63; F.wave = RFL(F.tid >> 6); F.G = gridDim.x; F.bx = blockIdx.x;
    F.p = &prm; F.ws = prm.ws; F.ctl = (unsigned*)(prm.ws + OFF_CTL); F.H = (float*)(prm.ws + OFF_H); F.mod = (float*)(prm.ws + OFF_MOD);
    volatile LAS unsigned* misc = (volatile LAS unsigned*)(F.lds + LDS_MISC);
    if (F.tid < 64) misc[F.tid] = 0u;
    __syncthreads();
    XcdBarrier bar; bar.bar = F.ctl + CW_BAR; bar.x = 0; bar.st = misc;
    const int lo = prm.ph_lo, hi = prm.ph_hi;
    if (hi - lo > 1) bar = xcd_barrier_post(F.ctl + CW_BAR, misc);
    int ph = 0;
#ifndef SITE_MASK
#define SITE_MASK 0xFFFFFFFFu
#endif
#ifndef PROBE_REPEAT_SITE
#define PROBE_REPEAT_SITE (-1)
#endif
#define PH_REPS(site) ((PROBE_REPEAT_SITE == (site)) ? 2 : 1)
#define PHASE_BEGIN(site) if (((SITE_MASK >> (site)) & 1u) && lo <= ph && ph < hi) { { int _t = threadIdx.x; LAUNDER_V(_t); F.tid = _t; F.lane = _t & 63; int _b = blockIdx.x; LAUNDER_S(_b); F.bx = _b; int _g = gridDim.x; LAUNDER_S(_g); F.G = _g; \
      F.ws = WSP(F); F.ctl = (unsigned*)(F.ws + OFF_CTL); F.H = (float*)(F.ws + OFF_H); F.mod = (float*)(F.ws + OFF_MOD); } \
      for (int _rep = 0; _rep < PH_REPS(site); ++_rep) { if (_rep) __syncthreads();
#define PHASE_END   } if (ph + 1 < hi) xcd_barrier(bar); } ++ph;
#define B_W (F.ws + OFF_W)
#define B_ACT (F.ws + OFF_ACT)
#define B_P ((bf16_t*)(B_ACT + A_P))
#define B_HID ((bf16_t*)(B_ACT + A_HID))
#define B_U ((bf16_t*)(B_ACT + A_U))
#define B_Z ((bf16_t*)(B_ACT + A_Z))
#define B_XBC ((bf16_t*)(B_ACT + A_XBC))
#define B_DT ((float*)(B_W + W_DT))
#define B_XT ((bf16_t*)(B_ACT + A_XT))
#define B_BROW ((bf16_t*)(B_ACT + A_BROW))
#define B_BT ((bf16_t*)(B_ACT + A_BT))
#define B_CROW ((bf16_t*)(B_ACT + A_CROW))
#define B_CB ((bf16_t*)(B_ACT + A_CB))
#define B_CUM ((float*)(B_ACT + A_CUM))
#define B_WJ ((float*)(B_ACT + A_WJ))
#define B_YF ((bf16_t*)(B_ACT + A_YF))
#define B_YB ((bf16_t*)(B_W + W_YB))
#define B_YN ((bf16_t*)(B_ACT + A_YN))
#define B_V ((bf16_t*)(B_ACT + A_V))
#define B_HIDM ((bf16_t*)(B_ACT + A_HIDM))
#define B_YS ((bf16_t*)(B_ACT + A_YS))

    PHASE_BEGIN(0) phase_mod(F); convert_even(F, 0); PHASE_END

    for (int lp = 0; lp < 2; ++lp) {
        const int le = 2 * lp, lod = 2 * lp + 1;
        PHASE_BEGIN(1) phase_poolprep(F, le, B_P); PHASE_END
        PHASE_BEGIN(2) { PolPool S; S.G = F.G; S.c = F.bx; S.K = 256; S.lda = D; S.ldb = 256; S.P = B_P; S.W = (const bf16_t*)(B_W + W_POOL); S.src = mksrc(F); S.layer = le; S.scale = INP(F, I_POOLS) + (size_t)lp * D;
                      ge::gemm_phase(F.lds, S, F.tid); } PHASE_END
        PHASE_BEGIN(3) phase_norm(F, le, 3, B_P, false); PHASE_END
        PHASE_BEGIN(4) { PolUp<false> S; S.G = F.G; S.c = F.bx; S.K = D; S.lda = D; S.ldb = D; S.A = B_P; S.W = (const bf16_t*)(B_W + W_UP); S.HID = B_HID; S.ldh = DFF; S.nq = DFF / 128; S.nM = NPAN; S.s2t = nullptr;
                      ge::gemm_phase(F.lds, S, F.tid); } PHASE_END
        PHASE_BEGIN(5) { PolResid S; S.G = F.G; S.c = F.bx; S.K = DFF; S.lda = DFF; S.ldb = DFF; S.A = B_HID; S.W = (const bf16_t*)(B_W + W_DN); S.src = mksrc(F); S.layer = le; S.which = 5; S.npan = NPAN;
                      ge::gemm_phase(F.lds, S, F.tid); } PHASE_END
        PHASE_BEGIN(6) phase_norm(F, lod, 0, B_U, false); convert_ssd(F, lp); PHASE_END
        PHASE_BEGIN(7) { PolInProj S; S.G = F.G; S.c = F.bx; S.K = D; S.lda = D; S.ldb = D; S.A = B_U; S.W = (const bf16_t*)(B_W + W_IN); S.Z = B_Z; S.XBC = B_XBC; S.DT = B_DT;
                      ge::gemm_phase(F.lds, S, F.tid); } PHASE_END
        PHASE_BEGIN(8) phase_conv(F, lp, B_XBC, B_XT, B_BROW, B_BT, B_CROW); PHASE_END
        PHASE_BEGIN(9) phase_cb(F, B_BROW, B_CROW, B_CB); phase_tables(F, lp, B_DT, B_CUM, B_WJ); PHASE_END
        PHASE_BEGIN(10) phase_scan(F, lp, B_XT, B_BT, B_CROW, B_CB, B_DT, B_CUM, B_WJ, B_YF, B_YB); PHASE_END
        PHASE_BEGIN(11) phase_gate(F, lp, B_YF, B_YB, B_Z, B_YN, lp == 1 ? ML : MT); PHASE_END
        PHASE_BEGIN(12) { PolResid S; S.G = F.G; S.c = F.bx; S.K = DIN; S.lda = DIN; S.ldb = DIN; S.A = B_YN; S.W = (const bf16_t*)(B_W + W_OUT); S.src = mksrc(F); S.layer = lod; S.which = 2; S.npan = lp == 1 ? ML / 256 : NPAN;
                      ge::gemm_phase(F.lds, S, F.tid); } PHASE_END
        PHASE_BEGIN(13) phase_route(F, lod, lp, B_V, lp == 1 ? ML : MT); convert_moe(F, lp); PHASE_END
        PHASE_BEGIN(14) phase_slots(F, lp, lp == 1 ? ML : MT); PHASE_END
        PHASE_BEGIN(15) { int ts[NEXP + 1]; unsigned cnt[NEXP]; tile_starts(F, lp, ts, cnt);
                      PolUp<true> S; S.G = F.G; S.c = F.bx; S.K = D; S.lda = D; S.ldb = D; S.A = B_V; S.W = (const bf16_t*)(B_W + W_MUP); S.HID = B_HIDM; S.ldh = DFFE; S.nq = DFFE / 128; S.nM = ts[NEXP];
                      S.s2t = (const int*)(F.ws + OFF_S2T);
#pragma unroll
                      for (int e = 0; e <= NEXP; ++e) S.tstart[e] = ts[e];
                      ge::gemm_phase(F.lds, S, F.tid); } PHASE_END
        PHASE_BEGIN(16) { int ts[NEXP + 1]; unsigned cnt[NEXP]; tile_starts(F, lp, ts, cnt);
                      PolMoeDown S; S.G = F.G; S.c = F.bx; S.K = DFFE; S.lda = DFFE; S.ldb = DFFE; S.A = B_HIDM; S.W = (const bf16_t*)(B_W + W_MDN); S.YS = B_YS; S.nM = ts[NEXP];
#pragma unroll
                      for (int e = 0; e <= NEXP; ++e) S.tstart[e] = ts[e];
                      ge::gemm_phase(F.lds, S, F.tid); } PHASE_END
        PHASE_BEGIN(17) phase_combine(F, lod, B_YS, lp == 1); if (lp == 0) convert_even(F, 1); PHASE_END
    }
#undef PHASE_BEGIN
#undef PHASE_END
}

extern "C" void kernel_launch(void* const* d_in, const int* in_sizes, int n_in, void* d_out, int out_size, void* d_ws, size_t ws_size, hipStream_t stream) {
    static int grid = 0;
    if (grid == 0) {
        if (n_in != 26 || ws_size < WS_NEED) { fprintf(stderr, "kernel_launch: need 26 inputs and %zu bytes of workspace (got %d, %zu)\n", (size_t)WS_NEED, n_in, ws_size); grid = -1; return; }
        int dev = 0, cus = 0, per_cu = 0;
        if (hipGetDevice(&dev) != hipSuccess || hipDeviceGetAttribute(&cus, hipDeviceAttributeMultiprocessorCount, dev) != hipSuccess) { grid = -1; return; }
        if (hipFuncSetAttribute((const void*)fwd_kernel, hipFuncAttributeMaxDynamicSharedMemorySize, LDS_BYTES) != hipSuccess) { grid = -1; return; }
        if (hipOccupancyMaxActiveBlocksPerMultiprocessor(&per_cu, (const void*)fwd_kernel, 512, LDS_BYTES) != hipSuccess || per_cu < 1) { fprintf(stderr, "kernel_launch: occupancy query says %d\n", per_cu); }
        (void)hipGetLastError();
        grid = cus;
    }
    if (grid < 0) return;
    (void)in_sizes; (void)out_size;
    if (hipMemsetAsync((char*)d_ws + OFF_CTL, 0, CTL_BYTES, stream) != hipSuccess) return;
    Params p{};
    for (int i = 0; i < 26; ++i) p.in[i] = (const float*)d_in[i];
    p.out = (float*)d_out; p.ws = (unsigned char*)d_ws;
    if (N_LAUNCH_MODE == 1) { p.ph_lo = 0; p.ph_hi = N_PHASES; hipLaunchKernelGGL(fwd_kernel, dim3(grid), dim3(512), LDS_BYTES, stream, p); }
    else for (int ph = 0; ph < N_PHASES; ++ph) { p.ph_lo = ph; p.ph_hi = ph + 1; hipLaunchKernelGGL(fwd_kernel, dim3(grid), dim3(512), LDS_BYTES, stream, p); }
}
```

```cpp
#ifndef EMU
#include <hip/hip_runtime.h>
#endif
#include <cstdio>
#include <cstdint>

#ifndef CFG_SEQ
#define CFG_SEQ 16384
#endif
#ifndef CFG_DFF
#define CFG_DFF 2816
#endif
#ifndef CFG_DFFE
#define CFG_DFFE 3584
#endif
#ifndef MOE_DOWN_FP8
#define MOE_DOWN_FP8 1
#endif
#ifndef N_LAUNCH_MODE
#define N_LAUNCH_MODE 1
#endif

#ifdef EMU
#define LAS
#define DEV inline
#define WAITV(n) ((void)0)
#define WAITL(n) ((void)0)
#define SBAR() emu_wg_sync()
#define SCHED() ((void)0)
#define SETPRIO(x) ((void)0)
#define MFMA16(a, b, c) emu_mfma16(a, b, c)
#define GLDS16(g, l) emu_glds16((const void*)(g), (void*)(l))
#define GLDS4(g, l) emu_glds4((const void*)(g), (void*)(l))
#define MFMA8(a, b, c) emu_mfma8(a, b, c)
#define RFL(x) emu_rfl(x)
#define MEMFENCE() ((void)0)
#define WSYNC() emu_wave_sync()
#define LDSBAR() emu_wg_sync()
#define LAUNDER_V(x) ((void)0)
#define SLEEP1() emu_yield()
#define MY_XCC_ID() ((unsigned)(blockIdx.x & 7u))
#define FENCE_REL() __atomic_thread_fence(__ATOMIC_SEQ_CST)
#define FENCE_ACQ() __atomic_thread_fence(__ATOMIC_SEQ_CST)
#define FEXP(x) expf(x)
#define RLX_AGENT __ATOMIC_RELAXED, 4
#else
#define LAS __attribute__((address_space(3)))
#define DEV __device__ __forceinline__
#define WAITV(n) asm volatile("s_waitcnt vmcnt(" #n ")" ::: "memory")
#define WAITL(n) asm volatile("s_waitcnt lgkmcnt(" #n ")" ::: "memory")
#define SBAR() __builtin_amdgcn_s_barrier()
#define SCHED() __builtin_amdgcn_sched_barrier(0)
#define SETPRIO(x) __builtin_amdgcn_s_setprio(x)
#define MFMA16(a, b, c) __builtin_amdgcn_mfma_f32_16x16x32_bf16(a, b, c, 0, 0, 0)
#define GLDS16(g, l) __builtin_amdgcn_global_load_lds((const unsigned*)(g), (LAS unsigned*)(l), 16, 0, 0)
#define GLDS4(g, l) __builtin_amdgcn_global_load_lds((const unsigned*)(g), (LAS unsigned*)(l), 4, 0, 0)
#define MFMA8(a, b, c) __builtin_amdgcn_mfma_scale_f32_16x16x128_f8f6f4(a, b, c, 0, 0, 0, 0x7f7f7f7f, 0, 0x7f7f7f7f)
#define RFL(x) __builtin_amdgcn_readfirstlane(x)
#define MEMFENCE() asm volatile("" ::: "memory")
#define LDSBAR() do { asm volatile("s_waitcnt lgkmcnt(0)" ::: "memory"); __builtin_amdgcn_s_barrier(); asm volatile("" ::: "memory"); } while (0)
#define WSYNC() asm volatile("s_waitcnt lgkmcnt(0)" ::: "memory")
#define SLEEP1() __builtin_amdgcn_s_sleep(1)
#define MY_XCC_ID() ((unsigned)__builtin_amdgcn_s_getreg((3 << 11) | 20) & 0xFu)
#define FENCE_REL() __builtin_amdgcn_fence(__ATOMIC_RELEASE, "agent")
#define FENCE_ACQ() __builtin_amdgcn_fence(__ATOMIC_ACQUIRE, "agent")
#define FEXP(x) __expf(x)
#define RLX_AGENT __ATOMIC_RELAXED, __HIP_MEMORY_SCOPE_AGENT
#define LAUNDER_V(x) asm volatile("" : "+v"(x))
#endif

typedef unsigned short bf16_t;
typedef short bf16x8 __attribute__((ext_vector_type(8)));
typedef float f32x4 __attribute__((ext_vector_type(4)));
typedef float f32x2 __attribute__((ext_vector_type(2)));
typedef unsigned u32x4 __attribute__((ext_vector_type(4)));
typedef unsigned u32x2 __attribute__((ext_vector_type(2)));
typedef int i32x8 __attribute__((ext_vector_type(8)));
typedef int i32x4 __attribute__((ext_vector_type(4)));
typedef unsigned char fp8_t;

constexpr int D = 1024, NB = 2, SEQ = CFG_SEQ, CTXL = 256, DEPTH = 4;
constexpr int ML = NB * SEQ, MC = NB * CTXL, MT = ML + MC, NPAN = MT / 256;
constexpr int DFF = CFG_DFF, DFFE = CFG_DFFE, NEXP = 8;
constexpr int DIN = 2048, NH = 32, HD = 64, NG = 4, DS = 128, CONVD = 3072, NPROJ = 5184, NPROJP = 5376, BCD = 512;
constexpr int TV = CTXL + SEQ, NCH = TV / 128;
constexpr int GRIDW = 64;
constexpr float EPS = 1e-6f;
constexpr int NSLOT_TILES = (2 * MT) / 256 + NEXP, NSLOT = NSLOT_TILES * 256;
static_assert(SEQ % 128 == 0 && ML % 256 == 0 && DFF % 128 == 0 && DFFE % 128 == 0 && DFF >= 256 && DFFE >= 256, "shape constraints");

constexpr size_t MiB = 1u << 20;
constexpr size_t al(size_t x) { return (x + 4095) & ~(size_t)4095; }
constexpr size_t OFF_CTL = 0, CTL_BYTES = 1 * MiB;
constexpr size_t OFF_MOD = 1 * MiB;
constexpr size_t OFF_TOK = 2 * MiB;
constexpr size_t OFF_S2T = 3 * MiB;
constexpr size_t OFF_H = 4 * MiB, SZ_H = (size_t)MT * D * 4;
constexpr size_t OFF_W = OFF_H + al(SZ_H);
constexpr size_t W_POOL = 0, SZ_WPOOL = (size_t)4 * 256 * 256 * 2;
constexpr size_t W_UP = al(SZ_WPOOL), SZ_WUP = (size_t)2 * DFF * D * 2;
constexpr size_t W_DN = W_UP + al(SZ_WUP), SZ_WDN = (size_t)D * DFF * 2;
constexpr size_t SZ_WEVEN = W_DN + al(SZ_WDN);
constexpr size_t W_IN = 0, SZ_WIN = (size_t)NPROJP * D * 2;
constexpr size_t W_OUT = al(SZ_WIN), SZ_WOUT = (size_t)D * DIN * 2;
constexpr size_t W_DT = W_OUT + al(SZ_WOUT), SZ_DT = (size_t)NB * 2 * NH * TV * 4;
constexpr size_t W_MUP = W_DT + al(SZ_DT), SZ_WMUP = (size_t)NEXP * 2 * DFFE * D * 2;
constexpr size_t W_MDN = W_MUP + al(SZ_WMUP), SZ_WMDN = (size_t)NEXP * D * DFFE * 2;
constexpr size_t W_YB = W_MUP, SZ_Y = (size_t)MT * DIN * 2;
constexpr size_t SZ_WODD_A = W_MDN + al(SZ_WMDN), SZ_WODD_B = W_YB + al(SZ_Y);
constexpr size_t mx(size_t a, size_t b) { return a > b ? a : b; }
constexpr size_t SZ_W = mx(SZ_WEVEN, mx(SZ_WODD_A, SZ_WODD_B));
constexpr size_t OFF_ACT = OFF_W + SZ_W;
constexpr size_t A_P = 0, SZ_ACT1 = (size_t)MT * D * 2;
constexpr size_t A_HID = al(SZ_ACT1), SZ_HID = (size_t)MT * DFF * 2;
constexpr size_t SZ_AEVEN = A_HID + al(SZ_HID);
constexpr size_t A_Z = 0;
constexpr size_t A_XBC = al(SZ_Y), SZ_XBC = (size_t)MT * CONVD * 2;
constexpr size_t A_YF = A_XBC;
constexpr size_t A_CB = A_XBC + al(SZ_Y), SZ_CB = (size_t)NB * NG * NCH * 128 * 128 * 2;
static_assert(al(SZ_Y) + SZ_CB <= SZ_XBC, "CB fits behind Yf inside the XBC region");
constexpr size_t A_XT = A_XBC + al(SZ_XBC), SZ_XT = (size_t)NB * DIN * TV * 2;
constexpr size_t A_U = A_XT, A_YN = A_XT;
constexpr size_t A_BROW = A_XT + al(SZ_XT), SZ_BC = (size_t)MT * BCD * 2;
constexpr size_t A_BT = A_BROW + al(SZ_BC);
constexpr size_t A_CROW = A_BT + al(SZ_BC);
constexpr size_t A_CUM = A_CROW + al(SZ_BC);
constexpr size_t A_WJ = A_CUM + al(SZ_DT);
constexpr size_t SZ_ASSD = A_WJ + al(SZ_DT);
constexpr size_t A_V = 0;
constexpr size_t A_HIDM = al(SZ_ACT1), SZ_HIDM = (size_t)NSLOT * DFFE * 2;
constexpr size_t A_YS = A_HIDM + al(SZ_HIDM), SZ_YS = (size_t)NSLOT * D * 2;
constexpr size_t SZ_AMOE = A_YS + al(SZ_YS);
constexpr size_t SZ_ACT = mx(SZ_AEVEN, mx(SZ_ASSD, SZ_AMOE));
constexpr size_t WS_NEED = OFF_ACT + SZ_ACT;

constexpr int CW_BAR = 4096;
constexpr int CW_CNT = 16384;
constexpr int CW_CUR = 16384 + 2 * 8 * 64;

DEV unsigned f2bf(float f) { unsigned u = __builtin_bit_cast(unsigned, f); return (u + 0x7fffu + ((u >> 16) & 1u)) >> 16; }
#ifndef EMU
typedef __bf16 bf16x2n __attribute__((ext_vector_type(2)));
#endif
DEV unsigned pk2(float lo, float hi) {
#ifdef EMU
    return f2bf(lo) | (f2bf(hi) << 16);
#else
    f32x2 v = {lo, hi}; bf16x2n b = __builtin_convertvector(v, bf16x2n); return __builtin_bit_cast(unsigned, b);
#endif
}
DEV unsigned pk4_fp8(float a, float b, float c, float d) {
#ifdef EMU
    return emu_f2fp8(a) | (emu_f2fp8(b) << 8) | (emu_f2fp8(c) << 16) | (emu_f2fp8(d) << 24);
#else
    unsigned w = 0; w = __builtin_amdgcn_cvt_pk_fp8_f32(a, b, w, false); w = __builtin_amdgcn_cvt_pk_fp8_f32(c, d, w, true); return w;
#endif
}
DEV float bf2f(unsigned b) { return __builtin_bit_cast(float, b << 16); }
DEV float bflo(unsigned w) { return __builtin_bit_cast(float, w << 16); }
DEV float bfhi(unsigned w) { return __builtin_bit_cast(float, w & 0xffff0000u); }
#ifdef EMU
DEV float frcp(float x) { return 1.0f / x; }
#else
DEV float frcp(float x) { return __builtin_amdgcn_rcpf(x); }
#endif
#ifdef EMU
DEV float fexp2(float x) { return exp2f(x); }
#else
DEV float fexp2(float x) { return __builtin_amdgcn_exp2f(x); }
#endif
DEV float siluf(float x) { return x * frcp(1.0f + FEXP(-x)); }
#ifdef EMU
DEV float flog2(float x) { return log2f(x); }
#else
DEV float flog2(float x) { return __builtin_amdgcn_logf(x); }
#endif
DEV float softplusf(float x) { if (x > 20.f) return x; const float e = FEXP(x); return e < 0.0625f ? e * (1.0f - e * (0.5f - e * (0.33333334f - e * (0.25f - e * 0.2f)))) : flog2(1.0f + e) * 0.6931471806f; }
DEV float wave_sum(float v) {
#pragma unroll
    for (int o = 1; o < 64; o <<= 1) v += __shfl_xor(v, o);
    return v;
}
DEV int vec_of(int r) { return r < ML ? (r / SEQ) : 2; }
DEV int row_of(int b, int tv) { return tv < CTXL ? ML + b * CTXL + tv : b * SEQ + (tv - CTXL); }

#define XB_TMO      128
#define XB_XCNT(j)  (256  + 64 * (j))
#define XB_XSUB(j)  (1280 + 64 * (j))
#define XB_XGEN(j)  (2304 + 64 * (j))
#define XB_TOP      3328
#define XB_TOPGEN   3392
#define XCD_BAR_WORDS 3456
#define XB_SPIN_CAP (1u << 22)
DEV unsigned xb_ld(unsigned* p)              { return __hip_atomic_load(p, RLX_AGENT); }
DEV unsigned xb_add(unsigned* p, unsigned v) { return __hip_atomic_fetch_add(p, v, RLX_AGENT); }
#define XB_SPIN(cond, bar) do { unsigned _sp = 0; while (cond) { SLEEP1(); \
    if ((++_sp & 255u) == 0u) { if (xb_ld(&(bar)[XB_TMO])) break; if (_sp > XB_SPIN_CAP) { atomicAdd(&(bar)[XB_TMO], 1u); break; } } } } while (0)
struct XcdBarrier { unsigned* bar; unsigned x; volatile LAS unsigned* st; };
DEV XcdBarrier xcd_barrier_post(unsigned* bar, volatile LAS unsigned* st) {
    XcdBarrier b; b.bar = bar; b.x = MY_XCC_ID(); b.st = st;
    if (threadIdx.x == 0) (void)xb_add(&bar[XB_XCNT(b.x)], 1u);
    return b;
}
DEV void xcd_barrier_complete(unsigned* bar, unsigned x, unsigned& nloc, unsigned& nx) {
    const unsigned G = gridDim.x;
    unsigned sum, cnt, mine, sp = 0u;
    for (;;) {
        sum = 0u; cnt = 0u; mine = 0u;
#pragma unroll
        for (unsigned j = 0; j < 16; ++j) { const unsigned c = xb_ld(&bar[XB_XCNT(j)]); sum += c; cnt += (c > 0u) ? 1u : 0u; mine = (j == x) ? c : mine; }
        if (sum == G) break;
        SLEEP1();
        if ((++sp & 255u) == 0u) { if (xb_ld(&bar[XB_TMO])) break; if (sp > XB_SPIN_CAP) { atomicAdd(&bar[XB_TMO], 1u); break; } }
    }
    nloc = mine > 0u ? mine : 1u; nx = cnt > 0u ? cnt : 1u;
}
DEV void xcd_barrier(const XcdBarrier& b) {
    WAITV(0);
    __syncthreads();
    if (threadIdx.x == 0) {
        unsigned* bar = b.bar;
#ifndef EMU
        __builtin_amdgcn_s_waitcnt(0);
#endif
        unsigned nloc = b.st[0], nx = b.st[1];
        if (nloc == 0u) { xcd_barrier_complete(bar, b.x, nloc, nx); b.st[0] = nloc; b.st[1] = nx; }
        const unsigned old = xb_add(&bar[XB_XSUB(b.x)], 1u);
        const unsigned gen = old / nloc;
        if (old + 1u == (gen + 1u) * nloc) {
            FENCE_REL();
            WAITV(0);
            const unsigned og = xb_add(&bar[XB_TOP], 1u);
            const unsigned tg = og / nx;
            if (og + 1u == (tg + 1u) * nx) xb_add(&bar[XB_TOPGEN], 1u);
            else XB_SPIN(xb_ld(&bar[XB_TOPGEN]) == tg, bar);
            FENCE_ACQ();
            xb_add(&bar[XB_XGEN(b.x)], 1u);
            WAITV(0);
        } else {
            XB_SPIN(xb_ld(&bar[XB_XGEN(b.x)]) == gen, bar);
            FENCE_ACQ();
            WAITV(0);
        }
    }
    __syncthreads();
}

namespace ge {
constexpr int BM = 256, BK = 64, HALF = 128, HTB = HALF * BK * 2, STAGE_BYTES = 8 * HTB, NXCD = 8, WGM = 8;
DEV int lds_byte(int r, int c) { const int st = (r >> 4) * 2 + (c >> 5), rr = r & 15, cc = c & 31, ob = rr * 64 + cc * 2; return st * 1024 + (ob ^ (((ob >> 9) & 1) << 5)); }
DEV void stage_rc(int b, int& R, int& C) { const int st = b / 1024, sb = b % 1024, swz = sb ^ (((sb >> 9) & 1) << 5); R = (st >> 1) * 16 + swz / 64; C = (st & 1) * 32 + (swz % 64) / 2; }
DEV int perm32(int rho) { const int n = rho >> 4, i = rho & 15; return 8 * (i >> 2) + 4 * n + (i & 3); }
struct Unit { int pm, pn; };
DEV bool static_next(int nM, int nN, int G, int c, int i, Unit& u) {
    const int nwg = nM * nN; const long L = (long)i * G + c; if (L >= nwg) return false;
    int wgid = (int)L; { const int q = nwg / NXCD, r = nwg % NXCD, xcd = wgid % NXCD, off = wgid / NXCD; wgid = (xcd < r ? xcd * (q + 1) : r * (q + 1) + (xcd - r) * q) + off; }
    const int nig = WGM * nN, gid = wgid / nig, fm = gid * WGM, gsz = (nM - fm) < WGM ? (nM - fm) : WGM;
    u.pm = fm + ((wgid % nig) % gsz); u.pn = (wgid % nig) / gsz; return true;
}
template <class P, bool SP2 = true>
DEV void gemm_phase(LAS unsigned char* lds, const P& S, const int tid) {
    const int wid = RFL(tid >> 6), lane = tid & 63, wr = wid >> 2, wc = wid & 3, fr = lane & 15, fq = lane >> 4;
    const int K = S.K, nt = K * P::ES / (BK * 2);
    unsigned voffB[2]; int RA[2], CA2[2];
#pragma unroll
    for (int i = 0; i < 2; ++i) { int R, C; stage_rc(tid * 16 + i * 8192, R, C); const int Rb = P::PERM ? ((R & ~31) + perm32(R & 31)) : R;
        RA[i] = R; CA2[i] = C * 2; voffB[i] = (unsigned)(Rb * S.ldb) * (unsigned)P::ES + (unsigned)(C * 2); }
    const size_t kstep = (size_t)(BK * 2);
    const size_t hstepB = (size_t)HALF * S.ldb * P::ES;
    const unsigned ldsw = (unsigned)wid * 1024u;
    const int aoff = lds_byte(wr * 64 + fr, fq * 8), boff = lds_byte(wc * 32 + fr, fq * 8);
#define GE_SA(b, h) (((b) * 2 + (h)) * HTB)
#define GE_SB(b, h) ((4 + (b) * 2 + (h)) * HTB)
#define GE_STAGEB(bufoff, gbase) do { _Pragma("unroll") for (int _i = 0; _i < 2; ++_i) { unsigned _o = voffB[_i]; LAUNDER_V(_o); \
        GLDS16((const char*)(gbase) + _o, lds + (bufoff) + ldsw + _i * 8192); } } while (0)
#define GE_STAGEA(bufoff, gbase, h) do { _Pragma("unroll") for (int _i = 0; _i < 2; ++_i) { unsigned _o = oA[h][_i]; LAUNDER_V(_o); \
        GLDS16((const char*)(gbase) + _o, lds + (bufoff) + ldsw + _i * 8192); } } while (0)
#define GE_LD1(p_) __builtin_shufflevector(*(const LAS i32x4*)(p_), *(const LAS i32x4*)((p_) + 1024), 0, 1, 2, 3, 4, 5, 6, 7)
#define GE_LDA(dst, b, h) do { _Pragma("unroll") for (int m = 0; m < 4; ++m) dst[m] = GE_LD1(lds + GE_SA(b, h) + aoff + m * 2048); } while (0)
#define GE_LDB(dst, b, h) do { _Pragma("unroll") for (int n = 0; n < 2; ++n) dst[n] = GE_LD1(lds + GE_SB(b, h) + boff + n * 2048); } while (0)
#define GE_LO(x) __builtin_bit_cast(bf16x8, __builtin_shufflevector(x, x, 0, 1, 2, 3))
#define GE_HI(x) __builtin_bit_cast(bf16x8, __builtin_shufflevector(x, x, 4, 5, 6, 7))
#define GE_MMA(ai, bj, At, Bt) do { SETPRIO(1); _Pragma("unroll") for (int m = 0; m < 4; ++m) _Pragma("unroll") for (int n = 0; n < 2; ++n) { \
        if constexpr (P::FP8) acc[ai][bj][m][n] = MFMA8(Bt[n], At[m], acc[ai][bj][m][n]);     \
        else { acc[ai][bj][m][n] = MFMA16(GE_LO(Bt[n]), GE_LO(At[m]), acc[ai][bj][m][n]); acc[ai][bj][m][n] = MFMA16(GE_HI(Bt[n]), GE_HI(At[m]), acc[ai][bj][m][n]); } } SETPRIO(0); } while (0)
    Unit cur, nxt; int ui = 0;
    if (!S.next(0, cur)) return;
    f32x4 acc[2][2][4][2];
#pragma unroll
    for (int a = 0; a < 2; ++a)
#pragma unroll
        for (int b = 0; b < 2; ++b)
#pragma unroll
            for (int m = 0; m < 4; ++m)
#pragma unroll
                for (int n = 0; n < 2; ++n) acc[a][b][m][n] = (f32x4){0.f, 0.f, 0.f, 0.f};
    unsigned oA[2][2];
#pragma unroll
    for (int h = 0; h < 2; ++h)
#pragma unroll
        for (int i = 0; i < 2; ++i) {
            if constexpr (P::GATHER) oA[h][i] = (unsigned)S.gather_row(cur, h * HALF + RA[i]) * (unsigned)(S.lda * P::ES) + (unsigned)CA2[i];
            else oA[h][i] = (unsigned)((h * HALF + RA[i]) * S.lda) * (unsigned)P::ES + (unsigned)CA2[i];
            }
    const char* cA = S.a_base(cur); const char* cB = S.b_base(cur);
    if constexpr (SP2) {
        GE_STAGEB(GE_SB(0, 0), cB); GE_STAGEB(GE_SB(0, 1), cB + hstepB); GE_STAGEA(GE_SA(0, 0), cA, 0); GE_STAGEA(GE_SA(0, 1), cA, 1);
        if (wr == 1) SBAR();
        WAITV(2); SBAR();
        GE_STAGEB(GE_SB(1, 0), cB + kstep); GE_STAGEA(GE_SA(1, 0), cA + kstep, 0); GE_STAGEB(GE_SB(1, 1), cB + hstepB + kstep);
        WAITV(6); SBAR();
    } else {
    GE_STAGEB(GE_SB(0, 0), cB); GE_STAGEA(GE_SA(0, 0), cA, 0); GE_STAGEB(GE_SB(0, 1), cB + hstepB); GE_STAGEA(GE_SA(0, 1), cA, 1);
    if (wr == 1) SBAR();
    WAITV(4); SBAR();
    GE_STAGEB(GE_SB(1, 0), cB + kstep); GE_STAGEA(GE_SA(1, 0), cA + kstep, 0); GE_STAGEB(GE_SB(1, 1), cB + hstepB + kstep);
    WAITV(6); SBAR();
    }
    for (;;) {
        const bool has_next = S.next(ui + 1, nxt);
        const char* nA = has_next ? S.a_base(nxt) : cA; const char* nB = has_next ? S.b_base(nxt) : cB;
        for (int t = 0; t < nt; t += 2) {
            const bool last = (t == nt - 2);
            const char* a1 = cA + (size_t)(t + 1) * kstep;
            const char* a2 = last ? nA : cA + (size_t)(t + 2) * kstep; const char* b2 = last ? nB : cB + (size_t)(t + 2) * kstep;
            const char* a3 = a2 + kstep; const char* b3 = b2 + kstep;
            i32x8 At[4], B0[2], B1[2];
            if constexpr (SP2) {
            GE_LDB(B0, 0, 0); GE_LDB(B1, 0, 1); SCHED(); GE_LDA(At, 0, 0); GE_STAGEA(GE_SA(1, 1), a1, 1);
            WAITV(8); WAITL(0); SBAR(); GE_MMA(0, 0, At, B0); GE_MMA(0, 1, At, B1); SBAR(); SCHED();
            if constexpr (P::GATHER) { if (last && has_next) {
#pragma unroll
                for (int i = 0; i < 2; ++i) { int R2, C2; stage_rc(tid * 16 + i * 8192, R2, C2);
#pragma unroll
                    for (int h = 0; h < 2; ++h) oA[h][i] = (unsigned)S.gather_row(nxt, h * HALF + R2) * (unsigned)(S.lda * P::ES) + (unsigned)(C2 * 2); } } }
            GE_LDA(At, 0, 1); GE_STAGEB(GE_SB(0, 0), b2); GE_STAGEB(GE_SB(0, 1), b2 + hstepB); GE_STAGEA(GE_SA(0, 0), a2, 0);
            WAITV(8); WAITL(0); SBAR(); GE_MMA(1, 0, At, B0); GE_MMA(1, 1, At, B1); SBAR(); SCHED();
            GE_LDB(B0, 1, 0); GE_LDB(B1, 1, 1); SCHED(); GE_LDA(At, 1, 0); GE_STAGEA(GE_SA(0, 1), a2, 1);
            WAITV(8); WAITL(0); SBAR(); GE_MMA(0, 0, At, B0); GE_MMA(0, 1, At, B1); SBAR(); SCHED();
            GE_LDA(At, 1, 1); GE_STAGEB(GE_SB(1, 0), b3); GE_STAGEB(GE_SB(1, 1), b3 + hstepB); GE_STAGEA(GE_SA(1, 0), a3, 0);
            WAITV(8); WAITL(0); SBAR(); GE_MMA(1, 0, At, B0); GE_MMA(1, 1, At, B1); SBAR(); SCHED();
            } else {
            GE_LDB(B0, 0, 0); SCHED(); GE_LDA(At, 0, 0); GE_STAGEA(GE_SA(1, 1), a1, 1);
            WAITL(8); SBAR(); WAITL(0); GE_MMA(0, 0, At, B0); SBAR(); SCHED();
            if constexpr (P::GATHER) { if (last && has_next) {
#pragma unroll
                for (int i = 0; i < 2; ++i) { int R2, C2; stage_rc(tid * 16 + i * 8192, R2, C2);
#pragma unroll
                    for (int h = 0; h < 2; ++h) oA[h][i] = (unsigned)S.gather_row(nxt, h * HALF + R2) * (unsigned)(S.lda * P::ES) + (unsigned)(C2 * 2); } } }
            GE_LDB(B1, 0, 1); GE_STAGEB(GE_SB(0, 0), b2);
            SBAR(); WAITL(0); GE_MMA(0, 1, At, B1); SBAR();
            GE_LDA(At, 0, 1); GE_STAGEA(GE_SA(0, 0), a2, 0);
            SBAR(); WAITL(0); GE_MMA(1, 0, At, B0); SBAR(); SCHED();
            GE_STAGEB(GE_SB(0, 1), b2 + hstepB);
            WAITV(6); SBAR(); GE_MMA(1, 1, At, B1); SBAR();
            GE_LDB(B0, 1, 0); SCHED(); GE_LDA(At, 1, 0); GE_STAGEA(GE_SA(0, 1), a2, 1);
            WAITL(8); SBAR(); WAITL(0); GE_MMA(0, 0, At, B0); SBAR(); SCHED();
            GE_LDB(B1, 1, 1); GE_STAGEB(GE_SB(1, 0), b3);
            SBAR(); WAITL(0); GE_MMA(0, 1, At, B1); SBAR();
            GE_LDA(At, 1, 1); GE_STAGEA(GE_SA(1, 0), a3, 0);
            SBAR(); WAITL(0); GE_MMA(1, 0, At, B0); SBAR(); SCHED();
            GE_STAGEB(GE_SB(1, 1), b3 + hstepB);
            WAITV(6); SBAR(); GE_MMA(1, 1, At, B1); SBAR();
            }
        }
        if (wr == 0) SBAR();
        S.epi(acc, cur, wr, wc, fr, fq);
        if (!has_next) break;
#pragma unroll
        for (int a = 0; a < 2; ++a)
#pragma unroll
            for (int b = 0; b < 2; ++b)
#pragma unroll
                for (int m = 0; m < 4; ++m)
#pragma unroll
                    for (int n = 0; n < 2; ++n) acc[a][b][m][n] = (f32x4){0.f, 0.f, 0.f, 0.f};
        cur = nxt; cA = nA; cB = nB; ++ui;
        if (wr == 1) SBAR();
    }
    WAITV(0);
    SBAR();
#undef GE_SA
#undef GE_SB
#undef GE_STAGEA
#undef GE_STAGEB
#undef GE_LDA
#undef GE_LDB
#undef GE_MMA
#undef GE_LO
#undef GE_HI
#undef GE_LD1
}
}
using ge::Unit;

struct Params {
    const float* in[26];
    float* out; unsigned char* ws;
    int ph_lo, ph_hi;
};
enum { I_X = 0, I_C, I_CTX, I_CCTX, I_ADAW, I_ADAB, I_NMIX, I_NFFN, I_POOLW, I_POOLS, I_INW, I_CONVW, I_CONVB, I_ALOG, I_DTB, I_DSKIP, I_SNORM, I_OUTW,
       I_W1, I_W3, I_W2, I_RW, I_MW1, I_MW3, I_MW2, I_FNORM };

struct Frame {
    LAS unsigned char* lds;
    int tid, lane, wave, G, bx;
    const Params* p;
    unsigned char* ws;
    unsigned* ctl;
    float* H; float* mod;
};
#ifdef EMU
DEV const float* INP(const Frame& F, int i) { return F.p->in[i]; }
DEV float* OUTP(const Frame& F) { return F.p->out; }
DEV unsigned char* WSP(const Frame& F) { return F.p->ws; }
#define LAUNDER_S(x) ((void)0)
#else
typedef const float* cfptr_t;
DEV const float* INP(const Frame&, int i) { int k = i; asm volatile("" : "+s"(k)); return ((const __attribute__((address_space(4))) cfptr_t*)__builtin_amdgcn_kernarg_segment_ptr())[k]; }
DEV float* OUTP(const Frame& F) { return (float*)INP(F, 26); }
DEV unsigned char* WSP(const Frame& F) { return (unsigned char*)INP(F, 27); }
#define LAUNDER_S(x) asm volatile("" : "+s"(x))
#endif
constexpr int LDS_MISC = ge::STAGE_BYTES;
constexpr int LDS_BYTES = ge::STAGE_BYTES + 16384;

struct Src { const float* x; const float* ctx; float* H; const float* mod; };
DEV const float* modq(const float* mod, int layer, int vec, int which) { return mod + ((size_t)(layer * 3 + vec) * 6 + which) * D; }
DEV const float* modp(const Frame& F, int layer, int vec, int which) { return modq(F.mod, layer, vec, which); }
DEV const float* hsrc_row(const Src& s, bool from_input, int r) {
    if (from_input) return r < ML ? s.x + (size_t)r * D : s.ctx + (size_t)(r - ML) * D;
    return s.H + (size_t)r * D;
}
DEV Src mksrc(const Frame& F) { Src s; s.x = INP(F, I_X); s.ctx = INP(F, I_CTX); s.H = F.H; s.mod = F.mod; return s; }
DEV const float* hin_row(const Frame& F, int layer, int r) { return hsrc_row(mksrc(F), layer == 0, r); }

template <int K, int N, class RM>
DEV void transpose_item(const float* Wsrc, bf16_t* WT, int ldt, RM rowmap, LAS float* scr, int item, int lane) {
    constexpr int nblk = N / 32; const int kb = item / nblk, nb = item % nblk, k0 = 64 * kb, n0 = 32 * nb;
    float tmp[32];
#pragma unroll
    for (int i = 0; i < 32; ++i) { const int kk = 2 * i + (lane >> 5); tmp[i] = Wsrc[(size_t)(k0 + kk) * N + n0 + (lane & 31)]; }
#pragma unroll
    for (int i = 0; i < 32; ++i) { const int kk = 2 * i + (lane >> 5); scr[kk * 33 + (lane & 31)] = tmp[i]; }
    WSYNC();
    const int c = lane & 7; const int row0 = rowmap(n0);
#pragma unroll
    for (int j = 0; j < 4; ++j) { const int n = (lane >> 3) + 8 * j; const LAS float* s = scr + (8 * c) * 33 + n;
        u32x4 o; o.x = pk2(s[0 * 33], s[1 * 33]); o.y = pk2(s[2 * 33], s[3 * 33]); o.z = pk2(s[4 * 33], s[5 * 33]); o.w = pk2(s[6 * 33], s[7 * 33]);
        *(u32x4*)(WT + (size_t)(row0 + n) * ldt + k0 + 8 * c) = o; }
    WSYNC();
}
template <int K, int N, class RM>
DEV void transpose_item_fp8(const float* Wsrc, fp8_t* WT, int ldt, RM rowmap, float scale, LAS float* scr, int item, int lane) {
    constexpr int nblk = N / 32; const int kb = item / nblk, nb = item % nblk, k0 = 64 * kb, n0 = 32 * nb;
    float tmp[32];
#pragma unroll
    for (int i = 0; i < 32; ++i) { const int kk = 2 * i + (lane >> 5); tmp[i] = Wsrc[(size_t)(k0 + kk) * N + n0 + (lane & 31)]; }
#pragma unroll
    for (int i = 0; i < 32; ++i) { const int kk = 2 * i + (lane >> 5); scr[kk * 33 + (lane & 31)] = tmp[i] * scale; }
    WSYNC();
    const int c = lane & 7; const int row0 = rowmap(n0);
#pragma unroll
    for (int j = 0; j < 4; ++j) { const int n = (lane >> 3) + 8 * j; const LAS float* s = scr + (8 * c) * 33 + n;
        u32x2 o; o.x = pk4_fp8(s[0 * 33], s[1 * 33], s[2 * 33], s[3 * 33]); o.y = pk4_fp8(s[4 * 33], s[5 * 33], s[6 * 33], s[7 * 33]);
        *(u32x2*)(WT + (size_t)(row0 + n) * ldt + k0 + 8 * c) = o; }
    WSYNC();
}
template <int K, int N, class RM>
DEV void convert_job_fp8(const Frame& F, const float* Wsrc, fp8_t* WT, int ldt, RM rm, float scale) {
    LAS float* scr = (LAS float*)(F.lds + F.wave * 16384);
    constexpr int items = (K / 64) * (N / 32); const int gw = F.bx * 8 + F.wave, NGW = F.G * 8;
    for (int it = gw; it < items; it += NGW) transpose_item_fp8<K, N>(Wsrc, WT, ldt, rm, scale, scr, it, F.lane);
}
struct RmId { DEV int operator()(int n0) const { return n0; } };
struct RmIlv { int s; DEV int operator()(int n0) const { return (n0 >> 7) * 256 + s * 128 + (n0 & 127); } };
template <int K, int N, class RM>
DEV void convert_job(const Frame& F, const float* Wsrc, bf16_t* WT, int ldt, RM rm) {
    LAS float* scr = (LAS float*)(F.lds + F.wave * 16384);
    constexpr int items = (K / 64) * (N / 32); const int gw = F.bx * 8 + F.wave, NGW = F.G * 8;
    for (int it = gw; it < items; it += NGW) transpose_item<K, N>(Wsrc, WT, ldt, rm, scr, it, F.lane);
}
DEV void convert_even(const Frame& F, int j) {
    bf16_t* Wb = (bf16_t*)(F.ws + OFF_W);
    for (int g = 0; g < 4; ++g) convert_job<256, 256>(F, INP(F, I_POOLW) + ((size_t)j * 4 + g) * 65536, Wb + W_POOL / 2 + (size_t)g * 65536, 256, RmId{});
    convert_job<D, DFF>(F, INP(F, I_W1) + (size_t)j * D * DFF, Wb + W_UP / 2, D, RmIlv{0});
    convert_job<D, DFF>(F, INP(F, I_W3) + (size_t)j * D * DFF, Wb + W_UP / 2, D, RmIlv{1});
    convert_job<DFF, D>(F, INP(F, I_W2) + (size_t)j * DFF * D, Wb + W_DN / 2, DFF, RmId{});
}
DEV void convert_ssd(const Frame& F, int j) {
    bf16_t* Wb = (bf16_t*)(F.ws + OFF_W);
    convert_job<D, NPROJ>(F, INP(F, I_INW) + (size_t)j * D * NPROJ, Wb + W_IN / 2, D, RmId{});
    convert_job<DIN, D>(F, INP(F, I_OUTW) + (size_t)j * DIN * D, Wb + W_OUT / 2, DIN, RmId{});
    { u32x4* z = (u32x4*)(Wb + W_IN / 2 + (size_t)NPROJ * D); const int n16 = (NPROJP - NPROJ) * D * 2 / 16;
      unsigned zz = 0u; LAUNDER_V(zz);
      for (int i = F.bx * 512 + F.tid; i < n16; i += F.G * 512) z[i] = (u32x4){zz, zz, zz, zz}; }
}
DEV void convert_moe(const Frame& F, int j) {
    fp8_t* Wb = (fp8_t*)(F.ws + OFF_W);
    for (int e = 0; e < NEXP; ++e) {
        convert_job_fp8<D, DFFE>(F, INP(F, I_MW1) + ((size_t)j * NEXP + e) * D * DFFE, Wb + W_MUP + (size_t)e * 2 * DFFE * D, D, RmIlv{0}, 32.0f);
        convert_job_fp8<D, DFFE>(F, INP(F, I_MW3) + ((size_t)j * NEXP + e) * D * DFFE, Wb + W_MUP + (size_t)e * 2 * DFFE * D, D, RmIlv{1}, 32.0f);
        if (MOE_DOWN_FP8) convert_job_fp8<DFFE, D>(F, INP(F, I_MW2) + ((size_t)j * NEXP + e) * DFFE * D, Wb + W_MDN + (size_t)e * D * DFFE, DFFE, RmId{}, 64.0f);
        else convert_job<DFFE, D>(F, INP(F, I_MW2) + ((size_t)j * NEXP + e) * DFFE * D, (bf16_t*)(Wb + W_MDN) + (size_t)e * D * DFFE, DFFE, RmId{});
    }
}

DEV void phase_mod(const Frame& F) {
    LAS float* red = (LAS float*)F.lds;
    LAS float* sc = (LAS float*)(F.lds + 8192);
    constexpr int nblk = DEPTH * 6144 / 32;
    const int col = F.tid & 31, ks = F.tid >> 5;
    for (int i = F.tid; i < 3 * D; i += 512) { const int v = i >> 10, k = i & (D - 1); sc[i] = siluf(v == 2 ? INP(F, I_CCTX)[k] : INP(F, I_C)[v * D + k]); }
    __syncthreads();
    for (int blk = F.bx; blk < nblk; blk += F.G) {
        const int layer = (blk * 32) / 6144, n = (blk * 32) % 6144 + col;
        const float* W = INP(F, I_ADAW) + (size_t)layer * D * 6144 + n;
        float a0 = 0.f, a1 = 0.f, a2 = 0.f;
#pragma unroll 1
        for (int kb = ks * 64; kb < ks * 64 + 64; kb += 16) {
            float wv[16];
#pragma unroll
            for (int k = 0; k < 16; ++k) wv[k] = W[(size_t)(kb + k) * 6144];
#pragma unroll
            for (int k = 0; k < 16; ++k) { a0 += sc[kb + k] * wv[k]; a1 += sc[D + kb + k] * wv[k]; a2 += sc[2 * D + kb + k] * wv[k]; } }
        red[(ks * 32 + col) * 3 + 0] = a0; red[(ks * 32 + col) * 3 + 1] = a1; red[(ks * 32 + col) * 3 + 2] = a2;
        __syncthreads();
        if (F.tid < 96) { const int c2 = F.tid & 31, v = F.tid >> 5; float s = 0.f;
            for (int q = 0; q < 16; ++q) s += red[(q * 32 + c2) * 3 + v];
            const int n2 = (blk * 32) % 6144 + c2;
            F.mod[(size_t)(layer * 3 + v) * 6144 + n2] = s + INP(F, I_ADAB)[(size_t)layer * 6144 + n2]; }
        __syncthreads();
    }
}

DEV void load_row(const float* p, int lane, f32x4 (&v)[4]) {
#pragma unroll
    for (int j = 0; j < 4; ++j) v[j] = *(const f32x4*)(p + 4 * lane + 256 * j);
}
DEV float sumsq_row(const f32x4 (&v)[4]) { float s = 0.f;
#pragma unroll
    for (int j = 0; j < 4; ++j) s += (v[j][0] * v[j][0] + v[j][1] * v[j][1]) + (v[j][2] * v[j][2] + v[j][3] * v[j][3]);
    return wave_sum(s); }
DEV void normmod_row(f32x4 (&v)[4], float rstd, const float* w, const float* sh, const float* sc, int lane) {
#pragma unroll
    for (int j = 0; j < 4; ++j) { const int c = 4 * lane + 256 * j; const f32x4 wv = *(const f32x4*)(w + c), sv = *(const f32x4*)(sh + c), cv = *(const f32x4*)(sc + c);
        v[j] = v[j] * rstd * wv * (cv + 1.0f) + sv; }
}
DEV void store_row_bf16(bf16_t* o, int lane, const f32x4 (&v)[4]) {
#pragma unroll
    for (int j = 0; j < 4; ++j) { u32x2 w; w.x = pk2(v[j][0], v[j][1]); w.y = pk2(v[j][2], v[j][3]); *(u32x2*)(o + 4 * lane + 256 * j) = w; }
}

DEV void phase_norm(const Frame& F, int layer, int which, bf16_t* out, bool from_input) {
    const int gw = F.bx * 8 + F.wave, NGW = F.G * 8;
    const float* w = INP(F, which == 0 ? I_NMIX : I_NFFN) + (size_t)layer * D;
    f32x4 nx[4];
    if (gw < MT) load_row(hsrc_row(mksrc(F), from_input, gw), F.lane, nx);
    for (int r = gw; r < MT; r += NGW) {
        f32x4 v[4];
#pragma unroll
        for (int q = 0; q < 4; ++q) v[q] = nx[q];
        if (r + NGW < MT) load_row(hsrc_row(mksrc(F), from_input, r + NGW), F.lane, nx);
        const float rstd = rsqrtf(sumsq_row(v) * (1.0f / D) + EPS);
        const int vec = vec_of(r);
        normmod_row(v, rstd, w, modp(F, layer, vec, which), modp(F, layer, vec, which + 1), F.lane);
        store_row_bf16(out + (size_t)r * D, F.lane, v);
    }
}

DEV void phase_poolprep(const Frame& F, int layer, bf16_t* P) {
    LAS bf16_t* ub = (LAS bf16_t*)(F.lds);
    LAS float* rs = (LAS float*)(F.lds + 81920);
    const float* w = INP(F, I_NMIX) + (size_t)layer * D;
    const int ntile = MT / 64;
    const int chunk = F.tid & 127, tg = F.tid >> 7;
    for (int tile = F.bx; tile < ntile; tile += F.G) {
        const int r0 = tile * 64;
        int seq0, seq1;
        if (r0 < ML) { seq0 = r0; seq1 = r0 + 64; } else { seq0 = ML + ((r0 - ML) / CTXL) * CTXL; seq1 = seq0 + CTXL; }
        const int lo_r = (r0 - 8 > seq0) ? r0 - 8 : seq0, hi_r = (r0 + 64 + 7 < seq1) ? r0 + 64 + 7 : seq1;
        const int nrow = hi_r - lo_r;
        for (int rb = lo_r + F.wave; rb < hi_r; rb += 40) {
            f32x4 v5[5][4];
#pragma unroll
            for (int k = 0; k < 5; ++k) { const int r = rb + 8 * k; if (r < hi_r) load_row(hin_row(F, layer, r), F.lane, v5[k]); }
#pragma unroll
            for (int k = 0; k < 5; ++k) { const int r = rb + 8 * k; if (r < hi_r) { const float ss = sumsq_row(v5[k]); if (F.lane == 0) rs[r - lo_r] = rsqrtf(ss * (1.0f / D) + EPS); } } }
        __syncthreads();
        const int vec = vec_of(r0);
#pragma unroll 1
        for (int half = 0; half < 2; ++half) {
            const int c = half * 512 + 4 * chunk, g = c >> 8, win = 2 << g, lo = win >> 1, hi = win - 1 - lo;
            const f32x4 wv = *(const f32x4*)(w + c), sv = *(const f32x4*)(modp(F, layer, vec, 0) + c), cv = *(const f32x4*)(modp(F, layer, vec, 1) + c) + 1.0f;
            const f32x4 wc = wv * cv;
#pragma unroll 1
            for (int kb = 0; kb < 20; kb += 10) {
                f32x4 hv[10];
#pragma unroll
                for (int k = 0; k < 10; ++k) { const int rr = tg + 4 * (kb + k); if (rr < nrow) hv[k] = *(const f32x4*)(hin_row(F, layer, lo_r + rr) + c); }
#pragma unroll
                for (int k = 0; k < 10; ++k) { const int rr = tg + 4 * (kb + k); if (rr < nrow) { const f32x4 u = hv[k] * rs[rr] * wc + sv;
                    u32x2 pw; pw.x = pk2(u[0], u[1]); pw.y = pk2(u[2], u[3]); *(LAS u32x2*)(ub + rr * 512 + 4 * chunk) = pw; } } }
            __syncthreads();
#define PP_U(r_) ({ const u32x2 _q = *(const LAS u32x2*)(ub + ((r_) - lo_r) * 512 + 4 * chunk); (f32x4){bflo(_q.x), bfhi(_q.x), bflo(_q.y), bfhi(_q.y)}; })
            const int ta = r0 + 16 * tg;
            f32x4 s = (f32x4){0.f, 0.f, 0.f, 0.f};
            { const int a = (ta - lo > seq0) ? ta - lo : seq0, b = (ta + hi + 1 < seq1) ? ta + hi + 1 : seq1; for (int r = a; r < b; ++r) s += PP_U(r); }
            for (int t = ta; t < ta + 16; ++t) {
                const int a = (t - lo > seq0) ? t - lo : seq0, b = (t + hi + 1 < seq1) ? t + hi + 1 : seq1;
                const float inv = 1.0f / (float)(b - a);
                const f32x4 o = s * inv - PP_U(t);
                u32x2 pw; pw.x = pk2(o[0], o[1]); pw.y = pk2(o[2], o[3]); *(u32x2*)(P + (size_t)t * D + c) = pw;
                if (t + 1 < ta + 16) {
                    if (t + 1 + hi < seq1) s += PP_U(t + 1 + hi);
                    if (t - lo >= seq0) s -= PP_U(t - lo); }
            }
#undef PP_U
            __syncthreads();
        }
    }
}

struct PolBase { int G, c; };
struct PolPool : PolBase {
    static constexpr bool PERM = false, GATHER = false; static constexpr bool FP8 = false; static constexpr int ES = 2; int K, lda, ldb;
    const bf16_t* P; const bf16_t* W; Src src; int layer; const float* scale;
    DEV bool next(int i, Unit& u) const { return ge::static_next(NPAN, 4, G, c, i, u); }
    DEV const char* a_base(const Unit& u) const { return (const char*)(P + (size_t)u.pm * 256 * D + u.pn * 256); }
    DEV const char* b_base(const Unit& u) const { return (const char*)(W + (size_t)u.pn * 65536); }
    DEV void epi(const f32x4 (&acc)[2][2][4][2], const Unit& u, int wr, int wc, int fr, int fq) const {
        const int row0 = u.pm * 256 + wr * 64 + fr, col0 = u.pn * 256 + wc * 32 + 4 * fq; const int vec = vec_of(u.pm * 256);
        const float* g1 = modq(src.mod, layer, vec, 2);
        f32x4 gv[2][2];
#pragma unroll
        for (int bj = 0; bj < 2; ++bj)
#pragma unroll
            for (int n = 0; n < 2; ++n) { const int cc = col0 + bj * 128 + n * 16; gv[bj][n] = *(const f32x4*)(g1 + cc) * *(const f32x4*)(scale + cc); }
#pragma unroll
        for (int ai = 0; ai < 2; ++ai)
#pragma unroll
            for (int m = 0; m < 4; ++m) { const int r = row0 + ai * 128 + m * 16; const float* hi = hsrc_row(src, layer == 0, r) + col0; float* ho = src.H + (size_t)r * D + col0;
#pragma unroll
                for (int bj = 0; bj < 2; ++bj)
#pragma unroll
                    for (int n = 0; n < 2; ++n) *(f32x4*)(ho + bj * 128 + n * 16) = *(const f32x4*)(hi + bj * 128 + n * 16) + gv[bj][n] * acc[ai][bj][m][n]; }
    }
};
struct PolResid : PolBase {
    static constexpr bool PERM = false, GATHER = false; static constexpr bool FP8 = false; static constexpr int ES = 2; int K, lda, ldb;
    const bf16_t* A; const bf16_t* W; Src src; int layer, which, npan;
    DEV bool next(int i, Unit& u) const { return ge::static_next(npan, 4, G, c, i, u); }
    DEV const char* a_base(const Unit& u) const { return (const char*)(A + (size_t)u.pm * 256 * lda); }
    DEV const char* b_base(const Unit& u) const { return (const char*)(W + (size_t)u.pn * 256 * ldb); }
    DEV void epi(const f32x4 (&acc)[2][2][4][2], const Unit& u, int wr, int wc, int fr, int fq) const {
        const int row0 = u.pm * 256 + wr * 64 + fr, col0 = u.pn * 256 + wc * 32 + 4 * fq; const int vec = vec_of(u.pm * 256);
        const float* gp = modq(src.mod, layer, vec, which);
        f32x4 gv[2][2];
#pragma unroll
        for (int bj = 0; bj < 2; ++bj)
#pragma unroll
            for (int n = 0; n < 2; ++n) gv[bj][n] = *(const f32x4*)(gp + col0 + bj * 128 + n * 16);
#pragma unroll
        for (int ai = 0; ai < 2; ++ai)
#pragma unroll
            for (int mp = 0; mp < 4; mp += 2) { f32x4 hv[2][2][2];
#pragma unroll
                for (int m2 = 0; m2 < 2; ++m2) { const float* hi = src.H + (size_t)(row0 + ai * 128 + (mp + m2) * 16) * D + col0;
#pragma unroll
                    for (int bj = 0; bj < 2; ++bj)
#pragma unroll
                        for (int n = 0; n < 2; ++n) hv[m2][bj][n] = *(const f32x4*)(hi + bj * 128 + n * 16); }
#pragma unroll
                for (int m2 = 0; m2 < 2; ++m2) { float* ho = src.H + (size_t)(row0 + ai * 128 + (mp + m2) * 16) * D + col0;
#pragma unroll
                    for (int bj = 0; bj < 2; ++bj)
#pragma unroll
                        for (int n = 0; n < 2; ++n) *(f32x4*)(ho + bj * 128 + n * 16) = hv[m2][bj][n] + gv[bj][n] * acc[ai][bj][mp + m2][n]; } }
    }
};
template <bool MOE>
struct PolUp : PolBase {
    static constexpr bool PERM = true, GATHER = MOE, FP8 = MOE; static constexpr int ES = MOE ? 1 : 2; int K, lda, ldb;
    const bf16_t* A; const bf16_t* W; bf16_t* HID; int ldh, nq;
    int nM; const int* s2t; int tstart[NEXP + 1];
    DEV bool next(int i, Unit& u) const { return ge::static_next(MOE ? nM : NPAN, nq, G, c, i, u); }
    DEV int expert_of(int pm) const { int e = 0;
#pragma unroll
        for (int k = 1; k < NEXP; ++k) e += (pm >= tstart[k]) ? 1 : 0;
        return e; }
    DEV const char* a_base(const Unit& u) const { return MOE ? (const char*)A : (const char*)(A + (size_t)u.pm * 256 * lda); }
    DEV const char* b_base(const Unit& u) const { size_t off = (size_t)u.pn * 256 * ldb; if (MOE) off += (size_t)expert_of(u.pm) * 2 * DFFE * ldb; return (const char*)W + off * ES; }
    DEV int gather_row(const Unit& u, int R) const { return s2t[u.pm * 256 + R]; }
    DEV void epi(const f32x4 (&acc)[2][2][4][2], const Unit& u, int wr, int wc, int fr, int fq) const {
        const int row0 = u.pm * 256 + wr * 64 + fr, col0 = u.pn * 128 + wc * 32 + 8 * fq;
#pragma unroll
        for (int ai = 0; ai < 2; ++ai)
#pragma unroll
            for (int m = 0; m < 4; ++m) { bf16_t* o = HID + (size_t)(row0 + ai * 128 + m * 16) * ldh + col0;
                float h[8];
#pragma unroll
                for (int n = 0; n < 2; ++n)
#pragma unroll
                    for (int i = 0; i < 4; ++i) { if (MOE) h[4 * n + i] = siluf(acc[ai][0][m][n][i] * 0.00390625f) * (acc[ai][1][m][n][i] * (MOE_DOWN_FP8 ? 0.015625f : 0.00390625f));
                                                  else h[4 * n + i] = siluf(acc[ai][0][m][n][i]) * acc[ai][1][m][n][i]; }
                if (MOE && MOE_DOWN_FP8) { u32x2 w8; w8.x = pk4_fp8(h[0], h[1], h[2], h[3]); w8.y = pk4_fp8(h[4], h[5], h[6], h[7]);
                    *(u32x2*)((fp8_t*)HID + (size_t)(row0 + ai * 128 + m * 16) * ldh + col0) = w8; }
                else { u32x4 w; w.x = pk2(h[0], h[1]); w.y = pk2(h[2], h[3]); w.z = pk2(h[4], h[5]); w.w = pk2(h[6], h[7]); *(u32x4*)o = w; } }
    }
};
struct PolMoeDown : PolBase {
    static constexpr bool PERM = true, GATHER = (MOE_DOWN_FP8 != 0), FP8 = (MOE_DOWN_FP8 != 0); static constexpr int ES = MOE_DOWN_FP8 ? 1 : 2; int K, lda, ldb;
    const bf16_t* A; const bf16_t* W; bf16_t* YS; int nM; int tstart[NEXP + 1];
    DEV bool next(int i, Unit& u) const { return ge::static_next(nM, 4, G, c, i, u); }
    DEV int expert_of(int pm) const { int e = 0;
#pragma unroll
        for (int k = 1; k < NEXP; ++k) e += (pm >= tstart[k]) ? 1 : 0;
        return e; }
    DEV const char* a_base(const Unit& u) const { return GATHER ? (const char*)A : (const char*)A + (size_t)u.pm * 256 * lda * ES; }
    DEV int gather_row(const Unit& u, int R) const { return u.pm * 256 + R; }
    DEV const char* b_base(const Unit& u) const { return (const char*)W + ((size_t)expert_of(u.pm) * D + (size_t)u.pn * 256) * ldb * ES; }
    DEV void epi(const f32x4 (&acc)[2][2][4][2], const Unit& u, int wr, int wc, int fr, int fq) const {
        const int row0 = u.pm * 256 + wr * 64 + fr, col0 = u.pn * 256 + wc * 32 + 8 * fq;
#pragma unroll
        for (int ai = 0; ai < 2; ++ai)
#pragma unroll
            for (int m = 0; m < 4; ++m) { bf16_t* o = YS + (size_t)(row0 + ai * 128 + m * 16) * D + col0;
#pragma unroll
                for (int bj = 0; bj < 2; ++bj) { u32x4 w; w.x = pk2(acc[ai][bj][m][0][0], acc[ai][bj][m][0][1]); w.y = pk2(acc[ai][bj][m][0][2], acc[ai][bj][m][0][3]);
                    w.z = pk2(acc[ai][bj][m][1][0], acc[ai][bj][m][1][1]); w.w = pk2(acc[ai][bj][m][1][2], acc[ai][bj][m][1][3]); *(u32x4*)(o + bj * 128) = w; } }
    }
};
struct PolInProj : PolBase {
    static constexpr bool PERM = true, GATHER = false; static constexpr bool FP8 = false; static constexpr int ES = 2; int K, lda, ldb;
    const bf16_t* A; const bf16_t* W; bf16_t* Z; bf16_t* XBC; float* DT;
    DEV bool next(int i, Unit& u) const { return ge::static_next(NPAN, NPROJP / 256, G, c, i, u); }
    DEV const char* a_base(const Unit& u) const { return (const char*)(A + (size_t)u.pm * 256 * lda); }
    DEV const char* b_base(const Unit& u) const { return (const char*)(W + (size_t)u.pn * 256 * ldb); }
    DEV void epi(const f32x4 (&acc)[2][2][4][2], const Unit& u, int wr, int wc, int fr, int fq) const {
        const int row0 = u.pm * 256 + wr * 64 + fr, cw = wc * 32 + 8 * fq;
        if (u.pn < 20) {
            bf16_t* base; int ld, col0;
            if (u.pn < 8) { base = Z; ld = DIN; col0 = u.pn * 256 + cw; } else { base = XBC; ld = CONVD; col0 = (u.pn - 8) * 256 + cw; }
#pragma unroll
            for (int ai = 0; ai < 2; ++ai)
#pragma unroll
                for (int m = 0; m < 4; ++m) { bf16_t* o = base + (size_t)(row0 + ai * 128 + m * 16) * ld + col0;
#pragma unroll
                    for (int bj = 0; bj < 2; ++bj) { u32x4 w; w.x = pk2(acc[ai][bj][m][0][0], acc[ai][bj][m][0][1]); w.y = pk2(acc[ai][bj][m][0][2], acc[ai][bj][m][0][3]);
                        w.z = pk2(acc[ai][bj][m][1][0], acc[ai][bj][m][1][1]); w.w = pk2(acc[ai][bj][m][1][2], acc[ai][bj][m][1][3]); *(u32x4*)(o + bj * 128) = w; } }
        } else if (cw < 64) {
#pragma unroll
            for (int ai = 0; ai < 2; ++ai)
#pragma unroll
                for (int m = 0; m < 4; ++m) { const int r = row0 + ai * 128 + m * 16; int b, tv;
                    if (r < ML) { b = r / SEQ; tv = CTXL + r % SEQ; } else { b = (r - ML) / CTXL; tv = (r - ML) % CTXL; }
#pragma unroll
                    for (int n = 0; n < 2; ++n)
#pragma unroll
                        for (int i = 0; i < 4; ++i) { const int j = cw + 4 * n + i, dir = j >> 5, h = j & 31;
                            DT[((size_t)(b * 2 + dir) * NH + h) * TV + tv] = acc[ai][0][m][n][i]; } }
        }
    }
};

DEV void phase_conv(const Frame& F, int j, const bf16_t* XBC, bf16_t* XT, bf16_t* Brow, bf16_t* BT, bf16_t* Crow) {
    LAS bf16_t* tl0 = (LAS bf16_t*)F.lds;
    const float* cw = INP(F, I_CONVW) + (size_t)j * 4 * CONVD; const float* cb = INP(F, I_CONVB) + (size_t)j * CONVD;
    constexpr int NPER = NB * NCH, nitem = NPER * (CONVD / 64);
    const int t2 = 2 * (F.tid >> 3), cg = F.tid & 7;
    const int i0 = (int)(((long)F.bx * nitem) / F.G), i1 = (int)(((long)(F.bx + 1) * nitem) / F.G);
    int cblk_cur = -1; f32x4 wv[4][2], bv[2]; int par = 0;
#define CV_LOAD(it_, q_) do { const int _cb = (it_) / NPER, _rs = (it_) % NPER, _b = _rs / NCH, _cv = _rs % NCH; const int _ch = _cb * 64 + cg * 8, _tv = _cv * 128 + t2; \
        const int _s0 = _tv < CTXL ? 0 : CTXL, _s1 = _tv < CTXL ? CTXL : TV; \
        _Pragma("unroll") for (int k = 0; k < 5; ++k) { const int tk = _tv - 2 + k; q_[k] = (u32x4){0u, 0u, 0u, 0u}; \
            if (tk >= _s0 && tk < _s1) q_[k] = *(const u32x4*)(XBC + (size_t)row_of(_b, tk) * CONVD + _ch); } } while (0)
    u32x4 qn[5];
    if (i0 < i1) CV_LOAD(i0, qn);
    for (int it = i0; it < i1; ++it) {
        const int cblk = it / NPER, rest = it % NPER, b = rest / NCH, cv = rest % NCH;
        const int ch0 = cblk * 64 + cg * 8;
        if (cblk != cblk_cur) { cblk_cur = cblk;
#pragma unroll
            for (int k = 0; k < 4; ++k) { wv[k][0] = *(const f32x4*)(cw + k * CONVD + ch0); wv[k][1] = *(const f32x4*)(cw + k * CONVD + ch0 + 4); }
            bv[0] = *(const f32x4*)(cb + ch0); bv[1] = *(const f32x4*)(cb + ch0 + 4); }
        const int tv = cv * 128 + t2;
        float xin[5][8];
#pragma unroll
        for (int k = 0; k < 5; ++k) { const u32x4 q = qn[k];
            xin[k][0] = bflo(q.x); xin[k][1] = bfhi(q.x); xin[k][2] = bflo(q.y); xin[k][3] = bfhi(q.y); xin[k][4] = bflo(q.z); xin[k][5] = bfhi(q.z); xin[k][6] = bflo(q.w); xin[k][7] = bfhi(q.w); }
        if (it + 1 < i1) CV_LOAD(it + 1, qn);
        unsigned pk[2][4];
#pragma unroll
        for (int o = 0; o < 2; ++o) { float a[8];
#pragma unroll
            for (int i = 0; i < 8; ++i) { float acc = bv[i >> 2][i & 3];
#pragma unroll
                for (int k = 0; k < 4; ++k) acc += wv[k][i >> 2][i & 3] * xin[o + k][i];
                a[i] = siluf(acc); }
#pragma unroll
            for (int i = 0; i < 4; ++i) pk[o][i] = pk2(a[2 * i], a[2 * i + 1]); }
        const int r = row_of(b, tv);
        const bool isx = cblk < DIN / 64, isb = !isx && cblk < (DIN + BCD) / 64;
        if (!isx) { bf16_t* o = (isb ? Brow + (ch0 - DIN) : Crow + (ch0 - DIN - BCD)) + (size_t)r * BCD;
            *(u32x4*)o = (u32x4){pk[0][0], pk[0][1], pk[0][2], pk[0][3]}; *(u32x4*)(o + BCD) = (u32x4){pk[1][0], pk[1][1], pk[1][2], pk[1][3]}; }
        if (isx || isb) {
            LAS bf16_t* tl = tl0 + par * (64 * 136); par ^= 1;
#pragma unroll
            for (int i = 0; i < 4; ++i) { const unsigned lo = (pk[0][i] & 0xffffu) | (pk[1][i] << 16), hi = (pk[0][i] >> 16) | (pk[1][i] & 0xffff0000u);
                *(LAS unsigned*)(tl + (cg * 8 + 2 * i) * 136 + t2) = lo; *(LAS unsigned*)(tl + (cg * 8 + 2 * i + 1) * 136 + t2) = hi; }
            __syncthreads();
            bf16_t* dst = isx ? XT + ((size_t)b * DIN + cblk * 64) * TV : BT + ((size_t)b * BCD + (cblk * 64 - DIN)) * TV;
#pragma unroll
            for (int q = 0; q < 2; ++q) { const int idx = F.tid + q * 512, ch = idx >> 4, t8 = (idx & 15) * 8;
                *(u32x4*)(dst + (size_t)ch * TV + cv * 128 + t8) = *(const LAS u32x4*)(tl + ch * 136 + t8); }
        }
    }
}

#undef CV_LOAD
DEV void phase_cb(const Frame& F, const bf16_t* Brow, const bf16_t* Crow, bf16_t* CB) {
    const int nitem = NB * NG * NCH; const int fr = F.lane & 15, fq = F.lane >> 4;
    for (int it = F.bx; it < nitem; it += F.G) {
        const int cv = it % NCH, g = (it / NCH) % NG, b = it / (NCH * NG);
        const int rbase = row_of(b, cv * 128);
        bf16x8 cf[4];
#pragma unroll
        for (int ks = 0; ks < 4; ++ks) cf[ks] = *(const bf16x8*)(Crow + (size_t)(rbase + 16 * F.wave + fr) * BCD + g * 128 + 32 * ks + 8 * fq);
        bf16_t* out = CB + ((size_t)((b * NG + g) * NCH + cv)) * 16384;
#pragma unroll
        for (int nt = 0; nt < 8; ++nt) {
            f32x4 acc = (f32x4){0.f, 0.f, 0.f, 0.f};
#pragma unroll
            for (int ks = 0; ks < 4; ++ks) { const bf16x8 bfr = *(const bf16x8*)(Brow + (size_t)(rbase + 16 * nt + fr) * BCD + g * 128 + 32 * ks + 8 * fq); acc = MFMA16(bfr, cf[ks], acc); }
            u32x2 w; w.x = pk2(acc[0], acc[1]); w.y = pk2(acc[2], acc[3]);
            *(u32x2*)(out + (size_t)(16 * F.wave + fr) * 128 + 16 * nt + 4 * fq) = w;
        }
    }
}

DEV void phase_tables(const Frame& F, int j, float* DT, float* CUM, float* WJ) {
    const int nitem = NB * 2 * NH * NCH; const int gw = F.bx * 8 + F.wave, NGW = F.G * 8;
    for (int it = gw; it < nitem; it += NGW) {
        const int cv = it % NCH, h = (it / NCH) % NH, dir = (it / (NCH * NH)) & 1, b = it / (NCH * NH * 2);
        const float A = -expf(INP(F, I_ALOG)[(size_t)(j * 2 + dir) * NH + h]); const float bias = INP(F, I_DTB)[(size_t)(j * 2 + dir) * NH + h];
        const size_t o = ((size_t)(b * 2 + dir) * NH + h) * TV + cv * 128 + 2 * F.lane;
        const f32x2 raw = *(const f32x2*)(DT + o); const float d0 = softplusf(raw.x + bias), d1 = softplusf(raw.y + bias); const float a0 = d0 * A, a1 = d1 * A;
        float c0, c1, tot, sum = a0 + a1;
        if (dir == 0) {
#pragma unroll
            for (int q = 1; q < 64; q <<= 1) { const float t2 = __shfl_up(sum, q); if (F.lane >= q) sum += t2; }
            c1 = sum; c0 = sum - a1; tot = __shfl(sum, 63);
        } else {
#pragma unroll
            for (int q = 1; q < 64; q <<= 1) { const float t2 = __shfl_down(sum, q); if (F.lane + q < 64) sum += t2; }
            c0 = sum; c1 = sum - a0; tot = __shfl(sum, 0);
        }
        constexpr float L2E = 1.4426950408889634f;
        *(f32x2*)(DT + o) = (f32x2){c0 * L2E - flog2(d0), c1 * L2E - flog2(d1)};
        *(f32x2*)(CUM + o) = (f32x2){c0 * L2E, c1 * L2E};
        *(f32x2*)(WJ + o) = (f32x2){d0 * FEXP(tot - c0), d1 * FEXP(tot - c1)};
    }
}

constexpr int SC_HL = 0, SC_TAB = 17408, SC_CB = 20480, SC_BT = SC_CB + 32768, SC_C = SC_BT + 32768, SC_X = SC_C + 32768, SC_END = SC_X + 8192;
static_assert(SC_END <= ge::STAGE_BYTES, "scan LDS map");
DEV void phase_scan(const Frame& F, int j, const bf16_t* XT, const bf16_t* BT, const bf16_t* Crow, const bf16_t* CB, const float* DT, const float* CUM, const float* WJ, bf16_t* Yf, bf16_t* Yb) {
    LAS unsigned char* L = F.lds;
    LAS bf16_t* Hl = (LAS bf16_t*)(L + SC_HL);
    LAS float* tab = (LAS float*)(L + SC_TAB);
    const int fr = F.lane & 15, fq = F.lane >> 4, w = F.wave;
    const int nitem = NB * NH * 2 * 2;
    for (int it = F.bx; it < nitem; it += F.G) {
        const int xq = it & 7, kq = it >> 3; const int b = xq >> 2, g = xq & 3, h = 8 * g + (kq >> 2), dir = (kq >> 1) & 1, ph = kq & 1;
        const float Dsk = dir == 0 ? INP(F, I_DSKIP)[(size_t)j * NH + h] : 0.f;
        const size_t tbase = ((size_t)(b * 2 + dir) * NH + h) * TV;
        const bf16_t* xt = XT + ((size_t)b * DIN + h * HD + ph * 32) * TV;
        const bf16_t* bt = BT + ((size_t)b * BCD + g * 128) * TV;
        const bf16_t* CBh = CB + (size_t)((b * NG + g) * NCH) * 16384;
        const bf16_t* Cg = Crow + g * 128;
        bf16_t* Y = (dir ? Yb : Yf) + h * HD + ph * 32;
        const int lrow = 16 * w + fr;
        const int dr = F.lane >> 4, dc = F.lane & 15;
        f32x4 accH[2]; accH[0] = (f32x4){0.f, 0.f, 0.f, 0.f}; accH[1] = accH[0];
        for (int i = F.tid; i < 32 * 136 / 2; i += 512) ((LAS unsigned*)Hl)[i] = 0u;
#define SC_CHUNK_OF(step) (dir == 0 ? (step) : ((step) < 2 ? 1 - (step) : (NCH - 1) - ((step) - 2)))
        const int rsw = (4 * (w & 3) + dr) & 15, gc = dc ^ rsw;
        const unsigned loCB = (unsigned)(dr * 128 + 8 * gc) * 2u, loT = (unsigned)(dr * TV + 8 * gc) * 2u, loC = (unsigned)(dr * BCD + 8 * gc) * 2u;
#define SC_ISSUE_TILES(cvx_) SC_ISSUE_PIECES(cvx_, 0, 13)
#define SC_ISSUE_PIECES(cvx_, j0_, j1_) do { const int cvx = (cvx_); const unsigned tvx = cvx * 128u; const unsigned rbx = (unsigned)row_of(b, cvx * 128); \
            _Pragma("unroll") for (int jj = (j0_); jj < (j1_); ++jj) { const int q = 8 * jj + w, r0 = 4 * (q & 31);   \
                const char* src; int toff; \
                if (jj < 4) { src = (const char*)(CBh + ((size_t)cvx * 16384u + (unsigned)r0 * 128u)) + loCB; toff = SC_CB; } \
                else if (jj < 8) { src = (const char*)(bt + ((size_t)r0 * TV + tvx)) + loT; toff = SC_BT; } \
                else if (jj < 12) { src = (const char*)(Cg + (size_t)(rbx + r0) * BCD) + loC; toff = SC_C; } \
                else { src = (const char*)(xt + ((size_t)r0 * TV + tvx)) + loT; toff = SC_X; } \
                GLDS16(src, L + toff + (q & 31) * 1024); } } while (0)
        const int kd = w >> 1; float km[8], dk[8];
#pragma unroll
        for (int i = 0; i < 8; ++i) { const int sidx = 32 * kd + 8 * fq + i; km[i] = (dir == 0 ? (sidx <= lrow) : (sidx >= lrow)) ? 1.f : 0.f; dk[i] = (sidx == lrow) ? Dsk : 0.f; }
#define SC_ISSUE_TAB(cvx_, tbuf_) do { if (w < 6) { const int tsel = w >> 1, half = w & 1; const float* tsrc = tsel == 0 ? CUM : (tsel == 1 ? DT : WJ); \
            GLDS4(tsrc + tbase + (cvx_) * 128 + half * 64 + F.lane, (LAS unsigned char*)(tab + (tbuf_) * 384 + tsel * 128 + half * 64)); } } while (0)
        { const int cv0 = SC_CHUNK_OF(0); SC_ISSUE_TILES(cv0); SC_ISSUE_TAB(cv0, 0); }
        for (int step = 0; step < NCH; ++step) {
            const int cv = SC_CHUNK_OF(step), buf = step & 1; const bool more = step + 1 < NCH;
            const int cvn = more ? SC_CHUNK_OF(step + 1) : cv;
            const unsigned rbase = (unsigned)row_of(b, cv * 128);
            if (step == 0) WAITV(0); else WAITV(2);
            LDSBAR();
            u32x4 rcb[4], rbt[4]; bf16x8 xf[2][4], cf[4];
#pragma unroll
            for (int ks = 0; ks < 4; ++ks) { const int fo = lrow * 256 + (((4 * ks + fq) ^ fr) << 4);
                rcb[ks] = *(const LAS u32x4*)(L + SC_CB + fo); rbt[ks] = *(const LAS u32x4*)(L + SC_BT + fo); cf[ks] = *(const LAS bf16x8*)(L + SC_C + fo);
#pragma unroll
                for (int nt = 0; nt < 2; ++nt) xf[nt][ks] = *(const LAS bf16x8*)(L + SC_X + (16 * nt + fr) * 256 + (((4 * ks + fq) ^ fr) << 4)); }
            LDSBAR();
            const LAS float* tb = tab + buf * 384;
            const float cl2 = tb[lrow]; const float ecum_l = fexp2(cl2);
            const float chunk_decay = fexp2(dir == 0 ? tb[127] : tb[0]);
            bf16x8 mf[4], bw[4];
#pragma unroll
            for (int ks = 0; ks < 4; ++ks) { const int s0 = 32 * ks + 8 * fq;
                const bool none = dir == 0 ? (ks > kd) : (ks < kd), diag = (ks == kd);
                unsigned om[4] = {0u, 0u, 0u, 0u};
                if (!none) {
                    const f32x4 cs0 = *(const LAS f32x4*)(tb + 128 + s0), cs1 = *(const LAS f32x4*)(tb + 128 + s0 + 4);
                    const float cs[8] = {cs0[0], cs0[1], cs0[2], cs0[3], cs1[0], cs1[1], cs1[2], cs1[3]};
                    const unsigned qc[4] = {rcb[ks].x, rcb[ks].y, rcb[ks].z, rcb[ks].w};
                    float v[8];
                    if (!diag) {
#pragma unroll
                        for (int i = 0; i < 8; ++i) { const float cbv = (i & 1) ? bfhi(qc[i >> 1]) : bflo(qc[i >> 1]); v[i] = cbv * fexp2(cl2 - cs[i]); }
                    } else {
#pragma unroll
                        for (int i = 0; i < 8; ++i) { const float cbv = (i & 1) ? bfhi(qc[i >> 1]) : bflo(qc[i >> 1]); const float x = cl2 - cs[i]; v[i] = (cbv * fexp2(x < 60.f ? x : 60.f)) * km[i] + dk[i]; }
                    }
#pragma unroll
                    for (int i = 0; i < 4; ++i) om[i] = pk2(v[2 * i], v[2 * i + 1]);
                }
                mf[ks] = __builtin_bit_cast(bf16x8, (u32x4){om[0], om[1], om[2], om[3]});
                { const f32x4 ws0 = *(const LAS f32x4*)(tb + 256 + s0), ws1 = *(const LAS f32x4*)(tb + 256 + s0 + 4); const float wsv[8] = {ws0[0], ws0[1], ws0[2], ws0[3], ws1[0], ws1[1], ws1[2], ws1[3]};
                  const unsigned qb[4] = {rbt[ks].x, rbt[ks].y, rbt[ks].z, rbt[ks].w}; unsigned ob[4];
#pragma unroll
                  for (int i = 0; i < 4; ++i) ob[i] = pk2(bflo(qb[i]) * wsv[2 * i], bfhi(qb[i]) * wsv[2 * i + 1]);
                  bw[ks] = __builtin_bit_cast(bf16x8, (u32x4){ob[0], ob[1], ob[2], ob[3]}); }
                if (more) { if (ks == 0) SC_ISSUE_PIECES(cvn, 0, 4); else if (ks == 1) SC_ISSUE_PIECES(cvn, 4, 8); else if (ks == 2) SC_ISSUE_PIECES(cvn, 8, 12); else { SC_ISSUE_PIECES(cvn, 12, 13); SC_ISSUE_TAB(cvn, buf ^ 1); } } }
            f32x4 yd[2], yo[2];
#pragma unroll
            for (int nt = 0; nt < 2; ++nt) { yd[nt] = (f32x4){0.f, 0.f, 0.f, 0.f}; yo[nt] = yd[nt]; accH[nt] = accH[nt] * chunk_decay; }
#pragma unroll
            for (int nt = 0; nt < 2; ++nt)
#pragma unroll
                for (int ks = 0; ks < 4; ++ks) {
                    yd[nt] = MFMA16(xf[nt][ks], mf[ks], yd[nt]);
                    const bf16x8 hf = *(const LAS bf16x8*)(Hl + buf * (32 * 136) + (16 * nt + fr) * 136 + 32 * ks + 8 * fq);
                    yo[nt] = MFMA16(hf, cf[ks], yo[nt]);
                    accH[nt] = MFMA16(bw[ks], xf[nt][ks], accH[nt]); }
#pragma unroll
            for (int nt = 0; nt < 2; ++nt) { u32x2 hw; hw.x = pk2(accH[nt][0], accH[nt][1]); hw.y = pk2(accH[nt][2], accH[nt][3]);
                *(LAS u32x2*)(Hl + (buf ^ 1) * (32 * 136) + (16 * nt + fr) * 136 + 16 * w + 4 * fq) = hw; }
#pragma unroll
            for (int nt = 0; nt < 2; ++nt) { u32x2 yw; yw.x = pk2(yd[nt][0] + ecum_l * yo[nt][0], yd[nt][1] + ecum_l * yo[nt][1]); yw.y = pk2(yd[nt][2] + ecum_l * yo[nt][2], yd[nt][3] + ecum_l * yo[nt][3]);
                *(u32x2*)(Y + ((size_t)(rbase + lrow) * DIN + 16 * nt + 4 * fq)) = yw; }
        }
        WAITV(0); LDSBAR();
    }
}

DEV void phase_gate(const Frame& F, int j, const bf16_t* Yf, const bf16_t* Yb, const bf16_t* Z, bf16_t* YN, int nrows) {
    const int gw = F.bx * 8 + F.wave, NGW = F.G * 8; const float* nw = INP(F, I_SNORM) + (size_t)j * DIN;
    u32x4 na[4], nb[4], nz[4];
    if (gw < nrows) {
#pragma unroll
        for (int q = 0; q < 4; ++q) { const size_t o = (size_t)gw * DIN + 8 * F.lane + 512 * q; na[q] = *(const u32x4*)(Yf + o); nb[q] = *(const u32x4*)(Yb + o); nz[q] = *(const u32x4*)(Z + o); } }
    for (int r = gw; r < nrows; r += NGW) {
        float t[32]; float ss = 0.f;
        u32x4 ca[4], cb4[4], cz[4];
#pragma unroll
        for (int q = 0; q < 4; ++q) { ca[q] = na[q]; cb4[q] = nb[q]; cz[q] = nz[q]; }
        if (r + NGW < nrows) {
#pragma unroll
            for (int q = 0; q < 4; ++q) { const size_t o = (size_t)(r + NGW) * DIN + 8 * F.lane + 512 * q; na[q] = *(const u32x4*)(Yf + o); nb[q] = *(const u32x4*)(Yb + o); nz[q] = *(const u32x4*)(Z + o); } }
#pragma unroll
        for (int q = 0; q < 4; ++q) { const u32x4 a = ca[q], bq = cb4[q], z = cz[q];
            const unsigned aa[4] = {a.x, a.y, a.z, a.w}, bb[4] = {bq.x, bq.y, bq.z, bq.w}, zz[4] = {z.x, z.y, z.z, z.w};
#pragma unroll
            for (int i = 0; i < 4; ++i) { const float v0 = (bflo(aa[i]) + bflo(bb[i])) * siluf(bflo(zz[i])), v1 = (bfhi(aa[i]) + bfhi(bb[i])) * siluf(bfhi(zz[i])); t[8 * q + 2 * i] = v0; t[8 * q + 2 * i + 1] = v1; ss += v0 * v0 + v1 * v1; } }
        const float rstd = rsqrtf(wave_sum(ss) * (1.0f / DIN) + EPS);
#pragma unroll
        for (int q = 0; q < 4; ++q) { const int c = 8 * F.lane + 512 * q; const f32x4 w0 = *(const f32x4*)(nw + c), w1 = *(const f32x4*)(nw + c + 4);
            u32x4 o; o.x = pk2(t[8 * q] * rstd * w0[0], t[8 * q + 1] * rstd * w0[1]); o.y = pk2(t[8 * q + 2] * rstd * w0[2], t[8 * q + 3] * rstd * w0[3]);
            o.z = pk2(t[8 * q + 4] * rstd * w1[0], t[8 * q + 5] * rstd * w1[1]); o.w = pk2(t[8 * q + 6] * rstd * w1[2], t[8 * q + 7] * rstd * w1[3]);
            *(u32x4*)(YN + (size_t)r * DIN + c) = o; }
    }
}

struct TokInfo { int s0, s1; float g0, g1; };
DEV void phase_route(const Frame& F, int layer, int ml, bf16_t* V, int nrows) {
    LAS unsigned* lc = (LAS unsigned*)(F.lds + LDS_MISC + 256);
    if (F.tid < 8) lc[F.tid] = 0u;
    __syncthreads();
    const int gw = F.bx * 8 + F.wave, NGW = F.G * 8; const int j = layer / 2;
    const float* w = INP(F, I_NFFN) + (size_t)layer * D; const float* rw = INP(F, I_RW) + (size_t)j * D * NEXP;
    LAS float* rwl = (LAS float*)F.lds;
    for (int q = F.tid; q < D * 2; q += 512) { const int c = q >> 1, hf = q & 1; const int ln = (c & 255) >> 2, ii = c & 3, jq = c >> 8;
        *(LAS f32x4*)(rwl + ((jq * 4 + ii) * 64 + ln) * 8 + hf * 4) = *(const f32x4*)(rw + (size_t)q * 4); }
    __syncthreads();
    TokInfo* tok = (TokInfo*)(F.ws + OFF_TOK);
    f32x4 nx[4];
    if (gw < nrows) load_row(F.H + (size_t)gw * D, F.lane, nx);
    for (int r = gw; r < nrows; r += NGW) {
        f32x4 v[4];
#pragma unroll
        for (int q = 0; q < 4; ++q) v[q] = nx[q];
        if (r + NGW < nrows) load_row(F.H + (size_t)(r + NGW) * D, F.lane, nx);
        const float rstd = rsqrtf(sumsq_row(v) * (1.0f / D) + EPS);
        const int vec = vec_of(r);
        normmod_row(v, rstd, w, modp(F, layer, vec, 3), modp(F, layer, vec, 4), F.lane);
#pragma unroll
        for (int jq = 0; jq < 4; ++jq) *(unsigned*)((fp8_t*)V + (size_t)r * D + 4 * F.lane + 256 * jq) = pk4_fp8(v[jq][0] * 8.0f, v[jq][1] * 8.0f, v[jq][2] * 8.0f, v[jq][3] * 8.0f);
        float lg[NEXP];
#pragma unroll
        for (int e = 0; e < NEXP; ++e) lg[e] = 0.f;
#pragma unroll
        for (int jj = 0; jj < 4; ++jj)
#pragma unroll
            for (int i = 0; i < 4; ++i) { const LAS float* rp = rwl + ((jj * 4 + i) * 64 + F.lane) * 8; const f32x4 r0 = *(const LAS f32x4*)rp, r1 = *(const LAS f32x4*)(rp + 4);
#pragma unroll
                for (int e = 0; e < 4; ++e) { lg[e] += v[jj][i] * r0[e]; lg[4 + e] += v[jj][i] * r1[e]; } }
#pragma unroll
        for (int e = 0; e < NEXP; ++e) lg[e] = wave_sum(lg[e]);
        int e0 = 0; float v0 = lg[0];
#pragma unroll
        for (int e = 1; e < NEXP; ++e) if (lg[e] > v0) { v0 = lg[e]; e0 = e; }
        int e1 = -1; float v1 = -3.0e38f;
#pragma unroll
        for (int e = 0; e < NEXP; ++e) if (e != e0 && lg[e] > v1) { v1 = lg[e]; e1 = e; }
        const float g1 = frcp(1.0f + FEXP(v0 - v1)), g0 = 1.0f - g1;
        if (F.lane == 0) { TokInfo ti; ti.s0 = e0; ti.s1 = e1; ti.g0 = g0; ti.g1 = g1; tok[r] = ti; atomicAdd((unsigned*)&lc[e0], 1u); atomicAdd((unsigned*)&lc[e1], 1u); }
    }
    __syncthreads();
    if (F.tid < 8) __hip_atomic_fetch_add(F.ctl + CW_CNT + (ml * 8 + F.tid) * 64, lc[F.tid], RLX_AGENT);
}
DEV void tile_starts(const Frame& F, int ml, int (&ts)[NEXP + 1], unsigned (&cnt)[NEXP]) {
    ts[0] = 0;
#pragma unroll
    for (int e = 0; e < NEXP; ++e) { cnt[e] = __hip_atomic_load(F.ctl + CW_CNT + (ml * 8 + e) * 64, RLX_AGENT); ts[e + 1] = ts[e] + (int)((cnt[e] + 255u) / 256u); }
}
DEV void phase_slots(const Frame& F, int ml, int nrows) {
    int ts[NEXP + 1]; unsigned cnt[NEXP]; tile_starts(F, ml, ts, cnt);
    TokInfo* tok = (TokInfo*)(F.ws + OFF_TOK); int* s2t = (int*)(F.ws + OFF_S2T);
    const int gw = F.bx * 8 + F.wave, NGW = F.G * 8;
    for (int base = gw * 64; base < nrows; base += NGW * 64) {
        const int r = base + F.lane; TokInfo ti = tok[r];
        unsigned long long m0[NEXP], m1[NEXP]; unsigned mycnt = 0;
#pragma unroll
        for (int e = 0; e < NEXP; ++e) { m0[e] = __ballot(ti.s0 == e); m1[e] = __ballot(ti.s1 == e); if (F.lane == e) mycnt = (unsigned)(__builtin_popcountll(m0[e]) + __builtin_popcountll(m1[e])); }
        unsigned b0 = 0;
        if (F.lane < NEXP && mycnt) b0 = __hip_atomic_fetch_add(F.ctl + CW_CUR + (ml * 8 + F.lane) * 64, mycnt, RLX_AGENT);
        const unsigned long long below = (1ull << F.lane) - 1ull; int sl0 = 0, sl1 = 0;
#pragma unroll
        for (int e = 0; e < NEXP; ++e) { const unsigned be = __shfl(b0, e); const int c0 = __builtin_popcountll(m0[e]);
            if (ti.s0 == e) sl0 = ts[e] * 256 + (int)be + __builtin_popcountll(m0[e] & below);
            if (ti.s1 == e) sl1 = ts[e] * 256 + (int)be + c0 + __builtin_popcountll(m1[e] & below); }
        ti.s0 = sl0; ti.s1 = sl1; tok[r] = ti; s2t[sl0] = r; s2t[sl1] = r;
    }
    if (F.bx == 0) { for (int e = 0; e < NEXP; ++e) { const int a = ts[e] * 256 + (int)cnt[e], b2 = ts[e + 1] * 256; for (int s = a + F.tid; s < b2; s += 512) s2t[s] = 0; } }
}
DEV void phase_combine(const Frame& F, int layer, const bf16_t* YS, bool final_) {
    const int gw = F.bx * 8 + F.wave, NGW = F.G * 8; const TokInfo* tok = (const TokInfo*)(F.ws + OFF_TOK);
    const int nrows = final_ ? ML : MT;
    f32x4 nh[4]; u32x2 nya[4], nyb[4]; TokInfo tcur, tnxt;
    tcur.s0 = tcur.s1 = 0; tcur.g0 = tcur.g1 = 0.f; tnxt = tcur;
    if (gw < nrows) { tcur = tok[gw]; load_row(F.H + (size_t)gw * D, F.lane, nh);
#pragma unroll
        for (int jj = 0; jj < 4; ++jj) { const int c = 4 * F.lane + 256 * jj; nya[jj] = *(const u32x2*)(YS + (size_t)tcur.s0 * D + c); nyb[jj] = *(const u32x2*)(YS + (size_t)tcur.s1 * D + c); } }
    if (gw + NGW < nrows) tnxt = tok[gw + NGW];
    for (int r = gw; r < nrows; r += NGW) {
        f32x4 v[4]; u32x2 ya[4], yb[4]; TokInfo ti = tcur;
#pragma unroll
        for (int q = 0; q < 4; ++q) { v[q] = nh[q]; ya[q] = nya[q]; yb[q] = nyb[q]; }
        tcur = tnxt;
        if (r + NGW < nrows) { load_row(F.H + (size_t)(r + NGW) * D, F.lane, nh);
#pragma unroll
            for (int jj = 0; jj < 4; ++jj) { const int c = 4 * F.lane + 256 * jj; nya[jj] = *(const u32x2*)(YS + (size_t)tcur.s0 * D + c); nyb[jj] = *(const u32x2*)(YS + (size_t)tcur.s1 * D + c); } }
        if (r + 2 * NGW < nrows) tnxt = tok[r + 2 * NGW];
        if (MOE_DOWN_FP8) { ti.g0 *= 0.00390625f; ti.g1 *= 0.00390625f; }
        const float* g2 = modp(F, layer, vec_of(r), 5);
#pragma unroll
        for (int jj = 0; jj < 4; ++jj) { const int c = 4 * F.lane + 256 * jj; const u32x2 a = ya[jj], b = yb[jj]; const f32x4 gv = *(const f32x4*)(g2 + c);
            v[jj][0] += gv[0] * (ti.g0 * bflo(a.x) + ti.g1 * bflo(b.x)); v[jj][1] += gv[1] * (ti.g0 * bfhi(a.x) + ti.g1 * bfhi(b.x));
            v[jj][2] += gv[2] * (ti.g0 * bflo(a.y) + ti.g1 * bflo(b.y)); v[jj][3] += gv[3] * (ti.g0 * bfhi(a.y) + ti.g1 * bfhi(b.y)); }
        if (!final_) {
#pragma unroll
            for (int jj = 0; jj < 4; ++jj) *(f32x4*)(F.H + (size_t)r * D + 4 * F.lane + 256 * jj) = v[jj];
        } else {
            const float rstd = rsqrtf(sumsq_row(v) * (1.0f / D) + EPS); const float* fw = INP(F, I_FNORM);
#pragma unroll
            for (int jj = 0; jj < 4; ++jj) { const int c = 4 * F.lane + 256 * jj; *(f32x4*)(OUTP(F) + (size_t)r * D + c) = v[jj] * rstd * *(const f32x4*)(fw + c); }
        }
    }
}

constexpr int PH_PER_PAIR = 17, N_PHASES = 1 + 2 * PH_PER_PAIR;
__global__ void __launch_bounds__(512, 2) fwd_kernel(Params prm) {
#ifdef EMU
    unsigned char* lds_raw = emu_lds();
#else
    extern __shared__ __attribute__((aligned(16))) unsigned char lds_raw[];
#endif
    Frame F;
    F.lds = (LAS unsigned char*)lds_raw;
    F.tid = threadIdx.x; F.lane = F.tid & 63; F.wave = RFL(F.tid >> 6); F.G = gridDim.x; F.bx = blockIdx.x;
    F.p = &prm; F.ws = prm.ws; F.ctl = (unsigned*)(prm.ws + OFF_CTL); F.H = (float*)(prm.ws + OFF_H); F.mod = (float*)(prm.ws + OFF_MOD);
    volatile LAS unsigned* misc = (volatile LAS unsigned*)(F.lds + LDS_MISC);
    if (F.tid < 64) misc[F.tid] = 0u;
    __syncthreads();
    XcdBarrier bar; bar.bar = F.ctl + CW_BAR; bar.x = 0; bar.st = misc;
    const int lo = prm.ph_lo, hi = prm.ph_hi;
    if (hi - lo > 1) bar = xcd_barrier_post(F.ctl + CW_BAR, misc);
    int ph = 0;
#ifndef SITE_MASK
#define SITE_MASK 0xFFFFFFFFu
#endif
#ifndef PROBE_REPEAT_SITE
#define PROBE_REPEAT_SITE (-1)
#endif
#define PH_REPS(site) ((PROBE_REPEAT_SITE == (site)) ? 2 : 1)
#define PHASE_BEGIN(site) if (((SITE_MASK >> (site)) & 1u) && lo <= ph && ph < hi) { { int _t = threadIdx.x; LAUNDER_V(_t); F.tid = _t; F.lane = _t & 63; int _b = blockIdx.x; LAUNDER_S(_b); F.bx = _b; int _g = gridDim.x; LAUNDER_S(_g); F.G = _g; \
      F.ws = WSP(F); F.ctl = (unsigned*)(F.ws + OFF_CTL); F.H = (float*)(F.ws + OFF_H); F.mod = (float*)(F.ws + OFF_MOD); } \
      for (int _rep = 0; _rep < PH_REPS(site); ++_rep) { if (_rep) __syncthreads();
#define PHASE_END   } if (ph + 1 < hi) xcd_barrier(bar); } ++ph;
#define B_W (F.ws + OFF_W)
#define B_ACT (F.ws + OFF_ACT)
#define B_P ((bf16_t*)(B_ACT + A_P))
#define B_HID ((bf16_t*)(B_ACT + A_HID))
#define B_U ((bf16_t*)(B_ACT + A_U))
#define B_Z ((bf16_t*)(B_ACT + A_Z))
#define B_XBC ((bf16_t*)(B_ACT + A_XBC))
#define B_DT ((float*)(B_W + W_DT))
#define B_XT ((bf16_t*)(B_ACT + A_XT))
#define B_BROW ((bf16_t*)(B_ACT + A_BROW))
#define B_BT ((bf16_t*)(B_ACT + A_BT))
#define B_CROW ((bf16_t*)(B_ACT + A_CROW))
#define B_CB ((bf16_t*)(B_ACT + A_CB))
#define B_CUM ((float*)(B_ACT + A_CUM))
#define B_WJ ((float*)(B_ACT + A_WJ))
#define B_YF ((bf16_t*)(B_ACT + A_YF))
#define B_YB ((bf16_t*)(B_W + W_YB))
#define B_YN ((bf16_t*)(B_ACT + A_YN))
#define B_V ((bf16_t*)(B_ACT + A_V))
#define B_HIDM ((bf16_t*)(B_ACT + A_HIDM))
#define B_YS ((bf16_t*)(B_ACT + A_YS))

    PHASE_BEGIN(0) phase_mod(F); convert_even(F, 0); PHASE_END

    for (int lp = 0; lp < 2; ++lp) {
        const int le = 2 * lp, lod = 2 * lp + 1;
        PHASE_BEGIN(1) phase_poolprep(F, le, B_P); PHASE_END
        PHASE_BEGIN(2) { PolPool S; S.G = F.G; S.c = F.bx; S.K = 256; S.lda = D; S.ldb = 256; S.P = B_P; S.W = (const bf16_t*)(B_W + W_POOL); S.src = mksrc(F); S.layer = le; S.scale = INP(F, I_POOLS) + (size_t)lp * D;
                      ge::gemm_phase(F.lds, S, F.tid); } PHASE_END
        PHASE_BEGIN(3) phase_norm(F, le, 3, B_P, false); PHASE_END
        PHASE_BEGIN(4) { PolUp<false> S; S.G = F.G; S.c = F.bx; S.K = D; S.lda = D; S.ldb = D; S.A = B_P; S.W = (const bf16_t*)(B_W + W_UP); S.HID = B_HID; S.ldh = DFF; S.nq = DFF / 128; S.nM = NPAN; S.s2t = nullptr;
                      ge::gemm_phase(F.lds, S, F.tid); } PHASE_END
        PHASE_BEGIN(5) { PolResid S; S.G = F.G; S.c = F.bx; S.K = DFF; S.lda = DFF; S.ldb = DFF; S.A = B_HID; S.W = (const bf16_t*)(B_W + W_DN); S.src = mksrc(F); S.layer = le; S.which = 5; S.npan = NPAN;
                      ge::gemm_phase(F.lds, S, F.tid); } PHASE_END
        PHASE_BEGIN(6) phase_norm(F, lod, 0, B_U, false); convert_ssd(F, lp); PHASE_END
        PHASE_BEGIN(7) { PolInProj S; S.G = F.G; S.c = F.bx; S.K = D; S.lda = D; S.ldb = D; S.A = B_U; S.W = (const bf16_t*)(B_W + W_IN); S.Z = B_Z; S.XBC = B_XBC; S.DT = B_DT;
                      ge::gemm_phase(F.lds, S, F.tid); } PHASE_END
        PHASE_BEGIN(8) phase_conv(F, lp, B_XBC, B_XT, B_BROW, B_BT, B_CROW); PHASE_END
        PHASE_BEGIN(9) phase_cb(F, B_BROW, B_CROW, B_CB); phase_tables(F, lp, B_DT, B_CUM, B_WJ); PHASE_END
        PHASE_BEGIN(10) phase_scan(F, lp, B_XT, B_BT, B_CROW, B_CB, B_DT, B_CUM, B_WJ, B_YF, B_YB); PHASE_END
        PHASE_BEGIN(11) phase_gate(F, lp, B_YF, B_YB, B_Z, B_YN, lp == 1 ? ML : MT); PHASE_END
        PHASE_BEGIN(12) { PolResid S; S.G = F.G; S.c = F.bx; S.K = DIN; S.lda = DIN; S.ldb = DIN; S.A = B_YN; S.W = (const bf16_t*)(B_W + W_OUT); S.src = mksrc(F); S.layer = lod; S.which = 2; S.npan = lp == 1 ? ML / 256 : NPAN;
                      ge::gemm_phase(F.lds, S, F.tid); } PHASE_END
        PHASE_BEGIN(13) phase_route(F, lod, lp, B_V, lp == 1 ? ML : MT); convert_moe(F, lp); PHASE_END
        PHASE_BEGIN(14) phase_slots(F, lp, lp == 1 ? ML : MT); PHASE_END
        PHASE_BEGIN(15) { int ts[NEXP + 1]; unsigned cnt[NEXP]; tile_starts(F, lp, ts, cnt);
                      PolUp<true> S; S.G = F.G; S.c = F.bx; S.K = D; S.lda = D; S.ldb = D; S.A = B_V; S.W = (const bf16_t*)(B_W + W_MUP); S.HID = B_HIDM; S.ldh = DFFE; S.nq = DFFE / 128; S.nM = ts[NEXP];
                      S.s2t = (const int*)(F.ws + OFF_S2T);
#pragma unroll
                      for (int e = 0; e <= NEXP; ++e) S.tstart[e] = ts[e];
                      ge::gemm_phase(F.lds, S, F.tid); } PHASE_END
        PHASE_BEGIN(16) { int ts[NEXP + 1]; unsigned cnt[NEXP]; tile_starts(F, lp, ts, cnt);
                      PolMoeDown S; S.G = F.G; S.c = F.bx; S.K = DFFE; S.lda = DFFE; S.ldb = DFFE; S.A = B_HIDM; S.W = (const bf16_t*)(B_W + W_MDN); S.YS = B_YS; S.nM = ts[NEXP];
#pragma unroll
                      for (int e = 0; e <= NEXP; ++e) S.tstart[e] = ts[e];
                      ge::gemm_phase(F.lds, S, F.tid); } PHASE_END
        PHASE_BEGIN(17) phase_combine(F, lod, B_YS, lp == 1); if (lp == 0) convert_even(F, 1); PHASE_END
    }
#undef PHASE_BEGIN
#undef PHASE_END
}

extern "C" void kernel_launch(void* const* d_in, const int* in_sizes, int n_in, void* d_out, int out_size, void* d_ws, size_t ws_size, hipStream_t stream) {
    static int grid = 0;
    if (grid == 0) {
        if (n_in != 26 || ws_size < WS_NEED) { fprintf(stderr, "kernel_launch: need 26 inputs and %zu bytes of workspace (got %d, %zu)\n", (size_t)WS_NEED, n_in, ws_size); grid = -1; return; }
        int dev = 0, cus = 0, per_cu = 0;
        if (hipGetDevice(&dev) != hipSuccess || hipDeviceGetAttribute(&cus, hipDeviceAttributeMultiprocessorCount, dev) != hipSuccess) { grid = -1; return; }
        if (hipFuncSetAttribute((const void*)fwd_kernel, hipFuncAttributeMaxDynamicSharedMemorySize, LDS_BYTES) != hipSuccess) { grid = -1; return; }
        if (hipOccupancyMaxActiveBlocksPerMultiprocessor(&per_cu, (const void*)fwd_kernel, 512, LDS_BYTES) != hipSuccess || per_cu < 1) { fprintf(stderr, "kernel_launch: occupancy query says %d\n", per_cu); }
        (void)hipGetLastError();
        grid = cus;
    }
    if (grid < 0) return;
    (void)in_sizes; (void)out_size;
    if (hipMemsetAsync((char*)d_ws + OFF_CTL, 0, CTL_BYTES, stream) != hipSuccess) return;
    Params p{};
    for (int i = 0; i < 26; ++i) p.in[i] = (const float*)d_in[i];
    p.out = (float*)d_out; p.ws = (unsigned char*)d_ws;
    if (N_LAUNCH_MODE == 1) { p.ph_lo = 0; p.ph_hi = N_PHASES; hipLaunchKernelGGL(fwd_kernel, dim3(grid), dim3(512), LDS_BYTES, stream, p); }
    else for (int ph = 0; ph < N_PHASES; ++ph) { p.ph_lo = ph; p.ph_hi = ph + 1; hipLaunchKernelGGL(fwd_kernel, dim3(grid), dim3(512), LDS_BYTES, stream, p); }
}
```

```cpp
#ifndef EMU
#include <hip/hip_runtime.h>
#endif
#include <cstdio>
#include <cstdint>

#ifndef CFG_SEQ
#define CFG_SEQ 16384
#endif
#ifndef CFG_DFF
#define CFG_DFF 2816
#endif
#ifndef CFG_DFFE
#define CFG_DFFE 3584
#endif
#ifndef MOE_DOWN_FP8
#define MOE_DOWN_FP8 1
#endif
#ifndef N_LAUNCH_MODE
#define N_LAUNCH_MODE 1
#endif

#ifdef EMU
#define LAS
#define DEV inline
#define WAITV(n) ((void)0)
#define WAITL(n) ((void)0)
#define SBAR() emu_wg_sync()
#define SCHED() ((void)0)
#define SETPRIO(x) ((void)0)
#define MFMA16(a, b, c) emu_mfma16(a, b, c)
#define GLDS16(g, l) emu_glds16((const void*)(g), (void*)(l))
#define GLDS4(g, l) emu_glds4((const void*)(g), (void*)(l))
#define MFMA8(a, b, c) emu_mfma8(a, b, c)
#define RFL(x) emu_rfl(x)
#define MEMFENCE() ((void)0)
#define WSYNC() emu_wave_sync()
#define LDSBAR() emu_wg_sync()
#define LAUNDER_V(x) ((void)0)
#define SLEEP1() emu_yield()
#define MY_XCC_ID() ((unsigned)(blockIdx.x & 7u))
#define FENCE_REL() __atomic_thread_fence(__ATOMIC_SEQ_CST)
#define FENCE_ACQ() __atomic_thread_fence(__ATOMIC_SEQ_CST)
#define FEXP(x) expf(x)
#define RLX_AGENT __ATOMIC_RELAXED, 4
#else
#define LAS __attribute__((address_space(3)))
#define DEV __device__ __forceinline__
#define WAITV(n) asm volatile("s_waitcnt vmcnt(" #n ")" ::: "memory")
#define WAITL(n) asm volatile("s_waitcnt lgkmcnt(" #n ")" ::: "memory")
#define SBAR() __builtin_amdgcn_s_barrier()
#define SCHED() __builtin_amdgcn_sched_barrier(0)
#define SETPRIO(x) __builtin_amdgcn_s_setprio(x)
#define MFMA16(a, b, c) __builtin_amdgcn_mfma_f32_16x16x32_bf16(a, b, c, 0, 0, 0)
#define GLDS16(g, l) __builtin_amdgcn_global_load_lds((const unsigned*)(g), (LAS unsigned*)(l), 16, 0, 0)
#define GLDS4(g, l) __builtin_amdgcn_global_load_lds((const unsigned*)(g), (LAS unsigned*)(l), 4, 0, 0)
#define MFMA8(a, b, c) __builtin_amdgcn_mfma_scale_f32_16x16x128_f8f6f4(a, b, c, 0, 0, 0, 0x7f7f7f7f, 0, 0x7f7f7f7f)
#define RFL(x) __builtin_amdgcn_readfirstlane(x)
#define MEMFENCE() asm volatile("" ::: "memory")
#define LDSBAR() do { asm volatile("s_waitcnt lgkmcnt(0)" ::: "memory"); __builtin_amdgcn_s_barrier(); asm volatile("" ::: "memory"); } while (0)
#define WSYNC() asm volatile("s_waitcnt lgkmcnt(0)" ::: "memory")
#define SLEEP1() __builtin_amdgcn_s_sleep(1)
#define MY_XCC_ID() ((unsigned)__builtin_amdgcn_s_getreg((3 << 11) | 20) & 0xFu)
#define FENCE_REL() __builtin_amdgcn_fence(__ATOMIC_RELEASE, "agent")
#define FENCE_ACQ() __builtin_amdgcn_fence(__ATOMIC_ACQUIRE, "agent")
#define FEXP(x) __expf(x)
#define RLX_AGENT __ATOMIC_RELAXED, __HIP_MEMORY_SCOPE_AGENT
#define LAUNDER_V(x) asm volatile("" : "+v"(x))
#endif

typedef unsigned short bf16_t;
typedef short bf16x8 __attribute__((ext_vector_type(8)));
typedef float f32x4 __attribute__((ext_vector_type(4)));
typedef float f32x2 __attribute__((ext_vector_type(2)));
typedef unsigned u32x4 __attribute__((ext_vector_type(4)));
typedef unsigned u32x2 __attribute__((ext_vector_type(2)));
typedef int i32x8 __attribute__((ext_vector_type(8)));
typedef int i32x4 __attribute__((ext_vector_type(4)));
typedef unsigned char fp8_t;

constexpr int D = 1024, NB = 2, SEQ = CFG_SEQ, CTXL = 256, DEPTH = 4;
constexpr int ML = NB * SEQ, MC = NB * CTXL, MT = ML + MC, NPAN = MT / 256;
constexpr int DFF = CFG_DFF, DFFE = CFG_DFFE, NEXP = 8;
constexpr int DIN = 2048, NH = 32, HD = 64, NG = 4, DS = 128, CONVD = 3072, NPROJ = 5184, NPROJP = 5376, BCD = 512;
constexpr int TV = CTXL + SEQ, NCH = TV / 128;
constexpr int GRIDW = 64;
constexpr float EPS = 1e-6f;
constexpr int NSLOT_TILES = (2 * MT) / 256 + NEXP, NSLOT = NSLOT_TILES * 256;
static_assert(SEQ % 128 == 0 && ML % 256 == 0 && DFF % 128 == 0 && DFFE % 128 == 0 && DFF >= 256 && DFFE >= 256, "shape constraints");

constexpr size_t MiB = 1u << 20;
constexpr size_t al(size_t x) { return (x + 4095) & ~(size_t)4095; }
constexpr size_t OFF_CTL = 0, CTL_BYTES = 1 * MiB;
constexpr size_t OFF_MOD = 1 * MiB;
constexpr size_t OFF_TOK = 2 * MiB;
constexpr size_t OFF_S2T = 3 * MiB;
constexpr size_t OFF_H = 4 * MiB, SZ_H = (size_t)MT * D * 4;
constexpr size_t OFF_W = OFF_H + al(SZ_H);
constexpr size_t W_POOL = 0, SZ_WPOOL = (size_t)4 * 256 * 256 * 2;
constexpr size_t W_UP = al(SZ_WPOOL), SZ_WUP = (size_t)2 * DFF * D * 2;
constexpr size_t W_DN = W_UP + al(SZ_WUP), SZ_WDN = (size_t)D * DFF * 2;
constexpr size_t SZ_WEVEN = W_DN + al(SZ_WDN);
constexpr size_t W_IN = 0, SZ_WIN = (size_t)NPROJP * D * 2;
constexpr size_t W_OUT = al(SZ_WIN), SZ_WOUT = (size_t)D * DIN * 2;
constexpr size_t W_DT = W_OUT + al(SZ_WOUT), SZ_DT = (size_t)NB * 2 * NH * TV * 4;
constexpr size_t W_MUP = W_DT + al(SZ_DT), SZ_WMUP = (size_t)NEXP * 2 * DFFE * D * 2;
constexpr size_t W_MDN = W_MUP + al(SZ_WMUP), SZ_WMDN = (size_t)NEXP * D * DFFE * 2;
constexpr size_t W_YB = W_MUP, SZ_Y = (size_t)MT * DIN * 2;
constexpr size_t SZ_WODD_A = W_MDN + al(SZ_WMDN), SZ_WODD_B = W_YB + al(SZ_Y);
constexpr size_t mx(size_t a, size_t b) { return a > b ? a : b; }
constexpr size_t SZ_W = mx(SZ_WEVEN, mx(SZ_WODD_A, SZ_WODD_B));
constexpr size_t OFF_ACT = OFF_W + SZ_W;
constexpr size_t A_P = 0, SZ_ACT1 = (size_t)MT * D * 2;
constexpr size_t A_HID = al(SZ_ACT1), SZ_HID = (size_t)MT * DFF * 2;
constexpr size_t SZ_AEVEN = A_HID + al(SZ_HID);
constexpr size_t A_Z = 0;
constexpr size_t A_XBC = al(SZ_Y), SZ_XBC = (size_t)MT * CONVD * 2;
constexpr size_t A_YF = A_XBC;
constexpr size_t A_CB = A_XBC + al(SZ_Y), SZ_CB = (size_t)NB * NG * NCH * 128 * 128 * 2;
static_assert(al(SZ_Y) + SZ_CB <= SZ_XBC, "CB fits behind Yf inside the XBC region");
constexpr size_t A_XT = A_XBC + al(SZ_XBC), SZ_XT = (size_t)NB * DIN * TV * 2;
constexpr size_t A_U = A_XT, A_YN = A_XT;
constexpr size_t A_BROW = A_XT + al(SZ_XT), SZ_BC = (size_t)MT * BCD * 2;
constexpr size_t A_BT = A_BROW + al(SZ_BC);
constexpr size_t A_CROW = A_BT + al(SZ_BC);
constexpr size_t A_CUM = A_CROW + al(SZ_BC);
constexpr size_t A_WJ = A_CUM + al(SZ_DT);
constexpr size_t A_CF = A_WJ + al(SZ_DT);
constexpr size_t SZ_ASSD = A_CF + al(SZ_DT);
constexpr size_t A_V = 0;
constexpr size_t A_HIDM = al(SZ_ACT1), SZ_HIDM = (size_t)NSLOT * DFFE * 2;
constexpr size_t A_YS = A_HIDM + al(SZ_HIDM), SZ_YS = (size_t)NSLOT * D * 2;
constexpr size_t SZ_AMOE = A_YS + al(SZ_YS);
constexpr size_t SZ_ACT = mx(SZ_AEVEN, mx(SZ_ASSD, SZ_AMOE));
constexpr size_t WS_NEED = OFF_ACT + SZ_ACT;

constexpr int CW_BAR = 4096;
constexpr int CW_CNT = 16384;
constexpr int CW_CUR = 16384 + 2 * 8 * 64;

DEV unsigned f2bf(float f) { unsigned u = __builtin_bit_cast(unsigned, f); return (u + 0x7fffu + ((u >> 16) & 1u)) >> 16; }
#ifndef EMU
typedef __bf16 bf16x2n __attribute__((ext_vector_type(2)));
#endif
DEV unsigned pk2(float lo, float hi) {
#ifdef EMU
    return f2bf(lo) | (f2bf(hi) << 16);
#else
    f32x2 v = {lo, hi}; bf16x2n b = __builtin_convertvector(v, bf16x2n); return __builtin_bit_cast(unsigned, b);
#endif
}
DEV unsigned pk4_fp8(float a, float b, float c, float d) {
#ifdef EMU
    return emu_f2fp8(a) | (emu_f2fp8(b) << 8) | (emu_f2fp8(c) << 16) | (emu_f2fp8(d) << 24);
#else
    unsigned w = 0; w = __builtin_amdgcn_cvt_pk_fp8_f32(a, b, w, false); w = __builtin_amdgcn_cvt_pk_fp8_f32(c, d, w, true); return w;
#endif
}
DEV float bf2f(unsigned b) { return __builtin_bit_cast(float, b << 16); }
DEV float bflo(unsigned w) { return __builtin_bit_cast(float, w << 16); }
DEV float bfhi(unsigned w) { return __builtin_bit_cast(float, w & 0xffff0000u); }
#ifdef EMU
DEV float frcp(float x) { return 1.0f / x; }
#else
DEV float frcp(float x) { return __builtin_amdgcn_rcpf(x); }
#endif
#ifdef EMU
DEV float fexp2(float x) { return exp2f(x); }
#else
DEV float fexp2(float x) { return __builtin_amdgcn_exp2f(x); }
#endif
DEV float siluf(float x) { return x * frcp(1.0f + FEXP(-x)); }
#ifdef EMU
DEV float flog2(float x) { return log2f(x); }
#else
DEV float flog2(float x) { return __builtin_amdgcn_logf(x); }
#endif
DEV float softplusf(float x) { if (x > 20.f) return x; const float e = FEXP(x); return e < 0.0625f ? e * (1.0f - e * (0.5f - e * (0.33333334f - e * (0.25f - e * 0.2f)))) : flog2(1.0f + e) * 0.6931471806f; }
DEV float wave_sum(float v) {
#pragma unroll
    for (int o = 1; o < 64; o <<= 1) v += __shfl_xor(v, o);
    return v;
}
DEV int vec_of(int r) { return r < ML ? (r / SEQ) : 2; }
DEV int row_of(int b, int tv) { return tv < CTXL ? ML + b * CTXL + tv : b * SEQ + (tv - CTXL); }

#define XB_TMO      128
#define XB_XCNT(j)  (256  + 64 * (j))
#define XB_XSUB(j)  (1280 + 64 * (j))
#define XB_XGEN(j)  (2304 + 64 * (j))
#define XB_TOP      3328
#define XB_TOPGEN   3392
#define XCD_BAR_WORDS 3456
#define XB_SPIN_CAP (1u << 22)
DEV unsigned xb_ld(unsigned* p)              { return __hip_atomic_load(p, RLX_AGENT); }
DEV unsigned xb_add(unsigned* p, unsigned v) { return __hip_atomic_fetch_add(p, v, RLX_AGENT); }
#define XB_SPIN(cond, bar) do { unsigned _sp = 0; while (cond) { SLEEP1(); \
    if ((++_sp & 255u) == 0u) { if (xb_ld(&(bar)[XB_TMO])) break; if (_sp > XB_SPIN_CAP) { atomicAdd(&(bar)[XB_TMO], 1u); break; } } } } while (0)
struct XcdBarrier { unsigned* bar; unsigned x; volatile LAS unsigned* st; };
DEV XcdBarrier xcd_barrier_post(unsigned* bar, volatile LAS unsigned* st) {
    XcdBarrier b; b.bar = bar; b.x = MY_XCC_ID(); b.st = st;
    if (threadIdx.x == 0) (void)xb_add(&bar[XB_XCNT(b.x)], 1u);
    return b;
}
DEV void xcd_barrier_complete(unsigned* bar, unsigned x, unsigned& nloc, unsigned& nx) {
    const unsigned G = gridDim.x;
    unsigned sum, cnt, mine, sp = 0u;
    for (;;) {
        sum = 0u; cnt = 0u; mine = 0u;
#pragma unroll
        for (unsigned j = 0; j < 16; ++j) { const unsigned c = xb_ld(&bar[XB_XCNT(j)]); sum += c; cnt += (c > 0u) ? 1u : 0u; mine = (j == x) ? c : mine; }
        if (sum == G) break;
        SLEEP1();
        if ((++sp & 255u) == 0u) { if (xb_ld(&bar[XB_TMO])) break; if (sp > XB_SPIN_CAP) { atomicAdd(&bar[XB_TMO], 1u); break; } }
    }
    nloc = mine > 0u ? mine : 1u; nx = cnt > 0u ? cnt : 1u;
}
DEV void xcd_barrier(const XcdBarrier& b) {
    WAITV(0);
    __syncthreads();
    if (threadIdx.x == 0) {
        unsigned* bar = b.bar;
#ifndef EMU
        __builtin_amdgcn_s_waitcnt(0);
#endif
        unsigned nloc = b.st[0], nx = b.st[1];
        if (nloc == 0u) { xcd_barrier_complete(bar, b.x, nloc, nx); b.st[0] = nloc; b.st[1] = nx; }
        const unsigned old = xb_add(&bar[XB_XSUB(b.x)], 1u);
        const unsigned gen = old / nloc;
        if (old + 1u == (gen + 1u) * nloc) {
            FENCE_REL();
            WAITV(0);
            const unsigned og = xb_add(&bar[XB_TOP], 1u);
            const unsigned tg = og / nx;
            if (og + 1u == (tg + 1u) * nx) xb_add(&bar[XB_TOPGEN], 1u);
            else XB_SPIN(xb_ld(&bar[XB_TOPGEN]) == tg, bar);
            FENCE_ACQ();
            xb_add(&bar[XB_XGEN(b.x)], 1u);
            WAITV(0);
        } else {
            XB_SPIN(xb_ld(&bar[XB_XGEN(b.x)]) == gen, bar);
            FENCE_ACQ();
            WAITV(0);
        }
    }
    __syncthreads();
}

namespace ge {
constexpr int BM = 256, BK = 64, HALF = 128, HTB = HALF * BK * 2, STAGE_BYTES = 8 * HTB, NXCD = 8, WGM = 8;
DEV int lds_byte(int r, int c) { const int st = (r >> 4) * 2 + (c >> 5), rr = r & 15, cc = c & 31, ob = rr * 64 + cc * 2; return st * 1024 + (ob ^ (((ob >> 9) & 1) << 5)); }
DEV void stage_rc(int b, int& R, int& C) { const int st = b / 1024, sb = b % 1024, swz = sb ^ (((sb >> 9) & 1) << 5); R = (st >> 1) * 16 + swz / 64; C = (st & 1) * 32 + (swz % 64) / 2; }
DEV int perm32(int rho) { const int n = rho >> 4, i = rho & 15; return 8 * (i >> 2) + 4 * n + (i & 3); }
struct Unit { int pm, pn; };
DEV bool static_next(int nM, int nN, int G, int c, int i, Unit& u) {
    const int nwg = nM * nN; const long L = (long)i * G + c; if (L >= nwg) return false;
    int wgid = (int)L; { const int q = nwg / NXCD, r = nwg % NXCD, xcd = wgid % NXCD, off = wgid / NXCD; wgid = (xcd < r ? xcd * (q + 1) : r * (q + 1) + (xcd - r) * q) + off; }
    const int nig = WGM * nN, gid = wgid / nig, fm = gid * WGM, gsz = (nM - fm) < WGM ? (nM - fm) : WGM;
    u.pm = fm + ((wgid % nig) % gsz); u.pn = (wgid % nig) / gsz; return true;
}
template <class P, bool SP2 = true>
DEV void gemm_phase(LAS unsigned char* lds, const P& S, const int tid) {
    const int wid = RFL(tid >> 6), lane = tid & 63, wr = wid >> 2, wc = wid & 3, fr = lane & 15, fq = lane >> 4;
    const int K = S.K, nt = K * P::ES / (BK * 2);
    unsigned voffB[2]; int RA[2], CA2[2];
#pragma unroll
    for (int i = 0; i < 2; ++i) { int R, C; stage_rc(tid * 16 + i * 8192, R, C); const int Rb = P::PERM ? ((R & ~31) + perm32(R & 31)) : R;
        RA[i] = R; CA2[i] = C * 2; voffB[i] = (unsigned)(Rb * S.ldb) * (unsigned)P::ES + (unsigned)(C * 2); }
    const size_t kstep = (size_t)(BK * 2);
    const size_t hstepB = (size_t)HALF * S.ldb * P::ES;
    const unsigned ldsw = (unsigned)wid * 1024u;
    const int aoff = lds_byte(wr * 64 + fr, fq * 8), boff = lds_byte(wc * 32 + fr, fq * 8);
#define GE_SA(b, h) (((b) * 2 + (h)) * HTB)
#define GE_SB(b, h) ((4 + (b) * 2 + (h)) * HTB)
#define GE_STAGEB(bufoff, gbase) do { _Pragma("unroll") for (int _i = 0; _i < 2; ++_i) { unsigned _o = voffB[_i]; LAUNDER_V(_o); \
        GLDS16((const char*)(gbase) + _o, lds + (bufoff) + ldsw + _i * 8192); } } while (0)
#define GE_STAGEA(bufoff, gbase, h) do { _Pragma("unroll") for (int _i = 0; _i < 2; ++_i) { unsigned _o = oA[h][_i]; LAUNDER_V(_o); \
        GLDS16((const char*)(gbase) + _o, lds + (bufoff) + ldsw + _i * 8192); } } while (0)
#define GE_LD1(p_) __builtin_shufflevector(*(const LAS i32x4*)(p_), *(const LAS i32x4*)((p_) + 1024), 0, 1, 2, 3, 4, 5, 6, 7)
#define GE_LDA(dst, b, h) do { _Pragma("unroll") for (int m = 0; m < 4; ++m) dst[m] = GE_LD1(lds + GE_SA(b, h) + aoff + m * 2048); } while (0)
#define GE_LDB(dst, b, h) do { _Pragma("unroll") for (int n = 0; n < 2; ++n) dst[n] = GE_LD1(lds + GE_SB(b, h) + boff + n * 2048); } while (0)
#define GE_LO(x) __builtin_bit_cast(bf16x8, __builtin_shufflevector(x, x, 0, 1, 2, 3))
#define GE_HI(x) __builtin_bit_cast(bf16x8, __builtin_shufflevector(x, x, 4, 5, 6, 7))
#define GE_MMA(ai, bj, At, Bt) do { SETPRIO(1); _Pragma("unroll") for (int m = 0; m < 4; ++m) _Pragma("unroll") for (int n = 0; n < 2; ++n) { \
        if constexpr (P::FP8) acc[ai][bj][m][n] = MFMA8(Bt[n], At[m], acc[ai][bj][m][n]);     \
        else { acc[ai][bj][m][n] = MFMA16(GE_LO(Bt[n]), GE_LO(At[m]), acc[ai][bj][m][n]); acc[ai][bj][m][n] = MFMA16(GE_HI(Bt[n]), GE_HI(At[m]), acc[ai][bj][m][n]); } } SETPRIO(0); } while (0)
    Unit cur, nxt; int ui = 0;
    if (!S.next(0, cur)) return;
    f32x4 acc[2][2][4][2];
#pragma unroll
    for (int a = 0; a < 2; ++a)
#pragma unroll
        for (int b = 0; b < 2; ++b)
#pragma unroll
            for (int m = 0; m < 4; ++m)
#pragma unroll
                for (int n = 0; n < 2; ++n) acc[a][b][m][n] = (f32x4){0.f, 0.f, 0.f, 0.f};
    unsigned oA[2][2];
#pragma unroll
    for (int h = 0; h < 2; ++h)
#pragma unroll
        for (int i = 0; i < 2; ++i) {
            if constexpr (P::GATHER) oA[h][i] = (unsigned)S.gather_row(cur, h * HALF + RA[i]) * (unsigned)(S.lda * P::ES) + (unsigned)CA2[i];
            else oA[h][i] = (unsigned)((h * HALF + RA[i]) * S.lda) * (unsigned)P::ES + (unsigned)CA2[i];
            }
    const char* cA = S.a_base(cur); const char* cB = S.b_base(cur);
    if constexpr (SP2) {
        GE_STAGEB(GE_SB(0, 0), cB); GE_STAGEB(GE_SB(0, 1), cB + hstepB); GE_STAGEA(GE_SA(0, 0), cA, 0); GE_STAGEA(GE_SA(0, 1), cA, 1);
        if (wr == 1) SBAR();
        WAITV(2); SBAR();
        GE_STAGEB(GE_SB(1, 0), cB + kstep); GE_STAGEA(GE_SA(1, 0), cA + kstep, 0); GE_STAGEB(GE_SB(1, 1), cB + hstepB + kstep);
        WAITV(6); SBAR();
    } else {
    GE_STAGEB(GE_SB(0, 0), cB); GE_STAGEA(GE_SA(0, 0), cA, 0); GE_STAGEB(GE_SB(0, 1), cB + hstepB); GE_STAGEA(GE_SA(0, 1), cA, 1);
    if (wr == 1) SBAR();
    WAITV(4); SBAR();
    GE_STAGEB(GE_SB(1, 0), cB + kstep); GE_STAGEA(GE_SA(1, 0), cA + kstep, 0); GE_STAGEB(GE_SB(1, 1), cB + hstepB + kstep);
    WAITV(6); SBAR();
    }
    for (;;) {
        const bool has_next = S.next(ui + 1, nxt);
        const char* nA = has_next ? S.a_base(nxt) : cA; const char* nB = has_next ? S.b_base(nxt) : cB;
        for (int t = 0; t < nt; t += 2) {
            const bool last = (t == nt - 2);
            const char* a1 = cA + (size_t)(t + 1) * kstep;
            const char* a2 = last ? nA : cA + (size_t)(t + 2) * kstep; const char* b2 = last ? nB : cB + (size_t)(t + 2) * kstep;
            const char* a3 = a2 + kstep; const char* b3 = b2 + kstep;
            i32x8 At[4], B0[2], B1[2];
            if constexpr (SP2) {
            GE_LDB(B0, 0, 0); GE_LDB(B1, 0, 1); SCHED(); GE_LDA(At, 0, 0); GE_STAGEA(GE_SA(1, 1), a1, 1);
            WAITV(8); WAITL(0); SBAR(); GE_MMA(0, 0, At, B0); GE_MMA(0, 1, At, B1); SBAR(); SCHED();
            if constexpr (P::GATHER) { if (last && has_next) {
#pragma unroll
                for (int i = 0; i < 2; ++i) { int R2, C2; stage_rc(tid * 16 + i * 8192, R2, C2);
#pragma unroll
                    for (int h = 0; h < 2; ++h) oA[h][i] = (unsigned)S.gather_row(nxt, h * HALF + R2) * (unsigned)(S.lda * P::ES) + (unsigned)(C2 * 2); } } }
            GE_LDA(At, 0, 1); GE_STAGEB(GE_SB(0, 0), b2); GE_STAGEB(GE_SB(0, 1), b2 + hstepB); GE_STAGEA(GE_SA(0, 0), a2, 0);
            WAITV(8); WAITL(0); SBAR(); GE_MMA(1, 0, At, B0); GE_MMA(1, 1, At, B1); SBAR(); SCHED();
            GE_LDB(B0, 1, 0); GE_LDB(B1, 1, 1); SCHED(); GE_LDA(At, 1, 0); GE_STAGEA(GE_SA(0, 1), a2, 1);
            WAITV(8); WAITL(0); SBAR(); GE_MMA(0, 0, At, B0); GE_MMA(0, 1, At, B1); SBAR(); SCHED();
            GE_LDA(At, 1, 1); GE_STAGEB(GE_SB(1, 0), b3); GE_STAGEB(GE_SB(1, 1), b3 + hstepB); GE_STAGEA(GE_SA(1, 0), a3, 0);
            WAITV(8); WAITL(0); SBAR(); GE_MMA(1, 0, At, B0); GE_MMA(1, 1, At, B1); SBAR(); SCHED();
            } else {
            GE_LDB(B0, 0, 0); SCHED(); GE_LDA(At, 0, 0); GE_STAGEA(GE_SA(1, 1), a1, 1);
            WAITL(8); SBAR(); WAITL(0); GE_MMA(0, 0, At, B0); SBAR(); SCHED();
            if constexpr (P::GATHER) { if (last && has_next) {
#pragma unroll
                for (int i = 0; i < 2; ++i) { int R2, C2; stage_rc(tid * 16 + i * 8192, R2, C2);
#pragma unroll
                    for (int h = 0; h < 2; ++h) oA[h][i] = (unsigned)S.gather_row(nxt, h * HALF + R2) * (unsigned)(S.lda * P::ES) + (unsigned)(C2 * 2); } } }
            GE_LDB(B1, 0, 1); GE_STAGEB(GE_SB(0, 0), b2);
            SBAR(); WAITL(0); GE_MMA(0, 1, At, B1); SBAR();
            GE_LDA(At, 0, 1); GE_STAGEA(GE_SA(0, 0), a2, 0);
            SBAR(); WAITL(0); GE_MMA(1, 0, At, B0); SBAR(); SCHED();
            GE_STAGEB(GE_SB(0, 1), b2 + hstepB);
            WAITV(6); SBAR(); GE_MMA(1, 1, At, B1); SBAR();
            GE_LDB(B0, 1, 0); SCHED(); GE_LDA(At, 1, 0); GE_STAGEA(GE_SA(0, 1), a2, 1);
            WAITL(8); SBAR(); WAITL(0); GE_MMA(0, 0, At, B0); SBAR(); SCHED();
            GE_LDB(B1, 1, 1); GE_STAGEB(GE_SB(1, 0), b3);
            SBAR(); WAITL(0); GE_MMA(0, 1, At, B1); SBAR();
            GE_LDA(At, 1, 1); GE_STAGEA(GE_SA(1, 0), a3, 0);
            SBAR(); WAITL(0); GE_MMA(1, 0, At, B0); SBAR(); SCHED();
            GE_STAGEB(GE_SB(1, 1), b3 + hstepB);
            WAITV(6); SBAR(); GE_MMA(1, 1, At, B1); SBAR();
            }
        }
        if (wr == 0) SBAR();
        S.epi(acc, cur, wr, wc, fr, fq);
        if (!has_next) break;
#pragma unroll
        for (int a = 0; a < 2; ++a)
#pragma unroll
            for (int b = 0; b < 2; ++b)
#pragma unroll
                for (int m = 0; m < 4; ++m)
#pragma unroll
                    for (int n = 0; n < 2; ++n) acc[a][b][m][n] = (f32x4){0.f, 0.f, 0.f, 0.f};
        cur = nxt; cA = nA; cB = nB; ++ui;
        if (wr == 1) SBAR();
    }
    WAITV(0);
    SBAR();
#undef GE_SA
#undef GE_SB
#undef GE_STAGEA
#undef GE_STAGEB
#undef GE_LDA
#undef GE_LDB
#undef GE_MMA
#undef GE_LO
#undef GE_HI
#undef GE_LD1
}
}
using ge::Unit;

struct Params {
    const float* in[26];
    float* out; unsigned char* ws;
    int ph_lo, ph_hi;
};
enum { I_X = 0, I_C, I_CTX, I_CCTX, I_ADAW, I_ADAB, I_NMIX, I_NFFN, I_POOLW, I_POOLS, I_INW, I_CONVW, I_CONVB, I_ALOG, I_DTB, I_DSKIP, I_SNORM, I_OUTW,
       I_W1, I_W3, I_W2, I_RW, I_MW1, I_MW3, I_MW2, I_FNORM };

struct Frame {
    LAS unsigned char* lds;
    int tid, lane, wave, G, bx;
    const Params* p;
    unsigned char* ws;
    unsigned* ctl;
    float* H; float* mod;
};
#ifdef EMU
DEV const float* INP(const Frame& F, int i) { return F.p->in[i]; }
DEV float* OUTP(const Frame& F) { return F.p->out; }
DEV unsigned char* WSP(const Frame& F) { return F.p->ws; }
#define LAUNDER_S(x) ((void)0)
#else
typedef const float* cfptr_t;
DEV const float* INP(const Frame&, int i) { int k = i; asm volatile("" : "+s"(k)); return ((const __attribute__((address_space(4))) cfptr_t*)__builtin_amdgcn_kernarg_segment_ptr())[k]; }
DEV float* OUTP(const Frame& F) { return (float*)INP(F, 26); }
DEV unsigned char* WSP(const Frame& F) { return (unsigned char*)INP(F, 27); }
#define LAUNDER_S(x) asm volatile("" : "+s"(x))
#endif
constexpr int LDS_MISC = ge::STAGE_BYTES;
constexpr int LDS_BYTES = ge::STAGE_BYTES + 16384;

struct Src { const float* x; const float* ctx; float* H; const float* mod; };
DEV const float* modq(const float* mod, int layer, int vec, int which) { return mod + ((size_t)(layer * 3 + vec) * 6 + which) * D; }
DEV const float* modp(const Frame& F, int layer, int vec, int which) { return modq(F.mod, layer, vec, which); }
DEV const float* hsrc_row(const Src& s, bool from_input, int r) {
    if (from_input) return r < ML ? s.x + (size_t)r * D : s.ctx + (size_t)(r - ML) * D;
    return s.H + (size_t)r * D;
}
DEV Src mksrc(const Frame& F) { Src s; s.x = INP(F, I_X); s.ctx = INP(F, I_CTX); s.H = F.H; s.mod = F.mod; return s; }
DEV const float* hin_row(const Frame& F, int layer, int r) { return hsrc_row(mksrc(F), layer == 0, r); }

struct RmId { DEV int operator()(int n0) const { return n0; } };
struct RmIlv { int s; DEV int operator()(int n0) const { return (n0 >> 7) * 256 + s * 128 + (n0 & 127); } };
template <int K, int N, bool F8, class RM>
DEV void convert_job_t(const Frame& F, const float* Wsrc, void* WTv, int ldt, RM rowmap, float scale) {
    LAS float* scr = (LAS float*)(F.lds + F.wave * 16384);
    constexpr int items = (K / 64) * (N / 32), nblk = N / 32; const int gw = F.bx * 8 + F.wave, NGW = F.G * 8, lane = F.lane;
    float nx[32];
#define CJ_LOAD(it_) do { const int _kb = (it_) / nblk, _nb = (it_) % nblk; const float* _p = Wsrc + (size_t)(64 * _kb + (lane >> 5)) * N + 32 * _nb + (lane & 31); \
        _Pragma("unroll") for (int i = 0; i < 32; ++i) nx[i] = _p[(size_t)(2 * i) * N]; } while (0)
    if (gw < items) CJ_LOAD(gw);
    for (int it = gw; it < items; it += NGW) {
        const int kb = it / nblk, nb = it % nblk, k0 = 64 * kb, n0 = 32 * nb;
#pragma unroll
        for (int i = 0; i < 32; ++i) { const int kk = 2 * i + (lane >> 5); scr[kk * 33 + (lane & 31)] = F8 ? nx[i] * scale : nx[i]; }
        if (it + NGW < items) CJ_LOAD(it + NGW);
        WSYNC();
        const int c = lane & 7; const int row0 = rowmap(n0);
#pragma unroll
        for (int j = 0; j < 4; ++j) { const int n = (lane >> 3) + 8 * j; const LAS float* sp = scr + (8 * c) * 33 + n;
            if (F8) { u32x2 o; o.x = pk4_fp8(sp[0 * 33], sp[1 * 33], sp[2 * 33], sp[3 * 33]); o.y = pk4_fp8(sp[4 * 33], sp[5 * 33], sp[6 * 33], sp[7 * 33]);
                *(u32x2*)((fp8_t*)WTv + (size_t)(row0 + n) * ldt + k0 + 8 * c) = o; }
            else { u32x4 o; o.x = pk2(sp[0 * 33], sp[1 * 33]); o.y = pk2(sp[2 * 33], sp[3 * 33]); o.z = pk2(sp[4 * 33], sp[5 * 33]); o.w = pk2(sp[6 * 33], sp[7 * 33]);
                *(u32x4*)((bf16_t*)WTv + (size_t)(row0 + n) * ldt + k0 + 8 * c) = o; } }
        WSYNC();
    }
#undef CJ_LOAD
}
template <int K, int N, class RM> DEV void convert_job(const Frame& F, const float* Wsrc, bf16_t* WT, int ldt, RM rm) { convert_job_t<K, N, false>(F, Wsrc, WT, ldt, rm, 1.0f); }
template <int K, int N, class RM> DEV void convert_job_fp8(const Frame& F, const float* Wsrc, fp8_t* WT, int ldt, RM rm, float scale) { convert_job_t<K, N, true>(F, Wsrc, WT, ldt, rm, scale); }
DEV void convert_even(const Frame& F, int j) {
    bf16_t* Wb = (bf16_t*)(F.ws + OFF_W);
    for (int g = 0; g < 4; ++g) convert_job<256, 256>(F, INP(F, I_POOLW) + ((size_t)j * 4 + g) * 65536, Wb + W_POOL / 2 + (size_t)g * 65536, 256, RmId{});
    convert_job<D, DFF>(F, INP(F, I_W1) + (size_t)j * D * DFF, Wb + W_UP / 2, D, RmIlv{0});
    convert_job<D, DFF>(F, INP(F, I_W3) + (size_t)j * D * DFF, Wb + W_UP / 2, D, RmIlv{1});
    convert_job<DFF, D>(F, INP(F, I_W2) + (size_t)j * DFF * D, Wb + W_DN / 2, DFF, RmId{});
}
DEV void convert_ssd(const Frame& F, int j) {
    bf16_t* Wb = (bf16_t*)(F.ws + OFF_W);
    convert_job<D, NPROJ>(F, INP(F, I_INW) + (size_t)j * D * NPROJ, Wb + W_IN / 2, D, RmId{});
    convert_job<DIN, D>(F, INP(F, I_OUTW) + (size_t)j * DIN * D, Wb + W_OUT / 2, DIN, RmId{});
    { u32x4* z = (u32x4*)(Wb + W_IN / 2 + (size_t)NPROJ * D); const int n16 = (NPROJP - NPROJ) * D * 2 / 16;
      unsigned zz = 0u; LAUNDER_V(zz);
      for (int i = F.bx * 512 + F.tid; i < n16; i += F.G * 512) z[i] = (u32x4){zz, zz, zz, zz}; }
}
DEV void convert_moe(const Frame& F, int j) {
    fp8_t* Wb = (fp8_t*)(F.ws + OFF_W);
    for (int e = 0; e < NEXP; ++e) {
        convert_job_fp8<D, DFFE>(F, INP(F, I_MW1) + ((size_t)j * NEXP + e) * D * DFFE, Wb + W_MUP + (size_t)e * 2 * DFFE * D, D, RmIlv{0}, 32.0f);
        convert_job_fp8<D, DFFE>(F, INP(F, I_MW3) + ((size_t)j * NEXP + e) * D * DFFE, Wb + W_MUP + (size_t)e * 2 * DFFE * D, D, RmIlv{1}, 32.0f);
        if (MOE_DOWN_FP8) convert_job_fp8<DFFE, D>(F, INP(F, I_MW2) + ((size_t)j * NEXP + e) * DFFE * D, Wb + W_MDN + (size_t)e * D * DFFE, DFFE, RmId{}, 64.0f);
        else convert_job<DFFE, D>(F, INP(F, I_MW2) + ((size_t)j * NEXP + e) * DFFE * D, (bf16_t*)(Wb + W_MDN) + (size_t)e * D * DFFE, DFFE, RmId{});
    }
}

DEV void phase_mod(const Frame& F) {
    LAS float* red = (LAS float*)F.lds;
    LAS float* sc = (LAS float*)(F.lds + 8192);
    constexpr int nblk = DEPTH * 6144 / 32;
    const int col = F.tid & 31, ks = F.tid >> 5;
    for (int i = F.tid; i < 3 * D; i += 512) { const int v = i >> 10, k = i & (D - 1); sc[i] = siluf(v == 2 ? INP(F, I_CCTX)[k] : INP(F, I_C)[v * D + k]); }
    __syncthreads();
    for (int blk = F.bx; blk < nblk; blk += F.G) {
        const int layer = (blk * 32) / 6144, n = (blk * 32) % 6144 + col;
        const float* W = INP(F, I_ADAW) + (size_t)layer * D * 6144 + n;
        float a0 = 0.f, a1 = 0.f, a2 = 0.f;
#pragma unroll 1
        for (int kb = ks * 64; kb < ks * 64 + 64; kb += 16) {
            float wv[16];
#pragma unroll
            for (int k = 0; k < 16; ++k) wv[k] = W[(size_t)(kb + k) * 6144];
#pragma unroll
            for (int k = 0; k < 16; ++k) { a0 += sc[kb + k] * wv[k]; a1 += sc[D + kb + k] * wv[k]; a2 += sc[2 * D + kb + k] * wv[k]; } }
        red[(ks * 32 + col) * 3 + 0] = a0; red[(ks * 32 + col) * 3 + 1] = a1; red[(ks * 32 + col) * 3 + 2] = a2;
        __syncthreads();
        if (F.tid < 96) { const int c2 = F.tid & 31, v = F.tid >> 5; float s = 0.f;
            for (int q = 0; q < 16; ++q) s += red[(q * 32 + c2) * 3 + v];
            const int n2 = (blk * 32) % 6144 + c2;
            F.mod[(size_t)(layer * 3 + v) * 6144 + n2] = s + INP(F, I_ADAB)[(size_t)layer * 6144 + n2]; }
        __syncthreads();
    }
}

DEV void load_row(const float* p, int lane, f32x4 (&v)[4]) {
#pragma unroll
    for (int j = 0; j < 4; ++j) v[j] = *(const f32x4*)(p + 4 * lane + 256 * j);
}
DEV float sumsq_row(const f32x4 (&v)[4]) { float s = 0.f;
#pragma unroll
    for (int j = 0; j < 4; ++j) s += (v[j][0] * v[j][0] + v[j][1] * v[j][1]) + (v[j][2] * v[j][2] + v[j][3] * v[j][3]);
    return wave_sum(s); }
DEV void normmod_row(f32x4 (&v)[4], float rstd, const float* w, const float* sh, const float* sc, int lane) {
#pragma unroll
    for (int j = 0; j < 4; ++j) { const int c = 4 * lane + 256 * j; const f32x4 wv = *(const f32x4*)(w + c), sv = *(const f32x4*)(sh + c), cv = *(const f32x4*)(sc + c);
        v[j] = v[j] * rstd * wv * (cv + 1.0f) + sv; }
}
DEV void store_row_bf16(bf16_t* o, int lane, const f32x4 (&v)[4]) {
#pragma unroll
    for (int j = 0; j < 4; ++j) { u32x2 w; w.x = pk2(v[j][0], v[j][1]); w.y = pk2(v[j][2], v[j][3]); *(u32x2*)(o + 4 * lane + 256 * j) = w; }
}

DEV void phase_norm(const Frame& F, int layer, int which, bf16_t* out, bool from_input) {
    const int gw = F.bx * 8 + F.wave, NGW = F.G * 8;
    const float* w = INP(F, which == 0 ? I_NMIX : I_NFFN) + (size_t)layer * D;
    f32x4 nx[4];
    if (gw < MT) load_row(hsrc_row(mksrc(F), from_input, gw), F.lane, nx);
    for (int r = gw; r < MT; r += NGW) {
        f32x4 v[4];
#pragma unroll
        for (int q = 0; q < 4; ++q) v[q] = nx[q];
        if (r + NGW < MT) load_row(hsrc_row(mksrc(F), from_input, r + NGW), F.lane, nx);
        const float rstd = rsqrtf(sumsq_row(v) * (1.0f / D) + EPS);
        const int vec = vec_of(r);
        normmod_row(v, rstd, w, modp(F, layer, vec, which), modp(F, layer, vec, which + 1), F.lane);
        store_row_bf16(out + (size_t)r * D, F.lane, v);
    }
}

struct TokInfo { int s0, s1; float g0, g1; };
DEV void phase_poolprep(const Frame& F, int layer, bf16_t* P, bool fuse, const bf16_t* YS) {
    const TokInfo* tok = (const TokInfo*)(F.ws + OFF_TOK);
    LAS bf16_t* ub = (LAS bf16_t*)(F.lds);
    LAS float* rs = (LAS float*)(F.lds + 81920);
    const float* w = INP(F, I_NMIX) + (size_t)layer * D;
    const int ntile = MT / 64;
    const int chunk = F.tid & 127, tg = F.tid >> 7;
    for (int tile = F.bx; tile < ntile; tile += F.G) {
        const int r0 = tile * 64;
        if (r0 < ML) {
            LAS bf16_t* ul = (LAS bf16_t*)(F.lds);
            const int vec = vec_of(r0);
            { f32x4 wc[4], sv[4], g2[4];
#pragma unroll
              for (int jq = 0; jq < 4; ++jq) { const int c = 4 * F.lane + 256 * jq; wc[jq] = *(const f32x4*)(w + c) * (*(const f32x4*)(modp(F, layer, vec, 1) + c) + 1.0f); sv[jq] = *(const f32x4*)(modp(F, layer, vec, 0) + c);
                  g2[jq] = fuse ? *(const f32x4*)(modp(F, layer - 1, vec, 5) + c) * (MOE_DOWN_FP8 ? 0.00390625f : 1.0f) : (f32x4){0.f, 0.f, 0.f, 0.f}; }
              f32x4 nh[4]; u32x2 nya[4], nyb[4]; TokInfo tn; tn.s0 = tn.s1 = 0; tn.g0 = tn.g1 = 0.f;
              { const int r = r0 + F.wave; load_row(hin_row(F, layer, r), F.lane, nh);
                if (fuse) { tn = tok[r];
#pragma unroll
                    for (int jq = 0; jq < 4; ++jq) { const int c = 4 * F.lane + 256 * jq; nya[jq] = *(const u32x2*)(YS + (size_t)tn.s0 * D + c); nyb[jq] = *(const u32x2*)(YS + (size_t)tn.s1 * D + c); } } }
#pragma unroll 1
              for (int k = 0; k < 8; ++k) { const int rl = F.wave + 8 * k, r = r0 + rl;
                  f32x4 v[4]; u32x2 ya[4], yb[4]; const TokInfo ti = tn;
#pragma unroll
                  for (int q = 0; q < 4; ++q) { v[q] = nh[q]; ya[q] = nya[q]; yb[q] = nyb[q]; }
                  if (k < 7) { load_row(hin_row(F, layer, r + 8), F.lane, nh);
                      if (fuse) { tn = tok[r + 8];
#pragma unroll
                          for (int jq = 0; jq < 4; ++jq) { const int c = 4 * F.lane + 256 * jq; nya[jq] = *(const u32x2*)(YS + (size_t)tn.s0 * D + c); nyb[jq] = *(const u32x2*)(YS + (size_t)tn.s1 * D + c); } } }
                  if (fuse) {
#pragma unroll
                      for (int jq = 0; jq < 4; ++jq) { const u32x2 a = ya[jq], b = yb[jq];
                          v[jq][0] += g2[jq][0] * (ti.g0 * bflo(a.x) + ti.g1 * bflo(b.x)); v[jq][1] += g2[jq][1] * (ti.g0 * bfhi(a.x) + ti.g1 * bfhi(b.x));
                          v[jq][2] += g2[jq][2] * (ti.g0 * bflo(a.y) + ti.g1 * bflo(b.y)); v[jq][3] += g2[jq][3] * (ti.g0 * bfhi(a.y) + ti.g1 * bfhi(b.y));
                          *(f32x4*)(F.H + (size_t)r * D + 4 * F.lane + 256 * jq) = v[jq]; } }
                  const float rstd = rsqrtf(sumsq_row(v) * (1.0f / D) + EPS);
#pragma unroll
                  for (int jq = 0; jq < 4; ++jq) { const f32x4 u = v[jq] * rstd * wc[jq] + sv[jq]; u32x2 pw; pw.x = pk2(u[0], u[1]); pw.y = pk2(u[2], u[3]);
                      *(LAS u32x2*)(ul + rl * 1024 + 4 * F.lane + 256 * jq) = pw; } } }
            __syncthreads();
            { const int cq = F.tid & 255, hf = F.tid >> 8, c = cq * 4, g = c >> 8, win = 2 << g, lo = win >> 1, hi = win - 1 - lo;
#define PL_U(t_) ({ const u32x2 _q = *(const LAS u32x2*)(ul + (t_) * 1024 + c); (f32x4){bflo(_q.x), bfhi(_q.x), bflo(_q.y), bfhi(_q.y)}; })
              const int ta = 32 * hf;
              f32x4 sacc = (f32x4){0.f, 0.f, 0.f, 0.f};
              { const int a = (ta - lo > 0) ? ta - lo : 0, b = (ta + hi + 1 < 64) ? ta + hi + 1 : 64; for (int t = a; t < b; ++t) sacc += PL_U(t); }
              for (int t = ta; t < ta + 32; ++t) {
                  const int a = (t - lo > 0) ? t - lo : 0, b = (t + hi + 1 < 64) ? t + hi + 1 : 64;
                  const float inv = 1.0f / (float)(b - a);
                  const f32x4 o = sacc * inv - PL_U(t);
                  u32x2 pw; pw.x = pk2(o[0], o[1]); pw.y = pk2(o[2], o[3]); *(u32x2*)(P + (size_t)(r0 + t) * D + c) = pw;
                  if (t + 1 < ta + 32) { if (t + 1 + hi < 64) sacc += PL_U(t + 1 + hi); if (t - lo >= 0) sacc -= PL_U(t - lo); } }
#undef PL_U
            }
            __syncthreads();
            continue;
        }
        int seq0, seq1;
        if (r0 < ML) { seq0 = r0; seq1 = r0 + 64; } else { seq0 = ML + ((r0 - ML) / CTXL) * CTXL; seq1 = seq0 + CTXL; }
        const int lo_r = (r0 - 8 > seq0) ? r0 - 8 : seq0, hi_r = (r0 + 64 + 7 < seq1) ? r0 + 64 + 7 : seq1;
        const int nrow = hi_r - lo_r;
        for (int rb = lo_r + F.wave; rb < hi_r; rb += 16) {
            f32x4 v5[2][4];
#pragma unroll
            for (int k = 0; k < 2; ++k) { const int r = rb + 8 * k; if (r < hi_r) load_row(hin_row(F, layer, r), F.lane, v5[k]); }
#pragma unroll
            for (int k = 0; k < 2; ++k) { const int r = rb + 8 * k; if (r < hi_r) { const float ss = sumsq_row(v5[k]); if (F.lane == 0) rs[r - lo_r] = rsqrtf(ss * (1.0f / D) + EPS); } } }
        __syncthreads();
        const int vec = vec_of(r0);
#pragma unroll 1
        for (int half = 0; half < 2; ++half) {
            const int c = half * 512 + 4 * chunk, g = c >> 8, win = 2 << g, lo = win >> 1, hi = win - 1 - lo;
            const f32x4 wv = *(const f32x4*)(w + c), sv = *(const f32x4*)(modp(F, layer, vec, 0) + c), cv = *(const f32x4*)(modp(F, layer, vec, 1) + c) + 1.0f;
            const f32x4 wc = wv * cv;
#pragma unroll 1
            for (int kb = 0; kb < 20; kb += 5) {
                f32x4 hv[5];
#pragma unroll
                for (int k = 0; k < 5; ++k) { const int rr = tg + 4 * (kb + k); if (rr < nrow) hv[k] = *(const f32x4*)(hin_row(F, layer, lo_r + rr) + c); }
#pragma unroll
                for (int k = 0; k < 5; ++k) { const int rr = tg + 4 * (kb + k); if (rr < nrow) { const f32x4 u = hv[k] * rs[rr] * wc + sv;
                    u32x2 pw; pw.x = pk2(u[0], u[1]); pw.y = pk2(u[2], u[3]); *(LAS u32x2*)(ub + rr * 512 + 4 * chunk) = pw; } } }
            __syncthreads();
#define PP_U(r_) ({ const u32x2 _q = *(const LAS u32x2*)(ub + ((r_) - lo_r) * 512 + 4 * chunk); (f32x4){bflo(_q.x), bfhi(_q.x), bflo(_q.y), bfhi(_q.y)}; })
            const int ta = r0 + 16 * tg;
            f32x4 s = (f32x4){0.f, 0.f, 0.f, 0.f};
            { const int a = (ta - lo > seq0) ? ta - lo : seq0, b = (ta + hi + 1 < seq1) ? ta + hi + 1 : seq1; for (int r = a; r < b; ++r) s += PP_U(r); }
            for (int t = ta; t < ta + 16; ++t) {
                const int a = (t - lo > seq0) ? t - lo : seq0, b = (t + hi + 1 < seq1) ? t + hi + 1 : seq1;
                const float inv = 1.0f / (float)(b - a);
                const f32x4 o = s * inv - PP_U(t);
                u32x2 pw; pw.x = pk2(o[0], o[1]); pw.y = pk2(o[2], o[3]); *(u32x2*)(P + (size_t)t * D + c) = pw;
                if (t + 1 < ta + 16) {
                    if (t + 1 + hi < seq1) s += PP_U(t + 1 + hi);
                    if (t - lo >= seq0) s -= PP_U(t - lo); }
            }
#undef PP_U
            __syncthreads();
        }
    }
}

struct PolBase { int G, c; };
struct PolPool : PolBase {
    static constexpr bool PERM = false, GATHER = false; static constexpr bool FP8 = false; static constexpr int ES = 2; int K, lda, ldb;
    const bf16_t* P; const bf16_t* W; Src src; int layer; const float* scale;
    DEV bool next(int i, Unit& u) const { return ge::static_next(NPAN, 4, G, c, i, u); }
    DEV const char* a_base(const Unit& u) const { return (const char*)(P + (size_t)u.pm * 256 * D + u.pn * 256); }
    DEV const char* b_base(const Unit& u) const { return (const char*)(W + (size_t)u.pn * 65536); }
    DEV void epi(const f32x4 (&acc)[2][2][4][2], const Unit& u, int wr, int wc, int fr, int fq) const {
        const int row0 = u.pm * 256 + wr * 64 + fr, col0 = u.pn * 256 + wc * 32 + 4 * fq; const int vec = vec_of(u.pm * 256);
        const float* g1 = modq(src.mod, layer, vec, 2);
        f32x4 gv[2][2];
#pragma unroll
        for (int bj = 0; bj < 2; ++bj)
#pragma unroll
            for (int n = 0; n < 2; ++n) { const int cc = col0 + bj * 128 + n * 16; gv[bj][n] = *(const f32x4*)(g1 + cc) * *(const f32x4*)(scale + cc); }
#pragma unroll
        for (int ai = 0; ai < 2; ++ai)
#pragma unroll
            for (int m = 0; m < 4; ++m) { const int r = row0 + ai * 128 + m * 16; const float* hi = hsrc_row(src, layer == 0, r) + col0; float* ho = src.H + (size_t)r * D + col0;
#pragma unroll
                for (int bj = 0; bj < 2; ++bj)
#pragma unroll
                    for (int n = 0; n < 2; ++n) *(f32x4*)(ho + bj * 128 + n * 16) = *(const f32x4*)(hi + bj * 128 + n * 16) + gv[bj][n] * acc[ai][bj][m][n]; }
    }
};
struct PolResid : PolBase {
    static constexpr bool PERM = false, GATHER = false; static constexpr bool FP8 = false; static constexpr int ES = 2; int K, lda, ldb;
    const bf16_t* A; const bf16_t* W; Src src; int layer, which, npan;
    DEV bool next(int i, Unit& u) const { return ge::static_next(npan, 4, G, c, i, u); }
    DEV const char* a_base(const Unit& u) const { return (const char*)(A + (size_t)u.pm * 256 * lda); }
    DEV const char* b_base(const Unit& u) const { return (const char*)(W + (size_t)u.pn * 256 * ldb); }
    DEV void epi(const f32x4 (&acc)[2][2][4][2], const Unit& u, int wr, int wc, int fr, int fq) const {
        const int row0 = u.pm * 256 + wr * 64 + fr, col0 = u.pn * 256 + wc * 32 + 4 * fq; const int vec = vec_of(u.pm * 256);
        const float* gp = modq(src.mod, layer, vec, which);
        f32x4 gv[2][2];
#pragma unroll
        for (int bj = 0; bj < 2; ++bj)
#pragma unroll
            for (int n = 0; n < 2; ++n) gv[bj][n] = *(const f32x4*)(gp + col0 + bj * 128 + n * 16);
#pragma unroll
        for (int ai = 0; ai < 2; ++ai)
#pragma unroll
            for (int mp = 0; mp < 4; mp += 2) { f32x4 hv[2][2][2];
#pragma unroll
                for (int m2 = 0; m2 < 2; ++m2) { const float* hi = src.H + (size_t)(row0 + ai * 128 + (mp + m2) * 16) * D + col0;
#pragma unroll
                    for (int bj = 0; bj < 2; ++bj)
#pragma unroll
                        for (int n = 0; n < 2; ++n) hv[m2][bj][n] = *(const f32x4*)(hi + bj * 128 + n * 16); }
#pragma unroll
                for (int m2 = 0; m2 < 2; ++m2) { float* ho = src.H + (size_t)(row0 + ai * 128 + (mp + m2) * 16) * D + col0;
#pragma unroll
                    for (int bj = 0; bj < 2; ++bj)
#pragma unroll
                        for (int n = 0; n < 2; ++n) *(f32x4*)(ho + bj * 128 + n * 16) = hv[m2][bj][n] + gv[bj][n] * acc[ai][bj][mp + m2][n]; } }
    }
};
template <bool MOE>
struct PolUp : PolBase {
    static constexpr bool PERM = true, GATHER = MOE, FP8 = MOE; static constexpr int ES = MOE ? 1 : 2; int K, lda, ldb;
    const bf16_t* A; const bf16_t* W; bf16_t* HID; int ldh, nq;
    int nM; const int* s2t; int tstart[NEXP + 1];
    DEV bool next(int i, Unit& u) const { return ge::static_next(MOE ? nM : NPAN, nq, G, c, i, u); }
    DEV int expert_of(int pm) const { int e = 0;
#pragma unroll
        for (int k = 1; k < NEXP; ++k) e += (pm >= tstart[k]) ? 1 : 0;
        return e; }
    DEV const char* a_base(const Unit& u) const { return MOE ? (const char*)A : (const char*)(A + (size_t)u.pm * 256 * lda); }
    DEV const char* b_base(const Unit& u) const { size_t off = (size_t)u.pn * 256 * ldb; if (MOE) off += (size_t)expert_of(u.pm) * 2 * DFFE * ldb; return (const char*)W + off * ES; }
    DEV int gather_row(const Unit& u, int R) const { return s2t[u.pm * 256 + R]; }
    DEV void epi(const f32x4 (&acc)[2][2][4][2], const Unit& u, int wr, int wc, int fr, int fq) const {
        const int row0 = u.pm * 256 + wr * 64 + fr, col0 = u.pn * 128 + wc * 32 + 8 * fq;
#pragma unroll
        for (int ai = 0; ai < 2; ++ai)
#pragma unroll
            for (int m = 0; m < 4; ++m) { bf16_t* o = HID + (size_t)(row0 + ai * 128 + m * 16) * ldh + col0;
                float h[8];
#pragma unroll
                for (int n = 0; n < 2; ++n)
#pragma unroll
                    for (int i = 0; i < 4; ++i) { if (MOE) h[4 * n + i] = siluf(acc[ai][0][m][n][i] * 0.00390625f) * (acc[ai][1][m][n][i] * (MOE_DOWN_FP8 ? 0.015625f : 0.00390625f));
                                                  else h[4 * n + i] = siluf(acc[ai][0][m][n][i]) * acc[ai][1][m][n][i]; }
                if (MOE && MOE_DOWN_FP8) { u32x2 w8; w8.x = pk4_fp8(h[0], h[1], h[2], h[3]); w8.y = pk4_fp8(h[4], h[5], h[6], h[7]);
                    *(u32x2*)((fp8_t*)HID + (size_t)(row0 + ai * 128 + m * 16) * ldh + col0) = w8; }
                else { u32x4 w; w.x = pk2(h[0], h[1]); w.y = pk2(h[2], h[3]); w.z = pk2(h[4], h[5]); w.w = pk2(h[6], h[7]); *(u32x4*)o = w; } }
    }
};
struct PolMoeDown : PolBase {
    static constexpr bool PERM = true, GATHER = (MOE_DOWN_FP8 != 0), FP8 = (MOE_DOWN_FP8 != 0); static constexpr int ES = MOE_DOWN_FP8 ? 1 : 2; int K, lda, ldb;
    const bf16_t* A; const bf16_t* W; bf16_t* YS; int nM; int tstart[NEXP + 1];
    DEV bool next(int i, Unit& u) const { return ge::static_next(nM, 4, G, c, i, u); }
    DEV int expert_of(int pm) const { int e = 0;
#pragma unroll
        for (int k = 1; k < NEXP; ++k) e += (pm >= tstart[k]) ? 1 : 0;
        return e; }
    DEV const char* a_base(const Unit& u) const { return GATHER ? (const char*)A : (const char*)A + (size_t)u.pm * 256 * lda * ES; }
    DEV int gather_row(const Unit& u, int R) const { return u.pm * 256 + R; }
    DEV const char* b_base(const Unit& u) const { return (const char*)W + ((size_t)expert_of(u.pm) * D + (size_t)u.pn * 256) * ldb * ES; }
    DEV void epi(const f32x4 (&acc)[2][2][4][2], const Unit& u, int wr, int wc, int fr, int fq) const {
        const int row0 = u.pm * 256 + wr * 64 + fr, col0 = u.pn * 256 + wc * 32 + 8 * fq;
#pragma unroll
        for (int ai = 0; ai < 2; ++ai)
#pragma unroll
            for (int m = 0; m < 4; ++m) { bf16_t* o = YS + (size_t)(row0 + ai * 128 + m * 16) * D + col0;
#pragma unroll
                for (int bj = 0; bj < 2; ++bj) { u32x4 w; w.x = pk2(acc[ai][bj][m][0][0], acc[ai][bj][m][0][1]); w.y = pk2(acc[ai][bj][m][0][2], acc[ai][bj][m][0][3]);
                    w.z = pk2(acc[ai][bj][m][1][0], acc[ai][bj][m][1][1]); w.w = pk2(acc[ai][bj][m][1][2], acc[ai][bj][m][1][3]); *(u32x4*)(o + bj * 128) = w; } }
    }
};
struct PolInProj : PolBase {
    static constexpr bool PERM = true, GATHER = false; static constexpr bool FP8 = false; static constexpr int ES = 2; int K, lda, ldb;
    const bf16_t* A; const bf16_t* W; bf16_t* Z; bf16_t* XBC; float* DT;
    DEV bool next(int i, Unit& u) const { return ge::static_next(NPAN, NPROJP / 256, G, c, i, u); }
    DEV const char* a_base(const Unit& u) const { return (const char*)(A + (size_t)u.pm * 256 * lda); }
    DEV const char* b_base(const Unit& u) const { return (const char*)(W + (size_t)u.pn * 256 * ldb); }
    DEV void epi(const f32x4 (&acc)[2][2][4][2], const Unit& u, int wr, int wc, int fr, int fq) const {
        const int row0 = u.pm * 256 + wr * 64 + fr, cw = wc * 32 + 8 * fq;
        if (u.pn < 20) {
            bf16_t* base; int ld, col0;
            if (u.pn < 8) { base = Z; ld = DIN; col0 = u.pn * 256 + cw; } else { base = XBC; ld = CONVD; col0 = (u.pn - 8) * 256 + cw; }
#pragma unroll
            for (int ai = 0; ai < 2; ++ai)
#pragma unroll
                for (int m = 0; m < 4; ++m) { bf16_t* o = base + (size_t)(row0 + ai * 128 + m * 16) * ld + col0;
#pragma unroll
                    for (int bj = 0; bj < 2; ++bj) { u32x4 w; w.x = pk2(acc[ai][bj][m][0][0], acc[ai][bj][m][0][1]); w.y = pk2(acc[ai][bj][m][0][2], acc[ai][bj][m][0][3]);
                        w.z = pk2(acc[ai][bj][m][1][0], acc[ai][bj][m][1][1]); w.w = pk2(acc[ai][bj][m][1][2], acc[ai][bj][m][1][3]); *(u32x4*)(o + bj * 128) = w; } }
        } else if (cw < 64) {
#pragma unroll
            for (int ai = 0; ai < 2; ++ai)
#pragma unroll
                for (int m = 0; m < 4; ++m) { const int r = row0 + ai * 128 + m * 16; int b, tv;
                    if (r < ML) { b = r / SEQ; tv = CTXL + r % SEQ; } else { b = (r - ML) / CTXL; tv = (r - ML) % CTXL; }
#pragma unroll
                    for (int n = 0; n < 2; ++n)
#pragma unroll
                        for (int i = 0; i < 4; ++i) { const int j = cw + 4 * n + i, dir = j >> 5, h = j & 31;
                            DT[((size_t)(b * 2 + dir) * NH + h) * TV + tv] = acc[ai][0][m][n][i]; } }
        }
    }
};

DEV void phase_conv(const Frame& F, int j, const bf16_t* XBC, bf16_t* XT, bf16_t* Brow, bf16_t* BT, bf16_t* Crow) {
    LAS bf16_t* tl0 = (LAS bf16_t*)F.lds;
    const float* cw = INP(F, I_CONVW) + (size_t)j * 4 * CONVD; const float* cb = INP(F, I_CONVB) + (size_t)j * CONVD;
    constexpr int NPER = NB * NCH, nitem = NPER * (CONVD / 64);
    const int t2 = 2 * (F.tid >> 3), cg = F.tid & 7;
    const int i0 = (int)(((long)F.bx * nitem) / F.G), i1 = (int)(((long)(F.bx + 1) * nitem) / F.G);
    int cblk_cur = -1; f32x4 wv[4][2], bv[2]; int par = 0;
#define CV_LOAD(it_, q_) do { const int _cb = (it_) / NPER, _rs = (it_) % NPER, _b = _rs / NCH, _cv = _rs % NCH; const int _ch = _cb * 64 + cg * 8, _tv = _cv * 128 + t2; \
        const int _s0 = _tv < CTXL ? 0 : CTXL, _s1 = _tv < CTXL ? CTXL : TV; \
        _Pragma("unroll") for (int k = 0; k < 5; ++k) { const int tk = _tv - 2 + k; q_[k] = (u32x4){0u, 0u, 0u, 0u}; \
            if (tk >= _s0 && tk < _s1) q_[k] = *(const u32x4*)(XBC + (size_t)row_of(_b, tk) * CONVD + _ch); } } while (0)
    u32x4 qn[5];
    if (i0 < i1) CV_LOAD(i0, qn);
    for (int it = i0; it < i1; ++it) {
        const int cblk = it / NPER, rest = it % NPER, b = rest / NCH, cv = rest % NCH;
        const int ch0 = cblk * 64 + cg * 8;
        if (cblk != cblk_cur) { cblk_cur = cblk;
#pragma unroll
            for (int k = 0; k < 4; ++k) { wv[k][0] = *(const f32x4*)(cw + k * CONVD + ch0); wv[k][1] = *(const f32x4*)(cw + k * CONVD + ch0 + 4); }
            bv[0] = *(const f32x4*)(cb + ch0); bv[1] = *(const f32x4*)(cb + ch0 + 4); }
        const int tv = cv * 128 + t2;
        float xin[5][8];
#pragma unroll
        for (int k = 0; k < 5; ++k) { const u32x4 q = qn[k];
            xin[k][0] = bflo(q.x); xin[k][1] = bfhi(q.x); xin[k][2] = bflo(q.y); xin[k][3] = bfhi(q.y); xin[k][4] = bflo(q.z); xin[k][5] = bfhi(q.z); xin[k][6] = bflo(q.w); xin[k][7] = bfhi(q.w); }
        if (it + 1 < i1) CV_LOAD(it + 1, qn);
        unsigned pk[2][4];
#pragma unroll
        for (int o = 0; o < 2; ++o) { float a[8];
#pragma unroll
            for (int i = 0; i < 8; ++i) { float acc = bv[i >> 2][i & 3];
#pragma unroll
                for (int k = 0; k < 4; ++k) acc += wv[k][i >> 2][i & 3] * xin[o + k][i];
                a[i] = siluf(acc); }
#pragma unroll
            for (int i = 0; i < 4; ++i) pk[o][i] = pk2(a[2 * i], a[2 * i + 1]); }
        const int r = row_of(b, tv);
        const bool isx = cblk < DIN / 64, isb = !isx && cblk < (DIN + BCD) / 64;
        if (!isx) { bf16_t* o = (isb ? Brow + (ch0 - DIN) : Crow + (ch0 - DIN - BCD)) + (size_t)r * BCD;
            *(u32x4*)o = (u32x4){pk[0][0], pk[0][1], pk[0][2], pk[0][3]}; *(u32x4*)(o + BCD) = (u32x4){pk[1][0], pk[1][1], pk[1][2], pk[1][3]}; }
        if (isx || isb) {
            LAS bf16_t* tl = tl0 + par * (64 * 136); par ^= 1;
#pragma unroll
            for (int i = 0; i < 4; ++i) { const unsigned lo = (pk[0][i] & 0xffffu) | (pk[1][i] << 16), hi = (pk[0][i] >> 16) | (pk[1][i] & 0xffff0000u);
                *(LAS unsigned*)(tl + (cg * 8 + 2 * i) * 136 + t2) = lo; *(LAS unsigned*)(tl + (cg * 8 + 2 * i + 1) * 136 + t2) = hi; }
            __syncthreads();
            bf16_t* dst = isx ? XT + ((size_t)b * DIN + cblk * 64) * TV : BT + ((size_t)b * BCD + (cblk * 64 - DIN)) * TV;
#pragma unroll
            for (int q = 0; q < 2; ++q) { const int idx = F.tid + q * 512, ch = idx >> 4, t8 = (idx & 15) * 8;
                *(u32x4*)(dst + (size_t)ch * TV + cv * 128 + t8) = *(const LAS u32x4*)(tl + ch * 136 + t8); }
        }
    }
}

#undef CV_LOAD
DEV void phase_cb(const Frame& F, const bf16_t* Brow, const bf16_t* Crow, bf16_t* CB) {
    const int nitem = NB * NG * NCH; const int fr = F.lane & 15, fq = F.lane >> 4;
    for (int it = F.bx; it < nitem; it += F.G) {
        const int cv = it % NCH, g = (it / NCH) % NG, b = it / (NCH * NG);
        const int rbase = row_of(b, cv * 128);
        bf16x8 cf[4];
#pragma unroll
        for (int ks = 0; ks < 4; ++ks) cf[ks] = *(const bf16x8*)(Crow + (size_t)(rbase + 16 * F.wave + fr) * BCD + g * 128 + 32 * ks + 8 * fq);
        bf16_t* out = CB + ((size_t)((b * NG + g) * NCH + cv)) * 16384;
#pragma unroll
        for (int nt = 0; nt < 8; ++nt) {
            f32x4 acc = (f32x4){0.f, 0.f, 0.f, 0.f};
#pragma unroll
            for (int ks = 0; ks < 4; ++ks) { const bf16x8 bfr = *(const bf16x8*)(Brow + (size_t)(rbase + 16 * nt + fr) * BCD + g * 128 + 32 * ks + 8 * fq); acc = MFMA16(bfr, cf[ks], acc); }
            u32x2 w; w.x = pk2(acc[0], acc[1]); w.y = pk2(acc[2], acc[3]);
            *(u32x2*)(out + (size_t)(16 * F.wave + fr) * 128 + 16 * nt + 4 * fq) = w;
        }
    }
}

DEV void phase_tables(const Frame& F, int j, float* DT, float* CUM, float* WJ, float* CF) {
    const int nitem = NB * 2 * NH * NCH; const int gw = F.bx * 8 + F.wave, NGW = F.G * 8;
    for (int it = gw; it < nitem; it += NGW) {
        const int cv = it % NCH, h = (it / NCH) % NH, dir = (it / (NCH * NH)) & 1, b = it / (NCH * NH * 2);
        const float A = -expf(INP(F, I_ALOG)[(size_t)(j * 2 + dir) * NH + h]); const float bias = INP(F, I_DTB)[(size_t)(j * 2 + dir) * NH + h];
        const size_t o = ((size_t)(b * 2 + dir) * NH + h) * TV + cv * 128 + 2 * F.lane;
        const f32x2 raw = *(const f32x2*)(DT + o); const float d0 = softplusf(raw.x + bias), d1 = softplusf(raw.y + bias); const float a0 = d0 * A, a1 = d1 * A;
        float c0, c1, tot, sum = a0 + a1;
        if (dir == 0) {
#pragma unroll
            for (int q = 1; q < 64; q <<= 1) { const float t2 = __shfl_up(sum, q); if (F.lane >= q) sum += t2; }
            c1 = sum; c0 = sum - a1; tot = __shfl(sum, 63);
        } else {
#pragma unroll
            for (int q = 1; q < 64; q <<= 1) { const float t2 = __shfl_down(sum, q); if (F.lane + q < 64) sum += t2; }
            c0 = sum; c1 = sum - a0; tot = __shfl(sum, 0);
        }
        constexpr float L2E = 1.4426950408889634f;
        *(f32x2*)(DT + o) = (f32x2){c0 * L2E - flog2(d0), c1 * L2E - flog2(d1)};
        *(f32x2*)(CUM + o) = (f32x2){c0 * L2E, c1 * L2E};
        *(f32x2*)(WJ + o) = (f32x2){d0 * FEXP(tot - c0), d1 * FEXP(tot - c1)};
        const float cref = L2E * __shfl(dir == 0 ? c1 : c0, dir == 0 ? (F.lane | 15) : (F.lane & ~15));
        *(f32x2*)(CF + o) = (f32x2){d0 * fexp2(cref - c0 * L2E), d1 * fexp2(cref - c1 * L2E)};
    }
}

constexpr int SC_HL = 0, SC_TAB = 17408, SC_CB = 21504, SC_BT = SC_CB + 32768, SC_C = SC_BT + 32768, SC_X = SC_C + 32768, SC_END = SC_X + 8192;
static_assert(SC_END <= ge::STAGE_BYTES, "scan LDS map");
DEV void phase_scan(const Frame& F, int j, const bf16_t* XT, const bf16_t* BT, const bf16_t* Crow, const bf16_t* CB, const float* DT, const float* CUM, const float* WJ, const float* CF, bf16_t* Yf, bf16_t* Yb) {
    LAS unsigned char* L = F.lds;
    LAS bf16_t* Hl = (LAS bf16_t*)(L + SC_HL);
    LAS float* tab = (LAS float*)(L + SC_TAB);
    const int fr = F.lane & 15, fq = F.lane >> 4, w = F.wave;
    const int nitem = NB * NH * 2 * 2;
    for (int it = F.bx; it < nitem; it += F.G) {
        const int xq = it & 7, kq = it >> 3; const int b = xq >> 2, g = xq & 3, h = 8 * g + (kq >> 2), dir = (kq >> 1) & 1, ph = kq & 1;
        const float Dsk = dir == 0 ? INP(F, I_DSKIP)[(size_t)j * NH + h] : 0.f;
        const size_t tbase = ((size_t)(b * 2 + dir) * NH + h) * TV;
        const bf16_t* xt = XT + ((size_t)b * DIN + h * HD + ph * 32) * TV;
        const bf16_t* bt = BT + ((size_t)b * BCD + g * 128) * TV;
        const bf16_t* CBh = CB + (size_t)((b * NG + g) * NCH) * 16384;
        const bf16_t* Cg = Crow + g * 128;
        bf16_t* Y = (dir ? Yb : Yf) + h * HD + ph * 32;
        const int lrow = 16 * w + fr;
        const int dr = F.lane >> 4, dc = F.lane & 15;
        f32x4 accH[2]; accH[0] = (f32x4){0.f, 0.f, 0.f, 0.f}; accH[1] = accH[0];
        for (int i = F.tid; i < 32 * 136 / 2; i += 512) ((LAS unsigned*)Hl)[i] = 0u;
#define SC_CHUNK_OF(step) (dir == 0 ? (step) : ((step) < 2 ? 1 - (step) : (NCH - 1) - ((step) - 2)))
        const int rsw = (4 * (w & 3) + dr) & 15, gc = dc ^ rsw;
        const unsigned loCB = (unsigned)(dr * 128 + 8 * gc) * 2u, loT = (unsigned)(dr * TV + 8 * gc) * 2u, loC = (unsigned)(dr * BCD + 8 * gc) * 2u;
#define SC_ISSUE_TILES(cvx_) SC_ISSUE_PIECES(cvx_, 0, 13)
#define SC_ISSUE_PIECES(cvx_, j0_, j1_) do { const int cvx = (cvx_); const unsigned tvx = cvx * 128u; const unsigned rbx = (unsigned)row_of(b, cvx * 128); \
            _Pragma("unroll") for (int jj = (j0_); jj < (j1_); ++jj) { const int q = 8 * jj + w, r0 = 4 * (q & 31);   \
                const char* src; int toff; \
                if (jj < 4) { src = (const char*)(CBh + ((size_t)cvx * 16384u + (unsigned)r0 * 128u)) + loCB; toff = SC_CB; } \
                else if (jj < 8) { src = (const char*)(bt + ((size_t)r0 * TV + tvx)) + loT; toff = SC_BT; } \
                else if (jj < 12) { src = (const char*)(Cg + (size_t)(rbx + r0) * BCD) + loC; toff = SC_C; } \
                else { src = (const char*)(xt + ((size_t)r0 * TV + tvx)) + loT; toff = SC_X; } \
                GLDS16(src, L + toff + (q & 31) * 1024); } } while (0)
        const int kd = w >> 1; float km[8], dk[8];
#pragma unroll
        for (int i = 0; i < 8; ++i) { const int sidx = 32 * kd + 8 * fq + i; km[i] = (dir == 0 ? (sidx <= lrow) : (sidx >= lrow)) ? 1.f : 0.f; dk[i] = (sidx == lrow) ? Dsk : 0.f; }
#define SC_ISSUE_TAB(cvx_, tbuf_) do { const int tsel = w >> 1, half = w & 1; const float* tsrc = tsel == 0 ? CUM : (tsel == 1 ? DT : (tsel == 2 ? WJ : CF)); \
            GLDS4(tsrc + tbase + (cvx_) * 128 + half * 64 + F.lane, (LAS unsigned char*)(tab + (tbuf_) * 512 + tsel * 128 + half * 64)); } while (0)
        { const int cv0 = SC_CHUNK_OF(0); SC_ISSUE_TILES(cv0); SC_ISSUE_TAB(cv0, 0); }
        for (int step = 0; step < NCH; ++step) {
            const int cv = SC_CHUNK_OF(step), buf = step & 1; const bool more = step + 1 < NCH;
            const int cvn = more ? SC_CHUNK_OF(step + 1) : cv;
            const unsigned rbase = (unsigned)row_of(b, cv * 128);
            if (step == 0) WAITV(0); else WAITV(2);
            LDSBAR();
            u32x4 rcb[4], rbt[4]; bf16x8 xf[2][4], cf[4];
#pragma unroll
            for (int ks = 0; ks < 4; ++ks) { const int fo = lrow * 256 + (((4 * ks + fq) ^ fr) << 4);
                rcb[ks] = *(const LAS u32x4*)(L + SC_CB + fo); rbt[ks] = *(const LAS u32x4*)(L + SC_BT + fo); cf[ks] = *(const LAS bf16x8*)(L + SC_C + fo);
#pragma unroll
                for (int nt = 0; nt < 2; ++nt) xf[nt][ks] = *(const LAS bf16x8*)(L + SC_X + (16 * nt + fr) * 256 + (((4 * ks + fq) ^ fr) << 4)); }
            LDSBAR();
            const LAS float* tb = tab + buf * 512;
            const float cl2 = tb[lrow]; const float ecum_l = fexp2(cl2);
            const float chunk_decay = fexp2(dir == 0 ? tb[127] : tb[0]);
            bf16x8 mf[4], bw[4];
#pragma unroll
            for (int ks = 0; ks < 4; ++ks) { const int s0 = 32 * ks + 8 * fq;
                const bool none = dir == 0 ? (ks > kd) : (ks < kd), diag = (ks == kd);
                unsigned om[4] = {0u, 0u, 0u, 0u};
                if (!none) {
                    const unsigned qc[4] = {rcb[ks].x, rcb[ks].y, rcb[ks].z, rcb[ks].w};
                    float v[8];
                    if (!diag) {
                        const f32x4 f0 = *(const LAS f32x4*)(tb + 384 + s0), f1 = *(const LAS f32x4*)(tb + 384 + s0 + 4);
                        const float rowf = fexp2(cl2 - tb[dir == 0 ? 32 * ks + 31 : 32 * ks]);
                        const float cfv[8] = {f0[0], f0[1], f0[2], f0[3], f1[0], f1[1], f1[2], f1[3]};
#pragma unroll
                        for (int i = 0; i < 8; ++i) { const float cbv = (i & 1) ? bfhi(qc[i >> 1]) : bflo(qc[i >> 1]); v[i] = cbv * (rowf * cfv[i]); }
                    } else {
                        const f32x4 cs0 = *(const LAS f32x4*)(tb + 128 + s0), cs1 = *(const LAS f32x4*)(tb + 128 + s0 + 4);
                        const float cs[8] = {cs0[0], cs0[1], cs0[2], cs0[3], cs1[0], cs1[1], cs1[2], cs1[3]};
#pragma unroll
                        for (int i = 0; i < 8; ++i) { const float cbv = (i & 1) ? bfhi(qc[i >> 1]) : bflo(qc[i >> 1]); const float x = cl2 - cs[i]; v[i] = (cbv * fexp2(x < 60.f ? x : 60.f)) * km[i] + dk[i]; }
                    }
#pragma unroll
                    for (int i = 0; i < 4; ++i) om[i] = pk2(v[2 * i], v[2 * i + 1]);
                }
                mf[ks] = __builtin_bit_cast(bf16x8, (u32x4){om[0], om[1], om[2], om[3]});
                { const f32x4 ws0 = *(const LAS f32x4*)(tb + 256 + s0), ws1 = *(const LAS f32x4*)(tb + 256 + s0 + 4); const float wsv[8] = {ws0[0], ws0[1], ws0[2], ws0[3], ws1[0], ws1[1], ws1[2], ws1[3]};
                  const unsigned qb[4] = {rbt[ks].x, rbt[ks].y, rbt[ks].z, rbt[ks].w}; unsigned ob[4];
#pragma unroll
                  for (int i = 0; i < 4; ++i) ob[i] = pk2(bflo(qb[i]) * wsv[2 * i], bfhi(qb[i]) * wsv[2 * i + 1]);
                  bw[ks] = __builtin_bit_cast(bf16x8, (u32x4){ob[0], ob[1], ob[2], ob[3]}); }
                if (more) { if (ks == 0) SC_ISSUE_PIECES(cvn, 0, 4); else if (ks == 1) SC_ISSUE_PIECES(cvn, 4, 8); else if (ks == 2) SC_ISSUE_PIECES(cvn, 8, 12); else { SC_ISSUE_PIECES(cvn, 12, 13); SC_ISSUE_TAB(cvn, buf ^ 1); } } }
            f32x4 yd[2], yo[2];
#pragma unroll
            for (int nt = 0; nt < 2; ++nt) { yd[nt] = (f32x4){0.f, 0.f, 0.f, 0.f}; yo[nt] = yd[nt]; accH[nt] = accH[nt] * chunk_decay; }
#pragma unroll
            for (int nt = 0; nt < 2; ++nt)
#pragma unroll
                for (int ks = 0; ks < 4; ++ks) {
                    yd[nt] = MFMA16(xf[nt][ks], mf[ks], yd[nt]);
                    const bf16x8 hf = *(const LAS bf16x8*)(Hl + buf * (32 * 136) + (16 * nt + fr) * 136 + 32 * ks + 8 * fq);
                    yo[nt] = MFMA16(hf, cf[ks], yo[nt]);
                    accH[nt] = MFMA16(bw[ks], xf[nt][ks], accH[nt]); }
#pragma unroll
            for (int nt = 0; nt < 2; ++nt) { u32x2 hw; hw.x = pk2(accH[nt][0], accH[nt][1]); hw.y = pk2(accH[nt][2], accH[nt][3]);
                *(LAS u32x2*)(Hl + (buf ^ 1) * (32 * 136) + (16 * nt + fr) * 136 + 16 * w + 4 * fq) = hw; }
#pragma unroll
            for (int nt = 0; nt < 2; ++nt) { u32x2 yw; yw.x = pk2(yd[nt][0] + ecum_l * yo[nt][0], yd[nt][1] + ecum_l * yo[nt][1]); yw.y = pk2(yd[nt][2] + ecum_l * yo[nt][2], yd[nt][3] + ecum_l * yo[nt][3]);
                *(u32x2*)(Y + ((size_t)(rbase + lrow) * DIN + 16 * nt + 4 * fq)) = yw; }
        }
        WAITV(0); LDSBAR();
    }
}

DEV void phase_gate(const Frame& F, int j, const bf16_t* Yf, const bf16_t* Yb, const bf16_t* Z, bf16_t* YN, int nrows) {
    const int gw = F.bx * 8 + F.wave, NGW = F.G * 8; const float* nw = INP(F, I_SNORM) + (size_t)j * DIN;
    u32x4 na[4], nb[4], nz[4];
    if (gw < nrows) {
#pragma unroll
        for (int q = 0; q < 4; ++q) { const size_t o = (size_t)gw * DIN + 8 * F.lane + 512 * q; na[q] = *(const u32x4*)(Yf + o); nb[q] = *(const u32x4*)(Yb + o); nz[q] = *(const u32x4*)(Z + o); } }
    for (int r = gw; r < nrows; r += NGW) {
        float t[32]; float ss = 0.f;
        u32x4 ca[4], cb4[4], cz[4];
#pragma unroll
        for (int q = 0; q < 4; ++q) { ca[q] = na[q]; cb4[q] = nb[q]; cz[q] = nz[q]; }
        if (r + NGW < nrows) {
#pragma unroll
            for (int q = 0; q < 4; ++q) { const size_t o = (size_t)(r + NGW) * DIN + 8 * F.lane + 512 * q; na[q] = *(const u32x4*)(Yf + o); nb[q] = *(const u32x4*)(Yb + o); nz[q] = *(const u32x4*)(Z + o); } }
#pragma unroll
        for (int q = 0; q < 4; ++q) { const u32x4 a = ca[q], bq = cb4[q], z = cz[q];
            const unsigned aa[4] = {a.x, a.y, a.z, a.w}, bb[4] = {bq.x, bq.y, bq.z, bq.w}, zz[4] = {z.x, z.y, z.z, z.w};
#pragma unroll
            for (int i = 0; i < 4; ++i) { const float v0 = (bflo(aa[i]) + bflo(bb[i])) * siluf(bflo(zz[i])), v1 = (bfhi(aa[i]) + bfhi(bb[i])) * siluf(bfhi(zz[i])); t[8 * q + 2 * i] = v0; t[8 * q + 2 * i + 1] = v1; ss += v0 * v0 + v1 * v1; } }
        const float rstd = rsqrtf(wave_sum(ss) * (1.0f / DIN) + EPS);
#pragma unroll
        for (int q = 0; q < 4; ++q) { const int c = 8 * F.lane + 512 * q; const f32x4 w0 = *(const f32x4*)(nw + c), w1 = *(const f32x4*)(nw + c + 4);
            u32x4 o; o.x = pk2(t[8 * q] * rstd * w0[0], t[8 * q + 1] * rstd * w0[1]); o.y = pk2(t[8 * q + 2] * rstd * w0[2], t[8 * q + 3] * rstd * w0[3]);
            o.z = pk2(t[8 * q + 4] * rstd * w1[0], t[8 * q + 5] * rstd * w1[1]); o.w = pk2(t[8 * q + 6] * rstd * w1[2], t[8 * q + 7] * rstd * w1[3]);
            *(u32x4*)(YN + (size_t)r * DIN + c) = o; }
    }
}

DEV void phase_route(const Frame& F, int layer, int ml, bf16_t* V, int nrows) {
    LAS unsigned* lc = (LAS unsigned*)(F.lds + LDS_MISC + 256);
    if (F.tid < 8) lc[F.tid] = 0u;
    __syncthreads();
    const int gw = F.bx * 8 + F.wave, NGW = F.G * 8; const int j = layer / 2;
    const float* w = INP(F, I_NFFN) + (size_t)layer * D; const float* rw = INP(F, I_RW) + (size_t)j * D * NEXP;
    LAS float* rwl = (LAS float*)F.lds;
    for (int q = F.tid; q < D * 2; q += 512) { const int c = q >> 1, hf = q & 1; const int ln = (c & 255) >> 2, ii = c & 3, jq = c >> 8;
        *(LAS f32x4*)(rwl + ((jq * 4 + ii) * 64 + ln) * 8 + hf * 4) = *(const f32x4*)(rw + (size_t)q * 4); }
    __syncthreads();
    TokInfo* tok = (TokInfo*)(F.ws + OFF_TOK);
    f32x4 nx[4];
    if (gw < nrows) load_row(F.H + (size_t)gw * D, F.lane, nx);
    for (int r = gw; r < nrows; r += NGW) {
        f32x4 v[4];
#pragma unroll
        for (int q = 0; q < 4; ++q) v[q] = nx[q];
        if (r + NGW < nrows) load_row(F.H + (size_t)(r + NGW) * D, F.lane, nx);
        const float rstd = rsqrtf(sumsq_row(v) * (1.0f / D) + EPS);
        const int vec = vec_of(r);
        normmod_row(v, rstd, w, modp(F, layer, vec, 3), modp(F, layer, vec, 4), F.lane);
#pragma unroll
        for (int jq = 0; jq < 4; ++jq) *(unsigned*)((fp8_t*)V + (size_t)r * D + 4 * F.lane + 256 * jq) = pk4_fp8(v[jq][0] * 8.0f, v[jq][1] * 8.0f, v[jq][2] * 8.0f, v[jq][3] * 8.0f);
        float lg[NEXP];
#pragma unroll
        for (int e = 0; e < NEXP; ++e) lg[e] = 0.f;
#pragma unroll
        for (int jj = 0; jj < 4; ++jj)
#pragma unroll
            for (int i = 0; i < 4; ++i) { const LAS float* rp = rwl + ((jj * 4 + i) * 64 + F.lane) * 8; const f32x4 r0 = *(const LAS f32x4*)rp, r1 = *(const LAS f32x4*)(rp + 4);
#pragma unroll
                for (int e = 0; e < 4; ++e) { lg[e] += v[jj][i] * r0[e]; lg[4 + e] += v[jj][i] * r1[e]; } }
#pragma unroll
        for (int e = 0; e < NEXP; ++e) lg[e] = wave_sum(lg[e]);
        int e0 = 0; float v0 = lg[0];
#pragma unroll
        for (int e = 1; e < NEXP; ++e) if (lg[e] > v0) { v0 = lg[e]; e0 = e; }
        int e1 = -1; float v1 = -3.0e38f;
#pragma unroll
        for (int e = 0; e < NEXP; ++e) if (e != e0 && lg[e] > v1) { v1 = lg[e]; e1 = e; }
        const float g1 = frcp(1.0f + FEXP(v0 - v1)), g0 = 1.0f - g1;
        if (F.lane == 0) { TokInfo ti; ti.s0 = e0; ti.s1 = e1; ti.g0 = g0; ti.g1 = g1; tok[r] = ti; atomicAdd((unsigned*)&lc[e0], 1u); atomicAdd((unsigned*)&lc[e1], 1u); }
    }
    __syncthreads();
    if (F.tid < 8) __hip_atomic_fetch_add(F.ctl + CW_CNT + (ml * 8 + F.tid) * 64, lc[F.tid], RLX_AGENT);
}
DEV void tile_starts(const Frame& F, int ml, int (&ts)[NEXP + 1], unsigned (&cnt)[NEXP]) {
    ts[0] = 0;
#pragma unroll
    for (int e = 0; e < NEXP; ++e) { cnt[e] = __hip_atomic_load(F.ctl + CW_CNT + (ml * 8 + e) * 64, RLX_AGENT); ts[e + 1] = ts[e] + (int)((cnt[e] + 255u) / 256u); }
}
DEV void phase_slots(const Frame& F, int ml, int nrows) {
    int ts[NEXP + 1]; unsigned cnt[NEXP]; tile_starts(F, ml, ts, cnt);
    TokInfo* tok = (TokInfo*)(F.ws + OFF_TOK); int* s2t = (int*)(F.ws + OFF_S2T);
    const int gw = F.bx * 8 + F.wave, NGW = F.G * 8;
    for (int base = gw * 64; base < nrows; base += NGW * 64) {
        const int r = base + F.lane; TokInfo ti = tok[r];
        unsigned long long m0[NEXP], m1[NEXP]; unsigned mycnt = 0;
#pragma unroll
        for (int e = 0; e < NEXP; ++e) { m0[e] = __ballot(ti.s0 == e); m1[e] = __ballot(ti.s1 == e); if (F.lane == e) mycnt = (unsigned)(__builtin_popcountll(m0[e]) + __builtin_popcountll(m1[e])); }
        unsigned b0 = 0;
        if (F.lane < NEXP && mycnt) b0 = __hip_atomic_fetch_add(F.ctl + CW_CUR + (ml * 8 + F.lane) * 64, mycnt, RLX_AGENT);
        const unsigned long long below = (1ull << F.lane) - 1ull; int sl0 = 0, sl1 = 0;
#pragma unroll
        for (int e = 0; e < NEXP; ++e) { const unsigned be = __shfl(b0, e); const int c0 = __builtin_popcountll(m0[e]);
            if (ti.s0 == e) sl0 = ts[e] * 256 + (int)be + __builtin_popcountll(m0[e] & below);
            if (ti.s1 == e) sl1 = ts[e] * 256 + (int)be + c0 + __builtin_popcountll(m1[e] & below); }
        ti.s0 = sl0; ti.s1 = sl1; tok[r] = ti; s2t[sl0] = r; s2t[sl1] = r;
    }
    if (F.bx == 0) { for (int e = 0; e < NEXP; ++e) { const int a = ts[e] * 256 + (int)cnt[e], b2 = ts[e + 1] * 256; for (int s = a + F.tid; s < b2; s += 512) s2t[s] = 0; } }
}
DEV void phase_combine(const Frame& F, int layer, const bf16_t* YS, bool final_) {
    const int NGW = F.G * 8; const int gw = F.bx * 8 + F.wave + (final_ ? 0 : ML); const TokInfo* tok = (const TokInfo*)(F.ws + OFF_TOK);
    const int nrows = final_ ? ML : MT;
    f32x4 nh[4]; u32x2 nya[4], nyb[4]; TokInfo tcur, tnxt;
    tcur.s0 = tcur.s1 = 0; tcur.g0 = tcur.g1 = 0.f; tnxt = tcur;
    if (gw < nrows) { tcur = tok[gw]; load_row(F.H + (size_t)gw * D, F.lane, nh);
#pragma unroll
        for (int jj = 0; jj < 4; ++jj) { const int c = 4 * F.lane + 256 * jj; nya[jj] = *(const u32x2*)(YS + (size_t)tcur.s0 * D + c); nyb[jj] = *(const u32x2*)(YS + (size_t)tcur.s1 * D + c); } }
    if (gw + NGW < nrows) tnxt = tok[gw + NGW];
    for (int r = gw; r < nrows; r += NGW) {
        f32x4 v[4]; u32x2 ya[4], yb[4]; TokInfo ti = tcur;
#pragma unroll
        for (int q = 0; q < 4; ++q) { v[q] = nh[q]; ya[q] = nya[q]; yb[q] = nyb[q]; }
        tcur = tnxt;
        if (r + NGW < nrows) { load_row(F.H + (size_t)(r + NGW) * D, F.lane, nh);
#pragma unroll
            for (int jj = 0; jj < 4; ++jj) { const int c = 4 * F.lane + 256 * jj; nya[jj] = *(const u32x2*)(YS + (size_t)tcur.s0 * D + c); nyb[jj] = *(const u32x2*)(YS + (size_t)tcur.s1 * D + c); } }
        if (r + 2 * NGW < nrows) tnxt = tok[r + 2 * NGW];
        if (MOE_DOWN_FP8) { ti.g0 *= 0.00390625f; ti.g1 *= 0.00390625f; }
        const float* g2 = modp(F, layer, vec_of(r), 5);
#pragma unroll
        for (int jj = 0; jj < 4; ++jj) { const int c = 4 * F.lane + 256 * jj; const u32x2 a = ya[jj], b = yb[jj]; const f32x4 gv = *(const f32x4*)(g2 + c);
            v[jj][0] += gv[0] * (ti.g0 * bflo(a.x) + ti.g1 * bflo(b.x)); v[jj][1] += gv[1] * (ti.g0 * bfhi(a.x) + ti.g1 * bfhi(b.x));
            v[jj][2] += gv[2] * (ti.g0 * bflo(a.y) + ti.g1 * bflo(b.y)); v[jj][3] += gv[3] * (ti.g0 * bfhi(a.y) + ti.g1 * bfhi(b.y)); }
        if (!final_) {
#pragma unroll
            for (int jj = 0; jj < 4; ++jj) *(f32x4*)(F.H + (size_t)r * D + 4 * F.lane + 256 * jj) = v[jj];
        } else {
            const float rstd = rsqrtf(sumsq_row(v) * (1.0f / D) + EPS); const float* fw = INP(F, I_FNORM);
#pragma unroll
            for (int jj = 0; jj < 4; ++jj) { const int c = 4 * F.lane + 256 * jj; *(f32x4*)(OUTP(F) + (size_t)r * D + c) = v[jj] * rstd * *(const f32x4*)(fw + c); }
        }
    }
}

constexpr int PH_PER_PAIR = 17, N_PHASES = 1 + 2 * PH_PER_PAIR;
__global__ void __launch_bounds__(512, 2) fwd_kernel(Params prm) {
#ifdef EMU
    unsigned char* lds_raw = emu_lds();
#else
    extern __shared__ __attribute__((aligned(16))) unsigned char lds_raw[];
#endif
    Frame F;
    F.lds = (LAS unsigned char*)lds_raw;
    F.tid = threadIdx.x; F.lane = F.tid & 63; F.wave = RFL(F.tid >> 6); F.G = gridDim.x; F.bx = blockIdx.x;
    F.p = &prm; F.ws = prm.ws; F.ctl = (unsigned*)(prm.ws + OFF_CTL); F.H = (float*)(prm.ws + OFF_H); F.mod = (float*)(prm.ws + OFF_MOD);
    volatile LAS unsigned* misc = (volatile LAS unsigned*)(F.lds + LDS_MISC);
    if (F.tid < 64) misc[F.tid] = 0u;
    __syncthreads();
    XcdBarrier bar; bar.bar = F.ctl + CW_BAR; bar.x = 0; bar.st = misc;
    const int lo = prm.ph_lo, hi = prm.ph_hi;
    if (hi - lo > 1) bar = xcd_barrier_post(F.ctl + CW_BAR, misc);
    int ph = 0;
#ifndef SITE_MASK
#define SITE_MASK 0xFFFFFFFFu
#endif
#ifndef PROBE_REPEAT_SITE
#define PROBE_REPEAT_SITE (-1)
#endif
#define PH_REPS(site) ((PROBE_REPEAT_SITE == (site)) ? 2 : 1)
#define PHASE_BEGIN(site) if (((SITE_MASK >> (site)) & 1u) && lo <= ph && ph < hi) { { int _t = threadIdx.x; LAUNDER_V(_t); F.tid = _t; F.lane = _t & 63; int _b = blockIdx.x; LAUNDER_S(_b); F.bx = _b; int _g = gridDim.x; LAUNDER_S(_g); F.G = _g; \
      F.ws = WSP(F); F.ctl = (unsigned*)(F.ws + OFF_CTL); F.H = (float*)(F.ws + OFF_H); F.mod = (float*)(F.ws + OFF_MOD); } \
      for (int _rep = 0; _rep < PH_REPS(site); ++_rep) { if (_rep) __syncthreads();
#define PHASE_END   } if (ph + 1 < hi) xcd_barrier(bar); } ++ph;
#define B_W (F.ws + OFF_W)
#define B_ACT (F.ws + OFF_ACT)
#define B_P ((bf16_t*)(B_ACT + A_P))
#define B_HID ((bf16_t*)(B_ACT + A_HID))
#define B_U ((bf16_t*)(B_ACT + A_U))
#define B_Z ((bf16_t*)(B_ACT + A_Z))
#define B_XBC ((bf16_t*)(B_ACT + A_XBC))
#define B_DT ((float*)(B_W + W_DT))
#define B_XT ((bf16_t*)(B_ACT + A_XT))
#define B_BROW ((bf16_t*)(B_ACT + A_BROW))
#define B_BT ((bf16_t*)(B_ACT + A_BT))
#define B_CROW ((bf16_t*)(B_ACT + A_CROW))
#define B_CB ((bf16_t*)(B_ACT + A_CB))
#define B_CUM ((float*)(B_ACT + A_CUM))
#define B_WJ ((float*)(B_ACT + A_WJ))
#define B_CF ((float*)(B_ACT + A_CF))
#define B_YF ((bf16_t*)(B_ACT + A_YF))
#define B_YB ((bf16_t*)(B_W + W_YB))
#define B_YN ((bf16_t*)(B_ACT + A_YN))
#define B_V ((bf16_t*)(B_ACT + A_V))
#define B_HIDM ((bf16_t*)(B_ACT + A_HIDM))
#define B_YS ((bf16_t*)(B_ACT + A_YS))

    PHASE_BEGIN(0) phase_mod(F); convert_even(F, 0); PHASE_END

    for (int lp = 0; lp < 2; ++lp) {
        const int le = 2 * lp, lod = 2 * lp + 1;
        PHASE_BEGIN(1) phase_poolprep(F, le, B_P, lp == 1, B_YS); PHASE_END
        PHASE_BEGIN(2) { PolPool S; S.G = F.G; S.c = F.bx; S.K = 256; S.lda = D; S.ldb = 256; S.P = B_P; S.W = (const bf16_t*)(B_W + W_POOL); S.src = mksrc(F); S.layer = le; S.scale = INP(F, I_POOLS) + (size_t)lp * D;
                      ge::gemm_phase(F.lds, S, F.tid); } PHASE_END
        PHASE_BEGIN(3) phase_norm(F, le, 3, B_P, false); PHASE_END
        PHASE_BEGIN(4) { PolUp<false> S; S.G = F.G; S.c = F.bx; S.K = D; S.lda = D; S.ldb = D; S.A = B_P; S.W = (const bf16_t*)(B_W + W_UP); S.HID = B_HID; S.ldh = DFF; S.nq = DFF / 128; S.nM = NPAN; S.s2t = nullptr;
                      ge::gemm_phase(F.lds, S, F.tid); } PHASE_END
        PHASE_BEGIN(5) { PolResid S; S.G = F.G; S.c = F.bx; S.K = DFF; S.lda = DFF; S.ldb = DFF; S.A = B_HID; S.W = (const bf16_t*)(B_W + W_DN); S.src = mksrc(F); S.layer = le; S.which = 5; S.npan = NPAN;
                      ge::gemm_phase(F.lds, S, F.tid); } PHASE_END
        PHASE_BEGIN(6) phase_norm(F, lod, 0, B_U, false); convert_ssd(F, lp); PHASE_END
        PHASE_BEGIN(7) { PolInProj S; S.G = F.G; S.c = F.bx; S.K = D; S.lda = D; S.ldb = D; S.A = B_U; S.W = (const bf16_t*)(B_W + W_IN); S.Z = B_Z; S.XBC = B_XBC; S.DT = B_DT;
                      ge::gemm_phase(F.lds, S, F.tid); } PHASE_END
        PHASE_BEGIN(8) phase_conv(F, lp, B_XBC, B_XT, B_BROW, B_BT, B_CROW); PHASE_END
        PHASE_BEGIN(9) phase_cb(F, B_BROW, B_CROW, B_CB); phase_tables(F, lp, B_DT, B_CUM, B_WJ, B_CF); PHASE_END
        PHASE_BEGIN(10) phase_scan(F, lp, B_XT, B_BT, B_CROW, B_CB, B_DT, B_CUM, B_WJ, B_CF, B_YF, B_YB); PHASE_END
        PHASE_BEGIN(11) phase_gate(F, lp, B_YF, B_YB, B_Z, B_YN, lp == 1 ? ML : MT); PHASE_END
        PHASE_BEGIN(12) { PolResid S; S.G = F.G; S.c = F.bx; S.K = DIN; S.lda = DIN; S.ldb = DIN; S.A = B_YN; S.W = (const bf16_t*)(B_W + W_OUT); S.src = mksrc(F); S.layer = lod; S.which = 2; S.npan = lp == 1 ? ML / 256 : NPAN;
                      ge::gemm_phase(F.lds, S, F.tid); } PHASE_END
        PHASE_BEGIN(13) phase_route(F, lod, lp, B_V, lp == 1 ? ML : MT); convert_moe(F, lp); PHASE_END
        PHASE_BEGIN(14) phase_slots(F, lp, lp == 1 ? ML : MT); PHASE_END
        PHASE_BEGIN(15) { int ts[NEXP + 1]; unsigned cnt[NEXP]; tile_starts(F, lp, ts, cnt);
                      PolUp<true> S; S.G = F.G; S.c = F.bx; S.K = D; S.lda = D; S.ldb = D; S.A = B_V; S.W = (const bf16_t*)(B_W + W_MUP); S.HID = B_HIDM; S.ldh = DFFE; S.nq = DFFE / 128; S.nM = ts[NEXP];
                      S.s2t = (const int*)(F.ws + OFF_S2T);
#pragma unroll
                      for (int e = 0; e <= NEXP; ++e) S.tstart[e] = ts[e];
                      ge::gemm_phase(F.lds, S, F.tid); } PHASE_END
        PHASE_BEGIN(16) { int ts[NEXP + 1]; unsigned cnt[NEXP]; tile_starts(F, lp, ts, cnt);
                      PolMoeDown S; S.G = F.G; S.c = F.bx; S.K = DFFE; S.lda = DFFE; S.ldb = DFFE; S.A = B_HIDM; S.W = (const bf16_t*)(B_W + W_MDN); S.YS = B_YS; S.nM = ts[NEXP];
#pragma unroll
                      for (int e = 0; e <= NEXP; ++e) S.tstart[e] = ts[e];
                      ge::gemm_phase(F.lds, S, F.tid); } PHASE_END
        PHASE_BEGIN(17) phase_combine(F, lod, B_YS, lp == 1); if (lp == 0) convert_even(F, 1); PHASE_END
    }
#undef PHASE_BEGIN
#undef PHASE_END
}

extern "C" void kernel_launch(void* const* d_in, const int* in_sizes, int n_in, void* d_out, int out_size, void* d_ws, size_t ws_size, hipStream_t stream) {
    static int grid = 0;
    if (grid == 0) {
        if (n_in != 26 || ws_size < WS_NEED) { fprintf(stderr, "kernel_launch: need 26 inputs and %zu bytes of workspace (got %d, %zu)\n", (size_t)WS_NEED, n_in, ws_size); grid = -1; return; }
        int dev = 0, cus = 0, per_cu = 0;
        if (hipGetDevice(&dev) != hipSuccess || hipDeviceGetAttribute(&cus, hipDeviceAttributeMultiprocessorCount, dev) != hipSuccess) { grid = -1; return; }
        if (hipFuncSetAttribute((const void*)fwd_kernel, hipFuncAttributeMaxDynamicSharedMemorySize, LDS_BYTES) != hipSuccess) { grid = -1; return; }
        if (hipOccupancyMaxActiveBlocksPerMultiprocessor(&per_cu, (const void*)fwd_kernel, 512, LDS_BYTES) != hipSuccess || per_cu < 1) { fprintf(stderr, "kernel_launch: occupancy query says %d\n", per_cu); }
        (void)hipGetLastError();
        grid = cus;
    }
    if (grid < 0) return;
    (void)in_sizes; (void)out_size;
    if (hipMemsetAsync((char*)d_ws + OFF_CTL, 0, CTL_BYTES, stream) != hipSuccess) return;
    Params p{};
    for (int i = 0; i < 26; ++i) p.in[i] = (const float*)d_in[i];
    p.out = (float*)d_out; p.ws = (unsigned char*)d_ws;
    if (N_LAUNCH_MODE == 1) { p.ph_lo = 0; p.ph_hi = N_PHASES; hipLaunchKernelGGL(fwd_kernel, dim3(grid), dim3(512), LDS_BYTES, stream, p); }
    else for (int ph = 0; ph < N_PHASES; ++ph) { p.ph_lo = ph; p.ph_hi = ph + 1; hipLaunchKernelGGL(fwd_kernel, dim3(grid), dim3(512), LDS_BYTES, stream, p); }
}
```

```cpp
#ifndef EMU
#include <hip/hip_runtime.h>
#endif
#include <cstdio>
#include <cstdint>

#ifndef CFG_SEQ
#define CFG_SEQ 16384
#endif
#ifndef CFG_DFF
#define CFG_DFF 2816
#endif
#ifndef CFG_DFFE
#define CFG_DFFE 3584
#endif
#ifndef MOE_DOWN_FP8
#define MOE_DOWN_FP8 1
#endif
#ifndef N_LAUNCH_MODE
#define N_LAUNCH_MODE 1
#endif

#ifdef EMU
#define LAS
#define DEV inline
#define WAITV(n) ((void)0)
#define WAITL(n) ((void)0)
#define SBAR() emu_wg_sync()
#define SCHED() ((void)0)
#define SETPRIO(x) ((void)0)
#define MFMA16(a, b, c) emu_mfma16(a, b, c)
#define GLDS16(g, l) emu_glds16((const void*)(g), (void*)(l))
#define GLDS4(g, l) emu_glds4((const void*)(g), (void*)(l))
#define MFMA8(a, b, c) emu_mfma8(a, b, c)
#define RFL(x) emu_rfl(x)
#define MEMFENCE() ((void)0)
#define WSYNC() emu_wave_sync()
#define LDSBAR() emu_wg_sync()
#define LAUNDER_V(x) ((void)0)
#define SLEEP1() emu_yield()
#define MY_XCC_ID() ((unsigned)(blockIdx.x & 7u))
#define FENCE_REL() __atomic_thread_fence(__ATOMIC_SEQ_CST)
#define FENCE_ACQ() __atomic_thread_fence(__ATOMIC_SEQ_CST)
#define FEXP(x) expf(x)
#define RLX_AGENT __ATOMIC_RELAXED, 4
#else
#define LAS __attribute__((address_space(3)))
#define DEV __device__ __forceinline__
#define WAITV(n) asm volatile("s_waitcnt vmcnt(" #n ")" ::: "memory")
#define WAITL(n) asm volatile("s_waitcnt lgkmcnt(" #n ")" ::: "memory")
#define SBAR() __builtin_amdgcn_s_barrier()
#define SCHED() __builtin_amdgcn_sched_barrier(0)
#define SETPRIO(x) __builtin_amdgcn_s_setprio(x)
#define MFMA16(a, b, c) __builtin_amdgcn_mfma_f32_16x16x32_bf16(a, b, c, 0, 0, 0)
#define GLDS16(g, l) __builtin_amdgcn_global_load_lds((const unsigned*)(g), (LAS unsigned*)(l), 16, 0, 0)
#define GLDS4(g, l) __builtin_amdgcn_global_load_lds((const unsigned*)(g), (LAS unsigned*)(l), 4, 0, 0)
#define MFMA8(a, b, c) __builtin_amdgcn_mfma_scale_f32_16x16x128_f8f6f4(a, b, c, 0, 0, 0, 0x7f7f7f7f, 0, 0x7f7f7f7f)
#define RFL(x) __builtin_amdgcn_readfirstlane(x)
#define MEMFENCE() asm volatile("" ::: "memory")
#define LDSBAR() do { asm volatile("s_waitcnt lgkmcnt(0)" ::: "memory"); __builtin_amdgcn_s_barrier(); asm volatile("" ::: "memory"); } while (0)
#define WSYNC() asm volatile("s_waitcnt lgkmcnt(0)" ::: "memory")
#define SLEEP1() __builtin_amdgcn_s_sleep(1)
#define MY_XCC_ID() ((unsigned)__builtin_amdgcn_s_getreg((3 << 11) | 20) & 0xFu)
#define FENCE_REL() __builtin_amdgcn_fence(__ATOMIC_RELEASE, "agent")
#define FENCE_ACQ() __builtin_amdgcn_fence(__ATOMIC_ACQUIRE, "agent")
#define FEXP(x) __expf(x)
#define RLX_AGENT __ATOMIC_RELAXED, __HIP_MEMORY_SCOPE_AGENT
#define LAUNDER_V(x) asm volatile("" : "+v"(x))
#endif

typedef unsigned short bf16_t;
typedef short bf16x8 __attribute__((ext_vector_type(8)));
typedef float f32x4 __attribute__((ext_vector_type(4)));
typedef float f32x2 __attribute__((ext_vector_type(2)));
typedef unsigned u32x4 __attribute__((ext_vector_type(4)));
typedef unsigned u32x2 __attribute__((ext_vector_type(2)));
typedef int i32x8 __attribute__((ext_vector_type(8)));
typedef int i32x4 __attribute__((ext_vector_type(4)));
typedef unsigned char fp8_t;

constexpr int D = 1024, NB = 2, SEQ = CFG_SEQ, CTXL = 256, DEPTH = 4;
constexpr int ML = NB * SEQ, MC = NB * CTXL, MT = ML + MC, NPAN = MT / 256;
constexpr int DFF = CFG_DFF, DFFE = CFG_DFFE, NEXP = 8;
constexpr int DIN = 2048, NH = 32, HD = 64, NG = 4, DS = 128, CONVD = 3072, NPROJ = 5184, NPROJP = 5376, BCD = 512;
constexpr int TV = CTXL + SEQ, NCH = TV / 128;
constexpr int GRIDW = 64;
constexpr float EPS = 1e-6f;
constexpr int NSLOT_TILES = (2 * MT) / 256 + NEXP, NSLOT = NSLOT_TILES * 256;
static_assert(SEQ % 128 == 0 && ML % 256 == 0 && DFF % 128 == 0 && DFFE % 128 == 0 && DFF >= 256 && DFFE >= 256, "shape constraints");

constexpr size_t MiB = 1u << 20;
constexpr size_t al(size_t x) { return (x + 4095) & ~(size_t)4095; }
constexpr size_t OFF_CTL = 0, CTL_BYTES = 1 * MiB;
constexpr size_t OFF_MOD = 1 * MiB;
constexpr size_t OFF_TOK = 2 * MiB;
constexpr size_t OFF_S2T = 3 * MiB;
constexpr size_t OFF_H = 4 * MiB, SZ_H = (size_t)MT * D * 4;
constexpr size_t OFF_W = OFF_H + al(SZ_H);
constexpr size_t W_POOL = 0, SZ_WPOOL = (size_t)4 * 256 * 256 * 2;
constexpr size_t W_UP = al(SZ_WPOOL), SZ_WUP = (size_t)2 * DFF * D * 2;
constexpr size_t W_DN = W_UP + al(SZ_WUP), SZ_WDN = (size_t)D * DFF * 2;
constexpr size_t SZ_WEVEN = W_DN + al(SZ_WDN);
constexpr size_t W_IN = 0, SZ_WIN = (size_t)NPROJP * D * 2;
constexpr size_t W_OUT = al(SZ_WIN), SZ_WOUT = (size_t)D * DIN * 2;
constexpr size_t W_DT = W_OUT + al(SZ_WOUT), SZ_DT = (size_t)NB * 2 * NH * TV * 4;
constexpr size_t W_MUP = W_DT + al(SZ_DT), SZ_WMUP = (size_t)NEXP * 2 * DFFE * D * 2;
constexpr size_t W_MDN = W_MUP + al(SZ_WMUP), SZ_WMDN = (size_t)NEXP * D * DFFE * 2;
constexpr size_t W_YB = W_MUP, SZ_Y = (size_t)MT * DIN * 2;
constexpr size_t SZ_WODD_A = W_MDN + al(SZ_WMDN), SZ_WODD_B = W_YB + al(SZ_Y);
constexpr size_t mx(size_t a, size_t b) { return a > b ? a : b; }
constexpr size_t SZ_W = mx(SZ_WEVEN, mx(SZ_WODD_A, SZ_WODD_B));
constexpr size_t OFF_ACT = OFF_W + SZ_W;
constexpr size_t A_P = 0, SZ_ACT1 = (size_t)MT * D * 2;
constexpr size_t A_HID = al(SZ_ACT1), SZ_HID = (size_t)MT * DFF * 2;
constexpr size_t SZ_AEVEN = A_HID + al(SZ_HID);
constexpr size_t A_Z = 0;
constexpr size_t A_XBC = al(SZ_Y), SZ_XBC = (size_t)MT * CONVD * 2;
constexpr size_t A_YF = A_XBC;
constexpr size_t A_CB = A_XBC + al(SZ_Y), SZ_CB = (size_t)NB * NG * NCH * 128 * 128 * 2;
static_assert(al(SZ_Y) + SZ_CB <= SZ_XBC, "CB fits behind Yf inside the XBC region");
constexpr size_t A_XT = A_XBC + al(SZ_XBC), SZ_XT = (size_t)NB * DIN * TV * 2;
constexpr size_t A_U = A_XT, A_YN = A_XT;
constexpr size_t A_BROW = A_XT + al(SZ_XT), SZ_BC = (size_t)MT * BCD * 2;
constexpr size_t A_BT = A_BROW + al(SZ_BC);
constexpr size_t A_CROW = A_BT + al(SZ_BC);
constexpr size_t A_CUM = A_CROW + al(SZ_BC);
constexpr size_t A_WJ = A_CUM + al(SZ_DT);
constexpr size_t A_CF = A_WJ + al(SZ_DT);
constexpr size_t SZ_ASSD = A_CF + al(SZ_DT);
constexpr size_t A_V = 0;
constexpr size_t A_HIDM = al(SZ_ACT1), SZ_HIDM = (size_t)NSLOT * DFFE * 2;
constexpr size_t A_YS = A_HIDM + al(SZ_HIDM), SZ_YS = (size_t)NSLOT * D * 2;
constexpr size_t SZ_AMOE = A_YS + al(SZ_YS);
constexpr size_t SZ_ACT = mx(SZ_AEVEN, mx(SZ_ASSD, SZ_AMOE));
constexpr size_t WS_NEED = OFF_ACT + SZ_ACT;

constexpr int CW_BAR = 4096;
constexpr int CW_CNT = 16384;
constexpr int CW_CUR = 16384 + 2 * 8 * 64;

DEV unsigned f2bf(float f) { unsigned u = __builtin_bit_cast(unsigned, f); return (u + 0x7fffu + ((u >> 16) & 1u)) >> 16; }
#ifndef EMU
typedef __bf16 bf16x2n __attribute__((ext_vector_type(2)));
#endif
DEV unsigned pk2(float lo, float hi) {
#ifdef EMU
    return f2bf(lo) | (f2bf(hi) << 16);
#else
    f32x2 v = {lo, hi}; bf16x2n b = __builtin_convertvector(v, bf16x2n); return __builtin_bit_cast(unsigned, b);
#endif
}
DEV unsigned pk4_fp8(float a, float b, float c, float d) {
#ifdef EMU
    return emu_f2fp8(a) | (emu_f2fp8(b) << 8) | (emu_f2fp8(c) << 16) | (emu_f2fp8(d) << 24);
#else
    unsigned w = 0; w = __builtin_amdgcn_cvt_pk_fp8_f32(a, b, w, false); w = __builtin_amdgcn_cvt_pk_fp8_f32(c, d, w, true); return w;
#endif
}
DEV float bf2f(unsigned b) { return __builtin_bit_cast(float, b << 16); }
DEV float bflo(unsigned w) { return __builtin_bit_cast(float, w << 16); }
DEV float bfhi(unsigned w) { return __builtin_bit_cast(float, w & 0xffff0000u); }
#ifdef EMU
DEV float frcp(float x) { return 1.0f / x; }
#else
DEV float frcp(float x) { return __builtin_amdgcn_rcpf(x); }
#endif
#ifdef EMU
DEV float fexp2(float x) { return exp2f(x); }
#else
DEV float fexp2(float x) { return __builtin_amdgcn_exp2f(x); }
#endif
DEV float siluf(float x) { return x * frcp(1.0f + FEXP(-x)); }
#ifdef EMU
DEV float flog2(float x) { return log2f(x); }
#else
DEV float flog2(float x) { return __builtin_amdgcn_logf(x); }
#endif
DEV float softplusf(float x) { if (x > 20.f) return x; const float e = FEXP(x); return e < 0.0625f ? e * (1.0f - e * (0.5f - e * (0.33333334f - e * (0.25f - e * 0.2f)))) : flog2(1.0f + e) * 0.6931471806f; }
DEV float wave_sum(float v) {
#pragma unroll
    for (int o = 1; o < 64; o <<= 1) v += __shfl_xor(v, o);
    return v;
}
DEV int vec_of(int r) { return r < ML ? (r / SEQ) : 2; }
DEV int frag_off(int r, int c) { return ((r >> 4) * 4 + (c >> 5)) * 512 + ((c >> 3) & 3) * 128 + (r & 15) * 8 + (c & 7); }
DEV int row_of(int b, int tv) { return tv < CTXL ? ML + b * CTXL + tv : b * SEQ + (tv - CTXL); }

#define XB_TMO      128
#define XB_XCNT(j)  (256  + 64 * (j))
#define XB_XSUB(j)  (1280 + 64 * (j))
#define XB_XGEN(j)  (2304 + 64 * (j))
#define XB_TOP      3328
#define XB_TOPGEN   3392
#define XCD_BAR_WORDS 3456
#define XB_SPIN_CAP (1u << 22)
DEV unsigned xb_ld(unsigned* p)              { return __hip_atomic_load(p, RLX_AGENT); }
DEV unsigned xb_add(unsigned* p, unsigned v) { return __hip_atomic_fetch_add(p, v, RLX_AGENT); }
#define XB_SPIN(cond, bar) do { unsigned _sp = 0; while (cond) { SLEEP1(); \
    if ((++_sp & 255u) == 0u) { if (xb_ld(&(bar)[XB_TMO])) break; if (_sp > XB_SPIN_CAP) { atomicAdd(&(bar)[XB_TMO], 1u); break; } } } } while (0)
struct XcdBarrier { unsigned* bar; unsigned x; volatile LAS unsigned* st; };
DEV XcdBarrier xcd_barrier_post(unsigned* bar, volatile LAS unsigned* st) {
    XcdBarrier b; b.bar = bar; b.x = MY_XCC_ID(); b.st = st;
    if (threadIdx.x == 0) (void)xb_add(&bar[XB_XCNT(b.x)], 1u);
    return b;
}
DEV void xcd_barrier_complete(unsigned* bar, unsigned x, unsigned& nloc, unsigned& nx) {
    const unsigned G = gridDim.x;
    unsigned sum, cnt, mine, sp = 0u;
    for (;;) {
        sum = 0u; cnt = 0u; mine = 0u;
#pragma unroll
        for (unsigned j = 0; j < 16; ++j) { const unsigned c = xb_ld(&bar[XB_XCNT(j)]); sum += c; cnt += (c > 0u) ? 1u : 0u; mine = (j == x) ? c : mine; }
        if (sum == G) break;
        SLEEP1();
        if ((++sp & 255u) == 0u) { if (xb_ld(&bar[XB_TMO])) break; if (sp > XB_SPIN_CAP) { atomicAdd(&bar[XB_TMO], 1u); break; } }
    }
    nloc = mine > 0u ? mine : 1u; nx = cnt > 0u ? cnt : 1u;
}
DEV void xcd_barrier(const XcdBarrier& b) {
    WAITV(0);
    __syncthreads();
    if (threadIdx.x == 0) {
        unsigned* bar = b.bar;
#ifndef EMU
        __builtin_amdgcn_s_waitcnt(0);
#endif
        unsigned nloc = b.st[0], nx = b.st[1];
        if (nloc == 0u) { xcd_barrier_complete(bar, b.x, nloc, nx); b.st[0] = nloc; b.st[1] = nx; }
        const unsigned old = xb_add(&bar[XB_XSUB(b.x)], 1u);
        const unsigned gen = old / nloc;
        if (old + 1u == (gen + 1u) * nloc) {
            FENCE_REL();
            WAITV(0);
            const unsigned og = xb_add(&bar[XB_TOP], 1u);
            const unsigned tg = og / nx;
            if (og + 1u == (tg + 1u) * nx) xb_add(&bar[XB_TOPGEN], 1u);
            else XB_SPIN(xb_ld(&bar[XB_TOPGEN]) == tg, bar);
            FENCE_ACQ();
            xb_add(&bar[XB_XGEN(b.x)], 1u);
            WAITV(0);
        } else {
            XB_SPIN(xb_ld(&bar[XB_XGEN(b.x)]) == gen, bar);
            FENCE_ACQ();
            WAITV(0);
        }
    }
    __syncthreads();
}

namespace ge {
constexpr int BM = 256, BK = 64, HALF = 128, HTB = HALF * BK * 2, STAGE_BYTES = 8 * HTB, NXCD = 8, WGM = 8;
DEV int lds_byte(int r, int c) { const int st = (r >> 4) * 2 + (c >> 5), rr = r & 15, cc = c & 31, ob = rr * 64 + cc * 2; return st * 1024 + (ob ^ (((ob >> 9) & 1) << 5)); }
DEV void stage_rc(int b, int& R, int& C) { const int st = b / 1024, sb = b % 1024, swz = sb ^ (((sb >> 9) & 1) << 5); R = (st >> 1) * 16 + swz / 64; C = (st & 1) * 32 + (swz % 64) / 2; }
DEV int perm32(int rho) { const int n = rho >> 4, i = rho & 15; return 8 * (i >> 2) + 4 * n + (i & 3); }
struct Unit { int pm, pn; };
DEV bool static_next(int nM, int nN, int G, int c, int i, Unit& u) {
    const int nwg = nM * nN; const long L = (long)i * G + c; if (L >= nwg) return false;
    int wgid = (int)L; { const int q = nwg / NXCD, r = nwg % NXCD, xcd = wgid % NXCD, off = wgid / NXCD; wgid = (xcd < r ? xcd * (q + 1) : r * (q + 1) + (xcd - r) * q) + off; }
    const int nig = WGM * nN, gid = wgid / nig, fm = gid * WGM, gsz = (nM - fm) < WGM ? (nM - fm) : WGM;
    u.pm = fm + ((wgid % nig) % gsz); u.pn = (wgid % nig) / gsz; return true;
}
template <class P, bool SP2 = true>
DEV void gemm_phase(LAS unsigned char* lds, const P& S, const int tid) {
    const int wid = RFL(tid >> 6), lane = tid & 63, wr = wid >> 2, wc = wid & 3, fr = lane & 15, fq = lane >> 4;
    const int K = S.K, nt = K * P::ES / (BK * 2);
    unsigned voffB[2]; int RA[2], CA2[2];
#pragma unroll
    for (int i = 0; i < 2; ++i) { int R, C; stage_rc(tid * 16 + i * 8192, R, C); const int Rb = P::PERM ? ((R & ~31) + perm32(R & 31)) : R;
        RA[i] = R; CA2[i] = C * 2; voffB[i] = (unsigned)(Rb * S.ldb) * (unsigned)P::ES + (unsigned)(C * 2); }
    const size_t kstep = (size_t)(BK * 2);
    const size_t hstepB = (size_t)HALF * S.ldb * P::ES;
    const unsigned ldsw = (unsigned)wid * 1024u;
    const int aoff = lds_byte(wr * 64 + fr, fq * 8), boff = lds_byte(wc * 32 + fr, fq * 8);
#define GE_SA(b, h) (((b) * 2 + (h)) * HTB)
#define GE_SB(b, h) ((4 + (b) * 2 + (h)) * HTB)
#define GE_STAGEB(bufoff, gbase) do { _Pragma("unroll") for (int _i = 0; _i < 2; ++_i) { unsigned _o = voffB[_i]; LAUNDER_V(_o); \
        GLDS16((const char*)(gbase) + _o, lds + (bufoff) + ldsw + _i * 8192); } } while (0)
#define GE_STAGEA(bufoff, gbase, h) do { _Pragma("unroll") for (int _i = 0; _i < 2; ++_i) { unsigned _o = oA[h][_i]; LAUNDER_V(_o); \
        GLDS16((const char*)(gbase) + _o, lds + (bufoff) + ldsw + _i * 8192); } } while (0)
#define GE_LD1(p_) __builtin_shufflevector(*(const LAS i32x4*)(p_), *(const LAS i32x4*)((p_) + 1024), 0, 1, 2, 3, 4, 5, 6, 7)
#define GE_LDA(dst, b, h) do { _Pragma("unroll") for (int m = 0; m < 4; ++m) dst[m] = GE_LD1(lds + GE_SA(b, h) + aoff + m * 2048); } while (0)
#define GE_LDB(dst, b, h) do { _Pragma("unroll") for (int n = 0; n < 2; ++n) dst[n] = GE_LD1(lds + GE_SB(b, h) + boff + n * 2048); } while (0)
#define GE_LO(x) __builtin_bit_cast(bf16x8, __builtin_shufflevector(x, x, 0, 1, 2, 3))
#define GE_HI(x) __builtin_bit_cast(bf16x8, __builtin_shufflevector(x, x, 4, 5, 6, 7))
#define GE_MMA(ai, bj, At, Bt) do { SETPRIO(1); _Pragma("unroll") for (int m = 0; m < 4; ++m) _Pragma("unroll") for (int n = 0; n < 2; ++n) { \
        if constexpr (P::FP8) acc[ai][bj][m][n] = MFMA8(Bt[n], At[m], acc[ai][bj][m][n]);     \
        else { acc[ai][bj][m][n] = MFMA16(GE_LO(Bt[n]), GE_LO(At[m]), acc[ai][bj][m][n]); acc[ai][bj][m][n] = MFMA16(GE_HI(Bt[n]), GE_HI(At[m]), acc[ai][bj][m][n]); } } SETPRIO(0); } while (0)
    Unit cur, nxt; int ui = 0;
    if (!S.next(0, cur)) return;
    f32x4 acc[2][2][4][2];
#pragma unroll
    for (int a = 0; a < 2; ++a)
#pragma unroll
        for (int b = 0; b < 2; ++b)
#pragma unroll
            for (int m = 0; m < 4; ++m)
#pragma unroll
                for (int n = 0; n < 2; ++n) acc[a][b][m][n] = (f32x4){0.f, 0.f, 0.f, 0.f};
    unsigned oA[2][2];
#pragma unroll
    for (int h = 0; h < 2; ++h)
#pragma unroll
        for (int i = 0; i < 2; ++i) {
            if constexpr (P::GATHER) oA[h][i] = (unsigned)S.gather_row(cur, h * HALF + RA[i]) * (unsigned)(S.lda * P::ES) + (unsigned)CA2[i];
            else oA[h][i] = (unsigned)((h * HALF + RA[i]) * S.lda) * (unsigned)P::ES + (unsigned)CA2[i];
            }
    const char* cA = S.a_base(cur); const char* cB = S.b_base(cur);
    if constexpr (SP2) {
        GE_STAGEB(GE_SB(0, 0), cB); GE_STAGEB(GE_SB(0, 1), cB + hstepB); GE_STAGEA(GE_SA(0, 0), cA, 0); GE_STAGEA(GE_SA(0, 1), cA, 1);
        if (wr == 1) SBAR();
        WAITV(2); SBAR();
        GE_STAGEB(GE_SB(1, 0), cB + kstep); GE_STAGEA(GE_SA(1, 0), cA + kstep, 0); GE_STAGEB(GE_SB(1, 1), cB + hstepB + kstep);
        WAITV(6); SBAR();
    } else {
    GE_STAGEB(GE_SB(0, 0), cB); GE_STAGEA(GE_SA(0, 0), cA, 0); GE_STAGEB(GE_SB(0, 1), cB + hstepB); GE_STAGEA(GE_SA(0, 1), cA, 1);
    if (wr == 1) SBAR();
    WAITV(4); SBAR();
    GE_STAGEB(GE_SB(1, 0), cB + kstep); GE_STAGEA(GE_SA(1, 0), cA + kstep, 0); GE_STAGEB(GE_SB(1, 1), cB + hstepB + kstep);
    WAITV(6); SBAR();
    }
    for (;;) {
        const bool has_next = S.next(ui + 1, nxt);
        const char* nA = has_next ? S.a_base(nxt) : cA; const char* nB = has_next ? S.b_base(nxt) : cB;
        for (int t = 0; t < nt; t += 2) {
            const bool last = (t == nt - 2);
            const char* a1 = cA + (size_t)(t + 1) * kstep;
            const char* a2 = last ? nA : cA + (size_t)(t + 2) * kstep; const char* b2 = last ? nB : cB + (size_t)(t + 2) * kstep;
            const char* a3 = a2 + kstep; const char* b3 = b2 + kstep;
            i32x8 At[4], B0[2], B1[2];
            if constexpr (SP2) {
            GE_LDB(B0, 0, 0); GE_LDB(B1, 0, 1); SCHED(); GE_LDA(At, 0, 0); GE_STAGEA(GE_SA(1, 1), a1, 1);
            WAITV(8); WAITL(0); SBAR(); GE_MMA(0, 0, At, B0); GE_MMA(0, 1, At, B1); SBAR(); SCHED();
            if constexpr (P::GATHER) { if (last && has_next) {
#pragma unroll
                for (int i = 0; i < 2; ++i) { int R2, C2; stage_rc(tid * 16 + i * 8192, R2, C2);
#pragma unroll
                    for (int h = 0; h < 2; ++h) oA[h][i] = (unsigned)S.gather_row(nxt, h * HALF + R2) * (unsigned)(S.lda * P::ES) + (unsigned)(C2 * 2); } } }
            GE_LDA(At, 0, 1); GE_STAGEB(GE_SB(0, 0), b2); GE_STAGEB(GE_SB(0, 1), b2 + hstepB); GE_STAGEA(GE_SA(0, 0), a2, 0);
            WAITV(8); WAITL(0); SBAR(); GE_MMA(1, 0, At, B0); GE_MMA(1, 1, At, B1); SBAR(); SCHED();
            GE_LDB(B0, 1, 0); GE_LDB(B1, 1, 1); SCHED(); GE_LDA(At, 1, 0); GE_STAGEA(GE_SA(0, 1), a2, 1);
            WAITV(8); WAITL(0); SBAR(); GE_MMA(0, 0, At, B0); GE_MMA(0, 1, At, B1); SBAR(); SCHED();
            GE_LDA(At, 1, 1); GE_STAGEB(GE_SB(1, 0), b3); GE_STAGEB(GE_SB(1, 1), b3 + hstepB); GE_STAGEA(GE_SA(1, 0), a3, 0);
            WAITV(8); WAITL(0); SBAR(); GE_MMA(1, 0, At, B0); GE_MMA(1, 1, At, B1); SBAR(); SCHED();
            } else {
            GE_LDB(B0, 0, 0); SCHED(); GE_LDA(At, 0, 0); GE_STAGEA(GE_SA(1, 1), a1, 1);
            WAITL(8); SBAR(); WAITL(0); GE_MMA(0, 0, At, B0); SBAR(); SCHED();
            if constexpr (P::GATHER) { if (last && has_next) {
#pragma unroll
                for (int i = 0; i < 2; ++i) { int R2, C2; stage_rc(tid * 16 + i * 8192, R2, C2);
#pragma unroll
                    for (int h = 0; h < 2; ++h) oA[h][i] = (unsigned)S.gather_row(nxt, h * HALF + R2) * (unsigned)(S.lda * P::ES) + (unsigned)(C2 * 2); } } }
            GE_LDB(B1, 0, 1); GE_STAGEB(GE_SB(0, 0), b2);
            SBAR(); WAITL(0); GE_MMA(0, 1, At, B1); SBAR();
            GE_LDA(At, 0, 1); GE_STAGEA(GE_SA(0, 0), a2, 0);
            SBAR(); WAITL(0); GE_MMA(1, 0, At, B0); SBAR(); SCHED();
            GE_STAGEB(GE_SB(0, 1), b2 + hstepB);
            WAITV(6); SBAR(); GE_MMA(1, 1, At, B1); SBAR();
            GE_LDB(B0, 1, 0); SCHED(); GE_LDA(At, 1, 0); GE_STAGEA(GE_SA(0, 1), a2, 1);
            WAITL(8); SBAR(); WAITL(0); GE_MMA(0, 0, At, B0); SBAR(); SCHED();
            GE_LDB(B1, 1, 1); GE_STAGEB(GE_SB(1, 0), b3);
            SBAR(); WAITL(0); GE_MMA(0, 1, At, B1); SBAR();
            GE_LDA(At, 1, 1); GE_STAGEA(GE_SA(1, 0), a3, 0);
            SBAR(); WAITL(0); GE_MMA(1, 0, At, B0); SBAR(); SCHED();
            GE_STAGEB(GE_SB(1, 1), b3 + hstepB);
            WAITV(6); SBAR(); GE_MMA(1, 1, At, B1); SBAR();
            }
        }
        if (wr == 0) SBAR();
        S.epi(acc, cur, wr, wc, fr, fq);
        if (!has_next) break;
#pragma unroll
        for (int a = 0; a < 2; ++a)
#pragma unroll
            for (int b = 0; b < 2; ++b)
#pragma unroll
                for (int m = 0; m < 4; ++m)
#pragma unroll
                    for (int n = 0; n < 2; ++n) acc[a][b][m][n] = (f32x4){0.f, 0.f, 0.f, 0.f};
        cur = nxt; cA = nA; cB = nB; ++ui;
        if (wr == 1) SBAR();
    }
    WAITV(0);
    SBAR();
#undef GE_SA
#undef GE_SB
#undef GE_STAGEA
#undef GE_STAGEB
#undef GE_LDA
#undef GE_LDB
#undef GE_MMA
#undef GE_LO
#undef GE_HI
#undef GE_LD1
}
}
using ge::Unit;

struct Params {
    const float* in[26];
    float* out; unsigned char* ws;
    int ph_lo, ph_hi;
};
enum { I_X = 0, I_C, I_CTX, I_CCTX, I_ADAW, I_ADAB, I_NMIX, I_NFFN, I_POOLW, I_POOLS, I_INW, I_CONVW, I_CONVB, I_ALOG, I_DTB, I_DSKIP, I_SNORM, I_OUTW,
       I_W1, I_W3, I_W2, I_RW, I_MW1, I_MW3, I_MW2, I_FNORM };

struct Frame {
    LAS unsigned char* lds;
    int tid, lane, wave, G, bx;
    const Params* p;
    unsigned char* ws;
    unsigned* ctl;
    float* H; float* mod;
};
#ifdef EMU
DEV const float* INP(const Frame& F, int i) { return F.p->in[i]; }
DEV float* OUTP(const Frame& F) { return F.p->out; }
DEV unsigned char* WSP(const Frame& F) { return F.p->ws; }
#define LAUNDER_S(x) ((void)0)
#else
typedef const float* cfptr_t;
DEV const float* INP(const Frame&, int i) { int k = i; asm volatile("" : "+s"(k)); return ((const __attribute__((address_space(4))) cfptr_t*)__builtin_amdgcn_kernarg_segment_ptr())[k]; }
DEV float* OUTP(const Frame& F) { return (float*)INP(F, 26); }
DEV unsigned char* WSP(const Frame& F) { return (unsigned char*)INP(F, 27); }
#define LAUNDER_S(x) asm volatile("" : "+s"(x))
#endif
constexpr int LDS_MISC = ge::STAGE_BYTES;
constexpr int LDS_BYTES = ge::STAGE_BYTES + 16384;

struct Src { const float* x; const float* ctx; float* H; const float* mod; };
DEV const float* modq(const float* mod, int layer, int vec, int which) { return mod + ((size_t)(layer * 3 + vec) * 6 + which) * D; }
DEV const float* modp(const Frame& F, int layer, int vec, int which) { return modq(F.mod, layer, vec, which); }
DEV const float* hsrc_row(const Src& s, bool from_input, int r) {
    if (from_input) return r < ML ? s.x + (size_t)r * D : s.ctx + (size_t)(r - ML) * D;
    return s.H + (size_t)r * D;
}
DEV Src mksrc(const Frame& F) { Src s; s.x = INP(F, I_X); s.ctx = INP(F, I_CTX); s.H = F.H; s.mod = F.mod; return s; }
DEV const float* hin_row(const Frame& F, int layer, int r) { return hsrc_row(mksrc(F), layer == 0, r); }

struct RmId { DEV int operator()(int n0) const { return n0; } };
struct RmIlv { int s; DEV int operator()(int n0) const { return (n0 >> 7) * 256 + s * 128 + (n0 & 127); } };
template <int K, int N, bool F8, class RM>
DEV void convert_job_t(const Frame& F, const float* Wsrc, void* WTv, int ldt, RM rowmap, float scale) {
    LAS float* scr = (LAS float*)(F.lds + F.wave * 16384);
    constexpr int items = (K / 64) * (N / 32), nblk = N / 32; const int gw = F.bx * 8 + F.wave, NGW = F.G * 8, lane = F.lane;
    float nx[32];
#define CJ_LOAD(it_) do { const int _kb = (it_) / nblk, _nb = (it_) % nblk; const float* _p = Wsrc + (size_t)(64 * _kb + (lane >> 5)) * N + 32 * _nb + (lane & 31); \
        _Pragma("unroll") for (int i = 0; i < 32; ++i) nx[i] = _p[(size_t)(2 * i) * N]; } while (0)
    if (gw < items) CJ_LOAD(gw);
    for (int it = gw; it < items; it += NGW) {
        const int kb = it / nblk, nb = it % nblk, k0 = 64 * kb, n0 = 32 * nb;
#pragma unroll
        for (int i = 0; i < 32; ++i) { const int kk = 2 * i + (lane >> 5); scr[kk * 33 + (lane & 31)] = F8 ? nx[i] * scale : nx[i]; }
        if (it + NGW < items) CJ_LOAD(it + NGW);
        WSYNC();
        const int c = lane & 7; const int row0 = rowmap(n0);
#pragma unroll
        for (int j = 0; j < 4; ++j) { const int n = (lane >> 3) + 8 * j; const LAS float* sp = scr + (8 * c) * 33 + n;
            if (F8) { u32x2 o; o.x = pk4_fp8(sp[0 * 33], sp[1 * 33], sp[2 * 33], sp[3 * 33]); o.y = pk4_fp8(sp[4 * 33], sp[5 * 33], sp[6 * 33], sp[7 * 33]);
                *(u32x2*)((fp8_t*)WTv + (size_t)(row0 + n) * ldt + k0 + 8 * c) = o; }
            else { u32x4 o; o.x = pk2(sp[0 * 33], sp[1 * 33]); o.y = pk2(sp[2 * 33], sp[3 * 33]); o.z = pk2(sp[4 * 33], sp[5 * 33]); o.w = pk2(sp[6 * 33], sp[7 * 33]);
                *(u32x4*)((bf16_t*)WTv + (size_t)(row0 + n) * ldt + k0 + 8 * c) = o; } }
        WSYNC();
    }
#undef CJ_LOAD
}
template <int K, int N, class RM> DEV void convert_job(const Frame& F, const float* Wsrc, bf16_t* WT, int ldt, RM rm) { convert_job_t<K, N, false>(F, Wsrc, WT, ldt, rm, 1.0f); }
template <int K, int N, class RM> DEV void convert_job_fp8(const Frame& F, const float* Wsrc, fp8_t* WT, int ldt, RM rm, float scale) { convert_job_t<K, N, true>(F, Wsrc, WT, ldt, rm, scale); }
DEV void convert_even(const Frame& F, int j) {
    bf16_t* Wb = (bf16_t*)(F.ws + OFF_W);
    for (int g = 0; g < 4; ++g) convert_job<256, 256>(F, INP(F, I_POOLW) + ((size_t)j * 4 + g) * 65536, Wb + W_POOL / 2 + (size_t)g * 65536, 256, RmId{});
    convert_job<D, DFF>(F, INP(F, I_W1) + (size_t)j * D * DFF, Wb + W_UP / 2, D, RmIlv{0});
    convert_job<D, DFF>(F, INP(F, I_W3) + (size_t)j * D * DFF, Wb + W_UP / 2, D, RmIlv{1});
    convert_job<DFF, D>(F, INP(F, I_W2) + (size_t)j * DFF * D, Wb + W_DN / 2, DFF, RmId{});
}
DEV void convert_ssd(const Frame& F, int j) {
    bf16_t* Wb = (bf16_t*)(F.ws + OFF_W);
    convert_job<D, NPROJ>(F, INP(F, I_INW) + (size_t)j * D * NPROJ, Wb + W_IN / 2, D, RmId{});
    convert_job<DIN, D>(F, INP(F, I_OUTW) + (size_t)j * DIN * D, Wb + W_OUT / 2, DIN, RmId{});
    { u32x4* z = (u32x4*)(Wb + W_IN / 2 + (size_t)NPROJ * D); const int n16 = (NPROJP - NPROJ) * D * 2 / 16;
      unsigned zz = 0u; LAUNDER_V(zz);
      for (int i = F.bx * 512 + F.tid; i < n16; i += F.G * 512) z[i] = (u32x4){zz, zz, zz, zz}; }
}
DEV void convert_moe(const Frame& F, int j) {
    fp8_t* Wb = (fp8_t*)(F.ws + OFF_W);
    for (int e = 0; e < NEXP; ++e) {
        convert_job_fp8<D, DFFE>(F, INP(F, I_MW1) + ((size_t)j * NEXP + e) * D * DFFE, Wb + W_MUP + (size_t)e * 2 * DFFE * D, D, RmIlv{0}, 32.0f);
        convert_job_fp8<D, DFFE>(F, INP(F, I_MW3) + ((size_t)j * NEXP + e) * D * DFFE, Wb + W_MUP + (size_t)e * 2 * DFFE * D, D, RmIlv{1}, 32.0f);
        if (MOE_DOWN_FP8) convert_job_fp8<DFFE, D>(F, INP(F, I_MW2) + ((size_t)j * NEXP + e) * DFFE * D, Wb + W_MDN + (size_t)e * D * DFFE, DFFE, RmId{}, 64.0f);
        else convert_job<DFFE, D>(F, INP(F, I_MW2) + ((size_t)j * NEXP + e) * DFFE * D, (bf16_t*)(Wb + W_MDN) + (size_t)e * D * DFFE, DFFE, RmId{});
    }
}

DEV void phase_mod(const Frame& F) {
    LAS float* red = (LAS float*)F.lds;
    LAS float* sc = (LAS float*)(F.lds + 8192);
    constexpr int nblk = DEPTH * 6144 / 32;
    const int col = F.tid & 31, ks = F.tid >> 5;
    for (int i = F.tid; i < 3 * D; i += 512) { const int v = i >> 10, k = i & (D - 1); sc[i] = siluf(v == 2 ? INP(F, I_CCTX)[k] : INP(F, I_C)[v * D + k]); }
    __syncthreads();
    for (int blk = F.bx; blk < nblk; blk += F.G) {
        const int layer = (blk * 32) / 6144, n = (blk * 32) % 6144 + col;
        const float* W = INP(F, I_ADAW) + (size_t)layer * D * 6144 + n;
        float a0 = 0.f, a1 = 0.f, a2 = 0.f;
#pragma unroll 1
        for (int kb = ks * 64; kb < ks * 64 + 64; kb += 16) {
            float wv[16];
#pragma unroll
            for (int k = 0; k < 16; ++k) wv[k] = W[(size_t)(kb + k) * 6144];
#pragma unroll
            for (int k = 0; k < 16; ++k) { a0 += sc[kb + k] * wv[k]; a1 += sc[D + kb + k] * wv[k]; a2 += sc[2 * D + kb + k] * wv[k]; } }
        red[(ks * 32 + col) * 3 + 0] = a0; red[(ks * 32 + col) * 3 + 1] = a1; red[(ks * 32 + col) * 3 + 2] = a2;
        __syncthreads();
        if (F.tid < 96) { const int c2 = F.tid & 31, v = F.tid >> 5; float s = 0.f;
            for (int q = 0; q < 16; ++q) s += red[(q * 32 + c2) * 3 + v];
            const int n2 = (blk * 32) % 6144 + c2;
            F.mod[(size_t)(layer * 3 + v) * 6144 + n2] = s + INP(F, I_ADAB)[(size_t)layer * 6144 + n2]; }
        __syncthreads();
    }
}

DEV void load_row(const float* p, int lane, f32x4 (&v)[4]) {
#pragma unroll
    for (int j = 0; j < 4; ++j) v[j] = *(const f32x4*)(p + 4 * lane + 256 * j);
}
DEV float sumsq_row(const f32x4 (&v)[4]) { float s = 0.f;
#pragma unroll
    for (int j = 0; j < 4; ++j) s += (v[j][0] * v[j][0] + v[j][1] * v[j][1]) + (v[j][2] * v[j][2] + v[j][3] * v[j][3]);
    return wave_sum(s); }
DEV void normmod_row(f32x4 (&v)[4], float rstd, const float* w, const float* sh, const float* sc, int lane) {
#pragma unroll
    for (int j = 0; j < 4; ++j) { const int c = 4 * lane + 256 * j; const f32x4 wv = *(const f32x4*)(w + c), sv = *(const f32x4*)(sh + c), cv = *(const f32x4*)(sc + c);
        v[j] = v[j] * rstd * wv * (cv + 1.0f) + sv; }
}
DEV void store_row_bf16(bf16_t* o, int lane, const f32x4 (&v)[4]) {
#pragma unroll
    for (int j = 0; j < 4; ++j) { u32x2 w; w.x = pk2(v[j][0], v[j][1]); w.y = pk2(v[j][2], v[j][3]); *(u32x2*)(o + 4 * lane + 256 * j) = w; }
}

DEV void phase_norm(const Frame& F, int layer, int which, bf16_t* out, bool from_input) {
    const int gw = F.bx * 8 + F.wave, NGW = F.G * 8;
    const float* w = INP(F, which == 0 ? I_NMIX : I_NFFN) + (size_t)layer * D;
    f32x4 nx[4];
    if (gw < MT) load_row(hsrc_row(mksrc(F), from_input, gw), F.lane, nx);
    for (int r = gw; r < MT; r += NGW) {
        f32x4 v[4];
#pragma unroll
        for (int q = 0; q < 4; ++q) v[q] = nx[q];
        if (r + NGW < MT) load_row(hsrc_row(mksrc(F), from_input, r + NGW), F.lane, nx);
        const float rstd = rsqrtf(sumsq_row(v) * (1.0f / D) + EPS);
        const int vec = vec_of(r);
        normmod_row(v, rstd, w, modp(F, layer, vec, which), modp(F, layer, vec, which + 1), F.lane);
        store_row_bf16(out + (size_t)r * D, F.lane, v);
    }
}

struct TokInfo { int s0, s1; float g0, g1; };
DEV void phase_poolprep(const Frame& F, int layer, bf16_t* P, bool fuse, const bf16_t* YS) {
    const TokInfo* tok = (const TokInfo*)(F.ws + OFF_TOK);
    LAS bf16_t* ub = (LAS bf16_t*)(F.lds);
    LAS float* rs = (LAS float*)(F.lds + 81920);
    const float* w = INP(F, I_NMIX) + (size_t)layer * D;
    const int ntile = MT / 64;
    const int chunk = F.tid & 127, tg = F.tid >> 7;
    for (int tile = F.bx; tile < ntile; tile += F.G) {
        const int r0 = tile * 64;
        if (r0 < ML) {
            LAS bf16_t* ul = (LAS bf16_t*)(F.lds);
            const int vec = vec_of(r0);
            { f32x4 wc[4], sv[4], g2[4];
#pragma unroll
              for (int jq = 0; jq < 4; ++jq) { const int c = 4 * F.lane + 256 * jq; wc[jq] = *(const f32x4*)(w + c) * (*(const f32x4*)(modp(F, layer, vec, 1) + c) + 1.0f); sv[jq] = *(const f32x4*)(modp(F, layer, vec, 0) + c);
                  g2[jq] = fuse ? *(const f32x4*)(modp(F, layer - 1, vec, 5) + c) * (MOE_DOWN_FP8 ? 0.00390625f : 1.0f) : (f32x4){0.f, 0.f, 0.f, 0.f}; }
              f32x4 nh[4]; u32x2 nya[4], nyb[4]; TokInfo tn; tn.s0 = tn.s1 = 0; tn.g0 = tn.g1 = 0.f;
              { const int r = r0 + F.wave; load_row(hin_row(F, layer, r), F.lane, nh);
                if (fuse) { tn = tok[r];
#pragma unroll
                    for (int jq = 0; jq < 4; ++jq) { const int c = 4 * F.lane + 256 * jq; nya[jq] = *(const u32x2*)(YS + (size_t)tn.s0 * D + c); nyb[jq] = *(const u32x2*)(YS + (size_t)tn.s1 * D + c); } } }
#pragma unroll 1
              for (int k = 0; k < 8; ++k) { const int rl = F.wave + 8 * k, r = r0 + rl;
                  f32x4 v[4]; u32x2 ya[4], yb[4]; const TokInfo ti = tn;
#pragma unroll
                  for (int q = 0; q < 4; ++q) { v[q] = nh[q]; ya[q] = nya[q]; yb[q] = nyb[q]; }
                  if (k < 7) { load_row(hin_row(F, layer, r + 8), F.lane, nh);
                      if (fuse) { tn = tok[r + 8];
#pragma unroll
                          for (int jq = 0; jq < 4; ++jq) { const int c = 4 * F.lane + 256 * jq; nya[jq] = *(const u32x2*)(YS + (size_t)tn.s0 * D + c); nyb[jq] = *(const u32x2*)(YS + (size_t)tn.s1 * D + c); } } }
                  if (fuse) {
#pragma unroll
                      for (int jq = 0; jq < 4; ++jq) { const u32x2 a = ya[jq], b = yb[jq];
                          v[jq][0] += g2[jq][0] * (ti.g0 * bflo(a.x) + ti.g1 * bflo(b.x)); v[jq][1] += g2[jq][1] * (ti.g0 * bfhi(a.x) + ti.g1 * bfhi(b.x));
                          v[jq][2] += g2[jq][2] * (ti.g0 * bflo(a.y) + ti.g1 * bflo(b.y)); v[jq][3] += g2[jq][3] * (ti.g0 * bfhi(a.y) + ti.g1 * bfhi(b.y));
                          *(f32x4*)(F.H + (size_t)r * D + 4 * F.lane + 256 * jq) = v[jq]; } }
                  const float rstd = rsqrtf(sumsq_row(v) * (1.0f / D) + EPS);
#pragma unroll
                  for (int jq = 0; jq < 4; ++jq) { const f32x4 u = v[jq] * rstd * wc[jq] + sv[jq]; u32x2 pw; pw.x = pk2(u[0], u[1]); pw.y = pk2(u[2], u[3]);
                      *(LAS u32x2*)(ul + rl * 1024 + 4 * F.lane + 256 * jq) = pw; } } }
            __syncthreads();
            { const int cq = F.tid & 255, hf = F.tid >> 8, c = cq * 4, g = c >> 8, win = 2 << g, lo = win >> 1, hi = win - 1 - lo;
#define PL_U(t_) ({ const u32x2 _q = *(const LAS u32x2*)(ul + (t_) * 1024 + c); (f32x4){bflo(_q.x), bfhi(_q.x), bflo(_q.y), bfhi(_q.y)}; })
              const int ta = 32 * hf;
              f32x4 sacc = (f32x4){0.f, 0.f, 0.f, 0.f};
              { const int a = (ta - lo > 0) ? ta - lo : 0, b = (ta + hi + 1 < 64) ? ta + hi + 1 : 64; for (int t = a; t < b; ++t) sacc += PL_U(t); }
              for (int t = ta; t < ta + 32; ++t) {
                  const int a = (t - lo > 0) ? t - lo : 0, b = (t + hi + 1 < 64) ? t + hi + 1 : 64;
                  const float inv = 1.0f / (float)(b - a);
                  const f32x4 o = sacc * inv - PL_U(t);
                  u32x2 pw; pw.x = pk2(o[0], o[1]); pw.y = pk2(o[2], o[3]); *(u32x2*)(P + (size_t)(r0 + t) * D + c) = pw;
                  if (t + 1 < ta + 32) { if (t + 1 + hi < 64) sacc += PL_U(t + 1 + hi); if (t - lo >= 0) sacc -= PL_U(t - lo); } }
#undef PL_U
            }
            __syncthreads();
            continue;
        }
        int seq0, seq1;
        if (r0 < ML) { seq0 = r0; seq1 = r0 + 64; } else { seq0 = ML + ((r0 - ML) / CTXL) * CTXL; seq1 = seq0 + CTXL; }
        const int lo_r = (r0 - 8 > seq0) ? r0 - 8 : seq0, hi_r = (r0 + 64 + 7 < seq1) ? r0 + 64 + 7 : seq1;
        const int nrow = hi_r - lo_r;
        for (int rb = lo_r + F.wave; rb < hi_r; rb += 16) {
            f32x4 v5[2][4];
#pragma unroll
            for (int k = 0; k < 2; ++k) { const int r = rb + 8 * k; if (r < hi_r) load_row(hin_row(F, layer, r), F.lane, v5[k]); }
#pragma unroll
            for (int k = 0; k < 2; ++k) { const int r = rb + 8 * k; if (r < hi_r) { const float ss = sumsq_row(v5[k]); if (F.lane == 0) rs[r - lo_r] = rsqrtf(ss * (1.0f / D) + EPS); } } }
        __syncthreads();
        const int vec = vec_of(r0);
#pragma unroll 1
        for (int half = 0; half < 2; ++half) {
            const int c = half * 512 + 4 * chunk, g = c >> 8, win = 2 << g, lo = win >> 1, hi = win - 1 - lo;
            const f32x4 wv = *(const f32x4*)(w + c), sv = *(const f32x4*)(modp(F, layer, vec, 0) + c), cv = *(const f32x4*)(modp(F, layer, vec, 1) + c) + 1.0f;
            const f32x4 wc = wv * cv;
#pragma unroll 1
            for (int kb = 0; kb < 20; kb += 5) {
                f32x4 hv[5];
#pragma unroll
                for (int k = 0; k < 5; ++k) { const int rr = tg + 4 * (kb + k); if (rr < nrow) hv[k] = *(const f32x4*)(hin_row(F, layer, lo_r + rr) + c); }
#pragma unroll
                for (int k = 0; k < 5; ++k) { const int rr = tg + 4 * (kb + k); if (rr < nrow) { const f32x4 u = hv[k] * rs[rr] * wc + sv;
                    u32x2 pw; pw.x = pk2(u[0], u[1]); pw.y = pk2(u[2], u[3]); *(LAS u32x2*)(ub + rr * 512 + 4 * chunk) = pw; } } }
            __syncthreads();
#define PP_U(r_) ({ const u32x2 _q = *(const LAS u32x2*)(ub + ((r_) - lo_r) * 512 + 4 * chunk); (f32x4){bflo(_q.x), bfhi(_q.x), bflo(_q.y), bfhi(_q.y)}; })
            const int ta = r0 + 16 * tg;
            f32x4 s = (f32x4){0.f, 0.f, 0.f, 0.f};
            { const int a = (ta - lo > seq0) ? ta - lo : seq0, b = (ta + hi + 1 < seq1) ? ta + hi + 1 : seq1; for (int r = a; r < b; ++r) s += PP_U(r); }
            for (int t = ta; t < ta + 16; ++t) {
                const int a = (t - lo > seq0) ? t - lo : seq0, b = (t + hi + 1 < seq1) ? t + hi + 1 : seq1;
                const float inv = 1.0f / (float)(b - a);
                const f32x4 o = s * inv - PP_U(t);
                u32x2 pw; pw.x = pk2(o[0], o[1]); pw.y = pk2(o[2], o[3]); *(u32x2*)(P + (size_t)t * D + c) = pw;
                if (t + 1 < ta + 16) {
                    if (t + 1 + hi < seq1) s += PP_U(t + 1 + hi);
                    if (t - lo >= seq0) s -= PP_U(t - lo); }
            }
#undef PP_U
            __syncthreads();
        }
    }
}

struct PolBase { int G, c; };
struct PolPool : PolBase {
    static constexpr bool PERM = false, GATHER = false; static constexpr bool FP8 = false; static constexpr int ES = 2; int K, lda, ldb;
    const bf16_t* P; const bf16_t* W; Src src; int layer; const float* scale;
    DEV bool next(int i, Unit& u) const { return ge::static_next(NPAN, 4, G, c, i, u); }
    DEV const char* a_base(const Unit& u) const { return (const char*)(P + (size_t)u.pm * 256 * D + u.pn * 256); }
    DEV const char* b_base(const Unit& u) const { return (const char*)(W + (size_t)u.pn * 65536); }
    DEV void epi(const f32x4 (&acc)[2][2][4][2], const Unit& u, int wr, int wc, int fr, int fq) const {
        const int row0 = u.pm * 256 + wr * 64 + fr, col0 = u.pn * 256 + wc * 32 + 4 * fq; const int vec = vec_of(u.pm * 256);
        const float* g1 = modq(src.mod, layer, vec, 2);
        f32x4 gv[2][2];
#pragma unroll
        for (int bj = 0; bj < 2; ++bj)
#pragma unroll
            for (int n = 0; n < 2; ++n) { const int cc = col0 + bj * 128 + n * 16; gv[bj][n] = *(const f32x4*)(g1 + cc) * *(const f32x4*)(scale + cc); }
#pragma unroll
        for (int ai = 0; ai < 2; ++ai)
#pragma unroll
            for (int m = 0; m < 4; ++m) { const int r = row0 + ai * 128 + m * 16; const float* hi = hsrc_row(src, layer == 0, r) + col0; float* ho = src.H + (size_t)r * D + col0;
#pragma unroll
                for (int bj = 0; bj < 2; ++bj)
#pragma unroll
                    for (int n = 0; n < 2; ++n) *(f32x4*)(ho + bj * 128 + n * 16) = *(const f32x4*)(hi + bj * 128 + n * 16) + gv[bj][n] * acc[ai][bj][m][n]; }
    }
};
struct PolResid : PolBase {
    static constexpr bool PERM = false, GATHER = false; static constexpr bool FP8 = false; static constexpr int ES = 2; int K, lda, ldb;
    const bf16_t* A; const bf16_t* W; Src src; int layer, which, npan;
    DEV bool next(int i, Unit& u) const { return ge::static_next(npan, 4, G, c, i, u); }
    DEV const char* a_base(const Unit& u) const { return (const char*)(A + (size_t)u.pm * 256 * lda); }
    DEV const char* b_base(const Unit& u) const { return (const char*)(W + (size_t)u.pn * 256 * ldb); }
    DEV void epi(const f32x4 (&acc)[2][2][4][2], const Unit& u, int wr, int wc, int fr, int fq) const {
        const int row0 = u.pm * 256 + wr * 64 + fr, col0 = u.pn * 256 + wc * 32 + 4 * fq; const int vec = vec_of(u.pm * 256);
        const float* gp = modq(src.mod, layer, vec, which);
        f32x4 gv[2][2];
#pragma unroll
        for (int bj = 0; bj < 2; ++bj)
#pragma unroll
            for (int n = 0; n < 2; ++n) gv[bj][n] = *(const f32x4*)(gp + col0 + bj * 128 + n * 16);
#pragma unroll
        for (int ai = 0; ai < 2; ++ai)
#pragma unroll
            for (int mp = 0; mp < 4; mp += 2) { f32x4 hv[2][2][2];
#pragma unroll
                for (int m2 = 0; m2 < 2; ++m2) { const float* hi = src.H + (size_t)(row0 + ai * 128 + (mp + m2) * 16) * D + col0;
#pragma unroll
                    for (int bj = 0; bj < 2; ++bj)
#pragma unroll
                        for (int n = 0; n < 2; ++n) hv[m2][bj][n] = *(const f32x4*)(hi + bj * 128 + n * 16); }
#pragma unroll
                for (int m2 = 0; m2 < 2; ++m2) { float* ho = src.H + (size_t)(row0 + ai * 128 + (mp + m2) * 16) * D + col0;
#pragma unroll
                    for (int bj = 0; bj < 2; ++bj)
#pragma unroll
                        for (int n = 0; n < 2; ++n) *(f32x4*)(ho + bj * 128 + n * 16) = hv[m2][bj][n] + gv[bj][n] * acc[ai][bj][mp + m2][n]; } }
    }
};
template <bool MOE>
struct PolUp : PolBase {
    static constexpr bool PERM = true, GATHER = MOE, FP8 = MOE; static constexpr int ES = MOE ? 1 : 2; int K, lda, ldb;
    const bf16_t* A; const bf16_t* W; bf16_t* HID; int ldh, nq;
    int nM; const int* s2t; int tstart[NEXP + 1];
    DEV bool next(int i, Unit& u) const { return ge::static_next(MOE ? nM : NPAN, nq, G, c, i, u); }
    DEV int expert_of(int pm) const { int e = 0;
#pragma unroll
        for (int k = 1; k < NEXP; ++k) e += (pm >= tstart[k]) ? 1 : 0;
        return e; }
    DEV const char* a_base(const Unit& u) const { return MOE ? (const char*)A : (const char*)(A + (size_t)u.pm * 256 * lda); }
    DEV const char* b_base(const Unit& u) const { size_t off = (size_t)u.pn * 256 * ldb; if (MOE) off += (size_t)expert_of(u.pm) * 2 * DFFE * ldb; return (const char*)W + off * ES; }
    DEV int gather_row(const Unit& u, int R) const { return s2t[u.pm * 256 + R]; }
    DEV void epi(const f32x4 (&acc)[2][2][4][2], const Unit& u, int wr, int wc, int fr, int fq) const {
        const int row0 = u.pm * 256 + wr * 64 + fr, col0 = u.pn * 128 + wc * 32 + 8 * fq;
#pragma unroll
        for (int ai = 0; ai < 2; ++ai)
#pragma unroll
            for (int m = 0; m < 4; ++m) { bf16_t* o = HID + (size_t)(row0 + ai * 128 + m * 16) * ldh + col0;
                float h[8];
#pragma unroll
                for (int n = 0; n < 2; ++n)
#pragma unroll
                    for (int i = 0; i < 4; ++i) { if (MOE) h[4 * n + i] = siluf(acc[ai][0][m][n][i] * 0.00390625f) * (acc[ai][1][m][n][i] * (MOE_DOWN_FP8 ? 0.015625f : 0.00390625f));
                                                  else h[4 * n + i] = siluf(acc[ai][0][m][n][i]) * acc[ai][1][m][n][i]; }
                if (MOE && MOE_DOWN_FP8) { u32x2 w8; w8.x = pk4_fp8(h[0], h[1], h[2], h[3]); w8.y = pk4_fp8(h[4], h[5], h[6], h[7]);
                    *(u32x2*)((fp8_t*)HID + (size_t)(row0 + ai * 128 + m * 16) * ldh + col0) = w8; }
                else { u32x4 w; w.x = pk2(h[0], h[1]); w.y = pk2(h[2], h[3]); w.z = pk2(h[4], h[5]); w.w = pk2(h[6], h[7]); *(u32x4*)o = w; } }
    }
};
struct PolMoeDown : PolBase {
    static constexpr bool PERM = true, GATHER = (MOE_DOWN_FP8 != 0), FP8 = (MOE_DOWN_FP8 != 0); static constexpr int ES = MOE_DOWN_FP8 ? 1 : 2; int K, lda, ldb;
    const bf16_t* A; const bf16_t* W; bf16_t* YS; int nM; int tstart[NEXP + 1];
    DEV bool next(int i, Unit& u) const { return ge::static_next(nM, 4, G, c, i, u); }
    DEV int expert_of(int pm) const { int e = 0;
#pragma unroll
        for (int k = 1; k < NEXP; ++k) e += (pm >= tstart[k]) ? 1 : 0;
        return e; }
    DEV const char* a_base(const Unit& u) const { return GATHER ? (const char*)A : (const char*)A + (size_t)u.pm * 256 * lda * ES; }
    DEV int gather_row(const Unit& u, int R) const { return u.pm * 256 + R; }
    DEV const char* b_base(const Unit& u) const { return (const char*)W + ((size_t)expert_of(u.pm) * D + (size_t)u.pn * 256) * ldb * ES; }
    DEV void epi(const f32x4 (&acc)[2][2][4][2], const Unit& u, int wr, int wc, int fr, int fq) const {
        const int row0 = u.pm * 256 + wr * 64 + fr, col0 = u.pn * 256 + wc * 32 + 8 * fq;
#pragma unroll
        for (int ai = 0; ai < 2; ++ai)
#pragma unroll
            for (int m = 0; m < 4; ++m) { bf16_t* o = YS + (size_t)(row0 + ai * 128 + m * 16) * D + col0;
#pragma unroll
                for (int bj = 0; bj < 2; ++bj) { u32x4 w; w.x = pk2(acc[ai][bj][m][0][0], acc[ai][bj][m][0][1]); w.y = pk2(acc[ai][bj][m][0][2], acc[ai][bj][m][0][3]);
                    w.z = pk2(acc[ai][bj][m][1][0], acc[ai][bj][m][1][1]); w.w = pk2(acc[ai][bj][m][1][2], acc[ai][bj][m][1][3]); *(u32x4*)(o + bj * 128) = w; } }
    }
};
struct PolInProj : PolBase {
    static constexpr bool PERM = true, GATHER = false; static constexpr bool FP8 = false; static constexpr int ES = 2; int K, lda, ldb;
    const bf16_t* A; const bf16_t* W; bf16_t* Z; bf16_t* XBC; float* DT;
    DEV bool next(int i, Unit& u) const { return ge::static_next(NPAN, NPROJP / 256, G, c, i, u); }
    DEV const char* a_base(const Unit& u) const { return (const char*)(A + (size_t)u.pm * 256 * lda); }
    DEV const char* b_base(const Unit& u) const { return (const char*)(W + (size_t)u.pn * 256 * ldb); }
    DEV void epi(const f32x4 (&acc)[2][2][4][2], const Unit& u, int wr, int wc, int fr, int fq) const {
        const int row0 = u.pm * 256 + wr * 64 + fr, cw = wc * 32 + 8 * fq;
        if (u.pn < 20) {
            bf16_t* base; int ld, col0;
            if (u.pn < 8) { base = Z; ld = DIN; col0 = u.pn * 256 + cw; } else { base = XBC; ld = CONVD; col0 = (u.pn - 8) * 256 + cw; }
#pragma unroll
            for (int ai = 0; ai < 2; ++ai)
#pragma unroll
                for (int m = 0; m < 4; ++m) { bf16_t* o = base + (size_t)(row0 + ai * 128 + m * 16) * ld + col0;
#pragma unroll
                    for (int bj = 0; bj < 2; ++bj) { u32x4 w; w.x = pk2(acc[ai][bj][m][0][0], acc[ai][bj][m][0][1]); w.y = pk2(acc[ai][bj][m][0][2], acc[ai][bj][m][0][3]);
                        w.z = pk2(acc[ai][bj][m][1][0], acc[ai][bj][m][1][1]); w.w = pk2(acc[ai][bj][m][1][2], acc[ai][bj][m][1][3]); *(u32x4*)(o + bj * 128) = w; } }
        } else if (cw < 64) {
#pragma unroll
            for (int ai = 0; ai < 2; ++ai)
#pragma unroll
                for (int m = 0; m < 4; ++m) { const int r = row0 + ai * 128 + m * 16; int b, tv;
                    if (r < ML) { b = r / SEQ; tv = CTXL + r % SEQ; } else { b = (r - ML) / CTXL; tv = (r - ML) % CTXL; }
#pragma unroll
                    for (int n = 0; n < 2; ++n)
#pragma unroll
                        for (int i = 0; i < 4; ++i) { const int j = cw + 4 * n + i, dir = j >> 5, h = j & 31;
                            DT[((size_t)(b * 2 + dir) * NH + h) * TV + tv] = acc[ai][0][m][n][i]; } }
        }
    }
};

DEV void phase_conv(const Frame& F, int j, const bf16_t* XBC, bf16_t* XT, bf16_t* Brow, bf16_t* BT, bf16_t* Crow) {
    LAS bf16_t* tl0 = (LAS bf16_t*)F.lds;
    const float* cw = INP(F, I_CONVW) + (size_t)j * 4 * CONVD; const float* cb = INP(F, I_CONVB) + (size_t)j * CONVD;
    constexpr int NPER = NB * NCH, nitem = NPER * (CONVD / 64);
    const int t2 = 2 * (F.tid >> 3), cg = F.tid & 7;
    const int i0 = (int)(((long)F.bx * nitem) / F.G), i1 = (int)(((long)(F.bx + 1) * nitem) / F.G);
    int cblk_cur = -1; f32x4 wv[4][2], bv[2]; int par = 0;
#define CV_LOAD(it_, q_) do { const int _cb = (it_) / NPER, _rs = (it_) % NPER, _b = _rs / NCH, _cv = _rs % NCH; const int _ch = _cb * 64 + cg * 8, _tv = _cv * 128 + t2; \
        const int _s0 = _tv < CTXL ? 0 : CTXL, _s1 = _tv < CTXL ? CTXL : TV; \
        _Pragma("unroll") for (int k = 0; k < 5; ++k) { const int tk = _tv - 2 + k; q_[k] = (u32x4){0u, 0u, 0u, 0u}; \
            if (tk >= _s0 && tk < _s1) q_[k] = *(const u32x4*)(XBC + (size_t)row_of(_b, tk) * CONVD + _ch); } } while (0)
    u32x4 qn[5];
    if (i0 < i1) CV_LOAD(i0, qn);
    for (int it = i0; it < i1; ++it) {
        const int cblk = it / NPER, rest = it % NPER, b = rest / NCH, cv = rest % NCH;
        const int ch0 = cblk * 64 + cg * 8;
        if (cblk != cblk_cur) { cblk_cur = cblk;
#pragma unroll
            for (int k = 0; k < 4; ++k) { wv[k][0] = *(const f32x4*)(cw + k * CONVD + ch0); wv[k][1] = *(const f32x4*)(cw + k * CONVD + ch0 + 4); }
            bv[0] = *(const f32x4*)(cb + ch0); bv[1] = *(const f32x4*)(cb + ch0 + 4); }
        const int tv = cv * 128 + t2;
        float xin[5][8];
#pragma unroll
        for (int k = 0; k < 5; ++k) { const u32x4 q = qn[k];
            xin[k][0] = bflo(q.x); xin[k][1] = bfhi(q.x); xin[k][2] = bflo(q.y); xin[k][3] = bfhi(q.y); xin[k][4] = bflo(q.z); xin[k][5] = bfhi(q.z); xin[k][6] = bflo(q.w); xin[k][7] = bfhi(q.w); }
        if (it + 1 < i1) CV_LOAD(it + 1, qn);
        unsigned pk[2][4];
#pragma unroll
        for (int o = 0; o < 2; ++o) { float a[8];
#pragma unroll
            for (int i = 0; i < 8; ++i) { float acc = bv[i >> 2][i & 3];
#pragma unroll
                for (int k = 0; k < 4; ++k) acc += wv[k][i >> 2][i & 3] * xin[o + k][i];
                a[i] = siluf(acc); }
#pragma unroll
            for (int i = 0; i < 4; ++i) pk[o][i] = pk2(a[2 * i], a[2 * i + 1]); }
        const int r = row_of(b, tv);
        const bool isx = cblk < DIN / 64, isb = !isx && cblk < (DIN + BCD) / 64;
        if (isb) { bf16_t* o = Brow + (ch0 - DIN) + (size_t)r * BCD;
            *(u32x4*)o = (u32x4){pk[0][0], pk[0][1], pk[0][2], pk[0][3]}; *(u32x4*)(o + BCD) = (u32x4){pk[1][0], pk[1][1], pk[1][2], pk[1][3]}; }
        else if (!isx) {
            const int chc = ch0 - DIN - BCD; bf16_t* o = Crow + (size_t)(r - t2) * BCD + (chc >> 7) * 16384 + frag_off(t2, chc & 127);
            *(u32x4*)o = (u32x4){pk[0][0], pk[0][1], pk[0][2], pk[0][3]}; *(u32x4*)(o + 8) = (u32x4){pk[1][0], pk[1][1], pk[1][2], pk[1][3]}; }
        if (isx || isb) {
            LAS bf16_t* tl = tl0 + par * (64 * 136); par ^= 1;
#pragma unroll
            for (int i = 0; i < 4; ++i) { const unsigned lo = (pk[0][i] & 0xffffu) | (pk[1][i] << 16), hi = (pk[0][i] >> 16) | (pk[1][i] & 0xffff0000u);
                *(LAS unsigned*)(tl + (cg * 8 + 2 * i) * 136 + t2) = lo; *(LAS unsigned*)(tl + (cg * 8 + 2 * i + 1) * 136 + t2) = hi; }
            __syncthreads();
            if (isx) { bf16_t* dst = XT + ((size_t)b * DIN + cblk * 64) * TV;
#pragma unroll
                for (int q = 0; q < 2; ++q) { const int idx = F.tid + q * 512, ch = idx >> 4, t8 = (idx & 15) * 8;
                    *(u32x4*)(dst + (size_t)ch * TV + cv * 128 + t8) = *(const LAS u32x4*)(tl + ch * 136 + t8); }
            } else {
                const int chb = cblk * 64 - DIN; bf16_t* dst = BT + (size_t)((b * NCH + cv) * NG + (chb >> 7)) * 16384 + ((chb & 127) >> 4) * 2048;
#pragma unroll
                for (int q = 0; q < 2; ++q) { const int idx = F.tid + q * 512, fr_ = idx & 15, fq_ = (idx >> 4) & 3, ks_ = (idx >> 6) & 3, rbl = idx >> 8;
                    *(u32x4*)(dst + idx * 8) = *(const LAS u32x4*)(tl + (rbl * 16 + fr_) * 136 + (ks_ * 4 + fq_) * 8); }
            }
        }
    }
}

#undef CV_LOAD
DEV void phase_cb(const Frame& F, const bf16_t* Brow, const bf16_t* Crow, bf16_t* CB) {
    const int nitem = NB * NG * NCH; const int fr = F.lane & 15, fq = F.lane >> 4;
    for (int it = F.bx; it < nitem; it += F.G) {
        const int cv = it % NCH, g = (it / NCH) % NG, b = it / (NCH * NG);
        const int rbase = row_of(b, cv * 128);
        bf16x8 cf[4];
#pragma unroll
        for (int ks = 0; ks < 4; ++ks) cf[ks] = *(const bf16x8*)(Crow + (size_t)rbase * BCD + g * 16384 + (F.wave * 4 + ks) * 512 + F.lane * 8);
        bf16_t* out = CB + ((size_t)((b * NG + g) * NCH + cv)) * 16384;
#pragma unroll
        for (int nt = 0; nt < 8; ++nt) {
            f32x4 acc = (f32x4){0.f, 0.f, 0.f, 0.f};
#pragma unroll
            for (int ks = 0; ks < 4; ++ks) { const bf16x8 bfr = *(const bf16x8*)(Brow + (size_t)(rbase + 16 * nt + fr) * BCD + g * 128 + 32 * ks + 8 * fq); acc = MFMA16(bfr, cf[ks], acc); }
            u32x2 w; w.x = pk2(acc[0], acc[1]); w.y = pk2(acc[2], acc[3]);
            *(u32x2*)(out + frag_off(16 * F.wave + fr, 16 * nt + 4 * fq)) = w;
        }
    }
}

DEV void phase_tables(const Frame& F, int j, float* DT, float* CUM, float* WJ, float* CF) {
    const int nitem = NB * 2 * NH * NCH; const int gw = F.bx * 8 + F.wave, NGW = F.G * 8;
    for (int it = gw; it < nitem; it += NGW) {
        const int cv = it % NCH, h = (it / NCH) % NH, dir = (it / (NCH * NH)) & 1, b = it / (NCH * NH * 2);
        const float A = -expf(INP(F, I_ALOG)[(size_t)(j * 2 + dir) * NH + h]); const float bias = INP(F, I_DTB)[(size_t)(j * 2 + dir) * NH + h];
        const size_t o = ((size_t)(b * 2 + dir) * NH + h) * TV + cv * 128 + 2 * F.lane;
        const f32x2 raw = *(const f32x2*)(DT + o); const float d0 = softplusf(raw.x + bias), d1 = softplusf(raw.y + bias); const float a0 = d0 * A, a1 = d1 * A;
        float c0, c1, tot, sum = a0 + a1;
        if (dir == 0) {
#pragma unroll
            for (int q = 1; q < 64; q <<= 1) { const float t2 = __shfl_up(sum, q); if (F.lane >= q) sum += t2; }
            c1 = sum; c0 = sum - a1; tot = __shfl(sum, 63);
        } else {
#pragma unroll
            for (int q = 1; q < 64; q <<= 1) { const float t2 = __shfl_down(sum, q); if (F.lane + q < 64) sum += t2; }
            c0 = sum; c1 = sum - a0; tot = __shfl(sum, 0);
        }
        constexpr float L2E = 1.4426950408889634f;
        *(f32x2*)(DT + o) = (f32x2){c0 * L2E - flog2(d0), c1 * L2E - flog2(d1)};
        *(f32x2*)(CUM + o) = (f32x2){c0 * L2E, c1 * L2E};
        *(f32x2*)(WJ + o) = (f32x2){d0 * FEXP(tot - c0), d1 * FEXP(tot - c1)};
        const float cref = L2E * __shfl(dir == 0 ? c1 : c0, dir == 0 ? (F.lane | 15) : (F.lane & ~15));
        *(f32x2*)(CF + o) = (f32x2){d0 * fexp2(cref - c0 * L2E), d1 * fexp2(cref - c1 * L2E)};
    }
}

constexpr int SC_HL = 0, SC_TAB = 17408, SC_X = 21504, SC_END = SC_X + 16384;
static_assert(SC_END <= ge::STAGE_BYTES, "scan LDS map");
DEV void phase_scan(const Frame& F, int j, const bf16_t* XT, const bf16_t* BT, const bf16_t* Crow, const bf16_t* CB, const float* DT, const float* CUM, const float* WJ, const float* CF, bf16_t* Yf, bf16_t* Yb) {
    LAS unsigned char* L = F.lds;
    LAS bf16_t* Hl = (LAS bf16_t*)(L + SC_HL);
    LAS float* tab = (LAS float*)(L + SC_TAB);
    const int fr = F.lane & 15, fq = F.lane >> 4, w = F.wave;
    const int rb = w < 4 ? w : 11 - w;
    const int nitem = NB * NH * 2 * 2;
    for (int it = F.bx; it < nitem; it += F.G) {
        const int xq = it & 7, kq = it >> 3; const int b = xq >> 2, g = xq & 3, h = 8 * g + (kq >> 2), dir = (kq >> 1) & 1, ph = kq & 1;
        const float Dsk = dir == 0 ? INP(F, I_DSKIP)[(size_t)j * NH + h] : 0.f;
        const size_t tbase = ((size_t)(b * 2 + dir) * NH + h) * TV;
        const bf16_t* xt = XT + ((size_t)b * DIN + h * HD + ph * 32) * TV;
        const bf16_t* bt = BT + (size_t)(b * NCH * NG + g) * 16384;
        const bf16_t* CBh = CB + (size_t)((b * NG + g) * NCH) * 16384;
        const bf16_t* Cg = Crow + g * 16384;
        bf16_t* Y = (dir ? Yb : Yf) + h * HD + ph * 32;
        const int lrow = 16 * rb + fr;
        f32x4 accH[2]; accH[0] = (f32x4){0.f, 0.f, 0.f, 0.f}; accH[1] = accH[0];
        for (int i = F.tid; i < 32 * 136 / 2; i += 512) ((LAS unsigned*)Hl)[i] = 0u;
#define SC_CHUNK_OF(step) (dir == 0 ? (step) : ((step) < 2 ? 1 - (step) : (NCH - 1) - ((step) - 2)))
        const int xr = 4 * w + (F.lane >> 4), xc = F.lane & 15;
        const unsigned lxs = (unsigned)(xr * TV + 8 * xc) * 2u, lxd = (unsigned)(xr * 256 + ((xc ^ (xr & 15)) << 4));
#define SC_LD_X(cvx_) (*(const u32x4*)((const char*)(xt + (unsigned)(cvx_) * 128u) + lxs))
#define SC_ST_X(xb_, v_) (*(LAS u32x4*)(L + SC_X + (xb_) * 8192 + lxd) = (v_))
        const float* tsrcw = ((w >> 1) == 0 ? CUM : ((w >> 1) == 1 ? DT : ((w >> 1) == 2 ? WJ : CF))) + tbase + (w & 1) * 64 + F.lane;
#define SC_LD_TAB(cvx_) (tsrcw[(cvx_) * 128])
#define SC_ST_TAB(tbuf_, v_) (tab[(tbuf_) * 512 + w * 64 + F.lane] = (v_))
        const unsigned lfo = (unsigned)(rb * 4096 + F.lane * 16);
#define SC_LD_CB(cvx_, ks_) (*(const u32x4*)((const char*)(CBh + (size_t)(cvx_) * 16384u) + lfo + (ks_) * 1024))
#define SC_LD_BT(cvx_, ks_) (*(const u32x4*)((const char*)(bt + (size_t)(cvx_) * 65536u) + lfo + (ks_) * 1024))
#define SC_LD_C(rbx_, ks_) (*(const bf16x8*)((const char*)(Cg + (size_t)(rbx_) * BCD) + lfo + (ks_) * 1024))
        const int kd = rb >> 1; float km[8], dk[8];
#pragma unroll
        for (int i = 0; i < 8; ++i) { const int sidx = 32 * kd + 8 * fq + i; km[i] = (dir == 0 ? (sidx <= lrow) : (sidx >= lrow)) ? 1.f : 0.f; dk[i] = (sidx == lrow) ? Dsk : 0.f; }
        u32x4 rcb[4], rbt[4]; bf16x8 cf[4];
        { const int cv0 = SC_CHUNK_OF(0); const u32x4 x0 = SC_LD_X(cv0); const float t0 = SC_LD_TAB(cv0); const unsigned rb0 = (unsigned)row_of(b, cv0 * 128);
#pragma unroll
          for (int ks = 0; ks < 4; ++ks) { rcb[ks] = SC_LD_CB(cv0, ks); rbt[ks] = SC_LD_BT(cv0, ks); cf[ks] = SC_LD_C(rb0, ks); }
          SC_ST_X(0, x0); SC_ST_TAB(0, t0); }
        for (int step = 0; step < NCH; ++step) {
            int kdl = kd, dirl = dir; LAUNDER_S(kdl); LAUNDER_S(dirl);
            const int cv = SC_CHUNK_OF(step), buf = step & 1; const bool more = step + 1 < NCH;
            const int cvn = more ? SC_CHUNK_OF(step + 1) : cv;
            const unsigned rbase = (unsigned)row_of(b, cv * 128), rbn = (unsigned)row_of(b, cvn * 128);
            LDSBAR();
            const u32x4 xn = SC_LD_X(cvn); const float tn = SC_LD_TAB(cvn);
            const LAS float* tb = tab + buf * 512;
            const float cl2 = tb[lrow]; const float ecum_l = fexp2(cl2);
            const float chunk_decay = fexp2(dir == 0 ? tb[127] : tb[0]);
            bf16x8 mf[4], bw[4];
#pragma unroll
            for (int ks = 0; ks < 4; ++ks) { const int s0 = 32 * ks + 8 * fq;
                const bool none = dirl == 0 ? (ks > kdl) : (ks < kdl), diag = (ks == kdl);
                unsigned om[4] = {0u, 0u, 0u, 0u};
                if (!none) {
                    const unsigned qc[4] = {rcb[ks].x, rcb[ks].y, rcb[ks].z, rcb[ks].w};
                    if (!diag) {
                        const f32x4 f0 = *(const LAS f32x4*)(tb + 384 + s0), f1 = *(const LAS f32x4*)(tb + 384 + s0 + 4);
                        const float rowf = fexp2(cl2 - tb[dirl == 0 ? 32 * ks + 31 : 32 * ks]);
                        const f32x2 rf2 = {rowf, rowf};
                        const f32x2 c2[4] = {(f32x2){f0[0], f0[1]}, (f32x2){f0[2], f0[3]}, (f32x2){f1[0], f1[1]}, (f32x2){f1[2], f1[3]}};
#pragma unroll
                        for (int i = 0; i < 4; ++i) { const f32x2 v2 = (f32x2){bflo(qc[i]), bfhi(qc[i])} * (c2[i] * rf2); om[i] = pk2(v2.x, v2.y); }
                    } else {
                        const f32x4 cs0 = *(const LAS f32x4*)(tb + 128 + s0), cs1 = *(const LAS f32x4*)(tb + 128 + s0 + 4);
                        const float cs[8] = {cs0[0], cs0[1], cs0[2], cs0[3], cs1[0], cs1[1], cs1[2], cs1[3]};
                        float v[8];
#pragma unroll
                        for (int i = 0; i < 8; ++i) { const float cbv = (i & 1) ? bfhi(qc[i >> 1]) : bflo(qc[i >> 1]); const float x = cl2 - cs[i]; v[i] = (cbv * fexp2(x < 60.f ? x : 60.f)) * km[i] + dk[i]; }
#pragma unroll
                        for (int i = 0; i < 4; ++i) om[i] = pk2(v[2 * i], v[2 * i + 1]);
                    }
                }
                rcb[ks] = SC_LD_CB(cvn, ks);
                mf[ks] = __builtin_bit_cast(bf16x8, (u32x4){om[0], om[1], om[2], om[3]});
                { const f32x4 ws0 = *(const LAS f32x4*)(tb + 256 + s0), ws1 = *(const LAS f32x4*)(tb + 256 + s0 + 4);
                  const f32x2 w2[4] = {(f32x2){ws0[0], ws0[1]}, (f32x2){ws0[2], ws0[3]}, (f32x2){ws1[0], ws1[1]}, (f32x2){ws1[2], ws1[3]}};
                  const unsigned qb[4] = {rbt[ks].x, rbt[ks].y, rbt[ks].z, rbt[ks].w}; unsigned ob[4];
#pragma unroll
                  for (int i = 0; i < 4; ++i) { const f32x2 v2 = (f32x2){bflo(qb[i]), bfhi(qb[i])} * w2[i]; ob[i] = pk2(v2.x, v2.y); LAUNDER_V(ob[i]); }
                  bw[ks] = __builtin_bit_cast(bf16x8, (u32x4){ob[0], ob[1], ob[2], ob[3]}); }
                rbt[ks] = SC_LD_BT(cvn, ks); }
            f32x4 yd[2], yo[2];
#pragma unroll
            for (int nt = 0; nt < 2; ++nt) { yd[nt] = (f32x4){0.f, 0.f, 0.f, 0.f}; yo[nt] = yd[nt]; accH[nt] = accH[nt] * chunk_decay; }
#pragma unroll
            for (int nt = 0; nt < 2; ++nt)
#pragma unroll
                for (int ks = 0; ks < 4; ++ks) {
                    const bf16x8 xf = *(const LAS bf16x8*)(L + SC_X + buf * 8192 + (16 * nt + fr) * 256 + (((4 * ks + fq) ^ fr) << 4));
                    yd[nt] = MFMA16(xf, mf[ks], yd[nt]);
                    const bf16x8 hf = *(const LAS bf16x8*)(Hl + buf * (32 * 136) + (16 * nt + fr) * 136 + 32 * ks + 8 * fq);
                    yo[nt] = MFMA16(hf, cf[ks], yo[nt]);
                    accH[nt] = MFMA16(bw[ks], xf, accH[nt]); }
#pragma unroll
            for (int ks = 0; ks < 4; ++ks) cf[ks] = SC_LD_C(rbn, ks);
            SC_ST_X(buf ^ 1, xn); SC_ST_TAB(buf ^ 1, tn);
#pragma unroll
            for (int nt = 0; nt < 2; ++nt) { u32x2 hw; hw.x = pk2(accH[nt][0], accH[nt][1]); hw.y = pk2(accH[nt][2], accH[nt][3]);
                *(LAS u32x2*)(Hl + (buf ^ 1) * (32 * 136) + (16 * nt + fr) * 136 + 16 * rb + 4 * fq) = hw; }
#pragma unroll
            for (int nt = 0; nt < 2; ++nt) { u32x2 yw; yw.x = pk2(yd[nt][0] + ecum_l * yo[nt][0], yd[nt][1] + ecum_l * yo[nt][1]); yw.y = pk2(yd[nt][2] + ecum_l * yo[nt][2], yd[nt][3] + ecum_l * yo[nt][3]);
                *(u32x2*)(Y + ((size_t)(rbase + lrow) * DIN + 16 * nt + 4 * fq)) = yw; }
        }
        WAITV(0); LDSBAR();
    }
}

DEV void phase_gate(const Frame& F, int j, const bf16_t* Yf, const bf16_t* Yb, const bf16_t* Z, bf16_t* YN, int nrows) {
    const int gw = F.bx * 8 + F.wave, NGW = F.G * 8; const float* nw = INP(F, I_SNORM) + (size_t)j * DIN;
    u32x4 na[4], nb[4], nz[4];
    if (gw < nrows) {
#pragma unroll
        for (int q = 0; q < 4; ++q) { const size_t o = (size_t)gw * DIN + 8 * F.lane + 512 * q; na[q] = *(const u32x4*)(Yf + o); nb[q] = *(const u32x4*)(Yb + o); nz[q] = *(const u32x4*)(Z + o); } }
    for (int r = gw; r < nrows; r += NGW) {
        float t[32]; float ss = 0.f;
        u32x4 ca[4], cb4[4], cz[4];
#pragma unroll
        for (int q = 0; q < 4; ++q) { ca[q] = na[q]; cb4[q] = nb[q]; cz[q] = nz[q]; }
        if (r + NGW < nrows) {
#pragma unroll
            for (int q = 0; q < 4; ++q) { const size_t o = (size_t)(r + NGW) * DIN + 8 * F.lane + 512 * q; na[q] = *(const u32x4*)(Yf + o); nb[q] = *(const u32x4*)(Yb + o); nz[q] = *(const u32x4*)(Z + o); } }
#pragma unroll
        for (int q = 0; q < 4; ++q) { const u32x4 a = ca[q], bq = cb4[q], z = cz[q];
            const unsigned aa[4] = {a.x, a.y, a.z, a.w}, bb[4] = {bq.x, bq.y, bq.z, bq.w}, zz[4] = {z.x, z.y, z.z, z.w};
#pragma unroll
            for (int i = 0; i < 4; ++i) { const float v0 = (bflo(aa[i]) + bflo(bb[i])) * siluf(bflo(zz[i])), v1 = (bfhi(aa[i]) + bfhi(bb[i])) * siluf(bfhi(zz[i])); t[8 * q + 2 * i] = v0; t[8 * q + 2 * i + 1] = v1; ss += v0 * v0 + v1 * v1; } }
        const float rstd = rsqrtf(wave_sum(ss) * (1.0f / DIN) + EPS);
#pragma unroll
        for (int q = 0; q < 4; ++q) { const int c = 8 * F.lane + 512 * q; const f32x4 w0 = *(const f32x4*)(nw + c), w1 = *(const f32x4*)(nw + c + 4);
            u32x4 o; o.x = pk2(t[8 * q] * rstd * w0[0], t[8 * q + 1] * rstd * w0[1]); o.y = pk2(t[8 * q + 2] * rstd * w0[2], t[8 * q + 3] * rstd * w0[3]);
            o.z = pk2(t[8 * q + 4] * rstd * w1[0], t[8 * q + 5] * rstd * w1[1]); o.w = pk2(t[8 * q + 6] * rstd * w1[2], t[8 * q + 7] * rstd * w1[3]);
            *(u32x4*)(YN + (size_t)r * DIN + c) = o; }
    }
}

DEV void phase_route(const Frame& F, int layer, int ml, bf16_t* V, int nrows) {
    LAS unsigned* lc = (LAS unsigned*)(F.lds + LDS_MISC + 256);
    if (F.tid < 8) lc[F.tid] = 0u;
    __syncthreads();
    const int gw = F.bx * 8 + F.wave, NGW = F.G * 8; const int j = layer / 2;
    const float* w = INP(F, I_NFFN) + (size_t)layer * D; const float* rw = INP(F, I_RW) + (size_t)j * D * NEXP;
    LAS float* rwl = (LAS float*)F.lds;
    for (int q = F.tid; q < D * 2; q += 512) { const int c = q >> 1, hf = q & 1; const int ln = (c & 255) >> 2, ii = c & 3, jq = c >> 8;
        *(LAS f32x4*)(rwl + ((jq * 4 + ii) * 64 + ln) * 8 + hf * 4) = *(const f32x4*)(rw + (size_t)q * 4); }
    __syncthreads();
    TokInfo* tok = (TokInfo*)(F.ws + OFF_TOK);
    f32x4 nx[4];
    if (gw < nrows) load_row(F.H + (size_t)gw * D, F.lane, nx);
    for (int r = gw; r < nrows; r += NGW) {
        f32x4 v[4];
#pragma unroll
        for (int q = 0; q < 4; ++q) v[q] = nx[q];
        if (r + NGW < nrows) load_row(F.H + (size_t)(r + NGW) * D, F.lane, nx);
        const float rstd = rsqrtf(sumsq_row(v) * (1.0f / D) + EPS);
        const int vec = vec_of(r);
        normmod_row(v, rstd, w, modp(F, layer, vec, 3), modp(F, layer, vec, 4), F.lane);
#pragma unroll
        for (int jq = 0; jq < 4; ++jq) *(unsigned*)((fp8_t*)V + (size_t)r * D + 4 * F.lane + 256 * jq) = pk4_fp8(v[jq][0] * 8.0f, v[jq][1] * 8.0f, v[jq][2] * 8.0f, v[jq][3] * 8.0f);
        float lg[NEXP];
#pragma unroll
        for (int e = 0; e < NEXP; ++e) lg[e] = 0.f;
#pragma unroll
        for (int jj = 0; jj < 4; ++jj)
#pragma unroll
            for (int i = 0; i < 4; ++i) { const LAS float* rp = rwl + ((jj * 4 + i) * 64 + F.lane) * 8; const f32x4 r0 = *(const LAS f32x4*)rp, r1 = *(const LAS f32x4*)(rp + 4);
#pragma unroll
                for (int e = 0; e < 4; ++e) { lg[e] += v[jj][i] * r0[e]; lg[4 + e] += v[jj][i] * r1[e]; } }
#pragma unroll
        for (int e = 0; e < NEXP; ++e) lg[e] = wave_sum(lg[e]);
        int e0 = 0; float v0 = lg[0];
#pragma unroll
        for (int e = 1; e < NEXP; ++e) if (lg[e] > v0) { v0 = lg[e]; e0 = e; }
        int e1 = -1; float v1 = -3.0e38f;
#pragma unroll
        for (int e = 0; e < NEXP; ++e) if (e != e0 && lg[e] > v1) { v1 = lg[e]; e1 = e; }
        const float g1 = frcp(1.0f + FEXP(v0 - v1)), g0 = 1.0f - g1;
        if (F.lane == 0) { TokInfo ti; ti.s0 = e0; ti.s1 = e1; ti.g0 = g0; ti.g1 = g1; tok[r] = ti; atomicAdd((unsigned*)&lc[e0], 1u); atomicAdd((unsigned*)&lc[e1], 1u); }
    }
    __syncthreads();
    if (F.tid < 8) __hip_atomic_fetch_add(F.ctl + CW_CNT + (ml * 8 + F.tid) * 64, lc[F.tid], RLX_AGENT);
}
DEV void tile_starts(const Frame& F, int ml, int (&ts)[NEXP + 1], unsigned (&cnt)[NEXP]) {
    ts[0] = 0;
#pragma unroll
    for (int e = 0; e < NEXP; ++e) { cnt[e] = __hip_atomic_load(F.ctl + CW_CNT + (ml * 8 + e) * 64, RLX_AGENT); ts[e + 1] = ts[e] + (int)((cnt[e] + 255u) / 256u); }
}
DEV void phase_slots(const Frame& F, int ml, int nrows) {
    int ts[NEXP + 1]; unsigned cnt[NEXP]; tile_starts(F, ml, ts, cnt);
    TokInfo* tok = (TokInfo*)(F.ws + OFF_TOK); int* s2t = (int*)(F.ws + OFF_S2T);
    const int gw = F.bx * 8 + F.wave, NGW = F.G * 8;
    for (int base = gw * 64; base < nrows; base += NGW * 64) {
        const int r = base + F.lane; TokInfo ti = tok[r];
        unsigned long long m0[NEXP], m1[NEXP]; unsigned mycnt = 0;
#pragma unroll
        for (int e = 0; e < NEXP; ++e) { m0[e] = __ballot(ti.s0 == e); m1[e] = __ballot(ti.s1 == e); if (F.lane == e) mycnt = (unsigned)(__builtin_popcountll(m0[e]) + __builtin_popcountll(m1[e])); }
        unsigned b0 = 0;
        if (F.lane < NEXP && mycnt) b0 = __hip_atomic_fetch_add(F.ctl + CW_CUR + (ml * 8 + F.lane) * 64, mycnt, RLX_AGENT);
        const unsigned long long below = (1ull << F.lane) - 1ull; int sl0 = 0, sl1 = 0;
#pragma unroll
        for (int e = 0; e < NEXP; ++e) { const unsigned be = __shfl(b0, e); const int c0 = __builtin_popcountll(m0[e]);
            if (ti.s0 == e) sl0 = ts[e] * 256 + (int)be + __builtin_popcountll(m0[e] & below);
            if (ti.s1 == e) sl1 = ts[e] * 256 + (int)be + c0 + __builtin_popcountll(m1[e] & below); }
        ti.s0 = sl0; ti.s1 = sl1; tok[r] = ti; s2t[sl0] = r; s2t[sl1] = r;
    }
    if (F.bx == 0) { for (int e = 0; e < NEXP; ++e) { const int a = ts[e] * 256 + (int)cnt[e], b2 = ts[e + 1] * 256; for (int s = a + F.tid; s < b2; s += 512) s2t[s] = 0; } }
}
DEV void phase_combine(const Frame& F, int layer, const bf16_t* YS, bool final_) {
    const int NGW = F.G * 8; const int gw = F.bx * 8 + F.wave + (final_ ? 0 : ML); const TokInfo* tok = (const TokInfo*)(F.ws + OFF_TOK);
    const int nrows = final_ ? ML : MT;
    f32x4 nh[4]; u32x2 nya[4], nyb[4]; TokInfo tcur, tnxt;
    tcur.s0 = tcur.s1 = 0; tcur.g0 = tcur.g1 = 0.f; tnxt = tcur;
    if (gw < nrows) { tcur = tok[gw]; load_row(F.H + (size_t)gw * D, F.lane, nh);
#pragma unroll
        for (int jj = 0; jj < 4; ++jj) { const int c = 4 * F.lane + 256 * jj; nya[jj] = *(const u32x2*)(YS + (size_t)tcur.s0 * D + c); nyb[jj] = *(const u32x2*)(YS + (size_t)tcur.s1 * D + c); } }
    if (gw + NGW < nrows) tnxt = tok[gw + NGW];
    for (int r = gw; r < nrows; r += NGW) {
        f32x4 v[4]; u32x2 ya[4], yb[4]; TokInfo ti = tcur;
#pragma unroll
        for (int q = 0; q < 4; ++q) { v[q] = nh[q]; ya[q] = nya[q]; yb[q] = nyb[q]; }
        tcur = tnxt;
        if (r + NGW < nrows) { load_row(F.H + (size_t)(r + NGW) * D, F.lane, nh);
#pragma unroll
            for (int jj = 0; jj < 4; ++jj) { const int c = 4 * F.lane + 256 * jj; nya[jj] = *(const u32x2*)(YS + (size_t)tcur.s0 * D + c); nyb[jj] = *(const u32x2*)(YS + (size_t)tcur.s1 * D + c); } }
        if (r + 2 * NGW < nrows) tnxt = tok[r + 2 * NGW];
        if (MOE_DOWN_FP8) { ti.g0 *= 0.00390625f; ti.g1 *= 0.00390625f; }
        const float* g2 = modp(F, layer, vec_of(r), 5);
#pragma unroll
        for (int jj = 0; jj < 4; ++jj) { const int c = 4 * F.lane + 256 * jj; const u32x2 a = ya[jj], b = yb[jj]; const f32x4 gv = *(const f32x4*)(g2 + c);
            v[jj][0] += gv[0] * (ti.g0 * bflo(a.x) + ti.g1 * bflo(b.x)); v[jj][1] += gv[1] * (ti.g0 * bfhi(a.x) + ti.g1 * bfhi(b.x));
            v[jj][2] += gv[2] * (ti.g0 * bflo(a.y) + ti.g1 * bflo(b.y)); v[jj][3] += gv[3] * (ti.g0 * bfhi(a.y) + ti.g1 * bfhi(b.y)); }
        if (!final_) {
#pragma unroll
            for (int jj = 0; jj < 4; ++jj) *(f32x4*)(F.H + (size_t)r * D + 4 * F.lane + 256 * jj) = v[jj];
        } else {
            const float rstd = rsqrtf(sumsq_row(v) * (1.0f / D) + EPS); const float* fw = INP(F, I_FNORM);
#pragma unroll
            for (int jj = 0; jj < 4; ++jj) { const int c = 4 * F.lane + 256 * jj; *(f32x4*)(OUTP(F) + (size_t)r * D + c) = v[jj] * rstd * *(const f32x4*)(fw + c); }
        }
    }
}

constexpr int PH_PER_PAIR = 17, N_PHASES = 1 + 2 * PH_PER_PAIR;
__global__ void __launch_bounds__(512, 2) fwd_kernel(Params prm) {
#ifdef EMU
    unsigned char* lds_raw = emu_lds();
#else
    extern __shared__ __attribute__((aligned(16))) unsigned char lds_raw[];
#endif
    Frame F;
    F.lds = (LAS unsigned char*)lds_raw;
    F.tid = threadIdx.x; F.lane = F.tid & 63; F.wave = RFL(F.tid >> 6); F.G = gridDim.x; F.bx = blockIdx.x;
    F.p = &prm; F.ws = prm.ws; F.ctl = (unsigned*)(prm.ws + OFF_CTL); F.H = (float*)(prm.ws + OFF_H); F.mod = (float*)(prm.ws + OFF_MOD);
    volatile LAS unsigned* misc = (volatile LAS unsigned*)(F.lds + LDS_MISC);
    if (F.tid < 64) misc[F.tid] = 0u;
    __syncthreads();
    XcdBarrier bar; bar.bar = F.ctl + CW_BAR; bar.x = 0; bar.st = misc;
    const int lo = prm.ph_lo, hi = prm.ph_hi;
    if (hi - lo > 1) bar = xcd_barrier_post(F.ctl + CW_BAR, misc);
    int ph = 0;
#ifndef SITE_MASK
#define SITE_MASK 0xFFFFFFFFu
#endif
#ifndef PROBE_REPEAT_SITE
#define PROBE_REPEAT_SITE (-1)
#endif
#define PH_REPS(site) ((PROBE_REPEAT_SITE == (site)) ? 2 : 1)
#define PHASE_BEGIN(site) if (((SITE_MASK >> (site)) & 1u) && lo <= ph && ph < hi) { { int _t = threadIdx.x; LAUNDER_V(_t); F.tid = _t; F.lane = _t & 63; int _b = blockIdx.x; LAUNDER_S(_b); F.bx = _b; int _g = gridDim.x; LAUNDER_S(_g); F.G = _g; \
      F.ws = WSP(F); F.ctl = (unsigned*)(F.ws + OFF_CTL); F.H = (float*)(F.ws + OFF_H); F.mod = (float*)(F.ws + OFF_MOD); } \
      for (int _rep = 0; _rep < PH_REPS(site); ++_rep) { if (_rep) __syncthreads();
#define PHASE_END   } if (ph + 1 < hi) xcd_barrier(bar); } ++ph;
#define B_W (F.ws + OFF_W)
#define B_ACT (F.ws + OFF_ACT)
#define B_P ((bf16_t*)(B_ACT + A_P))
#define B_HID ((bf16_t*)(B_ACT + A_HID))
#define B_U ((bf16_t*)(B_ACT + A_U))
#define B_Z ((bf16_t*)(B_ACT + A_Z))
#define B_XBC ((bf16_t*)(B_ACT + A_XBC))
#define B_DT ((float*)(B_W + W_DT))
#define B_XT ((bf16_t*)(B_ACT + A_XT))
#define B_BROW ((bf16_t*)(B_ACT + A_BROW))
#define B_BT ((bf16_t*)(B_ACT + A_BT))
#define B_CROW ((bf16_t*)(B_ACT + A_CROW))
#define B_CB ((bf16_t*)(B_ACT + A_CB))
#define B_CUM ((float*)(B_ACT + A_CUM))
#define B_WJ ((float*)(B_ACT + A_WJ))
#define B_CF ((float*)(B_ACT + A_CF))
#define B_YF ((bf16_t*)(B_ACT + A_YF))
#define B_YB ((bf16_t*)(B_W + W_YB))
#define B_YN ((bf16_t*)(B_ACT + A_YN))
#define B_V ((bf16_t*)(B_ACT + A_V))
#define B_HIDM ((bf16_t*)(B_ACT + A_HIDM))
#define B_YS ((bf16_t*)(B_ACT + A_YS))

    PHASE_BEGIN(0) phase_mod(F); convert_even(F, 0); PHASE_END

    for (int lp = 0; lp < 2; ++lp) {
        const int le = 2 * lp, lod = 2 * lp + 1;
        PHASE_BEGIN(1) phase_poolprep(F, le, B_P, lp == 1, B_YS); PHASE_END
        PHASE_BEGIN(2) { PolPool S; S.G = F.G; S.c = F.bx; S.K = 256; S.lda = D; S.ldb = 256; S.P = B_P; S.W = (const bf16_t*)(B_W + W_POOL); S.src = mksrc(F); S.layer = le; S.scale = INP(F, I_POOLS) + (size_t)lp * D;
                      ge::gemm_phase(F.lds, S, F.tid); } PHASE_END
        PHASE_BEGIN(3) phase_norm(F, le, 3, B_P, false); PHASE_END
        PHASE_BEGIN(4) { PolUp<false> S; S.G = F.G; S.c = F.bx; S.K = D; S.lda = D; S.ldb = D; S.A = B_P; S.W = (const bf16_t*)(B_W + W_UP); S.HID = B_HID; S.ldh = DFF; S.nq = DFF / 128; S.nM = NPAN; S.s2t = nullptr;
                      ge::gemm_phase(F.lds, S, F.tid); } PHASE_END
        PHASE_BEGIN(5) { PolResid S; S.G = F.G; S.c = F.bx; S.K = DFF; S.lda = DFF; S.ldb = DFF; S.A = B_HID; S.W = (const bf16_t*)(B_W + W_DN); S.src = mksrc(F); S.layer = le; S.which = 5; S.npan = NPAN;
                      ge::gemm_phase(F.lds, S, F.tid); } PHASE_END
        PHASE_BEGIN(6) phase_norm(F, lod, 0, B_U, false); convert_ssd(F, lp); PHASE_END
        PHASE_BEGIN(7) { PolInProj S; S.G = F.G; S.c = F.bx; S.K = D; S.lda = D; S.ldb = D; S.A = B_U; S.W = (const bf16_t*)(B_W + W_IN); S.Z = B_Z; S.XBC = B_XBC; S.DT = B_DT;
                      ge::gemm_phase(F.lds, S, F.tid); } PHASE_END
        PHASE_BEGIN(8) phase_conv(F, lp, B_XBC, B_XT, B_BROW, B_BT, B_CROW); PHASE_END
        PHASE_BEGIN(9) phase_cb(F, B_BROW, B_CROW, B_CB); phase_tables(F, lp, B_DT, B_CUM, B_WJ, B_CF); PHASE_END
        PHASE_BEGIN(10) phase_scan(F, lp, B_XT, B_BT, B_CROW, B_CB, B_DT, B_CUM, B_WJ, B_CF, B_YF, B_YB); PHASE_END
        PHASE_BEGIN(11) phase_gate(F, lp, B_YF, B_YB, B_Z, B_YN, lp == 1 ? ML : MT); PHASE_END
        PHASE_BEGIN(12) { PolResid S; S.G = F.G; S.c = F.bx; S.K = DIN; S.lda = DIN; S.ldb = DIN; S.A = B_YN; S.W = (const bf16_t*)(B_W + W_OUT); S.src = mksrc(F); S.layer = lod; S.which = 2; S.npan = lp == 1 ? ML / 256 : NPAN;
                      ge::gemm_phase(F.lds, S, F.tid); } PHASE_END
        PHASE_BEGIN(13) phase_route(F, lod, lp, B_V, lp == 1 ? ML : MT); convert_moe(F, lp); PHASE_END
        PHASE_BEGIN(14) phase_slots(F, lp, lp == 1 ? ML : MT); PHASE_END
        PHASE_BEGIN(15) { int ts[NEXP + 1]; unsigned cnt[NEXP]; tile_starts(F, lp, ts, cnt);
                      PolUp<true> S; S.G = F.G; S.c = F.bx; S.K = D; S.lda = D; S.ldb = D; S.A = B_V; S.W = (const bf16_t*)(B_W + W_MUP); S.HID = B_HIDM; S.ldh = DFFE; S.nq = DFFE / 128; S.nM = ts[NEXP];
                      S.s2t = (const int*)(F.ws + OFF_S2T);
#pragma unroll
                      for (int e = 0; e <= NEXP; ++e) S.tstart[e] = ts[e];
                      ge::gemm_phase(F.lds, S, F.tid); } PHASE_END
        PHASE_BEGIN(16) { int ts[NEXP + 1]; unsigned cnt[NEXP]; tile_starts(F, lp, ts, cnt);
                      PolMoeDown S; S.G = F.G; S.c = F.bx; S.K = DFFE; S.lda = DFFE; S.ldb = DFFE; S.A = B_HIDM; S.W = (const bf16_t*)(B_W + W_MDN); S.YS = B_YS; S.nM = ts[NEXP];
#pragma unroll
                      for (int e = 0; e <= NEXP; ++e) S.tstart[e] = ts[e];
                      ge::gemm_phase(F.lds, S, F.tid); } PHASE_END
        PHASE_BEGIN(17) phase_combine(F, lod, B_YS, lp == 1); if (lp == 0) convert_even(F, 1); PHASE_END
    }
#undef PHASE_BEGIN
#undef PHASE_END
}

extern "C" void kernel_launch(void* const* d_in, const int* in_sizes, int n_in, void* d_out, int out_size, void* d_ws, size_t ws_size, hipStream_t stream) {
    static int grid = 0;
    if (grid == 0) {
        if (n_in != 26 || ws_size < WS_NEED) { fprintf(stderr, "kernel_launch: need 26 inputs and %zu bytes of workspace (got %d, %zu)\n", (size_t)WS_NEED, n_in, ws_size); grid = -1; return; }
        int dev = 0, cus = 0, per_cu = 0;
        if (hipGetDevice(&dev) != hipSuccess || hipDeviceGetAttribute(&cus, hipDeviceAttributeMultiprocessorCount, dev) != hipSuccess) { grid = -1; return; }
        if (hipFuncSetAttribute((const void*)fwd_kernel, hipFuncAttributeMaxDynamicSharedMemorySize, LDS_BYTES) != hipSuccess) { grid = -1; return; }
        if (hipOccupancyMaxActiveBlocksPerMultiprocessor(&per_cu, (const void*)fwd_kernel, 512, LDS_BYTES) != hipSuccess || per_cu < 1) { fprintf(stderr, "kernel_launch: occupancy query says %d\n", per_cu); }
        (void)hipGetLastError();
        grid = cus;
    }
    if (grid < 0) return;
    (void)in_sizes; (void)out_size;
    if (hipMemsetAsync((char*)d_ws + OFF_CTL, 0, CTL_BYTES, stream) != hipSuccess) return;
    Params p{};
    for (int i = 0; i < 26; ++i) p.in[i] = (const float*)d_in[i];
    p.out = (float*)d_out; p.ws = (unsigned char*)d_ws;
    if (N_LAUNCH_MODE == 1) { p.ph_lo = 0; p.ph_hi = N_PHASES; hipLaunchKernelGGL(fwd_kernel, dim3(grid), dim3(512), LDS_BYTES, stream, p); }
    else for (int ph = 0; ph < N_PHASES; ++ph) { p.ph_lo = ph; p.ph_hi = ph + 1; hipLaunchKernelGGL(fwd_kernel, dim3(grid), dim3(512), LDS_BYTES, stream, p); }
}
```

```cpp
#ifndef EMU
#include <hip/hip_runtime.h>
#endif
#include <cstdio>
#include <cstdint>

#ifndef CFG_SEQ
#define CFG_SEQ 16384
#endif
#ifndef CFG_DFF
#define CFG_DFF 2816
#endif
#ifndef CFG_DFFE
#define CFG_DFFE 3584
#endif
#ifndef MOE_DOWN_FP8
#define MOE_DOWN_FP8 1
#endif
#ifndef N_LAUNCH_MODE
#define N_LAUNCH_MODE 1
#endif

#ifdef EMU
#define LAS
#define DEV inline
#define WAITV(n) ((void)0)
#define WAITL(n) ((void)0)
#define SBAR() emu_wg_sync()
#define SCHED() ((void)0)
#define SETPRIO(x) ((void)0)
#define MFMA16(a, b, c) emu_mfma16(a, b, c)
#define GLDS16(g, l) emu_glds16((const void*)(g), (void*)(l))
#define GLDS4(g, l) emu_glds4((const void*)(g), (void*)(l))
#define MFMA8(a, b, c) emu_mfma8(a, b, c)
#define RFL(x) emu_rfl(x)
#define MEMFENCE() ((void)0)
#define WSYNC() emu_wave_sync()
#define LDSBAR() emu_wg_sync()
#define LAUNDER_V(x) ((void)0)
#define SLEEP1() emu_yield()
#define MY_XCC_ID() ((unsigned)(blockIdx.x & 7u))
#define FENCE_REL() __atomic_thread_fence(__ATOMIC_SEQ_CST)
#define FENCE_ACQ() __atomic_thread_fence(__ATOMIC_SEQ_CST)
#define FEXP(x) expf(x)
#define RLX_AGENT __ATOMIC_RELAXED, 4
#else
#define LAS __attribute__((address_space(3)))
#define DEV __device__ __forceinline__
#define WAITV(n) asm volatile("s_waitcnt vmcnt(" #n ")" ::: "memory")
#define WAITL(n) asm volatile("s_waitcnt lgkmcnt(" #n ")" ::: "memory")
#define SBAR() __builtin_amdgcn_s_barrier()
#define SCHED() __builtin_amdgcn_sched_barrier(0)
#define SETPRIO(x) __builtin_amdgcn_s_setprio(x)
#define MFMA16(a, b, c) __builtin_amdgcn_mfma_f32_16x16x32_bf16(a, b, c, 0, 0, 0)
#define GLDS16(g, l) __builtin_amdgcn_global_load_lds((const unsigned*)(g), (LAS unsigned*)(l), 16, 0, 0)
#define GLDS4(g, l) __builtin_amdgcn_global_load_lds((const unsigned*)(g), (LAS unsigned*)(l), 4, 0, 0)
#define MFMA8(a, b, c) __builtin_amdgcn_mfma_scale_f32_16x16x128_f8f6f4(a, b, c, 0, 0, 0, 0x7f7f7f7f, 0, 0x7f7f7f7f)
#define RFL(x) __builtin_amdgcn_readfirstlane(x)
#define MEMFENCE() asm volatile("" ::: "memory")
#define LDSBAR() do { asm volatile("s_waitcnt lgkmcnt(0)" ::: "memory"); __builtin_amdgcn_s_barrier(); asm volatile("" ::: "memory"); } while (0)
#define WSYNC() asm volatile("s_waitcnt lgkmcnt(0)" ::: "memory")
#define SLEEP1() __builtin_amdgcn_s_sleep(1)
#define MY_XCC_ID() ((unsigned)__builtin_amdgcn_s_getreg((3 << 11) | 20) & 0xFu)
#define FENCE_REL() __builtin_amdgcn_fence(__ATOMIC_RELEASE, "agent")
#define FENCE_ACQ() __builtin_amdgcn_fence(__ATOMIC_ACQUIRE, "agent")
#define FEXP(x) __expf(x)
#define RLX_AGENT __ATOMIC_RELAXED, __HIP_MEMORY_SCOPE_AGENT
#define LAUNDER_V(x) asm volatile("" : "+v"(x))
#endif

typedef unsigned short bf16_t;
typedef short bf16x8 __attribute__((ext_vector_type(8)));
typedef float f32x4 __attribute__((ext_vector_type(4)));
typedef float f32x2 __attribute__((ext_vector_type(2)));
typedef unsigned u32x4 __attribute__((ext_vector_type(4)));
typedef unsigned u32x2 __attribute__((ext_vector_type(2)));
typedef int i32x8 __attribute__((ext_vector_type(8)));
typedef int i32x4 __attribute__((ext_vector_type(4)));
typedef unsigned char fp8_t;

constexpr int D = 1024, NB = 2, SEQ = CFG_SEQ, CTXL = 256, DEPTH = 4;
constexpr int ML = NB * SEQ, MC = NB * CTXL, MT = ML + MC, NPAN = MT / 256;
constexpr int DFF = CFG_DFF, DFFE = CFG_DFFE, NEXP = 8;
constexpr int DIN = 2048, NH = 32, HD = 64, NG = 4, DS = 128, CONVD = 3072, NPROJ = 5184, NPROJP = 5376, BCD = 512;
constexpr int TV = CTXL + SEQ, NCH = TV / 128;
constexpr int GRIDW = 64;
constexpr float EPS = 1e-6f;
constexpr int NSLOT_TILES = (2 * MT) / 256 + NEXP, NSLOT = NSLOT_TILES * 256;
static_assert(SEQ % 128 == 0 && ML % 256 == 0 && DFF % 128 == 0 && DFFE % 128 == 0 && DFF >= 256 && DFFE >= 256, "shape constraints");

constexpr size_t MiB = 1u << 20;
constexpr size_t al(size_t x) { return (x + 4095) & ~(size_t)4095; }
constexpr size_t OFF_CTL = 0, CTL_BYTES = 1 * MiB;
constexpr size_t OFF_MOD = 1 * MiB;
constexpr size_t OFF_TOK = 2 * MiB;
constexpr size_t OFF_S2T = 3 * MiB;
constexpr size_t OFF_H = 4 * MiB, SZ_H = (size_t)MT * D * 4;
constexpr size_t OFF_W = OFF_H + al(SZ_H);
constexpr size_t W_POOL = 0, SZ_WPOOL = (size_t)4 * 256 * 256 * 2;
constexpr size_t W_UP = al(SZ_WPOOL), SZ_WUP = (size_t)2 * DFF * D * 2;
constexpr size_t W_DN = W_UP + al(SZ_WUP), SZ_WDN = (size_t)D * DFF * 2;
constexpr size_t SZ_WEVEN = W_DN + al(SZ_WDN);
constexpr size_t W_IN = SZ_WEVEN, SZ_WIN = (size_t)NPROJP * D * 2;
constexpr size_t W_OUT = W_IN + al(SZ_WIN), SZ_WOUT = (size_t)D * DIN * 2;
constexpr size_t W_DT = W_OUT + al(SZ_WOUT), SZ_DT = (size_t)NB * 2 * NH * TV * 4;
constexpr size_t W_MUP = W_DT + al(SZ_DT), SZ_WMUP = (size_t)NEXP * 2 * DFFE * D;
constexpr size_t W_MDN = W_MUP + al(SZ_WMUP), SZ_WMDN = (size_t)NEXP * D * DFFE * (MOE_DOWN_FP8 ? 1 : 2);
constexpr size_t W_YB = W_MUP, SZ_Y = (size_t)MT * DIN * 2;
constexpr size_t SZ_WODD_A = W_MDN + al(SZ_WMDN), SZ_WODD_B = W_YB + al(SZ_Y);
constexpr size_t mx(size_t a, size_t b) { return a > b ? a : b; }
constexpr size_t SZ_W = mx(SZ_WEVEN, mx(SZ_WODD_A, SZ_WODD_B));
constexpr size_t OFF_ACT = OFF_W + SZ_W;
constexpr size_t A_P = 0, SZ_ACT1 = (size_t)MT * D * 2;
constexpr size_t A_HID = al(SZ_ACT1), SZ_HID = (size_t)MT * DFF * 2;
constexpr size_t SZ_AEVEN = A_HID + al(SZ_HID);
constexpr size_t A_Z = 0;
constexpr size_t A_XBC = al(SZ_Y), SZ_XBC = (size_t)MT * CONVD * 2;
constexpr size_t A_YF = A_XBC;
constexpr size_t A_CB = A_XBC + al(SZ_Y), SZ_CB = (size_t)NB * NG * NCH * 128 * 128 * 2;
static_assert(al(SZ_Y) + SZ_CB <= SZ_XBC, "CB fits behind Yf inside the XBC region");
constexpr size_t A_XT = A_XBC + al(SZ_XBC), SZ_XT = (size_t)NB * DIN * TV * 2;
constexpr size_t A_U = A_XT, A_YN = A_XT;
constexpr size_t A_BROW = A_XT + al(SZ_XT), SZ_BC = (size_t)MT * BCD * 2;
constexpr size_t A_BT = A_BROW + al(SZ_BC);
constexpr size_t A_CROW = A_BT + al(SZ_BC);
constexpr size_t A_CUM = A_CROW + al(SZ_BC);
constexpr size_t A_WJ = A_CUM + al(SZ_DT);
constexpr size_t A_CF = A_WJ + al(SZ_DT);
constexpr size_t SZ_ASSD = A_CF + al(SZ_DT);
constexpr size_t A_V = 0;
constexpr size_t A_HIDM = al(SZ_ACT1), SZ_HIDM = (size_t)NSLOT * DFFE * 2;
constexpr size_t A_YS = A_HIDM + al(SZ_HIDM), SZ_YS = (size_t)NSLOT * D * 2;
constexpr size_t SZ_AMOE = A_YS + al(SZ_YS);
constexpr size_t SZ_ACT = mx(SZ_AEVEN, mx(SZ_ASSD, SZ_AMOE));
constexpr size_t WS_NEED = OFF_ACT + SZ_ACT;

constexpr int CW_BAR = 4096;
constexpr int CW_CNT = 16384;
constexpr int CW_CUR = 16384 + 2 * 8 * 64;

DEV unsigned f2bf(float f) { unsigned u = __builtin_bit_cast(unsigned, f); return (u + 0x7fffu + ((u >> 16) & 1u)) >> 16; }
#ifndef EMU
typedef __bf16 bf16x2n __attribute__((ext_vector_type(2)));
#endif
DEV unsigned pk2(float lo, float hi) {
#ifdef EMU
    return f2bf(lo) | (f2bf(hi) << 16);
#else
    f32x2 v = {lo, hi}; bf16x2n b = __builtin_convertvector(v, bf16x2n); return __builtin_bit_cast(unsigned, b);
#endif
}
DEV unsigned pk4_fp8(float a, float b, float c, float d) {
#ifdef EMU
    return emu_f2fp8(a) | (emu_f2fp8(b) << 8) | (emu_f2fp8(c) << 16) | (emu_f2fp8(d) << 24);
#else
    unsigned w = 0; w = __builtin_amdgcn_cvt_pk_fp8_f32(a, b, w, false); w = __builtin_amdgcn_cvt_pk_fp8_f32(c, d, w, true); return w;
#endif
}
DEV float bf2f(unsigned b) { return __builtin_bit_cast(float, b << 16); }
DEV float bflo(unsigned w) { return __builtin_bit_cast(float, w << 16); }
DEV float bfhi(unsigned w) { return __builtin_bit_cast(float, w & 0xffff0000u); }
#ifdef EMU
DEV float frcp(float x) { return 1.0f / x; }
#else
DEV float frcp(float x) { return __builtin_amdgcn_rcpf(x); }
#endif
#ifdef EMU
DEV float fexp2(float x) { return exp2f(x); }
#else
DEV float fexp2(float x) { return __builtin_amdgcn_exp2f(x); }
#endif
DEV float siluf(float x) { return x * frcp(1.0f + FEXP(-x)); }
#ifdef EMU
DEV float flog2(float x) { return log2f(x); }
#else
DEV float flog2(float x) { return __builtin_amdgcn_logf(x); }
#endif
DEV float softplusf(float x) { if (x > 20.f) return x; const float e = FEXP(x); return e < 0.0625f ? e * (1.0f - e * (0.5f - e * (0.33333334f - e * (0.25f - e * 0.2f)))) : flog2(1.0f + e) * 0.6931471806f; }
DEV float wave_sum(float v) {
#pragma unroll
    for (int o = 1; o < 64; o <<= 1) v += __shfl_xor(v, o);
    return v;
}
DEV int vec_of(int r) { return r < ML ? (r / SEQ) : 2; }
DEV int frag_off(int r, int c) { return ((r >> 4) * 4 + (c >> 5)) * 512 + ((c >> 3) & 3) * 128 + (r & 15) * 8 + (c & 7); }
DEV int row_of(int b, int tv) { return tv < CTXL ? ML + b * CTXL + tv : b * SEQ + (tv - CTXL); }

#define XB_TMO      128
#define XB_XCNT(j)  (256  + 64 * (j))
#define XB_XSUB(j)  (1280 + 64 * (j))
#define XB_XGEN(j)  (2304 + 64 * (j))
#define XB_TOP      3328
#define XB_TOPGEN   3392
#define XCD_BAR_WORDS 3456
#define XB_SPIN_CAP (1u << 22)
DEV unsigned xb_ld(unsigned* p)              { return __hip_atomic_load(p, RLX_AGENT); }
DEV unsigned xb_add(unsigned* p, unsigned v) { return __hip_atomic_fetch_add(p, v, RLX_AGENT); }
#define XB_SPIN(cond, bar) do { unsigned _sp = 0; while (cond) { SLEEP1(); \
    if ((++_sp & 255u) == 0u) { if (xb_ld(&(bar)[XB_TMO])) break; if (_sp > XB_SPIN_CAP) { atomicAdd(&(bar)[XB_TMO], 1u); break; } } } } while (0)
struct XcdBarrier { unsigned* bar; unsigned x; volatile LAS unsigned* st; };
DEV XcdBarrier xcd_barrier_post(unsigned* bar, volatile LAS unsigned* st) {
    XcdBarrier b; b.bar = bar; b.x = MY_XCC_ID(); b.st = st;
    if (threadIdx.x == 0) (void)xb_add(&bar[XB_XCNT(b.x)], 1u);
    return b;
}
DEV void xcd_barrier_complete(unsigned* bar, unsigned x, unsigned& nloc, unsigned& nx) {
    const unsigned G = gridDim.x;
    unsigned sum, cnt, mine, sp = 0u;
    for (;;) {
        sum = 0u; cnt = 0u; mine = 0u;
#pragma unroll
        for (unsigned j = 0; j < 16; ++j) { const unsigned c = xb_ld(&bar[XB_XCNT(j)]); sum += c; cnt += (c > 0u) ? 1u : 0u; mine = (j == x) ? c : mine; }
        if (sum == G) break;
        SLEEP1();
        if ((++sp & 255u) == 0u) { if (xb_ld(&bar[XB_TMO])) break; if (sp > XB_SPIN_CAP) { atomicAdd(&bar[XB_TMO], 1u); break; } }
    }
    nloc = mine > 0u ? mine : 1u; nx = cnt > 0u ? cnt : 1u;
}
DEV void xcd_barrier(const XcdBarrier& b) {
    WAITV(0);
    __syncthreads();
    if (threadIdx.x == 0) {
        unsigned* bar = b.bar;
#ifndef EMU
        __builtin_amdgcn_s_waitcnt(0);
#endif
        unsigned nloc = b.st[0], nx = b.st[1];
        if (nloc == 0u) { xcd_barrier_complete(bar, b.x, nloc, nx); b.st[0] = nloc; b.st[1] = nx; }
        const unsigned old = xb_add(&bar[XB_XSUB(b.x)], 1u);
        const unsigned gen = old / nloc;
        if (old + 1u == (gen + 1u) * nloc) {
            FENCE_REL();
            WAITV(0);
            const unsigned og = xb_add(&bar[XB_TOP], 1u);
            const unsigned tg = og / nx;
            if (og + 1u == (tg + 1u) * nx) xb_add(&bar[XB_TOPGEN], 1u);
            else XB_SPIN(xb_ld(&bar[XB_TOPGEN]) == tg, bar);
            FENCE_ACQ();
            xb_add(&bar[XB_XGEN(b.x)], 1u);
            WAITV(0);
        } else {
            XB_SPIN(xb_ld(&bar[XB_XGEN(b.x)]) == gen, bar);
            FENCE_ACQ();
            WAITV(0);
        }
    }
    __syncthreads();
}

namespace ge {
constexpr int BM = 256, BK = 64, HALF = 128, HTB = HALF * BK * 2, STAGE_BYTES = 8 * HTB, NXCD = 8, WGM = 8;
DEV int lds_byte(int r, int c) { const int st = (r >> 4) * 2 + (c >> 5), rr = r & 15, cc = c & 31, ob = rr * 64 + cc * 2; return st * 1024 + (ob ^ (((ob >> 9) & 1) << 5)); }
DEV void stage_rc(int b, int& R, int& C) { const int st = b / 1024, sb = b % 1024, swz = sb ^ (((sb >> 9) & 1) << 5); R = (st >> 1) * 16 + swz / 64; C = (st & 1) * 32 + (swz % 64) / 2; }
DEV int perm32(int rho) { const int n = rho >> 4, i = rho & 15; return 8 * (i >> 2) + 4 * n + (i & 3); }
struct Unit { int pm, pn; };
DEV bool static_next(int nM, int nN, int G, int c, int i, Unit& u) {
    const int nwg = nM * nN; const long L = (long)i * G + c; if (L >= nwg) return false;
    int wgid = (int)L; { const int q = nwg / NXCD, r = nwg % NXCD, xcd = wgid % NXCD, off = wgid / NXCD; wgid = (xcd < r ? xcd * (q + 1) : r * (q + 1) + (xcd - r) * q) + off; }
    const int nig = WGM * nN, gid = wgid / nig, fm = gid * WGM, gsz = (nM - fm) < WGM ? (nM - fm) : WGM;
    u.pm = fm + ((wgid % nig) % gsz); u.pn = (wgid % nig) / gsz; return true;
}
template <class P, bool SP2 = true>
DEV void gemm_phase(LAS unsigned char* lds, const P& S, const int tid) {
    const int wid = RFL(tid >> 6), lane = tid & 63, wr = wid >> 2, wc = wid & 3, fr = lane & 15, fq = lane >> 4;
    const int K = S.K, nt = K * P::ES / (BK * 2);
    unsigned voffB[2]; int RA[2], CA2[2];
#pragma unroll
    for (int i = 0; i < 2; ++i) { int R, C; stage_rc(tid * 16 + i * 8192, R, C); const int Rb = P::PERM ? ((R & ~31) + perm32(R & 31)) : R;
        RA[i] = R; CA2[i] = C * 2; voffB[i] = (unsigned)(Rb * S.ldb) * (unsigned)P::ES + (unsigned)(C * 2); }
    const size_t kstep = (size_t)(BK * 2);
    const size_t hstepB = (size_t)HALF * S.ldb * P::ES;
    const unsigned ldsw = (unsigned)wid * 1024u;
    const int aoff = lds_byte(wr * 64 + fr, fq * 8), boff = lds_byte(wc * 32 + fr, fq * 8);
#define GE_SA(b, h) (((b) * 2 + (h)) * HTB)
#define GE_SB(b, h) ((4 + (b) * 2 + (h)) * HTB)
#define GE_STAGEB(bufoff, gbase) do { _Pragma("unroll") for (int _i = 0; _i < 2; ++_i) { unsigned _o = voffB[_i]; LAUNDER_V(_o); \
        GLDS16((const char*)(gbase) + _o, lds + (bufoff) + ldsw + _i * 8192); } } while (0)
#define GE_STAGEA(bufoff, gbase, h) do { _Pragma("unroll") for (int _i = 0; _i < 2; ++_i) { unsigned _o = oA[h][_i]; LAUNDER_V(_o); \
        GLDS16((const char*)(gbase) + _o, lds + (bufoff) + ldsw + _i * 8192); } } while (0)
#define GE_LD1(p_) __builtin_shufflevector(*(const LAS i32x4*)(p_), *(const LAS i32x4*)((p_) + 1024), 0, 1, 2, 3, 4, 5, 6, 7)
#define GE_LDA(dst, b, h) do { _Pragma("unroll") for (int m = 0; m < 4; ++m) dst[m] = GE_LD1(lds + GE_SA(b, h) + aoff + m * 2048); } while (0)
#define GE_LDB(dst, b, h) do { _Pragma("unroll") for (int n = 0; n < 2; ++n) dst[n] = GE_LD1(lds + GE_SB(b, h) + boff + n * 2048); } while (0)
#define GE_LO(x) __builtin_bit_cast(bf16x8, __builtin_shufflevector(x, x, 0, 1, 2, 3))
#define GE_HI(x) __builtin_bit_cast(bf16x8, __builtin_shufflevector(x, x, 4, 5, 6, 7))
#define GE_MMA(ai, bj, At, Bt) do { SETPRIO(1); _Pragma("unroll") for (int m = 0; m < 4; ++m) _Pragma("unroll") for (int n = 0; n < 2; ++n) { \
        if constexpr (P::FP8) acc[ai][bj][m][n] = MFMA8(Bt[n], At[m], acc[ai][bj][m][n]);     \
        else { acc[ai][bj][m][n] = MFMA16(GE_LO(Bt[n]), GE_LO(At[m]), acc[ai][bj][m][n]); acc[ai][bj][m][n] = MFMA16(GE_HI(Bt[n]), GE_HI(At[m]), acc[ai][bj][m][n]); } } SETPRIO(0); } while (0)
    Unit cur, nxt; int ui = 0;
    if (!S.next(0, cur)) return;
    f32x4 acc[2][2][4][2];
#pragma unroll
    for (int a = 0; a < 2; ++a)
#pragma unroll
        for (int b = 0; b < 2; ++b)
#pragma unroll
            for (int m = 0; m < 4; ++m)
#pragma unroll
                for (int n = 0; n < 2; ++n) acc[a][b][m][n] = (f32x4){0.f, 0.f, 0.f, 0.f};
    unsigned oA[2][2];
#pragma unroll
    for (int h = 0; h < 2; ++h)
#pragma unroll
        for (int i = 0; i < 2; ++i) {
            if constexpr (P::GATHER) oA[h][i] = (unsigned)S.gather_row(cur, h * HALF + RA[i]) * (unsigned)(S.lda * P::ES) + (unsigned)CA2[i];
            else oA[h][i] = (unsigned)((h * HALF + RA[i]) * S.lda) * (unsigned)P::ES + (unsigned)CA2[i];
            }
    const char* cA = S.a_base(cur); const char* cB = S.b_base(cur);
    if constexpr (SP2) {
        GE_STAGEB(GE_SB(0, 0), cB); GE_STAGEB(GE_SB(0, 1), cB + hstepB); GE_STAGEA(GE_SA(0, 0), cA, 0); GE_STAGEA(GE_SA(0, 1), cA, 1);
        if (wr == 1) SBAR();
        WAITV(2); SBAR();
        GE_STAGEB(GE_SB(1, 0), cB + kstep); GE_STAGEA(GE_SA(1, 0), cA + kstep, 0); GE_STAGEB(GE_SB(1, 1), cB + hstepB + kstep);
        WAITV(6); SBAR();
    } else {
    GE_STAGEB(GE_SB(0, 0), cB); GE_STAGEA(GE_SA(0, 0), cA, 0); GE_STAGEB(GE_SB(0, 1), cB + hstepB); GE_STAGEA(GE_SA(0, 1), cA, 1);
    if (wr == 1) SBAR();
    WAITV(4); SBAR();
    GE_STAGEB(GE_SB(1, 0), cB + kstep); GE_STAGEA(GE_SA(1, 0), cA + kstep, 0); GE_STAGEB(GE_SB(1, 1), cB + hstepB + kstep);
    WAITV(6); SBAR();
    }
    for (;;) {
        const bool has_next = S.next(ui + 1, nxt);
        const char* nA = has_next ? S.a_base(nxt) : cA; const char* nB = has_next ? S.b_base(nxt) : cB;
        for (int t = 0; t < nt; t += 2) {
            const bool last = (t == nt - 2);
            const char* a1 = cA + (size_t)(t + 1) * kstep;
            const char* a2 = last ? nA : cA + (size_t)(t + 2) * kstep; const char* b2 = last ? nB : cB + (size_t)(t + 2) * kstep;
            const char* a3 = a2 + kstep; const char* b3 = b2 + kstep;
            i32x8 At[4], B0[2], B1[2];
            if constexpr (SP2) {
            GE_LDB(B0, 0, 0); GE_LDB(B1, 0, 1); SCHED(); GE_LDA(At, 0, 0); GE_STAGEA(GE_SA(1, 1), a1, 1);
            WAITV(8); WAITL(0); SBAR(); GE_MMA(0, 0, At, B0); GE_MMA(0, 1, At, B1); SBAR(); SCHED();
            if constexpr (P::GATHER) { if (last && has_next) {
#pragma unroll
                for (int i = 0; i < 2; ++i) { int R2, C2; stage_rc(tid * 16 + i * 8192, R2, C2);
#pragma unroll
                    for (int h = 0; h < 2; ++h) oA[h][i] = (unsigned)S.gather_row(nxt, h * HALF + R2) * (unsigned)(S.lda * P::ES) + (unsigned)(C2 * 2); } } }
            GE_LDA(At, 0, 1); GE_STAGEB(GE_SB(0, 0), b2); GE_STAGEB(GE_SB(0, 1), b2 + hstepB); GE_STAGEA(GE_SA(0, 0), a2, 0);
            WAITV(8); WAITL(0); SBAR(); GE_MMA(1, 0, At, B0); GE_MMA(1, 1, At, B1); SBAR(); SCHED();
            GE_LDB(B0, 1, 0); GE_LDB(B1, 1, 1); SCHED(); GE_LDA(At, 1, 0); GE_STAGEA(GE_SA(0, 1), a2, 1);
            WAITV(8); WAITL(0); SBAR(); GE_MMA(0, 0, At, B0); GE_MMA(0, 1, At, B1); SBAR(); SCHED();
            GE_LDA(At, 1, 1); GE_STAGEB(GE_SB(1, 0), b3); GE_STAGEB(GE_SB(1, 1), b3 + hstepB); GE_STAGEA(GE_SA(1, 0), a3, 0);
            WAITV(8); WAITL(0); SBAR(); GE_MMA(1, 0, At, B0); GE_MMA(1, 1, At, B1); SBAR(); SCHED();
            } else {
            GE_LDB(B0, 0, 0); SCHED(); GE_LDA(At, 0, 0); GE_STAGEA(GE_SA(1, 1), a1, 1);
            WAITL(8); SBAR(); WAITL(0); GE_MMA(0, 0, At, B0); SBAR(); SCHED();
            if constexpr (P::GATHER) { if (last && has_next) {
#pragma unroll
                for (int i = 0; i < 2; ++i) { int R2, C2; stage_rc(tid * 16 + i * 8192, R2, C2);
#pragma unroll
                    for (int h = 0; h < 2; ++h) oA[h][i] = (unsigned)S.gather_row(nxt, h * HALF + R2) * (unsigned)(S.lda * P::ES) + (unsigned)(C2 * 2); } } }
            GE_LDB(B1, 0, 1); GE_STAGEB(GE_SB(0, 0), b2);
            SBAR(); WAITL(0); GE_MMA(0, 1, At, B1); SBAR();
            GE_LDA(At, 0, 1); GE_STAGEA(GE_SA(0, 0), a2, 0);
            SBAR(); WAITL(0); GE_MMA(1, 0, At, B0); SBAR(); SCHED();
            GE_STAGEB(GE_SB(0, 1), b2 + hstepB);
            WAITV(6); SBAR(); GE_MMA(1, 1, At, B1); SBAR();
            GE_LDB(B0, 1, 0); SCHED(); GE_LDA(At, 1, 0); GE_STAGEA(GE_SA(0, 1), a2, 1);
            WAITL(8); SBAR(); WAITL(0); GE_MMA(0, 0, At, B0); SBAR(); SCHED();
            GE_LDB(B1, 1, 1); GE_STAGEB(GE_SB(1, 0), b3);
            SBAR(); WAITL(0); GE_MMA(0, 1, At, B1); SBAR();
            GE_LDA(At, 1, 1); GE_STAGEA(GE_SA(1, 0), a3, 0);
            SBAR(); WAITL(0); GE_MMA(1, 0, At, B0); SBAR(); SCHED();
            GE_STAGEB(GE_SB(1, 1), b3 + hstepB);
            WAITV(6); SBAR(); GE_MMA(1, 1, At, B1); SBAR();
            }
        }
        if (wr == 0) SBAR();
        S.epi(acc, cur, wr, wc, fr, fq);
        if (!has_next) break;
#pragma unroll
        for (int a = 0; a < 2; ++a)
#pragma unroll
            for (int b = 0; b < 2; ++b)
#pragma unroll
                for (int m = 0; m < 4; ++m)
#pragma unroll
                    for (int n = 0; n < 2; ++n) acc[a][b][m][n] = (f32x4){0.f, 0.f, 0.f, 0.f};
        cur = nxt; cA = nA; cB = nB; ++ui;
        if (wr == 1) SBAR();
    }
    WAITV(0);
    SBAR();
#undef GE_SA
#undef GE_SB
#undef GE_STAGEA
#undef GE_STAGEB
#undef GE_LDA
#undef GE_LDB
#undef GE_MMA
#undef GE_LO
#undef GE_HI
#undef GE_LD1
}
}
using ge::Unit;

struct Params {
    const float* in[26];
    float* out; unsigned char* ws;
    int ph_lo, ph_hi;
};
enum { I_X = 0, I_C, I_CTX, I_CCTX, I_ADAW, I_ADAB, I_NMIX, I_NFFN, I_POOLW, I_POOLS, I_INW, I_CONVW, I_CONVB, I_ALOG, I_DTB, I_DSKIP, I_SNORM, I_OUTW,
       I_W1, I_W3, I_W2, I_RW, I_MW1, I_MW3, I_MW2, I_FNORM };

struct Frame {
    LAS unsigned char* lds;
    int tid, lane, wave, G, bx;
    const Params* p;
    unsigned char* ws;
    unsigned* ctl;
    float* H; float* mod;
};
#ifdef EMU
DEV const float* INP(const Frame& F, int i) { return F.p->in[i]; }
DEV float* OUTP(const Frame& F) { return F.p->out; }
DEV unsigned char* WSP(const Frame& F) { return F.p->ws; }
#define LAUNDER_S(x) ((void)0)
#else
typedef const float* cfptr_t;
DEV const float* INP(const Frame&, int i) { int k = i; asm volatile("" : "+s"(k)); return ((const __attribute__((address_space(4))) cfptr_t*)__builtin_amdgcn_kernarg_segment_ptr())[k]; }
DEV float* OUTP(const Frame& F) { return (float*)INP(F, 26); }
DEV unsigned char* WSP(const Frame& F) { return (unsigned char*)INP(F, 27); }
#define LAUNDER_S(x) asm volatile("" : "+s"(x))
#endif
constexpr int LDS_MISC = ge::STAGE_BYTES;
constexpr int LDS_BYTES = ge::STAGE_BYTES + 16384;

struct Src { const float* x; const float* ctx; float* H; const float* mod; };
DEV const float* modq(const float* mod, int layer, int vec, int which) { return mod + ((size_t)(layer * 3 + vec) * 6 + which) * D; }
DEV const float* modp(const Frame& F, int layer, int vec, int which) { return modq(F.mod, layer, vec, which); }
DEV const float* hsrc_row(const Src& s, bool from_input, int r) {
    if (from_input) return r < ML ? s.x + (size_t)r * D : s.ctx + (size_t)(r - ML) * D;
    return s.H + (size_t)r * D;
}
DEV Src mksrc(const Frame& F) { Src s; s.x = INP(F, I_X); s.ctx = INP(F, I_CTX); s.H = F.H; s.mod = F.mod; return s; }
DEV const float* hin_row(const Frame& F, int layer, int r) { return hsrc_row(mksrc(F), layer == 0, r); }

struct RmId { DEV int operator()(int n0) const { return n0; } };
struct RmIlv { int s; DEV int operator()(int n0) const { return (n0 >> 7) * 256 + s * 128 + (n0 & 127); } };
template <int K, int N, bool F8, class RM>
DEV void convert_job_t(const Frame& F, const float* Wsrc, void* WTv, int ldt, RM rowmap, float scale) {
    LAS float* scr = (LAS float*)(F.lds + F.wave * 16384);
    constexpr int items = (K / 64) * (N / 32), nblk = N / 32; const int gw = F.bx * 8 + F.wave, NGW = F.G * 8, lane = F.lane;
    float nx[32];
#define CJ_LOAD(it_) do { const int _kb = (it_) / nblk, _nb = (it_) % nblk; const float* _p = Wsrc + (size_t)(64 * _kb + (lane >> 5)) * N + 32 * _nb + (lane & 31); \
        _Pragma("unroll") for (int i = 0; i < 32; ++i) nx[i] = _p[(size_t)(2 * i) * N]; } while (0)
    if (gw < items) CJ_LOAD(gw);
    for (int it = gw; it < items; it += NGW) {
        const int kb = it / nblk, nb = it % nblk, k0 = 64 * kb, n0 = 32 * nb;
#pragma unroll
        for (int i = 0; i < 32; ++i) { const int kk = 2 * i + (lane >> 5); scr[kk * 33 + (lane & 31)] = F8 ? nx[i] * scale : nx[i]; }
        if (it + NGW < items) CJ_LOAD(it + NGW);
        WSYNC();
        const int c = lane & 7; const int row0 = rowmap(n0);
#pragma unroll
        for (int j = 0; j < 4; ++j) { const int n = (lane >> 3) + 8 * j; const LAS float* sp = scr + (8 * c) * 33 + n;
            if (F8) { u32x2 o; o.x = pk4_fp8(sp[0 * 33], sp[1 * 33], sp[2 * 33], sp[3 * 33]); o.y = pk4_fp8(sp[4 * 33], sp[5 * 33], sp[6 * 33], sp[7 * 33]);
                *(u32x2*)((fp8_t*)WTv + (size_t)(row0 + n) * ldt + k0 + 8 * c) = o; }
            else { u32x4 o; o.x = pk2(sp[0 * 33], sp[1 * 33]); o.y = pk2(sp[2 * 33], sp[3 * 33]); o.z = pk2(sp[4 * 33], sp[5 * 33]); o.w = pk2(sp[6 * 33], sp[7 * 33]);
                *(u32x4*)((bf16_t*)WTv + (size_t)(row0 + n) * ldt + k0 + 8 * c) = o; } }
        WSYNC();
    }
#undef CJ_LOAD
}
template <int K, int N, class RM> DEV void convert_job(const Frame& F, const float* Wsrc, bf16_t* WT, int ldt, RM rm) { convert_job_t<K, N, false>(F, Wsrc, WT, ldt, rm, 1.0f); }
template <int K, int N, class RM> DEV void convert_job_fp8(const Frame& F, const float* Wsrc, fp8_t* WT, int ldt, RM rm, float scale) { convert_job_t<K, N, true>(F, Wsrc, WT, ldt, rm, scale); }
DEV bool idle_subgrid(Frame& F2, int nwg) { const int rem = nwg % F2.G; if (rem == 0) return true; if (F2.bx < rem) return false; F2.bx -= rem; F2.G -= rem; return true; }
DEV void convert_even(const Frame& F, int j) {
    bf16_t* Wb = (bf16_t*)(F.ws + OFF_W);
    for (int g = 0; g < 4; ++g) convert_job<256, 256>(F, INP(F, I_POOLW) + ((size_t)j * 4 + g) * 65536, Wb + W_POOL / 2 + (size_t)g * 65536, 256, RmId{});
    convert_job<D, DFF>(F, INP(F, I_W1) + (size_t)j * D * DFF, Wb + W_UP / 2, D, RmIlv{0});
    convert_job<D, DFF>(F, INP(F, I_W3) + (size_t)j * D * DFF, Wb + W_UP / 2, D, RmIlv{1});
    convert_job<DFF, D>(F, INP(F, I_W2) + (size_t)j * DFF * D, Wb + W_DN / 2, DFF, RmId{});
}
DEV void convert_ssd(const Frame& F, int j) {
    bf16_t* Wb = (bf16_t*)(F.ws + OFF_W);
    convert_job<D, NPROJ>(F, INP(F, I_INW) + (size_t)j * D * NPROJ, Wb + W_IN / 2, D, RmId{});
    convert_job<DIN, D>(F, INP(F, I_OUTW) + (size_t)j * DIN * D, Wb + W_OUT / 2, DIN, RmId{});
    { u32x4* z = (u32x4*)(Wb + W_IN / 2 + (size_t)NPROJ * D); const int n16 = (NPROJP - NPROJ) * D * 2 / 16;
      unsigned zz = 0u; LAUNDER_V(zz);
      for (int i = F.bx * 512 + F.tid; i < n16; i += F.G * 512) z[i] = (u32x4){zz, zz, zz, zz}; }
}
DEV void convert_moe(const Frame& F, int j, bool up, bool down) {
    fp8_t* Wb = (fp8_t*)(F.ws + OFF_W);
    for (int e = 0; e < NEXP; ++e) {
        if (up) {
        convert_job_fp8<D, DFFE>(F, INP(F, I_MW1) + ((size_t)j * NEXP + e) * D * DFFE, Wb + W_MUP + (size_t)e * 2 * DFFE * D, D, RmIlv{0}, 32.0f);
        convert_job_fp8<D, DFFE>(F, INP(F, I_MW3) + ((size_t)j * NEXP + e) * D * DFFE, Wb + W_MUP + (size_t)e * 2 * DFFE * D, D, RmIlv{1}, 32.0f); }
        if (!down) continue;
        if (MOE_DOWN_FP8) convert_job_fp8<DFFE, D>(F, INP(F, I_MW2) + ((size_t)j * NEXP + e) * DFFE * D, Wb + W_MDN + (size_t)e * D * DFFE, DFFE, RmId{}, 64.0f);
        else convert_job<DFFE, D>(F, INP(F, I_MW2) + ((size_t)j * NEXP + e) * DFFE * D, (bf16_t*)(Wb + W_MDN) + (size_t)e * D * DFFE, DFFE, RmId{});
    }
}

DEV void phase_mod(const Frame& F) {
    LAS float* red = (LAS float*)F.lds;
    LAS float* sc = (LAS float*)(F.lds + 8192);
    constexpr int nblk = DEPTH * 6144 / 32;
    const int col = F.tid & 31, ks = F.tid >> 5;
    for (int i = F.tid; i < 3 * D; i += 512) { const int v = i >> 10, k = i & (D - 1); sc[i] = siluf(v == 2 ? INP(F, I_CCTX)[k] : INP(F, I_C)[v * D + k]); }
    __syncthreads();
    for (int blk = F.bx; blk < nblk; blk += F.G) {
        const int layer = (blk * 32) / 6144, n = (blk * 32) % 6144 + col;
        const float* W = INP(F, I_ADAW) + (size_t)layer * D * 6144 + n;
        float a0 = 0.f, a1 = 0.f, a2 = 0.f;
#pragma unroll 1
        for (int kb = ks * 64; kb < ks * 64 + 64; kb += 16) {
            float wv[16];
#pragma unroll
            for (int k = 0; k < 16; ++k) wv[k] = W[(size_t)(kb + k) * 6144];
#pragma unroll
            for (int k = 0; k < 16; ++k) { a0 += sc[kb + k] * wv[k]; a1 += sc[D + kb + k] * wv[k]; a2 += sc[2 * D + kb + k] * wv[k]; } }
        red[(ks * 32 + col) * 3 + 0] = a0; red[(ks * 32 + col) * 3 + 1] = a1; red[(ks * 32 + col) * 3 + 2] = a2;
        __syncthreads();
        if (F.tid < 96) { const int c2 = F.tid & 31, v = F.tid >> 5; float s = 0.f;
            for (int q = 0; q < 16; ++q) s += red[(q * 32 + c2) * 3 + v];
            const int n2 = (blk * 32) % 6144 + c2;
            F.mod[(size_t)(layer * 3 + v) * 6144 + n2] = s + INP(F, I_ADAB)[(size_t)layer * 6144 + n2]; }
        __syncthreads();
    }
}

DEV void load_row(const float* p, int lane, f32x4 (&v)[4]) {
#pragma unroll
    for (int j = 0; j < 4; ++j) v[j] = *(const f32x4*)(p + 4 * lane + 256 * j);
}
DEV float sumsq_row(const f32x4 (&v)[4]) { float s = 0.f;
#pragma unroll
    for (int j = 0; j < 4; ++j) s += (v[j][0] * v[j][0] + v[j][1] * v[j][1]) + (v[j][2] * v[j][2] + v[j][3] * v[j][3]);
    return wave_sum(s); }
DEV void normmod_row(f32x4 (&v)[4], float rstd, const float* w, const float* sh, const float* sc, int lane) {
#pragma unroll
    for (int j = 0; j < 4; ++j) { const int c = 4 * lane + 256 * j; const f32x4 wv = *(const f32x4*)(w + c), sv = *(const f32x4*)(sh + c), cv = *(const f32x4*)(sc + c);
        v[j] = v[j] * rstd * wv * (cv + 1.0f) + sv; }
}
DEV void store_row_bf16(bf16_t* o, int lane, const f32x4 (&v)[4]) {
#pragma unroll
    for (int j = 0; j < 4; ++j) { u32x2 w; w.x = pk2(v[j][0], v[j][1]); w.y = pk2(v[j][2], v[j][3]); *(u32x2*)(o + 4 * lane + 256 * j) = w; }
}

DEV void phase_norm(const Frame& F, int layer, int which, bf16_t* out, bool from_input) {
    const int gw = F.bx * 8 + F.wave, NGW = F.G * 8;
    const float* w = INP(F, which == 0 ? I_NMIX : I_NFFN) + (size_t)layer * D;
    f32x4 nx[4];
    if (gw < MT) load_row(hsrc_row(mksrc(F), from_input, gw), F.lane, nx);
    for (int r = gw; r < MT; r += NGW) {
        f32x4 v[4];
#pragma unroll
        for (int q = 0; q < 4; ++q) v[q] = nx[q];
        if (r + NGW < MT) load_row(hsrc_row(mksrc(F), from_input, r + NGW), F.lane, nx);
        const float rstd = rsqrtf(sumsq_row(v) * (1.0f / D) + EPS);
        const int vec = vec_of(r);
        normmod_row(v, rstd, w, modp(F, layer, vec, which), modp(F, layer, vec, which + 1), F.lane);
        store_row_bf16(out + (size_t)r * D, F.lane, v);
    }
}

struct TokInfo { int s0, s1; float g0, g1; };
DEV void phase_poolprep(const Frame& F, int layer, bf16_t* P, bool fuse, const bf16_t* YS) {
    const TokInfo* tok = (const TokInfo*)(F.ws + OFF_TOK);
    LAS bf16_t* ub = (LAS bf16_t*)(F.lds);
    LAS float* rs = (LAS float*)(F.lds + 81920);
    const float* w = INP(F, I_NMIX) + (size_t)layer * D;
    const int ntile = MT / 64;
    const int chunk = F.tid & 127, tg = F.tid >> 7;
    for (int tile = F.bx; tile < ntile; tile += F.G) {
        const int r0 = tile * 64;
        if (r0 < ML) {
            LAS bf16_t* ul = (LAS bf16_t*)(F.lds);
            const int vec = vec_of(r0);
            { f32x4 wc[4], sv[4], g2[4];
#pragma unroll
              for (int jq = 0; jq < 4; ++jq) { const int c = 4 * F.lane + 256 * jq; wc[jq] = *(const f32x4*)(w + c) * (*(const f32x4*)(modp(F, layer, vec, 1) + c) + 1.0f); sv[jq] = *(const f32x4*)(modp(F, layer, vec, 0) + c);
                  g2[jq] = fuse ? *(const f32x4*)(modp(F, layer - 1, vec, 5) + c) * (MOE_DOWN_FP8 ? 0.00390625f : 1.0f) : (f32x4){0.f, 0.f, 0.f, 0.f}; }
              f32x4 nh[4]; u32x2 nya[4], nyb[4]; TokInfo tn; tn.s0 = tn.s1 = 0; tn.g0 = tn.g1 = 0.f;
              { const int r = r0 + F.wave; load_row(hin_row(F, layer, r), F.lane, nh);
                if (fuse) { tn = tok[r];
#pragma unroll
                    for (int jq = 0; jq < 4; ++jq) { const int c = 4 * F.lane + 256 * jq; nya[jq] = *(const u32x2*)(YS + (size_t)tn.s0 * D + c); nyb[jq] = *(const u32x2*)(YS + (size_t)tn.s1 * D + c); } } }
#pragma unroll 1
              for (int k = 0; k < 8; ++k) { const int rl = F.wave + 8 * k, r = r0 + rl;
                  f32x4 v[4]; u32x2 ya[4], yb[4]; const TokInfo ti = tn;
#pragma unroll
                  for (int q = 0; q < 4; ++q) { v[q] = nh[q]; ya[q] = nya[q]; yb[q] = nyb[q]; }
                  if (k < 7) { load_row(hin_row(F, layer, r + 8), F.lane, nh);
                      if (fuse) { tn = tok[r + 8];
#pragma unroll
                          for (int jq = 0; jq < 4; ++jq) { const int c = 4 * F.lane + 256 * jq; nya[jq] = *(const u32x2*)(YS + (size_t)tn.s0 * D + c); nyb[jq] = *(const u32x2*)(YS + (size_t)tn.s1 * D + c); } } }
                  if (fuse) {
#pragma unroll
                      for (int jq = 0; jq < 4; ++jq) { const u32x2 a = ya[jq], b = yb[jq];
                          v[jq][0] += g2[jq][0] * (ti.g0 * bflo(a.x) + ti.g1 * bflo(b.x)); v[jq][1] += g2[jq][1] * (ti.g0 * bfhi(a.x) + ti.g1 * bfhi(b.x));
                          v[jq][2] += g2[jq][2] * (ti.g0 * bflo(a.y) + ti.g1 * bflo(b.y)); v[jq][3] += g2[jq][3] * (ti.g0 * bfhi(a.y) + ti.g1 * bfhi(b.y));
                          *(f32x4*)(F.H + (size_t)r * D + 4 * F.lane + 256 * jq) = v[jq]; } }
                  const float rstd = rsqrtf(sumsq_row(v) * (1.0f / D) + EPS);
#pragma unroll
                  for (int jq = 0; jq < 4; ++jq) { const f32x4 u = v[jq] * rstd * wc[jq] + sv[jq]; u32x2 pw; pw.x = pk2(u[0], u[1]); pw.y = pk2(u[2], u[3]);
                      *(LAS u32x2*)(ul + rl * 1024 + 4 * F.lane + 256 * jq) = pw; } } }
            __syncthreads();
            { const int cq = F.tid & 255, hf = F.tid >> 8, c = cq * 4, g = c >> 8, win = 2 << g, lo = win >> 1, hi = win - 1 - lo;
#define PL_U(t_) ({ const u32x2 _q = *(const LAS u32x2*)(ul + (t_) * 1024 + c); (f32x4){bflo(_q.x), bfhi(_q.x), bflo(_q.y), bfhi(_q.y)}; })
              const int ta = 32 * hf;
              f32x4 sacc = (f32x4){0.f, 0.f, 0.f, 0.f};
              { const int a = (ta - lo > 0) ? ta - lo : 0, b = (ta + hi + 1 < 64) ? ta + hi + 1 : 64; for (int t = a; t < b; ++t) sacc += PL_U(t); }
              for (int t = ta; t < ta + 32; ++t) {
                  const int a = (t - lo > 0) ? t - lo : 0, b = (t + hi + 1 < 64) ? t + hi + 1 : 64;
                  const float inv = 1.0f / (float)(b - a);
                  const f32x4 o = sacc * inv - PL_U(t);
                  u32x2 pw; pw.x = pk2(o[0], o[1]); pw.y = pk2(o[2], o[3]); *(u32x2*)(P + (size_t)(r0 + t) * D + c) = pw;
                  if (t + 1 < ta + 32) { if (t + 1 + hi < 64) sacc += PL_U(t + 1 + hi); if (t - lo >= 0) sacc -= PL_U(t - lo); } }
#undef PL_U
            }
            __syncthreads();
            continue;
        }
        int seq0, seq1;
        if (r0 < ML) { seq0 = r0; seq1 = r0 + 64; } else { seq0 = ML + ((r0 - ML) / CTXL) * CTXL; seq1 = seq0 + CTXL; }
        const int lo_r = (r0 - 8 > seq0) ? r0 - 8 : seq0, hi_r = (r0 + 64 + 7 < seq1) ? r0 + 64 + 7 : seq1;
        const int nrow = hi_r - lo_r;
        for (int rb = lo_r + F.wave; rb < hi_r; rb += 16) {
            f32x4 v5[2][4];
#pragma unroll
            for (int k = 0; k < 2; ++k) { const int r = rb + 8 * k; if (r < hi_r) load_row(hin_row(F, layer, r), F.lane, v5[k]); }
#pragma unroll
            for (int k = 0; k < 2; ++k) { const int r = rb + 8 * k; if (r < hi_r) { const float ss = sumsq_row(v5[k]); if (F.lane == 0) rs[r - lo_r] = rsqrtf(ss * (1.0f / D) + EPS); } } }
        __syncthreads();
        const int vec = vec_of(r0);
#pragma unroll 1
        for (int half = 0; half < 2; ++half) {
            const int c = half * 512 + 4 * chunk, g = c >> 8, win = 2 << g, lo = win >> 1, hi = win - 1 - lo;
            const f32x4 wv = *(const f32x4*)(w + c), sv = *(const f32x4*)(modp(F, layer, vec, 0) + c), cv = *(const f32x4*)(modp(F, layer, vec, 1) + c) + 1.0f;
            const f32x4 wc = wv * cv;
#pragma unroll 1
            for (int kb = 0; kb < 20; kb += 5) {
                f32x4 hv[5];
#pragma unroll
                for (int k = 0; k < 5; ++k) { const int rr = tg + 4 * (kb + k); if (rr < nrow) hv[k] = *(const f32x4*)(hin_row(F, layer, lo_r + rr) + c); }
#pragma unroll
                for (int k = 0; k < 5; ++k) { const int rr = tg + 4 * (kb + k); if (rr < nrow) { const f32x4 u = hv[k] * rs[rr] * wc + sv;
                    u32x2 pw; pw.x = pk2(u[0], u[1]); pw.y = pk2(u[2], u[3]); *(LAS u32x2*)(ub + rr * 512 + 4 * chunk) = pw; } } }
            __syncthreads();
#define PP_U(r_) ({ const u32x2 _q = *(const LAS u32x2*)(ub + ((r_) - lo_r) * 512 + 4 * chunk); (f32x4){bflo(_q.x), bfhi(_q.x), bflo(_q.y), bfhi(_q.y)}; })
            const int ta = r0 + 16 * tg;
            f32x4 s = (f32x4){0.f, 0.f, 0.f, 0.f};
            { const int a = (ta - lo > seq0) ? ta - lo : seq0, b = (ta + hi + 1 < seq1) ? ta + hi + 1 : seq1; for (int r = a; r < b; ++r) s += PP_U(r); }
            for (int t = ta; t < ta + 16; ++t) {
                const int a = (t - lo > seq0) ? t - lo : seq0, b = (t + hi + 1 < seq1) ? t + hi + 1 : seq1;
                const float inv = 1.0f / (float)(b - a);
                const f32x4 o = s * inv - PP_U(t);
                u32x2 pw; pw.x = pk2(o[0], o[1]); pw.y = pk2(o[2], o[3]); *(u32x2*)(P + (size_t)t * D + c) = pw;
                if (t + 1 < ta + 16) {
                    if (t + 1 + hi < seq1) s += PP_U(t + 1 + hi);
                    if (t - lo >= seq0) s -= PP_U(t - lo); }
            }
#undef PP_U
            __syncthreads();
        }
    }
}

struct PolBase { int G, c; };
struct PolPool : PolBase {
    static constexpr bool PERM = false, GATHER = false; static constexpr bool FP8 = false; static constexpr int ES = 2; int K, lda, ldb;
    const bf16_t* P; const bf16_t* W; Src src; int layer; const float* scale;
    DEV bool next(int i, Unit& u) const { return ge::static_next(NPAN, 4, G, c, i, u); }
    DEV const char* a_base(const Unit& u) const { return (const char*)(P + (size_t)u.pm * 256 * D + u.pn * 256); }
    DEV const char* b_base(const Unit& u) const { return (const char*)(W + (size_t)u.pn * 65536); }
    DEV void epi(const f32x4 (&acc)[2][2][4][2], const Unit& u, int wr, int wc, int fr, int fq) const {
        const int row0 = u.pm * 256 + wr * 64 + fr, col0 = u.pn * 256 + wc * 32 + 4 * fq; const int vec = vec_of(u.pm * 256);
        const float* g1 = modq(src.mod, layer, vec, 2);
        f32x4 gv[2][2];
#pragma unroll
        for (int bj = 0; bj < 2; ++bj)
#pragma unroll
            for (int n = 0; n < 2; ++n) { const int cc = col0 + bj * 128 + n * 16; gv[bj][n] = *(const f32x4*)(g1 + cc) * *(const f32x4*)(scale + cc); }
#pragma unroll
        for (int ai = 0; ai < 2; ++ai)
#pragma unroll
            for (int m = 0; m < 4; ++m) { const int r = row0 + ai * 128 + m * 16; const float* hi = hsrc_row(src, layer == 0, r) + col0; float* ho = src.H + (size_t)r * D + col0;
#pragma unroll
                for (int bj = 0; bj < 2; ++bj)
#pragma unroll
                    for (int n = 0; n < 2; ++n) *(f32x4*)(ho + bj * 128 + n * 16) = *(const f32x4*)(hi + bj * 128 + n * 16) + gv[bj][n] * acc[ai][bj][m][n]; }
    }
};
struct PolResid : PolBase {
    static constexpr bool PERM = false, GATHER = false; static constexpr bool FP8 = false; static constexpr int ES = 2; int K, lda, ldb;
    const bf16_t* A; const bf16_t* W; Src src; int layer, which, npan;
    DEV bool next(int i, Unit& u) const { return ge::static_next(npan, 4, G, c, i, u); }
    DEV const char* a_base(const Unit& u) const { return (const char*)(A + (size_t)u.pm * 256 * lda); }
    DEV const char* b_base(const Unit& u) const { return (const char*)(W + (size_t)u.pn * 256 * ldb); }
    DEV void epi(const f32x4 (&acc)[2][2][4][2], const Unit& u, int wr, int wc, int fr, int fq) const {
        const int row0 = u.pm * 256 + wr * 64 + fr, col0 = u.pn * 256 + wc * 32 + 4 * fq; const int vec = vec_of(u.pm * 256);
        const float* gp = modq(src.mod, layer, vec, which);
        f32x4 gv[2][2];
#pragma unroll
        for (int bj = 0; bj < 2; ++bj)
#pragma unroll
            for (int n = 0; n < 2; ++n) gv[bj][n] = *(const f32x4*)(gp + col0 + bj * 128 + n * 16);
#pragma unroll
        for (int ai = 0; ai < 2; ++ai)
#pragma unroll
            for (int mp = 0; mp < 4; mp += 2) { f32x4 hv[2][2][2];
#pragma unroll
                for (int m2 = 0; m2 < 2; ++m2) { const float* hi = src.H + (size_t)(row0 + ai * 128 + (mp + m2) * 16) * D + col0;
#pragma unroll
                    for (int bj = 0; bj < 2; ++bj)
#pragma unroll
                        for (int n = 0; n < 2; ++n) hv[m2][bj][n] = *(const f32x4*)(hi + bj * 128 + n * 16); }
#pragma unroll
                for (int m2 = 0; m2 < 2; ++m2) { float* ho = src.H + (size_t)(row0 + ai * 128 + (mp + m2) * 16) * D + col0;
#pragma unroll
                    for (int bj = 0; bj < 2; ++bj)
#pragma unroll
                        for (int n = 0; n < 2; ++n) *(f32x4*)(ho + bj * 128 + n * 16) = hv[m2][bj][n] + gv[bj][n] * acc[ai][bj][mp + m2][n]; } }
    }
};
template <bool MOE>
struct PolUp : PolBase {
    static constexpr bool PERM = true, GATHER = MOE, FP8 = MOE; static constexpr int ES = MOE ? 1 : 2; int K, lda, ldb;
    const bf16_t* A; const bf16_t* W; bf16_t* HID; int ldh, nq;
    int nM; const int* s2t; int tstart[NEXP + 1];
    DEV bool next(int i, Unit& u) const { return ge::static_next(MOE ? nM : NPAN, nq, G, c, i, u); }
    DEV int expert_of(int pm) const { int e = 0;
#pragma unroll
        for (int k = 1; k < NEXP; ++k) e += (pm >= tstart[k]) ? 1 : 0;
        return e; }
    DEV const char* a_base(const Unit& u) const { return MOE ? (const char*)A : (const char*)(A + (size_t)u.pm * 256 * lda); }
    DEV const char* b_base(const Unit& u) const { size_t off = (size_t)u.pn * 256 * ldb; if (MOE) off += (size_t)expert_of(u.pm) * 2 * DFFE * ldb; return (const char*)W + off * ES; }
    DEV int gather_row(const Unit& u, int R) const { return s2t[u.pm * 256 + R]; }
    DEV void epi(const f32x4 (&acc)[2][2][4][2], const Unit& u, int wr, int wc, int fr, int fq) const {
        const int row0 = u.pm * 256 + wr * 64 + fr, col0 = u.pn * 128 + wc * 32 + 8 * fq;
#pragma unroll
        for (int ai = 0; ai < 2; ++ai)
#pragma unroll
            for (int m = 0; m < 4; ++m) { bf16_t* o = HID + (size_t)(row0 + ai * 128 + m * 16) * ldh + col0;
                float h[8];
#pragma unroll
                for (int n = 0; n < 2; ++n)
#pragma unroll
                    for (int i = 0; i < 4; ++i) { if (MOE) h[4 * n + i] = siluf(acc[ai][0][m][n][i] * 0.00390625f) * (acc[ai][1][m][n][i] * (MOE_DOWN_FP8 ? 0.015625f : 0.00390625f));
                                                  else h[4 * n + i] = siluf(acc[ai][0][m][n][i]) * acc[ai][1][m][n][i]; }
                if (MOE && MOE_DOWN_FP8) { u32x2 w8; w8.x = pk4_fp8(h[0], h[1], h[2], h[3]); w8.y = pk4_fp8(h[4], h[5], h[6], h[7]);
                    *(u32x2*)((fp8_t*)HID + (size_t)(row0 + ai * 128 + m * 16) * ldh + col0) = w8; }
                else { u32x4 w; w.x = pk2(h[0], h[1]); w.y = pk2(h[2], h[3]); w.z = pk2(h[4], h[5]); w.w = pk2(h[6], h[7]); *(u32x4*)o = w; } }
    }
};
struct PolMoeDown : PolBase {
    static constexpr bool PERM = true, GATHER = (MOE_DOWN_FP8 != 0), FP8 = (MOE_DOWN_FP8 != 0); static constexpr int ES = MOE_DOWN_FP8 ? 1 : 2; int K, lda, ldb;
    const bf16_t* A; const bf16_t* W; bf16_t* YS; int nM; int tstart[NEXP + 1];
    DEV bool next(int i, Unit& u) const { return ge::static_next(nM, 4, G, c, i, u); }
    DEV int expert_of(int pm) const { int e = 0;
#pragma unroll
        for (int k = 1; k < NEXP; ++k) e += (pm >= tstart[k]) ? 1 : 0;
        return e; }
    DEV const char* a_base(const Unit& u) const { return GATHER ? (const char*)A : (const char*)A + (size_t)u.pm * 256 * lda * ES; }
    DEV int gather_row(const Unit& u, int R) const { return u.pm * 256 + R; }
    DEV const char* b_base(const Unit& u) const { return (const char*)W + ((size_t)expert_of(u.pm) * D + (size_t)u.pn * 256) * ldb * ES; }
    DEV void epi(const f32x4 (&acc)[2][2][4][2], const Unit& u, int wr, int wc, int fr, int fq) const {
        const int row0 = u.pm * 256 + wr * 64 + fr, col0 = u.pn * 256 + wc * 32 + 8 * fq;
#pragma unroll
        for (int ai = 0; ai < 2; ++ai)
#pragma unroll
            for (int m = 0; m < 4; ++m) { bf16_t* o = YS + (size_t)(row0 + ai * 128 + m * 16) * D + col0;
#pragma unroll
                for (int bj = 0; bj < 2; ++bj) { u32x4 w; w.x = pk2(acc[ai][bj][m][0][0], acc[ai][bj][m][0][1]); w.y = pk2(acc[ai][bj][m][0][2], acc[ai][bj][m][0][3]);
                    w.z = pk2(acc[ai][bj][m][1][0], acc[ai][bj][m][1][1]); w.w = pk2(acc[ai][bj][m][1][2], acc[ai][bj][m][1][3]); *(u32x4*)(o + bj * 128) = w; } }
    }
};
struct PolInProj : PolBase {
    static constexpr bool PERM = true, GATHER = false; static constexpr bool FP8 = false; static constexpr int ES = 2; int K, lda, ldb;
    const bf16_t* A; const bf16_t* W; bf16_t* Z; bf16_t* XBC; float* DT;
    DEV bool next(int i, Unit& u) const { return ge::static_next(NPAN, NPROJP / 256, G, c, i, u); }
    DEV const char* a_base(const Unit& u) const { return (const char*)(A + (size_t)u.pm * 256 * lda); }
    DEV const char* b_base(const Unit& u) const { return (const char*)(W + (size_t)u.pn * 256 * ldb); }
    DEV void epi(const f32x4 (&acc)[2][2][4][2], const Unit& u, int wr, int wc, int fr, int fq) const {
        const int row0 = u.pm * 256 + wr * 64 + fr, cw = wc * 32 + 8 * fq;
        if (u.pn < 20) {
            bf16_t* base; int ld, col0;
            if (u.pn < 8) { base = Z; ld = DIN; col0 = u.pn * 256 + cw; } else { base = XBC; ld = CONVD; col0 = (u.pn - 8) * 256 + cw; }
#pragma unroll
            for (int ai = 0; ai < 2; ++ai)
#pragma unroll
                for (int m = 0; m < 4; ++m) { bf16_t* o = base + (size_t)(row0 + ai * 128 + m * 16) * ld + col0;
#pragma unroll
                    for (int bj = 0; bj < 2; ++bj) { u32x4 w; w.x = pk2(acc[ai][bj][m][0][0], acc[ai][bj][m][0][1]); w.y = pk2(acc[ai][bj][m][0][2], acc[ai][bj][m][0][3]);
                        w.z = pk2(acc[ai][bj][m][1][0], acc[ai][bj][m][1][1]); w.w = pk2(acc[ai][bj][m][1][2], acc[ai][bj][m][1][3]); *(u32x4*)(o + bj * 128) = w; } }
        } else if (cw < 64) {
#pragma unroll
            for (int ai = 0; ai < 2; ++ai)
#pragma unroll
                for (int m = 0; m < 4; ++m) { const int r = row0 + ai * 128 + m * 16; int b, tv;
                    if (r < ML) { b = r / SEQ; tv = CTXL + r % SEQ; } else { b = (r - ML) / CTXL; tv = (r - ML) % CTXL; }
#pragma unroll
                    for (int n = 0; n < 2; ++n)
#pragma unroll
                        for (int i = 0; i < 4; ++i) { const int j = cw + 4 * n + i, dir = j >> 5, h = j & 31;
                            DT[((size_t)(b * 2 + dir) * NH + h) * TV + tv] = acc[ai][0][m][n][i]; } }
        }
    }
};

DEV void phase_conv(const Frame& F, int j, const bf16_t* XBC, bf16_t* XT, bf16_t* Brow, bf16_t* BT, bf16_t* Crow) {
    LAS bf16_t* tl0 = (LAS bf16_t*)F.lds;
    const float* cw = INP(F, I_CONVW) + (size_t)j * 4 * CONVD; const float* cb = INP(F, I_CONVB) + (size_t)j * CONVD;
    constexpr int NPER = NB * NCH, nitem = NPER * (CONVD / 64);
    const int t2 = 2 * (F.tid >> 3), cg = F.tid & 7;
    const int i0 = (int)(((long)F.bx * nitem) / F.G), i1 = (int)(((long)(F.bx + 1) * nitem) / F.G);
    int cblk_cur = -1; f32x4 wv[4][2], bv[2]; int par = 0;
#define CV_LOAD(it_, q_) do { const int _cb = (it_) / NPER, _rs = (it_) % NPER, _b = _rs / NCH, _cv = _rs % NCH; const int _ch = _cb * 64 + cg * 8, _tv = _cv * 128 + t2; \
        const int _s0 = _tv < CTXL ? 0 : CTXL, _s1 = _tv < CTXL ? CTXL : TV; \
        _Pragma("unroll") for (int k = 0; k < 5; ++k) { const int tk = _tv - 2 + k; q_[k] = (u32x4){0u, 0u, 0u, 0u}; \
            if (tk >= _s0 && tk < _s1) q_[k] = *(const u32x4*)(XBC + (size_t)row_of(_b, tk) * CONVD + _ch); } } while (0)
    u32x4 qn[5];
    if (i0 < i1) CV_LOAD(i0, qn);
    for (int it = i0; it < i1; ++it) {
        const int cblk = it / NPER, rest = it % NPER, b = rest / NCH, cv = rest % NCH;
        const int ch0 = cblk * 64 + cg * 8;
        if (cblk != cblk_cur) { cblk_cur = cblk;
#pragma unroll
            for (int k = 0; k < 4; ++k) { wv[k][0] = *(const f32x4*)(cw + k * CONVD + ch0); wv[k][1] = *(const f32x4*)(cw + k * CONVD + ch0 + 4); }
            bv[0] = *(const f32x4*)(cb + ch0); bv[1] = *(const f32x4*)(cb + ch0 + 4); }
        const int tv = cv * 128 + t2;
        float xin[5][8];
#pragma unroll
        for (int k = 0; k < 5; ++k) { const u32x4 q = qn[k];
            xin[k][0] = bflo(q.x); xin[k][1] = bfhi(q.x); xin[k][2] = bflo(q.y); xin[k][3] = bfhi(q.y); xin[k][4] = bflo(q.z); xin[k][5] = bfhi(q.z); xin[k][6] = bflo(q.w); xin[k][7] = bfhi(q.w); }
        if (it + 1 < i1) CV_LOAD(it + 1, qn);
        unsigned pk[2][4];
#pragma unroll
        for (int o = 0; o < 2; ++o) { float a[8];
#pragma unroll
            for (int i = 0; i < 8; ++i) { float acc = bv[i >> 2][i & 3];
#pragma unroll
                for (int k = 0; k < 4; ++k) acc += wv[k][i >> 2][i & 3] * xin[o + k][i];
                a[i] = siluf(acc); }
#pragma unroll
            for (int i = 0; i < 4; ++i) pk[o][i] = pk2(a[2 * i], a[2 * i + 1]); }
        const int r = row_of(b, tv);
        const bool isx = cblk < DIN / 64, isb = !isx && cblk < (DIN + BCD) / 64;
        if (isb) { bf16_t* o = Brow + (ch0 - DIN) + (size_t)r * BCD;
            *(u32x4*)o = (u32x4){pk[0][0], pk[0][1], pk[0][2], pk[0][3]}; *(u32x4*)(o + BCD) = (u32x4){pk[1][0], pk[1][1], pk[1][2], pk[1][3]}; }
        else if (!isx) {
            const int chc = ch0 - DIN - BCD; bf16_t* o = Crow + (size_t)(r - t2) * BCD + (chc >> 7) * 16384 + frag_off(t2, chc & 127);
            *(u32x4*)o = (u32x4){pk[0][0], pk[0][1], pk[0][2], pk[0][3]}; *(u32x4*)(o + 8) = (u32x4){pk[1][0], pk[1][1], pk[1][2], pk[1][3]}; }
        if (isx || isb) {
            LAS bf16_t* tl = tl0 + par * (64 * 136); par ^= 1;
#pragma unroll
            for (int i = 0; i < 4; ++i) { const unsigned lo = (pk[0][i] & 0xffffu) | (pk[1][i] << 16), hi = (pk[0][i] >> 16) | (pk[1][i] & 0xffff0000u);
                *(LAS unsigned*)(tl + (cg * 8 + 2 * i) * 136 + t2) = lo; *(LAS unsigned*)(tl + (cg * 8 + 2 * i + 1) * 136 + t2) = hi; }
            __syncthreads();
            if (isx) { bf16_t* dst = XT + ((size_t)b * DIN + cblk * 64) * TV;
#pragma unroll
                for (int q = 0; q < 2; ++q) { const int idx = F.tid + q * 512, ch = idx >> 4, t8 = (idx & 15) * 8;
                    *(u32x4*)(dst + (size_t)ch * TV + cv * 128 + t8) = *(const LAS u32x4*)(tl + ch * 136 + t8); }
            } else {
                const int chb = cblk * 64 - DIN; bf16_t* dst = BT + (size_t)((b * NCH + cv) * NG + (chb >> 7)) * 16384 + ((chb & 127) >> 4) * 2048;
#pragma unroll
                for (int q = 0; q < 2; ++q) { const int idx = F.tid + q * 512, fr_ = idx & 15, fq_ = (idx >> 4) & 3, ks_ = (idx >> 6) & 3, rbl = idx >> 8;
                    *(u32x4*)(dst + idx * 8) = *(const LAS u32x4*)(tl + (rbl * 16 + fr_) * 136 + (ks_ * 4 + fq_) * 8); }
            }
        }
    }
}

#undef CV_LOAD
DEV void phase_cb(const Frame& F, const bf16_t* Brow, const bf16_t* Crow, bf16_t* CB) {
    const int nitem = NB * NG * NCH; const int fr = F.lane & 15, fq = F.lane >> 4;
    for (int it = F.bx; it < nitem; it += F.G) {
        const int cv = it % NCH, g = (it / NCH) % NG, b = it / (NCH * NG);
        const int rbase = row_of(b, cv * 128);
        bf16x8 cf[4];
#pragma unroll
        for (int ks = 0; ks < 4; ++ks) cf[ks] = *(const bf16x8*)(Crow + (size_t)rbase * BCD + g * 16384 + (F.wave * 4 + ks) * 512 + F.lane * 8);
        bf16_t* out = CB + ((size_t)((b * NG + g) * NCH + cv)) * 16384;
#pragma unroll
        for (int nt = 0; nt < 8; ++nt) {
            f32x4 acc = (f32x4){0.f, 0.f, 0.f, 0.f};
#pragma unroll
            for (int ks = 0; ks < 4; ++ks) { const bf16x8 bfr = *(const bf16x8*)(Brow + (size_t)(rbase + 16 * nt + fr) * BCD + g * 128 + 32 * ks + 8 * fq); acc = MFMA16(bfr, cf[ks], acc); }
            u32x2 w; w.x = pk2(acc[0], acc[1]); w.y = pk2(acc[2], acc[3]);
            *(u32x2*)(out + frag_off(16 * F.wave + fr, 16 * nt + 4 * fq)) = w;
        }
    }
}

DEV void phase_tables(const Frame& F, int j, float* DT, float* CUM, float* WJ, float* CF) {
    const int nitem = NB * 2 * NH * NCH; const int gw = F.bx * 8 + F.wave, NGW = F.G * 8;
    for (int it = gw; it < nitem; it += NGW) {
        const int cv = it % NCH, h = (it / NCH) % NH, dir = (it / (NCH * NH)) & 1, b = it / (NCH * NH * 2);
        const float A = -expf(INP(F, I_ALOG)[(size_t)(j * 2 + dir) * NH + h]); const float bias = INP(F, I_DTB)[(size_t)(j * 2 + dir) * NH + h];
        const size_t o = ((size_t)(b * 2 + dir) * NH + h) * TV + cv * 128 + 2 * F.lane;
        const f32x2 raw = *(const f32x2*)(DT + o); const float d0 = softplusf(raw.x + bias), d1 = softplusf(raw.y + bias); const float a0 = d0 * A, a1 = d1 * A;
        float c0, c1, tot, sum = a0 + a1;
        if (dir == 0) {
#pragma unroll
            for (int q = 1; q < 64; q <<= 1) { const float t2 = __shfl_up(sum, q); if (F.lane >= q) sum += t2; }
            c1 = sum; c0 = sum - a1; tot = __shfl(sum, 63);
        } else {
#pragma unroll
            for (int q = 1; q < 64; q <<= 1) { const float t2 = __shfl_down(sum, q); if (F.lane + q < 64) sum += t2; }
            c0 = sum; c1 = sum - a0; tot = __shfl(sum, 0);
        }
        constexpr float L2E = 1.4426950408889634f;
        *(f32x2*)(DT + o) = (f32x2){c0 * L2E - flog2(d0), c1 * L2E - flog2(d1)};
        *(f32x2*)(CUM + o) = (f32x2){c0 * L2E, c1 * L2E};
        *(f32x2*)(WJ + o) = (f32x2){d0 * FEXP(tot - c0), d1 * FEXP(tot - c1)};
        const float cref = L2E * __shfl(dir == 0 ? c1 : c0, dir == 0 ? (F.lane | 15) : (F.lane & ~15));
        *(f32x2*)(CF + o) = (f32x2){d0 * fexp2(cref - c0 * L2E), d1 * fexp2(cref - c1 * L2E)};
    }
}

constexpr int SC_HL = 0, SC_TAB = 17408, SC_X = 21504, SC_END = SC_X + 16384;
static_assert(SC_END <= ge::STAGE_BYTES, "scan LDS map");
DEV void phase_scan(const Frame& F, int j, const bf16_t* XT, const bf16_t* BT, const bf16_t* Crow, const bf16_t* CB, const float* DT, const float* CUM, const float* WJ, const float* CF, bf16_t* Yf, bf16_t* Yb) {
    LAS unsigned char* L = F.lds;
    LAS bf16_t* Hl = (LAS bf16_t*)(L + SC_HL);
    LAS float* tab = (LAS float*)(L + SC_TAB);
    const int fr = F.lane & 15, fq = F.lane >> 4, w = F.wave;
    const int rb = w < 4 ? w : 11 - w;
    const int nitem = NB * NH * 2 * 2;
    for (int it = F.bx; it < nitem; it += F.G) {
        const int xq = it & 7, kq = it >> 3; const int b = xq >> 2, g = xq & 3, h = 8 * g + (kq >> 2), dir = (kq >> 1) & 1, ph = kq & 1;
        const float Dsk = dir == 0 ? INP(F, I_DSKIP)[(size_t)j * NH + h] : 0.f;
        const size_t tbase = ((size_t)(b * 2 + dir) * NH + h) * TV;
        const bf16_t* xt = XT + ((size_t)b * DIN + h * HD + ph * 32) * TV;
        const bf16_t* bt = BT + (size_t)(b * NCH * NG + g) * 16384;
        const bf16_t* CBh = CB + (size_t)((b * NG + g) * NCH) * 16384;
        const bf16_t* Cg = Crow + g * 16384;
        bf16_t* Y = (dir ? Yb : Yf) + h * HD + ph * 32;
        const int lrow = 16 * rb + fr;
        f32x4 accH[2]; accH[0] = (f32x4){0.f, 0.f, 0.f, 0.f}; accH[1] = accH[0];
        for (int i = F.tid; i < 32 * 136 / 2; i += 512) ((LAS unsigned*)Hl)[i] = 0u;
#define SC_CHUNK_OF(step) (dir == 0 ? (step) : ((step) < 2 ? 1 - (step) : (NCH - 1) - ((step) - 2)))
        const int xr = 4 * w + (F.lane >> 4), xc = F.lane & 15;
        const unsigned lxs = (unsigned)(xr * TV + 8 * xc) * 2u, lxd = (unsigned)(xr * 256 + ((xc ^ (xr & 15)) << 4));
#define SC_LD_X(cvx_) (*(const u32x4*)((const char*)(xt + (unsigned)(cvx_) * 128u) + lxs))
#define SC_ST_X(xb_, v_) (*(LAS u32x4*)(L + SC_X + (xb_) * 8192 + lxd) = (v_))
        const float* tsrcw = ((w >> 1) == 0 ? CUM : ((w >> 1) == 1 ? DT : ((w >> 1) == 2 ? WJ : CF))) + tbase + (w & 1) * 64 + F.lane;
#define SC_LD_TAB(cvx_) (tsrcw[(cvx_) * 128])
#define SC_ST_TAB(tbuf_, v_) (tab[(tbuf_) * 512 + w * 64 + F.lane] = (v_))
        const unsigned lfo = (unsigned)(rb * 4096 + F.lane * 16);
#define SC_LD_CB(cvx_, ks_) (*(const u32x4*)((const char*)(CBh + (size_t)(cvx_) * 16384u) + lfo + (ks_) * 1024))
#define SC_LD_BT(cvx_, ks_) (*(const u32x4*)((const char*)(bt + (size_t)(cvx_) * 65536u) + lfo + (ks_) * 1024))
#define SC_LD_C(rbx_, ks_) (*(const bf16x8*)((const char*)(Cg + (size_t)(rbx_) * BCD) + lfo + (ks_) * 1024))
        const int kd = rb >> 1; float km[8], dk[8];
#pragma unroll
        for (int i = 0; i < 8; ++i) { const int sidx = 32 * kd + 8 * fq + i; km[i] = (dir == 0 ? (sidx <= lrow) : (sidx >= lrow)) ? 1.f : 0.f; dk[i] = (sidx == lrow) ? Dsk : 0.f; }
        u32x4 rcb[4], rbt[4]; bf16x8 cf[4];
        { const int cv0 = SC_CHUNK_OF(0); const u32x4 x0 = SC_LD_X(cv0); const float t0 = SC_LD_TAB(cv0); const unsigned rb0 = (unsigned)row_of(b, cv0 * 128);
#pragma unroll
          for (int ks = 0; ks < 4; ++ks) { rcb[ks] = SC_LD_CB(cv0, ks); rbt[ks] = SC_LD_BT(cv0, ks); cf[ks] = SC_LD_C(rb0, ks); }
          SC_ST_X(0, x0); SC_ST_TAB(0, t0); }
        for (int step = 0; step < NCH; ++step) {
            int kdl = kd, dirl = dir; LAUNDER_S(kdl); LAUNDER_S(dirl);
            const int cv = SC_CHUNK_OF(step), buf = step & 1; const bool more = step + 1 < NCH;
            const int cvn = more ? SC_CHUNK_OF(step + 1) : cv;
            const unsigned rbase = (unsigned)row_of(b, cv * 128), rbn = (unsigned)row_of(b, cvn * 128);
            LDSBAR();
            const u32x4 xn = SC_LD_X(cvn); const float tn = SC_LD_TAB(cvn);
            const LAS float* tb = tab + buf * 512;
            const float cl2 = tb[lrow]; const float ecum_l = fexp2(cl2);
            const float chunk_decay = fexp2(dir == 0 ? tb[127] : tb[0]);
            bf16x8 mf[4], bw[4];
#pragma unroll
            for (int ks = 0; ks < 4; ++ks) { const int s0 = 32 * ks + 8 * fq;
                const bool none = dirl == 0 ? (ks > kdl) : (ks < kdl), diag = (ks == kdl);
                unsigned om[4] = {0u, 0u, 0u, 0u};
                if (!none) {
                    const unsigned qc[4] = {rcb[ks].x, rcb[ks].y, rcb[ks].z, rcb[ks].w};
                    if (!diag) {
                        const f32x4 f0 = *(const LAS f32x4*)(tb + 384 + s0), f1 = *(const LAS f32x4*)(tb + 384 + s0 + 4);
                        const float rowf = fexp2(cl2 - tb[dirl == 0 ? 32 * ks + 31 : 32 * ks]);
                        const f32x2 rf2 = {rowf, rowf};
                        const f32x2 c2[4] = {(f32x2){f0[0], f0[1]}, (f32x2){f0[2], f0[3]}, (f32x2){f1[0], f1[1]}, (f32x2){f1[2], f1[3]}};
#pragma unroll
                        for (int i = 0; i < 4; ++i) { const f32x2 v2 = (f32x2){bflo(qc[i]), bfhi(qc[i])} * (c2[i] * rf2); om[i] = pk2(v2.x, v2.y); }
                    } else {
                        const f32x4 cs0 = *(const LAS f32x4*)(tb + 128 + s0), cs1 = *(const LAS f32x4*)(tb + 128 + s0 + 4);
                        const float cs[8] = {cs0[0], cs0[1], cs0[2], cs0[3], cs1[0], cs1[1], cs1[2], cs1[3]};
                        float v[8];
#pragma unroll
                        for (int i = 0; i < 8; ++i) { const float cbv = (i & 1) ? bfhi(qc[i >> 1]) : bflo(qc[i >> 1]); const float x = cl2 - cs[i]; v[i] = (cbv * fexp2(x < 60.f ? x : 60.f)) * km[i] + dk[i]; }
#pragma unroll
                        for (int i = 0; i < 4; ++i) om[i] = pk2(v[2 * i], v[2 * i + 1]);
                    }
                }
                rcb[ks] = SC_LD_CB(cvn, ks);
                mf[ks] = __builtin_bit_cast(bf16x8, (u32x4){om[0], om[1], om[2], om[3]});
                { const f32x4 ws0 = *(const LAS f32x4*)(tb + 256 + s0), ws1 = *(const LAS f32x4*)(tb + 256 + s0 + 4);
                  const f32x2 w2[4] = {(f32x2){ws0[0], ws0[1]}, (f32x2){ws0[2], ws0[3]}, (f32x2){ws1[0], ws1[1]}, (f32x2){ws1[2], ws1[3]}};
                  const unsigned qb[4] = {rbt[ks].x, rbt[ks].y, rbt[ks].z, rbt[ks].w}; unsigned ob[4];
#pragma unroll
                  for (int i = 0; i < 4; ++i) { const f32x2 v2 = (f32x2){bflo(qb[i]), bfhi(qb[i])} * w2[i]; ob[i] = pk2(v2.x, v2.y); LAUNDER_V(ob[i]); }
                  bw[ks] = __builtin_bit_cast(bf16x8, (u32x4){ob[0], ob[1], ob[2], ob[3]}); }
                rbt[ks] = SC_LD_BT(cvn, ks); }
            f32x4 yd[2], yo[2];
#pragma unroll
            for (int nt = 0; nt < 2; ++nt) { yd[nt] = (f32x4){0.f, 0.f, 0.f, 0.f}; yo[nt] = yd[nt]; accH[nt] = accH[nt] * chunk_decay; }
#pragma unroll
            for (int nt = 0; nt < 2; ++nt)
#pragma unroll
                for (int ks = 0; ks < 4; ++ks) {
                    const bf16x8 xf = *(const LAS bf16x8*)(L + SC_X + buf * 8192 + (16 * nt + fr) * 256 + (((4 * ks + fq) ^ fr) << 4));
                    yd[nt] = MFMA16(xf, mf[ks], yd[nt]);
                    const bf16x8 hf = *(const LAS bf16x8*)(Hl + buf * (32 * 136) + (16 * nt + fr) * 136 + 32 * ks + 8 * fq);
                    yo[nt] = MFMA16(hf, cf[ks], yo[nt]);
                    accH[nt] = MFMA16(bw[ks], xf, accH[nt]); }
#pragma unroll
            for (int ks = 0; ks < 4; ++ks) cf[ks] = SC_LD_C(rbn, ks);
            SC_ST_X(buf ^ 1, xn); SC_ST_TAB(buf ^ 1, tn);
#pragma unroll
            for (int nt = 0; nt < 2; ++nt) { u32x2 hw; hw.x = pk2(accH[nt][0], accH[nt][1]); hw.y = pk2(accH[nt][2], accH[nt][3]);
                *(LAS u32x2*)(Hl + (buf ^ 1) * (32 * 136) + (16 * nt + fr) * 136 + 16 * rb + 4 * fq) = hw; }
#pragma unroll
            for (int nt = 0; nt < 2; ++nt) { u32x2 yw; yw.x = pk2(yd[nt][0] + ecum_l * yo[nt][0], yd[nt][1] + ecum_l * yo[nt][1]); yw.y = pk2(yd[nt][2] + ecum_l * yo[nt][2], yd[nt][3] + ecum_l * yo[nt][3]);
                *(u32x2*)(Y + ((size_t)(rbase + lrow) * DIN + 16 * nt + 4 * fq)) = yw; }
        }
        WAITV(0); LDSBAR();
    }
}

DEV void phase_gate(const Frame& F, int j, const bf16_t* Yf, const bf16_t* Yb, const bf16_t* Z, bf16_t* YN, int nrows) {
    const int gw = F.bx * 8 + F.wave, NGW = F.G * 8; const float* nw = INP(F, I_SNORM) + (size_t)j * DIN;
    u32x4 na[4], nb[4], nz[4];
    if (gw < nrows) {
#pragma unroll
        for (int q = 0; q < 4; ++q) { const size_t o = (size_t)gw * DIN + 8 * F.lane + 512 * q; na[q] = *(const u32x4*)(Yf + o); nb[q] = *(const u32x4*)(Yb + o); nz[q] = *(const u32x4*)(Z + o); } }
    for (int r = gw; r < nrows; r += NGW) {
        float t[32]; float ss = 0.f;
        u32x4 ca[4], cb4[4], cz[4];
#pragma unroll
        for (int q = 0; q < 4; ++q) { ca[q] = na[q]; cb4[q] = nb[q]; cz[q] = nz[q]; }
        if (r + NGW < nrows) {
#pragma unroll
            for (int q = 0; q < 4; ++q) { const size_t o = (size_t)(r + NGW) * DIN + 8 * F.lane + 512 * q; na[q] = *(const u32x4*)(Yf + o); nb[q] = *(const u32x4*)(Yb + o); nz[q] = *(const u32x4*)(Z + o); } }
#pragma unroll
        for (int q = 0; q < 4; ++q) { const u32x4 a = ca[q], bq = cb4[q], z = cz[q];
            const unsigned aa[4] = {a.x, a.y, a.z, a.w}, bb[4] = {bq.x, bq.y, bq.z, bq.w}, zz[4] = {z.x, z.y, z.z, z.w};
#pragma unroll
            for (int i = 0; i < 4; ++i) { const float v0 = (bflo(aa[i]) + bflo(bb[i])) * siluf(bflo(zz[i])), v1 = (bfhi(aa[i]) + bfhi(bb[i])) * siluf(bfhi(zz[i])); t[8 * q + 2 * i] = v0; t[8 * q + 2 * i + 1] = v1; ss += v0 * v0 + v1 * v1; } }
        const float rstd = rsqrtf(wave_sum(ss) * (1.0f / DIN) + EPS);
#pragma unroll
        for (int q = 0; q < 4; ++q) { const int c = 8 * F.lane + 512 * q; const f32x4 w0 = *(const f32x4*)(nw + c), w1 = *(const f32x4*)(nw + c + 4);
            u32x4 o; o.x = pk2(t[8 * q] * rstd * w0[0], t[8 * q + 1] * rstd * w0[1]); o.y = pk2(t[8 * q + 2] * rstd * w0[2], t[8 * q + 3] * rstd * w0[3]);
            o.z = pk2(t[8 * q + 4] * rstd * w1[0], t[8 * q + 5] * rstd * w1[1]); o.w = pk2(t[8 * q + 6] * rstd * w1[2], t[8 * q + 7] * rstd * w1[3]);
            *(u32x4*)(YN + (size_t)r * DIN + c) = o; }
    }
}

DEV void phase_route(const Frame& F, int layer, int ml, bf16_t* V, int nrows) {
    LAS unsigned* lc = (LAS unsigned*)(F.lds + LDS_MISC + 256);
    if (F.tid < 8) lc[F.tid] = 0u;
    __syncthreads();
    const int gw = F.bx * 8 + F.wave, NGW = F.G * 8; const int j = layer / 2;
    const float* w = INP(F, I_NFFN) + (size_t)layer * D; const float* rw = INP(F, I_RW) + (size_t)j * D * NEXP;
    LAS float* rwl = (LAS float*)F.lds;
    for (int q = F.tid; q < D * 2; q += 512) { const int c = q >> 1, hf = q & 1; const int ln = (c & 255) >> 2, ii = c & 3, jq = c >> 8;
        *(LAS f32x4*)(rwl + ((jq * 4 + ii) * 64 + ln) * 8 + hf * 4) = *(const f32x4*)(rw + (size_t)q * 4); }
    __syncthreads();
    TokInfo* tok = (TokInfo*)(F.ws + OFF_TOK);
    f32x4 nx[4];
    if (gw < nrows) load_row(F.H + (size_t)gw * D, F.lane, nx);
    for (int r = gw; r < nrows; r += NGW) {
        f32x4 v[4];
#pragma unroll
        for (int q = 0; q < 4; ++q) v[q] = nx[q];
        if (r + NGW < nrows) load_row(F.H + (size_t)(r + NGW) * D, F.lane, nx);
        const float rstd = rsqrtf(sumsq_row(v) * (1.0f / D) + EPS);
        const int vec = vec_of(r);
        normmod_row(v, rstd, w, modp(F, layer, vec, 3), modp(F, layer, vec, 4), F.lane);
#pragma unroll
        for (int jq = 0; jq < 4; ++jq) *(unsigned*)((fp8_t*)V + (size_t)r * D + 4 * F.lane + 256 * jq) = pk4_fp8(v[jq][0] * 8.0f, v[jq][1] * 8.0f, v[jq][2] * 8.0f, v[jq][3] * 8.0f);
        float lg[NEXP];
#pragma unroll
        for (int e = 0; e < NEXP; ++e) lg[e] = 0.f;
#pragma unroll
        for (int jj = 0; jj < 4; ++jj)
#pragma unroll
            for (int i = 0; i < 4; ++i) { const LAS float* rp = rwl + ((jj * 4 + i) * 64 + F.lane) * 8; const f32x4 r0 = *(const LAS f32x4*)rp, r1 = *(const LAS f32x4*)(rp + 4);
#pragma unroll
                for (int e = 0; e < 4; ++e) { lg[e] += v[jj][i] * r0[e]; lg[4 + e] += v[jj][i] * r1[e]; } }
#pragma unroll
        for (int e = 0; e < NEXP; ++e) lg[e] = wave_sum(lg[e]);
        int e0 = 0; float v0 = lg[0];
#pragma unroll
        for (int e = 1; e < NEXP; ++e) if (lg[e] > v0) { v0 = lg[e]; e0 = e; }
        int e1 = -1; float v1 = -3.0e38f;
#pragma unroll
        for (int e = 0; e < NEXP; ++e) if (e != e0 && lg[e] > v1) { v1 = lg[e]; e1 = e; }
        const float g1 = frcp(1.0f + FEXP(v0 - v1)), g0 = 1.0f - g1;
        if (F.lane == 0) { TokInfo ti; ti.s0 = e0; ti.s1 = e1; ti.g0 = g0; ti.g1 = g1; tok[r] = ti; atomicAdd((unsigned*)&lc[e0], 1u); atomicAdd((unsigned*)&lc[e1], 1u); }
    }
    __syncthreads();
    if (F.tid < 8) __hip_atomic_fetch_add(F.ctl + CW_CNT + (ml * 8 + F.tid) * 64, lc[F.tid], RLX_AGENT);
}
DEV void tile_starts(const Frame& F, int ml, int (&ts)[NEXP + 1], unsigned (&cnt)[NEXP]) {
    ts[0] = 0;
#pragma unroll
    for (int e = 0; e < NEXP; ++e) { cnt[e] = __hip_atomic_load(F.ctl + CW_CNT + (ml * 8 + e) * 64, RLX_AGENT); ts[e + 1] = ts[e] + (int)((cnt[e] + 255u) / 256u); }
}
DEV void phase_slots(const Frame& F, int ml, int nrows) {
    int ts[NEXP + 1]; unsigned cnt[NEXP]; tile_starts(F, ml, ts, cnt);
    TokInfo* tok = (TokInfo*)(F.ws + OFF_TOK); int* s2t = (int*)(F.ws + OFF_S2T);
    const int gw = F.bx * 8 + F.wave, NGW = F.G * 8;
    for (int base = gw * 64; base < nrows; base += NGW * 64) {
        const int r = base + F.lane; TokInfo ti = tok[r];
        unsigned long long m0[NEXP], m1[NEXP]; unsigned mycnt = 0;
#pragma unroll
        for (int e = 0; e < NEXP; ++e) { m0[e] = __ballot(ti.s0 == e); m1[e] = __ballot(ti.s1 == e); if (F.lane == e) mycnt = (unsigned)(__builtin_popcountll(m0[e]) + __builtin_popcountll(m1[e])); }
        unsigned b0 = 0;
        if (F.lane < NEXP && mycnt) b0 = __hip_atomic_fetch_add(F.ctl + CW_CUR + (ml * 8 + F.lane) * 64, mycnt, RLX_AGENT);
        const unsigned long long below = (1ull << F.lane) - 1ull; int sl0 = 0, sl1 = 0;
#pragma unroll
        for (int e = 0; e < NEXP; ++e) { const unsigned be = __shfl(b0, e); const int c0 = __builtin_popcountll(m0[e]);
            if (ti.s0 == e) sl0 = ts[e] * 256 + (int)be + __builtin_popcountll(m0[e] & below);
            if (ti.s1 == e) sl1 = ts[e] * 256 + (int)be + c0 + __builtin_popcountll(m1[e] & below); }
        ti.s0 = sl0; ti.s1 = sl1; tok[r] = ti; s2t[sl0] = r; s2t[sl1] = r;
    }
    if (F.bx == 0) { for (int e = 0; e < NEXP; ++e) { const int a = ts[e] * 256 + (int)cnt[e], b2 = ts[e + 1] * 256; for (int s = a + F.tid; s < b2; s += 512) s2t[s] = 0; } }
}
DEV void phase_combine(const Frame& F, int layer, const bf16_t* YS, bool final_) {
    const int NGW = F.G * 8; const int gw = F.bx * 8 + F.wave + (final_ ? 0 : ML); const TokInfo* tok = (const TokInfo*)(F.ws + OFF_TOK);
    const int nrows = final_ ? ML : MT;
    f32x4 nh[4]; u32x2 nya[4], nyb[4]; TokInfo tcur, tnxt;
    tcur.s0 = tcur.s1 = 0; tcur.g0 = tcur.g1 = 0.f; tnxt = tcur;
    if (gw < nrows) { tcur = tok[gw]; load_row(F.H + (size_t)gw * D, F.lane, nh);
#pragma unroll
        for (int jj = 0; jj < 4; ++jj) { const int c = 4 * F.lane + 256 * jj; nya[jj] = *(const u32x2*)(YS + (size_t)tcur.s0 * D + c); nyb[jj] = *(const u32x2*)(YS + (size_t)tcur.s1 * D + c); } }
    if (gw + NGW < nrows) tnxt = tok[gw + NGW];
    for (int r = gw; r < nrows; r += NGW) {
        f32x4 v[4]; u32x2 ya[4], yb[4]; TokInfo ti = tcur;
#pragma unroll
        for (int q = 0; q < 4; ++q) { v[q] = nh[q]; ya[q] = nya[q]; yb[q] = nyb[q]; }
        tcur = tnxt;
        if (r + NGW < nrows) { load_row(F.H + (size_t)(r + NGW) * D, F.lane, nh);
#pragma unroll
            for (int jj = 0; jj < 4; ++jj) { const int c = 4 * F.lane + 256 * jj; nya[jj] = *(const u32x2*)(YS + (size_t)tcur.s0 * D + c); nyb[jj] = *(const u32x2*)(YS + (size_t)tcur.s1 * D + c); } }
        if (r + 2 * NGW < nrows) tnxt = tok[r + 2 * NGW];
        if (MOE_DOWN_FP8) { ti.g0 *= 0.00390625f; ti.g1 *= 0.00390625f; }
        const float* g2 = modp(F, layer, vec_of(r), 5);
#pragma unroll
        for (int jj = 0; jj < 4; ++jj) { const int c = 4 * F.lane + 256 * jj; const u32x2 a = ya[jj], b = yb[jj]; const f32x4 gv = *(const f32x4*)(g2 + c);
            v[jj][0] += gv[0] * (ti.g0 * bflo(a.x) + ti.g1 * bflo(b.x)); v[jj][1] += gv[1] * (ti.g0 * bfhi(a.x) + ti.g1 * bfhi(b.x));
            v[jj][2] += gv[2] * (ti.g0 * bflo(a.y) + ti.g1 * bflo(b.y)); v[jj][3] += gv[3] * (ti.g0 * bfhi(a.y) + ti.g1 * bfhi(b.y)); }
        if (!final_) {
#pragma unroll
            for (int jj = 0; jj < 4; ++jj) *(f32x4*)(F.H + (size_t)r * D + 4 * F.lane + 256 * jj) = v[jj];
        } else {
            const float rstd = rsqrtf(sumsq_row(v) * (1.0f / D) + EPS); const float* fw = INP(F, I_FNORM);
#pragma unroll
            for (int jj = 0; jj < 4; ++jj) { const int c = 4 * F.lane + 256 * jj; *(f32x4*)(OUTP(F) + (size_t)r * D + c) = v[jj] * rstd * *(const f32x4*)(fw + c); }
        }
    }
}

constexpr int PH_PER_PAIR = 17, N_PHASES = 1 + 2 * PH_PER_PAIR;
__global__ void __launch_bounds__(512, 2) fwd_kernel(Params prm) {
#ifdef EMU
    unsigned char* lds_raw = emu_lds();
#else
    extern __shared__ __attribute__((aligned(16))) unsigned char lds_raw[];
#endif
    Frame F;
    F.lds = (LAS unsigned char*)lds_raw;
    F.tid = threadIdx.x; F.lane = F.tid & 63; F.wave = RFL(F.tid >> 6); F.G = gridDim.x; F.bx = blockIdx.x;
    F.p = &prm; F.ws = prm.ws; F.ctl = (unsigned*)(prm.ws + OFF_CTL); F.H = (float*)(prm.ws + OFF_H); F.mod = (float*)(prm.ws + OFF_MOD);
    volatile LAS unsigned* misc = (volatile LAS unsigned*)(F.lds + LDS_MISC);
    if (F.tid < 64) misc[F.tid] = 0u;
    __syncthreads();
    XcdBarrier bar; bar.bar = F.ctl + CW_BAR; bar.x = 0; bar.st = misc;
    const int lo = prm.ph_lo, hi = prm.ph_hi;
    if (hi - lo > 1) bar = xcd_barrier_post(F.ctl + CW_BAR, misc);
    int ph = 0;
#ifndef SITE_MASK
#define SITE_MASK 0xFFFFFFFFu
#endif
#ifndef PROBE_REPEAT_SITE
#define PROBE_REPEAT_SITE (-1)
#endif
#define PH_REPS(site) ((PROBE_REPEAT_SITE == (site)) ? 2 : 1)
#define PHASE_BEGIN(site) if (((SITE_MASK >> (site)) & 1u) && lo <= ph && ph < hi) { { int _t = threadIdx.x; LAUNDER_V(_t); F.tid = _t; F.lane = _t & 63; int _b = blockIdx.x; LAUNDER_S(_b); F.bx = _b; int _g = gridDim.x; LAUNDER_S(_g); F.G = _g; \
      F.ws = WSP(F); F.ctl = (unsigned*)(F.ws + OFF_CTL); F.H = (float*)(F.ws + OFF_H); F.mod = (float*)(F.ws + OFF_MOD); } \
      for (int _rep = 0; _rep < PH_REPS(site); ++_rep) { if (_rep) __syncthreads();
#define PHASE_END   } if (ph + 1 < hi) xcd_barrier(bar); } ++ph;
#define B_W (F.ws + OFF_W)
#define B_ACT (F.ws + OFF_ACT)
#define B_P ((bf16_t*)(B_ACT + A_P))
#define B_HID ((bf16_t*)(B_ACT + A_HID))
#define B_U ((bf16_t*)(B_ACT + A_U))
#define B_Z ((bf16_t*)(B_ACT + A_Z))
#define B_XBC ((bf16_t*)(B_ACT + A_XBC))
#define B_DT ((float*)(B_W + W_DT))
#define B_XT ((bf16_t*)(B_ACT + A_XT))
#define B_BROW ((bf16_t*)(B_ACT + A_BROW))
#define B_BT ((bf16_t*)(B_ACT + A_BT))
#define B_CROW ((bf16_t*)(B_ACT + A_CROW))
#define B_CB ((bf16_t*)(B_ACT + A_CB))
#define B_CUM ((float*)(B_ACT + A_CUM))
#define B_WJ ((float*)(B_ACT + A_WJ))
#define B_CF ((float*)(B_ACT + A_CF))
#define B_YF ((bf16_t*)(B_ACT + A_YF))
#define B_YB ((bf16_t*)(B_W + W_YB))
#define B_YN ((bf16_t*)(B_ACT + A_YN))
#define B_V ((bf16_t*)(B_ACT + A_V))
#define B_HIDM ((bf16_t*)(B_ACT + A_HIDM))
#define B_YS ((bf16_t*)(B_ACT + A_YS))

    PHASE_BEGIN(0) phase_mod(F); convert_even(F, 0); PHASE_END

    for (int lp = 0; lp < 2; ++lp) {
        const int le = 2 * lp, lod = 2 * lp + 1;
        PHASE_BEGIN(1) phase_poolprep(F, le, B_P, lp == 1, B_YS); PHASE_END
        PHASE_BEGIN(2) { PolPool S; S.G = F.G; S.c = F.bx; S.K = 256; S.lda = D; S.ldb = 256; S.P = B_P; S.W = (const bf16_t*)(B_W + W_POOL); S.src = mksrc(F); S.layer = le; S.scale = INP(F, I_POOLS) + (size_t)lp * D;
                      ge::gemm_phase(F.lds, S, F.tid); } PHASE_END
        PHASE_BEGIN(3) phase_norm(F, le, 3, B_P, false); PHASE_END
        PHASE_BEGIN(4) { PolUp<false> S; S.G = F.G; S.c = F.bx; S.K = D; S.lda = D; S.ldb = D; S.A = B_P; S.W = (const bf16_t*)(B_W + W_UP); S.HID = B_HID; S.ldh = DFF; S.nq = DFF / 128; S.nM = NPAN; S.s2t = nullptr;
                      ge::gemm_phase(F.lds, S, F.tid); } PHASE_END
        PHASE_BEGIN(5) { PolResid S; S.G = F.G; S.c = F.bx; S.K = DFF; S.lda = DFF; S.ldb = DFF; S.A = B_HID; S.W = (const bf16_t*)(B_W + W_DN); S.src = mksrc(F); S.layer = le; S.which = 5; S.npan = NPAN;
                      ge::gemm_phase(F.lds, S, F.tid);
                      Frame F2 = F; if (idle_subgrid(F2, NPAN * 4)) convert_ssd(F2, lp); } PHASE_END
        PHASE_BEGIN(6) phase_norm(F, lod, 0, B_U, false); PHASE_END
        PHASE_BEGIN(7) { PolInProj S; S.G = F.G; S.c = F.bx; S.K = D; S.lda = D; S.ldb = D; S.A = B_U; S.W = (const bf16_t*)(B_W + W_IN); S.Z = B_Z; S.XBC = B_XBC; S.DT = B_DT;
                      ge::gemm_phase(F.lds, S, F.tid); } PHASE_END
        PHASE_BEGIN(8) phase_conv(F, lp, B_XBC, B_XT, B_BROW, B_BT, B_CROW); PHASE_END
        PHASE_BEGIN(9) phase_cb(F, B_BROW, B_CROW, B_CB); phase_tables(F, lp, B_DT, B_CUM, B_WJ, B_CF); PHASE_END
        PHASE_BEGIN(10) phase_scan(F, lp, B_XT, B_BT, B_CROW, B_CB, B_DT, B_CUM, B_WJ, B_CF, B_YF, B_YB); PHASE_END
        PHASE_BEGIN(11) phase_gate(F, lp, B_YF, B_YB, B_Z, B_YN, lp == 1 ? ML : MT); PHASE_END
        PHASE_BEGIN(12) { PolResid S; S.G = F.G; S.c = F.bx; S.K = DIN; S.lda = DIN; S.ldb = DIN; S.A = B_YN; S.W = (const bf16_t*)(B_W + W_OUT); S.src = mksrc(F); S.layer = lod; S.which = 2; S.npan = lp == 1 ? ML / 256 : NPAN;
                      ge::gemm_phase(F.lds, S, F.tid);
                      Frame F2 = F; if (idle_subgrid(F2, S.npan * 4)) convert_moe(F2, lp, false, true); } PHASE_END
        PHASE_BEGIN(13) phase_route(F, lod, lp, B_V, lp == 1 ? ML : MT); convert_moe(F, lp, true, false); PHASE_END
        PHASE_BEGIN(14) phase_slots(F, lp, lp == 1 ? ML : MT); PHASE_END
        PHASE_BEGIN(15) { int ts[NEXP + 1]; unsigned cnt[NEXP]; tile_starts(F, lp, ts, cnt);
                      PolUp<true> S; S.G = F.G; S.c = F.bx; S.K = D; S.lda = D; S.ldb = D; S.A = B_V; S.W = (const bf16_t*)(B_W + W_MUP); S.HID = B_HIDM; S.ldh = DFFE; S.nq = DFFE / 128; S.nM = ts[NEXP];
                      S.s2t = (const int*)(F.ws + OFF_S2T);
#pragma unroll
                      for (int e = 0; e <= NEXP; ++e) S.tstart[e] = ts[e];
                      ge::gemm_phase(F.lds, S, F.tid); } PHASE_END
        PHASE_BEGIN(16) { int ts[NEXP + 1]; unsigned cnt[NEXP]; tile_starts(F, lp, ts, cnt);
                      PolMoeDown S; S.G = F.G; S.c = F.bx; S.K = DFFE; S.lda = DFFE; S.ldb = DFFE; S.A = B_HIDM; S.W = (const bf16_t*)(B_W + W_MDN); S.YS = B_YS; S.nM = ts[NEXP];
#pragma unroll
                      for (int e = 0; e <= NEXP; ++e) S.tstart[e] = ts[e];
                      ge::gemm_phase(F.lds, S, F.tid);
                      if (lp == 0) { Frame F2 = F; if (idle_subgrid(F2, S.nM * 4)) convert_even(F2, 1); } } PHASE_END
        PHASE_BEGIN(17) phase_combine(F, lod, B_YS, lp == 1); PHASE_END
    }
#undef PHASE_BEGIN
#undef PHASE_END
}

extern "C" void kernel_launch(void* const* d_in, const int* in_sizes, int n_in, void* d_out, int out_size, void* d_ws, size_t ws_size, hipStream_t stream) {
    static int grid = 0;
    if (grid == 0) {
        if (n_in != 26 || ws_size < WS_NEED) { fprintf(stderr, "kernel_launch: need 26 inputs and %zu bytes of workspace (got %d, %zu)\n", (size_t)WS_NEED, n_in, ws_size); grid = -1; return; }
        int dev = 0, cus = 0, per_cu = 0;
        if (hipGetDevice(&dev) != hipSuccess || hipDeviceGetAttribute(&cus, hipDeviceAttributeMultiprocessorCount, dev) != hipSuccess) { grid = -1; return; }
        if (hipFuncSetAttribute((const void*)fwd_kernel, hipFuncAttributeMaxDynamicSharedMemorySize, LDS_BYTES) != hipSuccess) { grid = -1; return; }
        if (hipOccupancyMaxActiveBlocksPerMultiprocessor(&per_cu, (const void*)fwd_kernel, 512, LDS_BYTES) != hipSuccess || per_cu < 1) { fprintf(stderr, "kernel_launch: occupancy query says %d\n", per_cu); }
        (void)hipGetLastError();
        grid = cus;
    }
    if (grid < 0) return;
    (void)in_sizes; (void)out_size;
    if (hipMemsetAsync((char*)d_ws + OFF_CTL, 0, CTL_BYTES, stream) != hipSuccess) return;
    Params p{};
    for (int i = 0; i < 26; ++i) p.in[i] = (const float*)d_in[i];
    p.out = (float*)d_out; p.ws = (unsigned char*)d_ws;
    if (N_LAUNCH_MODE == 1) { p.ph_lo = 0; p.ph_hi = N_PHASES; hipLaunchKernelGGL(fwd_kernel, dim3(grid), dim3(512), LDS_BYTES, stream, p); }
    else for (int ph = 0; ph < N_PHASES; ++ph) { p.ph_lo = ph; p.ph_hi = ph + 1; hipLaunchKernelGGL(fwd_kernel, dim3(grid), dim3(512), LDS_BYTES, stream, p); }
}
```

```cpp
#ifndef EMU
#include <hip/hip_runtime.h>
#endif
#include <cstdio>
#include <cstdint>

#ifndef CFG_SEQ
#define CFG_SEQ 16384
#endif
#ifndef CFG_DFF
#define CFG_DFF 2816
#endif
#ifndef CFG_DFFE
#define CFG_DFFE 3584
#endif
#ifndef MOE_DOWN_FP8
#define MOE_DOWN_FP8 1
#endif
#ifndef N_LAUNCH_MODE
#define N_LAUNCH_MODE 1
#endif

#ifdef EMU
#define LAS
#define DEV inline
#define WAITV(n) ((void)0)
#define WAITL(n) ((void)0)
#define SBAR() emu_wg_sync()
#define SCHED() ((void)0)
#define SETPRIO(x) ((void)0)
#define MFMA16(a, b, c) emu_mfma16(a, b, c)
#define GLDS16(g, l) emu_glds16((const void*)(g), (void*)(l))
#define GLDS4(g, l) emu_glds4((const void*)(g), (void*)(l))
#define MFMA8(a, b, c) emu_mfma8(a, b, c)
#define RFL(x) emu_rfl(x)
#define MEMFENCE() ((void)0)
#define WSYNC() emu_wave_sync()
#define LDSBAR() emu_wg_sync()
#define LAUNDER_V(x) ((void)0)
#define SLEEP1() emu_yield()
#define MY_XCC_ID() ((unsigned)(blockIdx.x & 7u))
#define FENCE_REL() __atomic_thread_fence(__ATOMIC_SEQ_CST)
#define FENCE_ACQ() __atomic_thread_fence(__ATOMIC_SEQ_CST)
#define FEXP(x) expf(x)
#define RLX_AGENT __ATOMIC_RELAXED, 4
#else
#define LAS __attribute__((address_space(3)))
#define DEV __device__ __forceinline__
#define WAITV(n) asm volatile("s_waitcnt vmcnt(" #n ")" ::: "memory")
#define WAITL(n) asm volatile("s_waitcnt lgkmcnt(" #n ")" ::: "memory")
#define SBAR() __builtin_amdgcn_s_barrier()
#define SCHED() __builtin_amdgcn_sched_barrier(0)
#define SETPRIO(x) __builtin_amdgcn_s_setprio(x)
#define MFMA16(a, b, c) __builtin_amdgcn_mfma_f32_16x16x32_bf16(a, b, c, 0, 0, 0)
#define GLDS16(g, l) __builtin_amdgcn_global_load_lds((const unsigned*)(g), (LAS unsigned*)(l), 16, 0, 0)
#define GLDS4(g, l) __builtin_amdgcn_global_load_lds((const unsigned*)(g), (LAS unsigned*)(l), 4, 0, 0)
#define MFMA8(a, b, c) __builtin_amdgcn_mfma_scale_f32_16x16x128_f8f6f4(a, b, c, 0, 0, 0, 0x7f7f7f7f, 0, 0x7f7f7f7f)
#define RFL(x) __builtin_amdgcn_readfirstlane(x)
#define MEMFENCE() asm volatile("" ::: "memory")
#define LDSBAR() do { asm volatile("s_waitcnt lgkmcnt(0)" ::: "memory"); __builtin_amdgcn_s_barrier(); asm volatile("" ::: "memory"); } while (0)
#define WSYNC() asm volatile("s_waitcnt lgkmcnt(0)" ::: "memory")
#define SLEEP1() __builtin_amdgcn_s_sleep(1)
#define MY_XCC_ID() ((unsigned)__builtin_amdgcn_s_getreg((3 << 11) | 20) & 0xFu)
#define FENCE_REL() __builtin_amdgcn_fence(__ATOMIC_RELEASE, "agent")
#define FENCE_ACQ() __builtin_amdgcn_fence(__ATOMIC_ACQUIRE, "agent")
#define FEXP(x) __expf(x)
#define RLX_AGENT __ATOMIC_RELAXED, __HIP_MEMORY_SCOPE_AGENT
#define LAUNDER_V(x) asm volatile("" : "+v"(x))
#endif

typedef unsigned short bf16_t;
typedef short bf16x8 __attribute__((ext_vector_type(8)));
typedef float f32x4 __attribute__((ext_vector_type(4)));
typedef float f32x2 __attribute__((ext_vector_type(2)));
typedef unsigned u32x4 __attribute__((ext_vector_type(4)));
typedef unsigned u32x2 __attribute__((ext_vector_type(2)));
typedef int i32x8 __attribute__((ext_vector_type(8)));
typedef int i32x4 __attribute__((ext_vector_type(4)));
typedef unsigned char fp8_t;

constexpr int D = 1024, NB = 2, SEQ = CFG_SEQ, CTXL = 256, DEPTH = 4;
constexpr int ML = NB * SEQ, MC = NB * CTXL, MT = ML + MC, NPAN = MT / 256;
constexpr int DFF = CFG_DFF, DFFE = CFG_DFFE, NEXP = 8;
constexpr int DIN = 2048, NH = 32, HD = 64, NG = 4, DS = 128, CONVD = 3072, NPROJ = 5184, NPROJP = 5376, BCD = 512;
constexpr int TV = CTXL + SEQ, NCH = TV / 128;
constexpr int GRIDW = 64;
constexpr float EPS = 1e-6f;
constexpr int NSLOT_TILES = (2 * MT) / 256 + NEXP, NSLOT = NSLOT_TILES * 256;
static_assert(SEQ % 128 == 0 && ML % 256 == 0 && DFF % 128 == 0 && DFFE % 128 == 0 && DFF >= 256 && DFFE >= 256, "shape constraints");

constexpr size_t MiB = 1u << 20;
constexpr size_t al(size_t x) { return (x + 4095) & ~(size_t)4095; }
constexpr size_t OFF_CTL = 0, CTL_BYTES = 1 * MiB;
constexpr size_t OFF_MOD = 1 * MiB;
constexpr size_t OFF_TOK = 2 * MiB;
constexpr size_t OFF_S2T = 3 * MiB;
constexpr size_t OFF_H = 4 * MiB, SZ_H = (size_t)MT * D * 4;
constexpr size_t OFF_W = OFF_H + al(SZ_H);
constexpr size_t W_POOL = 0, SZ_WPOOL = (size_t)4 * 256 * 256 * 2;
constexpr size_t W_UP = al(SZ_WPOOL), SZ_WUP = (size_t)2 * DFF * D * 2;
constexpr size_t W_DN = W_UP + al(SZ_WUP), SZ_WDN = (size_t)D * DFF * 2;
constexpr size_t SZ_WEVEN = W_DN + al(SZ_WDN);
constexpr size_t W_IN = SZ_WEVEN, SZ_WIN = (size_t)NPROJP * D * 2;
constexpr size_t W_OUT = W_IN + al(SZ_WIN), SZ_WOUT = (size_t)D * DIN * 2;
constexpr size_t W_DT = W_OUT + al(SZ_WOUT), SZ_DT = (size_t)NB * 2 * NH * TV * 4;
constexpr size_t W_MUP = W_DT + al(SZ_DT), SZ_WMUP = (size_t)NEXP * 2 * DFFE * D;
constexpr size_t W_MDN = W_MUP + al(SZ_WMUP), SZ_WMDN = (size_t)NEXP * D * DFFE * (MOE_DOWN_FP8 ? 1 : 2);
constexpr size_t W_YB = W_MUP, SZ_Y = (size_t)MT * DIN * 2;
constexpr size_t SZ_WODD_A = W_MDN + al(SZ_WMDN), SZ_WODD_B = W_YB + al(SZ_Y);
constexpr size_t mx(size_t a, size_t b) { return a > b ? a : b; }
constexpr size_t SZ_W = mx(SZ_WEVEN, mx(SZ_WODD_A, SZ_WODD_B));
constexpr size_t OFF_ACT = OFF_W + SZ_W;
constexpr size_t A_P = 0, SZ_ACT1 = (size_t)MT * D * 2;
constexpr size_t A_HID = al(SZ_ACT1), SZ_HID = (size_t)MT * DFF * 2;
constexpr size_t SZ_AEVEN = A_HID + al(SZ_HID);
constexpr size_t A_Z = 0;
constexpr size_t A_XBC = al(SZ_Y), SZ_XBC = (size_t)MT * CONVD * 2;
constexpr size_t A_YF = A_XBC;
constexpr size_t A_CB = A_XBC + al(SZ_Y), SZ_CB = (size_t)NB * NG * NCH * 128 * 128 * 2;
static_assert(al(SZ_Y) + SZ_CB <= SZ_XBC, "CB fits behind Yf inside the XBC region");
constexpr size_t A_XT = A_XBC + al(SZ_XBC), SZ_XT = (size_t)NB * DIN * TV * 2;
constexpr size_t A_U = A_XT, A_YN = A_XT;
constexpr size_t A_BROW = A_XT + al(SZ_XT), SZ_BC = (size_t)MT * BCD * 2;
constexpr size_t A_BT = A_BROW + al(SZ_BC);
constexpr size_t A_CROW = A_BT + al(SZ_BC);
constexpr size_t A_CUM = A_CROW + al(SZ_BC);
constexpr size_t A_WJ = A_CUM + al(SZ_DT);
constexpr size_t A_CF = A_WJ + al(SZ_DT);
constexpr size_t SZ_ASSD = A_CF + al(SZ_DT);
constexpr size_t A_V = 0;
constexpr size_t A_HIDM = al(SZ_ACT1), SZ_HIDM = (size_t)NSLOT * DFFE * 2;
constexpr size_t A_YS = A_HIDM + al(SZ_HIDM), SZ_YS = (size_t)NSLOT * D * 2;
constexpr size_t SZ_AMOE = A_YS + al(SZ_YS);
constexpr size_t SZ_ACT = mx(SZ_AEVEN, mx(SZ_ASSD, SZ_AMOE));
constexpr size_t WS_NEED = OFF_ACT + SZ_ACT;

constexpr int CW_BAR = 4096;
constexpr int CW_CNT = 16384;
constexpr int CW_CUR = 16384 + 2 * 8 * 64;

DEV unsigned f2bf(float f) { unsigned u = __builtin_bit_cast(unsigned, f); return (u + 0x7fffu + ((u >> 16) & 1u)) >> 16; }
#ifndef EMU
typedef __bf16 bf16x2n __attribute__((ext_vector_type(2)));
#endif
DEV unsigned pk2(float lo, float hi) {
#ifdef EMU
    return f2bf(lo) | (f2bf(hi) << 16);
#else
    f32x2 v = {lo, hi}; bf16x2n b = __builtin_convertvector(v, bf16x2n); return __builtin_bit_cast(unsigned, b);
#endif
}
DEV unsigned pk4_fp8(float a, float b, float c, float d) {
#ifdef EMU
    return emu_f2fp8(a) | (emu_f2fp8(b) << 8) | (emu_f2fp8(c) << 16) | (emu_f2fp8(d) << 24);
#else
    unsigned w = 0; w = __builtin_amdgcn_cvt_pk_fp8_f32(a, b, w, false); w = __builtin_amdgcn_cvt_pk_fp8_f32(c, d, w, true); return w;
#endif
}
DEV float bf2f(unsigned b) { return __builtin_bit_cast(float, b << 16); }
DEV float bflo(unsigned w) { return __builtin_bit_cast(float, w << 16); }
DEV float bfhi(unsigned w) { return __builtin_bit_cast(float, w & 0xffff0000u); }
#ifdef EMU
DEV float frcp(float x) { return 1.0f / x; }
#else
DEV float frcp(float x) { return __builtin_amdgcn_rcpf(x); }
#endif
#ifdef EMU
DEV float fexp2(float x) { return exp2f(x); }
#else
DEV float fexp2(float x) { return __builtin_amdgcn_exp2f(x); }
#endif
DEV float siluf(float x) { return x * frcp(1.0f + FEXP(-x)); }
#ifdef EMU
DEV float flog2(float x) { return log2f(x); }
#else
DEV float flog2(float x) { return __builtin_amdgcn_logf(x); }
#endif
DEV float softplusf(float x) { if (x > 20.f) return x; const float e = FEXP(x); return e < 0.0625f ? e * (1.0f - e * (0.5f - e * (0.33333334f - e * (0.25f - e * 0.2f)))) : flog2(1.0f + e) * 0.6931471806f; }
DEV float wave_sum(float v) {
#pragma unroll
    for (int o = 1; o < 64; o <<= 1) v += __shfl_xor(v, o);
    return v;
}
DEV int vec_of(int r) { return r < ML ? (r / SEQ) : 2; }
DEV int frag_off(int r, int c) { return ((r >> 4) * 4 + (c >> 5)) * 512 + ((c >> 3) & 3) * 128 + (r & 15) * 8 + (c & 7); }
DEV int row_of(int b, int tv) { return tv < CTXL ? ML + b * CTXL + tv : b * SEQ + (tv - CTXL); }

#define XB_TMO      128
#define XB_XCNT(j)  (256  + 64 * (j))
#define XB_XSUB(j)  (1280 + 64 * (j))
#define XB_XGEN(j)  (2304 + 64 * (j))
#define XB_TOP      3328
#define XB_TOPGEN   3392
#define XCD_BAR_WORDS 3456
#define XB_SPIN_CAP (1u << 22)
DEV unsigned xb_ld(unsigned* p)              { return __hip_atomic_load(p, RLX_AGENT); }
DEV unsigned xb_add(unsigned* p, unsigned v) { return __hip_atomic_fetch_add(p, v, RLX_AGENT); }
#define XB_SPIN(cond, bar) do { unsigned _sp = 0; while (cond) { SLEEP1(); \
    if ((++_sp & 255u) == 0u) { if (xb_ld(&(bar)[XB_TMO])) break; if (_sp > XB_SPIN_CAP) { atomicAdd(&(bar)[XB_TMO], 1u); break; } } } } while (0)
struct XcdBarrier { unsigned* bar; unsigned x; volatile LAS unsigned* st; };
DEV XcdBarrier xcd_barrier_post(unsigned* bar, volatile LAS unsigned* st) {
    XcdBarrier b; b.bar = bar; b.x = MY_XCC_ID(); b.st = st;
    if (threadIdx.x == 0) (void)xb_add(&bar[XB_XCNT(b.x)], 1u);
    return b;
}
DEV void xcd_barrier_complete(unsigned* bar, unsigned x, unsigned& nloc, unsigned& nx) {
    const unsigned G = gridDim.x;
    unsigned sum, cnt, mine, sp = 0u;
    for (;;) {
        sum = 0u; cnt = 0u; mine = 0u;
#pragma unroll
        for (unsigned j = 0; j < 16; ++j) { const unsigned c = xb_ld(&bar[XB_XCNT(j)]); sum += c; cnt += (c > 0u) ? 1u : 0u; mine = (j == x) ? c : mine; }
        if (sum == G) break;
        SLEEP1();
        if ((++sp & 255u) == 0u) { if (xb_ld(&bar[XB_TMO])) break; if (sp > XB_SPIN_CAP) { atomicAdd(&bar[XB_TMO], 1u); break; } }
    }
    nloc = mine > 0u ? mine : 1u; nx = cnt > 0u ? cnt : 1u;
}
DEV void xcd_barrier(const XcdBarrier& b) {
    WAITV(0);
    __syncthreads();
    if (threadIdx.x == 0) {
        unsigned* bar = b.bar;
#ifndef EMU
        __builtin_amdgcn_s_waitcnt(0);
#endif
        unsigned nloc = b.st[0], nx = b.st[1];
        if (nloc == 0u) { xcd_barrier_complete(bar, b.x, nloc, nx); b.st[0] = nloc; b.st[1] = nx; }
        const unsigned old = xb_add(&bar[XB_XSUB(b.x)], 1u);
        const unsigned gen = old / nloc;
        if (old + 1u == (gen + 1u) * nloc) {
            FENCE_REL();
            WAITV(0);
            const unsigned og = xb_add(&bar[XB_TOP], 1u);
            const unsigned tg = og / nx;
            if (og + 1u == (tg + 1u) * nx) xb_add(&bar[XB_TOPGEN], 1u);
            else XB_SPIN(xb_ld(&bar[XB_TOPGEN]) == tg, bar);
            FENCE_ACQ();
            xb_add(&bar[XB_XGEN(b.x)], 1u);
            WAITV(0);
        } else {
            XB_SPIN(xb_ld(&bar[XB_XGEN(b.x)]) == gen, bar);
            FENCE_ACQ();
            WAITV(0);
        }
    }
    __syncthreads();
}

namespace ge {
constexpr int BM = 256, BK = 64, HALF = 128, HTB = HALF * BK * 2, STAGE_BYTES = 8 * HTB, NXCD = 8, WGM = 8;
DEV int lds_byte(int r, int c) { const int st = (r >> 4) * 2 + (c >> 5), rr = r & 15, cc = c & 31, ob = rr * 64 + cc * 2; return st * 1024 + (ob ^ (((ob >> 9) & 1) << 5)); }
DEV void stage_rc(int b, int& R, int& C) { const int st = b / 1024, sb = b % 1024, swz = sb ^ (((sb >> 9) & 1) << 5); R = (st >> 1) * 16 + swz / 64; C = (st & 1) * 32 + (swz % 64) / 2; }
DEV int perm32(int rho) { const int n = rho >> 4, i = rho & 15; return 8 * (i >> 2) + 4 * n + (i & 3); }
struct Unit { int pm, pn; };
DEV bool static_next(int nM, int nN, int G, int c, int i, Unit& u) {
    const int nwg = nM * nN; const long L = (long)i * G + c; if (L >= nwg) return false;
    int wgid = (int)L; { const int q = nwg / NXCD, r = nwg % NXCD, xcd = wgid % NXCD, off = wgid / NXCD; wgid = (xcd < r ? xcd * (q + 1) : r * (q + 1) + (xcd - r) * q) + off; }
    const int nig = WGM * nN, gid = wgid / nig, fm = gid * WGM, gsz = (nM - fm) < WGM ? (nM - fm) : WGM;
    u.pm = fm + ((wgid % nig) % gsz); u.pn = (wgid % nig) / gsz; return true;
}
template <class P, bool SP2 = true>
DEV void gemm_phase(LAS unsigned char* lds, const P& S, const int tid) {
    const int wid = RFL(tid >> 6), lane = tid & 63, wr = wid >> 2, wc = wid & 3, fr = lane & 15, fq = lane >> 4;
    const int K = S.K; int nt = K * P::ES / (BK * 2);
    unsigned voffB[2]; int RA[2], CA2[2];
#pragma unroll
    for (int i = 0; i < 2; ++i) { int R, C; stage_rc(tid * 16 + i * 8192, R, C); const int Rb = P::PERM ? ((R & ~31) + perm32(R & 31)) : R;
        RA[i] = R; CA2[i] = C * 2; voffB[i] = (unsigned)(Rb * S.ldb) * (unsigned)P::ES + (unsigned)(C * 2); }
    const size_t kstep = (size_t)(BK * 2);
    const size_t hstepB = (size_t)HALF * S.ldb * P::ES;
    const unsigned ldsw = (unsigned)wid * 1024u;
    const int aoff = lds_byte(wr * 64 + fr, fq * 8), boff = lds_byte(wc * 32 + fr, fq * 8);
#define GE_SA(b, h) (((b) * 2 + (h)) * HTB)
#define GE_SB(b, h) ((4 + (b) * 2 + (h)) * HTB)
#define GE_STAGEB(bufoff, gbase) do { _Pragma("unroll") for (int _i = 0; _i < 2; ++_i) { unsigned _o = voffB[_i]; LAUNDER_V(_o); \
        GLDS16((const char*)(gbase) + _o, lds + (bufoff) + ldsw + _i * 8192); } } while (0)
#define GE_STAGEA(bufoff, gbase, h) do { _Pragma("unroll") for (int _i = 0; _i < 2; ++_i) { unsigned _o = oA[h][_i]; LAUNDER_V(_o); \
        GLDS16((const char*)(gbase) + _o, lds + (bufoff) + ldsw + _i * 8192); } } while (0)
#define GE_LD1(p_) __builtin_shufflevector(*(const LAS i32x4*)(p_), *(const LAS i32x4*)((p_) + 1024), 0, 1, 2, 3, 4, 5, 6, 7)
#define GE_LDA(dst, b, h) do { _Pragma("unroll") for (int m = 0; m < 4; ++m) dst[m] = GE_LD1(lds + GE_SA(b, h) + aoff + m * 2048); } while (0)
#define GE_LDB(dst, b, h) do { _Pragma("unroll") for (int n = 0; n < 2; ++n) dst[n] = GE_LD1(lds + GE_SB(b, h) + boff + n * 2048); } while (0)
#define GE_LO(x) __builtin_bit_cast(bf16x8, __builtin_shufflevector(x, x, 0, 1, 2, 3))
#define GE_HI(x) __builtin_bit_cast(bf16x8, __builtin_shufflevector(x, x, 4, 5, 6, 7))
#define GE_MMA(ai, bj, At, Bt) do { SETPRIO(1); _Pragma("unroll") for (int m = 0; m < 4; ++m) _Pragma("unroll") for (int n = 0; n < 2; ++n) { \
        if constexpr (P::FP8) acc[ai][bj][m][n] = MFMA8(Bt[n], At[m], acc[ai][bj][m][n]);     \
        else { acc[ai][bj][m][n] = MFMA16(GE_LO(Bt[n]), GE_LO(At[m]), acc[ai][bj][m][n]); acc[ai][bj][m][n] = MFMA16(GE_HI(Bt[n]), GE_HI(At[m]), acc[ai][bj][m][n]); } } SETPRIO(0); } while (0)
    Unit cur, nxt; int ui = 0;
    if (!S.next(0, cur)) return;
    f32x4 acc[2][2][4][2];
#pragma unroll
    for (int a = 0; a < 2; ++a)
#pragma unroll
        for (int b = 0; b < 2; ++b)
#pragma unroll
            for (int m = 0; m < 4; ++m)
#pragma unroll
                for (int n = 0; n < 2; ++n) acc[a][b][m][n] = (f32x4){0.f, 0.f, 0.f, 0.f};
    unsigned oA[2][2];
#pragma unroll
    for (int h = 0; h < 2; ++h)
#pragma unroll
        for (int i = 0; i < 2; ++i) {
            if constexpr (P::GATHER) oA[h][i] = (unsigned)S.gather_row(cur, h * HALF + RA[i]) * (unsigned)(S.lda * P::ES) + (unsigned)CA2[i];
            else oA[h][i] = (unsigned)((h * HALF + RA[i]) * S.lda) * (unsigned)P::ES + (unsigned)CA2[i];
            }
    const char* cA = S.a_base(cur); const char* cB = S.b_base(cur);
    if constexpr (SP2) {
        GE_STAGEB(GE_SB(0, 0), cB); GE_STAGEB(GE_SB(0, 1), cB + hstepB); GE_STAGEA(GE_SA(0, 0), cA, 0); GE_STAGEA(GE_SA(0, 1), cA, 1);
        if (wr == 1) SBAR();
        WAITV(2); SBAR();
        GE_STAGEB(GE_SB(1, 0), cB + kstep); GE_STAGEA(GE_SA(1, 0), cA + kstep, 0); GE_STAGEB(GE_SB(1, 1), cB + hstepB + kstep);
        WAITV(6); SBAR();
    } else {
    GE_STAGEB(GE_SB(0, 0), cB); GE_STAGEA(GE_SA(0, 0), cA, 0); GE_STAGEB(GE_SB(0, 1), cB + hstepB); GE_STAGEA(GE_SA(0, 1), cA, 1);
    if (wr == 1) SBAR();
    WAITV(4); SBAR();
    GE_STAGEB(GE_SB(1, 0), cB + kstep); GE_STAGEA(GE_SA(1, 0), cA + kstep, 0); GE_STAGEB(GE_SB(1, 1), cB + hstepB + kstep);
    WAITV(6); SBAR();
    }
    for (;;) {
        if constexpr (P::VARK) nt = S.unit_nt(cur);
        const bool has_next = S.next(ui + 1, nxt);
        const char* nA = has_next ? S.a_base(nxt) : cA; const char* nB = has_next ? S.b_base(nxt) : cB;
        for (int t = 0; t < nt; t += 2) {
            const bool last = (t == nt - 2);
            const char* a1 = cA + (size_t)(t + 1) * kstep;
            const char* a2 = last ? nA : cA + (size_t)(t + 2) * kstep; const char* b2 = last ? nB : cB + (size_t)(t + 2) * kstep;
            const char* a3 = a2 + kstep; const char* b3 = b2 + kstep;
            i32x8 At[4], B0[2], B1[2];
            if constexpr (SP2) {
            GE_LDB(B0, 0, 0); GE_LDB(B1, 0, 1); SCHED(); GE_LDA(At, 0, 0); GE_STAGEA(GE_SA(1, 1), a1, 1);
            WAITV(8); WAITL(0); SBAR(); GE_MMA(0, 0, At, B0); GE_MMA(0, 1, At, B1); SBAR(); SCHED();
            if constexpr (P::GATHER) { if (last && has_next) {
#pragma unroll
                for (int i = 0; i < 2; ++i) { int R2, C2; stage_rc(tid * 16 + i * 8192, R2, C2);
#pragma unroll
                    for (int h = 0; h < 2; ++h) oA[h][i] = (unsigned)S.gather_row(nxt, h * HALF + R2) * (unsigned)(S.lda * P::ES) + (unsigned)(C2 * 2); } } }
            GE_LDA(At, 0, 1); GE_STAGEB(GE_SB(0, 0), b2); GE_STAGEB(GE_SB(0, 1), b2 + hstepB); GE_STAGEA(GE_SA(0, 0), a2, 0);
            WAITV(8); WAITL(0); SBAR(); GE_MMA(1, 0, At, B0); GE_MMA(1, 1, At, B1); SBAR(); SCHED();
            GE_LDB(B0, 1, 0); GE_LDB(B1, 1, 1); SCHED(); GE_LDA(At, 1, 0); GE_STAGEA(GE_SA(0, 1), a2, 1);
            WAITV(8); WAITL(0); SBAR(); GE_MMA(0, 0, At, B0); GE_MMA(0, 1, At, B1); SBAR(); SCHED();
            GE_LDA(At, 1, 1); GE_STAGEB(GE_SB(1, 0), b3); GE_STAGEB(GE_SB(1, 1), b3 + hstepB); GE_STAGEA(GE_SA(1, 0), a3, 0);
            WAITV(8); WAITL(0); SBAR(); GE_MMA(1, 0, At, B0); GE_MMA(1, 1, At, B1); SBAR(); SCHED();
            } else {
            GE_LDB(B0, 0, 0); SCHED(); GE_LDA(At, 0, 0); GE_STAGEA(GE_SA(1, 1), a1, 1);
            WAITL(8); SBAR(); WAITL(0); GE_MMA(0, 0, At, B0); SBAR(); SCHED();
            if constexpr (P::GATHER) { if (last && has_next) {
#pragma unroll
                for (int i = 0; i < 2; ++i) { int R2, C2; stage_rc(tid * 16 + i * 8192, R2, C2);
#pragma unroll
                    for (int h = 0; h < 2; ++h) oA[h][i] = (unsigned)S.gather_row(nxt, h * HALF + R2) * (unsigned)(S.lda * P::ES) + (unsigned)(C2 * 2); } } }
            GE_LDB(B1, 0, 1); GE_STAGEB(GE_SB(0, 0), b2);
            SBAR(); WAITL(0); GE_MMA(0, 1, At, B1); SBAR();
            GE_LDA(At, 0, 1); GE_STAGEA(GE_SA(0, 0), a2, 0);
            SBAR(); WAITL(0); GE_MMA(1, 0, At, B0); SBAR(); SCHED();
            GE_STAGEB(GE_SB(0, 1), b2 + hstepB);
            WAITV(6); SBAR(); GE_MMA(1, 1, At, B1); SBAR();
            GE_LDB(B0, 1, 0); SCHED(); GE_LDA(At, 1, 0); GE_STAGEA(GE_SA(0, 1), a2, 1);
            WAITL(8); SBAR(); WAITL(0); GE_MMA(0, 0, At, B0); SBAR(); SCHED();
            GE_LDB(B1, 1, 1); GE_STAGEB(GE_SB(1, 0), b3);
            SBAR(); WAITL(0); GE_MMA(0, 1, At, B1); SBAR();
            GE_LDA(At, 1, 1); GE_STAGEA(GE_SA(1, 0), a3, 0);
            SBAR(); WAITL(0); GE_MMA(1, 0, At, B0); SBAR(); SCHED();
            GE_STAGEB(GE_SB(1, 1), b3 + hstepB);
            WAITV(6); SBAR(); GE_MMA(1, 1, At, B1); SBAR();
            }
        }
        if (wr == 0) SBAR();
        S.epi(acc, cur, wr, wc, fr, fq);
        if (!has_next) break;
#pragma unroll
        for (int a = 0; a < 2; ++a)
#pragma unroll
            for (int b = 0; b < 2; ++b)
#pragma unroll
                for (int m = 0; m < 4; ++m)
#pragma unroll
                    for (int n = 0; n < 2; ++n) acc[a][b][m][n] = (f32x4){0.f, 0.f, 0.f, 0.f};
        cur = nxt; cA = nA; cB = nB; ++ui;
        if (wr == 1) SBAR();
    }
    WAITV(0);
    SBAR();
#undef GE_SA
#undef GE_SB
#undef GE_STAGEA
#undef GE_STAGEB
#undef GE_LDA
#undef GE_LDB
#undef GE_MMA
#undef GE_LO
#undef GE_HI
#undef GE_LD1
}
}
using ge::Unit;

struct Params {
    const float* in[26];
    float* out; unsigned char* ws;
    int ph_lo, ph_hi;
};
enum { I_X = 0, I_C, I_CTX, I_CCTX, I_ADAW, I_ADAB, I_NMIX, I_NFFN, I_POOLW, I_POOLS, I_INW, I_CONVW, I_CONVB, I_ALOG, I_DTB, I_DSKIP, I_SNORM, I_OUTW,
       I_W1, I_W3, I_W2, I_RW, I_MW1, I_MW3, I_MW2, I_FNORM };

struct Frame {
    LAS unsigned char* lds;
    int tid, lane, wave, G, bx;
    const Params* p;
    unsigned char* ws;
    unsigned* ctl;
    float* H; float* mod;
};
#ifdef EMU
DEV const float* INP(const Frame& F, int i) { return F.p->in[i]; }
DEV float* OUTP(const Frame& F) { return F.p->out; }
DEV unsigned char* WSP(const Frame& F) { return F.p->ws; }
#define LAUNDER_S(x) ((void)0)
#else
typedef const float* cfptr_t;
DEV const float* INP(const Frame&, int i) { int k = i; asm volatile("" : "+s"(k)); return ((const __attribute__((address_space(4))) cfptr_t*)__builtin_amdgcn_kernarg_segment_ptr())[k]; }
DEV float* OUTP(const Frame& F) { return (float*)INP(F, 26); }
DEV unsigned char* WSP(const Frame& F) { return (unsigned char*)INP(F, 27); }
#define LAUNDER_S(x) asm volatile("" : "+s"(x))
#endif
constexpr int LDS_MISC = ge::STAGE_BYTES;
constexpr int LDS_BYTES = ge::STAGE_BYTES + 16384;

struct Src { const float* x; const float* ctx; float* H; const float* mod; };
DEV const float* modq(const float* mod, int layer, int vec, int which) { return mod + ((size_t)(layer * 3 + vec) * 6 + which) * D; }
DEV const float* modp(const Frame& F, int layer, int vec, int which) { return modq(F.mod, layer, vec, which); }
DEV const float* hsrc_row(const Src& s, bool from_input, int r) {
    if (from_input) return r < ML ? s.x + (size_t)r * D : s.ctx + (size_t)(r - ML) * D;
    return s.H + (size_t)r * D;
}
DEV Src mksrc(const Frame& F) { Src s; s.x = INP(F, I_X); s.ctx = INP(F, I_CTX); s.H = F.H; s.mod = F.mod; return s; }
DEV const float* hin_row(const Frame& F, int layer, int r) { return hsrc_row(mksrc(F), layer == 0, r); }

struct RmId { DEV int operator()(int n0) const { return n0; } };
struct RmIlv { int s; DEV int operator()(int n0) const { return (n0 >> 7) * 256 + s * 128 + (n0 & 127); } };
template <int K, int N, bool F8, class RM>
DEV void convert_job_t(const Frame& F, const float* Wsrc, void* WTv, int ldt, RM rowmap, float scale) {
    LAS float* scr = (LAS float*)(F.lds + F.wave * 16384);
    constexpr int items = (K / 64) * (N / 32), nblk = N / 32; const int gw = F.bx * 8 + F.wave, NGW = F.G * 8, lane = F.lane;
    float nx[32];
#define CJ_LOAD(it_) do { const int _kb = (it_) / nblk, _nb = (it_) % nblk; const float* _p = Wsrc + (size_t)(64 * _kb + (lane >> 5)) * N + 32 * _nb + (lane & 31); \
        _Pragma("unroll") for (int i = 0; i < 32; ++i) nx[i] = _p[(size_t)(2 * i) * N]; } while (0)
    if (gw < items) CJ_LOAD(gw);
    for (int it = gw; it < items; it += NGW) {
        const int kb = it / nblk, nb = it % nblk, k0 = 64 * kb, n0 = 32 * nb;
#pragma unroll
        for (int i = 0; i < 32; ++i) { const int kk = 2 * i + (lane >> 5); scr[kk * 33 + (lane & 31)] = F8 ? nx[i] * scale : nx[i]; }
        if (it + NGW < items) CJ_LOAD(it + NGW);
        WSYNC();
        const int c = lane & 7; const int row0 = rowmap(n0);
#pragma unroll
        for (int j = 0; j < 4; ++j) { const int n = (lane >> 3) + 8 * j; const LAS float* sp = scr + (8 * c) * 33 + n;
            if (F8) { u32x2 o; o.x = pk4_fp8(sp[0 * 33], sp[1 * 33], sp[2 * 33], sp[3 * 33]); o.y = pk4_fp8(sp[4 * 33], sp[5 * 33], sp[6 * 33], sp[7 * 33]);
                *(u32x2*)((fp8_t*)WTv + (size_t)(row0 + n) * ldt + k0 + 8 * c) = o; }
            else { u32x4 o; o.x = pk2(sp[0 * 33], sp[1 * 33]); o.y = pk2(sp[2 * 33], sp[3 * 33]); o.z = pk2(sp[4 * 33], sp[5 * 33]); o.w = pk2(sp[6 * 33], sp[7 * 33]);
                *(u32x4*)((bf16_t*)WTv + (size_t)(row0 + n) * ldt + k0 + 8 * c) = o; } }
        WSYNC();
    }
#undef CJ_LOAD
}
template <int K, int N, class RM> DEV void convert_job(const Frame& F, const float* Wsrc, bf16_t* WT, int ldt, RM rm) { convert_job_t<K, N, false>(F, Wsrc, WT, ldt, rm, 1.0f); }
template <int K, int N, class RM> DEV void convert_job_fp8(const Frame& F, const float* Wsrc, fp8_t* WT, int ldt, RM rm, float scale) { convert_job_t<K, N, true>(F, Wsrc, WT, ldt, rm, scale); }
DEV bool idle_subgrid(Frame& F2, int nwg) { const int rem = nwg % F2.G; if (rem == 0) return true; if (F2.bx < rem) return false; F2.bx -= rem; F2.G -= rem; return true; }
DEV void convert_even(const Frame& F, int j) {
    bf16_t* Wb = (bf16_t*)(F.ws + OFF_W);
    for (int g = 0; g < 4; ++g) convert_job<256, 256>(F, INP(F, I_POOLW) + ((size_t)j * 4 + g) * 65536, Wb + W_POOL / 2 + (size_t)g * 65536, 256, RmId{});
    convert_job<D, DFF>(F, INP(F, I_W1) + (size_t)j * D * DFF, Wb + W_UP / 2, D, RmIlv{0});
    convert_job<D, DFF>(F, INP(F, I_W3) + (size_t)j * D * DFF, Wb + W_UP / 2, D, RmIlv{1});
    convert_job<DFF, D>(F, INP(F, I_W2) + (size_t)j * DFF * D, Wb + W_DN / 2, DFF, RmId{});
}
DEV void convert_ssd(const Frame& F, int j) {
    bf16_t* Wb = (bf16_t*)(F.ws + OFF_W);
    convert_job<D, NPROJ>(F, INP(F, I_INW) + (size_t)j * D * NPROJ, Wb + W_IN / 2, D, RmId{});
    convert_job<DIN, D>(F, INP(F, I_OUTW) + (size_t)j * DIN * D, Wb + W_OUT / 2, DIN, RmId{});
    { u32x4* z = (u32x4*)(Wb + W_IN / 2 + (size_t)NPROJ * D); const int n16 = (NPROJP - NPROJ) * D * 2 / 16;
      unsigned zz = 0u; LAUNDER_V(zz);
      for (int i = F.bx * 512 + F.tid; i < n16; i += F.G * 512) z[i] = (u32x4){zz, zz, zz, zz}; }
}
DEV void convert_moe(const Frame& F, int j, bool up, bool down) {
    fp8_t* Wb = (fp8_t*)(F.ws + OFF_W);
    for (int e = 0; e < NEXP; ++e) {
        if (up) {
        convert_job_fp8<D, DFFE>(F, INP(F, I_MW1) + ((size_t)j * NEXP + e) * D * DFFE, Wb + W_MUP + (size_t)e * 2 * DFFE * D, D, RmIlv{0}, 32.0f);
        convert_job_fp8<D, DFFE>(F, INP(F, I_MW3) + ((size_t)j * NEXP + e) * D * DFFE, Wb + W_MUP + (size_t)e * 2 * DFFE * D, D, RmIlv{1}, 32.0f); }
        if (!down) continue;
        if (MOE_DOWN_FP8) convert_job_fp8<DFFE, D>(F, INP(F, I_MW2) + ((size_t)j * NEXP + e) * DFFE * D, Wb + W_MDN + (size_t)e * D * DFFE, DFFE, RmId{}, 64.0f);
        else convert_job<DFFE, D>(F, INP(F, I_MW2) + ((size_t)j * NEXP + e) * DFFE * D, (bf16_t*)(Wb + W_MDN) + (size_t)e * D * DFFE, DFFE, RmId{});
    }
}

DEV void phase_mod(const Frame& F) {
    LAS float* red = (LAS float*)F.lds;
    LAS float* sc = (LAS float*)(F.lds + 8192);
    constexpr int nblk = DEPTH * 6144 / 32;
    const int col = F.tid & 31, ks = F.tid >> 5;
    for (int i = F.tid; i < 3 * D; i += 512) { const int v = i >> 10, k = i & (D - 1); sc[i] = siluf(v == 2 ? INP(F, I_CCTX)[k] : INP(F, I_C)[v * D + k]); }
    __syncthreads();
    for (int blk = F.bx; blk < nblk; blk += F.G) {
        const int layer = (blk * 32) / 6144, n = (blk * 32) % 6144 + col;
        const float* W = INP(F, I_ADAW) + (size_t)layer * D * 6144 + n;
        float a0 = 0.f, a1 = 0.f, a2 = 0.f;
#pragma unroll 1
        for (int kb = ks * 64; kb < ks * 64 + 64; kb += 16) {
            float wv[16];
#pragma unroll
            for (int k = 0; k < 16; ++k) wv[k] = W[(size_t)(kb + k) * 6144];
#pragma unroll
            for (int k = 0; k < 16; ++k) { a0 += sc[kb + k] * wv[k]; a1 += sc[D + kb + k] * wv[k]; a2 += sc[2 * D + kb + k] * wv[k]; } }
        red[(ks * 32 + col) * 3 + 0] = a0; red[(ks * 32 + col) * 3 + 1] = a1; red[(ks * 32 + col) * 3 + 2] = a2;
        __syncthreads();
        if (F.tid < 96) { const int c2 = F.tid & 31, v = F.tid >> 5; float s = 0.f;
            for (int q = 0; q < 16; ++q) s += red[(q * 32 + c2) * 3 + v];
            const int n2 = (blk * 32) % 6144 + c2;
            F.mod[(size_t)(layer * 3 + v) * 6144 + n2] = s + INP(F, I_ADAB)[(size_t)layer * 6144 + n2]; }
        __syncthreads();
    }
}

DEV void load_row(const float* p, int lane, f32x4 (&v)[4]) {
#pragma unroll
    for (int j = 0; j < 4; ++j) v[j] = *(const f32x4*)(p + 4 * lane + 256 * j);
}
DEV float sumsq_row(const f32x4 (&v)[4]) { float s = 0.f;
#pragma unroll
    for (int j = 0; j < 4; ++j) s += (v[j][0] * v[j][0] + v[j][1] * v[j][1]) + (v[j][2] * v[j][2] + v[j][3] * v[j][3]);
    return wave_sum(s); }
DEV void normmod_row(f32x4 (&v)[4], float rstd, const float* w, const float* sh, const float* sc, int lane) {
#pragma unroll
    for (int j = 0; j < 4; ++j) { const int c = 4 * lane + 256 * j; const f32x4 wv = *(const f32x4*)(w + c), sv = *(const f32x4*)(sh + c), cv = *(const f32x4*)(sc + c);
        v[j] = v[j] * rstd * wv * (cv + 1.0f) + sv; }
}
DEV void store_row_bf16(bf16_t* o, int lane, const f32x4 (&v)[4]) {
#pragma unroll
    for (int j = 0; j < 4; ++j) { u32x2 w; w.x = pk2(v[j][0], v[j][1]); w.y = pk2(v[j][2], v[j][3]); *(u32x2*)(o + 4 * lane + 256 * j) = w; }
}

struct CtxFix { const float* PART; int S, layer, which; const float* scale; bool from_input; };
DEV void phase_norm(const Frame& F, int layer, int which, bf16_t* out, bool from_input, const CtxFix fx) {
    const int gw = F.bx * 8 + F.wave, NGW = F.G * 8;
    const float* w = INP(F, which == 0 ? I_NMIX : I_NFFN) + (size_t)layer * D;
    const int nrows = fx.PART ? ML : MT;
    constexpr int NS = 3;
    f32x4 ns[NS][4];
#pragma unroll
    for (int k = 0; k < NS; ++k) if (gw + k * NGW < nrows) load_row(hsrc_row(mksrc(F), from_input, gw + k * NGW), F.lane, ns[k]);
    for (int r0 = gw; r0 < nrows; r0 += NS * NGW) {
#pragma unroll
        for (int k = 0; k < NS; ++k) { const int r = r0 + k * NGW; if (r >= nrows) break;
            f32x4 v[4];
#pragma unroll
            for (int q = 0; q < 4; ++q) v[q] = ns[k][q];
            if (r + NS * NGW < nrows) load_row(hsrc_row(mksrc(F), from_input, r + NS * NGW), F.lane, ns[k]);
            const float rstd = rsqrtf(sumsq_row(v) * (1.0f / D) + EPS);
            const int vec = vec_of(r);
            normmod_row(v, rstd, w, modp(F, layer, vec, which), modp(F, layer, vec, which + 1), F.lane);
            store_row_bf16(out + (size_t)r * D, F.lane, v); }
    }
    if (fx.PART) {
        const Src src = mksrc(F); const float* gp = modq(src.mod, fx.layer, 2, fx.which);
        for (int r = ML + gw; r < MT; r += NGW) {
            f32x4 v[4], y[4], g[4];
            load_row(hsrc_row(src, fx.from_input, r), F.lane, v); load_row(gp, F.lane, g);
            if (fx.scale) { f32x4 sc[4]; load_row(fx.scale, F.lane, sc);
#pragma unroll
                for (int q = 0; q < 4; ++q) g[q] = g[q] * sc[q]; }
#pragma unroll
            for (int q = 0; q < 4; ++q) y[q] = (f32x4){0.f, 0.f, 0.f, 0.f};
            int sl = 0;
            for (; sl + 2 <= fx.S; sl += 2) { f32x4 t0[4], t1[4];
                load_row(fx.PART + ((size_t)sl * MC + (r - ML)) * D, F.lane, t0); load_row(fx.PART + ((size_t)(sl + 1) * MC + (r - ML)) * D, F.lane, t1);
#pragma unroll
                for (int q = 0; q < 4; ++q) { y[q] += t0[q]; y[q] += t1[q]; } }
            for (; sl < fx.S; ++sl) { f32x4 t0[4]; load_row(fx.PART + ((size_t)sl * MC + (r - ML)) * D, F.lane, t0);
#pragma unroll
                for (int q = 0; q < 4; ++q) y[q] += t0[q]; }
#pragma unroll
            for (int q = 0; q < 4; ++q) { v[q] = v[q] + g[q] * y[q]; *(f32x4*)(src.H + (size_t)r * D + 4 * F.lane + 256 * q) = v[q]; }
            const float rstd = rsqrtf(sumsq_row(v) * (1.0f / D) + EPS);
            normmod_row(v, rstd, w, modp(F, layer, 2, which), modp(F, layer, 2, which + 1), F.lane);
            store_row_bf16(out + (size_t)r * D, F.lane, v); }
    }
}

struct TokInfo { int s0, s1; float g0, g1; };
DEV void phase_poolprep(const Frame& F, int layer, bf16_t* P, bool fuse, const bf16_t* YS) {
    const TokInfo* tok = (const TokInfo*)(F.ws + OFF_TOK);
    LAS bf16_t* ub = (LAS bf16_t*)(F.lds);
    LAS float* rs = (LAS float*)(F.lds + 81920);
    const float* w = INP(F, I_NMIX) + (size_t)layer * D;
    constexpr int CTH = 4, NLT = ML / 64; const int ntile = NLT + MC / CTH;
    const int chunk = F.tid & 127, tg = F.tid >> 7;
    for (int tile = F.bx; tile < ntile; tile += F.G) {
        const int r0 = tile < NLT ? tile * 64 : ML + (tile - NLT) * CTH; const int th = tile < NLT ? 64 : CTH;
        if (r0 < ML) {
            LAS bf16_t* ul = (LAS bf16_t*)(F.lds);
            const int vec = vec_of(r0);
            { f32x4 wc[4], sv[4], g2[4];
#pragma unroll
              for (int jq = 0; jq < 4; ++jq) { const int c = 4 * F.lane + 256 * jq; wc[jq] = *(const f32x4*)(w + c) * (*(const f32x4*)(modp(F, layer, vec, 1) + c) + 1.0f); sv[jq] = *(const f32x4*)(modp(F, layer, vec, 0) + c);
                  g2[jq] = fuse ? *(const f32x4*)(modp(F, layer - 1, vec, 5) + c) * (MOE_DOWN_FP8 ? 0.00390625f : 1.0f) : (f32x4){0.f, 0.f, 0.f, 0.f}; }
              f32x4 nh[4]; u32x2 nya[4], nyb[4]; TokInfo tn; tn.s0 = tn.s1 = 0; tn.g0 = tn.g1 = 0.f;
              { const int r = r0 + F.wave; load_row(hin_row(F, layer, r), F.lane, nh);
                if (fuse) { tn = tok[r];
#pragma unroll
                    for (int jq = 0; jq < 4; ++jq) { const int c = 4 * F.lane + 256 * jq; nya[jq] = *(const u32x2*)(YS + (size_t)tn.s0 * D + c); nyb[jq] = *(const u32x2*)(YS + (size_t)tn.s1 * D + c); } } }
#pragma unroll 1
              for (int k = 0; k < 8; ++k) { const int rl = F.wave + 8 * k, r = r0 + rl;
                  f32x4 v[4]; u32x2 ya[4], yb[4]; const TokInfo ti = tn;
#pragma unroll
                  for (int q = 0; q < 4; ++q) { v[q] = nh[q]; ya[q] = nya[q]; yb[q] = nyb[q]; }
                  if (k < 7) { load_row(hin_row(F, layer, r + 8), F.lane, nh);
                      if (fuse) { tn = tok[r + 8];
#pragma unroll
                          for (int jq = 0; jq < 4; ++jq) { const int c = 4 * F.lane + 256 * jq; nya[jq] = *(const u32x2*)(YS + (size_t)tn.s0 * D + c); nyb[jq] = *(const u32x2*)(YS + (size_t)tn.s1 * D + c); } } }
                  if (fuse) {
#pragma unroll
                      for (int jq = 0; jq < 4; ++jq) { const u32x2 a = ya[jq], b = yb[jq];
                          v[jq][0] += g2[jq][0] * (ti.g0 * bflo(a.x) + ti.g1 * bflo(b.x)); v[jq][1] += g2[jq][1] * (ti.g0 * bfhi(a.x) + ti.g1 * bfhi(b.x));
                          v[jq][2] += g2[jq][2] * (ti.g0 * bflo(a.y) + ti.g1 * bflo(b.y)); v[jq][3] += g2[jq][3] * (ti.g0 * bfhi(a.y) + ti.g1 * bfhi(b.y));
                          *(f32x4*)(F.H + (size_t)r * D + 4 * F.lane + 256 * jq) = v[jq]; } }
                  const float rstd = rsqrtf(sumsq_row(v) * (1.0f / D) + EPS);
#pragma unroll
                  for (int jq = 0; jq < 4; ++jq) { const f32x4 u = v[jq] * rstd * wc[jq] + sv[jq]; u32x2 pw; pw.x = pk2(u[0], u[1]); pw.y = pk2(u[2], u[3]);
                      *(LAS u32x2*)(ul + rl * 1024 + 4 * F.lane + 256 * jq) = pw; } } }
            __syncthreads();
            { const int cq = F.tid & 255, hf = F.tid >> 8, c = cq * 4, g = c >> 8, win = 2 << g, lo = win >> 1, hi = win - 1 - lo;
#define PL_U(t_) ({ const u32x2 _q = *(const LAS u32x2*)(ul + (t_) * 1024 + c); (f32x4){bflo(_q.x), bfhi(_q.x), bflo(_q.y), bfhi(_q.y)}; })
              const int ta = 32 * hf;
              f32x4 sacc = (f32x4){0.f, 0.f, 0.f, 0.f};
              { const int a = (ta - lo > 0) ? ta - lo : 0, b = (ta + hi + 1 < 64) ? ta + hi + 1 : 64; for (int t = a; t < b; ++t) sacc += PL_U(t); }
              for (int t = ta; t < ta + 32; ++t) {
                  const int a = (t - lo > 0) ? t - lo : 0, b = (t + hi + 1 < 64) ? t + hi + 1 : 64;
                  const float inv = 1.0f / (float)(b - a);
                  const f32x4 o = sacc * inv - PL_U(t);
                  u32x2 pw; pw.x = pk2(o[0], o[1]); pw.y = pk2(o[2], o[3]); *(u32x2*)(P + (size_t)(r0 + t) * D + c) = pw;
                  if (t + 1 < ta + 32) { if (t + 1 + hi < 64) sacc += PL_U(t + 1 + hi); if (t - lo >= 0) sacc -= PL_U(t - lo); } }
#undef PL_U
            }
            __syncthreads();
            continue;
        }
        int seq0, seq1;
        if (r0 < ML) { seq0 = r0; seq1 = r0 + 64; } else { seq0 = ML + ((r0 - ML) / CTXL) * CTXL; seq1 = seq0 + CTXL; }
        const int lo_r = (r0 - 8 > seq0) ? r0 - 8 : seq0, hi_r = (r0 + th + 7 < seq1) ? r0 + th + 7 : seq1;
        const int nrow = hi_r - lo_r;
        for (int rb = lo_r + F.wave; rb < hi_r; rb += 16) {
            f32x4 v5[2][4];
#pragma unroll
            for (int k = 0; k < 2; ++k) { const int r = rb + 8 * k; if (r < hi_r) load_row(hin_row(F, layer, r), F.lane, v5[k]); }
#pragma unroll
            for (int k = 0; k < 2; ++k) { const int r = rb + 8 * k; if (r < hi_r) { const float ss = sumsq_row(v5[k]); if (F.lane == 0) rs[r - lo_r] = rsqrtf(ss * (1.0f / D) + EPS); } } }
        __syncthreads();
        const int vec = vec_of(r0);
#pragma unroll 1
        for (int half = 0; half < 2; ++half) {
            const int c = half * 512 + 4 * chunk, g = c >> 8, win = 2 << g, lo = win >> 1, hi = win - 1 - lo;
            const f32x4 wv = *(const f32x4*)(w + c), sv = *(const f32x4*)(modp(F, layer, vec, 0) + c), cv = *(const f32x4*)(modp(F, layer, vec, 1) + c) + 1.0f;
            const f32x4 wc = wv * cv;
#pragma unroll 1
            for (int kb = 0; kb < 20; kb += 5) {
                f32x4 hv[5];
#pragma unroll
                for (int k = 0; k < 5; ++k) { const int rr = tg + 4 * (kb + k); if (rr < nrow) hv[k] = *(const f32x4*)(hin_row(F, layer, lo_r + rr) + c); }
#pragma unroll
                for (int k = 0; k < 5; ++k) { const int rr = tg + 4 * (kb + k); if (rr < nrow) { const f32x4 u = hv[k] * rs[rr] * wc + sv;
                    u32x2 pw; pw.x = pk2(u[0], u[1]); pw.y = pk2(u[2], u[3]); *(LAS u32x2*)(ub + rr * 512 + 4 * chunk) = pw; } } }
            __syncthreads();
#define PP_U(r_) ({ const u32x2 _q = *(const LAS u32x2*)(ub + ((r_) - lo_r) * 512 + 4 * chunk); (f32x4){bflo(_q.x), bfhi(_q.x), bflo(_q.y), bfhi(_q.y)}; })
            const int tq = th >> 2, ta = r0 + tq * tg;
            f32x4 s = (f32x4){0.f, 0.f, 0.f, 0.f};
            { const int a = (ta - lo > seq0) ? ta - lo : seq0, b = (ta + hi + 1 < seq1) ? ta + hi + 1 : seq1; for (int r = a; r < b; ++r) s += PP_U(r); }
            for (int t = ta; t < ta + tq; ++t) {
                const int a = (t - lo > seq0) ? t - lo : seq0, b = (t + hi + 1 < seq1) ? t + hi + 1 : seq1;
                const float inv = 1.0f / (float)(b - a);
                const f32x4 o = s * inv - PP_U(t);
                u32x2 pw; pw.x = pk2(o[0], o[1]); pw.y = pk2(o[2], o[3]); *(u32x2*)(P + (size_t)t * D + c) = pw;
                if (t + 1 < ta + tq) {
                    if (t + 1 + hi < seq1) s += PP_U(t + 1 + hi);
                    if (t - lo >= seq0) s -= PP_U(t - lo); }
            }
#undef PP_U
            __syncthreads();
        }
    }
}

struct PolBase { int G, c; static constexpr bool VARK = false; };
DEV bool ctx_next(int npan, int nsl, int G, int c, int i, Unit& u) {
    const int nmain = npan * 4; const long L = (long)i * G + c;
    if (L < nmain) return ge::static_next(npan, 4, G, c, i, u);
    const long L2 = L - nmain; if (L2 >= 8L * nsl) return false;
    const int t = (int)(L2 & 7); u.pm = ML / 256 + (t >> 2); u.pn = (t & 3) + 4 * (1 + (int)(L2 >> 3)); return true;
}
DEV int ctx_koff(const Unit& u) { return (u.pn >> 2) ? ((u.pn >> 2) - 1) * 128 : 0; }
DEV void ctx_store(float* PART, const f32x4 (&acc)[2][2][4][2], const Unit& u, int wr, int wc, int fr, int fq) {
    float* o = PART + ((size_t)((u.pn >> 2) - 1) * MC + (u.pm * 256 - ML) + wr * 64 + fr) * D + (u.pn & 3) * 256 + wc * 32 + 4 * fq;
#pragma unroll
    for (int ai = 0; ai < 2; ++ai)
#pragma unroll
        for (int m = 0; m < 4; ++m)
#pragma unroll
            for (int bj = 0; bj < 2; ++bj)
#pragma unroll
                for (int n = 0; n < 2; ++n) *(f32x4*)(o + (size_t)(ai * 128 + m * 16) * D + bj * 128 + n * 16) = acc[ai][bj][m][n];
}
struct PolPool : PolBase {
    static constexpr bool PERM = false, GATHER = false; static constexpr bool FP8 = false; static constexpr int ES = 2; int K, lda, ldb;
    static constexpr bool VARK = true;
    const bf16_t* P; const bf16_t* W; Src src; int layer, npan; const float* scale; float* PART;
    DEV bool next(int i, Unit& u) const { return ctx_next(npan, 2, G, c, i, u); }
    DEV int unit_nt(const Unit& u) const { return (u.pn >> 2) ? 2 : 4; }
    DEV const char* a_base(const Unit& u) const { return (const char*)(P + (size_t)u.pm * 256 * D + (u.pn & 3) * 256 + ctx_koff(u)); }
    DEV const char* b_base(const Unit& u) const { return (const char*)(W + (size_t)(u.pn & 3) * 65536 + ctx_koff(u)); }
    DEV void epi(const f32x4 (&acc)[2][2][4][2], const Unit& u, int wr, int wc, int fr, int fq) const {
        if (u.pn >> 2) { ctx_store(PART, acc, u, wr, wc, fr, fq); return; }
        const int row0 = u.pm * 256 + wr * 64 + fr, col0 = u.pn * 256 + wc * 32 + 4 * fq; const int vec = vec_of(u.pm * 256);
        const float* g1 = modq(src.mod, layer, vec, 2);
        f32x4 gv[2][2];
#pragma unroll
        for (int bj = 0; bj < 2; ++bj)
#pragma unroll
            for (int n = 0; n < 2; ++n) { const int cc = col0 + bj * 128 + n * 16; gv[bj][n] = *(const f32x4*)(g1 + cc) * *(const f32x4*)(scale + cc); }
#pragma unroll
        for (int ai = 0; ai < 2; ++ai)
#pragma unroll
            for (int mp = 0; mp < 4; mp += 2) { f32x4 hv[2][2][2];
#pragma unroll
                for (int m2 = 0; m2 < 2; ++m2) { const float* hi = hsrc_row(src, layer == 0, row0 + ai * 128 + (mp + m2) * 16) + col0;
#pragma unroll
                    for (int bj = 0; bj < 2; ++bj)
#pragma unroll
                        for (int n = 0; n < 2; ++n) hv[m2][bj][n] = *(const f32x4*)(hi + bj * 128 + n * 16); }
#pragma unroll
                for (int m2 = 0; m2 < 2; ++m2) { float* ho = src.H + (size_t)(row0 + ai * 128 + (mp + m2) * 16) * D + col0;
#pragma unroll
                    for (int bj = 0; bj < 2; ++bj)
#pragma unroll
                        for (int n = 0; n < 2; ++n) *(f32x4*)(ho + bj * 128 + n * 16) = hv[m2][bj][n] + gv[bj][n] * acc[ai][bj][mp + m2][n]; } }
    }
};
struct PolResid : PolBase {
    static constexpr bool PERM = false, GATHER = false; static constexpr bool FP8 = false; static constexpr int ES = 2; int K, lda, ldb;
    static constexpr bool VARK = true;
    const bf16_t* A; const bf16_t* W; Src src; int layer, which, npan, nsl; float* PART;
    DEV bool next(int i, Unit& u) const { return ctx_next(npan, nsl, G, c, i, u); }
    DEV int unit_nt(const Unit& u) const { return (u.pn >> 2) ? 2 : K / 64; }
    DEV const char* a_base(const Unit& u) const { return (const char*)(A + (size_t)u.pm * 256 * lda + ctx_koff(u)); }
    DEV const char* b_base(const Unit& u) const { return (const char*)(W + (size_t)(u.pn & 3) * 256 * ldb + ctx_koff(u)); }
    DEV void epi(const f32x4 (&acc)[2][2][4][2], const Unit& u, int wr, int wc, int fr, int fq) const {
        if (u.pn >> 2) { ctx_store(PART, acc, u, wr, wc, fr, fq); return; }
        const int row0 = u.pm * 256 + wr * 64 + fr, col0 = u.pn * 256 + wc * 32 + 4 * fq; const int vec = vec_of(u.pm * 256);
        const float* gp = modq(src.mod, layer, vec, which);
        f32x4 gv[2][2];
#pragma unroll
        for (int bj = 0; bj < 2; ++bj)
#pragma unroll
            for (int n = 0; n < 2; ++n) gv[bj][n] = *(const f32x4*)(gp + col0 + bj * 128 + n * 16);
#pragma unroll
        for (int ai = 0; ai < 2; ++ai)
#pragma unroll
            for (int mp = 0; mp < 4; mp += 2) { f32x4 hv[2][2][2];
#pragma unroll
                for (int m2 = 0; m2 < 2; ++m2) { const float* hi = src.H + (size_t)(row0 + ai * 128 + (mp + m2) * 16) * D + col0;
#pragma unroll
                    for (int bj = 0; bj < 2; ++bj)
#pragma unroll
                        for (int n = 0; n < 2; ++n) hv[m2][bj][n] = *(const f32x4*)(hi + bj * 128 + n * 16); }
#pragma unroll
                for (int m2 = 0; m2 < 2; ++m2) { float* ho = src.H + (size_t)(row0 + ai * 128 + (mp + m2) * 16) * D + col0;
#pragma unroll
                    for (int bj = 0; bj < 2; ++bj)
#pragma unroll
                        for (int n = 0; n < 2; ++n) *(f32x4*)(ho + bj * 128 + n * 16) = hv[m2][bj][n] + gv[bj][n] * acc[ai][bj][mp + m2][n]; } }
    }
};
template <bool MOE>
struct PolUp : PolBase {
    static constexpr bool PERM = true, GATHER = MOE, FP8 = MOE; static constexpr int ES = MOE ? 1 : 2; int K, lda, ldb;
    const bf16_t* A; const bf16_t* W; bf16_t* HID; int ldh, nq;
    int nM; const int* s2t; int tstart[NEXP + 1];
    DEV bool next(int i, Unit& u) const { return ge::static_next(MOE ? nM : NPAN, nq, G, c, i, u); }
    DEV int expert_of(int pm) const { int e = 0;
#pragma unroll
        for (int k = 1; k < NEXP; ++k) e += (pm >= tstart[k]) ? 1 : 0;
        return e; }
    DEV const char* a_base(const Unit& u) const { return MOE ? (const char*)A : (const char*)(A + (size_t)u.pm * 256 * lda); }
    DEV const char* b_base(const Unit& u) const { size_t off = (size_t)u.pn * 256 * ldb; if (MOE) off += (size_t)expert_of(u.pm) * 2 * DFFE * ldb; return (const char*)W + off * ES; }
    DEV int gather_row(const Unit& u, int R) const { return s2t[u.pm * 256 + R]; }
    DEV void epi(const f32x4 (&acc)[2][2][4][2], const Unit& u, int wr, int wc, int fr, int fq) const {
        const int row0 = u.pm * 256 + wr * 64 + fr, col0 = u.pn * 128 + wc * 32 + 8 * fq;
#pragma unroll
        for (int ai = 0; ai < 2; ++ai)
#pragma unroll
            for (int m = 0; m < 4; ++m) { bf16_t* o = HID + (size_t)(row0 + ai * 128 + m * 16) * ldh + col0;
                float h[8];
                constexpr float SG = MOE ? 0.00390625f : 1.0f, SU = MOE ? (MOE_DOWN_FP8 ? 0.015625f : 0.00390625f) : 1.0f;
                const f32x2 ke = {-1.4426950408889634f * SG, -1.4426950408889634f * SG}, ks = {SG * SU, SG * SU}, one = {1.0f, 1.0f};
#pragma unroll
                for (int n = 0; n < 2; ++n)
#pragma unroll
                    for (int ip = 0; ip < 2; ++ip) { const f32x2 g = {acc[ai][0][m][n][2 * ip], acc[ai][0][m][n][2 * ip + 1]}, u = {acc[ai][1][m][n][2 * ip], acc[ai][1][m][n][2 * ip + 1]};
                        const f32x2 t = g * ke; const f32x2 d = (f32x2){fexp2(t.x), fexp2(t.y)} + one; const f32x2 r = {frcp(d.x), frcp(d.y)};
                        const f32x2 hh = MOE ? (g * u) * (r * ks) : (g * u) * r; h[4 * n + 2 * ip] = hh.x; h[4 * n + 2 * ip + 1] = hh.y; }
                if (MOE && MOE_DOWN_FP8) { u32x2 w8; w8.x = pk4_fp8(h[0], h[1], h[2], h[3]); w8.y = pk4_fp8(h[4], h[5], h[6], h[7]);
                    *(u32x2*)((fp8_t*)HID + (size_t)(row0 + ai * 128 + m * 16) * ldh + col0) = w8; }
                else { u32x4 w; w.x = pk2(h[0], h[1]); w.y = pk2(h[2], h[3]); w.z = pk2(h[4], h[5]); w.w = pk2(h[6], h[7]); *(u32x4*)o = w; } }
    }
};
struct PolMoeDown : PolBase {
    static constexpr bool PERM = true, GATHER = (MOE_DOWN_FP8 != 0), FP8 = (MOE_DOWN_FP8 != 0); static constexpr int ES = MOE_DOWN_FP8 ? 1 : 2; int K, lda, ldb;
    const bf16_t* A; const bf16_t* W; bf16_t* YS; int nM; int tstart[NEXP + 1];
    DEV bool next(int i, Unit& u) const { return ge::static_next(nM, 4, G, c, i, u); }
    DEV int expert_of(int pm) const { int e = 0;
#pragma unroll
        for (int k = 1; k < NEXP; ++k) e += (pm >= tstart[k]) ? 1 : 0;
        return e; }
    DEV const char* a_base(const Unit& u) const { return GATHER ? (const char*)A : (const char*)A + (size_t)u.pm * 256 * lda * ES; }
    DEV int gather_row(const Unit& u, int R) const { return u.pm * 256 + R; }
    DEV const char* b_base(const Unit& u) const { return (const char*)W + ((size_t)expert_of(u.pm) * D + (size_t)u.pn * 256) * ldb * ES; }
    DEV void epi(const f32x4 (&acc)[2][2][4][2], const Unit& u, int wr, int wc, int fr, int fq) const {
        const int row0 = u.pm * 256 + wr * 64 + fr, col0 = u.pn * 256 + wc * 32 + 8 * fq;
#pragma unroll
        for (int ai = 0; ai < 2; ++ai)
#pragma unroll
            for (int m = 0; m < 4; ++m) { bf16_t* o = YS + (size_t)(row0 + ai * 128 + m * 16) * D + col0;
#pragma unroll
                for (int bj = 0; bj < 2; ++bj) { u32x4 w; w.x = pk2(acc[ai][bj][m][0][0], acc[ai][bj][m][0][1]); w.y = pk2(acc[ai][bj][m][0][2], acc[ai][bj][m][0][3]);
                    w.z = pk2(acc[ai][bj][m][1][0], acc[ai][bj][m][1][1]); w.w = pk2(acc[ai][bj][m][1][2], acc[ai][bj][m][1][3]); *(u32x4*)(o + bj * 128) = w; } }
    }
};
struct PolInProj : PolBase {
    static constexpr bool PERM = true, GATHER = false; static constexpr bool FP8 = false; static constexpr int ES = 2; int K, lda, ldb;
    const bf16_t* A; const bf16_t* W; bf16_t* Z; bf16_t* XBC; float* DT;
    DEV bool next(int i, Unit& u) const { return ge::static_next(NPAN, NPROJP / 256, G, c, i, u); }
    DEV const char* a_base(const Unit& u) const { return (const char*)(A + (size_t)u.pm * 256 * lda); }
    DEV const char* b_base(const Unit& u) const { return (const char*)(W + (size_t)u.pn * 256 * ldb); }
    DEV void epi(const f32x4 (&acc)[2][2][4][2], const Unit& u, int wr, int wc, int fr, int fq) const {
        const int row0 = u.pm * 256 + wr * 64 + fr, cw = wc * 32 + 8 * fq;
        if (u.pn < 20) {
            bf16_t* base; int ld, col0;
            if (u.pn < 8) { base = Z; ld = DIN; col0 = u.pn * 256 + cw; } else { base = XBC; ld = CONVD; col0 = (u.pn - 8) * 256 + cw; }
#pragma unroll
            for (int ai = 0; ai < 2; ++ai)
#pragma unroll
                for (int m = 0; m < 4; ++m) { bf16_t* o = base + (size_t)(row0 + ai * 128 + m * 16) * ld + col0;
#pragma unroll
                    for (int bj = 0; bj < 2; ++bj) { u32x4 w; w.x = pk2(acc[ai][bj][m][0][0], acc[ai][bj][m][0][1]); w.y = pk2(acc[ai][bj][m][0][2], acc[ai][bj][m][0][3]);
                        w.z = pk2(acc[ai][bj][m][1][0], acc[ai][bj][m][1][1]); w.w = pk2(acc[ai][bj][m][1][2], acc[ai][bj][m][1][3]); *(u32x4*)(o + bj * 128) = w; } }
        } else if (cw < 64) {
#pragma unroll
            for (int ai = 0; ai < 2; ++ai)
#pragma unroll
                for (int m = 0; m < 4; ++m) { const int r = row0 + ai * 128 + m * 16; int b, tv;
                    if (r < ML) { b = r / SEQ; tv = CTXL + r % SEQ; } else { b = (r - ML) / CTXL; tv = (r - ML) % CTXL; }
#pragma unroll
                    for (int n = 0; n < 2; ++n)
#pragma unroll
                        for (int i = 0; i < 4; ++i) { const int j = cw + 4 * n + i, dir = j >> 5, h = j & 31;
                            DT[((size_t)(b * 2 + dir) * NH + h) * TV + tv] = acc[ai][0][m][n][i]; } }
        }
    }
};

DEV void phase_conv(const Frame& F, int j, const bf16_t* XBC, bf16_t* XT, bf16_t* Brow, bf16_t* BT, bf16_t* Crow) {
    LAS bf16_t* tl0 = (LAS bf16_t*)F.lds;
    const float* cw = INP(F, I_CONVW) + (size_t)j * 4 * CONVD; const float* cb = INP(F, I_CONVB) + (size_t)j * CONVD;
    constexpr int NPER = NB * NCH, nitem = NPER * (CONVD / 64);
    const int t2 = 2 * (F.tid >> 3), cg = F.tid & 7;
    const int i0 = (int)(((long)F.bx * nitem) / F.G), i1 = (int)(((long)(F.bx + 1) * nitem) / F.G);
    int cblk_cur = -1; f32x4 wv[4][2], bv[2]; int par = 0;
#define CV_LOAD(it_, q_) do { const int _cb = (it_) / NPER, _rs = (it_) % NPER, _b = _rs / NCH, _cv = _rs % NCH; const int _ch = _cb * 64 + cg * 8, _tv = _cv * 128 + t2; \
        const int _s0 = _tv < CTXL ? 0 : CTXL, _s1 = _tv < CTXL ? CTXL : TV; \
        _Pragma("unroll") for (int k = 0; k < 5; ++k) { const int tk = _tv - 2 + k; q_[k] = (u32x4){0u, 0u, 0u, 0u}; \
            if (tk >= _s0 && tk < _s1) q_[k] = *(const u32x4*)(XBC + (size_t)row_of(_b, tk) * CONVD + _ch); } } while (0)
    u32x4 qn[5];
    if (i0 < i1) CV_LOAD(i0, qn);
    for (int it = i0; it < i1; ++it) {
        const int cblk = it / NPER, rest = it % NPER, b = rest / NCH, cv = rest % NCH;
        const int ch0 = cblk * 64 + cg * 8;
        if (cblk != cblk_cur) { cblk_cur = cblk;
#pragma unroll
            for (int k = 0; k < 4; ++k) { wv[k][0] = *(const f32x4*)(cw + k * CONVD + ch0); wv[k][1] = *(const f32x4*)(cw + k * CONVD + ch0 + 4); }
            bv[0] = *(const f32x4*)(cb + ch0); bv[1] = *(const f32x4*)(cb + ch0 + 4); }
        const int tv = cv * 128 + t2;
        float xin[5][8];
#pragma unroll
        for (int k = 0; k < 5; ++k) { const u32x4 q = qn[k];
            xin[k][0] = bflo(q.x); xin[k][1] = bfhi(q.x); xin[k][2] = bflo(q.y); xin[k][3] = bfhi(q.y); xin[k][4] = bflo(q.z); xin[k][5] = bfhi(q.z); xin[k][6] = bflo(q.w); xin[k][7] = bfhi(q.w); }
        if (it + 1 < i1) CV_LOAD(it + 1, qn);
        unsigned pk[2][4];
#pragma unroll
        for (int o = 0; o < 2; ++o) { float a[8];
#pragma unroll
            for (int i = 0; i < 8; ++i) { float acc = bv[i >> 2][i & 3];
#pragma unroll
                for (int k = 0; k < 4; ++k) acc += wv[k][i >> 2][i & 3] * xin[o + k][i];
                a[i] = siluf(acc); }
#pragma unroll
            for (int i = 0; i < 4; ++i) pk[o][i] = pk2(a[2 * i], a[2 * i + 1]); }
        const int r = row_of(b, tv);
        const bool isx = cblk < DIN / 64, isb = !isx && cblk < (DIN + BCD) / 64;
        if (!isx) {
            const int chc = ch0 - DIN - (isb ? 0 : BCD); bf16_t* o = (isb ? Brow : Crow) + (size_t)(r - t2) * BCD + (chc >> 7) * 16384 + frag_off(t2, chc & 127);
            *(u32x4*)o = (u32x4){pk[0][0], pk[0][1], pk[0][2], pk[0][3]}; *(u32x4*)(o + 8) = (u32x4){pk[1][0], pk[1][1], pk[1][2], pk[1][3]}; }
        if (isx || isb) {
            LAS bf16_t* tl = tl0 + par * (64 * 136); par ^= 1;
#pragma unroll
            for (int i = 0; i < 4; ++i) { const unsigned lo = (pk[0][i] & 0xffffu) | (pk[1][i] << 16), hi = (pk[0][i] >> 16) | (pk[1][i] & 0xffff0000u);
                *(LAS unsigned*)(tl + (cg * 8 + 2 * i) * 136 + t2) = lo; *(LAS unsigned*)(tl + (cg * 8 + 2 * i + 1) * 136 + t2) = hi; }
            __syncthreads();
            if (isx) { bf16_t* dst = XT + ((size_t)b * DIN + cblk * 64) * TV;
#pragma unroll
                for (int q = 0; q < 2; ++q) { const int idx = F.tid + q * 512, ch = idx >> 4, t8 = (idx & 15) * 8;
                    *(u32x4*)(dst + (size_t)ch * TV + cv * 128 + t8) = *(const LAS u32x4*)(tl + ch * 136 + t8); }
            } else {
                const int chb = cblk * 64 - DIN; bf16_t* dst = BT + (size_t)((b * NCH + cv) * NG + (chb >> 7)) * 16384 + ((chb & 127) >> 4) * 2048;
#pragma unroll
                for (int q = 0; q < 2; ++q) { const int idx = F.tid + q * 512, fr_ = idx & 15, fq_ = (idx >> 4) & 3, ks_ = (idx >> 6) & 3, rbl = idx >> 8;
                    *(u32x4*)(dst + idx * 8) = *(const LAS u32x4*)(tl + (rbl * 16 + fr_) * 136 + (ks_ * 4 + fq_) * 8); }
            }
        }
    }
}

#undef CV_LOAD
DEV void phase_cb(const Frame& F, const bf16_t* Brow, const bf16_t* Crow, bf16_t* CB) {
    const int nitem = NB * NG * NCH; const int fr = F.lane & 15, fq = F.lane >> 4;
    for (int it = F.bx; it < nitem; it += F.G) {
        const int cv = it % NCH, g = (it / NCH) % NG, b = it / (NCH * NG);
        const int rbase = row_of(b, cv * 128);
        const bf16_t* ct = Crow + (size_t)rbase * BCD + g * 16384 + F.lane * 8; const bf16_t* bt_ = Brow + (size_t)rbase * BCD + g * 16384 + F.lane * 8;
        bf16x8 cf[4], bfr[8][4];
#pragma unroll
        for (int ks = 0; ks < 4; ++ks) cf[ks] = *(const bf16x8*)(ct + (F.wave * 4 + ks) * 512);
#pragma unroll
        for (int nt = 0; nt < 8; ++nt)
#pragma unroll
            for (int ks = 0; ks < 4; ++ks) bfr[nt][ks] = *(const bf16x8*)(bt_ + (nt * 4 + ks) * 512);
        bf16_t* out = CB + ((size_t)((b * NG + g) * NCH + cv)) * 16384;
#pragma unroll
        for (int nt = 0; nt < 8; ++nt) {
            f32x4 acc = (f32x4){0.f, 0.f, 0.f, 0.f};
#pragma unroll
            for (int ks = 0; ks < 4; ++ks) acc = MFMA16(bfr[nt][ks], cf[ks], acc);
            u32x2 w; w.x = pk2(acc[0], acc[1]); w.y = pk2(acc[2], acc[3]);
            *(u32x2*)(out + frag_off(16 * F.wave + fr, 16 * nt + 4 * fq)) = w;
        }
    }
}

DEV void phase_tables(const Frame& F, int j, float* DT, float* CUM, float* WJ, float* CF) {
    const int nitem = NB * 2 * NH * NCH; const int gw = F.bx * 8 + F.wave, NGW = F.G * 8;
    f32x2 rawn = (f32x2){0.f, 0.f}; if (gw < nitem) rawn = *(const f32x2*)(DT + (size_t)gw * 128 + 2 * F.lane);
    for (int it = gw; it < nitem; it += NGW) {
        const int cv = it % NCH, h = (it / NCH) % NH, dir = (it / (NCH * NH)) & 1, b = it / (NCH * NH * 2);
        const float A = -expf(INP(F, I_ALOG)[(size_t)(j * 2 + dir) * NH + h]); const float bias = INP(F, I_DTB)[(size_t)(j * 2 + dir) * NH + h];
        const size_t o = ((size_t)(b * 2 + dir) * NH + h) * TV + cv * 128 + 2 * F.lane;
        const f32x2 raw = rawn; if (it + NGW < nitem) rawn = *(const f32x2*)(DT + (size_t)(it + NGW) * 128 + 2 * F.lane);
        const float d0 = softplusf(raw.x + bias), d1 = softplusf(raw.y + bias); const float a0 = d0 * A, a1 = d1 * A;
        float c0, c1, tot, sum = a0 + a1;
        if (dir == 0) {
#pragma unroll
            for (int q = 1; q < 64; q <<= 1) { const float t2 = __shfl_up(sum, q); if (F.lane >= q) sum += t2; }
            c1 = sum; c0 = sum - a1; tot = __shfl(sum, 63);
        } else {
#pragma unroll
            for (int q = 1; q < 64; q <<= 1) { const float t2 = __shfl_down(sum, q); if (F.lane + q < 64) sum += t2; }
            c0 = sum; c1 = sum - a0; tot = __shfl(sum, 0);
        }
        constexpr float L2E = 1.4426950408889634f;
        *(f32x2*)(DT + o) = (f32x2){c0 * L2E - flog2(d0), c1 * L2E - flog2(d1)};
        *(f32x2*)(CUM + o) = (f32x2){c0 * L2E, c1 * L2E};
        *(f32x2*)(WJ + o) = (f32x2){d0 * FEXP(tot - c0), d1 * FEXP(tot - c1)};
        const float cref = L2E * __shfl(dir == 0 ? c1 : c0, dir == 0 ? (F.lane | 15) : (F.lane & ~15));
        *(f32x2*)(CF + o) = (f32x2){d0 * fexp2(cref - c0 * L2E), d1 * fexp2(cref - c1 * L2E)};
    }
}

constexpr int SC_HL = 0, SC_TAB = 17408, SC_X = 21504, SC_END = SC_X + 16384;
static_assert(SC_END <= ge::STAGE_BYTES, "scan LDS map");
DEV void phase_scan(const Frame& F, int j, const bf16_t* XT, const bf16_t* BT, const bf16_t* Crow, const bf16_t* CB, const float* DT, const float* CUM, const float* WJ, const float* CF, bf16_t* Yf, bf16_t* Yb) {
    LAS unsigned char* L = F.lds;
    LAS bf16_t* Hl = (LAS bf16_t*)(L + SC_HL);
    LAS float* tab = (LAS float*)(L + SC_TAB);
    const int fr = F.lane & 15, fq = F.lane >> 4, w = F.wave;
    const int rb = w < 4 ? w : 11 - w;
    const int nitem = NB * NH * 2 * 2;
    for (int it = F.bx; it < nitem; it += F.G) {
        const int xq = it & 7, kq = it >> 3; const int b = xq >> 2, g = xq & 3, h = 8 * g + (kq >> 2), dir = (kq >> 1) & 1, ph = kq & 1;
        const float Dsk = dir == 0 ? INP(F, I_DSKIP)[(size_t)j * NH + h] : 0.f;
        const size_t tbase = ((size_t)(b * 2 + dir) * NH + h) * TV;
        const bf16_t* xt = XT + ((size_t)b * DIN + h * HD + ph * 32) * TV;
        const bf16_t* bt = BT + (size_t)(b * NCH * NG + g) * 16384;
        const bf16_t* CBh = CB + (size_t)((b * NG + g) * NCH) * 16384;
        const bf16_t* Cg = Crow + g * 16384;
        bf16_t* Y = (dir ? Yb : Yf) + h * HD + ph * 32;
        const int lrow = 16 * rb + fr;
        f32x4 accH[2]; accH[0] = (f32x4){0.f, 0.f, 0.f, 0.f}; accH[1] = accH[0];
        for (int i = F.tid; i < 32 * 136 / 2; i += 512) ((LAS unsigned*)Hl)[i] = 0u;
#define SC_CHUNK_OF(step) (dir == 0 ? (step) : ((step) < 2 ? 1 - (step) : (NCH - 1) - ((step) - 2)))
        const int xr = 4 * w + (F.lane >> 4), xc = F.lane & 15;
        const unsigned lxs = (unsigned)(xr * TV + 8 * xc) * 2u, lxd = (unsigned)(xr * 256 + ((xc ^ (xr & 15)) << 4));
#define SC_LD_X(cvx_) (*(const u32x4*)((const char*)(xt + (unsigned)(cvx_) * 128u) + lxs))
#define SC_ST_X(xb_, v_) (*(LAS u32x4*)(L + SC_X + (xb_) * 8192 + lxd) = (v_))
        const float* tsrcw = ((w >> 1) == 0 ? CUM : ((w >> 1) == 1 ? DT : ((w >> 1) == 2 ? WJ : CF))) + tbase + (w & 1) * 64 + F.lane;
#define SC_LD_TAB(cvx_) (tsrcw[(cvx_) * 128])
#define SC_ST_TAB(tbuf_, v_) (tab[(tbuf_) * 512 + w * 64 + F.lane] = (v_))
        const unsigned lfo = (unsigned)(rb * 4096 + F.lane * 16);
#define SC_LD_CB(cvx_, ks_) (*(const u32x4*)((const char*)(CBh + (size_t)(cvx_) * 16384u) + lfo + (ks_) * 1024))
#define SC_LD_BT(cvx_, ks_) (*(const u32x4*)((const char*)(bt + (size_t)(cvx_) * 65536u) + lfo + (ks_) * 1024))
#define SC_LD_C(rbx_, ks_) (*(const bf16x8*)((const char*)(Cg + (size_t)(rbx_) * BCD) + lfo + (ks_) * 1024))
        const int kd = rb >> 1; float km[8], dk[8];
#pragma unroll
        for (int i = 0; i < 8; ++i) { const int sidx = 32 * kd + 8 * fq + i; km[i] = (dir == 0 ? (sidx <= lrow) : (sidx >= lrow)) ? 1.f : 0.f; dk[i] = (sidx == lrow) ? Dsk : 0.f; }
        u32x4 rcb[4], rbt[4]; bf16x8 cf[4];
        { const int cv0 = SC_CHUNK_OF(0); const u32x4 x0 = SC_LD_X(cv0); const float t0 = SC_LD_TAB(cv0); const unsigned rb0 = (unsigned)row_of(b, cv0 * 128);
#pragma unroll
          for (int ks = 0; ks < 4; ++ks) { rcb[ks] = SC_LD_CB(cv0, ks); rbt[ks] = SC_LD_BT(cv0, ks); cf[ks] = SC_LD_C(rb0, ks); }
          SC_ST_X(0, x0); SC_ST_TAB(0, t0); }
        for (int step = 0; step < NCH; ++step) {
            int kdl = kd, dirl = dir; LAUNDER_S(kdl); LAUNDER_S(dirl);
            const int cv = SC_CHUNK_OF(step), buf = step & 1; const bool more = step + 1 < NCH;
            const int cvn = more ? SC_CHUNK_OF(step + 1) : cv;
            const unsigned rbase = (unsigned)row_of(b, cv * 128), rbn = (unsigned)row_of(b, cvn * 128);
            LDSBAR();
            const u32x4 xn = SC_LD_X(cvn); const float tn = SC_LD_TAB(cvn);
            const LAS float* tb = tab + buf * 512;
            const float cl2 = tb[lrow]; const float ecum_l = fexp2(cl2);
            const float chunk_decay = fexp2(dir == 0 ? tb[127] : tb[0]);
            f32x4 yd[2], yo[2];
#pragma unroll
            for (int nt = 0; nt < 2; ++nt) { yd[nt] = (f32x4){0.f, 0.f, 0.f, 0.f}; yo[nt] = yd[nt]; accH[nt] = accH[nt] * chunk_decay; }
#pragma unroll
            for (int ks = 0; ks < 4; ++ks) { const int s0 = 32 * ks + 8 * fq; bf16x8 mfk, bwk;
                const bool none = dirl == 0 ? (ks > kdl) : (ks < kdl), diag = (ks == kdl);
                unsigned om[4] = {0u, 0u, 0u, 0u};
                if (!none) {
                    const unsigned qc[4] = {rcb[ks].x, rcb[ks].y, rcb[ks].z, rcb[ks].w};
                    if (!diag) {
                        const f32x4 f0 = *(const LAS f32x4*)(tb + 384 + s0), f1 = *(const LAS f32x4*)(tb + 384 + s0 + 4);
                        const float rowf = fexp2(cl2 - tb[dirl == 0 ? 32 * ks + 31 : 32 * ks]);
                        const f32x2 rf2 = {rowf, rowf};
                        const f32x2 c2[4] = {(f32x2){f0[0], f0[1]}, (f32x2){f0[2], f0[3]}, (f32x2){f1[0], f1[1]}, (f32x2){f1[2], f1[3]}};
#pragma unroll
                        for (int i = 0; i < 4; ++i) { const f32x2 v2 = (f32x2){bflo(qc[i]), bfhi(qc[i])} * (c2[i] * rf2); om[i] = pk2(v2.x, v2.y); }
                    } else {
                        const f32x4 cs0 = *(const LAS f32x4*)(tb + 128 + s0), cs1 = *(const LAS f32x4*)(tb + 128 + s0 + 4);
                        const float cs[8] = {cs0[0], cs0[1], cs0[2], cs0[3], cs1[0], cs1[1], cs1[2], cs1[3]};
                        float v[8];
#pragma unroll
                        for (int i = 0; i < 8; ++i) { const float cbv = (i & 1) ? bfhi(qc[i >> 1]) : bflo(qc[i >> 1]); const float x = cl2 - cs[i]; v[i] = (cbv * fexp2(x < 60.f ? x : 60.f)) * km[i] + dk[i]; }
#pragma unroll
                        for (int i = 0; i < 4; ++i) om[i] = pk2(v[2 * i], v[2 * i + 1]);
                    }
                    rcb[ks] = SC_LD_CB(cvn, ks);
                }
                mfk = __builtin_bit_cast(bf16x8, (u32x4){om[0], om[1], om[2], om[3]});
                { const f32x4 ws0 = *(const LAS f32x4*)(tb + 256 + s0), ws1 = *(const LAS f32x4*)(tb + 256 + s0 + 4);
                  const f32x2 w2[4] = {(f32x2){ws0[0], ws0[1]}, (f32x2){ws0[2], ws0[3]}, (f32x2){ws1[0], ws1[1]}, (f32x2){ws1[2], ws1[3]}};
                  const unsigned qb[4] = {rbt[ks].x, rbt[ks].y, rbt[ks].z, rbt[ks].w}; unsigned ob[4];
#pragma unroll
                  for (int i = 0; i < 4; ++i) { const f32x2 v2 = (f32x2){bflo(qb[i]), bfhi(qb[i])} * w2[i]; ob[i] = pk2(v2.x, v2.y); LAUNDER_V(ob[i]); }
                  bwk = __builtin_bit_cast(bf16x8, (u32x4){ob[0], ob[1], ob[2], ob[3]}); }
                rbt[ks] = SC_LD_BT(cvn, ks);
#pragma unroll
                for (int nt = 0; nt < 2; ++nt) {
                    const bf16x8 xf = *(const LAS bf16x8*)(L + SC_X + buf * 8192 + (16 * nt + fr) * 256 + (((4 * ks + fq) ^ fr) << 4));
                    if (!none) yd[nt] = MFMA16(xf, mfk, yd[nt]);
                    const bf16x8 hf = *(const LAS bf16x8*)(Hl + buf * (32 * 136) + (16 * nt + fr) * 136 + 32 * ks + 8 * fq);
                    yo[nt] = MFMA16(hf, cf[ks], yo[nt]);
                    accH[nt] = MFMA16(bwk, xf, accH[nt]); } }
#pragma unroll
            for (int ks = 0; ks < 4; ++ks) cf[ks] = SC_LD_C(rbn, ks);
            SC_ST_X(buf ^ 1, xn); SC_ST_TAB(buf ^ 1, tn);
#pragma unroll
            for (int nt = 0; nt < 2; ++nt) { u32x2 hw; hw.x = pk2(accH[nt][0], accH[nt][1]); hw.y = pk2(accH[nt][2], accH[nt][3]);
                *(LAS u32x2*)(Hl + (buf ^ 1) * (32 * 136) + (16 * nt + fr) * 136 + 16 * rb + 4 * fq) = hw; }
#pragma unroll
            for (int nt = 0; nt < 2; ++nt) { u32x2 yw; yw.x = pk2(yd[nt][0] + ecum_l * yo[nt][0], yd[nt][1] + ecum_l * yo[nt][1]); yw.y = pk2(yd[nt][2] + ecum_l * yo[nt][2], yd[nt][3] + ecum_l * yo[nt][3]);
                *(u32x2*)(Y + ((size_t)(rbase + lrow) * DIN + 16 * nt + 4 * fq)) = yw; }
        }
        WAITV(0); LDSBAR();
    }
}

DEV void phase_gate(const Frame& F, int j, const bf16_t* Yf, const bf16_t* Yb, const bf16_t* Z, bf16_t* YN, int nrows) {
    const int gw = F.bx * 8 + F.wave, NGW = F.G * 8; const float* nw = INP(F, I_SNORM) + (size_t)j * DIN;
    u32x4 na[4], nb[4], nz[4];
    if (gw < nrows) {
#pragma unroll
        for (int q = 0; q < 4; ++q) { const size_t o = (size_t)gw * DIN + 8 * F.lane + 512 * q; na[q] = *(const u32x4*)(Yf + o); nb[q] = *(const u32x4*)(Yb + o); nz[q] = *(const u32x4*)(Z + o); } }
    for (int r = gw; r < nrows; r += NGW) {
        float t[32]; float ss = 0.f;
        u32x4 ca[4], cb4[4], cz[4];
#pragma unroll
        for (int q = 0; q < 4; ++q) { ca[q] = na[q]; cb4[q] = nb[q]; cz[q] = nz[q]; }
        if (r + NGW < nrows) {
#pragma unroll
            for (int q = 0; q < 4; ++q) { const size_t o = (size_t)(r + NGW) * DIN + 8 * F.lane + 512 * q; na[q] = *(const u32x4*)(Yf + o); nb[q] = *(const u32x4*)(Yb + o); nz[q] = *(const u32x4*)(Z + o); } }
#pragma unroll
        for (int q = 0; q < 4; ++q) { const u32x4 a = ca[q], bq = cb4[q], z = cz[q];
            const unsigned aa[4] = {a.x, a.y, a.z, a.w}, bb[4] = {bq.x, bq.y, bq.z, bq.w}, zz[4] = {z.x, z.y, z.z, z.w};
#pragma unroll
            for (int i = 0; i < 4; ++i) { const float v0 = (bflo(aa[i]) + bflo(bb[i])) * siluf(bflo(zz[i])), v1 = (bfhi(aa[i]) + bfhi(bb[i])) * siluf(bfhi(zz[i])); t[8 * q + 2 * i] = v0; t[8 * q + 2 * i + 1] = v1; ss += v0 * v0 + v1 * v1; } }
        const float rstd = rsqrtf(wave_sum(ss) * (1.0f / DIN) + EPS);
#pragma unroll
        for (int q = 0; q < 4; ++q) { const int c = 8 * F.lane + 512 * q; const f32x4 w0 = *(const f32x4*)(nw + c), w1 = *(const f32x4*)(nw + c + 4);
            u32x4 o; o.x = pk2(t[8 * q] * rstd * w0[0], t[8 * q + 1] * rstd * w0[1]); o.y = pk2(t[8 * q + 2] * rstd * w0[2], t[8 * q + 3] * rstd * w0[3]);
            o.z = pk2(t[8 * q + 4] * rstd * w1[0], t[8 * q + 5] * rstd * w1[1]); o.w = pk2(t[8 * q + 6] * rstd * w1[2], t[8 * q + 7] * rstd * w1[3]);
            *(u32x4*)(YN + (size_t)r * DIN + c) = o; }
    }
}

DEV void phase_route(const Frame& F, int layer, int ml, bf16_t* V, int nrows) {
    LAS unsigned* lc = (LAS unsigned*)(F.lds + LDS_MISC + 256);
    if (F.tid < 8) lc[F.tid] = 0u;
    __syncthreads();
    const int gw = F.bx * 8 + F.wave, NGW = F.G * 8; const int j = layer / 2;
    const float* w = INP(F, I_NFFN) + (size_t)layer * D; const float* rw = INP(F, I_RW) + (size_t)j * D * NEXP;
    LAS float* rwl = (LAS float*)F.lds;
    for (int q = F.tid; q < D * 2; q += 512) { const int c = q >> 1, hf = q & 1; const int ln = (c & 255) >> 2, ii = c & 3, jq = c >> 8;
        *(LAS f32x4*)(rwl + ((jq * 4 + ii) * 64 + ln) * 8 + hf * 4) = *(const f32x4*)(rw + (size_t)q * 4); }
    __syncthreads();
    TokInfo* tok = (TokInfo*)(F.ws + OFF_TOK);
    constexpr int NS = 3;
    f32x4 ns[NS][4];
#pragma unroll
    for (int k = 0; k < NS; ++k) if (gw + k * NGW < nrows) load_row(F.H + (size_t)(gw + k * NGW) * D, F.lane, ns[k]);
    for (int r0 = gw; r0 < nrows; r0 += NS * NGW) {
#pragma unroll
      for (int k = 0; k < NS; ++k) { const int r = r0 + k * NGW; if (r >= nrows) break;
        f32x4 v[4];
#pragma unroll
        for (int q = 0; q < 4; ++q) v[q] = ns[k][q];
        if (r + NS * NGW < nrows) load_row(F.H + (size_t)(r + NS * NGW) * D, F.lane, ns[k]);
        const float rstd = rsqrtf(sumsq_row(v) * (1.0f / D) + EPS);
        const int vec = vec_of(r);
        normmod_row(v, rstd, w, modp(F, layer, vec, 3), modp(F, layer, vec, 4), F.lane);
#pragma unroll
        for (int jq = 0; jq < 4; ++jq) *(unsigned*)((fp8_t*)V + (size_t)r * D + 4 * F.lane + 256 * jq) = pk4_fp8(v[jq][0] * 8.0f, v[jq][1] * 8.0f, v[jq][2] * 8.0f, v[jq][3] * 8.0f);
        float lg[NEXP];
#pragma unroll
        for (int e = 0; e < NEXP; ++e) lg[e] = 0.f;
#pragma unroll
        for (int jj = 0; jj < 4; ++jj)
#pragma unroll
            for (int i = 0; i < 4; ++i) { const LAS float* rp = rwl + ((jj * 4 + i) * 64 + F.lane) * 8; const f32x4 r0 = *(const LAS f32x4*)rp, r1 = *(const LAS f32x4*)(rp + 4);
#pragma unroll
                for (int e = 0; e < 4; ++e) { lg[e] += v[jj][i] * r0[e]; lg[4 + e] += v[jj][i] * r1[e]; } }
#pragma unroll
        for (int e = 0; e < NEXP; ++e) lg[e] = wave_sum(lg[e]);
        int e0 = 0; float v0 = lg[0];
#pragma unroll
        for (int e = 1; e < NEXP; ++e) if (lg[e] > v0) { v0 = lg[e]; e0 = e; }
        int e1 = -1; float v1 = -3.0e38f;
#pragma unroll
        for (int e = 0; e < NEXP; ++e) if (e != e0 && lg[e] > v1) { v1 = lg[e]; e1 = e; }
        const float g1 = frcp(1.0f + FEXP(v0 - v1)), g0 = 1.0f - g1;
        if (F.lane == 0) { TokInfo ti; ti.s0 = e0; ti.s1 = e1; ti.g0 = g0; ti.g1 = g1; tok[r] = ti; atomicAdd((unsigned*)&lc[e0], 1u); atomicAdd((unsigned*)&lc[e1], 1u); }
      }
    }
    __syncthreads();
    if (F.tid < 8) __hip_atomic_fetch_add(F.ctl + CW_CNT + (ml * 8 + F.tid) * 64, lc[F.tid], RLX_AGENT);
}
DEV void tile_starts(const Frame& F, int ml, int (&ts)[NEXP + 1], unsigned (&cnt)[NEXP]) {
    ts[0] = 0;
#pragma unroll
    for (int e = 0; e < NEXP; ++e) { cnt[e] = __hip_atomic_load(F.ctl + CW_CNT + (ml * 8 + e) * 64, RLX_AGENT); ts[e + 1] = ts[e] + (int)((cnt[e] + 255u) / 256u); }
}
DEV void phase_slots(const Frame& F, int ml, int nrows) {
    int ts[NEXP + 1]; unsigned cnt[NEXP]; tile_starts(F, ml, ts, cnt);
    TokInfo* tok = (TokInfo*)(F.ws + OFF_TOK); int* s2t = (int*)(F.ws + OFF_S2T);
    const int gw = F.bx * 8 + F.wave, NGW = F.G * 8;
    for (int base = gw * 64; base < nrows; base += NGW * 64) {
        const int r = base + F.lane; TokInfo ti = tok[r];
        unsigned long long m0[NEXP], m1[NEXP]; unsigned mycnt = 0;
#pragma unroll
        for (int e = 0; e < NEXP; ++e) { m0[e] = __ballot(ti.s0 == e); m1[e] = __ballot(ti.s1 == e); if (F.lane == e) mycnt = (unsigned)(__builtin_popcountll(m0[e]) + __builtin_popcountll(m1[e])); }
        unsigned b0 = 0;
        if (F.lane < NEXP && mycnt) b0 = __hip_atomic_fetch_add(F.ctl + CW_CUR + (ml * 8 + F.lane) * 64, mycnt, RLX_AGENT);
        const unsigned long long below = (1ull << F.lane) - 1ull; int sl0 = 0, sl1 = 0;
#pragma unroll
        for (int e = 0; e < NEXP; ++e) { const unsigned be = __shfl(b0, e); const int c0 = __builtin_popcountll(m0[e]);
            if (ti.s0 == e) sl0 = ts[e] * 256 + (int)be + __builtin_popcountll(m0[e] & below);
            if (ti.s1 == e) sl1 = ts[e] * 256 + (int)be + c0 + __builtin_popcountll(m1[e] & below); }
        ti.s0 = sl0; ti.s1 = sl1; tok[r] = ti; s2t[sl0] = r; s2t[sl1] = r;
    }
    if (F.bx == 0) { for (int e = 0; e < NEXP; ++e) { const int a = ts[e] * 256 + (int)cnt[e], b2 = ts[e + 1] * 256; for (int s = a + F.tid; s < b2; s += 512) s2t[s] = 0; } }
}
DEV void phase_combine(const Frame& F, int layer, const bf16_t* YS, bool final_) {
    const int NGW = F.G * 8; const int gw = F.bx * 8 + F.wave + (final_ ? 0 : ML); const TokInfo* tok = (const TokInfo*)(F.ws + OFF_TOK);
    const int nrows = final_ ? ML : MT;
    f32x4 nh[4]; u32x2 nya[4], nyb[4]; TokInfo tcur, tnxt;
    tcur.s0 = tcur.s1 = 0; tcur.g0 = tcur.g1 = 0.f; tnxt = tcur;
    if (gw < nrows) { tcur = tok[gw]; load_row(F.H + (size_t)gw * D, F.lane, nh);
#pragma unroll
        for (int jj = 0; jj < 4; ++jj) { const int c = 4 * F.lane + 256 * jj; nya[jj] = *(const u32x2*)(YS + (size_t)tcur.s0 * D + c); nyb[jj] = *(const u32x2*)(YS + (size_t)tcur.s1 * D + c); } }
    if (gw + NGW < nrows) tnxt = tok[gw + NGW];
    for (int r = gw; r < nrows; r += NGW) {
        f32x4 v[4]; u32x2 ya[4], yb[4]; TokInfo ti = tcur;
#pragma unroll
        for (int q = 0; q < 4; ++q) { v[q] = nh[q]; ya[q] = nya[q]; yb[q] = nyb[q]; }
        tcur = tnxt;
        if (r + NGW < nrows) { load_row(F.H + (size_t)(r + NGW) * D, F.lane, nh);
#pragma unroll
            for (int jj = 0; jj < 4; ++jj) { const int c = 4 * F.lane + 256 * jj; nya[jj] = *(const u32x2*)(YS + (size_t)tcur.s0 * D + c); nyb[jj] = *(const u32x2*)(YS + (size_t)tcur.s1 * D + c); } }
        if (r + 2 * NGW < nrows) tnxt = tok[r + 2 * NGW];
        if (MOE_DOWN_FP8) { ti.g0 *= 0.00390625f; ti.g1 *= 0.00390625f; }
        const float* g2 = modp(F, layer, vec_of(r), 5);
#pragma unroll
        for (int jj = 0; jj < 4; ++jj) { const int c = 4 * F.lane + 256 * jj; const u32x2 a = ya[jj], b = yb[jj]; const f32x4 gv = *(const f32x4*)(g2 + c);
            v[jj][0] += gv[0] * (ti.g0 * bflo(a.x) + ti.g1 * bflo(b.x)); v[jj][1] += gv[1] * (ti.g0 * bfhi(a.x) + ti.g1 * bfhi(b.x));
            v[jj][2] += gv[2] * (ti.g0 * bflo(a.y) + ti.g1 * bflo(b.y)); v[jj][3] += gv[3] * (ti.g0 * bfhi(a.y) + ti.g1 * bfhi(b.y)); }
        if (!final_) {
#pragma unroll
            for (int jj = 0; jj < 4; ++jj) *(f32x4*)(F.H + (size_t)r * D + 4 * F.lane + 256 * jj) = v[jj];
        } else {
            const float rstd = rsqrtf(sumsq_row(v) * (1.0f / D) + EPS); const float* fw = INP(F, I_FNORM);
#pragma unroll
            for (int jj = 0; jj < 4; ++jj) { const int c = 4 * F.lane + 256 * jj; *(f32x4*)(OUTP(F) + (size_t)r * D + c) = v[jj] * rstd * *(const f32x4*)(fw + c); }
        }
    }
}

constexpr int PH_PER_PAIR = 17, N_PHASES = 1 + 2 * PH_PER_PAIR;
static_assert((size_t)(DFF / 128) * MC * D * 4 <= al(SZ_WMUP) + SZ_WMDN, "context K-slice partials fit the expert-weight region");
__global__ void __launch_bounds__(512, 2) fwd_kernel(Params prm) {
#ifdef EMU
    unsigned char* lds_raw = emu_lds();
#else
    extern __shared__ __attribute__((aligned(16))) unsigned char lds_raw[];
#endif
    Frame F;
    F.lds = (LAS unsigned char*)lds_raw;
    F.tid = threadIdx.x; F.lane = F.tid & 63; F.wave = RFL(F.tid >> 6); F.G = gridDim.x; F.bx = blockIdx.x;
    F.p = &prm; F.ws = prm.ws; F.ctl = (unsigned*)(prm.ws + OFF_CTL); F.H = (float*)(prm.ws + OFF_H); F.mod = (float*)(prm.ws + OFF_MOD);
    volatile LAS unsigned* misc = (volatile LAS unsigned*)(F.lds + LDS_MISC);
    if (F.tid < 64) misc[F.tid] = 0u;
    __syncthreads();
    XcdBarrier bar; bar.bar = F.ctl + CW_BAR; bar.x = 0; bar.st = misc;
    const int lo = prm.ph_lo, hi = prm.ph_hi;
    if (hi - lo > 1) bar = xcd_barrier_post(F.ctl + CW_BAR, misc);
    int ph = 0;
#ifndef SITE_MASK
#define SITE_MASK 0xFFFFFFFFu
#endif
#ifndef PROBE_REPEAT_SITE
#define PROBE_REPEAT_SITE (-1)
#endif
#define PH_REPS(site) ((PROBE_REPEAT_SITE == (site)) ? 2 : 1)
#ifndef PROBE_TS_MASK
#define PROBE_TS_MASK 0u
#endif
#ifndef PROBE_TS_MULT
#define PROBE_TS_MULT 1
#endif
#ifdef EMU
#define NOWT() 0ull
#else
#define NOWT() ((unsigned long long)__builtin_amdgcn_s_memrealtime())
#endif
    unsigned long long tsacc = 0;
#define PHASE_BEGIN(site) if (((SITE_MASK >> (site)) & 1u) && lo <= ph && ph < hi) { { int _t = threadIdx.x; LAUNDER_V(_t); F.tid = _t; F.lane = _t & 63; int _b = blockIdx.x; LAUNDER_S(_b); F.bx = _b; int _g = gridDim.x; LAUNDER_S(_g); F.G = _g; \
      F.ws = WSP(F); F.ctl = (unsigned*)(F.ws + OFF_CTL); F.H = (float*)(F.ws + OFF_H); F.mod = (float*)(F.ws + OFF_MOD); } \
      const bool _tson = ((PROBE_TS_MASK >> (site)) & 1u) != 0u; unsigned long long _ts0 = 0; if (_tson) _ts0 = NOWT(); \
      for (int _rep = 0; _rep < PH_REPS(site); ++_rep) { if (_rep) __syncthreads();
#define PHASE_END   } if (ph + 1 < hi) xcd_barrier(bar); if (_tson) tsacc += NOWT() - _ts0; } ++ph;
#define B_W (F.ws + OFF_W)
#define B_ACT (F.ws + OFF_ACT)
#define B_P ((bf16_t*)(B_ACT + A_P))
#define B_HID ((bf16_t*)(B_ACT + A_HID))
#define B_U ((bf16_t*)(B_ACT + A_U))
#define B_Z ((bf16_t*)(B_ACT + A_Z))
#define B_XBC ((bf16_t*)(B_ACT + A_XBC))
#define B_DT ((float*)(B_W + W_DT))
#define B_XT ((bf16_t*)(B_ACT + A_XT))
#define B_BROW ((bf16_t*)(B_ACT + A_BROW))
#define B_BT ((bf16_t*)(B_ACT + A_BT))
#define B_CROW ((bf16_t*)(B_ACT + A_CROW))
#define B_CB ((bf16_t*)(B_ACT + A_CB))
#define B_CUM ((float*)(B_ACT + A_CUM))
#define B_WJ ((float*)(B_ACT + A_WJ))
#define B_CF ((float*)(B_ACT + A_CF))
#define B_YF ((bf16_t*)(B_ACT + A_YF))
#define B_YB ((bf16_t*)(B_W + W_YB))
#define B_YN ((bf16_t*)(B_ACT + A_YN))
#define B_V ((bf16_t*)(B_ACT + A_V))
#define B_HIDM ((bf16_t*)(B_ACT + A_HIDM))
#define B_YS ((bf16_t*)(B_ACT + A_YS))
#define B_PART ((float*)(B_W + W_MUP))

    PHASE_BEGIN(0) phase_mod(F); convert_even(F, 0); PHASE_END

    for (int lp = 0; lp < 2; ++lp) {
        const int le = 2 * lp, lod = 2 * lp + 1;
        PHASE_BEGIN(1) phase_poolprep(F, le, B_P, lp == 1, B_YS); PHASE_END
        PHASE_BEGIN(2) { PolPool S; S.G = F.G; S.c = F.bx; S.K = 256; S.lda = D; S.ldb = 256; S.P = B_P; S.W = (const bf16_t*)(B_W + W_POOL); S.src = mksrc(F); S.layer = le; S.scale = INP(F, I_POOLS) + (size_t)lp * D; S.npan = ML / 256; S.PART = B_PART;
                      ge::gemm_phase(F.lds, S, F.tid); } PHASE_END
        PHASE_BEGIN(3) { CtxFix fx; fx.PART = B_PART; fx.S = 2; fx.layer = le; fx.which = 2; fx.scale = INP(F, I_POOLS) + (size_t)lp * D; fx.from_input = le == 0; phase_norm(F, le, 3, B_P, false, fx); } PHASE_END
        PHASE_BEGIN(4) { PolUp<false> S; S.G = F.G; S.c = F.bx; S.K = D; S.lda = D; S.ldb = D; S.A = B_P; S.W = (const bf16_t*)(B_W + W_UP); S.HID = B_HID; S.ldh = DFF; S.nq = DFF / 128; S.nM = NPAN; S.s2t = nullptr;
                      ge::gemm_phase(F.lds, S, F.tid);
                      Frame F2 = F; if (idle_subgrid(F2, NPAN * S.nq)) convert_ssd(F2, lp); } PHASE_END
        PHASE_BEGIN(5) { PolResid S; S.G = F.G; S.c = F.bx; S.K = DFF; S.lda = DFF; S.ldb = DFF; S.A = B_HID; S.W = (const bf16_t*)(B_W + W_DN); S.src = mksrc(F); S.layer = le; S.which = 5; S.npan = ML / 256; S.nsl = DFF / 128; S.PART = B_PART;
                      ge::gemm_phase(F.lds, S, F.tid); } PHASE_END

        PHASE_BEGIN(6) { CtxFix fx; fx.PART = B_PART; fx.S = DFF / 128; fx.layer = le; fx.which = 5; fx.scale = nullptr; fx.from_input = false; phase_norm(F, lod, 0, B_U, false, fx); } PHASE_END
        PHASE_BEGIN(7) { PolInProj S; S.G = F.G; S.c = F.bx; S.K = D; S.lda = D; S.ldb = D; S.A = B_U; S.W = (const bf16_t*)(B_W + W_IN); S.Z = B_Z; S.XBC = B_XBC; S.DT = B_DT;
                      ge::gemm_phase(F.lds, S, F.tid); } PHASE_END
        PHASE_BEGIN(8) phase_conv(F, lp, B_XBC, B_XT, B_BROW, B_BT, B_CROW); PHASE_END
        PHASE_BEGIN(9) phase_cb(F, B_BROW, B_CROW, B_CB); { Frame F2 = F; if (idle_subgrid(F2, NB * NG * NCH)) phase_tables(F2, lp, B_DT, B_CUM, B_WJ, B_CF); } PHASE_END
        PHASE_BEGIN(10) phase_scan(F, lp, B_XT, B_BT, B_CROW, B_CB, B_DT, B_CUM, B_WJ, B_CF, B_YF, B_YB); PHASE_END
        PHASE_BEGIN(11) phase_gate(F, lp, B_YF, B_YB, B_Z, B_YN, lp == 1 ? ML : MT); PHASE_END
        PHASE_BEGIN(12) { PolResid S; S.G = F.G; S.c = F.bx; S.K = DIN; S.lda = DIN; S.ldb = DIN; S.A = B_YN; S.W = (const bf16_t*)(B_W + W_OUT); S.src = mksrc(F); S.layer = lod; S.which = 2; S.npan = lp == 1 ? ML / 256 : NPAN; S.nsl = 0; S.PART = nullptr;
                      ge::gemm_phase(F.lds, S, F.tid);
                      Frame F2 = F; if (idle_subgrid(F2, S.npan * 4)) convert_moe(F2, lp, false, true); } PHASE_END
        PHASE_BEGIN(13) phase_route(F, lod, lp, B_V, lp == 1 ? ML : MT); convert_moe(F, lp, true, false); PHASE_END
        PHASE_BEGIN(14) phase_slots(F, lp, lp == 1 ? ML : MT); PHASE_END
        PHASE_BEGIN(15) { int ts[NEXP + 1]; unsigned cnt[NEXP]; tile_starts(F, lp, ts, cnt);
                      PolUp<true> S; S.G = F.G; S.c = F.bx; S.K = D; S.lda = D; S.ldb = D; S.A = B_V; S.W = (const bf16_t*)(B_W + W_MUP); S.HID = B_HIDM; S.ldh = DFFE; S.nq = DFFE / 128; S.nM = ts[NEXP];
                      S.s2t = (const int*)(F.ws + OFF_S2T);
#pragma unroll
                      for (int e = 0; e <= NEXP; ++e) S.tstart[e] = ts[e];
                      ge::gemm_phase(F.lds, S, F.tid); } PHASE_END
        PHASE_BEGIN(16) { int ts[NEXP + 1]; unsigned cnt[NEXP]; tile_starts(F, lp, ts, cnt);
                      PolMoeDown S; S.G = F.G; S.c = F.bx; S.K = DFFE; S.lda = DFFE; S.ldb = DFFE; S.A = B_HIDM; S.W = (const bf16_t*)(B_W + W_MDN); S.YS = B_YS; S.nM = ts[NEXP];
#pragma unroll
                      for (int e = 0; e <= NEXP; ++e) S.tstart[e] = ts[e];
                      ge::gemm_phase(F.lds, S, F.tid);
                      if (lp == 0) { Frame F2 = F; if (idle_subgrid(F2, S.nM * 4)) convert_even(F2, 1); } } PHASE_END
        PHASE_BEGIN(17) phase_combine(F, lod, B_YS, lp == 1); PHASE_END
    }
#undef PHASE_BEGIN
#undef PHASE_END
    if (PROBE_TS_MASK != 0u && blockIdx.x == 0) { const unsigned long long t1 = NOWT(), wt = tsacc * (unsigned long long)PROBE_TS_MULT; while (NOWT() - t1 < wt) { } }
}

extern "C" void kernel_launch(void* const* d_in, const int* in_sizes, int n_in, void* d_out, int out_size, void* d_ws, size_t ws_size, hipStream_t stream) {
    static int grid = 0;
    if (grid == 0) {
        if (n_in != 26 || ws_size < WS_NEED) { fprintf(stderr, "kernel_launch: need 26 inputs and %zu bytes of workspace (got %d, %zu)\n", (size_t)WS_NEED, n_in, ws_size); grid = -1; return; }
        int dev = 0, cus = 0, per_cu = 0;
        if (hipGetDevice(&dev) != hipSuccess || hipDeviceGetAttribute(&cus, hipDeviceAttributeMultiprocessorCount, dev) != hipSuccess) { grid = -1; return; }
        if (hipFuncSetAttribute((const void*)fwd_kernel, hipFuncAttributeMaxDynamicSharedMemorySize, LDS_BYTES) != hipSuccess) { grid = -1; return; }
        if (hipOccupancyMaxActiveBlocksPerMultiprocessor(&per_cu, (const void*)fwd_kernel, 512, LDS_BYTES) != hipSuccess || per_cu < 1) { fprintf(stderr, "kernel_launch: occupancy query says %d\n", per_cu); }
        (void)hipGetLastError();
        grid = cus;
    }
    if (grid < 0) return;
    (void)in_sizes; (void)out_size;
    if (hipMemsetAsync((char*)d_ws + OFF_CTL, 0, CTL_BYTES, stream) != hipSuccess) return;
    Params p{};
    for (int i = 0; i < 26; ++i) p.in[i] = (const float*)d_in[i];
    p.out = (float*)d_out; p.ws = (unsigned char*)d_ws;
    if (N_LAUNCH_MODE == 1) { p.ph_lo = 0; p.ph_hi = N_PHASES; hipLaunchKernelGGL(fwd_kernel, dim3(grid), dim3(512), LDS_BYTES, stream, p); }
    else for (int ph = 0; ph < N_PHASES; ++ph) { p.ph_lo = ph; p.ph_hi = ph + 1; hipLaunchKernelGGL(fwd_kernel, dim3(grid), dim3(512), LDS_BYTES, stream, p); }
}
```

```cpp
#ifndef EMU
#include <hip/hip_runtime.h>
#endif
#include <cstdio>
#include <cstdint>

#ifndef CFG_SEQ
#define CFG_SEQ 16384
#endif
#ifndef CFG_DFF
#define CFG_DFF 2816
#endif
#ifndef CFG_DFFE
#define CFG_DFFE 3584
#endif
#ifndef MOE_DOWN_FP8
#define MOE_DOWN_FP8 1
#endif
#ifndef N_LAUNCH_MODE
#define N_LAUNCH_MODE 1
#endif

#ifdef EMU
#define LAS
#define DEV inline
#define WAITV(n) ((void)0)
#define WAITL(n) ((void)0)
#define SBAR() emu_wg_sync()
#define SCHED() ((void)0)
#define SETPRIO(x) ((void)0)
#define MFMA16(a, b, c) emu_mfma16(a, b, c)
#define GLDS16(g, l) emu_glds16((const void*)(g), (void*)(l))
#define GLDS4(g, l) emu_glds4((const void*)(g), (void*)(l))
#define MFMA8(a, b, c) emu_mfma8(a, b, c)
#define RFL(x) emu_rfl(x)
#define MEMFENCE() ((void)0)
#define WSYNC() emu_wave_sync()
#define LDSBAR() emu_wg_sync()
#define LAUNDER_V(x) ((void)0)
#define SLEEP1() emu_yield()
#define MY_XCC_ID() ((unsigned)(blockIdx.x & 7u))
#define FENCE_REL() __atomic_thread_fence(__ATOMIC_SEQ_CST)
#define FENCE_ACQ() __atomic_thread_fence(__ATOMIC_SEQ_CST)
#define FEXP(x) expf(x)
#define RLX_AGENT __ATOMIC_RELAXED, 4
#else
#define LAS __attribute__((address_space(3)))
#define DEV __device__ __forceinline__
#define WAITV(n) asm volatile("s_waitcnt vmcnt(" #n ")" ::: "memory")
#define WAITL(n) asm volatile("s_waitcnt lgkmcnt(" #n ")" ::: "memory")
#define SBAR() __builtin_amdgcn_s_barrier()
#define SCHED() __builtin_amdgcn_sched_barrier(0)
#define SETPRIO(x) __builtin_amdgcn_s_setprio(x)
#define MFMA16(a, b, c) __builtin_amdgcn_mfma_f32_16x16x32_bf16(a, b, c, 0, 0, 0)
#define GLDS16(g, l) __builtin_amdgcn_global_load_lds((const unsigned*)(g), (LAS unsigned*)(l), 16, 0, 0)
#define GLDS4(g, l) __builtin_amdgcn_global_load_lds((const unsigned*)(g), (LAS unsigned*)(l), 4, 0, 0)
#define MFMA8(a, b, c) __builtin_amdgcn_mfma_scale_f32_16x16x128_f8f6f4(a, b, c, 0, 0, 0, 0x7f7f7f7f, 0, 0x7f7f7f7f)
#define RFL(x) __builtin_amdgcn_readfirstlane(x)
#define MEMFENCE() asm volatile("" ::: "memory")
#define LDSBAR() do { asm volatile("s_waitcnt lgkmcnt(0)" ::: "memory"); __builtin_amdgcn_s_barrier(); asm volatile("" ::: "memory"); } while (0)
#define WSYNC() asm volatile("s_waitcnt lgkmcnt(0)" ::: "memory")
#define SLEEP1() __builtin_amdgcn_s_sleep(1)
#define MY_XCC_ID() ((unsigned)__builtin_amdgcn_s_getreg((3 << 11) | 20) & 0xFu)
#define FENCE_REL() __builtin_amdgcn_fence(__ATOMIC_RELEASE, "agent")
#define FENCE_ACQ() __builtin_amdgcn_fence(__ATOMIC_ACQUIRE, "agent")
#define FEXP(x) __expf(x)
#define RLX_AGENT __ATOMIC_RELAXED, __HIP_MEMORY_SCOPE_AGENT
#define LAUNDER_V(x) asm volatile("" : "+v"(x))
#endif

typedef unsigned short bf16_t;
typedef short bf16x8 __attribute__((ext_vector_type(8)));
typedef float f32x4 __attribute__((ext_vector_type(4)));
typedef float f32x2 __attribute__((ext_vector_type(2)));
typedef unsigned u32x4 __attribute__((ext_vector_type(4)));
typedef unsigned u32x2 __attribute__((ext_vector_type(2)));
typedef int i32x8 __attribute__((ext_vector_type(8)));
typedef int i32x4 __attribute__((ext_vector_type(4)));
typedef unsigned char fp8_t;

constexpr int D = 1024, NB = 2, SEQ = CFG_SEQ, CTXL = 256, DEPTH = 4;
constexpr int ML = NB * SEQ, MC = NB * CTXL, MT = ML + MC, NPAN = MT / 256;
constexpr int DFF = CFG_DFF, DFFE = CFG_DFFE, NEXP = 8;
constexpr int DIN = 2048, NH = 32, HD = 64, NG = 4, DS = 128, CONVD = 3072, NPROJ = 5184, NPROJP = 5376, BCD = 512;
constexpr int TV = CTXL + SEQ, NCH = TV / 128;
constexpr int GRIDW = 64;
constexpr float EPS = 1e-6f;
constexpr int NSLOT_TILES = (2 * MT) / 256 + NEXP, NSLOT = NSLOT_TILES * 256;
static_assert(SEQ % 128 == 0 && ML % 256 == 0 && DFF % 128 == 0 && DFFE % 128 == 0 && DFF >= 256 && DFFE >= 256, "shape constraints");

constexpr size_t MiB = 1u << 20;
constexpr size_t al(size_t x) { return (x + 4095) & ~(size_t)4095; }
constexpr size_t OFF_CTL = 0, CTL_BYTES = 1 * MiB;
constexpr size_t OFF_MOD = 1 * MiB;
constexpr size_t OFF_TOK = 2 * MiB;
constexpr size_t OFF_S2T = 3 * MiB;
constexpr size_t OFF_H = 4 * MiB, SZ_H = (size_t)MT * D * 4;
constexpr size_t OFF_W = OFF_H + al(SZ_H);
constexpr size_t W_POOL = 0, SZ_WPOOL = (size_t)4 * 256 * 256 * 2;
constexpr size_t W_UP = al(SZ_WPOOL), SZ_WUP = (size_t)2 * DFF * D * 2;
constexpr size_t W_DN = W_UP + al(SZ_WUP), SZ_WDN = (size_t)D * DFF * 2;
constexpr size_t SZ_WEVEN = W_DN + al(SZ_WDN);
constexpr size_t W_IN = SZ_WEVEN, SZ_WIN = (size_t)NPROJP * D * 2;
constexpr size_t W_OUT = W_IN + al(SZ_WIN), SZ_WOUT = (size_t)D * DIN * 2;
constexpr size_t W_DT = W_OUT + al(SZ_WOUT), SZ_DT = (size_t)NB * 2 * NH * TV * 4;
constexpr size_t W_MUP = W_DT + al(SZ_DT), SZ_WMUP = (size_t)NEXP * 2 * DFFE * D;
constexpr size_t W_MDN = W_MUP + al(SZ_WMUP), SZ_WMDN = (size_t)NEXP * D * DFFE * (MOE_DOWN_FP8 ? 1 : 2);
constexpr size_t W_YB = W_MUP, SZ_Y = (size_t)MT * DIN * 2;
constexpr size_t SZ_WODD_A = W_MDN + al(SZ_WMDN), SZ_WODD_B = W_YB + al(SZ_Y);
constexpr size_t mx(size_t a, size_t b) { return a > b ? a : b; }
constexpr size_t SZ_W = mx(SZ_WEVEN, mx(SZ_WODD_A, SZ_WODD_B));
constexpr size_t OFF_ACT = OFF_W + SZ_W;
constexpr size_t A_P = 0, SZ_ACT1 = (size_t)MT * D * 2;
constexpr size_t A_HID = al(SZ_ACT1), SZ_HID = (size_t)MT * DFF * 2;
constexpr size_t SZ_AEVEN = A_HID + al(SZ_HID);
constexpr size_t A_Z = 0;
constexpr size_t A_XBC = al(SZ_Y), SZ_XBC = (size_t)MT * CONVD * 2;
constexpr size_t A_YF = A_XBC;
constexpr size_t A_CB = A_XBC + al(SZ_Y), SZ_CB = (size_t)NB * NG * NCH * 128 * 128 * 2;
static_assert(al(SZ_Y) + SZ_CB <= SZ_XBC, "CB fits behind Yf inside the XBC region");
constexpr size_t A_XT = A_XBC + al(SZ_XBC), SZ_XT = (size_t)NB * DIN * TV * 2;
constexpr size_t A_U = A_XT, A_YN = A_XT;
constexpr size_t A_BROW = A_XT + al(SZ_XT), SZ_BC = (size_t)MT * BCD * 2;
constexpr size_t A_BT = A_BROW + al(SZ_BC);
constexpr size_t A_CROW = A_BT + al(SZ_BC);
constexpr size_t A_CUM = A_CROW + al(SZ_BC);
constexpr size_t A_WJ = A_CUM + al(SZ_DT);
constexpr size_t A_CF = A_WJ + al(SZ_DT);
constexpr size_t SZ_ASSD = A_CF + al(SZ_DT);
constexpr size_t A_V = 0;
constexpr size_t A_HIDM = al(SZ_ACT1), SZ_HIDM = (size_t)NSLOT * DFFE * 2;
constexpr size_t A_YS = A_HIDM + al(SZ_HIDM), SZ_YS = (size_t)NSLOT * D * 2;
constexpr size_t SZ_AMOE = A_YS + al(SZ_YS);
constexpr size_t SZ_ACT = mx(SZ_AEVEN, mx(SZ_ASSD, SZ_AMOE));
constexpr size_t WS_NEED = OFF_ACT + SZ_ACT;

constexpr int CW_BAR = 4096;
constexpr int CW_CNT = 16384;
constexpr int CW_CUR = 16384 + 2 * 8 * 64;

DEV unsigned f2bf(float f) { unsigned u = __builtin_bit_cast(unsigned, f); return (u + 0x7fffu + ((u >> 16) & 1u)) >> 16; }
#ifndef EMU
typedef __bf16 bf16x2n __attribute__((ext_vector_type(2)));
#endif
DEV unsigned pk2(float lo, float hi) {
#ifdef EMU
    return f2bf(lo) | (f2bf(hi) << 16);
#else
    f32x2 v = {lo, hi}; bf16x2n b = __builtin_convertvector(v, bf16x2n); return __builtin_bit_cast(unsigned, b);
#endif
}
DEV unsigned pk4_fp8(float a, float b, float c, float d) {
#ifdef EMU
    return emu_f2fp8(a) | (emu_f2fp8(b) << 8) | (emu_f2fp8(c) << 16) | (emu_f2fp8(d) << 24);
#else
    unsigned w = 0; w = __builtin_amdgcn_cvt_pk_fp8_f32(a, b, w, false); w = __builtin_amdgcn_cvt_pk_fp8_f32(c, d, w, true); return w;
#endif
}
DEV float bf2f(unsigned b) { return __builtin_bit_cast(float, b << 16); }
DEV float bflo(unsigned w) { return __builtin_bit_cast(float, w << 16); }
DEV float bfhi(unsigned w) { return __builtin_bit_cast(float, w & 0xffff0000u); }
#ifdef EMU
DEV float frcp(float x) { return 1.0f / x; }
#else
DEV float frcp(float x) { return __builtin_amdgcn_rcpf(x); }
#endif
#ifdef EMU
DEV float fexp2(float x) { return exp2f(x); }
#else
DEV float fexp2(float x) { return __builtin_amdgcn_exp2f(x); }
#endif
DEV float siluf(float x) { return x * frcp(1.0f + FEXP(-x)); }
#ifdef EMU
DEV float flog2(float x) { return log2f(x); }
#else
DEV float flog2(float x) { return __builtin_amdgcn_logf(x); }
#endif
DEV float softplusf(float x) { if (x > 20.f) return x; const float e = FEXP(x); return e < 0.0625f ? e * (1.0f - e * (0.5f - e * (0.33333334f - e * (0.25f - e * 0.2f)))) : flog2(1.0f + e) * 0.6931471806f; }
DEV float wave_sum(float v) {
#pragma unroll
    for (int o = 1; o < 64; o <<= 1) v += __shfl_xor(v, o);
    return v;
}
DEV int vec_of(int r) { return r < ML ? (r / SEQ) : 2; }
DEV int frag_off(int r, int c) { return ((r >> 4) * 4 + (c >> 5)) * 512 + ((c >> 3) & 3) * 128 + (r & 15) * 8 + (c & 7); }
DEV int row_of(int b, int tv) { return tv < CTXL ? ML + b * CTXL + tv : b * SEQ + (tv - CTXL); }

#define XB_TMO      128
#define XB_XCNT(j)  (256  + 64 * (j))
#define XB_XSUB(j)  (1280 + 64 * (j))
#define XB_XGEN(j)  (2304 + 64 * (j))
#define XB_TOP      3328
#define XB_TOPGEN   3392
#define XCD_BAR_WORDS 3456
#define XB_SPIN_CAP (1u << 22)
DEV unsigned xb_ld(unsigned* p)              { return __hip_atomic_load(p, RLX_AGENT); }
DEV unsigned xb_add(unsigned* p, unsigned v) { return __hip_atomic_fetch_add(p, v, RLX_AGENT); }
#define XB_SPIN(cond, bar) do { unsigned _sp = 0; while (cond) { SLEEP1(); \
    if ((++_sp & 255u) == 0u) { if (xb_ld(&(bar)[XB_TMO])) break; if (_sp > XB_SPIN_CAP) { atomicAdd(&(bar)[XB_TMO], 1u); break; } } } } while (0)
struct XcdBarrier { unsigned* bar; unsigned x; volatile LAS unsigned* st; };
DEV XcdBarrier xcd_barrier_post(unsigned* bar, volatile LAS unsigned* st) {
    XcdBarrier b; b.bar = bar; b.x = MY_XCC_ID(); b.st = st;
    if (threadIdx.x == 0) (void)xb_add(&bar[XB_XCNT(b.x)], 1u);
    return b;
}
DEV void xcd_barrier_complete(unsigned* bar, unsigned x, unsigned& nloc, unsigned& nx) {
    const unsigned G = gridDim.x;
    unsigned sum, cnt, mine, sp = 0u;
    for (;;) {
        sum = 0u; cnt = 0u; mine = 0u;
#pragma unroll
        for (unsigned j = 0; j < 16; ++j) { const unsigned c = xb_ld(&bar[XB_XCNT(j)]); sum += c; cnt += (c > 0u) ? 1u : 0u; mine = (j == x) ? c : mine; }
        if (sum == G) break;
        SLEEP1();
        if ((++sp & 255u) == 0u) { if (xb_ld(&bar[XB_TMO])) break; if (sp > XB_SPIN_CAP) { atomicAdd(&bar[XB_TMO], 1u); break; } }
    }
    nloc = mine > 0u ? mine : 1u; nx = cnt > 0u ? cnt : 1u;
}
DEV void xcd_barrier(const XcdBarrier& b) {
    WAITV(0);
    __syncthreads();
    if (threadIdx.x == 0) {
        unsigned* bar = b.bar;
#ifndef EMU
        __builtin_amdgcn_s_waitcnt(0);
#endif
        unsigned nloc = b.st[0], nx = b.st[1];
        if (nloc == 0u) { xcd_barrier_complete(bar, b.x, nloc, nx); b.st[0] = nloc; b.st[1] = nx; }
        const unsigned old = xb_add(&bar[XB_XSUB(b.x)], 1u);
        const unsigned gen = old / nloc;
        if (old + 1u == (gen + 1u) * nloc) {
            FENCE_REL();
            WAITV(0);
            const unsigned og = xb_add(&bar[XB_TOP], 1u);
            const unsigned tg = og / nx;
            if (og + 1u == (tg + 1u) * nx) xb_add(&bar[XB_TOPGEN], 1u);
            else XB_SPIN(xb_ld(&bar[XB_TOPGEN]) == tg, bar);
            FENCE_ACQ();
            xb_add(&bar[XB_XGEN(b.x)], 1u);
            WAITV(0);
        } else {
            XB_SPIN(xb_ld(&bar[XB_XGEN(b.x)]) == gen, bar);
            FENCE_ACQ();
            WAITV(0);
        }
    }
    __syncthreads();
}

namespace ge {
constexpr int BM = 256, BK = 64, HALF = 128, HTB = HALF * BK * 2, STAGE_BYTES = 8 * HTB, NXCD = 8, WGM = 8;
DEV int lds_byte(int r, int c) { const int st = (r >> 4) * 2 + (c >> 5), rr = r & 15, cc = c & 31, ob = rr * 64 + cc * 2; return st * 1024 + (ob ^ (((ob >> 9) & 1) << 5)); }
DEV void stage_rc(int b, int& R, int& C) { const int st = b / 1024, sb = b % 1024, swz = sb ^ (((sb >> 9) & 1) << 5); R = (st >> 1) * 16 + swz / 64; C = (st & 1) * 32 + (swz % 64) / 2; }
DEV int perm32(int rho) { const int n = rho >> 4, i = rho & 15; return 8 * (i >> 2) + 4 * n + (i & 3); }
struct Unit { int pm, pn; };
DEV bool static_next(int nM, int nN, int G, int c, int i, Unit& u) {
    const int nwg = nM * nN; const long L = (long)i * G + c; if (L >= nwg) return false;
    int wgid = (int)L; { const int q = nwg / NXCD, r = nwg % NXCD, xcd = wgid % NXCD, off = wgid / NXCD; wgid = (xcd < r ? xcd * (q + 1) : r * (q + 1) + (xcd - r) * q) + off; }
    const int nig = WGM * nN, gid = wgid / nig, fm = gid * WGM, gsz = (nM - fm) < WGM ? (nM - fm) : WGM;
    u.pm = fm + ((wgid % nig) % gsz); u.pn = (wgid % nig) / gsz; return true;
}
template <class P, bool SP2 = true>
DEV void gemm_phase(LAS unsigned char* lds, const P& S, const int tid) {
    const int wid = RFL(tid >> 6), lane = tid & 63, wr = wid >> 2, wc = wid & 3, fr = lane & 15, fq = lane >> 4;
    const int K = S.K; int nt = K * P::ES / (BK * 2);
    unsigned voffB[2]; int RA[2], CA2[2];
#pragma unroll
    for (int i = 0; i < 2; ++i) { int R, C; stage_rc(tid * 16 + i * 8192, R, C); const int Rb = P::PERM ? ((R & ~31) + perm32(R & 31)) : R;
        RA[i] = R; CA2[i] = C * 2; voffB[i] = (unsigned)(Rb * S.ldb) * (unsigned)P::ES + (unsigned)(C * 2); }
    const size_t kstep = (size_t)(BK * 2);
    const size_t hstepB = (size_t)HALF * S.ldb * P::ES;
    const unsigned ldsw = (unsigned)wid * 1024u;
    const int aoff = lds_byte(wr * 64 + fr, fq * 8), boff = lds_byte(wc * 32 + fr, fq * 8);
#define GE_SA(b, h) (((b) * 2 + (h)) * HTB)
#define GE_SB(b, h) ((4 + (b) * 2 + (h)) * HTB)
#define GE_STAGEB(bufoff, gbase) do { _Pragma("unroll") for (int _i = 0; _i < 2; ++_i) { unsigned _o = voffB[_i]; LAUNDER_V(_o); \
        GLDS16((const char*)(gbase) + _o, lds + (bufoff) + ldsw + _i * 8192); } } while (0)
#define GE_STAGEA(bufoff, gbase, h) do { _Pragma("unroll") for (int _i = 0; _i < 2; ++_i) { unsigned _o = oA[h][_i]; LAUNDER_V(_o); \
        GLDS16((const char*)(gbase) + _o, lds + (bufoff) + ldsw + _i * 8192); } } while (0)
#define GE_LD1(p_) __builtin_shufflevector(*(const LAS i32x4*)(p_), *(const LAS i32x4*)((p_) + 1024), 0, 1, 2, 3, 4, 5, 6, 7)
#define GE_LDA(dst, b, h) do { _Pragma("unroll") for (int m = 0; m < 4; ++m) dst[m] = GE_LD1(lds + GE_SA(b, h) + aoff + m * 2048); } while (0)
#define GE_LDB(dst, b, h) do { _Pragma("unroll") for (int n = 0; n < 2; ++n) dst[n] = GE_LD1(lds + GE_SB(b, h) + boff + n * 2048); } while (0)
#define GE_LO(x) __builtin_bit_cast(bf16x8, __builtin_shufflevector(x, x, 0, 1, 2, 3))
#define GE_HI(x) __builtin_bit_cast(bf16x8, __builtin_shufflevector(x, x, 4, 5, 6, 7))
#define GE_MMA(ai, bj, At, Bt) do { SETPRIO(1); _Pragma("unroll") for (int m = 0; m < 4; ++m) _Pragma("unroll") for (int n = 0; n < 2; ++n) { \
        if constexpr (P::FP8) acc[ai][bj][m][n] = MFMA8(Bt[n], At[m], acc[ai][bj][m][n]);     \
        else { acc[ai][bj][m][n] = MFMA16(GE_LO(Bt[n]), GE_LO(At[m]), acc[ai][bj][m][n]); acc[ai][bj][m][n] = MFMA16(GE_HI(Bt[n]), GE_HI(At[m]), acc[ai][bj][m][n]); } } SETPRIO(0); } while (0)
    Unit cur, nxt; int ui = 0;
    if (!S.next(0, cur)) return;
    f32x4 acc[2][2][4][2];
#pragma unroll
    for (int a = 0; a < 2; ++a)
#pragma unroll
        for (int b = 0; b < 2; ++b)
#pragma unroll
            for (int m = 0; m < 4; ++m)
#pragma unroll
                for (int n = 0; n < 2; ++n) acc[a][b][m][n] = (f32x4){0.f, 0.f, 0.f, 0.f};
    unsigned oA[2][2];
#pragma unroll
    for (int h = 0; h < 2; ++h)
#pragma unroll
        for (int i = 0; i < 2; ++i) {
            if constexpr (P::GATHER) oA[h][i] = (unsigned)S.gather_row(cur, h * HALF + RA[i]) * (unsigned)(S.lda * P::ES) + (unsigned)CA2[i];
            else oA[h][i] = (unsigned)((h * HALF + RA[i]) * S.lda) * (unsigned)P::ES + (unsigned)CA2[i];
            }
    const char* cA = S.a_base(cur); const char* cB = S.b_base(cur);
    if constexpr (SP2) {
        GE_STAGEB(GE_SB(0, 0), cB); GE_STAGEB(GE_SB(0, 1), cB + hstepB); GE_STAGEA(GE_SA(0, 0), cA, 0); GE_STAGEA(GE_SA(0, 1), cA, 1);
        if (wr == 1) SBAR();
        WAITV(2); SBAR();
        GE_STAGEB(GE_SB(1, 0), cB + kstep); GE_STAGEA(GE_SA(1, 0), cA + kstep, 0); GE_STAGEB(GE_SB(1, 1), cB + hstepB + kstep);
        WAITV(6); SBAR();
    } else {
    GE_STAGEB(GE_SB(0, 0), cB); GE_STAGEA(GE_SA(0, 0), cA, 0); GE_STAGEB(GE_SB(0, 1), cB + hstepB); GE_STAGEA(GE_SA(0, 1), cA, 1);
    if (wr == 1) SBAR();
    WAITV(4); SBAR();
    GE_STAGEB(GE_SB(1, 0), cB + kstep); GE_STAGEA(GE_SA(1, 0), cA + kstep, 0); GE_STAGEB(GE_SB(1, 1), cB + hstepB + kstep);
    WAITV(6); SBAR();
    }
    for (;;) {
        if constexpr (P::VARK) nt = S.unit_nt(cur);
        const bool has_next = S.next(ui + 1, nxt);
        const char* nA = has_next ? S.a_base(nxt) : cA; const char* nB = has_next ? S.b_base(nxt) : cB;
        for (int t = 0; t < nt; t += 2) {
            const bool last = (t == nt - 2);
            const char* a1 = cA + (size_t)(t + 1) * kstep;
            const char* a2 = last ? nA : cA + (size_t)(t + 2) * kstep; const char* b2 = last ? nB : cB + (size_t)(t + 2) * kstep;
            const char* a3 = a2 + kstep; const char* b3 = b2 + kstep;
            i32x8 At[4], B0[2], B1[2];
            if constexpr (SP2) {
            GE_LDB(B0, 0, 0); GE_LDB(B1, 0, 1); SCHED(); GE_LDA(At, 0, 0); GE_STAGEA(GE_SA(1, 1), a1, 1);
            WAITV(8); WAITL(0); SBAR(); GE_MMA(0, 0, At, B0); GE_MMA(0, 1, At, B1); SBAR(); SCHED();
            if constexpr (P::GATHER) { if (last && has_next) {
#pragma unroll
                for (int i = 0; i < 2; ++i) { int R2, C2; stage_rc(tid * 16 + i * 8192, R2, C2);
#pragma unroll
                    for (int h = 0; h < 2; ++h) oA[h][i] = (unsigned)S.gather_row(nxt, h * HALF + R2) * (unsigned)(S.lda * P::ES) + (unsigned)(C2 * 2); } } }
            GE_LDA(At, 0, 1); GE_STAGEB(GE_SB(0, 0), b2); GE_STAGEB(GE_SB(0, 1), b2 + hstepB); GE_STAGEA(GE_SA(0, 0), a2, 0);
            WAITV(8); WAITL(0); SBAR(); GE_MMA(1, 0, At, B0); GE_MMA(1, 1, At, B1); SBAR(); SCHED();
            GE_LDB(B0, 1, 0); GE_LDB(B1, 1, 1); SCHED(); GE_LDA(At, 1, 0); GE_STAGEA(GE_SA(0, 1), a2, 1);
            WAITV(8); WAITL(0); SBAR(); GE_MMA(0, 0, At, B0); GE_MMA(0, 1, At, B1); SBAR(); SCHED();
            GE_LDA(At, 1, 1); GE_STAGEB(GE_SB(1, 0), b3); GE_STAGEB(GE_SB(1, 1), b3 + hstepB); GE_STAGEA(GE_SA(1, 0), a3, 0);
            WAITV(8); WAITL(0); SBAR(); GE_MMA(1, 0, At, B0); GE_MMA(1, 1, At, B1); SBAR(); SCHED();
            } else {
            GE_LDB(B0, 0, 0); SCHED(); GE_LDA(At, 0, 0); GE_STAGEA(GE_SA(1, 1), a1, 1);
            WAITL(8); SBAR(); WAITL(0); GE_MMA(0, 0, At, B0); SBAR(); SCHED();
            if constexpr (P::GATHER) { if (last && has_next) {
#pragma unroll
                for (int i = 0; i < 2; ++i) { int R2, C2; stage_rc(tid * 16 + i * 8192, R2, C2);
#pragma unroll
                    for (int h = 0; h < 2; ++h) oA[h][i] = (unsigned)S.gather_row(nxt, h * HALF + R2) * (unsigned)(S.lda * P::ES) + (unsigned)(C2 * 2); } } }
            GE_LDB(B1, 0, 1); GE_STAGEB(GE_SB(0, 0), b2);
            SBAR(); WAITL(0); GE_MMA(0, 1, At, B1); SBAR();
            GE_LDA(At, 0, 1); GE_STAGEA(GE_SA(0, 0), a2, 0);
            SBAR(); WAITL(0); GE_MMA(1, 0, At, B0); SBAR(); SCHED();
            GE_STAGEB(GE_SB(0, 1), b2 + hstepB);
            WAITV(6); SBAR(); GE_MMA(1, 1, At, B1); SBAR();
            GE_LDB(B0, 1, 0); SCHED(); GE_LDA(At, 1, 0); GE_STAGEA(GE_SA(0, 1), a2, 1);
            WAITL(8); SBAR(); WAITL(0); GE_MMA(0, 0, At, B0); SBAR(); SCHED();
            GE_LDB(B1, 1, 1); GE_STAGEB(GE_SB(1, 0), b3);
            SBAR(); WAITL(0); GE_MMA(0, 1, At, B1); SBAR();
            GE_LDA(At, 1, 1); GE_STAGEA(GE_SA(1, 0), a3, 0);
            SBAR(); WAITL(0); GE_MMA(1, 0, At, B0); SBAR(); SCHED();
            GE_STAGEB(GE_SB(1, 1), b3 + hstepB);
            WAITV(6); SBAR(); GE_MMA(1, 1, At, B1); SBAR();
            }
        }
        if (wr == 0) SBAR();
        S.epi(acc, cur, wr, wc, fr, fq);
        if (!has_next) break;
#pragma unroll
        for (int a = 0; a < 2; ++a)
#pragma unroll
            for (int b = 0; b < 2; ++b)
#pragma unroll
                for (int m = 0; m < 4; ++m)
#pragma unroll
                    for (int n = 0; n < 2; ++n) acc[a][b][m][n] = (f32x4){0.f, 0.f, 0.f, 0.f};
        cur = nxt; cA = nA; cB = nB; ++ui;
        if (wr == 1) SBAR();
    }
    WAITV(0);
    SBAR();
#undef GE_SA
#undef GE_SB
#undef GE_STAGEA
#undef GE_STAGEB
#undef GE_LDA
#undef GE_LDB
#undef GE_MMA
#undef GE_LO
#undef GE_HI
#undef GE_LD1
}
}
using ge::Unit;

struct Params {
    const float* in[26];
    float* out; unsigned char* ws;
    int ph_lo, ph_hi;
};
enum { I_X = 0, I_C, I_CTX, I_CCTX, I_ADAW, I_ADAB, I_NMIX, I_NFFN, I_POOLW, I_POOLS, I_INW, I_CONVW, I_CONVB, I_ALOG, I_DTB, I_DSKIP, I_SNORM, I_OUTW,
       I_W1, I_W3, I_W2, I_RW, I_MW1, I_MW3, I_MW2, I_FNORM };

struct Frame {
    LAS unsigned char* lds;
    int tid, lane, wave, G, bx;
    const Params* p;
    unsigned char* ws;
    unsigned* ctl;
    float* H; float* mod;
};
#ifdef EMU
DEV const float* INP(const Frame& F, int i) { return F.p->in[i]; }
DEV float* OUTP(const Frame& F) { return F.p->out; }
DEV unsigned char* WSP(const Frame& F) { return F.p->ws; }
#define LAUNDER_S(x) ((void)0)
#else
typedef const float* cfptr_t;
DEV const float* INP(const Frame&, int i) { int k = i; asm volatile("" : "+s"(k)); return ((const __attribute__((address_space(4))) cfptr_t*)__builtin_amdgcn_kernarg_segment_ptr())[k]; }
DEV float* OUTP(const Frame& F) { return (float*)INP(F, 26); }
DEV unsigned char* WSP(const Frame& F) { return (unsigned char*)INP(F, 27); }
#define LAUNDER_S(x) asm volatile("" : "+s"(x))
#endif
constexpr int LDS_MISC = ge::STAGE_BYTES;
constexpr int LDS_BYTES = ge::STAGE_BYTES + 16384;

struct Src { const float* x; const float* ctx; float* H; const float* mod; };
DEV const float* modq(const float* mod, int layer, int vec, int which) { return mod + ((size_t)(layer * 3 + vec) * 6 + which) * D; }
DEV const float* modp(const Frame& F, int layer, int vec, int which) { return modq(F.mod, layer, vec, which); }
DEV const float* hsrc_row(const Src& s, bool from_input, int r) {
    if (from_input) return r < ML ? s.x + (size_t)r * D : s.ctx + (size_t)(r - ML) * D;
    return s.H + (size_t)r * D;
}
DEV Src mksrc(const Frame& F) { Src s; s.x = INP(F, I_X); s.ctx = INP(F, I_CTX); s.H = F.H; s.mod = F.mod; return s; }
DEV const float* hin_row(const Frame& F, int layer, int r) { return hsrc_row(mksrc(F), layer == 0, r); }

struct RmId { DEV int operator()(int n0) const { return n0; } };
struct RmIlv { int s; DEV int operator()(int n0) const { return (n0 >> 7) * 256 + s * 128 + (n0 & 127); } };
template <int K, int N, bool F8, class RM>
DEV void convert_job_t(const Frame& F, const float* Wsrc, void* WTv, int ldt, RM rowmap, float scale) {
    LAS float* scr = (LAS float*)(F.lds + F.wave * 16384);
    constexpr int items = (K / 64) * (N / 32), nblk = N / 32; const int gw = F.bx * 8 + F.wave, NGW = F.G * 8, lane = F.lane;
    float nx[32];
#define CJ_LOAD(it_) do { const int _kb = (it_) / nblk, _nb = (it_) % nblk; const float* _p = Wsrc + (size_t)(64 * _kb + (lane >> 5)) * N + 32 * _nb + (lane & 31); \
        _Pragma("unroll") for (int i = 0; i < 32; ++i) nx[i] = _p[(size_t)(2 * i) * N]; } while (0)
    if (gw < items) CJ_LOAD(gw);
    for (int it = gw; it < items; it += NGW) {
        const int kb = it / nblk, nb = it % nblk, k0 = 64 * kb, n0 = 32 * nb;
#pragma unroll
        for (int i = 0; i < 32; ++i) { const int kk = 2 * i + (lane >> 5); scr[kk * 33 + (lane & 31)] = F8 ? nx[i] * scale : nx[i]; }
        if (it + NGW < items) CJ_LOAD(it + NGW);
        WSYNC();
        const int c = lane & 7; const int row0 = rowmap(n0);
#pragma unroll
        for (int j = 0; j < 4; ++j) { const int n = (lane >> 3) + 8 * j; const LAS float* sp = scr + (8 * c) * 33 + n;
            if (F8) { u32x2 o; o.x = pk4_fp8(sp[0 * 33], sp[1 * 33], sp[2 * 33], sp[3 * 33]); o.y = pk4_fp8(sp[4 * 33], sp[5 * 33], sp[6 * 33], sp[7 * 33]);
                *(u32x2*)((fp8_t*)WTv + (size_t)(row0 + n) * ldt + k0 + 8 * c) = o; }
            else { u32x4 o; o.x = pk2(sp[0 * 33], sp[1 * 33]); o.y = pk2(sp[2 * 33], sp[3 * 33]); o.z = pk2(sp[4 * 33], sp[5 * 33]); o.w = pk2(sp[6 * 33], sp[7 * 33]);
                *(u32x4*)((bf16_t*)WTv + (size_t)(row0 + n) * ldt + k0 + 8 * c) = o; } }
        WSYNC();
    }
#undef CJ_LOAD
}
template <int K, int N, class RM> DEV void convert_job(const Frame& F, const float* Wsrc, bf16_t* WT, int ldt, RM rm) { convert_job_t<K, N, false>(F, Wsrc, WT, ldt, rm, 1.0f); }
template <int K, int N, class RM> DEV void convert_job_fp8(const Frame& F, const float* Wsrc, fp8_t* WT, int ldt, RM rm, float scale) { convert_job_t<K, N, true>(F, Wsrc, WT, ldt, rm, scale); }
DEV bool idle_subgrid(Frame& F2, int nwg) { const int rem = nwg % F2.G; if (rem == 0) return true; if (F2.bx < rem) return false; F2.bx -= rem; F2.G -= rem; return true; }
DEV void convert_even(const Frame& F, int j) {
    bf16_t* Wb = (bf16_t*)(F.ws + OFF_W);
    for (int g = 0; g < 4; ++g) convert_job<256, 256>(F, INP(F, I_POOLW) + ((size_t)j * 4 + g) * 65536, Wb + W_POOL / 2 + (size_t)g * 65536, 256, RmId{});
    convert_job<D, DFF>(F, INP(F, I_W1) + (size_t)j * D * DFF, Wb + W_UP / 2, D, RmIlv{0});
    convert_job<D, DFF>(F, INP(F, I_W3) + (size_t)j * D * DFF, Wb + W_UP / 2, D, RmIlv{1});
    convert_job<DFF, D>(F, INP(F, I_W2) + (size_t)j * DFF * D, Wb + W_DN / 2, DFF, RmId{});
}
DEV void convert_ssd(const Frame& F, int j) {
    bf16_t* Wb = (bf16_t*)(F.ws + OFF_W);
    convert_job<D, NPROJ>(F, INP(F, I_INW) + (size_t)j * D * NPROJ, Wb + W_IN / 2, D, RmId{});
    convert_job<DIN, D>(F, INP(F, I_OUTW) + (size_t)j * DIN * D, Wb + W_OUT / 2, DIN, RmId{});
    { u32x4* z = (u32x4*)(Wb + W_IN / 2 + (size_t)NPROJ * D); const int n16 = (NPROJP - NPROJ) * D * 2 / 16;
      unsigned zz = 0u; LAUNDER_V(zz);
      for (int i = F.bx * 512 + F.tid; i < n16; i += F.G * 512) z[i] = (u32x4){zz, zz, zz, zz}; }
}
DEV void convert_moe(const Frame& F, int j, bool up, bool down) {
    fp8_t* Wb = (fp8_t*)(F.ws + OFF_W);
    for (int e = 0; e < NEXP; ++e) {
        if (up) {
        convert_job_fp8<D, DFFE>(F, INP(F, I_MW1) + ((size_t)j * NEXP + e) * D * DFFE, Wb + W_MUP + (size_t)e * 2 * DFFE * D, D, RmIlv{0}, 32.0f);
        convert_job_fp8<D, DFFE>(F, INP(F, I_MW3) + ((size_t)j * NEXP + e) * D * DFFE, Wb + W_MUP + (size_t)e * 2 * DFFE * D, D, RmIlv{1}, 32.0f); }
        if (!down) continue;
        if (MOE_DOWN_FP8) convert_job_fp8<DFFE, D>(F, INP(F, I_MW2) + ((size_t)j * NEXP + e) * DFFE * D, Wb + W_MDN + (size_t)e * D * DFFE, DFFE, RmId{}, 64.0f);
        else convert_job<DFFE, D>(F, INP(F, I_MW2) + ((size_t)j * NEXP + e) * DFFE * D, (bf16_t*)(Wb + W_MDN) + (size_t)e * D * DFFE, DFFE, RmId{});
    }
}

DEV void phase_mod(const Frame& F) {
    LAS float* red = (LAS float*)F.lds;
    LAS float* sc = (LAS float*)(F.lds + 8192);
    constexpr int nblk = DEPTH * 6144 / 32;
    const int col = F.tid & 31, ks = F.tid >> 5;
    for (int i = F.tid; i < 3 * D; i += 512) { const int v = i >> 10, k = i & (D - 1); sc[i] = siluf(v == 2 ? INP(F, I_CCTX)[k] : INP(F, I_C)[v * D + k]); }
    __syncthreads();
    for (int blk = F.bx; blk < nblk; blk += F.G) {
        const int layer = (blk * 32) / 6144, n = (blk * 32) % 6144 + col;
        const float* W = INP(F, I_ADAW) + (size_t)layer * D * 6144 + n;
        float a0 = 0.f, a1 = 0.f, a2 = 0.f;
#pragma unroll 1
        for (int kb = ks * 64; kb < ks * 64 + 64; kb += 16) {
            float wv[16];
#pragma unroll
            for (int k = 0; k < 16; ++k) wv[k] = W[(size_t)(kb + k) * 6144];
#pragma unroll
            for (int k = 0; k < 16; ++k) { a0 += sc[kb + k] * wv[k]; a1 += sc[D + kb + k] * wv[k]; a2 += sc[2 * D + kb + k] * wv[k]; } }
        red[(ks * 32 + col) * 3 + 0] = a0; red[(ks * 32 + col) * 3 + 1] = a1; red[(ks * 32 + col) * 3 + 2] = a2;
        __syncthreads();
        if (F.tid < 96) { const int c2 = F.tid & 31, v = F.tid >> 5; float s = 0.f;
            for (int q = 0; q < 16; ++q) s += red[(q * 32 + c2) * 3 + v];
            const int n2 = (blk * 32) % 6144 + c2;
            F.mod[(size_t)(layer * 3 + v) * 6144 + n2] = s + INP(F, I_ADAB)[(size_t)layer * 6144 + n2]; }
        __syncthreads();
    }
}

DEV void load_row(const float* p, int lane, f32x4 (&v)[4]) {
#pragma unroll
    for (int j = 0; j < 4; ++j) v[j] = *(const f32x4*)(p + 4 * lane + 256 * j);
}
DEV float sumsq_row(const f32x4 (&v)[4]) { float s = 0.f;
#pragma unroll
    for (int j = 0; j < 4; ++j) s += (v[j][0] * v[j][0] + v[j][1] * v[j][1]) + (v[j][2] * v[j][2] + v[j][3] * v[j][3]);
    return wave_sum(s); }
DEV void normmod_row(f32x4 (&v)[4], float rstd, const float* w, const float* sh, const float* sc, int lane) {
#pragma unroll
    for (int j = 0; j < 4; ++j) { const int c = 4 * lane + 256 * j; const f32x4 wv = *(const f32x4*)(w + c), sv = *(const f32x4*)(sh + c), cv = *(const f32x4*)(sc + c);
        v[j] = v[j] * rstd * wv * (cv + 1.0f) + sv; }
}
DEV void store_row_bf16(bf16_t* o, int lane, const f32x4 (&v)[4]) {
#pragma unroll
    for (int j = 0; j < 4; ++j) { u32x2 w; w.x = pk2(v[j][0], v[j][1]); w.y = pk2(v[j][2], v[j][3]); *(u32x2*)(o + 4 * lane + 256 * j) = w; }
}

struct CtxFix { const float* PART; int S, layer, which; const float* scale; bool from_input; };
DEV void phase_norm(const Frame& F, int layer, int which, bf16_t* out, bool from_input, const CtxFix fx) {
    const int gw = F.bx * 8 + F.wave, NGW = F.G * 8;
    const float* w = INP(F, which == 0 ? I_NMIX : I_NFFN) + (size_t)layer * D;
    const int nrows = fx.PART ? ML : MT;
    constexpr int NS = 3;
    f32x4 ns[NS][4];
#pragma unroll
    for (int k = 0; k < NS; ++k) if (gw + k * NGW < nrows) load_row(hsrc_row(mksrc(F), from_input, gw + k * NGW), F.lane, ns[k]);
    for (int r0 = gw; r0 < nrows; r0 += NS * NGW) {
#pragma unroll
        for (int k = 0; k < NS; ++k) { const int r = r0 + k * NGW; if (r >= nrows) break;
            f32x4 v[4];
#pragma unroll
            for (int q = 0; q < 4; ++q) v[q] = ns[k][q];
            if (r + NS * NGW < nrows) load_row(hsrc_row(mksrc(F), from_input, r + NS * NGW), F.lane, ns[k]);
            const float rstd = rsqrtf(sumsq_row(v) * (1.0f / D) + EPS);
            const int vec = vec_of(r);
            normmod_row(v, rstd, w, modp(F, layer, vec, which), modp(F, layer, vec, which + 1), F.lane);
            store_row_bf16(out + (size_t)r * D, F.lane, v); }
    }
    if (fx.PART) {
        const Src src = mksrc(F); const float* gp = modq(src.mod, fx.layer, 2, fx.which);
        for (int r = ML + gw; r < MT; r += NGW) {
            f32x4 v[4], y[4], g[4];
            load_row(hsrc_row(src, fx.from_input, r), F.lane, v); load_row(gp, F.lane, g);
            if (fx.scale) { f32x4 sc[4]; load_row(fx.scale, F.lane, sc);
#pragma unroll
                for (int q = 0; q < 4; ++q) g[q] = g[q] * sc[q]; }
#pragma unroll
            for (int q = 0; q < 4; ++q) y[q] = (f32x4){0.f, 0.f, 0.f, 0.f};
            int sl = 0;
            for (; sl + 2 <= fx.S; sl += 2) { f32x4 t0[4], t1[4];
                load_row(fx.PART + ((size_t)sl * MC + (r - ML)) * D, F.lane, t0); load_row(fx.PART + ((size_t)(sl + 1) * MC + (r - ML)) * D, F.lane, t1);
#pragma unroll
                for (int q = 0; q < 4; ++q) { y[q] += t0[q]; y[q] += t1[q]; } }
            for (; sl < fx.S; ++sl) { f32x4 t0[4]; load_row(fx.PART + ((size_t)sl * MC + (r - ML)) * D, F.lane, t0);
#pragma unroll
                for (int q = 0; q < 4; ++q) y[q] += t0[q]; }
#pragma unroll
            for (int q = 0; q < 4; ++q) { v[q] = v[q] + g[q] * y[q]; *(f32x4*)(src.H + (size_t)r * D + 4 * F.lane + 256 * q) = v[q]; }
            const float rstd = rsqrtf(sumsq_row(v) * (1.0f / D) + EPS);
            normmod_row(v, rstd, w, modp(F, layer, 2, which), modp(F, layer, 2, which + 1), F.lane);
            store_row_bf16(out + (size_t)r * D, F.lane, v); }
    }
}

struct TokInfo { int s0, s1; float g0, g1; };
DEV void phase_poolprep(const Frame& F, int layer, bf16_t* P, bool fuse, const bf16_t* YS) {
    const TokInfo* tok = (const TokInfo*)(F.ws + OFF_TOK);
    LAS bf16_t* ub = (LAS bf16_t*)(F.lds);
    LAS float* rs = (LAS float*)(F.lds + 81920);
    const float* w = INP(F, I_NMIX) + (size_t)layer * D;
    constexpr int CTH = 4, NLT = ML / 64; const int ntile = NLT + MC / CTH;
    const int chunk = F.tid & 127, tg = F.tid >> 7;
    for (int tile = F.bx; tile < ntile; tile += F.G) {
        const int r0 = tile < NLT ? tile * 64 : ML + (tile - NLT) * CTH; const int th = tile < NLT ? 64 : CTH;
        if (r0 < ML) {
            LAS bf16_t* ul = (LAS bf16_t*)(F.lds);
            const int vec = vec_of(r0);
            { f32x4 wc[4], sv[4], g2[4];
#pragma unroll
              for (int jq = 0; jq < 4; ++jq) { const int c = 4 * F.lane + 256 * jq; wc[jq] = *(const f32x4*)(w + c) * (*(const f32x4*)(modp(F, layer, vec, 1) + c) + 1.0f); sv[jq] = *(const f32x4*)(modp(F, layer, vec, 0) + c);
                  g2[jq] = fuse ? *(const f32x4*)(modp(F, layer - 1, vec, 5) + c) * (MOE_DOWN_FP8 ? 0.00390625f : 1.0f) : (f32x4){0.f, 0.f, 0.f, 0.f}; }
              f32x4 nh[4]; u32x2 nya[4], nyb[4]; TokInfo tn; tn.s0 = tn.s1 = 0; tn.g0 = tn.g1 = 0.f;
              { const int r = r0 + F.wave; load_row(hin_row(F, layer, r), F.lane, nh);
                if (fuse) { tn = tok[r];
#pragma unroll
                    for (int jq = 0; jq < 4; ++jq) { const int c = 4 * F.lane + 256 * jq; nya[jq] = *(const u32x2*)(YS + (size_t)tn.s0 * D + c); nyb[jq] = *(const u32x2*)(YS + (size_t)tn.s1 * D + c); } } }
#pragma unroll 1
              for (int k = 0; k < 8; ++k) { const int rl = F.wave + 8 * k, r = r0 + rl;
                  f32x4 v[4]; u32x2 ya[4], yb[4]; const TokInfo ti = tn;
#pragma unroll
                  for (int q = 0; q < 4; ++q) { v[q] = nh[q]; ya[q] = nya[q]; yb[q] = nyb[q]; }
                  if (k < 7) { load_row(hin_row(F, layer, r + 8), F.lane, nh);
                      if (fuse) { tn = tok[r + 8];
#pragma unroll
                          for (int jq = 0; jq < 4; ++jq) { const int c = 4 * F.lane + 256 * jq; nya[jq] = *(const u32x2*)(YS + (size_t)tn.s0 * D + c); nyb[jq] = *(const u32x2*)(YS + (size_t)tn.s1 * D + c); } } }
                  if (fuse) {
#pragma unroll
                      for (int jq = 0; jq < 4; ++jq) { const u32x2 a = ya[jq], b = yb[jq];
                          v[jq][0] += g2[jq][0] * (ti.g0 * bflo(a.x) + ti.g1 * bflo(b.x)); v[jq][1] += g2[jq][1] * (ti.g0 * bfhi(a.x) + ti.g1 * bfhi(b.x));
                          v[jq][2] += g2[jq][2] * (ti.g0 * bflo(a.y) + ti.g1 * bflo(b.y)); v[jq][3] += g2[jq][3] * (ti.g0 * bfhi(a.y) + ti.g1 * bfhi(b.y));
                          *(f32x4*)(F.H + (size_t)r * D + 4 * F.lane + 256 * jq) = v[jq]; } }
                  const float rstd = rsqrtf(sumsq_row(v) * (1.0f / D) + EPS);
#pragma unroll
                  for (int jq = 0; jq < 4; ++jq) { const f32x4 u = v[jq] * rstd * wc[jq] + sv[jq]; u32x2 pw; pw.x = pk2(u[0], u[1]); pw.y = pk2(u[2], u[3]);
                      *(LAS u32x2*)(ul + rl * 1024 + 4 * F.lane + 256 * jq) = pw; } } }
            __syncthreads();
            { const int cq = F.tid & 255, hf = F.tid >> 8, c = cq * 4, g = c >> 8, win = 2 << g, lo = win >> 1, hi = win - 1 - lo;
#define PL_U(t_) ({ const u32x2 _q = *(const LAS u32x2*)(ul + (t_) * 1024 + c); (f32x4){bflo(_q.x), bfhi(_q.x), bflo(_q.y), bfhi(_q.y)}; })
              const int ta = 32 * hf;
              f32x4 sacc = (f32x4){0.f, 0.f, 0.f, 0.f};
              { const int a = (ta - lo > 0) ? ta - lo : 0, b = (ta + hi + 1 < 64) ? ta + hi + 1 : 64; for (int t = a; t < b; ++t) sacc += PL_U(t); }
              for (int t = ta; t < ta + 32; ++t) {
                  const int a = (t - lo > 0) ? t - lo : 0, b = (t + hi + 1 < 64) ? t + hi + 1 : 64;
                  const float inv = 1.0f / (float)(b - a);
                  const f32x4 o = sacc * inv - PL_U(t);
                  u32x2 pw; pw.x = pk2(o[0], o[1]); pw.y = pk2(o[2], o[3]); *(u32x2*)(P + (size_t)(r0 + t) * D + c) = pw;
                  if (t + 1 < ta + 32) { if (t + 1 + hi < 64) sacc += PL_U(t + 1 + hi); if (t - lo >= 0) sacc -= PL_U(t - lo); } }
#undef PL_U
            }
            __syncthreads();
            continue;
        }
        int seq0, seq1;
        if (r0 < ML) { seq0 = r0; seq1 = r0 + 64; } else { seq0 = ML + ((r0 - ML) / CTXL) * CTXL; seq1 = seq0 + CTXL; }
        const int lo_r = (r0 - 8 > seq0) ? r0 - 8 : seq0, hi_r = (r0 + th + 7 < seq1) ? r0 + th + 7 : seq1;
        const int nrow = hi_r - lo_r;
        for (int rb = lo_r + F.wave; rb < hi_r; rb += 16) {
            f32x4 v5[2][4];
#pragma unroll
            for (int k = 0; k < 2; ++k) { const int r = rb + 8 * k; if (r < hi_r) load_row(hin_row(F, layer, r), F.lane, v5[k]); }
#pragma unroll
            for (int k = 0; k < 2; ++k) { const int r = rb + 8 * k; if (r < hi_r) { const float ss = sumsq_row(v5[k]); if (F.lane == 0) rs[r - lo_r] = rsqrtf(ss * (1.0f / D) + EPS); } } }
        __syncthreads();
        const int vec = vec_of(r0);
#pragma unroll 1
        for (int half = 0; half < 2; ++half) {
            const int c = half * 512 + 4 * chunk, g = c >> 8, win = 2 << g, lo = win >> 1, hi = win - 1 - lo;
            const f32x4 wv = *(const f32x4*)(w + c), sv = *(const f32x4*)(modp(F, layer, vec, 0) + c), cv = *(const f32x4*)(modp(F, layer, vec, 1) + c) + 1.0f;
            const f32x4 wc = wv * cv;
#pragma unroll 1
            for (int kb = 0; kb < 20; kb += 5) {
                f32x4 hv[5];
#pragma unroll
                for (int k = 0; k < 5; ++k) { const int rr = tg + 4 * (kb + k); if (rr < nrow) hv[k] = *(const f32x4*)(hin_row(F, layer, lo_r + rr) + c); }
#pragma unroll
                for (int k = 0; k < 5; ++k) { const int rr = tg + 4 * (kb + k); if (rr < nrow) { const f32x4 u = hv[k] * rs[rr] * wc + sv;
                    u32x2 pw; pw.x = pk2(u[0], u[1]); pw.y = pk2(u[2], u[3]); *(LAS u32x2*)(ub + rr * 512 + 4 * chunk) = pw; } } }
            __syncthreads();
#define PP_U(r_) ({ const u32x2 _q = *(const LAS u32x2*)(ub + ((r_) - lo_r) * 512 + 4 * chunk); (f32x4){bflo(_q.x), bfhi(_q.x), bflo(_q.y), bfhi(_q.y)}; })
            const int tq = th >> 2, ta = r0 + tq * tg;
            f32x4 s = (f32x4){0.f, 0.f, 0.f, 0.f};
            { const int a = (ta - lo > seq0) ? ta - lo : seq0, b = (ta + hi + 1 < seq1) ? ta + hi + 1 : seq1; for (int r = a; r < b; ++r) s += PP_U(r); }
            for (int t = ta; t < ta + tq; ++t) {
                const int a = (t - lo > seq0) ? t - lo : seq0, b = (t + hi + 1 < seq1) ? t + hi + 1 : seq1;
                const float inv = 1.0f / (float)(b - a);
                const f32x4 o = s * inv - PP_U(t);
                u32x2 pw; pw.x = pk2(o[0], o[1]); pw.y = pk2(o[2], o[3]); *(u32x2*)(P + (size_t)t * D + c) = pw;
                if (t + 1 < ta + tq) {
                    if (t + 1 + hi < seq1) s += PP_U(t + 1 + hi);
                    if (t - lo >= seq0) s -= PP_U(t - lo); }
            }
#undef PP_U
            __syncthreads();
        }
    }
}

struct PolBase { int G, c; static constexpr bool VARK = false; };
DEV bool ctx_next(int npan, int nsl, int G, int c, int i, Unit& u) {
    const int nmain = npan * 4; const long L = (long)i * G + c;
    if (L < nmain) return ge::static_next(npan, 4, G, c, i, u);
    const long L2 = L - nmain; if (L2 >= 8L * nsl) return false;
    const int t = (int)(L2 & 7); u.pm = ML / 256 + (t >> 2); u.pn = (t & 3) + 4 * (1 + (int)(L2 >> 3)); return true;
}
DEV int ctx_koff(const Unit& u) { return (u.pn >> 2) ? ((u.pn >> 2) - 1) * 128 : 0; }
DEV void ctx_store(float* PART, const f32x4 (&acc)[2][2][4][2], const Unit& u, int wr, int wc, int fr, int fq) {
    float* o = PART + ((size_t)((u.pn >> 2) - 1) * MC + (u.pm * 256 - ML) + wr * 64 + fr) * D + (u.pn & 3) * 256 + wc * 32 + 4 * fq;
#pragma unroll
    for (int ai = 0; ai < 2; ++ai)
#pragma unroll
        for (int m = 0; m < 4; ++m)
#pragma unroll
            for (int bj = 0; bj < 2; ++bj)
#pragma unroll
                for (int n = 0; n < 2; ++n) *(f32x4*)(o + (size_t)(ai * 128 + m * 16) * D + bj * 128 + n * 16) = acc[ai][bj][m][n];
}
struct PolPool : PolBase {
    static constexpr bool PERM = false, GATHER = false; static constexpr bool FP8 = false; static constexpr int ES = 2; int K, lda, ldb;
    static constexpr bool VARK = true;
    const bf16_t* P; const bf16_t* W; Src src; int layer, npan; const float* scale; float* PART;
    DEV bool next(int i, Unit& u) const { return ctx_next(npan, 2, G, c, i, u); }
    DEV int unit_nt(const Unit& u) const { return (u.pn >> 2) ? 2 : 4; }
    DEV const char* a_base(const Unit& u) const { return (const char*)(P + (size_t)u.pm * 256 * D + (u.pn & 3) * 256 + ctx_koff(u)); }
    DEV const char* b_base(const Unit& u) const { return (const char*)(W + (size_t)(u.pn & 3) * 65536 + ctx_koff(u)); }
    DEV void epi(const f32x4 (&acc)[2][2][4][2], const Unit& u, int wr, int wc, int fr, int fq) const {
        if (u.pn >> 2) { ctx_store(PART, acc, u, wr, wc, fr, fq); return; }
        const int row0 = u.pm * 256 + wr * 64 + fr, col0 = u.pn * 256 + wc * 32 + 4 * fq; const int vec = vec_of(u.pm * 256);
        const float* g1 = modq(src.mod, layer, vec, 2);
        f32x4 gv[2][2];
#pragma unroll
        for (int bj = 0; bj < 2; ++bj)
#pragma unroll
            for (int n = 0; n < 2; ++n) { const int cc = col0 + bj * 128 + n * 16; gv[bj][n] = *(const f32x4*)(g1 + cc) * *(const f32x4*)(scale + cc); }
#pragma unroll
        for (int ai = 0; ai < 2; ++ai)
#pragma unroll
            for (int mp = 0; mp < 4; mp += 2) { f32x4 hv[2][2][2];
#pragma unroll
                for (int m2 = 0; m2 < 2; ++m2) { const float* hi = hsrc_row(src, layer == 0, row0 + ai * 128 + (mp + m2) * 16) + col0;
#pragma unroll
                    for (int bj = 0; bj < 2; ++bj)
#pragma unroll
                        for (int n = 0; n < 2; ++n) hv[m2][bj][n] = *(const f32x4*)(hi + bj * 128 + n * 16); }
#pragma unroll
                for (int m2 = 0; m2 < 2; ++m2) { float* ho = src.H + (size_t)(row0 + ai * 128 + (mp + m2) * 16) * D + col0;
#pragma unroll
                    for (int bj = 0; bj < 2; ++bj)
#pragma unroll
                        for (int n = 0; n < 2; ++n) *(f32x4*)(ho + bj * 128 + n * 16) = hv[m2][bj][n] + gv[bj][n] * acc[ai][bj][mp + m2][n]; } }
    }
};
struct PolResid : PolBase {
    static constexpr bool PERM = false, GATHER = false; static constexpr bool FP8 = false; static constexpr int ES = 2; int K, lda, ldb;
    static constexpr bool VARK = true;
    const bf16_t* A; const bf16_t* W; Src src; int layer, which, npan, nsl; float* PART;
    DEV bool next(int i, Unit& u) const { return ctx_next(npan, nsl, G, c, i, u); }
    DEV int unit_nt(const Unit& u) const { return (u.pn >> 2) ? 2 : K / 64; }
    DEV const char* a_base(const Unit& u) const { return (const char*)(A + (size_t)u.pm * 256 * lda + ctx_koff(u)); }
    DEV const char* b_base(const Unit& u) const { return (const char*)(W + (size_t)(u.pn & 3) * 256 * ldb + ctx_koff(u)); }
    DEV void epi(const f32x4 (&acc)[2][2][4][2], const Unit& u, int wr, int wc, int fr, int fq) const {
        if (u.pn >> 2) { ctx_store(PART, acc, u, wr, wc, fr, fq); return; }
        const int row0 = u.pm * 256 + wr * 64 + fr, col0 = u.pn * 256 + wc * 32 + 4 * fq; const int vec = vec_of(u.pm * 256);
        const float* gp = modq(src.mod, layer, vec, which);
        f32x4 gv[2][2];
#pragma unroll
        for (int bj = 0; bj < 2; ++bj)
#pragma unroll
            for (int n = 0; n < 2; ++n) gv[bj][n] = *(const f32x4*)(gp + col0 + bj * 128 + n * 16);
#pragma unroll
        for (int ai = 0; ai < 2; ++ai)
#pragma unroll
            for (int mp = 0; mp < 4; mp += 2) { f32x4 hv[2][2][2];
#pragma unroll
                for (int m2 = 0; m2 < 2; ++m2) { const float* hi = src.H + (size_t)(row0 + ai * 128 + (mp + m2) * 16) * D + col0;
#pragma unroll
                    for (int bj = 0; bj < 2; ++bj)
#pragma unroll
                        for (int n = 0; n < 2; ++n) hv[m2][bj][n] = *(const f32x4*)(hi + bj * 128 + n * 16); }
#pragma unroll
                for (int m2 = 0; m2 < 2; ++m2) { float* ho = src.H + (size_t)(row0 + ai * 128 + (mp + m2) * 16) * D + col0;
#pragma unroll
                    for (int bj = 0; bj < 2; ++bj)
#pragma unroll
                        for (int n = 0; n < 2; ++n) *(f32x4*)(ho + bj * 128 + n * 16) = hv[m2][bj][n] + gv[bj][n] * acc[ai][bj][mp + m2][n]; } }
    }
};
template <bool MOE>
struct PolUp : PolBase {
    static constexpr bool PERM = true, GATHER = MOE, FP8 = MOE; static constexpr int ES = MOE ? 1 : 2; int K, lda, ldb;
    const bf16_t* A; const bf16_t* W; bf16_t* HID; int ldh, nq;
    int nM; const int* s2t; int tstart[NEXP + 1];
    DEV bool next(int i, Unit& u) const { return ge::static_next(MOE ? nM : NPAN, nq, G, c, i, u); }
    DEV int expert_of(int pm) const { int e = 0;
#pragma unroll
        for (int k = 1; k < NEXP; ++k) e += (pm >= tstart[k]) ? 1 : 0;
        return e; }
    DEV const char* a_base(const Unit& u) const { return MOE ? (const char*)A : (const char*)(A + (size_t)u.pm * 256 * lda); }
    DEV const char* b_base(const Unit& u) const { size_t off = (size_t)u.pn * 256 * ldb; if (MOE) off += (size_t)expert_of(u.pm) * 2 * DFFE * ldb; return (const char*)W + off * ES; }
    DEV int gather_row(const Unit& u, int R) const { return s2t[u.pm * 256 + R]; }
    DEV void epi(const f32x4 (&acc)[2][2][4][2], const Unit& u, int wr, int wc, int fr, int fq) const {
        const int row0 = u.pm * 256 + wr * 64 + fr, col0 = u.pn * 128 + wc * 32 + 8 * fq;
#pragma unroll
        for (int ai = 0; ai < 2; ++ai)
#pragma unroll
            for (int m = 0; m < 4; ++m) { bf16_t* o = HID + (size_t)(row0 + ai * 128 + m * 16) * ldh + col0;
                float h[8];
                constexpr float SG = MOE ? 0.00390625f : 1.0f, SU = MOE ? (MOE_DOWN_FP8 ? 0.015625f : 0.00390625f) : 1.0f;
                const f32x2 ke = {-1.4426950408889634f * SG, -1.4426950408889634f * SG}, ks = {SG * SU, SG * SU}, one = {1.0f, 1.0f};
#pragma unroll
                for (int n = 0; n < 2; ++n)
#pragma unroll
                    for (int ip = 0; ip < 2; ++ip) { const f32x2 g = {acc[ai][0][m][n][2 * ip], acc[ai][0][m][n][2 * ip + 1]}, u = {acc[ai][1][m][n][2 * ip], acc[ai][1][m][n][2 * ip + 1]};
                        const f32x2 t = g * ke; const f32x2 d = (f32x2){fexp2(t.x), fexp2(t.y)} + one; const f32x2 r = {frcp(d.x), frcp(d.y)};
                        const f32x2 hh = MOE ? (g * u) * (r * ks) : (g * u) * r; h[4 * n + 2 * ip] = hh.x; h[4 * n + 2 * ip + 1] = hh.y; }
                if (MOE && MOE_DOWN_FP8) { u32x2 w8; w8.x = pk4_fp8(h[0], h[1], h[2], h[3]); w8.y = pk4_fp8(h[4], h[5], h[6], h[7]);
                    *(u32x2*)((fp8_t*)HID + (size_t)(row0 + ai * 128 + m * 16) * ldh + col0) = w8; }
                else { u32x4 w; w.x = pk2(h[0], h[1]); w.y = pk2(h[2], h[3]); w.z = pk2(h[4], h[5]); w.w = pk2(h[6], h[7]); *(u32x4*)o = w; } }
    }
};
struct PolMoeDown : PolBase {
    static constexpr bool PERM = true, GATHER = (MOE_DOWN_FP8 != 0), FP8 = (MOE_DOWN_FP8 != 0); static constexpr int ES = MOE_DOWN_FP8 ? 1 : 2; int K, lda, ldb;
    const bf16_t* A; const bf16_t* W; bf16_t* YS; int nM; int tstart[NEXP + 1];
    DEV bool next(int i, Unit& u) const { return ge::static_next(nM, 4, G, c, i, u); }
    DEV int expert_of(int pm) const { int e = 0;
#pragma unroll
        for (int k = 1; k < NEXP; ++k) e += (pm >= tstart[k]) ? 1 : 0;
        return e; }
    DEV const char* a_base(const Unit& u) const { return GATHER ? (const char*)A : (const char*)A + (size_t)u.pm * 256 * lda * ES; }
    DEV int gather_row(const Unit& u, int R) const { return u.pm * 256 + R; }
    DEV const char* b_base(const Unit& u) const { return (const char*)W + ((size_t)expert_of(u.pm) * D + (size_t)u.pn * 256) * ldb * ES; }
    DEV void epi(const f32x4 (&acc)[2][2][4][2], const Unit& u, int wr, int wc, int fr, int fq) const {
        const int row0 = u.pm * 256 + wr * 64 + fr, col0 = u.pn * 256 + wc * 32 + 8 * fq;
#pragma unroll
        for (int ai = 0; ai < 2; ++ai)
#pragma unroll
            for (int m = 0; m < 4; ++m) { bf16_t* o = YS + (size_t)(row0 + ai * 128 + m * 16) * D + col0;
#pragma unroll
                for (int bj = 0; bj < 2; ++bj) { u32x4 w; w.x = pk2(acc[ai][bj][m][0][0], acc[ai][bj][m][0][1]); w.y = pk2(acc[ai][bj][m][0][2], acc[ai][bj][m][0][3]);
                    w.z = pk2(acc[ai][bj][m][1][0], acc[ai][bj][m][1][1]); w.w = pk2(acc[ai][bj][m][1][2], acc[ai][bj][m][1][3]); *(u32x4*)(o + bj * 128) = w; } }
    }
};
struct PolInProj : PolBase {
    static constexpr bool PERM = true, GATHER = false; static constexpr bool FP8 = false; static constexpr int ES = 2; int K, lda, ldb;
    const bf16_t* A; const bf16_t* W; bf16_t* Z; bf16_t* XBC; float* DT;
    DEV bool next(int i, Unit& u) const { return ge::static_next(NPAN, NPROJP / 256, G, c, i, u); }
    DEV const char* a_base(const Unit& u) const { return (const char*)(A + (size_t)u.pm * 256 * lda); }
    DEV const char* b_base(const Unit& u) const { return (const char*)(W + (size_t)u.pn * 256 * ldb); }
    DEV void epi(const f32x4 (&acc)[2][2][4][2], const Unit& u, int wr, int wc, int fr, int fq) const {
        const int row0 = u.pm * 256 + wr * 64 + fr, cw = wc * 32 + 8 * fq;
        if (u.pn < 20) {
            bf16_t* base; size_t ld, bjs; int col0;
            if (u.pn < 8) { base = Z; ld = DIN; col0 = u.pn * 256 + cw; bjs = 128; }
            else { base = XBC + (size_t)((u.pn - 8) * 4 + (wc >> 1)) * MT * 64; ld = 64; col0 = (wc & 1) * 32 + 8 * fq; bjs = (size_t)2 * MT * 64; }
#pragma unroll
            for (int ai = 0; ai < 2; ++ai)
#pragma unroll
                for (int m = 0; m < 4; ++m) { bf16_t* o = base + (size_t)(row0 + ai * 128 + m * 16) * ld + col0;
#pragma unroll
                    for (int bj = 0; bj < 2; ++bj) { u32x4 w; w.x = pk2(acc[ai][bj][m][0][0], acc[ai][bj][m][0][1]); w.y = pk2(acc[ai][bj][m][0][2], acc[ai][bj][m][0][3]);
                        w.z = pk2(acc[ai][bj][m][1][0], acc[ai][bj][m][1][1]); w.w = pk2(acc[ai][bj][m][1][2], acc[ai][bj][m][1][3]); *(u32x4*)(o + bj * bjs) = w; } }
        } else if (cw < 64) {
#pragma unroll
            for (int ai = 0; ai < 2; ++ai)
#pragma unroll
                for (int m = 0; m < 4; ++m) { const int r = row0 + ai * 128 + m * 16; int b, tv;
                    if (r < ML) { b = r / SEQ; tv = CTXL + r % SEQ; } else { b = (r - ML) / CTXL; tv = (r - ML) % CTXL; }
#pragma unroll
                    for (int n = 0; n < 2; ++n)
#pragma unroll
                        for (int i = 0; i < 4; ++i) { const int j = cw + 4 * n + i, dir = j >> 5, h = j & 31;
                            DT[((size_t)(b * 2 + dir) * NH + h) * TV + tv] = acc[ai][0][m][n][i]; } }
        }
    }
};

DEV void phase_conv(const Frame& F, int j, const bf16_t* XBC, bf16_t* XT, bf16_t* Brow, bf16_t* BT, bf16_t* Crow) {
    LAS bf16_t* tl0 = (LAS bf16_t*)F.lds;
    const float* cw = INP(F, I_CONVW) + (size_t)j * 4 * CONVD; const float* cb = INP(F, I_CONVB) + (size_t)j * CONVD;
    constexpr int NPER = NB * NCH, nitem = NPER * (CONVD / 64);
    const int t2 = 2 * (F.tid >> 3), cg = F.tid & 7;
    const int i0 = (int)(((long)F.bx * nitem) / F.G), i1 = (int)(((long)(F.bx + 1) * nitem) / F.G);
    int cblk_cur = -1; f32x4 wv[4][2], bv[2]; int par = 0;
#define CV_LOAD(it_, q_) do { const int _cb = (it_) / NPER, _rs = (it_) % NPER, _b = _rs / NCH, _cv = _rs % NCH; const int _ch = _cb * 64 + cg * 8, _tv = _cv * 128 + t2; \
        const int _s0 = _tv < CTXL ? 0 : CTXL, _s1 = _tv < CTXL ? CTXL : TV; \
        _Pragma("unroll") for (int k = 0; k < 5; ++k) { const int tk = _tv - 2 + k; q_[k] = (u32x4){0u, 0u, 0u, 0u}; \
            if (tk >= _s0 && tk < _s1) q_[k] = *(const u32x4*)(XBC + ((size_t)_cb * MT + row_of(_b, tk)) * 64 + cg * 8); } } while (0)
    u32x4 qn[5];
    if (i0 < i1) CV_LOAD(i0, qn);
    for (int it = i0; it < i1; ++it) {
        const int cblk = it / NPER, rest = it % NPER, b = rest / NCH, cv = rest % NCH;
        const int ch0 = cblk * 64 + cg * 8;
        if (cblk != cblk_cur) { cblk_cur = cblk;
#pragma unroll
            for (int k = 0; k < 4; ++k) { wv[k][0] = *(const f32x4*)(cw + k * CONVD + ch0); wv[k][1] = *(const f32x4*)(cw + k * CONVD + ch0 + 4); }
            bv[0] = *(const f32x4*)(cb + ch0); bv[1] = *(const f32x4*)(cb + ch0 + 4); }
        const int tv = cv * 128 + t2;
        float xin[5][8];
#pragma unroll
        for (int k = 0; k < 5; ++k) { const u32x4 q = qn[k];
            xin[k][0] = bflo(q.x); xin[k][1] = bfhi(q.x); xin[k][2] = bflo(q.y); xin[k][3] = bfhi(q.y); xin[k][4] = bflo(q.z); xin[k][5] = bfhi(q.z); xin[k][6] = bflo(q.w); xin[k][7] = bfhi(q.w); }
        if (it + 1 < i1) CV_LOAD(it + 1, qn);
        unsigned pk[2][4];
#pragma unroll
        for (int o = 0; o < 2; ++o) { float a[8];
#pragma unroll
            for (int i = 0; i < 8; ++i) { float acc = bv[i >> 2][i & 3];
#pragma unroll
                for (int k = 0; k < 4; ++k) acc += wv[k][i >> 2][i & 3] * xin[o + k][i];
                a[i] = siluf(acc); }
#pragma unroll
            for (int i = 0; i < 4; ++i) pk[o][i] = pk2(a[2 * i], a[2 * i + 1]); }
        const int r = row_of(b, tv);
        const bool isx = cblk < DIN / 64, isb = !isx && cblk < (DIN + BCD) / 64;
        if (!isx) {
            const int chc = ch0 - DIN - (isb ? 0 : BCD); bf16_t* o = (isb ? Brow : Crow) + (size_t)(r - t2) * BCD + (chc >> 7) * 16384 + frag_off(t2, chc & 127);
            *(u32x4*)o = (u32x4){pk[0][0], pk[0][1], pk[0][2], pk[0][3]}; *(u32x4*)(o + 8) = (u32x4){pk[1][0], pk[1][1], pk[1][2], pk[1][3]}; }
        if (isx || isb) {
            LAS bf16_t* tl = tl0 + par * (64 * 136); par ^= 1;
#pragma unroll
            for (int i = 0; i < 4; ++i) { const unsigned lo = (pk[0][i] & 0xffffu) | (pk[1][i] << 16), hi = (pk[0][i] >> 16) | (pk[1][i] & 0xffff0000u);
                *(LAS unsigned*)(tl + (cg * 8 + 2 * i) * 136 + t2) = lo; *(LAS unsigned*)(tl + (cg * 8 + 2 * i + 1) * 136 + t2) = hi; }
            __syncthreads();
            if (isx) { bf16_t* dst = XT + ((size_t)b * DIN + cblk * 64) * TV;
#pragma unroll
                for (int q = 0; q < 2; ++q) { const int idx = F.tid + q * 512, ch = idx >> 4, t8 = (idx & 15) * 8;
                    *(u32x4*)(dst + (size_t)ch * TV + cv * 128 + t8) = *(const LAS u32x4*)(tl + ch * 136 + t8); }
            } else {
                const int chb = cblk * 64 - DIN; bf16_t* dst = BT + (size_t)((b * NCH + cv) * NG + (chb >> 7)) * 16384 + ((chb & 127) >> 4) * 2048;
#pragma unroll
                for (int q = 0; q < 2; ++q) { const int idx = F.tid + q * 512, fr_ = idx & 15, fq_ = (idx >> 4) & 3, ks_ = (idx >> 6) & 3, rbl = idx >> 8;
                    *(u32x4*)(dst + idx * 8) = *(const LAS u32x4*)(tl + (rbl * 16 + fr_) * 136 + (ks_ * 4 + fq_) * 8); }
            }
        }
    }
}

#undef CV_LOAD
DEV void phase_cb(const Frame& F, const bf16_t* Brow, const bf16_t* Crow, bf16_t* CB) {
    const int nitem = NB * NG * NCH; const int fr = F.lane & 15, fq = F.lane >> 4;
    for (int it = F.bx; it < nitem; it += F.G) {
        const int cv = it % NCH, g = (it / NCH) % NG, b = it / (NCH * NG);
        const int rbase = row_of(b, cv * 128);
        const bf16_t* ct = Crow + (size_t)rbase * BCD + g * 16384 + F.lane * 8; const bf16_t* bt_ = Brow + (size_t)rbase * BCD + g * 16384 + F.lane * 8;
        bf16x8 cf[4], bfr[8][4];
#pragma unroll
        for (int ks = 0; ks < 4; ++ks) cf[ks] = *(const bf16x8*)(ct + (F.wave * 4 + ks) * 512);
#pragma unroll
        for (int nt = 0; nt < 8; ++nt)
#pragma unroll
            for (int ks = 0; ks < 4; ++ks) bfr[nt][ks] = *(const bf16x8*)(bt_ + (nt * 4 + ks) * 512);
        bf16_t* out = CB + ((size_t)((b * NG + g) * NCH + cv)) * 16384;
#pragma unroll
        for (int nt = 0; nt < 8; ++nt) {
            f32x4 acc = (f32x4){0.f, 0.f, 0.f, 0.f};
#pragma unroll
            for (int ks = 0; ks < 4; ++ks) acc = MFMA16(bfr[nt][ks], cf[ks], acc);
            u32x2 w; w.x = pk2(acc[0], acc[1]); w.y = pk2(acc[2], acc[3]);
            *(u32x2*)(out + frag_off(16 * F.wave + fr, 16 * nt + 4 * fq)) = w;
        }
    }
}

DEV void phase_tables(const Frame& F, int j, float* DT, float* CUM, float* WJ, float* CF) {
    const int nitem = NB * 2 * NH * NCH; const int gw = F.bx * 8 + F.wave, NGW = F.G * 8;
    f32x2 rawn = (f32x2){0.f, 0.f}; if (gw < nitem) rawn = *(const f32x2*)(DT + (size_t)gw * 128 + 2 * F.lane);
    for (int it = gw; it < nitem; it += NGW) {
        const int cv = it % NCH, h = (it / NCH) % NH, dir = (it / (NCH * NH)) & 1, b = it / (NCH * NH * 2);
        const float A = -expf(INP(F, I_ALOG)[(size_t)(j * 2 + dir) * NH + h]); const float bias = INP(F, I_DTB)[(size_t)(j * 2 + dir) * NH + h];
        const size_t o = ((size_t)(b * 2 + dir) * NH + h) * TV + cv * 128 + 2 * F.lane;
        const f32x2 raw = rawn; if (it + NGW < nitem) rawn = *(const f32x2*)(DT + (size_t)(it + NGW) * 128 + 2 * F.lane);
        const float d0 = softplusf(raw.x + bias), d1 = softplusf(raw.y + bias); const float a0 = d0 * A, a1 = d1 * A;
        float c0, c1, tot, sum = a0 + a1;
        if (dir == 0) {
#pragma unroll
            for (int q = 1; q < 64; q <<= 1) { const float t2 = __shfl_up(sum, q); if (F.lane >= q) sum += t2; }
            c1 = sum; c0 = sum - a1; tot = __shfl(sum, 63);
        } else {
#pragma unroll
            for (int q = 1; q < 64; q <<= 1) { const float t2 = __shfl_down(sum, q); if (F.lane + q < 64) sum += t2; }
            c0 = sum; c1 = sum - a0; tot = __shfl(sum, 0);
        }
        constexpr float L2E = 1.4426950408889634f;
        *(f32x2*)(DT + o) = (f32x2){c0 * L2E - flog2(d0), c1 * L2E - flog2(d1)};
        *(f32x2*)(CUM + o) = (f32x2){c0 * L2E, c1 * L2E};
        *(f32x2*)(WJ + o) = (f32x2){d0 * FEXP(tot - c0), d1 * FEXP(tot - c1)};
        const float cref = L2E * __shfl(dir == 0 ? c1 : c0, dir == 0 ? (F.lane | 15) : (F.lane & ~15));
        *(f32x2*)(CF + o) = (f32x2){d0 * fexp2(cref - c0 * L2E), d1 * fexp2(cref - c1 * L2E)};
    }
}

constexpr int SC_HL = 0, SC_TAB = 17408, SC_X = 21504, SC_END = SC_X + 16384;
static_assert(SC_END <= ge::STAGE_BYTES, "scan LDS map");
DEV void phase_scan(const Frame& F, int j, const bf16_t* XT, const bf16_t* BT, const bf16_t* Crow, const bf16_t* CB, const float* DT, const float* CUM, const float* WJ, const float* CF, bf16_t* Yf, bf16_t* Yb) {
    LAS unsigned char* L = F.lds;
    LAS bf16_t* Hl = (LAS bf16_t*)(L + SC_HL);
    LAS float* tab = (LAS float*)(L + SC_TAB);
    const int fr = F.lane & 15, fq = F.lane >> 4, w = F.wave;
    const int rb = w < 4 ? w : 11 - w;
    const int nitem = NB * NH * 2 * 2;
    for (int it = F.bx; it < nitem; it += F.G) {
        const int xq = it & 7, kq = it >> 3; const int b = xq >> 2, g = xq & 3, h = 8 * g + (kq >> 2), dir = (kq >> 1) & 1, ph = kq & 1;
        const float Dsk = dir == 0 ? INP(F, I_DSKIP)[(size_t)j * NH + h] : 0.f;
        const size_t tbase = ((size_t)(b * 2 + dir) * NH + h) * TV;
        const bf16_t* xt = XT + ((size_t)b * DIN + h * HD + ph * 32) * TV;
        const bf16_t* bt = BT + (size_t)(b * NCH * NG + g) * 16384;
        const bf16_t* CBh = CB + (size_t)((b * NG + g) * NCH) * 16384;
        const bf16_t* Cg = Crow + g * 16384;
        bf16_t* Y = (dir ? Yb : Yf) + h * HD + ph * 32;
        const int lrow = 16 * rb + fr;
        f32x4 accH[2]; accH[0] = (f32x4){0.f, 0.f, 0.f, 0.f}; accH[1] = accH[0];
        for (int i = F.tid; i < 32 * 136 / 2; i += 512) ((LAS unsigned*)Hl)[i] = 0u;
#define SC_CHUNK_OF(step) (dir == 0 ? (step) : ((step) < 2 ? 1 - (step) : (NCH - 1) - ((step) - 2)))
        const int xr = 4 * w + (F.lane >> 4), xc = F.lane & 15;
        const unsigned lxs = (unsigned)(xr * TV + 8 * xc) * 2u, lxd = (unsigned)(xr * 256 + ((xc ^ (xr & 15)) << 4));
#define SC_LD_X(cvx_) (*(const u32x4*)((const char*)(xt + (unsigned)(cvx_) * 128u) + lxs))
#define SC_ST_X(xb_, v_) (*(LAS u32x4*)(L + SC_X + (xb_) * 8192 + lxd) = (v_))
        const float* tsrcw = ((w >> 1) == 0 ? CUM : ((w >> 1) == 1 ? DT : ((w >> 1) == 2 ? WJ : CF))) + tbase + (w & 1) * 64 + F.lane;
#define SC_LD_TAB(cvx_) (tsrcw[(cvx_) * 128])
#define SC_ST_TAB(tbuf_, v_) (tab[(tbuf_) * 512 + w * 64 + F.lane] = (v_))
        const unsigned lfo = (unsigned)(rb * 4096 + F.lane * 16);
#define SC_LD_CB(cvx_, ks_) (*(const u32x4*)((const char*)(CBh + (size_t)(cvx_) * 16384u) + lfo + (ks_) * 1024))
#define SC_LD_BT(cvx_, ks_) (*(const u32x4*)((const char*)(bt + (size_t)(cvx_) * 65536u) + lfo + (ks_) * 1024))
#define SC_LD_C(rbx_, ks_) (*(const bf16x8*)((const char*)(Cg + (size_t)(rbx_) * BCD) + lfo + (ks_) * 1024))
        const int kd = rb >> 1; float km[8], dk[8];
#pragma unroll
        for (int i = 0; i < 8; ++i) { const int sidx = 32 * kd + 8 * fq + i; km[i] = (dir == 0 ? (sidx <= lrow) : (sidx >= lrow)) ? 1.f : 0.f; dk[i] = (sidx == lrow) ? Dsk : 0.f; }
        u32x4 rcb[4], rbt[4]; bf16x8 cf[4];
        { const int cv0 = SC_CHUNK_OF(0); const u32x4 x0 = SC_LD_X(cv0); const float t0 = SC_LD_TAB(cv0); const unsigned rb0 = (unsigned)row_of(b, cv0 * 128);
#pragma unroll
          for (int ks = 0; ks < 4; ++ks) { rcb[ks] = SC_LD_CB(cv0, ks); rbt[ks] = SC_LD_BT(cv0, ks); cf[ks] = SC_LD_C(rb0, ks); }
          SC_ST_X(0, x0); SC_ST_TAB(0, t0); }
        for (int step = 0; step < NCH; ++step) {
            int kdl = kd, dirl = dir; LAUNDER_S(kdl); LAUNDER_S(dirl);
            const int cv = SC_CHUNK_OF(step), buf = step & 1; const bool more = step + 1 < NCH;
            const int cvn = more ? SC_CHUNK_OF(step + 1) : cv;
            const unsigned rbase = (unsigned)row_of(b, cv * 128), rbn = (unsigned)row_of(b, cvn * 128);
            LDSBAR();
            const u32x4 xn = SC_LD_X(cvn); const float tn = SC_LD_TAB(cvn);
            const LAS float* tb = tab + buf * 512;
            const float cl2 = tb[lrow]; const float ecum_l = fexp2(cl2);
            const float chunk_decay = fexp2(dir == 0 ? tb[127] : tb[0]);
            f32x4 yd[2], yo[2];
#pragma unroll
            for (int nt = 0; nt < 2; ++nt) { yd[nt] = (f32x4){0.f, 0.f, 0.f, 0.f}; yo[nt] = yd[nt]; accH[nt] = accH[nt] * chunk_decay; }
#pragma unroll
            for (int ks = 0; ks < 4; ++ks) { const int s0 = 32 * ks + 8 * fq; bf16x8 mfk, bwk;
                const bool none = dirl == 0 ? (ks > kdl) : (ks < kdl), diag = (ks == kdl);
                unsigned om[4] = {0u, 0u, 0u, 0u};
                if (!none) {
                    const unsigned qc[4] = {rcb[ks].x, rcb[ks].y, rcb[ks].z, rcb[ks].w};
                    if (!diag) {
                        const f32x4 f0 = *(const LAS f32x4*)(tb + 384 + s0), f1 = *(const LAS f32x4*)(tb + 384 + s0 + 4);
                        const float rowf = fexp2(cl2 - tb[dirl == 0 ? 32 * ks + 31 : 32 * ks]);
                        const f32x2 rf2 = {rowf, rowf};
                        const f32x2 c2[4] = {(f32x2){f0[0], f0[1]}, (f32x2){f0[2], f0[3]}, (f32x2){f1[0], f1[1]}, (f32x2){f1[2], f1[3]}};
#pragma unroll
                        for (int i = 0; i < 4; ++i) { const f32x2 v2 = (f32x2){bflo(qc[i]), bfhi(qc[i])} * (c2[i] * rf2); om[i] = pk2(v2.x, v2.y); }
                    } else {
                        const f32x4 cs0 = *(const LAS f32x4*)(tb + 128 + s0), cs1 = *(const LAS f32x4*)(tb + 128 + s0 + 4);
                        const float cs[8] = {cs0[0], cs0[1], cs0[2], cs0[3], cs1[0], cs1[1], cs1[2], cs1[3]};
                        float v[8];
#pragma unroll
                        for (int i = 0; i < 8; ++i) { const float cbv = (i & 1) ? bfhi(qc[i >> 1]) : bflo(qc[i >> 1]); const float x = cl2 - cs[i]; v[i] = (cbv * fexp2(x < 60.f ? x : 60.f)) * km[i] + dk[i]; }
#pragma unroll
                        for (int i = 0; i < 4; ++i) om[i] = pk2(v[2 * i], v[2 * i + 1]);
                    }
                    rcb[ks] = SC_LD_CB(cvn, ks);
                }
                mfk = __builtin_bit_cast(bf16x8, (u32x4){om[0], om[1], om[2], om[3]});
                { const f32x4 ws0 = *(const LAS f32x4*)(tb + 256 + s0), ws1 = *(const LAS f32x4*)(tb + 256 + s0 + 4);
                  const f32x2 w2[4] = {(f32x2){ws0[0], ws0[1]}, (f32x2){ws0[2], ws0[3]}, (f32x2){ws1[0], ws1[1]}, (f32x2){ws1[2], ws1[3]}};
                  const unsigned qb[4] = {rbt[ks].x, rbt[ks].y, rbt[ks].z, rbt[ks].w}; unsigned ob[4];
#pragma unroll
                  for (int i = 0; i < 4; ++i) { const f32x2 v2 = (f32x2){bflo(qb[i]), bfhi(qb[i])} * w2[i]; ob[i] = pk2(v2.x, v2.y); LAUNDER_V(ob[i]); }
                  bwk = __builtin_bit_cast(bf16x8, (u32x4){ob[0], ob[1], ob[2], ob[3]}); }
                rbt[ks] = SC_LD_BT(cvn, ks);
#pragma unroll
                for (int nt = 0; nt < 2; ++nt) {
                    const bf16x8 xf = *(const LAS bf16x8*)(L + SC_X + buf * 8192 + (16 * nt + fr) * 256 + (((4 * ks + fq) ^ fr) << 4));
                    if (!none) yd[nt] = MFMA16(xf, mfk, yd[nt]);
                    const bf16x8 hf = *(const LAS bf16x8*)(Hl + buf * (32 * 136) + (16 * nt + fr) * 136 + 32 * ks + 8 * fq);
                    yo[nt] = MFMA16(hf, cf[ks], yo[nt]);
                    accH[nt] = MFMA16(bwk, xf, accH[nt]); } }
#pragma unroll
            for (int ks = 0; ks < 4; ++ks) cf[ks] = SC_LD_C(rbn, ks);
            SC_ST_X(buf ^ 1, xn); SC_ST_TAB(buf ^ 1, tn);
#pragma unroll
            for (int nt = 0; nt < 2; ++nt) { u32x2 hw; hw.x = pk2(accH[nt][0], accH[nt][1]); hw.y = pk2(accH[nt][2], accH[nt][3]);
                *(LAS u32x2*)(Hl + (buf ^ 1) * (32 * 136) + (16 * nt + fr) * 136 + 16 * rb + 4 * fq) = hw; }
#pragma unroll
            for (int nt = 0; nt < 2; ++nt) { u32x2 yw; yw.x = pk2(yd[nt][0] + ecum_l * yo[nt][0], yd[nt][1] + ecum_l * yo[nt][1]); yw.y = pk2(yd[nt][2] + ecum_l * yo[nt][2], yd[nt][3] + ecum_l * yo[nt][3]);
                *(u32x2*)(Y + ((size_t)(rbase + lrow) * DIN + 16 * nt + 4 * fq)) = yw; }
        }
        WAITV(0); LDSBAR();
    }
}

DEV void phase_gate(const Frame& F, int j, const bf16_t* Yf, const bf16_t* Yb, const bf16_t* Z, bf16_t* YN, int nrows) {
    const int gw = F.bx * 8 + F.wave, NGW = F.G * 8; const float* nw = INP(F, I_SNORM) + (size_t)j * DIN;
    u32x4 na[4], nb[4], nz[4];
    if (gw < nrows) {
#pragma unroll
        for (int q = 0; q < 4; ++q) { const size_t o = (size_t)gw * DIN + 8 * F.lane + 512 * q; na[q] = *(const u32x4*)(Yf + o); nb[q] = *(const u32x4*)(Yb + o); nz[q] = *(const u32x4*)(Z + o); } }
    for (int r = gw; r < nrows; r += NGW) {
        float t[32]; float ss = 0.f;
        u32x4 ca[4], cb4[4], cz[4];
#pragma unroll
        for (int q = 0; q < 4; ++q) { ca[q] = na[q]; cb4[q] = nb[q]; cz[q] = nz[q]; }
        if (r + NGW < nrows) {
#pragma unroll
            for (int q = 0; q < 4; ++q) { const size_t o = (size_t)(r + NGW) * DIN + 8 * F.lane + 512 * q; na[q] = *(const u32x4*)(Yf + o); nb[q] = *(const u32x4*)(Yb + o); nz[q] = *(const u32x4*)(Z + o); } }
#pragma unroll
        for (int q = 0; q < 4; ++q) { const u32x4 a = ca[q], bq = cb4[q], z = cz[q];
            const unsigned aa[4] = {a.x, a.y, a.z, a.w}, bb[4] = {bq.x, bq.y, bq.z, bq.w}, zz[4] = {z.x, z.y, z.z, z.w};
#pragma unroll
            for (int i = 0; i < 4; ++i) { const float v0 = (bflo(aa[i]) + bflo(bb[i])) * siluf(bflo(zz[i])), v1 = (bfhi(aa[i]) + bfhi(bb[i])) * siluf(bfhi(zz[i])); t[8 * q + 2 * i] = v0; t[8 * q + 2 * i + 1] = v1; ss += v0 * v0 + v1 * v1; } }
        const float rstd = rsqrtf(wave_sum(ss) * (1.0f / DIN) + EPS);
#pragma unroll
        for (int q = 0; q < 4; ++q) { const int c = 8 * F.lane + 512 * q; const f32x4 w0 = *(const f32x4*)(nw + c), w1 = *(const f32x4*)(nw + c + 4);
            u32x4 o; o.x = pk2(t[8 * q] * rstd * w0[0], t[8 * q + 1] * rstd * w0[1]); o.y = pk2(t[8 * q + 2] * rstd * w0[2], t[8 * q + 3] * rstd * w0[3]);
            o.z = pk2(t[8 * q + 4] * rstd * w1[0], t[8 * q + 5] * rstd * w1[1]); o.w = pk2(t[8 * q + 6] * rstd * w1[2], t[8 * q + 7] * rstd * w1[3]);
            *(u32x4*)(YN + (size_t)r * DIN + c) = o; }
    }
}

DEV void phase_route(const Frame& F, int layer, int ml, bf16_t* V, int nrows) {
    LAS unsigned* lc = (LAS unsigned*)(F.lds + LDS_MISC + 256);
    if (F.tid < 8) lc[F.tid] = 0u;
    __syncthreads();
    const int gw = F.bx * 8 + F.wave, NGW = F.G * 8; const int j = layer / 2;
    const float* w = INP(F, I_NFFN) + (size_t)layer * D; const float* rw = INP(F, I_RW) + (size_t)j * D * NEXP;
    LAS float* rwl = (LAS float*)F.lds;
    for (int q = F.tid; q < D * 2; q += 512) { const int c = q >> 1, hf = q & 1; const int ln = (c & 255) >> 2, ii = c & 3, jq = c >> 8;
        *(LAS f32x4*)(rwl + ((jq * 4 + ii) * 64 + ln) * 8 + hf * 4) = *(const f32x4*)(rw + (size_t)q * 4); }
    __syncthreads();
    TokInfo* tok = (TokInfo*)(F.ws + OFF_TOK);
    constexpr int NS = 3;
    f32x4 ns[NS][4];
#pragma unroll
    for (int k = 0; k < NS; ++k) if (gw + k * NGW < nrows) load_row(F.H + (size_t)(gw + k * NGW) * D, F.lane, ns[k]);
    for (int r0 = gw; r0 < nrows; r0 += NS * NGW) {
#pragma unroll
      for (int k = 0; k < NS; ++k) { const int r = r0 + k * NGW; if (r >= nrows) break;
        f32x4 v[4];
#pragma unroll
        for (int q = 0; q < 4; ++q) v[q] = ns[k][q];
        if (r + NS * NGW < nrows) load_row(F.H + (size_t)(r + NS * NGW) * D, F.lane, ns[k]);
        const float rstd = rsqrtf(sumsq_row(v) * (1.0f / D) + EPS);
        const int vec = vec_of(r);
        normmod_row(v, rstd, w, modp(F, layer, vec, 3), modp(F, layer, vec, 4), F.lane);
#pragma unroll
        for (int jq = 0; jq < 4; ++jq) *(unsigned*)((fp8_t*)V + (size_t)r * D + 4 * F.lane + 256 * jq) = pk4_fp8(v[jq][0] * 8.0f, v[jq][1] * 8.0f, v[jq][2] * 8.0f, v[jq][3] * 8.0f);
        float lg[NEXP];
#pragma unroll
        for (int e = 0; e < NEXP; ++e) lg[e] = 0.f;
#pragma unroll
        for (int jj = 0; jj < 4; ++jj)
#pragma unroll
            for (int i = 0; i < 4; ++i) { const LAS float* rp = rwl + ((jj * 4 + i) * 64 + F.lane) * 8; const f32x4 r0 = *(const LAS f32x4*)rp, r1 = *(const LAS f32x4*)(rp + 4);
#pragma unroll
                for (int e = 0; e < 4; ++e) { lg[e] += v[jj][i] * r0[e]; lg[4 + e] += v[jj][i] * r1[e]; } }
#pragma unroll
        for (int e = 0; e < NEXP; ++e) lg[e] = wave_sum(lg[e]);
        int e0 = 0; float v0 = lg[0];
#pragma unroll
        for (int e = 1; e < NEXP; ++e) if (lg[e] > v0) { v0 = lg[e]; e0 = e; }
        int e1 = -1; float v1 = -3.0e38f;
#pragma unroll
        for (int e = 0; e < NEXP; ++e) if (e != e0 && lg[e] > v1) { v1 = lg[e]; e1 = e; }
        const float g1 = frcp(1.0f + FEXP(v0 - v1)), g0 = 1.0f - g1;
        if (F.lane == 0) { TokInfo ti; ti.s0 = e0; ti.s1 = e1; ti.g0 = g0; ti.g1 = g1; tok[r] = ti; atomicAdd((unsigned*)&lc[e0], 1u); atomicAdd((unsigned*)&lc[e1], 1u); }
      }
    }
    __syncthreads();
    if (F.tid < 8) __hip_atomic_fetch_add(F.ctl + CW_CNT + (ml * 8 + F.tid) * 64, lc[F.tid], RLX_AGENT);
}
DEV void tile_starts(const Frame& F, int ml, int (&ts)[NEXP + 1], unsigned (&cnt)[NEXP]) {
    ts[0] = 0;
#pragma unroll
    for (int e = 0; e < NEXP; ++e) { cnt[e] = __hip_atomic_load(F.ctl + CW_CNT + (ml * 8 + e) * 64, RLX_AGENT); ts[e + 1] = ts[e] + (int)((cnt[e] + 255u) / 256u); }
}
DEV void phase_slots(const Frame& F, int ml, int nrows) {
    int ts[NEXP + 1]; unsigned cnt[NEXP]; tile_starts(F, ml, ts, cnt);
    TokInfo* tok = (TokInfo*)(F.ws + OFF_TOK); int* s2t = (int*)(F.ws + OFF_S2T);
    const int gw = F.bx * 8 + F.wave, NGW = F.G * 8;
    for (int base = gw * 64; base < nrows; base += NGW * 64) {
        const int r = base + F.lane; TokInfo ti = tok[r];
        unsigned long long m0[NEXP], m1[NEXP]; unsigned mycnt = 0;
#pragma unroll
        for (int e = 0; e < NEXP; ++e) { m0[e] = __ballot(ti.s0 == e); m1[e] = __ballot(ti.s1 == e); if (F.lane == e) mycnt = (unsigned)(__builtin_popcountll(m0[e]) + __builtin_popcountll(m1[e])); }
        unsigned b0 = 0;
        if (F.lane < NEXP && mycnt) b0 = __hip_atomic_fetch_add(F.ctl + CW_CUR + (ml * 8 + F.lane) * 64, mycnt, RLX_AGENT);
        const unsigned long long below = (1ull << F.lane) - 1ull; int sl0 = 0, sl1 = 0;
#pragma unroll
        for (int e = 0; e < NEXP; ++e) { const unsigned be = __shfl(b0, e); const int c0 = __builtin_popcountll(m0[e]);
            if (ti.s0 == e) sl0 = ts[e] * 256 + (int)be + __builtin_popcountll(m0[e] & below);
            if (ti.s1 == e) sl1 = ts[e] * 256 + (int)be + c0 + __builtin_popcountll(m1[e] & below); }
        ti.s0 = sl0; ti.s1 = sl1; tok[r] = ti; s2t[sl0] = r; s2t[sl1] = r;
    }
    if (F.bx == 0) { for (int e = 0; e < NEXP; ++e) { const int a = ts[e] * 256 + (int)cnt[e], b2 = ts[e + 1] * 256; for (int s = a + F.tid; s < b2; s += 512) s2t[s] = 0; } }
}
DEV void phase_combine(const Frame& F, int layer, const bf16_t* YS, bool final_) {
    const int NGW = F.G * 8; const int gw = F.bx * 8 + F.wave + (final_ ? 0 : ML); const TokInfo* tok = (const TokInfo*)(F.ws + OFF_TOK);
    const int nrows = final_ ? ML : MT;
    f32x4 nh[4]; u32x2 nya[4], nyb[4]; TokInfo tcur, tnxt;
    tcur.s0 = tcur.s1 = 0; tcur.g0 = tcur.g1 = 0.f; tnxt = tcur;
    if (gw < nrows) { tcur = tok[gw]; load_row(F.H + (size_t)gw * D, F.lane, nh);
#pragma unroll
        for (int jj = 0; jj < 4; ++jj) { const int c = 4 * F.lane + 256 * jj; nya[jj] = *(const u32x2*)(YS + (size_t)tcur.s0 * D + c); nyb[jj] = *(const u32x2*)(YS + (size_t)tcur.s1 * D + c); } }
    if (gw + NGW < nrows) tnxt = tok[gw + NGW];
    for (int r = gw; r < nrows; r += NGW) {
        f32x4 v[4]; u32x2 ya[4], yb[4]; TokInfo ti = tcur;
#pragma unroll
        for (int q = 0; q < 4; ++q) { v[q] = nh[q]; ya[q] = nya[q]; yb[q] = nyb[q]; }
        tcur = tnxt;
        if (r + NGW < nrows) { load_row(F.H + (size_t)(r + NGW) * D, F.lane, nh);
#pragma unroll
            for (int jj = 0; jj < 4; ++jj) { const int c = 4 * F.lane + 256 * jj; nya[jj] = *(const u32x2*)(YS + (size_t)tcur.s0 * D + c); nyb[jj] = *(const u32x2*)(YS + (size_t)tcur.s1 * D + c); } }
        if (r + 2 * NGW < nrows) tnxt = tok[r + 2 * NGW];
        if (MOE_DOWN_FP8) { ti.g0 *= 0.00390625f; ti.g1 *= 0.00390625f; }
        const float* g2 = modp(F, layer, vec_of(r), 5);
#pragma unroll
        for (int jj = 0; jj < 4; ++jj) { const int c = 4 * F.lane + 256 * jj; const u32x2 a = ya[jj], b = yb[jj]; const f32x4 gv = *(const f32x4*)(g2 + c);
            v[jj][0] += gv[0] * (ti.g0 * bflo(a.x) + ti.g1 * bflo(b.x)); v[jj][1] += gv[1] * (ti.g0 * bfhi(a.x) + ti.g1 * bfhi(b.x));
            v[jj][2] += gv[2] * (ti.g0 * bflo(a.y) + ti.g1 * bflo(b.y)); v[jj][3] += gv[3] * (ti.g0 * bfhi(a.y) + ti.g1 * bfhi(b.y)); }
        if (!final_) {
#pragma unroll
            for (int jj = 0; jj < 4; ++jj) *(f32x4*)(F.H + (size_t)r * D + 4 * F.lane + 256 * jj) = v[jj];
        } else {
            const float rstd = rsqrtf(sumsq_row(v) * (1.0f / D) + EPS); const float* fw = INP(F, I_FNORM);
#pragma unroll
            for (int jj = 0; jj < 4; ++jj) { const int c = 4 * F.lane + 256 * jj; *(f32x4*)(OUTP(F) + (size_t)r * D + c) = v[jj] * rstd * *(const f32x4*)(fw + c); }
        }
    }
}

constexpr int PH_PER_PAIR = 17, N_PHASES = 1 + 2 * PH_PER_PAIR;
static_assert((size_t)(DFF / 128) * MC * D * 4 <= al(SZ_WMUP) + SZ_WMDN, "context K-slice partials fit the expert-weight region");
__global__ void __launch_bounds__(512, 2) fwd_kernel(Params prm) {
#ifdef EMU
    unsigned char* lds_raw = emu_lds();
#else
    extern __shared__ __attribute__((aligned(16))) unsigned char lds_raw[];
#endif
    Frame F;
    F.lds = (LAS unsigned char*)lds_raw;
    F.tid = threadIdx.x; F.lane = F.tid & 63; F.wave = RFL(F.tid >> 6); F.G = gridDim.x; F.bx = blockIdx.x;
    F.p = &prm; F.ws = prm.ws; F.ctl = (unsigned*)(prm.ws + OFF_CTL); F.H = (float*)(prm.ws + OFF_H); F.mod = (float*)(prm.ws + OFF_MOD);
    volatile LAS unsigned* misc = (volatile LAS unsigned*)(F.lds + LDS_MISC);
    if (F.tid < 64) misc[F.tid] = 0u;
    __syncthreads();
    XcdBarrier bar; bar.bar = F.ctl + CW_BAR; bar.x = 0; bar.st = misc;
    const int lo = prm.ph_lo, hi = prm.ph_hi;
    if (hi - lo > 1) bar = xcd_barrier_post(F.ctl + CW_BAR, misc);
    int ph = 0;
#ifndef SITE_MASK
#define SITE_MASK 0xFFFFFFFFu
#endif
#ifndef PROBE_REPEAT_SITE
#define PROBE_REPEAT_SITE (-1)
#endif
#define PH_REPS(site) ((PROBE_REPEAT_SITE == (site)) ? 2 : 1)
#ifndef PROBE_TS_MASK
#define PROBE_TS_MASK 0u
#endif
#ifndef PROBE_TS_MULT
#define PROBE_TS_MULT 1
#endif
#ifdef EMU
#define NOWT() 0ull
#else
#define NOWT() ((unsigned long long)__builtin_amdgcn_s_memrealtime())
#endif
    unsigned long long tsacc = 0;
#define PHASE_BEGIN(site) if (((SITE_MASK >> (site)) & 1u) && lo <= ph && ph < hi) { { int _t = threadIdx.x; LAUNDER_V(_t); F.tid = _t; F.lane = _t & 63; int _b = blockIdx.x; LAUNDER_S(_b); F.bx = _b; int _g = gridDim.x; LAUNDER_S(_g); F.G = _g; \
      F.ws = WSP(F); F.ctl = (unsigned*)(F.ws + OFF_CTL); F.H = (float*)(F.ws + OFF_H); F.mod = (float*)(F.ws + OFF_MOD); } \
      const bool _tson = ((PROBE_TS_MASK >> (site)) & 1u) != 0u; unsigned long long _ts0 = 0; if (_tson) _ts0 = NOWT(); \
      for (int _rep = 0; _rep < PH_REPS(site); ++_rep) { if (_rep) __syncthreads();
#define PHASE_END   } if (ph + 1 < hi) xcd_barrier(bar); if (_tson) tsacc += NOWT() - _ts0; } ++ph;
#define B_W (F.ws + OFF_W)
#define B_ACT (F.ws + OFF_ACT)
#define B_P ((bf16_t*)(B_ACT + A_P))
#define B_HID ((bf16_t*)(B_ACT + A_HID))
#define B_U ((bf16_t*)(B_ACT + A_U))
#define B_Z ((bf16_t*)(B_ACT + A_Z))
#define B_XBC ((bf16_t*)(B_ACT + A_XBC))
#define B_DT ((float*)(B_W + W_DT))
#define B_XT ((bf16_t*)(B_ACT + A_XT))
#define B_BROW ((bf16_t*)(B_ACT + A_BROW))
#define B_BT ((bf16_t*)(B_ACT + A_BT))
#define B_CROW ((bf16_t*)(B_ACT + A_CROW))
#define B_CB ((bf16_t*)(B_ACT + A_CB))
#define B_CUM ((float*)(B_ACT + A_CUM))
#define B_WJ ((float*)(B_ACT + A_WJ))
#define B_CF ((float*)(B_ACT + A_CF))
#define B_YF ((bf16_t*)(B_ACT + A_YF))
#define B_YB ((bf16_t*)(B_W + W_YB))
#define B_YN ((bf16_t*)(B_ACT + A_YN))
#define B_V ((bf16_t*)(B_ACT + A_V))
#define B_HIDM ((bf16_t*)(B_ACT + A_HIDM))
#define B_YS ((bf16_t*)(B_ACT + A_YS))
#define B_PART ((float*)(B_W + W_MUP))

    PHASE_BEGIN(0) phase_mod(F); convert_even(F, 0); PHASE_END

    for (int lp = 0; lp < 2; ++lp) {
        const int le = 2 * lp, lod = 2 * lp + 1;
        PHASE_BEGIN(1) phase_poolprep(F, le, B_P, lp == 1, B_YS); PHASE_END
        PHASE_BEGIN(2) { PolPool S; S.G = F.G; S.c = F.bx; S.K = 256; S.lda = D; S.ldb = 256; S.P = B_P; S.W = (const bf16_t*)(B_W + W_POOL); S.src = mksrc(F); S.layer = le; S.scale = INP(F, I_POOLS) + (size_t)lp * D; S.npan = ML / 256; S.PART = B_PART;
                      ge::gemm_phase(F.lds, S, F.tid); } PHASE_END
        PHASE_BEGIN(3) { CtxFix fx; fx.PART = B_PART; fx.S = 2; fx.layer = le; fx.which = 2; fx.scale = INP(F, I_POOLS) + (size_t)lp * D; fx.from_input = le == 0; phase_norm(F, le, 3, B_P, false, fx); } PHASE_END
        PHASE_BEGIN(4) { PolUp<false> S; S.G = F.G; S.c = F.bx; S.K = D; S.lda = D; S.ldb = D; S.A = B_P; S.W = (const bf16_t*)(B_W + W_UP); S.HID = B_HID; S.ldh = DFF; S.nq = DFF / 128; S.nM = NPAN; S.s2t = nullptr;
                      ge::gemm_phase(F.lds, S, F.tid);
                      Frame F2 = F; if (idle_subgrid(F2, NPAN * S.nq)) convert_ssd(F2, lp); } PHASE_END
        PHASE_BEGIN(5) { PolResid S; S.G = F.G; S.c = F.bx; S.K = DFF; S.lda = DFF; S.ldb = DFF; S.A = B_HID; S.W = (const bf16_t*)(B_W + W_DN); S.src = mksrc(F); S.layer = le; S.which = 5; S.npan = ML / 256; S.nsl = DFF / 128; S.PART = B_PART;
                      ge::gemm_phase(F.lds, S, F.tid); } PHASE_END

        PHASE_BEGIN(6) { CtxFix fx; fx.PART = B_PART; fx.S = DFF / 128; fx.layer = le; fx.which = 5; fx.scale = nullptr; fx.from_input = false; phase_norm(F, lod, 0, B_U, false, fx); } PHASE_END
        PHASE_BEGIN(7) { PolInProj S; S.G = F.G; S.c = F.bx; S.K = D; S.lda = D; S.ldb = D; S.A = B_U; S.W = (const bf16_t*)(B_W + W_IN); S.Z = B_Z; S.XBC = B_XBC; S.DT = B_DT;
                      ge::gemm_phase(F.lds, S, F.tid); } PHASE_END
        PHASE_BEGIN(8) phase_conv(F, lp, B_XBC, B_XT, B_BROW, B_BT, B_CROW); PHASE_END
        PHASE_BEGIN(9) phase_cb(F, B_BROW, B_CROW, B_CB); { Frame F2 = F; if (idle_subgrid(F2, NB * NG * NCH)) phase_tables(F2, lp, B_DT, B_CUM, B_WJ, B_CF); } PHASE_END
        PHASE_BEGIN(10) phase_scan(F, lp, B_XT, B_BT, B_CROW, B_CB, B_DT, B_CUM, B_WJ, B_CF, B_YF, B_YB); PHASE_END
        PHASE_BEGIN(11) phase_gate(F, lp, B_YF, B_YB, B_Z, B_YN, lp == 1 ? ML : MT); PHASE_END
        PHASE_BEGIN(12) { PolResid S; S.G = F.G; S.c = F.bx; S.K = DIN; S.lda = DIN; S.ldb = DIN; S.A = B_YN; S.W = (const bf16_t*)(B_W + W_OUT); S.src = mksrc(F); S.layer = lod; S.which = 2; S.npan = lp == 1 ? ML / 256 : NPAN; S.nsl = 0; S.PART = nullptr;
                      ge::gemm_phase(F.lds, S, F.tid);
                      Frame F2 = F; if (idle_subgrid(F2, S.npan * 4)) convert_moe(F2, lp, false, true); } PHASE_END
        PHASE_BEGIN(13) phase_route(F, lod, lp, B_V, lp == 1 ? ML : MT); convert_moe(F, lp, true, false); PHASE_END
        PHASE_BEGIN(14) phase_slots(F, lp, lp == 1 ? ML : MT); PHASE_END
        PHASE_BEGIN(15) { int ts[NEXP + 1]; unsigned cnt[NEXP]; tile_starts(F, lp, ts, cnt);
                      PolUp<true> S; S.G = F.G; S.c = F.bx; S.K = D; S.lda = D; S.ldb = D; S.A = B_V; S.W = (const bf16_t*)(B_W + W_MUP); S.HID = B_HIDM; S.ldh = DFFE; S.nq = DFFE / 128; S.nM = ts[NEXP];
                      S.s2t = (const int*)(F.ws + OFF_S2T);
#pragma unroll
                      for (int e = 0; e <= NEXP; ++e) S.tstart[e] = ts[e];
                      ge::gemm_phase(F.lds, S, F.tid); } PHASE_END
        PHASE_BEGIN(16) { int ts[NEXP + 1]; unsigned cnt[NEXP]; tile_starts(F, lp, ts, cnt);
                      PolMoeDown S; S.G = F.G; S.c = F.bx; S.K = DFFE; S.lda = DFFE; S.ldb = DFFE; S.A = B_HIDM; S.W = (const bf16_t*)(B_W + W_MDN); S.YS = B_YS; S.nM = ts[NEXP];
#pragma unroll
                      for (int e = 0; e <= NEXP; ++e) S.tstart[e] = ts[e];
                      ge::gemm_phase(F.lds, S, F.tid);
                      if (lp == 0) { Frame F2 = F; if (idle_subgrid(F2, S.nM * 4)) convert_even(F2, 1); } } PHASE_END
        PHASE_BEGIN(17) phase_combine(F, lod, B_YS, lp == 1); PHASE_END
    }
#undef PHASE_BEGIN
#undef PHASE_END
    if (PROBE_TS_MASK != 0u && blockIdx.x == 0) { const unsigned long long t1 = NOWT(), wt = tsacc * (unsigned long long)PROBE_TS_MULT; while (NOWT() - t1 < wt) { } }
}

extern "C" void kernel_launch(void* const* d_in, const int* in_sizes, int n_in, void* d_out, int out_size, void* d_ws, size_t ws_size, hipStream_t stream) {
    static int grid = 0;
    if (grid == 0) {
        if (n_in != 26 || ws_size < WS_NEED) { fprintf(stderr, "kernel_launch: need 26 inputs and %zu bytes of workspace (got %d, %zu)\n", (size_t)WS_NEED, n_in, ws_size); grid = -1; return; }
        int dev = 0, cus = 0, per_cu = 0;
        if (hipGetDevice(&dev) != hipSuccess || hipDeviceGetAttribute(&cus, hipDeviceAttributeMultiprocessorCount, dev) != hipSuccess) { grid = -1; return; }
        if (hipFuncSetAttribute((const void*)fwd_kernel, hipFuncAttributeMaxDynamicSharedMemorySize, LDS_BYTES) != hipSuccess) { grid = -1; return; }
        if (hipOccupancyMaxActiveBlocksPerMultiprocessor(&per_cu, (const void*)fwd_kernel, 512, LDS_BYTES) != hipSuccess || per_cu < 1) { fprintf(stderr, "kernel_launch: occupancy query says %d\n", per_cu); }
        (void)hipGetLastError();
        grid = cus;
    }
    if (grid < 0) return;
    (void)in_sizes; (void)out_size;
    if (hipMemsetAsync((char*)d_ws + OFF_CTL, 0, CTL_BYTES, stream) != hipSuccess) return;
    Params p{};
    for (int i = 0; i < 26; ++i) p.in[i] = (const float*)d_in[i];
    p.out = (float*)d_out; p.ws = (unsigned char*)d_ws;
    if (N_LAUNCH_MODE == 1) { p.ph_lo = 0; p.ph_hi = N_PHASES; hipLaunchKernelGGL(fwd_kernel, dim3(grid), dim3(512), LDS_BYTES, stream, p); }
    else for (int ph = 0; ph < N_PHASES; ++ph) { p.ph_lo = ph; p.ph_hi = ph + 1; hipLaunchKernelGGL(fwd_kernel, dim3(grid), dim3(512), LDS_BYTES, stream, p); }
}
```

```cpp
#ifndef EMU
#include <hip/hip_runtime.h>
#endif
#include <cstdio>
#include <cstdint>

#ifndef CFG_SEQ
#define CFG_SEQ 16384
#endif
#ifndef CFG_DFF
#define CFG_DFF 2816
#endif
#ifndef CFG_DFFE
#define CFG_DFFE 3584
#endif
#ifndef MOE_DOWN_FP8
#define MOE_DOWN_FP8 1
#endif
#ifndef N_LAUNCH_MODE
#define N_LAUNCH_MODE 1
#endif

#ifdef EMU
#define LAS
#define DEV inline
#define WAITV(n) ((void)0)
#define WAITL(n) ((void)0)
#define SBAR() emu_wg_sync()
#define SCHED() ((void)0)
#define SETPRIO(x) ((void)0)
#define MFMA16(a, b, c) emu_mfma16(a, b, c)
#define GLDS16(g, l) emu_glds16((const void*)(g), (void*)(l))
#define GLDS4(g, l) emu_glds4((const void*)(g), (void*)(l))
#define MFMA8(a, b, c) emu_mfma8(a, b, c)
#define RFL(x) emu_rfl(x)
#define MEMFENCE() ((void)0)
#define WSYNC() emu_wave_sync()
#define LDSBAR() emu_wg_sync()
#define LAUNDER_V(x) ((void)0)
#define SLEEP1() emu_yield()
#define MY_XCC_ID() ((unsigned)(blockIdx.x & 7u))
#define FENCE_REL() __atomic_thread_fence(__ATOMIC_SEQ_CST)
#define FENCE_ACQ() __atomic_thread_fence(__ATOMIC_SEQ_CST)
#define FEXP(x) expf(x)
#define RLX_AGENT __ATOMIC_RELAXED, 4
#else
#define LAS __attribute__((address_space(3)))
#define DEV __device__ __forceinline__
#define WAITV(n) asm volatile("s_waitcnt vmcnt(" #n ")" ::: "memory")
#define WAITL(n) asm volatile("s_waitcnt lgkmcnt(" #n ")" ::: "memory")
#define SBAR() __builtin_amdgcn_s_barrier()
#define SCHED() __builtin_amdgcn_sched_barrier(0)
#define SETPRIO(x) __builtin_amdgcn_s_setprio(x)
#define MFMA16(a, b, c) __builtin_amdgcn_mfma_f32_16x16x32_bf16(a, b, c, 0, 0, 0)
#define GLDS16(g, l) __builtin_amdgcn_global_load_lds((const unsigned*)(g), (LAS unsigned*)(l), 16, 0, 0)
#define GLDS4(g, l) __builtin_amdgcn_global_load_lds((const unsigned*)(g), (LAS unsigned*)(l), 4, 0, 0)
#define MFMA8(a, b, c) __builtin_amdgcn_mfma_scale_f32_16x16x128_f8f6f4(a, b, c, 0, 0, 0, 0x7f7f7f7f, 0, 0x7f7f7f7f)
#define RFL(x) __builtin_amdgcn_readfirstlane(x)
#define MEMFENCE() asm volatile("" ::: "memory")
#define LDSBAR() do { asm volatile("s_waitcnt lgkmcnt(0)" ::: "memory"); __builtin_amdgcn_s_barrier(); asm volatile("" ::: "memory"); } while (0)
#define WSYNC() asm volatile("s_waitcnt lgkmcnt(0)" ::: "memory")
#define SLEEP1() __builtin_amdgcn_s_sleep(1)
#define MY_XCC_ID() ((unsigned)__builtin_amdgcn_s_getreg((3 << 11) | 20) & 0xFu)
#define FENCE_REL() __builtin_amdgcn_fence(__ATOMIC_RELEASE, "agent")
#define FENCE_ACQ() __builtin_amdgcn_fence(__ATOMIC_ACQUIRE, "agent")
#define FEXP(x) __expf(x)
#define RLX_AGENT __ATOMIC_RELAXED, __HIP_MEMORY_SCOPE_AGENT
#define LAUNDER_V(x) asm volatile("" : "+v"(x))
#endif

typedef unsigned short bf16_t;
typedef short bf16x8 __attribute__((ext_vector_type(8)));
typedef float f32x4 __attribute__((ext_vector_type(4)));
typedef float f32x2 __attribute__((ext_vector_type(2)));
typedef unsigned u32x4 __attribute__((ext_vector_type(4)));
typedef unsigned u32x2 __attribute__((ext_vector_type(2)));
typedef int i32x8 __attribute__((ext_vector_type(8)));
typedef int i32x4 __attribute__((ext_vector_type(4)));
typedef unsigned char fp8_t;

constexpr int D = 1024, NB = 2, SEQ = CFG_SEQ, CTXL = 256, DEPTH = 4;
constexpr int ML = NB * SEQ, MC = NB * CTXL, MT = ML + MC, NPAN = MT / 256;
constexpr int DFF = CFG_DFF, DFFE = CFG_DFFE, NEXP = 8;
constexpr int DIN = 2048, NH = 32, HD = 64, NG = 4, DS = 128, CONVD = 3072, NPROJ = 5184, NPROJP = 5376, BCD = 512;
constexpr int TV = CTXL + SEQ, NCH = TV / 128;
constexpr int GRIDW = 64;
constexpr float EPS = 1e-6f;
constexpr int NSLOT_TILES = (2 * MT) / 256 + NEXP, NSLOT = NSLOT_TILES * 256;
static_assert(SEQ % 128 == 0 && ML % 256 == 0 && DFF % 128 == 0 && DFFE % 128 == 0 && DFF >= 256 && DFFE >= 256, "shape constraints");

constexpr size_t MiB = 1u << 20;
constexpr size_t al(size_t x) { return (x + 4095) & ~(size_t)4095; }
constexpr size_t OFF_CTL = 0, CTL_BYTES = 1 * MiB;
constexpr size_t OFF_MOD = 1 * MiB;
constexpr size_t OFF_TOK = 2 * MiB;
constexpr size_t OFF_S2T = 3 * MiB;
constexpr size_t OFF_H = 4 * MiB, SZ_H = (size_t)MT * D * 4;
constexpr size_t OFF_W = OFF_H + al(SZ_H);
constexpr size_t W_POOL = 0, SZ_WPOOL = (size_t)4 * 256 * 256 * 2;
constexpr size_t W_UP = al(SZ_WPOOL), SZ_WUP = (size_t)2 * DFF * D * 2;
constexpr size_t W_DN = W_UP + al(SZ_WUP), SZ_WDN = (size_t)D * DFF * 2;
constexpr size_t SZ_WEVEN = W_DN + al(SZ_WDN);
constexpr size_t W_IN = SZ_WEVEN, SZ_WIN = (size_t)NPROJP * D * 2;
constexpr size_t W_OUT = W_IN + al(SZ_WIN), SZ_WOUT = (size_t)D * DIN * 2;
constexpr size_t W_DT = W_OUT + al(SZ_WOUT), SZ_DT = (size_t)NB * 2 * NH * TV * 4;
constexpr size_t W_MUP = W_DT + al(SZ_DT), SZ_WMUP = (size_t)NEXP * 2 * DFFE * D;
constexpr size_t W_MDN = W_MUP + al(SZ_WMUP), SZ_WMDN = (size_t)NEXP * D * DFFE * (MOE_DOWN_FP8 ? 1 : 2);
constexpr size_t W_YB = W_MUP, SZ_Y = (size_t)MT * DIN * 2;
constexpr size_t SZ_WODD_A = W_MDN + al(SZ_WMDN), SZ_WODD_B = W_YB + al(SZ_Y);
constexpr size_t mx(size_t a, size_t b) { return a > b ? a : b; }
constexpr size_t SZ_W = mx(SZ_WEVEN, mx(SZ_WODD_A, SZ_WODD_B));
constexpr size_t OFF_ACT = OFF_W + SZ_W;
constexpr size_t A_P = 0, SZ_ACT1 = (size_t)MT * D * 2;
constexpr size_t A_HID = al(SZ_ACT1), SZ_HID = (size_t)MT * DFF * 2;
constexpr size_t SZ_AEVEN = A_HID + al(SZ_HID);
constexpr size_t A_Z = 0;
constexpr size_t A_XBC = al(SZ_Y), SZ_XBC = (size_t)MT * CONVD * 2;
constexpr size_t A_YF = A_XBC;
constexpr size_t A_CB = A_XBC + al(SZ_Y), SZ_CB = (size_t)NB * NG * NCH * 128 * 128 * 2;
static_assert(al(SZ_Y) + SZ_CB <= SZ_XBC, "CB fits behind Yf inside the XBC region");
constexpr size_t A_XT = A_XBC + al(SZ_XBC), SZ_XT = (size_t)NB * DIN * TV * 2;
constexpr size_t A_U = A_XT, A_YN = A_XT;
constexpr size_t A_BROW = A_XT + al(SZ_XT), SZ_BC = (size_t)MT * BCD * 2;
constexpr size_t A_BT = A_BROW + al(SZ_BC);
constexpr size_t A_CROW = A_BT + al(SZ_BC);
constexpr size_t A_CUM = A_CROW + al(SZ_BC);
constexpr size_t A_WJ = A_CUM + al(SZ_DT);
constexpr size_t A_CF = A_WJ + al(SZ_DT);
constexpr size_t SZ_ASSD = A_CF + al(SZ_DT);
constexpr size_t A_V = 0;
constexpr size_t A_HIDM = al(SZ_ACT1), SZ_HIDM = (size_t)NSLOT * DFFE * 2;
constexpr size_t A_YS = A_HIDM + al(SZ_HIDM), SZ_YS = (size_t)NSLOT * D * 2;
constexpr size_t SZ_AMOE = A_YS + al(SZ_YS);
constexpr size_t SZ_ACT = mx(SZ_AEVEN, mx(SZ_ASSD, SZ_AMOE));
constexpr size_t WS_NEED = OFF_ACT + SZ_ACT;

constexpr int CW_BAR = 4096;
constexpr int CW_CNT = 16384;
constexpr int CW_CUR = 16384 + 2 * 8 * 64;

DEV unsigned f2bf(float f) { unsigned u = __builtin_bit_cast(unsigned, f); return (u + 0x7fffu + ((u >> 16) & 1u)) >> 16; }
#ifndef EMU
typedef __bf16 bf16x2n __attribute__((ext_vector_type(2)));
#endif
DEV unsigned pk2(float lo, float hi) {
#ifdef EMU
    return f2bf(lo) | (f2bf(hi) << 16);
#else
    f32x2 v = {lo, hi}; bf16x2n b = __builtin_convertvector(v, bf16x2n); return __builtin_bit_cast(unsigned, b);
#endif
}
DEV unsigned pk4_fp8(float a, float b, float c, float d) {
#ifdef EMU
    return emu_f2fp8(a) | (emu_f2fp8(b) << 8) | (emu_f2fp8(c) << 16) | (emu_f2fp8(d) << 24);
#else
    unsigned w = 0; w = __builtin_amdgcn_cvt_pk_fp8_f32(a, b, w, false); w = __builtin_amdgcn_cvt_pk_fp8_f32(c, d, w, true); return w;
#endif
}
DEV float bf2f(unsigned b) { return __builtin_bit_cast(float, b << 16); }
DEV float bflo(unsigned w) { return __builtin_bit_cast(float, w << 16); }
DEV float bfhi(unsigned w) { return __builtin_bit_cast(float, w & 0xffff0000u); }
#ifdef EMU
DEV float frcp(float x) { return 1.0f / x; }
#else
DEV float frcp(float x) { return __builtin_amdgcn_rcpf(x); }
#endif
#ifdef EMU
DEV float fexp2(float x) { return exp2f(x); }
#else
DEV float fexp2(float x) { return __builtin_amdgcn_exp2f(x); }
#endif
DEV float siluf(float x) { return x * frcp(1.0f + FEXP(-x)); }
#ifdef EMU
DEV float flog2(float x) { return log2f(x); }
#else
DEV float flog2(float x) { return __builtin_amdgcn_logf(x); }
#endif
DEV float softplusf(float x) { if (x > 20.f) return x; const float e = FEXP(x); return e < 0.0625f ? e * (1.0f - e * (0.5f - e * (0.33333334f - e * (0.25f - e * 0.2f)))) : flog2(1.0f + e) * 0.6931471806f; }
DEV float wave_sum(float v) {
#pragma unroll
    for (int o = 1; o < 64; o <<= 1) v += __shfl_xor(v, o);
    return v;
}
DEV int vec_of(int r) { return r < ML ? (r / SEQ) : 2; }
DEV int frag_off(int r, int c) { return ((r >> 4) * 4 + (c >> 5)) * 512 + ((c >> 3) & 3) * 128 + (r & 15) * 8 + (c & 7); }
DEV int row_of(int b, int tv) { return tv < CTXL ? ML + b * CTXL + tv : b * SEQ + (tv - CTXL); }

#define XB_TMO      128
#define XB_XCNT(j)  (256  + 64 * (j))
#define XB_XSUB(j)  (1280 + 64 * (j))
#define XB_XGEN(j)  (2304 + 64 * (j))
#define XB_TOP      3328
#define XB_TOPGEN   3392
#define XCD_BAR_WORDS 3456
#define XB_SPIN_CAP (1u << 22)
DEV unsigned xb_ld(unsigned* p)              { return __hip_atomic_load(p, RLX_AGENT); }
DEV unsigned xb_add(unsigned* p, unsigned v) { return __hip_atomic_fetch_add(p, v, RLX_AGENT); }
#define XB_SPIN(cond, bar) do { unsigned _sp = 0; while (cond) { SLEEP1(); \
    if ((++_sp & 255u) == 0u) { if (xb_ld(&(bar)[XB_TMO])) break; if (_sp > XB_SPIN_CAP) { atomicAdd(&(bar)[XB_TMO], 1u); break; } } } } while (0)
struct XcdBarrier { unsigned* bar; unsigned x; volatile LAS unsigned* st; };
DEV XcdBarrier xcd_barrier_post(unsigned* bar, volatile LAS unsigned* st) {
    XcdBarrier b; b.bar = bar; b.x = MY_XCC_ID(); b.st = st;
    if (threadIdx.x == 0) (void)xb_add(&bar[XB_XCNT(b.x)], 1u);
    return b;
}
DEV void xcd_barrier_complete(unsigned* bar, unsigned x, unsigned& nloc, unsigned& nx) {
    const unsigned G = gridDim.x;
    unsigned sum, cnt, mine, sp = 0u;
    for (;;) {
        sum = 0u; cnt = 0u; mine = 0u;
#pragma unroll
        for (unsigned j = 0; j < 16; ++j) { const unsigned c = xb_ld(&bar[XB_XCNT(j)]); sum += c; cnt += (c > 0u) ? 1u : 0u; mine = (j == x) ? c : mine; }
        if (sum == G) break;
        SLEEP1();
        if ((++sp & 255u) == 0u) { if (xb_ld(&bar[XB_TMO])) break; if (sp > XB_SPIN_CAP) { atomicAdd(&bar[XB_TMO], 1u); break; } }
    }
    nloc = mine > 0u ? mine : 1u; nx = cnt > 0u ? cnt : 1u;
}
DEV void xcd_barrier(const XcdBarrier& b) {
    WAITV(0);
    __syncthreads();
    if (threadIdx.x == 0) {
        unsigned* bar = b.bar;
#ifndef EMU
        __builtin_amdgcn_s_waitcnt(0);
#endif
        unsigned nloc = b.st[0], nx = b.st[1];
        if (nloc == 0u) { xcd_barrier_complete(bar, b.x, nloc, nx); b.st[0] = nloc; b.st[1] = nx; }
        const unsigned old = xb_add(&bar[XB_XSUB(b.x)], 1u);
        const unsigned gen = old / nloc;
        if (old + 1u == (gen + 1u) * nloc) {
            FENCE_REL();
            WAITV(0);
            const unsigned og = xb_add(&bar[XB_TOP], 1u);
            const unsigned tg = og / nx;
            if (og + 1u == (tg + 1u) * nx) xb_add(&bar[XB_TOPGEN], 1u);
            else XB_SPIN(xb_ld(&bar[XB_TOPGEN]) == tg, bar);
            FENCE_ACQ();
            xb_add(&bar[XB_XGEN(b.x)], 1u);
            WAITV(0);
        } else {
            XB_SPIN(xb_ld(&bar[XB_XGEN(b.x)]) == gen, bar);
            FENCE_ACQ();
            WAITV(0);
        }
    }
    __syncthreads();
}

namespace ge {
constexpr int BM = 256, BK = 64, HALF = 128, HTB = HALF * BK * 2, STAGE_BYTES = 8 * HTB, NXCD = 8, WGM = 8;
DEV int lds_byte(int r, int c) { const int st = (r >> 4) * 2 + (c >> 5), rr = r & 15, cc = c & 31, ob = rr * 64 + cc * 2; return st * 1024 + (ob ^ (((ob >> 9) & 1) << 5)); }
DEV void stage_rc(int b, int& R, int& C) { const int st = b / 1024, sb = b % 1024, swz = sb ^ (((sb >> 9) & 1) << 5); R = (st >> 1) * 16 + swz / 64; C = (st & 1) * 32 + (swz % 64) / 2; }
DEV int perm32(int rho) { const int n = rho >> 4, i = rho & 15; return 8 * (i >> 2) + 4 * n + (i & 3); }
struct Unit { int pm, pn; };
DEV bool static_next(int nM, int nN, int G, int c, int i, Unit& u) {
    const int nwg = nM * nN; const long L = (long)i * G + c; if (L >= nwg) return false;
    int wgid = (int)L; { const int q = nwg / NXCD, r = nwg % NXCD, xcd = wgid % NXCD, off = wgid / NXCD; wgid = (xcd < r ? xcd * (q + 1) : r * (q + 1) + (xcd - r) * q) + off; }
    const int nig = WGM * nN, gid = wgid / nig, fm = gid * WGM, gsz = (nM - fm) < WGM ? (nM - fm) : WGM;
    u.pm = fm + ((wgid % nig) % gsz); u.pn = (wgid % nig) / gsz; return true;
}
template <class P, bool SP2 = true>
DEV void gemm_phase(LAS unsigned char* lds, const P& S, const int tid) {
    const int wid = RFL(tid >> 6), lane = tid & 63, wr = wid >> 2, wc = wid & 3, fr = lane & 15, fq = lane >> 4;
    const int K = S.K; int nt = K * P::ES / (BK * 2);
    unsigned voffB[2]; int RA[2], CA2[2];
#pragma unroll
    for (int i = 0; i < 2; ++i) { int R, C; stage_rc(tid * 16 + i * 8192, R, C); const int Rb = P::PERM ? ((R & ~31) + perm32(R & 31)) : R;
        RA[i] = R; CA2[i] = C * 2; voffB[i] = (unsigned)(Rb * S.ldb) * (unsigned)P::ES + (unsigned)(C * 2); }
    const size_t kstep = (size_t)(BK * 2);
    const size_t hstepB = (size_t)HALF * S.ldb * P::ES;
    const unsigned ldsw = (unsigned)wid * 1024u;
    const int aoff = lds_byte(wr * 64 + fr, fq * 8), boff = lds_byte(wc * 32 + fr, fq * 8);
#define GE_SA(b, h) (((b) * 2 + (h)) * HTB)
#define GE_SB(b, h) ((4 + (b) * 2 + (h)) * HTB)
#define GE_STAGEB(bufoff, gbase) do { _Pragma("unroll") for (int _i = 0; _i < 2; ++_i) { unsigned _o = voffB[_i]; LAUNDER_V(_o); \
        GLDS16((const char*)(gbase) + _o, lds + (bufoff) + ldsw + _i * 8192); } } while (0)
#define GE_STAGEA(bufoff, gbase, h) do { _Pragma("unroll") for (int _i = 0; _i < 2; ++_i) { unsigned _o = oA[h][_i]; LAUNDER_V(_o); \
        GLDS16((const char*)(gbase) + _o, lds + (bufoff) + ldsw + _i * 8192); } } while (0)
#define GE_LD1(p_) __builtin_shufflevector(*(const LAS i32x4*)(p_), *(const LAS i32x4*)((p_) + 1024), 0, 1, 2, 3, 4, 5, 6, 7)
#define GE_LDA(dst, b, h) do { _Pragma("unroll") for (int m = 0; m < 4; ++m) dst[m] = GE_LD1(lds + GE_SA(b, h) + aoff + m * 2048); } while (0)
#define GE_LDB(dst, b, h) do { _Pragma("unroll") for (int n = 0; n < 2; ++n) dst[n] = GE_LD1(lds + GE_SB(b, h) + boff + n * 2048); } while (0)
#define GE_LO(x) __builtin_bit_cast(bf16x8, __builtin_shufflevector(x, x, 0, 1, 2, 3))
#define GE_HI(x) __builtin_bit_cast(bf16x8, __builtin_shufflevector(x, x, 4, 5, 6, 7))
#define GE_MMA(ai, bj, At, Bt) do { SETPRIO(1); _Pragma("unroll") for (int m = 0; m < 4; ++m) _Pragma("unroll") for (int n = 0; n < 2; ++n) { \
        if constexpr (P::FP8) acc[ai][bj][m][n] = MFMA8(Bt[n], At[m], acc[ai][bj][m][n]);     \
        else { acc[ai][bj][m][n] = MFMA16(GE_LO(Bt[n]), GE_LO(At[m]), acc[ai][bj][m][n]); acc[ai][bj][m][n] = MFMA16(GE_HI(Bt[n]), GE_HI(At[m]), acc[ai][bj][m][n]); } } SETPRIO(0); } while (0)
    Unit cur, nxt; int ui = 0;
    if (!S.next(0, cur)) return;
    f32x4 acc[2][2][4][2];
#pragma unroll
    for (int a = 0; a < 2; ++a)
#pragma unroll
        for (int b = 0; b < 2; ++b)
#pragma unroll
            for (int m = 0; m < 4; ++m)
#pragma unroll
                for (int n = 0; n < 2; ++n) acc[a][b][m][n] = (f32x4){0.f, 0.f, 0.f, 0.f};
    unsigned oA[2][2];
#pragma unroll
    for (int h = 0; h < 2; ++h)
#pragma unroll
        for (int i = 0; i < 2; ++i) {
            if constexpr (P::GATHER) oA[h][i] = (unsigned)S.gather_row(cur, h * HALF + RA[i]) * (unsigned)(S.lda * P::ES) + (unsigned)CA2[i];
            else oA[h][i] = (unsigned)((h * HALF + RA[i]) * S.lda) * (unsigned)P::ES + (unsigned)CA2[i];
            }
    const char* cA = S.a_base(cur); const char* cB = S.b_base(cur);
    if constexpr (SP2) {
        GE_STAGEB(GE_SB(0, 0), cB); GE_STAGEB(GE_SB(0, 1), cB + hstepB); GE_STAGEA(GE_SA(0, 0), cA, 0); GE_STAGEA(GE_SA(0, 1), cA, 1);
        if (wr == 1) SBAR();
        WAITV(2); SBAR();
        GE_STAGEB(GE_SB(1, 0), cB + kstep); GE_STAGEA(GE_SA(1, 0), cA + kstep, 0); GE_STAGEB(GE_SB(1, 1), cB + hstepB + kstep);
        WAITV(6); SBAR();
    } else {
    GE_STAGEB(GE_SB(0, 0), cB); GE_STAGEA(GE_SA(0, 0), cA, 0); GE_STAGEB(GE_SB(0, 1), cB + hstepB); GE_STAGEA(GE_SA(0, 1), cA, 1);
    if (wr == 1) SBAR();
    WAITV(4); SBAR();
    GE_STAGEB(GE_SB(1, 0), cB + kstep); GE_STAGEA(GE_SA(1, 0), cA + kstep, 0); GE_STAGEB(GE_SB(1, 1), cB + hstepB + kstep);
    WAITV(6); SBAR();
    }
    for (;;) {
        if constexpr (P::VARK) nt = S.unit_nt(cur);
        const bool has_next = S.next(ui + 1, nxt);
        const char* nA = has_next ? S.a_base(nxt) : cA; const char* nB = has_next ? S.b_base(nxt) : cB;
        for (int t = 0; t < nt; t += 2) {
            const bool last = (t == nt - 2);
            const char* a1 = cA + (size_t)(t + 1) * kstep;
            const char* a2 = last ? nA : cA + (size_t)(t + 2) * kstep; const char* b2 = last ? nB : cB + (size_t)(t + 2) * kstep;
            const char* a3 = a2 + kstep; const char* b3 = b2 + kstep;
            i32x8 At[4], B0[2], B1[2];
            if constexpr (SP2) {
            GE_LDB(B0, 0, 0); GE_LDB(B1, 0, 1); SCHED(); GE_LDA(At, 0, 0); GE_STAGEA(GE_SA(1, 1), a1, 1);
            WAITV(8); WAITL(0); SBAR(); GE_MMA(0, 0, At, B0); GE_MMA(0, 1, At, B1); SBAR(); SCHED();
            if constexpr (P::GATHER) { if (last && has_next) {
#pragma unroll
                for (int i = 0; i < 2; ++i) { int R2, C2; stage_rc(tid * 16 + i * 8192, R2, C2);
#pragma unroll
                    for (int h = 0; h < 2; ++h) oA[h][i] = (unsigned)S.gather_row(nxt, h * HALF + R2) * (unsigned)(S.lda * P::ES) + (unsigned)(C2 * 2); } } }
            GE_LDA(At, 0, 1); GE_STAGEB(GE_SB(0, 0), b2); GE_STAGEB(GE_SB(0, 1), b2 + hstepB); GE_STAGEA(GE_SA(0, 0), a2, 0);
            WAITV(8); WAITL(0); SBAR(); GE_MMA(1, 0, At, B0); GE_MMA(1, 1, At, B1); SBAR(); SCHED();
            GE_LDB(B0, 1, 0); GE_LDB(B1, 1, 1); SCHED(); GE_LDA(At, 1, 0); GE_STAGEA(GE_SA(0, 1), a2, 1);
            WAITV(8); WAITL(0); SBAR(); GE_MMA(0, 0, At, B0); GE_MMA(0, 1, At, B1); SBAR(); SCHED();
            GE_LDA(At, 1, 1); GE_STAGEB(GE_SB(1, 0), b3); GE_STAGEB(GE_SB(1, 1), b3 + hstepB); GE_STAGEA(GE_SA(1, 0), a3, 0);
            WAITV(8); WAITL(0); SBAR(); GE_MMA(1, 0, At, B0); GE_MMA(1, 1, At, B1); SBAR(); SCHED();
            } else {
            GE_LDB(B0, 0, 0); SCHED(); GE_LDA(At, 0, 0); GE_STAGEA(GE_SA(1, 1), a1, 1);
            WAITL(8); SBAR(); WAITL(0); GE_MMA(0, 0, At, B0); SBAR(); SCHED();
            if constexpr (P::GATHER) { if (last && has_next) {
#pragma unroll
                for (int i = 0; i < 2; ++i) { int R2, C2; stage_rc(tid * 16 + i * 8192, R2, C2);
#pragma unroll
                    for (int h = 0; h < 2; ++h) oA[h][i] = (unsigned)S.gather_row(nxt, h * HALF + R2) * (unsigned)(S.lda * P::ES) + (unsigned)(C2 * 2); } } }
            GE_LDB(B1, 0, 1); GE_STAGEB(GE_SB(0, 0), b2);
            SBAR(); WAITL(0); GE_MMA(0, 1, At, B1); SBAR();
            GE_LDA(At, 0, 1); GE_STAGEA(GE_SA(0, 0), a2, 0);
            SBAR(); WAITL(0); GE_MMA(1, 0, At, B0); SBAR(); SCHED();
            GE_STAGEB(GE_SB(0, 1), b2 + hstepB);
            WAITV(6); SBAR(); GE_MMA(1, 1, At, B1); SBAR();
            GE_LDB(B0, 1, 0); SCHED(); GE_LDA(At, 1, 0); GE_STAGEA(GE_SA(0, 1), a2, 1);
            WAITL(8); SBAR(); WAITL(0); GE_MMA(0, 0, At, B0); SBAR(); SCHED();
            GE_LDB(B1, 1, 1); GE_STAGEB(GE_SB(1, 0), b3);
            SBAR(); WAITL(0); GE_MMA(0, 1, At, B1); SBAR();
            GE_LDA(At, 1, 1); GE_STAGEA(GE_SA(1, 0), a3, 0);
            SBAR(); WAITL(0); GE_MMA(1, 0, At, B0); SBAR(); SCHED();
            GE_STAGEB(GE_SB(1, 1), b3 + hstepB);
            WAITV(6); SBAR(); GE_MMA(1, 1, At, B1); SBAR();
            }
        }
        if (wr == 0) SBAR();
        S.epi(acc, cur, wr, wc, fr, fq);
        if (!has_next) break;
#pragma unroll
        for (int a = 0; a < 2; ++a)
#pragma unroll
            for (int b = 0; b < 2; ++b)
#pragma unroll
                for (int m = 0; m < 4; ++m)
#pragma unroll
                    for (int n = 0; n < 2; ++n) acc[a][b][m][n] = (f32x4){0.f, 0.f, 0.f, 0.f};
        cur = nxt; cA = nA; cB = nB; ++ui;
        if (wr == 1) SBAR();
    }
    WAITV(0);
    SBAR();
#undef GE_SA
#undef GE_SB
#undef GE_STAGEA
#undef GE_STAGEB
#undef GE_LDA
#undef GE_LDB
#undef GE_MMA
#undef GE_LO
#undef GE_HI
#undef GE_LD1
}
}
using ge::Unit;

struct Params {
    const float* in[26];
    float* out; unsigned char* ws;
    int ph_lo, ph_hi;
};
enum { I_X = 0, I_C, I_CTX, I_CCTX, I_ADAW, I_ADAB, I_NMIX, I_NFFN, I_POOLW, I_POOLS, I_INW, I_CONVW, I_CONVB, I_ALOG, I_DTB, I_DSKIP, I_SNORM, I_OUTW,
       I_W1, I_W3, I_W2, I_RW, I_MW1, I_MW3, I_MW2, I_FNORM };

struct Frame {
    LAS unsigned char* lds;
    int tid, lane, wave, G, bx;
    const Params* p;
    unsigned char* ws;
    unsigned* ctl;
    float* H; float* mod;
};
#ifdef EMU
DEV const float* INP(const Frame& F, int i) { return F.p->in[i]; }
DEV float* OUTP(const Frame& F) { return F.p->out; }
DEV unsigned char* WSP(const Frame& F) { return F.p->ws; }
#define LAUNDER_S(x) ((void)0)
#else
typedef const float* cfptr_t;
DEV const float* INP(const Frame&, int i) { int k = i; asm volatile("" : "+s"(k)); return ((const __attribute__((address_space(4))) cfptr_t*)__builtin_amdgcn_kernarg_segment_ptr())[k]; }
DEV float* OUTP(const Frame& F) { return (float*)INP(F, 26); }
DEV unsigned char* WSP(const Frame& F) { return (unsigned char*)INP(F, 27); }
#define LAUNDER_S(x) asm volatile("" : "+s"(x))
#endif
constexpr int LDS_MISC = ge::STAGE_BYTES;
constexpr int LDS_BYTES = ge::STAGE_BYTES + 16384;

struct Src { const float* x; const float* ctx; float* H; const float* mod; };
DEV const float* modq(const float* mod, int layer, int vec, int which) { return mod + ((size_t)(layer * 3 + vec) * 6 + which) * D; }
DEV const float* modp(const Frame& F, int layer, int vec, int which) { return modq(F.mod, layer, vec, which); }
DEV const float* hsrc_row(const Src& s, bool from_input, int r) {
    if (from_input) return r < ML ? s.x + (size_t)r * D : s.ctx + (size_t)(r - ML) * D;
    return s.H + (size_t)r * D;
}
DEV Src mksrc(const Frame& F) { Src s; s.x = INP(F, I_X); s.ctx = INP(F, I_CTX); s.H = F.H; s.mod = F.mod; return s; }
DEV const float* hin_row(const Frame& F, int layer, int r) { return hsrc_row(mksrc(F), layer == 0, r); }

struct RmId { DEV int operator()(int n0) const { return n0; } };
struct RmIlv { int s; DEV int operator()(int n0) const { return (n0 >> 7) * 256 + s * 128 + (n0 & 127); } };
template <int K, int N, bool F8, class RM>
DEV void convert_job_t(const Frame& F, const float* Wsrc, void* WTv, int ldt, RM rowmap, float scale) {
    LAS float* scr = (LAS float*)(F.lds + F.wave * 16384);
    constexpr int items = (K / 64) * (N / 32), nblk = N / 32; const int gw = F.bx * 8 + F.wave, NGW = F.G * 8, lane = F.lane;
    float nx[32];
#define CJ_LOAD(it_) do { const int _kb = (it_) / nblk, _nb = (it_) % nblk; const float* _p = Wsrc + (size_t)(64 * _kb + (lane >> 5)) * N + 32 * _nb + (lane & 31); \
        _Pragma("unroll") for (int i = 0; i < 32; ++i) nx[i] = _p[(size_t)(2 * i) * N]; } while (0)
    if (gw < items) CJ_LOAD(gw);
    for (int it = gw; it < items; it += NGW) {
        const int kb = it / nblk, nb = it % nblk, k0 = 64 * kb, n0 = 32 * nb;
#pragma unroll
        for (int i = 0; i < 32; ++i) { const int kk = 2 * i + (lane >> 5); scr[kk * 33 + (lane & 31)] = F8 ? nx[i] * scale : nx[i]; }
        if (it + NGW < items) CJ_LOAD(it + NGW);
        WSYNC();
        const int c = lane & 7; const int row0 = rowmap(n0);
#pragma unroll
        for (int j = 0; j < 4; ++j) { const int n = (lane >> 3) + 8 * j; const LAS float* sp = scr + (8 * c) * 33 + n;
            if (F8) { u32x2 o; o.x = pk4_fp8(sp[0 * 33], sp[1 * 33], sp[2 * 33], sp[3 * 33]); o.y = pk4_fp8(sp[4 * 33], sp[5 * 33], sp[6 * 33], sp[7 * 33]);
                *(u32x2*)((fp8_t*)WTv + (size_t)(row0 + n) * ldt + k0 + 8 * c) = o; }
            else { u32x4 o; o.x = pk2(sp[0 * 33], sp[1 * 33]); o.y = pk2(sp[2 * 33], sp[3 * 33]); o.z = pk2(sp[4 * 33], sp[5 * 33]); o.w = pk2(sp[6 * 33], sp[7 * 33]);
                *(u32x4*)((bf16_t*)WTv + (size_t)(row0 + n) * ldt + k0 + 8 * c) = o; } }
        WSYNC();
    }
#undef CJ_LOAD
}
template <int K, int N, class RM> DEV void convert_job(const Frame& F, const float* Wsrc, bf16_t* WT, int ldt, RM rm) { convert_job_t<K, N, false>(F, Wsrc, WT, ldt, rm, 1.0f); }
template <int K, int N, class RM> DEV void convert_job_fp8(const Frame& F, const float* Wsrc, fp8_t* WT, int ldt, RM rm, float scale) { convert_job_t<K, N, true>(F, Wsrc, WT, ldt, rm, scale); }
DEV bool idle_subgrid(Frame& F2, int nwg) { const int rem = nwg % F2.G; if (rem == 0) return true; if (F2.bx < rem) return false; F2.bx -= rem; F2.G -= rem; return true; }
constexpr int MOE_UP_EARLY = 3;
DEV void convert_even(const Frame& F, int j) {
    bf16_t* Wb = (bf16_t*)(F.ws + OFF_W);
    for (int g = 0; g < 4; ++g) convert_job<256, 256>(F, INP(F, I_POOLW) + ((size_t)j * 4 + g) * 65536, Wb + W_POOL / 2 + (size_t)g * 65536, 256, RmId{});
    convert_job<D, DFF>(F, INP(F, I_W1) + (size_t)j * D * DFF, Wb + W_UP / 2, D, RmIlv{0});
    convert_job<D, DFF>(F, INP(F, I_W3) + (size_t)j * D * DFF, Wb + W_UP / 2, D, RmIlv{1});
    convert_job<DFF, D>(F, INP(F, I_W2) + (size_t)j * DFF * D, Wb + W_DN / 2, DFF, RmId{});
}
DEV void convert_ssd(const Frame& F, int j) {
    bf16_t* Wb = (bf16_t*)(F.ws + OFF_W);
    convert_job<D, NPROJ>(F, INP(F, I_INW) + (size_t)j * D * NPROJ, Wb + W_IN / 2, D, RmId{});
    convert_job<DIN, D>(F, INP(F, I_OUTW) + (size_t)j * DIN * D, Wb + W_OUT / 2, DIN, RmId{});
    { u32x4* z = (u32x4*)(Wb + W_IN / 2 + (size_t)NPROJ * D); const int n16 = (NPROJP - NPROJ) * D * 2 / 16;
      unsigned zz = 0u; LAUNDER_V(zz);
      for (int i = F.bx * 512 + F.tid; i < n16; i += F.G * 512) z[i] = (u32x4){zz, zz, zz, zz}; }
}
DEV void convert_moe(const Frame& F, int j, int up_lo, int up_hi, bool down) {
    fp8_t* Wb = (fp8_t*)(F.ws + OFF_W);
    for (int e = 0; e < NEXP; ++e) {
        if (e >= up_lo && e < up_hi) {
        convert_job_fp8<D, DFFE>(F, INP(F, I_MW1) + ((size_t)j * NEXP + e) * D * DFFE, Wb + W_MUP + (size_t)e * 2 * DFFE * D, D, RmIlv{0}, 32.0f);
        convert_job_fp8<D, DFFE>(F, INP(F, I_MW3) + ((size_t)j * NEXP + e) * D * DFFE, Wb + W_MUP + (size_t)e * 2 * DFFE * D, D, RmIlv{1}, 32.0f); }
        if (!down) continue;
        if (MOE_DOWN_FP8) convert_job_fp8<DFFE, D>(F, INP(F, I_MW2) + ((size_t)j * NEXP + e) * DFFE * D, Wb + W_MDN + (size_t)e * D * DFFE, DFFE, RmId{}, 64.0f);
        else convert_job<DFFE, D>(F, INP(F, I_MW2) + ((size_t)j * NEXP + e) * DFFE * D, (bf16_t*)(Wb + W_MDN) + (size_t)e * D * DFFE, DFFE, RmId{});
    }
}

DEV void phase_mod(const Frame& F) {
    LAS float* red = (LAS float*)F.lds;
    LAS float* sc = (LAS float*)(F.lds + 8192);
    constexpr int nblk = DEPTH * 6144 / 32;
    const int col = F.tid & 31, ks = F.tid >> 5;
    for (int i = F.tid; i < 3 * D; i += 512) { const int v = i >> 10, k = i & (D - 1); sc[i] = siluf(v == 2 ? INP(F, I_CCTX)[k] : INP(F, I_C)[v * D + k]); }
    __syncthreads();
    for (int blk = F.bx; blk < nblk; blk += F.G) {
        const int layer = (blk * 32) / 6144, n = (blk * 32) % 6144 + col;
        const float* W = INP(F, I_ADAW) + (size_t)layer * D * 6144 + n;
        float a0 = 0.f, a1 = 0.f, a2 = 0.f;
#pragma unroll 1
        for (int kb = ks * 64; kb < ks * 64 + 64; kb += 16) {
            float wv[16];
#pragma unroll
            for (int k = 0; k < 16; ++k) wv[k] = W[(size_t)(kb + k) * 6144];
#pragma unroll
            for (int k = 0; k < 16; ++k) { a0 += sc[kb + k] * wv[k]; a1 += sc[D + kb + k] * wv[k]; a2 += sc[2 * D + kb + k] * wv[k]; } }
        red[(ks * 32 + col) * 3 + 0] = a0; red[(ks * 32 + col) * 3 + 1] = a1; red[(ks * 32 + col) * 3 + 2] = a2;
        __syncthreads();
        if (F.tid < 96) { const int c2 = F.tid & 31, v = F.tid >> 5; float s = 0.f;
            for (int q = 0; q < 16; ++q) s += red[(q * 32 + c2) * 3 + v];
            const int n2 = (blk * 32) % 6144 + c2;
            F.mod[(size_t)(layer * 3 + v) * 6144 + n2] = s + INP(F, I_ADAB)[(size_t)layer * 6144 + n2]; }
        __syncthreads();
    }
}

DEV void load_row(const float* p, int lane, f32x4 (&v)[4]) {
#pragma unroll
    for (int j = 0; j < 4; ++j) v[j] = *(const f32x4*)(p + 4 * lane + 256 * j);
}
DEV float sumsq_row(const f32x4 (&v)[4]) { float s = 0.f;
#pragma unroll
    for (int j = 0; j < 4; ++j) s += (v[j][0] * v[j][0] + v[j][1] * v[j][1]) + (v[j][2] * v[j][2] + v[j][3] * v[j][3]);
    return wave_sum(s); }
DEV void normmod_row(f32x4 (&v)[4], float rstd, const float* w, const float* sh, const float* sc, int lane) {
#pragma unroll
    for (int j = 0; j < 4; ++j) { const int c = 4 * lane + 256 * j; const f32x4 wv = *(const f32x4*)(w + c), sv = *(const f32x4*)(sh + c), cv = *(const f32x4*)(sc + c);
        v[j] = v[j] * rstd * wv * (cv + 1.0f) + sv; }
}
DEV void store_row_bf16(bf16_t* o, int lane, const f32x4 (&v)[4]) {
#pragma unroll
    for (int j = 0; j < 4; ++j) { u32x2 w; w.x = pk2(v[j][0], v[j][1]); w.y = pk2(v[j][2], v[j][3]); *(u32x2*)(o + 4 * lane + 256 * j) = w; }
}

struct CtxFix { const float* PART; int S, layer, which; const float* scale; bool from_input; };
DEV void phase_norm(const Frame& F, int layer, int which, bf16_t* out, bool from_input, const CtxFix fx) {
    const int gw = F.bx * 8 + F.wave, NGW = F.G * 8;
    const float* w = INP(F, which == 0 ? I_NMIX : I_NFFN) + (size_t)layer * D;
    const int nrows = fx.PART ? ML : MT;
    constexpr int NS = 3;
    f32x4 ns[NS][4];
#pragma unroll
    for (int k = 0; k < NS; ++k) if (gw + k * NGW < nrows) load_row(hsrc_row(mksrc(F), from_input, gw + k * NGW), F.lane, ns[k]);
    for (int r0 = gw; r0 < nrows; r0 += NS * NGW) {
#pragma unroll
        for (int k = 0; k < NS; ++k) { const int r = r0 + k * NGW; if (r >= nrows) break;
            f32x4 v[4];
#pragma unroll
            for (int q = 0; q < 4; ++q) v[q] = ns[k][q];
            if (r + NS * NGW < nrows) load_row(hsrc_row(mksrc(F), from_input, r + NS * NGW), F.lane, ns[k]);
            const float rstd = rsqrtf(sumsq_row(v) * (1.0f / D) + EPS);
            const int vec = vec_of(r);
            normmod_row(v, rstd, w, modp(F, layer, vec, which), modp(F, layer, vec, which + 1), F.lane);
            store_row_bf16(out + (size_t)r * D, F.lane, v); }
    }
    if (fx.PART) {
        const Src src = mksrc(F); const float* gp = modq(src.mod, fx.layer, 2, fx.which);
        for (int r = ML + gw; r < MT; r += NGW) {
            f32x4 v[4], y[4], g[4];
            load_row(hsrc_row(src, fx.from_input, r), F.lane, v); load_row(gp, F.lane, g);
            if (fx.scale) { f32x4 sc[4]; load_row(fx.scale, F.lane, sc);
#pragma unroll
                for (int q = 0; q < 4; ++q) g[q] = g[q] * sc[q]; }
#pragma unroll
            for (int q = 0; q < 4; ++q) y[q] = (f32x4){0.f, 0.f, 0.f, 0.f};
            int sl = 0;
            for (; sl + 2 <= fx.S; sl += 2) { f32x4 t0[4], t1[4];
                load_row(fx.PART + ((size_t)sl * MC + (r - ML)) * D, F.lane, t0); load_row(fx.PART + ((size_t)(sl + 1) * MC + (r - ML)) * D, F.lane, t1);
#pragma unroll
                for (int q = 0; q < 4; ++q) { y[q] += t0[q]; y[q] += t1[q]; } }
            for (; sl < fx.S; ++sl) { f32x4 t0[4]; load_row(fx.PART + ((size_t)sl * MC + (r - ML)) * D, F.lane, t0);
#pragma unroll
                for (int q = 0; q < 4; ++q) y[q] += t0[q]; }
#pragma unroll
            for (int q = 0; q < 4; ++q) { v[q] = v[q] + g[q] * y[q]; *(f32x4*)(src.H + (size_t)r * D + 4 * F.lane + 256 * q) = v[q]; }
            const float rstd = rsqrtf(sumsq_row(v) * (1.0f / D) + EPS);
            normmod_row(v, rstd, w, modp(F, layer, 2, which), modp(F, layer, 2, which + 1), F.lane);
            store_row_bf16(out + (size_t)r * D, F.lane, v); }
    }
}

struct TokInfo { int s0, s1; float g0, g1; };
DEV void phase_poolprep(const Frame& F, int layer, bf16_t* P, bool fuse, const bf16_t* YS) {
    const TokInfo* tok = (const TokInfo*)(F.ws + OFF_TOK);
    LAS bf16_t* ub = (LAS bf16_t*)(F.lds);
    LAS float* rs = (LAS float*)(F.lds + 81920);
    const float* w = INP(F, I_NMIX) + (size_t)layer * D;
    constexpr int CTH = 4, NLT = ML / 64; const int ntile = NLT + MC / CTH;
    const int chunk = F.tid & 127, tg = F.tid >> 7;
    for (int tile = F.bx; tile < ntile; tile += F.G) {
        const int r0 = tile < NLT ? tile * 64 : ML + (tile - NLT) * CTH; const int th = tile < NLT ? 64 : CTH;
        if (r0 < ML) {
            LAS bf16_t* ul = (LAS bf16_t*)(F.lds);
            const int vec = vec_of(r0);
            { f32x4 wc[4], sv[4], g2[4];
#pragma unroll
              for (int jq = 0; jq < 4; ++jq) { const int c = 4 * F.lane + 256 * jq; wc[jq] = *(const f32x4*)(w + c) * (*(const f32x4*)(modp(F, layer, vec, 1) + c) + 1.0f); sv[jq] = *(const f32x4*)(modp(F, layer, vec, 0) + c);
                  g2[jq] = fuse ? *(const f32x4*)(modp(F, layer - 1, vec, 5) + c) * (MOE_DOWN_FP8 ? 0.00390625f : 1.0f) : (f32x4){0.f, 0.f, 0.f, 0.f}; }
              f32x4 nh[4]; u32x2 nya[4], nyb[4]; TokInfo tn; tn.s0 = tn.s1 = 0; tn.g0 = tn.g1 = 0.f;
              { const int r = r0 + F.wave; load_row(hin_row(F, layer, r), F.lane, nh);
                if (fuse) { tn = tok[r];
#pragma unroll
                    for (int jq = 0; jq < 4; ++jq) { const int c = 4 * F.lane + 256 * jq; nya[jq] = *(const u32x2*)(YS + (size_t)tn.s0 * D + c); nyb[jq] = *(const u32x2*)(YS + (size_t)tn.s1 * D + c); } } }
#pragma unroll 1
              for (int k = 0; k < 8; ++k) { const int rl = F.wave + 8 * k, r = r0 + rl;
                  f32x4 v[4]; u32x2 ya[4], yb[4]; const TokInfo ti = tn;
#pragma unroll
                  for (int q = 0; q < 4; ++q) { v[q] = nh[q]; ya[q] = nya[q]; yb[q] = nyb[q]; }
                  if (k < 7) { load_row(hin_row(F, layer, r + 8), F.lane, nh);
                      if (fuse) { tn = tok[r + 8];
#pragma unroll
                          for (int jq = 0; jq < 4; ++jq) { const int c = 4 * F.lane + 256 * jq; nya[jq] = *(const u32x2*)(YS + (size_t)tn.s0 * D + c); nyb[jq] = *(const u32x2*)(YS + (size_t)tn.s1 * D + c); } } }
                  if (fuse) {
#pragma unroll
                      for (int jq = 0; jq < 4; ++jq) { const u32x2 a = ya[jq], b = yb[jq];
                          v[jq][0] += g2[jq][0] * (ti.g0 * bflo(a.x) + ti.g1 * bflo(b.x)); v[jq][1] += g2[jq][1] * (ti.g0 * bfhi(a.x) + ti.g1 * bfhi(b.x));
                          v[jq][2] += g2[jq][2] * (ti.g0 * bflo(a.y) + ti.g1 * bflo(b.y)); v[jq][3] += g2[jq][3] * (ti.g0 * bfhi(a.y) + ti.g1 * bfhi(b.y));
                          *(f32x4*)(F.H + (size_t)r * D + 4 * F.lane + 256 * jq) = v[jq]; } }
                  const float rstd = rsqrtf(sumsq_row(v) * (1.0f / D) + EPS);
#pragma unroll
                  for (int jq = 0; jq < 4; ++jq) { const f32x4 u = v[jq] * rstd * wc[jq] + sv[jq]; u32x2 pw; pw.x = pk2(u[0], u[1]); pw.y = pk2(u[2], u[3]);
                      *(LAS u32x2*)(ul + rl * 1024 + 4 * F.lane + 256 * jq) = pw; } } }
            __syncthreads();
            { const int cq = F.tid & 255, hf = F.tid >> 8, c = cq * 4, g = c >> 8, win = 2 << g, lo = win >> 1, hi = win - 1 - lo;
#define PL_U(t_) ({ const u32x2 _q = *(const LAS u32x2*)(ul + (t_) * 1024 + c); (f32x4){bflo(_q.x), bfhi(_q.x), bflo(_q.y), bfhi(_q.y)}; })
              const int ta = 32 * hf;
              f32x4 sacc = (f32x4){0.f, 0.f, 0.f, 0.f};
              { const int a = (ta - lo > 0) ? ta - lo : 0, b = (ta + hi + 1 < 64) ? ta + hi + 1 : 64; for (int t = a; t < b; ++t) sacc += PL_U(t); }
              for (int t = ta; t < ta + 32; ++t) {
                  const int a = (t - lo > 0) ? t - lo : 0, b = (t + hi + 1 < 64) ? t + hi + 1 : 64;
                  const float inv = 1.0f / (float)(b - a);
                  const f32x4 o = sacc * inv - PL_U(t);
                  u32x2 pw; pw.x = pk2(o[0], o[1]); pw.y = pk2(o[2], o[3]); *(u32x2*)(P + (size_t)(r0 + t) * D + c) = pw;
                  if (t + 1 < ta + 32) { if (t + 1 + hi < 64) sacc += PL_U(t + 1 + hi); if (t - lo >= 0) sacc -= PL_U(t - lo); } }
#undef PL_U
            }
            __syncthreads();
            continue;
        }
        int seq0, seq1;
        if (r0 < ML) { seq0 = r0; seq1 = r0 + 64; } else { seq0 = ML + ((r0 - ML) / CTXL) * CTXL; seq1 = seq0 + CTXL; }
        const int lo_r = (r0 - 8 > seq0) ? r0 - 8 : seq0, hi_r = (r0 + th + 7 < seq1) ? r0 + th + 7 : seq1;
        const int nrow = hi_r - lo_r;
        for (int rb = lo_r + F.wave; rb < hi_r; rb += 16) {
            f32x4 v5[2][4];
#pragma unroll
            for (int k = 0; k < 2; ++k) { const int r = rb + 8 * k; if (r < hi_r) load_row(hin_row(F, layer, r), F.lane, v5[k]); }
#pragma unroll
            for (int k = 0; k < 2; ++k) { const int r = rb + 8 * k; if (r < hi_r) { const float ss = sumsq_row(v5[k]); if (F.lane == 0) rs[r - lo_r] = rsqrtf(ss * (1.0f / D) + EPS); } } }
        __syncthreads();
        const int vec = vec_of(r0);
#pragma unroll 1
        for (int half = 0; half < 2; ++half) {
            const int c = half * 512 + 4 * chunk, g = c >> 8, win = 2 << g, lo = win >> 1, hi = win - 1 - lo;
            const f32x4 wv = *(const f32x4*)(w + c), sv = *(const f32x4*)(modp(F, layer, vec, 0) + c), cv = *(const f32x4*)(modp(F, layer, vec, 1) + c) + 1.0f;
            const f32x4 wc = wv * cv;
#pragma unroll 1
            for (int kb = 0; kb < 20; kb += 5) {
                f32x4 hv[5];
#pragma unroll
                for (int k = 0; k < 5; ++k) { const int rr = tg + 4 * (kb + k); if (rr < nrow) hv[k] = *(const f32x4*)(hin_row(F, layer, lo_r + rr) + c); }
#pragma unroll
                for (int k = 0; k < 5; ++k) { const int rr = tg + 4 * (kb + k); if (rr < nrow) { const f32x4 u = hv[k] * rs[rr] * wc + sv;
                    u32x2 pw; pw.x = pk2(u[0], u[1]); pw.y = pk2(u[2], u[3]); *(LAS u32x2*)(ub + rr * 512 + 4 * chunk) = pw; } } }
            __syncthreads();
#define PP_U(r_) ({ const u32x2 _q = *(const LAS u32x2*)(ub + ((r_) - lo_r) * 512 + 4 * chunk); (f32x4){bflo(_q.x), bfhi(_q.x), bflo(_q.y), bfhi(_q.y)}; })
            const int tq = th >> 2, ta = r0 + tq * tg;
            f32x4 s = (f32x4){0.f, 0.f, 0.f, 0.f};
            { const int a = (ta - lo > seq0) ? ta - lo : seq0, b = (ta + hi + 1 < seq1) ? ta + hi + 1 : seq1; for (int r = a; r < b; ++r) s += PP_U(r); }
            for (int t = ta; t < ta + tq; ++t) {
                const int a = (t - lo > seq0) ? t - lo : seq0, b = (t + hi + 1 < seq1) ? t + hi + 1 : seq1;
                const float inv = 1.0f / (float)(b - a);
                const f32x4 o = s * inv - PP_U(t);
                u32x2 pw; pw.x = pk2(o[0], o[1]); pw.y = pk2(o[2], o[3]); *(u32x2*)(P + (size_t)t * D + c) = pw;
                if (t + 1 < ta + tq) {
                    if (t + 1 + hi < seq1) s += PP_U(t + 1 + hi);
                    if (t - lo >= seq0) s -= PP_U(t - lo); }
            }
#undef PP_U
            __syncthreads();
        }
    }
}

struct PolBase { int G, c; static constexpr bool VARK = false; };
DEV bool ctx_next(int npan, int nsl, int G, int c, int i, Unit& u) {
    const int nmain = npan * 4; const long L = (long)i * G + c;
    if (L < nmain) return ge::static_next(npan, 4, G, c, i, u);
    const long L2 = L - nmain; if (L2 >= 8L * nsl) return false;
    const int t = (int)(L2 & 7); u.pm = ML / 256 + (t >> 2); u.pn = (t & 3) + 4 * (1 + (int)(L2 >> 3)); return true;
}
DEV int ctx_koff(const Unit& u) { return (u.pn >> 2) ? ((u.pn >> 2) - 1) * 128 : 0; }
DEV void ctx_store(float* PART, const f32x4 (&acc)[2][2][4][2], const Unit& u, int wr, int wc, int fr, int fq) {
    float* o = PART + ((size_t)((u.pn >> 2) - 1) * MC + (u.pm * 256 - ML) + wr * 64 + fr) * D + (u.pn & 3) * 256 + wc * 32 + 4 * fq;
#pragma unroll
    for (int ai = 0; ai < 2; ++ai)
#pragma unroll
        for (int m = 0; m < 4; ++m)
#pragma unroll
            for (int bj = 0; bj < 2; ++bj)
#pragma unroll
                for (int n = 0; n < 2; ++n) *(f32x4*)(o + (size_t)(ai * 128 + m * 16) * D + bj * 128 + n * 16) = acc[ai][bj][m][n];
}
struct PolPool : PolBase {
    static constexpr bool PERM = false, GATHER = false; static constexpr bool FP8 = false; static constexpr int ES = 2; int K, lda, ldb;
    static constexpr bool VARK = true;
    const bf16_t* P; const bf16_t* W; Src src; int layer, npan; const float* scale; float* PART;
    DEV bool next(int i, Unit& u) const { return ctx_next(npan, 2, G, c, i, u); }
    DEV int unit_nt(const Unit& u) const { return (u.pn >> 2) ? 2 : 4; }
    DEV const char* a_base(const Unit& u) const { return (const char*)(P + (size_t)u.pm * 256 * D + (u.pn & 3) * 256 + ctx_koff(u)); }
    DEV const char* b_base(const Unit& u) const { return (const char*)(W + (size_t)(u.pn & 3) * 65536 + ctx_koff(u)); }
    DEV void epi(const f32x4 (&acc)[2][2][4][2], const Unit& u, int wr, int wc, int fr, int fq) const {
        if (u.pn >> 2) { ctx_store(PART, acc, u, wr, wc, fr, fq); return; }
        const int row0 = u.pm * 256 + wr * 64 + fr, col0 = u.pn * 256 + wc * 32 + 4 * fq; const int vec = vec_of(u.pm * 256);
        const float* g1 = modq(src.mod, layer, vec, 2);
        f32x4 gv[2][2];
#pragma unroll
        for (int bj = 0; bj < 2; ++bj)
#pragma unroll
            for (int n = 0; n < 2; ++n) { const int cc = col0 + bj * 128 + n * 16; gv[bj][n] = *(const f32x4*)(g1 + cc) * *(const f32x4*)(scale + cc); }
#pragma unroll
        for (int ai = 0; ai < 2; ++ai)
#pragma unroll
            for (int mp = 0; mp < 4; mp += 2) { f32x4 hv[2][2][2];
#pragma unroll
                for (int m2 = 0; m2 < 2; ++m2) { const float* hi = hsrc_row(src, layer == 0, row0 + ai * 128 + (mp + m2) * 16) + col0;
#pragma unroll
                    for (int bj = 0; bj < 2; ++bj)
#pragma unroll
                        for (int n = 0; n < 2; ++n) hv[m2][bj][n] = *(const f32x4*)(hi + bj * 128 + n * 16); }
#pragma unroll
                for (int m2 = 0; m2 < 2; ++m2) { float* ho = src.H + (size_t)(row0 + ai * 128 + (mp + m2) * 16) * D + col0;
#pragma unroll
                    for (int bj = 0; bj < 2; ++bj)
#pragma unroll
                        for (int n = 0; n < 2; ++n) *(f32x4*)(ho + bj * 128 + n * 16) = hv[m2][bj][n] + gv[bj][n] * acc[ai][bj][mp + m2][n]; } }
    }
};
struct PolResid : PolBase {
    static constexpr bool PERM = false, GATHER = false; static constexpr bool FP8 = false; static constexpr int ES = 2; int K, lda, ldb;
    static constexpr bool VARK = true;
    const bf16_t* A; const bf16_t* W; Src src; int layer, which, npan, nsl; float* PART;
    DEV bool next(int i, Unit& u) const { return ctx_next(npan, nsl, G, c, i, u); }
    DEV int unit_nt(const Unit& u) const { return (u.pn >> 2) ? 2 : K / 64; }
    DEV const char* a_base(const Unit& u) const { return (const char*)(A + (size_t)u.pm * 256 * lda + ctx_koff(u)); }
    DEV const char* b_base(const Unit& u) const { return (const char*)(W + (size_t)(u.pn & 3) * 256 * ldb + ctx_koff(u)); }
    DEV void epi(const f32x4 (&acc)[2][2][4][2], const Unit& u, int wr, int wc, int fr, int fq) const {
        if (u.pn >> 2) { ctx_store(PART, acc, u, wr, wc, fr, fq); return; }
        const int row0 = u.pm * 256 + wr * 64 + fr, col0 = u.pn * 256 + wc * 32 + 4 * fq; const int vec = vec_of(u.pm * 256);
        const float* gp = modq(src.mod, layer, vec, which);
        f32x4 gv[2][2];
#pragma unroll
        for (int bj = 0; bj < 2; ++bj)
#pragma unroll
            for (int n = 0; n < 2; ++n) gv[bj][n] = *(const f32x4*)(gp + col0 + bj * 128 + n * 16);
#pragma unroll
        for (int ai = 0; ai < 2; ++ai)
#pragma unroll
            for (int mp = 0; mp < 4; mp += 2) { f32x4 hv[2][2][2];
#pragma unroll
                for (int m2 = 0; m2 < 2; ++m2) { const float* hi = src.H + (size_t)(row0 + ai * 128 + (mp + m2) * 16) * D + col0;
#pragma unroll
                    for (int bj = 0; bj < 2; ++bj)
#pragma unroll
                        for (int n = 0; n < 2; ++n) hv[m2][bj][n] = *(const f32x4*)(hi + bj * 128 + n * 16); }
#pragma unroll
                for (int m2 = 0; m2 < 2; ++m2) { float* ho = src.H + (size_t)(row0 + ai * 128 + (mp + m2) * 16) * D + col0;
#pragma unroll
                    for (int bj = 0; bj < 2; ++bj)
#pragma unroll
                        for (int n = 0; n < 2; ++n) *(f32x4*)(ho + bj * 128 + n * 16) = hv[m2][bj][n] + gv[bj][n] * acc[ai][bj][mp + m2][n]; } }
    }
};
template <bool MOE>
struct PolUp : PolBase {
    static constexpr bool PERM = true, GATHER = MOE, FP8 = MOE; static constexpr int ES = MOE ? 1 : 2; int K, lda, ldb;
    const bf16_t* A; const bf16_t* W; bf16_t* HID; int ldh, nq;
    int nM; const int* s2t; int tstart[NEXP + 1];
    DEV bool next(int i, Unit& u) const { return ge::static_next(MOE ? nM : NPAN, nq, G, c, i, u); }
    DEV int expert_of(int pm) const { int e = 0;
#pragma unroll
        for (int k = 1; k < NEXP; ++k) e += (pm >= tstart[k]) ? 1 : 0;
        return e; }
    DEV const char* a_base(const Unit& u) const { return MOE ? (const char*)A : (const char*)(A + (size_t)u.pm * 256 * lda); }
    DEV const char* b_base(const Unit& u) const { size_t off = (size_t)u.pn * 256 * ldb; if (MOE) off += (size_t)expert_of(u.pm) * 2 * DFFE * ldb; return (const char*)W + off * ES; }
    DEV int gather_row(const Unit& u, int R) const { return s2t[u.pm * 256 + R]; }
    DEV void epi(const f32x4 (&acc)[2][2][4][2], const Unit& u, int wr, int wc, int fr, int fq) const {
        const int row0 = u.pm * 256 + wr * 64 + fr, col0 = u.pn * 128 + wc * 32 + 8 * fq;
#pragma unroll
        for (int ai = 0; ai < 2; ++ai)
#pragma unroll
            for (int m = 0; m < 4; ++m) { bf16_t* o = HID + (size_t)(row0 + ai * 128 + m * 16) * ldh + col0;
                float h[8];
                constexpr float SG = MOE ? 0.00390625f : 1.0f, SU = MOE ? (MOE_DOWN_FP8 ? 0.015625f : 0.00390625f) : 1.0f;
                const f32x2 ke = {-1.4426950408889634f * SG, -1.4426950408889634f * SG}, ks = {SG * SU, SG * SU}, one = {1.0f, 1.0f};
#pragma unroll
                for (int n = 0; n < 2; ++n)
#pragma unroll
                    for (int ip = 0; ip < 2; ++ip) { const f32x2 g = {acc[ai][0][m][n][2 * ip], acc[ai][0][m][n][2 * ip + 1]}, u = {acc[ai][1][m][n][2 * ip], acc[ai][1][m][n][2 * ip + 1]};
                        const f32x2 t = g * ke; const f32x2 d = (f32x2){fexp2(t.x), fexp2(t.y)} + one; const f32x2 r = {frcp(d.x), frcp(d.y)};
                        const f32x2 hh = MOE ? (g * u) * (r * ks) : (g * u) * r; h[4 * n + 2 * ip] = hh.x; h[4 * n + 2 * ip + 1] = hh.y; }
                if (MOE && MOE_DOWN_FP8) { u32x2 w8; w8.x = pk4_fp8(h[0], h[1], h[2], h[3]); w8.y = pk4_fp8(h[4], h[5], h[6], h[7]);
                    *(u32x2*)((fp8_t*)HID + (size_t)(row0 + ai * 128 + m * 16) * ldh + col0) = w8; }
                else { u32x4 w; w.x = pk2(h[0], h[1]); w.y = pk2(h[2], h[3]); w.z = pk2(h[4], h[5]); w.w = pk2(h[6], h[7]); *(u32x4*)o = w; } }
    }
};
struct PolMoeDown : PolBase {
    static constexpr bool PERM = true, GATHER = (MOE_DOWN_FP8 != 0), FP8 = (MOE_DOWN_FP8 != 0); static constexpr int ES = MOE_DOWN_FP8 ? 1 : 2; int K, lda, ldb;
    const bf16_t* A; const bf16_t* W; bf16_t* YS; int nM; int tstart[NEXP + 1];
    DEV bool next(int i, Unit& u) const { return ge::static_next(nM, 4, G, c, i, u); }
    DEV int expert_of(int pm) const { int e = 0;
#pragma unroll
        for (int k = 1; k < NEXP; ++k) e += (pm >= tstart[k]) ? 1 : 0;
        return e; }
    DEV const char* a_base(const Unit& u) const { return GATHER ? (const char*)A : (const char*)A + (size_t)u.pm * 256 * lda * ES; }
    DEV int gather_row(const Unit& u, int R) const { return u.pm * 256 + R; }
    DEV const char* b_base(const Unit& u) const { return (const char*)W + ((size_t)expert_of(u.pm) * D + (size_t)u.pn * 256) * ldb * ES; }
    DEV void epi(const f32x4 (&acc)[2][2][4][2], const Unit& u, int wr, int wc, int fr, int fq) const {
        const int row0 = u.pm * 256 + wr * 64 + fr, col0 = u.pn * 256 + wc * 32 + 8 * fq;
#pragma unroll
        for (int ai = 0; ai < 2; ++ai)
#pragma unroll
            for (int m = 0; m < 4; ++m) { bf16_t* o = YS + (size_t)(row0 + ai * 128 + m * 16) * D + col0;
#pragma unroll
                for (int bj = 0; bj < 2; ++bj) { u32x4 w; w.x = pk2(acc[ai][bj][m][0][0], acc[ai][bj][m][0][1]); w.y = pk2(acc[ai][bj][m][0][2], acc[ai][bj][m][0][3]);
                    w.z = pk2(acc[ai][bj][m][1][0], acc[ai][bj][m][1][1]); w.w = pk2(acc[ai][bj][m][1][2], acc[ai][bj][m][1][3]); *(u32x4*)(o + bj * 128) = w; } }
    }
};
struct PolInProj : PolBase {
    static constexpr bool PERM = true, GATHER = false; static constexpr bool FP8 = false; static constexpr int ES = 2; int K, lda, ldb;
    const bf16_t* A; const bf16_t* W; bf16_t* Z; bf16_t* XBC; float* DT;
    DEV bool next(int i, Unit& u) const { return ge::static_next(NPAN, NPROJP / 256, G, c, i, u); }
    DEV const char* a_base(const Unit& u) const { return (const char*)(A + (size_t)u.pm * 256 * lda); }
    DEV const char* b_base(const Unit& u) const { return (const char*)(W + (size_t)u.pn * 256 * ldb); }
    DEV void epi(const f32x4 (&acc)[2][2][4][2], const Unit& u, int wr, int wc, int fr, int fq) const {
        const int row0 = u.pm * 256 + wr * 64 + fr, cw = wc * 32 + 8 * fq;
        if (u.pn < 20) {
            bf16_t* base; size_t ld, bjs; int col0;
            if (u.pn < 8) { base = Z; ld = DIN; col0 = u.pn * 256 + cw; bjs = 128; }
            else { base = XBC + (size_t)((u.pn - 8) * 4 + (wc >> 1)) * MT * 64; ld = 64; col0 = (wc & 1) * 32 + 8 * fq; bjs = (size_t)2 * MT * 64; }
#pragma unroll
            for (int ai = 0; ai < 2; ++ai)
#pragma unroll
                for (int m = 0; m < 4; ++m) { bf16_t* o = base + (size_t)(row0 + ai * 128 + m * 16) * ld + col0;
#pragma unroll
                    for (int bj = 0; bj < 2; ++bj) { u32x4 w; w.x = pk2(acc[ai][bj][m][0][0], acc[ai][bj][m][0][1]); w.y = pk2(acc[ai][bj][m][0][2], acc[ai][bj][m][0][3]);
                        w.z = pk2(acc[ai][bj][m][1][0], acc[ai][bj][m][1][1]); w.w = pk2(acc[ai][bj][m][1][2], acc[ai][bj][m][1][3]); *(u32x4*)(o + bj * bjs) = w; } }
        } else if (cw < 64) {
#pragma unroll
            for (int ai = 0; ai < 2; ++ai)
#pragma unroll
                for (int m = 0; m < 4; ++m) { const int r = row0 + ai * 128 + m * 16; int b, tv;
                    if (r < ML) { b = r / SEQ; tv = CTXL + r % SEQ; } else { b = (r - ML) / CTXL; tv = (r - ML) % CTXL; }
#pragma unroll
                    for (int n = 0; n < 2; ++n)
#pragma unroll
                        for (int i = 0; i < 4; ++i) { const int j = cw + 4 * n + i, dir = j >> 5, h = j & 31;
                            DT[((size_t)(b * 2 + dir) * NH + h) * TV + tv] = acc[ai][0][m][n][i]; } }
        }
    }
};

DEV void phase_conv(const Frame& F, int j, const bf16_t* XBC, bf16_t* XT, bf16_t* Brow, bf16_t* BT, bf16_t* Crow) {
    LAS bf16_t* tl0 = (LAS bf16_t*)F.lds;
    const float* cw = INP(F, I_CONVW) + (size_t)j * 4 * CONVD; const float* cb = INP(F, I_CONVB) + (size_t)j * CONVD;
    constexpr int NPER = NB * NCH, nitem = NPER * (CONVD / 64);
    const int t2 = 2 * (F.tid >> 3), cg = F.tid & 7;
    const int i0 = (int)(((long)F.bx * nitem) / F.G), i1 = (int)(((long)(F.bx + 1) * nitem) / F.G);
    int cblk_cur = -1; f32x4 wv[4][2], bv[2]; int par = 0;
#define CV_LOAD(it_, q_) do { const int _cb = (it_) / NPER, _rs = (it_) % NPER, _b = _rs / NCH, _cv = _rs % NCH; const int _ch = _cb * 64 + cg * 8, _tv = _cv * 128 + t2; \
        const int _s0 = _tv < CTXL ? 0 : CTXL, _s1 = _tv < CTXL ? CTXL : TV; \
        _Pragma("unroll") for (int k = 0; k < 5; ++k) { const int tk = _tv - 2 + k; q_[k] = (u32x4){0u, 0u, 0u, 0u}; \
            if (tk >= _s0 && tk < _s1) q_[k] = *(const u32x4*)(XBC + ((size_t)_cb * MT + row_of(_b, tk)) * 64 + cg * 8); } } while (0)
    u32x4 qn[5];
    if (i0 < i1) CV_LOAD(i0, qn);
    for (int it = i0; it < i1; ++it) {
        const int cblk = it / NPER, rest = it % NPER, b = rest / NCH, cv = rest % NCH;
        const int ch0 = cblk * 64 + cg * 8;
        if (cblk != cblk_cur) { cblk_cur = cblk;
#pragma unroll
            for (int k = 0; k < 4; ++k) { wv[k][0] = *(const f32x4*)(cw + k * CONVD + ch0); wv[k][1] = *(const f32x4*)(cw + k * CONVD + ch0 + 4); }
            bv[0] = *(const f32x4*)(cb + ch0); bv[1] = *(const f32x4*)(cb + ch0 + 4); }
        const int tv = cv * 128 + t2;
        float xin[5][8];
#pragma unroll
        for (int k = 0; k < 5; ++k) { const u32x4 q = qn[k];
            xin[k][0] = bflo(q.x); xin[k][1] = bfhi(q.x); xin[k][2] = bflo(q.y); xin[k][3] = bfhi(q.y); xin[k][4] = bflo(q.z); xin[k][5] = bfhi(q.z); xin[k][6] = bflo(q.w); xin[k][7] = bfhi(q.w); }
        if (it + 1 < i1) CV_LOAD(it + 1, qn);
        unsigned pk[2][4];
#pragma unroll
        for (int o = 0; o < 2; ++o) { float a[8];
#pragma unroll
            for (int i = 0; i < 8; ++i) { float acc = bv[i >> 2][i & 3];
#pragma unroll
                for (int k = 0; k < 4; ++k) acc += wv[k][i >> 2][i & 3] * xin[o + k][i];
                a[i] = siluf(acc); }
#pragma unroll
            for (int i = 0; i < 4; ++i) pk[o][i] = pk2(a[2 * i], a[2 * i + 1]); }
        const int r = row_of(b, tv);
        const bool isx = cblk < DIN / 64, isb = !isx && cblk < (DIN + BCD) / 64;
        if (!isx) {
            const int chc = ch0 - DIN - (isb ? 0 : BCD); bf16_t* o = (isb ? Brow : Crow) + (size_t)(r - t2) * BCD + (chc >> 7) * 16384 + frag_off(t2, chc & 127);
            *(u32x4*)o = (u32x4){pk[0][0], pk[0][1], pk[0][2], pk[0][3]}; *(u32x4*)(o + 8) = (u32x4){pk[1][0], pk[1][1], pk[1][2], pk[1][3]}; }
        if (isx || isb) {
            LAS bf16_t* tl = tl0 + par * (64 * 136); par ^= 1;
#pragma unroll
            for (int i = 0; i < 4; ++i) { const unsigned lo = (pk[0][i] & 0xffffu) | (pk[1][i] << 16), hi = (pk[0][i] >> 16) | (pk[1][i] & 0xffff0000u);
                *(LAS unsigned*)(tl + (cg * 8 + 2 * i) * 136 + t2) = lo; *(LAS unsigned*)(tl + (cg * 8 + 2 * i + 1) * 136 + t2) = hi; }
            __syncthreads();
            if (isx) { bf16_t* dst = XT + ((size_t)(b * NCH + cv) * DIN + cblk * 64) * 128;
#pragma unroll
                for (int q = 0; q < 2; ++q) { const int idx = F.tid + q * 512, ch = idx >> 4, t8 = (idx & 15) * 8;
                    *(u32x4*)(dst + idx * 8) = *(const LAS u32x4*)(tl + ch * 136 + t8); }
            } else {
                const int chb = cblk * 64 - DIN; bf16_t* dst = BT + (size_t)((b * NCH + cv) * NG + (chb >> 7)) * 16384 + ((chb & 127) >> 4) * 2048;
#pragma unroll
                for (int q = 0; q < 2; ++q) { const int idx = F.tid + q * 512, fr_ = idx & 15, fq_ = (idx >> 4) & 3, ks_ = (idx >> 6) & 3, rbl = idx >> 8;
                    *(u32x4*)(dst + idx * 8) = *(const LAS u32x4*)(tl + (rbl * 16 + fr_) * 136 + (ks_ * 4 + fq_) * 8); }
            }
        }
    }
}

#undef CV_LOAD
DEV void phase_cb(const Frame& F, const bf16_t* Brow, const bf16_t* Crow, bf16_t* CB) {
    const int nitem = NB * NG * NCH; const int fr = F.lane & 15, fq = F.lane >> 4;
    for (int it = F.bx; it < nitem; it += F.G) {
        const int cv = it % NCH, g = (it / NCH) % NG, b = it / (NCH * NG);
        const int rbase = row_of(b, cv * 128);
        const bf16_t* ct = Crow + (size_t)rbase * BCD + g * 16384 + F.lane * 8; const bf16_t* bt_ = Brow + (size_t)rbase * BCD + g * 16384 + F.lane * 8;
        bf16x8 cf[4], bfr[8][4];
#pragma unroll
        for (int ks = 0; ks < 4; ++ks) cf[ks] = *(const bf16x8*)(ct + (F.wave * 4 + ks) * 512);
#pragma unroll
        for (int nt = 0; nt < 8; ++nt)
#pragma unroll
            for (int ks = 0; ks < 4; ++ks) bfr[nt][ks] = *(const bf16x8*)(bt_ + (nt * 4 + ks) * 512);
        bf16_t* out = CB + ((size_t)((b * NG + g) * NCH + cv)) * 16384;
#pragma unroll
        for (int nt = 0; nt < 8; ++nt) {
            f32x4 acc = (f32x4){0.f, 0.f, 0.f, 0.f};
#pragma unroll
            for (int ks = 0; ks < 4; ++ks) acc = MFMA16(bfr[nt][ks], cf[ks], acc);
            u32x2 w; w.x = pk2(acc[0], acc[1]); w.y = pk2(acc[2], acc[3]);
            *(u32x2*)(out + frag_off(16 * F.wave + fr, 16 * nt + 4 * fq)) = w;
        }
    }
}

DEV void phase_tables(const Frame& F, int j, float* DT, float* CUM, float* WJ, float* CF) {
    const int nitem = NB * 2 * NH * NCH; const int gw = F.bx * 8 + F.wave, NGW = F.G * 8;
    f32x2 rawn = (f32x2){0.f, 0.f}; if (gw < nitem) rawn = *(const f32x2*)(DT + (size_t)gw * 128 + 2 * F.lane);
    for (int it = gw; it < nitem; it += NGW) {
        const int cv = it % NCH, h = (it / NCH) % NH, dir = (it / (NCH * NH)) & 1, b = it / (NCH * NH * 2);
        const float A = -expf(INP(F, I_ALOG)[(size_t)(j * 2 + dir) * NH + h]); const float bias = INP(F, I_DTB)[(size_t)(j * 2 + dir) * NH + h];
        const size_t o = ((size_t)(b * 2 + dir) * NH + h) * TV + cv * 128 + 2 * F.lane;
        const f32x2 raw = rawn; if (it + NGW < nitem) rawn = *(const f32x2*)(DT + (size_t)(it + NGW) * 128 + 2 * F.lane);
        const float d0 = softplusf(raw.x + bias), d1 = softplusf(raw.y + bias); const float a0 = d0 * A, a1 = d1 * A;
        float c0, c1, tot, sum = a0 + a1;
        if (dir == 0) {
#pragma unroll
            for (int q = 1; q < 64; q <<= 1) { const float t2 = __shfl_up(sum, q); if (F.lane >= q) sum += t2; }
            c1 = sum; c0 = sum - a1; tot = __shfl(sum, 63);
        } else {
#pragma unroll
            for (int q = 1; q < 64; q <<= 1) { const float t2 = __shfl_down(sum, q); if (F.lane + q < 64) sum += t2; }
            c0 = sum; c1 = sum - a0; tot = __shfl(sum, 0);
        }
        constexpr float L2E = 1.4426950408889634f;
        *(f32x2*)(DT + o) = (f32x2){c0 * L2E - flog2(d0), c1 * L2E - flog2(d1)};
        *(f32x2*)(CUM + o) = (f32x2){c0 * L2E, c1 * L2E};
        *(f32x2*)(WJ + o) = (f32x2){d0 * FEXP(tot - c0), d1 * FEXP(tot - c1)};
        const float cref = L2E * __shfl(dir == 0 ? c1 : c0, dir == 0 ? (F.lane | 15) : (F.lane & ~15));
        *(f32x2*)(CF + o) = (f32x2){d0 * fexp2(cref - c0 * L2E), d1 * fexp2(cref - c1 * L2E)};
    }
}

constexpr int SC_HL = 0, SC_TAB = 17408, SC_X = 21504, SC_END = SC_X + 16384;
static_assert(SC_END <= ge::STAGE_BYTES, "scan LDS map");
DEV void phase_scan(const Frame& F, int j, const bf16_t* XT, const bf16_t* BT, const bf16_t* Crow, const bf16_t* CB, const float* DT, const float* CUM, const float* WJ, const float* CF, bf16_t* Yf, bf16_t* Yb) {
    LAS unsigned char* L = F.lds;
    LAS bf16_t* Hl = (LAS bf16_t*)(L + SC_HL);
    LAS float* tab = (LAS float*)(L + SC_TAB);
    const int fr = F.lane & 15, fq = F.lane >> 4, w = F.wave;
    const int rb = w < 4 ? w : 11 - w;
    const int nitem = NB * NH * 2 * 2;
    for (int it = F.bx; it < nitem; it += F.G) {
        const int xq = it & 7, kq = it >> 3; const int b = xq >> 2, g = xq & 3, h = 8 * g + (kq >> 2), dir = (kq >> 1) & 1, ph = kq & 1;
        const float Dsk = dir == 0 ? INP(F, I_DSKIP)[(size_t)j * NH + h] : 0.f;
        const size_t tbase = ((size_t)(b * 2 + dir) * NH + h) * TV;
        const bf16_t* xt = XT + ((size_t)b * NCH * DIN + h * HD + ph * 32) * 128;
        const bf16_t* bt = BT + (size_t)(b * NCH * NG + g) * 16384;
        const bf16_t* CBh = CB + (size_t)((b * NG + g) * NCH) * 16384;
        const bf16_t* Cg = Crow + g * 16384;
        bf16_t* Y = (dir ? Yb : Yf) + h * HD + ph * 32;
        const int lrow = 16 * rb + fr;
        f32x4 accH[2]; accH[0] = (f32x4){0.f, 0.f, 0.f, 0.f}; accH[1] = accH[0];
        for (int i = F.tid; i < 32 * 136 / 2; i += 512) ((LAS unsigned*)Hl)[i] = 0u;
#define SC_CHUNK_OF(step) (dir == 0 ? (step) : ((step) < 2 ? 1 - (step) : (NCH - 1) - ((step) - 2)))
        const int xr = 4 * w + (F.lane >> 4), xc = F.lane & 15;
        const unsigned lxs = (unsigned)(xr * 128 + 8 * xc) * 2u, lxd = (unsigned)(xr * 256 + ((xc ^ (xr & 15)) << 4));
#define SC_LD_X(cvx_) (*(const u32x4*)((const char*)(xt + (size_t)(cvx_) * (DIN * 128)) + lxs))
#define SC_ST_X(xb_, v_) (*(LAS u32x4*)(L + SC_X + (xb_) * 8192 + lxd) = (v_))
        const float* tsrcw = ((w >> 1) == 0 ? CUM : ((w >> 1) == 1 ? DT : ((w >> 1) == 2 ? WJ : CF))) + tbase + (w & 1) * 64 + F.lane;
#define SC_LD_TAB(cvx_) (tsrcw[(cvx_) * 128])
#define SC_ST_TAB(tbuf_, v_) (tab[(tbuf_) * 512 + w * 64 + F.lane] = (v_))
        const unsigned lfo = (unsigned)(rb * 4096 + F.lane * 16);
#define SC_LD_CB(cvx_, ks_) (*(const u32x4*)((const char*)(CBh + (size_t)(cvx_) * 16384u) + lfo + (ks_) * 1024))
#define SC_LD_BT(cvx_, ks_) (*(const u32x4*)((const char*)(bt + (size_t)(cvx_) * 65536u) + lfo + (ks_) * 1024))
#define SC_LD_C(rbx_, ks_) (*(const bf16x8*)((const char*)(Cg + (size_t)(rbx_) * BCD) + lfo + (ks_) * 1024))
        const int kd = rb >> 1; float km[8], dk[8];
#pragma unroll
        for (int i = 0; i < 8; ++i) { const int sidx = 32 * kd + 8 * fq + i; km[i] = (dir == 0 ? (sidx <= lrow) : (sidx >= lrow)) ? 1.f : 0.f; dk[i] = (sidx == lrow) ? Dsk : 0.f; }
        u32x4 rcb[4], rbt[4]; bf16x8 cf[4];
        { const int cv0 = SC_CHUNK_OF(0); const u32x4 x0 = SC_LD_X(cv0); const float t0 = SC_LD_TAB(cv0); const unsigned rb0 = (unsigned)row_of(b, cv0 * 128);
#pragma unroll
          for (int ks = 0; ks < 4; ++ks) { rcb[ks] = SC_LD_CB(cv0, ks); rbt[ks] = SC_LD_BT(cv0, ks); cf[ks] = SC_LD_C(rb0, ks); }
          SC_ST_X(0, x0); SC_ST_TAB(0, t0); }
        for (int step = 0; step < NCH; ++step) {
            int kdl = kd, dirl = dir; LAUNDER_S(kdl); LAUNDER_S(dirl);
            const int cv = SC_CHUNK_OF(step), buf = step & 1; const bool more = step + 1 < NCH;
            const int cvn = more ? SC_CHUNK_OF(step + 1) : cv;
            const unsigned rbase = (unsigned)row_of(b, cv * 128), rbn = (unsigned)row_of(b, cvn * 128);
            LDSBAR();
            const u32x4 xn = SC_LD_X(cvn); const float tn = SC_LD_TAB(cvn);
            const LAS float* tb = tab + buf * 512;
            const float cl2 = tb[lrow]; const float ecum_l = fexp2(cl2);
            const float chunk_decay = fexp2(dir == 0 ? tb[127] : tb[0]);
            f32x4 yd[2], yo[2];
#pragma unroll
            for (int nt = 0; nt < 2; ++nt) { yd[nt] = (f32x4){0.f, 0.f, 0.f, 0.f}; yo[nt] = yd[nt]; accH[nt] = accH[nt] * chunk_decay; }
#pragma unroll
            for (int ks = 0; ks < 4; ++ks) { const int s0 = 32 * ks + 8 * fq; bf16x8 mfk, bwk;
                const bool none = dirl == 0 ? (ks > kdl) : (ks < kdl), diag = (ks == kdl);
                unsigned om[4] = {0u, 0u, 0u, 0u};
                if (!none) {
                    const unsigned qc[4] = {rcb[ks].x, rcb[ks].y, rcb[ks].z, rcb[ks].w};
                    if (!diag) {
                        const f32x4 f0 = *(const LAS f32x4*)(tb + 384 + s0), f1 = *(const LAS f32x4*)(tb + 384 + s0 + 4);
                        const float rowf = fexp2(cl2 - tb[dirl == 0 ? 32 * ks + 31 : 32 * ks]);
                        const f32x2 rf2 = {rowf, rowf};
                        const f32x2 c2[4] = {(f32x2){f0[0], f0[1]}, (f32x2){f0[2], f0[3]}, (f32x2){f1[0], f1[1]}, (f32x2){f1[2], f1[3]}};
#pragma unroll
                        for (int i = 0; i < 4; ++i) { const f32x2 v2 = (f32x2){bflo(qc[i]), bfhi(qc[i])} * (c2[i] * rf2); om[i] = pk2(v2.x, v2.y); }
                    } else {
                        const f32x4 cs0 = *(const LAS f32x4*)(tb + 128 + s0), cs1 = *(const LAS f32x4*)(tb + 128 + s0 + 4);
                        const float cs[8] = {cs0[0], cs0[1], cs0[2], cs0[3], cs1[0], cs1[1], cs1[2], cs1[3]};
                        float v[8];
#pragma unroll
                        for (int i = 0; i < 8; ++i) { const float cbv = (i & 1) ? bfhi(qc[i >> 1]) : bflo(qc[i >> 1]); const float x = cl2 - cs[i]; v[i] = (cbv * fexp2(x < 60.f ? x : 60.f)) * km[i] + dk[i]; }
#pragma unroll
                        for (int i = 0; i < 4; ++i) om[i] = pk2(v[2 * i], v[2 * i + 1]);
                    }
                    rcb[ks] = SC_LD_CB(cvn, ks);
                }
                mfk = __builtin_bit_cast(bf16x8, (u32x4){om[0], om[1], om[2], om[3]});
                { const f32x4 ws0 = *(const LAS f32x4*)(tb + 256 + s0), ws1 = *(const LAS f32x4*)(tb + 256 + s0 + 4);
                  const f32x2 w2[4] = {(f32x2){ws0[0], ws0[1]}, (f32x2){ws0[2], ws0[3]}, (f32x2){ws1[0], ws1[1]}, (f32x2){ws1[2], ws1[3]}};
                  const unsigned qb[4] = {rbt[ks].x, rbt[ks].y, rbt[ks].z, rbt[ks].w}; unsigned ob[4];
#pragma unroll
                  for (int i = 0; i < 4; ++i) { const f32x2 v2 = (f32x2){bflo(qb[i]), bfhi(qb[i])} * w2[i]; ob[i] = pk2(v2.x, v2.y); LAUNDER_V(ob[i]); }
                  bwk = __builtin_bit_cast(bf16x8, (u32x4){ob[0], ob[1], ob[2], ob[3]}); }
                rbt[ks] = SC_LD_BT(cvn, ks);
#pragma unroll
                for (int nt = 0; nt < 2; ++nt) {
                    const bf16x8 xf = *(const LAS bf16x8*)(L + SC_X + buf * 8192 + (16 * nt + fr) * 256 + (((4 * ks + fq) ^ fr) << 4));
                    if (!none) yd[nt] = MFMA16(xf, mfk, yd[nt]);
                    const bf16x8 hf = *(const LAS bf16x8*)(Hl + buf * (32 * 136) + (16 * nt + fr) * 136 + 32 * ks + 8 * fq);
                    yo[nt] = MFMA16(hf, cf[ks], yo[nt]);
                    accH[nt] = MFMA16(bwk, xf, accH[nt]); } }
#pragma unroll
            for (int ks = 0; ks < 4; ++ks) cf[ks] = SC_LD_C(rbn, ks);
            SC_ST_X(buf ^ 1, xn); SC_ST_TAB(buf ^ 1, tn);
#pragma unroll
            for (int nt = 0; nt < 2; ++nt) { u32x2 hw; hw.x = pk2(accH[nt][0], accH[nt][1]); hw.y = pk2(accH[nt][2], accH[nt][3]);
                *(LAS u32x2*)(Hl + (buf ^ 1) * (32 * 136) + (16 * nt + fr) * 136 + 16 * rb + 4 * fq) = hw; }
#pragma unroll
            for (int nt = 0; nt < 2; ++nt) { u32x2 yw; yw.x = pk2(yd[nt][0] + ecum_l * yo[nt][0], yd[nt][1] + ecum_l * yo[nt][1]); yw.y = pk2(yd[nt][2] + ecum_l * yo[nt][2], yd[nt][3] + ecum_l * yo[nt][3]);
                *(u32x2*)(Y + ((size_t)(rbase + lrow) * DIN + 16 * nt + 4 * fq)) = yw; }
        }
        WAITV(0); LDSBAR();
    }
}

DEV void phase_gate(const Frame& F, int j, const bf16_t* Yf, const bf16_t* Yb, const bf16_t* Z, bf16_t* YN, int nrows) {
    const int gw = F.bx * 8 + F.wave, NGW = F.G * 8; const float* nw = INP(F, I_SNORM) + (size_t)j * DIN;
    u32x4 na[4], nb[4], nz[4];
    if (gw < nrows) {
#pragma unroll
        for (int q = 0; q < 4; ++q) { const size_t o = (size_t)gw * DIN + 8 * F.lane + 512 * q; na[q] = *(const u32x4*)(Yf + o); nb[q] = *(const u32x4*)(Yb + o); nz[q] = *(const u32x4*)(Z + o); } }
    for (int r = gw; r < nrows; r += NGW) {
        float t[32]; float ss = 0.f;
        u32x4 ca[4], cb4[4], cz[4];
#pragma unroll
        for (int q = 0; q < 4; ++q) { ca[q] = na[q]; cb4[q] = nb[q]; cz[q] = nz[q]; }
        if (r + NGW < nrows) {
#pragma unroll
            for (int q = 0; q < 4; ++q) { const size_t o = (size_t)(r + NGW) * DIN + 8 * F.lane + 512 * q; na[q] = *(const u32x4*)(Yf + o); nb[q] = *(const u32x4*)(Yb + o); nz[q] = *(const u32x4*)(Z + o); } }
#pragma unroll
        for (int q = 0; q < 4; ++q) { const u32x4 a = ca[q], bq = cb4[q], z = cz[q];
            const unsigned aa[4] = {a.x, a.y, a.z, a.w}, bb[4] = {bq.x, bq.y, bq.z, bq.w}, zz[4] = {z.x, z.y, z.z, z.w};
#pragma unroll
            for (int i = 0; i < 4; ++i) { const float v0 = (bflo(aa[i]) + bflo(bb[i])) * siluf(bflo(zz[i])), v1 = (bfhi(aa[i]) + bfhi(bb[i])) * siluf(bfhi(zz[i])); t[8 * q + 2 * i] = v0; t[8 * q + 2 * i + 1] = v1; ss += v0 * v0 + v1 * v1; } }
        const float rstd = rsqrtf(wave_sum(ss) * (1.0f / DIN) + EPS);
#pragma unroll
        for (int q = 0; q < 4; ++q) { const int c = 8 * F.lane + 512 * q; const f32x4 w0 = *(const f32x4*)(nw + c), w1 = *(const f32x4*)(nw + c + 4);
            u32x4 o; o.x = pk2(t[8 * q] * rstd * w0[0], t[8 * q + 1] * rstd * w0[1]); o.y = pk2(t[8 * q + 2] * rstd * w0[2], t[8 * q + 3] * rstd * w0[3]);
            o.z = pk2(t[8 * q + 4] * rstd * w1[0], t[8 * q + 5] * rstd * w1[1]); o.w = pk2(t[8 * q + 6] * rstd * w1[2], t[8 * q + 7] * rstd * w1[3]);
            *(u32x4*)(YN + (size_t)r * DIN + c) = o; }
    }
}

DEV void phase_route(const Frame& F, int layer, int ml, bf16_t* V, int nrows) {
    LAS unsigned* lc = (LAS unsigned*)(F.lds + LDS_MISC + 256);
    if (F.tid < 8) lc[F.tid] = 0u;
    __syncthreads();
    const int gw = F.bx * 8 + F.wave, NGW = F.G * 8; const int j = layer / 2;
    const float* w = INP(F, I_NFFN) + (size_t)layer * D; const float* rw = INP(F, I_RW) + (size_t)j * D * NEXP;
    LAS float* rwl = (LAS float*)F.lds;
    for (int q = F.tid; q < D * 2; q += 512) { const int c = q >> 1, hf = q & 1; const int ln = (c & 255) >> 2, ii = c & 3, jq = c >> 8;
        *(LAS f32x4*)(rwl + ((jq * 4 + ii) * 64 + ln) * 8 + hf * 4) = *(const f32x4*)(rw + (size_t)q * 4); }
    __syncthreads();
    TokInfo* tok = (TokInfo*)(F.ws + OFF_TOK);
    constexpr int NS = 3;
    f32x4 ns[NS][4];
#pragma unroll
    for (int k = 0; k < NS; ++k) if (gw + k * NGW < nrows) load_row(F.H + (size_t)(gw + k * NGW) * D, F.lane, ns[k]);
    for (int r0 = gw; r0 < nrows; r0 += NS * NGW) {
#pragma unroll
      for (int k = 0; k < NS; ++k) { const int r = r0 + k * NGW; if (r >= nrows) break;
        f32x4 v[4];
#pragma unroll
        for (int q = 0; q < 4; ++q) v[q] = ns[k][q];
        if (r + NS * NGW < nrows) load_row(F.H + (size_t)(r + NS * NGW) * D, F.lane, ns[k]);
        const float rstd = rsqrtf(sumsq_row(v) * (1.0f / D) + EPS);
        const int vec = vec_of(r);
        normmod_row(v, rstd, w, modp(F, layer, vec, 3), modp(F, layer, vec, 4), F.lane);
#pragma unroll
        for (int jq = 0; jq < 4; ++jq) *(unsigned*)((fp8_t*)V + (size_t)r * D + 4 * F.lane + 256 * jq) = pk4_fp8(v[jq][0] * 8.0f, v[jq][1] * 8.0f, v[jq][2] * 8.0f, v[jq][3] * 8.0f);
        float lg[NEXP];
#pragma unroll
        for (int e = 0; e < NEXP; ++e) lg[e] = 0.f;
#pragma unroll
        for (int jj = 0; jj < 4; ++jj)
#pragma unroll
            for (int i = 0; i < 4; ++i) { const LAS float* rp = rwl + ((jj * 4 + i) * 64 + F.lane) * 8; const f32x4 r0 = *(const LAS f32x4*)rp, r1 = *(const LAS f32x4*)(rp + 4);
#pragma unroll
                for (int e = 0; e < 4; ++e) { lg[e] += v[jj][i] * r0[e]; lg[4 + e] += v[jj][i] * r1[e]; } }
#pragma unroll
        for (int e = 0; e < NEXP; ++e) lg[e] = wave_sum(lg[e]);
        int e0 = 0; float v0 = lg[0];
#pragma unroll
        for (int e = 1; e < NEXP; ++e) if (lg[e] > v0) { v0 = lg[e]; e0 = e; }
        int e1 = -1; float v1 = -3.0e38f;
#pragma unroll
        for (int e = 0; e < NEXP; ++e) if (e != e0 && lg[e] > v1) { v1 = lg[e]; e1 = e; }
        const float g1 = frcp(1.0f + FEXP(v0 - v1)), g0 = 1.0f - g1;
        if (F.lane == 0) { TokInfo ti; ti.s0 = e0; ti.s1 = e1; ti.g0 = g0; ti.g1 = g1; tok[r] = ti; atomicAdd((unsigned*)&lc[e0], 1u); atomicAdd((unsigned*)&lc[e1], 1u); }
      }
    }
    __syncthreads();
    if (F.tid < 8) __hip_atomic_fetch_add(F.ctl + CW_CNT + (ml * 8 + F.tid) * 64, lc[F.tid], RLX_AGENT);
}
DEV void tile_starts(const Frame& F, int ml, int (&ts)[NEXP + 1], unsigned (&cnt)[NEXP]) {
    ts[0] = 0;
#pragma unroll
    for (int e = 0; e < NEXP; ++e) { cnt[e] = __hip_atomic_load(F.ctl + CW_CNT + (ml * 8 + e) * 64, RLX_AGENT); ts[e + 1] = ts[e] + (int)((cnt[e] + 255u) / 256u); }
}
DEV void phase_slots(const Frame& F, int ml, int nrows) {
    int ts[NEXP + 1]; unsigned cnt[NEXP]; tile_starts(F, ml, ts, cnt);
    TokInfo* tok = (TokInfo*)(F.ws + OFF_TOK); int* s2t = (int*)(F.ws + OFF_S2T);
    const int gw = F.bx * 8 + F.wave, NGW = F.G * 8;
    for (int base = gw * 64; base < nrows; base += NGW * 64) {
        const int r = base + F.lane; TokInfo ti = tok[r];
        unsigned long long m0[NEXP], m1[NEXP]; unsigned mycnt = 0;
#pragma unroll
        for (int e = 0; e < NEXP; ++e) { m0[e] = __ballot(ti.s0 == e); m1[e] = __ballot(ti.s1 == e); if (F.lane == e) mycnt = (unsigned)(__builtin_popcountll(m0[e]) + __builtin_popcountll(m1[e])); }
        unsigned b0 = 0;
        if (F.lane < NEXP && mycnt) b0 = __hip_atomic_fetch_add(F.ctl + CW_CUR + (ml * 8 + F.lane) * 64, mycnt, RLX_AGENT);
        const unsigned long long below = (1ull << F.lane) - 1ull; int sl0 = 0, sl1 = 0;
#pragma unroll
        for (int e = 0; e < NEXP; ++e) { const unsigned be = __shfl(b0, e); const int c0 = __builtin_popcountll(m0[e]);
            if (ti.s0 == e) sl0 = ts[e] * 256 + (int)be + __builtin_popcountll(m0[e] & below);
            if (ti.s1 == e) sl1 = ts[e] * 256 + (int)be + c0 + __builtin_popcountll(m1[e] & below); }
        ti.s0 = sl0; ti.s1 = sl1; tok[r] = ti; s2t[sl0] = r; s2t[sl1] = r;
    }
    if (F.bx == 0) { for (int e = 0; e < NEXP; ++e) { const int a = ts[e] * 256 + (int)cnt[e], b2 = ts[e + 1] * 256; for (int s = a + F.tid; s < b2; s += 512) s2t[s] = 0; } }
}
DEV void phase_combine(const Frame& F, int layer, const bf16_t* YS, bool final_) {
    const int NGW = F.G * 8; const int gw = F.bx * 8 + F.wave + (final_ ? 0 : ML); const TokInfo* tok = (const TokInfo*)(F.ws + OFF_TOK);
    const int nrows = final_ ? ML : MT;
    f32x4 nh[4]; u32x2 nya[4], nyb[4]; TokInfo tcur, tnxt;
    tcur.s0 = tcur.s1 = 0; tcur.g0 = tcur.g1 = 0.f; tnxt = tcur;
    if (gw < nrows) { tcur = tok[gw]; load_row(F.H + (size_t)gw * D, F.lane, nh);
#pragma unroll
        for (int jj = 0; jj < 4; ++jj) { const int c = 4 * F.lane + 256 * jj; nya[jj] = *(const u32x2*)(YS + (size_t)tcur.s0 * D + c); nyb[jj] = *(const u32x2*)(YS + (size_t)tcur.s1 * D + c); } }
    if (gw + NGW < nrows) tnxt = tok[gw + NGW];
    for (int r = gw; r < nrows; r += NGW) {
        f32x4 v[4]; u32x2 ya[4], yb[4]; TokInfo ti = tcur;
#pragma unroll
        for (int q = 0; q < 4; ++q) { v[q] = nh[q]; ya[q] = nya[q]; yb[q] = nyb[q]; }
        tcur = tnxt;
        if (r + NGW < nrows) { load_row(F.H + (size_t)(r + NGW) * D, F.lane, nh);
#pragma unroll
            for (int jj = 0; jj < 4; ++jj) { const int c = 4 * F.lane + 256 * jj; nya[jj] = *(const u32x2*)(YS + (size_t)tcur.s0 * D + c); nyb[jj] = *(const u32x2*)(YS + (size_t)tcur.s1 * D + c); } }
        if (r + 2 * NGW < nrows) tnxt = tok[r + 2 * NGW];
        if (MOE_DOWN_FP8) { ti.g0 *= 0.00390625f; ti.g1 *= 0.00390625f; }
        const float* g2 = modp(F, layer, vec_of(r), 5);
#pragma unroll
        for (int jj = 0; jj < 4; ++jj) { const int c = 4 * F.lane + 256 * jj; const u32x2 a = ya[jj], b = yb[jj]; const f32x4 gv = *(const f32x4*)(g2 + c);
            v[jj][0] += gv[0] * (ti.g0 * bflo(a.x) + ti.g1 * bflo(b.x)); v[jj][1] += gv[1] * (ti.g0 * bfhi(a.x) + ti.g1 * bfhi(b.x));
            v[jj][2] += gv[2] * (ti.g0 * bflo(a.y) + ti.g1 * bflo(b.y)); v[jj][3] += gv[3] * (ti.g0 * bfhi(a.y) + ti.g1 * bfhi(b.y)); }
        if (!final_) {
#pragma unroll
            for (int jj = 0; jj < 4; ++jj) *(f32x4*)(F.H + (size_t)r * D + 4 * F.lane + 256 * jj) = v[jj];
        } else {
            const float rstd = rsqrtf(sumsq_row(v) * (1.0f / D) + EPS); const float* fw = INP(F, I_FNORM);
#pragma unroll
            for (int jj = 0; jj < 4; ++jj) { const int c = 4 * F.lane + 256 * jj; *(f32x4*)(OUTP(F) + (size_t)r * D + c) = v[jj] * rstd * *(const f32x4*)(fw + c); }
        }
    }
}

constexpr int PH_PER_PAIR = 17, N_PHASES = 1 + 2 * PH_PER_PAIR;
static_assert((size_t)(DFF / 128) * MC * D * 4 <= al(SZ_WMUP) + SZ_WMDN, "context K-slice partials fit the expert-weight region");
__global__ void __launch_bounds__(512, 2) fwd_kernel(Params prm) {
#ifdef EMU
    unsigned char* lds_raw = emu_lds();
#else
    extern __shared__ __attribute__((aligned(16))) unsigned char lds_raw[];
#endif
    Frame F;
    F.lds = (LAS unsigned char*)lds_raw;
    F.tid = threadIdx.x; F.lane = F.tid & 63; F.wave = RFL(F.tid >> 6); F.G = gridDim.x; F.bx = blockIdx.x;
    F.p = &prm; F.ws = prm.ws; F.ctl = (unsigned*)(prm.ws + OFF_CTL); F.H = (float*)(prm.ws + OFF_H); F.mod = (float*)(prm.ws + OFF_MOD);
    volatile LAS unsigned* misc = (volatile LAS unsigned*)(F.lds + LDS_MISC);
    if (F.tid < 64) misc[F.tid] = 0u;
    __syncthreads();
    XcdBarrier bar; bar.bar = F.ctl + CW_BAR; bar.x = 0; bar.st = misc;
    const int lo = prm.ph_lo, hi = prm.ph_hi;
    if (hi - lo > 1) bar = xcd_barrier_post(F.ctl + CW_BAR, misc);
    int ph = 0;
#ifndef SITE_MASK
#define SITE_MASK 0xFFFFFFFFu
#endif
#ifndef PROBE_REPEAT_SITE
#define PROBE_REPEAT_SITE (-1)
#endif
#define PH_REPS(site) ((PROBE_REPEAT_SITE == (site)) ? 2 : 1)
#ifndef PROBE_TS_MASK
#define PROBE_TS_MASK 0u
#endif
#ifndef PROBE_TS_MULT
#define PROBE_TS_MULT 1
#endif
#ifdef EMU
#define NOWT() 0ull
#else
#define NOWT() ((unsigned long long)__builtin_amdgcn_s_memrealtime())
#endif
    unsigned long long tsacc = 0;
#define PHASE_BEGIN(site) if (((SITE_MASK >> (site)) & 1u) && lo <= ph && ph < hi) { { int _t = threadIdx.x; LAUNDER_V(_t); F.tid = _t; F.lane = _t & 63; int _b = blockIdx.x; LAUNDER_S(_b); F.bx = _b; int _g = gridDim.x; LAUNDER_S(_g); F.G = _g; \
      F.ws = WSP(F); F.ctl = (unsigned*)(F.ws + OFF_CTL); F.H = (float*)(F.ws + OFF_H); F.mod = (float*)(F.ws + OFF_MOD); } \
      const bool _tson = ((PROBE_TS_MASK >> (site)) & 1u) != 0u; unsigned long long _ts0 = 0; if (_tson) _ts0 = NOWT(); \
      for (int _rep = 0; _rep < PH_REPS(site); ++_rep) { if (_rep) __syncthreads();
#define PHASE_END   } if (ph + 1 < hi) xcd_barrier(bar); if (_tson) tsacc += NOWT() - _ts0; } ++ph;
#define B_W (F.ws + OFF_W)
#define B_ACT (F.ws + OFF_ACT)
#define B_P ((bf16_t*)(B_ACT + A_P))
#define B_HID ((bf16_t*)(B_ACT + A_HID))
#define B_U ((bf16_t*)(B_ACT + A_U))
#define B_Z ((bf16_t*)(B_ACT + A_Z))
#define B_XBC ((bf16_t*)(B_ACT + A_XBC))
#define B_DT ((float*)(B_W + W_DT))
#define B_XT ((bf16_t*)(B_ACT + A_XT))
#define B_BROW ((bf16_t*)(B_ACT + A_BROW))
#define B_BT ((bf16_t*)(B_ACT + A_BT))
#define B_CROW ((bf16_t*)(B_ACT + A_CROW))
#define B_CB ((bf16_t*)(B_ACT + A_CB))
#define B_CUM ((float*)(B_ACT + A_CUM))
#define B_WJ ((float*)(B_ACT + A_WJ))
#define B_CF ((float*)(B_ACT + A_CF))
#define B_YF ((bf16_t*)(B_ACT + A_YF))
#define B_YB ((bf16_t*)(B_W + W_YB))
#define B_YN ((bf16_t*)(B_ACT + A_YN))
#define B_V ((bf16_t*)(B_ACT + A_V))
#define B_HIDM ((bf16_t*)(B_ACT + A_HIDM))
#define B_YS ((bf16_t*)(B_ACT + A_YS))
#define B_PART ((float*)(B_W + W_MUP))

    PHASE_BEGIN(0) phase_mod(F); convert_even(F, 0); PHASE_END

    for (int lp = 0; lp < 2; ++lp) {
        const int le = 2 * lp, lod = 2 * lp + 1;
        PHASE_BEGIN(1) phase_poolprep(F, le, B_P, lp == 1, B_YS); PHASE_END
        PHASE_BEGIN(2) { PolPool S; S.G = F.G; S.c = F.bx; S.K = 256; S.lda = D; S.ldb = 256; S.P = B_P; S.W = (const bf16_t*)(B_W + W_POOL); S.src = mksrc(F); S.layer = le; S.scale = INP(F, I_POOLS) + (size_t)lp * D; S.npan = ML / 256; S.PART = B_PART;
                      ge::gemm_phase(F.lds, S, F.tid); } PHASE_END
        PHASE_BEGIN(3) { CtxFix fx; fx.PART = B_PART; fx.S = 2; fx.layer = le; fx.which = 2; fx.scale = INP(F, I_POOLS) + (size_t)lp * D; fx.from_input = le == 0; phase_norm(F, le, 3, B_P, false, fx); } PHASE_END
        PHASE_BEGIN(4) { PolUp<false> S; S.G = F.G; S.c = F.bx; S.K = D; S.lda = D; S.ldb = D; S.A = B_P; S.W = (const bf16_t*)(B_W + W_UP); S.HID = B_HID; S.ldh = DFF; S.nq = DFF / 128; S.nM = NPAN; S.s2t = nullptr;
                      ge::gemm_phase(F.lds, S, F.tid);
                      Frame F2 = F; if (idle_subgrid(F2, NPAN * S.nq)) convert_ssd(F2, lp); } PHASE_END
        PHASE_BEGIN(5) { PolResid S; S.G = F.G; S.c = F.bx; S.K = DFF; S.lda = DFF; S.ldb = DFF; S.A = B_HID; S.W = (const bf16_t*)(B_W + W_DN); S.src = mksrc(F); S.layer = le; S.which = 5; S.npan = ML / 256; S.nsl = DFF / 128; S.PART = B_PART;
                      ge::gemm_phase(F.lds, S, F.tid); } PHASE_END

        PHASE_BEGIN(6) { CtxFix fx; fx.PART = B_PART; fx.S = DFF / 128; fx.layer = le; fx.which = 5; fx.scale = nullptr; fx.from_input = false; phase_norm(F, lod, 0, B_U, false, fx); } PHASE_END
        PHASE_BEGIN(7) { PolInProj S; S.G = F.G; S.c = F.bx; S.K = D; S.lda = D; S.ldb = D; S.A = B_U; S.W = (const bf16_t*)(B_W + W_IN); S.Z = B_Z; S.XBC = B_XBC; S.DT = B_DT;
                      ge::gemm_phase(F.lds, S, F.tid); } PHASE_END
        PHASE_BEGIN(8) phase_conv(F, lp, B_XBC, B_XT, B_BROW, B_BT, B_CROW); PHASE_END
        PHASE_BEGIN(9) phase_cb(F, B_BROW, B_CROW, B_CB); { Frame F2 = F; if (idle_subgrid(F2, NB * NG * NCH)) phase_tables(F2, lp, B_DT, B_CUM, B_WJ, B_CF); } PHASE_END
        PHASE_BEGIN(10) phase_scan(F, lp, B_XT, B_BT, B_CROW, B_CB, B_DT, B_CUM, B_WJ, B_CF, B_YF, B_YB); PHASE_END
        PHASE_BEGIN(11) phase_gate(F, lp, B_YF, B_YB, B_Z, B_YN, lp == 1 ? ML : MT); PHASE_END
        PHASE_BEGIN(12) { PolResid S; S.G = F.G; S.c = F.bx; S.K = DIN; S.lda = DIN; S.ldb = DIN; S.A = B_YN; S.W = (const bf16_t*)(B_W + W_OUT); S.src = mksrc(F); S.layer = lod; S.which = 2; S.npan = lp == 1 ? ML / 256 : NPAN; S.nsl = 0; S.PART = nullptr;
                      ge::gemm_phase(F.lds, S, F.tid);
                      Frame F2 = F; if (idle_subgrid(F2, S.npan * 4)) convert_moe(F2, lp, 0, MOE_UP_EARLY, true); } PHASE_END
        PHASE_BEGIN(13) phase_route(F, lod, lp, B_V, lp == 1 ? ML : MT); convert_moe(F, lp, MOE_UP_EARLY, NEXP, false); PHASE_END
        PHASE_BEGIN(14) phase_slots(F, lp, lp == 1 ? ML : MT); PHASE_END
        PHASE_BEGIN(15) { int ts[NEXP + 1]; unsigned cnt[NEXP]; tile_starts(F, lp, ts, cnt);
                      PolUp<true> S; S.G = F.G; S.c = F.bx; S.K = D; S.lda = D; S.ldb = D; S.A = B_V; S.W = (const bf16_t*)(B_W + W_MUP); S.HID = B_HIDM; S.ldh = DFFE; S.nq = DFFE / 128; S.nM = ts[NEXP];
                      S.s2t = (const int*)(F.ws + OFF_S2T);
#pragma unroll
                      for (int e = 0; e <= NEXP; ++e) S.tstart[e] = ts[e];
                      ge::gemm_phase(F.lds, S, F.tid); } PHASE_END
        PHASE_BEGIN(16) { int ts[NEXP + 1]; unsigned cnt[NEXP]; tile_starts(F, lp, ts, cnt);
                      PolMoeDown S; S.G = F.G; S.c = F.bx; S.K = DFFE; S.lda = DFFE; S.ldb = DFFE; S.A = B_HIDM; S.W = (const bf16_t*)(B_W + W_MDN); S.YS = B_YS; S.nM = ts[NEXP];
#pragma unroll
                      for (int e = 0; e <= NEXP; ++e) S.tstart[e] = ts[e];
                      ge::gemm_phase(F.lds, S, F.tid);
                      if (lp == 0) { Frame F2 = F; if (idle_subgrid(F2, S.nM * 4)) convert_even(F2, 1); } } PHASE_END
        PHASE_BEGIN(17) phase_combine(F, lod, B_YS, lp == 1); PHASE_END
    }
#undef PHASE_BEGIN
#undef PHASE_END
    if (PROBE_TS_MASK != 0u && blockIdx.x == 0) { const unsigned long long t1 = NOWT(), wt = tsacc * (unsigned long long)PROBE_TS_MULT; while (NOWT() - t1 < wt) { } }
}

extern "C" void kernel_launch(void* const* d_in, const int* in_sizes, int n_in, void* d_out, int out_size, void* d_ws, size_t ws_size, hipStream_t stream) {
    static int grid = 0;
    if (grid == 0) {
        if (n_in != 26 || ws_size < WS_NEED) { fprintf(stderr, "kernel_launch: need 26 inputs and %zu bytes of workspace (got %d, %zu)\n", (size_t)WS_NEED, n_in, ws_size); grid = -1; return; }
        int dev = 0, cus = 0, per_cu = 0;
        if (hipGetDevice(&dev) != hipSuccess || hipDeviceGetAttribute(&cus, hipDeviceAttributeMultiprocessorCount, dev) != hipSuccess) { grid = -1; return; }
        if (hipFuncSetAttribute((const void*)fwd_kernel, hipFuncAttributeMaxDynamicSharedMemorySize, LDS_BYTES) != hipSuccess) { grid = -1; return; }
        if (hipOccupancyMaxActiveBlocksPerMultiprocessor(&per_cu, (const void*)fwd_kernel, 512, LDS_BYTES) != hipSuccess || per_cu < 1) { fprintf(stderr, "kernel_launch: occupancy query says %d\n", per_cu); }
        (void)hipGetLastError();
        grid = cus;
    }
    if (grid < 0) return;
    (void)in_sizes; (void)out_size;
    if (hipMemsetAsync((char*)d_ws + OFF_CTL, 0, CTL_BYTES, stream) != hipSuccess) return;
    Params p{};
    for (int i = 0; i < 26; ++i) p.in[i] = (const float*)d_in[i];
    p.out = (float*)d_out; p.ws = (unsigned char*)d_ws;
    if (N_LAUNCH_MODE == 1) { p.ph_lo = 0; p.ph_hi = N_PHASES; hipLaunchKernelGGL(fwd_kernel, dim3(grid), dim3(512), LDS_BYTES, stream, p); }
    else for (int ph = 0; ph < N_PHASES; ++ph) { p.ph_lo = ph; p.ph_hi = ph + 1; hipLaunchKernelGGL(fwd_kernel, dim3(grid), dim3(512), LDS_BYTES, stream, p); }
}
```

```cpp
#ifndef EMU
#include <hip/hip_runtime.h>
#endif
#include <cstdio>
#include <cstdint>

#ifndef CFG_SEQ
#define CFG_SEQ 16384
#endif
#ifndef CFG_DFF
#define CFG_DFF 2816
#endif
#ifndef CFG_DFFE
#define CFG_DFFE 3584
#endif
#ifndef MOE_DOWN_FP8
#define MOE_DOWN_FP8 1
#endif
#ifndef FFN_DOWN_FP8
#define FFN_DOWN_FP8 1
#endif
#ifndef N_LAUNCH_MODE
#define N_LAUNCH_MODE 1
#endif

#ifdef EMU
#define LAS
#define DEV inline
#define WAITV(n) ((void)0)
#define WAITL(n) ((void)0)
#define SBAR() emu_wg_sync()
#define SCHED() ((void)0)
#define SETPRIO(x) ((void)0)
#define MFMA16(a, b, c) emu_mfma16(a, b, c)
#define GLDS16(g, l) emu_glds16((const void*)(g), (void*)(l))
#define GLDS4(g, l) emu_glds4((const void*)(g), (void*)(l))
#define MFMA8(a, b, c) emu_mfma8(a, b, c)
#define RFL(x) emu_rfl(x)
#define MEMFENCE() ((void)0)
#define WSYNC() emu_wave_sync()
#define LDSBAR() emu_wg_sync()
#define LAUNDER_V(x) ((void)0)
#define SLEEP1() emu_yield()
#define MY_XCC_ID() ((unsigned)(blockIdx.x & 7u))
#define FENCE_REL() __atomic_thread_fence(__ATOMIC_SEQ_CST)
#define FENCE_ACQ() __atomic_thread_fence(__ATOMIC_SEQ_CST)
#define FEXP(x) expf(x)
#define RLX_AGENT __ATOMIC_RELAXED, 4
#else
#define LAS __attribute__((address_space(3)))
#define DEV __device__ __forceinline__
#define WAITV(n) asm volatile("s_waitcnt vmcnt(" #n ")" ::: "memory")
#define WAITL(n) asm volatile("s_waitcnt lgkmcnt(" #n ")" ::: "memory")
#define SBAR() __builtin_amdgcn_s_barrier()
#define SCHED() __builtin_amdgcn_sched_barrier(0)
#define SETPRIO(x) __builtin_amdgcn_s_setprio(x)
#define MFMA16(a, b, c) __builtin_amdgcn_mfma_f32_16x16x32_bf16(a, b, c, 0, 0, 0)
#define GLDS16(g, l) __builtin_amdgcn_global_load_lds((const unsigned*)(g), (LAS unsigned*)(l), 16, 0, 0)
#define GLDS4(g, l) __builtin_amdgcn_global_load_lds((const unsigned*)(g), (LAS unsigned*)(l), 4, 0, 0)
#define MFMA8(a, b, c) __builtin_amdgcn_mfma_scale_f32_16x16x128_f8f6f4(a, b, c, 0, 0, 0, 0x7f7f7f7f, 0, 0x7f7f7f7f)
#define RFL(x) __builtin_amdgcn_readfirstlane(x)
#define MEMFENCE() asm volatile("" ::: "memory")
#define LDSBAR() do { asm volatile("s_waitcnt lgkmcnt(0)" ::: "memory"); __builtin_amdgcn_s_barrier(); asm volatile("" ::: "memory"); } while (0)
#define WSYNC() asm volatile("s_waitcnt lgkmcnt(0)" ::: "memory")
#define SLEEP1() __builtin_amdgcn_s_sleep(1)
#define MY_XCC_ID() ((unsigned)__builtin_amdgcn_s_getreg((3 << 11) | 20) & 0xFu)
#define FENCE_REL() __builtin_amdgcn_fence(__ATOMIC_RELEASE, "agent")
#define FENCE_ACQ() __builtin_amdgcn_fence(__ATOMIC_ACQUIRE, "agent")
#define FEXP(x) __expf(x)
#define RLX_AGENT __ATOMIC_RELAXED, __HIP_MEMORY_SCOPE_AGENT
#define LAUNDER_V(x) asm volatile("" : "+v"(x))
#endif

typedef unsigned short bf16_t;
typedef short bf16x8 __attribute__((ext_vector_type(8)));
typedef float f32x4 __attribute__((ext_vector_type(4)));
typedef float f32x2 __attribute__((ext_vector_type(2)));
typedef unsigned u32x4 __attribute__((ext_vector_type(4)));
typedef unsigned u32x2 __attribute__((ext_vector_type(2)));
typedef int i32x8 __attribute__((ext_vector_type(8)));
typedef int i32x4 __attribute__((ext_vector_type(4)));
typedef unsigned char fp8_t;

constexpr int D = 1024, NB = 2, SEQ = CFG_SEQ, CTXL = 256, DEPTH = 4;
constexpr int ML = NB * SEQ, MC = NB * CTXL, MT = ML + MC, NPAN = MT / 256;
constexpr int DFF = CFG_DFF, DFFE = CFG_DFFE, NEXP = 8;
constexpr int DIN = 2048, NH = 32, HD = 64, NG = 4, DS = 128, CONVD = 3072, NPROJ = 5184, NPROJP = 5376, BCD = 512;
constexpr int TV = CTXL + SEQ, NCH = TV / 128;
constexpr int GRIDW = 64;
constexpr float EPS = 1e-6f;
constexpr int NSLOT_TILES = (2 * MT) / 256 + NEXP, NSLOT = NSLOT_TILES * 256;
static_assert(SEQ % 128 == 0 && ML % 256 == 0 && DFF % 128 == 0 && DFFE % 128 == 0 && DFF >= 256 && DFFE >= 256, "shape constraints");

constexpr size_t MiB = 1u << 20;
constexpr size_t al(size_t x) { return (x + 4095) & ~(size_t)4095; }
constexpr size_t OFF_CTL = 0, CTL_BYTES = 1 * MiB;
constexpr size_t OFF_MOD = 1 * MiB;
constexpr size_t OFF_TOK = 2 * MiB;
constexpr size_t OFF_S2T = 3 * MiB;
constexpr size_t OFF_H = 4 * MiB, SZ_H = (size_t)MT * D * 4;
constexpr size_t OFF_W = OFF_H + al(SZ_H);
constexpr size_t W_POOL = 0, SZ_WPOOL = (size_t)4 * 256 * 256 * 2;
constexpr size_t W_UP = al(SZ_WPOOL), SZ_WUP = (size_t)2 * DFF * D * 2;
constexpr size_t W_DN = W_UP + al(SZ_WUP), SZ_WDN = (size_t)D * DFF * 2;
constexpr size_t SZ_WEVEN = W_DN + al(SZ_WDN);
constexpr size_t W_IN = SZ_WEVEN, SZ_WIN = (size_t)NPROJP * D * 2;
constexpr size_t W_OUT = W_IN + al(SZ_WIN), SZ_WOUT = (size_t)D * DIN * 2;
constexpr size_t W_DT = W_OUT + al(SZ_WOUT), SZ_DT = (size_t)NB * 2 * NH * TV * 4;
constexpr size_t W_MUP = W_DT + al(SZ_DT), SZ_WMUP = (size_t)NEXP * 2 * DFFE * D;
constexpr size_t W_MDN = W_MUP + al(SZ_WMUP), SZ_WMDN = (size_t)NEXP * D * DFFE * (MOE_DOWN_FP8 ? 1 : 2);
constexpr size_t W_YB = W_MUP, SZ_Y = (size_t)MT * DIN * 2;
constexpr size_t SZ_WODD_A = W_MDN + al(SZ_WMDN), SZ_WODD_B = W_YB + al(SZ_Y);
constexpr size_t mx(size_t a, size_t b) { return a > b ? a : b; }
constexpr size_t SZ_W = mx(SZ_WEVEN, mx(SZ_WODD_A, SZ_WODD_B));
constexpr size_t OFF_ACT = OFF_W + SZ_W;
constexpr size_t A_P = 0, SZ_ACT1 = (size_t)MT * D * 2;
constexpr size_t A_HID = al(SZ_ACT1), SZ_HID = (size_t)MT * DFF * 2;
constexpr size_t SZ_AEVEN = A_HID + al(SZ_HID);
constexpr size_t A_Z = 0;
constexpr size_t A_XBC = al(SZ_Y), SZ_XBC = (size_t)MT * CONVD * 2;
constexpr size_t A_YF = A_XBC;
constexpr size_t A_CB = A_XBC + al(SZ_Y), SZ_CB = (size_t)NB * NG * NCH * 128 * 128 * 2;
static_assert(al(SZ_Y) + SZ_CB <= SZ_XBC, "CB fits behind Yf inside the XBC region");
constexpr size_t A_XT = A_XBC + al(SZ_XBC), SZ_XT = (size_t)NB * DIN * TV * 2;
constexpr size_t A_U = A_XT, A_YN = A_XT;
constexpr size_t A_BROW = A_XT + al(SZ_XT), SZ_BC = (size_t)MT * BCD * 2;
constexpr size_t A_BT = A_BROW + al(SZ_BC);
constexpr size_t A_CROW = A_BT + al(SZ_BC);
constexpr size_t A_CUM = A_CROW + al(SZ_BC);
constexpr size_t A_WJ = A_CUM + al(SZ_DT);
constexpr size_t A_CF = A_WJ + al(SZ_DT);
constexpr size_t SZ_ASSD = A_CF + al(SZ_DT);
constexpr size_t A_V = 0;
constexpr size_t A_HIDM = al(SZ_ACT1), SZ_HIDM = (size_t)NSLOT * DFFE * 2;
constexpr size_t A_YS = A_HIDM + al(SZ_HIDM), SZ_YS = (size_t)NSLOT * D * 2;
constexpr size_t SZ_AMOE = A_YS + al(SZ_YS);
constexpr size_t SZ_ACT = mx(SZ_AEVEN, mx(SZ_ASSD, SZ_AMOE));
constexpr size_t WS_NEED = OFF_ACT + SZ_ACT;

constexpr int CW_BAR = 4096;
constexpr int CW_CNT = 16384;
constexpr int CW_CUR = 16384 + 2 * 8 * 64;

DEV unsigned f2bf(float f) { unsigned u = __builtin_bit_cast(unsigned, f); return (u + 0x7fffu + ((u >> 16) & 1u)) >> 16; }
#ifndef EMU
typedef __bf16 bf16x2n __attribute__((ext_vector_type(2)));
#endif
DEV unsigned pk2(float lo, float hi) {
#ifdef EMU
    return f2bf(lo) | (f2bf(hi) << 16);
#else
    f32x2 v = {lo, hi}; bf16x2n b = __builtin_convertvector(v, bf16x2n); return __builtin_bit_cast(unsigned, b);
#endif
}
DEV unsigned pk4_fp8(float a, float b, float c, float d) {
#ifdef EMU
    return emu_f2fp8(a) | (emu_f2fp8(b) << 8) | (emu_f2fp8(c) << 16) | (emu_f2fp8(d) << 24);
#else
    unsigned w = 0; w = __builtin_amdgcn_cvt_pk_fp8_f32(a, b, w, false); w = __builtin_amdgcn_cvt_pk_fp8_f32(c, d, w, true); return w;
#endif
}
DEV float bf2f(unsigned b) { return __builtin_bit_cast(float, b << 16); }
DEV float bflo(unsigned w) { return __builtin_bit_cast(float, w << 16); }
DEV float bfhi(unsigned w) { return __builtin_bit_cast(float, w & 0xffff0000u); }
#ifdef EMU
DEV float frcp(float x) { return 1.0f / x; }
#else
DEV float frcp(float x) { return __builtin_amdgcn_rcpf(x); }
#endif
#ifdef EMU
DEV float fexp2(float x) { return exp2f(x); }
#else
DEV float fexp2(float x) { return __builtin_amdgcn_exp2f(x); }
#endif
DEV float siluf(float x) { return x * frcp(1.0f + FEXP(-x)); }
#ifdef EMU
DEV float flog2(float x) { return log2f(x); }
#else
DEV float flog2(float x) { return __builtin_amdgcn_logf(x); }
#endif
DEV float softplusf(float x) { if (x > 20.f) return x; const float e = FEXP(x); return e < 0.0625f ? e * (1.0f - e * (0.5f - e * (0.33333334f - e * (0.25f - e * 0.2f)))) : flog2(1.0f + e) * 0.6931471806f; }
DEV float wave_sum(float v) {
#pragma unroll
    for (int o = 1; o < 64; o <<= 1) v += __shfl_xor(v, o);
    return v;
}
DEV int vec_of(int r) { return r < ML ? (r / SEQ) : 2; }
DEV int frag_off(int r, int c) { return ((r >> 4) * 4 + (c >> 5)) * 512 + ((c >> 3) & 3) * 128 + (r & 15) * 8 + (c & 7); }
DEV int row_of(int b, int tv) { return tv < CTXL ? ML + b * CTXL + tv : b * SEQ + (tv - CTXL); }

#define XB_TMO      128
#define XB_XCNT(j)  (256  + 64 * (j))
#define XB_XSUB(j)  (1280 + 64 * (j))
#define XB_XGEN(j)  (2304 + 64 * (j))
#define XB_TOP      3328
#define XB_TOPGEN   3392
#define XCD_BAR_WORDS 3456
#define XB_SPIN_CAP (1u << 22)
DEV unsigned xb_ld(unsigned* p)              { return __hip_atomic_load(p, RLX_AGENT); }
DEV unsigned xb_add(unsigned* p, unsigned v) { return __hip_atomic_fetch_add(p, v, RLX_AGENT); }
#define XB_SPIN(cond, bar) do { unsigned _sp = 0; while (cond) { SLEEP1(); \
    if ((++_sp & 255u) == 0u) { if (xb_ld(&(bar)[XB_TMO])) break; if (_sp > XB_SPIN_CAP) { atomicAdd(&(bar)[XB_TMO], 1u); break; } } } } while (0)
struct XcdBarrier { unsigned* bar; unsigned x; volatile LAS unsigned* st; };
DEV XcdBarrier xcd_barrier_post(unsigned* bar, volatile LAS unsigned* st) {
    XcdBarrier b; b.bar = bar; b.x = MY_XCC_ID(); b.st = st;
    if (threadIdx.x == 0) (void)xb_add(&bar[XB_XCNT(b.x)], 1u);
    return b;
}
DEV void xcd_barrier_complete(unsigned* bar, unsigned x, unsigned& nloc, unsigned& nx) {
    const unsigned G = gridDim.x;
    unsigned sum, cnt, mine, sp = 0u;
    for (;;) {
        sum = 0u; cnt = 0u; mine = 0u;
#pragma unroll
        for (unsigned j = 0; j < 16; ++j) { const unsigned c = xb_ld(&bar[XB_XCNT(j)]); sum += c; cnt += (c > 0u) ? 1u : 0u; mine = (j == x) ? c : mine; }
        if (sum == G) break;
        SLEEP1();
        if ((++sp & 255u) == 0u) { if (xb_ld(&bar[XB_TMO])) break; if (sp > XB_SPIN_CAP) { atomicAdd(&bar[XB_TMO], 1u); break; } }
    }
    nloc = mine > 0u ? mine : 1u; nx = cnt > 0u ? cnt : 1u;
}
DEV void xcd_barrier(const XcdBarrier& b) {
    WAITV(0);
    __syncthreads();
    if (threadIdx.x == 0) {
        unsigned* bar = b.bar;
#ifndef EMU
        __builtin_amdgcn_s_waitcnt(0);
#endif
        unsigned nloc = b.st[0], nx = b.st[1];
        if (nloc == 0u) { xcd_barrier_complete(bar, b.x, nloc, nx); b.st[0] = nloc; b.st[1] = nx; }
        const unsigned old = xb_add(&bar[XB_XSUB(b.x)], 1u);
        const unsigned gen = old / nloc;
        if (old + 1u == (gen + 1u) * nloc) {
            FENCE_REL();
            WAITV(0);
            const unsigned og = xb_add(&bar[XB_TOP], 1u);
            const unsigned tg = og / nx;
            if (og + 1u == (tg + 1u) * nx) xb_add(&bar[XB_TOPGEN], 1u);
            else XB_SPIN(xb_ld(&bar[XB_TOPGEN]) == tg, bar);
            FENCE_ACQ();
            xb_add(&bar[XB_XGEN(b.x)], 1u);
            WAITV(0);
        } else {
            XB_SPIN(xb_ld(&bar[XB_XGEN(b.x)]) == gen, bar);
            FENCE_ACQ();
            WAITV(0);
        }
    }
    __syncthreads();
}

namespace ge {
constexpr int BM = 256, BK = 64, HALF = 128, HTB = HALF * BK * 2, STAGE_BYTES = 8 * HTB, NXCD = 8, WGM = 8;
DEV int lds_byte(int r, int c) { const int st = (r >> 4) * 2 + (c >> 5), rr = r & 15, cc = c & 31, ob = rr * 64 + cc * 2; return st * 1024 + (ob ^ (((ob >> 9) & 1) << 5)); }
DEV void stage_rc(int b, int& R, int& C) { const int st = b / 1024, sb = b % 1024, swz = sb ^ (((sb >> 9) & 1) << 5); R = (st >> 1) * 16 + swz / 64; C = (st & 1) * 32 + (swz % 64) / 2; }
DEV int perm32(int rho) { const int n = rho >> 4, i = rho & 15; return 8 * (i >> 2) + 4 * n + (i & 3); }
struct Unit { int pm, pn; };
DEV bool static_next(int nM, int nN, int G, int c, int i, Unit& u) {
    const int nwg = nM * nN; const long L = (long)i * G + c; if (L >= nwg) return false;
    int wgid = (int)L; { const int q = nwg / NXCD, r = nwg % NXCD, xcd = wgid % NXCD, off = wgid / NXCD; wgid = (xcd < r ? xcd * (q + 1) : r * (q + 1) + (xcd - r) * q) + off; }
    const int nig = WGM * nN, gid = wgid / nig, fm = gid * WGM, gsz = (nM - fm) < WGM ? (nM - fm) : WGM;
    u.pm = fm + ((wgid % nig) % gsz); u.pn = (wgid % nig) / gsz; return true;
}
template <class P, bool SP2 = true>
DEV void gemm_phase(LAS unsigned char* lds, const P& S, const int tid) {
    const int wid = RFL(tid >> 6), lane = tid & 63, wr = wid >> 2, wc = wid & 3, fr = lane & 15, fq = lane >> 4;
    const int K = S.K; int nt = K * P::ES / (BK * 2);
    unsigned voffB[2]; int RA[2], CA2[2];
#pragma unroll
    for (int i = 0; i < 2; ++i) { int R, C; stage_rc(tid * 16 + i * 8192, R, C); const int Rb = P::PERM ? ((R & ~31) + perm32(R & 31)) : R;
        RA[i] = R; CA2[i] = C * 2; voffB[i] = (unsigned)(Rb * S.ldb) * (unsigned)P::ES + (unsigned)(C * 2); }
    const size_t kstep = (size_t)(BK * 2);
    const size_t hstepB = (size_t)HALF * S.ldb * P::ES;
    const unsigned ldsw = (unsigned)wid * 1024u;
    const int aoff = lds_byte(wr * 64 + fr, fq * 8), boff = lds_byte(wc * 32 + fr, fq * 8);
#define GE_SA(b, h) (((b) * 2 + (h)) * HTB)
#define GE_SB(b, h) ((4 + (b) * 2 + (h)) * HTB)
#define GE_STAGEB(bufoff, gbase) do { _Pragma("unroll") for (int _i = 0; _i < 2; ++_i) { unsigned _o = voffB[_i]; LAUNDER_V(_o); \
        GLDS16((const char*)(gbase) + _o, lds + (bufoff) + ldsw + _i * 8192); } } while (0)
#define GE_STAGEA(bufoff, gbase, h) do { _Pragma("unroll") for (int _i = 0; _i < 2; ++_i) { unsigned _o = oA[h][_i]; LAUNDER_V(_o); \
        GLDS16((const char*)(gbase) + _o, lds + (bufoff) + ldsw + _i * 8192); } } while (0)
#define GE_LD1(p_) __builtin_shufflevector(*(const LAS i32x4*)(p_), *(const LAS i32x4*)((p_) + 1024), 0, 1, 2, 3, 4, 5, 6, 7)
#define GE_LDA(dst, b, h) do { _Pragma("unroll") for (int m = 0; m < 4; ++m) dst[m] = GE_LD1(lds + GE_SA(b, h) + aoff + m * 2048); } while (0)
#define GE_LDB(dst, b, h) do { _Pragma("unroll") for (int n = 0; n < 2; ++n) dst[n] = GE_LD1(lds + GE_SB(b, h) + boff + n * 2048); } while (0)
#define GE_LO(x) __builtin_bit_cast(bf16x8, __builtin_shufflevector(x, x, 0, 1, 2, 3))
#define GE_HI(x) __builtin_bit_cast(bf16x8, __builtin_shufflevector(x, x, 4, 5, 6, 7))
#define GE_MMA(ai, bj, At, Bt) do { SETPRIO(1); _Pragma("unroll") for (int m = 0; m < 4; ++m) _Pragma("unroll") for (int n = 0; n < 2; ++n) { \
        if constexpr (P::FP8) acc[ai][bj][m][n] = MFMA8(Bt[n], At[m], acc[ai][bj][m][n]);     \
        else { acc[ai][bj][m][n] = MFMA16(GE_LO(Bt[n]), GE_LO(At[m]), acc[ai][bj][m][n]); acc[ai][bj][m][n] = MFMA16(GE_HI(Bt[n]), GE_HI(At[m]), acc[ai][bj][m][n]); } } SETPRIO(0); } while (0)
    Unit cur, nxt; int ui = 0;
    if (!S.next(0, cur)) return;
    f32x4 acc[2][2][4][2];
#pragma unroll
    for (int a = 0; a < 2; ++a)
#pragma unroll
        for (int b = 0; b < 2; ++b)
#pragma unroll
            for (int m = 0; m < 4; ++m)
#pragma unroll
                for (int n = 0; n < 2; ++n) acc[a][b][m][n] = (f32x4){0.f, 0.f, 0.f, 0.f};
    unsigned oA[2][2];
#pragma unroll
    for (int h = 0; h < 2; ++h)
#pragma unroll
        for (int i = 0; i < 2; ++i) {
            if constexpr (P::GATHER) oA[h][i] = (unsigned)S.gather_row(cur, h * HALF + RA[i]) * (unsigned)(S.lda * P::ES) + (unsigned)CA2[i];
            else oA[h][i] = (unsigned)((h * HALF + RA[i]) * S.lda) * (unsigned)P::ES + (unsigned)CA2[i];
            }
    const char* cA = S.a_base(cur); const char* cB = S.b_base(cur);
    if constexpr (SP2) {
        GE_STAGEB(GE_SB(0, 0), cB); GE_STAGEB(GE_SB(0, 1), cB + hstepB); GE_STAGEA(GE_SA(0, 0), cA, 0); GE_STAGEA(GE_SA(0, 1), cA, 1);
        if (wr == 1) SBAR();
        WAITV(2); SBAR();
        GE_STAGEB(GE_SB(1, 0), cB + kstep); GE_STAGEA(GE_SA(1, 0), cA + kstep, 0); GE_STAGEB(GE_SB(1, 1), cB + hstepB + kstep);
        WAITV(6); SBAR();
    } else {
    GE_STAGEB(GE_SB(0, 0), cB); GE_STAGEA(GE_SA(0, 0), cA, 0); GE_STAGEB(GE_SB(0, 1), cB + hstepB); GE_STAGEA(GE_SA(0, 1), cA, 1);
    if (wr == 1) SBAR();
    WAITV(4); SBAR();
    GE_STAGEB(GE_SB(1, 0), cB + kstep); GE_STAGEA(GE_SA(1, 0), cA + kstep, 0); GE_STAGEB(GE_SB(1, 1), cB + hstepB + kstep);
    WAITV(6); SBAR();
    }
    for (;;) {
        if constexpr (P::VARK) nt = S.unit_nt(cur);
        const bool has_next = S.next(ui + 1, nxt);
        const char* nA = has_next ? S.a_base(nxt) : cA; const char* nB = has_next ? S.b_base(nxt) : cB;
        for (int t = 0; t < nt; t += 2) {
            const bool last = (t == nt - 2);
            const char* a1 = cA + (size_t)(t + 1) * kstep;
            const char* a2 = last ? nA : cA + (size_t)(t + 2) * kstep; const char* b2 = last ? nB : cB + (size_t)(t + 2) * kstep;
            const char* a3 = a2 + kstep; const char* b3 = b2 + kstep;
            i32x8 At[4], B0[2], B1[2];
            if constexpr (SP2) {
            GE_LDB(B0, 0, 0); GE_LDB(B1, 0, 1); SCHED(); GE_LDA(At, 0, 0); GE_STAGEA(GE_SA(1, 1), a1, 1);
            WAITV(8); WAITL(0); SBAR(); GE_MMA(0, 0, At, B0); GE_MMA(0, 1, At, B1); SBAR(); SCHED();
            if constexpr (P::GATHER) { if (last && has_next) {
#pragma unroll
                for (int i = 0; i < 2; ++i) { int R2, C2; stage_rc(tid * 16 + i * 8192, R2, C2);
#pragma unroll
                    for (int h = 0; h < 2; ++h) oA[h][i] = (unsigned)S.gather_row(nxt, h * HALF + R2) * (unsigned)(S.lda * P::ES) + (unsigned)(C2 * 2); } } }
            GE_LDA(At, 0, 1); GE_STAGEB(GE_SB(0, 0), b2); GE_STAGEB(GE_SB(0, 1), b2 + hstepB); GE_STAGEA(GE_SA(0, 0), a2, 0);
            WAITV(8); WAITL(0); SBAR(); GE_MMA(1, 0, At, B0); GE_MMA(1, 1, At, B1); SBAR(); SCHED();
            GE_LDB(B0, 1, 0); GE_LDB(B1, 1, 1); SCHED(); GE_LDA(At, 1, 0); GE_STAGEA(GE_SA(0, 1), a2, 1);
            WAITV(8); WAITL(0); SBAR(); GE_MMA(0, 0, At, B0); GE_MMA(0, 1, At, B1); SBAR(); SCHED();
            GE_LDA(At, 1, 1); GE_STAGEB(GE_SB(1, 0), b3); GE_STAGEB(GE_SB(1, 1), b3 + hstepB); GE_STAGEA(GE_SA(1, 0), a3, 0);
            WAITV(8); WAITL(0); SBAR(); GE_MMA(1, 0, At, B0); GE_MMA(1, 1, At, B1); SBAR(); SCHED();
            } else {
            GE_LDB(B0, 0, 0); SCHED(); GE_LDA(At, 0, 0); GE_STAGEA(GE_SA(1, 1), a1, 1);
            WAITL(8); SBAR(); WAITL(0); GE_MMA(0, 0, At, B0); SBAR(); SCHED();
            if constexpr (P::GATHER) { if (last && has_next) {
#pragma unroll
                for (int i = 0; i < 2; ++i) { int R2, C2; stage_rc(tid * 16 + i * 8192, R2, C2);
#pragma unroll
                    for (int h = 0; h < 2; ++h) oA[h][i] = (unsigned)S.gather_row(nxt, h * HALF + R2) * (unsigned)(S.lda * P::ES) + (unsigned)(C2 * 2); } } }
            GE_LDB(B1, 0, 1); GE_STAGEB(GE_SB(0, 0), b2);
            SBAR(); WAITL(0); GE_MMA(0, 1, At, B1); SBAR();
            GE_LDA(At, 0, 1); GE_STAGEA(GE_SA(0, 0), a2, 0);
            SBAR(); WAITL(0); GE_MMA(1, 0, At, B0); SBAR(); SCHED();
            GE_STAGEB(GE_SB(0, 1), b2 + hstepB);
            WAITV(6); SBAR(); GE_MMA(1, 1, At, B1); SBAR();
            GE_LDB(B0, 1, 0); SCHED(); GE_LDA(At, 1, 0); GE_STAGEA(GE_SA(0, 1), a2, 1);
            WAITL(8); SBAR(); WAITL(0); GE_MMA(0, 0, At, B0); SBAR(); SCHED();
            GE_LDB(B1, 1, 1); GE_STAGEB(GE_SB(1, 0), b3);
            SBAR(); WAITL(0); GE_MMA(0, 1, At, B1); SBAR();
            GE_LDA(At, 1, 1); GE_STAGEA(GE_SA(1, 0), a3, 0);
            SBAR(); WAITL(0); GE_MMA(1, 0, At, B0); SBAR(); SCHED();
            GE_STAGEB(GE_SB(1, 1), b3 + hstepB);
            WAITV(6); SBAR(); GE_MMA(1, 1, At, B1); SBAR();
            }
        }
        if (wr == 0) SBAR();
        S.epi(acc, cur, wr, wc, fr, fq);
        if (!has_next) break;
#pragma unroll
        for (int a = 0; a < 2; ++a)
#pragma unroll
            for (int b = 0; b < 2; ++b)
#pragma unroll
                for (int m = 0; m < 4; ++m)
#pragma unroll
                    for (int n = 0; n < 2; ++n) acc[a][b][m][n] = (f32x4){0.f, 0.f, 0.f, 0.f};
        cur = nxt; cA = nA; cB = nB; ++ui;
        if (wr == 1) SBAR();
    }
    WAITV(0);
    SBAR();
#undef GE_SA
#undef GE_SB
#undef GE_STAGEA
#undef GE_STAGEB
#undef GE_LDA
#undef GE_LDB
#undef GE_MMA
#undef GE_LO
#undef GE_HI
#undef GE_LD1
}
}
using ge::Unit;

struct Params {
    const float* in[26];
    float* out; unsigned char* ws;
    int ph_lo, ph_hi;
};
enum { I_X = 0, I_C, I_CTX, I_CCTX, I_ADAW, I_ADAB, I_NMIX, I_NFFN, I_POOLW, I_POOLS, I_INW, I_CONVW, I_CONVB, I_ALOG, I_DTB, I_DSKIP, I_SNORM, I_OUTW,
       I_W1, I_W3, I_W2, I_RW, I_MW1, I_MW3, I_MW2, I_FNORM };

struct Frame {
    LAS unsigned char* lds;
    int tid, lane, wave, G, bx;
    const Params* p;
    unsigned char* ws;
    unsigned* ctl;
    float* H; float* mod;
};
#ifdef EMU
DEV const float* INP(const Frame& F, int i) { return F.p->in[i]; }
DEV float* OUTP(const Frame& F) { return F.p->out; }
DEV unsigned char* WSP(const Frame& F) { return F.p->ws; }
#define LAUNDER_S(x) ((void)0)
#else
typedef const float* cfptr_t;
DEV const float* INP(const Frame&, int i) { int k = i; asm volatile("" : "+s"(k)); return ((const __attribute__((address_space(4))) cfptr_t*)__builtin_amdgcn_kernarg_segment_ptr())[k]; }
DEV float* OUTP(const Frame& F) { return (float*)INP(F, 26); }
DEV unsigned char* WSP(const Frame& F) { return (unsigned char*)INP(F, 27); }
#define LAUNDER_S(x) asm volatile("" : "+s"(x))
#endif
constexpr int LDS_MISC = ge::STAGE_BYTES;
constexpr int LDS_BYTES = ge::STAGE_BYTES + 16384;

struct Src { const float* x; const float* ctx; float* H; const float* mod; };
DEV const float* modq(const float* mod, int layer, int vec, int which) { return mod + ((size_t)(layer * 3 + vec) * 6 + which) * D; }
DEV const float* modp(const Frame& F, int layer, int vec, int which) { return modq(F.mod, layer, vec, which); }
DEV const float* hsrc_row(const Src& s, bool from_input, int r) {
    if (from_input) return r < ML ? s.x + (size_t)r * D : s.ctx + (size_t)(r - ML) * D;
    return s.H + (size_t)r * D;
}
DEV Src mksrc(const Frame& F) { Src s; s.x = INP(F, I_X); s.ctx = INP(F, I_CTX); s.H = F.H; s.mod = F.mod; return s; }
DEV const float* hin_row(const Frame& F, int layer, int r) { return hsrc_row(mksrc(F), layer == 0, r); }

struct RmId { DEV int operator()(int n0) const { return n0; } };
struct RmIlv { int s; DEV int operator()(int n0) const { return (n0 >> 7) * 256 + s * 128 + (n0 & 127); } };
template <int K, int N, bool F8, class RM>
DEV void convert_job_t(const Frame& F, const float* Wsrc, void* WTv, int ldt, RM rowmap, float scale) {
    LAS float* scr = (LAS float*)(F.lds + F.wave * 16384);
    constexpr int items = (K / 64) * (N / 32), nblk = N / 32; const int gw = F.bx * 8 + F.wave, NGW = F.G * 8, lane = F.lane;
    float nx[32];
#define CJ_LOAD(it_) do { const int _kb = (it_) / nblk, _nb = (it_) % nblk; const float* _p = Wsrc + (size_t)(64 * _kb + (lane >> 5)) * N + 32 * _nb + (lane & 31); \
        _Pragma("unroll") for (int i = 0; i < 32; ++i) nx[i] = _p[(size_t)(2 * i) * N]; } while (0)
    if (gw < items) CJ_LOAD(gw);
    for (int it = gw; it < items; it += NGW) {
        const int kb = it / nblk, nb = it % nblk, k0 = 64 * kb, n0 = 32 * nb;
#pragma unroll
        for (int i = 0; i < 32; ++i) { const int kk = 2 * i + (lane >> 5); scr[kk * 33 + (lane & 31)] = F8 ? nx[i] * scale : nx[i]; }
        if (it + NGW < items) CJ_LOAD(it + NGW);
        WSYNC();
        const int c = lane & 7; const int row0 = rowmap(n0);
#pragma unroll
        for (int j = 0; j < 4; ++j) { const int n = (lane >> 3) + 8 * j; const LAS float* sp = scr + (8 * c) * 33 + n;
            if (F8) { u32x2 o; o.x = pk4_fp8(sp[0 * 33], sp[1 * 33], sp[2 * 33], sp[3 * 33]); o.y = pk4_fp8(sp[4 * 33], sp[5 * 33], sp[6 * 33], sp[7 * 33]);
                *(u32x2*)((fp8_t*)WTv + (size_t)(row0 + n) * ldt + k0 + 8 * c) = o; }
            else { u32x4 o; o.x = pk2(sp[0 * 33], sp[1 * 33]); o.y = pk2(sp[2 * 33], sp[3 * 33]); o.z = pk2(sp[4 * 33], sp[5 * 33]); o.w = pk2(sp[6 * 33], sp[7 * 33]);
                *(u32x4*)((bf16_t*)WTv + (size_t)(row0 + n) * ldt + k0 + 8 * c) = o; } }
        WSYNC();
    }
#undef CJ_LOAD
}
template <int K, int N, class RM> DEV void convert_job(const Frame& F, const float* Wsrc, bf16_t* WT, int ldt, RM rm) { convert_job_t<K, N, false>(F, Wsrc, WT, ldt, rm, 1.0f); }
template <int K, int N, class RM> DEV void convert_job_fp8(const Frame& F, const float* Wsrc, fp8_t* WT, int ldt, RM rm, float scale) { convert_job_t<K, N, true>(F, Wsrc, WT, ldt, rm, scale); }
DEV bool idle_subgrid(Frame& F2, int nwg) { const int rem = nwg % F2.G; if (rem == 0) return true; if (F2.bx < rem) return false; F2.bx -= rem; F2.G -= rem; return true; }
constexpr int MOE_UP_EARLY = 3;
DEV void convert_even(const Frame& F, int j) {
    bf16_t* Wb = (bf16_t*)(F.ws + OFF_W);
    for (int g = 0; g < 4; ++g) convert_job<256, 256>(F, INP(F, I_POOLW) + ((size_t)j * 4 + g) * 65536, Wb + W_POOL / 2 + (size_t)g * 65536, 256, RmId{});
    convert_job<D, DFF>(F, INP(F, I_W1) + (size_t)j * D * DFF, Wb + W_UP / 2, D, RmIlv{0});
    convert_job<D, DFF>(F, INP(F, I_W3) + (size_t)j * D * DFF, Wb + W_UP / 2, D, RmIlv{1});
    if (FFN_DOWN_FP8) convert_job_fp8<DFF, D>(F, INP(F, I_W2) + (size_t)j * DFF * D, (fp8_t*)(F.ws + OFF_W) + W_DN, DFF, RmId{}, 64.0f);
    else convert_job<DFF, D>(F, INP(F, I_W2) + (size_t)j * DFF * D, Wb + W_DN / 2, DFF, RmId{});
}
DEV void convert_ssd(const Frame& F, int j) {
    bf16_t* Wb = (bf16_t*)(F.ws + OFF_W);
    convert_job<D, NPROJ>(F, INP(F, I_INW) + (size_t)j * D * NPROJ, Wb + W_IN / 2, D, RmId{});
    convert_job<DIN, D>(F, INP(F, I_OUTW) + (size_t)j * DIN * D, Wb + W_OUT / 2, DIN, RmId{});
    { u32x4* z = (u32x4*)(Wb + W_IN / 2 + (size_t)NPROJ * D); const int n16 = (NPROJP - NPROJ) * D * 2 / 16;
      unsigned zz = 0u; LAUNDER_V(zz);
      for (int i = F.bx * 512 + F.tid; i < n16; i += F.G * 512) z[i] = (u32x4){zz, zz, zz, zz}; }
}
DEV void convert_moe(const Frame& F, int j, int up_lo, int up_hi, bool down) {
    fp8_t* Wb = (fp8_t*)(F.ws + OFF_W);
    for (int e = 0; e < NEXP; ++e) {
        if (e >= up_lo && e < up_hi) {
        convert_job_fp8<D, DFFE>(F, INP(F, I_MW1) + ((size_t)j * NEXP + e) * D * DFFE, Wb + W_MUP + (size_t)e * 2 * DFFE * D, D, RmIlv{0}, 32.0f);
        convert_job_fp8<D, DFFE>(F, INP(F, I_MW3) + ((size_t)j * NEXP + e) * D * DFFE, Wb + W_MUP + (size_t)e * 2 * DFFE * D, D, RmIlv{1}, 32.0f); }
        if (!down) continue;
        if (MOE_DOWN_FP8) convert_job_fp8<DFFE, D>(F, INP(F, I_MW2) + ((size_t)j * NEXP + e) * DFFE * D, Wb + W_MDN + (size_t)e * D * DFFE, DFFE, RmId{}, 64.0f);
        else convert_job<DFFE, D>(F, INP(F, I_MW2) + ((size_t)j * NEXP + e) * DFFE * D, (bf16_t*)(Wb + W_MDN) + (size_t)e * D * DFFE, DFFE, RmId{});
    }
}

DEV void phase_mod(const Frame& F) {
    LAS float* red = (LAS float*)F.lds;
    LAS float* sc = (LAS float*)(F.lds + 8192);
    constexpr int nblk = DEPTH * 6144 / 32;
    const int col = F.tid & 31, ks = F.tid >> 5;
    for (int i = F.tid; i < 3 * D; i += 512) { const int v = i >> 10, k = i & (D - 1); sc[i] = siluf(v == 2 ? INP(F, I_CCTX)[k] : INP(F, I_C)[v * D + k]); }
    __syncthreads();
    for (int blk = F.bx; blk < nblk; blk += F.G) {
        const int layer = (blk * 32) / 6144, n = (blk * 32) % 6144 + col;
        const float* W = INP(F, I_ADAW) + (size_t)layer * D * 6144 + n;
        float a0 = 0.f, a1 = 0.f, a2 = 0.f;
#pragma unroll 1
        for (int kb = ks * 64; kb < ks * 64 + 64; kb += 16) {
            float wv[16];
#pragma unroll
            for (int k = 0; k < 16; ++k) wv[k] = W[(size_t)(kb + k) * 6144];
#pragma unroll
            for (int k = 0; k < 16; ++k) { a0 += sc[kb + k] * wv[k]; a1 += sc[D + kb + k] * wv[k]; a2 += sc[2 * D + kb + k] * wv[k]; } }
        red[(ks * 32 + col) * 3 + 0] = a0; red[(ks * 32 + col) * 3 + 1] = a1; red[(ks * 32 + col) * 3 + 2] = a2;
        __syncthreads();
        if (F.tid < 96) { const int c2 = F.tid & 31, v = F.tid >> 5; float s = 0.f;
            for (int q = 0; q < 16; ++q) s += red[(q * 32 + c2) * 3 + v];
            const int n2 = (blk * 32) % 6144 + c2;
            F.mod[(size_t)(layer * 3 + v) * 6144 + n2] = s + INP(F, I_ADAB)[(size_t)layer * 6144 + n2]; }
        __syncthreads();
    }
}

DEV void load_row(const float* p, int lane, f32x4 (&v)[4]) {
#pragma unroll
    for (int j = 0; j < 4; ++j) v[j] = *(const f32x4*)(p + 4 * lane + 256 * j);
}
DEV float sumsq_row(const f32x4 (&v)[4]) { float s = 0.f;
#pragma unroll
    for (int j = 0; j < 4; ++j) s += (v[j][0] * v[j][0] + v[j][1] * v[j][1]) + (v[j][2] * v[j][2] + v[j][3] * v[j][3]);
    return wave_sum(s); }
DEV void normmod_row(f32x4 (&v)[4], float rstd, const float* w, const float* sh, const float* sc, int lane) {
#pragma unroll
    for (int j = 0; j < 4; ++j) { const int c = 4 * lane + 256 * j; const f32x4 wv = *(const f32x4*)(w + c), sv = *(const f32x4*)(sh + c), cv = *(const f32x4*)(sc + c);
        v[j] = v[j] * rstd * wv * (cv + 1.0f) + sv; }
}
DEV void store_row_bf16(bf16_t* o, int lane, const f32x4 (&v)[4]) {
#pragma unroll
    for (int j = 0; j < 4; ++j) { u32x2 w; w.x = pk2(v[j][0], v[j][1]); w.y = pk2(v[j][2], v[j][3]); *(u32x2*)(o + 4 * lane + 256 * j) = w; }
}

struct CtxFix { const float* PART; int S, layer, which; const float* scale; bool from_input; float ascale; };
DEV void phase_norm(const Frame& F, int layer, int which, bf16_t* out, bool from_input, const CtxFix fx) {
    const int gw = F.bx * 8 + F.wave, NGW = F.G * 8;
    const float* w = INP(F, which == 0 ? I_NMIX : I_NFFN) + (size_t)layer * D;
    const int nrows = fx.PART ? ML : MT;
    constexpr int NS = 3;
    f32x4 ns[NS][4];
#pragma unroll
    for (int k = 0; k < NS; ++k) if (gw + k * NGW < nrows) load_row(hsrc_row(mksrc(F), from_input, gw + k * NGW), F.lane, ns[k]);
    for (int r0 = gw; r0 < nrows; r0 += NS * NGW) {
#pragma unroll
        for (int k = 0; k < NS; ++k) { const int r = r0 + k * NGW; if (r >= nrows) break;
            f32x4 v[4];
#pragma unroll
            for (int q = 0; q < 4; ++q) v[q] = ns[k][q];
            if (r + NS * NGW < nrows) load_row(hsrc_row(mksrc(F), from_input, r + NS * NGW), F.lane, ns[k]);
            const float rstd = rsqrtf(sumsq_row(v) * (1.0f / D) + EPS);
            const int vec = vec_of(r);
            normmod_row(v, rstd, w, modp(F, layer, vec, which), modp(F, layer, vec, which + 1), F.lane);
            store_row_bf16(out + (size_t)r * D, F.lane, v); }
    }
    if (fx.PART) {
        const Src src = mksrc(F); const float* gp = modq(src.mod, fx.layer, 2, fx.which);
        for (int r = ML + gw; r < MT; r += NGW) {
            f32x4 v[4], y[4], g[4];
            load_row(hsrc_row(src, fx.from_input, r), F.lane, v); load_row(gp, F.lane, g);
            if (fx.scale) { f32x4 sc[4]; load_row(fx.scale, F.lane, sc);
#pragma unroll
                for (int q = 0; q < 4; ++q) g[q] = g[q] * sc[q]; }
#pragma unroll
            for (int q = 0; q < 4; ++q) y[q] = (f32x4){0.f, 0.f, 0.f, 0.f};
            int sl = 0;
            for (; sl + 2 <= fx.S; sl += 2) { f32x4 t0[4], t1[4];
                load_row(fx.PART + ((size_t)sl * MC + (r - ML)) * D, F.lane, t0); load_row(fx.PART + ((size_t)(sl + 1) * MC + (r - ML)) * D, F.lane, t1);
#pragma unroll
                for (int q = 0; q < 4; ++q) { y[q] += t0[q]; y[q] += t1[q]; } }
            for (; sl < fx.S; ++sl) { f32x4 t0[4]; load_row(fx.PART + ((size_t)sl * MC + (r - ML)) * D, F.lane, t0);
#pragma unroll
                for (int q = 0; q < 4; ++q) y[q] += t0[q]; }
#pragma unroll
            for (int q = 0; q < 4; ++q) { v[q] = v[q] + g[q] * (y[q] * fx.ascale); *(f32x4*)(src.H + (size_t)r * D + 4 * F.lane + 256 * q) = v[q]; }
            const float rstd = rsqrtf(sumsq_row(v) * (1.0f / D) + EPS);
            normmod_row(v, rstd, w, modp(F, layer, 2, which), modp(F, layer, 2, which + 1), F.lane);
            store_row_bf16(out + (size_t)r * D, F.lane, v); }
    }
}

struct TokInfo { int s0, s1; float g0, g1; };
DEV void phase_poolprep(const Frame& F, int layer, bf16_t* P, bool fuse, const bf16_t* YS) {
    const TokInfo* tok = (const TokInfo*)(F.ws + OFF_TOK);
    LAS bf16_t* ub = (LAS bf16_t*)(F.lds);
    LAS float* rs = (LAS float*)(F.lds + 81920);
    const float* w = INP(F, I_NMIX) + (size_t)layer * D;
    constexpr int CTH = 4, NLT = ML / 64; const int ntile = NLT + MC / CTH;
    const int chunk = F.tid & 127, tg = F.tid >> 7;
    for (int tile = F.bx; tile < ntile; tile += F.G) {
        const int r0 = tile < NLT ? tile * 64 : ML + (tile - NLT) * CTH; const int th = tile < NLT ? 64 : CTH;
        if (r0 < ML) {
            LAS bf16_t* ul = (LAS bf16_t*)(F.lds);
            const int vec = vec_of(r0);
            { f32x4 wc[4], sv[4], g2[4];
#pragma unroll
              for (int jq = 0; jq < 4; ++jq) { const int c = 4 * F.lane + 256 * jq; wc[jq] = *(const f32x4*)(w + c) * (*(const f32x4*)(modp(F, layer, vec, 1) + c) + 1.0f); sv[jq] = *(const f32x4*)(modp(F, layer, vec, 0) + c);
                  g2[jq] = fuse ? *(const f32x4*)(modp(F, layer - 1, vec, 5) + c) * (MOE_DOWN_FP8 ? 0.00390625f : 1.0f) : (f32x4){0.f, 0.f, 0.f, 0.f}; }
              f32x4 nh[4]; u32x2 nya[4], nyb[4]; TokInfo tn; tn.s0 = tn.s1 = 0; tn.g0 = tn.g1 = 0.f;
              { const int r = r0 + F.wave; load_row(hin_row(F, layer, r), F.lane, nh);
                if (fuse) { tn = tok[r];
#pragma unroll
                    for (int jq = 0; jq < 4; ++jq) { const int c = 4 * F.lane + 256 * jq; nya[jq] = *(const u32x2*)(YS + (size_t)tn.s0 * D + c); nyb[jq] = *(const u32x2*)(YS + (size_t)tn.s1 * D + c); } } }
#pragma unroll 1
              for (int k = 0; k < 8; ++k) { const int rl = F.wave + 8 * k, r = r0 + rl;
                  f32x4 v[4]; u32x2 ya[4], yb[4]; const TokInfo ti = tn;
#pragma unroll
                  for (int q = 0; q < 4; ++q) { v[q] = nh[q]; ya[q] = nya[q]; yb[q] = nyb[q]; }
                  if (k < 7) { load_row(hin_row(F, layer, r + 8), F.lane, nh);
                      if (fuse) { tn = tok[r + 8];
#pragma unroll
                          for (int jq = 0; jq < 4; ++jq) { const int c = 4 * F.lane + 256 * jq; nya[jq] = *(const u32x2*)(YS + (size_t)tn.s0 * D + c); nyb[jq] = *(const u32x2*)(YS + (size_t)tn.s1 * D + c); } } }
                  if (fuse) {
#pragma unroll
                      for (int jq = 0; jq < 4; ++jq) { const u32x2 a = ya[jq], b = yb[jq];
                          v[jq][0] += g2[jq][0] * (ti.g0 * bflo(a.x) + ti.g1 * bflo(b.x)); v[jq][1] += g2[jq][1] * (ti.g0 * bfhi(a.x) + ti.g1 * bfhi(b.x));
                          v[jq][2] += g2[jq][2] * (ti.g0 * bflo(a.y) + ti.g1 * bflo(b.y)); v[jq][3] += g2[jq][3] * (ti.g0 * bfhi(a.y) + ti.g1 * bfhi(b.y));
                          *(f32x4*)(F.H + (size_t)r * D + 4 * F.lane + 256 * jq) = v[jq]; } }
                  const float rstd = rsqrtf(sumsq_row(v) * (1.0f / D) + EPS);
#pragma unroll
                  for (int jq = 0; jq < 4; ++jq) { const f32x4 u = v[jq] * rstd * wc[jq] + sv[jq]; u32x2 pw; pw.x = pk2(u[0], u[1]); pw.y = pk2(u[2], u[3]);
                      *(LAS u32x2*)(ul + rl * 1024 + 4 * F.lane + 256 * jq) = pw; } } }
            __syncthreads();
            { const int cq = F.tid & 255, hf = F.tid >> 8, c = cq * 4, g = c >> 8, win = 2 << g, lo = win >> 1, hi = win - 1 - lo;
#define PL_U(t_) ({ const u32x2 _q = *(const LAS u32x2*)(ul + (t_) * 1024 + c); (f32x4){bflo(_q.x), bfhi(_q.x), bflo(_q.y), bfhi(_q.y)}; })
              const int ta = 32 * hf;
              f32x4 sacc = (f32x4){0.f, 0.f, 0.f, 0.f};
              { const int a = (ta - lo > 0) ? ta - lo : 0, b = (ta + hi + 1 < 64) ? ta + hi + 1 : 64; for (int t = a; t < b; ++t) sacc += PL_U(t); }
              for (int t = ta; t < ta + 32; ++t) {
                  const int a = (t - lo > 0) ? t - lo : 0, b = (t + hi + 1 < 64) ? t + hi + 1 : 64;
                  const float inv = 1.0f / (float)(b - a);
                  const f32x4 o = sacc * inv - PL_U(t);
                  u32x2 pw; pw.x = pk2(o[0], o[1]); pw.y = pk2(o[2], o[3]); *(u32x2*)(P + (size_t)(r0 + t) * D + c) = pw;
                  if (t + 1 < ta + 32) { if (t + 1 + hi < 64) sacc += PL_U(t + 1 + hi); if (t - lo >= 0) sacc -= PL_U(t - lo); } }
#undef PL_U
            }
            __syncthreads();
            continue;
        }
        int seq0, seq1;
        if (r0 < ML) { seq0 = r0; seq1 = r0 + 64; } else { seq0 = ML + ((r0 - ML) / CTXL) * CTXL; seq1 = seq0 + CTXL; }
        const int lo_r = (r0 - 8 > seq0) ? r0 - 8 : seq0, hi_r = (r0 + th + 7 < seq1) ? r0 + th + 7 : seq1;
        const int nrow = hi_r - lo_r;
        for (int rb = lo_r + F.wave; rb < hi_r; rb += 16) {
            f32x4 v5[2][4];
#pragma unroll
            for (int k = 0; k < 2; ++k) { const int r = rb + 8 * k; if (r < hi_r) load_row(hin_row(F, layer, r), F.lane, v5[k]); }
#pragma unroll
            for (int k = 0; k < 2; ++k) { const int r = rb + 8 * k; if (r < hi_r) { const float ss = sumsq_row(v5[k]); if (F.lane == 0) rs[r - lo_r] = rsqrtf(ss * (1.0f / D) + EPS); } } }
        __syncthreads();
        const int vec = vec_of(r0);
#pragma unroll 1
        for (int half = 0; half < 2; ++half) {
            const int c = half * 512 + 4 * chunk, g = c >> 8, win = 2 << g, lo = win >> 1, hi = win - 1 - lo;
            const f32x4 wv = *(const f32x4*)(w + c), sv = *(const f32x4*)(modp(F, layer, vec, 0) + c), cv = *(const f32x4*)(modp(F, layer, vec, 1) + c) + 1.0f;
            const f32x4 wc = wv * cv;
#pragma unroll 1
            for (int kb = 0; kb < 20; kb += 5) {
                f32x4 hv[5];
#pragma unroll
                for (int k = 0; k < 5; ++k) { const int rr = tg + 4 * (kb + k); if (rr < nrow) hv[k] = *(const f32x4*)(hin_row(F, layer, lo_r + rr) + c); }
#pragma unroll
                for (int k = 0; k < 5; ++k) { const int rr = tg + 4 * (kb + k); if (rr < nrow) { const f32x4 u = hv[k] * rs[rr] * wc + sv;
                    u32x2 pw; pw.x = pk2(u[0], u[1]); pw.y = pk2(u[2], u[3]); *(LAS u32x2*)(ub + rr * 512 + 4 * chunk) = pw; } } }
            __syncthreads();
#define PP_U(r_) ({ const u32x2 _q = *(const LAS u32x2*)(ub + ((r_) - lo_r) * 512 + 4 * chunk); (f32x4){bflo(_q.x), bfhi(_q.x), bflo(_q.y), bfhi(_q.y)}; })
            const int tq = th >> 2, ta = r0 + tq * tg;
            f32x4 s = (f32x4){0.f, 0.f, 0.f, 0.f};
            { const int a = (ta - lo > seq0) ? ta - lo : seq0, b = (ta + hi + 1 < seq1) ? ta + hi + 1 : seq1; for (int r = a; r < b; ++r) s += PP_U(r); }
            for (int t = ta; t < ta + tq; ++t) {
                const int a = (t - lo > seq0) ? t - lo : seq0, b = (t + hi + 1 < seq1) ? t + hi + 1 : seq1;
                const float inv = 1.0f / (float)(b - a);
                const f32x4 o = s * inv - PP_U(t);
                u32x2 pw; pw.x = pk2(o[0], o[1]); pw.y = pk2(o[2], o[3]); *(u32x2*)(P + (size_t)t * D + c) = pw;
                if (t + 1 < ta + tq) {
                    if (t + 1 + hi < seq1) s += PP_U(t + 1 + hi);
                    if (t - lo >= seq0) s -= PP_U(t - lo); }
            }
#undef PP_U
            __syncthreads();
        }
    }
}

struct PolBase { int G, c; static constexpr bool VARK = false; };
DEV bool ctx_next(int npan, int nsl, int G, int c, int i, Unit& u) {
    const int nmain = npan * 4; const long L = (long)i * G + c;
    if (L < nmain) return ge::static_next(npan, 4, G, c, i, u);
    const long L2 = L - nmain; if (L2 >= 8L * nsl) return false;
    const int t = (int)(L2 & 7); u.pm = ML / 256 + (t >> 2); u.pn = (t & 3) + 4 * (1 + (int)(L2 >> 3)); return true;
}
DEV int ctx_koff(const Unit& u) { return (u.pn >> 2) ? ((u.pn >> 2) - 1) * 128 : 0; }
DEV void ctx_store(float* PART, const f32x4 (&acc)[2][2][4][2], const Unit& u, int wr, int wc, int fr, int fq) {
    float* o = PART + ((size_t)((u.pn >> 2) - 1) * MC + (u.pm * 256 - ML) + wr * 64 + fr) * D + (u.pn & 3) * 256 + wc * 32 + 4 * fq;
#pragma unroll
    for (int ai = 0; ai < 2; ++ai)
#pragma unroll
        for (int m = 0; m < 4; ++m)
#pragma unroll
            for (int bj = 0; bj < 2; ++bj)
#pragma unroll
                for (int n = 0; n < 2; ++n) *(f32x4*)(o + (size_t)(ai * 128 + m * 16) * D + bj * 128 + n * 16) = acc[ai][bj][m][n];
}
struct PolPool : PolBase {
    static constexpr bool PERM = false, GATHER = false; static constexpr bool FP8 = false; static constexpr int ES = 2; int K, lda, ldb;
    static constexpr bool VARK = true;
    const bf16_t* P; const bf16_t* W; Src src; int layer, npan; const float* scale; float* PART;
    DEV bool next(int i, Unit& u) const { return ctx_next(npan, 2, G, c, i, u); }
    DEV int unit_nt(const Unit& u) const { return (u.pn >> 2) ? 2 : 4; }
    DEV const char* a_base(const Unit& u) const { return (const char*)(P + (size_t)u.pm * 256 * D + (u.pn & 3) * 256 + ctx_koff(u)); }
    DEV const char* b_base(const Unit& u) const { return (const char*)(W + (size_t)(u.pn & 3) * 65536 + ctx_koff(u)); }
    DEV void epi(const f32x4 (&acc)[2][2][4][2], const Unit& u, int wr, int wc, int fr, int fq) const {
        if (u.pn >> 2) { ctx_store(PART, acc, u, wr, wc, fr, fq); return; }
        const int row0 = u.pm * 256 + wr * 64 + fr, col0 = u.pn * 256 + wc * 32 + 4 * fq; const int vec = vec_of(u.pm * 256);
        const float* g1 = modq(src.mod, layer, vec, 2);
        f32x4 gv[2][2];
#pragma unroll
        for (int bj = 0; bj < 2; ++bj)
#pragma unroll
            for (int n = 0; n < 2; ++n) { const int cc = col0 + bj * 128 + n * 16; gv[bj][n] = *(const f32x4*)(g1 + cc) * *(const f32x4*)(scale + cc); }
#pragma unroll
        for (int ai = 0; ai < 2; ++ai)
#pragma unroll
            for (int mp = 0; mp < 4; mp += 2) { f32x4 hv[2][2][2];
#pragma unroll
                for (int m2 = 0; m2 < 2; ++m2) { const float* hi = hsrc_row(src, layer == 0, row0 + ai * 128 + (mp + m2) * 16) + col0;
#pragma unroll
                    for (int bj = 0; bj < 2; ++bj)
#pragma unroll
                        for (int n = 0; n < 2; ++n) hv[m2][bj][n] = *(const f32x4*)(hi + bj * 128 + n * 16); }
#pragma unroll
                for (int m2 = 0; m2 < 2; ++m2) { float* ho = src.H + (size_t)(row0 + ai * 128 + (mp + m2) * 16) * D + col0;
#pragma unroll
                    for (int bj = 0; bj < 2; ++bj)
#pragma unroll
                        for (int n = 0; n < 2; ++n) *(f32x4*)(ho + bj * 128 + n * 16) = hv[m2][bj][n] + gv[bj][n] * acc[ai][bj][mp + m2][n]; } }
    }
};
template <bool F8>
struct PolResid : PolBase {
    static constexpr bool PERM = false, GATHER = F8; static constexpr bool FP8 = F8; static constexpr int ES = F8 ? 1 : 2; int K, lda, ldb;
    static constexpr bool VARK = true;
    const bf16_t* A; const bf16_t* W; Src src; int layer, which, npan, nsl; float* PART;
    DEV bool next(int i, Unit& u) const { return ctx_next(npan, nsl, G, c, i, u); }
    DEV int unit_nt(const Unit& u) const { return (u.pn >> 2) ? 2 : K * ES / 128; }
    DEV int gather_row(const Unit& u, int R) const { return u.pm * 256 + R; }
    DEV const char* a_base(const Unit& u) const { return (const char*)A + (GATHER ? (size_t)0 : (size_t)u.pm * 256 * lda * ES) + ctx_koff(u) * 2; }
    DEV const char* b_base(const Unit& u) const { return (const char*)W + (size_t)(u.pn & 3) * 256 * ldb * ES + ctx_koff(u) * 2; }
    DEV void epi(const f32x4 (&acc)[2][2][4][2], const Unit& u, int wr, int wc, int fr, int fq) const {
        if (u.pn >> 2) { ctx_store(PART, acc, u, wr, wc, fr, fq); return; }
        const int row0 = u.pm * 256 + wr * 64 + fr, col0 = u.pn * 256 + wc * 32 + 4 * fq; const int vec = vec_of(u.pm * 256);
        const float* gp = modq(src.mod, layer, vec, which);
        f32x4 gv[2][2];
#pragma unroll
        for (int bj = 0; bj < 2; ++bj)
#pragma unroll
            for (int n = 0; n < 2; ++n) gv[bj][n] = *(const f32x4*)(gp + col0 + bj * 128 + n * 16) * (F8 ? 0.00390625f : 1.0f);
#pragma unroll
        for (int ai = 0; ai < 2; ++ai)
#pragma unroll
            for (int mp = 0; mp < 4; mp += 2) { f32x4 hv[2][2][2];
#pragma unroll
                for (int m2 = 0; m2 < 2; ++m2) { const float* hi = src.H + (size_t)(row0 + ai * 128 + (mp + m2) * 16) * D + col0;
#pragma unroll
                    for (int bj = 0; bj < 2; ++bj)
#pragma unroll
                        for (int n = 0; n < 2; ++n) hv[m2][bj][n] = *(const f32x4*)(hi + bj * 128 + n * 16); }
#pragma unroll
                for (int m2 = 0; m2 < 2; ++m2) { float* ho = src.H + (size_t)(row0 + ai * 128 + (mp + m2) * 16) * D + col0;
#pragma unroll
                    for (int bj = 0; bj < 2; ++bj)
#pragma unroll
                        for (int n = 0; n < 2; ++n) *(f32x4*)(ho + bj * 128 + n * 16) = hv[m2][bj][n] + gv[bj][n] * acc[ai][bj][mp + m2][n]; } }
    }
};
template <bool MOE>
struct PolUp : PolBase {
    static constexpr bool PERM = true, GATHER = MOE, FP8 = MOE; static constexpr int ES = MOE ? 1 : 2; int K, lda, ldb;
    const bf16_t* A; const bf16_t* W; bf16_t* HID; int ldh, nq;
    int nM; const int* s2t; int tstart[NEXP + 1];
    DEV bool next(int i, Unit& u) const { return ge::static_next(MOE ? nM : NPAN, nq, G, c, i, u); }
    DEV int expert_of(int pm) const { int e = 0;
#pragma unroll
        for (int k = 1; k < NEXP; ++k) e += (pm >= tstart[k]) ? 1 : 0;
        return e; }
    DEV const char* a_base(const Unit& u) const { return MOE ? (const char*)A : (const char*)(A + (size_t)u.pm * 256 * lda); }
    DEV const char* b_base(const Unit& u) const { size_t off = (size_t)u.pn * 256 * ldb; if (MOE) off += (size_t)expert_of(u.pm) * 2 * DFFE * ldb; return (const char*)W + off * ES; }
    DEV int gather_row(const Unit& u, int R) const { return s2t[u.pm * 256 + R]; }
    DEV void epi(const f32x4 (&acc)[2][2][4][2], const Unit& u, int wr, int wc, int fr, int fq) const {
        const int row0 = u.pm * 256 + wr * 64 + fr, col0 = u.pn * 128 + wc * 32 + 8 * fq;
#pragma unroll
        for (int ai = 0; ai < 2; ++ai)
#pragma unroll
            for (int m = 0; m < 4; ++m) { bf16_t* o = HID + (size_t)(row0 + ai * 128 + m * 16) * ldh + col0;
                float h[8];
                constexpr bool H8 = MOE ? (MOE_DOWN_FP8 != 0) : (FFN_DOWN_FP8 != 0);
                constexpr float SG = MOE ? 0.00390625f : 1.0f, SU = MOE ? (MOE_DOWN_FP8 ? 0.015625f : 0.00390625f) : (FFN_DOWN_FP8 ? 4.0f : 1.0f);
                const f32x2 ke = {-1.4426950408889634f * SG, -1.4426950408889634f * SG}, ks = {SG * SU, SG * SU}, one = {1.0f, 1.0f};
#pragma unroll
                for (int n = 0; n < 2; ++n)
#pragma unroll
                    for (int ip = 0; ip < 2; ++ip) { const f32x2 g = {acc[ai][0][m][n][2 * ip], acc[ai][0][m][n][2 * ip + 1]}, u = {acc[ai][1][m][n][2 * ip], acc[ai][1][m][n][2 * ip + 1]};
                        const f32x2 t = g * ke; const f32x2 d = (f32x2){fexp2(t.x), fexp2(t.y)} + one; const f32x2 r = {frcp(d.x), frcp(d.y)};
                        const f32x2 hh = (MOE || H8) ? (g * u) * (r * ks) : (g * u) * r; h[4 * n + 2 * ip] = hh.x; h[4 * n + 2 * ip + 1] = hh.y; }
                if (H8) { u32x2 w8; w8.x = pk4_fp8(h[0], h[1], h[2], h[3]); w8.y = pk4_fp8(h[4], h[5], h[6], h[7]);
                    *(u32x2*)((fp8_t*)HID + (size_t)(row0 + ai * 128 + m * 16) * ldh + col0) = w8; }
                else { u32x4 w; w.x = pk2(h[0], h[1]); w.y = pk2(h[2], h[3]); w.z = pk2(h[4], h[5]); w.w = pk2(h[6], h[7]); *(u32x4*)o = w; } }
    }
};
struct PolMoeDown : PolBase {
    static constexpr bool PERM = true, GATHER = (MOE_DOWN_FP8 != 0), FP8 = (MOE_DOWN_FP8 != 0); static constexpr int ES = MOE_DOWN_FP8 ? 1 : 2; int K, lda, ldb;
    const bf16_t* A; const bf16_t* W; bf16_t* YS; int nM; int tstart[NEXP + 1];
    DEV bool next(int i, Unit& u) const { return ge::static_next(nM, 4, G, c, i, u); }
    DEV int expert_of(int pm) const { int e = 0;
#pragma unroll
        for (int k = 1; k < NEXP; ++k) e += (pm >= tstart[k]) ? 1 : 0;
        return e; }
    DEV const char* a_base(const Unit& u) const { return GATHER ? (const char*)A : (const char*)A + (size_t)u.pm * 256 * lda * ES; }
    DEV int gather_row(const Unit& u, int R) const { return u.pm * 256 + R; }
    DEV const char* b_base(const Unit& u) const { return (const char*)W + ((size_t)expert_of(u.pm) * D + (size_t)u.pn * 256) * ldb * ES; }
    DEV void epi(const f32x4 (&acc)[2][2][4][2], const Unit& u, int wr, int wc, int fr, int fq) const {
        const int row0 = u.pm * 256 + wr * 64 + fr, col0 = u.pn * 256 + wc * 32 + 8 * fq;
#pragma unroll
        for (int ai = 0; ai < 2; ++ai)
#pragma unroll
            for (int m = 0; m < 4; ++m) { bf16_t* o = YS + (size_t)(row0 + ai * 128 + m * 16) * D + col0;
#pragma unroll
                for (int bj = 0; bj < 2; ++bj) { u32x4 w; w.x = pk2(acc[ai][bj][m][0][0], acc[ai][bj][m][0][1]); w.y = pk2(acc[ai][bj][m][0][2], acc[ai][bj][m][0][3]);
                    w.z = pk2(acc[ai][bj][m][1][0], acc[ai][bj][m][1][1]); w.w = pk2(acc[ai][bj][m][1][2], acc[ai][bj][m][1][3]); *(u32x4*)(o + bj * 128) = w; } }
    }
};
struct PolInProj : PolBase {
    static constexpr bool PERM = true, GATHER = false; static constexpr bool FP8 = false; static constexpr int ES = 2; int K, lda, ldb;
    const bf16_t* A; const bf16_t* W; bf16_t* Z; bf16_t* XBC; float* DT;
    DEV bool next(int i, Unit& u) const { return ge::static_next(NPAN, NPROJP / 256, G, c, i, u); }
    DEV const char* a_base(const Unit& u) const { return (const char*)(A + (size_t)u.pm * 256 * lda); }
    DEV const char* b_base(const Unit& u) const { return (const char*)(W + (size_t)u.pn * 256 * ldb); }
    DEV void epi(const f32x4 (&acc)[2][2][4][2], const Unit& u, int wr, int wc, int fr, int fq) const {
        const int row0 = u.pm * 256 + wr * 64 + fr, cw = wc * 32 + 8 * fq;
        if (u.pn < 20) {
            bf16_t* base; size_t ld, bjs; int col0;
            if (u.pn < 8) { base = Z; ld = DIN; col0 = u.pn * 256 + cw; bjs = 128; }
            else { base = XBC + (size_t)((u.pn - 8) * 4 + (wc >> 1)) * MT * 64; ld = 64; col0 = (wc & 1) * 32 + 8 * fq; bjs = (size_t)2 * MT * 64; }
#pragma unroll
            for (int ai = 0; ai < 2; ++ai)
#pragma unroll
                for (int m = 0; m < 4; ++m) { bf16_t* o = base + (size_t)(row0 + ai * 128 + m * 16) * ld + col0;
#pragma unroll
                    for (int bj = 0; bj < 2; ++bj) { u32x4 w; w.x = pk2(acc[ai][bj][m][0][0], acc[ai][bj][m][0][1]); w.y = pk2(acc[ai][bj][m][0][2], acc[ai][bj][m][0][3]);
                        w.z = pk2(acc[ai][bj][m][1][0], acc[ai][bj][m][1][1]); w.w = pk2(acc[ai][bj][m][1][2], acc[ai][bj][m][1][3]); *(u32x4*)(o + bj * bjs) = w; } }
        } else if (cw < 64) {
#pragma unroll
            for (int ai = 0; ai < 2; ++ai)
#pragma unroll
                for (int m = 0; m < 4; ++m) { const int r = row0 + ai * 128 + m * 16; int b, tv;
                    if (r < ML) { b = r / SEQ; tv = CTXL + r % SEQ; } else { b = (r - ML) / CTXL; tv = (r - ML) % CTXL; }
#pragma unroll
                    for (int n = 0; n < 2; ++n)
#pragma unroll
                        for (int i = 0; i < 4; ++i) { const int j = cw + 4 * n + i, dir = j >> 5, h = j & 31;
                            DT[((size_t)(b * 2 + dir) * NH + h) * TV + tv] = acc[ai][0][m][n][i]; } }
        }
    }
};

DEV void phase_conv(const Frame& F, int j, const bf16_t* XBC, bf16_t* XT, bf16_t* Brow, bf16_t* BT, bf16_t* Crow) {
    LAS bf16_t* tl0 = (LAS bf16_t*)F.lds;
    const float* cw = INP(F, I_CONVW) + (size_t)j * 4 * CONVD; const float* cb = INP(F, I_CONVB) + (size_t)j * CONVD;
    constexpr int NPER = NB * NCH, nitem = NPER * (CONVD / 64);
    const int t2 = 2 * (F.tid >> 3), cg = F.tid & 7;
    const int i0 = (int)(((long)F.bx * nitem) / F.G), i1 = (int)(((long)(F.bx + 1) * nitem) / F.G);
    int cblk_cur = -1; f32x4 wv[4][2], bv[2]; int par = 0;
#define CV_LOAD(it_, q_) do { const int _cb = (it_) / NPER, _rs = (it_) % NPER, _b = _rs / NCH, _cv = _rs % NCH; const int _ch = _cb * 64 + cg * 8, _tv = _cv * 128 + t2; \
        const int _s0 = _tv < CTXL ? 0 : CTXL, _s1 = _tv < CTXL ? CTXL : TV; \
        _Pragma("unroll") for (int k = 0; k < 5; ++k) { const int tk = _tv - 2 + k; q_[k] = (u32x4){0u, 0u, 0u, 0u}; \
            if (tk >= _s0 && tk < _s1) q_[k] = *(const u32x4*)(XBC + ((size_t)_cb * MT + row_of(_b, tk)) * 64 + cg * 8); } } while (0)
    u32x4 qn[5];
    if (i0 < i1) CV_LOAD(i0, qn);
    for (int it = i0; it < i1; ++it) {
        const int cblk = it / NPER, rest = it % NPER, b = rest / NCH, cv = rest % NCH;
        const int ch0 = cblk * 64 + cg * 8;
        if (cblk != cblk_cur) { cblk_cur = cblk;
#pragma unroll
            for (int k = 0; k < 4; ++k) { wv[k][0] = *(const f32x4*)(cw + k * CONVD + ch0); wv[k][1] = *(const f32x4*)(cw + k * CONVD + ch0 + 4); }
            bv[0] = *(const f32x4*)(cb + ch0); bv[1] = *(const f32x4*)(cb + ch0 + 4); }
        const int tv = cv * 128 + t2;
        float xin[5][8];
#pragma unroll
        for (int k = 0; k < 5; ++k) { const u32x4 q = qn[k];
            xin[k][0] = bflo(q.x); xin[k][1] = bfhi(q.x); xin[k][2] = bflo(q.y); xin[k][3] = bfhi(q.y); xin[k][4] = bflo(q.z); xin[k][5] = bfhi(q.z); xin[k][6] = bflo(q.w); xin[k][7] = bfhi(q.w); }
        if (it + 1 < i1) CV_LOAD(it + 1, qn);
        unsigned pk[2][4];
#pragma unroll
        for (int o = 0; o < 2; ++o) { float a[8];
#pragma unroll
            for (int i = 0; i < 8; ++i) { float acc = bv[i >> 2][i & 3];
#pragma unroll
                for (int k = 0; k < 4; ++k) acc += wv[k][i >> 2][i & 3] * xin[o + k][i];
                a[i] = siluf(acc); }
#pragma unroll
            for (int i = 0; i < 4; ++i) pk[o][i] = pk2(a[2 * i], a[2 * i + 1]); }
        const int r = row_of(b, tv);
        const bool isx = cblk < DIN / 64, isb = !isx && cblk < (DIN + BCD) / 64;
        if (!isx) {
            const int chc = ch0 - DIN - (isb ? 0 : BCD); bf16_t* o = (isb ? Brow : Crow) + (size_t)(r - t2) * BCD + (chc >> 7) * 16384 + frag_off(t2, chc & 127);
            *(u32x4*)o = (u32x4){pk[0][0], pk[0][1], pk[0][2], pk[0][3]}; *(u32x4*)(o + 8) = (u32x4){pk[1][0], pk[1][1], pk[1][2], pk[1][3]}; }
        if (isx || isb) {
            LAS bf16_t* tl = tl0 + par * (64 * 136); par ^= 1;
#pragma unroll
            for (int i = 0; i < 4; ++i) { const unsigned lo = (pk[0][i] & 0xffffu) | (pk[1][i] << 16), hi = (pk[0][i] >> 16) | (pk[1][i] & 0xffff0000u);
                *(LAS unsigned*)(tl + (cg * 8 + 2 * i) * 136 + t2) = lo; *(LAS unsigned*)(tl + (cg * 8 + 2 * i + 1) * 136 + t2) = hi; }
            __syncthreads();
            if (isx) { bf16_t* dst = XT + ((size_t)(b * NCH + cv) * DIN + cblk * 64) * 128;
#pragma unroll
                for (int q = 0; q < 2; ++q) { const int idx = F.tid + q * 512, ch = idx >> 4, t8 = (idx & 15) * 8;
                    *(u32x4*)(dst + idx * 8) = *(const LAS u32x4*)(tl + ch * 136 + t8); }
            } else {
                const int chb = cblk * 64 - DIN; bf16_t* dst = BT + (size_t)((b * NCH + cv) * NG + (chb >> 7)) * 16384 + ((chb & 127) >> 4) * 2048;
#pragma unroll
                for (int q = 0; q < 2; ++q) { const int idx = F.tid + q * 512, fr_ = idx & 15, fq_ = (idx >> 4) & 3, ks_ = (idx >> 6) & 3, rbl = idx >> 8;
                    *(u32x4*)(dst + idx * 8) = *(const LAS u32x4*)(tl + (rbl * 16 + fr_) * 136 + (ks_ * 4 + fq_) * 8); }
            }
        }
    }
}

#undef CV_LOAD
DEV void phase_cb(const Frame& F, const bf16_t* Brow, const bf16_t* Crow, bf16_t* CB) {
    const int nitem = NB * NG * NCH; const int fr = F.lane & 15, fq = F.lane >> 4;
    for (int it = F.bx; it < nitem; it += F.G) {
        const int cv = it % NCH, g = (it / NCH) % NG, b = it / (NCH * NG);
        const int rbase = row_of(b, cv * 128);
        const bf16_t* ct = Crow + (size_t)rbase * BCD + g * 16384 + F.lane * 8; const bf16_t* bt_ = Brow + (size_t)rbase * BCD + g * 16384 + F.lane * 8;
        bf16x8 cf[4], bfr[8][4];
#pragma unroll
        for (int ks = 0; ks < 4; ++ks) cf[ks] = *(const bf16x8*)(ct + (F.wave * 4 + ks) * 512);
#pragma unroll
        for (int nt = 0; nt < 8; ++nt)
#pragma unroll
            for (int ks = 0; ks < 4; ++ks) bfr[nt][ks] = *(const bf16x8*)(bt_ + (nt * 4 + ks) * 512);
        bf16_t* out = CB + ((size_t)((b * NG + g) * NCH + cv)) * 16384;
#pragma unroll
        for (int nt = 0; nt < 8; ++nt) {
            f32x4 acc = (f32x4){0.f, 0.f, 0.f, 0.f};
#pragma unroll
            for (int ks = 0; ks < 4; ++ks) acc = MFMA16(bfr[nt][ks], cf[ks], acc);
            u32x2 w; w.x = pk2(acc[0], acc[1]); w.y = pk2(acc[2], acc[3]);
            *(u32x2*)(out + frag_off(16 * F.wave + fr, 16 * nt + 4 * fq)) = w;
        }
    }
}

DEV void phase_tables(const Frame& F, int j, float* DT, float* CUM, float* WJ, float* CF) {
    const int nitem = NB * 2 * NH * NCH; const int gw = F.bx * 8 + F.wave, NGW = F.G * 8;
    f32x2 rawn = (f32x2){0.f, 0.f}; if (gw < nitem) rawn = *(const f32x2*)(DT + (size_t)gw * 128 + 2 * F.lane);
    for (int it = gw; it < nitem; it += NGW) {
        const int cv = it % NCH, h = (it / NCH) % NH, dir = (it / (NCH * NH)) & 1, b = it / (NCH * NH * 2);
        const float A = -expf(INP(F, I_ALOG)[(size_t)(j * 2 + dir) * NH + h]); const float bias = INP(F, I_DTB)[(size_t)(j * 2 + dir) * NH + h];
        const size_t o = ((size_t)(b * 2 + dir) * NH + h) * TV + cv * 128 + 2 * F.lane;
        const f32x2 raw = rawn; if (it + NGW < nitem) rawn = *(const f32x2*)(DT + (size_t)(it + NGW) * 128 + 2 * F.lane);
        const float d0 = softplusf(raw.x + bias), d1 = softplusf(raw.y + bias); const float a0 = d0 * A, a1 = d1 * A;
        float c0, c1, tot, sum = a0 + a1;
        if (dir == 0) {
#pragma unroll
            for (int q = 1; q < 64; q <<= 1) { const float t2 = __shfl_up(sum, q); if (F.lane >= q) sum += t2; }
            c1 = sum; c0 = sum - a1; tot = __shfl(sum, 63);
        } else {
#pragma unroll
            for (int q = 1; q < 64; q <<= 1) { const float t2 = __shfl_down(sum, q); if (F.lane + q < 64) sum += t2; }
            c0 = sum; c1 = sum - a0; tot = __shfl(sum, 0);
        }
        constexpr float L2E = 1.4426950408889634f;
        *(f32x2*)(DT + o) = (f32x2){c0 * L2E - flog2(d0), c1 * L2E - flog2(d1)};
        *(f32x2*)(CUM + o) = (f32x2){c0 * L2E, c1 * L2E};
        *(f32x2*)(WJ + o) = (f32x2){d0 * FEXP(tot - c0), d1 * FEXP(tot - c1)};
        const float cref = L2E * __shfl(dir == 0 ? c1 : c0, dir == 0 ? (F.lane | 15) : (F.lane & ~15));
        *(f32x2*)(CF + o) = (f32x2){d0 * fexp2(cref - c0 * L2E), d1 * fexp2(cref - c1 * L2E)};
    }
}

constexpr int SC_HL = 0, SC_TAB = 17408, SC_X = 21504, SC_END = SC_X + 16384;
static_assert(SC_END <= ge::STAGE_BYTES, "scan LDS map");
DEV void phase_scan(const Frame& F, int j, const bf16_t* XT, const bf16_t* BT, const bf16_t* Crow, const bf16_t* CB, const float* DT, const float* CUM, const float* WJ, const float* CF, bf16_t* Yf, bf16_t* Yb) {
    LAS unsigned char* L = F.lds;
    LAS bf16_t* Hl = (LAS bf16_t*)(L + SC_HL);
    LAS float* tab = (LAS float*)(L + SC_TAB);
    const int fr = F.lane & 15, fq = F.lane >> 4, w = F.wave;
    const int rb = w < 4 ? w : 11 - w;
    const int nitem = NB * NH * 2 * 2;
    for (int it = F.bx; it < nitem; it += F.G) {
        const int xq = it & 7, kq = it >> 3; const int b = xq >> 2, g = xq & 3, h = 8 * g + (kq >> 2), dir = (kq >> 1) & 1, ph = kq & 1;
        const float Dsk = dir == 0 ? INP(F, I_DSKIP)[(size_t)j * NH + h] : 0.f;
        const size_t tbase = ((size_t)(b * 2 + dir) * NH + h) * TV;
        const bf16_t* xt = XT + ((size_t)b * NCH * DIN + h * HD + ph * 32) * 128;
        const bf16_t* bt = BT + (size_t)(b * NCH * NG + g) * 16384;
        const bf16_t* CBh = CB + (size_t)((b * NG + g) * NCH) * 16384;
        const bf16_t* Cg = Crow + g * 16384;
        bf16_t* Y = (dir ? Yb : Yf) + h * HD + ph * 32;
        const int lrow = 16 * rb + fr;
        f32x4 accH[2]; accH[0] = (f32x4){0.f, 0.f, 0.f, 0.f}; accH[1] = accH[0];
        for (int i = F.tid; i < 32 * 136 / 2; i += 512) ((LAS unsigned*)Hl)[i] = 0u;
#define SC_CHUNK_OF(step) (dir == 0 ? (step) : ((step) < 2 ? 1 - (step) : (NCH - 1) - ((step) - 2)))
        const int xr = 4 * w + (F.lane >> 4), xc = F.lane & 15;
        const unsigned lxs = (unsigned)(xr * 128 + 8 * xc) * 2u, lxd = (unsigned)(xr * 256 + ((xc ^ (xr & 15)) << 4));
#define SC_LD_X(cvx_) (*(const u32x4*)((const char*)(xt + (size_t)(cvx_) * (DIN * 128)) + lxs))
#define SC_ST_X(xb_, v_) (*(LAS u32x4*)(L + SC_X + (xb_) * 8192 + lxd) = (v_))
        const float* tsrcw = ((w >> 1) == 0 ? CUM : ((w >> 1) == 1 ? DT : ((w >> 1) == 2 ? WJ : CF))) + tbase + (w & 1) * 64 + F.lane;
#define SC_LD_TAB(cvx_) (tsrcw[(cvx_) * 128])
#define SC_ST_TAB(tbuf_, v_) (tab[(tbuf_) * 512 + w * 64 + F.lane] = (v_))
        const unsigned lfo = (unsigned)(rb * 4096 + F.lane * 16);
#define SC_LD_CB(cvx_, ks_) (*(const u32x4*)((const char*)(CBh + (size_t)(cvx_) * 16384u) + lfo + (ks_) * 1024))
#define SC_LD_BT(cvx_, ks_) (*(const u32x4*)((const char*)(bt + (size_t)(cvx_) * 65536u) + lfo + (ks_) * 1024))
#define SC_LD_C(rbx_, ks_) (*(const bf16x8*)((const char*)(Cg + (size_t)(rbx_) * BCD) + lfo + (ks_) * 1024))
        const int kd = rb >> 1; float km[8], dk[8];
#pragma unroll
        for (int i = 0; i < 8; ++i) { const int sidx = 32 * kd + 8 * fq + i; km[i] = (dir == 0 ? (sidx <= lrow) : (sidx >= lrow)) ? 1.f : 0.f; dk[i] = (sidx == lrow) ? Dsk : 0.f; }
        u32x4 rcb[4], rbt[4]; bf16x8 cf[4];
        { const int cv0 = SC_CHUNK_OF(0); const u32x4 x0 = SC_LD_X(cv0); const float t0 = SC_LD_TAB(cv0); const unsigned rb0 = (unsigned)row_of(b, cv0 * 128);
#pragma unroll
          for (int ks = 0; ks < 4; ++ks) { rcb[ks] = SC_LD_CB(cv0, ks); rbt[ks] = SC_LD_BT(cv0, ks); cf[ks] = SC_LD_C(rb0, ks); }
          SC_ST_X(0, x0); SC_ST_TAB(0, t0); }
        for (int step = 0; step < NCH; ++step) {
            int kdl = kd, dirl = dir; LAUNDER_S(kdl); LAUNDER_S(dirl);
            const int cv = SC_CHUNK_OF(step), buf = step & 1; const bool more = step + 1 < NCH;
            const int cvn = more ? SC_CHUNK_OF(step + 1) : cv;
            const unsigned rbase = (unsigned)row_of(b, cv * 128), rbn = (unsigned)row_of(b, cvn * 128);
            LDSBAR();
            const u32x4 xn = SC_LD_X(cvn); const float tn = SC_LD_TAB(cvn);
            const LAS float* tb = tab + buf * 512;
            const float cl2 = tb[lrow]; const float ecum_l = fexp2(cl2);
            const float chunk_decay = fexp2(dir == 0 ? tb[127] : tb[0]);
            f32x4 yd[2], yo[2];
#pragma unroll
            for (int nt = 0; nt < 2; ++nt) { yd[nt] = (f32x4){0.f, 0.f, 0.f, 0.f}; yo[nt] = yd[nt]; accH[nt] = accH[nt] * chunk_decay; }
#pragma unroll
            for (int ks = 0; ks < 4; ++ks) { const int s0 = 32 * ks + 8 * fq; bf16x8 mfk, bwk;
                const bool none = dirl == 0 ? (ks > kdl) : (ks < kdl), diag = (ks == kdl);
                unsigned om[4] = {0u, 0u, 0u, 0u};
                if (!none) {
                    const unsigned qc[4] = {rcb[ks].x, rcb[ks].y, rcb[ks].z, rcb[ks].w};
                    if (!diag) {
                        const f32x4 f0 = *(const LAS f32x4*)(tb + 384 + s0), f1 = *(const LAS f32x4*)(tb + 384 + s0 + 4);
                        const float rowf = fexp2(cl2 - tb[dirl == 0 ? 32 * ks + 31 : 32 * ks]);
                        const f32x2 rf2 = {rowf, rowf};
                        const f32x2 c2[4] = {(f32x2){f0[0], f0[1]}, (f32x2){f0[2], f0[3]}, (f32x2){f1[0], f1[1]}, (f32x2){f1[2], f1[3]}};
#pragma unroll
                        for (int i = 0; i < 4; ++i) { const f32x2 v2 = (f32x2){bflo(qc[i]), bfhi(qc[i])} * (c2[i] * rf2); om[i] = pk2(v2.x, v2.y); }
                    } else {
                        const f32x4 cs0 = *(const LAS f32x4*)(tb + 128 + s0), cs1 = *(const LAS f32x4*)(tb + 128 + s0 + 4);
                        const float cs[8] = {cs0[0], cs0[1], cs0[2], cs0[3], cs1[0], cs1[1], cs1[2], cs1[3]};
                        float v[8];
#pragma unroll
                        for (int i = 0; i < 8; ++i) { const float cbv = (i & 1) ? bfhi(qc[i >> 1]) : bflo(qc[i >> 1]); const float x = cl2 - cs[i]; v[i] = (cbv * fexp2(x < 60.f ? x : 60.f)) * km[i] + dk[i]; }
#pragma unroll
                        for (int i = 0; i < 4; ++i) om[i] = pk2(v[2 * i], v[2 * i + 1]);
                    }
                    rcb[ks] = SC_LD_CB(cvn, ks);
                }
                mfk = __builtin_bit_cast(bf16x8, (u32x4){om[0], om[1], om[2], om[3]});
                { const f32x4 ws0 = *(const LAS f32x4*)(tb + 256 + s0), ws1 = *(const LAS f32x4*)(tb + 256 + s0 + 4);
                  const f32x2 w2[4] = {(f32x2){ws0[0], ws0[1]}, (f32x2){ws0[2], ws0[3]}, (f32x2){ws1[0], ws1[1]}, (f32x2){ws1[2], ws1[3]}};
                  const unsigned qb[4] = {rbt[ks].x, rbt[ks].y, rbt[ks].z, rbt[ks].w}; unsigned ob[4];
#pragma unroll
                  for (int i = 0; i < 4; ++i) { const f32x2 v2 = (f32x2){bflo(qb[i]), bfhi(qb[i])} * w2[i]; ob[i] = pk2(v2.x, v2.y); LAUNDER_V(ob[i]); }
                  bwk = __builtin_bit_cast(bf16x8, (u32x4){ob[0], ob[1], ob[2], ob[3]}); }
                rbt[ks] = SC_LD_BT(cvn, ks);
#pragma unroll
                for (int nt = 0; nt < 2; ++nt) {
                    const bf16x8 xf = *(const LAS bf16x8*)(L + SC_X + buf * 8192 + (16 * nt + fr) * 256 + (((4 * ks + fq) ^ fr) << 4));
                    if (!none) yd[nt] = MFMA16(xf, mfk, yd[nt]);
                    const bf16x8 hf = *(const LAS bf16x8*)(Hl + buf * (32 * 136) + (16 * nt + fr) * 136 + 32 * ks + 8 * fq);
                    yo[nt] = MFMA16(hf, cf[ks], yo[nt]);
                    accH[nt] = MFMA16(bwk, xf, accH[nt]); } }
#pragma unroll
            for (int ks = 0; ks < 4; ++ks) cf[ks] = SC_LD_C(rbn, ks);
            SC_ST_X(buf ^ 1, xn); SC_ST_TAB(buf ^ 1, tn);
#pragma unroll
            for (int nt = 0; nt < 2; ++nt) { u32x2 hw; hw.x = pk2(accH[nt][0], accH[nt][1]); hw.y = pk2(accH[nt][2], accH[nt][3]);
                *(LAS u32x2*)(Hl + (buf ^ 1) * (32 * 136) + (16 * nt + fr) * 136 + 16 * rb + 4 * fq) = hw; }
#pragma unroll
            for (int nt = 0; nt < 2; ++nt) { u32x2 yw; yw.x = pk2(yd[nt][0] + ecum_l * yo[nt][0], yd[nt][1] + ecum_l * yo[nt][1]); yw.y = pk2(yd[nt][2] + ecum_l * yo[nt][2], yd[nt][3] + ecum_l * yo[nt][3]);
                *(u32x2*)(Y + ((size_t)(rbase + lrow) * DIN + 16 * nt + 4 * fq)) = yw; }
        }
        WAITV(0); LDSBAR();
    }
}

DEV void phase_gate(const Frame& F, int j, const bf16_t* Yf, const bf16_t* Yb, const bf16_t* Z, bf16_t* YN, int nrows) {
    const int gw = F.bx * 8 + F.wave, NGW = F.G * 8; const float* nw = INP(F, I_SNORM) + (size_t)j * DIN;
    u32x4 na[4], nb[4], nz[4];
    if (gw < nrows) {
#pragma unroll
        for (int q = 0; q < 4; ++q) { const size_t o = (size_t)gw * DIN + 8 * F.lane + 512 * q; na[q] = *(const u32x4*)(Yf + o); nb[q] = *(const u32x4*)(Yb + o); nz[q] = *(const u32x4*)(Z + o); } }
    for (int r = gw; r < nrows; r += NGW) {
        float t[32]; float ss = 0.f;
        u32x4 ca[4], cb4[4], cz[4];
#pragma unroll
        for (int q = 0; q < 4; ++q) { ca[q] = na[q]; cb4[q] = nb[q]; cz[q] = nz[q]; }
        if (r + NGW < nrows) {
#pragma unroll
            for (int q = 0; q < 4; ++q) { const size_t o = (size_t)(r + NGW) * DIN + 8 * F.lane + 512 * q; na[q] = *(const u32x4*)(Yf + o); nb[q] = *(const u32x4*)(Yb + o); nz[q] = *(const u32x4*)(Z + o); } }
#pragma unroll
        for (int q = 0; q < 4; ++q) { const u32x4 a = ca[q], bq = cb4[q], z = cz[q];
            const unsigned aa[4] = {a.x, a.y, a.z, a.w}, bb[4] = {bq.x, bq.y, bq.z, bq.w}, zz[4] = {z.x, z.y, z.z, z.w};
#pragma unroll
            for (int i = 0; i < 4; ++i) { const float v0 = (bflo(aa[i]) + bflo(bb[i])) * siluf(bflo(zz[i])), v1 = (bfhi(aa[i]) + bfhi(bb[i])) * siluf(bfhi(zz[i])); t[8 * q + 2 * i] = v0; t[8 * q + 2 * i + 1] = v1; ss += v0 * v0 + v1 * v1; } }
        const float rstd = rsqrtf(wave_sum(ss) * (1.0f / DIN) + EPS);
#pragma unroll
        for (int q = 0; q < 4; ++q) { const int c = 8 * F.lane + 512 * q; const f32x4 w0 = *(const f32x4*)(nw + c), w1 = *(const f32x4*)(nw + c + 4);
            u32x4 o; o.x = pk2(t[8 * q] * rstd * w0[0], t[8 * q + 1] * rstd * w0[1]); o.y = pk2(t[8 * q + 2] * rstd * w0[2], t[8 * q + 3] * rstd * w0[3]);
            o.z = pk2(t[8 * q + 4] * rstd * w1[0], t[8 * q + 5] * rstd * w1[1]); o.w = pk2(t[8 * q + 6] * rstd * w1[2], t[8 * q + 7] * rstd * w1[3]);
            *(u32x4*)(YN + (size_t)r * DIN + c) = o; }
    }
}

DEV void phase_route(const Frame& F, int layer, int ml, bf16_t* V, int nrows) {
    LAS unsigned* lc = (LAS unsigned*)(F.lds + LDS_MISC + 256);
    if (F.tid < 8) lc[F.tid] = 0u;
    __syncthreads();
    const int gw = F.bx * 8 + F.wave, NGW = F.G * 8; const int j = layer / 2;
    const float* w = INP(F, I_NFFN) + (size_t)layer * D; const float* rw = INP(F, I_RW) + (size_t)j * D * NEXP;
    LAS float* rwl = (LAS float*)F.lds;
    for (int q = F.tid; q < D * 2; q += 512) { const int c = q >> 1, hf = q & 1; const int ln = (c & 255) >> 2, ii = c & 3, jq = c >> 8;
        *(LAS f32x4*)(rwl + ((jq * 4 + ii) * 64 + ln) * 8 + hf * 4) = *(const f32x4*)(rw + (size_t)q * 4); }
    __syncthreads();
    TokInfo* tok = (TokInfo*)(F.ws + OFF_TOK);
    constexpr int NS = 3;
    f32x4 ns[NS][4];
#pragma unroll
    for (int k = 0; k < NS; ++k) if (gw + k * NGW < nrows) load_row(F.H + (size_t)(gw + k * NGW) * D, F.lane, ns[k]);
    for (int r0 = gw; r0 < nrows; r0 += NS * NGW) {
#pragma unroll
      for (int k = 0; k < NS; ++k) { const int r = r0 + k * NGW; if (r >= nrows) break;
        f32x4 v[4];
#pragma unroll
        for (int q = 0; q < 4; ++q) v[q] = ns[k][q];
        if (r + NS * NGW < nrows) load_row(F.H + (size_t)(r + NS * NGW) * D, F.lane, ns[k]);
        const float rstd = rsqrtf(sumsq_row(v) * (1.0f / D) + EPS);
        const int vec = vec_of(r);
        normmod_row(v, rstd, w, modp(F, layer, vec, 3), modp(F, layer, vec, 4), F.lane);
#pragma unroll
        for (int jq = 0; jq < 4; ++jq) *(unsigned*)((fp8_t*)V + (size_t)r * D + 4 * F.lane + 256 * jq) = pk4_fp8(v[jq][0] * 8.0f, v[jq][1] * 8.0f, v[jq][2] * 8.0f, v[jq][3] * 8.0f);
        float lg[NEXP];
#pragma unroll
        for (int e = 0; e < NEXP; ++e) lg[e] = 0.f;
#pragma unroll
        for (int jj = 0; jj < 4; ++jj)
#pragma unroll
            for (int i = 0; i < 4; ++i) { const LAS float* rp = rwl + ((jj * 4 + i) * 64 + F.lane) * 8; const f32x4 r0 = *(const LAS f32x4*)rp, r1 = *(const LAS f32x4*)(rp + 4);
#pragma unroll
                for (int e = 0; e < 4; ++e) { lg[e] += v[jj][i] * r0[e]; lg[4 + e] += v[jj][i] * r1[e]; } }
#pragma unroll
        for (int e = 0; e < NEXP; ++e) lg[e] = wave_sum(lg[e]);
        int e0 = 0; float v0 = lg[0];
#pragma unroll
        for (int e = 1; e < NEXP; ++e) if (lg[e] > v0) { v0 = lg[e]; e0 = e; }
        int e1 = -1; float v1 = -3.0e38f;
#pragma unroll
        for (int e = 0; e < NEXP; ++e) if (e != e0 && lg[e] > v1) { v1 = lg[e]; e1 = e; }
        const float g1 = frcp(1.0f + FEXP(v0 - v1)), g0 = 1.0f - g1;
        if (F.lane == 0) { TokInfo ti; ti.s0 = e0; ti.s1 = e1; ti.g0 = g0; ti.g1 = g1; tok[r] = ti; atomicAdd((unsigned*)&lc[e0], 1u); atomicAdd((unsigned*)&lc[e1], 1u); }
      }
    }
    __syncthreads();
    if (F.tid < 8) __hip_atomic_fetch_add(F.ctl + CW_CNT + (ml * 8 + F.tid) * 64, lc[F.tid], RLX_AGENT);
}
DEV void tile_starts(const Frame& F, int ml, int (&ts)[NEXP + 1], unsigned (&cnt)[NEXP]) {
    ts[0] = 0;
#pragma unroll
    for (int e = 0; e < NEXP; ++e) { cnt[e] = __hip_atomic_load(F.ctl + CW_CNT + (ml * 8 + e) * 64, RLX_AGENT); ts[e + 1] = ts[e] + (int)((cnt[e] + 255u) / 256u); }
}
DEV void phase_slots(const Frame& F, int ml, int nrows) {
    int ts[NEXP + 1]; unsigned cnt[NEXP]; tile_starts(F, ml, ts, cnt);
    TokInfo* tok = (TokInfo*)(F.ws + OFF_TOK); int* s2t = (int*)(F.ws + OFF_S2T);
    const int gw = F.bx * 8 + F.wave, NGW = F.G * 8;
    for (int base = gw * 64; base < nrows; base += NGW * 64) {
        const int r = base + F.lane; TokInfo ti = tok[r];
        unsigned long long m0[NEXP], m1[NEXP]; unsigned mycnt = 0;
#pragma unroll
        for (int e = 0; e < NEXP; ++e) { m0[e] = __ballot(ti.s0 == e); m1[e] = __ballot(ti.s1 == e); if (F.lane == e) mycnt = (unsigned)(__builtin_popcountll(m0[e]) + __builtin_popcountll(m1[e])); }
        unsigned b0 = 0;
        if (F.lane < NEXP && mycnt) b0 = __hip_atomic_fetch_add(F.ctl + CW_CUR + (ml * 8 + F.lane) * 64, mycnt, RLX_AGENT);
        const unsigned long long below = (1ull << F.lane) - 1ull; int sl0 = 0, sl1 = 0;
#pragma unroll
        for (int e = 0; e < NEXP; ++e) { const unsigned be = __shfl(b0, e); const int c0 = __builtin_popcountll(m0[e]);
            if (ti.s0 == e) sl0 = ts[e] * 256 + (int)be + __builtin_popcountll(m0[e] & below);
            if (ti.s1 == e) sl1 = ts[e] * 256 + (int)be + c0 + __builtin_popcountll(m1[e] & below); }
        ti.s0 = sl0; ti.s1 = sl1; tok[r] = ti; s2t[sl0] = r; s2t[sl1] = r;
    }
    if (F.bx == 0) { for (int e = 0; e < NEXP; ++e) { const int a = ts[e] * 256 + (int)cnt[e], b2 = ts[e + 1] * 256; for (int s = a + F.tid; s < b2; s += 512) s2t[s] = 0; } }
}
DEV void phase_combine(const Frame& F, int layer, const bf16_t* YS, bool final_) {
    const int NGW = F.G * 8; const int gw = F.bx * 8 + F.wave + (final_ ? 0 : ML); const TokInfo* tok = (const TokInfo*)(F.ws + OFF_TOK);
    const int nrows = final_ ? ML : MT;
    f32x4 nh[4]; u32x2 nya[4], nyb[4]; TokInfo tcur, tnxt;
    tcur.s0 = tcur.s1 = 0; tcur.g0 = tcur.g1 = 0.f; tnxt = tcur;
    if (gw < nrows) { tcur = tok[gw]; load_row(F.H + (size_t)gw * D, F.lane, nh);
#pragma unroll
        for (int jj = 0; jj < 4; ++jj) { const int c = 4 * F.lane + 256 * jj; nya[jj] = *(const u32x2*)(YS + (size_t)tcur.s0 * D + c); nyb[jj] = *(const u32x2*)(YS + (size_t)tcur.s1 * D + c); } }
    if (gw + NGW < nrows) tnxt = tok[gw + NGW];
    for (int r = gw; r < nrows; r += NGW) {
        f32x4 v[4]; u32x2 ya[4], yb[4]; TokInfo ti = tcur;
#pragma unroll
        for (int q = 0; q < 4; ++q) { v[q] = nh[q]; ya[q] = nya[q]; yb[q] = nyb[q]; }
        tcur = tnxt;
        if (r + NGW < nrows) { load_row(F.H + (size_t)(r + NGW) * D, F.lane, nh);
#pragma unroll
            for (int jj = 0; jj < 4; ++jj) { const int c = 4 * F.lane + 256 * jj; nya[jj] = *(const u32x2*)(YS + (size_t)tcur.s0 * D + c); nyb[jj] = *(const u32x2*)(YS + (size_t)tcur.s1 * D + c); } }
        if (r + 2 * NGW < nrows) tnxt = tok[r + 2 * NGW];
        if (MOE_DOWN_FP8) { ti.g0 *= 0.00390625f; ti.g1 *= 0.00390625f; }
        const float* g2 = modp(F, layer, vec_of(r), 5);
#pragma unroll
        for (int jj = 0; jj < 4; ++jj) { const int c = 4 * F.lane + 256 * jj; const u32x2 a = ya[jj], b = yb[jj]; const f32x4 gv = *(const f32x4*)(g2 + c);
            v[jj][0] += gv[0] * (ti.g0 * bflo(a.x) + ti.g1 * bflo(b.x)); v[jj][1] += gv[1] * (ti.g0 * bfhi(a.x) + ti.g1 * bfhi(b.x));
            v[jj][2] += gv[2] * (ti.g0 * bflo(a.y) + ti.g1 * bflo(b.y)); v[jj][3] += gv[3] * (ti.g0 * bfhi(a.y) + ti.g1 * bfhi(b.y)); }
        if (!final_) {
#pragma unroll
            for (int jj = 0; jj < 4; ++jj) *(f32x4*)(F.H + (size_t)r * D + 4 * F.lane + 256 * jj) = v[jj];
        } else {
            const float rstd = rsqrtf(sumsq_row(v) * (1.0f / D) + EPS); const float* fw = INP(F, I_FNORM);
#pragma unroll
            for (int jj = 0; jj < 4; ++jj) { const int c = 4 * F.lane + 256 * jj; *(f32x4*)(OUTP(F) + (size_t)r * D + c) = v[jj] * rstd * *(const f32x4*)(fw + c); }
        }
    }
}

constexpr int PH_PER_PAIR = 17, N_PHASES = 1 + 2 * PH_PER_PAIR;
static_assert((size_t)(DFF / 128) * MC * D * 4 <= al(SZ_WMUP) + SZ_WMDN, "context K-slice partials fit the expert-weight region");
__global__ void __launch_bounds__(512, 2) fwd_kernel(Params prm) {
#ifdef EMU
    unsigned char* lds_raw = emu_lds();
#else
    extern __shared__ __attribute__((aligned(16))) unsigned char lds_raw[];
#endif
    Frame F;
    F.lds = (LAS unsigned char*)lds_raw;
    F.tid = threadIdx.x; F.lane = F.tid & 63; F.wave = RFL(F.tid >> 6); F.G = gridDim.x; F.bx = blockIdx.x;
    F.p = &prm; F.ws = prm.ws; F.ctl = (unsigned*)(prm.ws + OFF_CTL); F.H = (float*)(prm.ws + OFF_H); F.mod = (float*)(prm.ws + OFF_MOD);
    volatile LAS unsigned* misc = (volatile LAS unsigned*)(F.lds + LDS_MISC);
    if (F.tid < 64) misc[F.tid] = 0u;
    __syncthreads();
    XcdBarrier bar; bar.bar = F.ctl + CW_BAR; bar.x = 0; bar.st = misc;
    const int lo = prm.ph_lo, hi = prm.ph_hi;
    if (hi - lo > 1) bar = xcd_barrier_post(F.ctl + CW_BAR, misc);
    int ph = 0;
#ifndef SITE_MASK
#define SITE_MASK 0xFFFFFFFFu
#endif
#ifndef PROBE_REPEAT_SITE
#define PROBE_REPEAT_SITE (-1)
#endif
#define PH_REPS(site) ((PROBE_REPEAT_SITE == (site)) ? 2 : 1)
#ifndef PROBE_TS_MASK
#define PROBE_TS_MASK 0u
#endif
#ifndef PROBE_TS_MULT
#define PROBE_TS_MULT 1
#endif
#ifdef EMU
#define NOWT() 0ull
#else
#define NOWT() ((unsigned long long)__builtin_amdgcn_s_memrealtime())
#endif
    unsigned long long tsacc = 0;
#define PHASE_BEGIN(site) if (((SITE_MASK >> (site)) & 1u) && lo <= ph && ph < hi) { { int _t = threadIdx.x; LAUNDER_V(_t); F.tid = _t; F.lane = _t & 63; int _b = blockIdx.x; LAUNDER_S(_b); F.bx = _b; int _g = gridDim.x; LAUNDER_S(_g); F.G = _g; \
      F.ws = WSP(F); F.ctl = (unsigned*)(F.ws + OFF_CTL); F.H = (float*)(F.ws + OFF_H); F.mod = (float*)(F.ws + OFF_MOD); } \
      const bool _tson = ((PROBE_TS_MASK >> (site)) & 1u) != 0u; unsigned long long _ts0 = 0; if (_tson) _ts0 = NOWT(); \
      for (int _rep = 0; _rep < PH_REPS(site); ++_rep) { if (_rep) __syncthreads();
#define PHASE_END   } if (ph + 1 < hi) xcd_barrier(bar); if (_tson) tsacc += NOWT() - _ts0; } ++ph;
#define B_W (F.ws + OFF_W)
#define B_ACT (F.ws + OFF_ACT)
#define B_P ((bf16_t*)(B_ACT + A_P))
#define B_HID ((bf16_t*)(B_ACT + A_HID))
#define B_U ((bf16_t*)(B_ACT + A_U))
#define B_Z ((bf16_t*)(B_ACT + A_Z))
#define B_XBC ((bf16_t*)(B_ACT + A_XBC))
#define B_DT ((float*)(B_W + W_DT))
#define B_XT ((bf16_t*)(B_ACT + A_XT))
#define B_BROW ((bf16_t*)(B_ACT + A_BROW))
#define B_BT ((bf16_t*)(B_ACT + A_BT))
#define B_CROW ((bf16_t*)(B_ACT + A_CROW))
#define B_CB ((bf16_t*)(B_ACT + A_CB))
#define B_CUM ((float*)(B_ACT + A_CUM))
#define B_WJ ((float*)(B_ACT + A_WJ))
#define B_CF ((float*)(B_ACT + A_CF))
#define B_YF ((bf16_t*)(B_ACT + A_YF))
#define B_YB ((bf16_t*)(B_W + W_YB))
#define B_YN ((bf16_t*)(B_ACT + A_YN))
#define B_V ((bf16_t*)(B_ACT + A_V))
#define B_HIDM ((bf16_t*)(B_ACT + A_HIDM))
#define B_YS ((bf16_t*)(B_ACT + A_YS))
#define B_PART ((float*)(B_W + W_MUP))

    PHASE_BEGIN(0) phase_mod(F); convert_even(F, 0); PHASE_END

    for (int lp = 0; lp < 2; ++lp) {
        const int le = 2 * lp, lod = 2 * lp + 1;
        PHASE_BEGIN(1) phase_poolprep(F, le, B_P, lp == 1, B_YS); PHASE_END
        PHASE_BEGIN(2) { PolPool S; S.G = F.G; S.c = F.bx; S.K = 256; S.lda = D; S.ldb = 256; S.P = B_P; S.W = (const bf16_t*)(B_W + W_POOL); S.src = mksrc(F); S.layer = le; S.scale = INP(F, I_POOLS) + (size_t)lp * D; S.npan = ML / 256; S.PART = B_PART;
                      ge::gemm_phase(F.lds, S, F.tid); } PHASE_END
        PHASE_BEGIN(3) { CtxFix fx; fx.PART = B_PART; fx.S = 2; fx.layer = le; fx.which = 2; fx.scale = INP(F, I_POOLS) + (size_t)lp * D; fx.from_input = le == 0; fx.ascale = 1.0f; phase_norm(F, le, 3, B_P, false, fx); } PHASE_END
        PHASE_BEGIN(4) { PolUp<false> S; S.G = F.G; S.c = F.bx; S.K = D; S.lda = D; S.ldb = D; S.A = B_P; S.W = (const bf16_t*)(B_W + W_UP); S.HID = B_HID; S.ldh = DFF; S.nq = DFF / 128; S.nM = NPAN; S.s2t = nullptr;
                      ge::gemm_phase(F.lds, S, F.tid);
                      Frame F2 = F; if (idle_subgrid(F2, NPAN * S.nq)) convert_ssd(F2, lp); } PHASE_END
        PHASE_BEGIN(5) { PolResid<FFN_DOWN_FP8 != 0> S; S.G = F.G; S.c = F.bx; S.K = DFF; S.lda = DFF; S.ldb = DFF; S.A = B_HID; S.W = (const bf16_t*)(B_W + W_DN); S.src = mksrc(F); S.layer = le; S.which = 5; S.npan = ML / 256; S.nsl = DFF / (FFN_DOWN_FP8 ? 256 : 128); S.PART = B_PART;
                      ge::gemm_phase(F.lds, S, F.tid); } PHASE_END

        PHASE_BEGIN(6) { CtxFix fx; fx.PART = B_PART; fx.S = DFF / (FFN_DOWN_FP8 ? 256 : 128); fx.layer = le; fx.which = 5; fx.scale = nullptr; fx.from_input = false; fx.ascale = FFN_DOWN_FP8 ? 0.00390625f : 1.0f; phase_norm(F, lod, 0, B_U, false, fx); } PHASE_END
        PHASE_BEGIN(7) { PolInProj S; S.G = F.G; S.c = F.bx; S.K = D; S.lda = D; S.ldb = D; S.A = B_U; S.W = (const bf16_t*)(B_W + W_IN); S.Z = B_Z; S.XBC = B_XBC; S.DT = B_DT;
                      ge::gemm_phase(F.lds, S, F.tid); } PHASE_END
        PHASE_BEGIN(8) phase_conv(F, lp, B_XBC, B_XT, B_BROW, B_BT, B_CROW); PHASE_END
        PHASE_BEGIN(9) phase_cb(F, B_BROW, B_CROW, B_CB); { Frame F2 = F; if (idle_subgrid(F2, NB * NG * NCH)) phase_tables(F2, lp, B_DT, B_CUM, B_WJ, B_CF); } PHASE_END
        PHASE_BEGIN(10) phase_scan(F, lp, B_XT, B_BT, B_CROW, B_CB, B_DT, B_CUM, B_WJ, B_CF, B_YF, B_YB); PHASE_END
        PHASE_BEGIN(11) phase_gate(F, lp, B_YF, B_YB, B_Z, B_YN, lp == 1 ? ML : MT); PHASE_END
        PHASE_BEGIN(12) { PolResid<false> S; S.G = F.G; S.c = F.bx; S.K = DIN; S.lda = DIN; S.ldb = DIN; S.A = B_YN; S.W = (const bf16_t*)(B_W + W_OUT); S.src = mksrc(F); S.layer = lod; S.which = 2; S.npan = lp == 1 ? ML / 256 : NPAN; S.nsl = 0; S.PART = nullptr;
                      ge::gemm_phase(F.lds, S, F.tid);
                      Frame F2 = F; if (idle_subgrid(F2, S.npan * 4)) convert_moe(F2, lp, 0, MOE_UP_EARLY, true); } PHASE_END
        PHASE_BEGIN(13) phase_route(F, lod, lp, B_V, lp == 1 ? ML : MT); convert_moe(F, lp, MOE_UP_EARLY, NEXP, false); PHASE_END
        PHASE_BEGIN(14) phase_slots(F, lp, lp == 1 ? ML : MT); PHASE_END
        PHASE_BEGIN(15) { int ts[NEXP + 1]; unsigned cnt[NEXP]; tile_starts(F, lp, ts, cnt);
                      PolUp<true> S; S.G = F.G; S.c = F.bx; S.K = D; S.lda = D; S.ldb = D; S.A = B_V; S.W = (const bf16_t*)(B_W + W_MUP); S.HID = B_HIDM; S.ldh = DFFE; S.nq = DFFE / 128; S.nM = ts[NEXP];
                      S.s2t = (const int*)(F.ws + OFF_S2T);
#pragma unroll
                      for (int e = 0; e <= NEXP; ++e) S.tstart[e] = ts[e];
                      ge::gemm_phase(F.lds, S, F.tid); } PHASE_END
        PHASE_BEGIN(16) { int ts[NEXP + 1]; unsigned cnt[NEXP]; tile_starts(F, lp, ts, cnt);
                      PolMoeDown S; S.G = F.G; S.c = F.bx; S.K = DFFE; S.lda = DFFE; S.ldb = DFFE; S.A = B_HIDM; S.W = (const bf16_t*)(B_W + W_MDN); S.YS = B_YS; S.nM = ts[NEXP];
#pragma unroll
                      for (int e = 0; e <= NEXP; ++e) S.tstart[e] = ts[e];
                      ge::gemm_phase(F.lds, S, F.tid);
                      if (lp == 0) { Frame F2 = F; if (idle_subgrid(F2, S.nM * 4)) convert_even(F2, 1); } } PHASE_END
        PHASE_BEGIN(17) phase_combine(F, lod, B_YS, lp == 1); PHASE_END
    }
#undef PHASE_BEGIN
#undef PHASE_END
    if (PROBE_TS_MASK != 0u && blockIdx.x == 0) { const unsigned long long t1 = NOWT(), wt = tsacc * (unsigned long long)PROBE_TS_MULT; while (NOWT() - t1 < wt) { } }
}

extern "C" void kernel_launch(void* const* d_in, const int* in_sizes, int n_in, void* d_out, int out_size, void* d_ws, size_t ws_size, hipStream_t stream) {
    static int grid = 0;
    if (grid == 0) {
        if (n_in != 26 || ws_size < WS_NEED) { fprintf(stderr, "kernel_launch: need 26 inputs and %zu bytes of workspace (got %d, %zu)\n", (size_t)WS_NEED, n_in, ws_size); grid = -1; return; }
        int dev = 0, cus = 0, per_cu = 0;
        if (hipGetDevice(&dev) != hipSuccess || hipDeviceGetAttribute(&cus, hipDeviceAttributeMultiprocessorCount, dev) != hipSuccess) { grid = -1; return; }
        if (hipFuncSetAttribute((const void*)fwd_kernel, hipFuncAttributeMaxDynamicSharedMemorySize, LDS_BYTES) != hipSuccess) { grid = -1; return; }
        if (hipOccupancyMaxActiveBlocksPerMultiprocessor(&per_cu, (const void*)fwd_kernel, 512, LDS_BYTES) != hipSuccess || per_cu < 1) { fprintf(stderr, "kernel_launch: occupancy query says %d\n", per_cu); }
        (void)hipGetLastError();
        grid = cus;
    }
    if (grid < 0) return;
    (void)in_sizes; (void)out_size;
    if (hipMemsetAsync((char*)d_ws + OFF_CTL, 0, CTL_BYTES, stream) != hipSuccess) return;
    Params p{};
    for (int i = 0; i < 26; ++i) p.in[i] = (const float*)d_in[i];
    p.out = (float*)d_out; p.ws = (unsigned char*)d_ws;
    if (N_LAUNCH_MODE == 1) { p.ph_lo = 0; p.ph_hi = N_PHASES; hipLaunchKernelGGL(fwd_kernel, dim3(grid), dim3(512), LDS_BYTES, stream, p); }
    else for (int ph = 0; ph < N_PHASES; ++ph) { p.ph_lo = ph; p.ph_hi = ph + 1; hipLaunchKernelGGL(fwd_kernel, dim3(grid), dim3(512), LDS_BYTES, stream, p); }
}
```

```cpp
#ifndef EMU
#include <hip/hip_runtime.h>
#endif
#include <cstdio>
#include <cstdint>

#ifndef CFG_SEQ
#define CFG_SEQ 16384
#endif
#ifndef CFG_DFF
#define CFG_DFF 2816
#endif
#ifndef CFG_DFFE
#define CFG_DFFE 3584
#endif
#ifndef MOE_DOWN_FP8
#define MOE_DOWN_FP8 1
#endif
#ifndef FFN_DOWN_FP8
#define FFN_DOWN_FP8 1
#endif
#ifndef N_LAUNCH_MODE
#define N_LAUNCH_MODE 1
#endif

#ifdef EMU
#define LAS
#define DEV inline
#define WAITV(n) ((void)0)
#define WAITL(n) ((void)0)
#define SBAR() emu_wg_sync()
#define SCHED() ((void)0)
#define SETPRIO(x) ((void)0)
#define MFMA16(a, b, c) emu_mfma16(a, b, c)
#define GLDS16(g, l) emu_glds16((const void*)(g), (void*)(l))
#define GLDS4(g, l) emu_glds4((const void*)(g), (void*)(l))
#define MFMA8(a, b, c) emu_mfma8(a, b, c)
#define RFL(x) emu_rfl(x)
#define MEMFENCE() ((void)0)
#define WSYNC() emu_wave_sync()
#define LDSBAR() emu_wg_sync()
#define LAUNDER_V(x) ((void)0)
#define SLEEP1() emu_yield()
#define MY_XCC_ID() ((unsigned)(blockIdx.x & 7u))
#define FENCE_REL() __atomic_thread_fence(__ATOMIC_SEQ_CST)
#define FENCE_ACQ() __atomic_thread_fence(__ATOMIC_SEQ_CST)
#define FEXP(x) expf(x)
#define RLX_AGENT __ATOMIC_RELAXED, 4
#else
#define LAS __attribute__((address_space(3)))
#define DEV __device__ __forceinline__
#define WAITV(n) asm volatile("s_waitcnt vmcnt(" #n ")" ::: "memory")
#define WAITL(n) asm volatile("s_waitcnt lgkmcnt(" #n ")" ::: "memory")
#define SBAR() __builtin_amdgcn_s_barrier()
#define SCHED() __builtin_amdgcn_sched_barrier(0)
#define SETPRIO(x) __builtin_amdgcn_s_setprio(x)
#define MFMA16(a, b, c) __builtin_amdgcn_mfma_f32_16x16x32_bf16(a, b, c, 0, 0, 0)
#define GLDS16(g, l) __builtin_amdgcn_global_load_lds((const unsigned*)(g), (LAS unsigned*)(l), 16, 0, 0)
#define GLDS4(g, l) __builtin_amdgcn_global_load_lds((const unsigned*)(g), (LAS unsigned*)(l), 4, 0, 0)
#define MFMA8(a, b, c) __builtin_amdgcn_mfma_scale_f32_16x16x128_f8f6f4(a, b, c, 0, 0, 0, 0x7f7f7f7f, 0, 0x7f7f7f7f)
#define RFL(x) __builtin_amdgcn_readfirstlane(x)
#define MEMFENCE() asm volatile("" ::: "memory")
#define LDSBAR() do { asm volatile("s_waitcnt lgkmcnt(0)" ::: "memory"); __builtin_amdgcn_s_barrier(); asm volatile("" ::: "memory"); } while (0)
#define WSYNC() asm volatile("s_waitcnt lgkmcnt(0)" ::: "memory")
#define SLEEP1() __builtin_amdgcn_s_sleep(1)
#define MY_XCC_ID() ((unsigned)__builtin_amdgcn_s_getreg((3 << 11) | 20) & 0xFu)
#define FENCE_REL() __builtin_amdgcn_fence(__ATOMIC_RELEASE, "agent")
#define FENCE_ACQ() __builtin_amdgcn_fence(__ATOMIC_ACQUIRE, "agent")
#define FEXP(x) __expf(x)
#define RLX_AGENT __ATOMIC_RELAXED, __HIP_MEMORY_SCOPE_AGENT
#define LAUNDER_V(x) asm volatile("" : "+v"(x))
#endif

typedef unsigned short bf16_t;
typedef short bf16x8 __attribute__((ext_vector_type(8)));
typedef float f32x4 __attribute__((ext_vector_type(4)));
typedef float f32x2 __attribute__((ext_vector_type(2)));
typedef unsigned u32x4 __attribute__((ext_vector_type(4)));
typedef unsigned u32x2 __attribute__((ext_vector_type(2)));
typedef int i32x8 __attribute__((ext_vector_type(8)));
typedef int i32x4 __attribute__((ext_vector_type(4)));
typedef unsigned char fp8_t;

constexpr int D = 1024, NB = 2, SEQ = CFG_SEQ, CTXL = 256, DEPTH = 4;
constexpr int ML = NB * SEQ, MC = NB * CTXL, MT = ML + MC, NPAN = MT / 256;
constexpr int DFF = CFG_DFF, DFFE = CFG_DFFE, NEXP = 8;
constexpr int DIN = 2048, NH = 32, HD = 64, NG = 4, DS = 128, CONVD = 3072, NPROJ = 5184, NPROJP = 5376, BCD = 512;
constexpr int TV = CTXL + SEQ, NCH = TV / 128;
constexpr int GRIDW = 64;
constexpr float EPS = 1e-6f;
constexpr int NSLOT_TILES = (2 * MT) / 256 + NEXP, NSLOT = NSLOT_TILES * 256;
static_assert(SEQ % 128 == 0 && ML % 256 == 0 && DFF % 128 == 0 && DFFE % 128 == 0 && DFF >= 256 && DFFE >= 256, "shape constraints");

constexpr size_t MiB = 1u << 20;
constexpr size_t al(size_t x) { return (x + 4095) & ~(size_t)4095; }
constexpr size_t OFF_CTL = 0, CTL_BYTES = 1 * MiB;
constexpr size_t OFF_MOD = 1 * MiB;
constexpr size_t OFF_TOK = 2 * MiB;
constexpr size_t OFF_S2T = 3 * MiB;
constexpr size_t OFF_H = 4 * MiB, SZ_H = (size_t)MT * D * 4;
constexpr size_t OFF_W = OFF_H + al(SZ_H);
constexpr size_t W_POOL = 0, SZ_WPOOL = (size_t)4 * 256 * 256 * 2;
constexpr size_t W_UP = al(SZ_WPOOL), SZ_WUP = (size_t)2 * DFF * D * 2;
constexpr size_t W_DN = W_UP + al(SZ_WUP), SZ_WDN = (size_t)D * DFF * 2;
constexpr size_t SZ_WEVEN = W_DN + al(SZ_WDN);
constexpr size_t W_IN = SZ_WEVEN, SZ_WIN = (size_t)NPROJP * D * 2;
constexpr size_t W_OUT = W_IN + al(SZ_WIN), SZ_WOUT = (size_t)D * DIN * 2;
constexpr size_t W_DT = W_OUT + al(SZ_WOUT), SZ_DT = (size_t)NB * 2 * NH * TV * 4;
constexpr size_t W_MUP = W_DT + al(SZ_DT), SZ_WMUP = (size_t)NEXP * 2 * DFFE * D;
constexpr size_t W_MDN = W_MUP + al(SZ_WMUP), SZ_WMDN = (size_t)NEXP * D * DFFE * (MOE_DOWN_FP8 ? 1 : 2);
constexpr size_t W_YB = W_MUP, SZ_Y = (size_t)MT * DIN * 2;
constexpr size_t SZ_WODD_A = W_MDN + al(SZ_WMDN), SZ_WODD_B = W_YB + al(SZ_Y);
constexpr size_t mx(size_t a, size_t b) { return a > b ? a : b; }
constexpr size_t SZ_W = mx(SZ_WEVEN, mx(SZ_WODD_A, SZ_WODD_B));
constexpr size_t OFF_ACT = OFF_W + SZ_W;
constexpr size_t A_P = 0, SZ_ACT1 = (size_t)MT * D * 2;
constexpr size_t A_HID = al(SZ_ACT1), SZ_HID = (size_t)MT * DFF * 2;
constexpr size_t SZ_AEVEN = A_HID + al(SZ_HID);
constexpr size_t A_Z = 0;
constexpr size_t A_XBC = al(SZ_Y), SZ_XBC = (size_t)MT * CONVD * 2;
constexpr size_t A_YF = A_XBC;
constexpr size_t A_CB = A_XBC + al(SZ_Y), SZ_CB = (size_t)NB * NG * NCH * 128 * 128 * 2;
static_assert(al(SZ_Y) + SZ_CB <= SZ_XBC, "CB fits behind Yf inside the XBC region");
constexpr size_t A_XT = A_XBC + al(SZ_XBC), SZ_XT = (size_t)NB * DIN * TV * 2;
constexpr size_t A_U = A_XT, A_YN = A_XT;
constexpr size_t A_BROW = A_XT + al(SZ_XT), SZ_BC = (size_t)MT * BCD * 2;
constexpr size_t A_BT = A_BROW + al(SZ_BC);
constexpr size_t A_CROW = A_BT + al(SZ_BC);
constexpr size_t A_CUM = A_CROW + al(SZ_BC);
constexpr size_t A_WJ = A_CUM + al(SZ_DT);
constexpr size_t A_CF = A_WJ + al(SZ_DT);
constexpr size_t SZ_ASSD = A_CF + al(SZ_DT);
constexpr size_t A_V = 0;
constexpr size_t A_HIDM = al(SZ_ACT1), SZ_HIDM = (size_t)NSLOT * DFFE * 2;
constexpr size_t A_YS = A_HIDM + al(SZ_HIDM), SZ_YS = (size_t)NSLOT * D * 2;
constexpr size_t SZ_AMOE = A_YS + al(SZ_YS);
constexpr size_t SZ_ACT = mx(SZ_AEVEN, mx(SZ_ASSD, SZ_AMOE));
constexpr size_t WS_NEED = OFF_ACT + SZ_ACT;

constexpr int CW_BAR = 4096;
constexpr int CW_CNT = 16384;
constexpr int CW_CUR = 16384 + 2 * 8 * 64;

DEV unsigned f2bf(float f) { unsigned u = __builtin_bit_cast(unsigned, f); return (u + 0x7fffu + ((u >> 16) & 1u)) >> 16; }
#ifndef EMU
typedef __bf16 bf16x2n __attribute__((ext_vector_type(2)));
#endif
DEV unsigned pk2(float lo, float hi) {
#ifdef EMU
    return f2bf(lo) | (f2bf(hi) << 16);
#else
    f32x2 v = {lo, hi}; bf16x2n b = __builtin_convertvector(v, bf16x2n); return __builtin_bit_cast(unsigned, b);
#endif
}
DEV unsigned pk4_fp8(float a, float b, float c, float d) {
#ifdef EMU
    return emu_f2fp8(a) | (emu_f2fp8(b) << 8) | (emu_f2fp8(c) << 16) | (emu_f2fp8(d) << 24);
#else
    unsigned w = 0; w = __builtin_amdgcn_cvt_pk_fp8_f32(a, b, w, false); w = __builtin_amdgcn_cvt_pk_fp8_f32(c, d, w, true); return w;
#endif
}
DEV float bf2f(unsigned b) { return __builtin_bit_cast(float, b << 16); }
DEV float bflo(unsigned w) { return __builtin_bit_cast(float, w << 16); }
DEV float bfhi(unsigned w) { return __builtin_bit_cast(float, w & 0xffff0000u); }
#ifdef EMU
DEV float frcp(float x) { return 1.0f / x; }
#else
DEV float frcp(float x) { return __builtin_amdgcn_rcpf(x); }
#endif
#ifdef EMU
DEV float fexp2(float x) { return exp2f(x); }
#else
DEV float fexp2(float x) { return __builtin_amdgcn_exp2f(x); }
#endif
DEV float siluf(float x) { return x * frcp(1.0f + FEXP(-x)); }
#ifdef EMU
DEV float flog2(float x) { return log2f(x); }
#else
DEV float flog2(float x) { return __builtin_amdgcn_logf(x); }
#endif
DEV float softplusf(float x) { if (x > 20.f) return x; const float e = FEXP(x); return e < 0.0625f ? e * (1.0f - e * (0.5f - e * (0.33333334f - e * (0.25f - e * 0.2f)))) : flog2(1.0f + e) * 0.6931471806f; }
DEV float wave_sum(float v) {
#ifdef EMU
#pragma unroll
    for (int o = 1; o < 64; o <<= 1) v += __shfl_xor(v, o);
    return v;
#else
#define WS_DPP(x_, ctrl_) __builtin_bit_cast(float, __builtin_amdgcn_update_dpp(0, __builtin_bit_cast(int, (x_)), (ctrl_), 0xf, 0xf, false))
    v += WS_DPP(v, 0xB1);
    v += WS_DPP(v, 0x4E);
    v += WS_DPP(v, 0x141);
    v += WS_DPP(v, 0x140);
#undef WS_DPP
    const int vi = __builtin_bit_cast(int, v);
    const float s0 = __builtin_bit_cast(float, __builtin_amdgcn_readlane(vi, 0)), s1 = __builtin_bit_cast(float, __builtin_amdgcn_readlane(vi, 16)),
                s2 = __builtin_bit_cast(float, __builtin_amdgcn_readlane(vi, 32)), s3 = __builtin_bit_cast(float, __builtin_amdgcn_readlane(vi, 48));
    return (s0 + s1) + (s2 + s3);
#endif
}
DEV int vec_of(int r) { return r < ML ? (r / SEQ) : 2; }
DEV int frag_off(int r, int c) { return ((r >> 4) * 4 + (c >> 5)) * 512 + ((c >> 3) & 3) * 128 + (r & 15) * 8 + (c & 7); }
DEV int row_of(int b, int tv) { return tv < CTXL ? ML + b * CTXL + tv : b * SEQ + (tv - CTXL); }

#define XB_TMO      128
#define XB_XCNT(j)  (256  + 64 * (j))
#define XB_XSUB(j)  (1280 + 64 * (j))
#define XB_XGEN(j)  (2304 + 64 * (j))
#define XB_TOP      3328
#define XB_TOPGEN   3392
#define XCD_BAR_WORDS 3456
#define XB_SPIN_CAP (1u << 22)
DEV unsigned xb_ld(unsigned* p)              { return __hip_atomic_load(p, RLX_AGENT); }
DEV unsigned xb_add(unsigned* p, unsigned v) { return __hip_atomic_fetch_add(p, v, RLX_AGENT); }
#define XB_SPIN(cond, bar) do { unsigned _sp = 0; while (cond) { SLEEP1(); \
    if ((++_sp & 255u) == 0u) { if (xb_ld(&(bar)[XB_TMO])) break; if (_sp > XB_SPIN_CAP) { atomicAdd(&(bar)[XB_TMO], 1u); break; } } } } while (0)
struct XcdBarrier { unsigned* bar; unsigned x; volatile LAS unsigned* st; };
DEV XcdBarrier xcd_barrier_post(unsigned* bar, volatile LAS unsigned* st) {
    XcdBarrier b; b.bar = bar; b.x = MY_XCC_ID(); b.st = st;
    if (threadIdx.x == 0) (void)xb_add(&bar[XB_XCNT(b.x)], 1u);
    return b;
}
DEV void xcd_barrier_complete(unsigned* bar, unsigned x, unsigned& nloc, unsigned& nx) {
    const unsigned G = gridDim.x;
    unsigned sum, cnt, mine, sp = 0u;
    for (;;) {
        sum = 0u; cnt = 0u; mine = 0u;
#pragma unroll
        for (unsigned j = 0; j < 16; ++j) { const unsigned c = xb_ld(&bar[XB_XCNT(j)]); sum += c; cnt += (c > 0u) ? 1u : 0u; mine = (j == x) ? c : mine; }
        if (sum == G) break;
        SLEEP1();
        if ((++sp & 255u) == 0u) { if (xb_ld(&bar[XB_TMO])) break; if (sp > XB_SPIN_CAP) { atomicAdd(&bar[XB_TMO], 1u); break; } }
    }
    nloc = mine > 0u ? mine : 1u; nx = cnt > 0u ? cnt : 1u;
}
DEV void xcd_barrier(const XcdBarrier& b) {
    WAITV(0);
    __syncthreads();
    if (threadIdx.x == 0) {
        unsigned* bar = b.bar;
#ifndef EMU
        __builtin_amdgcn_s_waitcnt(0);
#endif
        unsigned nloc = b.st[0], nx = b.st[1];
        if (nloc == 0u) { xcd_barrier_complete(bar, b.x, nloc, nx); b.st[0] = nloc; b.st[1] = nx; }
        const unsigned old = xb_add(&bar[XB_XSUB(b.x)], 1u);
        const unsigned gen = old / nloc;
        if (old + 1u == (gen + 1u) * nloc) {
            FENCE_REL();
            WAITV(0);
            const unsigned og = xb_add(&bar[XB_TOP], 1u);
            const unsigned tg = og / nx;
            if (og + 1u == (tg + 1u) * nx) xb_add(&bar[XB_TOPGEN], 1u);
            else XB_SPIN(xb_ld(&bar[XB_TOPGEN]) == tg, bar);
            FENCE_ACQ();
            xb_add(&bar[XB_XGEN(b.x)], 1u);
            WAITV(0);
        } else {
            XB_SPIN(xb_ld(&bar[XB_XGEN(b.x)]) == gen, bar);
            FENCE_ACQ();
            WAITV(0);
        }
    }
    __syncthreads();
}

namespace ge {
constexpr int BM = 256, BK = 64, HALF = 128, HTB = HALF * BK * 2, STAGE_BYTES = 8 * HTB, NXCD = 8, WGM = 8;
DEV int lds_byte(int r, int c) { const int st = (r >> 4) * 2 + (c >> 5), rr = r & 15, cc = c & 31, ob = rr * 64 + cc * 2; return st * 1024 + (ob ^ (((ob >> 9) & 1) << 5)); }
DEV void stage_rc(int b, int& R, int& C) { const int st = b / 1024, sb = b % 1024, swz = sb ^ (((sb >> 9) & 1) << 5); R = (st >> 1) * 16 + swz / 64; C = (st & 1) * 32 + (swz % 64) / 2; }
DEV int perm32(int rho) { const int n = rho >> 4, i = rho & 15; return 8 * (i >> 2) + 4 * n + (i & 3); }
struct Unit { int pm, pn; };
DEV bool static_next(int nM, int nN, int G, int c, int i, Unit& u) {
    const int nwg = nM * nN; const long L = (long)i * G + c; if (L >= nwg) return false;
    int wgid = (int)L; { const int q = nwg / NXCD, r = nwg % NXCD, xcd = wgid % NXCD, off = wgid / NXCD; wgid = (xcd < r ? xcd * (q + 1) : r * (q + 1) + (xcd - r) * q) + off; }
    const int nig = WGM * nN, gid = wgid / nig, fm = gid * WGM, gsz = (nM - fm) < WGM ? (nM - fm) : WGM;
    u.pm = fm + ((wgid % nig) % gsz); u.pn = (wgid % nig) / gsz; return true;
}
template <class P, bool SP2 = true>
DEV void gemm_phase(LAS unsigned char* lds, const P& S, const int tid) {
    const int wid = RFL(tid >> 6), lane = tid & 63, wr = wid >> 2, wc = wid & 3, fr = lane & 15, fq = lane >> 4;
    const int K = S.K; int nt = K * P::ES / (BK * 2);
    unsigned voffB[2]; int RA[2], CA2[2];
#pragma unroll
    for (int i = 0; i < 2; ++i) { int R, C; stage_rc(tid * 16 + i * 8192, R, C); const int Rb = P::PERM ? ((R & ~31) + perm32(R & 31)) : R;
        RA[i] = R; CA2[i] = C * 2; voffB[i] = (unsigned)(Rb * S.ldb) * (unsigned)P::ES + (unsigned)(C * 2); }
    const size_t kstep = (size_t)(BK * 2);
    const size_t hstepB = (size_t)HALF * S.ldb * P::ES;
    const unsigned ldsw = (unsigned)wid * 1024u;
    const int aoff = lds_byte(wr * 64 + fr, fq * 8), boff = lds_byte(wc * 32 + fr, fq * 8);
#define GE_SA(b, h) (((b) * 2 + (h)) * HTB)
#define GE_SB(b, h) ((4 + (b) * 2 + (h)) * HTB)
#define GE_STAGEB(bufoff, gbase) do { _Pragma("unroll") for (int _i = 0; _i < 2; ++_i) { unsigned _o = voffB[_i]; LAUNDER_V(_o); \
        GLDS16((const char*)(gbase) + _o, lds + (bufoff) + ldsw + _i * 8192); } } while (0)
#define GE_STAGEA(bufoff, gbase, h) do { _Pragma("unroll") for (int _i = 0; _i < 2; ++_i) { unsigned _o = oA[h][_i]; LAUNDER_V(_o); \
        GLDS16((const char*)(gbase) + _o, lds + (bufoff) + ldsw + _i * 8192); } } while (0)
#define GE_LD1(p_) __builtin_shufflevector(*(const LAS i32x4*)(p_), *(const LAS i32x4*)((p_) + 1024), 0, 1, 2, 3, 4, 5, 6, 7)
#define GE_LDA(dst, b, h) do { _Pragma("unroll") for (int m = 0; m < 4; ++m) dst[m] = GE_LD1(lds + GE_SA(b, h) + aoff + m * 2048); } while (0)
#define GE_LDB(dst, b, h) do { _Pragma("unroll") for (int n = 0; n < 2; ++n) dst[n] = GE_LD1(lds + GE_SB(b, h) + boff + n * 2048); } while (0)
#define GE_LO(x) __builtin_bit_cast(bf16x8, __builtin_shufflevector(x, x, 0, 1, 2, 3))
#define GE_HI(x) __builtin_bit_cast(bf16x8, __builtin_shufflevector(x, x, 4, 5, 6, 7))
#define GE_MMA(ai, bj, At, Bt) do { SETPRIO(1); _Pragma("unroll") for (int m = 0; m < 4; ++m) _Pragma("unroll") for (int n = 0; n < 2; ++n) { \
        if constexpr (P::FP8) acc[ai][bj][m][n] = MFMA8(Bt[n], At[m], acc[ai][bj][m][n]);     \
        else { acc[ai][bj][m][n] = MFMA16(GE_LO(Bt[n]), GE_LO(At[m]), acc[ai][bj][m][n]); acc[ai][bj][m][n] = MFMA16(GE_HI(Bt[n]), GE_HI(At[m]), acc[ai][bj][m][n]); } } SETPRIO(0); } while (0)
    Unit cur, nxt; int ui = 0;
    if (!S.next(0, cur)) return;
    f32x4 acc[2][2][4][2];
#pragma unroll
    for (int a = 0; a < 2; ++a)
#pragma unroll
        for (int b = 0; b < 2; ++b)
#pragma unroll
            for (int m = 0; m < 4; ++m)
#pragma unroll
                for (int n = 0; n < 2; ++n) acc[a][b][m][n] = (f32x4){0.f, 0.f, 0.f, 0.f};
    unsigned oA[2][2];
#pragma unroll
    for (int h = 0; h < 2; ++h)
#pragma unroll
        for (int i = 0; i < 2; ++i) {
            if constexpr (P::GATHER) oA[h][i] = (unsigned)S.gather_row(cur, h * HALF + RA[i]) * (unsigned)(S.lda * P::ES) + (unsigned)CA2[i];
            else oA[h][i] = (unsigned)((h * HALF + RA[i]) * S.lda) * (unsigned)P::ES + (unsigned)CA2[i];
            }
    const char* cA = S.a_base(cur); const char* cB = S.b_base(cur);
    if constexpr (SP2) {
        GE_STAGEB(GE_SB(0, 0), cB); GE_STAGEB(GE_SB(0, 1), cB + hstepB); GE_STAGEA(GE_SA(0, 0), cA, 0); GE_STAGEA(GE_SA(0, 1), cA, 1);
        if (wr == 1) SBAR();
        WAITV(2); SBAR();
        GE_STAGEB(GE_SB(1, 0), cB + kstep); GE_STAGEA(GE_SA(1, 0), cA + kstep, 0); GE_STAGEB(GE_SB(1, 1), cB + hstepB + kstep);
        WAITV(6); SBAR();
    } else {
    GE_STAGEB(GE_SB(0, 0), cB); GE_STAGEA(GE_SA(0, 0), cA, 0); GE_STAGEB(GE_SB(0, 1), cB + hstepB); GE_STAGEA(GE_SA(0, 1), cA, 1);
    if (wr == 1) SBAR();
    WAITV(4); SBAR();
    GE_STAGEB(GE_SB(1, 0), cB + kstep); GE_STAGEA(GE_SA(1, 0), cA + kstep, 0); GE_STAGEB(GE_SB(1, 1), cB + hstepB + kstep);
    WAITV(6); SBAR();
    }
    for (;;) {
        if constexpr (P::VARK) nt = S.unit_nt(cur);
        const bool has_next = S.next(ui + 1, nxt);
        const char* nA = has_next ? S.a_base(nxt) : cA; const char* nB = has_next ? S.b_base(nxt) : cB;
        for (int t = 0; t < nt; t += 2) {
            const bool last = (t == nt - 2);
            const char* a1 = cA + (size_t)(t + 1) * kstep;
            const char* a2 = last ? nA : cA + (size_t)(t + 2) * kstep; const char* b2 = last ? nB : cB + (size_t)(t + 2) * kstep;
            const char* a3 = a2 + kstep; const char* b3 = b2 + kstep;
            i32x8 At[4], B0[2], B1[2];
            if constexpr (SP2) {
            GE_LDB(B0, 0, 0); GE_LDB(B1, 0, 1); SCHED(); GE_LDA(At, 0, 0); GE_STAGEA(GE_SA(1, 1), a1, 1);
            WAITV(8); WAITL(0); SBAR(); GE_MMA(0, 0, At, B0); GE_MMA(0, 1, At, B1); SBAR(); SCHED();
            if constexpr (P::GATHER) { if (last && has_next) {
#pragma unroll
                for (int i = 0; i < 2; ++i) { int R2, C2; stage_rc(tid * 16 + i * 8192, R2, C2);
#pragma unroll
                    for (int h = 0; h < 2; ++h) oA[h][i] = (unsigned)S.gather_row(nxt, h * HALF + R2) * (unsigned)(S.lda * P::ES) + (unsigned)(C2 * 2); } } }
            GE_LDA(At, 0, 1); GE_STAGEB(GE_SB(0, 0), b2); GE_STAGEB(GE_SB(0, 1), b2 + hstepB); GE_STAGEA(GE_SA(0, 0), a2, 0);
            WAITV(8); WAITL(0); SBAR(); GE_MMA(1, 0, At, B0); GE_MMA(1, 1, At, B1); SBAR(); SCHED();
            GE_LDB(B0, 1, 0); GE_LDB(B1, 1, 1); SCHED(); GE_LDA(At, 1, 0); GE_STAGEA(GE_SA(0, 1), a2, 1);
            WAITV(8); WAITL(0); SBAR(); GE_MMA(0, 0, At, B0); GE_MMA(0, 1, At, B1); SBAR(); SCHED();
            GE_LDA(At, 1, 1); GE_STAGEB(GE_SB(1, 0), b3); GE_STAGEB(GE_SB(1, 1), b3 + hstepB); GE_STAGEA(GE_SA(1, 0), a3, 0);
            WAITV(8); WAITL(0); SBAR(); GE_MMA(1, 0, At, B0); GE_MMA(1, 1, At, B1); SBAR(); SCHED();
            } else {
            GE_LDB(B0, 0, 0); SCHED(); GE_LDA(At, 0, 0); GE_STAGEA(GE_SA(1, 1), a1, 1);
            WAITL(8); SBAR(); WAITL(0); GE_MMA(0, 0, At, B0); SBAR(); SCHED();
            if constexpr (P::GATHER) { if (last && has_next) {
#pragma unroll
                for (int i = 0; i < 2; ++i) { int R2, C2; stage_rc(tid * 16 + i * 8192, R2, C2);
#pragma unroll
                    for (int h = 0; h < 2; ++h) oA[h][i] = (unsigned)S.gather_row(nxt, h * HALF + R2) * (unsigned)(S.lda * P::ES) + (unsigned)(C2 * 2); } } }
            GE_LDB(B1, 0, 1); GE_STAGEB(GE_SB(0, 0), b2);
            SBAR(); WAITL(0); GE_MMA(0, 1, At, B1); SBAR();
            GE_LDA(At, 0, 1); GE_STAGEA(GE_SA(0, 0), a2, 0);
            SBAR(); WAITL(0); GE_MMA(1, 0, At, B0); SBAR(); SCHED();
            GE_STAGEB(GE_SB(0, 1), b2 + hstepB);
            WAITV(6); SBAR(); GE_MMA(1, 1, At, B1); SBAR();
            GE_LDB(B0, 1, 0); SCHED(); GE_LDA(At, 1, 0); GE_STAGEA(GE_SA(0, 1), a2, 1);
            WAITL(8); SBAR(); WAITL(0); GE_MMA(0, 0, At, B0); SBAR(); SCHED();
            GE_LDB(B1, 1, 1); GE_STAGEB(GE_SB(1, 0), b3);
            SBAR(); WAITL(0); GE_MMA(0, 1, At, B1); SBAR();
            GE_LDA(At, 1, 1); GE_STAGEA(GE_SA(1, 0), a3, 0);
            SBAR(); WAITL(0); GE_MMA(1, 0, At, B0); SBAR(); SCHED();
            GE_STAGEB(GE_SB(1, 1), b3 + hstepB);
            WAITV(6); SBAR(); GE_MMA(1, 1, At, B1); SBAR();
            }
        }
        if (wr == 0) SBAR();
        S.epi(acc, cur, wr, wc, fr, fq);
        if (!has_next) break;
#pragma unroll
        for (int a = 0; a < 2; ++a)
#pragma unroll
            for (int b = 0; b < 2; ++b)
#pragma unroll
                for (int m = 0; m < 4; ++m)
#pragma unroll
                    for (int n = 0; n < 2; ++n) acc[a][b][m][n] = (f32x4){0.f, 0.f, 0.f, 0.f};
        cur = nxt; cA = nA; cB = nB; ++ui;
        if (wr == 1) SBAR();
    }
    WAITV(0);
    SBAR();
#undef GE_SA
#undef GE_SB
#undef GE_STAGEA
#undef GE_STAGEB
#undef GE_LDA
#undef GE_LDB
#undef GE_MMA
#undef GE_LO
#undef GE_HI
#undef GE_LD1
}
}
using ge::Unit;

struct Params {
    const float* in[26];
    float* out; unsigned char* ws;
    int ph_lo, ph_hi;
};
enum { I_X = 0, I_C, I_CTX, I_CCTX, I_ADAW, I_ADAB, I_NMIX, I_NFFN, I_POOLW, I_POOLS, I_INW, I_CONVW, I_CONVB, I_ALOG, I_DTB, I_DSKIP, I_SNORM, I_OUTW,
       I_W1, I_W3, I_W2, I_RW, I_MW1, I_MW3, I_MW2, I_FNORM };

struct Frame {
    LAS unsigned char* lds;
    int tid, lane, wave, G, bx;
    const Params* p;
    unsigned char* ws;
    unsigned* ctl;
    float* H; float* mod;
};
#ifdef EMU
DEV const float* INP(const Frame& F, int i) { return F.p->in[i]; }
DEV float* OUTP(const Frame& F) { return F.p->out; }
DEV unsigned char* WSP(const Frame& F) { return F.p->ws; }
#define LAUNDER_S(x) ((void)0)
#else
typedef const float* cfptr_t;
DEV const float* INP(const Frame&, int i) { int k = i; asm volatile("" : "+s"(k)); return ((const __attribute__((address_space(4))) cfptr_t*)__builtin_amdgcn_kernarg_segment_ptr())[k]; }
DEV float* OUTP(const Frame& F) { return (float*)INP(F, 26); }
DEV unsigned char* WSP(const Frame& F) { return (unsigned char*)INP(F, 27); }
#define LAUNDER_S(x) asm volatile("" : "+s"(x))
#endif
constexpr int LDS_MISC = ge::STAGE_BYTES;
constexpr int LDS_BYTES = ge::STAGE_BYTES + 16384;

struct Src { const float* x; const float* ctx; float* H; const float* mod; };
DEV const float* modq(const float* mod, int layer, int vec, int which) { return mod + ((size_t)(layer * 3 + vec) * 6 + which) * D; }
DEV const float* modp(const Frame& F, int layer, int vec, int which) { return modq(F.mod, layer, vec, which); }
DEV const float* hsrc_row(const Src& s, bool from_input, int r) {
    if (from_input) return r < ML ? s.x + (size_t)r * D : s.ctx + (size_t)(r - ML) * D;
    return s.H + (size_t)r * D;
}
DEV Src mksrc(const Frame& F) { Src s; s.x = INP(F, I_X); s.ctx = INP(F, I_CTX); s.H = F.H; s.mod = F.mod; return s; }
DEV const float* hin_row(const Frame& F, int layer, int r) { return hsrc_row(mksrc(F), layer == 0, r); }

struct RmId { DEV int operator()(int n0) const { return n0; } };
struct RmIlv { int s; DEV int operator()(int n0) const { return (n0 >> 7) * 256 + s * 128 + (n0 & 127); } };
template <int K, int N, bool F8, class RM>
DEV void convert_job_t(const Frame& F, const float* Wsrc, void* WTv, int ldt, RM rowmap, float scale) {
    LAS float* scr = (LAS float*)(F.lds + F.wave * 16384);
    constexpr int items = (K / 64) * (N / 32), nblk = N / 32; const int gw = F.bx * 8 + F.wave, NGW = F.G * 8, lane = F.lane;
    float nx[32];
#define CJ_LOAD(it_) do { const int _kb = (it_) / nblk, _nb = (it_) % nblk; const float* _p = Wsrc + (size_t)(64 * _kb + (lane >> 5)) * N + 32 * _nb + (lane & 31); \
        _Pragma("unroll") for (int i = 0; i < 32; ++i) nx[i] = _p[(size_t)(2 * i) * N]; } while (0)
    if (gw < items) CJ_LOAD(gw);
    for (int it = gw; it < items; it += NGW) {
        const int kb = it / nblk, nb = it % nblk, k0 = 64 * kb, n0 = 32 * nb;
#pragma unroll
        for (int i = 0; i < 32; ++i) { const int kk = 2 * i + (lane >> 5); scr[kk * 33 + (lane & 31)] = F8 ? nx[i] * scale : nx[i]; }
        if (it + NGW < items) CJ_LOAD(it + NGW);
        WSYNC();
        const int c = lane & 7; const int row0 = rowmap(n0);
#pragma unroll
        for (int j = 0; j < 4; ++j) { const int n = (lane >> 3) + 8 * j; const LAS float* sp = scr + (8 * c) * 33 + n;
            if (F8) { u32x2 o; o.x = pk4_fp8(sp[0 * 33], sp[1 * 33], sp[2 * 33], sp[3 * 33]); o.y = pk4_fp8(sp[4 * 33], sp[5 * 33], sp[6 * 33], sp[7 * 33]);
                *(u32x2*)((fp8_t*)WTv + (size_t)(row0 + n) * ldt + k0 + 8 * c) = o; }
            else { u32x4 o; o.x = pk2(sp[0 * 33], sp[1 * 33]); o.y = pk2(sp[2 * 33], sp[3 * 33]); o.z = pk2(sp[4 * 33], sp[5 * 33]); o.w = pk2(sp[6 * 33], sp[7 * 33]);
                *(u32x4*)((bf16_t*)WTv + (size_t)(row0 + n) * ldt + k0 + 8 * c) = o; } }
        WSYNC();
    }
#undef CJ_LOAD
}
template <int K, int N, class RM> DEV void convert_job(const Frame& F, const float* Wsrc, bf16_t* WT, int ldt, RM rm) { convert_job_t<K, N, false>(F, Wsrc, WT, ldt, rm, 1.0f); }
template <int K, int N, class RM> DEV void convert_job_fp8(const Frame& F, const float* Wsrc, fp8_t* WT, int ldt, RM rm, float scale) { convert_job_t<K, N, true>(F, Wsrc, WT, ldt, rm, scale); }
DEV bool idle_subgrid(Frame& F2, int nwg) { const int rem = nwg % F2.G; if (rem == 0) return true; if (F2.bx < rem) return false; F2.bx -= rem; F2.G -= rem; return true; }
constexpr int MOE_UP_EARLY = 3;
DEV void convert_even(const Frame& F, int j) {
    bf16_t* Wb = (bf16_t*)(F.ws + OFF_W);
    for (int g = 0; g < 4; ++g) convert_job<256, 256>(F, INP(F, I_POOLW) + ((size_t)j * 4 + g) * 65536, Wb + W_POOL / 2 + (size_t)g * 65536, 256, RmId{});
    convert_job<D, DFF>(F, INP(F, I_W1) + (size_t)j * D * DFF, Wb + W_UP / 2, D, RmIlv{0});
    convert_job<D, DFF>(F, INP(F, I_W3) + (size_t)j * D * DFF, Wb + W_UP / 2, D, RmIlv{1});
    if (FFN_DOWN_FP8) convert_job_fp8<DFF, D>(F, INP(F, I_W2) + (size_t)j * DFF * D, (fp8_t*)(F.ws + OFF_W) + W_DN, DFF, RmId{}, 64.0f);
    else convert_job<DFF, D>(F, INP(F, I_W2) + (size_t)j * DFF * D, Wb + W_DN / 2, DFF, RmId{});
}
DEV void convert_ssd(const Frame& F, int j) {
    bf16_t* Wb = (bf16_t*)(F.ws + OFF_W);
    convert_job<D, NPROJ>(F, INP(F, I_INW) + (size_t)j * D * NPROJ, Wb + W_IN / 2, D, RmId{});
    convert_job<DIN, D>(F, INP(F, I_OUTW) + (size_t)j * DIN * D, Wb + W_OUT / 2, DIN, RmId{});
    { u32x4* z = (u32x4*)(Wb + W_IN / 2 + (size_t)NPROJ * D); const int n16 = (NPROJP - NPROJ) * D * 2 / 16;
      unsigned zz = 0u; LAUNDER_V(zz);
      for (int i = F.bx * 512 + F.tid; i < n16; i += F.G * 512) z[i] = (u32x4){zz, zz, zz, zz}; }
}
DEV void convert_moe(const Frame& F, int j, int up_lo, int up_hi, bool down) {
    fp8_t* Wb = (fp8_t*)(F.ws + OFF_W);
    for (int e = 0; e < NEXP; ++e) {
        if (e >= up_lo && e < up_hi) {
        convert_job_fp8<D, DFFE>(F, INP(F, I_MW1) + ((size_t)j * NEXP + e) * D * DFFE, Wb + W_MUP + (size_t)e * 2 * DFFE * D, D, RmIlv{0}, 32.0f);
        convert_job_fp8<D, DFFE>(F, INP(F, I_MW3) + ((size_t)j * NEXP + e) * D * DFFE, Wb + W_MUP + (size_t)e * 2 * DFFE * D, D, RmIlv{1}, 32.0f); }
        if (!down) continue;
        if (MOE_DOWN_FP8) convert_job_fp8<DFFE, D>(F, INP(F, I_MW2) + ((size_t)j * NEXP + e) * DFFE * D, Wb + W_MDN + (size_t)e * D * DFFE, DFFE, RmId{}, 64.0f);
        else convert_job<DFFE, D>(F, INP(F, I_MW2) + ((size_t)j * NEXP + e) * DFFE * D, (bf16_t*)(Wb + W_MDN) + (size_t)e * D * DFFE, DFFE, RmId{});
    }
}

DEV void phase_mod(const Frame& F) {
    LAS float* red = (LAS float*)F.lds;
    LAS float* sc = (LAS float*)(F.lds + 8192);
    constexpr int nblk = DEPTH * 6144 / 32;
    const int col = F.tid & 31, ks = F.tid >> 5;
    for (int i = F.tid; i < 3 * D; i += 512) { const int v = i >> 10, k = i & (D - 1); sc[i] = siluf(v == 2 ? INP(F, I_CCTX)[k] : INP(F, I_C)[v * D + k]); }
    __syncthreads();
    for (int blk = F.bx; blk < nblk; blk += F.G) {
        const int layer = (blk * 32) / 6144, n = (blk * 32) % 6144 + col;
        const float* W = INP(F, I_ADAW) + (size_t)layer * D * 6144 + n;
        float a0 = 0.f, a1 = 0.f, a2 = 0.f;
#pragma unroll 1
        for (int kb = ks * 64; kb < ks * 64 + 64; kb += 16) {
            float wv[16];
#pragma unroll
            for (int k = 0; k < 16; ++k) wv[k] = W[(size_t)(kb + k) * 6144];
#pragma unroll
            for (int k = 0; k < 16; ++k) { a0 += sc[kb + k] * wv[k]; a1 += sc[D + kb + k] * wv[k]; a2 += sc[2 * D + kb + k] * wv[k]; } }
        red[(ks * 32 + col) * 3 + 0] = a0; red[(ks * 32 + col) * 3 + 1] = a1; red[(ks * 32 + col) * 3 + 2] = a2;
        __syncthreads();
        if (F.tid < 96) { const int c2 = F.tid & 31, v = F.tid >> 5; float s = 0.f;
            for (int q = 0; q < 16; ++q) s += red[(q * 32 + c2) * 3 + v];
            const int n2 = (blk * 32) % 6144 + c2;
            F.mod[(size_t)(layer * 3 + v) * 6144 + n2] = s + INP(F, I_ADAB)[(size_t)layer * 6144 + n2]; }
        __syncthreads();
    }
}

DEV void load_row(const float* p, int lane, f32x4 (&v)[4]) {
#pragma unroll
    for (int j = 0; j < 4; ++j) v[j] = *(const f32x4*)(p + 4 * lane + 256 * j);
}
DEV float sumsq_row(const f32x4 (&v)[4]) { float s = 0.f;
#pragma unroll
    for (int j = 0; j < 4; ++j) s += (v[j][0] * v[j][0] + v[j][1] * v[j][1]) + (v[j][2] * v[j][2] + v[j][3] * v[j][3]);
    return wave_sum(s); }
struct ModRow { f32x4 wc[4], sv[4]; int vec; };
DEV void modrow_set(ModRow& m, int vec, const float* w, const float* sh, const float* sc, int lane) {
    m.vec = vec;
#pragma unroll
    for (int j = 0; j < 4; ++j) { const int c = 4 * lane + 256 * j; m.wc[j] = *(const f32x4*)(w + c) * (*(const f32x4*)(sc + c) + 1.0f); m.sv[j] = *(const f32x4*)(sh + c); }
}
DEV void modrow_apply(f32x4 (&v)[4], float rstd, const ModRow& m) {
#pragma unroll
    for (int j = 0; j < 4; ++j) v[j] = v[j] * rstd * m.wc[j] + m.sv[j];
}
DEV void normmod_row(f32x4 (&v)[4], float rstd, const float* w, const float* sh, const float* sc, int lane) {
#pragma unroll
    for (int j = 0; j < 4; ++j) { const int c = 4 * lane + 256 * j; const f32x4 wv = *(const f32x4*)(w + c), sv = *(const f32x4*)(sh + c), cv = *(const f32x4*)(sc + c);
        v[j] = v[j] * rstd * wv * (cv + 1.0f) + sv; }
}
DEV void store_row_bf16(bf16_t* o, int lane, const f32x4 (&v)[4]) {
#pragma unroll
    for (int j = 0; j < 4; ++j) { u32x2 w; w.x = pk2(v[j][0], v[j][1]); w.y = pk2(v[j][2], v[j][3]); *(u32x2*)(o + 4 * lane + 256 * j) = w; }
}

struct CtxFix { const float* PART; int S, layer, which; const float* scale; bool from_input; float ascale; };
DEV void phase_norm(const Frame& F, int layer, int which, bf16_t* out, bool from_input, const CtxFix fx) {
    const int gw = F.bx * 8 + F.wave, NGW = F.G * 8;
    const float* w = INP(F, which == 0 ? I_NMIX : I_NFFN) + (size_t)layer * D;
    const int nrows = fx.PART ? ML : MT;
    constexpr int NS = 3;
    f32x4 ns[NS][4]; ModRow mr; mr.vec = -1;
#pragma unroll
    for (int k = 0; k < NS; ++k) if (gw + k * NGW < nrows) load_row(hsrc_row(mksrc(F), from_input, gw + k * NGW), F.lane, ns[k]);
    for (int r0 = gw; r0 < nrows; r0 += NS * NGW) {
#pragma unroll
        for (int k = 0; k < NS; ++k) { const int r = r0 + k * NGW; if (r >= nrows) break;
            f32x4 v[4];
#pragma unroll
            for (int q = 0; q < 4; ++q) v[q] = ns[k][q];
            if (r + NS * NGW < nrows) load_row(hsrc_row(mksrc(F), from_input, r + NS * NGW), F.lane, ns[k]);
            const float rstd = rsqrtf(sumsq_row(v) * (1.0f / D) + EPS);
            const int vec = vec_of(r);
            if (vec != mr.vec) modrow_set(mr, vec, w, modp(F, layer, vec, which), modp(F, layer, vec, which + 1), F.lane);
            modrow_apply(v, rstd, mr);
            store_row_bf16(out + (size_t)r * D, F.lane, v); }
    }
    if (fx.PART) {
        const Src src = mksrc(F); const float* gp = modq(src.mod, fx.layer, 2, fx.which);
        for (int r = ML + gw; r < MT; r += NGW) {
            f32x4 v[4], y[4], g[4];
            load_row(hsrc_row(src, fx.from_input, r), F.lane, v); load_row(gp, F.lane, g);
            if (fx.scale) { f32x4 sc[4]; load_row(fx.scale, F.lane, sc);
#pragma unroll
                for (int q = 0; q < 4; ++q) g[q] = g[q] * sc[q]; }
#pragma unroll
            for (int q = 0; q < 4; ++q) y[q] = (f32x4){0.f, 0.f, 0.f, 0.f};
            int sl = 0;
            for (; sl + 2 <= fx.S; sl += 2) { f32x4 t0[4], t1[4];
                load_row(fx.PART + ((size_t)sl * MC + (r - ML)) * D, F.lane, t0); load_row(fx.PART + ((size_t)(sl + 1) * MC + (r - ML)) * D, F.lane, t1);
#pragma unroll
                for (int q = 0; q < 4; ++q) { y[q] += t0[q]; y[q] += t1[q]; } }
            for (; sl < fx.S; ++sl) { f32x4 t0[4]; load_row(fx.PART + ((size_t)sl * MC + (r - ML)) * D, F.lane, t0);
#pragma unroll
                for (int q = 0; q < 4; ++q) y[q] += t0[q]; }
#pragma unroll
            for (int q = 0; q < 4; ++q) { v[q] = v[q] + g[q] * (y[q] * fx.ascale); *(f32x4*)(src.H + (size_t)r * D + 4 * F.lane + 256 * q) = v[q]; }
            const float rstd = rsqrtf(sumsq_row(v) * (1.0f / D) + EPS);
            if (mr.vec != 2) modrow_set(mr, 2, w, modp(F, layer, 2, which), modp(F, layer, 2, which + 1), F.lane);
            modrow_apply(v, rstd, mr);
            store_row_bf16(out + (size_t)r * D, F.lane, v); }
    }
}

struct TokInfo { int s0, s1; float g0, g1; };
DEV void phase_poolprep(const Frame& F, int layer, bf16_t* P, bool fuse, const bf16_t* YS) {
    const TokInfo* tok = (const TokInfo*)(F.ws + OFF_TOK);
    LAS bf16_t* ub = (LAS bf16_t*)(F.lds);
    LAS float* rs = (LAS float*)(F.lds + 81920);
    const float* w = INP(F, I_NMIX) + (size_t)layer * D;
    constexpr int CTH = 4, NLT = ML / 64; const int ntile = NLT + MC / CTH;
    const int chunk = F.tid & 127, tg = F.tid >> 7;
    for (int tile = F.bx; tile < ntile; tile += F.G) {
        const int r0 = tile < NLT ? tile * 64 : ML + (tile - NLT) * CTH; const int th = tile < NLT ? 64 : CTH;
        if (r0 < ML) {
            LAS bf16_t* ul = (LAS bf16_t*)(F.lds);
            const int vec = vec_of(r0);
            { f32x4 wc[4], sv[4], g2[4];
#pragma unroll
              for (int jq = 0; jq < 4; ++jq) { const int c = 4 * F.lane + 256 * jq; wc[jq] = *(const f32x4*)(w + c) * (*(const f32x4*)(modp(F, layer, vec, 1) + c) + 1.0f); sv[jq] = *(const f32x4*)(modp(F, layer, vec, 0) + c);
                  g2[jq] = fuse ? *(const f32x4*)(modp(F, layer - 1, vec, 5) + c) * (MOE_DOWN_FP8 ? 0.00390625f : 1.0f) : (f32x4){0.f, 0.f, 0.f, 0.f}; }
              f32x4 nh[4]; u32x2 nya[4], nyb[4]; TokInfo tn; tn.s0 = tn.s1 = 0; tn.g0 = tn.g1 = 0.f;
              { const int r = r0 + F.wave; load_row(hin_row(F, layer, r), F.lane, nh);
                if (fuse) { tn = tok[r];
#pragma unroll
                    for (int jq = 0; jq < 4; ++jq) { const int c = 4 * F.lane + 256 * jq; nya[jq] = *(const u32x2*)(YS + (size_t)tn.s0 * D + c); nyb[jq] = *(const u32x2*)(YS + (size_t)tn.s1 * D + c); } } }
#pragma unroll 1
              for (int k = 0; k < 8; ++k) { const int rl = F.wave + 8 * k, r = r0 + rl;
                  f32x4 v[4]; u32x2 ya[4], yb[4]; const TokInfo ti = tn;
#pragma unroll
                  for (int q = 0; q < 4; ++q) { v[q] = nh[q]; ya[q] = nya[q]; yb[q] = nyb[q]; }
                  if (k < 7) { load_row(hin_row(F, layer, r + 8), F.lane, nh);
                      if (fuse) { tn = tok[r + 8];
#pragma unroll
                          for (int jq = 0; jq < 4; ++jq) { const int c = 4 * F.lane + 256 * jq; nya[jq] = *(const u32x2*)(YS + (size_t)tn.s0 * D + c); nyb[jq] = *(const u32x2*)(YS + (size_t)tn.s1 * D + c); } } }
                  if (fuse) {
#pragma unroll
                      for (int jq = 0; jq < 4; ++jq) { const u32x2 a = ya[jq], b = yb[jq];
                          v[jq][0] += g2[jq][0] * (ti.g0 * bflo(a.x) + ti.g1 * bflo(b.x)); v[jq][1] += g2[jq][1] * (ti.g0 * bfhi(a.x) + ti.g1 * bfhi(b.x));
                          v[jq][2] += g2[jq][2] * (ti.g0 * bflo(a.y) + ti.g1 * bflo(b.y)); v[jq][3] += g2[jq][3] * (ti.g0 * bfhi(a.y) + ti.g1 * bfhi(b.y));
                          *(f32x4*)(F.H + (size_t)r * D + 4 * F.lane + 256 * jq) = v[jq]; } }
                  const float rstd = rsqrtf(sumsq_row(v) * (1.0f / D) + EPS);
#pragma unroll
                  for (int jq = 0; jq < 4; ++jq) { const f32x4 u = v[jq] * rstd * wc[jq] + sv[jq]; u32x2 pw; pw.x = pk2(u[0], u[1]); pw.y = pk2(u[2], u[3]);
                      *(LAS u32x2*)(ul + rl * 1024 + 4 * F.lane + 256 * jq) = pw; } } }
            __syncthreads();
            { const int cq = F.tid & 255, hf = F.tid >> 8, c = cq * 4, g = c >> 8, win = 2 << g, lo = win >> 1, hi = win - 1 - lo;
#define PL_U(t_) ({ const u32x2 _q = *(const LAS u32x2*)(ul + (t_) * 1024 + c); (f32x4){bflo(_q.x), bfhi(_q.x), bflo(_q.y), bfhi(_q.y)}; })
              const int ta = 32 * hf;
              f32x4 sacc = (f32x4){0.f, 0.f, 0.f, 0.f};
              { const int a = (ta - lo > 0) ? ta - lo : 0, b = (ta + hi + 1 < 64) ? ta + hi + 1 : 64; for (int t = a; t < b; ++t) sacc += PL_U(t); }
              for (int t = ta; t < ta + 32; ++t) {
                  const int a = (t - lo > 0) ? t - lo : 0, b = (t + hi + 1 < 64) ? t + hi + 1 : 64;
                  const float inv = 1.0f / (float)(b - a);
                  const f32x4 o = sacc * inv - PL_U(t);
                  u32x2 pw; pw.x = pk2(o[0], o[1]); pw.y = pk2(o[2], o[3]); *(u32x2*)(P + (size_t)(r0 + t) * D + c) = pw;
                  if (t + 1 < ta + 32) { if (t + 1 + hi < 64) sacc += PL_U(t + 1 + hi); if (t - lo >= 0) sacc -= PL_U(t - lo); } }
#undef PL_U
            }
            __syncthreads();
            continue;
        }
        int seq0, seq1;
        if (r0 < ML) { seq0 = r0; seq1 = r0 + 64; } else { seq0 = ML + ((r0 - ML) / CTXL) * CTXL; seq1 = seq0 + CTXL; }
        const int lo_r = (r0 - 8 > seq0) ? r0 - 8 : seq0, hi_r = (r0 + th + 7 < seq1) ? r0 + th + 7 : seq1;
        const int nrow = hi_r - lo_r;
        for (int rb = lo_r + F.wave; rb < hi_r; rb += 16) {
            f32x4 v5[2][4];
#pragma unroll
            for (int k = 0; k < 2; ++k) { const int r = rb + 8 * k; if (r < hi_r) load_row(hin_row(F, layer, r), F.lane, v5[k]); }
#pragma unroll
            for (int k = 0; k < 2; ++k) { const int r = rb + 8 * k; if (r < hi_r) { const float ss = sumsq_row(v5[k]); if (F.lane == 0) rs[r - lo_r] = rsqrtf(ss * (1.0f / D) + EPS); } } }
        __syncthreads();
        const int vec = vec_of(r0);
#pragma unroll 1
        for (int half = 0; half < 2; ++half) {
            const int c = half * 512 + 4 * chunk, g = c >> 8, win = 2 << g, lo = win >> 1, hi = win - 1 - lo;
            const f32x4 wv = *(const f32x4*)(w + c), sv = *(const f32x4*)(modp(F, layer, vec, 0) + c), cv = *(const f32x4*)(modp(F, layer, vec, 1) + c) + 1.0f;
            const f32x4 wc = wv * cv;
#pragma unroll 1
            for (int kb = 0; kb < 20; kb += 5) {
                f32x4 hv[5];
#pragma unroll
                for (int k = 0; k < 5; ++k) { const int rr = tg + 4 * (kb + k); if (rr < nrow) hv[k] = *(const f32x4*)(hin_row(F, layer, lo_r + rr) + c); }
#pragma unroll
                for (int k = 0; k < 5; ++k) { const int rr = tg + 4 * (kb + k); if (rr < nrow) { const f32x4 u = hv[k] * rs[rr] * wc + sv;
                    u32x2 pw; pw.x = pk2(u[0], u[1]); pw.y = pk2(u[2], u[3]); *(LAS u32x2*)(ub + rr * 512 + 4 * chunk) = pw; } } }
            __syncthreads();
#define PP_U(r_) ({ const u32x2 _q = *(const LAS u32x2*)(ub + ((r_) - lo_r) * 512 + 4 * chunk); (f32x4){bflo(_q.x), bfhi(_q.x), bflo(_q.y), bfhi(_q.y)}; })
            const int tq = th >> 2, ta = r0 + tq * tg;
            f32x4 s = (f32x4){0.f, 0.f, 0.f, 0.f};
            { const int a = (ta - lo > seq0) ? ta - lo : seq0, b = (ta + hi + 1 < seq1) ? ta + hi + 1 : seq1; for (int r = a; r < b; ++r) s += PP_U(r); }
            for (int t = ta; t < ta + tq; ++t) {
                const int a = (t - lo > seq0) ? t - lo : seq0, b = (t + hi + 1 < seq1) ? t + hi + 1 : seq1;
                const float inv = 1.0f / (float)(b - a);
                const f32x4 o = s * inv - PP_U(t);
                u32x2 pw; pw.x = pk2(o[0], o[1]); pw.y = pk2(o[2], o[3]); *(u32x2*)(P + (size_t)t * D + c) = pw;
                if (t + 1 < ta + tq) {
                    if (t + 1 + hi < seq1) s += PP_U(t + 1 + hi);
                    if (t - lo >= seq0) s -= PP_U(t - lo); }
            }
#undef PP_U
            __syncthreads();
        }
    }
}

struct PolBase { int G, c; static constexpr bool VARK = false; };
DEV bool ctx_next(int npan, int nsl, int G, int c, int i, Unit& u) {
    const int nmain = npan * 4; const long L = (long)i * G + c;
    if (L < nmain) return ge::static_next(npan, 4, G, c, i, u);
    const long L2 = L - nmain; if (L2 >= 8L * nsl) return false;
    const int t = (int)(L2 & 7); u.pm = ML / 256 + (t >> 2); u.pn = (t & 3) + 4 * (1 + (int)(L2 >> 3)); return true;
}
DEV int ctx_koff(const Unit& u) { return (u.pn >> 2) ? ((u.pn >> 2) - 1) * 128 : 0; }
DEV void ctx_store(float* PART, const f32x4 (&acc)[2][2][4][2], const Unit& u, int wr, int wc, int fr, int fq) {
    float* o = PART + ((size_t)((u.pn >> 2) - 1) * MC + (u.pm * 256 - ML) + wr * 64 + fr) * D + (u.pn & 3) * 256 + wc * 32 + 4 * fq;
#pragma unroll
    for (int ai = 0; ai < 2; ++ai)
#pragma unroll
        for (int m = 0; m < 4; ++m)
#pragma unroll
            for (int bj = 0; bj < 2; ++bj)
#pragma unroll
                for (int n = 0; n < 2; ++n) *(f32x4*)(o + (size_t)(ai * 128 + m * 16) * D + bj * 128 + n * 16) = acc[ai][bj][m][n];
}
struct PolPool : PolBase {
    static constexpr bool PERM = false, GATHER = false; static constexpr bool FP8 = false; static constexpr int ES = 2; int K, lda, ldb;
    static constexpr bool VARK = true;
    const bf16_t* P; const bf16_t* W; Src src; int layer, npan; const float* scale; float* PART;
    DEV bool next(int i, Unit& u) const { return ctx_next(npan, 2, G, c, i, u); }
    DEV int unit_nt(const Unit& u) const { return (u.pn >> 2) ? 2 : 4; }
    DEV const char* a_base(const Unit& u) const { return (const char*)(P + (size_t)u.pm * 256 * D + (u.pn & 3) * 256 + ctx_koff(u)); }
    DEV const char* b_base(const Unit& u) const { return (const char*)(W + (size_t)(u.pn & 3) * 65536 + ctx_koff(u)); }
    DEV void epi(const f32x4 (&acc)[2][2][4][2], const Unit& u, int wr, int wc, int fr, int fq) const {
        if (u.pn >> 2) { ctx_store(PART, acc, u, wr, wc, fr, fq); return; }
        const int row0 = u.pm * 256 + wr * 64 + fr, col0 = u.pn * 256 + wc * 32 + 4 * fq; const int vec = vec_of(u.pm * 256);
        const float* g1 = modq(src.mod, layer, vec, 2);
        f32x4 gv[2][2];
#pragma unroll
        for (int bj = 0; bj < 2; ++bj)
#pragma unroll
            for (int n = 0; n < 2; ++n) { const int cc = col0 + bj * 128 + n * 16; gv[bj][n] = *(const f32x4*)(g1 + cc) * *(const f32x4*)(scale + cc); }
#pragma unroll
        for (int ai = 0; ai < 2; ++ai)
#pragma unroll
            for (int mp = 0; mp < 4; mp += 2) { f32x4 hv[2][2][2];
#pragma unroll
                for (int m2 = 0; m2 < 2; ++m2) { const float* hi = hsrc_row(src, layer == 0, row0 + ai * 128 + (mp + m2) * 16) + col0;
#pragma unroll
                    for (int bj = 0; bj < 2; ++bj)
#pragma unroll
                        for (int n = 0; n < 2; ++n) hv[m2][bj][n] = *(const f32x4*)(hi + bj * 128 + n * 16); }
#pragma unroll
                for (int m2 = 0; m2 < 2; ++m2) { float* ho = src.H + (size_t)(row0 + ai * 128 + (mp + m2) * 16) * D + col0;
#pragma unroll
                    for (int bj = 0; bj < 2; ++bj)
#pragma unroll
                        for (int n = 0; n < 2; ++n) *(f32x4*)(ho + bj * 128 + n * 16) = hv[m2][bj][n] + gv[bj][n] * acc[ai][bj][mp + m2][n]; } }
    }
};
template <bool F8>
struct PolResid : PolBase {
    static constexpr bool PERM = false, GATHER = F8; static constexpr bool FP8 = F8; static constexpr int ES = F8 ? 1 : 2; int K, lda, ldb;
    static constexpr bool VARK = true;
    const bf16_t* A; const bf16_t* W; Src src; int layer, which, npan, nsl; float* PART;
    DEV bool next(int i, Unit& u) const { return ctx_next(npan, nsl, G, c, i, u); }
    DEV int unit_nt(const Unit& u) const { return (u.pn >> 2) ? 2 : K * ES / 128; }
    DEV int gather_row(const Unit& u, int R) const { return u.pm * 256 + R; }
    DEV const char* a_base(const Unit& u) const { return (const char*)A + (GATHER ? (size_t)0 : (size_t)u.pm * 256 * lda * ES) + ctx_koff(u) * 2; }
    DEV const char* b_base(const Unit& u) const { return (const char*)W + (size_t)(u.pn & 3) * 256 * ldb * ES + ctx_koff(u) * 2; }
    DEV void epi(const f32x4 (&acc)[2][2][4][2], const Unit& u, int wr, int wc, int fr, int fq) const {
        if (u.pn >> 2) { ctx_store(PART, acc, u, wr, wc, fr, fq); return; }
        const int row0 = u.pm * 256 + wr * 64 + fr, col0 = u.pn * 256 + wc * 32 + 4 * fq; const int vec = vec_of(u.pm * 256);
        const float* gp = modq(src.mod, layer, vec, which);
        f32x4 gv[2][2];
#pragma unroll
        for (int bj = 0; bj < 2; ++bj)
#pragma unroll
            for (int n = 0; n < 2; ++n) gv[bj][n] = *(const f32x4*)(gp + col0 + bj * 128 + n * 16) * (F8 ? 0.00390625f : 1.0f);
#pragma unroll
        for (int ai = 0; ai < 2; ++ai)
#pragma unroll
            for (int mp = 0; mp < 4; mp += 2) { f32x4 hv[2][2][2];
#pragma unroll
                for (int m2 = 0; m2 < 2; ++m2) { const float* hi = src.H + (size_t)(row0 + ai * 128 + (mp + m2) * 16) * D + col0;
#pragma unroll
                    for (int bj = 0; bj < 2; ++bj)
#pragma unroll
                        for (int n = 0; n < 2; ++n) hv[m2][bj][n] = *(const f32x4*)(hi + bj * 128 + n * 16); }
#pragma unroll
                for (int m2 = 0; m2 < 2; ++m2) { float* ho = src.H + (size_t)(row0 + ai * 128 + (mp + m2) * 16) * D + col0;
#pragma unroll
                    for (int bj = 0; bj < 2; ++bj)
#pragma unroll
                        for (int n = 0; n < 2; ++n) *(f32x4*)(ho + bj * 128 + n * 16) = hv[m2][bj][n] + gv[bj][n] * acc[ai][bj][mp + m2][n]; } }
    }
};
template <bool MOE>
struct PolUp : PolBase {
    static constexpr bool PERM = true, GATHER = MOE, FP8 = MOE; static constexpr int ES = MOE ? 1 : 2; int K, lda, ldb;
    const bf16_t* A; const bf16_t* W; bf16_t* HID; int ldh, nq;
    int nM; const int* s2t; int tstart[NEXP + 1];
    DEV bool next(int i, Unit& u) const { return ge::static_next(MOE ? nM : NPAN, nq, G, c, i, u); }
    DEV int expert_of(int pm) const { int e = 0;
#pragma unroll
        for (int k = 1; k < NEXP; ++k) e += (pm >= tstart[k]) ? 1 : 0;
        return e; }
    DEV const char* a_base(const Unit& u) const { return MOE ? (const char*)A : (const char*)(A + (size_t)u.pm * 256 * lda); }
    DEV const char* b_base(const Unit& u) const { size_t off = (size_t)u.pn * 256 * ldb; if (MOE) off += (size_t)expert_of(u.pm) * 2 * DFFE * ldb; return (const char*)W + off * ES; }
    DEV int gather_row(const Unit& u, int R) const { return s2t[u.pm * 256 + R]; }
    DEV void epi(const f32x4 (&acc)[2][2][4][2], const Unit& u, int wr, int wc, int fr, int fq) const {
        const int row0 = u.pm * 256 + wr * 64 + fr, col0 = u.pn * 128 + wc * 32 + 8 * fq;
#pragma unroll
        for (int ai = 0; ai < 2; ++ai)
#pragma unroll
            for (int m = 0; m < 4; ++m) { bf16_t* o = HID + (size_t)(row0 + ai * 128 + m * 16) * ldh + col0;
                float h[8];
                constexpr bool H8 = MOE ? (MOE_DOWN_FP8 != 0) : (FFN_DOWN_FP8 != 0);
                constexpr float SG = MOE ? 0.00390625f : 1.0f, SU = MOE ? (MOE_DOWN_FP8 ? 0.015625f : 0.00390625f) : (FFN_DOWN_FP8 ? 4.0f : 1.0f);
                const f32x2 ke = {-1.4426950408889634f * SG, -1.4426950408889634f * SG}, ks = {SG * SU, SG * SU}, one = {1.0f, 1.0f};
#pragma unroll
                for (int n = 0; n < 2; ++n)
#pragma unroll
                    for (int ip = 0; ip < 2; ++ip) { const f32x2 g = {acc[ai][0][m][n][2 * ip], acc[ai][0][m][n][2 * ip + 1]}, u = {acc[ai][1][m][n][2 * ip], acc[ai][1][m][n][2 * ip + 1]};
                        const f32x2 t = g * ke; const f32x2 d = (f32x2){fexp2(t.x), fexp2(t.y)} + one; const f32x2 r = {frcp(d.x), frcp(d.y)};
                        const f32x2 hh = (MOE || H8) ? (g * u) * (r * ks) : (g * u) * r; h[4 * n + 2 * ip] = hh.x; h[4 * n + 2 * ip + 1] = hh.y; }
                if (H8) { u32x2 w8; w8.x = pk4_fp8(h[0], h[1], h[2], h[3]); w8.y = pk4_fp8(h[4], h[5], h[6], h[7]);
                    *(u32x2*)((fp8_t*)HID + (size_t)(row0 + ai * 128 + m * 16) * ldh + col0) = w8; }
                else { u32x4 w; w.x = pk2(h[0], h[1]); w.y = pk2(h[2], h[3]); w.z = pk2(h[4], h[5]); w.w = pk2(h[6], h[7]); *(u32x4*)o = w; } }
    }
};
struct PolMoeDown : PolBase {
    static constexpr bool PERM = true, GATHER = (MOE_DOWN_FP8 != 0), FP8 = (MOE_DOWN_FP8 != 0); static constexpr int ES = MOE_DOWN_FP8 ? 1 : 2; int K, lda, ldb;
    const bf16_t* A; const bf16_t* W; bf16_t* YS; int nM; int tstart[NEXP + 1];
    DEV bool next(int i, Unit& u) const { return ge::static_next(nM, 4, G, c, i, u); }
    DEV int expert_of(int pm) const { int e = 0;
#pragma unroll
        for (int k = 1; k < NEXP; ++k) e += (pm >= tstart[k]) ? 1 : 0;
        return e; }
    DEV const char* a_base(const Unit& u) const { return GATHER ? (const char*)A : (const char*)A + (size_t)u.pm * 256 * lda * ES; }
    DEV int gather_row(const Unit& u, int R) const { return u.pm * 256 + R; }
    DEV const char* b_base(const Unit& u) const { return (const char*)W + ((size_t)expert_of(u.pm) * D + (size_t)u.pn * 256) * ldb * ES; }
    DEV void epi(const f32x4 (&acc)[2][2][4][2], const Unit& u, int wr, int wc, int fr, int fq) const {
        const int row0 = u.pm * 256 + wr * 64 + fr, col0 = u.pn * 256 + wc * 32 + 8 * fq;
#pragma unroll
        for (int ai = 0; ai < 2; ++ai)
#pragma unroll
            for (int m = 0; m < 4; ++m) { bf16_t* o = YS + (size_t)(row0 + ai * 128 + m * 16) * D + col0;
#pragma unroll
                for (int bj = 0; bj < 2; ++bj) { u32x4 w; w.x = pk2(acc[ai][bj][m][0][0], acc[ai][bj][m][0][1]); w.y = pk2(acc[ai][bj][m][0][2], acc[ai][bj][m][0][3]);
                    w.z = pk2(acc[ai][bj][m][1][0], acc[ai][bj][m][1][1]); w.w = pk2(acc[ai][bj][m][1][2], acc[ai][bj][m][1][3]); *(u32x4*)(o + bj * 128) = w; } }
    }
};
struct PolInProj : PolBase {
    static constexpr bool PERM = true, GATHER = false; static constexpr bool FP8 = false; static constexpr int ES = 2; int K, lda, ldb;
    const bf16_t* A; const bf16_t* W; bf16_t* Z; bf16_t* XBC; float* DT;
    DEV bool next(int i, Unit& u) const { return ge::static_next(NPAN, NPROJP / 256, G, c, i, u); }
    DEV const char* a_base(const Unit& u) const { return (const char*)(A + (size_t)u.pm * 256 * lda); }
    DEV const char* b_base(const Unit& u) const { return (const char*)(W + (size_t)u.pn * 256 * ldb); }
    DEV void epi(const f32x4 (&acc)[2][2][4][2], const Unit& u, int wr, int wc, int fr, int fq) const {
        const int row0 = u.pm * 256 + wr * 64 + fr, cw = wc * 32 + 8 * fq;
        if (u.pn < 20) {
            bf16_t* base; size_t ld, bjs; int col0;
            if (u.pn < 8) { base = Z; ld = DIN; col0 = u.pn * 256 + cw; bjs = 128; }
            else { base = XBC + (size_t)((u.pn - 8) * 4 + (wc >> 1)) * MT * 64; ld = 64; col0 = (wc & 1) * 32 + 8 * fq; bjs = (size_t)2 * MT * 64; }
#pragma unroll
            for (int ai = 0; ai < 2; ++ai)
#pragma unroll
                for (int m = 0; m < 4; ++m) { bf16_t* o = base + (size_t)(row0 + ai * 128 + m * 16) * ld + col0;
#pragma unroll
                    for (int bj = 0; bj < 2; ++bj) { u32x4 w; w.x = pk2(acc[ai][bj][m][0][0], acc[ai][bj][m][0][1]); w.y = pk2(acc[ai][bj][m][0][2], acc[ai][bj][m][0][3]);
                        w.z = pk2(acc[ai][bj][m][1][0], acc[ai][bj][m][1][1]); w.w = pk2(acc[ai][bj][m][1][2], acc[ai][bj][m][1][3]); *(u32x4*)(o + bj * bjs) = w; } }
        } else if (cw < 64) {
#pragma unroll
            for (int ai = 0; ai < 2; ++ai)
#pragma unroll
                for (int m = 0; m < 4; ++m) { const int r = row0 + ai * 128 + m * 16; int b, tv;
                    if (r < ML) { b = r / SEQ; tv = CTXL + r % SEQ; } else { b = (r - ML) / CTXL; tv = (r - ML) % CTXL; }
#pragma unroll
                    for (int n = 0; n < 2; ++n)
#pragma unroll
                        for (int i = 0; i < 4; ++i) { const int j = cw + 4 * n + i, dir = j >> 5, h = j & 31;
                            DT[((size_t)(b * 2 + dir) * NH + h) * TV + tv] = acc[ai][0][m][n][i]; } }
        }
    }
};

DEV void phase_conv(const Frame& F, int j, const bf16_t* XBC, bf16_t* XT, bf16_t* Brow, bf16_t* BT, bf16_t* Crow) {
    LAS bf16_t* tl0 = (LAS bf16_t*)F.lds;
    const float* cw = INP(F, I_CONVW) + (size_t)j * 4 * CONVD; const float* cb = INP(F, I_CONVB) + (size_t)j * CONVD;
    constexpr int NPER = NB * NCH, nitem = NPER * (CONVD / 64);
    const int t2 = 2 * (F.tid >> 3), cg = F.tid & 7;
    const int i0 = (int)(((long)F.bx * nitem) / F.G), i1 = (int)(((long)(F.bx + 1) * nitem) / F.G);
    int cblk_cur = -1; f32x4 wv[4][2], bv[2]; int par = 0;
#define CV_LOAD(it_, q_) do { const int _cb = (it_) / NPER, _rs = (it_) % NPER, _b = _rs / NCH, _cv = _rs % NCH; const int _ch = _cb * 64 + cg * 8, _tv = _cv * 128 + t2; \
        const int _s0 = _tv < CTXL ? 0 : CTXL, _s1 = _tv < CTXL ? CTXL : TV; \
        _Pragma("unroll") for (int k = 0; k < 5; ++k) { const int tk = _tv - 2 + k; q_[k] = (u32x4){0u, 0u, 0u, 0u}; \
            if (tk >= _s0 && tk < _s1) q_[k] = *(const u32x4*)(XBC + ((size_t)_cb * MT + row_of(_b, tk)) * 64 + cg * 8); } } while (0)
    u32x4 qn[5];
    if (i0 < i1) CV_LOAD(i0, qn);
    for (int it = i0; it < i1; ++it) {
        const int cblk = it / NPER, rest = it % NPER, b = rest / NCH, cv = rest % NCH;
        const int ch0 = cblk * 64 + cg * 8;
        if (cblk != cblk_cur) { cblk_cur = cblk;
#pragma unroll
            for (int k = 0; k < 4; ++k) { wv[k][0] = *(const f32x4*)(cw + k * CONVD + ch0); wv[k][1] = *(const f32x4*)(cw + k * CONVD + ch0 + 4); }
            bv[0] = *(const f32x4*)(cb + ch0); bv[1] = *(const f32x4*)(cb + ch0 + 4); }
        const int tv = cv * 128 + t2;
        f32x2 xin[5][4];
#pragma unroll
        for (int k = 0; k < 5; ++k) { const u32x4 q = qn[k];
            xin[k][0] = (f32x2){bflo(q.x), bfhi(q.x)}; xin[k][1] = (f32x2){bflo(q.y), bfhi(q.y)}; xin[k][2] = (f32x2){bflo(q.z), bfhi(q.z)}; xin[k][3] = (f32x2){bflo(q.w), bfhi(q.w)}; }
        if (it + 1 < i1) CV_LOAD(it + 1, qn);
        unsigned pk[2][4];
#pragma unroll
        for (int o = 0; o < 2; ++o) {
#pragma unroll
            for (int i = 0; i < 4; ++i) { f32x2 acc = (f32x2){bv[i >> 1][2 * (i & 1)], bv[i >> 1][2 * (i & 1) + 1]};
#pragma unroll
                for (int k = 0; k < 4; ++k) acc = (f32x2){wv[k][i >> 1][2 * (i & 1)], wv[k][i >> 1][2 * (i & 1) + 1]} * xin[o + k][i] + acc;
                const f32x2 t = acc * (f32x2){-1.4426950408889634f, -1.4426950408889634f}; const f32x2 d = (f32x2){fexp2(t.x), fexp2(t.y)} + (f32x2){1.0f, 1.0f};
                const f32x2 sv = acc * (f32x2){frcp(d.x), frcp(d.y)};
                pk[o][i] = pk2(sv.x, sv.y); } }
        const int r = row_of(b, tv);
        const bool isx = cblk < DIN / 64, isb = !isx && cblk < (DIN + BCD) / 64;
        if (!isx) {
            const int chc = ch0 - DIN - (isb ? 0 : BCD); bf16_t* o = (isb ? Brow : Crow) + (size_t)(r - t2) * BCD + (chc >> 7) * 16384 + frag_off(t2, chc & 127);
            *(u32x4*)o = (u32x4){pk[0][0], pk[0][1], pk[0][2], pk[0][3]}; *(u32x4*)(o + 8) = (u32x4){pk[1][0], pk[1][1], pk[1][2], pk[1][3]}; }
        if (isx || isb) {
            LAS bf16_t* tl = tl0 + par * (64 * 136); par ^= 1;
#pragma unroll
            for (int i = 0; i < 4; ++i) { const unsigned lo = (pk[0][i] & 0xffffu) | (pk[1][i] << 16), hi = (pk[0][i] >> 16) | (pk[1][i] & 0xffff0000u);
                *(LAS unsigned*)(tl + (cg * 8 + 2 * i) * 136 + t2) = lo; *(LAS unsigned*)(tl + (cg * 8 + 2 * i + 1) * 136 + t2) = hi; }
            __syncthreads();
            if (isx) { bf16_t* dst = XT + ((size_t)(b * NCH + cv) * DIN + cblk * 64) * 128;
#pragma unroll
                for (int q = 0; q < 2; ++q) { const int idx = F.tid + q * 512, ch = idx >> 4, t8 = (idx & 15) * 8;
                    *(u32x4*)(dst + idx * 8) = *(const LAS u32x4*)(tl + ch * 136 + t8); }
            } else {
                const int chb = cblk * 64 - DIN; bf16_t* dst = BT + (size_t)((b * NCH + cv) * NG + (chb >> 7)) * 16384 + ((chb & 127) >> 4) * 2048;
#pragma unroll
                for (int q = 0; q < 2; ++q) { const int idx = F.tid + q * 512, fr_ = idx & 15, fq_ = (idx >> 4) & 3, ks_ = (idx >> 6) & 3, rbl = idx >> 8;
                    *(u32x4*)(dst + idx * 8) = *(const LAS u32x4*)(tl + (rbl * 16 + fr_) * 136 + (ks_ * 4 + fq_) * 8); }
            }
        }
    }
}

#undef CV_LOAD
DEV void phase_cb(const Frame& F, const bf16_t* Brow, const bf16_t* Crow, bf16_t* CB) {
    const int nitem = NB * NG * NCH; const int fr = F.lane & 15, fq = F.lane >> 4;
    for (int it = F.bx; it < nitem; it += F.G) {
        const int cv = it % NCH, g = (it / NCH) % NG, b = it / (NCH * NG);
        const int rbase = row_of(b, cv * 128);
        const bf16_t* ct = Crow + (size_t)rbase * BCD + g * 16384 + F.lane * 8; const bf16_t* bt_ = Brow + (size_t)rbase * BCD + g * 16384 + F.lane * 8;
        bf16x8 cf[4], bfr[8][4];
#pragma unroll
        for (int ks = 0; ks < 4; ++ks) cf[ks] = *(const bf16x8*)(ct + (F.wave * 4 + ks) * 512);
#pragma unroll
        for (int nt = 0; nt < 8; ++nt)
#pragma unroll
            for (int ks = 0; ks < 4; ++ks) bfr[nt][ks] = *(const bf16x8*)(bt_ + (nt * 4 + ks) * 512);
        bf16_t* out = CB + ((size_t)((b * NG + g) * NCH + cv)) * 16384;
#pragma unroll
        for (int nt = 0; nt < 8; ++nt) {
            f32x4 acc = (f32x4){0.f, 0.f, 0.f, 0.f};
#pragma unroll
            for (int ks = 0; ks < 4; ++ks) acc = MFMA16(bfr[nt][ks], cf[ks], acc);
            u32x2 w; w.x = pk2(acc[0], acc[1]); w.y = pk2(acc[2], acc[3]);
            *(u32x2*)(out + frag_off(16 * F.wave + fr, 16 * nt + 4 * fq)) = w;
        }
    }
}

DEV void phase_tables(const Frame& F, int j, float* DT, float* CUM, float* WJ, float* CF) {
    const int nitem = NB * 2 * NH * NCH; const int gw = F.bx * 8 + F.wave, NGW = F.G * 8;
    f32x2 rawn = (f32x2){0.f, 0.f}; float aln = 0.f, dbn = 0.f;
#define TB_HP(it_) ((size_t)(j * 2 + (((it_) / (NCH * NH)) & 1)) * NH + (((it_) / NCH) % NH))
    if (gw < nitem) { rawn = *(const f32x2*)(DT + (size_t)gw * 128 + 2 * F.lane); aln = INP(F, I_ALOG)[TB_HP(gw)]; dbn = INP(F, I_DTB)[TB_HP(gw)]; }
    for (int it = gw; it < nitem; it += NGW) {
        const int cv = it % NCH, h = (it / NCH) % NH, dir = (it / (NCH * NH)) & 1, b = it / (NCH * NH * 2);
        const float A = -expf(aln); const float bias = dbn;
        const size_t o = ((size_t)(b * 2 + dir) * NH + h) * TV + cv * 128 + 2 * F.lane;
        const f32x2 raw = rawn; if (it + NGW < nitem) { rawn = *(const f32x2*)(DT + (size_t)(it + NGW) * 128 + 2 * F.lane); aln = INP(F, I_ALOG)[TB_HP(it + NGW)]; dbn = INP(F, I_DTB)[TB_HP(it + NGW)]; }
        const float d0 = softplusf(raw.x + bias), d1 = softplusf(raw.y + bias); const float a0 = d0 * A, a1 = d1 * A;
        float c0, c1, tot, sum = a0 + a1;
        if (dir == 0) {
#pragma unroll
            for (int q = 1; q < 64; q <<= 1) { const float t2 = __shfl_up(sum, q); if (F.lane >= q) sum += t2; }
            c1 = sum; c0 = sum - a1; tot = __shfl(sum, 63);
        } else {
#pragma unroll
            for (int q = 1; q < 64; q <<= 1) { const float t2 = __shfl_down(sum, q); if (F.lane + q < 64) sum += t2; }
            c0 = sum; c1 = sum - a0; tot = __shfl(sum, 0);
        }
        constexpr float L2E = 1.4426950408889634f;
        *(f32x2*)(DT + o) = (f32x2){c0 * L2E - flog2(d0), c1 * L2E - flog2(d1)};
        *(f32x2*)(CUM + o) = (f32x2){c0 * L2E, c1 * L2E};
        *(f32x2*)(WJ + o) = (f32x2){d0 * FEXP(tot - c0), d1 * FEXP(tot - c1)};
        const float cref = L2E * __shfl(dir == 0 ? c1 : c0, dir == 0 ? (F.lane | 15) : (F.lane & ~15));
        *(f32x2*)(CF + o) = (f32x2){d0 * fexp2(cref - c0 * L2E), d1 * fexp2(cref - c1 * L2E)};
    }
}

constexpr int SC_HL = 0, SC_TAB = 17408, SC_X = 21504, SC_END = SC_X + 16384;
static_assert(SC_END <= ge::STAGE_BYTES, "scan LDS map");
DEV void phase_scan(const Frame& F, int j, const bf16_t* XT, const bf16_t* BT, const bf16_t* Crow, const bf16_t* CB, const float* DT, const float* CUM, const float* WJ, const float* CF, bf16_t* Yf, bf16_t* Yb) {
    LAS unsigned char* L = F.lds;
    LAS bf16_t* Hl = (LAS bf16_t*)(L + SC_HL);
    LAS float* tab = (LAS float*)(L + SC_TAB);
    const int fr = F.lane & 15, fq = F.lane >> 4, w = F.wave;
    const int rb = w < 4 ? w : 11 - w;
    const int nitem = NB * NH * 2 * 2;
    for (int it = F.bx; it < nitem; it += F.G) {
        const int xq = it & 7, kq = it >> 3; const int b = xq >> 2, g = xq & 3, h = 8 * g + (kq >> 2), dir = (kq >> 1) & 1, ph = kq & 1;
        const float Dsk = dir == 0 ? INP(F, I_DSKIP)[(size_t)j * NH + h] : 0.f;
        const size_t tbase = ((size_t)(b * 2 + dir) * NH + h) * TV;
        const bf16_t* xt = XT + ((size_t)b * NCH * DIN + h * HD + ph * 32) * 128;
        const bf16_t* bt = BT + (size_t)(b * NCH * NG + g) * 16384;
        const bf16_t* CBh = CB + (size_t)((b * NG + g) * NCH) * 16384;
        const bf16_t* Cg = Crow + g * 16384;
        bf16_t* Y = (dir ? Yb : Yf) + h * HD + ph * 32;
        const int lrow = 16 * rb + fr;
        const int prow[2] = {8 * (fr >> 2) + (fr & 3), 8 * (fr >> 2) + 4 + (fr & 3)};
        f32x4 accH[2]; accH[0] = (f32x4){0.f, 0.f, 0.f, 0.f}; accH[1] = accH[0];
        for (int i = F.tid; i < 32 * 136 / 2; i += 512) ((LAS unsigned*)Hl)[i] = 0u;
#define SC_CHUNK_OF(step) (dir == 0 ? (step) : ((step) < 2 ? 1 - (step) : (NCH - 1) - ((step) - 2)))
        const int xr = 4 * w + (F.lane >> 4), xc = F.lane & 15;
        const unsigned lxs = (unsigned)(xr * 128 + 8 * xc) * 2u, lxd = (unsigned)(xr * 256 + ((xc ^ (xr & 15)) << 4));
#define SC_LD_X(cvx_) (*(const u32x4*)((const char*)(xt + (size_t)(cvx_) * (DIN * 128)) + lxs))
#define SC_ST_X(xb_, v_) (*(LAS u32x4*)(L + SC_X + (xb_) * 8192 + lxd) = (v_))
        const float* tsrcw = ((w >> 1) == 0 ? CUM : ((w >> 1) == 1 ? DT : ((w >> 1) == 2 ? WJ : CF))) + tbase + (w & 1) * 64 + F.lane;
#define SC_LD_TAB(cvx_) (tsrcw[(cvx_) * 128])
#define SC_ST_TAB(tbuf_, v_) (tab[(tbuf_) * 512 + w * 64 + F.lane] = (v_))
        const unsigned lfo = (unsigned)(rb * 4096 + F.lane * 16);
#define SC_LD_CB(cvx_, ks_) (*(const u32x4*)((const char*)(CBh + (size_t)(cvx_) * 16384u) + lfo + (ks_) * 1024))
#define SC_LD_BT(cvx_, ks_) (*(const u32x4*)((const char*)(bt + (size_t)(cvx_) * 65536u) + lfo + (ks_) * 1024))
#define SC_LD_C(rbx_, ks_) (*(const bf16x8*)((const char*)(Cg + (size_t)(rbx_) * BCD) + lfo + (ks_) * 1024))
        const int kd = rb >> 1; float km[8], dk[8];
        if ((dir == 0) == (rb >= 4)) SETPRIO(1); else SETPRIO(0);
#pragma unroll
        for (int i = 0; i < 8; ++i) { const int sidx = 32 * kd + 8 * fq + i; km[i] = (dir == 0 ? (sidx <= lrow) : (sidx >= lrow)) ? 1.f : 0.f; dk[i] = (sidx == lrow) ? Dsk : 0.f; }
        u32x4 rcb[4], rbt[4]; bf16x8 cf[4];
        { const int cv0 = SC_CHUNK_OF(0); const u32x4 x0 = SC_LD_X(cv0); const float t0 = SC_LD_TAB(cv0); const unsigned rb0 = (unsigned)row_of(b, cv0 * 128);
#pragma unroll
          for (int ks = 0; ks < 4; ++ks) { rcb[ks] = SC_LD_CB(cv0, ks); rbt[ks] = SC_LD_BT(cv0, ks); cf[ks] = SC_LD_C(rb0, ks); }
          SC_ST_X(0, x0); SC_ST_TAB(0, t0); }
        for (int step = 0; step < NCH; ++step) {
            int kdl = kd, dirl = dir; LAUNDER_S(kdl); LAUNDER_S(dirl);
            const int cv = SC_CHUNK_OF(step), buf = step & 1; const bool more = step + 1 < NCH;
            const int cvn = more ? SC_CHUNK_OF(step + 1) : cv;
            const unsigned rbase = (unsigned)row_of(b, cv * 128), rbn = (unsigned)row_of(b, cvn * 128);
            LDSBAR();
            const u32x4 xn = SC_LD_X(cvn); const float tn = SC_LD_TAB(cvn);
            const LAS float* tb = tab + buf * 512;
            const float cl2 = tb[lrow]; const float ecum_l = fexp2(cl2);
            const float chunk_decay = fexp2(dir == 0 ? tb[127] : tb[0]);
            f32x4 yd[2], yo[2];
#pragma unroll
            for (int nt = 0; nt < 2; ++nt) { yd[nt] = (f32x4){0.f, 0.f, 0.f, 0.f}; yo[nt] = yd[nt]; accH[nt] = accH[nt] * chunk_decay; }
#pragma unroll
            for (int ks = 0; ks < 4; ++ks) { const int s0 = 32 * ks + 8 * fq; bf16x8 mfk, bwk;
                const bool none = dirl == 0 ? (ks > kdl) : (ks < kdl), diag = (ks == kdl);
                unsigned om[4] = {0u, 0u, 0u, 0u};
                if (!none) {
                    const unsigned qc[4] = {rcb[ks].x, rcb[ks].y, rcb[ks].z, rcb[ks].w};
                    if (!diag) {
                        const f32x4 f0 = *(const LAS f32x4*)(tb + 384 + s0), f1 = *(const LAS f32x4*)(tb + 384 + s0 + 4);
                        const float rowf = fexp2(cl2 - tb[dirl == 0 ? 32 * ks + 31 : 32 * ks]);
                        const f32x2 rf2 = {rowf, rowf};
                        const f32x2 c2[4] = {(f32x2){f0[0], f0[1]}, (f32x2){f0[2], f0[3]}, (f32x2){f1[0], f1[1]}, (f32x2){f1[2], f1[3]}};
#pragma unroll
                        for (int i = 0; i < 4; ++i) { const f32x2 v2 = (f32x2){bflo(qc[i]), bfhi(qc[i])} * (c2[i] * rf2); om[i] = pk2(v2.x, v2.y); }
                    } else {
                        const f32x4 cs0 = *(const LAS f32x4*)(tb + 128 + s0), cs1 = *(const LAS f32x4*)(tb + 128 + s0 + 4);
                        const float cs[8] = {cs0[0], cs0[1], cs0[2], cs0[3], cs1[0], cs1[1], cs1[2], cs1[3]};
                        float v[8];
#pragma unroll
                        for (int i = 0; i < 8; ++i) { const float cbv = (i & 1) ? bfhi(qc[i >> 1]) : bflo(qc[i >> 1]); const float x = cl2 - cs[i]; v[i] = (cbv * fexp2(x < 60.f ? x : 60.f)) * km[i] + dk[i]; }
#pragma unroll
                        for (int i = 0; i < 4; ++i) om[i] = pk2(v[2 * i], v[2 * i + 1]);
                    }
                    rcb[ks] = SC_LD_CB(cvn, ks);
                }
                mfk = __builtin_bit_cast(bf16x8, (u32x4){om[0], om[1], om[2], om[3]});
                { const f32x4 ws0 = *(const LAS f32x4*)(tb + 256 + s0), ws1 = *(const LAS f32x4*)(tb + 256 + s0 + 4);
                  const f32x2 w2[4] = {(f32x2){ws0[0], ws0[1]}, (f32x2){ws0[2], ws0[3]}, (f32x2){ws1[0], ws1[1]}, (f32x2){ws1[2], ws1[3]}};
                  const unsigned qb[4] = {rbt[ks].x, rbt[ks].y, rbt[ks].z, rbt[ks].w}; unsigned ob[4];
#pragma unroll
                  for (int i = 0; i < 4; ++i) { const f32x2 v2 = (f32x2){bflo(qb[i]), bfhi(qb[i])} * w2[i]; ob[i] = pk2(v2.x, v2.y); LAUNDER_V(ob[i]); }
                  bwk = __builtin_bit_cast(bf16x8, (u32x4){ob[0], ob[1], ob[2], ob[3]}); }
                rbt[ks] = SC_LD_BT(cvn, ks);
#pragma unroll
                for (int nt = 0; nt < 2; ++nt) {
                    const bf16x8 xf = *(const LAS bf16x8*)(L + SC_X + buf * 8192 + prow[nt] * 256 + (((4 * ks + fq) ^ (prow[nt] & 15)) << 4));
                    if (!none) yd[nt] = MFMA16(xf, mfk, yd[nt]);
                    const bf16x8 hf = *(const LAS bf16x8*)(Hl + buf * (32 * 136) + prow[nt] * 136 + 32 * ks + 8 * fq);
                    yo[nt] = MFMA16(hf, cf[ks], yo[nt]);
                    accH[nt] = MFMA16(bwk, xf, accH[nt]); } }
#pragma unroll
            for (int ks = 0; ks < 4; ++ks) cf[ks] = SC_LD_C(rbn, ks);
            SC_ST_X(buf ^ 1, xn); SC_ST_TAB(buf ^ 1, tn);
#pragma unroll
            for (int nt = 0; nt < 2; ++nt) { u32x2 hw; hw.x = pk2(accH[nt][0], accH[nt][1]); hw.y = pk2(accH[nt][2], accH[nt][3]);
                *(LAS u32x2*)(Hl + (buf ^ 1) * (32 * 136) + prow[nt] * 136 + 16 * rb + 4 * fq) = hw; }
            { u32x4 yw; yw.x = pk2(yd[0][0] + ecum_l * yo[0][0], yd[0][1] + ecum_l * yo[0][1]); yw.y = pk2(yd[0][2] + ecum_l * yo[0][2], yd[0][3] + ecum_l * yo[0][3]);
              yw.z = pk2(yd[1][0] + ecum_l * yo[1][0], yd[1][1] + ecum_l * yo[1][1]); yw.w = pk2(yd[1][2] + ecum_l * yo[1][2], yd[1][3] + ecum_l * yo[1][3]);
              *(u32x4*)(Y + ((size_t)(rbase + lrow) * DIN + 8 * fq)) = yw; }
        }
        WAITV(0); LDSBAR();
        SETPRIO(0);
    }
}

DEV void phase_gate(const Frame& F, int j, const bf16_t* Yf, const bf16_t* Yb, const bf16_t* Z, bf16_t* YN, int nrows) {
    const int gw = F.bx * 8 + F.wave, NGW = F.G * 8; const float* nw = INP(F, I_SNORM) + (size_t)j * DIN;
    u32x4 na[4], nb[4], nz[4];
    if (gw < nrows) {
#pragma unroll
        for (int q = 0; q < 4; ++q) { const size_t o = (size_t)gw * DIN + 8 * F.lane + 512 * q; na[q] = *(const u32x4*)(Yf + o); nb[q] = *(const u32x4*)(Yb + o); nz[q] = *(const u32x4*)(Z + o); } }
    for (int r = gw; r < nrows; r += NGW) {
        float t[32]; float ss = 0.f;
        u32x4 ca[4], cb4[4], cz[4];
#pragma unroll
        for (int q = 0; q < 4; ++q) { ca[q] = na[q]; cb4[q] = nb[q]; cz[q] = nz[q]; }
        if (r + NGW < nrows) {
#pragma unroll
            for (int q = 0; q < 4; ++q) { const size_t o = (size_t)(r + NGW) * DIN + 8 * F.lane + 512 * q; na[q] = *(const u32x4*)(Yf + o); nb[q] = *(const u32x4*)(Yb + o); nz[q] = *(const u32x4*)(Z + o); } }
#pragma unroll
        for (int q = 0; q < 4; ++q) { const u32x4 a = ca[q], bq = cb4[q], z = cz[q];
            const unsigned aa[4] = {a.x, a.y, a.z, a.w}, bb[4] = {bq.x, bq.y, bq.z, bq.w}, zz[4] = {z.x, z.y, z.z, z.w};
#pragma unroll
            for (int i = 0; i < 4; ++i) { const float v0 = (bflo(aa[i]) + bflo(bb[i])) * siluf(bflo(zz[i])), v1 = (bfhi(aa[i]) + bfhi(bb[i])) * siluf(bfhi(zz[i])); t[8 * q + 2 * i] = v0; t[8 * q + 2 * i + 1] = v1; ss += v0 * v0 + v1 * v1; } }
        const float rstd = rsqrtf(wave_sum(ss) * (1.0f / DIN) + EPS);
#pragma unroll
        for (int q = 0; q < 4; ++q) { const int c = 8 * F.lane + 512 * q; const f32x4 w0 = *(const f32x4*)(nw + c), w1 = *(const f32x4*)(nw + c + 4);
            u32x4 o; o.x = pk2(t[8 * q] * rstd * w0[0], t[8 * q + 1] * rstd * w0[1]); o.y = pk2(t[8 * q + 2] * rstd * w0[2], t[8 * q + 3] * rstd * w0[3]);
            o.z = pk2(t[8 * q + 4] * rstd * w1[0], t[8 * q + 5] * rstd * w1[1]); o.w = pk2(t[8 * q + 6] * rstd * w1[2], t[8 * q + 7] * rstd * w1[3]);
            *(u32x4*)(YN + (size_t)r * DIN + c) = o; }
    }
}

DEV void phase_route(const Frame& F, int layer, int ml, bf16_t* V, int nrows) {
    LAS unsigned* lc = (LAS unsigned*)(F.lds + LDS_MISC + 256);
    if (F.tid < 8) lc[F.tid] = 0u;
    __syncthreads();
    const int gw = F.bx * 8 + F.wave, NGW = F.G * 8; const int j = layer / 2;
    const float* w = INP(F, I_NFFN) + (size_t)layer * D; const float* rw = INP(F, I_RW) + (size_t)j * D * NEXP;
    LAS float* rwl = (LAS float*)F.lds;
    for (int q = F.tid; q < D * 2; q += 512) { const int c = q >> 1, hf = q & 1; const int ln = (c & 255) >> 2, ii = c & 3, jq = c >> 8;
        *(LAS f32x4*)(rwl + ((jq * 4 + ii) * 64 + ln) * 8 + hf * 4) = *(const f32x4*)(rw + (size_t)q * 4); }
    __syncthreads();
    TokInfo* tok = (TokInfo*)(F.ws + OFF_TOK);
    constexpr int NS = 2;
    f32x4 ns[NS][4]; ModRow mr; mr.vec = -1;
#pragma unroll
    for (int k = 0; k < NS; ++k) if (gw + k * NGW < nrows) load_row(F.H + (size_t)(gw + k * NGW) * D, F.lane, ns[k]);
    for (int r0 = gw; r0 < nrows; r0 += NS * NGW) {
#pragma unroll
      for (int p = 0; p < NS / 2; ++p) { const int rA = r0 + 2 * p * NGW; if (rA >= nrows) break;
        const int rB = rA + NGW; const bool hasB = rB < nrows; const int rr[2] = {rA, hasB ? rB : rA};
        f32x4 v[2][4];
#pragma unroll
        for (int q = 0; q < 4; ++q) { v[0][q] = ns[2 * p][q]; v[1][q] = ns[2 * p + 1][q]; }
        if (rA + NS * NGW < nrows) load_row(F.H + (size_t)(rA + NS * NGW) * D, F.lane, ns[2 * p]);
        if (rB + NS * NGW < nrows) load_row(F.H + (size_t)(rB + NS * NGW) * D, F.lane, ns[2 * p + 1]);
        const float rstd0 = rsqrtf(sumsq_row(v[0]) * (1.0f / D) + EPS), rstd1 = rsqrtf(sumsq_row(v[1]) * (1.0f / D) + EPS);
#pragma unroll
        for (int q = 0; q < 2; ++q) { const int vec = vec_of(rr[q]);
            if (vec != mr.vec) modrow_set(mr, vec, w, modp(F, layer, vec, 3), modp(F, layer, vec, 4), F.lane);
            modrow_apply(v[q], q ? rstd1 : rstd0, mr);
            if (q == 0 || hasB) {
#pragma unroll
                for (int jq = 0; jq < 4; ++jq) *(unsigned*)((fp8_t*)V + (size_t)rr[q] * D + 4 * F.lane + 256 * jq) = pk4_fp8(v[q][jq][0] * 8.0f, v[q][jq][1] * 8.0f, v[q][jq][2] * 8.0f, v[q][jq][3] * 8.0f); } }
        f32x2 lg2[2][4];
#pragma unroll
        for (int e = 0; e < 4; ++e) { lg2[0][e] = (f32x2){0.f, 0.f}; lg2[1][e] = lg2[0][e]; }
#pragma unroll
        for (int jj = 0; jj < 4; ++jj)
#pragma unroll
            for (int i = 0; i < 4; ++i) { const LAS float* rp = rwl + ((jj * 4 + i) * 64 + F.lane) * 8; const f32x4 r0 = *(const LAS f32x4*)rp, r1 = *(const LAS f32x4*)(rp + 4);
                const f32x2 w0 = {r0[0], r0[1]}, w1 = {r0[2], r0[3]}, w2 = {r1[0], r1[1]}, w3 = {r1[2], r1[3]};
#pragma unroll
                for (int q = 0; q < 2; ++q) { const f32x2 vv = {v[q][jj][i], v[q][jj][i]};
                    lg2[q][0] = vv * w0 + lg2[q][0]; lg2[q][1] = vv * w1 + lg2[q][1]; lg2[q][2] = vv * w2 + lg2[q][2]; lg2[q][3] = vv * w3 + lg2[q][3]; }
                if (i == 3) SCHED(); }
#pragma unroll
        for (int q = 0; q < 2; ++q) { float lg[NEXP];
#pragma unroll
            for (int e = 0; e < 4; ++e) { lg[2 * e] = wave_sum(lg2[q][e].x); lg[2 * e + 1] = wave_sum(lg2[q][e].y); }
            int e0 = 0; float v0 = lg[0];
#pragma unroll
            for (int e = 1; e < NEXP; ++e) if (lg[e] > v0) { v0 = lg[e]; e0 = e; }
            int e1 = -1; float v1 = -3.0e38f;
#pragma unroll
            for (int e = 0; e < NEXP; ++e) if (e != e0 && lg[e] > v1) { v1 = lg[e]; e1 = e; }
            const float g1 = frcp(1.0f + FEXP(v0 - v1)), g0 = 1.0f - g1;
            if (F.lane == 0 && (q == 0 || hasB)) { TokInfo ti; ti.s0 = e0; ti.s1 = e1; ti.g0 = g0; ti.g1 = g1; tok[rr[q]] = ti; atomicAdd((unsigned*)&lc[e0], 1u); atomicAdd((unsigned*)&lc[e1], 1u); } }
      }
    }
    __syncthreads();
    if (F.tid < 8) __hip_atomic_fetch_add(F.ctl + CW_CNT + (ml * 8 + F.tid) * 64, lc[F.tid], RLX_AGENT);
}
DEV void tile_starts(const Frame& F, int ml, int (&ts)[NEXP + 1], unsigned (&cnt)[NEXP]) {
    ts[0] = 0;
#pragma unroll
    for (int e = 0; e < NEXP; ++e) { cnt[e] = __hip_atomic_load(F.ctl + CW_CNT + (ml * 8 + e) * 64, RLX_AGENT); ts[e + 1] = ts[e] + (int)((cnt[e] + 255u) / 256u); }
}
DEV void phase_slots(const Frame& F, int ml, int nrows) {
    int ts[NEXP + 1]; unsigned cnt[NEXP]; tile_starts(F, ml, ts, cnt);
    TokInfo* tok = (TokInfo*)(F.ws + OFF_TOK); int* s2t = (int*)(F.ws + OFF_S2T);
    const int gw = F.bx * 8 + F.wave, NGW = F.G * 8;
    for (int base = gw * 64; base < nrows; base += NGW * 64) {
        const int r = base + F.lane; TokInfo ti = tok[r];
        unsigned long long m0[NEXP], m1[NEXP]; unsigned mycnt = 0;
#pragma unroll
        for (int e = 0; e < NEXP; ++e) { m0[e] = __ballot(ti.s0 == e); m1[e] = __ballot(ti.s1 == e); if (F.lane == e) mycnt = (unsigned)(__builtin_popcountll(m0[e]) + __builtin_popcountll(m1[e])); }
        unsigned b0 = 0;
        if (F.lane < NEXP && mycnt) b0 = __hip_atomic_fetch_add(F.ctl + CW_CUR + (ml * 8 + F.lane) * 64, mycnt, RLX_AGENT);
        const unsigned long long below = (1ull << F.lane) - 1ull; int sl0 = 0, sl1 = 0;
#pragma unroll
        for (int e = 0; e < NEXP; ++e) { const unsigned be = __shfl(b0, e); const int c0 = __builtin_popcountll(m0[e]);
            if (ti.s0 == e) sl0 = ts[e] * 256 + (int)be + __builtin_popcountll(m0[e] & below);
            if (ti.s1 == e) sl1 = ts[e] * 256 + (int)be + c0 + __builtin_popcountll(m1[e] & below); }
        ti.s0 = sl0; ti.s1 = sl1; tok[r] = ti; s2t[sl0] = r; s2t[sl1] = r;
    }
    if (F.bx == 0) { for (int e = 0; e < NEXP; ++e) { const int a = ts[e] * 256 + (int)cnt[e], b2 = ts[e + 1] * 256; for (int s = a + F.tid; s < b2; s += 512) s2t[s] = 0; } }
}
DEV void phase_combine(const Frame& F, int layer, const bf16_t* YS, bool final_) {
    const int NGW = F.G * 8; const int gw = F.bx * 8 + F.wave + (final_ ? 0 : ML); const TokInfo* tok = (const TokInfo*)(F.ws + OFF_TOK);
    const int nrows = final_ ? ML : MT;
    f32x4 nh[4]; u32x2 nya[4], nyb[4]; TokInfo tcur, tnxt;
    tcur.s0 = tcur.s1 = 0; tcur.g0 = tcur.g1 = 0.f; tnxt = tcur;
    if (gw < nrows) { tcur = tok[gw]; load_row(F.H + (size_t)gw * D, F.lane, nh);
#pragma unroll
        for (int jj = 0; jj < 4; ++jj) { const int c = 4 * F.lane + 256 * jj; nya[jj] = *(const u32x2*)(YS + (size_t)tcur.s0 * D + c); nyb[jj] = *(const u32x2*)(YS + (size_t)tcur.s1 * D + c); } }
    if (gw + NGW < nrows) tnxt = tok[gw + NGW];
    for (int r = gw; r < nrows; r += NGW) {
        f32x4 v[4]; u32x2 ya[4], yb[4]; TokInfo ti = tcur;
#pragma unroll
        for (int q = 0; q < 4; ++q) { v[q] = nh[q]; ya[q] = nya[q]; yb[q] = nyb[q]; }
        tcur = tnxt;
        if (r + NGW < nrows) { load_row(F.H + (size_t)(r + NGW) * D, F.lane, nh);
#pragma unroll
            for (int jj = 0; jj < 4; ++jj) { const int c = 4 * F.lane + 256 * jj; nya[jj] = *(const u32x2*)(YS + (size_t)tcur.s0 * D + c); nyb[jj] = *(const u32x2*)(YS + (size_t)tcur.s1 * D + c); } }
        if (r + 2 * NGW < nrows) tnxt = tok[r + 2 * NGW];
        if (MOE_DOWN_FP8) { ti.g0 *= 0.00390625f; ti.g1 *= 0.00390625f; }
        const float* g2 = modp(F, layer, vec_of(r), 5);
#pragma unroll
        for (int jj = 0; jj < 4; ++jj) { const int c = 4 * F.lane + 256 * jj; const u32x2 a = ya[jj], b = yb[jj]; const f32x4 gv = *(const f32x4*)(g2 + c);
            v[jj][0] += gv[0] * (ti.g0 * bflo(a.x) + ti.g1 * bflo(b.x)); v[jj][1] += gv[1] * (ti.g0 * bfhi(a.x) + ti.g1 * bfhi(b.x));
            v[jj][2] += gv[2] * (ti.g0 * bflo(a.y) + ti.g1 * bflo(b.y)); v[jj][3] += gv[3] * (ti.g0 * bfhi(a.y) + ti.g1 * bfhi(b.y)); }
        if (!final_) {
#pragma unroll
            for (int jj = 0; jj < 4; ++jj) *(f32x4*)(F.H + (size_t)r * D + 4 * F.lane + 256 * jj) = v[jj];
        } else {
            const float rstd = rsqrtf(sumsq_row(v) * (1.0f / D) + EPS); const float* fw = INP(F, I_FNORM);
#pragma unroll
            for (int jj = 0; jj < 4; ++jj) { const int c = 4 * F.lane + 256 * jj; *(f32x4*)(OUTP(F) + (size_t)r * D + c) = v[jj] * rstd * *(const f32x4*)(fw + c); }
        }
    }
}

constexpr int PH_PER_PAIR = 17, N_PHASES = 1 + 2 * PH_PER_PAIR;
static_assert((size_t)(DFF / 128) * MC * D * 4 <= al(SZ_WMUP) + SZ_WMDN, "context K-slice partials fit the expert-weight region");
__global__ void __launch_bounds__(512, 2) fwd_kernel(Params prm) {
#ifdef EMU
    unsigned char* lds_raw = emu_lds();
#else
    extern __shared__ __attribute__((aligned(16))) unsigned char lds_raw[];
#endif
    Frame F;
    F.lds = (LAS unsigned char*)lds_raw;
    F.tid = threadIdx.x; F.lane = F.tid & 63; F.wave = RFL(F.tid >> 6); F.G = gridDim.x; F.bx = blockIdx.x;
    F.p = &prm; F.ws = prm.ws; F.ctl = (unsigned*)(prm.ws + OFF_CTL); F.H = (float*)(prm.ws + OFF_H); F.mod = (float*)(prm.ws + OFF_MOD);
    volatile LAS unsigned* misc = (volatile LAS unsigned*)(F.lds + LDS_MISC);
    if (F.tid < 64) misc[F.tid] = 0u;
    __syncthreads();
    XcdBarrier bar; bar.bar = F.ctl + CW_BAR; bar.x = 0; bar.st = misc;
    const int lo = prm.ph_lo, hi = prm.ph_hi;
    if (hi - lo > 1) bar = xcd_barrier_post(F.ctl + CW_BAR, misc);
    int ph = 0;
#ifndef SITE_MASK
#define SITE_MASK 0xFFFFFFFFu
#endif
#ifndef PROBE_REPEAT_SITE
#define PROBE_REPEAT_SITE (-1)
#endif
#define PH_REPS(site) ((PROBE_REPEAT_SITE == (site)) ? 2 : 1)
#ifndef PROBE_TS_MASK
#define PROBE_TS_MASK 0u
#endif
#ifndef PROBE_TS_MULT
#define PROBE_TS_MULT 1
#endif
#ifdef EMU
#define NOWT() 0ull
#else
#define NOWT() ((unsigned long long)__builtin_amdgcn_s_memrealtime())
#endif
    unsigned long long tsacc = 0;
#define PHASE_BEGIN(site) if (((SITE_MASK >> (site)) & 1u) && lo <= ph && ph < hi) { { int _t = threadIdx.x; LAUNDER_V(_t); F.tid = _t; F.lane = _t & 63; int _b = blockIdx.x; LAUNDER_S(_b); F.bx = _b; int _g = gridDim.x; LAUNDER_S(_g); F.G = _g; \
      F.ws = WSP(F); F.ctl = (unsigned*)(F.ws + OFF_CTL); F.H = (float*)(F.ws + OFF_H); F.mod = (float*)(F.ws + OFF_MOD); } \
      const bool _tson = ((PROBE_TS_MASK >> (site)) & 1u) != 0u; unsigned long long _ts0 = 0; if (_tson) _ts0 = NOWT(); \
      for (int _rep = 0; _rep < PH_REPS(site); ++_rep) { if (_rep) __syncthreads();
#define PHASE_END   } if (ph + 1 < hi) xcd_barrier(bar); if (_tson) tsacc += NOWT() - _ts0; } ++ph;
#define B_W (F.ws + OFF_W)
#define B_ACT (F.ws + OFF_ACT)
#define B_P ((bf16_t*)(B_ACT + A_P))
#define B_HID ((bf16_t*)(B_ACT + A_HID))
#define B_U ((bf16_t*)(B_ACT + A_U))
#define B_Z ((bf16_t*)(B_ACT + A_Z))
#define B_XBC ((bf16_t*)(B_ACT + A_XBC))
#define B_DT ((float*)(B_W + W_DT))
#define B_XT ((bf16_t*)(B_ACT + A_XT))
#define B_BROW ((bf16_t*)(B_ACT + A_BROW))
#define B_BT ((bf16_t*)(B_ACT + A_BT))
#define B_CROW ((bf16_t*)(B_ACT + A_CROW))
#define B_CB ((bf16_t*)(B_ACT + A_CB))
#define B_CUM ((float*)(B_ACT + A_CUM))
#define B_WJ ((float*)(B_ACT + A_WJ))
#define B_CF ((float*)(B_ACT + A_CF))
#define B_YF ((bf16_t*)(B_ACT + A_YF))
#define B_YB ((bf16_t*)(B_W + W_YB))
#define B_YN ((bf16_t*)(B_ACT + A_YN))
#define B_V ((bf16_t*)(B_ACT + A_V))
#define B_HIDM ((bf16_t*)(B_ACT + A_HIDM))
#define B_YS ((bf16_t*)(B_ACT + A_YS))
#define B_PART ((float*)(B_W + W_MUP))

    PHASE_BEGIN(0) phase_mod(F); convert_even(F, 0); PHASE_END

    for (int lp = 0; lp < 2; ++lp) {
        const int le = 2 * lp, lod = 2 * lp + 1;
        PHASE_BEGIN(1) phase_poolprep(F, le, B_P, lp == 1, B_YS); PHASE_END
        PHASE_BEGIN(2) { PolPool S; S.G = F.G; S.c = F.bx; S.K = 256; S.lda = D; S.ldb = 256; S.P = B_P; S.W = (const bf16_t*)(B_W + W_POOL); S.src = mksrc(F); S.layer = le; S.scale = INP(F, I_POOLS) + (size_t)lp * D; S.npan = ML / 256; S.PART = B_PART;
                      ge::gemm_phase(F.lds, S, F.tid); } PHASE_END
        PHASE_BEGIN(3) { CtxFix fx; fx.PART = B_PART; fx.S = 2; fx.layer = le; fx.which = 2; fx.scale = INP(F, I_POOLS) + (size_t)lp * D; fx.from_input = le == 0; fx.ascale = 1.0f; phase_norm(F, le, 3, B_P, false, fx); } PHASE_END
        PHASE_BEGIN(4) { PolUp<false> S; S.G = F.G; S.c = F.bx; S.K = D; S.lda = D; S.ldb = D; S.A = B_P; S.W = (const bf16_t*)(B_W + W_UP); S.HID = B_HID; S.ldh = DFF; S.nq = DFF / 128; S.nM = NPAN; S.s2t = nullptr;
                      ge::gemm_phase(F.lds, S, F.tid);
                      Frame F2 = F; if (idle_subgrid(F2, NPAN * S.nq)) convert_ssd(F2, lp); } PHASE_END
        PHASE_BEGIN(5) { PolResid<FFN_DOWN_FP8 != 0> S; S.G = F.G; S.c = F.bx; S.K = DFF; S.lda = DFF; S.ldb = DFF; S.A = B_HID; S.W = (const bf16_t*)(B_W + W_DN); S.src = mksrc(F); S.layer = le; S.which = 5; S.npan = ML / 256; S.nsl = DFF / (FFN_DOWN_FP8 ? 256 : 128); S.PART = B_PART;
                      ge::gemm_phase(F.lds, S, F.tid); } PHASE_END

        PHASE_BEGIN(6) { CtxFix fx; fx.PART = B_PART; fx.S = DFF / (FFN_DOWN_FP8 ? 256 : 128); fx.layer = le; fx.which = 5; fx.scale = nullptr; fx.from_input = false; fx.ascale = FFN_DOWN_FP8 ? 0.00390625f : 1.0f; phase_norm(F, lod, 0, B_U, false, fx); } PHASE_END
        PHASE_BEGIN(7) { PolInProj S; S.G = F.G; S.c = F.bx; S.K = D; S.lda = D; S.ldb = D; S.A = B_U; S.W = (const bf16_t*)(B_W + W_IN); S.Z = B_Z; S.XBC = B_XBC; S.DT = B_DT;
                      ge::gemm_phase(F.lds, S, F.tid); } PHASE_END
        PHASE_BEGIN(8) phase_conv(F, lp, B_XBC, B_XT, B_BROW, B_BT, B_CROW); PHASE_END
        PHASE_BEGIN(9) phase_cb(F, B_BROW, B_CROW, B_CB); { Frame F2 = F; if (idle_subgrid(F2, NB * NG * NCH)) phase_tables(F2, lp, B_DT, B_CUM, B_WJ, B_CF); } PHASE_END
        PHASE_BEGIN(10) phase_scan(F, lp, B_XT, B_BT, B_CROW, B_CB, B_DT, B_CUM, B_WJ, B_CF, B_YF, B_YB); PHASE_END
        PHASE_BEGIN(11) phase_gate(F, lp, B_YF, B_YB, B_Z, B_YN, lp == 1 ? ML : MT); PHASE_END
        PHASE_BEGIN(12) { PolResid<false> S; S.G = F.G; S.c = F.bx; S.K = DIN; S.lda = DIN; S.ldb = DIN; S.A = B_YN; S.W = (const bf16_t*)(B_W + W_OUT); S.src = mksrc(F); S.layer = lod; S.which = 2; S.npan = lp == 1 ? ML / 256 : NPAN; S.nsl = 0; S.PART = nullptr;
                      ge::gemm_phase(F.lds, S, F.tid);
                      Frame F2 = F; if (idle_subgrid(F2, S.npan * 4)) convert_moe(F2, lp, 0, MOE_UP_EARLY, true); } PHASE_END
        PHASE_BEGIN(13) phase_route(F, lod, lp, B_V, lp == 1 ? ML : MT); convert_moe(F, lp, MOE_UP_EARLY, NEXP, false); PHASE_END
        PHASE_BEGIN(14) phase_slots(F, lp, lp == 1 ? ML : MT); PHASE_END
        PHASE_BEGIN(15) { int ts[NEXP + 1]; unsigned cnt[NEXP]; tile_starts(F, lp, ts, cnt);
                      PolUp<true> S; S.G = F.G; S.c = F.bx; S.K = D; S.lda = D; S.ldb = D; S.A = B_V; S.W = (const bf16_t*)(B_W + W_MUP); S.HID = B_HIDM; S.ldh = DFFE; S.nq = DFFE / 128; S.nM = ts[NEXP];
                      S.s2t = (const int*)(F.ws + OFF_S2T);
#pragma unroll
                      for (int e = 0; e <= NEXP; ++e) S.tstart[e] = ts[e];
                      ge::gemm_phase(F.lds, S, F.tid); } PHASE_END
        PHASE_BEGIN(16) { int ts[NEXP + 1]; unsigned cnt[NEXP]; tile_starts(F, lp, ts, cnt);
                      PolMoeDown S; S.G = F.G; S.c = F.bx; S.K = DFFE; S.lda = DFFE; S.ldb = DFFE; S.A = B_HIDM; S.W = (const bf16_t*)(B_W + W_MDN); S.YS = B_YS; S.nM = ts[NEXP];
#pragma unroll
                      for (int e = 0; e <= NEXP; ++e) S.tstart[e] = ts[e];
                      ge::gemm_phase(F.lds, S, F.tid);
                      if (lp == 0) { Frame F2 = F; if (idle_subgrid(F2, S.nM * 4)) convert_even(F2, 1); } } PHASE_END
        PHASE_BEGIN(17) phase_combine(F, lod, B_YS, lp == 1); PHASE_END
    }
#undef PHASE_BEGIN
#undef PHASE_END
    if (PROBE_TS_MASK != 0u && blockIdx.x == 0) { const unsigned long long t1 = NOWT(), wt = tsacc * (unsigned long long)PROBE_TS_MULT; while (NOWT() - t1 < wt) { } }
}

extern "C" void kernel_launch(void* const* d_in, const int* in_sizes, int n_in, void* d_out, int out_size, void* d_ws, size_t ws_size, hipStream_t stream) {
    static int grid = 0;
    if (grid == 0) {
        if (n_in != 26 || ws_size < WS_NEED) { fprintf(stderr, "kernel_launch: need 26 inputs and %zu bytes of workspace (got %d, %zu)\n", (size_t)WS_NEED, n_in, ws_size); grid = -1; return; }
        int dev = 0, cus = 0, per_cu = 0;
        if (hipGetDevice(&dev) != hipSuccess || hipDeviceGetAttribute(&cus, hipDeviceAttributeMultiprocessorCount, dev) != hipSuccess) { grid = -1; return; }
        if (hipFuncSetAttribute((const void*)fwd_kernel, hipFuncAttributeMaxDynamicSharedMemorySize, LDS_BYTES) != hipSuccess) { grid = -1; return; }
        if (hipOccupancyMaxActiveBlocksPerMultiprocessor(&per_cu, (const void*)fwd_kernel, 512, LDS_BYTES) != hipSuccess || per_cu < 1) { fprintf(stderr, "kernel_launch: occupancy query says %d\n", per_cu); }
        (void)hipGetLastError();
        grid = cus;
    }
    if (grid < 0) return;
    (void)in_sizes; (void)out_size;
    if (hipMemsetAsync((char*)d_ws + OFF_CTL, 0, CTL_BYTES, stream) != hipSuccess) return;
    Params p{};
    for (int i = 0; i < 26; ++i) p.in[i] = (const float*)d_in[i];
    p.out = (float*)d_out; p.ws = (unsigned char*)d_ws;
    if (N_LAUNCH_MODE == 1) { p.ph_lo = 0; p.ph_hi = N_PHASES; hipLaunchKernelGGL(fwd_kernel, dim3(grid), dim3(512), LDS_BYTES, stream, p); }
    else for (int ph = 0; ph < N_PHASES; ++ph) { p.ph_lo = ph; p.ph_hi = ph + 1; hipLaunchKernelGGL(fwd_kernel, dim3(grid), dim3(512), LDS_BYTES, stream, p); }
}
```
